# Optimizing an MI355X kernel written in HIP

```python
import math
import jax
import jax.numpy as jnp
from jax import lax
import numpy as np

D_MODEL = 1024
BATCH = 2
SEQ = 8192
DEPTH = 2

GRID_W = 64
CTX_LEN = 256
F32 = jnp.float32

N_EVEN = (DEPTH + 1) // 2
N_ODD = DEPTH // 2

RET_WIDTH = D_MODEL // 2
RET_HEADS = 4
RET_HEAD_DIM = RET_WIDTH // RET_HEADS
RET_CHUNK = 128
ROPE_BASE = 10000.0

HY_WIDTH = D_MODEL // 2
HY_ORDER = 2
HY_SHORT = 3
HY_EMB = 33
HY_FFN = 64
HY_SHORT_DECAY_PCT = 0.3
HY_LONG_DECAY_PCT = 1.5
HY_TARGET = 1e-2

AB_IN = 4 * RET_WIDTH + (HY_ORDER + 1) * HY_WIDTH
AB_OUT = RET_WIDTH + HY_WIDTH

GLA_HEADS = 4
GLA_KEY = D_MODEL // 2
GLA_VAL = D_MODEL
GLA_DK = GLA_KEY // GLA_HEADS
GLA_DV = GLA_VAL // GLA_HEADS
GLA_RANK = 16
GLA_TAU = 16.0
GLA_CHUNK = 64
GLA_SPLITS = [GLA_KEY, 2 * GLA_KEY, 2 * GLA_KEY + GLA_VAL, 2 * GLA_KEY + 2 * GLA_VAL,
              2 * GLA_KEY + 2 * GLA_VAL + GLA_RANK]
GLA_IN = 2 * GLA_KEY + 2 * GLA_VAL + 2 * GLA_RANK

N_EXPERTS = 16
N_GROUPS = 4
EXPERTS_PER_GROUP = N_EXPERTS // N_GROUPS
TOP_K = 2
EXPERT_HIDDEN = D_MODEL // 2

DN_ALPHA = (2.0 * DEPTH) ** 0.25
DN_BETA = (8.0 * DEPTH) ** -0.25
LN_EPS = 1e-5

kernel_name = 'hybrid_retention_hyena_gla_moe_dit'


def layer_norm(x, g, b):
    xf = x.astype(F32)
    mu = jnp.mean(xf, axis=-1, keepdims=True)
    var = jnp.mean(jnp.square(xf - mu), axis=-1, keepdims=True)
    return ((xf - mu) * lax.rsqrt(var + LN_EPS) * g.astype(F32) + b.astype(F32)).astype(x.dtype)


def head_layernorm(o):
    of = o.astype(F32)
    mu = jnp.mean(of, axis=-1, keepdims=True)
    var = jnp.mean(jnp.square(of - mu), axis=-1, keepdims=True)
    return ((of - mu) * lax.rsqrt(var + LN_EPS)).astype(o.dtype)


def head_rmsnorm(o):
    of = o.astype(F32)
    return (of * lax.rsqrt(jnp.mean(jnp.square(of), axis=-1, keepdims=True) + LN_EPS)).astype(o.dtype)


def ada(cond, w, b):
    return jnp.split(jax.nn.silu(cond) @ w + b, 6, axis=-1)


def post_norm(x, gate, y, g, b):
    return layer_norm(DN_ALPHA * x + gate * y, g, b)


def to_heads(t, n):
    bsz, length, width = t.shape
    return t.reshape(bsz, length, n, width // n).transpose(0, 2, 1, 3)


def from_heads(t):
    bsz, n, length, d = t.shape
    return t.transpose(0, 2, 1, 3).reshape(bsz, length, n * d)


def rev(t):
    return jnp.flip(t, axis=2)


def to_chunks(t, size):
    bsz, n, length, d = t.shape
    return jnp.moveaxis(t.reshape(bsz, n, length // size, size, d), 2, 0)


def from_chunks(t):
    nc, bsz, n, size, d = t.shape
    return jnp.moveaxis(t, 0, 2).reshape(bsz, n, nc * size, d)


def axial_rope(t, rows):
    hd = t.shape[-1]
    quarter = hd // 4
    inv = ROPE_BASE ** (-jnp.arange(quarter, dtype=F32) / quarter)
    r = jnp.repeat(jnp.arange(rows, dtype=F32), GRID_W)
    col = jnp.tile(jnp.arange(GRID_W, dtype=F32), rows)
    ang = jnp.concatenate([r[:, None] * inv, col[:, None] * inv], axis=-1)
    cos, sin = jnp.cos(ang), jnp.sin(ang)
    t1, t2 = jnp.split(t.astype(F32), 2, axis=-1)
    return jnp.concatenate([t1 * cos - t2 * sin, t1 * sin + t2 * cos], axis=-1).astype(t.dtype)


def retention_scan(q, k, v, log_gamma, s0):
    C = RET_CHUNK
    lg = log_gamma.astype(F32)[:, None]
    idx = jnp.arange(C, dtype=F32)
    diff = idx[:, None] - idx[None, :]
    intra = jnp.where(diff >= 0, jnp.exp(jnp.maximum(diff, 0.0)[None] * lg[:, :, None]), 0.0)
    q_decay = jnp.exp((idx + 1.0) * lg)[..., None]
    k_decay = jnp.exp((C - 1.0 - idx) * lg)[..., None]
    c_decay = jnp.exp(C * lg)[..., None]

    def step(s, inp):
        qc, kc, vc = inp
        scores = jnp.einsum('bhid,bhjd->bhij', qc, kc) * intra
        o = jnp.einsum('bhij,bhje->bhie', scores, vc) + jnp.einsum('bhid,bhde->bhie', qc * q_decay, s)
        s = c_decay * s + jnp.einsum('bhjd,bhje->bhde', kc * k_decay, vc)
        return s, o

    s_fin, o = lax.scan(step, s0, (to_chunks(q, C), to_chunks(k, C), to_chunks(v, C)))
    return from_chunks(o).astype(v.dtype), s_fin


def gla_scan(q, k, v, log_a, s0):
    C = GLA_CHUNK
    mask = jnp.tril(jnp.ones((C, C), dtype=bool))

    def step(s, inp):
        qc, kc, vc, ac = inp
        b = jnp.cumsum(ac, axis=2)
        qd = qc * jnp.exp(b)
        kd = kc * jnp.exp(-b)
        scores = jnp.where(mask, jnp.einsum('bhid,bhjd->bhij', qd, kd), 0.0)
        o = jnp.einsum('bhij,bhje->bhie', scores, vc) + jnp.einsum('bhid,bhde->bhie', qd, s)
        b_end = b[:, :, -1:, :]
        s = jnp.exp(b_end)[:, :, 0, :, None] * s + jnp.einsum('bhjd,bhje->bhde', kc * jnp.exp(b_end - b), vc)
        return s, o

    s_fin, o = lax.scan(step, s0, tuple(to_chunks(t, C) for t in (q, k, v, log_a)))
    return from_chunks(o).astype(v.dtype), s_fin


def final_state(k, v, log_a):
    la = jnp.broadcast_to(log_a.astype(F32), k.shape)
    cum = jnp.cumsum(la, axis=2)
    return jnp.einsum('bhld,bhle->bhde', k * jnp.exp(cum[:, :, -1:, :] - cum), v)


def retention_bidir(q, k, v, lg_f, lg_b, s0_f, s0_b):
    o_f, s_f = retention_scan(q, k, v, lg_f, s0_f)
    o_b, s_b = retention_scan(rev(q), rev(k), rev(v), lg_b, s0_b)
    return o_f + rev(o_b), s_f, s_b


def gla_bidir(q, k, v, la_f, la_b, s0_f, s0_b):
    o_f, s_f = gla_scan(q, k, v, la_f, s0_f)
    o_b, s_b = gla_scan(rev(q), rev(k), rev(v), rev(la_b), s0_b)
    return o_f + rev(o_b), s_f, s_b


def hyena_filters(length, w1, b1, w2, b2, w3, b3, w4, freq):
    t = jnp.linspace(0.0, 1.0, length, dtype=F32)[:, None]
    bands = (HY_EMB - 1) // 2
    w = 2.0 * math.pi * jnp.arange(length, dtype=F32)[:, None] / length
    f = jnp.linspace(1e-4, bands - 1, bands, dtype=F32)[None, :]
    feats = jnp.concatenate([t, jnp.cos(f * w), -jnp.sin(f * w)], axis=-1)
    a = jnp.sin(freq[0] * (feats @ w1 + b1))
    a = jnp.sin(freq[1] * (a @ w2 + b2))
    a = jnp.sin(freq[2] * (a @ w3 + b3))
    filt = (a @ w4).astype(F32).reshape(length, HY_ORDER, 2, HY_WIDTH)
    max_decay = math.log(HY_TARGET) / HY_SHORT_DECAY_PCT
    min_decay = math.log(HY_TARGET) / HY_LONG_DECAY_PCT
    deltas = jnp.abs(jnp.linspace(min_decay, max_decay, HY_WIDTH, dtype=F32))
    filt = filt * jnp.exp(-t * deltas)[:, None, None, :]
    return filt * lax.rsqrt(jnp.sum(filt * filt, axis=0, keepdims=True))


def bidir_long_conv(u, h_f, h_b):
    L = u.shape[1]
    taps = jnp.concatenate([h_f[:1] + h_b[:1], h_f[1:], jnp.zeros_like(h_f[:1]), jnp.flip(h_b[1:], axis=0)], axis=0)
    U = jnp.fft.rfft(u.astype(F32), n=2 * L, axis=1)
    H = jnp.fft.rfft(taps, n=2 * L, axis=0)
    return jnp.fft.irfft(U * H[None], n=2 * L, axis=1)[:, :L].astype(u.dtype)


def centred_depthwise_conv(u, w, b):
    pad = HY_SHORT // 2
    y = lax.conv_general_dilated(u, w[:, None, :].astype(u.dtype), window_strides=(1,), padding=((pad, pad),),
                                 dimension_numbers=('NWC', 'WIO', 'NWC'), feature_group_count=u.shape[-1])
    return y + b


def hyena(u, conv_w, conv_b, filt, skip):
    u = centred_depthwise_conv(u, conv_w, conv_b)
    x1, x2, v = jnp.split(u, 3, axis=-1)
    z = v
    for n, gate in enumerate((x1, x2)):
        z = gate * (bidir_long_conv(z, filt[:, n, 0], filt[:, n, 1]) + skip[n] * z)
    return z


def ret_project(z):
    q, k, v, g = jnp.split(z[..., :4 * RET_WIDTH], 4, axis=-1)
    return (to_heads(q, RET_HEADS), to_heads(k, RET_HEADS) * RET_HEAD_DIM ** -0.5,
            to_heads(v, RET_HEADS), g)


def ret_hyena_mixer(h, hc, rows, w_in, lg_f, lg_b, conv_w, conv_b, filt_w, skip, w_out, need_ctx_out):
    z = h @ w_in
    zc = hc @ w_in
    q, k, v, g = ret_project(z)
    qc, kc, vc, gc = ret_project(zc)
    q, k = axial_rope(q, rows), axial_rope(k, rows)
    if need_ctx_out:
        zero = jnp.zeros(kc.shape[:2] + (RET_HEAD_DIM, RET_HEAD_DIM), F32)
        oc, s_f, s_b = retention_bidir(qc, kc, vc, lg_f, lg_b, zero, zero)
    else:
        s_f = final_state(kc, vc, lg_f[:, None, None])
        s_b = final_state(rev(kc), rev(vc), lg_b[:, None, None])
    o, _, _ = retention_bidir(q, k, v, lg_f, lg_b, s_f, s_b)
    y_ret = from_heads(head_layernorm(o)) * jax.nn.silu(g)
    y_hy = hyena(z[..., 4 * RET_WIDTH:], conv_w, conv_b, hyena_filters(h.shape[1], *filt_w), skip)
    y = jnp.concatenate([y_ret, y_hy], axis=-1) @ w_out
    if not need_ctx_out:
        return y, None
    yc_ret = from_heads(head_layernorm(oc)) * jax.nn.silu(gc)
    yc_hy = hyena(zc[..., 4 * RET_WIDTH:], conv_w, conv_b, hyena_filters(hc.shape[1], *filt_w), skip)
    yc = jnp.concatenate([yc_ret, yc_hy], axis=-1) @ w_out
    return y, yc


def gla_project(hh, w_in, gw_f, gb_f, gw_b, gb_b):
    q, k, v, g, lr_f, lr_b = jnp.split(hh @ w_in, GLA_SPLITS, axis=-1)
    la_f = jax.nn.log_sigmoid((lr_f @ gw_f + gb_f).astype(F32)) / GLA_TAU
    la_b = jax.nn.log_sigmoid((lr_b @ gw_b + gb_b).astype(F32)) / GLA_TAU
    return (to_heads(q, GLA_HEADS) * GLA_DK ** -0.5, to_heads(k, GLA_HEADS), to_heads(v, GLA_HEADS), g,
            to_heads(la_f, GLA_HEADS), to_heads(la_b, GLA_HEADS))


def gla_mixer(h, hc, w_in, gw_f, gb_f, gw_b, gb_b, w_out, need_ctx_out):
    q, k, v, g, la_f, la_b = gla_project(h, w_in, gw_f, gb_f, gw_b, gb_b)
    qc, kc, vc, gc, lac_f, lac_b = gla_project(hc, w_in, gw_f, gb_f, gw_b, gb_b)
    if need_ctx_out:
        zero = jnp.zeros(kc.shape[:2] + (GLA_DK, GLA_DV), F32)
        oc, s_f, s_b = gla_bidir(qc, kc, vc, lac_f, lac_b, zero, zero)
    else:
        s_f = final_state(kc, vc, lac_f)
        s_b = final_state(rev(kc), rev(vc), rev(lac_b))
    o, _, _ = gla_bidir(q, k, v, la_f, la_b, s_f, s_b)
    y = (from_heads(head_rmsnorm(o)) * jax.nn.silu(g)) @ w_out
    if not need_ctx_out:
        return y, None
    yc = (from_heads(head_rmsnorm(oc)) * jax.nn.silu(gc)) @ w_out
    return y, yc


def moe(h, router_w, router_bias, w_gate, w_up, w_down):
    T = h.shape[0]
    s = jax.nn.sigmoid((h @ router_w).astype(F32))
    sel = s + router_bias.astype(F32)
    grp_score = jnp.sum(lax.top_k(sel.reshape(T, N_GROUPS, EXPERTS_PER_GROUP), TOP_K)[0], axis=-1)
    best = jnp.argmax(grp_score, axis=-1)
    in_group = (jnp.arange(N_EXPERTS) // EXPERTS_PER_GROUP)[None, :] == best[:, None]
    _, idx = lax.top_k(jnp.where(in_group, sel, -jnp.inf), TOP_K)
    w = jnp.take_along_axis(s, idx, axis=-1)
    w = w / jnp.sum(w, axis=-1, keepdims=True)
    combine = jnp.sum(jax.nn.one_hot(idx, N_EXPERTS, dtype=F32) * w[..., None], axis=1)
    y = jnp.zeros((T, h.shape[1]), F32)
    for e in range(N_EXPERTS):
        he = jax.nn.silu(h @ w_gate[e]) * (h @ w_up[e])
        y = y + combine[:, e:e + 1] * (he @ w_down[e])
    return y.astype(h.dtype)


def setup_inputs(seed: int = 0) -> dict:
    key = jax.random.key(seed)
    ks = iter(jax.random.split(key, 40))

    def nrm(shape, scale):
        return jax.random.normal(next(ks), shape, F32) * scale

    base_decay = jnp.log(1.0 - 2.0 ** (-5.0 - jnp.arange(RET_HEADS, dtype=F32)))
    return {
        'x': nrm((BATCH, SEQ, D_MODEL), 1.0),
        'c': nrm((BATCH, D_MODEL), 1.0),
        'ctx': nrm((BATCH, CTX_LEN, D_MODEL), 1.0),
        'c_ctx': nrm((D_MODEL,), 1.0),
        'mod_w': nrm((DEPTH, D_MODEL, 6 * D_MODEL), 0.5 * D_MODEL ** -0.5),
        'mod_b': nrm((DEPTH, 6 * D_MODEL), 0.02),
        'ln_g': 1.0 + nrm((DEPTH, 2, D_MODEL), 0.02),
        'ln_b': nrm((DEPTH, 2, D_MODEL), 0.02),
        'ab_w_in': nrm((N_EVEN, D_MODEL, AB_IN), D_MODEL ** -0.5),
        'ret_log_decay_f': base_decay * (1.0 + nrm((N_EVEN, RET_HEADS), 0.05)),
        'ret_log_decay_b': base_decay * (1.0 + nrm((N_EVEN, RET_HEADS), 0.05)),
        'hy_conv_w': nrm((N_EVEN, HY_SHORT, (HY_ORDER + 1) * HY_WIDTH), HY_SHORT ** -0.5),
        'hy_conv_b': nrm((N_EVEN, (HY_ORDER + 1) * HY_WIDTH), 0.02),
        'hy_w1': nrm((N_EVEN, HY_EMB, HY_FFN), HY_EMB ** -0.5),
        'hy_b1': nrm((N_EVEN, HY_FFN), 0.1),
        'hy_w2': nrm((N_EVEN, HY_FFN, HY_FFN), HY_FFN ** -0.5),
        'hy_b2': nrm((N_EVEN, HY_FFN), 0.1),
        'hy_w3': nrm((N_EVEN, HY_FFN, HY_FFN), HY_FFN ** -0.5),
        'hy_b3': nrm((N_EVEN, HY_FFN), 0.1),
        'hy_w4': nrm((N_EVEN, HY_FFN, HY_ORDER * 2 * HY_WIDTH), HY_FFN ** -0.5),
        'hy_freq': 1.0 + nrm((N_EVEN, 3, HY_FFN), 0.1),
        'hy_skip': nrm((N_EVEN, HY_ORDER, HY_WIDTH), 0.5),
        'ab_w_out': nrm((N_EVEN, AB_OUT, D_MODEL), DN_BETA * AB_OUT ** -0.5),
        'gla_w_in': nrm((N_ODD, D_MODEL, GLA_IN), D_MODEL ** -0.5),
        'gla_gate_w_f': nrm((N_ODD, GLA_RANK, GLA_KEY), GLA_RANK ** -0.5),
        'gla_gate_b_f': nrm((N_ODD, GLA_KEY), 0.1),
        'gla_gate_w_b': nrm((N_ODD, GLA_RANK, GLA_KEY), GLA_RANK ** -0.5),
        'gla_gate_b_b': nrm((N_ODD, GLA_KEY), 0.1),
        'gla_w_out': nrm((N_ODD, GLA_VAL, D_MODEL), DN_BETA * GLA_VAL ** -0.5),
        'router_w': nrm((D_MODEL, N_EXPERTS), D_MODEL ** -0.5),
        'router_bias': nrm((N_EXPERTS,), 0.01),
        'exp_w_gate': nrm((DEPTH, N_EXPERTS, D_MODEL, EXPERT_HIDDEN), D_MODEL ** -0.5),
        'exp_w_up': nrm((DEPTH, N_EXPERTS, D_MODEL, EXPERT_HIDDEN), D_MODEL ** -0.5),
        'exp_w_down': nrm((DEPTH, N_EXPERTS, EXPERT_HIDDEN, D_MODEL), DN_BETA * EXPERT_HIDDEN ** -0.5),
    }


def reference(x, c, ctx, c_ctx, mod_w, mod_b, ln_g, ln_b, ab_w_in, ret_log_decay_f, ret_log_decay_b,
              hy_conv_w, hy_conv_b, hy_w1, hy_b1, hy_w2, hy_b2, hy_w3, hy_b3, hy_w4, hy_freq, hy_skip,
              ab_w_out, gla_w_in, gla_gate_w_f, gla_gate_b_f, gla_gate_w_b, gla_gate_b_b, gla_w_out,
              router_w, router_bias, exp_w_gate, exp_w_up, exp_w_down):
    B, L, D = x.shape
    rows = L // GRID_W
    for layer in range(DEPTH):
        last = layer == DEPTH - 1
        i = layer // 2
        sh1, sc1, g1, sh2, sc2, g2 = [t[:, None, :] for t in ada(c, mod_w[layer], mod_b[layer])]
        csh1, csc1, cg1, csh2, csc2, cg2 = ada(c_ctx, mod_w[layer], mod_b[layer])
        h = x * (1.0 + sc1) + sh1
        hc = ctx * (1.0 + csc1) + csh1
        if layer % 2 == 0:
            filt_w = (hy_w1[i], hy_b1[i], hy_w2[i], hy_b2[i], hy_w3[i], hy_b3[i], hy_w4[i], hy_freq[i])
            y, yc = ret_hyena_mixer(h, hc, rows, ab_w_in[i], ret_log_decay_f[i], ret_log_decay_b[i],
                                    hy_conv_w[i], hy_conv_b[i], filt_w, hy_skip[i], ab_w_out[i], not last)
        else:
            y, yc = gla_mixer(h, hc, gla_w_in[i], gla_gate_w_f[i], gla_gate_b_f[i], gla_gate_w_b[i],
                              gla_gate_b_b[i], gla_w_out[i], not last)
        x = post_norm(x, g1, y, ln_g[layer, 0], ln_b[layer, 0])
        h = (x * (1.0 + sc2) + sh2).reshape(B * L, D)
        if last:
            out = moe(h, router_w, router_bias, exp_w_gate[layer], exp_w_up[layer], exp_w_down[layer])
            x = post_norm(x, g2, out.reshape(B, L, D), ln_g[layer, 1], ln_b[layer, 1])
        else:
            ctx = post_norm(ctx, cg1, yc, ln_g[layer, 0], ln_b[layer, 0])
            n_ctx = ctx.shape[1]
            hc = (ctx * (1.0 + csc2) + csh2).reshape(B * n_ctx, D)
            out = moe(jnp.concatenate([h, hc], axis=0), router_w, router_bias,
                      exp_w_gate[layer], exp_w_up[layer], exp_w_down[layer])
            x = post_norm(x, g2, out[:B * L].reshape(B, L, D), ln_g[layer, 1], ln_b[layer, 1])
            ctx = post_norm(ctx, cg2, out[B * L:].reshape(B, n_ctx, D), ln_g[layer, 1], ln_b[layer, 1])
    return x
```

```cpp
#include <hip/hip_runtime.h>
#include <hip/hip_cooperative_groups.h>
#include <cstdio>
#include <cstdint>
namespace cg = cooperative_groups;

#ifndef ONE_LAUNCH
#define ONE_LAUNCH 0
#endif

constexpr int NB = 2, L = 8192, D = 1024, CTX = 256, RB = L + CTX;
constexpr int GW = 64;
constexpr int RW = 512, RH = 4, RHD = 128, RC = 128, NCH = RB / RC;
constexpr int HW = 512, ABIN = 3584;
constexpr int GK = 512, GV = 1024, GDK = 128, GDV = 256, GIN = 3104, GC = 128;
constexpr int NE = 16, NG = 4, EPG = 4, EH = 512;
constexpr float ALPHA = 1.4142135623730951f;
constexpr float LN_EPS = 1e-5f;
constexpr int NT = 256;

struct P {
    const float* in[34];
    float* out;
    float* Xc;
    float* MOD;
    float* FILT;
    float* NORM;
    float* A1; float* A2;
    float* Hb;
    float* Zb;
    float* US;
    float* Pb;
    float* RS;
    int* RE;
    float* RWt;
};

__device__ __forceinline__ float siluf(float x) { return x / (1.f + expf(-x)); }
__device__ __forceinline__ float sigmf(float x) { return 1.f / (1.f + expf(-x)); }
__device__ __forceinline__ float logsigf(float x) { return fminf(x, 0.f) - log1pf(expf(-fabsf(x))); }

#define GSTRIDE(i, n) for (long i = (long)blockIdx.x * blockDim.x + threadIdx.x; i < (long)(n); i += (long)gridDim.x * blockDim.x)

__device__ __forceinline__ float* xrow(const P& p, int b, int lr) {
    return lr < L ? p.out + ((size_t)b * L + lr) * D : p.Xc + ((size_t)b * CTX + (lr - L)) * D;
}
__device__ __forceinline__ const float* modv(const P& p, int l, int b, int lr, int chunk) {
    const int j = lr < L ? b : 2;
    return p.MOD + ((size_t)(l * 3 + j) * 6 + chunk) * D;
}

__device__ void ph_ada(const P& p) {
    GSTRIDE(idx, 2 * 3 * 6144) {
        const int n = idx % 6144, j = (idx / 6144) % 3, l = idx / (3 * 6144);
        const float* cv = j < 2 ? p.in[1] + j * D : p.in[3];
        const float* w = p.in[4] + (size_t)l * D * 6144;
        float acc = p.in[5][l * 6144 + n];
        for (int k = 0; k < D; ++k) acc += siluf(cv[k]) * w[(size_t)k * 6144 + n];
        p.MOD[idx] = acc;
    }
}
__device__ void ph_init(const P& p) {
    GSTRIDE(i, (long)NB * L * D) p.out[i] = p.in[0][i];
    GSTRIDE(i, (long)NB * CTX * D) p.Xc[i] = p.in[2][i];
    GSTRIDE(i, 2 * 2048) p.NORM[i] = 0.f;
}
__device__ void ph_mod(const P& p, int l, int b, int which) {
    GSTRIDE(i, (long)RB * D) {
        const int lr = i / D, k = i % D;
        const float sh = modv(p, l, b, lr, which * 3 + 0)[k], sc = modv(p, l, b, lr, which * 3 + 1)[k];
        p.Hb[i] = xrow(p, b, lr)[k] * (1.f + sc) + sh;
    }
}
__device__ void ph_gemm(const float* A, int lda, const float* Bm, int ldb, float* C, int ldc, int M, int N, int K) {
    __shared__ float As[16][65];
    __shared__ float Bs[16][64];
    const int tid = threadIdx.x, tx = tid & 15, ty = tid >> 4;
    const int tm = M / 64, tn = (N + 63) / 64;
    for (int tile = blockIdx.x; tile < tm * tn; tile += gridDim.x) {
        const int m0 = (tile / tn) * 64, n0 = (tile % tn) * 64;
        float acc[4][4];
#pragma unroll
        for (int i = 0; i < 4; ++i)
#pragma unroll
            for (int j = 0; j < 4; ++j) acc[i][j] = 0.f;
        for (int k0 = 0; k0 < K; k0 += 16) {
            __syncthreads();
#pragma unroll
            for (int i = 0; i < 4; ++i) {
                const int e = tid + i * 256;
                const int r = e >> 4, kk = e & 15;
                As[kk][r] = A[(size_t)(m0 + r) * lda + k0 + kk];
                const int kr = e >> 6, cc = e & 63;
                Bs[kr][cc] = (n0 + cc < N) ? Bm[(size_t)(k0 + kr) * ldb + n0 + cc] : 0.f;
            }
            __syncthreads();
#pragma unroll
            for (int kk = 0; kk < 16; ++kk) {
                float a[4], bb[4];
#pragma unroll
                for (int i = 0; i < 4; ++i) { a[i] = As[kk][ty * 4 + i]; bb[i] = Bs[kk][tx * 4 + i]; }
#pragma unroll
                for (int i = 0; i < 4; ++i)
#pragma unroll
                    for (int j = 0; j < 4; ++j) acc[i][j] += a[i] * bb[j];
            }
        }
#pragma unroll
        for (int i = 0; i < 4; ++i)
#pragma unroll
            for (int j = 0; j < 4; ++j) { const int n = n0 + tx * 4 + j; if (n < N) C[(size_t)(m0 + ty * 4 + i) * ldc + n] = acc[i][j]; }
    }
}
__device__ void ph_rope(const P& p, int b) {
    float* Z = p.Zb;
    GSTRIDE(i, (long)RB * RW) { const int lr = i / RW, c = i % RW; Z[(size_t)lr * ABIN + RW + c] *= 0.08838834764831845f; }
}
__device__ void ph_rope2(const P& p, int b) {
    float* Z = p.Zb;
    GSTRIDE(i, (long)L * 2 * RH * 64) {
        const int pr = i % 64, h = (i / 64) % RH, w = (i / (64 * RH)) % 2, t = i / (64 * RH * 2);
        const int row = t / GW, col = t % GW;
        const int fi = pr & 31;
        const float inv = powf(10000.f, -(float)fi / 32.f);
        const float ang = (pr < 32 ? (float)row : (float)col) * inv;
        float sn, cs; sincosf(ang, &sn, &cs);
        float* base = Z + (size_t)t * ABIN + w * RW + h * RHD;
        const float t1 = base[pr], t2 = base[64 + pr];
        base[pr] = t1 * cs - t2 * sn; base[64 + pr] = t1 * sn + t2 * cs;
    }
}
__device__ __forceinline__ int chunk_row0(int c) { return c < 2 ? L + c * RC : (c - 2) * RC; }
__device__ void ph_retU(const P& p, int b) {
    float* Uf = p.US; float* Ub = p.US + (size_t)RH * NCH * RHD * RHD;
    const float* Z = p.Zb;
    GSTRIDE(idx, (long)RH * NCH * RHD * RHD) {
        const int e = idx % RHD, d = (idx / RHD) % RHD, c = (idx / (RHD * RHD)) % NCH, h = idx / (RHD * RHD * NCH);
        const float lgf = p.in[9][h], lgb = p.in[10][h];
        const int r0 = chunk_row0(c);
        float uf = 0.f, ub = 0.f;
        for (int j = 0; j < RC; ++j) {
            const float kk = Z[(size_t)(r0 + j) * ABIN + RW + h * RHD + d], vv = Z[(size_t)(r0 + j) * ABIN + 2 * RW + h * RHD + e];
            uf += kk * expf(lgf * (float)(RC - 1 - j)) * vv; ub += kk * expf(lgb * (float)j) * vv;
        }
        Uf[idx] = uf; Ub[idx] = ub;
    }
}
__device__ void ph_retScan(const P& p, int b) {
    float* Uf = p.US; float* Ub = p.US + (size_t)RH * NCH * RHD * RHD;
    GSTRIDE(idx, (long)RH * RHD * RHD) {
        const int de = idx % (RHD * RHD), h = idx / (RHD * RHD);
        const float df = expf(p.in[9][h] * (float)RC), db = expf(p.in[10][h] * (float)RC);
        float s = 0.f;
        for (int c = 0; c < NCH; ++c) { float* q = Uf + ((size_t)h * NCH + c) * RHD * RHD + de; const float u = *q; *q = s; s = df * s + u; }
        s = 0.f;
        for (int c = 1; c >= 0; --c) { float* q = Ub + ((size_t)h * NCH + c) * RHD * RHD + de; const float u = *q; *q = s; s = db * s + u; }
        for (int c = NCH - 1; c >= 2; --c) { float* q = Ub + ((size_t)h * NCH + c) * RHD * RHD + de; const float u = *q; *q = s; s = db * s + u; }
    }
}
__device__ void ph_retP(const P& p, int b) {
    const float* Z = p.Zb;
    GSTRIDE(idx, (long)RB * RH * RC) {
        const int j = idx % RC, h = (idx / RC) % RH, lr = idx / (RC * RH);
        const int i = lr % RC, r0 = lr - i;
        const float* q = Z + (size_t)lr * ABIN + h * RHD; const float* k = Z + (size_t)(r0 + j) * ABIN + RW + h * RHD;
        float s = 0.f;
        for (int d = 0; d < RHD; ++d) s += q[d] * k[d];
        const float m = i > j ? expf(p.in[9][h] * (float)(i - j)) : (j > i ? expf(p.in[10][h] * (float)(j - i)) : 2.f);
        p.Pb[idx] = s * m;
    }
}
__device__ void ph_retO(const P& p, int b) {
    const float* Z = p.Zb; float* O = p.Hb;
    const float* Sf = p.US; const float* Sb = p.US + (size_t)RH * NCH * RHD * RHD;
    GSTRIDE(idx, (long)RB * RW) {
        const int e = idx % RHD, h = (idx / RHD) % RH, lr = idx / RW;
        const int i = lr % RC, r0 = lr - i, c = lr < L ? 2 + lr / RC : (lr - L) / RC;
        const float* pp = p.Pb + ((size_t)lr * RH + h) * RC;
        float o = 0.f;
        for (int j = 0; j < RC; ++j) o += pp[j] * Z[(size_t)(r0 + j) * ABIN + 2 * RW + h * RHD + e];
        const float qf = expf(p.in[9][h] * (float)(i + 1)), qb = expf(p.in[10][h] * (float)(RC - i));
        const float* q = Z + (size_t)lr * ABIN + h * RHD;
        const float* sf = Sf + ((size_t)h * NCH + c) * RHD * RHD + e; const float* sb = Sb + ((size_t)h * NCH + c) * RHD * RHD + e;
        float of = 0.f, ob = 0.f;
        for (int d = 0; d < RHD; ++d) { of += q[d] * sf[(size_t)d * RHD]; ob += q[d] * sb[(size_t)d * RHD]; }
        O[idx] = o + qf * of + qb * ob;
    }
}
__device__ void ph_retNorm(const P& p, int b) {
    float* Z = p.Zb; const float* O = p.Hb;
    GSTRIDE(idx, (long)RB * RH) {
        const int h = idx % RH, lr = idx / RH;
        const float* o = O + (size_t)lr * RW + h * RHD;
        float mu = 0.f; for (int e = 0; e < RHD; ++e) mu += o[e]; mu *= (1.f / RHD);
        float var = 0.f; for (int e = 0; e < RHD; ++e) { const float d = o[e] - mu; var += d * d; } var *= (1.f / RHD);
        const float rs = 1.f / sqrtf(var + LN_EPS);
        for (int e = 0; e < RHD; ++e) { const float g = Z[(size_t)lr * ABIN + 3 * RW + h * RHD + e]; Z[(size_t)lr * ABIN + h * RHD + e] = (o[e] - mu) * rs * siluf(g); }
    }
}
__device__ __forceinline__ void hy_pos(int pidx, int& len, int& i) { if (pidx < L) { len = L; i = pidx; } else { len = CTX; i = pidx - L; } }
__device__ void ph_hyA1(const P& p) {
    GSTRIDE(idx, (long)RB * 64) {
        const int j = idx % 64, pidx = idx / 64; int len, i; hy_pos(pidx, len, i);
        const float t = (float)i / (float)(len - 1);
        const float w = 2.0f * 3.14159265358979323846f * (float)i / (float)len;
        const float* w1 = p.in[13];
        float acc = p.in[14][j] + t * w1[j];
        for (int m = 0; m < 16; ++m) {
            const float f = 1e-4f + (float)m * ((15.f - 1e-4f) / 15.f);
            acc += cosf(f * w) * w1[(1 + m) * 64 + j] - sinf(f * w) * w1[(17 + m) * 64 + j];
        }
        p.A1[idx] = sinf(p.in[20][0 * 64 + j] * acc);
    }
}
__device__ void ph_hyA(const P& p, const float* src, float* dst, const float* w, const float* bias, const float* freq) {
    GSTRIDE(idx, (long)RB * 64) {
        const int j = idx % 64, pidx = idx / 64;
        float acc = bias[j];
        for (int i = 0; i < 64; ++i) acc += src[(size_t)pidx * 64 + i] * w[i * 64 + j];
        dst[idx] = sinf(freq[j] * acc);
    }
}
__device__ void ph_hyF(const P& p, const float* a3) {
    const float mind = logf(1e-2f) / 1.5f, maxd = logf(1e-2f) / 0.3f;
    GSTRIDE(idx, (long)RB * 2048) {
        const int col = idx % 2048, pidx = idx / 2048, ch = col % HW; int len, i; hy_pos(pidx, len, i);
        const float t = (float)i / (float)(len - 1);
        float acc = 0.f;
        for (int m = 0; m < 64; ++m) acc += a3[(size_t)pidx * 64 + m] * p.in[19][m * 2048 + col];
        const float delta = fabsf(mind + (float)ch * ((maxd - mind) / 511.f));
        const float v = acc * expf(-t * delta);
        p.FILT[idx] = v;
    }
}
__device__ void ph_hyNorm(const P& p) {
    GSTRIDE(idx, (long)(RB / 64) * 2048) {
        const int col = idx % 2048, pb = idx / 2048;
        float s = 0.f;
        for (int q = 0; q < 64; ++q) { const float v = p.FILT[(size_t)(pb * 64 + q) * 2048 + col]; s += v * v; }
        atomicAdd(&p.NORM[(pb * 64 < L ? 0 : 1) * 2048 + col], s);
    }
}
__device__ __forceinline__ float dwc(const P& p, const float* Z, int lr, int col) {
    const int s0 = lr < L ? 0 : L, s1 = lr < L ? L : RB;
    const float* w = p.in[11];
    float acc = p.in[12][col] + w[1 * 1536 + col] * Z[(size_t)lr * ABIN + 2048 + col];
    if (lr - 1 >= s0) acc += w[0 * 1536 + col] * Z[(size_t)(lr - 1) * ABIN + 2048 + col];
    if (lr + 1 < s1) acc += w[2 * 1536 + col] * Z[(size_t)(lr + 1) * ABIN + 2048 + col];
    return acc;
}
__device__ void ph_hydw(const P& p, int b) {
    GSTRIDE(idx, (long)RB * HW) { const int ch = idx % HW, lr = idx / HW; p.Hb[idx] = dwc(p, p.Zb, lr, 2 * HW + ch); }
}
__device__ __forceinline__ float hy_tap(const P& p, int fbase, int nrm, int n, int ch, int d) {
    const float nf = 1.f / sqrtf(p.NORM[nrm * 2048 + n * 1024 + ch]), nb = 1.f / sqrtf(p.NORM[nrm * 2048 + n * 1024 + 512 + ch]);
    if (d > 0) return p.FILT[(size_t)(fbase + d) * 2048 + n * 1024 + ch] * nf;
    if (d < 0) return p.FILT[(size_t)(fbase - d) * 2048 + n * 1024 + 512 + ch] * nb;
    return p.FILT[(size_t)fbase * 2048 + n * 1024 + ch] * nf + p.FILT[(size_t)fbase * 2048 + n * 1024 + 512 + ch] * nb;
}
__device__ void ph_hyconv(const P& p, int b, int n) {
    const float* src = p.Hb; float* dst = p.Hb + (size_t)RB * HW;
    GSTRIDE(idx, (long)(RB / 4) * HW) {
        const int ch = idx % HW, tb = idx / HW, lr0 = tb * 4;
        const int s0 = lr0 < L ? 0 : L, len = lr0 < L ? L : CTX, nrm = lr0 < L ? 0 : 1, t0 = lr0 - s0;
        const float nf = 1.f / sqrtf(p.NORM[nrm * 2048 + n * 1024 + ch]), nb = 1.f / sqrtf(p.NORM[nrm * 2048 + n * 1024 + 512 + ch]);
        const float* Ff = p.FILT + (size_t)s0 * 2048 + n * 1024 + ch; const float* Fb = Ff + 512;
        float w0 = hy_tap(p, s0, nrm, n, ch, t0), w1 = hy_tap(p, s0, nrm, n, ch, t0 + 1), w2 = hy_tap(p, s0, nrm, n, ch, t0 + 2), w3 = hy_tap(p, s0, nrm, n, ch, t0 + 3);
        float a0 = 0.f, a1 = 0.f, a2 = 0.f, a3 = 0.f;
        for (int s = 0; s < len; ++s) {
            const float z = src[(size_t)(s0 + s) * HW + ch];
            a0 += w0 * z; a1 += w1 * z; a2 += w2 * z; a3 += w3 * z;
            w3 = w2; w2 = w1; w1 = w0;
            const int dn = t0 - (s + 1);
            if (s + 1 < len) {
                if (dn > 0) w0 = Ff[(size_t)dn * 2048] * nf; else if (dn < 0) w0 = Fb[(size_t)(-dn) * 2048] * nb; else w0 = Ff[0] * nf + Fb[0] * nb;
            }
        }
        dst[(size_t)(lr0 + 0) * HW + ch] = a0; dst[(size_t)(lr0 + 1) * HW + ch] = a1; dst[(size_t)(lr0 + 2) * HW + ch] = a2; dst[(size_t)(lr0 + 3) * HW + ch] = a3;
    }
}
__device__ void ph_hygate(const P& p, int b, int n) {
    float* z = p.Hb; const float* cv = p.Hb + (size_t)RB * HW;
    GSTRIDE(idx, (long)RB * HW) {
        const int ch = idx % HW, lr = idx / HW;
        const float gate = dwc(p, p.Zb, lr, n * HW + ch);
        const float r = gate * (cv[idx] + p.in[21][n * HW + ch] * z[idx]);
        if (n == 0) z[idx] = r; else p.Zb[(size_t)lr * ABIN + RW + ch] = r;
    }
}
__device__ void ph_post(const P& p, int l, int b, int which, const float* Y, int ldy) {
    __shared__ float red[NT];
    const float* lg = p.in[6] + (size_t)(l * 2 + which) * D; const float* lb = p.in[7] + (size_t)(l * 2 + which) * D;
    for (int lr = blockIdx.x; lr < RB; lr += gridDim.x) {
        float* x = xrow(p, b, lr); const float* gate = modv(p, l, b, lr, which * 3 + 2);
        float v[4]; float s = 0.f;
#pragma unroll
        for (int i = 0; i < 4; ++i) { const int k = threadIdx.x + i * NT; v[i] = ALPHA * x[k] + gate[k] * Y[(size_t)lr * ldy + k]; s += v[i]; }
        red[threadIdx.x] = s; __syncthreads();
        for (int o = NT / 2; o > 0; o >>= 1) { if (threadIdx.x < o) red[threadIdx.x] += red[threadIdx.x + o]; __syncthreads(); }
        const float mu = red[0] * (1.f / D); __syncthreads();
        float q = 0.f;
#pragma unroll
        for (int i = 0; i < 4; ++i) { const float d = v[i] - mu; q += d * d; }
        red[threadIdx.x] = q; __syncthreads();
        for (int o = NT / 2; o > 0; o >>= 1) { if (threadIdx.x < o) red[threadIdx.x] += red[threadIdx.x + o]; __syncthreads(); }
        const float rs = 1.f / sqrtf(red[0] * (1.f / D) + LN_EPS); __syncthreads();
#pragma unroll
        for (int i = 0; i < 4; ++i) { const int k = threadIdx.x + i * NT; x[k] = (v[i] - mu) * rs * lg[k] + lb[k]; }
    }
}
__device__ void ph_route1(const P& p) {
    GSTRIDE(idx, (long)RB * NE) {
        const int e = idx % NE, lr = idx / NE;
        float acc = 0.f;
        for (int k = 0; k < D; ++k) acc += p.Hb[(size_t)lr * D + k] * p.in[29][k * NE + e];
        p.RS[idx] = sigmf(acc);
    }
}
__device__ void ph_route2(const P& p) {
    GSTRIDE(lr, RB) {
        const float* s = p.RS + (size_t)lr * NE; const float* rb = p.in[30];
        int best = 0; float bs = -1e30f;
        for (int g = 0; g < NG; ++g) {
            float m1 = -1e30f, m2 = -1e30f;
            for (int q = 0; q < EPG; ++q) { const float v = s[g * EPG + q] + rb[g * EPG + q]; if (v > m1) { m2 = m1; m1 = v; } else if (v > m2) m2 = v; }
            if (m1 + m2 > bs) { bs = m1 + m2; best = g; }
        }
        int i1 = 0; float v1 = -1e30f;
        for (int q = 0; q < EPG; ++q) { const float v = s[best * EPG + q] + rb[best * EPG + q]; if (v > v1) { v1 = v; i1 = q; } }
        int i2 = 0; float v2 = -1e30f;
        for (int q = 0; q < EPG; ++q) { if (q == i1) continue; const float v = s[best * EPG + q] + rb[best * EPG + q]; if (v > v2) { v2 = v; i2 = q; } }
        const int e1 = best * EPG + i1, e2 = best * EPG + i2; const float a = s[e1], c = s[e2];
        p.RE[lr * 2] = e1; p.RE[lr * 2 + 1] = e2; p.RWt[lr * 2] = a / (a + c); p.RWt[lr * 2 + 1] = c / (a + c);
    }
}
__device__ void ph_moe1(const P& p, int l) {
    GSTRIDE(idx, (long)RB * 2 * EH) {
        const int j = idx % EH, k = (idx / EH) % 2, lr = idx / (2 * EH);
        const int e = p.RE[lr * 2 + k];
        const float* wg = p.in[31] + ((size_t)(l * NE + e) * D) * EH + j; const float* wu = p.in[32] + ((size_t)(l * NE + e) * D) * EH + j;
        const float* h = p.Hb + (size_t)lr * D;
        float g = 0.f, u = 0.f;
        for (int i = 0; i < D; ++i) { g += h[i] * wg[(size_t)i * EH]; u += h[i] * wu[(size_t)i * EH]; }
        p.US[idx] = siluf(g) * u;
    }
}
__device__ void ph_moe2(const P& p, int l) {
    GSTRIDE(idx, (long)RB * D) {
        const int n = idx % D, lr = idx / D;
        float acc = 0.f;
        for (int k = 0; k < 2; ++k) {
            const int e = p.RE[lr * 2 + k]; const float* wd = p.in[33] + ((size_t)(l * NE + e) * EH) * D + n; const float* he = p.US + ((size_t)lr * 2 + k) * EH;
            float a = 0.f;
            for (int j = 0; j < EH; ++j) a += he[j] * wd[(size_t)j * D];
            acc += p.RWt[lr * 2 + k] * a;
        }
        p.Zb[idx] = acc;
    }
}
__device__ void ph_glagate(const P& p) {
    GSTRIDE(idx, (long)2 * RB * GK) {
        const int ch = idx % GK, lr = (idx / GK) % RB, dir = idx / (GK * RB);
        const float* gw = p.in[dir ? 26 : 24]; const float* gb = p.in[dir ? 27 : 25];
        float acc = gb[ch];
        for (int r = 0; r < 16; ++r) acc += p.Zb[(size_t)lr * GIN + 3072 + dir * 16 + r] * gw[r * GK + ch];
        p.Hb[idx] = logsigf(acc) * (1.f / 16.f);
    }
}
__device__ void ph_glacum(const P& p) {
    GSTRIDE(idx, (long)2 * NCH * GK) {
        const int ch = idx % GK, c = (idx / GK) % NCH, dir = idx / (GK * NCH);
        float* a = p.Hb + (size_t)dir * RB * GK + (size_t)chunk_row0(c) * GK + ch;
        float s = 0.f;
        if (dir == 0) for (int i = 0; i < GC; ++i) { s += a[(size_t)i * GK]; a[(size_t)i * GK] = s; }
        else for (int i = GC - 1; i >= 0; --i) { s += a[(size_t)i * GK]; a[(size_t)i * GK] = s; }
    }
}
constexpr size_t GSZ = (size_t)4 * NCH * GDK * GDV;
__device__ void ph_glaU(const P& p) {
    const float* Z = p.Zb; const float* BF = p.Hb; const float* BB = p.Hb + (size_t)RB * GK;
    GSTRIDE(idx, (long)GSZ) {
        const int e = idx % GDV, d = (idx / GDV) % GDK, c = (idx / (GDV * GDK)) % NCH, h = idx / (GDV * GDK * NCH);
        const int r0 = chunk_row0(c);
        const float bfe = BF[(size_t)(r0 + GC - 1) * GK + h * GDK + d], bbe = BB[(size_t)r0 * GK + h * GDK + d];
        float uf = 0.f, ub = 0.f;
        for (int j = 0; j < GC; ++j) {
            const float kk = Z[(size_t)(r0 + j) * GIN + GK + h * GDK + d], vv = Z[(size_t)(r0 + j) * GIN + 2 * GK + h * GDV + e];
            uf += kk * expf(bfe - BF[(size_t)(r0 + j) * GK + h * GDK + d]) * vv;
            ub += kk * expf(bbe - BB[(size_t)(r0 + j) * GK + h * GDK + d]) * vv;
        }
        p.FILT[idx] = uf; p.FILT[GSZ + idx] = ub;
    }
}
__device__ void ph_glaScan(const P& p) {
    const float* BF = p.Hb; const float* BB = p.Hb + (size_t)RB * GK;
    GSTRIDE(idx, (long)4 * GDK * GDV) {
        const int e = idx % GDV, d = (idx / GDV) % GDK, h = idx / (GDV * GDK);
        float s = 0.f;
        for (int c = 0; c < NCH; ++c) {
            float* q = p.FILT + (((size_t)h * NCH + c) * GDK + d) * GDV + e; const float u = *q; *q = s;
            s = expf(BF[(size_t)(chunk_row0(c) + GC - 1) * GK + h * GDK + d]) * s + u;
        }
        s = 0.f;
        for (int cc = 0; cc < NCH; ++cc) {
            const int c = cc < 2 ? 1 - cc : NCH + 1 - cc;
            float* q = p.FILT + GSZ + (((size_t)h * NCH + c) * GDK + d) * GDV + e; const float u = *q; *q = s;
            s = expf(BB[(size_t)chunk_row0(c) * GK + h * GDK + d]) * s + u;
        }
    }
}
__device__ void ph_glaP(const P& p) {
    const float* Z = p.Zb; const float* BF = p.Hb; const float* BB = p.Hb + (size_t)RB * GK;
    GSTRIDE(idx, (long)L * 4 * GC) {
        const int j = idx % GC, h = (idx / GC) % 4, lr = idx / (GC * 4);
        const int i = lr % GC, r0 = lr - i;
        const float* q = Z + (size_t)lr * GIN + h * GDK; const float* k = Z + (size_t)(r0 + j) * GIN + GK + h * GDK;
        float s = 0.f;
        if (i >= j) { const float* bi = BF + (size_t)lr * GK + h * GDK; const float* bj = BF + (size_t)(r0 + j) * GK + h * GDK;
            for (int d = 0; d < GDK; ++d) s += q[d] * k[d] * expf(bi[d] - bj[d]); }
        if (i <= j) { const float* bi = BB + (size_t)lr * GK + h * GDK; const float* bj = BB + (size_t)(r0 + j) * GK + h * GDK;
            for (int d = 0; d < GDK; ++d) s += q[d] * k[d] * expf(bi[d] - bj[d]); }
        p.Pb[idx] = s * 0.08838834764831845f;
    }
}
__device__ void ph_glaO(const P& p) {
    const float* Z = p.Zb; const float* BF = p.Hb; const float* BB = p.Hb + (size_t)RB * GK;
    GSTRIDE(idx, (long)RB * GV) {
        const int e = idx % GDV, h = (idx / GDV) % 4, lr = idx / GV;
        if (lr >= L) { p.US[idx] = 0.f; continue; }
        const int i = lr % GC, r0 = lr - i, c = 2 + lr / GC;
        const float* pp = p.Pb + ((size_t)lr * 4 + h) * GC;
        float o = 0.f;
        for (int j = 0; j < GC; ++j) o += pp[j] * Z[(size_t)(r0 + j) * GIN + 2 * GK + h * GDV + e];
        const float* q = Z + (size_t)lr * GIN + h * GDK;
        const float* sf = p.FILT + (((size_t)h * NCH + c) * GDK) * GDV + e; const float* sb = sf + GSZ;
        const float* bi = BF + (size_t)lr * GK + h * GDK; const float* bbi = BB + (size_t)lr * GK + h * GDK;
        float a = 0.f;
        for (int d = 0; d < GDK; ++d) a += q[d] * (expf(bi[d]) * sf[(size_t)d * GDV] + expf(bbi[d]) * sb[(size_t)d * GDV]);
        p.US[idx] = o + a * 0.08838834764831845f;
    }
}
__device__ void ph_glaNorm(const P& p) {
    GSTRIDE(idx, (long)RB * 4) {
        const int h = idx % 4, lr = idx / 4;
        float* o = p.US + (size_t)lr * GV + h * GDV;
        float ss = 0.f; for (int e = 0; e < GDV; ++e) ss += o[e] * o[e];
        const float rs = 1.f / sqrtf(ss * (1.f / GDV) + LN_EPS);
        for (int e = 0; e < GDV; ++e) o[e] = o[e] * rs * siluf(p.Zb[(size_t)lr * GIN + 2 * GK + GV + h * GDV + e]);
    }
}

constexpr int S_PRE = 6, S_L0 = 22, S_L1 = 17, N_STEPS = S_PRE + NB * S_L0 + NB * S_L1;
__device__ void run_step(const P& p, int step) {
    if (step < S_PRE) {
        switch (step) {
            case 0: ph_ada(p); ph_init(p); break;
            case 1: ph_hyA1(p); break;
            case 2: ph_hyA(p, p.A1, p.A2, p.in[15], p.in[16], p.in[20] + 64); break;
            case 3: ph_hyA(p, p.A2, p.A1, p.in[17], p.in[18], p.in[20] + 128); break;
            case 4: ph_hyF(p, p.A1); break;
            case 5: ph_hyNorm(p); break;
        }
        return;
    }
    step -= S_PRE;
    if (step < NB * S_L0) {
        const int b = step / S_L0, s = step % S_L0, l = 0;
        switch (s) {
            case 0: ph_mod(p, l, b, 0); break;
            case 1: ph_gemm(p.Hb, D, p.in[8], ABIN, p.Zb, ABIN, RB, ABIN, D); break;
            case 2: ph_rope(p, b); break;
            case 3: ph_rope2(p, b); break;
            case 4: ph_retU(p, b); break;
            case 5: ph_retScan(p, b); break;
            case 6: ph_retP(p, b); break;
            case 7: ph_retO(p, b); break;
            case 8: ph_retNorm(p, b); break;
            case 9: ph_hydw(p, b); break;
            case 10: ph_hyconv(p, b, 0); break;
            case 11: ph_hygate(p, b, 0); break;
            case 12: ph_hyconv(p, b, 1); break;
            case 13: ph_hygate(p, b, 1); break;
            case 14: ph_gemm(p.Zb, ABIN, p.in[22], D, p.Hb, D, RB, D, D); break;
            case 15: ph_post(p, l, b, 0, p.Hb, D); break;
            case 16: ph_mod(p, l, b, 1); break;
            case 17: ph_route1(p); break;
            case 18: ph_route2(p); break;
            case 19: ph_moe1(p, l); break;
            case 20: ph_moe2(p, l); break;
            case 21: ph_post(p, l, b, 1, p.Zb, D); break;
        }
        return;
    }
    step -= NB * S_L0;
    {
        const int b = step / S_L1, s = step % S_L1, l = 1;
        switch (s) {
            case 0: ph_mod(p, l, b, 0); break;
            case 1: ph_gemm(p.Hb, D, p.in[23], GIN, p.Zb, GIN, RB, GIN, D); break;
            case 2: ph_glagate(p); break;
            case 3: ph_glacum(p); break;
            case 4: ph_glaU(p); break;
            case 5: ph_glaScan(p); break;
            case 6: ph_glaP(p); break;
            case 7: ph_glaO(p); break;
            case 8: ph_glaNorm(p); break;
            case 9: ph_gemm(p.US, D, p.in[28], D, p.Hb, D, RB, D, D); break;
            case 10: ph_post(p, l, b, 0, p.Hb, D); break;
            case 11: ph_mod(p, l, b, 1); break;
            case 12: ph_route1(p); break;
            case 13: ph_route2(p); break;
            case 14: ph_moe1(p, l); break;
            case 15: ph_moe2(p, l); break;
            case 16: ph_post(p, l, b, 1, p.Zb, D); break;
        }
    }
}

__global__ void __launch_bounds__(NT) k_step(P p, int step) { run_step(p, step); }
__global__ void __launch_bounds__(NT) k_all(P p) {
    cg::grid_group grid = cg::this_grid();
    for (int s = 0; s < N_STEPS; ++s) { run_step(p, s); grid.sync(); }
}

extern "C" void kernel_launch(void* const* d_in, const int* in_sizes, int n_in, void* d_out, int out_size, void* d_ws, size_t ws_size, hipStream_t stream) {
    P p{};
    for (int i = 0; i < 34; ++i) p.in[i] = (const float*)d_in[i];
    p.out = (float*)d_out;
    float* w = (float*)d_ws; size_t off = 0;
    auto take = [&](size_t n) { float* r = w + off; off += (n + 63) & ~(size_t)63; return r; };
    p.Xc = take((size_t)NB * CTX * D);
    p.MOD = take(2 * 3 * 6144);
    p.FILT = take((size_t)RB * 2048);
    p.NORM = take(2 * 2048);
    p.A1 = take((size_t)RB * 64); p.A2 = take((size_t)RB * 64);
    p.Hb = take((size_t)RB * D);
    p.Zb = take((size_t)RB * ABIN);
    p.US = take((size_t)RB * D);
    p.Pb = take((size_t)RB * 512);
    p.RS = take((size_t)RB * NE);
    p.RE = (int*)take((size_t)RB * 2);
    p.RWt = take((size_t)RB * 2);
    if (off * sizeof(float) > ws_size || n_in != 34 || out_size != NB * L * D) { fprintf(stderr, "kernel_launch: bad sizes (need %zu ws bytes, have %zu)\n", off * sizeof(float), ws_size); return; }
#if ONE_LAUNCH
    static int grid = 0;
    if (!grid) { int dev = 0, cus = 0, per = 0; hipGetDevice(&dev); hipDeviceGetAttribute(&cus, hipDeviceAttributeMultiprocessorCount, dev);
        hipOccupancyMaxActiveBlocksPerMultiprocessor(&per, k_all, NT, 0); if (per > 4) per = 4; grid = cus * per; }
    void* args[] = {&p};
    hipError_t e = hipLaunchCooperativeKernel((void*)k_all, dim3(grid), dim3(NT), args, 0, stream);
    if (e != hipSuccess) fprintf(stderr, "coop launch failed: %s (grid %d)\n", hipGetErrorString(e), grid);
#else
    for (int s = 0; s < N_STEPS; ++s) hipLaunchKernelGGL(k_step, dim3(2048), dim3(NT), 0, stream, p, s);
#endif
}
```

```cpp
#include <hip/hip_runtime.h>
#include <hip/hip_cooperative_groups.h>
#include <cstdio>
#include <cstdint>
namespace cg = cooperative_groups;

#ifndef ONE_LAUNCH
#define ONE_LAUNCH 1
#endif

constexpr int NB = 2, L = 8192, D = 1024, CTX = 256, RB = L + CTX;
constexpr int GW = 64;
constexpr int RW = 512, RH = 4, RHD = 128, RC = 128, NCH = RB / RC;
constexpr int HW = 512, ABIN = 3584;
constexpr int GK = 512, GV = 1024, GDK = 128, GDV = 256, GIN = 3104, GC = 128;
constexpr int NE = 16, NG = 4, EPG = 4, EH = 512;
constexpr float ALPHA = 1.4142135623730951f;
constexpr float LN_EPS = 1e-5f;
constexpr int NT = 256;

struct P {
    const float* in[34];
    float* out;
    float* Xc;
    float* MOD;
    float* FILT;
    float* NORM;
    float* A1; float* A2;
    float* Hb;
    float* Zb;
    float* US;
    float* Pb;
    float* RS;
    int* RE;
    float* RWt;
};

__device__ __forceinline__ float siluf(float x) { return x / (1.f + expf(-x)); }
__device__ __forceinline__ float sigmf(float x) { return 1.f / (1.f + expf(-x)); }
__device__ __forceinline__ float logsigf(float x) { return fminf(x, 0.f) - log1pf(expf(-fabsf(x))); }

#define GSTRIDE(i, n) for (long i = (long)blockIdx.x * blockDim.x + threadIdx.x; i < (long)(n); i += (long)gridDim.x * blockDim.x)

__device__ __forceinline__ float* xrow(const P& p, int b, int lr) {
    return lr < L ? p.out + ((size_t)b * L + lr) * D : p.Xc + ((size_t)b * CTX + (lr - L)) * D;
}
__device__ __forceinline__ const float* modv(const P& p, int l, int b, int lr, int chunk) {
    const int j = lr < L ? b : 2;
    return p.MOD + ((size_t)(l * 3 + j) * 6 + chunk) * D;
}

__device__ void ph_ada(const P& p) {
    GSTRIDE(idx, 2 * 3 * 6144) {
        const int n = idx % 6144, j = (idx / 6144) % 3, l = idx / (3 * 6144);
        const float* cv = j < 2 ? p.in[1] + j * D : p.in[3];
        const float* w = p.in[4] + (size_t)l * D * 6144;
        float acc = p.in[5][l * 6144 + n];
        for (int k = 0; k < D; ++k) acc += siluf(cv[k]) * w[(size_t)k * 6144 + n];
        p.MOD[idx] = acc;
    }
}
__device__ void ph_init(const P& p) {
    GSTRIDE(i, (long)NB * L * D) p.out[i] = p.in[0][i];
    GSTRIDE(i, (long)NB * CTX * D) p.Xc[i] = p.in[2][i];
    GSTRIDE(i, 2 * 2048) p.NORM[i] = 0.f;
}
__device__ void ph_mod(const P& p, int l, int b, int which) {
    GSTRIDE(i, (long)RB * D) {
        const int lr = i / D, k = i % D;
        const float sh = modv(p, l, b, lr, which * 3 + 0)[k], sc = modv(p, l, b, lr, which * 3 + 1)[k];
        p.Hb[i] = xrow(p, b, lr)[k] * (1.f + sc) + sh;
    }
}
__device__ void ph_gemm(const float* A, int lda, const float* Bm, int ldb, float* C, int ldc, int M, int N, int K) {
    __shared__ float As[16][65];
    __shared__ float Bs[16][64];
    const int tid = threadIdx.x, tx = tid & 15, ty = tid >> 4;
    const int tm = M / 64, tn = (N + 63) / 64;
    for (int tile = blockIdx.x; tile < tm * tn; tile += gridDim.x) {
        const int m0 = (tile / tn) * 64, n0 = (tile % tn) * 64;
        float acc[4][4];
#pragma unroll
        for (int i = 0; i < 4; ++i)
#pragma unroll
            for (int j = 0; j < 4; ++j) acc[i][j] = 0.f;
        for (int k0 = 0; k0 < K; k0 += 16) {
            __syncthreads();
#pragma unroll
            for (int i = 0; i < 4; ++i) {
                const int e = tid + i * 256;
                const int r = e >> 4, kk = e & 15;
                As[kk][r] = A[(size_t)(m0 + r) * lda + k0 + kk];
                const int kr = e >> 6, cc = e & 63;
                Bs[kr][cc] = (n0 + cc < N) ? Bm[(size_t)(k0 + kr) * ldb + n0 + cc] : 0.f;
            }
            __syncthreads();
#pragma unroll
            for (int kk = 0; kk < 16; ++kk) {
                float a[4], bb[4];
#pragma unroll
                for (int i = 0; i < 4; ++i) { a[i] = As[kk][ty * 4 + i]; bb[i] = Bs[kk][tx * 4 + i]; }
#pragma unroll
                for (int i = 0; i < 4; ++i)
#pragma unroll
                    for (int j = 0; j < 4; ++j) acc[i][j] += a[i] * bb[j];
            }
        }
#pragma unroll
        for (int i = 0; i < 4; ++i)
#pragma unroll
            for (int j = 0; j < 4; ++j) { const int n = n0 + tx * 4 + j; if (n < N) C[(size_t)(m0 + ty * 4 + i) * ldc + n] = acc[i][j]; }
    }
}
__device__ void ph_rope(const P& p, int b) {
    float* Z = p.Zb;
    GSTRIDE(i, (long)RB * RW) { const int lr = i / RW, c = i % RW; Z[(size_t)lr * ABIN + RW + c] *= 0.08838834764831845f; }
}
__device__ void ph_rope2(const P& p, int b) {
    float* Z = p.Zb;
    GSTRIDE(i, (long)L * 2 * RH * 64) {
        const int pr = i % 64, h = (i / 64) % RH, w = (i / (64 * RH)) % 2, t = i / (64 * RH * 2);
        const int row = t / GW, col = t % GW;
        const int fi = pr & 31;
        const float inv = powf(10000.f, -(float)fi / 32.f);
        const float ang = (pr < 32 ? (float)row : (float)col) * inv;
        float sn, cs; sincosf(ang, &sn, &cs);
        float* base = Z + (size_t)t * ABIN + w * RW + h * RHD;
        const float t1 = base[pr], t2 = base[64 + pr];
        base[pr] = t1 * cs - t2 * sn; base[64 + pr] = t1 * sn + t2 * cs;
    }
}
__device__ __forceinline__ int chunk_row0(int c) { return c < 2 ? L + c * RC : (c - 2) * RC; }
__device__ void ph_retU(const P& p, int b) {
    float* Uf = p.US; float* Ub = p.US + (size_t)RH * NCH * RHD * RHD;
    const float* Z = p.Zb;
    GSTRIDE(idx, (long)RH * NCH * RHD * RHD) {
        const int e = idx % RHD, d = (idx / RHD) % RHD, c = (idx / (RHD * RHD)) % NCH, h = idx / (RHD * RHD * NCH);
        const float lgf = p.in[9][h], lgb = p.in[10][h];
        const int r0 = chunk_row0(c);
        float uf = 0.f, ub = 0.f;
        for (int j = 0; j < RC; ++j) {
            const float kk = Z[(size_t)(r0 + j) * ABIN + RW + h * RHD + d], vv = Z[(size_t)(r0 + j) * ABIN + 2 * RW + h * RHD + e];
            uf += kk * expf(lgf * (float)(RC - 1 - j)) * vv; ub += kk * expf(lgb * (float)j) * vv;
        }
        Uf[idx] = uf; Ub[idx] = ub;
    }
}
__device__ void ph_retScan(const P& p, int b) {
    float* Uf = p.US; float* Ub = p.US + (size_t)RH * NCH * RHD * RHD;
    GSTRIDE(idx, (long)RH * RHD * RHD) {
        const int de = idx % (RHD * RHD), h = idx / (RHD * RHD);
        const float df = expf(p.in[9][h] * (float)RC), db = expf(p.in[10][h] * (float)RC);
        float s = 0.f;
        for (int c = 0; c < NCH; ++c) { float* q = Uf + ((size_t)h * NCH + c) * RHD * RHD + de; const float u = *q; *q = s; s = df * s + u; }
        s = 0.f;
        for (int c = 1; c >= 0; --c) { float* q = Ub + ((size_t)h * NCH + c) * RHD * RHD + de; const float u = *q; *q = s; s = db * s + u; }
        for (int c = NCH - 1; c >= 2; --c) { float* q = Ub + ((size_t)h * NCH + c) * RHD * RHD + de; const float u = *q; *q = s; s = db * s + u; }
    }
}
__device__ void ph_retP(const P& p, int b) {
    const float* Z = p.Zb;
    GSTRIDE(idx, (long)RB * RH * RC) {
        const int j = idx % RC, h = (idx / RC) % RH, lr = idx / (RC * RH);
        const int i = lr % RC, r0 = lr - i;
        const float* q = Z + (size_t)lr * ABIN + h * RHD; const float* k = Z + (size_t)(r0 + j) * ABIN + RW + h * RHD;
        float s = 0.f;
        for (int d = 0; d < RHD; ++d) s += q[d] * k[d];
        const float m = i > j ? expf(p.in[9][h] * (float)(i - j)) : (j > i ? expf(p.in[10][h] * (float)(j - i)) : 2.f);
        p.Pb[idx] = s * m;
    }
}
__device__ void ph_retO(const P& p, int b) {
    const float* Z = p.Zb; float* O = p.Hb;
    const float* Sf = p.US; const float* Sb = p.US + (size_t)RH * NCH * RHD * RHD;
    GSTRIDE(idx, (long)RB * RW) {
        const int e = idx % RHD, h = (idx / RHD) % RH, lr = idx / RW;
        const int i = lr % RC, r0 = lr - i, c = lr < L ? 2 + lr / RC : (lr - L) / RC;
        const float* pp = p.Pb + ((size_t)lr * RH + h) * RC;
        float o = 0.f;
        for (int j = 0; j < RC; ++j) o += pp[j] * Z[(size_t)(r0 + j) * ABIN + 2 * RW + h * RHD + e];
        const float qf = expf(p.in[9][h] * (float)(i + 1)), qb = expf(p.in[10][h] * (float)(RC - i));
        const float* q = Z + (size_t)lr * ABIN + h * RHD;
        const float* sf = Sf + ((size_t)h * NCH + c) * RHD * RHD + e; const float* sb = Sb + ((size_t)h * NCH + c) * RHD * RHD + e;
        float of = 0.f, ob = 0.f;
        for (int d = 0; d < RHD; ++d) { of += q[d] * sf[(size_t)d * RHD]; ob += q[d] * sb[(size_t)d * RHD]; }
        O[idx] = o + qf * of + qb * ob;
    }
}
__device__ void ph_retNorm(const P& p, int b) {
    float* Z = p.Zb; const float* O = p.Hb;
    GSTRIDE(idx, (long)RB * RH) {
        const int h = idx % RH, lr = idx / RH;
        const float* o = O + (size_t)lr * RW + h * RHD;
        float mu = 0.f; for (int e = 0; e < RHD; ++e) mu += o[e]; mu *= (1.f / RHD);
        float var = 0.f; for (int e = 0; e < RHD; ++e) { const float d = o[e] - mu; var += d * d; } var *= (1.f / RHD);
        const float rs = 1.f / sqrtf(var + LN_EPS);
        for (int e = 0; e < RHD; ++e) { const float g = Z[(size_t)lr * ABIN + 3 * RW + h * RHD + e]; Z[(size_t)lr * ABIN + h * RHD + e] = (o[e] - mu) * rs * siluf(g); }
    }
}
__device__ __forceinline__ void hy_pos(int pidx, int& len, int& i) { if (pidx < L) { len = L; i = pidx; } else { len = CTX; i = pidx - L; } }
__device__ void ph_hyA1(const P& p) {
    GSTRIDE(idx, (long)RB * 64) {
        const int j = idx % 64, pidx = idx / 64; int len, i; hy_pos(pidx, len, i);
        const float t = (float)i / (float)(len - 1);
        const float w = 2.0f * 3.14159265358979323846f * (float)i / (float)len;
        const float* w1 = p.in[13];
        float acc = p.in[14][j] + t * w1[j];
        for (int m = 0; m < 16; ++m) {
            const float f = 1e-4f + (float)m * ((15.f - 1e-4f) / 15.f);
            acc += cosf(f * w) * w1[(1 + m) * 64 + j] - sinf(f * w) * w1[(17 + m) * 64 + j];
        }
        p.A1[idx] = sinf(p.in[20][0 * 64 + j] * acc);
    }
}
__device__ void ph_hyA(const P& p, const float* src, float* dst, const float* w, const float* bias, const float* freq) {
    GSTRIDE(idx, (long)RB * 64) {
        const int j = idx % 64, pidx = idx / 64;
        float acc = bias[j];
        for (int i = 0; i < 64; ++i) acc += src[(size_t)pidx * 64 + i] * w[i * 64 + j];
        dst[idx] = sinf(freq[j] * acc);
    }
}
__device__ void ph_hyF(const P& p, const float* a3) {
    const float mind = logf(1e-2f) / 1.5f, maxd = logf(1e-2f) / 0.3f;
    GSTRIDE(idx, (long)RB * 2048) {
        const int col = idx % 2048, pidx = idx / 2048, ch = col % HW; int len, i; hy_pos(pidx, len, i);
        const float t = (float)i / (float)(len - 1);
        float acc = 0.f;
        for (int m = 0; m < 64; ++m) acc += a3[(size_t)pidx * 64 + m] * p.in[19][m * 2048 + col];
        const float delta = fabsf(mind + (float)ch * ((maxd - mind) / 511.f));
        const float v = acc * expf(-t * delta);
        p.FILT[idx] = v;
    }
}
__device__ void ph_hyNorm(const P& p) {
    GSTRIDE(idx, (long)(RB / 64) * 2048) {
        const int col = idx % 2048, pb = idx / 2048;
        float s = 0.f;
        for (int q = 0; q < 64; ++q) { const float v = p.FILT[(size_t)(pb * 64 + q) * 2048 + col]; s += v * v; }
        atomicAdd(&p.NORM[(pb * 64 < L ? 0 : 1) * 2048 + col], s);
    }
}
__device__ __forceinline__ float dwc(const P& p, const float* Z, int lr, int col) {
    const int s0 = lr < L ? 0 : L, s1 = lr < L ? L : RB;
    const float* w = p.in[11];
    float acc = p.in[12][col] + w[1 * 1536 + col] * Z[(size_t)lr * ABIN + 2048 + col];
    if (lr - 1 >= s0) acc += w[0 * 1536 + col] * Z[(size_t)(lr - 1) * ABIN + 2048 + col];
    if (lr + 1 < s1) acc += w[2 * 1536 + col] * Z[(size_t)(lr + 1) * ABIN + 2048 + col];
    return acc;
}
__device__ void ph_hydw(const P& p, int b) {
    GSTRIDE(idx, (long)RB * HW) { const int ch = idx % HW, lr = idx / HW; p.Hb[idx] = dwc(p, p.Zb, lr, 2 * HW + ch); }
}
__device__ __forceinline__ float hy_tap(const P& p, int fbase, int nrm, int n, int ch, int d) {
    const float nf = 1.f / sqrtf(p.NORM[nrm * 2048 + n * 1024 + ch]), nb = 1.f / sqrtf(p.NORM[nrm * 2048 + n * 1024 + 512 + ch]);
    if (d > 0) return p.FILT[(size_t)(fbase + d) * 2048 + n * 1024 + ch] * nf;
    if (d < 0) return p.FILT[(size_t)(fbase - d) * 2048 + n * 1024 + 512 + ch] * nb;
    return p.FILT[(size_t)fbase * 2048 + n * 1024 + ch] * nf + p.FILT[(size_t)fbase * 2048 + n * 1024 + 512 + ch] * nb;
}
__device__ void ph_hyconv(const P& p, int b, int n) {
    const float* src = p.Hb; float* dst = p.Hb + (size_t)RB * HW;
    GSTRIDE(idx, (long)(RB / 4) * HW) {
        const int ch = idx % HW, tb = idx / HW, lr0 = tb * 4;
        const int s0 = lr0 < L ? 0 : L, len = lr0 < L ? L : CTX, nrm = lr0 < L ? 0 : 1, t0 = lr0 - s0;
        const float nf = 1.f / sqrtf(p.NORM[nrm * 2048 + n * 1024 + ch]), nb = 1.f / sqrtf(p.NORM[nrm * 2048 + n * 1024 + 512 + ch]);
        const float* Ff = p.FILT + (size_t)s0 * 2048 + n * 1024 + ch; const float* Fb = Ff + 512;
        float w0 = hy_tap(p, s0, nrm, n, ch, t0), w1 = hy_tap(p, s0, nrm, n, ch, t0 + 1), w2 = hy_tap(p, s0, nrm, n, ch, t0 + 2), w3 = hy_tap(p, s0, nrm, n, ch, t0 + 3);
        float a0 = 0.f, a1 = 0.f, a2 = 0.f, a3 = 0.f;
        for (int s = 0; s < len; ++s) {
            const float z = src[(size_t)(s0 + s) * HW + ch];
            a0 += w0 * z; a1 += w1 * z; a2 += w2 * z; a3 += w3 * z;
            w3 = w2; w2 = w1; w1 = w0;
            const int dn = t0 - (s + 1);
            if (s + 1 < len) {
                if (dn > 0) w0 = Ff[(size_t)dn * 2048] * nf; else if (dn < 0) w0 = Fb[(size_t)(-dn) * 2048] * nb; else w0 = Ff[0] * nf + Fb[0] * nb;
            }
        }
        dst[(size_t)(lr0 + 0) * HW + ch] = a0; dst[(size_t)(lr0 + 1) * HW + ch] = a1; dst[(size_t)(lr0 + 2) * HW + ch] = a2; dst[(size_t)(lr0 + 3) * HW + ch] = a3;
    }
}
__device__ void ph_hygate(const P& p, int b, int n) {
    float* z = p.Hb; const float* cv = p.Hb + (size_t)RB * HW;
    GSTRIDE(idx, (long)RB * HW) {
        const int ch = idx % HW, lr = idx / HW;
        const float gate = dwc(p, p.Zb, lr, n * HW + ch);
        const float r = gate * (cv[idx] + p.in[21][n * HW + ch] * z[idx]);
        if (n == 0) z[idx] = r; else p.Zb[(size_t)lr * ABIN + RW + ch] = r;
    }
}
__device__ void ph_post(const P& p, int l, int b, int which, const float* Y, int ldy) {
    __shared__ float red[NT];
    const float* lg = p.in[6] + (size_t)(l * 2 + which) * D; const float* lb = p.in[7] + (size_t)(l * 2 + which) * D;
    for (int lr = blockIdx.x; lr < RB; lr += gridDim.x) {
        float* x = xrow(p, b, lr); const float* gate = modv(p, l, b, lr, which * 3 + 2);
        float v[4]; float s = 0.f;
#pragma unroll
        for (int i = 0; i < 4; ++i) { const int k = threadIdx.x + i * NT; v[i] = ALPHA * x[k] + gate[k] * Y[(size_t)lr * ldy + k]; s += v[i]; }
        red[threadIdx.x] = s; __syncthreads();
        for (int o = NT / 2; o > 0; o >>= 1) { if (threadIdx.x < o) red[threadIdx.x] += red[threadIdx.x + o]; __syncthreads(); }
        const float mu = red[0] * (1.f / D); __syncthreads();
        float q = 0.f;
#pragma unroll
        for (int i = 0; i < 4; ++i) { const float d = v[i] - mu; q += d * d; }
        red[threadIdx.x] = q; __syncthreads();
        for (int o = NT / 2; o > 0; o >>= 1) { if (threadIdx.x < o) red[threadIdx.x] += red[threadIdx.x + o]; __syncthreads(); }
        const float rs = 1.f / sqrtf(red[0] * (1.f / D) + LN_EPS); __syncthreads();
#pragma unroll
        for (int i = 0; i < 4; ++i) { const int k = threadIdx.x + i * NT; x[k] = (v[i] - mu) * rs * lg[k] + lb[k]; }
    }
}
__device__ void ph_route1(const P& p) {
    GSTRIDE(idx, (long)RB * NE) {
        const int e = idx % NE, lr = idx / NE;
        float acc = 0.f;
        for (int k = 0; k < D; ++k) acc += p.Hb[(size_t)lr * D + k] * p.in[29][k * NE + e];
        p.RS[idx] = sigmf(acc);
    }
}
__device__ void ph_route2(const P& p) {
    GSTRIDE(lr, RB) {
        const float* s = p.RS + (size_t)lr * NE; const float* rb = p.in[30];
        int best = 0; float bs = -1e30f;
        for (int g = 0; g < NG; ++g) {
            float m1 = -1e30f, m2 = -1e30f;
            for (int q = 0; q < EPG; ++q) { const float v = s[g * EPG + q] + rb[g * EPG + q]; if (v > m1) { m2 = m1; m1 = v; } else if (v > m2) m2 = v; }
            if (m1 + m2 > bs) { bs = m1 + m2; best = g; }
        }
        int i1 = 0; float v1 = -1e30f;
        for (int q = 0; q < EPG; ++q) { const float v = s[best * EPG + q] + rb[best * EPG + q]; if (v > v1) { v1 = v; i1 = q; } }
        int i2 = 0; float v2 = -1e30f;
        for (int q = 0; q < EPG; ++q) { if (q == i1) continue; const float v = s[best * EPG + q] + rb[best * EPG + q]; if (v > v2) { v2 = v; i2 = q; } }
        const int e1 = best * EPG + i1, e2 = best * EPG + i2; const float a = s[e1], c = s[e2];
        p.RE[lr * 2] = e1; p.RE[lr * 2 + 1] = e2; p.RWt[lr * 2] = a / (a + c); p.RWt[lr * 2 + 1] = c / (a + c);
    }
}
__device__ void ph_moe1(const P& p, int l) {
    GSTRIDE(idx, (long)RB * 2 * EH) {
        const int j = idx % EH, k = (idx / EH) % 2, lr = idx / (2 * EH);
        const int e = p.RE[lr * 2 + k];
        const float* wg = p.in[31] + ((size_t)(l * NE + e) * D) * EH + j; const float* wu = p.in[32] + ((size_t)(l * NE + e) * D) * EH + j;
        const float* h = p.Hb + (size_t)lr * D;
        float g = 0.f, u = 0.f;
        for (int i = 0; i < D; ++i) { g += h[i] * wg[(size_t)i * EH]; u += h[i] * wu[(size_t)i * EH]; }
        p.US[idx] = siluf(g) * u;
    }
}
__device__ void ph_moe2(const P& p, int l) {
    GSTRIDE(idx, (long)RB * D) {
        const int n = idx % D, lr = idx / D;
        float acc = 0.f;
        for (int k = 0; k < 2; ++k) {
            const int e = p.RE[lr * 2 + k]; const float* wd = p.in[33] + ((size_t)(l * NE + e) * EH) * D + n; const float* he = p.US + ((size_t)lr * 2 + k) * EH;
            float a = 0.f;
            for (int j = 0; j < EH; ++j) a += he[j] * wd[(size_t)j * D];
            acc += p.RWt[lr * 2 + k] * a;
        }
        p.Zb[idx] = acc;
    }
}
__device__ void ph_glagate(const P& p) {
    GSTRIDE(idx, (long)2 * RB * GK) {
        const int ch = idx % GK, lr = (idx / GK) % RB, dir = idx / (GK * RB);
        const float* gw = p.in[dir ? 26 : 24]; const float* gb = p.in[dir ? 27 : 25];
        float acc = gb[ch];
        for (int r = 0; r < 16; ++r) acc += p.Zb[(size_t)lr * GIN + 3072 + dir * 16 + r] * gw[r * GK + ch];
        p.Hb[idx] = logsigf(acc) * (1.f / 16.f);
    }
}
__device__ void ph_glacum(const P& p) {
    GSTRIDE(idx, (long)2 * NCH * GK) {
        const int ch = idx % GK, c = (idx / GK) % NCH, dir = idx / (GK * NCH);
        float* a = p.Hb + (size_t)dir * RB * GK + (size_t)chunk_row0(c) * GK + ch;
        float s = 0.f;
        if (dir == 0) for (int i = 0; i < GC; ++i) { s += a[(size_t)i * GK]; a[(size_t)i * GK] = s; }
        else for (int i = GC - 1; i >= 0; --i) { s += a[(size_t)i * GK]; a[(size_t)i * GK] = s; }
    }
}
constexpr size_t GSZ = (size_t)4 * NCH * GDK * GDV;
__device__ void ph_glaU(const P& p) {
    const float* Z = p.Zb; const float* BF = p.Hb; const float* BB = p.Hb + (size_t)RB * GK;
    GSTRIDE(idx, (long)GSZ) {
        const int e = idx % GDV, d = (idx / GDV) % GDK, c = (idx / (GDV * GDK)) % NCH, h = idx / (GDV * GDK * NCH);
        const int r0 = chunk_row0(c);
        const float bfe = BF[(size_t)(r0 + GC - 1) * GK + h * GDK + d], bbe = BB[(size_t)r0 * GK + h * GDK + d];
        float uf = 0.f, ub = 0.f;
        for (int j = 0; j < GC; ++j) {
            const float kk = Z[(size_t)(r0 + j) * GIN + GK + h * GDK + d], vv = Z[(size_t)(r0 + j) * GIN + 2 * GK + h * GDV + e];
            uf += kk * expf(bfe - BF[(size_t)(r0 + j) * GK + h * GDK + d]) * vv;
            ub += kk * expf(bbe - BB[(size_t)(r0 + j) * GK + h * GDK + d]) * vv;
        }
        p.FILT[idx] = uf; p.FILT[GSZ + idx] = ub;
    }
}
__device__ void ph_glaScan(const P& p) {
    const float* BF = p.Hb; const float* BB = p.Hb + (size_t)RB * GK;
    GSTRIDE(idx, (long)4 * GDK * GDV) {
        const int e = idx % GDV, d = (idx / GDV) % GDK, h = idx / (GDV * GDK);
        float s = 0.f;
        for (int c = 0; c < NCH; ++c) {
            float* q = p.FILT + (((size_t)h * NCH + c) * GDK + d) * GDV + e; const float u = *q; *q = s;
            s = expf(BF[(size_t)(chunk_row0(c) + GC - 1) * GK + h * GDK + d]) * s + u;
        }
        s = 0.f;
        for (int cc = 0; cc < NCH; ++cc) {
            const int c = cc < 2 ? 1 - cc : NCH + 1 - cc;
            float* q = p.FILT + GSZ + (((size_t)h * NCH + c) * GDK + d) * GDV + e; const float u = *q; *q = s;
            s = expf(BB[(size_t)chunk_row0(c) * GK + h * GDK + d]) * s + u;
        }
    }
}
__device__ void ph_glaP(const P& p) {
    const float* Z = p.Zb; const float* BF = p.Hb; const float* BB = p.Hb + (size_t)RB * GK;
    GSTRIDE(idx, (long)L * 4 * GC) {
        const int j = idx % GC, h = (idx / GC) % 4, lr = idx / (GC * 4);
        const int i = lr % GC, r0 = lr - i;
        const float* q = Z + (size_t)lr * GIN + h * GDK; const float* k = Z + (size_t)(r0 + j) * GIN + GK + h * GDK;
        float s = 0.f;
        if (i >= j) { const float* bi = BF + (size_t)lr * GK + h * GDK; const float* bj = BF + (size_t)(r0 + j) * GK + h * GDK;
            for (int d = 0; d < GDK; ++d) s += q[d] * k[d] * expf(bi[d] - bj[d]); }
        if (i <= j) { const float* bi = BB + (size_t)lr * GK + h * GDK; const float* bj = BB + (size_t)(r0 + j) * GK + h * GDK;
            for (int d = 0; d < GDK; ++d) s += q[d] * k[d] * expf(bi[d] - bj[d]); }
        p.Pb[idx] = s * 0.08838834764831845f;
    }
}
__device__ void ph_glaO(const P& p) {
    const float* Z = p.Zb; const float* BF = p.Hb; const float* BB = p.Hb + (size_t)RB * GK;
    GSTRIDE(idx, (long)RB * GV) {
        const int e = idx % GDV, h = (idx / GDV) % 4, lr = idx / GV;
        if (lr >= L) { p.US[idx] = 0.f; continue; }
        const int i = lr % GC, r0 = lr - i, c = 2 + lr / GC;
        const float* pp = p.Pb + ((size_t)lr * 4 + h) * GC;
        float o = 0.f;
        for (int j = 0; j < GC; ++j) o += pp[j] * Z[(size_t)(r0 + j) * GIN + 2 * GK + h * GDV + e];
        const float* q = Z + (size_t)lr * GIN + h * GDK;
        const float* sf = p.FILT + (((size_t)h * NCH + c) * GDK) * GDV + e; const float* sb = sf + GSZ;
        const float* bi = BF + (size_t)lr * GK + h * GDK; const float* bbi = BB + (size_t)lr * GK + h * GDK;
        float a = 0.f;
        for (int d = 0; d < GDK; ++d) a += q[d] * (expf(bi[d]) * sf[(size_t)d * GDV] + expf(bbi[d]) * sb[(size_t)d * GDV]);
        p.US[idx] = o + a * 0.08838834764831845f;
    }
}
__device__ void ph_glaNorm(const P& p) {
    GSTRIDE(idx, (long)RB * 4) {
        const int h = idx % 4, lr = idx / 4;
        float* o = p.US + (size_t)lr * GV + h * GDV;
        float ss = 0.f; for (int e = 0; e < GDV; ++e) ss += o[e] * o[e];
        const float rs = 1.f / sqrtf(ss * (1.f / GDV) + LN_EPS);
        for (int e = 0; e < GDV; ++e) o[e] = o[e] * rs * siluf(p.Zb[(size_t)lr * GIN + 2 * GK + GV + h * GDV + e]);
    }
}

constexpr int S_PRE = 6, S_L0 = 22, S_L1 = 17, N_STEPS = S_PRE + NB * S_L0 + NB * S_L1;
__device__ void run_step(const P& p, int step) {
    if (step < S_PRE) {
        switch (step) {
            case 0: ph_ada(p); ph_init(p); break;
            case 1: ph_hyA1(p); break;
            case 2: ph_hyA(p, p.A1, p.A2, p.in[15], p.in[16], p.in[20] + 64); break;
            case 3: ph_hyA(p, p.A2, p.A1, p.in[17], p.in[18], p.in[20] + 128); break;
            case 4: ph_hyF(p, p.A1); break;
            case 5: ph_hyNorm(p); break;
        }
        return;
    }
    step -= S_PRE;
    if (step < NB * S_L0) {
        const int b = step / S_L0, s = step % S_L0, l = 0;
        switch (s) {
            case 0: ph_mod(p, l, b, 0); break;
            case 1: ph_gemm(p.Hb, D, p.in[8], ABIN, p.Zb, ABIN, RB, ABIN, D); break;
            case 2: ph_rope(p, b); break;
            case 3: ph_rope2(p, b); break;
            case 4: ph_retU(p, b); break;
            case 5: ph_retScan(p, b); break;
            case 6: ph_retP(p, b); break;
            case 7: ph_retO(p, b); break;
            case 8: ph_retNorm(p, b); break;
            case 9: ph_hydw(p, b); break;
            case 10: ph_hyconv(p, b, 0); break;
            case 11: ph_hygate(p, b, 0); break;
            case 12: ph_hyconv(p, b, 1); break;
            case 13: ph_hygate(p, b, 1); break;
            case 14: ph_gemm(p.Zb, ABIN, p.in[22], D, p.Hb, D, RB, D, D); break;
            case 15: ph_post(p, l, b, 0, p.Hb, D); break;
            case 16: ph_mod(p, l, b, 1); break;
            case 17: ph_route1(p); break;
            case 18: ph_route2(p); break;
            case 19: ph_moe1(p, l); break;
            case 20: ph_moe2(p, l); break;
            case 21: ph_post(p, l, b, 1, p.Zb, D); break;
        }
        return;
    }
    step -= NB * S_L0;
    {
        const int b = step / S_L1, s = step % S_L1, l = 1;
        switch (s) {
            case 0: ph_mod(p, l, b, 0); break;
            case 1: ph_gemm(p.Hb, D, p.in[23], GIN, p.Zb, GIN, RB, GIN, D); break;
            case 2: ph_glagate(p); break;
            case 3: ph_glacum(p); break;
            case 4: ph_glaU(p); break;
            case 5: ph_glaScan(p); break;
            case 6: ph_glaP(p); break;
            case 7: ph_glaO(p); break;
            case 8: ph_glaNorm(p); break;
            case 9: ph_gemm(p.US, D, p.in[28], D, p.Hb, D, RB, D, D); break;
            case 10: ph_post(p, l, b, 0, p.Hb, D); break;
            case 11: ph_mod(p, l, b, 1); break;
            case 12: ph_route1(p); break;
            case 13: ph_route2(p); break;
            case 14: ph_moe1(p, l); break;
            case 15: ph_moe2(p, l); break;
            case 16: ph_post(p, l, b, 1, p.Zb, D); break;
        }
    }
}

__global__ void __launch_bounds__(NT) k_step(P p, int step) { run_step(p, step); }
__global__ void __launch_bounds__(NT) k_all(P p) {
    cg::grid_group grid = cg::this_grid();
    for (int s = 0; s < N_STEPS; ++s) { run_step(p, s); grid.sync(); }
}

extern "C" void kernel_launch(void* const* d_in, const int* in_sizes, int n_in, void* d_out, int out_size, void* d_ws, size_t ws_size, hipStream_t stream) {
    P p{};
    for (int i = 0; i < 34; ++i) p.in[i] = (const float*)d_in[i];
    p.out = (float*)d_out;
    float* w = (float*)d_ws; size_t off = 0;
    auto take = [&](size_t n) { float* r = w + off; off += (n + 63) & ~(size_t)63; return r; };
    p.Xc = take((size_t)NB * CTX * D);
    p.MOD = take(2 * 3 * 6144);
    p.FILT = take((size_t)RB * 2048);
    p.NORM = take(2 * 2048);
    p.A1 = take((size_t)RB * 64); p.A2 = take((size_t)RB * 64);
    p.Hb = take((size_t)RB * D);
    p.Zb = take((size_t)RB * ABIN);
    p.US = take((size_t)RB * D);
    p.Pb = take((size_t)RB * 512);
    p.RS = take((size_t)RB * NE);
    p.RE = (int*)take((size_t)RB * 2);
    p.RWt = take((size_t)RB * 2);
    if (off * sizeof(float) > ws_size || n_in != 34 || out_size != NB * L * D) { fprintf(stderr, "kernel_launch: bad sizes (need %zu ws bytes, have %zu)\n", off * sizeof(float), ws_size); return; }
#if ONE_LAUNCH
    static int grid = 0;
    if (!grid) { int dev = 0, cus = 0, per = 0; hipGetDevice(&dev); hipDeviceGetAttribute(&cus, hipDeviceAttributeMultiprocessorCount, dev);
        hipOccupancyMaxActiveBlocksPerMultiprocessor(&per, k_all, NT, 0); if (per > 4) per = 4; grid = cus * per; }
    void* args[] = {&p};
    hipError_t e = hipLaunchCooperativeKernel((void*)k_all, dim3(grid), dim3(NT), args, 0, stream);
    if (e != hipSuccess) fprintf(stderr, "coop launch failed: %s (grid %d)\n", hipGetErrorString(e), grid);
#else
    for (int s = 0; s < N_STEPS; ++s) hipLaunchKernelGGL(k_step, dim3(2048), dim3(NT), 0, stream, p, s);
#endif
}
```

```cpp
#include <hip/hip_runtime.h>
#include <hip/hip_cooperative_groups.h>
#include <cstdio>
#include <cstdint>
namespace cg = cooperative_groups;


namespace pg8 {
#define PG8_LAS __attribute__((address_space(3)))
typedef unsigned short bf16_t;
typedef short bf16x8 __attribute__((ext_vector_type(8)));
typedef float f32x4 __attribute__((ext_vector_type(4)));
typedef unsigned u32x4 __attribute__((ext_vector_type(4)));
constexpr int BM = 256, BK = 64, HALF = 128, HTB = HALF * BK * 2  , STAGE_BYTES = 8 * HTB, NXCD = 8, WGM = 8;

__host__ __device__ __forceinline__ int lds_byte(int r, int c) { const int st = (r >> 4) * 2 + (c >> 5), rr = r & 15, cc = c & 31, ob = rr * 64 + cc * 2; return st * 1024 + (ob ^ (((ob >> 9) & 1) << 5)); }
__host__ __device__ __forceinline__ void stage_rc(int b, int& R, int& C) { const int st = b / 1024, sb = b % 1024, swz = sb ^ (((sb >> 9) & 1) << 5); R = (st >> 1) * 16 + swz / 64; C = (st & 1) * 32 + (swz % 64) / 2; }
__host__ __device__ __forceinline__ int perm32(int rho) { const int n = rho >> 4, i = rho & 15; return 8 * (i >> 2) + 4 * n + (i & 3); }

struct Unit { int pm, pn; };
struct Gemm { const bf16_t* A; const bf16_t* Bt; int M, N, K; };

struct StaticOrder {
    int nM, nN, nwg, G, c;
    __host__ __device__ void init(int M, int N, int G_, int c_) { nM = M / BM; nN = N / BM; nwg = nM * nN; G = G_; c = c_; }
    __host__ __device__ bool next(int i, Unit& u) const {
        const long L = (long)i * G + c; if (L >= nwg) return false;
        int wgid = (int)L; { const int q = nwg / NXCD, r = nwg % NXCD, xcd = wgid % NXCD, off = wgid / NXCD; wgid = (xcd < r ? xcd * (q + 1) : r * (q + 1) + (xcd - r) * q) + off; }
        const int nig = WGM * nN, gid = wgid / nig, fm = gid * WGM, gsz = (nM - fm) < WGM ? (nM - fm) : WGM;
        u.pm = fm + ((wgid % nig) % gsz); u.pn = (wgid % nig) / gsz; return true;
    }
    __device__ __forceinline__ void a_ready(const Unit&) const {}
    __device__ __forceinline__ void done(const Unit&) const {}
};


__device__ __forceinline__ unsigned cvt_pk_bf16(float lo, float hi) { unsigned r; asm volatile("v_cvt_pk_bf16_f32 %0, %1, %2" : "=v"(r) : "v"(lo), "v"(hi)); return r; }

template <class Epi, class Sched, bool ALIGN_EPI = false, bool SP2 = false>
__device__ __forceinline__ void gemm_phase(PG8_LAS unsigned char* lds, const Gemm g, const Sched& S, const Epi& E) {
    int tid_l = threadIdx.x; asm volatile("" : "+v"(tid_l)); const int tid = tid_l, wid = __builtin_amdgcn_readfirstlane(tid >> 6), lane = tid & 63, wr = wid >> 2, wc = wid & 3, fr = lane & 15, fq = lane >> 4;
    const int K = g.K, nt = K / BK;
    unsigned voffA[2], voffB[2];
#pragma unroll
    for (int i = 0; i < 2; ++i) { int R, C; stage_rc(tid * 16 + i * 8192, R, C); const int Rb = Epi::PERM ? ((R & ~31) + perm32(R & 31)) : R;
        voffA[i] = (unsigned)(R * K + C) * 2u; voffB[i] = (unsigned)(Rb * K + C) * 2u; }
    const size_t kstep = (size_t)(BK * 2);
    const size_t hstep = (size_t)HALF * K * 2;
    const size_t tstep = 2 * hstep;
    const unsigned ldsw = (unsigned)wid * 1024u;
    const int aoff = lds_byte(wr * 64 + fr, fq * 8), boff = lds_byte(wc * 32 + fr, fq * 8);
#define PG8_SA(b, h) (((b) * 2 + (h)) * HTB)
#define PG8_SB(b, h) ((4 + (b) * 2 + (h)) * HTB)
#define PG8_STAGE(bufoff, gbase, voff) do { _Pragma("unroll") for (int _i = 0; _i < 2; ++_i) \
        __builtin_amdgcn_global_load_lds((const unsigned*)((const char*)(gbase) + (voff)[_i]), (PG8_LAS unsigned*)(lds + (bufoff) + ldsw + _i * 8192), 16, 0, 0); } while (0)
#define PG8_LDA(dst, b, h) do { _Pragma("unroll") for (int m = 0; m < 4; ++m) _Pragma("unroll") for (int k = 0; k < 2; ++k) dst[m][k] = *(const PG8_LAS bf16x8*)(lds + PG8_SA(b, h) + aoff + m * 2048 + k * 1024); } while (0)
#define PG8_LDB(dst, b, h) do { _Pragma("unroll") for (int n = 0; n < 2; ++n) _Pragma("unroll") for (int k = 0; k < 2; ++k) dst[n][k] = *(const PG8_LAS bf16x8*)(lds + PG8_SB(b, h) + boff + n * 2048 + k * 1024); } while (0)
#define PG8_MMA(ai, bj, At, Bt) do { __builtin_amdgcn_s_setprio(1); _Pragma("unroll") for (int m = 0; m < 4; ++m) _Pragma("unroll") for (int n = 0; n < 2; ++n) _Pragma("unroll") for (int k = 0; k < 2; ++k) \
        acc[ai][bj][m][n] = __builtin_amdgcn_mfma_f32_16x16x32_bf16(Bt[n][k], At[m][k], acc[ai][bj][m][n], 0, 0, 0); __builtin_amdgcn_s_setprio(0); } while (0)
#define PG8_WAIT_V(n) asm volatile("s_waitcnt vmcnt(" #n ")" ::: "memory")
#define PG8_WAIT_L(n) asm volatile("s_waitcnt lgkmcnt(" #n ")" ::: "memory")
#define PG8_BAR __builtin_amdgcn_s_barrier()
#define PG8_SCHED __builtin_amdgcn_sched_barrier(0)
    Unit cur, nxt; int ui = 0;
    if (!S.next(0, cur)) return;
    f32x4 acc[2][2][4][2];
#pragma unroll
    for (int a = 0; a < 2; ++a)
#pragma unroll
        for (int b = 0; b < 2; ++b)
#pragma unroll
            for (int m = 0; m < 4; ++m)
#pragma unroll
                for (int n = 0; n < 2; ++n) acc[a][b][m][n] = (f32x4){0.f, 0.f, 0.f, 0.f};
    bf16x8 At[4][2], B0[2][2], B1[2][2];
    const char* cA = (const char*)g.A + (size_t)cur.pm * tstep; const char* cB = (const char*)g.Bt + (size_t)cur.pn * tstep;
    S.a_ready(cur);
    if constexpr (SP2) {
        PG8_STAGE(PG8_SB(0, 0), cB, voffB); PG8_STAGE(PG8_SB(0, 1), cB + hstep, voffB); PG8_STAGE(PG8_SA(0, 0), cA, voffA); PG8_STAGE(PG8_SA(0, 1), cA + hstep, voffA);
        if (wr == 1) PG8_BAR;
        PG8_WAIT_V(2); PG8_BAR;
        PG8_STAGE(PG8_SB(1, 0), cB + kstep, voffB); PG8_STAGE(PG8_SA(1, 0), cA + kstep, voffA); PG8_STAGE(PG8_SB(1, 1), cB + hstep + kstep, voffB);
        PG8_WAIT_V(6); PG8_BAR;
    } else {
        PG8_STAGE(PG8_SB(0, 0), cB, voffB); PG8_STAGE(PG8_SA(0, 0), cA, voffA); PG8_STAGE(PG8_SB(0, 1), cB + hstep, voffB); PG8_STAGE(PG8_SA(0, 1), cA + hstep, voffA);
        if (wr == 1) PG8_BAR;
        PG8_WAIT_V(4); PG8_BAR;
        PG8_STAGE(PG8_SB(1, 0), cB + kstep, voffB); PG8_STAGE(PG8_SA(1, 0), cA + kstep, voffA); PG8_STAGE(PG8_SB(1, 1), cB + hstep + kstep, voffB);
        PG8_WAIT_V(6); PG8_BAR;
    }
    for (;;) {
        const bool has_next = S.next(ui + 1, nxt);
        const char* nA = has_next ? (const char*)g.A + (size_t)nxt.pm * tstep : cA; const char* nB = has_next ? (const char*)g.Bt + (size_t)nxt.pn * tstep : cB;
        for (int t = 0; t < nt; t += 2) {
            const bool last = (t == nt - 2);
            const char* a1 = cA + (size_t)(t + 1) * kstep;
            const char* a2 = last ? nA : cA + (size_t)(t + 2) * kstep; const char* b2 = last ? nB : cB + (size_t)(t + 2) * kstep;
            const char* a3 = a2 + kstep; const char* b3 = b2 + kstep;
            if (last && has_next) S.a_ready(nxt);
            if constexpr (SP2) {
            PG8_LDB(B0, 0, 0); PG8_LDB(B1, 0, 1); PG8_SCHED; PG8_LDA(At, 0, 0); PG8_STAGE(PG8_SA(1, 1), a1 + hstep, voffA);
            PG8_WAIT_V(8); PG8_WAIT_L(0); PG8_BAR; PG8_MMA(0, 0, At, B0); PG8_MMA(0, 1, At, B1); PG8_BAR; PG8_SCHED;
            PG8_LDA(At, 0, 1); PG8_STAGE(PG8_SB(0, 0), b2, voffB); PG8_STAGE(PG8_SB(0, 1), b2 + hstep, voffB); PG8_STAGE(PG8_SA(0, 0), a2, voffA);
            PG8_WAIT_V(8); PG8_WAIT_L(0); PG8_BAR; PG8_MMA(1, 0, At, B0); PG8_MMA(1, 1, At, B1); PG8_BAR; PG8_SCHED;
            PG8_LDB(B0, 1, 0); PG8_LDB(B1, 1, 1); PG8_SCHED; PG8_LDA(At, 1, 0); PG8_STAGE(PG8_SA(0, 1), a2 + hstep, voffA);
            PG8_WAIT_V(8); PG8_WAIT_L(0); PG8_BAR; PG8_MMA(0, 0, At, B0); PG8_MMA(0, 1, At, B1); PG8_BAR; PG8_SCHED;
            PG8_LDA(At, 1, 1); PG8_STAGE(PG8_SB(1, 0), b3, voffB); PG8_STAGE(PG8_SB(1, 1), b3 + hstep, voffB); PG8_STAGE(PG8_SA(1, 0), a3, voffA);
            PG8_WAIT_V(8); PG8_WAIT_L(0); PG8_BAR; PG8_MMA(1, 0, At, B0); PG8_MMA(1, 1, At, B1); PG8_BAR; PG8_SCHED;
            } else {
            PG8_LDB(B0, 0, 0); PG8_SCHED; PG8_LDA(At, 0, 0); PG8_STAGE(PG8_SA(1, 1), a1 + hstep, voffA);
            PG8_WAIT_L(8); PG8_BAR; PG8_WAIT_L(0); PG8_MMA(0, 0, At, B0); PG8_BAR; PG8_SCHED;
            PG8_LDB(B1, 0, 1); PG8_STAGE(PG8_SB(0, 0), b2, voffB);
            PG8_BAR; PG8_WAIT_L(0); PG8_MMA(0, 1, At, B1); PG8_BAR;
            PG8_LDA(At, 0, 1); PG8_STAGE(PG8_SA(0, 0), a2, voffA);
            PG8_BAR; PG8_WAIT_L(0); PG8_MMA(1, 0, At, B0); PG8_BAR; PG8_SCHED;
            PG8_STAGE(PG8_SB(0, 1), b2 + hstep, voffB);
            PG8_WAIT_V(6); PG8_BAR; PG8_MMA(1, 1, At, B1); PG8_BAR;
            PG8_LDB(B0, 1, 0); PG8_SCHED; PG8_LDA(At, 1, 0); PG8_STAGE(PG8_SA(0, 1), a2 + hstep, voffA);
            PG8_WAIT_L(8); PG8_BAR; PG8_WAIT_L(0); PG8_MMA(0, 0, At, B0); PG8_BAR; PG8_SCHED;
            PG8_LDB(B1, 1, 1); PG8_STAGE(PG8_SB(1, 0), b3, voffB);
            PG8_BAR; PG8_WAIT_L(0); PG8_MMA(0, 1, At, B1); PG8_BAR;
            PG8_LDA(At, 1, 1); PG8_STAGE(PG8_SA(1, 0), a3, voffA);
            PG8_BAR; PG8_WAIT_L(0); PG8_MMA(1, 0, At, B0); PG8_BAR; PG8_SCHED;
            PG8_STAGE(PG8_SB(1, 1), b3 + hstep, voffB);
            PG8_WAIT_V(6); PG8_BAR; PG8_MMA(1, 1, At, B1); PG8_BAR;
            }
        }
        if constexpr (ALIGN_EPI) { if (wr == 0) PG8_BAR; }
        if constexpr (!Epi::AFTER_DRAIN) { E(acc, cur, wr, wc, fr, fq); S.done(cur); }
        if (!has_next) break;
#pragma unroll
        for (int a = 0; a < 2; ++a)
#pragma unroll
            for (int b = 0; b < 2; ++b)
#pragma unroll
                for (int m = 0; m < 4; ++m)
#pragma unroll
                    for (int n = 0; n < 2; ++n) acc[a][b][m][n] = (f32x4){0.f, 0.f, 0.f, 0.f};
        cur = nxt; cA = nA; cB = nB; ++ui;
        if constexpr (ALIGN_EPI) { if (wr == 1) PG8_BAR; }
    }
    PG8_WAIT_V(0);
    if constexpr (!ALIGN_EPI) { if (wr == 0) PG8_BAR; }
    PG8_BAR;
    if constexpr (Epi::AFTER_DRAIN) { E.fused(acc, cur, wr, wc, fr, fq, lds, wid, lane); S.done(cur); }
#undef PG8_SA
#undef PG8_SB
#undef PG8_STAGE
#undef PG8_LDA
#undef PG8_LDB
#undef PG8_MMA
#undef PG8_WAIT_V
#undef PG8_WAIT_L
#undef PG8_BAR
#undef PG8_SCHED
}
}

namespace pg8 {
typedef unsigned u32x2 __attribute__((ext_vector_type(2)));
struct EpiSplit {
    static constexpr bool PERM = true, AFTER_DRAIN = false;
    bf16_t* O0; int ld0; bf16_t* O1; int ld1; int split_col;
    __device__ __forceinline__ void operator()(const f32x4 (&acc)[2][2][4][2], const Unit& u, int wr, int wc, int fr, int fq) const {
        const int row0 = u.pm * BM + wr * 64 + fr; int colt = u.pn * BM; bf16_t* base = O0; int ldc = ld0;
        if (colt >= split_col) { base = O1; ldc = ld1; colt -= split_col; }
        const int col0 = colt + wc * 32 + 8 * fq;
#pragma unroll
        for (int ai = 0; ai < 2; ++ai)
#pragma unroll
            for (int m = 0; m < 4; ++m) { bf16_t* rowp = base + (size_t)(row0 + ai * HALF + m * 16) * ldc + col0;
#pragma unroll
                for (int bj = 0; bj < 2; ++bj) { const f32x4 v0 = acc[ai][bj][m][0], v1 = acc[ai][bj][m][1];
                    u32x4 w; w.x = cvt_pk_bf16(v0[0], v0[1]); w.y = cvt_pk_bf16(v0[2], v0[3]); w.z = cvt_pk_bf16(v1[0], v1[1]); w.w = cvt_pk_bf16(v1[2], v1[3]);
                    *(u32x4*)(rowp + bj * HALF) = w; } }
    }
};
struct EpiSwiGLU {
    static constexpr bool PERM = true, AFTER_DRAIN = false;
    bf16_t* O;
    __device__ __forceinline__ void operator()(const f32x4 (&acc)[2][2][4][2], const Unit& u, int wr, int wc, int fr, int fq) const {
        const int row0 = u.pm * BM + wr * 64 + fr; const int j0 = (u.pn & 3) * 128 + wc * 16 + 4 * fq;
#pragma unroll
        for (int ai = 0; ai < 2; ++ai)
#pragma unroll
            for (int m = 0; m < 4; ++m) { bf16_t* rowp = O + (size_t)(row0 + ai * HALF + m * 16) * 512 + j0;
#pragma unroll
                for (int bj = 0; bj < 2; ++bj) { const f32x4 g = acc[ai][bj][m][0], up = acc[ai][bj][m][1]; float h[4];
#pragma unroll
                    for (int q = 0; q < 4; ++q) h[q] = g[q] / (1.f + __expf(-g[q])) * up[q];
                    u32x2 w; w.x = cvt_pk_bf16(h[0], h[1]); w.y = cvt_pk_bf16(h[2], h[3]);
                    *(u32x2*)(rowp + bj * 64) = w; } }
    }
};
struct EpiRowScale {
    static constexpr bool PERM = true, AFTER_DRAIN = false;
    bf16_t* O; const float* ws;
    __device__ __forceinline__ void operator()(const f32x4 (&acc)[2][2][4][2], const Unit& u, int wr, int wc, int fr, int fq) const {
        const int row0 = u.pm * BM + wr * 64 + fr; const int col0 = (u.pn & 3) * BM + wc * 32 + 8 * fq;
#pragma unroll
        for (int ai = 0; ai < 2; ++ai)
#pragma unroll
            for (int m = 0; m < 4; ++m) { const int row = row0 + ai * HALF + m * 16; const float s = ws[row]; bf16_t* rowp = O + (size_t)row * 1024 + col0;
#pragma unroll
                for (int bj = 0; bj < 2; ++bj) { const f32x4 v0 = acc[ai][bj][m][0] * s, v1 = acc[ai][bj][m][1] * s;
                    u32x4 w; w.x = cvt_pk_bf16(v0[0], v0[1]); w.y = cvt_pk_bf16(v0[2], v0[3]); w.z = cvt_pk_bf16(v1[0], v1[1]); w.w = cvt_pk_bf16(v1[2], v1[3]);
                    *(u32x4*)(rowp + bj * HALF) = w; } }
    }
};
struct MoeOrder {
    int G, c, nt; int toff[16];
    __device__ __forceinline__ void init(const int* cnt, int G_, int c_) { G = G_; c = c_; int s = 0;
#pragma unroll
        for (int e = 0; e < 16; ++e) { toff[e] = s; s += (cnt[e] + 255) >> 8; } nt = s; }
    __device__ __forceinline__ bool next(int i, Unit& u) const {
        const int Lq = i * G + c; if (Lq >= nt * 4) return false;
        const int pm = Lq % nt, pn4 = Lq / nt; int e = 0;
#pragma unroll
        for (int q = 1; q < 16; ++q) e += (pm >= toff[q]) ? 1 : 0;
        u.pm = pm; u.pn = e * 4 + pn4; return true; }
    __device__ __forceinline__ void a_ready(const Unit&) const {}
    __device__ __forceinline__ void done(const Unit&) const {}
};
}

constexpr int NB = 2, L = 8192, D = 1024, CTX = 256, RB = L + CTX;
constexpr int RL = NB * L, RCX = NB * CTX, R = RL + RCX;
constexpr int GW = 64;
constexpr int NCH = 66;
constexpr int ABIN = 3584, GIN = 3104, GINP = 3328;
constexpr int NE = 16, NG = 4, EPG = 4, EH = 512;
constexpr int MOE_ROWS = 37888;
constexpr float ALPHA = 1.4142135623730951f, LN_EPS = 1e-5f, KSCALE = 0.08838834764831845f;
constexpr int NT = 512;
constexpr int LDS_BYTES = 147456;

typedef unsigned short bf16_t;
#define LAS __attribute__((address_space(3)))
__device__ __forceinline__ float bf2f(bf16_t v) { return __uint_as_float((unsigned)v << 16); }
__device__ __forceinline__ bf16_t f2bf(float f) { unsigned u = __float_as_uint(f); return (bf16_t)((u + 0x7fffu + ((u >> 16) & 1u)) >> 16); }
__device__ __forceinline__ float siluf(float x) { return x / (1.f + expf(-x)); }
__device__ __forceinline__ float sigmf(float x) { return 1.f / (1.f + expf(-x)); }
__device__ __forceinline__ float logsigf(float x) { return fminf(x, 0.f) - log1pf(expf(-fabsf(x))); }

struct P {
    const float* in[34];
    float* out;
    float* Xc;
    float* MOD;
    float* NORM;
    int* CNT;
    float* A1; float* A2;
    float* RS; int* RE; int* RPOS; float* RWt; float* WS;
    bf16_t *Win0, *Wout0, *Win1, *Wout1, *Wgu, *Wd;
    bf16_t* H;
    bf16_t* Zr;
    bf16_t* Zh;
    bf16_t* hyT;
    float* FILT;
    bf16_t *Hs, *he, *slots;
    bf16_t* Z1;
    float* BG;
    bf16_t* GST;
};

__device__ __forceinline__ int launder_i(int x) { asm volatile("" : "+v"(x)); return x; }
#define TIDX launder_i((int)threadIdx.x)
#define GSTRIDE(i, n) for (long i = (long)blockIdx.x * blockDim.x + TIDX; i < (long)(n); i += (long)gridDim.x * blockDim.x)

__device__ __forceinline__ float* xrow(const P& p, int r) { return r < RL ? p.out + (size_t)r * D : p.Xc + (size_t)(r - RL) * D; }
__device__ __forceinline__ int seg_of(int r) { return r < RL ? r / L : 2; }
__device__ __forceinline__ const float* modv(const P& p, int l, int r, int chunk) { return p.MOD + ((size_t)(l * 3 + seg_of(r)) * 6 + chunk) * D; }
__device__ __forceinline__ int chunk_row0(int b, int c) { return c < 2 ? RL + b * CTX + c * 128 : b * L + (c - 2) * 128; }
__device__ __forceinline__ void row_bt(int r, int& b, int& tl) { if (r < RL) { b = r / L; tl = r % L; } else { b = (r - RL) / CTX; tl = L + (r - RL) % CTX; } }
__device__ __forceinline__ int bt_row(int b, int tl) { return tl < L ? b * L + tl : RL + b * CTX + (tl - L); }

__device__ void ph_wconv(bf16_t* dst, const float* src, int N, int K, int ldsrc, int nvalid) {
    GSTRIDE(idx, (long)N * K) { const int k = idx % K, n = idx / K; dst[idx] = n < nvalid ? f2bf(src[(size_t)k * ldsrc + n]) : (bf16_t)0; }
}
__device__ void ph_wconv_moe(const P& p, int l) {
    GSTRIDE(idx, (long)NE * 1024 * 1024) {
        const int k = idx % 1024, n = (idx / 1024) % 1024, e = idx / (1024 * 1024);
        const int q = n >> 3, r = n & 7, j = 4 * q + (r & 3);
        const float* src = (r < 4 ? p.in[31] : p.in[32]) + ((size_t)(l * NE + e) * D + k) * EH + j;
        p.Wgu[idx] = f2bf(*src);
    }
    GSTRIDE(idx, (long)NE * 1024 * 512) {
        const int k = idx % 512, n = (idx / 512) % 1024, e = idx / (512 * 1024);
        p.Wd[idx] = f2bf(p.in[33][((size_t)(l * NE + e) * EH + k) * D + n]);
    }
}
__device__ void ph_ada(const P& p) {
    GSTRIDE(idx, 2 * 3 * 6144) {
        const int n = idx % 6144, j = (idx / 6144) % 3, l = idx / (3 * 6144);
        const float* cv = j < 2 ? p.in[1] + j * D : p.in[3];
        const float* w = p.in[4] + (size_t)l * D * 6144;
        float acc = p.in[5][l * 6144 + n];
        for (int k = 0; k < D; ++k) acc += siluf(cv[k]) * w[(size_t)k * 6144 + n];
        p.MOD[idx] = acc;
    }
}
__device__ void ph_init(const P& p) {
    GSTRIDE(i, (long)RL * D) p.out[i] = p.in[0][i];
    GSTRIDE(i, (long)RCX * D) p.Xc[i] = p.in[2][i];
}
__device__ __forceinline__ void hy_pos(int pidx, int& len, int& i) { if (pidx < L) { len = L; i = pidx; } else { len = CTX; i = pidx - L; } }
__device__ void ph_hyA1(const P& p) {
    GSTRIDE(idx, (long)RB * 64) {
        const int j = idx % 64, pidx = idx / 64; int len, i; hy_pos(pidx, len, i);
        const float t = (float)i / (float)(len - 1);
        const float w = 2.0f * 3.14159265358979323846f * (float)i / (float)len;
        const float* w1 = p.in[13];
        float acc = p.in[14][j] + t * w1[j];
        for (int m = 0; m < 16; ++m) {
            const float f = 1e-4f + (float)m * ((15.f - 1e-4f) / 15.f);
            acc += cosf(f * w) * w1[(1 + m) * 64 + j] - sinf(f * w) * w1[(17 + m) * 64 + j];
        }
        p.A1[idx] = sinf(p.in[20][j] * acc);
    }
}
__device__ void ph_hyA(const float* src, float* dst, const float* w, const float* bias, const float* freq) {
    GSTRIDE(idx, (long)RB * 64) {
        const int j = idx % 64, pidx = idx / 64;
        float acc = bias[j];
        for (int i = 0; i < 64; ++i) acc += src[(size_t)pidx * 64 + i] * w[i * 64 + j];
        dst[idx] = sinf(freq[j] * acc);
    }
}
__device__ void ph_hyF(const P& p, const float* a3) {
    const float mind = logf(1e-2f) / 1.5f, maxd = logf(1e-2f) / 0.3f;
    GSTRIDE(idx, (long)2048 * RB) {
        const int pidx = idx % RB, col = idx / RB, ch = col % 512; int len, i; hy_pos(pidx, len, i);
        const float t = (float)i / (float)(len - 1);
        float acc = 0.f;
        for (int m = 0; m < 64; ++m) acc += a3[(size_t)pidx * 64 + m] * p.in[19][m * 2048 + col];
        const float delta = fabsf(mind + (float)ch * ((maxd - mind) / 511.f));
        p.FILT[idx] = acc * expf(-t * delta);
    }
}
__device__ void ph_hyNorm(const P& p) {
    GSTRIDE(idx, (long)2048 * (RB / 64)) {
        const int pb = idx % (RB / 64), col = idx / (RB / 64);
        float s = 0.f;
        for (int q = 0; q < 64; ++q) { const float v = p.FILT[(size_t)col * RB + pb * 64 + q]; s += v * v; }
        atomicAdd(&p.NORM[(pb * 64 < L ? 0 : 1) * 2048 + col], s);
    }
}
__device__ void ph_mod(const P& p, int l, int which) {
    GSTRIDE(i, (long)R * D) {
        const int r = i / D, k = i % D;
        p.H[i] = f2bf(xrow(p, r)[k] * (1.f + modv(p, l, r, which * 3 + 1)[k]) + modv(p, l, r, which * 3 + 0)[k]);
    }
}
__device__ void ph_prep_rope(const P& p) {
    GSTRIDE(i, (long)R * 2 * 4 * 64) {
        const int pr = i % 64, h = (i / 64) % 4, w = (i / 256) % 2, r = i / 512;
        bf16_t* base = p.Zr + (size_t)r * 2048 + w * 512 + h * 128;
        float t1 = bf2f(base[pr]), t2 = bf2f(base[64 + pr]);
        if (w == 1) { t1 *= KSCALE; t2 *= KSCALE; }
        if (r < RL) {
            const int t = r % L, row = t / GW, col = t % GW;
            const float inv = powf(10000.f, -(float)(pr & 31) / 32.f);
            const float ang = (pr < 32 ? (float)row : (float)col) * inv;
            float sn, cs; sincosf(ang, &sn, &cs);
            const float a = t1 * cs - t2 * sn, bb = t1 * sn + t2 * cs; t1 = a; t2 = bb;
        }
        base[pr] = f2bf(t1); base[64 + pr] = f2bf(t2);
    }
}
__device__ void ph_prep_hy(const P& p) {
    GSTRIDE(idx, (long)NB * 1536 * RB) {
        const int tl = idx % RB, col = (idx / RB) % 1536, b = idx / (RB * 1536);
        const int s0 = tl < L ? 0 : L, s1 = tl < L ? L : RB;
        const float* w = p.in[11];
        float acc = p.in[12][col] + w[1536 + col] * bf2f(p.Zh[(size_t)bt_row(b, tl) * 1536 + col]);
        if (tl - 1 >= s0) acc += w[col] * bf2f(p.Zh[(size_t)bt_row(b, tl - 1) * 1536 + col]);
        if (tl + 1 < s1) acc += w[2 * 1536 + col] * bf2f(p.Zh[(size_t)bt_row(b, tl + 1) * 1536 + col]);
        p.hyT[idx] = f2bf(acc);
    }
}
__device__ __forceinline__ float hy_tapT(const float* Ff, const float* Fb, float nf, float nb, int d) {
    if (d > 0) return Ff[d] * nf; if (d < 0) return Fb[-d] * nb; return Ff[0] * nf + Fb[0] * nb;
}
__device__ void ph_hyconv_naive(const P& p, int n, float* conv) {
    GSTRIDE(idx, (long)NB * 512 * (RB / 4)) {
        const int tb = idx % (RB / 4), ch = (idx / (RB / 4)) % 512, b = idx / ((RB / 4) * 512);
        const int tl0 = tb * 4, s0 = tl0 < L ? 0 : L, len = tl0 < L ? L : CTX, nrm = tl0 < L ? 0 : 1, t0 = tl0 - s0;
        const int cf = (n * 2 + 0) * 512 + ch, cb = (n * 2 + 1) * 512 + ch;
        const float nf = 1.f / sqrtf(p.NORM[nrm * 2048 + cf]), nb = 1.f / sqrtf(p.NORM[nrm * 2048 + cb]);
        const float* Ff = p.FILT + (size_t)cf * RB + s0; const float* Fb = p.FILT + (size_t)cb * RB + s0;
        const bf16_t* z = p.hyT + ((size_t)(b * 3 + 2) * 512 + ch) * RB + s0;
        float w0 = hy_tapT(Ff, Fb, nf, nb, t0), w1 = hy_tapT(Ff, Fb, nf, nb, t0 + 1), w2 = hy_tapT(Ff, Fb, nf, nb, t0 + 2), w3 = hy_tapT(Ff, Fb, nf, nb, t0 + 3);
        float a0 = 0.f, a1 = 0.f, a2 = 0.f, a3 = 0.f;
        for (int s = 0; s < len; ++s) {
            const float zz = bf2f(z[s]);
            a0 += w0 * zz; a1 += w1 * zz; a2 += w2 * zz; a3 += w3 * zz;
            w3 = w2; w2 = w1; w1 = w0;
            if (s + 1 < len) w0 = hy_tapT(Ff, Fb, nf, nb, t0 - (s + 1));
        }
        float* o = conv + ((size_t)b * 512 + ch) * RB + tl0; o[0] = a0; o[1] = a1; o[2] = a2; o[3] = a3;
    }
}
__device__ void ph_hygate_naive(const P& p, int n, const float* conv) {
    bf16_t* yhT = p.Zh + (size_t)2 * NB * 4 * NCH * 16384;
    GSTRIDE(idx, (long)NB * 512 * RB) {
        const int tl = idx % RB, ch = (idx / RB) % 512, b = idx / (RB * 512);
        bf16_t* z = p.hyT + ((size_t)(b * 3 + 2) * 512 + ch) * RB + tl; const float gate = bf2f(p.hyT[((size_t)(b * 3 + n) * 512 + ch) * RB + tl]);
        const float r = gate * (conv[idx] + p.in[21][n * 512 + ch] * bf2f(*z));
        if (n == 0) *z = f2bf(r); else yhT[idx] = f2bf(r);
    }
}
__device__ void ph_hy_untranspose(const P& p) {
    const bf16_t* yhT = p.Zh + (size_t)2 * NB * 4 * NCH * 16384;
    GSTRIDE(idx, (long)R * 512) { const int ch = idx % 512, r = idx / 512; int b, tl; row_bt(r, b, tl); p.H[(size_t)r * D + 512 + ch] = yhT[((size_t)b * 512 + ch) * RB + tl]; }
}
__device__ __forceinline__ size_t st_idx(int dir, int b, int h, int c) { return ((((size_t)dir * NB + b) * 4 + h) * NCH + c) * 16384; }
__device__ void ph_retU_naive(const P& p) {
    bf16_t* ST = p.Zh;
    GSTRIDE(idx, (long)NB * 4 * NCH * 16384) {
        const int d = idx % 128, e = (idx / 128) % 128, c = (idx / 16384) % NCH, h = (idx / (16384 * NCH)) % 4, b = idx / (16384 * NCH * 4);
        const float lgf = p.in[9][h], lgb = p.in[10][h]; const int r0 = chunk_row0(b, c);
        float uf = 0.f, ub = 0.f;
        for (int j = 0; j < 128; ++j) {
            const float kk = bf2f(p.Zr[(size_t)(r0 + j) * 2048 + 512 + h * 128 + d]), vv = bf2f(p.Zr[(size_t)(r0 + j) * 2048 + 1024 + h * 128 + e]);
            uf += kk * expf(lgf * (float)(127 - j)) * vv; ub += kk * expf(lgb * (float)j) * vv;
        }
        ST[st_idx(0, b, h, c) + e * 128 + d] = f2bf(uf); ST[st_idx(1, b, h, c) + e * 128 + d] = f2bf(ub);
    }
}
__device__ void ph_retScan(const P& p) {
    bf16_t* ST = p.Zh;
    GSTRIDE(idx, (long)2 * NB * 4 * 16384) {
        const int ed = idx % 16384, h = (idx / 16384) % 4, b = (idx / 65536) % NB, dir = idx / (65536 * NB);
        const float dc = expf(p.in[dir ? 10 : 9][h] * 128.f);
        float s = 0.f;
        for (int cc = 0; cc < NCH; ++cc) {
            const int c = dir == 0 ? cc : (cc < 2 ? 1 - cc : NCH + 1 - cc);
            bf16_t* q = ST + st_idx(dir, b, h, c) + ed; const float u = bf2f(*q); *q = f2bf(s); s = dc * s + u;
        }
    }
}
__device__ void ph_retO_naive(const P& p, float* lds) {
    const bf16_t* ST = p.Zh;
    for (int u = blockIdx.x; u < NB * 4 * NCH; u += gridDim.x) {
        const int c = u % NCH, h = (u / NCH) % 4, b = u / (NCH * 4); const int r0 = chunk_row0(b, c);
        const float lgf = p.in[9][h], lgb = p.in[10][h];
        __syncthreads();
        for (int e = TIDX; e < 128 * 128; e += NT) {
            const int j = e % 128, i = e / 128;
            const bf16_t* q = p.Zr + (size_t)(r0 + i) * 2048 + h * 128; const bf16_t* k = p.Zr + (size_t)(r0 + j) * 2048 + 512 + h * 128;
            float s = 0.f; for (int d = 0; d < 128; ++d) s += bf2f(q[d]) * bf2f(k[d]);
            const float m = i > j ? expf(lgf * (float)(i - j)) : (j > i ? expf(lgb * (float)(j - i)) : 2.f);
            lds[e] = s * m;
        }
        __syncthreads();
        const bf16_t* sf = ST + st_idx(0, b, h, c); const bf16_t* sb = ST + st_idx(1, b, h, c);
        for (int e2 = TIDX; e2 < 128 * 128; e2 += NT) {
            const int e = e2 % 128, i = e2 / 128;
            float o = 0.f; for (int j = 0; j < 128; ++j) o += lds[i * 128 + j] * bf2f(p.Zr[(size_t)(r0 + j) * 2048 + 1024 + h * 128 + e]);
            const bf16_t* q = p.Zr + (size_t)(r0 + i) * 2048 + h * 128;
            float of = 0.f, ob = 0.f; for (int d = 0; d < 128; ++d) { const float qq = bf2f(q[d]); of += qq * bf2f(sf[e * 128 + d]); ob += qq * bf2f(sb[e * 128 + d]); }
            p.H[(size_t)(r0 + i) * D + h * 128 + e] = f2bf(o + expf(lgf * (float)(i + 1)) * of + expf(lgb * (float)(128 - i)) * ob);
        }
    }
}
__device__ void ph_retNorm_naive(const P& p) {
    GSTRIDE(idx, (long)R * 4) {
        const int h = idx % 4, r = idx / 4; bf16_t* o = p.H + (size_t)r * D + h * 128;
        float mu = 0.f; for (int e = 0; e < 128; ++e) mu += bf2f(o[e]); mu *= (1.f / 128.f);
        float var = 0.f; for (int e = 0; e < 128; ++e) { const float d = bf2f(o[e]) - mu; var += d * d; } var *= (1.f / 128.f);
        const float rs = 1.f / sqrtf(var + LN_EPS);
        for (int e = 0; e < 128; ++e) o[e] = f2bf((bf2f(o[e]) - mu) * rs * siluf(bf2f(p.Zr[(size_t)r * 2048 + 1536 + h * 128 + e])));
    }
}
__device__ __forceinline__ float block_sum(float v, float* red) {
    __syncthreads();
#pragma unroll
    for (int o = 32; o > 0; o >>= 1) v += __shfl_xor(v, o);
    if ((TIDX & 63) == 0) red[TIDX >> 6] = v;
    __syncthreads();
    float t = 0.f;
#pragma unroll
    for (int w = 0; w < NT / 64; ++w) t += red[w];
    return t;
}
template <int MODE> __device__ void ph_post(const P& p, int l, int which, const bf16_t* Y, int ln, int wn, int nrows, float* red) {
    const float* lg = p.in[6] + (size_t)(l * 2 + which) * D; const float* lb = p.in[7] + (size_t)(l * 2 + which) * D;
    int toff[16];
    if (MODE == 1) { int s = 0;
#pragma unroll
        for (int e = 0; e < 16; ++e) { toff[e] = s; s += (p.CNT[l * 16 + e] + 255) >> 8; } }
    for (int r = blockIdx.x; r < nrows; r += gridDim.x) {
        float* x = xrow(p, r); const float* gate = modv(p, l, r, which * 3 + 2);
        const bf16_t *y0, *y1 = nullptr;
        if (MODE == 0) y0 = Y + (size_t)r * D;
        else {
            int sr[2];
#pragma unroll
            for (int k = 0; k < 2; ++k) { const int e = p.RE[r * 2 + k]; int to = 0;
#pragma unroll
                for (int q = 0; q < 16; ++q) to = (q == e) ? toff[q] : to;
                sr[k] = to * 256 + p.RPOS[r * 2 + k]; }
            y0 = p.slots + (size_t)sr[0] * D; y1 = p.slots + (size_t)sr[1] * D;
        }
        float v[2]; float s = 0.f;
#pragma unroll
        for (int i = 0; i < 2; ++i) { const int k = TIDX + i * NT; float yy = bf2f(y0[k]); if (MODE == 1) yy += bf2f(y1[k]); v[i] = ALPHA * x[k] + gate[k] * yy; s += v[i]; }
        const float mu = block_sum(s, red) * (1.f / D);
        float q = 0.f;
#pragma unroll
        for (int i = 0; i < 2; ++i) { const float d = v[i] - mu; q += d * d; }
        const float rs = 1.f / sqrtf(block_sum(q, red) * (1.f / D) + LN_EPS);
#pragma unroll
        for (int i = 0; i < 2; ++i) { const int k = TIDX + i * NT; const float xn = (v[i] - mu) * rs * lg[k] + lb[k]; x[k] = xn;
            if (ln >= 0) p.H[(size_t)r * D + k] = f2bf(xn * (1.f + modv(p, ln, r, wn * 3 + 1)[k]) + modv(p, ln, r, wn * 3 + 0)[k]); }
    }
}
__device__ void ph_route1(const P& p, int l, int nrows) {
    GSTRIDE(idx, (long)nrows * NE) {
        const int e = idx % NE, r = idx / NE; const float* x = xrow(p, r); const float* sc = modv(p, l, r, 4); const float* sh = modv(p, l, r, 3);
        float acc = 0.f;
        for (int k = 0; k < D; ++k) acc += (x[k] * (1.f + sc[k]) + sh[k]) * p.in[29][k * NE + e];
        p.RS[idx] = sigmf(acc);
    }
}
__device__ void ph_route2(const P& p, int l, int nrows) {
    GSTRIDE(r, nrows) {
        const float* s = p.RS + (size_t)r * NE; const float* rb = p.in[30];
        int best = 0; float bs = -1e30f;
        for (int g = 0; g < NG; ++g) {
            float m1 = -1e30f, m2 = -1e30f;
            for (int q = 0; q < EPG; ++q) { const float v = s[g * EPG + q] + rb[g * EPG + q]; if (v > m1) { m2 = m1; m1 = v; } else if (v > m2) m2 = v; }
            if (m1 + m2 > bs) { bs = m1 + m2; best = g; }
        }
        int i1 = 0; float v1 = -1e30f;
        for (int q = 0; q < EPG; ++q) { const float v = s[best * EPG + q] + rb[best * EPG + q]; if (v > v1) { v1 = v; i1 = q; } }
        int i2 = 0; float v2 = -1e30f;
        for (int q = 0; q < EPG; ++q) { if (q == i1) continue; const float v = s[best * EPG + q] + rb[best * EPG + q]; if (v > v2) { v2 = v; i2 = q; } }
        const int e1 = best * EPG + i1, e2 = best * EPG + i2; const float a = s[e1], c = s[e2];
        p.RE[r * 2] = e1; p.RE[r * 2 + 1] = e2; p.RWt[r * 2] = a / (a + c); p.RWt[r * 2 + 1] = c / (a + c);
        p.RPOS[r * 2] = atomicAdd(&p.CNT[l * 16 + e1], 1); p.RPOS[r * 2 + 1] = atomicAdd(&p.CNT[l * 16 + e2], 1);
    }
}
__device__ void ph_permute(const P& p, int l, int nrows) {
    int toff[16]; { int s = 0;
#pragma unroll
        for (int e = 0; e < 16; ++e) { toff[e] = s; s += (p.CNT[l * 16 + e] + 255) >> 8; } }
    GSTRIDE(idx, (long)nrows * 2 * 128) {
        const int ck = idx % 128, k = (idx / 128) % 2, r = idx / 256; const int e = p.RE[r * 2 + k]; int to = 0;
#pragma unroll
        for (int q = 0; q < 16; ++q) to = (q == e) ? toff[q] : to;
        const int sr = to * 256 + p.RPOS[r * 2 + k];
        ((uint4*)(p.Hs + (size_t)sr * D))[ck] = ((const uint4*)(p.H + (size_t)r * D))[ck];
        if (ck == 0) p.WS[sr] = p.RWt[r * 2 + k];
    }
}
__device__ void ph_glagate(const P& p) {
    GSTRIDE(idx, (long)2 * R * 512) {
        const int ch = idx % 512, r = (idx / 512) % R, dir = idx / (512 * R);
        const float* gw = p.in[dir ? 26 : 24]; const float* gb = p.in[dir ? 27 : 25];
        float acc = gb[ch];
        for (int q = 0; q < 16; ++q) acc += bf2f(p.Z1[(size_t)r * GINP + 3072 + dir * 16 + q]) * gw[q * 512 + ch];
        p.BG[idx] = logsigf(acc) * (1.f / 16.f);
    }
}
__device__ void ph_glacum(const P& p) {
    GSTRIDE(idx, (long)2 * NB * NCH * 512) {
        const int ch = idx % 512, c = (idx / 512) % NCH, b = (idx / (512 * NCH)) % NB, dir = idx / (512 * NCH * NB);
        float* a = p.BG + ((size_t)dir * R + chunk_row0(b, c)) * 512 + ch;
        float s = 0.f;
        if (dir == 0) for (int i = 0; i < 128; ++i) { s += a[(size_t)i * 512]; a[(size_t)i * 512] = s; }
        else for (int i = 127; i >= 0; --i) { s += a[(size_t)i * 512]; a[(size_t)i * 512] = s; }
    }
}
__device__ __forceinline__ size_t gst_idx(int dir, int b, int h, int c) { return ((((size_t)dir * NB + b) * 4 + h) * NCH + c) * 32768; }
__device__ void ph_glaU_naive(const P& p) {
    const float* BF = p.BG; const float* BB = p.BG + (size_t)R * 512;
    GSTRIDE(idx, (long)NB * 4 * NCH * 32768) {
        const int d = idx % 128, e = (idx / 128) % 256, c = (idx / 32768) % NCH, h = (idx / (32768 * NCH)) % 4, b = idx / (32768 * NCH * 4);
        const int r0 = chunk_row0(b, c);
        const float bfe = BF[(size_t)(r0 + 127) * 512 + h * 128 + d], bbe = BB[(size_t)r0 * 512 + h * 128 + d];
        float uf = 0.f, ub = 0.f;
        for (int j = 0; j < 128; ++j) {
            const float kk = bf2f(p.Z1[(size_t)(r0 + j) * GINP + 512 + h * 128 + d]), vv = bf2f(p.Z1[(size_t)(r0 + j) * GINP + 1024 + h * 256 + e]);
            uf += kk * expf(bfe - BF[(size_t)(r0 + j) * 512 + h * 128 + d]) * vv; ub += kk * expf(bbe - BB[(size_t)(r0 + j) * 512 + h * 128 + d]) * vv;
        }
        p.GST[gst_idx(0, b, h, c) + e * 128 + d] = f2bf(uf); p.GST[gst_idx(1, b, h, c) + e * 128 + d] = f2bf(ub);
    }
}
__device__ void ph_glaScan(const P& p) {
    const float* BF = p.BG; const float* BB = p.BG + (size_t)R * 512;
    GSTRIDE(idx, (long)2 * NB * 4 * 32768) {
        const int d = idx % 128, ed = idx % 32768, h = (idx / 32768) % 4, b = (idx / 131072) % NB, dir = idx / (131072 * NB);
        float s = 0.f;
        for (int cc = 0; cc < NCH; ++cc) {
            const int c = dir == 0 ? cc : (cc < 2 ? 1 - cc : NCH + 1 - cc); const int r0 = chunk_row0(b, c);
            const float dc = dir == 0 ? expf(BF[(size_t)(r0 + 127) * 512 + h * 128 + d]) : expf(BB[(size_t)r0 * 512 + h * 128 + d]);
            bf16_t* q = p.GST + gst_idx(dir, b, h, c) + ed; const float u = bf2f(*q); *q = f2bf(s); s = dc * s + u;
        }
    }
}
__device__ void ph_glaO_naive(const P& p, float* lds) {
    const float* BF = p.BG; const float* BB = p.BG + (size_t)R * 512;
    for (int u = blockIdx.x; u < NB * 4 * 64; u += gridDim.x) {
        const int c = 2 + u % 64, h = (u / 64) % 4, b = u / 256; const int r0 = chunk_row0(b, c);
        __syncthreads();
        for (int e = TIDX; e < 128 * 128; e += NT) {
            const int j = e % 128, i = e / 128;
            const bf16_t* q = p.Z1 + (size_t)(r0 + i) * GINP + h * 128; const bf16_t* k = p.Z1 + (size_t)(r0 + j) * GINP + 512 + h * 128;
            float s = 0.f;
            if (i >= j) { const float* bi = BF + (size_t)(r0 + i) * 512 + h * 128; const float* bj = BF + (size_t)(r0 + j) * 512 + h * 128;
                for (int d = 0; d < 128; ++d) s += bf2f(q[d]) * bf2f(k[d]) * expf(bi[d] - bj[d]); }
            if (i <= j) { const float* bi = BB + (size_t)(r0 + i) * 512 + h * 128; const float* bj = BB + (size_t)(r0 + j) * 512 + h * 128;
                for (int d = 0; d < 128; ++d) s += bf2f(q[d]) * bf2f(k[d]) * expf(bi[d] - bj[d]); }
            lds[e] = s * KSCALE;
        }
        __syncthreads();
        const bf16_t* sf = p.GST + gst_idx(0, b, h, c); const bf16_t* sb = p.GST + gst_idx(1, b, h, c);
        for (int e2 = TIDX; e2 < 128 * 256; e2 += NT) {
            const int e = e2 % 256, i = e2 / 256;
            float o = 0.f; for (int j = 0; j < 128; ++j) o += lds[i * 128 + j] * bf2f(p.Z1[(size_t)(r0 + j) * GINP + 1024 + h * 256 + e]);
            const bf16_t* q = p.Z1 + (size_t)(r0 + i) * GINP + h * 128; const float* bi = BF + (size_t)(r0 + i) * 512 + h * 128; const float* bbi = BB + (size_t)(r0 + i) * 512 + h * 128;
            float a = 0.f; for (int d = 0; d < 128; ++d) a += bf2f(q[d]) * (expf(bi[d]) * bf2f(sf[e * 128 + d]) + expf(bbi[d]) * bf2f(sb[e * 128 + d]));
            p.H[(size_t)(r0 + i) * D + h * 256 + e] = f2bf(o + a * KSCALE);
        }
    }
}
__device__ void ph_glaNorm_naive(const P& p) {
    GSTRIDE(idx, (long)RL * 4) {
        const int h = idx % 4, r = idx / 4; bf16_t* o = p.H + (size_t)r * D + h * 256;
        float ss = 0.f; for (int e = 0; e < 256; ++e) { const float v = bf2f(o[e]); ss += v * v; }
        const float rs = 1.f / sqrtf(ss * (1.f / 256.f) + LN_EPS);
        for (int e = 0; e < 256; ++e) o[e] = f2bf(bf2f(o[e]) * rs * siluf(bf2f(p.Z1[(size_t)r * GINP + 2048 + h * 256 + e])));
    }
}

constexpr int N_STEPS = 34;
#define PG8_ALIGN true
#define PG8_SP2 true
template <class Epi> __device__ __forceinline__ void dense_gemm(LAS unsigned char* lds, const bf16_t* A, const bf16_t* Bt, int M, int N, int K, const Epi& E) {
    pg8::Gemm g{A, Bt, M, N, K}; pg8::StaticOrder S; S.init(M, N, (int)gridDim.x, (int)blockIdx.x);
    pg8::gemm_phase<Epi, pg8::StaticOrder, PG8_ALIGN, PG8_SP2>(lds, g, S, E);
}
__device__ __forceinline__ void moe_gemms(const P& p, LAS unsigned char* lds, int l, int which) {
    pg8::MoeOrder S; S.init(p.CNT + l * 16, (int)gridDim.x, (int)blockIdx.x);
    if (which == 0) { pg8::Gemm g{p.Hs, p.Wgu, 0, 0, 1024}; pg8::EpiSwiGLU E{p.he}; pg8::gemm_phase<pg8::EpiSwiGLU, pg8::MoeOrder, PG8_ALIGN, PG8_SP2>(lds, g, S, E); }
    else { pg8::Gemm g{p.he, p.Wd, 0, 0, 512}; pg8::EpiRowScale E{p.slots, p.WS}; pg8::gemm_phase<pg8::EpiRowScale, pg8::MoeOrder, PG8_ALIGN, PG8_SP2>(lds, g, S, E); }
}
__device__ __forceinline__ void run_step(const P& p, int step, unsigned char* smem) {
    LAS unsigned char* lds = (LAS unsigned char*)smem; float* fl = (float*)smem;
    float* conv = (float*)p.H;
    switch (step) {
        case 0: ph_ada(p); ph_init(p); ph_wconv(p.Win0, p.in[8], ABIN, D, ABIN, ABIN); ph_wconv(p.Wout0, p.in[22], D, D, D, D);
                ph_wconv(p.Win1, p.in[23], GINP, D, GIN, GIN); ph_wconv(p.Wout1, p.in[28], D, D, D, D); ph_wconv_moe(p, 0); ph_hyA1(p); break;
        case 1: ph_mod(p, 0, 0); ph_hyA(p.A1, p.A2, p.in[15], p.in[16], p.in[20] + 64); break;
        case 2: { pg8::EpiSplit E{p.Zr, 2048, p.Zh, 1536, 2048}; dense_gemm(lds, p.H, p.Win0, R, ABIN, D, E); }
                ph_hyA(p.A2, p.A1, p.in[17], p.in[18], p.in[20] + 128); break;
        case 3: ph_prep_rope(p); ph_prep_hy(p); ph_hyF(p, p.A1); break;
        case 4: ph_hyNorm(p); ph_retU_naive(p); break;
        case 5: ph_hyconv_naive(p, 0, conv); ph_retScan(p); break;
        case 6: ph_hygate_naive(p, 0, conv); break;
        case 7: ph_hyconv_naive(p, 1, conv); break;
        case 8: ph_hygate_naive(p, 1, conv); break;
        case 9: ph_retO_naive(p, fl); break;
        case 10: ph_retNorm_naive(p); ph_hy_untranspose(p); break;
        case 11: { pg8::EpiSplit E{p.Zr, 1024, p.Zr, 1024, 1 << 30}; dense_gemm(lds, p.H, p.Wout0, R, D, D, E); } break;
        case 12: ph_post<0>(p, 0, 0, p.Zr, 0, 1, R, fl); break;
        case 13: ph_route1(p, 0, R); break;
        case 14: ph_route2(p, 0, R); break;
        case 15: ph_permute(p, 0, R); break;
        case 16: moe_gemms(p, lds, 0, 0); break;
        case 17: moe_gemms(p, lds, 0, 1); break;
        case 18: ph_post<1>(p, 0, 1, nullptr, 1, 0, R, fl); break;
        case 19: { pg8::EpiSplit E{p.Z1, GINP, p.Z1, GINP, 1 << 30}; dense_gemm(lds, p.H, p.Win1, R, GINP, D, E); } ph_wconv_moe(p, 1); break;
        case 20: ph_glagate(p); break;
        case 21: ph_glacum(p); break;
        case 22: ph_glaU_naive(p); break;
        case 23: ph_glaScan(p); break;
        case 24: ph_glaO_naive(p, fl); break;
        case 25: ph_glaNorm_naive(p); break;
        case 26: { pg8::EpiSplit E{p.Zr, 1024, p.Zr, 1024, 1 << 30}; dense_gemm(lds, p.H, p.Wout1, RL, D, D, E); } break;
        case 27: ph_post<0>(p, 1, 0, p.Zr, 1, 1, RL, fl); break;
        case 28: ph_route1(p, 1, RL); break;
        case 29: ph_route2(p, 1, RL); break;
        case 30: ph_permute(p, 1, RL); break;
        case 31: moe_gemms(p, lds, 1, 0); break;
        case 32: moe_gemms(p, lds, 1, 1); break;
        case 33: ph_post<1>(p, 1, 1, nullptr, -1, 0, RL, fl); break;
    }
}
__global__ void __launch_bounds__(NT, 2) k_all(P p) {
    extern __shared__ __attribute__((aligned(16))) unsigned char smem[];
    cg::grid_group grid = cg::this_grid();
#define STEP(n) run_step(p, n, smem); grid.sync();
    STEP(0) STEP(1) STEP(2) STEP(3) STEP(4) STEP(5) STEP(6) STEP(7) STEP(8) STEP(9) STEP(10) STEP(11) STEP(12) STEP(13) STEP(14) STEP(15) STEP(16)
    STEP(17) STEP(18) STEP(19) STEP(20) STEP(21) STEP(22) STEP(23) STEP(24) STEP(25) STEP(26) STEP(27) STEP(28) STEP(29) STEP(30) STEP(31) STEP(32) STEP(33)
#undef STEP
}

extern "C" void kernel_launch(void* const* d_in, const int* in_sizes, int n_in, void* d_out, int out_size, void* d_ws, size_t ws_size, hipStream_t stream) {
    P p{};
    for (int i = 0; i < 34; ++i) p.in[i] = (const float*)d_in[i];
    p.out = (float*)d_out;
    unsigned char* w = (unsigned char*)d_ws; size_t off = 0;
    auto take = [&](size_t bytes) { unsigned char* r = w + off; off += (bytes + 255) & ~(size_t)255; return r; };
    p.NORM = (float*)take(2 * 2048 * 4); p.CNT = (int*)take(2 * 16 * 4);
    const size_t ctl_bytes = off;
    p.Win1 = (bf16_t*)take((size_t)GINP * D * 2); p.Wout1 = (bf16_t*)take((size_t)D * D * 2);
    p.Wgu = (bf16_t*)take((size_t)NE * 1024 * 1024 * 2); p.Wd = (bf16_t*)take((size_t)NE * 1024 * 512 * 2);
    p.Xc = (float*)take((size_t)RCX * D * 4); p.MOD = (float*)take(2 * 3 * 6144 * 4);
    p.RS = (float*)take((size_t)R * NE * 4); p.RE = (int*)take((size_t)R * 2 * 4); p.RPOS = (int*)take((size_t)R * 2 * 4); p.RWt = (float*)take((size_t)R * 2 * 4);
    p.WS = (float*)take((size_t)MOE_ROWS * 4);
    const size_t big = off;
    p.H = (bf16_t*)take((size_t)R * D * 2);
    p.Zr = (bf16_t*)take((size_t)R * 2048 * 2);
    p.Zh = (bf16_t*)take((size_t)R * 1536 * 2);
    p.hyT = (bf16_t*)take((size_t)NB * 3 * 512 * RB * 2);
    p.FILT = (float*)take((size_t)2048 * RB * 4);
    p.Win0 = (bf16_t*)take((size_t)ABIN * D * 2); p.Wout0 = (bf16_t*)take((size_t)D * D * 2);
    p.A1 = (float*)take((size_t)RB * 64 * 4); p.A2 = (float*)take((size_t)RB * 64 * 4);
    const size_t total = off;
    off = big + (((size_t)R * D * 2 + 255) & ~(size_t)255);
    p.Hs = (bf16_t*)take((size_t)MOE_ROWS * D * 2); p.he = (bf16_t*)take((size_t)MOE_ROWS * EH * 2); p.slots = (bf16_t*)take((size_t)MOE_ROWS * D * 2);
    const size_t moe_end = off;
    off = big + (((size_t)R * D * 2 + 255) & ~(size_t)255);
    p.Z1 = (bf16_t*)take((size_t)R * GINP * 2); p.BG = (float*)take((size_t)2 * R * 512 * 4); p.GST = (bf16_t*)take((size_t)2 * NB * 4 * NCH * 32768 * 2);
    const size_t l1_end = off;
    if (total > ws_size || moe_end > total || l1_end > total || n_in != 34 || out_size != RL * D) {
        fprintf(stderr, "kernel_launch: bad sizes (need %zu ws bytes, have %zu; moe_end %zu l1_end %zu)\n", total, ws_size, moe_end, l1_end); return; }
    static int grid = 0;
    if (!grid) {
        int dev = 0, cus = 0, per = 0; hipGetDevice(&dev); hipDeviceGetAttribute(&cus, hipDeviceAttributeMultiprocessorCount, dev);
        hipFuncSetAttribute((const void*)k_all, hipFuncAttributeMaxDynamicSharedMemorySize, LDS_BYTES);
        hipOccupancyMaxActiveBlocksPerMultiprocessor(&per, k_all, NT, LDS_BYTES);
        if (per < 1) { fprintf(stderr, "kernel_launch: occupancy query says %d blocks per CU\n", per); per = 1; }
        grid = cus;
    }
    hipMemsetAsync(d_ws, 0, ctl_bytes, stream);
    void* args[] = {&p};
    hipError_t e = hipLaunchCooperativeKernel((void*)k_all, dim3(grid), dim3(NT), args, LDS_BYTES, stream);
    if (e != hipSuccess) fprintf(stderr, "coop launch failed: %s (grid %d)\n", hipGetErrorString(e), grid);
}
```

```cpp
#include <hip/hip_runtime.h>
#include <hip/hip_cooperative_groups.h>
#include <cstdio>
#include <cstdint>
namespace cg = cooperative_groups;


namespace pg8 {
#define PG8_LAS __attribute__((address_space(3)))
typedef unsigned short bf16_t;
typedef short bf16x8 __attribute__((ext_vector_type(8)));
typedef float f32x4 __attribute__((ext_vector_type(4)));
typedef unsigned u32x4 __attribute__((ext_vector_type(4)));
constexpr int BM = 256, BK = 64, HALF = 128, HTB = HALF * BK * 2  , STAGE_BYTES = 8 * HTB, NXCD = 8, WGM = 8;

__host__ __device__ __forceinline__ int lds_byte(int r, int c) { const int st = (r >> 4) * 2 + (c >> 5), rr = r & 15, cc = c & 31, ob = rr * 64 + cc * 2; return st * 1024 + (ob ^ (((ob >> 9) & 1) << 5)); }
__host__ __device__ __forceinline__ void stage_rc(int b, int& R, int& C) { const int st = b / 1024, sb = b % 1024, swz = sb ^ (((sb >> 9) & 1) << 5); R = (st >> 1) * 16 + swz / 64; C = (st & 1) * 32 + (swz % 64) / 2; }
__host__ __device__ __forceinline__ int perm32(int rho) { const int n = rho >> 4, i = rho & 15; return 8 * (i >> 2) + 4 * n + (i & 3); }

struct Unit { int pm, pn; };
struct Gemm { const bf16_t* A; const bf16_t* Bt; int M, N, K; };

struct StaticOrder {
    int nM, nN, nwg, G, c;
    __host__ __device__ void init(int M, int N, int G_, int c_) { nM = M / BM; nN = N / BM; nwg = nM * nN; G = G_; c = c_; }
    __host__ __device__ bool next(int i, Unit& u) const {
        const long L = (long)i * G + c; if (L >= nwg) return false;
        int wgid = (int)L; { const int q = nwg / NXCD, r = nwg % NXCD, xcd = wgid % NXCD, off = wgid / NXCD; wgid = (xcd < r ? xcd * (q + 1) : r * (q + 1) + (xcd - r) * q) + off; }
        const int nig = WGM * nN, gid = wgid / nig, fm = gid * WGM, gsz = (nM - fm) < WGM ? (nM - fm) : WGM;
        u.pm = fm + ((wgid % nig) % gsz); u.pn = (wgid % nig) / gsz; return true;
    }
    __device__ __forceinline__ void a_ready(const Unit&) const {}
    __device__ __forceinline__ void done(const Unit&) const {}
};


__device__ __forceinline__ unsigned cvt_pk_bf16(float lo, float hi) { unsigned r; asm volatile("v_cvt_pk_bf16_f32 %0, %1, %2" : "=v"(r) : "v"(lo), "v"(hi)); return r; }

template <class Epi, class Sched, bool ALIGN_EPI = false, bool SP2 = false>
__device__ __forceinline__ void gemm_phase(PG8_LAS unsigned char* lds, const Gemm g, const Sched& S, const Epi& E) {
    int tid_l = threadIdx.x; asm volatile("" : "+v"(tid_l)); const int tid = tid_l, wid = __builtin_amdgcn_readfirstlane(tid >> 6), lane = tid & 63, wr = wid >> 2, wc = wid & 3, fr = lane & 15, fq = lane >> 4;
    const int K = g.K, nt = K / BK;
    unsigned voffA[2], voffB[2];
#pragma unroll
    for (int i = 0; i < 2; ++i) { int R, C; stage_rc(tid * 16 + i * 8192, R, C); const int Rb = Epi::PERM ? ((R & ~31) + perm32(R & 31)) : R;
        voffA[i] = (unsigned)(R * K + C) * 2u; voffB[i] = (unsigned)(Rb * K + C) * 2u; }
    const size_t kstep = (size_t)(BK * 2);
    const size_t hstep = (size_t)HALF * K * 2;
    const size_t tstep = 2 * hstep;
    const unsigned ldsw = (unsigned)wid * 1024u;
    const int aoff = lds_byte(wr * 64 + fr, fq * 8), boff = lds_byte(wc * 32 + fr, fq * 8);
#define PG8_SA(b, h) (((b) * 2 + (h)) * HTB)
#define PG8_SB(b, h) ((4 + (b) * 2 + (h)) * HTB)
#define PG8_STAGE(bufoff, gbase, voff) do { _Pragma("unroll") for (int _i = 0; _i < 2; ++_i) \
        __builtin_amdgcn_global_load_lds((const unsigned*)((const char*)(gbase) + (voff)[_i]), (PG8_LAS unsigned*)(lds + (bufoff) + ldsw + _i * 8192), 16, 0, 0); } while (0)
#define PG8_LDA(dst, b, h) do { _Pragma("unroll") for (int m = 0; m < 4; ++m) _Pragma("unroll") for (int k = 0; k < 2; ++k) dst[m][k] = *(const PG8_LAS bf16x8*)(lds + PG8_SA(b, h) + aoff + m * 2048 + k * 1024); } while (0)
#define PG8_LDB(dst, b, h) do { _Pragma("unroll") for (int n = 0; n < 2; ++n) _Pragma("unroll") for (int k = 0; k < 2; ++k) dst[n][k] = *(const PG8_LAS bf16x8*)(lds + PG8_SB(b, h) + boff + n * 2048 + k * 1024); } while (0)
#define PG8_MMA(ai, bj, At, Bt) do { __builtin_amdgcn_s_setprio(1); _Pragma("unroll") for (int m = 0; m < 4; ++m) _Pragma("unroll") for (int n = 0; n < 2; ++n) _Pragma("unroll") for (int k = 0; k < 2; ++k) \
        acc[ai][bj][m][n] = __builtin_amdgcn_mfma_f32_16x16x32_bf16(Bt[n][k], At[m][k], acc[ai][bj][m][n], 0, 0, 0); __builtin_amdgcn_s_setprio(0); } while (0)
#define PG8_WAIT_V(n) asm volatile("s_waitcnt vmcnt(" #n ")" ::: "memory")
#define PG8_WAIT_L(n) asm volatile("s_waitcnt lgkmcnt(" #n ")" ::: "memory")
#define PG8_BAR __builtin_amdgcn_s_barrier()
#define PG8_SCHED __builtin_amdgcn_sched_barrier(0)
    Unit cur, nxt; int ui = 0;
    if (!S.next(0, cur)) return;
    f32x4 acc[2][2][4][2];
#pragma unroll
    for (int a = 0; a < 2; ++a)
#pragma unroll
        for (int b = 0; b < 2; ++b)
#pragma unroll
            for (int m = 0; m < 4; ++m)
#pragma unroll
                for (int n = 0; n < 2; ++n) acc[a][b][m][n] = (f32x4){0.f, 0.f, 0.f, 0.f};
    bf16x8 At[4][2], B0[2][2], B1[2][2];
    const char* cA = (const char*)g.A + (size_t)cur.pm * tstep; const char* cB = (const char*)g.Bt + (size_t)cur.pn * tstep;
    S.a_ready(cur);
    if constexpr (SP2) {
        PG8_STAGE(PG8_SB(0, 0), cB, voffB); PG8_STAGE(PG8_SB(0, 1), cB + hstep, voffB); PG8_STAGE(PG8_SA(0, 0), cA, voffA); PG8_STAGE(PG8_SA(0, 1), cA + hstep, voffA);
        if (wr == 1) PG8_BAR;
        PG8_WAIT_V(2); PG8_BAR;
        PG8_STAGE(PG8_SB(1, 0), cB + kstep, voffB); PG8_STAGE(PG8_SA(1, 0), cA + kstep, voffA); PG8_STAGE(PG8_SB(1, 1), cB + hstep + kstep, voffB);
        PG8_WAIT_V(6); PG8_BAR;
    } else {
        PG8_STAGE(PG8_SB(0, 0), cB, voffB); PG8_STAGE(PG8_SA(0, 0), cA, voffA); PG8_STAGE(PG8_SB(0, 1), cB + hstep, voffB); PG8_STAGE(PG8_SA(0, 1), cA + hstep, voffA);
        if (wr == 1) PG8_BAR;
        PG8_WAIT_V(4); PG8_BAR;
        PG8_STAGE(PG8_SB(1, 0), cB + kstep, voffB); PG8_STAGE(PG8_SA(1, 0), cA + kstep, voffA); PG8_STAGE(PG8_SB(1, 1), cB + hstep + kstep, voffB);
        PG8_WAIT_V(6); PG8_BAR;
    }
    for (;;) {
        const bool has_next = S.next(ui + 1, nxt);
        const char* nA = has_next ? (const char*)g.A + (size_t)nxt.pm * tstep : cA; const char* nB = has_next ? (const char*)g.Bt + (size_t)nxt.pn * tstep : cB;
        for (int t = 0; t < nt; t += 2) {
            const bool last = (t == nt - 2);
            const char* a1 = cA + (size_t)(t + 1) * kstep;
            const char* a2 = last ? nA : cA + (size_t)(t + 2) * kstep; const char* b2 = last ? nB : cB + (size_t)(t + 2) * kstep;
            const char* a3 = a2 + kstep; const char* b3 = b2 + kstep;
            if (last && has_next) S.a_ready(nxt);
            if constexpr (SP2) {
            PG8_LDB(B0, 0, 0); PG8_LDB(B1, 0, 1); PG8_SCHED; PG8_LDA(At, 0, 0); PG8_STAGE(PG8_SA(1, 1), a1 + hstep, voffA);
            PG8_WAIT_V(8); PG8_WAIT_L(0); PG8_BAR; PG8_MMA(0, 0, At, B0); PG8_MMA(0, 1, At, B1); PG8_BAR; PG8_SCHED;
            PG8_LDA(At, 0, 1); PG8_STAGE(PG8_SB(0, 0), b2, voffB); PG8_STAGE(PG8_SB(0, 1), b2 + hstep, voffB); PG8_STAGE(PG8_SA(0, 0), a2, voffA);
            PG8_WAIT_V(8); PG8_WAIT_L(0); PG8_BAR; PG8_MMA(1, 0, At, B0); PG8_MMA(1, 1, At, B1); PG8_BAR; PG8_SCHED;
            PG8_LDB(B0, 1, 0); PG8_LDB(B1, 1, 1); PG8_SCHED; PG8_LDA(At, 1, 0); PG8_STAGE(PG8_SA(0, 1), a2 + hstep, voffA);
            PG8_WAIT_V(8); PG8_WAIT_L(0); PG8_BAR; PG8_MMA(0, 0, At, B0); PG8_MMA(0, 1, At, B1); PG8_BAR; PG8_SCHED;
            PG8_LDA(At, 1, 1); PG8_STAGE(PG8_SB(1, 0), b3, voffB); PG8_STAGE(PG8_SB(1, 1), b3 + hstep, voffB); PG8_STAGE(PG8_SA(1, 0), a3, voffA);
            PG8_WAIT_V(8); PG8_WAIT_L(0); PG8_BAR; PG8_MMA(1, 0, At, B0); PG8_MMA(1, 1, At, B1); PG8_BAR; PG8_SCHED;
            } else {
            PG8_LDB(B0, 0, 0); PG8_SCHED; PG8_LDA(At, 0, 0); PG8_STAGE(PG8_SA(1, 1), a1 + hstep, voffA);
            PG8_WAIT_L(8); PG8_BAR; PG8_WAIT_L(0); PG8_MMA(0, 0, At, B0); PG8_BAR; PG8_SCHED;
            PG8_LDB(B1, 0, 1); PG8_STAGE(PG8_SB(0, 0), b2, voffB);
            PG8_BAR; PG8_WAIT_L(0); PG8_MMA(0, 1, At, B1); PG8_BAR;
            PG8_LDA(At, 0, 1); PG8_STAGE(PG8_SA(0, 0), a2, voffA);
            PG8_BAR; PG8_WAIT_L(0); PG8_MMA(1, 0, At, B0); PG8_BAR; PG8_SCHED;
            PG8_STAGE(PG8_SB(0, 1), b2 + hstep, voffB);
            PG8_WAIT_V(6); PG8_BAR; PG8_MMA(1, 1, At, B1); PG8_BAR;
            PG8_LDB(B0, 1, 0); PG8_SCHED; PG8_LDA(At, 1, 0); PG8_STAGE(PG8_SA(0, 1), a2 + hstep, voffA);
            PG8_WAIT_L(8); PG8_BAR; PG8_WAIT_L(0); PG8_MMA(0, 0, At, B0); PG8_BAR; PG8_SCHED;
            PG8_LDB(B1, 1, 1); PG8_STAGE(PG8_SB(1, 0), b3, voffB);
            PG8_BAR; PG8_WAIT_L(0); PG8_MMA(0, 1, At, B1); PG8_BAR;
            PG8_LDA(At, 1, 1); PG8_STAGE(PG8_SA(1, 0), a3, voffA);
            PG8_BAR; PG8_WAIT_L(0); PG8_MMA(1, 0, At, B0); PG8_BAR; PG8_SCHED;
            PG8_STAGE(PG8_SB(1, 1), b3 + hstep, voffB);
            PG8_WAIT_V(6); PG8_BAR; PG8_MMA(1, 1, At, B1); PG8_BAR;
            }
        }
        if constexpr (ALIGN_EPI) { if (wr == 0) PG8_BAR; }
        if constexpr (!Epi::AFTER_DRAIN) { E(acc, cur, wr, wc, fr, fq); S.done(cur); }
        if (!has_next) break;
#pragma unroll
        for (int a = 0; a < 2; ++a)
#pragma unroll
            for (int b = 0; b < 2; ++b)
#pragma unroll
                for (int m = 0; m < 4; ++m)
#pragma unroll
                    for (int n = 0; n < 2; ++n) acc[a][b][m][n] = (f32x4){0.f, 0.f, 0.f, 0.f};
        cur = nxt; cA = nA; cB = nB; ++ui;
        if constexpr (ALIGN_EPI) { if (wr == 1) PG8_BAR; }
    }
    PG8_WAIT_V(0);
    if constexpr (!ALIGN_EPI) { if (wr == 0) PG8_BAR; }
    PG8_BAR;
    if constexpr (Epi::AFTER_DRAIN) { E.fused(acc, cur, wr, wc, fr, fq, lds, wid, lane); S.done(cur); }
#undef PG8_SA
#undef PG8_SB
#undef PG8_STAGE
#undef PG8_LDA
#undef PG8_LDB
#undef PG8_MMA
#undef PG8_WAIT_V
#undef PG8_WAIT_L
#undef PG8_BAR
#undef PG8_SCHED
}
}

namespace pg8 {
typedef unsigned u32x2 __attribute__((ext_vector_type(2)));
struct EpiSplit {
    static constexpr bool PERM = true, AFTER_DRAIN = false;
    bf16_t* O0; int ld0; bf16_t* O1; int ld1; int split_col;
    __device__ __forceinline__ void operator()(const f32x4 (&acc)[2][2][4][2], const Unit& u, int wr, int wc, int fr, int fq) const {
        const int row0 = u.pm * BM + wr * 64 + fr; int colt = u.pn * BM; bf16_t* base = O0; int ldc = ld0;
        if (colt >= split_col) { base = O1; ldc = ld1; colt -= split_col; }
        const int col0 = colt + wc * 32 + 8 * fq;
#pragma unroll
        for (int ai = 0; ai < 2; ++ai)
#pragma unroll
            for (int m = 0; m < 4; ++m) { bf16_t* rowp = base + (size_t)(row0 + ai * HALF + m * 16) * ldc + col0;
#pragma unroll
                for (int bj = 0; bj < 2; ++bj) { const f32x4 v0 = acc[ai][bj][m][0], v1 = acc[ai][bj][m][1];
                    u32x4 w; w.x = cvt_pk_bf16(v0[0], v0[1]); w.y = cvt_pk_bf16(v0[2], v0[3]); w.z = cvt_pk_bf16(v1[0], v1[1]); w.w = cvt_pk_bf16(v1[2], v1[3]);
                    *(u32x4*)(rowp + bj * HALF) = w; } }
    }
};
struct EpiSwiGLU {
    static constexpr bool PERM = true, AFTER_DRAIN = false;
    bf16_t* O;
    __device__ __forceinline__ void operator()(const f32x4 (&acc)[2][2][4][2], const Unit& u, int wr, int wc, int fr, int fq) const {
        const int row0 = u.pm * BM + wr * 64 + fr; const int j0 = (u.pn & 3) * 128 + wc * 16 + 4 * fq;
#pragma unroll
        for (int ai = 0; ai < 2; ++ai)
#pragma unroll
            for (int m = 0; m < 4; ++m) { bf16_t* rowp = O + (size_t)(row0 + ai * HALF + m * 16) * 512 + j0;
#pragma unroll
                for (int bj = 0; bj < 2; ++bj) { const f32x4 g = acc[ai][bj][m][0], up = acc[ai][bj][m][1]; float h[4];
#pragma unroll
                    for (int q = 0; q < 4; ++q) h[q] = g[q] / (1.f + __expf(-g[q])) * up[q];
                    u32x2 w; w.x = cvt_pk_bf16(h[0], h[1]); w.y = cvt_pk_bf16(h[2], h[3]);
                    *(u32x2*)(rowp + bj * 64) = w; } }
    }
};
struct EpiRowScale {
    static constexpr bool PERM = true, AFTER_DRAIN = false;
    bf16_t* O; const float* ws;
    __device__ __forceinline__ void operator()(const f32x4 (&acc)[2][2][4][2], const Unit& u, int wr, int wc, int fr, int fq) const {
        const int row0 = u.pm * BM + wr * 64 + fr; const int col0 = (u.pn & 3) * BM + wc * 32 + 8 * fq;
#pragma unroll
        for (int ai = 0; ai < 2; ++ai)
#pragma unroll
            for (int m = 0; m < 4; ++m) { const int row = row0 + ai * HALF + m * 16; const float s = ws[row]; bf16_t* rowp = O + (size_t)row * 1024 + col0;
#pragma unroll
                for (int bj = 0; bj < 2; ++bj) { const f32x4 v0 = acc[ai][bj][m][0] * s, v1 = acc[ai][bj][m][1] * s;
                    u32x4 w; w.x = cvt_pk_bf16(v0[0], v0[1]); w.y = cvt_pk_bf16(v0[2], v0[3]); w.z = cvt_pk_bf16(v1[0], v1[1]); w.w = cvt_pk_bf16(v1[2], v1[3]);
                    *(u32x4*)(rowp + bj * HALF) = w; } }
    }
};
struct MoeOrder {
    int G, c, nt; int toff[16];
    __device__ __forceinline__ void init(const int* cnt, int G_, int c_) { G = G_; c = c_; int s = 0;
#pragma unroll
        for (int e = 0; e < 16; ++e) { toff[e] = s; s += (cnt[e] + 255) >> 8; } nt = s; }
    __device__ __forceinline__ bool next(int i, Unit& u) const {
        const int Lq = i * G + c; if (Lq >= nt * 4) return false;
        const int pm = Lq % nt, pn4 = Lq / nt; int e = 0;
#pragma unroll
        for (int q = 1; q < 16; ++q) e += (pm >= toff[q]) ? 1 : 0;
        u.pm = pm; u.pn = e * 4 + pn4; return true; }
    __device__ __forceinline__ void a_ready(const Unit&) const {}
    __device__ __forceinline__ void done(const Unit&) const {}
};
}

constexpr int NB = 2, L = 8192, D = 1024, CTX = 256, RB = L + CTX;
constexpr int RL = NB * L, RCX = NB * CTX, R = RL + RCX;
constexpr int GW = 64;
constexpr int NCH = 66;
constexpr int ABIN = 3584, GIN = 3104, GINP = 3328;
constexpr int NE = 16, NG = 4, EPG = 4, EH = 512;
constexpr int MOE_ROWS = 37888;
constexpr float ALPHA = 1.4142135623730951f, LN_EPS = 1e-5f, KSCALE = 0.08838834764831845f;
constexpr int NT = 512;
constexpr int LDS_BYTES = 147456;

typedef unsigned short bf16_t;
#define LAS __attribute__((address_space(3)))
__device__ __forceinline__ float bf2f(bf16_t v) { return __uint_as_float((unsigned)v << 16); }
__device__ __forceinline__ bf16_t f2bf(float f) { unsigned u = __float_as_uint(f); return (bf16_t)((u + 0x7fffu + ((u >> 16) & 1u)) >> 16); }
__device__ __forceinline__ float siluf(float x) { return x / (1.f + expf(-x)); }
__device__ __forceinline__ float sigmf(float x) { return 1.f / (1.f + expf(-x)); }
__device__ __forceinline__ float logsigf(float x) { return fminf(x, 0.f) - log1pf(expf(-fabsf(x))); }

struct P {
    const float* in[34];
    float* out;
    float* Xc;
    float* MOD;
    float* NORM;
    int* CNT;
    float* A1; float* A2;
    float* RS; int* RE; int* RPOS; float* RWt; float* WS;
    bf16_t *Win0, *Wout0, *Win1, *Wout1, *Wgu, *Wd;
    bf16_t* H;
    bf16_t* Zr;
    bf16_t* Zh;
    bf16_t* hyT;
    float* FILT;
    bf16_t *Hs, *he, *slots;
    bf16_t* Z1;
    float* BG;
    bf16_t* GST;
};

__device__ __forceinline__ int launder_i(int x) { asm volatile("" : "+v"(x)); return x; }
#define TIDX launder_i((int)threadIdx.x)
#define GSTRIDE(i, n) for (long i = (long)blockIdx.x * blockDim.x + TIDX; i < (long)(n); i += (long)gridDim.x * blockDim.x)

__device__ __forceinline__ float* xrow(const P& p, int r) { return r < RL ? p.out + (size_t)r * D : p.Xc + (size_t)(r - RL) * D; }
__device__ __forceinline__ int seg_of(int r) { return r < RL ? r / L : 2; }
__device__ __forceinline__ const float* modv(const P& p, int l, int r, int chunk) { return p.MOD + ((size_t)(l * 3 + seg_of(r)) * 6 + chunk) * D; }
__device__ __forceinline__ int chunk_row0(int b, int c) { return c < 2 ? RL + b * CTX + c * 128 : b * L + (c - 2) * 128; }
__device__ __forceinline__ void row_bt(int r, int& b, int& tl) { if (r < RL) { b = r / L; tl = r % L; } else { b = (r - RL) / CTX; tl = L + (r - RL) % CTX; } }
__device__ __forceinline__ int bt_row(int b, int tl) { return tl < L ? b * L + tl : RL + b * CTX + (tl - L); }

__device__ void ph_wconv(bf16_t* dst, const float* src, int N, int K, int ldsrc, int nvalid) {
    GSTRIDE(idx, (long)N * K) { const int k = idx % K, n = idx / K; dst[idx] = n < nvalid ? f2bf(src[(size_t)k * ldsrc + n]) : (bf16_t)0; }
}
__device__ void ph_wconv_moe(const P& p, int l) {
    GSTRIDE(idx, (long)NE * 1024 * 1024) {
        const int k = idx % 1024, n = (idx / 1024) % 1024, e = idx / (1024 * 1024);
        const int q = n >> 3, r = n & 7, j = 4 * q + (r & 3);
        const float* src = (r < 4 ? p.in[31] : p.in[32]) + ((size_t)(l * NE + e) * D + k) * EH + j;
        p.Wgu[idx] = f2bf(*src);
    }
    GSTRIDE(idx, (long)NE * 1024 * 512) {
        const int k = idx % 512, n = (idx / 512) % 1024, e = idx / (512 * 1024);
        p.Wd[idx] = f2bf(p.in[33][((size_t)(l * NE + e) * EH + k) * D + n]);
    }
}
__device__ void ph_ada(const P& p) {
    GSTRIDE(idx, 2 * 3 * 6144) {
        const int n = idx % 6144, j = (idx / 6144) % 3, l = idx / (3 * 6144);
        const float* cv = j < 2 ? p.in[1] + j * D : p.in[3];
        const float* w = p.in[4] + (size_t)l * D * 6144;
        float acc = p.in[5][l * 6144 + n];
        for (int k = 0; k < D; ++k) acc += siluf(cv[k]) * w[(size_t)k * 6144 + n];
        p.MOD[idx] = acc;
    }
}
__device__ void ph_init(const P& p) {
    GSTRIDE(i, (long)RL * D) p.out[i] = p.in[0][i];
    GSTRIDE(i, (long)RCX * D) p.Xc[i] = p.in[2][i];
}
__device__ __forceinline__ void hy_pos(int pidx, int& len, int& i) { if (pidx < L) { len = L; i = pidx; } else { len = CTX; i = pidx - L; } }
__device__ void ph_hyA1(const P& p) {
    GSTRIDE(idx, (long)RB * 64) {
        const int j = idx % 64, pidx = idx / 64; int len, i; hy_pos(pidx, len, i);
        const float t = (float)i / (float)(len - 1);
        const float w = 2.0f * 3.14159265358979323846f * (float)i / (float)len;
        const float* w1 = p.in[13];
        float acc = p.in[14][j] + t * w1[j];
        for (int m = 0; m < 16; ++m) {
            const float f = 1e-4f + (float)m * ((15.f - 1e-4f) / 15.f);
            acc += cosf(f * w) * w1[(1 + m) * 64 + j] - sinf(f * w) * w1[(17 + m) * 64 + j];
        }
        p.A1[idx] = sinf(p.in[20][j] * acc);
    }
}
__device__ void ph_hyA(const float* src, float* dst, const float* w, const float* bias, const float* freq) {
    GSTRIDE(idx, (long)RB * 64) {
        const int j = idx % 64, pidx = idx / 64;
        float acc = bias[j];
        for (int i = 0; i < 64; ++i) acc += src[(size_t)pidx * 64 + i] * w[i * 64 + j];
        dst[idx] = sinf(freq[j] * acc);
    }
}
__device__ void ph_hyF(const P& p, const float* a3) {
    const float mind = logf(1e-2f) / 1.5f, maxd = logf(1e-2f) / 0.3f;
    GSTRIDE(idx, (long)2048 * RB) {
        const int pidx = idx % RB, col = idx / RB, ch = col % 512; int len, i; hy_pos(pidx, len, i);
        const float t = (float)i / (float)(len - 1);
        float acc = 0.f;
        for (int m = 0; m < 64; ++m) acc += a3[(size_t)pidx * 64 + m] * p.in[19][m * 2048 + col];
        const float delta = fabsf(mind + (float)ch * ((maxd - mind) / 511.f));
        p.FILT[idx] = acc * expf(-t * delta);
    }
}
__device__ void ph_hyNorm(const P& p) {
    GSTRIDE(idx, (long)2048 * (RB / 64)) {
        const int pb = idx % (RB / 64), col = idx / (RB / 64);
        float s = 0.f;
        for (int q = 0; q < 64; ++q) { const float v = p.FILT[(size_t)col * RB + pb * 64 + q]; s += v * v; }
        atomicAdd(&p.NORM[(pb * 64 < L ? 0 : 1) * 2048 + col], s);
    }
}
__device__ void ph_mod(const P& p, int l, int which) {
    GSTRIDE(i, (long)R * D) {
        const int r = i / D, k = i % D;
        p.H[i] = f2bf(xrow(p, r)[k] * (1.f + modv(p, l, r, which * 3 + 1)[k]) + modv(p, l, r, which * 3 + 0)[k]);
    }
}
__device__ void ph_prep_rope(const P& p) {
    GSTRIDE(i, (long)R * 2 * 4 * 64) {
        const int pr = i % 64, h = (i / 64) % 4, w = (i / 256) % 2, r = i / 512;
        bf16_t* base = p.Zr + (size_t)r * 2048 + w * 512 + h * 128;
        float t1 = bf2f(base[pr]), t2 = bf2f(base[64 + pr]);
        if (w == 1) { t1 *= KSCALE; t2 *= KSCALE; }
        if (r < RL) {
            const int t = r % L, row = t / GW, col = t % GW;
            const float inv = powf(10000.f, -(float)(pr & 31) / 32.f);
            const float ang = (pr < 32 ? (float)row : (float)col) * inv;
            float sn, cs; sincosf(ang, &sn, &cs);
            const float a = t1 * cs - t2 * sn, bb = t1 * sn + t2 * cs; t1 = a; t2 = bb;
        }
        base[pr] = f2bf(t1); base[64 + pr] = f2bf(t2);
    }
}
__device__ void ph_prep_hy(const P& p) {
    GSTRIDE(idx, (long)NB * 1536 * RB) {
        const int tl = idx % RB, col = (idx / RB) % 1536, b = idx / (RB * 1536);
        const int s0 = tl < L ? 0 : L, s1 = tl < L ? L : RB;
        const float* w = p.in[11];
        float acc = p.in[12][col] + w[1536 + col] * bf2f(p.Zh[(size_t)bt_row(b, tl) * 1536 + col]);
        if (tl - 1 >= s0) acc += w[col] * bf2f(p.Zh[(size_t)bt_row(b, tl - 1) * 1536 + col]);
        if (tl + 1 < s1) acc += w[2 * 1536 + col] * bf2f(p.Zh[(size_t)bt_row(b, tl + 1) * 1536 + col]);
        p.hyT[idx] = f2bf(acc);
    }
}
__device__ __forceinline__ float hy_tapT(const float* Ff, const float* Fb, float nf, float nb, int d) {
    if (d > 0) return Ff[d] * nf; if (d < 0) return Fb[-d] * nb; return Ff[0] * nf + Fb[0] * nb;
}
__device__ void ph_hyconv_naive(const P& p, int n, float* conv) {
    GSTRIDE(idx, (long)NB * 512 * (RB / 4)) {
        const int tb = idx % (RB / 4), ch = (idx / (RB / 4)) % 512, b = idx / ((RB / 4) * 512);
        const int tl0 = tb * 4, s0 = tl0 < L ? 0 : L, len = tl0 < L ? L : CTX, nrm = tl0 < L ? 0 : 1, t0 = tl0 - s0;
        const int cf = (n * 2 + 0) * 512 + ch, cb = (n * 2 + 1) * 512 + ch;
        const float nf = 1.f / sqrtf(p.NORM[nrm * 2048 + cf]), nb = 1.f / sqrtf(p.NORM[nrm * 2048 + cb]);
        const float* Ff = p.FILT + (size_t)cf * RB + s0; const float* Fb = p.FILT + (size_t)cb * RB + s0;
        const bf16_t* z = p.hyT + ((size_t)(b * 3 + 2) * 512 + ch) * RB + s0;
        float w0 = hy_tapT(Ff, Fb, nf, nb, t0), w1 = hy_tapT(Ff, Fb, nf, nb, t0 + 1), w2 = hy_tapT(Ff, Fb, nf, nb, t0 + 2), w3 = hy_tapT(Ff, Fb, nf, nb, t0 + 3);
        float a0 = 0.f, a1 = 0.f, a2 = 0.f, a3 = 0.f;
        for (int s = 0; s < len; ++s) {
            const float zz = bf2f(z[s]);
            a0 += w0 * zz; a1 += w1 * zz; a2 += w2 * zz; a3 += w3 * zz;
            w3 = w2; w2 = w1; w1 = w0;
            if (s + 1 < len) w0 = hy_tapT(Ff, Fb, nf, nb, t0 - (s + 1));
        }
        float* o = conv + ((size_t)b * 512 + ch) * RB + tl0; o[0] = a0; o[1] = a1; o[2] = a2; o[3] = a3;
    }
}
__device__ void ph_hygate_naive(const P& p, int n, const float* conv) {
    bf16_t* yhT = p.Zh + (size_t)2 * NB * 4 * NCH * 16384;
    GSTRIDE(idx, (long)NB * 512 * RB) {
        const int tl = idx % RB, ch = (idx / RB) % 512, b = idx / (RB * 512);
        bf16_t* z = p.hyT + ((size_t)(b * 3 + 2) * 512 + ch) * RB + tl; const float gate = bf2f(p.hyT[((size_t)(b * 3 + n) * 512 + ch) * RB + tl]);
        const float r = gate * (conv[idx] + p.in[21][n * 512 + ch] * bf2f(*z));
        if (n == 0) *z = f2bf(r); else yhT[idx] = f2bf(r);
    }
}
__device__ void ph_hy_untranspose(const P& p) {
    const bf16_t* yhT = p.Zh + (size_t)2 * NB * 4 * NCH * 16384;
    GSTRIDE(idx, (long)R * 512) { const int ch = idx % 512, r = idx / 512; int b, tl; row_bt(r, b, tl); p.H[(size_t)r * D + 512 + ch] = yhT[((size_t)b * 512 + ch) * RB + tl]; }
}
__device__ __forceinline__ size_t st_idx(int dir, int b, int h, int c) { return ((((size_t)dir * NB + b) * 4 + h) * NCH + c) * 16384; }
__device__ void ph_retU_naive(const P& p) {
    bf16_t* ST = p.Zh;
    GSTRIDE(idx, (long)NB * 4 * NCH * 16384) {
        const int d = idx % 128, e = (idx / 128) % 128, c = (idx / 16384) % NCH, h = (idx / (16384 * NCH)) % 4, b = idx / (16384 * NCH * 4);
        const float lgf = p.in[9][h], lgb = p.in[10][h]; const int r0 = chunk_row0(b, c);
        float uf = 0.f, ub = 0.f;
        for (int j = 0; j < 128; ++j) {
            const float kk = bf2f(p.Zr[(size_t)(r0 + j) * 2048 + 512 + h * 128 + d]), vv = bf2f(p.Zr[(size_t)(r0 + j) * 2048 + 1024 + h * 128 + e]);
            uf += kk * expf(lgf * (float)(127 - j)) * vv; ub += kk * expf(lgb * (float)j) * vv;
        }
        ST[st_idx(0, b, h, c) + e * 128 + d] = f2bf(uf); ST[st_idx(1, b, h, c) + e * 128 + d] = f2bf(ub);
    }
}
__device__ void ph_retScan(const P& p) {
    bf16_t* ST = p.Zh;
    GSTRIDE(idx, (long)2 * NB * 4 * 16384) {
        const int ed = idx % 16384, h = (idx / 16384) % 4, b = (idx / 65536) % NB, dir = idx / (65536 * NB);
        const float dc = expf(p.in[dir ? 10 : 9][h] * 128.f);
        float s = 0.f;
        for (int cc = 0; cc < NCH; ++cc) {
            const int c = dir == 0 ? cc : (cc < 2 ? 1 - cc : NCH + 1 - cc);
            bf16_t* q = ST + st_idx(dir, b, h, c) + ed; const float u = bf2f(*q); *q = f2bf(s); s = dc * s + u;
        }
    }
}
__device__ void ph_retO_naive(const P& p, float* lds) {
    const bf16_t* ST = p.Zh;
    for (int u = blockIdx.x; u < NB * 4 * NCH; u += gridDim.x) {
        const int c = u % NCH, h = (u / NCH) % 4, b = u / (NCH * 4); const int r0 = chunk_row0(b, c);
        const float lgf = p.in[9][h], lgb = p.in[10][h];
        __syncthreads();
        for (int e = TIDX; e < 128 * 128; e += NT) {
            const int j = e % 128, i = e / 128;
            const bf16_t* q = p.Zr + (size_t)(r0 + i) * 2048 + h * 128; const bf16_t* k = p.Zr + (size_t)(r0 + j) * 2048 + 512 + h * 128;
            float s = 0.f; for (int d = 0; d < 128; ++d) s += bf2f(q[d]) * bf2f(k[d]);
            const float m = i > j ? expf(lgf * (float)(i - j)) : (j > i ? expf(lgb * (float)(j - i)) : 2.f);
            lds[e] = s * m;
        }
        __syncthreads();
        const bf16_t* sf = ST + st_idx(0, b, h, c); const bf16_t* sb = ST + st_idx(1, b, h, c);
        for (int e2 = TIDX; e2 < 128 * 128; e2 += NT) {
            const int e = e2 % 128, i = e2 / 128;
            float o = 0.f; for (int j = 0; j < 128; ++j) o += lds[i * 128 + j] * bf2f(p.Zr[(size_t)(r0 + j) * 2048 + 1024 + h * 128 + e]);
            const bf16_t* q = p.Zr + (size_t)(r0 + i) * 2048 + h * 128;
            float of = 0.f, ob = 0.f; for (int d = 0; d < 128; ++d) { const float qq = bf2f(q[d]); of += qq * bf2f(sf[e * 128 + d]); ob += qq * bf2f(sb[e * 128 + d]); }
            p.H[(size_t)(r0 + i) * D + h * 128 + e] = f2bf(o + expf(lgf * (float)(i + 1)) * of + expf(lgb * (float)(128 - i)) * ob);
        }
    }
}
__device__ void ph_retNorm_naive(const P& p) {
    GSTRIDE(idx, (long)R * 4) {
        const int h = idx % 4, r = idx / 4; bf16_t* o = p.H + (size_t)r * D + h * 128;
        float mu = 0.f; for (int e = 0; e < 128; ++e) mu += bf2f(o[e]); mu *= (1.f / 128.f);
        float var = 0.f; for (int e = 0; e < 128; ++e) { const float d = bf2f(o[e]) - mu; var += d * d; } var *= (1.f / 128.f);
        const float rs = 1.f / sqrtf(var + LN_EPS);
        for (int e = 0; e < 128; ++e) o[e] = f2bf((bf2f(o[e]) - mu) * rs * siluf(bf2f(p.Zr[(size_t)r * 2048 + 1536 + h * 128 + e])));
    }
}
__device__ __forceinline__ float block_sum(float v, float* red) {
    __syncthreads();
#pragma unroll
    for (int o = 32; o > 0; o >>= 1) v += __shfl_xor(v, o);
    if ((TIDX & 63) == 0) red[TIDX >> 6] = v;
    __syncthreads();
    float t = 0.f;
#pragma unroll
    for (int w = 0; w < NT / 64; ++w) t += red[w];
    return t;
}
template <int MODE> __device__ void ph_post(const P& p, int l, int which, const bf16_t* Y, int ln, int wn, int nrows, float* red) {
    const float* lg = p.in[6] + (size_t)(l * 2 + which) * D; const float* lb = p.in[7] + (size_t)(l * 2 + which) * D;
    int toff[16];
    if (MODE == 1) { int s = 0;
#pragma unroll
        for (int e = 0; e < 16; ++e) { toff[e] = s; s += (p.CNT[l * 16 + e] + 255) >> 8; } }
    for (int r = blockIdx.x; r < nrows; r += gridDim.x) {
        float* x = xrow(p, r); const float* gate = modv(p, l, r, which * 3 + 2);
        const bf16_t *y0, *y1 = nullptr;
        if (MODE == 0) y0 = Y + (size_t)r * D;
        else {
            int sr[2];
#pragma unroll
            for (int k = 0; k < 2; ++k) { const int e = p.RE[r * 2 + k]; int to = 0;
#pragma unroll
                for (int q = 0; q < 16; ++q) to = (q == e) ? toff[q] : to;
                sr[k] = to * 256 + p.RPOS[r * 2 + k]; }
            y0 = p.slots + (size_t)sr[0] * D; y1 = p.slots + (size_t)sr[1] * D;
        }
        float v[2]; float s = 0.f;
#pragma unroll
        for (int i = 0; i < 2; ++i) { const int k = TIDX + i * NT; float yy = bf2f(y0[k]); if (MODE == 1) yy += bf2f(y1[k]); v[i] = ALPHA * x[k] + gate[k] * yy; s += v[i]; }
        const float mu = block_sum(s, red) * (1.f / D);
        float q = 0.f;
#pragma unroll
        for (int i = 0; i < 2; ++i) { const float d = v[i] - mu; q += d * d; }
        const float rs = 1.f / sqrtf(block_sum(q, red) * (1.f / D) + LN_EPS);
#pragma unroll
        for (int i = 0; i < 2; ++i) { const int k = TIDX + i * NT; const float xn = (v[i] - mu) * rs * lg[k] + lb[k]; x[k] = xn;
            if (ln >= 0) p.H[(size_t)r * D + k] = f2bf(xn * (1.f + modv(p, ln, r, wn * 3 + 1)[k]) + modv(p, ln, r, wn * 3 + 0)[k]); }
    }
}
__device__ void ph_route1(const P& p, int l, int nrows) {
    GSTRIDE(idx, (long)nrows * NE) {
        const int e = idx % NE, r = idx / NE; const float* x = xrow(p, r); const float* sc = modv(p, l, r, 4); const float* sh = modv(p, l, r, 3);
        float acc = 0.f;
        for (int k = 0; k < D; ++k) acc += (x[k] * (1.f + sc[k]) + sh[k]) * p.in[29][k * NE + e];
        p.RS[idx] = sigmf(acc);
    }
}
__device__ void ph_route2(const P& p, int l, int nrows) {
    GSTRIDE(r, nrows) {
        const float* s = p.RS + (size_t)r * NE; const float* rb = p.in[30];
        int best = 0; float bs = -1e30f;
        for (int g = 0; g < NG; ++g) {
            float m1 = -1e30f, m2 = -1e30f;
            for (int q = 0; q < EPG; ++q) { const float v = s[g * EPG + q] + rb[g * EPG + q]; if (v > m1) { m2 = m1; m1 = v; } else if (v > m2) m2 = v; }
            if (m1 + m2 > bs) { bs = m1 + m2; best = g; }
        }
        int i1 = 0; float v1 = -1e30f;
        for (int q = 0; q < EPG; ++q) { const float v = s[best * EPG + q] + rb[best * EPG + q]; if (v > v1) { v1 = v; i1 = q; } }
        int i2 = 0; float v2 = -1e30f;
        for (int q = 0; q < EPG; ++q) { if (q == i1) continue; const float v = s[best * EPG + q] + rb[best * EPG + q]; if (v > v2) { v2 = v; i2 = q; } }
        const int e1 = best * EPG + i1, e2 = best * EPG + i2; const float a = s[e1], c = s[e2];
        p.RE[r * 2] = e1; p.RE[r * 2 + 1] = e2; p.RWt[r * 2] = a / (a + c); p.RWt[r * 2 + 1] = c / (a + c);
        p.RPOS[r * 2] = atomicAdd(&p.CNT[l * 16 + e1], 1); p.RPOS[r * 2 + 1] = atomicAdd(&p.CNT[l * 16 + e2], 1);
    }
}
__device__ void ph_permute(const P& p, int l, int nrows) {
    int toff[16]; { int s = 0;
#pragma unroll
        for (int e = 0; e < 16; ++e) { toff[e] = s; s += (p.CNT[l * 16 + e] + 255) >> 8; } }
    GSTRIDE(idx, (long)nrows * 2 * 128) {
        const int ck = idx % 128, k = (idx / 128) % 2, r = idx / 256; const int e = p.RE[r * 2 + k]; int to = 0;
#pragma unroll
        for (int q = 0; q < 16; ++q) to = (q == e) ? toff[q] : to;
        const int sr = to * 256 + p.RPOS[r * 2 + k];
        ((uint4*)(p.Hs + (size_t)sr * D))[ck] = ((const uint4*)(p.H + (size_t)r * D))[ck];
        if (ck == 0) p.WS[sr] = p.RWt[r * 2 + k];
    }
}
__device__ void ph_glagate(const P& p) {
    GSTRIDE(idx, (long)2 * R * 512) {
        const int ch = idx % 512, r = (idx / 512) % R, dir = idx / (512 * R);
        const float* gw = p.in[dir ? 26 : 24]; const float* gb = p.in[dir ? 27 : 25];
        float acc = gb[ch];
        for (int q = 0; q < 16; ++q) acc += bf2f(p.Z1[(size_t)r * GINP + 3072 + dir * 16 + q]) * gw[q * 512 + ch];
        p.BG[idx] = logsigf(acc) * (1.f / 16.f);
    }
}
__device__ void ph_glacum(const P& p) {
    GSTRIDE(idx, (long)2 * NB * NCH * 512) {
        const int ch = idx % 512, c = (idx / 512) % NCH, b = (idx / (512 * NCH)) % NB, dir = idx / (512 * NCH * NB);
        float* a = p.BG + ((size_t)dir * R + chunk_row0(b, c)) * 512 + ch;
        float s = 0.f;
        if (dir == 0) for (int i = 0; i < 128; ++i) { s += a[(size_t)i * 512]; a[(size_t)i * 512] = s; }
        else for (int i = 127; i >= 0; --i) { s += a[(size_t)i * 512]; a[(size_t)i * 512] = s; }
    }
}
__device__ __forceinline__ size_t gst_idx(int dir, int b, int h, int c) { return ((((size_t)dir * NB + b) * 4 + h) * NCH + c) * 32768; }
__device__ void ph_glaU_naive(const P& p) {
    const float* BF = p.BG; const float* BB = p.BG + (size_t)R * 512;
    GSTRIDE(idx, (long)NB * 4 * NCH * 32768) {
        const int d = idx % 128, e = (idx / 128) % 256, c = (idx / 32768) % NCH, h = (idx / (32768 * NCH)) % 4, b = idx / (32768 * NCH * 4);
        const int r0 = chunk_row0(b, c);
        const float bfe = BF[(size_t)(r0 + 127) * 512 + h * 128 + d], bbe = BB[(size_t)r0 * 512 + h * 128 + d];
        float uf = 0.f, ub = 0.f;
        for (int j = 0; j < 128; ++j) {
            const float kk = bf2f(p.Z1[(size_t)(r0 + j) * GINP + 512 + h * 128 + d]), vv = bf2f(p.Z1[(size_t)(r0 + j) * GINP + 1024 + h * 256 + e]);
            uf += kk * expf(bfe - BF[(size_t)(r0 + j) * 512 + h * 128 + d]) * vv; ub += kk * expf(bbe - BB[(size_t)(r0 + j) * 512 + h * 128 + d]) * vv;
        }
        p.GST[gst_idx(0, b, h, c) + e * 128 + d] = f2bf(uf); p.GST[gst_idx(1, b, h, c) + e * 128 + d] = f2bf(ub);
    }
}
__device__ void ph_glaScan(const P& p) {
    const float* BF = p.BG; const float* BB = p.BG + (size_t)R * 512;
    GSTRIDE(idx, (long)2 * NB * 4 * 32768) {
        const int d = idx % 128, ed = idx % 32768, h = (idx / 32768) % 4, b = (idx / 131072) % NB, dir = idx / (131072 * NB);
        float s = 0.f;
        for (int cc = 0; cc < NCH; ++cc) {
            const int c = dir == 0 ? cc : (cc < 2 ? 1 - cc : NCH + 1 - cc); const int r0 = chunk_row0(b, c);
            const float dc = dir == 0 ? expf(BF[(size_t)(r0 + 127) * 512 + h * 128 + d]) : expf(BB[(size_t)r0 * 512 + h * 128 + d]);
            bf16_t* q = p.GST + gst_idx(dir, b, h, c) + ed; const float u = bf2f(*q); *q = f2bf(s); s = dc * s + u;
        }
    }
}
__device__ void ph_glaO_naive(const P& p, float* lds) {
    const float* BF = p.BG; const float* BB = p.BG + (size_t)R * 512;
    for (int u = blockIdx.x; u < NB * 4 * 64; u += gridDim.x) {
        const int c = 2 + u % 64, h = (u / 64) % 4, b = u / 256; const int r0 = chunk_row0(b, c);
        __syncthreads();
        for (int e = TIDX; e < 128 * 128; e += NT) {
            const int j = e % 128, i = e / 128;
            const bf16_t* q = p.Z1 + (size_t)(r0 + i) * GINP + h * 128; const bf16_t* k = p.Z1 + (size_t)(r0 + j) * GINP + 512 + h * 128;
            float s = 0.f;
            if (i >= j) { const float* bi = BF + (size_t)(r0 + i) * 512 + h * 128; const float* bj = BF + (size_t)(r0 + j) * 512 + h * 128;
                for (int d = 0; d < 128; ++d) s += bf2f(q[d]) * bf2f(k[d]) * expf(bi[d] - bj[d]); }
            if (i <= j) { const float* bi = BB + (size_t)(r0 + i) * 512 + h * 128; const float* bj = BB + (size_t)(r0 + j) * 512 + h * 128;
                for (int d = 0; d < 128; ++d) s += bf2f(q[d]) * bf2f(k[d]) * expf(bi[d] - bj[d]); }
            lds[e] = s * KSCALE;
        }
        __syncthreads();
        const bf16_t* sf = p.GST + gst_idx(0, b, h, c); const bf16_t* sb = p.GST + gst_idx(1, b, h, c);
        for (int e2 = TIDX; e2 < 128 * 256; e2 += NT) {
            const int e = e2 % 256, i = e2 / 256;
            float o = 0.f; for (int j = 0; j < 128; ++j) o += lds[i * 128 + j] * bf2f(p.Z1[(size_t)(r0 + j) * GINP + 1024 + h * 256 + e]);
            const bf16_t* q = p.Z1 + (size_t)(r0 + i) * GINP + h * 128; const float* bi = BF + (size_t)(r0 + i) * 512 + h * 128; const float* bbi = BB + (size_t)(r0 + i) * 512 + h * 128;
            float a = 0.f; for (int d = 0; d < 128; ++d) a += bf2f(q[d]) * (expf(bi[d]) * bf2f(sf[e * 128 + d]) + expf(bbi[d]) * bf2f(sb[e * 128 + d]));
            p.H[(size_t)(r0 + i) * D + h * 256 + e] = f2bf(o + a * KSCALE);
        }
    }
}
__device__ void ph_glaNorm_naive(const P& p) {
    GSTRIDE(idx, (long)RL * 4) {
        const int h = idx % 4, r = idx / 4; bf16_t* o = p.H + (size_t)r * D + h * 256;
        float ss = 0.f; for (int e = 0; e < 256; ++e) { const float v = bf2f(o[e]); ss += v * v; }
        const float rs = 1.f / sqrtf(ss * (1.f / 256.f) + LN_EPS);
        for (int e = 0; e < 256; ++e) o[e] = f2bf(bf2f(o[e]) * rs * siluf(bf2f(p.Z1[(size_t)r * GINP + 2048 + h * 256 + e])));
    }
}

#define FD __device__ __forceinline__
#define TIE(a, b) asm volatile("" : "+v"(a) : "v"(b))
#define HWCOS(x) __builtin_amdgcn_cosf(x)
#define HWSIN(x) __builtin_amdgcn_sinf(x)
struct cf { float x, y; };
FD cf cadd(cf a, cf b) { return {a.x + b.x, a.y + b.y}; }
FD cf csub(cf a, cf b) { return {a.x - b.x, a.y - b.y}; }
FD cf cmul(cf a, cf b) { return {a.x * b.x - a.y * b.y, a.x * b.y + a.y * b.x}; }
#define C32(k) ((k)==0?1.0f:(k)==1?0.98078528040323043f:(k)==2?0.92387953251128674f:(k)==3?0.83146961230254524f:(k)==4?0.70710678118654752f:(k)==5?0.55557023301960222f:(k)==6?0.38268343236508977f:(k)==7?0.19509032201612825f:(k)==8?0.0f:(k)==9?-0.19509032201612825f:(k)==10?-0.38268343236508977f:(k)==11?-0.55557023301960222f:(k)==12?-0.70710678118654752f:(k)==13?-0.83146961230254524f:(k)==14?-0.92387953251128674f:-0.98078528040323043f)
#define S32(k) ((k)==0?0.0f:(k)==1?0.19509032201612825f:(k)==2?0.38268343236508977f:(k)==3?0.55557023301960222f:(k)==4?0.70710678118654752f:(k)==5?0.83146961230254524f:(k)==6?0.92387953251128674f:(k)==7?0.98078528040323043f:(k)==8?1.0f:(k)==9?0.98078528040323043f:(k)==10?0.92387953251128674f:(k)==11?0.83146961230254524f:(k)==12?0.70710678118654752f:(k)==13?0.55557023301960222f:(k)==14?0.38268343236508977f:0.19509032201612825f)
template <int N, int LEN, bool INV> FD void dit_level(cf (&x)[N]) {
#pragma unroll
    for (int blk = 0; blk < N; blk += LEN)
#pragma unroll
        for (int j = 0; j < LEN / 2; ++j) {
            const int k = j * (32 / LEN);
            const cf a = x[blk + j], b0 = x[blk + j + LEN / 2];
            const cf b = k == 0 ? b0 : (k == 8 ? (INV ? cf{-b0.y, b0.x} : cf{b0.y, -b0.x}) : cmul(b0, cf{C32(k), INV ? S32(k) : -S32(k)}));
            x[blk + j] = cadd(a, b); x[blk + j + LEN / 2] = csub(a, b);
        }
}
template <int N, bool INV> FD void dit_reg(cf (&x)[N]) {
    dit_level<N, 2, INV>(x); dit_level<N, 4, INV>(x);
    if constexpr (N >= 8) dit_level<N, 8, INV>(x);
    if constexpr (N >= 16) dit_level<N, 16, INV>(x);
}
template <int N, int LEN, bool INV> FD void dif_level(cf (&x)[N]) {
#pragma unroll
    for (int blk = 0; blk < N; blk += LEN)
#pragma unroll
        for (int j = 0; j < LEN / 2; ++j) {
            const int k = j * (32 / LEN);
            const cf a = x[blk + j], b = x[blk + j + LEN / 2];
            x[blk + j] = cadd(a, b); const cf d = csub(a, b);
            x[blk + j + LEN / 2] = k == 0 ? d : (k == 8 ? (INV ? cf{-d.y, d.x} : cf{d.y, -d.x}) : cmul(d, cf{C32(k), INV ? S32(k) : -S32(k)}));
        }
}
template <int N, bool INV> FD void dif_reg(cf (&x)[N]) {
    if constexpr (N >= 16) dif_level<N, 16, INV>(x);
    if constexpr (N >= 8) dif_level<N, 8, INV>(x);
    dif_level<N, 4, INV>(x); dif_level<N, 2, INV>(x);
}
constexpr int FFT_N = 16384, FFT_LDS_CF = 17920;
FD int brev4(int i) { return ((i & 1) << 3) | ((i & 2) << 1) | ((i & 4) >> 1) | ((i & 8) >> 3); }
FD int physA(int m, int a) { return 4480 * a + m + (m >> 4) + 16 * (m >> 9); }
FD int physB(int b, int a, int m) { return 4480 * b + 272 * a + 16 * (a >> 1) + m + (m >> 4); }
FD int physC(int b, int a, int m) { return 272 * b + 16 * (b >> 1) + 17 * a + m; }
FD int physD(int g, int j) { return 17 * g + 16 * (g >> 5) + j; }
template <int RR, int RM> FD void twiddle(cf (&x)[RR], int m, float sgn) {
#pragma unroll
    for (int s = 1; s < RR; ++s) { const float fr = (float)((m * s) & (RM - 1)) * (1.0f / (float)RM); x[s] = cmul(x[s], cf{HWCOS(fr), sgn * HWSIN(fr)}); }
}
FD void stA_fwd(int m, cf v0, cf v1, cf v2, cf v3, cf* buf) {
    cf x[4] = {v0, v2, v1, v3};
    dit_reg<4, false>(x); twiddle<4, 16384>(x, m, -1.f);
#pragma unroll
    for (int s = 0; s < 4; ++s) buf[physA(m, s)] = x[s];
}
FD void stB_fwd(int idx, cf* buf) {
    const int b = idx >> 8, m = idx & 255; cf x[16];
#pragma unroll
    for (int i = 0; i < 16; ++i) x[i] = buf[physB(b, brev4(i), m)];
    dit_reg<16, false>(x); twiddle<16, 4096>(x, m, -1.f);
#pragma unroll
    for (int s = 0; s < 16; ++s) buf[physB(b, s, m)] = x[s];
}
FD void stC_fwd(int idx, cf* buf) {
    const int b = idx >> 4, m = idx & 15; cf x[16];
#pragma unroll
    for (int i = 0; i < 16; ++i) x[i] = buf[physC(b, brev4(i), m)];
    dit_reg<16, false>(x); twiddle<16, 256>(x, m, -1.f);
#pragma unroll
    for (int s = 0; s < 16; ++s) buf[physC(b, s, m)] = x[s];
}
FD void stD_fwd_regs(int g, const cf* buf, cf (&x)[16]) {
#pragma unroll
    for (int i = 0; i < 16; ++i) x[i] = buf[physD(g, brev4(i))];
    dit_reg<16, false>(x);
}
FD void stD_mul(int g, cf* buf, const cf (&h)[16]) {
    cf x[16];
#pragma unroll
    for (int i = 0; i < 16; ++i) x[i] = buf[physD(g, brev4(i))];
    dit_reg<16, false>(x);
#pragma unroll
    for (int s = 0; s < 16; ++s) x[s] = cmul(x[s], h[s]);
    dif_reg<16, true>(x);
#pragma unroll
    for (int i = 0; i < 16; ++i) buf[physD(g, brev4(i))] = x[i];
}
FD void stC_inv(int idx, cf* buf) {
    const int b = idx >> 4, m = idx & 15; cf x[16];
#pragma unroll
    for (int s = 0; s < 16; ++s) x[s] = buf[physC(b, s, m)];
    twiddle<16, 256>(x, m, 1.f); dif_reg<16, true>(x);
#pragma unroll
    for (int i = 0; i < 16; ++i) buf[physC(b, brev4(i), m)] = x[i];
}
FD void stB_inv(int idx, cf* buf) {
    const int b = idx >> 8, m = idx & 255; cf x[16];
#pragma unroll
    for (int s = 0; s < 16; ++s) x[s] = buf[physB(b, s, m)];
    twiddle<16, 4096>(x, m, 1.f); dif_reg<16, true>(x);
#pragma unroll
    for (int i = 0; i < 16; ++i) buf[physB(b, brev4(i), m)] = x[i];
}
FD void stA_inv(int m, const cf* buf, cf& r0, cf& r1) {
    cf x[4];
#pragma unroll
    for (int s = 0; s < 4; ++s) x[s] = buf[physA(m, s)];
    twiddle<4, 16384>(x, m, 1.f); dif_reg<4, true>(x);
    r0 = x[0]; r1 = x[2];
}

#undef FD
__device__ void ph_hyena_fft(const P& p, unsigned char* smem) {
    cf* buf = (cf*)smem; float* fb = (float*)smem;
    const int t = TIDX;
    bf16_t* yhT = p.Zh + (size_t)2 * NB * 4 * NCH * 16384;
    for (int ch = blockIdx.x; ch < 512; ch += gridDim.x) {
        const bf16_t* hy0 = p.hyT + ((size_t)0 * 512 + ch) * RB;
        const size_t bstr = (size_t)3 * 512 * RB, jstr = (size_t)512 * RB;
        cf* Hg = (cf*)p.H + (size_t)blockIdx.x * 16384;
        bf16_t* zs0 = p.hyT + ((size_t)2 * 512 + ch) * RB;
#pragma unroll 1
        for (int n = 0; n < 2; ++n) {
            const int cfi = (n * 2) * 512 + ch, cbi = (n * 2 + 1) * 512 + ch;
            const float nf = 1.f / sqrtf(p.NORM[cfi]), nb = 1.f / sqrtf(p.NORM[cbi]);
            const float* Ff = p.FILT + (size_t)cfi * RB; const float* Fb = p.FILT + (size_t)cbi * RB;
#pragma unroll 2
            for (int j = 0; j < 8; ++j) { const int m = launder_i(t) + 512 * j;
                float v0 = Ff[m] * nf; if (m == 0) v0 += Fb[0] * nb;
                const float v1 = Ff[4096 + m] * nf, v2 = (m == 0) ? 0.f : Fb[8192 - (m == 0 ? 1 : m)] * nb, v3 = Fb[4096 - m] * nb;
                stA_fwd(m, cf{v0, 0.f}, cf{v1, 0.f}, cf{v2, 0.f}, cf{v3, 0.f}, buf); }
            __syncthreads();
#pragma unroll 1
            for (int q = 0; q < 2; ++q) stB_fwd(launder_i(t) + 512 * q, buf);
            __syncthreads();
#pragma unroll 1
            for (int q = 0; q < 2; ++q) stC_fwd(launder_i(t) + 512 * q, buf);
            __syncthreads();
#pragma unroll 1
            for (int q = 0; q < 2; ++q) { const int g = launder_i(t) + 512 * q; cf hh[16]; stD_fwd_regs(g, buf, hh);
#pragma unroll
                for (int s = 0; s < 16; ++s) Hg[s * 1024 + g] = hh[s]; }
            __syncthreads();
#pragma unroll 2
            for (int j = 0; j < 8; ++j) { const int m = launder_i(t) + 512 * j;
                stA_fwd(m, cf{bf2f(zs0[m]), bf2f(zs0[bstr + m])}, cf{bf2f(zs0[4096 + m]), bf2f(zs0[bstr + 4096 + m])}, cf{0.f, 0.f}, cf{0.f, 0.f}, buf); }
            __syncthreads();
#pragma unroll 1
            for (int q = 0; q < 2; ++q) stB_fwd(launder_i(t) + 512 * q, buf);
            __syncthreads();
#pragma unroll 1
            for (int q = 0; q < 2; ++q) stC_fwd(launder_i(t) + 512 * q, buf);
            __syncthreads();
#pragma unroll 1
            for (int q = 0; q < 2; ++q) { const int g = launder_i(t) + 512 * q; cf hh[16];
#pragma unroll
                for (int s = 0; s < 16; ++s) hh[s] = Hg[s * 1024 + g];
                stD_mul(g, buf, hh); }
            __syncthreads();
#pragma unroll 1
            for (int q = 0; q < 2; ++q) stC_inv(launder_i(t) + 512 * q, buf);
            __syncthreads();
#pragma unroll 1
            for (int q = 0; q < 2; ++q) stB_inv(launder_i(t) + 512 * q, buf);
            __syncthreads();
            const float sk = p.in[21][n * 512 + ch];
#pragma unroll 2
            for (int j = 0; j < 8; ++j) { const int m = launder_i(t) + 512 * j; cf r0, r1; stA_inv(m, buf, r0, r1);
#pragma unroll
                for (int hlf = 0; hlf < 2; ++hlf) { const int d = m + 4096 * hlf; const cf r = hlf ? r1 : r0;
                    const float g0 = bf2f(hy0[n * jstr + d]), g1 = bf2f(hy0[bstr + n * jstr + d]);
                    const float o0 = g0 * (r.x * (1.f / 16384.f) + sk * bf2f(zs0[d])), o1 = g1 * (r.y * (1.f / 16384.f) + sk * bf2f(zs0[bstr + d]));
                    if (n == 0) { zs0[d] = f2bf(o0); zs0[bstr + d] = f2bf(o1); }
                    else { yhT[((size_t)0 * 512 + ch) * RB + d] = f2bf(o0); yhT[((size_t)1 * 512 + ch) * RB + d] = f2bf(o1); } } }
            __syncthreads();
        }
        {
            float* tap = fb;
            float* zc = fb + 1024;
            const int b = t >> 8, tt = t & 255;
#pragma unroll
            for (int n = 0; n < 2; ++n) {
                const int cfi = (n * 2) * 512 + ch, cbi = (n * 2 + 1) * 512 + ch;
                const float nf = 1.f / sqrtf(p.NORM[2048 + cfi]), nb = 1.f / sqrtf(p.NORM[2048 + cbi]);
                const float* Ff = p.FILT + (size_t)cfi * RB + L; const float* Fb = p.FILT + (size_t)cbi * RB + L;
                if (t < 511) { const int d = t - 255; tap[n * 512 + t] = d > 0 ? Ff[d] * nf : (d < 0 ? Fb[-d] * nb : Ff[0] * nf + Fb[0] * nb); }
            }
            const bf16_t* hb_ = hy0 + (size_t)b * bstr + L + tt;
            const float z1 = bf2f(hb_[2 * jstr]);
            zc[b * 256 + tt] = z1;
            __syncthreads();
            float c1 = 0.f;
            for (int s = 0; s < 256; ++s) c1 += tap[tt - s + 255] * zc[b * 256 + s];
            const float z2 = bf2f(hb_[0]) * (c1 + p.in[21][ch] * z1);
            __syncthreads();
            zc[b * 256 + tt] = z2;
            __syncthreads();
            float c2 = 0.f;
            for (int s = 0; s < 256; ++s) c2 += tap[512 + tt - s + 255] * zc[b * 256 + s];
            yhT[((size_t)b * 512 + ch) * RB + L + tt] = f2bf(bf2f(hb_[jstr]) * (c2 + p.in[21][512 + ch] * z2));
            __syncthreads();
        }
    }
}

constexpr int N_STEPS = 34;
#define PG8_ALIGN true
#define PG8_SP2 true
template <class Epi> __device__ __forceinline__ void dense_gemm(LAS unsigned char* lds, const bf16_t* A, const bf16_t* Bt, int M, int N, int K, const Epi& E) {
    pg8::Gemm g{A, Bt, M, N, K}; pg8::StaticOrder S; S.init(M, N, (int)gridDim.x, (int)blockIdx.x);
    pg8::gemm_phase<Epi, pg8::StaticOrder, PG8_ALIGN, PG8_SP2>(lds, g, S, E);
}
__device__ __forceinline__ void moe_gemms(const P& p, LAS unsigned char* lds, int l, int which) {
    pg8::MoeOrder S; S.init(p.CNT + l * 16, (int)gridDim.x, (int)blockIdx.x);
    if (which == 0) { pg8::Gemm g{p.Hs, p.Wgu, 0, 0, 1024}; pg8::EpiSwiGLU E{p.he}; pg8::gemm_phase<pg8::EpiSwiGLU, pg8::MoeOrder, PG8_ALIGN, PG8_SP2>(lds, g, S, E); }
    else { pg8::Gemm g{p.he, p.Wd, 0, 0, 512}; pg8::EpiRowScale E{p.slots, p.WS}; pg8::gemm_phase<pg8::EpiRowScale, pg8::MoeOrder, PG8_ALIGN, PG8_SP2>(lds, g, S, E); }
}
__device__ __forceinline__ void run_step(const P& p, int step, unsigned char* smem) {
    LAS unsigned char* lds = (LAS unsigned char*)smem; float* fl = (float*)smem;
    float* conv = (float*)p.H;
    switch (step) {
        case 0: ph_ada(p); ph_init(p); ph_wconv(p.Win0, p.in[8], ABIN, D, ABIN, ABIN); ph_wconv(p.Wout0, p.in[22], D, D, D, D);
                ph_wconv(p.Win1, p.in[23], GINP, D, GIN, GIN); ph_wconv(p.Wout1, p.in[28], D, D, D, D); ph_wconv_moe(p, 0); ph_hyA1(p); break;
        case 1: ph_mod(p, 0, 0); ph_hyA(p.A1, p.A2, p.in[15], p.in[16], p.in[20] + 64); break;
        case 2: { pg8::EpiSplit E{p.Zr, 2048, p.Zh, 1536, 2048}; dense_gemm(lds, p.H, p.Win0, R, ABIN, D, E); }
                ph_hyA(p.A2, p.A1, p.in[17], p.in[18], p.in[20] + 128); break;
        case 3: ph_prep_rope(p); ph_prep_hy(p); ph_hyF(p, p.A1); break;
        case 4: ph_hyNorm(p); ph_retU_naive(p); break;
        case 5: ph_retScan(p); ph_hyena_fft(p, smem); break;
        case 6: break;
        case 7: break;
        case 8: break;
        case 9: ph_retO_naive(p, fl); break;
        case 10: ph_retNorm_naive(p); ph_hy_untranspose(p); break;
        case 11: { pg8::EpiSplit E{p.Zr, 1024, p.Zr, 1024, 1 << 30}; dense_gemm(lds, p.H, p.Wout0, R, D, D, E); } break;
        case 12: ph_post<0>(p, 0, 0, p.Zr, 0, 1, R, fl); break;
        case 13: ph_route1(p, 0, R); break;
        case 14: ph_route2(p, 0, R); break;
        case 15: ph_permute(p, 0, R); break;
        case 16: moe_gemms(p, lds, 0, 0); break;
        case 17: moe_gemms(p, lds, 0, 1); break;
        case 18: ph_post<1>(p, 0, 1, nullptr, 1, 0, R, fl); break;
        case 19: { pg8::EpiSplit E{p.Z1, GINP, p.Z1, GINP, 1 << 30}; dense_gemm(lds, p.H, p.Win1, R, GINP, D, E); } ph_wconv_moe(p, 1); break;
        case 20: ph_glagate(p); break;
        case 21: ph_glacum(p); break;
        case 22: ph_glaU_naive(p); break;
        case 23: ph_glaScan(p); break;
        case 24: ph_glaO_naive(p, fl); break;
        case 25: ph_glaNorm_naive(p); break;
        case 26: { pg8::EpiSplit E{p.Zr, 1024, p.Zr, 1024, 1 << 30}; dense_gemm(lds, p.H, p.Wout1, RL, D, D, E); } break;
        case 27: ph_post<0>(p, 1, 0, p.Zr, 1, 1, RL, fl); break;
        case 28: ph_route1(p, 1, RL); break;
        case 29: ph_route2(p, 1, RL); break;
        case 30: ph_permute(p, 1, RL); break;
        case 31: moe_gemms(p, lds, 1, 0); break;
        case 32: moe_gemms(p, lds, 1, 1); break;
        case 33: ph_post<1>(p, 1, 1, nullptr, -1, 0, RL, fl); break;
    }
}
__global__ void __launch_bounds__(NT, 2) k_all(P p) {
    extern __shared__ __attribute__((aligned(16))) unsigned char smem[];
    cg::grid_group grid = cg::this_grid();
#define STEP(n) run_step(p, n, smem); grid.sync();
    STEP(0) STEP(1) STEP(2) STEP(3) STEP(4) STEP(5) STEP(9) STEP(10) STEP(11) STEP(12) STEP(13) STEP(14) STEP(15) STEP(16)
    STEP(17) STEP(18) STEP(19) STEP(20) STEP(21) STEP(22) STEP(23) STEP(24) STEP(25) STEP(26) STEP(27) STEP(28) STEP(29) STEP(30) STEP(31) STEP(32) STEP(33)
#undef STEP
}

extern "C" void kernel_launch(void* const* d_in, const int* in_sizes, int n_in, void* d_out, int out_size, void* d_ws, size_t ws_size, hipStream_t stream) {
    P p{};
    for (int i = 0; i < 34; ++i) p.in[i] = (const float*)d_in[i];
    p.out = (float*)d_out;
    unsigned char* w = (unsigned char*)d_ws; size_t off = 0;
    auto take = [&](size_t bytes) { unsigned char* r = w + off; off += (bytes + 255) & ~(size_t)255; return r; };
    p.NORM = (float*)take(2 * 2048 * 4); p.CNT = (int*)take(2 * 16 * 4);
    const size_t ctl_bytes = off;
    p.Win1 = (bf16_t*)take((size_t)GINP * D * 2); p.Wout1 = (bf16_t*)take((size_t)D * D * 2);
    p.Wgu = (bf16_t*)take((size_t)NE * 1024 * 1024 * 2); p.Wd = (bf16_t*)take((size_t)NE * 1024 * 512 * 2);
    p.Xc = (float*)take((size_t)RCX * D * 4); p.MOD = (float*)take(2 * 3 * 6144 * 4);
    p.RS = (float*)take((size_t)R * NE * 4); p.RE = (int*)take((size_t)R * 2 * 4); p.RPOS = (int*)take((size_t)R * 2 * 4); p.RWt = (float*)take((size_t)R * 2 * 4);
    p.WS = (float*)take((size_t)MOE_ROWS * 4);
    const size_t big = off;
    p.H = (bf16_t*)take((size_t)R * D * 2);
    p.Zr = (bf16_t*)take((size_t)R * 2048 * 2);
    p.Zh = (bf16_t*)take((size_t)R * 1536 * 2);
    p.hyT = (bf16_t*)take((size_t)NB * 3 * 512 * RB * 2);
    p.FILT = (float*)take((size_t)2048 * RB * 4);
    p.Win0 = (bf16_t*)take((size_t)ABIN * D * 2); p.Wout0 = (bf16_t*)take((size_t)D * D * 2);
    p.A1 = (float*)take((size_t)RB * 64 * 4); p.A2 = (float*)take((size_t)RB * 64 * 4);
    const size_t total = off;
    off = big + (((size_t)R * D * 2 + 255) & ~(size_t)255);
    p.Hs = (bf16_t*)take((size_t)MOE_ROWS * D * 2); p.he = (bf16_t*)take((size_t)MOE_ROWS * EH * 2); p.slots = (bf16_t*)take((size_t)MOE_ROWS * D * 2);
    const size_t moe_end = off;
    off = big + (((size_t)R * D * 2 + 255) & ~(size_t)255);
    p.Z1 = (bf16_t*)take((size_t)R * GINP * 2); p.BG = (float*)take((size_t)2 * R * 512 * 4); p.GST = (bf16_t*)take((size_t)2 * NB * 4 * NCH * 32768 * 2);
    const size_t l1_end = off;
    if (total > ws_size || moe_end > total || l1_end > total || n_in != 34 || out_size != RL * D) {
        fprintf(stderr, "kernel_launch: bad sizes (need %zu ws bytes, have %zu; moe_end %zu l1_end %zu)\n", total, ws_size, moe_end, l1_end); return; }
    static int grid = 0;
    if (!grid) {
        int dev = 0, cus = 0, per = 0; hipGetDevice(&dev); hipDeviceGetAttribute(&cus, hipDeviceAttributeMultiprocessorCount, dev);
        hipFuncSetAttribute((const void*)k_all, hipFuncAttributeMaxDynamicSharedMemorySize, LDS_BYTES);
        hipOccupancyMaxActiveBlocksPerMultiprocessor(&per, k_all, NT, LDS_BYTES);
        if (per < 1) { fprintf(stderr, "kernel_launch: occupancy query says %d blocks per CU\n", per); per = 1; }
        grid = cus;
    }
    hipMemsetAsync(d_ws, 0, ctl_bytes, stream);
    void* args[] = {&p};
    hipError_t e = hipLaunchCooperativeKernel((void*)k_all, dim3(grid), dim3(NT), args, LDS_BYTES, stream);
    if (e != hipSuccess) fprintf(stderr, "coop launch failed: %s (grid %d)\n", hipGetErrorString(e), grid);
}
```

```cpp
#include <hip/hip_runtime.h>
#include <hip/hip_cooperative_groups.h>
#include <cstdio>
#include <cstdint>
namespace cg = cooperative_groups;


namespace pg8 {
#define PG8_LAS __attribute__((address_space(3)))
typedef unsigned short bf16_t;
typedef short bf16x8 __attribute__((ext_vector_type(8)));
typedef float f32x4 __attribute__((ext_vector_type(4)));
typedef unsigned u32x4 __attribute__((ext_vector_type(4)));
constexpr int BM = 256, BK = 64, HALF = 128, HTB = HALF * BK * 2  , STAGE_BYTES = 8 * HTB, NXCD = 8, WGM = 8;

__host__ __device__ __forceinline__ int lds_byte(int r, int c) { const int st = (r >> 4) * 2 + (c >> 5), rr = r & 15, cc = c & 31, ob = rr * 64 + cc * 2; return st * 1024 + (ob ^ (((ob >> 9) & 1) << 5)); }
__host__ __device__ __forceinline__ void stage_rc(int b, int& R, int& C) { const int st = b / 1024, sb = b % 1024, swz = sb ^ (((sb >> 9) & 1) << 5); R = (st >> 1) * 16 + swz / 64; C = (st & 1) * 32 + (swz % 64) / 2; }
__host__ __device__ __forceinline__ int perm32(int rho) { const int n = rho >> 4, i = rho & 15; return 8 * (i >> 2) + 4 * n + (i & 3); }

struct Unit { int pm, pn; };
struct Gemm { const bf16_t* A; const bf16_t* Bt; int M, N, K; };

struct StaticOrder {
    int nM, nN, nwg, G, c;
    __host__ __device__ void init(int M, int N, int G_, int c_) { nM = M / BM; nN = N / BM; nwg = nM * nN; G = G_; c = c_; }
    __host__ __device__ bool next(int i, Unit& u) const {
        const long L = (long)i * G + c; if (L >= nwg) return false;
        int wgid = (int)L; { const int q = nwg / NXCD, r = nwg % NXCD, xcd = wgid % NXCD, off = wgid / NXCD; wgid = (xcd < r ? xcd * (q + 1) : r * (q + 1) + (xcd - r) * q) + off; }
        const int nig = WGM * nN, gid = wgid / nig, fm = gid * WGM, gsz = (nM - fm) < WGM ? (nM - fm) : WGM;
        u.pm = fm + ((wgid % nig) % gsz); u.pn = (wgid % nig) / gsz; return true;
    }
    __device__ __forceinline__ void a_ready(const Unit&) const {}
    __device__ __forceinline__ void done(const Unit&) const {}
};


__device__ __forceinline__ unsigned cvt_pk_bf16(float lo, float hi) { unsigned r; asm volatile("v_cvt_pk_bf16_f32 %0, %1, %2" : "=v"(r) : "v"(lo), "v"(hi)); return r; }

template <class Epi, class Sched, bool ALIGN_EPI = false, bool SP2 = false>
__device__ __forceinline__ void gemm_phase(PG8_LAS unsigned char* lds, const Gemm g, const Sched& S, const Epi& E) {
    int tid_l = threadIdx.x; asm volatile("" : "+v"(tid_l)); const int tid = tid_l, wid = __builtin_amdgcn_readfirstlane(tid >> 6), lane = tid & 63, wr = wid >> 2, wc = wid & 3, fr = lane & 15, fq = lane >> 4;
    const int K = g.K, nt = K / BK;
    unsigned voffA[2], voffB[2];
#pragma unroll
    for (int i = 0; i < 2; ++i) { int R, C; stage_rc(tid * 16 + i * 8192, R, C); const int Rb = Epi::PERM ? ((R & ~31) + perm32(R & 31)) : R;
        voffA[i] = (unsigned)(R * K + C) * 2u; voffB[i] = (unsigned)(Rb * K + C) * 2u; }
    const size_t kstep = (size_t)(BK * 2);
    const size_t hstep = (size_t)HALF * K * 2;
    const size_t tstep = 2 * hstep;
    const unsigned ldsw = (unsigned)wid * 1024u;
    const int aoff = lds_byte(wr * 64 + fr, fq * 8), boff = lds_byte(wc * 32 + fr, fq * 8);
#define PG8_SA(b, h) (((b) * 2 + (h)) * HTB)
#define PG8_SB(b, h) ((4 + (b) * 2 + (h)) * HTB)
#define PG8_STAGE(bufoff, gbase, voff) do { _Pragma("unroll") for (int _i = 0; _i < 2; ++_i) \
        __builtin_amdgcn_global_load_lds((const unsigned*)((const char*)(gbase) + (voff)[_i]), (PG8_LAS unsigned*)(lds + (bufoff) + ldsw + _i * 8192), 16, 0, 0); } while (0)
#define PG8_LDA(dst, b, h) do { _Pragma("unroll") for (int m = 0; m < 4; ++m) _Pragma("unroll") for (int k = 0; k < 2; ++k) dst[m][k] = *(const PG8_LAS bf16x8*)(lds + PG8_SA(b, h) + aoff + m * 2048 + k * 1024); } while (0)
#define PG8_LDB(dst, b, h) do { _Pragma("unroll") for (int n = 0; n < 2; ++n) _Pragma("unroll") for (int k = 0; k < 2; ++k) dst[n][k] = *(const PG8_LAS bf16x8*)(lds + PG8_SB(b, h) + boff + n * 2048 + k * 1024); } while (0)
#define PG8_MMA(ai, bj, At, Bt) do { __builtin_amdgcn_s_setprio(1); _Pragma("unroll") for (int m = 0; m < 4; ++m) _Pragma("unroll") for (int n = 0; n < 2; ++n) _Pragma("unroll") for (int k = 0; k < 2; ++k) \
        acc[ai][bj][m][n] = __builtin_amdgcn_mfma_f32_16x16x32_bf16(Bt[n][k], At[m][k], acc[ai][bj][m][n], 0, 0, 0); __builtin_amdgcn_s_setprio(0); } while (0)
#define PG8_WAIT_V(n) asm volatile("s_waitcnt vmcnt(" #n ")" ::: "memory")
#define PG8_WAIT_L(n) asm volatile("s_waitcnt lgkmcnt(" #n ")" ::: "memory")
#define PG8_BAR __builtin_amdgcn_s_barrier()
#define PG8_SCHED __builtin_amdgcn_sched_barrier(0)
    Unit cur, nxt; int ui = 0;
    if (!S.next(0, cur)) return;
    f32x4 acc[2][2][4][2];
#pragma unroll
    for (int a = 0; a < 2; ++a)
#pragma unroll
        for (int b = 0; b < 2; ++b)
#pragma unroll
            for (int m = 0; m < 4; ++m)
#pragma unroll
                for (int n = 0; n < 2; ++n) acc[a][b][m][n] = (f32x4){0.f, 0.f, 0.f, 0.f};
    bf16x8 At[4][2], B0[2][2], B1[2][2];
    const char* cA = (const char*)g.A + (size_t)cur.pm * tstep; const char* cB = (const char*)g.Bt + (size_t)cur.pn * tstep;
    S.a_ready(cur);
    if constexpr (SP2) {
        PG8_STAGE(PG8_SB(0, 0), cB, voffB); PG8_STAGE(PG8_SB(0, 1), cB + hstep, voffB); PG8_STAGE(PG8_SA(0, 0), cA, voffA); PG8_STAGE(PG8_SA(0, 1), cA + hstep, voffA);
        if (wr == 1) PG8_BAR;
        PG8_WAIT_V(2); PG8_BAR;
        PG8_STAGE(PG8_SB(1, 0), cB + kstep, voffB); PG8_STAGE(PG8_SA(1, 0), cA + kstep, voffA); PG8_STAGE(PG8_SB(1, 1), cB + hstep + kstep, voffB);
        PG8_WAIT_V(6); PG8_BAR;
    } else {
        PG8_STAGE(PG8_SB(0, 0), cB, voffB); PG8_STAGE(PG8_SA(0, 0), cA, voffA); PG8_STAGE(PG8_SB(0, 1), cB + hstep, voffB); PG8_STAGE(PG8_SA(0, 1), cA + hstep, voffA);
        if (wr == 1) PG8_BAR;
        PG8_WAIT_V(4); PG8_BAR;
        PG8_STAGE(PG8_SB(1, 0), cB + kstep, voffB); PG8_STAGE(PG8_SA(1, 0), cA + kstep, voffA); PG8_STAGE(PG8_SB(1, 1), cB + hstep + kstep, voffB);
        PG8_WAIT_V(6); PG8_BAR;
    }
    for (;;) {
        const bool has_next = S.next(ui + 1, nxt);
        const char* nA = has_next ? (const char*)g.A + (size_t)nxt.pm * tstep : cA; const char* nB = has_next ? (const char*)g.Bt + (size_t)nxt.pn * tstep : cB;
        for (int t = 0; t < nt; t += 2) {
            const bool last = (t == nt - 2);
            const char* a1 = cA + (size_t)(t + 1) * kstep;
            const char* a2 = last ? nA : cA + (size_t)(t + 2) * kstep; const char* b2 = last ? nB : cB + (size_t)(t + 2) * kstep;
            const char* a3 = a2 + kstep; const char* b3 = b2 + kstep;
            if (last && has_next) S.a_ready(nxt);
            if constexpr (SP2) {
            PG8_LDB(B0, 0, 0); PG8_LDB(B1, 0, 1); PG8_SCHED; PG8_LDA(At, 0, 0); PG8_STAGE(PG8_SA(1, 1), a1 + hstep, voffA);
            PG8_WAIT_V(8); PG8_WAIT_L(0); PG8_BAR; PG8_MMA(0, 0, At, B0); PG8_MMA(0, 1, At, B1); PG8_BAR; PG8_SCHED;
            PG8_LDA(At, 0, 1); PG8_STAGE(PG8_SB(0, 0), b2, voffB); PG8_STAGE(PG8_SB(0, 1), b2 + hstep, voffB); PG8_STAGE(PG8_SA(0, 0), a2, voffA);
            PG8_WAIT_V(8); PG8_WAIT_L(0); PG8_BAR; PG8_MMA(1, 0, At, B0); PG8_MMA(1, 1, At, B1); PG8_BAR; PG8_SCHED;
            PG8_LDB(B0, 1, 0); PG8_LDB(B1, 1, 1); PG8_SCHED; PG8_LDA(At, 1, 0); PG8_STAGE(PG8_SA(0, 1), a2 + hstep, voffA);
            PG8_WAIT_V(8); PG8_WAIT_L(0); PG8_BAR; PG8_MMA(0, 0, At, B0); PG8_MMA(0, 1, At, B1); PG8_BAR; PG8_SCHED;
            PG8_LDA(At, 1, 1); PG8_STAGE(PG8_SB(1, 0), b3, voffB); PG8_STAGE(PG8_SB(1, 1), b3 + hstep, voffB); PG8_STAGE(PG8_SA(1, 0), a3, voffA);
            PG8_WAIT_V(8); PG8_WAIT_L(0); PG8_BAR; PG8_MMA(1, 0, At, B0); PG8_MMA(1, 1, At, B1); PG8_BAR; PG8_SCHED;
            } else {
            PG8_LDB(B0, 0, 0); PG8_SCHED; PG8_LDA(At, 0, 0); PG8_STAGE(PG8_SA(1, 1), a1 + hstep, voffA);
            PG8_WAIT_L(8); PG8_BAR; PG8_WAIT_L(0); PG8_MMA(0, 0, At, B0); PG8_BAR; PG8_SCHED;
            PG8_LDB(B1, 0, 1); PG8_STAGE(PG8_SB(0, 0), b2, voffB);
            PG8_BAR; PG8_WAIT_L(0); PG8_MMA(0, 1, At, B1); PG8_BAR;
            PG8_LDA(At, 0, 1); PG8_STAGE(PG8_SA(0, 0), a2, voffA);
            PG8_BAR; PG8_WAIT_L(0); PG8_MMA(1, 0, At, B0); PG8_BAR; PG8_SCHED;
            PG8_STAGE(PG8_SB(0, 1), b2 + hstep, voffB);
            PG8_WAIT_V(6); PG8_BAR; PG8_MMA(1, 1, At, B1); PG8_BAR;
            PG8_LDB(B0, 1, 0); PG8_SCHED; PG8_LDA(At, 1, 0); PG8_STAGE(PG8_SA(0, 1), a2 + hstep, voffA);
            PG8_WAIT_L(8); PG8_BAR; PG8_WAIT_L(0); PG8_MMA(0, 0, At, B0); PG8_BAR; PG8_SCHED;
            PG8_LDB(B1, 1, 1); PG8_STAGE(PG8_SB(1, 0), b3, voffB);
            PG8_BAR; PG8_WAIT_L(0); PG8_MMA(0, 1, At, B1); PG8_BAR;
            PG8_LDA(At, 1, 1); PG8_STAGE(PG8_SA(1, 0), a3, voffA);
            PG8_BAR; PG8_WAIT_L(0); PG8_MMA(1, 0, At, B0); PG8_BAR; PG8_SCHED;
            PG8_STAGE(PG8_SB(1, 1), b3 + hstep, voffB);
            PG8_WAIT_V(6); PG8_BAR; PG8_MMA(1, 1, At, B1); PG8_BAR;
            }
        }
        if constexpr (ALIGN_EPI) { if (wr == 0) PG8_BAR; }
        if constexpr (!Epi::AFTER_DRAIN) { E(acc, cur, wr, wc, fr, fq); S.done(cur); }
        if (!has_next) break;
#pragma unroll
        for (int a = 0; a < 2; ++a)
#pragma unroll
            for (int b = 0; b < 2; ++b)
#pragma unroll
                for (int m = 0; m < 4; ++m)
#pragma unroll
                    for (int n = 0; n < 2; ++n) acc[a][b][m][n] = (f32x4){0.f, 0.f, 0.f, 0.f};
        cur = nxt; cA = nA; cB = nB; ++ui;
        if constexpr (ALIGN_EPI) { if (wr == 1) PG8_BAR; }
    }
    PG8_WAIT_V(0);
    if constexpr (!ALIGN_EPI) { if (wr == 0) PG8_BAR; }
    PG8_BAR;
    if constexpr (Epi::AFTER_DRAIN) { E.fused(acc, cur, wr, wc, fr, fq, lds, wid, lane); S.done(cur); }
#undef PG8_SA
#undef PG8_SB
#undef PG8_STAGE
#undef PG8_LDA
#undef PG8_LDB
#undef PG8_MMA
#undef PG8_WAIT_V
#undef PG8_WAIT_L
#undef PG8_BAR
#undef PG8_SCHED
}
}

typedef float f2v_t __attribute__((ext_vector_type(2)));
typedef __bf16 b2v_t __attribute__((ext_vector_type(2)));
__device__ __forceinline__ unsigned pk_bf16(float lo, float hi) { const f2v_t f = {lo, hi}; const b2v_t b = __builtin_convertvector(f, b2v_t); return __builtin_bit_cast(unsigned, b); }
namespace pg8 {
typedef unsigned u32x2 __attribute__((ext_vector_type(2)));
struct EpiSplit {
    static constexpr bool PERM = true, AFTER_DRAIN = false;
    bf16_t* O0; int ld0; bf16_t* O1; int ld1; int split_col;
    __device__ __forceinline__ void operator()(const f32x4 (&acc)[2][2][4][2], const Unit& u, int wr, int wc, int fr, int fq) const {
        const int row0 = u.pm * BM + wr * 64 + fr; int colt = u.pn * BM; bf16_t* base = O0; int ldc = ld0;
        if (colt >= split_col) { base = O1; ldc = ld1; colt -= split_col; }
        const int col0 = colt + wc * 32 + 8 * fq;
#pragma unroll
        for (int ai = 0; ai < 2; ++ai)
#pragma unroll
            for (int m = 0; m < 4; ++m) { bf16_t* rowp = base + (size_t)(row0 + ai * HALF + m * 16) * ldc + col0;
#pragma unroll
                for (int bj = 0; bj < 2; ++bj) { const f32x4 v0 = acc[ai][bj][m][0], v1 = acc[ai][bj][m][1];
                    u32x4 w; w.x = ::pk_bf16(v0[0], v0[1]); w.y = ::pk_bf16(v0[2], v0[3]); w.z = ::pk_bf16(v1[0], v1[1]); w.w = ::pk_bf16(v1[2], v1[3]);
                    *(u32x4*)(rowp + bj * HALF) = w; } }
    }
};
struct EpiSwiGLU {
    static constexpr bool PERM = true, AFTER_DRAIN = false;
    bf16_t* O;
    __device__ __forceinline__ void operator()(const f32x4 (&acc)[2][2][4][2], const Unit& u, int wr, int wc, int fr, int fq) const {
        const int row0 = u.pm * BM + wr * 64 + fr; const int j0 = (u.pn & 3) * 128 + wc * 16 + 4 * fq;
#pragma unroll
        for (int ai = 0; ai < 2; ++ai)
#pragma unroll
            for (int m = 0; m < 4; ++m) { bf16_t* rowp = O + (size_t)(row0 + ai * HALF + m * 16) * 512 + j0;
#pragma unroll
                for (int bj = 0; bj < 2; ++bj) { const f32x4 g = acc[ai][bj][m][0], up = acc[ai][bj][m][1]; float h[4];
#pragma unroll
                    for (int q = 0; q < 4; ++q) h[q] = g[q] / (1.f + __expf(-g[q])) * up[q];
                    u32x2 w; w.x = ::pk_bf16(h[0], h[1]); w.y = ::pk_bf16(h[2], h[3]);
                    *(u32x2*)(rowp + bj * 64) = w; } }
    }
};
struct EpiRowScale {
    static constexpr bool PERM = true, AFTER_DRAIN = false;
    bf16_t* O; const float* ws;
    __device__ __forceinline__ void operator()(const f32x4 (&acc)[2][2][4][2], const Unit& u, int wr, int wc, int fr, int fq) const {
        const int row0 = u.pm * BM + wr * 64 + fr; const int col0 = (u.pn & 3) * BM + wc * 32 + 8 * fq;
#pragma unroll
        for (int ai = 0; ai < 2; ++ai)
#pragma unroll
            for (int m = 0; m < 4; ++m) { const int row = row0 + ai * HALF + m * 16; const float s = ws[row]; bf16_t* rowp = O + (size_t)row * 1024 + col0;
#pragma unroll
                for (int bj = 0; bj < 2; ++bj) { const f32x4 v0 = acc[ai][bj][m][0] * s, v1 = acc[ai][bj][m][1] * s;
                    u32x4 w; w.x = ::pk_bf16(v0[0], v0[1]); w.y = ::pk_bf16(v0[2], v0[3]); w.z = ::pk_bf16(v1[0], v1[1]); w.w = ::pk_bf16(v1[2], v1[3]);
                    *(u32x4*)(rowp + bj * HALF) = w; } }
    }
};
struct MoeOrder {
    int G, c, nt; int toff[16];
    __device__ __forceinline__ void init(const int* cnt, int G_, int c_) { G = G_; c = c_; int s = 0;
#pragma unroll
        for (int e = 0; e < 16; ++e) { toff[e] = s; s += (cnt[e] + 255) >> 8; } nt = s; }
    __device__ __forceinline__ bool next(int i, Unit& u) const {
        const int Lq = i * G + c; if (Lq >= nt * 4) return false;
        const int pm = Lq % nt, pn4 = Lq / nt; int e = 0;
#pragma unroll
        for (int q = 1; q < 16; ++q) e += (pm >= toff[q]) ? 1 : 0;
        u.pm = pm; u.pn = e * 4 + pn4; return true; }
    __device__ __forceinline__ void a_ready(const Unit&) const {}
    __device__ __forceinline__ void done(const Unit&) const {}
};
}

constexpr int NB = 2, L = 8192, D = 1024, CTX = 256, RB = L + CTX;
constexpr int RL = NB * L, RCX = NB * CTX, R = RL + RCX;
constexpr int GW = 64;
constexpr int NCH = 66;
constexpr int ABIN = 3584, GIN = 3104, GINP = 3328;
constexpr int NE = 16, NG = 4, EPG = 4, EH = 512;
constexpr int MOE_ROWS = 37888;
constexpr float ALPHA = 1.4142135623730951f, LN_EPS = 1e-5f, KSCALE = 0.08838834764831845f;
constexpr int NT = 512;
constexpr int LDS_BYTES = 147456;

typedef unsigned short bf16_t;
#define LAS __attribute__((address_space(3)))
__device__ __forceinline__ float bf2f(bf16_t v) { return __uint_as_float((unsigned)v << 16); }
__device__ __forceinline__ bf16_t f2bf(float f) { unsigned u = __float_as_uint(f); return (bf16_t)((u + 0x7fffu + ((u >> 16) & 1u)) >> 16); }
__device__ __forceinline__ float siluf(float x) { return x / (1.f + expf(-x)); }
__device__ __forceinline__ float sigmf(float x) { return 1.f / (1.f + expf(-x)); }
__device__ __forceinline__ float logsigf(float x) { return fminf(x, 0.f) - log1pf(expf(-fabsf(x))); }

struct P {
    const float* in[34];
    float* out;
    float* Xc;
    float* MOD;
    float* NORM;
    int* CNT;
    float* A1; float* A2;
    float* RS; int* RE; int* RPOS; float* RWt; float* WS;
    bf16_t *Win0, *Wout0, *Win1, *Wout1, *Wgu, *Wd;
    bf16_t* H;
    bf16_t* Zr;
    bf16_t* Zh;
    bf16_t* hyT;
    float* FILT;
    bf16_t *Hs, *he, *slots;
    bf16_t* Z1;
    float* BG;
    bf16_t* GST;
};

__device__ __forceinline__ int launder_i(int x) { asm volatile("" : "+v"(x)); return x; }
#define TIDX launder_i((int)threadIdx.x)
#define GSTRIDE(i, n) for (long i = (long)blockIdx.x * blockDim.x + TIDX; i < (long)(n); i += (long)gridDim.x * blockDim.x)

__device__ __forceinline__ float* xrow(const P& p, int r) { return r < RL ? p.out + (size_t)r * D : p.Xc + (size_t)(r - RL) * D; }
__device__ __forceinline__ int seg_of(int r) { return r < RL ? r / L : 2; }
__device__ __forceinline__ const float* modv(const P& p, int l, int r, int chunk) { return p.MOD + ((size_t)(l * 3 + seg_of(r)) * 6 + chunk) * D; }
__device__ __forceinline__ int chunk_row0(int b, int c) { return c < 2 ? RL + b * CTX + c * 128 : b * L + (c - 2) * 128; }
__device__ __forceinline__ void row_bt(int r, int& b, int& tl) { if (r < RL) { b = r / L; tl = r % L; } else { b = (r - RL) / CTX; tl = L + (r - RL) % CTX; } }
__device__ __forceinline__ int bt_row(int b, int tl) { return tl < L ? b * L + tl : RL + b * CTX + (tl - L); }

__device__ void ph_wconv(bf16_t* dst, const float* src, int N, int K, int ldsrc, int nvalid) {
    GSTRIDE(idx, (long)N * K) { const int k = idx % K, n = idx / K; dst[idx] = n < nvalid ? f2bf(src[(size_t)k * ldsrc + n]) : (bf16_t)0; }
}
__device__ void ph_wconv_moe(const P& p, int l) {
    GSTRIDE(idx, (long)NE * 1024 * 1024) {
        const int k = idx % 1024, n = (idx / 1024) % 1024, e = idx / (1024 * 1024);
        const int q = n >> 3, r = n & 7, j = 4 * q + (r & 3);
        const float* src = (r < 4 ? p.in[31] : p.in[32]) + ((size_t)(l * NE + e) * D + k) * EH + j;
        p.Wgu[idx] = f2bf(*src);
    }
    GSTRIDE(idx, (long)NE * 1024 * 512) {
        const int k = idx % 512, n = (idx / 512) % 1024, e = idx / (512 * 1024);
        p.Wd[idx] = f2bf(p.in[33][((size_t)(l * NE + e) * EH + k) * D + n]);
    }
}
__device__ void ph_ada(const P& p) {
    GSTRIDE(idx, 2 * 3 * 6144) {
        const int n = idx % 6144, j = (idx / 6144) % 3, l = idx / (3 * 6144);
        const float* cv = j < 2 ? p.in[1] + j * D : p.in[3];
        const float* w = p.in[4] + (size_t)l * D * 6144;
        float acc = p.in[5][l * 6144 + n];
        for (int k = 0; k < D; ++k) acc += siluf(cv[k]) * w[(size_t)k * 6144 + n];
        p.MOD[idx] = acc;
    }
}
__device__ void ph_init(const P& p) {
    GSTRIDE(i, (long)RL * D) p.out[i] = p.in[0][i];
    GSTRIDE(i, (long)RCX * D) p.Xc[i] = p.in[2][i];
}
__device__ __forceinline__ void hy_pos(int pidx, int& len, int& i) { if (pidx < L) { len = L; i = pidx; } else { len = CTX; i = pidx - L; } }
__device__ void ph_hyA1(const P& p) {
    GSTRIDE(idx, (long)RB * 64) {
        const int j = idx % 64, pidx = idx / 64; int len, i; hy_pos(pidx, len, i);
        const float t = (float)i / (float)(len - 1);
        const float w = 2.0f * 3.14159265358979323846f * (float)i / (float)len;
        const float* w1 = p.in[13];
        float acc = p.in[14][j] + t * w1[j];
        for (int m = 0; m < 16; ++m) {
            const float f = 1e-4f + (float)m * ((15.f - 1e-4f) / 15.f);
            acc += cosf(f * w) * w1[(1 + m) * 64 + j] - sinf(f * w) * w1[(17 + m) * 64 + j];
        }
        p.A1[idx] = sinf(p.in[20][j] * acc);
    }
}
__device__ void ph_hyA(const float* src, float* dst, const float* w, const float* bias, const float* freq) {
    GSTRIDE(idx, (long)RB * 64) {
        const int j = idx % 64, pidx = idx / 64;
        float acc = bias[j];
        for (int i = 0; i < 64; ++i) acc += src[(size_t)pidx * 64 + i] * w[i * 64 + j];
        dst[idx] = sinf(freq[j] * acc);
    }
}
__device__ void ph_hyF(const P& p, const float* a3) {
    const float mind = logf(1e-2f) / 1.5f, maxd = logf(1e-2f) / 0.3f;
    GSTRIDE(idx, (long)2048 * RB) {
        const int pidx = idx % RB, col = idx / RB, ch = col % 512; int len, i; hy_pos(pidx, len, i);
        const float t = (float)i / (float)(len - 1);
        float acc = 0.f;
        for (int m = 0; m < 64; ++m) acc += a3[(size_t)pidx * 64 + m] * p.in[19][m * 2048 + col];
        const float delta = fabsf(mind + (float)ch * ((maxd - mind) / 511.f));
        p.FILT[idx] = acc * expf(-t * delta);
    }
}
__device__ __forceinline__ float block_sum(float v, float* red);
__device__ void ph_hyNorm(const P& p, float* red) {
    for (int u = blockIdx.x; u < 2 * 2048; u += gridDim.x) {
        const int col = u % 2048, which = u / 2048; const int p0 = which ? L : 0, n = which ? CTX : L;
        float s = 0.f;
        for (int i = TIDX; i < n; i += NT) { const float v = p.FILT[(size_t)col * RB + p0 + i]; s += v * v; }
        const float t = block_sum(s, red);
        if (TIDX == 0) p.NORM[which * 2048 + col] = t;
    }
}
__device__ void ph_mod(const P& p, int l, int which) {
    GSTRIDE(i, (long)R * D) {
        const int r = i / D, k = i % D;
        p.H[i] = f2bf(xrow(p, r)[k] * (1.f + modv(p, l, r, which * 3 + 1)[k]) + modv(p, l, r, which * 3 + 0)[k]);
    }
}
__device__ void ph_prep_rope(const P& p) {
    GSTRIDE(i, (long)R * 2 * 4 * 64) {
        const int pr = i % 64, h = (i / 64) % 4, w = (i / 256) % 2, r = i / 512;
        bf16_t* base = p.Zr + (size_t)r * 2048 + w * 512 + h * 128;
        float t1 = bf2f(base[pr]), t2 = bf2f(base[64 + pr]);
        if (w == 1) { t1 *= KSCALE; t2 *= KSCALE; }
        if (r < RL) {
            const int t = r % L, row = t / GW, col = t % GW;
            const float inv = powf(10000.f, -(float)(pr & 31) / 32.f);
            const float ang = (pr < 32 ? (float)row : (float)col) * inv;
            float sn, cs; sincosf(ang, &sn, &cs);
            const float a = t1 * cs - t2 * sn, bb = t1 * sn + t2 * cs; t1 = a; t2 = bb;
        }
        base[pr] = f2bf(t1); base[64 + pr] = f2bf(t2);
    }
}
__device__ void ph_prep_hy(const P& p) {
    GSTRIDE(idx, (long)NB * 1536 * RB) {
        const int tl = idx % RB, col = (idx / RB) % 1536, b = idx / (RB * 1536);
        const int s0 = tl < L ? 0 : L, s1 = tl < L ? L : RB;
        const float* w = p.in[11];
        float acc = p.in[12][col] + w[1536 + col] * bf2f(p.Zh[(size_t)bt_row(b, tl) * 1536 + col]);
        if (tl - 1 >= s0) acc += w[col] * bf2f(p.Zh[(size_t)bt_row(b, tl - 1) * 1536 + col]);
        if (tl + 1 < s1) acc += w[2 * 1536 + col] * bf2f(p.Zh[(size_t)bt_row(b, tl + 1) * 1536 + col]);
        p.hyT[idx] = f2bf(acc);
    }
}
__device__ __forceinline__ float hy_tapT(const float* Ff, const float* Fb, float nf, float nb, int d) {
    if (d > 0) return Ff[d] * nf; if (d < 0) return Fb[-d] * nb; return Ff[0] * nf + Fb[0] * nb;
}
__device__ void ph_hyconv_naive(const P& p, int n, float* conv) {
    GSTRIDE(idx, (long)NB * 512 * (RB / 4)) {
        const int tb = idx % (RB / 4), ch = (idx / (RB / 4)) % 512, b = idx / ((RB / 4) * 512);
        const int tl0 = tb * 4, s0 = tl0 < L ? 0 : L, len = tl0 < L ? L : CTX, nrm = tl0 < L ? 0 : 1, t0 = tl0 - s0;
        const int cf = (n * 2 + 0) * 512 + ch, cb = (n * 2 + 1) * 512 + ch;
        const float nf = 1.f / sqrtf(p.NORM[nrm * 2048 + cf]), nb = 1.f / sqrtf(p.NORM[nrm * 2048 + cb]);
        const float* Ff = p.FILT + (size_t)cf * RB + s0; const float* Fb = p.FILT + (size_t)cb * RB + s0;
        const bf16_t* z = p.hyT + ((size_t)(b * 3 + 2) * 512 + ch) * RB + s0;
        float w0 = hy_tapT(Ff, Fb, nf, nb, t0), w1 = hy_tapT(Ff, Fb, nf, nb, t0 + 1), w2 = hy_tapT(Ff, Fb, nf, nb, t0 + 2), w3 = hy_tapT(Ff, Fb, nf, nb, t0 + 3);
        float a0 = 0.f, a1 = 0.f, a2 = 0.f, a3 = 0.f;
        for (int s = 0; s < len; ++s) {
            const float zz = bf2f(z[s]);
            a0 += w0 * zz; a1 += w1 * zz; a2 += w2 * zz; a3 += w3 * zz;
            w3 = w2; w2 = w1; w1 = w0;
            if (s + 1 < len) w0 = hy_tapT(Ff, Fb, nf, nb, t0 - (s + 1));
        }
        float* o = conv + ((size_t)b * 512 + ch) * RB + tl0; o[0] = a0; o[1] = a1; o[2] = a2; o[3] = a3;
    }
}
__device__ void ph_hygate_naive(const P& p, int n, const float* conv) {
    bf16_t* yhT = p.Zh + (size_t)2 * NB * 4 * NCH * 16384;
    GSTRIDE(idx, (long)NB * 512 * RB) {
        const int tl = idx % RB, ch = (idx / RB) % 512, b = idx / (RB * 512);
        bf16_t* z = p.hyT + ((size_t)(b * 3 + 2) * 512 + ch) * RB + tl; const float gate = bf2f(p.hyT[((size_t)(b * 3 + n) * 512 + ch) * RB + tl]);
        const float r = gate * (conv[idx] + p.in[21][n * 512 + ch] * bf2f(*z));
        if (n == 0) *z = f2bf(r); else yhT[idx] = f2bf(r);
    }
}
__device__ void ph_hy_untranspose(const P& p) {
    const bf16_t* yhT = p.Zh + (size_t)2 * NB * 4 * NCH * 16384;
    GSTRIDE(idx, (long)R * 512) { const int ch = idx % 512, r = idx / 512; int b, tl; row_bt(r, b, tl); p.H[(size_t)r * D + 512 + ch] = yhT[((size_t)b * 512 + ch) * RB + tl]; }
}
__device__ __forceinline__ size_t st_idx(int dir, int b, int h, int c) { return ((((size_t)dir * NB + b) * 4 + h) * NCH + c) * 16384; }
__device__ void ph_retU_naive(const P& p) {
    bf16_t* ST = p.Zh;
    GSTRIDE(idx, (long)NB * 4 * NCH * 16384) {
        const int d = idx % 128, e = (idx / 128) % 128, c = (idx / 16384) % NCH, h = (idx / (16384 * NCH)) % 4, b = idx / (16384 * NCH * 4);
        const float lgf = p.in[9][h], lgb = p.in[10][h]; const int r0 = chunk_row0(b, c);
        float uf = 0.f, ub = 0.f;
        for (int j = 0; j < 128; ++j) {
            const float kk = bf2f(p.Zr[(size_t)(r0 + j) * 2048 + 512 + h * 128 + d]), vv = bf2f(p.Zr[(size_t)(r0 + j) * 2048 + 1024 + h * 128 + e]);
            uf += kk * expf(lgf * (float)(127 - j)) * vv; ub += kk * expf(lgb * (float)j) * vv;
        }
        ST[st_idx(0, b, h, c) + e * 128 + d] = f2bf(uf); ST[st_idx(1, b, h, c) + e * 128 + d] = f2bf(ub);
    }
}
__device__ void ph_retScan(const P& p) {
    bf16_t* ST = p.Zh;
    GSTRIDE(idx, (long)2 * NB * 4 * 16384) {
        const int ed = idx % 16384, h = (idx / 16384) % 4, b = (idx / 65536) % NB, dir = idx / (65536 * NB);
        const float dc = expf(p.in[dir ? 10 : 9][h] * 128.f);
        float s = 0.f;
        for (int cc = 0; cc < NCH; ++cc) {
            const int c = dir == 0 ? cc : (cc < 2 ? 1 - cc : NCH + 1 - cc);
            bf16_t* q = ST + st_idx(dir, b, h, c) + ed; const float u = bf2f(*q); *q = f2bf(s); s = dc * s + u;
        }
    }
}
__device__ void ph_retO_naive(const P& p, float* lds) {
    const bf16_t* ST = p.Zh;
    for (int u = blockIdx.x; u < NB * 4 * NCH; u += gridDim.x) {
        const int c = u % NCH, h = (u / NCH) % 4, b = u / (NCH * 4); const int r0 = chunk_row0(b, c);
        const float lgf = p.in[9][h], lgb = p.in[10][h];
        __syncthreads();
        for (int e = TIDX; e < 128 * 128; e += NT) {
            const int j = e % 128, i = e / 128;
            const bf16_t* q = p.Zr + (size_t)(r0 + i) * 2048 + h * 128; const bf16_t* k = p.Zr + (size_t)(r0 + j) * 2048 + 512 + h * 128;
            float s = 0.f; for (int d = 0; d < 128; ++d) s += bf2f(q[d]) * bf2f(k[d]);
            const float m = i > j ? expf(lgf * (float)(i - j)) : (j > i ? expf(lgb * (float)(j - i)) : 2.f);
            lds[e] = s * m;
        }
        __syncthreads();
        const bf16_t* sf = ST + st_idx(0, b, h, c); const bf16_t* sb = ST + st_idx(1, b, h, c);
        for (int e2 = TIDX; e2 < 128 * 128; e2 += NT) {
            const int e = e2 % 128, i = e2 / 128;
            float o = 0.f; for (int j = 0; j < 128; ++j) o += lds[i * 128 + j] * bf2f(p.Zr[(size_t)(r0 + j) * 2048 + 1024 + h * 128 + e]);
            const bf16_t* q = p.Zr + (size_t)(r0 + i) * 2048 + h * 128;
            float of = 0.f, ob = 0.f; for (int d = 0; d < 128; ++d) { const float qq = bf2f(q[d]); of += qq * bf2f(sf[e * 128 + d]); ob += qq * bf2f(sb[e * 128 + d]); }
            p.H[(size_t)(r0 + i) * D + h * 128 + e] = f2bf(o + expf(lgf * (float)(i + 1)) * of + expf(lgb * (float)(128 - i)) * ob);
        }
    }
}
__device__ void ph_retNorm_naive(const P& p) {
    GSTRIDE(idx, (long)R * 4) {
        const int h = idx % 4, r = idx / 4; bf16_t* o = p.H + (size_t)r * D + h * 128;
        float mu = 0.f; for (int e = 0; e < 128; ++e) mu += bf2f(o[e]); mu *= (1.f / 128.f);
        float var = 0.f; for (int e = 0; e < 128; ++e) { const float d = bf2f(o[e]) - mu; var += d * d; } var *= (1.f / 128.f);
        const float rs = 1.f / sqrtf(var + LN_EPS);
        for (int e = 0; e < 128; ++e) o[e] = f2bf((bf2f(o[e]) - mu) * rs * siluf(bf2f(p.Zr[(size_t)r * 2048 + 1536 + h * 128 + e])));
    }
}
__device__ __forceinline__ float block_sum(float v, float* red) {
    __syncthreads();
#pragma unroll
    for (int o = 32; o > 0; o >>= 1) v += __shfl_xor(v, o);
    if ((TIDX & 63) == 0) red[TIDX >> 6] = v;
    __syncthreads();
    float t = 0.f;
#pragma unroll
    for (int w = 0; w < NT / 64; ++w) t += red[w];
    return t;
}
template <int MODE> __device__ void ph_post(const P& p, int l, int which, const bf16_t* Y, int ln, int wn, int nrows, float* red) {
    const float* lg = p.in[6] + (size_t)(l * 2 + which) * D; const float* lb = p.in[7] + (size_t)(l * 2 + which) * D;
    int toff[16];
    if (MODE == 1) { int s = 0;
#pragma unroll
        for (int e = 0; e < 16; ++e) { toff[e] = s; s += (p.CNT[l * 16 + e] + 255) >> 8; } }
    for (int r = blockIdx.x; r < nrows; r += gridDim.x) {
        float* x = xrow(p, r); const float* gate = modv(p, l, r, which * 3 + 2);
        const bf16_t *y0, *y1 = nullptr;
        if (MODE == 0) y0 = Y + (size_t)r * D;
        else {
            int sr[2];
#pragma unroll
            for (int k = 0; k < 2; ++k) { const int e = p.RE[r * 2 + k]; int to = 0;
#pragma unroll
                for (int q = 0; q < 16; ++q) to = (q == e) ? toff[q] : to;
                sr[k] = to * 256 + p.RPOS[r * 2 + k]; }
            y0 = p.slots + (size_t)sr[0] * D; y1 = p.slots + (size_t)sr[1] * D;
        }
        float v[2]; float s = 0.f;
#pragma unroll
        for (int i = 0; i < 2; ++i) { const int k = TIDX + i * NT; float yy = bf2f(y0[k]); if (MODE == 1) yy += bf2f(y1[k]); v[i] = ALPHA * x[k] + gate[k] * yy; s += v[i]; }
        const float mu = block_sum(s, red) * (1.f / D);
        float q = 0.f;
#pragma unroll
        for (int i = 0; i < 2; ++i) { const float d = v[i] - mu; q += d * d; }
        const float rs = 1.f / sqrtf(block_sum(q, red) * (1.f / D) + LN_EPS);
#pragma unroll
        for (int i = 0; i < 2; ++i) { const int k = TIDX + i * NT; const float xn = (v[i] - mu) * rs * lg[k] + lb[k]; x[k] = xn;
            if (ln >= 0) p.H[(size_t)r * D + k] = f2bf(xn * (1.f + modv(p, ln, r, wn * 3 + 1)[k]) + modv(p, ln, r, wn * 3 + 0)[k]); }
    }
}
__device__ void ph_route1(const P& p, int l, int nrows) {
    GSTRIDE(idx, (long)nrows * NE) {
        const int e = idx % NE, r = idx / NE; const float* x = xrow(p, r); const float* sc = modv(p, l, r, 4); const float* sh = modv(p, l, r, 3);
        float acc = 0.f;
        for (int k = 0; k < D; ++k) acc += (x[k] * (1.f + sc[k]) + sh[k]) * p.in[29][k * NE + e];
        p.RS[idx] = sigmf(acc);
    }
}
__device__ void ph_route2(const P& p, int l, int nrows) {
    GSTRIDE(r, nrows) {
        const float* s = p.RS + (size_t)r * NE; const float* rb = p.in[30];
        int best = 0; float bs = -1e30f;
        for (int g = 0; g < NG; ++g) {
            float m1 = -1e30f, m2 = -1e30f;
            for (int q = 0; q < EPG; ++q) { const float v = s[g * EPG + q] + rb[g * EPG + q]; if (v > m1) { m2 = m1; m1 = v; } else if (v > m2) m2 = v; }
            if (m1 + m2 > bs) { bs = m1 + m2; best = g; }
        }
        int i1 = 0; float v1 = -1e30f;
        for (int q = 0; q < EPG; ++q) { const float v = s[best * EPG + q] + rb[best * EPG + q]; if (v > v1) { v1 = v; i1 = q; } }
        int i2 = 0; float v2 = -1e30f;
        for (int q = 0; q < EPG; ++q) { if (q == i1) continue; const float v = s[best * EPG + q] + rb[best * EPG + q]; if (v > v2) { v2 = v; i2 = q; } }
        const int e1 = best * EPG + i1, e2 = best * EPG + i2; const float a = s[e1], c = s[e2];
        p.RE[r * 2] = e1; p.RE[r * 2 + 1] = e2; p.RWt[r * 2] = a / (a + c); p.RWt[r * 2 + 1] = c / (a + c);
        p.RPOS[r * 2] = atomicAdd(&p.CNT[l * 16 + e1], 1); p.RPOS[r * 2 + 1] = atomicAdd(&p.CNT[l * 16 + e2], 1);
    }
}
__device__ void ph_permute(const P& p, int l, int nrows) {
    int toff[16]; { int s = 0;
#pragma unroll
        for (int e = 0; e < 16; ++e) { toff[e] = s; s += (p.CNT[l * 16 + e] + 255) >> 8; } }
    GSTRIDE(idx, (long)nrows * 2 * 128) {
        const int ck = idx % 128, k = (idx / 128) % 2, r = idx / 256; const int e = p.RE[r * 2 + k]; int to = 0;
#pragma unroll
        for (int q = 0; q < 16; ++q) to = (q == e) ? toff[q] : to;
        const int sr = to * 256 + p.RPOS[r * 2 + k];
        ((uint4*)(p.Hs + (size_t)sr * D))[ck] = ((const uint4*)(p.H + (size_t)r * D))[ck];
        if (ck == 0) p.WS[sr] = p.RWt[r * 2 + k];
    }
}
__device__ void ph_glagate(const P& p) {
    GSTRIDE(idx, (long)2 * R * 512) {
        const int ch = idx % 512, r = (idx / 512) % R, dir = idx / (512 * R);
        const float* gw = p.in[dir ? 26 : 24]; const float* gb = p.in[dir ? 27 : 25];
        float acc = gb[ch];
        for (int q = 0; q < 16; ++q) acc += bf2f(p.Z1[(size_t)r * GINP + 3072 + dir * 16 + q]) * gw[q * 512 + ch];
        p.BG[idx] = logsigf(acc) * (1.f / 16.f);
    }
}
__device__ void ph_glacum(const P& p) {
    GSTRIDE(idx, (long)2 * NB * NCH * 512) {
        const int ch = idx % 512, c = (idx / 512) % NCH, b = (idx / (512 * NCH)) % NB, dir = idx / (512 * NCH * NB);
        float* a = p.BG + ((size_t)dir * R + chunk_row0(b, c)) * 512 + ch;
        float s = 0.f;
        if (dir == 0) for (int i = 0; i < 128; ++i) { s += a[(size_t)i * 512]; a[(size_t)i * 512] = s; }
        else for (int i = 127; i >= 0; --i) { s += a[(size_t)i * 512]; a[(size_t)i * 512] = s; }
    }
}
__device__ __forceinline__ size_t gst_idx(int dir, int b, int h, int c) { return ((((size_t)dir * NB + b) * 4 + h) * NCH + c) * 32768; }
__device__ void ph_glaU_naive(const P& p) {
    const float* BF = p.BG; const float* BB = p.BG + (size_t)R * 512;
    GSTRIDE(idx, (long)NB * 4 * NCH * 32768) {
        const int d = idx % 128, e = (idx / 128) % 256, c = (idx / 32768) % NCH, h = (idx / (32768 * NCH)) % 4, b = idx / (32768 * NCH * 4);
        const int r0 = chunk_row0(b, c);
        const float bfe = BF[(size_t)(r0 + 127) * 512 + h * 128 + d], bbe = BB[(size_t)r0 * 512 + h * 128 + d];
        float uf = 0.f, ub = 0.f;
        for (int j = 0; j < 128; ++j) {
            const float kk = bf2f(p.Z1[(size_t)(r0 + j) * GINP + 512 + h * 128 + d]), vv = bf2f(p.Z1[(size_t)(r0 + j) * GINP + 1024 + h * 256 + e]);
            uf += kk * expf(bfe - BF[(size_t)(r0 + j) * 512 + h * 128 + d]) * vv; ub += kk * expf(bbe - BB[(size_t)(r0 + j) * 512 + h * 128 + d]) * vv;
        }
        p.GST[gst_idx(0, b, h, c) + e * 128 + d] = f2bf(uf); p.GST[gst_idx(1, b, h, c) + e * 128 + d] = f2bf(ub);
    }
}
__device__ void ph_glaScan(const P& p) {
    const float* BF = p.BG; const float* BB = p.BG + (size_t)R * 512;
    GSTRIDE(idx, (long)2 * NB * 4 * 32768) {
        const int d = idx % 128, ed = idx % 32768, h = (idx / 32768) % 4, b = (idx / 131072) % NB, dir = idx / (131072 * NB);
        float s = 0.f;
        for (int cc = 0; cc < NCH; ++cc) {
            const int c = dir == 0 ? cc : (cc < 2 ? 1 - cc : NCH + 1 - cc); const int r0 = chunk_row0(b, c);
            const float dc = dir == 0 ? expf(BF[(size_t)(r0 + 127) * 512 + h * 128 + d]) : expf(BB[(size_t)r0 * 512 + h * 128 + d]);
            bf16_t* q = p.GST + gst_idx(dir, b, h, c) + ed; const float u = bf2f(*q); *q = f2bf(s); s = dc * s + u;
        }
    }
}
__device__ void ph_glaO_naive(const P& p, float* lds) {
    const float* BF = p.BG; const float* BB = p.BG + (size_t)R * 512;
    for (int u = blockIdx.x; u < NB * 4 * 64; u += gridDim.x) {
        const int c = 2 + u % 64, h = (u / 64) % 4, b = u / 256; const int r0 = chunk_row0(b, c);
        __syncthreads();
        for (int e = TIDX; e < 128 * 128; e += NT) {
            const int j = e % 128, i = e / 128;
            const bf16_t* q = p.Z1 + (size_t)(r0 + i) * GINP + h * 128; const bf16_t* k = p.Z1 + (size_t)(r0 + j) * GINP + 512 + h * 128;
            float s = 0.f;
            if (i >= j) { const float* bi = BF + (size_t)(r0 + i) * 512 + h * 128; const float* bj = BF + (size_t)(r0 + j) * 512 + h * 128;
                for (int d = 0; d < 128; ++d) s += bf2f(q[d]) * bf2f(k[d]) * expf(bi[d] - bj[d]); }
            if (i <= j) { const float* bi = BB + (size_t)(r0 + i) * 512 + h * 128; const float* bj = BB + (size_t)(r0 + j) * 512 + h * 128;
                for (int d = 0; d < 128; ++d) s += bf2f(q[d]) * bf2f(k[d]) * expf(bi[d] - bj[d]); }
            lds[e] = s * KSCALE;
        }
        __syncthreads();
        const bf16_t* sf = p.GST + gst_idx(0, b, h, c); const bf16_t* sb = p.GST + gst_idx(1, b, h, c);
        for (int e2 = TIDX; e2 < 128 * 256; e2 += NT) {
            const int e = e2 % 256, i = e2 / 256;
            float o = 0.f; for (int j = 0; j < 128; ++j) o += lds[i * 128 + j] * bf2f(p.Z1[(size_t)(r0 + j) * GINP + 1024 + h * 256 + e]);
            const bf16_t* q = p.Z1 + (size_t)(r0 + i) * GINP + h * 128; const float* bi = BF + (size_t)(r0 + i) * 512 + h * 128; const float* bbi = BB + (size_t)(r0 + i) * 512 + h * 128;
            float a = 0.f; for (int d = 0; d < 128; ++d) a += bf2f(q[d]) * (expf(bi[d]) * bf2f(sf[e * 128 + d]) + expf(bbi[d]) * bf2f(sb[e * 128 + d]));
            p.H[(size_t)(r0 + i) * D + h * 256 + e] = f2bf(o + a * KSCALE);
        }
    }
}
__device__ void ph_glaNorm_naive(const P& p) {
    GSTRIDE(idx, (long)RL * 4) {
        const int h = idx % 4, r = idx / 4; bf16_t* o = p.H + (size_t)r * D + h * 256;
        float ss = 0.f; for (int e = 0; e < 256; ++e) { const float v = bf2f(o[e]); ss += v * v; }
        const float rs = 1.f / sqrtf(ss * (1.f / 256.f) + LN_EPS);
        for (int e = 0; e < 256; ++e) o[e] = f2bf(bf2f(o[e]) * rs * siluf(bf2f(p.Z1[(size_t)r * GINP + 2048 + h * 256 + e])));
    }
}

#define FD __device__ __forceinline__
#define TIE(a, b) asm volatile("" : "+v"(a) : "v"(b))
#define HWCOS(x) __builtin_amdgcn_cosf(x)
#define HWSIN(x) __builtin_amdgcn_sinf(x)
struct cf { float x, y; };
FD cf cadd(cf a, cf b) { return {a.x + b.x, a.y + b.y}; }
FD cf csub(cf a, cf b) { return {a.x - b.x, a.y - b.y}; }
FD cf cmul(cf a, cf b) { return {a.x * b.x - a.y * b.y, a.x * b.y + a.y * b.x}; }
#define C32(k) ((k)==0?1.0f:(k)==1?0.98078528040323043f:(k)==2?0.92387953251128674f:(k)==3?0.83146961230254524f:(k)==4?0.70710678118654752f:(k)==5?0.55557023301960222f:(k)==6?0.38268343236508977f:(k)==7?0.19509032201612825f:(k)==8?0.0f:(k)==9?-0.19509032201612825f:(k)==10?-0.38268343236508977f:(k)==11?-0.55557023301960222f:(k)==12?-0.70710678118654752f:(k)==13?-0.83146961230254524f:(k)==14?-0.92387953251128674f:-0.98078528040323043f)
#define S32(k) ((k)==0?0.0f:(k)==1?0.19509032201612825f:(k)==2?0.38268343236508977f:(k)==3?0.55557023301960222f:(k)==4?0.70710678118654752f:(k)==5?0.83146961230254524f:(k)==6?0.92387953251128674f:(k)==7?0.98078528040323043f:(k)==8?1.0f:(k)==9?0.98078528040323043f:(k)==10?0.92387953251128674f:(k)==11?0.83146961230254524f:(k)==12?0.70710678118654752f:(k)==13?0.55557023301960222f:(k)==14?0.38268343236508977f:0.19509032201612825f)
template <int N, int LEN, bool INV> FD void dit_level(cf (&x)[N]) {
#pragma unroll
    for (int blk = 0; blk < N; blk += LEN)
#pragma unroll
        for (int j = 0; j < LEN / 2; ++j) {
            const int k = j * (32 / LEN);
            const cf a = x[blk + j], b0 = x[blk + j + LEN / 2];
            const cf b = k == 0 ? b0 : (k == 8 ? (INV ? cf{-b0.y, b0.x} : cf{b0.y, -b0.x}) : cmul(b0, cf{C32(k), INV ? S32(k) : -S32(k)}));
            x[blk + j] = cadd(a, b); x[blk + j + LEN / 2] = csub(a, b);
        }
}
template <int N, bool INV> FD void dit_reg(cf (&x)[N]) {
    dit_level<N, 2, INV>(x); dit_level<N, 4, INV>(x);
    if constexpr (N >= 8) dit_level<N, 8, INV>(x);
    if constexpr (N >= 16) dit_level<N, 16, INV>(x);
}
template <int N, int LEN, bool INV> FD void dif_level(cf (&x)[N]) {
#pragma unroll
    for (int blk = 0; blk < N; blk += LEN)
#pragma unroll
        for (int j = 0; j < LEN / 2; ++j) {
            const int k = j * (32 / LEN);
            const cf a = x[blk + j], b = x[blk + j + LEN / 2];
            x[blk + j] = cadd(a, b); const cf d = csub(a, b);
            x[blk + j + LEN / 2] = k == 0 ? d : (k == 8 ? (INV ? cf{-d.y, d.x} : cf{d.y, -d.x}) : cmul(d, cf{C32(k), INV ? S32(k) : -S32(k)}));
        }
}
template <int N, bool INV> FD void dif_reg(cf (&x)[N]) {
    if constexpr (N >= 16) dif_level<N, 16, INV>(x);
    if constexpr (N >= 8) dif_level<N, 8, INV>(x);
    dif_level<N, 4, INV>(x); dif_level<N, 2, INV>(x);
}
constexpr int FFT_N = 16384, FFT_LDS_CF = 17920;
FD int brev4(int i) { return ((i & 1) << 3) | ((i & 2) << 1) | ((i & 4) >> 1) | ((i & 8) >> 3); }
FD int physA(int m, int a) { return 4480 * a + m + (m >> 4) + 16 * (m >> 9); }
FD int physB(int b, int a, int m) { return 4480 * b + 272 * a + 16 * (a >> 1) + m + (m >> 4); }
FD int physC(int b, int a, int m) { return 272 * b + 16 * (b >> 1) + 17 * a + m; }
FD int physD(int g, int j) { return 17 * g + 16 * (g >> 5) + j; }
template <int RR, int RM> FD void twiddle(cf (&x)[RR], int m, float sgn) {
#pragma unroll
    for (int s = 1; s < RR; ++s) { const float fr = (float)((m * s) & (RM - 1)) * (1.0f / (float)RM); x[s] = cmul(x[s], cf{HWCOS(fr), sgn * HWSIN(fr)}); }
}
FD void stA_fwd(int m, cf v0, cf v1, cf v2, cf v3, cf* buf) {
    cf x[4] = {v0, v2, v1, v3};
    dit_reg<4, false>(x); twiddle<4, 16384>(x, m, -1.f);
#pragma unroll
    for (int s = 0; s < 4; ++s) buf[physA(m, s)] = x[s];
}
FD void stB_fwd(int idx, cf* buf) {
    const int b = idx >> 8, m = idx & 255; cf x[16];
#pragma unroll
    for (int i = 0; i < 16; ++i) x[i] = buf[physB(b, brev4(i), m)];
    dit_reg<16, false>(x); twiddle<16, 4096>(x, m, -1.f);
#pragma unroll
    for (int s = 0; s < 16; ++s) buf[physB(b, s, m)] = x[s];
}
FD void stC_fwd(int idx, cf* buf) {
    const int b = idx >> 4, m = idx & 15; cf x[16];
#pragma unroll
    for (int i = 0; i < 16; ++i) x[i] = buf[physC(b, brev4(i), m)];
    dit_reg<16, false>(x); twiddle<16, 256>(x, m, -1.f);
#pragma unroll
    for (int s = 0; s < 16; ++s) buf[physC(b, s, m)] = x[s];
}
FD void stD_fwd_regs(int g, const cf* buf, cf (&x)[16]) {
#pragma unroll
    for (int i = 0; i < 16; ++i) x[i] = buf[physD(g, brev4(i))];
    dit_reg<16, false>(x);
}
FD void stD_mul(int g, cf* buf, const cf (&h)[16]) {
    cf x[16];
#pragma unroll
    for (int i = 0; i < 16; ++i) x[i] = buf[physD(g, brev4(i))];
    dit_reg<16, false>(x);
#pragma unroll
    for (int s = 0; s < 16; ++s) x[s] = cmul(x[s], h[s]);
    dif_reg<16, true>(x);
#pragma unroll
    for (int i = 0; i < 16; ++i) buf[physD(g, brev4(i))] = x[i];
}
FD void stC_inv(int idx, cf* buf) {
    const int b = idx >> 4, m = idx & 15; cf x[16];
#pragma unroll
    for (int s = 0; s < 16; ++s) x[s] = buf[physC(b, s, m)];
    twiddle<16, 256>(x, m, 1.f); dif_reg<16, true>(x);
#pragma unroll
    for (int i = 0; i < 16; ++i) buf[physC(b, brev4(i), m)] = x[i];
}
FD void stB_inv(int idx, cf* buf) {
    const int b = idx >> 8, m = idx & 255; cf x[16];
#pragma unroll
    for (int s = 0; s < 16; ++s) x[s] = buf[physB(b, s, m)];
    twiddle<16, 4096>(x, m, 1.f); dif_reg<16, true>(x);
#pragma unroll
    for (int i = 0; i < 16; ++i) buf[physB(b, brev4(i), m)] = x[i];
}
FD void stA_inv(int m, const cf* buf, cf& r0, cf& r1) {
    cf x[4];
#pragma unroll
    for (int s = 0; s < 4; ++s) x[s] = buf[physA(m, s)];
    twiddle<4, 16384>(x, m, 1.f); dif_reg<4, true>(x);
    r0 = x[0]; r1 = x[2];
}

#undef FD
__device__ void ph_hyena_fft(const P& p, unsigned char* smem) {
    cf* buf = (cf*)smem; float* fb = (float*)smem;
    const int t = TIDX;
    bf16_t* yhT = p.Zh + (size_t)2 * NB * 4 * NCH * 16384;
    for (int ch = blockIdx.x; ch < 512; ch += gridDim.x) {
        const bf16_t* hy0 = p.hyT + ((size_t)0 * 512 + ch) * RB;
        const size_t bstr = (size_t)3 * 512 * RB, jstr = (size_t)512 * RB;
        cf* Hg = (cf*)p.H + (size_t)blockIdx.x * 16384;
        bf16_t* zs0 = p.hyT + ((size_t)2 * 512 + ch) * RB;
#pragma unroll 1
        for (int n = 0; n < 2; ++n) {
            const int cfi = (n * 2) * 512 + ch, cbi = (n * 2 + 1) * 512 + ch;
            const float nf = 1.f / sqrtf(p.NORM[cfi]), nb = 1.f / sqrtf(p.NORM[cbi]);
            const float* Ff = p.FILT + (size_t)cfi * RB; const float* Fb = p.FILT + (size_t)cbi * RB;
#pragma unroll 2
            for (int j = 0; j < 8; ++j) { const int m = launder_i(t) + 512 * j;
                float v0 = Ff[m] * nf; if (m == 0) v0 += Fb[0] * nb;
                const float v1 = Ff[4096 + m] * nf, v2 = (m == 0) ? 0.f : Fb[8192 - (m == 0 ? 1 : m)] * nb, v3 = Fb[4096 - m] * nb;
                stA_fwd(m, cf{v0, 0.f}, cf{v1, 0.f}, cf{v2, 0.f}, cf{v3, 0.f}, buf); }
            __syncthreads();
#pragma unroll 1
            for (int q = 0; q < 2; ++q) stB_fwd(launder_i(t) + 512 * q, buf);
            __syncthreads();
#pragma unroll 1
            for (int q = 0; q < 2; ++q) stC_fwd(launder_i(t) + 512 * q, buf);
            __syncthreads();
#pragma unroll 1
            for (int q = 0; q < 2; ++q) { const int g = launder_i(t) + 512 * q; cf hh[16]; stD_fwd_regs(g, buf, hh);
#pragma unroll
                for (int s = 0; s < 16; ++s) Hg[s * 1024 + g] = hh[s]; }
            __syncthreads();
#pragma unroll 2
            for (int j = 0; j < 8; ++j) { const int m = launder_i(t) + 512 * j;
                stA_fwd(m, cf{bf2f(zs0[m]), bf2f(zs0[bstr + m])}, cf{bf2f(zs0[4096 + m]), bf2f(zs0[bstr + 4096 + m])}, cf{0.f, 0.f}, cf{0.f, 0.f}, buf); }
            __syncthreads();
#pragma unroll 1
            for (int q = 0; q < 2; ++q) stB_fwd(launder_i(t) + 512 * q, buf);
            __syncthreads();
#pragma unroll 1
            for (int q = 0; q < 2; ++q) stC_fwd(launder_i(t) + 512 * q, buf);
            __syncthreads();
#pragma unroll 1
            for (int q = 0; q < 2; ++q) { const int g = launder_i(t) + 512 * q; cf hh[16];
#pragma unroll
                for (int s = 0; s < 16; ++s) hh[s] = Hg[s * 1024 + g];
                stD_mul(g, buf, hh); }
            __syncthreads();
#pragma unroll 1
            for (int q = 0; q < 2; ++q) stC_inv(launder_i(t) + 512 * q, buf);
            __syncthreads();
#pragma unroll 1
            for (int q = 0; q < 2; ++q) stB_inv(launder_i(t) + 512 * q, buf);
            __syncthreads();
            const float sk = p.in[21][n * 512 + ch];
#pragma unroll 2
            for (int j = 0; j < 8; ++j) { const int m = launder_i(t) + 512 * j; cf r0, r1; stA_inv(m, buf, r0, r1);
#pragma unroll
                for (int hlf = 0; hlf < 2; ++hlf) { const int d = m + 4096 * hlf; const cf r = hlf ? r1 : r0;
                    const float g0 = bf2f(hy0[n * jstr + d]), g1 = bf2f(hy0[bstr + n * jstr + d]);
                    const float o0 = g0 * (r.x * (1.f / 16384.f) + sk * bf2f(zs0[d])), o1 = g1 * (r.y * (1.f / 16384.f) + sk * bf2f(zs0[bstr + d]));
                    if (n == 0) { zs0[d] = f2bf(o0); zs0[bstr + d] = f2bf(o1); }
                    else { yhT[((size_t)0 * 512 + ch) * RB + d] = f2bf(o0); yhT[((size_t)1 * 512 + ch) * RB + d] = f2bf(o1); } } }
            __syncthreads();
        }
        {
            float* tap = fb;
            float* zc = fb + 1024;
            const int b = t >> 8, tt = t & 255;
#pragma unroll
            for (int n = 0; n < 2; ++n) {
                const int cfi = (n * 2) * 512 + ch, cbi = (n * 2 + 1) * 512 + ch;
                const float nf = 1.f / sqrtf(p.NORM[2048 + cfi]), nb = 1.f / sqrtf(p.NORM[2048 + cbi]);
                const float* Ff = p.FILT + (size_t)cfi * RB + L; const float* Fb = p.FILT + (size_t)cbi * RB + L;
                if (t < 511) { const int d = t - 255; tap[n * 512 + t] = d > 0 ? Ff[d] * nf : (d < 0 ? Fb[-d] * nb : Ff[0] * nf + Fb[0] * nb); }
            }
            const bf16_t* hb_ = hy0 + (size_t)b * bstr + L + tt;
            const float z1 = bf2f(hb_[2 * jstr]);
            zc[b * 256 + tt] = z1;
            __syncthreads();
            float c1 = 0.f;
            for (int s = 0; s < 256; ++s) c1 += tap[tt - s + 255] * zc[b * 256 + s];
            const float z2 = bf2f(hb_[0]) * (c1 + p.in[21][ch] * z1);
            __syncthreads();
            zc[b * 256 + tt] = z2;
            __syncthreads();
            float c2 = 0.f;
            for (int s = 0; s < 256; ++s) c2 += tap[512 + tt - s + 255] * zc[b * 256 + s];
            yhT[((size_t)b * 512 + ch) * RB + L + tt] = f2bf(bf2f(hb_[jstr]) * (c2 + p.in[21][512 + ch] * z2));
            __syncthreads();
        }
    }
}

typedef short bf16x8 __attribute__((ext_vector_type(8)));
typedef short s16x4 __attribute__((ext_vector_type(4)));
typedef float f32x4 __attribute__((ext_vector_type(4)));
typedef unsigned u4v __attribute__((ext_vector_type(4)));
typedef unsigned u2v __attribute__((ext_vector_type(2)));
constexpr int LDT = 136;
constexpr int TILE_E = 128 * LDT;
__device__ __forceinline__ bf16x8 frag_row(const LAS bf16_t* T, int ld, int r0, int k0, int lane) {
    return *(const LAS bf16x8*)(T + (r0 + (lane & 15)) * ld + k0 + 8 * (lane >> 4));
}
__device__ __forceinline__ bf16x8 frag_tr(const LAS bf16_t* T, int ld, int k0, int n0, int lane) {
    const int g = lane >> 4, q = (lane & 15) >> 2, pp = lane & 3;
    const LAS bf16_t* a0 = T + (k0 + 8 * g + q) * ld + n0 + 4 * pp;
    const s16x4 lo = __builtin_amdgcn_ds_read_tr16_b64_v4i16((LAS s16x4*)a0);
    const s16x4 hi = __builtin_amdgcn_ds_read_tr16_b64_v4i16((LAS s16x4*)(a0 + 4 * ld));
    return (bf16x8){lo[0], lo[1], lo[2], lo[3], hi[0], hi[1], hi[2], hi[3]};
}
#define MFMA16(xn, xm, acc) __builtin_amdgcn_mfma_f32_16x16x32_bf16(xn, xm, acc, 0, 0, 0)
__device__ __forceinline__ void unpack8(const u4v u, float (&f)[8]) {
    f[0] = __uint_as_float(u.x << 16); f[1] = __uint_as_float(u.x & 0xffff0000u); f[2] = __uint_as_float(u.y << 16); f[3] = __uint_as_float(u.y & 0xffff0000u);
    f[4] = __uint_as_float(u.z << 16); f[5] = __uint_as_float(u.z & 0xffff0000u); f[6] = __uint_as_float(u.w << 16); f[7] = __uint_as_float(u.w & 0xffff0000u);
}
__device__ __forceinline__ u4v pack8(const float (&f)[8]) {
    u4v u; u.x = pk_bf16(f[0], f[1]); u.y = pk_bf16(f[2], f[3]); u.z = pk_bf16(f[4], f[5]); u.w = pk_bf16(f[6], f[7]); return u;
}
__device__ __forceinline__ void stage_tile(LAS bf16_t* dst, const bf16_t* src, int gld, int tid) {
#pragma unroll
    for (int i = 0; i < 4; ++i) { const int c = tid + 512 * i, row = c >> 4, ch = c & 15;
        *(LAS u4v*)(dst + row * LDT + ch * 8) = *(const u4v*)(src + (size_t)row * gld + ch * 8); }
}
__device__ void ph_retU_mfma(const P& p, unsigned char* smem) {
    LAS bf16_t* Kt = (LAS bf16_t*)smem; LAS bf16_t* VF = Kt + TILE_E; LAS bf16_t* VB = VF + TILE_E;
    bf16_t* ST = p.Zh;
    for (int u = blockIdx.x; u < NB * 4 * NCH; u += gridDim.x) {
        const int tid = TIDX, lane = tid & 63, w = tid >> 6;
        const int c = u % NCH, h = (u / NCH) % 4, b = u / (NCH * 4); const int r0 = chunk_row0(b, c);
        const float lgf = p.in[9][h], lgb = p.in[10][h];
        const bf16_t* kb = p.Zr + (size_t)r0 * 2048 + 512 + h * 128; const bf16_t* vb = p.Zr + (size_t)r0 * 2048 + 1024 + h * 128;
        __syncthreads();
        stage_tile(Kt, kb, 2048, tid);
#pragma unroll
        for (int i = 0; i < 4; ++i) { const int cc = tid + 512 * i, j = cc >> 4, ch = cc & 15;
            float f[8], g[8]; unpack8(*(const u4v*)(vb + (size_t)j * 2048 + ch * 8), f);
            const float wf = __expf(lgf * (float)(127 - j)), wb = __expf(lgb * (float)j);
#pragma unroll
            for (int q = 0; q < 8; ++q) { g[q] = f[q] * wb; f[q] *= wf; }
            *(LAS u4v*)(VF + j * LDT + ch * 8) = pack8(f); *(LAS u4v*)(VB + j * LDT + ch * 8) = pack8(g); }
        __syncthreads();
        f32x4 af[8], ab[8];
#pragma unroll
        for (int nt = 0; nt < 8; ++nt) { af[nt] = (f32x4){0.f, 0.f, 0.f, 0.f}; ab[nt] = (f32x4){0.f, 0.f, 0.f, 0.f}; }
#pragma unroll
        for (int ks = 0; ks < 4; ++ks) {
            const bf16x8 xf = frag_tr(VF, LDT, 32 * ks, 16 * w, lane), xb = frag_tr(VB, LDT, 32 * ks, 16 * w, lane);
#pragma unroll
            for (int nt = 0; nt < 8; ++nt) { const bf16x8 xn = frag_tr(Kt, LDT, 32 * ks, 16 * nt, lane); af[nt] = MFMA16(xn, xf, af[nt]); ab[nt] = MFMA16(xn, xb, ab[nt]); }
        }
        const int e = 16 * w + (lane & 15), d0 = 4 * (lane >> 4);
        bf16_t* of = ST + st_idx(0, b, h, c) + e * 128 + d0; bf16_t* ob = ST + st_idx(1, b, h, c) + e * 128 + d0;
#pragma unroll
        for (int nt = 0; nt < 8; ++nt) {
            u2v o; o.x = pk_bf16(af[nt][0], af[nt][1]); o.y = pk_bf16(af[nt][2], af[nt][3]); *(u2v*)(of + 16 * nt) = o;
            o.x = pk_bf16(ab[nt][0], ab[nt][1]); o.y = pk_bf16(ab[nt][2], ab[nt][3]); *(u2v*)(ob + 16 * nt) = o; }
    }
}
__device__ void ph_retO_mfma(const P& p, unsigned char* smem) {
    LAS bf16_t* Qs = (LAS bf16_t*)smem; LAS bf16_t* Ks = Qs + TILE_E; LAS bf16_t* Vs = Ks + TILE_E; LAS bf16_t* Ss = Vs + TILE_E;
    const bf16_t* ST = p.Zh;
    for (int u = blockIdx.x; u < NB * 4 * NCH; u += gridDim.x) {
        const int tid = TIDX, lane = tid & 63, w = tid >> 6, fr = lane & 15, fq = lane >> 4;
        const int c = u % NCH, h = (u / NCH) % 4, b = u / (NCH * 4); const int r0 = chunk_row0(b, c);
        const float lgf = p.in[9][h], lgb = p.in[10][h];
        const bf16_t* zb = p.Zr + (size_t)r0 * 2048 + h * 128;
        __syncthreads();
        stage_tile(Qs, zb, 2048, tid); stage_tile(Ks, zb + 512, 2048, tid); stage_tile(Vs, zb + 1024, 2048, tid); stage_tile(Ss, ST + st_idx(0, b, h, c), 128, tid);
        __syncthreads();
        f32x4 as[8], af[8];
#pragma unroll
        for (int nt = 0; nt < 8; ++nt) { as[nt] = (f32x4){0.f, 0.f, 0.f, 0.f}; af[nt] = (f32x4){0.f, 0.f, 0.f, 0.f}; }
#pragma unroll
        for (int ks = 0; ks < 4; ++ks) { const bf16x8 xm = frag_row(Qs, LDT, 16 * w, 32 * ks, lane);
#pragma unroll
            for (int nt = 0; nt < 8; ++nt) { as[nt] = MFMA16(frag_row(Ks, LDT, 16 * nt, 32 * ks, lane), xm, as[nt]); af[nt] = MFMA16(frag_row(Ss, LDT, 16 * nt, 32 * ks, lane), xm, af[nt]); } }
        const int i = 16 * w + fr;
        __syncthreads();
#pragma unroll
        for (int nt = 0; nt < 8; ++nt) { float pv[4];
#pragma unroll
            for (int q = 0; q < 4; ++q) { const int j = 16 * nt + 4 * fq + q; const float m = i > j ? __expf(lgf * (float)(i - j)) : (j > i ? __expf(lgb * (float)(j - i)) : 2.f); pv[q] = as[nt][q] * m; }
            u2v o; o.x = pk_bf16(pv[0], pv[1]); o.y = pk_bf16(pv[2], pv[3]); *(LAS u2v*)(Ks + i * LDT + 16 * nt + 4 * fq) = o; }
        stage_tile(Ss, ST + st_idx(1, b, h, c), 128, tid);
        __syncthreads();
        f32x4 ao[8], ab[8];
#pragma unroll
        for (int nt = 0; nt < 8; ++nt) { ao[nt] = (f32x4){0.f, 0.f, 0.f, 0.f}; ab[nt] = (f32x4){0.f, 0.f, 0.f, 0.f}; }
#pragma unroll
        for (int ks = 0; ks < 4; ++ks) { const bf16x8 xp = frag_row(Ks, LDT, 16 * w, 32 * ks, lane), xq = frag_row(Qs, LDT, 16 * w, 32 * ks, lane);
#pragma unroll
            for (int nt = 0; nt < 8; ++nt) { ao[nt] = MFMA16(frag_tr(Vs, LDT, 32 * ks, 16 * nt, lane), xp, ao[nt]); ab[nt] = MFMA16(frag_row(Ss, LDT, 16 * nt, 32 * ks, lane), xq, ab[nt]); } }
        const float rf = __expf(lgf * (float)(i + 1)), rb = __expf(lgb * (float)(128 - i));
        float s = 0.f;
#pragma unroll
        for (int nt = 0; nt < 8; ++nt) { ao[nt] = ao[nt] + af[nt] * rf + ab[nt] * rb; s += (ao[nt][0] + ao[nt][1]) + (ao[nt][2] + ao[nt][3]); }
        s += __shfl_xor(s, 16); s += __shfl_xor(s, 32);
        const float mu = s * (1.f / 128.f); float qv = 0.f;
#pragma unroll
        for (int nt = 0; nt < 8; ++nt) { const f32x4 dd = ao[nt] - mu; qv += (dd[0] * dd[0] + dd[1] * dd[1]) + (dd[2] * dd[2] + dd[3] * dd[3]); }
        qv += __shfl_xor(qv, 16); qv += __shfl_xor(qv, 32);
        const float rs = 1.f / sqrtf(qv * (1.f / 128.f) + LN_EPS);
        const bf16_t* gp = p.Zr + (size_t)(r0 + i) * 2048 + 1536 + h * 128 + 4 * fq; bf16_t* yp = p.H + (size_t)(r0 + i) * D + h * 128 + 4 * fq;
#pragma unroll
        for (int nt = 0; nt < 8; ++nt) { const u2v gu = *(const u2v*)(gp + 16 * nt);
            const float g0 = __uint_as_float(gu.x << 16), g1 = __uint_as_float(gu.x & 0xffff0000u), g2 = __uint_as_float(gu.y << 16), g3 = __uint_as_float(gu.y & 0xffff0000u);
            u2v o; o.x = pk_bf16((ao[nt][0] - mu) * rs * siluf(g0), (ao[nt][1] - mu) * rs * siluf(g1)); o.y = pk_bf16((ao[nt][2] - mu) * rs * siluf(g2), (ao[nt][3] - mu) * rs * siluf(g3));
            *(u2v*)(yp + 16 * nt) = o; }
    }
}
__device__ void ph_glaU_mfma(const P& p, unsigned char* smem) {
    LAS bf16_t* KF = (LAS bf16_t*)smem; LAS bf16_t* KB = KF + TILE_E; LAS bf16_t* Vs = KB + TILE_E;
    for (int u = blockIdx.x; u < NB * 4 * NCH; u += gridDim.x) {
        const int tid = TIDX, lane = tid & 63, w = tid >> 6;
        const int c = u % NCH, h = (u / NCH) % 4, b = u / (NCH * 4); const int r0 = chunk_row0(b, c);
        const bf16_t* kb = p.Z1 + (size_t)r0 * GINP + 512 + h * 128; const bf16_t* vb = p.Z1 + (size_t)r0 * GINP + 1024 + h * 256;
        const float* BF = p.BG + (size_t)r0 * 512 + h * 128; const float* BB = p.BG + (size_t)R * 512 + (size_t)r0 * 512 + h * 128;
        __syncthreads();
#pragma unroll
        for (int i = 0; i < 4; ++i) { const int cc = tid + 512 * i, j = cc >> 4, ch = cc & 15;
            float k8[8], g8[8]; unpack8(*(const u4v*)(kb + (size_t)j * GINP + ch * 8), k8);
            const f32x4 f0 = *(const f32x4*)(BF + (size_t)j * 512 + ch * 8), f1 = *(const f32x4*)(BF + (size_t)j * 512 + ch * 8 + 4), e0 = *(const f32x4*)(BF + (size_t)127 * 512 + ch * 8), e1 = *(const f32x4*)(BF + (size_t)127 * 512 + ch * 8 + 4);
            const f32x4 b0 = *(const f32x4*)(BB + (size_t)j * 512 + ch * 8), b1 = *(const f32x4*)(BB + (size_t)j * 512 + ch * 8 + 4), t0 = *(const f32x4*)(BB + ch * 8), t1 = *(const f32x4*)(BB + ch * 8 + 4);
#pragma unroll
            for (int q = 0; q < 4; ++q) { g8[q] = k8[q] * __expf(t0[q] - b0[q]); g8[q + 4] = k8[q + 4] * __expf(t1[q] - b1[q]); k8[q] *= __expf(e0[q] - f0[q]); k8[q + 4] *= __expf(e1[q] - f1[q]); }
            *(LAS u4v*)(KF + j * LDT + ch * 8) = pack8(k8); *(LAS u4v*)(KB + j * LDT + ch * 8) = pack8(g8); }
        const int fr = lane & 15, fq = lane >> 4;
#pragma unroll 1
        for (int hf = 0; hf < 2; ++hf) {
            if (hf) __syncthreads();
            stage_tile(Vs, vb + hf * 128, GINP, tid);
            __syncthreads();
            {
                f32x4 af[8], ab[8];
#pragma unroll
                for (int nt = 0; nt < 8; ++nt) { af[nt] = (f32x4){0.f, 0.f, 0.f, 0.f}; ab[nt] = (f32x4){0.f, 0.f, 0.f, 0.f}; }
#pragma unroll
                for (int ks = 0; ks < 4; ++ks) { const bf16x8 x0 = frag_tr(Vs, LDT, 32 * ks, 16 * w, lane);
#pragma unroll
                    for (int nt = 0; nt < 8; ++nt) { af[nt] = MFMA16(frag_tr(KF, LDT, 32 * ks, 16 * nt, lane), x0, af[nt]); ab[nt] = MFMA16(frag_tr(KB, LDT, 32 * ks, 16 * nt, lane), x0, ab[nt]); } }
                bf16_t* of = p.GST + gst_idx(0, b, h, c) + (size_t)(hf * 128 + 16 * w + fr) * 128 + 4 * fq; bf16_t* ob = p.GST + gst_idx(1, b, h, c) + (size_t)(hf * 128 + 16 * w + fr) * 128 + 4 * fq;
#pragma unroll
                for (int nt = 0; nt < 8; ++nt) { u2v v; v.x = pk_bf16(af[nt][0], af[nt][1]); v.y = pk_bf16(af[nt][2], af[nt][3]); *(u2v*)(of + 16 * nt) = v;
                    v.x = pk_bf16(ab[nt][0], ab[nt][1]); v.y = pk_bf16(ab[nt][2], ab[nt][3]); *(u2v*)(ob + 16 * nt) = v; }
            }
        }
    }
}
__device__ __forceinline__ void stage_scaled(LAS bf16_t* dst, const bf16_t* src, const float* G, float sgn, float mul, int tid) {
#pragma unroll
    for (int i = 0; i < 4; ++i) { const int cc = tid + 512 * i, j = cc >> 4, ch = cc & 15;
        float k8[8]; unpack8(*(const u4v*)(src + (size_t)j * GINP + ch * 8), k8);
        const f32x4 f0 = *(const f32x4*)(G + (size_t)j * 512 + ch * 8), f1 = *(const f32x4*)(G + (size_t)j * 512 + ch * 8 + 4);
#pragma unroll
        for (int q = 0; q < 4; ++q) { k8[q] *= __expf(sgn * f0[q]) * mul; k8[q + 4] *= __expf(sgn * f1[q]) * mul; }
        *(LAS u4v*)(dst + j * LDT + ch * 8) = pack8(k8); }
}
__device__ void ph_glaO_mfma(const P& p, unsigned char* smem) {
    LAS bf16_t* QF = (LAS bf16_t*)smem; LAS bf16_t* QB = QF + TILE_E; LAS bf16_t* KX = QB + TILE_E; LAS bf16_t* R4 = KX + TILE_E;
    for (int u = blockIdx.x; u < NB * 4 * 64; u += gridDim.x) {
        const int tid = TIDX, lane = tid & 63, w = tid >> 6, fr = lane & 15, fq = lane >> 4;
        const int c = 2 + u % 64, h = (u / 64) % 4, b = u / 256; const int r0 = chunk_row0(b, c);
        const bf16_t* qb = p.Z1 + (size_t)r0 * GINP + h * 128; const bf16_t* kb = qb + 512; const bf16_t* vb = p.Z1 + (size_t)r0 * GINP + 1024 + h * 256;
        const float* BF = p.BG + (size_t)r0 * 512 + h * 128; const float* BB = p.BG + (size_t)R * 512 + (size_t)r0 * 512 + h * 128;
        const int i = 16 * w + fr;
        __syncthreads();
        stage_scaled(QF, qb, BF, 1.f, KSCALE, tid); stage_scaled(QB, qb, BB, 1.f, KSCALE, tid); stage_scaled(KX, kb, BF, -1.f, 1.f, tid);
        __syncthreads();
        f32x4 s1[8];
#pragma unroll
        for (int nt = 0; nt < 8; ++nt) s1[nt] = (f32x4){0.f, 0.f, 0.f, 0.f};
#pragma unroll
        for (int ks = 0; ks < 4; ++ks) { const bf16x8 xm = frag_row(QF, LDT, 16 * w, 32 * ks, lane);
#pragma unroll
            for (int nt = 0; nt < 8; ++nt) s1[nt] = MFMA16(frag_row(KX, LDT, 16 * nt, 32 * ks, lane), xm, s1[nt]); }
#pragma unroll
        for (int nt = 0; nt < 8; ++nt)
#pragma unroll
            for (int q = 0; q < 4; ++q) { const int j = 16 * nt + 4 * fq + q; s1[nt][q] = (i >= j) ? s1[nt][q] : 0.f; }
        __syncthreads();
        stage_scaled(KX, kb, BB, -1.f, 1.f, tid);
        __syncthreads();
        {
            f32x4 s2[8];
#pragma unroll
            for (int nt = 0; nt < 8; ++nt) s2[nt] = (f32x4){0.f, 0.f, 0.f, 0.f};
#pragma unroll
            for (int ks = 0; ks < 4; ++ks) { const bf16x8 xm = frag_row(QB, LDT, 16 * w, 32 * ks, lane);
#pragma unroll
                for (int nt = 0; nt < 8; ++nt) s2[nt] = MFMA16(frag_row(KX, LDT, 16 * nt, 32 * ks, lane), xm, s2[nt]); }
#pragma unroll
            for (int nt = 0; nt < 8; ++nt)
#pragma unroll
                for (int q = 0; q < 4; ++q) { const int j = 16 * nt + 4 * fq + q; s1[nt][q] += (i <= j) ? s2[nt][q] : 0.f; }
        }
        __syncthreads();
#pragma unroll
        for (int nt = 0; nt < 8; ++nt) { u2v o; o.x = pk_bf16(s1[nt][0], s1[nt][1]); o.y = pk_bf16(s1[nt][2], s1[nt][3]); *(LAS u2v*)(KX + i * LDT + 16 * nt + 4 * fq) = o; }
        f32x4 ao[2][8];
#pragma unroll
        for (int hf = 0; hf < 2; ++hf) {
#pragma unroll
            for (int nt = 0; nt < 8; ++nt) ao[hf][nt] = (f32x4){0.f, 0.f, 0.f, 0.f};
            stage_tile(R4, vb + hf * 128, GINP, tid);
            __syncthreads();
#pragma unroll
            for (int ks = 0; ks < 4; ++ks) { const bf16x8 xp = frag_row(KX, LDT, 16 * w, 32 * ks, lane);
#pragma unroll
                for (int nt = 0; nt < 8; ++nt) ao[hf][nt] = MFMA16(frag_tr(R4, LDT, 32 * ks, 16 * nt, lane), xp, ao[hf][nt]); }
            __syncthreads();
            stage_tile(R4, p.GST + gst_idx(0, b, h, c) + (size_t)hf * 128 * 128, 128, tid);
            __syncthreads();
#pragma unroll
            for (int ks = 0; ks < 4; ++ks) { const bf16x8 xq = frag_row(QF, LDT, 16 * w, 32 * ks, lane);
#pragma unroll
                for (int nt = 0; nt < 8; ++nt) ao[hf][nt] = MFMA16(frag_row(R4, LDT, 16 * nt, 32 * ks, lane), xq, ao[hf][nt]); }
            __syncthreads();
            stage_tile(R4, p.GST + gst_idx(1, b, h, c) + (size_t)hf * 128 * 128, 128, tid);
            __syncthreads();
#pragma unroll
            for (int ks = 0; ks < 4; ++ks) { const bf16x8 xq = frag_row(QB, LDT, 16 * w, 32 * ks, lane);
#pragma unroll
                for (int nt = 0; nt < 8; ++nt) ao[hf][nt] = MFMA16(frag_row(R4, LDT, 16 * nt, 32 * ks, lane), xq, ao[hf][nt]); }
            __syncthreads();
        }
        float ss = 0.f;
#pragma unroll
        for (int hf = 0; hf < 2; ++hf)
#pragma unroll
            for (int nt = 0; nt < 8; ++nt) { const f32x4 v = ao[hf][nt]; ss += (v[0] * v[0] + v[1] * v[1]) + (v[2] * v[2] + v[3] * v[3]); }
        ss += __shfl_xor(ss, 16); ss += __shfl_xor(ss, 32);
        const float rs = 1.f / sqrtf(ss * (1.f / 256.f) + LN_EPS);
        const bf16_t* gp = p.Z1 + (size_t)(r0 + i) * GINP + 2048 + h * 256 + 4 * fq; bf16_t* yp = p.H + (size_t)(r0 + i) * D + h * 256 + 4 * fq;
#pragma unroll
        for (int hf = 0; hf < 2; ++hf)
#pragma unroll
            for (int nt = 0; nt < 8; ++nt) { const u2v gu = *(const u2v*)(gp + hf * 128 + 16 * nt);
                const float g0 = __uint_as_float(gu.x << 16), g1 = __uint_as_float(gu.x & 0xffff0000u), g2 = __uint_as_float(gu.y << 16), g3 = __uint_as_float(gu.y & 0xffff0000u);
                u2v o; o.x = pk_bf16(ao[hf][nt][0] * rs * siluf(g0), ao[hf][nt][1] * rs * siluf(g1)); o.y = pk_bf16(ao[hf][nt][2] * rs * siluf(g2), ao[hf][nt][3] * rs * siluf(g3));
                *(u2v*)(yp + hf * 128 + 16 * nt) = o; }
    }
}

constexpr int N_STEPS = 34;
#define PG8_ALIGN true
#define PG8_SP2 true
template <class Epi> __device__ __forceinline__ void dense_gemm(LAS unsigned char* lds, const bf16_t* A, const bf16_t* Bt, int M, int N, int K, const Epi& E) {
    pg8::Gemm g{A, Bt, M, N, K}; pg8::StaticOrder S; S.init(M, N, (int)gridDim.x, (int)blockIdx.x);
    pg8::gemm_phase<Epi, pg8::StaticOrder, PG8_ALIGN, PG8_SP2>(lds, g, S, E);
}
__device__ __forceinline__ void moe_gemms(const P& p, LAS unsigned char* lds, int l, int which) {
    pg8::MoeOrder S; S.init(p.CNT + l * 16, (int)gridDim.x, (int)blockIdx.x);
    if (which == 0) { pg8::Gemm g{p.Hs, p.Wgu, 0, 0, 1024}; pg8::EpiSwiGLU E{p.he}; pg8::gemm_phase<pg8::EpiSwiGLU, pg8::MoeOrder, PG8_ALIGN, PG8_SP2>(lds, g, S, E); }
    else { pg8::Gemm g{p.he, p.Wd, 0, 0, 512}; pg8::EpiRowScale E{p.slots, p.WS}; pg8::gemm_phase<pg8::EpiRowScale, pg8::MoeOrder, PG8_ALIGN, PG8_SP2>(lds, g, S, E); }
}
__device__ __forceinline__ void run_step(const P& p, int step, unsigned char* smem) {
    LAS unsigned char* lds = (LAS unsigned char*)smem; float* fl = (float*)smem;
    float* conv = (float*)p.H;
    switch (step) {
        case 0: ph_ada(p); ph_init(p); ph_wconv(p.Win0, p.in[8], ABIN, D, ABIN, ABIN); ph_wconv(p.Wout0, p.in[22], D, D, D, D);
                ph_wconv(p.Win1, p.in[23], GINP, D, GIN, GIN); ph_wconv(p.Wout1, p.in[28], D, D, D, D); ph_wconv_moe(p, 0); ph_hyA1(p); break;
        case 1: ph_mod(p, 0, 0); ph_hyA(p.A1, p.A2, p.in[15], p.in[16], p.in[20] + 64); break;
        case 2: { pg8::EpiSplit E{p.Zr, 2048, p.Zh, 1536, 2048}; dense_gemm(lds, p.H, p.Win0, R, ABIN, D, E); }
                ph_hyA(p.A2, p.A1, p.in[17], p.in[18], p.in[20] + 128); break;
        case 3: ph_prep_rope(p); ph_prep_hy(p); ph_hyF(p, p.A1); break;
        case 4: ph_hyNorm(p, fl); ph_retU_mfma(p, smem); break;
        case 5: ph_retScan(p); ph_hyena_fft(p, smem); break;
        case 6: break;
        case 7: break;
        case 8: break;
        case 9: ph_retO_mfma(p, smem); break;
        case 10: ph_hy_untranspose(p); break;
        case 11: { pg8::EpiSplit E{p.Zr, 1024, p.Zr, 1024, 1 << 30}; dense_gemm(lds, p.H, p.Wout0, R, D, D, E); } break;
        case 12: ph_post<0>(p, 0, 0, p.Zr, 0, 1, R, fl); break;
        case 13: ph_route1(p, 0, R); break;
        case 14: ph_route2(p, 0, R); break;
        case 15: ph_permute(p, 0, R); break;
        case 16: moe_gemms(p, lds, 0, 0); break;
        case 17: moe_gemms(p, lds, 0, 1); break;
        case 18: ph_post<1>(p, 0, 1, nullptr, 1, 0, R, fl); break;
        case 19: { pg8::EpiSplit E{p.Z1, GINP, p.Z1, GINP, 1 << 30}; dense_gemm(lds, p.H, p.Win1, R, GINP, D, E); } ph_wconv_moe(p, 1); break;
        case 20: ph_glagate(p); break;
        case 21: ph_glacum(p); break;
        case 22: ph_glaU_mfma(p, smem); break;
        case 23: ph_glaScan(p); break;
        case 24: ph_glaO_mfma(p, smem); break;
        case 25: break;
        case 26: { pg8::EpiSplit E{p.Zr, 1024, p.Zr, 1024, 1 << 30}; dense_gemm(lds, p.H, p.Wout1, RL, D, D, E); } break;
        case 27: ph_post<0>(p, 1, 0, p.Zr, 1, 1, RL, fl); break;
        case 28: ph_route1(p, 1, RL); break;
        case 29: ph_route2(p, 1, RL); break;
        case 30: ph_permute(p, 1, RL); break;
        case 31: moe_gemms(p, lds, 1, 0); break;
        case 32: moe_gemms(p, lds, 1, 1); break;
        case 33: ph_post<1>(p, 1, 1, nullptr, -1, 0, RL, fl); break;
    }
}
__global__ void __launch_bounds__(NT, 2) k_all(P p) {
    extern __shared__ __attribute__((aligned(16))) unsigned char smem[];
    cg::grid_group grid = cg::this_grid();
#define STEP(n) run_step(p, n, smem); asm volatile("s_waitcnt vmcnt(0)" ::: "memory"); grid.sync();
    STEP(0) STEP(1) STEP(2) STEP(3) STEP(4) STEP(5) STEP(9) STEP(10) STEP(11) STEP(12) STEP(13) STEP(14) STEP(15) STEP(16)
    STEP(17) STEP(18) STEP(19) STEP(20) STEP(21) STEP(22) STEP(23) STEP(24) STEP(26) STEP(27) STEP(28) STEP(29) STEP(30) STEP(31) STEP(32) STEP(33)
#undef STEP
}

extern "C" void kernel_launch(void* const* d_in, const int* in_sizes, int n_in, void* d_out, int out_size, void* d_ws, size_t ws_size, hipStream_t stream) {
    P p{};
    for (int i = 0; i < 34; ++i) p.in[i] = (const float*)d_in[i];
    p.out = (float*)d_out;
    unsigned char* w = (unsigned char*)d_ws; size_t off = 0;
    auto take = [&](size_t bytes) { unsigned char* r = w + off; off += (bytes + 255) & ~(size_t)255; return r; };
    p.NORM = (float*)take(2 * 2048 * 4); p.CNT = (int*)take(2 * 16 * 4);
    const size_t ctl_bytes = off;
    p.Win1 = (bf16_t*)take((size_t)GINP * D * 2); p.Wout1 = (bf16_t*)take((size_t)D * D * 2);
    p.Wgu = (bf16_t*)take((size_t)NE * 1024 * 1024 * 2); p.Wd = (bf16_t*)take((size_t)NE * 1024 * 512 * 2);
    p.Xc = (float*)take((size_t)RCX * D * 4); p.MOD = (float*)take(2 * 3 * 6144 * 4);
    p.RS = (float*)take((size_t)R * NE * 4); p.RE = (int*)take((size_t)R * 2 * 4); p.RPOS = (int*)take((size_t)R * 2 * 4); p.RWt = (float*)take((size_t)R * 2 * 4);
    p.WS = (float*)take((size_t)MOE_ROWS * 4);
    const size_t big = off;
    p.H = (bf16_t*)take((size_t)R * D * 2);
    p.Zr = (bf16_t*)take((size_t)R * 2048 * 2);
    p.Zh = (bf16_t*)take((size_t)R * 1536 * 2);
    p.hyT = (bf16_t*)take((size_t)NB * 3 * 512 * RB * 2);
    p.FILT = (float*)take((size_t)2048 * RB * 4);
    p.Win0 = (bf16_t*)take((size_t)ABIN * D * 2); p.Wout0 = (bf16_t*)take((size_t)D * D * 2);
    p.A1 = (float*)take((size_t)RB * 64 * 4); p.A2 = (float*)take((size_t)RB * 64 * 4);
    const size_t total = off;
    off = big + (((size_t)R * D * 2 + 255) & ~(size_t)255);
    p.Hs = (bf16_t*)take((size_t)MOE_ROWS * D * 2); p.he = (bf16_t*)take((size_t)MOE_ROWS * EH * 2); p.slots = (bf16_t*)take((size_t)MOE_ROWS * D * 2);
    const size_t moe_end = off;
    off = big + (((size_t)R * D * 2 + 255) & ~(size_t)255);
    p.Z1 = (bf16_t*)take((size_t)R * GINP * 2); p.BG = (float*)take((size_t)2 * R * 512 * 4); p.GST = (bf16_t*)take((size_t)2 * NB * 4 * NCH * 32768 * 2);
    const size_t l1_end = off;
    if (total > ws_size || moe_end > total || l1_end > total || n_in != 34 || out_size != RL * D) {
        fprintf(stderr, "kernel_launch: bad sizes (need %zu ws bytes, have %zu; moe_end %zu l1_end %zu)\n", total, ws_size, moe_end, l1_end); return; }
    static int grid = 0;
    if (!grid) {
        int dev = 0, cus = 0, per = 0; hipGetDevice(&dev); hipDeviceGetAttribute(&cus, hipDeviceAttributeMultiprocessorCount, dev);
        hipFuncSetAttribute((const void*)k_all, hipFuncAttributeMaxDynamicSharedMemorySize, LDS_BYTES);
        hipOccupancyMaxActiveBlocksPerMultiprocessor(&per, k_all, NT, LDS_BYTES);
        if (per < 1) { fprintf(stderr, "kernel_launch: occupancy query says %d blocks per CU\n", per); per = 1; }
        grid = cus;
    }
    hipMemsetAsync(d_ws, 0, ctl_bytes, stream);
    void* args[] = {&p};
    hipError_t e = hipLaunchCooperativeKernel((void*)k_all, dim3(grid), dim3(NT), args, LDS_BYTES, stream);
    if (e != hipSuccess) fprintf(stderr, "coop launch failed: %s (grid %d)\n", hipGetErrorString(e), grid);
}
```

```cpp
#include <hip/hip_runtime.h>
#include <hip/hip_cooperative_groups.h>
#include <cstdio>
#include <cstdint>
namespace cg = cooperative_groups;


namespace pg8 {
#define PG8_LAS __attribute__((address_space(3)))
typedef unsigned short bf16_t;
typedef short bf16x8 __attribute__((ext_vector_type(8)));
typedef float f32x4 __attribute__((ext_vector_type(4)));
typedef unsigned u32x4 __attribute__((ext_vector_type(4)));
constexpr int BM = 256, BK = 64, HALF = 128, HTB = HALF * BK * 2  , STAGE_BYTES = 8 * HTB, NXCD = 8, WGM = 8;

__host__ __device__ __forceinline__ int lds_byte(int r, int c) { const int st = (r >> 4) * 2 + (c >> 5), rr = r & 15, cc = c & 31, ob = rr * 64 + cc * 2; return st * 1024 + (ob ^ (((ob >> 9) & 1) << 5)); }
__host__ __device__ __forceinline__ void stage_rc(int b, int& R, int& C) { const int st = b / 1024, sb = b % 1024, swz = sb ^ (((sb >> 9) & 1) << 5); R = (st >> 1) * 16 + swz / 64; C = (st & 1) * 32 + (swz % 64) / 2; }
__host__ __device__ __forceinline__ int perm32(int rho) { const int n = rho >> 4, i = rho & 15; return 8 * (i >> 2) + 4 * n + (i & 3); }

struct Unit { int pm, pn; };
struct Gemm { const bf16_t* A; const bf16_t* Bt; int M, N, K; };

struct StaticOrder {
    int nM, nN, nwg, G, c;
    __host__ __device__ void init(int M, int N, int G_, int c_) { nM = M / BM; nN = N / BM; nwg = nM * nN; G = G_; c = c_; }
    __host__ __device__ bool next(int i, Unit& u) const {
        const long L = (long)i * G + c; if (L >= nwg) return false;
        int wgid = (int)L; { const int q = nwg / NXCD, r = nwg % NXCD, xcd = wgid % NXCD, off = wgid / NXCD; wgid = (xcd < r ? xcd * (q + 1) : r * (q + 1) + (xcd - r) * q) + off; }
        const int nig = WGM * nN, gid = wgid / nig, fm = gid * WGM, gsz = (nM - fm) < WGM ? (nM - fm) : WGM;
        u.pm = fm + ((wgid % nig) % gsz); u.pn = (wgid % nig) / gsz; return true;
    }
    __device__ __forceinline__ void a_ready(const Unit&) const {}
    __device__ __forceinline__ void done(const Unit&) const {}
};


__device__ __forceinline__ unsigned cvt_pk_bf16(float lo, float hi) { unsigned r; asm volatile("v_cvt_pk_bf16_f32 %0, %1, %2" : "=v"(r) : "v"(lo), "v"(hi)); return r; }

template <class Epi, class Sched, bool ALIGN_EPI = false, bool SP2 = false>
__device__ __forceinline__ void gemm_phase(PG8_LAS unsigned char* lds, const Gemm g, const Sched& S, const Epi& E) {
    int tid_l = threadIdx.x; asm volatile("" : "+v"(tid_l)); const int tid = tid_l, wid = __builtin_amdgcn_readfirstlane(tid >> 6), lane = tid & 63, wr = wid >> 2, wc = wid & 3, fr = lane & 15, fq = lane >> 4;
    const int K = g.K, nt = K / BK;
    unsigned voffA[2], voffB[2];
#pragma unroll
    for (int i = 0; i < 2; ++i) { int R, C; stage_rc(tid * 16 + i * 8192, R, C); const int Rb = Epi::PERM ? ((R & ~31) + perm32(R & 31)) : R;
        voffA[i] = (unsigned)(R * K + C) * 2u; voffB[i] = (unsigned)(Rb * K + C) * 2u; }
    const size_t kstep = (size_t)(BK * 2);
    const size_t hstep = (size_t)HALF * K * 2;
    const size_t tstep = 2 * hstep;
    const unsigned ldsw = (unsigned)wid * 1024u;
    const int aoff = lds_byte(wr * 64 + fr, fq * 8), boff = lds_byte(wc * 32 + fr, fq * 8);
#define PG8_SA(b, h) (((b) * 2 + (h)) * HTB)
#define PG8_SB(b, h) ((4 + (b) * 2 + (h)) * HTB)
#define PG8_STAGE(bufoff, gbase, voff) do { _Pragma("unroll") for (int _i = 0; _i < 2; ++_i) \
        __builtin_amdgcn_global_load_lds((const unsigned*)((const char*)(gbase) + (voff)[_i]), (PG8_LAS unsigned*)(lds + (bufoff) + ldsw + _i * 8192), 16, 0, 0); } while (0)
#define PG8_LDA(dst, b, h) do { _Pragma("unroll") for (int m = 0; m < 4; ++m) _Pragma("unroll") for (int k = 0; k < 2; ++k) dst[m][k] = *(const PG8_LAS bf16x8*)(lds + PG8_SA(b, h) + aoff + m * 2048 + k * 1024); } while (0)
#define PG8_LDB(dst, b, h) do { _Pragma("unroll") for (int n = 0; n < 2; ++n) _Pragma("unroll") for (int k = 0; k < 2; ++k) dst[n][k] = *(const PG8_LAS bf16x8*)(lds + PG8_SB(b, h) + boff + n * 2048 + k * 1024); } while (0)
#define PG8_MMA(ai, bj, At, Bt) do { __builtin_amdgcn_s_setprio(1); _Pragma("unroll") for (int m = 0; m < 4; ++m) _Pragma("unroll") for (int n = 0; n < 2; ++n) _Pragma("unroll") for (int k = 0; k < 2; ++k) \
        acc[ai][bj][m][n] = __builtin_amdgcn_mfma_f32_16x16x32_bf16(Bt[n][k], At[m][k], acc[ai][bj][m][n], 0, 0, 0); __builtin_amdgcn_s_setprio(0); } while (0)
#define PG8_WAIT_V(n) asm volatile("s_waitcnt vmcnt(" #n ")" ::: "memory")
#define PG8_WAIT_L(n) asm volatile("s_waitcnt lgkmcnt(" #n ")" ::: "memory")
#define PG8_BAR __builtin_amdgcn_s_barrier()
#define PG8_SCHED __builtin_amdgcn_sched_barrier(0)
    Unit cur, nxt; int ui = 0;
    if (!S.next(0, cur)) return;
    f32x4 acc[2][2][4][2];
#pragma unroll
    for (int a = 0; a < 2; ++a)
#pragma unroll
        for (int b = 0; b < 2; ++b)
#pragma unroll
            for (int m = 0; m < 4; ++m)
#pragma unroll
                for (int n = 0; n < 2; ++n) acc[a][b][m][n] = (f32x4){0.f, 0.f, 0.f, 0.f};
    bf16x8 At[4][2], B0[2][2], B1[2][2];
    const char* cA = (const char*)g.A + (size_t)cur.pm * tstep; const char* cB = (const char*)g.Bt + (size_t)cur.pn * tstep;
    S.a_ready(cur);
    if constexpr (SP2) {
        PG8_STAGE(PG8_SB(0, 0), cB, voffB); PG8_STAGE(PG8_SB(0, 1), cB + hstep, voffB); PG8_STAGE(PG8_SA(0, 0), cA, voffA); PG8_STAGE(PG8_SA(0, 1), cA + hstep, voffA);
        if (wr == 1) PG8_BAR;
        PG8_WAIT_V(2); PG8_BAR;
        PG8_STAGE(PG8_SB(1, 0), cB + kstep, voffB); PG8_STAGE(PG8_SA(1, 0), cA + kstep, voffA); PG8_STAGE(PG8_SB(1, 1), cB + hstep + kstep, voffB);
        PG8_WAIT_V(6); PG8_BAR;
    } else {
        PG8_STAGE(PG8_SB(0, 0), cB, voffB); PG8_STAGE(PG8_SA(0, 0), cA, voffA); PG8_STAGE(PG8_SB(0, 1), cB + hstep, voffB); PG8_STAGE(PG8_SA(0, 1), cA + hstep, voffA);
        if (wr == 1) PG8_BAR;
        PG8_WAIT_V(4); PG8_BAR;
        PG8_STAGE(PG8_SB(1, 0), cB + kstep, voffB); PG8_STAGE(PG8_SA(1, 0), cA + kstep, voffA); PG8_STAGE(PG8_SB(1, 1), cB + hstep + kstep, voffB);
        PG8_WAIT_V(6); PG8_BAR;
    }
    for (;;) {
        const bool has_next = S.next(ui + 1, nxt);
        const char* nA = has_next ? (const char*)g.A + (size_t)nxt.pm * tstep : cA; const char* nB = has_next ? (const char*)g.Bt + (size_t)nxt.pn * tstep : cB;
        for (int t = 0; t < nt; t += 2) {
            const bool last = (t == nt - 2);
            const char* a1 = cA + (size_t)(t + 1) * kstep;
            const char* a2 = last ? nA : cA + (size_t)(t + 2) * kstep; const char* b2 = last ? nB : cB + (size_t)(t + 2) * kstep;
            const char* a3 = a2 + kstep; const char* b3 = b2 + kstep;
            if (last && has_next) S.a_ready(nxt);
            if constexpr (SP2) {
            PG8_LDB(B0, 0, 0); PG8_LDB(B1, 0, 1); PG8_SCHED; PG8_LDA(At, 0, 0); PG8_STAGE(PG8_SA(1, 1), a1 + hstep, voffA);
            PG8_WAIT_V(8); PG8_WAIT_L(0); PG8_BAR; PG8_MMA(0, 0, At, B0); PG8_MMA(0, 1, At, B1); PG8_BAR; PG8_SCHED;
            PG8_LDA(At, 0, 1); PG8_STAGE(PG8_SB(0, 0), b2, voffB); PG8_STAGE(PG8_SB(0, 1), b2 + hstep, voffB); PG8_STAGE(PG8_SA(0, 0), a2, voffA);
            PG8_WAIT_V(8); PG8_WAIT_L(0); PG8_BAR; PG8_MMA(1, 0, At, B0); PG8_MMA(1, 1, At, B1); PG8_BAR; PG8_SCHED;
            PG8_LDB(B0, 1, 0); PG8_LDB(B1, 1, 1); PG8_SCHED; PG8_LDA(At, 1, 0); PG8_STAGE(PG8_SA(0, 1), a2 + hstep, voffA);
            PG8_WAIT_V(8); PG8_WAIT_L(0); PG8_BAR; PG8_MMA(0, 0, At, B0); PG8_MMA(0, 1, At, B1); PG8_BAR; PG8_SCHED;
            PG8_LDA(At, 1, 1); PG8_STAGE(PG8_SB(1, 0), b3, voffB); PG8_STAGE(PG8_SB(1, 1), b3 + hstep, voffB); PG8_STAGE(PG8_SA(1, 0), a3, voffA);
            PG8_WAIT_V(8); PG8_WAIT_L(0); PG8_BAR; PG8_MMA(1, 0, At, B0); PG8_MMA(1, 1, At, B1); PG8_BAR; PG8_SCHED;
            } else {
            PG8_LDB(B0, 0, 0); PG8_SCHED; PG8_LDA(At, 0, 0); PG8_STAGE(PG8_SA(1, 1), a1 + hstep, voffA);
            PG8_WAIT_L(8); PG8_BAR; PG8_WAIT_L(0); PG8_MMA(0, 0, At, B0); PG8_BAR; PG8_SCHED;
            PG8_LDB(B1, 0, 1); PG8_STAGE(PG8_SB(0, 0), b2, voffB);
            PG8_BAR; PG8_WAIT_L(0); PG8_MMA(0, 1, At, B1); PG8_BAR;
            PG8_LDA(At, 0, 1); PG8_STAGE(PG8_SA(0, 0), a2, voffA);
            PG8_BAR; PG8_WAIT_L(0); PG8_MMA(1, 0, At, B0); PG8_BAR; PG8_SCHED;
            PG8_STAGE(PG8_SB(0, 1), b2 + hstep, voffB);
            PG8_WAIT_V(6); PG8_BAR; PG8_MMA(1, 1, At, B1); PG8_BAR;
            PG8_LDB(B0, 1, 0); PG8_SCHED; PG8_LDA(At, 1, 0); PG8_STAGE(PG8_SA(0, 1), a2 + hstep, voffA);
            PG8_WAIT_L(8); PG8_BAR; PG8_WAIT_L(0); PG8_MMA(0, 0, At, B0); PG8_BAR; PG8_SCHED;
            PG8_LDB(B1, 1, 1); PG8_STAGE(PG8_SB(1, 0), b3, voffB);
            PG8_BAR; PG8_WAIT_L(0); PG8_MMA(0, 1, At, B1); PG8_BAR;
            PG8_LDA(At, 1, 1); PG8_STAGE(PG8_SA(1, 0), a3, voffA);
            PG8_BAR; PG8_WAIT_L(0); PG8_MMA(1, 0, At, B0); PG8_BAR; PG8_SCHED;
            PG8_STAGE(PG8_SB(1, 1), b3 + hstep, voffB);
            PG8_WAIT_V(6); PG8_BAR; PG8_MMA(1, 1, At, B1); PG8_BAR;
            }
        }
        if constexpr (ALIGN_EPI) { if (wr == 0) PG8_BAR; }
        if constexpr (!Epi::AFTER_DRAIN) { E(acc, cur, wr, wc, fr, fq); S.done(cur); }
        if (!has_next) break;
#pragma unroll
        for (int a = 0; a < 2; ++a)
#pragma unroll
            for (int b = 0; b < 2; ++b)
#pragma unroll
                for (int m = 0; m < 4; ++m)
#pragma unroll
                    for (int n = 0; n < 2; ++n) acc[a][b][m][n] = (f32x4){0.f, 0.f, 0.f, 0.f};
        cur = nxt; cA = nA; cB = nB; ++ui;
        if constexpr (ALIGN_EPI) { if (wr == 1) PG8_BAR; }
    }
    PG8_WAIT_V(0);
    if constexpr (!ALIGN_EPI) { if (wr == 0) PG8_BAR; }
    PG8_BAR;
    if constexpr (Epi::AFTER_DRAIN) { E.fused(acc, cur, wr, wc, fr, fq, lds, wid, lane); S.done(cur); }
#undef PG8_SA
#undef PG8_SB
#undef PG8_STAGE
#undef PG8_LDA
#undef PG8_LDB
#undef PG8_MMA
#undef PG8_WAIT_V
#undef PG8_WAIT_L
#undef PG8_BAR
#undef PG8_SCHED
}
}

typedef float f2v_t __attribute__((ext_vector_type(2)));
typedef __bf16 b2v_t __attribute__((ext_vector_type(2)));
__device__ __forceinline__ unsigned pk_bf16(float lo, float hi) { const f2v_t f = {lo, hi}; const b2v_t b = __builtin_convertvector(f, b2v_t); return __builtin_bit_cast(unsigned, b); }
namespace pg8 {
typedef unsigned u32x2 __attribute__((ext_vector_type(2)));
struct EpiSplit {
    static constexpr bool PERM = true, AFTER_DRAIN = false;
    bf16_t* O0; int ld0; bf16_t* O1; int ld1; int split_col;
    __device__ __forceinline__ void operator()(const f32x4 (&acc)[2][2][4][2], const Unit& u, int wr, int wc, int fr, int fq) const {
        const int row0 = u.pm * BM + wr * 64 + fr; int colt = u.pn * BM; bf16_t* base = O0; int ldc = ld0;
        if (colt >= split_col) { base = O1; ldc = ld1; colt -= split_col; }
        const int col0 = colt + wc * 32 + 8 * fq;
#pragma unroll
        for (int ai = 0; ai < 2; ++ai)
#pragma unroll
            for (int m = 0; m < 4; ++m) { bf16_t* rowp = base + (size_t)(row0 + ai * HALF + m * 16) * ldc + col0;
#pragma unroll
                for (int bj = 0; bj < 2; ++bj) { const f32x4 v0 = acc[ai][bj][m][0], v1 = acc[ai][bj][m][1];
                    u32x4 w; w.x = ::pk_bf16(v0[0], v0[1]); w.y = ::pk_bf16(v0[2], v0[3]); w.z = ::pk_bf16(v1[0], v1[1]); w.w = ::pk_bf16(v1[2], v1[3]);
                    *(u32x4*)(rowp + bj * HALF) = w; } }
    }
};
struct EpiSwiGLU {
    static constexpr bool PERM = true, AFTER_DRAIN = false;
    bf16_t* O;
    __device__ __forceinline__ void operator()(const f32x4 (&acc)[2][2][4][2], const Unit& u, int wr, int wc, int fr, int fq) const {
        const int row0 = u.pm * BM + wr * 64 + fr; const int j0 = (u.pn & 3) * 128 + wc * 16 + 4 * fq;
#pragma unroll
        for (int ai = 0; ai < 2; ++ai)
#pragma unroll
            for (int m = 0; m < 4; ++m) { bf16_t* rowp = O + (size_t)(row0 + ai * HALF + m * 16) * 512 + j0;
#pragma unroll
                for (int bj = 0; bj < 2; ++bj) { const f32x4 g = acc[ai][bj][m][0], up = acc[ai][bj][m][1]; float h[4];
#pragma unroll
                    for (int q = 0; q < 4; ++q) h[q] = g[q] / (1.f + __expf(-g[q])) * up[q];
                    u32x2 w; w.x = ::pk_bf16(h[0], h[1]); w.y = ::pk_bf16(h[2], h[3]);
                    *(u32x2*)(rowp + bj * 64) = w; } }
    }
};
struct EpiRowScale {
    static constexpr bool PERM = true, AFTER_DRAIN = false;
    bf16_t* O; const float* ws;
    __device__ __forceinline__ void operator()(const f32x4 (&acc)[2][2][4][2], const Unit& u, int wr, int wc, int fr, int fq) const {
        const int row0 = u.pm * BM + wr * 64 + fr; const int col0 = (u.pn & 3) * BM + wc * 32 + 8 * fq;
#pragma unroll
        for (int ai = 0; ai < 2; ++ai)
#pragma unroll
            for (int m = 0; m < 4; ++m) { const int row = row0 + ai * HALF + m * 16; const float s = ws[row]; bf16_t* rowp = O + (size_t)row * 1024 + col0;
#pragma unroll
                for (int bj = 0; bj < 2; ++bj) { const f32x4 v0 = acc[ai][bj][m][0] * s, v1 = acc[ai][bj][m][1] * s;
                    u32x4 w; w.x = ::pk_bf16(v0[0], v0[1]); w.y = ::pk_bf16(v0[2], v0[3]); w.z = ::pk_bf16(v1[0], v1[1]); w.w = ::pk_bf16(v1[2], v1[3]);
                    *(u32x4*)(rowp + bj * HALF) = w; } }
    }
};
struct MoeOrder {
    int G, c, nt; int toff[16];
    __device__ __forceinline__ void init(const int* cnt, int G_, int c_) { G = G_; c = c_; int s = 0;
#pragma unroll
        for (int e = 0; e < 16; ++e) { toff[e] = s; s += (cnt[e] + 255) >> 8; } nt = s; }
    __device__ __forceinline__ bool next(int i, Unit& u) const {
        const int Lq = i * G + c; if (Lq >= nt * 4) return false;
        const int pm = Lq % nt, pn4 = Lq / nt; int e = 0;
#pragma unroll
        for (int q = 1; q < 16; ++q) e += (pm >= toff[q]) ? 1 : 0;
        u.pm = pm; u.pn = e * 4 + pn4; return true; }
    __device__ __forceinline__ void a_ready(const Unit&) const {}
    __device__ __forceinline__ void done(const Unit&) const {}
};
}

constexpr int NB = 2, L = 8192, D = 1024, CTX = 256, RB = L + CTX;
constexpr int RL = NB * L, RCX = NB * CTX, R = RL + RCX;
constexpr int GW = 64;
constexpr int NCH = 66;
constexpr int ABIN = 3584, GIN = 3104, GINP = 3328;
constexpr int NE = 16, NG = 4, EPG = 4, EH = 512;
constexpr int MOE_ROWS = 37888;
constexpr float ALPHA = 1.4142135623730951f, LN_EPS = 1e-5f, KSCALE = 0.08838834764831845f;
constexpr int NT = 512;
constexpr int LDS_BYTES = 147456;

typedef unsigned short bf16_t;
#define LAS __attribute__((address_space(3)))
__device__ __forceinline__ float bf2f(bf16_t v) { return __uint_as_float((unsigned)v << 16); }
__device__ __forceinline__ bf16_t f2bf(float f) { unsigned u = __float_as_uint(f); return (bf16_t)((u + 0x7fffu + ((u >> 16) & 1u)) >> 16); }
__device__ __forceinline__ float siluf(float x) { return x / (1.f + expf(-x)); }
__device__ __forceinline__ float sigmf(float x) { return 1.f / (1.f + expf(-x)); }
__device__ __forceinline__ float logsigf(float x) { return fminf(x, 0.f) - log1pf(expf(-fabsf(x))); }

struct P {
    const float* in[34];
    float* out;
    float* Xc;
    float* MOD;
    float* NORM;
    int* CNT;
    float* A1; float* A2;
    float* RS; int* RE; int* RPOS; float* RWt; float* WS;
    bf16_t *Win0, *Wout0, *Win1, *Wout1, *Wgu, *Wd;
    bf16_t* H;
    bf16_t* Zr;
    bf16_t* Zh;
    bf16_t* hyT;
    float* FILT;
    bf16_t *Hs, *he, *slots;
    bf16_t* Z1;
    float* BG;
    bf16_t* GST;
};

__device__ __forceinline__ int launder_i(int x) { asm volatile("" : "+v"(x)); return x; }
#define TIDX launder_i((int)threadIdx.x)
#define GSTRIDE(i, n) for (long i = (long)blockIdx.x * blockDim.x + TIDX; i < (long)(n); i += (long)gridDim.x * blockDim.x)

__device__ __forceinline__ float* xrow(const P& p, int r) { return r < RL ? p.out + (size_t)r * D : p.Xc + (size_t)(r - RL) * D; }
__device__ __forceinline__ int seg_of(int r) { return r < RL ? r / L : 2; }
__device__ __forceinline__ const float* modv(const P& p, int l, int r, int chunk) { return p.MOD + ((size_t)(l * 3 + seg_of(r)) * 6 + chunk) * D; }
__device__ __forceinline__ int chunk_row0(int b, int c) { return c < 2 ? RL + b * CTX + c * 128 : b * L + (c - 2) * 128; }
__device__ __forceinline__ void row_bt(int r, int& b, int& tl) { if (r < RL) { b = r / L; tl = r % L; } else { b = (r - RL) / CTX; tl = L + (r - RL) % CTX; } }
__device__ __forceinline__ int bt_row(int b, int tl) { return tl < L ? b * L + tl : RL + b * CTX + (tl - L); }

__device__ void ph_wconv(bf16_t* dst, const float* src, int N, int K, int ldsrc, int nvalid) {
    GSTRIDE(idx, (long)N * K) { const int k = idx % K, n = idx / K; dst[idx] = n < nvalid ? f2bf(src[(size_t)k * ldsrc + n]) : (bf16_t)0; }
}
__device__ void ph_wconv_moe(const P& p, int l) {
    GSTRIDE(idx, (long)NE * 1024 * 1024) {
        const int k = idx % 1024, n = (idx / 1024) % 1024, e = idx / (1024 * 1024);
        const int q = n >> 3, r = n & 7, j = 4 * q + (r & 3);
        const float* src = (r < 4 ? p.in[31] : p.in[32]) + ((size_t)(l * NE + e) * D + k) * EH + j;
        p.Wgu[idx] = f2bf(*src);
    }
    GSTRIDE(idx, (long)NE * 1024 * 512) {
        const int k = idx % 512, n = (idx / 512) % 1024, e = idx / (512 * 1024);
        p.Wd[idx] = f2bf(p.in[33][((size_t)(l * NE + e) * EH + k) * D + n]);
    }
}
__device__ void ph_ada(const P& p) {
    GSTRIDE(idx, 2 * 3 * 6144) {
        const int n = idx % 6144, j = (idx / 6144) % 3, l = idx / (3 * 6144);
        const float* cv = j < 2 ? p.in[1] + j * D : p.in[3];
        const float* w = p.in[4] + (size_t)l * D * 6144;
        float acc = p.in[5][l * 6144 + n];
        for (int k = 0; k < D; ++k) acc += siluf(cv[k]) * w[(size_t)k * 6144 + n];
        p.MOD[idx] = acc;
    }
}
__device__ void ph_init(const P& p) {
    GSTRIDE(i, (long)RL * D) p.out[i] = p.in[0][i];
    GSTRIDE(i, (long)RCX * D) p.Xc[i] = p.in[2][i];
}
__device__ __forceinline__ void hy_pos(int pidx, int& len, int& i) { if (pidx < L) { len = L; i = pidx; } else { len = CTX; i = pidx - L; } }
__device__ void ph_hyA1(const P& p) {
    GSTRIDE(idx, (long)RB * 64) {
        const int j = idx % 64, pidx = idx / 64; int len, i; hy_pos(pidx, len, i);
        const float t = (float)i / (float)(len - 1);
        const float w = 2.0f * 3.14159265358979323846f * (float)i / (float)len;
        const float* w1 = p.in[13];
        float acc = p.in[14][j] + t * w1[j];
        for (int m = 0; m < 16; ++m) {
            const float f = 1e-4f + (float)m * ((15.f - 1e-4f) / 15.f);
            acc += cosf(f * w) * w1[(1 + m) * 64 + j] - sinf(f * w) * w1[(17 + m) * 64 + j];
        }
        p.A1[idx] = sinf(p.in[20][j] * acc);
    }
}
__device__ void ph_hyA(const float* src, float* dst, const float* w, const float* bias, const float* freq) {
    GSTRIDE(idx, (long)RB * 64) {
        const int j = idx % 64, pidx = idx / 64;
        float acc = bias[j];
        for (int i = 0; i < 64; ++i) acc += src[(size_t)pidx * 64 + i] * w[i * 64 + j];
        dst[idx] = sinf(freq[j] * acc);
    }
}
__device__ void ph_hyF(const P& p, const float* a3) {
    const float mind = logf(1e-2f) / 1.5f, maxd = logf(1e-2f) / 0.3f;
    GSTRIDE(idx, (long)2048 * RB) {
        const int pidx = idx % RB, col = idx / RB, ch = col % 512; int len, i; hy_pos(pidx, len, i);
        const float t = (float)i / (float)(len - 1);
        float acc = 0.f;
        for (int m = 0; m < 64; ++m) acc += a3[(size_t)pidx * 64 + m] * p.in[19][m * 2048 + col];
        const float delta = fabsf(mind + (float)ch * ((maxd - mind) / 511.f));
        p.FILT[idx] = acc * expf(-t * delta);
    }
}
__device__ __forceinline__ float block_sum(float v, float* red);
__device__ void ph_hyNorm(const P& p, float* red) {
    for (int u = blockIdx.x; u < 2 * 2048; u += gridDim.x) {
        const int col = u % 2048, which = u / 2048; const int p0 = which ? L : 0, n = which ? CTX : L;
        float s = 0.f;
        for (int i = TIDX; i < n; i += NT) { const float v = p.FILT[(size_t)col * RB + p0 + i]; s += v * v; }
        const float t = block_sum(s, red);
        if (TIDX == 0) p.NORM[which * 2048 + col] = t;
    }
}
__device__ void ph_mod(const P& p, int l, int which) {
    GSTRIDE(i, (long)R * D) {
        const int r = i / D, k = i % D;
        p.H[i] = f2bf(xrow(p, r)[k] * (1.f + modv(p, l, r, which * 3 + 1)[k]) + modv(p, l, r, which * 3 + 0)[k]);
    }
}
__device__ void ph_prep_rope(const P& p) {
    GSTRIDE(i, (long)R * 2 * 4 * 64) {
        const int pr = i % 64, h = (i / 64) % 4, w = (i / 256) % 2, r = i / 512;
        bf16_t* base = p.Zr + (size_t)r * 2048 + w * 512 + h * 128;
        float t1 = bf2f(base[pr]), t2 = bf2f(base[64 + pr]);
        if (w == 1) { t1 *= KSCALE; t2 *= KSCALE; }
        if (r < RL) {
            const int t = r % L, row = t / GW, col = t % GW;
            const float inv = powf(10000.f, -(float)(pr & 31) / 32.f);
            const float ang = (pr < 32 ? (float)row : (float)col) * inv;
            float sn, cs; sincosf(ang, &sn, &cs);
            const float a = t1 * cs - t2 * sn, bb = t1 * sn + t2 * cs; t1 = a; t2 = bb;
        }
        base[pr] = f2bf(t1); base[64 + pr] = f2bf(t2);
    }
}
__device__ void ph_prep_hy(const P& p) {
    GSTRIDE(idx, (long)NB * 1536 * RB) {
        const int tl = idx % RB, col = (idx / RB) % 1536, b = idx / (RB * 1536);
        const int s0 = tl < L ? 0 : L, s1 = tl < L ? L : RB;
        const float* w = p.in[11];
        float acc = p.in[12][col] + w[1536 + col] * bf2f(p.Zh[(size_t)bt_row(b, tl) * 1536 + col]);
        if (tl - 1 >= s0) acc += w[col] * bf2f(p.Zh[(size_t)bt_row(b, tl - 1) * 1536 + col]);
        if (tl + 1 < s1) acc += w[2 * 1536 + col] * bf2f(p.Zh[(size_t)bt_row(b, tl + 1) * 1536 + col]);
        p.hyT[idx] = f2bf(acc);
    }
}
__device__ __forceinline__ float hy_tapT(const float* Ff, const float* Fb, float nf, float nb, int d) {
    if (d > 0) return Ff[d] * nf; if (d < 0) return Fb[-d] * nb; return Ff[0] * nf + Fb[0] * nb;
}
__device__ void ph_hyconv_naive(const P& p, int n, float* conv) {
    GSTRIDE(idx, (long)NB * 512 * (RB / 4)) {
        const int tb = idx % (RB / 4), ch = (idx / (RB / 4)) % 512, b = idx / ((RB / 4) * 512);
        const int tl0 = tb * 4, s0 = tl0 < L ? 0 : L, len = tl0 < L ? L : CTX, nrm = tl0 < L ? 0 : 1, t0 = tl0 - s0;
        const int cf = (n * 2 + 0) * 512 + ch, cb = (n * 2 + 1) * 512 + ch;
        const float nf = 1.f / sqrtf(p.NORM[nrm * 2048 + cf]), nb = 1.f / sqrtf(p.NORM[nrm * 2048 + cb]);
        const float* Ff = p.FILT + (size_t)cf * RB + s0; const float* Fb = p.FILT + (size_t)cb * RB + s0;
        const bf16_t* z = p.hyT + ((size_t)(b * 3 + 2) * 512 + ch) * RB + s0;
        float w0 = hy_tapT(Ff, Fb, nf, nb, t0), w1 = hy_tapT(Ff, Fb, nf, nb, t0 + 1), w2 = hy_tapT(Ff, Fb, nf, nb, t0 + 2), w3 = hy_tapT(Ff, Fb, nf, nb, t0 + 3);
        float a0 = 0.f, a1 = 0.f, a2 = 0.f, a3 = 0.f;
        for (int s = 0; s < len; ++s) {
            const float zz = bf2f(z[s]);
            a0 += w0 * zz; a1 += w1 * zz; a2 += w2 * zz; a3 += w3 * zz;
            w3 = w2; w2 = w1; w1 = w0;
            if (s + 1 < len) w0 = hy_tapT(Ff, Fb, nf, nb, t0 - (s + 1));
        }
        float* o = conv + ((size_t)b * 512 + ch) * RB + tl0; o[0] = a0; o[1] = a1; o[2] = a2; o[3] = a3;
    }
}
__device__ void ph_hygate_naive(const P& p, int n, const float* conv) {
    bf16_t* yhT = p.Zh + (size_t)2 * NB * 4 * NCH * 16384;
    GSTRIDE(idx, (long)NB * 512 * RB) {
        const int tl = idx % RB, ch = (idx / RB) % 512, b = idx / (RB * 512);
        bf16_t* z = p.hyT + ((size_t)(b * 3 + 2) * 512 + ch) * RB + tl; const float gate = bf2f(p.hyT[((size_t)(b * 3 + n) * 512 + ch) * RB + tl]);
        const float r = gate * (conv[idx] + p.in[21][n * 512 + ch] * bf2f(*z));
        if (n == 0) *z = f2bf(r); else yhT[idx] = f2bf(r);
    }
}
__device__ void ph_hy_untranspose(const P& p) {
    const bf16_t* yhT = p.Zh + (size_t)2 * NB * 4 * NCH * 16384;
    GSTRIDE(idx, (long)R * 512) { const int ch = idx % 512, r = idx / 512; int b, tl; row_bt(r, b, tl); p.H[(size_t)r * D + 512 + ch] = yhT[((size_t)b * 512 + ch) * RB + tl]; }
}
__device__ __forceinline__ size_t st_idx(int dir, int b, int h, int c) { return ((((size_t)dir * NB + b) * 4 + h) * NCH + c) * 16384; }
__device__ void ph_retU_naive(const P& p) {
    bf16_t* ST = p.Zh;
    GSTRIDE(idx, (long)NB * 4 * NCH * 16384) {
        const int d = idx % 128, e = (idx / 128) % 128, c = (idx / 16384) % NCH, h = (idx / (16384 * NCH)) % 4, b = idx / (16384 * NCH * 4);
        const float lgf = p.in[9][h], lgb = p.in[10][h]; const int r0 = chunk_row0(b, c);
        float uf = 0.f, ub = 0.f;
        for (int j = 0; j < 128; ++j) {
            const float kk = bf2f(p.Zr[(size_t)(r0 + j) * 2048 + 512 + h * 128 + d]), vv = bf2f(p.Zr[(size_t)(r0 + j) * 2048 + 1024 + h * 128 + e]);
            uf += kk * expf(lgf * (float)(127 - j)) * vv; ub += kk * expf(lgb * (float)j) * vv;
        }
        ST[st_idx(0, b, h, c) + e * 128 + d] = f2bf(uf); ST[st_idx(1, b, h, c) + e * 128 + d] = f2bf(ub);
    }
}
__device__ void ph_retScan(const P& p) {
    bf16_t* ST = p.Zh;
    GSTRIDE(idx, (long)2 * NB * 4 * 16384) {
        const int ed = idx % 16384, h = (idx / 16384) % 4, b = (idx / 65536) % NB, dir = idx / (65536 * NB);
        const float dc = expf(p.in[dir ? 10 : 9][h] * 128.f);
        float s = 0.f;
        for (int cc = 0; cc < NCH; ++cc) {
            const int c = dir == 0 ? cc : (cc < 2 ? 1 - cc : NCH + 1 - cc);
            bf16_t* q = ST + st_idx(dir, b, h, c) + ed; const float u = bf2f(*q); *q = f2bf(s); s = dc * s + u;
        }
    }
}
__device__ void ph_retO_naive(const P& p, float* lds) {
    const bf16_t* ST = p.Zh;
    for (int u = blockIdx.x; u < NB * 4 * NCH; u += gridDim.x) {
        const int c = u % NCH, h = (u / NCH) % 4, b = u / (NCH * 4); const int r0 = chunk_row0(b, c);
        const float lgf = p.in[9][h], lgb = p.in[10][h];
        __syncthreads();
        for (int e = TIDX; e < 128 * 128; e += NT) {
            const int j = e % 128, i = e / 128;
            const bf16_t* q = p.Zr + (size_t)(r0 + i) * 2048 + h * 128; const bf16_t* k = p.Zr + (size_t)(r0 + j) * 2048 + 512 + h * 128;
            float s = 0.f; for (int d = 0; d < 128; ++d) s += bf2f(q[d]) * bf2f(k[d]);
            const float m = i > j ? expf(lgf * (float)(i - j)) : (j > i ? expf(lgb * (float)(j - i)) : 2.f);
            lds[e] = s * m;
        }
        __syncthreads();
        const bf16_t* sf = ST + st_idx(0, b, h, c); const bf16_t* sb = ST + st_idx(1, b, h, c);
        for (int e2 = TIDX; e2 < 128 * 128; e2 += NT) {
            const int e = e2 % 128, i = e2 / 128;
            float o = 0.f; for (int j = 0; j < 128; ++j) o += lds[i * 128 + j] * bf2f(p.Zr[(size_t)(r0 + j) * 2048 + 1024 + h * 128 + e]);
            const bf16_t* q = p.Zr + (size_t)(r0 + i) * 2048 + h * 128;
            float of = 0.f, ob = 0.f; for (int d = 0; d < 128; ++d) { const float qq = bf2f(q[d]); of += qq * bf2f(sf[e * 128 + d]); ob += qq * bf2f(sb[e * 128 + d]); }
            p.H[(size_t)(r0 + i) * D + h * 128 + e] = f2bf(o + expf(lgf * (float)(i + 1)) * of + expf(lgb * (float)(128 - i)) * ob);
        }
    }
}
__device__ void ph_retNorm_naive(const P& p) {
    GSTRIDE(idx, (long)R * 4) {
        const int h = idx % 4, r = idx / 4; bf16_t* o = p.H + (size_t)r * D + h * 128;
        float mu = 0.f; for (int e = 0; e < 128; ++e) mu += bf2f(o[e]); mu *= (1.f / 128.f);
        float var = 0.f; for (int e = 0; e < 128; ++e) { const float d = bf2f(o[e]) - mu; var += d * d; } var *= (1.f / 128.f);
        const float rs = 1.f / sqrtf(var + LN_EPS);
        for (int e = 0; e < 128; ++e) o[e] = f2bf((bf2f(o[e]) - mu) * rs * siluf(bf2f(p.Zr[(size_t)r * 2048 + 1536 + h * 128 + e])));
    }
}
__device__ __forceinline__ float block_sum(float v, float* red) {
    __syncthreads();
#pragma unroll
    for (int o = 32; o > 0; o >>= 1) v += __shfl_xor(v, o);
    if ((TIDX & 63) == 0) red[TIDX >> 6] = v;
    __syncthreads();
    float t = 0.f;
#pragma unroll
    for (int w = 0; w < NT / 64; ++w) t += red[w];
    return t;
}
template <int MODE> __device__ void ph_post(const P& p, int l, int which, const bf16_t* Y, int ln, int wn, int nrows, float* red) {
    const float* lg = p.in[6] + (size_t)(l * 2 + which) * D; const float* lb = p.in[7] + (size_t)(l * 2 + which) * D;
    int toff[16];
    if (MODE == 1) { int s = 0;
#pragma unroll
        for (int e = 0; e < 16; ++e) { toff[e] = s; s += (p.CNT[l * 16 + e] + 255) >> 8; } }
    for (int r = blockIdx.x; r < nrows; r += gridDim.x) {
        float* x = xrow(p, r); const float* gate = modv(p, l, r, which * 3 + 2);
        const bf16_t *y0, *y1 = nullptr;
        if (MODE == 0) y0 = Y + (size_t)r * D;
        else {
            int sr[2];
#pragma unroll
            for (int k = 0; k < 2; ++k) { const int e = p.RE[r * 2 + k]; int to = 0;
#pragma unroll
                for (int q = 0; q < 16; ++q) to = (q == e) ? toff[q] : to;
                sr[k] = to * 256 + p.RPOS[r * 2 + k]; }
            y0 = p.slots + (size_t)sr[0] * D; y1 = p.slots + (size_t)sr[1] * D;
        }
        float v[2]; float s = 0.f;
#pragma unroll
        for (int i = 0; i < 2; ++i) { const int k = TIDX + i * NT; float yy = bf2f(y0[k]); if (MODE == 1) yy += bf2f(y1[k]); v[i] = ALPHA * x[k] + gate[k] * yy; s += v[i]; }
        const float mu = block_sum(s, red) * (1.f / D);
        float q = 0.f;
#pragma unroll
        for (int i = 0; i < 2; ++i) { const float d = v[i] - mu; q += d * d; }
        const float rs = 1.f / sqrtf(block_sum(q, red) * (1.f / D) + LN_EPS);
#pragma unroll
        for (int i = 0; i < 2; ++i) { const int k = TIDX + i * NT; const float xn = (v[i] - mu) * rs * lg[k] + lb[k]; x[k] = xn;
            if (ln >= 0) p.H[(size_t)r * D + k] = f2bf(xn * (1.f + modv(p, ln, r, wn * 3 + 1)[k]) + modv(p, ln, r, wn * 3 + 0)[k]); }
    }
}
__device__ void ph_route1(const P& p, int l, int nrows) {
    GSTRIDE(idx, (long)nrows * NE) {
        const int e = idx % NE, r = idx / NE; const float* x = xrow(p, r); const float* sc = modv(p, l, r, 4); const float* sh = modv(p, l, r, 3);
        float acc = 0.f;
        for (int k = 0; k < D; ++k) acc += (x[k] * (1.f + sc[k]) + sh[k]) * p.in[29][k * NE + e];
        p.RS[idx] = sigmf(acc);
    }
}
__device__ void ph_route2(const P& p, int l, int nrows) {
    GSTRIDE(r, nrows) {
        const float* s = p.RS + (size_t)r * NE; const float* rb = p.in[30];
        int best = 0; float bs = -1e30f;
        for (int g = 0; g < NG; ++g) {
            float m1 = -1e30f, m2 = -1e30f;
            for (int q = 0; q < EPG; ++q) { const float v = s[g * EPG + q] + rb[g * EPG + q]; if (v > m1) { m2 = m1; m1 = v; } else if (v > m2) m2 = v; }
            if (m1 + m2 > bs) { bs = m1 + m2; best = g; }
        }
        int i1 = 0; float v1 = -1e30f;
        for (int q = 0; q < EPG; ++q) { const float v = s[best * EPG + q] + rb[best * EPG + q]; if (v > v1) { v1 = v; i1 = q; } }
        int i2 = 0; float v2 = -1e30f;
        for (int q = 0; q < EPG; ++q) { if (q == i1) continue; const float v = s[best * EPG + q] + rb[best * EPG + q]; if (v > v2) { v2 = v; i2 = q; } }
        const int e1 = best * EPG + i1, e2 = best * EPG + i2; const float a = s[e1], c = s[e2];
        p.RE[r * 2] = e1; p.RE[r * 2 + 1] = e2; p.RWt[r * 2] = a / (a + c); p.RWt[r * 2 + 1] = c / (a + c);
        p.RPOS[r * 2] = atomicAdd(&p.CNT[l * 16 + e1], 1); p.RPOS[r * 2 + 1] = atomicAdd(&p.CNT[l * 16 + e2], 1);
    }
}
__device__ void ph_permute(const P& p, int l, int nrows) {
    int toff[16]; { int s = 0;
#pragma unroll
        for (int e = 0; e < 16; ++e) { toff[e] = s; s += (p.CNT[l * 16 + e] + 255) >> 8; } }
    GSTRIDE(idx, (long)nrows * 2 * 128) {
        const int ck = idx % 128, k = (idx / 128) % 2, r = idx / 256; const int e = p.RE[r * 2 + k]; int to = 0;
#pragma unroll
        for (int q = 0; q < 16; ++q) to = (q == e) ? toff[q] : to;
        const int sr = to * 256 + p.RPOS[r * 2 + k];
        ((uint4*)(p.Hs + (size_t)sr * D))[ck] = ((const uint4*)(p.H + (size_t)r * D))[ck];
        if (ck == 0) p.WS[sr] = p.RWt[r * 2 + k];
    }
}
__device__ void ph_glagate(const P& p) {
    GSTRIDE(idx, (long)2 * R * 512) {
        const int ch = idx % 512, r = (idx / 512) % R, dir = idx / (512 * R);
        const float* gw = p.in[dir ? 26 : 24]; const float* gb = p.in[dir ? 27 : 25];
        float acc = gb[ch];
        for (int q = 0; q < 16; ++q) acc += bf2f(p.Z1[(size_t)r * GINP + 3072 + dir * 16 + q]) * gw[q * 512 + ch];
        p.BG[idx] = logsigf(acc) * (1.f / 16.f);
    }
}
__device__ void ph_glacum(const P& p) {
    GSTRIDE(idx, (long)2 * NB * NCH * 512) {
        const int ch = idx % 512, c = (idx / 512) % NCH, b = (idx / (512 * NCH)) % NB, dir = idx / (512 * NCH * NB);
        float* a = p.BG + ((size_t)dir * R + chunk_row0(b, c)) * 512 + ch;
        float s = 0.f;
        if (dir == 0) for (int i = 0; i < 128; ++i) { s += a[(size_t)i * 512]; a[(size_t)i * 512] = s; }
        else for (int i = 127; i >= 0; --i) { s += a[(size_t)i * 512]; a[(size_t)i * 512] = s; }
    }
}
__device__ __forceinline__ size_t gst_idx(int dir, int b, int h, int c) { return ((((size_t)dir * NB + b) * 4 + h) * NCH + c) * 32768; }
__device__ void ph_glaU_naive(const P& p) {
    const float* BF = p.BG; const float* BB = p.BG + (size_t)R * 512;
    GSTRIDE(idx, (long)NB * 4 * NCH * 32768) {
        const int d = idx % 128, e = (idx / 128) % 256, c = (idx / 32768) % NCH, h = (idx / (32768 * NCH)) % 4, b = idx / (32768 * NCH * 4);
        const int r0 = chunk_row0(b, c);
        const float bfe = BF[(size_t)(r0 + 127) * 512 + h * 128 + d], bbe = BB[(size_t)r0 * 512 + h * 128 + d];
        float uf = 0.f, ub = 0.f;
        for (int j = 0; j < 128; ++j) {
            const float kk = bf2f(p.Z1[(size_t)(r0 + j) * GINP + 512 + h * 128 + d]), vv = bf2f(p.Z1[(size_t)(r0 + j) * GINP + 1024 + h * 256 + e]);
            uf += kk * expf(bfe - BF[(size_t)(r0 + j) * 512 + h * 128 + d]) * vv; ub += kk * expf(bbe - BB[(size_t)(r0 + j) * 512 + h * 128 + d]) * vv;
        }
        p.GST[gst_idx(0, b, h, c) + e * 128 + d] = f2bf(uf); p.GST[gst_idx(1, b, h, c) + e * 128 + d] = f2bf(ub);
    }
}
__device__ void ph_glaScan(const P& p) {
    const float* BF = p.BG; const float* BB = p.BG + (size_t)R * 512;
    GSTRIDE(idx, (long)2 * NB * 4 * 32768) {
        const int d = idx % 128, ed = idx % 32768, h = (idx / 32768) % 4, b = (idx / 131072) % NB, dir = idx / (131072 * NB);
        float s = 0.f;
        for (int cc = 0; cc < NCH; ++cc) {
            const int c = dir == 0 ? cc : (cc < 2 ? 1 - cc : NCH + 1 - cc); const int r0 = chunk_row0(b, c);
            const float dc = dir == 0 ? expf(BF[(size_t)(r0 + 127) * 512 + h * 128 + d]) : expf(BB[(size_t)r0 * 512 + h * 128 + d]);
            bf16_t* q = p.GST + gst_idx(dir, b, h, c) + ed; const float u = bf2f(*q); *q = f2bf(s); s = dc * s + u;
        }
    }
}
__device__ void ph_glaO_naive(const P& p, float* lds) {
    const float* BF = p.BG; const float* BB = p.BG + (size_t)R * 512;
    for (int u = blockIdx.x; u < NB * 4 * 64; u += gridDim.x) {
        const int c = 2 + u % 64, h = (u / 64) % 4, b = u / 256; const int r0 = chunk_row0(b, c);
        __syncthreads();
        for (int e = TIDX; e < 128 * 128; e += NT) {
            const int j = e % 128, i = e / 128;
            const bf16_t* q = p.Z1 + (size_t)(r0 + i) * GINP + h * 128; const bf16_t* k = p.Z1 + (size_t)(r0 + j) * GINP + 512 + h * 128;
            float s = 0.f;
            if (i >= j) { const float* bi = BF + (size_t)(r0 + i) * 512 + h * 128; const float* bj = BF + (size_t)(r0 + j) * 512 + h * 128;
                for (int d = 0; d < 128; ++d) s += bf2f(q[d]) * bf2f(k[d]) * expf(bi[d] - bj[d]); }
            if (i <= j) { const float* bi = BB + (size_t)(r0 + i) * 512 + h * 128; const float* bj = BB + (size_t)(r0 + j) * 512 + h * 128;
                for (int d = 0; d < 128; ++d) s += bf2f(q[d]) * bf2f(k[d]) * expf(bi[d] - bj[d]); }
            lds[e] = s * KSCALE;
        }
        __syncthreads();
        const bf16_t* sf = p.GST + gst_idx(0, b, h, c); const bf16_t* sb = p.GST + gst_idx(1, b, h, c);
        for (int e2 = TIDX; e2 < 128 * 256; e2 += NT) {
            const int e = e2 % 256, i = e2 / 256;
            float o = 0.f; for (int j = 0; j < 128; ++j) o += lds[i * 128 + j] * bf2f(p.Z1[(size_t)(r0 + j) * GINP + 1024 + h * 256 + e]);
            const bf16_t* q = p.Z1 + (size_t)(r0 + i) * GINP + h * 128; const float* bi = BF + (size_t)(r0 + i) * 512 + h * 128; const float* bbi = BB + (size_t)(r0 + i) * 512 + h * 128;
            float a = 0.f; for (int d = 0; d < 128; ++d) a += bf2f(q[d]) * (expf(bi[d]) * bf2f(sf[e * 128 + d]) + expf(bbi[d]) * bf2f(sb[e * 128 + d]));
            p.H[(size_t)(r0 + i) * D + h * 256 + e] = f2bf(o + a * KSCALE);
        }
    }
}
__device__ void ph_glaNorm_naive(const P& p) {
    GSTRIDE(idx, (long)RL * 4) {
        const int h = idx % 4, r = idx / 4; bf16_t* o = p.H + (size_t)r * D + h * 256;
        float ss = 0.f; for (int e = 0; e < 256; ++e) { const float v = bf2f(o[e]); ss += v * v; }
        const float rs = 1.f / sqrtf(ss * (1.f / 256.f) + LN_EPS);
        for (int e = 0; e < 256; ++e) o[e] = f2bf(bf2f(o[e]) * rs * siluf(bf2f(p.Z1[(size_t)r * GINP + 2048 + h * 256 + e])));
    }
}

#define FD __device__ __forceinline__
#define TIE(a, b) asm volatile("" : "+v"(a) : "v"(b))
#define HWCOS(x) __builtin_amdgcn_cosf(x)
#define HWSIN(x) __builtin_amdgcn_sinf(x)
struct cf { float x, y; };
FD cf cadd(cf a, cf b) { return {a.x + b.x, a.y + b.y}; }
FD cf csub(cf a, cf b) { return {a.x - b.x, a.y - b.y}; }
FD cf cmul(cf a, cf b) { return {a.x * b.x - a.y * b.y, a.x * b.y + a.y * b.x}; }
#define C32(k) ((k)==0?1.0f:(k)==1?0.98078528040323043f:(k)==2?0.92387953251128674f:(k)==3?0.83146961230254524f:(k)==4?0.70710678118654752f:(k)==5?0.55557023301960222f:(k)==6?0.38268343236508977f:(k)==7?0.19509032201612825f:(k)==8?0.0f:(k)==9?-0.19509032201612825f:(k)==10?-0.38268343236508977f:(k)==11?-0.55557023301960222f:(k)==12?-0.70710678118654752f:(k)==13?-0.83146961230254524f:(k)==14?-0.92387953251128674f:-0.98078528040323043f)
#define S32(k) ((k)==0?0.0f:(k)==1?0.19509032201612825f:(k)==2?0.38268343236508977f:(k)==3?0.55557023301960222f:(k)==4?0.70710678118654752f:(k)==5?0.83146961230254524f:(k)==6?0.92387953251128674f:(k)==7?0.98078528040323043f:(k)==8?1.0f:(k)==9?0.98078528040323043f:(k)==10?0.92387953251128674f:(k)==11?0.83146961230254524f:(k)==12?0.70710678118654752f:(k)==13?0.55557023301960222f:(k)==14?0.38268343236508977f:0.19509032201612825f)
template <int N, int LEN, bool INV> FD void dit_level(cf (&x)[N]) {
#pragma unroll
    for (int blk = 0; blk < N; blk += LEN)
#pragma unroll
        for (int j = 0; j < LEN / 2; ++j) {
            const int k = j * (32 / LEN);
            const cf a = x[blk + j], b0 = x[blk + j + LEN / 2];
            const cf b = k == 0 ? b0 : (k == 8 ? (INV ? cf{-b0.y, b0.x} : cf{b0.y, -b0.x}) : cmul(b0, cf{C32(k), INV ? S32(k) : -S32(k)}));
            x[blk + j] = cadd(a, b); x[blk + j + LEN / 2] = csub(a, b);
        }
}
template <int N, bool INV> FD void dit_reg(cf (&x)[N]) {
    dit_level<N, 2, INV>(x); dit_level<N, 4, INV>(x);
    if constexpr (N >= 8) dit_level<N, 8, INV>(x);
    if constexpr (N >= 16) dit_level<N, 16, INV>(x);
}
template <int N, int LEN, bool INV> FD void dif_level(cf (&x)[N]) {
#pragma unroll
    for (int blk = 0; blk < N; blk += LEN)
#pragma unroll
        for (int j = 0; j < LEN / 2; ++j) {
            const int k = j * (32 / LEN);
            const cf a = x[blk + j], b = x[blk + j + LEN / 2];
            x[blk + j] = cadd(a, b); const cf d = csub(a, b);
            x[blk + j + LEN / 2] = k == 0 ? d : (k == 8 ? (INV ? cf{-d.y, d.x} : cf{d.y, -d.x}) : cmul(d, cf{C32(k), INV ? S32(k) : -S32(k)}));
        }
}
template <int N, bool INV> FD void dif_reg(cf (&x)[N]) {
    if constexpr (N >= 16) dif_level<N, 16, INV>(x);
    if constexpr (N >= 8) dif_level<N, 8, INV>(x);
    dif_level<N, 4, INV>(x); dif_level<N, 2, INV>(x);
}
constexpr int FFT_N = 16384, FFT_LDS_CF = 17920;
FD int brev4(int i) { return ((i & 1) << 3) | ((i & 2) << 1) | ((i & 4) >> 1) | ((i & 8) >> 3); }
FD int physA(int m, int a) { return 4480 * a + m + (m >> 4) + 16 * (m >> 9); }
FD int physB(int b, int a, int m) { return 4480 * b + 272 * a + 16 * (a >> 1) + m + (m >> 4); }
FD int physC(int b, int a, int m) { return 272 * b + 16 * (b >> 1) + 17 * a + m; }
FD int physD(int g, int j) { return 17 * g + 16 * (g >> 5) + j; }
template <int RR, int RM> FD void twiddle(cf (&x)[RR], int m, float sgn) {
#pragma unroll
    for (int s = 1; s < RR; ++s) { const float fr = (float)((m * s) & (RM - 1)) * (1.0f / (float)RM); x[s] = cmul(x[s], cf{HWCOS(fr), sgn * HWSIN(fr)}); }
}
FD void stA_fwd(int m, cf v0, cf v1, cf v2, cf v3, cf* buf) {
    cf x[4] = {v0, v2, v1, v3};
    dit_reg<4, false>(x); twiddle<4, 16384>(x, m, -1.f);
#pragma unroll
    for (int s = 0; s < 4; ++s) buf[physA(m, s)] = x[s];
}
FD void stB_fwd(int idx, cf* buf) {
    const int b = idx >> 8, m = idx & 255; cf x[16];
#pragma unroll
    for (int i = 0; i < 16; ++i) x[i] = buf[physB(b, brev4(i), m)];
    dit_reg<16, false>(x); twiddle<16, 4096>(x, m, -1.f);
#pragma unroll
    for (int s = 0; s < 16; ++s) buf[physB(b, s, m)] = x[s];
}
FD void stC_fwd(int idx, cf* buf) {
    const int b = idx >> 4, m = idx & 15; cf x[16];
#pragma unroll
    for (int i = 0; i < 16; ++i) x[i] = buf[physC(b, brev4(i), m)];
    dit_reg<16, false>(x); twiddle<16, 256>(x, m, -1.f);
#pragma unroll
    for (int s = 0; s < 16; ++s) buf[physC(b, s, m)] = x[s];
}
FD void stD_fwd_regs(int g, const cf* buf, cf (&x)[16]) {
#pragma unroll
    for (int i = 0; i < 16; ++i) x[i] = buf[physD(g, brev4(i))];
    dit_reg<16, false>(x);
}
FD void stD_mul(int g, cf* buf, const cf (&h)[16]) {
    cf x[16];
#pragma unroll
    for (int i = 0; i < 16; ++i) x[i] = buf[physD(g, brev4(i))];
    dit_reg<16, false>(x);
#pragma unroll
    for (int s = 0; s < 16; ++s) x[s] = cmul(x[s], h[s]);
    dif_reg<16, true>(x);
#pragma unroll
    for (int i = 0; i < 16; ++i) buf[physD(g, brev4(i))] = x[i];
}
FD void stC_inv(int idx, cf* buf) {
    const int b = idx >> 4, m = idx & 15; cf x[16];
#pragma unroll
    for (int s = 0; s < 16; ++s) x[s] = buf[physC(b, s, m)];
    twiddle<16, 256>(x, m, 1.f); dif_reg<16, true>(x);
#pragma unroll
    for (int i = 0; i < 16; ++i) buf[physC(b, brev4(i), m)] = x[i];
}
FD void stB_inv(int idx, cf* buf) {
    const int b = idx >> 8, m = idx & 255; cf x[16];
#pragma unroll
    for (int s = 0; s < 16; ++s) x[s] = buf[physB(b, s, m)];
    twiddle<16, 4096>(x, m, 1.f); dif_reg<16, true>(x);
#pragma unroll
    for (int i = 0; i < 16; ++i) buf[physB(b, brev4(i), m)] = x[i];
}
FD void stA_inv(int m, const cf* buf, cf& r0, cf& r1) {
    cf x[4];
#pragma unroll
    for (int s = 0; s < 4; ++s) x[s] = buf[physA(m, s)];
    twiddle<4, 16384>(x, m, 1.f); dif_reg<4, true>(x);
    r0 = x[0]; r1 = x[2];
}

#undef FD
__device__ void ph_hyena_fft(const P& p, unsigned char* smem) {
    cf* buf = (cf*)smem; float* fb = (float*)smem;
    const int t = TIDX;
    bf16_t* yhT = p.Zh + (size_t)2 * NB * 4 * NCH * 16384;
    for (int ch = blockIdx.x; ch < 512; ch += gridDim.x) {
        const bf16_t* hy0 = p.hyT + ((size_t)0 * 512 + ch) * RB;
        const size_t bstr = (size_t)3 * 512 * RB, jstr = (size_t)512 * RB;
        cf* Hg = (cf*)p.H + (size_t)blockIdx.x * 16384;
        bf16_t* zs0 = p.hyT + ((size_t)2 * 512 + ch) * RB;
#pragma unroll 1
        for (int n = 0; n < 2; ++n) {
            const int cfi = (n * 2) * 512 + ch, cbi = (n * 2 + 1) * 512 + ch;
            const float nf = 1.f / sqrtf(p.NORM[cfi]), nb = 1.f / sqrtf(p.NORM[cbi]);
            const float* Ff = p.FILT + (size_t)cfi * RB; const float* Fb = p.FILT + (size_t)cbi * RB;
#pragma unroll 2
            for (int j = 0; j < 8; ++j) { const int m = launder_i(t) + 512 * j;
                float v0 = Ff[m] * nf; if (m == 0) v0 += Fb[0] * nb;
                const float v1 = Ff[4096 + m] * nf, v2 = (m == 0) ? 0.f : Fb[8192 - (m == 0 ? 1 : m)] * nb, v3 = Fb[4096 - m] * nb;
                stA_fwd(m, cf{v0, 0.f}, cf{v1, 0.f}, cf{v2, 0.f}, cf{v3, 0.f}, buf); }
            __syncthreads();
#pragma unroll 1
            for (int q = 0; q < 2; ++q) stB_fwd(launder_i(t) + 512 * q, buf);
            __syncthreads();
#pragma unroll 1
            for (int q = 0; q < 2; ++q) stC_fwd(launder_i(t) + 512 * q, buf);
            __syncthreads();
#pragma unroll 1
            for (int q = 0; q < 2; ++q) { const int g = launder_i(t) + 512 * q; cf hh[16]; stD_fwd_regs(g, buf, hh);
#pragma unroll
                for (int s = 0; s < 16; ++s) Hg[s * 1024 + g] = hh[s]; }
            __syncthreads();
#pragma unroll 2
            for (int j = 0; j < 8; ++j) { const int m = launder_i(t) + 512 * j;
                stA_fwd(m, cf{bf2f(zs0[m]), bf2f(zs0[bstr + m])}, cf{bf2f(zs0[4096 + m]), bf2f(zs0[bstr + 4096 + m])}, cf{0.f, 0.f}, cf{0.f, 0.f}, buf); }
            __syncthreads();
#pragma unroll 1
            for (int q = 0; q < 2; ++q) stB_fwd(launder_i(t) + 512 * q, buf);
            __syncthreads();
#pragma unroll 1
            for (int q = 0; q < 2; ++q) stC_fwd(launder_i(t) + 512 * q, buf);
            __syncthreads();
#pragma unroll 1
            for (int q = 0; q < 2; ++q) { const int g = launder_i(t) + 512 * q; cf hh[16];
#pragma unroll
                for (int s = 0; s < 16; ++s) hh[s] = Hg[s * 1024 + g];
                stD_mul(g, buf, hh); }
            __syncthreads();
#pragma unroll 1
            for (int q = 0; q < 2; ++q) stC_inv(launder_i(t) + 512 * q, buf);
            __syncthreads();
#pragma unroll 1
            for (int q = 0; q < 2; ++q) stB_inv(launder_i(t) + 512 * q, buf);
            __syncthreads();
            const float sk = p.in[21][n * 512 + ch];
#pragma unroll 2
            for (int j = 0; j < 8; ++j) { const int m = launder_i(t) + 512 * j; cf r0, r1; stA_inv(m, buf, r0, r1);
#pragma unroll
                for (int hlf = 0; hlf < 2; ++hlf) { const int d = m + 4096 * hlf; const cf r = hlf ? r1 : r0;
                    const float g0 = bf2f(hy0[n * jstr + d]), g1 = bf2f(hy0[bstr + n * jstr + d]);
                    const float o0 = g0 * (r.x * (1.f / 16384.f) + sk * bf2f(zs0[d])), o1 = g1 * (r.y * (1.f / 16384.f) + sk * bf2f(zs0[bstr + d]));
                    if (n == 0) { zs0[d] = f2bf(o0); zs0[bstr + d] = f2bf(o1); }
                    else { yhT[((size_t)0 * 512 + ch) * RB + d] = f2bf(o0); yhT[((size_t)1 * 512 + ch) * RB + d] = f2bf(o1); } } }
            __syncthreads();
        }
        {
            float* tap = fb;
            float* zc = fb + 1024;
            const int b = t >> 8, tt = t & 255;
#pragma unroll
            for (int n = 0; n < 2; ++n) {
                const int cfi = (n * 2) * 512 + ch, cbi = (n * 2 + 1) * 512 + ch;
                const float nf = 1.f / sqrtf(p.NORM[2048 + cfi]), nb = 1.f / sqrtf(p.NORM[2048 + cbi]);
                const float* Ff = p.FILT + (size_t)cfi * RB + L; const float* Fb = p.FILT + (size_t)cbi * RB + L;
                if (t < 511) { const int d = t - 255; tap[n * 512 + t] = d > 0 ? Ff[d] * nf : (d < 0 ? Fb[-d] * nb : Ff[0] * nf + Fb[0] * nb); }
            }
            const bf16_t* hb_ = hy0 + (size_t)b * bstr + L + tt;
            const float z1 = bf2f(hb_[2 * jstr]);
            zc[b * 256 + tt] = z1;
            __syncthreads();
            float c1 = 0.f;
            for (int s = 0; s < 256; ++s) c1 += tap[tt - s + 255] * zc[b * 256 + s];
            const float z2 = bf2f(hb_[0]) * (c1 + p.in[21][ch] * z1);
            __syncthreads();
            zc[b * 256 + tt] = z2;
            __syncthreads();
            float c2 = 0.f;
            for (int s = 0; s < 256; ++s) c2 += tap[512 + tt - s + 255] * zc[b * 256 + s];
            yhT[((size_t)b * 512 + ch) * RB + L + tt] = f2bf(bf2f(hb_[jstr]) * (c2 + p.in[21][512 + ch] * z2));
            __syncthreads();
        }
    }
}

typedef short bf16x8 __attribute__((ext_vector_type(8)));
typedef short s16x4 __attribute__((ext_vector_type(4)));
typedef float f32x4 __attribute__((ext_vector_type(4)));
typedef unsigned u4v __attribute__((ext_vector_type(4)));
typedef unsigned u2v __attribute__((ext_vector_type(2)));
constexpr int LDT = 136;
constexpr int TILE_E = 128 * LDT;
__device__ __forceinline__ bf16x8 frag_row(const LAS bf16_t* T, int ld, int r0, int k0, int lane) {
    return *(const LAS bf16x8*)(T + (r0 + (lane & 15)) * ld + k0 + 8 * (lane >> 4));
}
__device__ __forceinline__ bf16x8 frag_tr(const LAS bf16_t* T, int ld, int k0, int n0, int lane) {
    const int g = lane >> 4, q = (lane & 15) >> 2, pp = lane & 3;
    const LAS bf16_t* a0 = T + (k0 + 8 * g + q) * ld + n0 + 4 * pp;
    const s16x4 lo = __builtin_amdgcn_ds_read_tr16_b64_v4i16((LAS s16x4*)a0);
    const s16x4 hi = __builtin_amdgcn_ds_read_tr16_b64_v4i16((LAS s16x4*)(a0 + 4 * ld));
    return (bf16x8){lo[0], lo[1], lo[2], lo[3], hi[0], hi[1], hi[2], hi[3]};
}
#define MFMA16(xn, xm, acc) __builtin_amdgcn_mfma_f32_16x16x32_bf16(xn, xm, acc, 0, 0, 0)
__device__ __forceinline__ void unpack8(const u4v u, float (&f)[8]) {
    f[0] = __uint_as_float(u.x << 16); f[1] = __uint_as_float(u.x & 0xffff0000u); f[2] = __uint_as_float(u.y << 16); f[3] = __uint_as_float(u.y & 0xffff0000u);
    f[4] = __uint_as_float(u.z << 16); f[5] = __uint_as_float(u.z & 0xffff0000u); f[6] = __uint_as_float(u.w << 16); f[7] = __uint_as_float(u.w & 0xffff0000u);
}
__device__ __forceinline__ u4v pack8(const float (&f)[8]) {
    u4v u; u.x = pk_bf16(f[0], f[1]); u.y = pk_bf16(f[2], f[3]); u.z = pk_bf16(f[4], f[5]); u.w = pk_bf16(f[6], f[7]); return u;
}
__device__ __forceinline__ void stage_tile(LAS bf16_t* dst, const bf16_t* src, int gld, int tid) {
#pragma unroll
    for (int i = 0; i < 4; ++i) { const int c = tid + 512 * i, row = c >> 4, ch = c & 15;
        *(LAS u4v*)(dst + row * LDT + ch * 8) = *(const u4v*)(src + (size_t)row * gld + ch * 8); }
}
__device__ void ph_retU_mfma(const P& p, unsigned char* smem) {
    LAS bf16_t* Kt = (LAS bf16_t*)smem; LAS bf16_t* VF = Kt + TILE_E; LAS bf16_t* VB = VF + TILE_E;
    bf16_t* ST = p.Zh;
    for (int u = blockIdx.x; u < NB * 4 * NCH; u += gridDim.x) {
        const int tid = TIDX, lane = tid & 63, w = tid >> 6;
        const int c = u % NCH, h = (u / NCH) % 4, b = u / (NCH * 4); const int r0 = chunk_row0(b, c);
        const float lgf = p.in[9][h], lgb = p.in[10][h];
        const bf16_t* kb = p.Zr + (size_t)r0 * 2048 + 512 + h * 128; const bf16_t* vb = p.Zr + (size_t)r0 * 2048 + 1024 + h * 128;
        __syncthreads();
        stage_tile(Kt, kb, 2048, tid);
#pragma unroll
        for (int i = 0; i < 4; ++i) { const int cc = tid + 512 * i, j = cc >> 4, ch = cc & 15;
            float f[8], g[8]; unpack8(*(const u4v*)(vb + (size_t)j * 2048 + ch * 8), f);
            const float wf = __expf(lgf * (float)(127 - j)), wb = __expf(lgb * (float)j);
#pragma unroll
            for (int q = 0; q < 8; ++q) { g[q] = f[q] * wb; f[q] *= wf; }
            *(LAS u4v*)(VF + j * LDT + ch * 8) = pack8(f); *(LAS u4v*)(VB + j * LDT + ch * 8) = pack8(g); }
        __syncthreads();
        f32x4 af[8], ab[8];
#pragma unroll
        for (int nt = 0; nt < 8; ++nt) { af[nt] = (f32x4){0.f, 0.f, 0.f, 0.f}; ab[nt] = (f32x4){0.f, 0.f, 0.f, 0.f}; }
#pragma unroll
        for (int ks = 0; ks < 4; ++ks) {
            const bf16x8 xf = frag_tr(VF, LDT, 32 * ks, 16 * w, lane), xb = frag_tr(VB, LDT, 32 * ks, 16 * w, lane);
#pragma unroll
            for (int nt = 0; nt < 8; ++nt) { const bf16x8 xn = frag_tr(Kt, LDT, 32 * ks, 16 * nt, lane); af[nt] = MFMA16(xn, xf, af[nt]); ab[nt] = MFMA16(xn, xb, ab[nt]); }
        }
        const int e = 16 * w + (lane & 15), d0 = 4 * (lane >> 4);
        bf16_t* of = ST + st_idx(0, b, h, c) + e * 128 + d0; bf16_t* ob = ST + st_idx(1, b, h, c) + e * 128 + d0;
#pragma unroll
        for (int nt = 0; nt < 8; ++nt) {
            u2v o; o.x = pk_bf16(af[nt][0], af[nt][1]); o.y = pk_bf16(af[nt][2], af[nt][3]); *(u2v*)(of + 16 * nt) = o;
            o.x = pk_bf16(ab[nt][0], ab[nt][1]); o.y = pk_bf16(ab[nt][2], ab[nt][3]); *(u2v*)(ob + 16 * nt) = o; }
    }
}
__device__ void ph_retO_mfma(const P& p, unsigned char* smem) {
    LAS bf16_t* Qs = (LAS bf16_t*)smem; LAS bf16_t* Ks = Qs + TILE_E; LAS bf16_t* Vs = Ks + TILE_E; LAS bf16_t* Ss = Vs + TILE_E;
    const bf16_t* ST = p.Zh;
    for (int u = blockIdx.x; u < NB * 4 * NCH; u += gridDim.x) {
        const int tid = TIDX, lane = tid & 63, w = tid >> 6, fr = lane & 15, fq = lane >> 4;
        const int c = u % NCH, h = (u / NCH) % 4, b = u / (NCH * 4); const int r0 = chunk_row0(b, c);
        const float lgf = p.in[9][h], lgb = p.in[10][h];
        const bf16_t* zb = p.Zr + (size_t)r0 * 2048 + h * 128;
        __syncthreads();
        stage_tile(Qs, zb, 2048, tid); stage_tile(Ks, zb + 512, 2048, tid); stage_tile(Vs, zb + 1024, 2048, tid); stage_tile(Ss, ST + st_idx(0, b, h, c), 128, tid);
        __syncthreads();
        f32x4 as[8], af[8];
#pragma unroll
        for (int nt = 0; nt < 8; ++nt) { as[nt] = (f32x4){0.f, 0.f, 0.f, 0.f}; af[nt] = (f32x4){0.f, 0.f, 0.f, 0.f}; }
#pragma unroll
        for (int ks = 0; ks < 4; ++ks) { const bf16x8 xm = frag_row(Qs, LDT, 16 * w, 32 * ks, lane);
#pragma unroll
            for (int nt = 0; nt < 8; ++nt) { as[nt] = MFMA16(frag_row(Ks, LDT, 16 * nt, 32 * ks, lane), xm, as[nt]); af[nt] = MFMA16(frag_row(Ss, LDT, 16 * nt, 32 * ks, lane), xm, af[nt]); } }
        const int i = 16 * w + fr;
        __syncthreads();
#pragma unroll
        for (int nt = 0; nt < 8; ++nt) { float pv[4];
#pragma unroll
            for (int q = 0; q < 4; ++q) { const int j = 16 * nt + 4 * fq + q; const float m = i > j ? __expf(lgf * (float)(i - j)) : (j > i ? __expf(lgb * (float)(j - i)) : 2.f); pv[q] = as[nt][q] * m; }
            u2v o; o.x = pk_bf16(pv[0], pv[1]); o.y = pk_bf16(pv[2], pv[3]); *(LAS u2v*)(Ks + i * LDT + 16 * nt + 4 * fq) = o; }
        stage_tile(Ss, ST + st_idx(1, b, h, c), 128, tid);
        __syncthreads();
        f32x4 ao[8], ab[8];
#pragma unroll
        for (int nt = 0; nt < 8; ++nt) { ao[nt] = (f32x4){0.f, 0.f, 0.f, 0.f}; ab[nt] = (f32x4){0.f, 0.f, 0.f, 0.f}; }
#pragma unroll
        for (int ks = 0; ks < 4; ++ks) { const bf16x8 xp = frag_row(Ks, LDT, 16 * w, 32 * ks, lane), xq = frag_row(Qs, LDT, 16 * w, 32 * ks, lane);
#pragma unroll
            for (int nt = 0; nt < 8; ++nt) { ao[nt] = MFMA16(frag_tr(Vs, LDT, 32 * ks, 16 * nt, lane), xp, ao[nt]); ab[nt] = MFMA16(frag_row(Ss, LDT, 16 * nt, 32 * ks, lane), xq, ab[nt]); } }
        const float rf = __expf(lgf * (float)(i + 1)), rb = __expf(lgb * (float)(128 - i));
        float s = 0.f;
#pragma unroll
        for (int nt = 0; nt < 8; ++nt) { ao[nt] = ao[nt] + af[nt] * rf + ab[nt] * rb; s += (ao[nt][0] + ao[nt][1]) + (ao[nt][2] + ao[nt][3]); }
        s += __shfl_xor(s, 16); s += __shfl_xor(s, 32);
        const float mu = s * (1.f / 128.f); float qv = 0.f;
#pragma unroll
        for (int nt = 0; nt < 8; ++nt) { const f32x4 dd = ao[nt] - mu; qv += (dd[0] * dd[0] + dd[1] * dd[1]) + (dd[2] * dd[2] + dd[3] * dd[3]); }
        qv += __shfl_xor(qv, 16); qv += __shfl_xor(qv, 32);
        const float rs = 1.f / sqrtf(qv * (1.f / 128.f) + LN_EPS);
        const bf16_t* gp = p.Zr + (size_t)(r0 + i) * 2048 + 1536 + h * 128 + 4 * fq; bf16_t* yp = p.H + (size_t)(r0 + i) * D + h * 128 + 4 * fq;
#pragma unroll
        for (int nt = 0; nt < 8; ++nt) { const u2v gu = *(const u2v*)(gp + 16 * nt);
            const float g0 = __uint_as_float(gu.x << 16), g1 = __uint_as_float(gu.x & 0xffff0000u), g2 = __uint_as_float(gu.y << 16), g3 = __uint_as_float(gu.y & 0xffff0000u);
            u2v o; o.x = pk_bf16((ao[nt][0] - mu) * rs * siluf(g0), (ao[nt][1] - mu) * rs * siluf(g1)); o.y = pk_bf16((ao[nt][2] - mu) * rs * siluf(g2), (ao[nt][3] - mu) * rs * siluf(g3));
            *(u2v*)(yp + 16 * nt) = o; }
    }
}
__device__ void ph_glaU_mfma(const P& p, unsigned char* smem) {
    LAS bf16_t* KF = (LAS bf16_t*)smem; LAS bf16_t* KB = KF + TILE_E; LAS bf16_t* Vs = KB + TILE_E;
    for (int u = blockIdx.x; u < NB * 4 * NCH; u += gridDim.x) {
        const int tid = TIDX, lane = tid & 63, w = tid >> 6;
        const int c = u % NCH, h = (u / NCH) % 4, b = u / (NCH * 4); const int r0 = chunk_row0(b, c);
        const bf16_t* kb = p.Z1 + (size_t)r0 * GINP + 512 + h * 128; const bf16_t* vb = p.Z1 + (size_t)r0 * GINP + 1024 + h * 256;
        const float* BF = p.BG + (size_t)r0 * 512 + h * 128; const float* BB = p.BG + (size_t)R * 512 + (size_t)r0 * 512 + h * 128;
        __syncthreads();
#pragma unroll
        for (int i = 0; i < 4; ++i) { const int cc = tid + 512 * i, j = cc >> 4, ch = cc & 15;
            float k8[8], g8[8]; unpack8(*(const u4v*)(kb + (size_t)j * GINP + ch * 8), k8);
            const f32x4 f0 = *(const f32x4*)(BF + (size_t)j * 512 + ch * 8), f1 = *(const f32x4*)(BF + (size_t)j * 512 + ch * 8 + 4), e0 = *(const f32x4*)(BF + (size_t)127 * 512 + ch * 8), e1 = *(const f32x4*)(BF + (size_t)127 * 512 + ch * 8 + 4);
            const f32x4 b0 = *(const f32x4*)(BB + (size_t)j * 512 + ch * 8), b1 = *(const f32x4*)(BB + (size_t)j * 512 + ch * 8 + 4), t0 = *(const f32x4*)(BB + ch * 8), t1 = *(const f32x4*)(BB + ch * 8 + 4);
#pragma unroll
            for (int q = 0; q < 4; ++q) { g8[q] = k8[q] * __expf(t0[q] - b0[q]); g8[q + 4] = k8[q + 4] * __expf(t1[q] - b1[q]); k8[q] *= __expf(e0[q] - f0[q]); k8[q + 4] *= __expf(e1[q] - f1[q]); }
            *(LAS u4v*)(KF + j * LDT + ch * 8) = pack8(k8); *(LAS u4v*)(KB + j * LDT + ch * 8) = pack8(g8); }
        const int fr = lane & 15, fq = lane >> 4;
#pragma unroll 1
        for (int hf = 0; hf < 2; ++hf) {
            if (hf) __syncthreads();
            stage_tile(Vs, vb + hf * 128, GINP, tid);
            __syncthreads();
            {
                f32x4 af[8], ab[8];
#pragma unroll
                for (int nt = 0; nt < 8; ++nt) { af[nt] = (f32x4){0.f, 0.f, 0.f, 0.f}; ab[nt] = (f32x4){0.f, 0.f, 0.f, 0.f}; }
#pragma unroll
                for (int ks = 0; ks < 4; ++ks) { const bf16x8 x0 = frag_tr(Vs, LDT, 32 * ks, 16 * w, lane);
#pragma unroll
                    for (int nt = 0; nt < 8; ++nt) { af[nt] = MFMA16(frag_tr(KF, LDT, 32 * ks, 16 * nt, lane), x0, af[nt]); ab[nt] = MFMA16(frag_tr(KB, LDT, 32 * ks, 16 * nt, lane), x0, ab[nt]); } }
                bf16_t* of = p.GST + gst_idx(0, b, h, c) + (size_t)(hf * 128 + 16 * w + fr) * 128 + 4 * fq; bf16_t* ob = p.GST + gst_idx(1, b, h, c) + (size_t)(hf * 128 + 16 * w + fr) * 128 + 4 * fq;
#pragma unroll
                for (int nt = 0; nt < 8; ++nt) { u2v v; v.x = pk_bf16(af[nt][0], af[nt][1]); v.y = pk_bf16(af[nt][2], af[nt][3]); *(u2v*)(of + 16 * nt) = v;
                    v.x = pk_bf16(ab[nt][0], ab[nt][1]); v.y = pk_bf16(ab[nt][2], ab[nt][3]); *(u2v*)(ob + 16 * nt) = v; }
            }
        }
    }
}
__device__ __forceinline__ void stage_scaled(LAS bf16_t* dst, const bf16_t* src, const float* G, float sgn, float mul, int tid) {
#pragma unroll
    for (int i = 0; i < 4; ++i) { const int cc = tid + 512 * i, j = cc >> 4, ch = cc & 15;
        float k8[8]; unpack8(*(const u4v*)(src + (size_t)j * GINP + ch * 8), k8);
        const f32x4 f0 = *(const f32x4*)(G + (size_t)j * 512 + ch * 8), f1 = *(const f32x4*)(G + (size_t)j * 512 + ch * 8 + 4);
#pragma unroll
        for (int q = 0; q < 4; ++q) { k8[q] *= __expf(sgn * f0[q]) * mul; k8[q + 4] *= __expf(sgn * f1[q]) * mul; }
        *(LAS u4v*)(dst + j * LDT + ch * 8) = pack8(k8); }
}
__device__ void ph_glaO_mfma(const P& p, unsigned char* smem) {
    LAS bf16_t* QF = (LAS bf16_t*)smem; LAS bf16_t* QB = QF + TILE_E; LAS bf16_t* KX = QB + TILE_E; LAS bf16_t* R4 = KX + TILE_E;
    for (int u = blockIdx.x; u < NB * 4 * 64; u += gridDim.x) {
        const int tid = TIDX, lane = tid & 63, w = tid >> 6, fr = lane & 15, fq = lane >> 4;
        const int c = 2 + u % 64, h = (u / 64) % 4, b = u / 256; const int r0 = chunk_row0(b, c);
        const bf16_t* qb = p.Z1 + (size_t)r0 * GINP + h * 128; const bf16_t* kb = qb + 512; const bf16_t* vb = p.Z1 + (size_t)r0 * GINP + 1024 + h * 256;
        const float* BF = p.BG + (size_t)r0 * 512 + h * 128; const float* BB = p.BG + (size_t)R * 512 + (size_t)r0 * 512 + h * 128;
        const int i = 16 * w + fr;
        __syncthreads();
        stage_scaled(QF, qb, BF, 1.f, KSCALE, tid); stage_scaled(QB, qb, BB, 1.f, KSCALE, tid); stage_scaled(KX, kb, BF, -1.f, 1.f, tid);
        __syncthreads();
        f32x4 s1[8];
#pragma unroll
        for (int nt = 0; nt < 8; ++nt) s1[nt] = (f32x4){0.f, 0.f, 0.f, 0.f};
#pragma unroll
        for (int ks = 0; ks < 4; ++ks) { const bf16x8 xm = frag_row(QF, LDT, 16 * w, 32 * ks, lane);
#pragma unroll
            for (int nt = 0; nt < 8; ++nt) s1[nt] = MFMA16(frag_row(KX, LDT, 16 * nt, 32 * ks, lane), xm, s1[nt]); }
#pragma unroll
        for (int nt = 0; nt < 8; ++nt)
#pragma unroll
            for (int q = 0; q < 4; ++q) { const int j = 16 * nt + 4 * fq + q; s1[nt][q] = (i >= j) ? s1[nt][q] : 0.f; }
        __syncthreads();
        stage_scaled(KX, kb, BB, -1.f, 1.f, tid);
        __syncthreads();
        {
            f32x4 s2[8];
#pragma unroll
            for (int nt = 0; nt < 8; ++nt) s2[nt] = (f32x4){0.f, 0.f, 0.f, 0.f};
#pragma unroll
            for (int ks = 0; ks < 4; ++ks) { const bf16x8 xm = frag_row(QB, LDT, 16 * w, 32 * ks, lane);
#pragma unroll
                for (int nt = 0; nt < 8; ++nt) s2[nt] = MFMA16(frag_row(KX, LDT, 16 * nt, 32 * ks, lane), xm, s2[nt]); }
#pragma unroll
            for (int nt = 0; nt < 8; ++nt)
#pragma unroll
                for (int q = 0; q < 4; ++q) { const int j = 16 * nt + 4 * fq + q; s1[nt][q] += (i <= j) ? s2[nt][q] : 0.f; }
        }
        __syncthreads();
#pragma unroll
        for (int nt = 0; nt < 8; ++nt) { u2v o; o.x = pk_bf16(s1[nt][0], s1[nt][1]); o.y = pk_bf16(s1[nt][2], s1[nt][3]); *(LAS u2v*)(KX + i * LDT + 16 * nt + 4 * fq) = o; }
        f32x4 ao[2][8];
#pragma unroll
        for (int hf = 0; hf < 2; ++hf) {
#pragma unroll
            for (int nt = 0; nt < 8; ++nt) ao[hf][nt] = (f32x4){0.f, 0.f, 0.f, 0.f};
            stage_tile(R4, vb + hf * 128, GINP, tid);
            __syncthreads();
#pragma unroll
            for (int ks = 0; ks < 4; ++ks) { const bf16x8 xp = frag_row(KX, LDT, 16 * w, 32 * ks, lane);
#pragma unroll
                for (int nt = 0; nt < 8; ++nt) ao[hf][nt] = MFMA16(frag_tr(R4, LDT, 32 * ks, 16 * nt, lane), xp, ao[hf][nt]); }
            __syncthreads();
            stage_tile(R4, p.GST + gst_idx(0, b, h, c) + (size_t)hf * 128 * 128, 128, tid);
            __syncthreads();
#pragma unroll
            for (int ks = 0; ks < 4; ++ks) { const bf16x8 xq = frag_row(QF, LDT, 16 * w, 32 * ks, lane);
#pragma unroll
                for (int nt = 0; nt < 8; ++nt) ao[hf][nt] = MFMA16(frag_row(R4, LDT, 16 * nt, 32 * ks, lane), xq, ao[hf][nt]); }
            __syncthreads();
            stage_tile(R4, p.GST + gst_idx(1, b, h, c) + (size_t)hf * 128 * 128, 128, tid);
            __syncthreads();
#pragma unroll
            for (int ks = 0; ks < 4; ++ks) { const bf16x8 xq = frag_row(QB, LDT, 16 * w, 32 * ks, lane);
#pragma unroll
                for (int nt = 0; nt < 8; ++nt) ao[hf][nt] = MFMA16(frag_row(R4, LDT, 16 * nt, 32 * ks, lane), xq, ao[hf][nt]); }
            __syncthreads();
        }
        float ss = 0.f;
#pragma unroll
        for (int hf = 0; hf < 2; ++hf)
#pragma unroll
            for (int nt = 0; nt < 8; ++nt) { const f32x4 v = ao[hf][nt]; ss += (v[0] * v[0] + v[1] * v[1]) + (v[2] * v[2] + v[3] * v[3]); }
        ss += __shfl_xor(ss, 16); ss += __shfl_xor(ss, 32);
        const float rs = 1.f / sqrtf(ss * (1.f / 256.f) + LN_EPS);
        const bf16_t* gp = p.Z1 + (size_t)(r0 + i) * GINP + 2048 + h * 256 + 4 * fq; bf16_t* yp = p.H + (size_t)(r0 + i) * D + h * 256 + 4 * fq;
#pragma unroll
        for (int hf = 0; hf < 2; ++hf)
#pragma unroll
            for (int nt = 0; nt < 8; ++nt) { const u2v gu = *(const u2v*)(gp + hf * 128 + 16 * nt);
                const float g0 = __uint_as_float(gu.x << 16), g1 = __uint_as_float(gu.x & 0xffff0000u), g2 = __uint_as_float(gu.y << 16), g3 = __uint_as_float(gu.y & 0xffff0000u);
                u2v o; o.x = pk_bf16(ao[hf][nt][0] * rs * siluf(g0), ao[hf][nt][1] * rs * siluf(g1)); o.y = pk_bf16(ao[hf][nt][2] * rs * siluf(g2), ao[hf][nt][3] * rs * siluf(g3));
                *(u2v*)(yp + hf * 128 + 16 * nt) = o; }
    }
}

template <int MODE> __device__ void tr_w(bf16_t* dst, const float* src, int N, int K, int ldsrc, float* t  , int& tile0, int tile_stride) {
    const int nt_n = N / 64, ntiles = nt_n * (K / 64);
    for (int tile = tile0; tile < ntiles; tile += tile_stride) {
        const int tid = TIDX; const int n0 = (tile % nt_n) * 64, k0 = (tile / nt_n) * 64;
        __syncthreads();
#pragma unroll
        for (int i = 0; i < 8; ++i) { const int e = tid + 512 * i, kk = e >> 6, nn = e & 63; t[kk * 65 + nn] = src[(size_t)(k0 + kk) * ldsrc + n0 + nn]; }
        __syncthreads();
#pragma unroll
        for (int i = 0; i < 4; ++i) { const int e = tid + 512 * i, nn = e >> 5, kp = e & 31; const int n = n0 + nn;
            const int row = MODE == 0 ? n : (8 * (n >> 2) + (n & 3) + (MODE == 2 ? 4 : 0));
            *(unsigned*)(dst + (size_t)row * K + k0 + 2 * kp) = pk_bf16(t[(2 * kp) * 65 + nn], t[(2 * kp + 1) * 65 + nn]); }
    }
    tile0 = tile0 - (ntiles % tile_stride);
    if (tile0 < 0) tile0 += tile_stride;
}
__device__ void ph_wconv_fast(const P& p, float* t) {
    int t0 = blockIdx.x; const int G = gridDim.x;
    tr_w<0>(p.Win0, p.in[8], ABIN, D, ABIN, t, t0, G);
    tr_w<0>(p.Wout0, p.in[22], D, D, D, t, t0, G);
    tr_w<0>(p.Win1, p.in[23], 3072, D, GIN, t, t0, G);
    tr_w<0>(p.Wout1, p.in[28], D, D, D, t, t0, G);
    GSTRIDE(idx, (long)(GINP - 3072) * D) { const int k = idx % D, n = 3072 + idx / D; p.Win1[(size_t)n * D + k] = n < GIN ? f2bf(p.in[23][(size_t)k * GIN + n]) : (bf16_t)0; }
}
__device__ void ph_wconv_moe_fast(const P& p, int l, float* t) {
    int t0 = blockIdx.x; const int G = gridDim.x;
    for (int e = 0; e < NE; ++e) {
        tr_w<1>(p.Wgu + (size_t)e * 1024 * 1024, p.in[31] + (size_t)(l * NE + e) * D * EH, EH, D, EH, t, t0, G);
        tr_w<2>(p.Wgu + (size_t)e * 1024 * 1024, p.in[32] + (size_t)(l * NE + e) * D * EH, EH, D, EH, t, t0, G);
        tr_w<0>(p.Wd + (size_t)e * 1024 * 512, p.in[33] + (size_t)(l * NE + e) * EH * D, D, EH, D, t, t0, G);
    }
}
__device__ void ph_prep_hy_fast(const P& p, float* t  ) {
    const int ntt = RB / 64, ntc = 1536 / 64;
    for (int tile = blockIdx.x; tile < NB * ntt * ntc; tile += gridDim.x) {
        const int tid = TIDX; const int ct = tile % ntc, tt = (tile / ntc) % ntt, b = tile / (ntc * ntt); const int c0 = ct * 64, tl0 = tt * 64;
        const int s0 = tl0 < L ? 0 : L, s1 = tl0 < L ? L : RB;
        __syncthreads();
        for (int e = tid; e < 66 * 64; e += NT) { const int rr = e >> 6, cc = e & 63, tl = tl0 - 1 + rr;
            t[rr * 65 + cc] = (tl >= s0 && tl < s1) ? bf2f(p.Zh[(size_t)bt_row(b, tl) * 1536 + c0 + cc]) : 0.f; }
        __syncthreads();
#pragma unroll
        for (int i = 0; i < 4; ++i) { const int e = tid + 512 * i, cc = e >> 5, tp = e & 31; const int col = c0 + cc;
            const float w0 = p.in[11][col], w1 = p.in[11][1536 + col], w2 = p.in[11][3072 + col], bs = p.in[12][col];
            const float a = bs + w0 * t[(2 * tp) * 65 + cc] + w1 * t[(2 * tp + 1) * 65 + cc] + w2 * t[(2 * tp + 2) * 65 + cc];
            const float c2 = bs + w0 * t[(2 * tp + 1) * 65 + cc] + w1 * t[(2 * tp + 2) * 65 + cc] + w2 * t[(2 * tp + 3) * 65 + cc];
            *(unsigned*)(p.hyT + ((size_t)b * 1536 + col) * RB + tl0 + 2 * tp) = pk_bf16(a, c2); }
    }
}
__device__ void ph_hy_untranspose_fast(const P& p, float* t) {
    const bf16_t* yhT = p.Zh + (size_t)2 * NB * 4 * NCH * 16384;
    const int ntt = RB / 64, ntc = 512 / 64;
    for (int tile = blockIdx.x; tile < NB * ntt * ntc; tile += gridDim.x) {
        const int tid = TIDX; const int ct = tile % ntc, tt = (tile / ntc) % ntt, b = tile / (ntc * ntt); const int c0 = ct * 64, tl0 = tt * 64;
        __syncthreads();
#pragma unroll
        for (int i = 0; i < 8; ++i) { const int e = tid + 512 * i, cc = e >> 6, ti = e & 63; t[cc * 65 + ti] = bf2f(yhT[((size_t)b * 512 + c0 + cc) * RB + tl0 + ti]); }
        __syncthreads();
#pragma unroll
        for (int i = 0; i < 4; ++i) { const int e = tid + 512 * i, ti = e >> 5, cp = e & 31;
            *(unsigned*)(p.H + (size_t)bt_row(b, tl0 + ti) * D + 512 + c0 + 2 * cp) = pk_bf16(t[(2 * cp) * 65 + ti], t[(2 * cp + 1) * 65 + ti]); }
    }
}
__device__ void ph_prep_rope_fast(const P& p) {
    GSTRIDE(idx, (long)R * 2 * 4 * 8) {
        const int pc = idx % 8, h = (idx / 8) % 4, w = (idx / 32) % 2, r = idx / 64;
        bf16_t* base = p.Zr + (size_t)r * 2048 + w * 512 + h * 128 + pc * 8;
        float a[8], c[8]; unpack8(*(const u4v*)base, a); unpack8(*(const u4v*)(base + 64), c);
        const float sc = w ? KSCALE : 1.f;
        if (r < RL) {
            const int t = r % L; const float pos = (pc < 4) ? (float)(t / GW) : (float)(t % GW);
#pragma unroll
            for (int q = 0; q < 8; ++q) { const int pr = pc * 8 + q; const float inv = exp2f(-(float)(pr & 31) * (13.287712379549449f / 32.f));
                float sn, cs; sincosf(pos * inv, &sn, &cs); const float x1 = a[q] * sc, x2 = c[q] * sc; a[q] = x1 * cs - x2 * sn; c[q] = x1 * sn + x2 * cs; }
        } else {
#pragma unroll
            for (int q = 0; q < 8; ++q) { a[q] *= sc; c[q] *= sc; }
        }
        *(u4v*)base = pack8(a); *(u4v*)(base + 64) = pack8(c);
    }
}
__device__ void ph_mod_fast(const P& p, int l, int which, const float* xl  , const float* xc  ) {
    const int lane = TIDX & 63, gw = blockIdx.x * (NT / 64) + (TIDX >> 6), ngw = gridDim.x * (NT / 64);
    for (int r = gw; r < R; r += ngw) {
        const float* x = r < RL ? xl + (size_t)r * D : xc + (size_t)(r - RL) * D; const float* sh = modv(p, l, r, which * 3 + 0); const float* sc = modv(p, l, r, which * 3 + 1);
#pragma unroll
        for (int i = 0; i < 4; ++i) { const int k = 4 * lane + 256 * i; const f32x4 xv = *(const f32x4*)(x + k), s = *(const f32x4*)(sc + k), hh = *(const f32x4*)(sh + k);
            u2v o; o.x = pk_bf16(xv[0] * (1.f + s[0]) + hh[0], xv[1] * (1.f + s[1]) + hh[1]); o.y = pk_bf16(xv[2] * (1.f + s[2]) + hh[2], xv[3] * (1.f + s[3]) + hh[3]);
            *(u2v*)(p.H + (size_t)r * D + k) = o; }
    }
}

__device__ __forceinline__ float wave_sum(float v) {
#pragma unroll
    for (int o = 1; o < 64; o <<= 1) v += __shfl_xor(v, o);
    return v;
}
__device__ void ph_ada_fast(const P& p, float* lds) {
    float* sv = lds;
    float* red = lds + 3072;
    const int tid = TIDX;
    __syncthreads();
    for (int i = tid; i < 3 * D; i += NT) { const int j = i / D, k = i % D; sv[i] = siluf(j < 2 ? p.in[1][j * D + k] : p.in[3][k]); }
    __syncthreads();
    for (int u = blockIdx.x; u < 2 * 96; u += gridDim.x) {
        const int l = u / 96, n = (u % 96) * 64 + (tid & 63), ks = tid >> 6;
        const float* w = p.in[4] + (size_t)l * D * 6144 + n;
        float a0 = 0.f, a1 = 0.f, a2 = 0.f;
#pragma unroll 8
        for (int k = ks * 128; k < ks * 128 + 128; ++k) { const float wv = w[(size_t)k * 6144]; a0 += sv[k] * wv; a1 += sv[D + k] * wv; a2 += sv[2 * D + k] * wv; }
        red[(ks * 3 + 0) * 64 + (tid & 63)] = a0; red[(ks * 3 + 1) * 64 + (tid & 63)] = a1; red[(ks * 3 + 2) * 64 + (tid & 63)] = a2;
        __syncthreads();
        if (tid < 192) { const int j = tid >> 6, nl = tid & 63; float s = p.in[5][l * 6144 + (u % 96) * 64 + nl];
#pragma unroll
            for (int q = 0; q < 8; ++q) s += red[(q * 3 + j) * 64 + nl];
            p.MOD[(size_t)(l * 3 + j) * 6144 + (u % 96) * 64 + nl] = s; }
        __syncthreads();
    }
}
__device__ void ph_hyF_fast(const P& p, const float* a3, float* lds) {
    float* at = lds;
    float* wt = lds + 64 * 65;
    const float mind = logf(1e-2f) / 1.5f, maxd = logf(1e-2f) / 0.3f;
    for (int u = blockIdx.x; u < (RB / 64) * 16; u += gridDim.x) {
        const int tid = TIDX; const int ct = u % 16, pt = u / 16, p0 = pt * 64, c0 = ct * 128;
        __syncthreads();
#pragma unroll
        for (int i = 0; i < 8; ++i) { const int e = tid + 512 * i; at[(e >> 6) * 65 + (e & 63)] = a3[(size_t)(p0 + (e >> 6)) * 64 + (e & 63)]; }
#pragma unroll
        for (int i = 0; i < 16; ++i) { const int e = tid + 512 * i; wt[e] = p.in[19][(size_t)(e >> 7) * 2048 + c0 + (e & 127)]; }
        __syncthreads();
        const int pos = tid & 63, cg = tid >> 6;
        float acc[16];
#pragma unroll
        for (int q = 0; q < 16; ++q) acc[q] = 0.f;
#pragma unroll 4
        for (int m = 0; m < 64; ++m) { const float a = at[pos * 65 + m];
#pragma unroll
            for (int q = 0; q < 16; ++q) acc[q] += a * wt[m * 128 + cg * 16 + q]; }
        int len, i0; hy_pos(p0 + pos, len, i0); const float tt = (float)i0 / (float)(len - 1);
#pragma unroll
        for (int q = 0; q < 16; ++q) { const int col = c0 + cg * 16 + q; const float delta = fabsf(mind + (float)(col % 512) * ((maxd - mind) / 511.f));
            p.FILT[(size_t)col * RB + p0 + pos] = acc[q] * expf(-tt * delta); }
    }
}
__device__ void ph_retScan_fast(const P& p) {
    bf16_t* ST = p.Zh;
    GSTRIDE(idx, (long)2 * NB * 4 * 16384) {
        const int ed = idx % 16384, h = (idx / 16384) % 4, b = (idx / 65536) % NB, dir = idx / (65536 * NB);
        const float dc = expf(p.in[dir ? 10 : 9][h] * 128.f);
        bf16_t* base = ST + st_idx(dir, b, h, 0) + ed;
        float s = 0.f;
#pragma unroll 1
        for (int c0 = 0; c0 < NCH; c0 += 11) {
            float u[11]; int cc[11];
#pragma unroll
            for (int j = 0; j < 11; ++j) { const int q = c0 + j; cc[j] = dir == 0 ? q : (q < 2 ? 1 - q : NCH + 1 - q); u[j] = bf2f(base[(size_t)cc[j] * 16384]); }
#pragma unroll
            for (int j = 0; j < 11; ++j) { base[(size_t)cc[j] * 16384] = f2bf(s); s = dc * s + u[j]; }
        }
    }
}
__device__ void ph_glaScan_fast(const P& p) {
    const float* BF = p.BG; const float* BB = p.BG + (size_t)R * 512;
    GSTRIDE(idx, (long)2 * NB * 4 * 32768) {
        const int d = idx % 128, ed = idx % 32768, h = (idx / 32768) % 4, b = (idx / 131072) % NB, dir = idx / (131072 * NB);
        bf16_t* base = p.GST + gst_idx(dir, b, h, 0) + ed;
        float s = 0.f;
#pragma unroll 1
        for (int c0 = 0; c0 < NCH; c0 += 11) {
            float u[11], dcv[11]; int cc[11];
#pragma unroll
            for (int j = 0; j < 11; ++j) { const int q = c0 + j; cc[j] = dir == 0 ? q : (q < 2 ? 1 - q : NCH + 1 - q); const int r0 = chunk_row0(b, cc[j]);
                u[j] = bf2f(base[(size_t)cc[j] * 32768]); dcv[j] = dir == 0 ? BF[(size_t)(r0 + 127) * 512 + h * 128 + d] : BB[(size_t)r0 * 512 + h * 128 + d]; }
#pragma unroll
            for (int j = 0; j < 11; ++j) { base[(size_t)cc[j] * 32768] = f2bf(s); s = __expf(dcv[j]) * s + u[j]; }
        }
    }
}
__device__ void ph_glagates_fast(const P& p, float* lds) {
    float* lr = lds;
    for (int u = blockIdx.x; u < NB * NCH * 2; u += gridDim.x) {
        const int tid = TIDX; const int dir = u % 2, c = (u / 2) % NCH, b = u / (2 * NCH); const int r0 = chunk_row0(b, c);
        __syncthreads();
        for (int e = tid; e < 128 * 16; e += NT) lr[e] = bf2f(p.Z1[(size_t)(r0 + (e >> 4)) * GINP + 3072 + dir * 16 + (e & 15)]);
        __syncthreads();
        const float* gw = p.in[dir ? 26 : 24]; float g[16];
#pragma unroll
        for (int q = 0; q < 16; ++q) g[q] = gw[q * 512 + tid];
        const float gb = p.in[dir ? 27 : 25][tid];
        float* out = p.BG + ((size_t)dir * R + r0) * 512 + tid;
        float s = 0.f;
#pragma unroll 4
        for (int ii = 0; ii < 128; ++ii) { const int i = dir ? 127 - ii : ii; float acc = gb;
#pragma unroll
            for (int q = 0; q < 16; ++q) acc += lr[i * 16 + q] * g[q];
            s += logsigf(acc) * (1.f / 16.f); out[(size_t)i * 512] = s; }
    }
}
template <int MODE, bool ROUTE> __device__ void ph_post_fast(const P& p, int l, int which, const bf16_t* Y, int ln, int wn, int nrows, const float* xl, const float* xc, float* lds) {
    const float* lg = p.in[6] + (size_t)(l * 2 + which) * D; const float* lb = p.in[7] + (size_t)(l * 2 + which) * D;
    const int tid = TIDX, lane = tid & 63, gw = blockIdx.x * (NT / 64) + (tid >> 6), ngw = gridDim.x * (NT / 64);
    if (ROUTE) { __syncthreads(); for (int e = tid; e < D * NE; e += NT) lds[(e & 15) * D + (e >> 4)] = p.in[29][e]; __syncthreads(); }
    int toff[16];
    if (MODE == 1) { int s = 0;
#pragma unroll
        for (int e = 0; e < 16; ++e) { toff[e] = s; s += (p.CNT[l * 16 + e] + 255) >> 8; } }
    for (int r = gw; r < nrows; r += ngw) {
        const float* x = r < RL ? xl + (size_t)r * D : xc + (size_t)(r - RL) * D; float* xo = xrow(p, r);
        const float* gate = modv(p, l, r, which * 3 + 2);
        const bf16_t *y0, *y1 = nullptr;
        if (MODE == 0) y0 = Y + (size_t)r * D;
        else { int sr[2];
#pragma unroll
            for (int k = 0; k < 2; ++k) { const int e = p.RE[r * 2 + k]; int to = 0;
#pragma unroll
                for (int q = 0; q < 16; ++q) to = (q == e) ? toff[q] : to;
                sr[k] = to * 256 + p.RPOS[r * 2 + k]; }
            y0 = p.slots + (size_t)sr[0] * D; y1 = p.slots + (size_t)sr[1] * D; }
        f32x4 v[4]; float s = 0.f;
#pragma unroll
        for (int i = 0; i < 4; ++i) { const int k = 4 * lane + 256 * i; const f32x4 xv = *(const f32x4*)(x + k), gv = *(const f32x4*)(gate + k);
            const u2v yu = *(const u2v*)(y0 + k); f32x4 yy = {__uint_as_float(yu.x << 16), __uint_as_float(yu.x & 0xffff0000u), __uint_as_float(yu.y << 16), __uint_as_float(yu.y & 0xffff0000u)};
            if (MODE == 1) { const u2v y2 = *(const u2v*)(y1 + k); yy += (f32x4){__uint_as_float(y2.x << 16), __uint_as_float(y2.x & 0xffff0000u), __uint_as_float(y2.y << 16), __uint_as_float(y2.y & 0xffff0000u)}; }
            v[i] = xv * ALPHA + gv * yy; s += (v[i][0] + v[i][1]) + (v[i][2] + v[i][3]); }
        const float mu = wave_sum(s) * (1.f / D); float q2 = 0.f;
#pragma unroll
        for (int i = 0; i < 4; ++i) { v[i] = v[i] - mu; q2 += (v[i][0] * v[i][0] + v[i][1] * v[i][1]) + (v[i][2] * v[i][2] + v[i][3] * v[i][3]); }
        const float rs = 1.f / sqrtf(wave_sum(q2) * (1.f / D) + LN_EPS);
        f32x4 hk[4];
#pragma unroll
        for (int i = 0; i < 4; ++i) { const int k = 4 * lane + 256 * i; const f32x4 xn = v[i] * rs * *(const f32x4*)(lg + k) + *(const f32x4*)(lb + k);
            *(f32x4*)(xo + k) = xn;
            if (ln >= 0) { const f32x4 h2 = xn * (*(const f32x4*)(modv(p, ln, r, wn * 3 + 1) + k) + 1.f) + *(const f32x4*)(modv(p, ln, r, wn * 3 + 0) + k);
                u2v o; o.x = pk_bf16(h2[0], h2[1]); o.y = pk_bf16(h2[2], h2[3]); *(u2v*)(p.H + (size_t)r * D + k) = o;
                if (ROUTE) hk[i] = h2; } }
        if (ROUTE) {
            int best = 0, i1 = 0, i2 = 0; float bs = -1e30f, a1 = 0.f, a2 = 0.f;
#pragma unroll 1
            for (int g = 0; g < NG; ++g) {
                float sg[4], sel[4];
#pragma unroll
                for (int q = 0; q < 4; ++q) { const float* wr = lds + (g * EPG + q) * D + 4 * lane; float a = 0.f;
#pragma unroll
                    for (int i = 0; i < 4; ++i) { const f32x4 wv = *(const f32x4*)(wr + 256 * i); a += (hk[i][0] * wv[0] + hk[i][1] * wv[1]) + (hk[i][2] * wv[2] + hk[i][3] * wv[3]); }
                    sg[q] = sigmf(wave_sum(a)); sel[q] = sg[q] + p.in[30][g * EPG + q]; }
                int j1 = 0; float v1 = sel[0];
#pragma unroll
                for (int q = 1; q < 4; ++q) if (sel[q] > v1) { v1 = sel[q]; j1 = q; }
                int j2 = -1; float v2 = -1e30f;
#pragma unroll
                for (int q = 0; q < 4; ++q) if (q != j1 && sel[q] > v2) { v2 = sel[q]; j2 = q; }
                if (v1 + v2 > bs) { bs = v1 + v2; best = g; i1 = j1; i2 = j2; a1 = 0.f; a2 = 0.f;
#pragma unroll
                    for (int q = 0; q < 4; ++q) { a1 = (q == j1) ? sg[q] : a1; a2 = (q == j2) ? sg[q] : a2; } }
            }
            if (lane == 0) { const int e1 = best * EPG + i1, e2 = best * EPG + i2;
                p.RE[r * 2] = e1; p.RE[r * 2 + 1] = e2; p.RWt[r * 2] = a1 / (a1 + a2); p.RWt[r * 2 + 1] = a2 / (a1 + a2);
                p.RPOS[r * 2] = atomicAdd(&p.CNT[l * 16 + e1], 1); p.RPOS[r * 2 + 1] = atomicAdd(&p.CNT[l * 16 + e2], 1); }
        }
    }
}

constexpr int N_STEPS = 34;
#define PG8_ALIGN true
#define PG8_SP2 true
template <class Epi> __device__ __forceinline__ void dense_gemm(LAS unsigned char* lds, const bf16_t* A, const bf16_t* Bt, int M, int N, int K, const Epi& E) {
    pg8::Gemm g{A, Bt, M, N, K}; pg8::StaticOrder S; S.init(M, N, (int)gridDim.x, (int)blockIdx.x);
    pg8::gemm_phase<Epi, pg8::StaticOrder, PG8_ALIGN, PG8_SP2>(lds, g, S, E);
}
__device__ __forceinline__ void moe_gemms(const P& p, LAS unsigned char* lds, int l, int which) {
    pg8::MoeOrder S; S.init(p.CNT + l * 16, (int)gridDim.x, (int)blockIdx.x);
    if (which == 0) { pg8::Gemm g{p.Hs, p.Wgu, 0, 0, 1024}; pg8::EpiSwiGLU E{p.he}; pg8::gemm_phase<pg8::EpiSwiGLU, pg8::MoeOrder, PG8_ALIGN, PG8_SP2>(lds, g, S, E); }
    else { pg8::Gemm g{p.he, p.Wd, 0, 0, 512}; pg8::EpiRowScale E{p.slots, p.WS}; pg8::gemm_phase<pg8::EpiRowScale, pg8::MoeOrder, PG8_ALIGN, PG8_SP2>(lds, g, S, E); }
}
__device__ __forceinline__ void run_step(const P& p, int step, unsigned char* smem) {
    LAS unsigned char* lds = (LAS unsigned char*)smem; float* fl = (float*)smem;
    float* conv = (float*)p.H;
    switch (step) {
        case 0: ph_ada_fast(p, fl); ph_wconv_fast(p, fl); ph_wconv_moe_fast(p, 0, fl); ph_hyA1(p); break;
        case 1: ph_mod_fast(p, 0, 0, p.in[0], p.in[2]); ph_hyA(p.A1, p.A2, p.in[15], p.in[16], p.in[20] + 64); break;
        case 2: { pg8::EpiSplit E{p.Zr, 2048, p.Zh, 1536, 2048}; dense_gemm(lds, p.H, p.Win0, R, ABIN, D, E); }
                ph_hyA(p.A2, p.A1, p.in[17], p.in[18], p.in[20] + 128); break;
        case 3: ph_prep_rope_fast(p); ph_prep_hy_fast(p, fl); ph_hyF_fast(p, p.A1, fl); break;
        case 4: ph_hyNorm(p, fl); ph_retU_mfma(p, smem); break;
        case 5: ph_retScan_fast(p); ph_hyena_fft(p, smem); break;
        case 6: break;
        case 7: break;
        case 8: break;
        case 9: ph_retO_mfma(p, smem); break;
        case 10: ph_hy_untranspose_fast(p, fl); break;
        case 11: { pg8::EpiSplit E{p.Zr, 1024, p.Zr, 1024, 1 << 30}; dense_gemm(lds, p.H, p.Wout0, R, D, D, E); } break;
        case 12: ph_post_fast<0, true>(p, 0, 0, p.Zr, 0, 1, R, p.in[0], p.in[2], fl); break;
        case 13: break;
        case 14: break;
        case 15: ph_permute(p, 0, R); break;
        case 16: moe_gemms(p, lds, 0, 0); break;
        case 17: moe_gemms(p, lds, 0, 1); break;
        case 18: ph_post_fast<1, false>(p, 0, 1, nullptr, 1, 0, R, p.out, p.Xc, fl); break;
        case 19: { pg8::EpiSplit E{p.Z1, GINP, p.Z1, GINP, 1 << 30}; dense_gemm(lds, p.H, p.Win1, R, GINP, D, E); } ph_wconv_moe_fast(p, 1, fl); break;
        case 20: ph_glagates_fast(p, fl); break;
        case 21: break;
        case 22: ph_glaU_mfma(p, smem); break;
        case 23: ph_glaScan_fast(p); break;
        case 24: ph_glaO_mfma(p, smem); break;
        case 25: break;
        case 26: { pg8::EpiSplit E{p.Zr, 1024, p.Zr, 1024, 1 << 30}; dense_gemm(lds, p.H, p.Wout1, RL, D, D, E); } break;
        case 27: ph_post_fast<0, true>(p, 1, 0, p.Zr, 1, 1, RL, p.out, p.Xc, fl); break;
        case 28: break;
        case 29: break;
        case 30: ph_permute(p, 1, RL); break;
        case 31: moe_gemms(p, lds, 1, 0); break;
        case 32: moe_gemms(p, lds, 1, 1); break;
        case 33: ph_post_fast<1, false>(p, 1, 1, nullptr, -1, 0, RL, p.out, p.Xc, fl); break;
    }
}
__global__ void __launch_bounds__(NT, 2) k_all(P p) {
    extern __shared__ __attribute__((aligned(16))) unsigned char smem[];
    cg::grid_group grid = cg::this_grid();
#define STEP(n) run_step(p, n, smem); asm volatile("s_waitcnt vmcnt(0)" ::: "memory"); grid.sync();
    STEP(0) STEP(1) STEP(2) STEP(3) STEP(4) STEP(5) STEP(9) STEP(10) STEP(11) STEP(12) STEP(15) STEP(16)
    STEP(17) STEP(18) STEP(19) STEP(20) STEP(22) STEP(23) STEP(24) STEP(26) STEP(27) STEP(30) STEP(31) STEP(32) STEP(33)
#undef STEP
}

extern "C" void kernel_launch(void* const* d_in, const int* in_sizes, int n_in, void* d_out, int out_size, void* d_ws, size_t ws_size, hipStream_t stream) {
    P p{};
    for (int i = 0; i < 34; ++i) p.in[i] = (const float*)d_in[i];
    p.out = (float*)d_out;
    unsigned char* w = (unsigned char*)d_ws; size_t off = 0;
    auto take = [&](size_t bytes) { unsigned char* r = w + off; off += (bytes + 255) & ~(size_t)255; return r; };
    p.NORM = (float*)take(2 * 2048 * 4); p.CNT = (int*)take(2 * 16 * 4);
    const size_t ctl_bytes = off;
    p.Win1 = (bf16_t*)take((size_t)GINP * D * 2); p.Wout1 = (bf16_t*)take((size_t)D * D * 2);
    p.Wgu = (bf16_t*)take((size_t)NE * 1024 * 1024 * 2); p.Wd = (bf16_t*)take((size_t)NE * 1024 * 512 * 2);
    p.Xc = (float*)take((size_t)RCX * D * 4); p.MOD = (float*)take(2 * 3 * 6144 * 4);
    p.RS = (float*)take((size_t)R * NE * 4); p.RE = (int*)take((size_t)R * 2 * 4); p.RPOS = (int*)take((size_t)R * 2 * 4); p.RWt = (float*)take((size_t)R * 2 * 4);
    p.WS = (float*)take((size_t)MOE_ROWS * 4);
    const size_t big = off;
    p.H = (bf16_t*)take((size_t)R * D * 2);
    p.Zr = (bf16_t*)take((size_t)R * 2048 * 2);
    p.Zh = (bf16_t*)take((size_t)R * 1536 * 2);
    p.hyT = (bf16_t*)take((size_t)NB * 3 * 512 * RB * 2);
    p.FILT = (float*)take((size_t)2048 * RB * 4);
    p.Win0 = (bf16_t*)take((size_t)ABIN * D * 2); p.Wout0 = (bf16_t*)take((size_t)D * D * 2);
    p.A1 = (float*)take((size_t)RB * 64 * 4); p.A2 = (float*)take((size_t)RB * 64 * 4);
    const size_t total = off;
    off = big + (((size_t)R * D * 2 + 255) & ~(size_t)255);
    p.Hs = (bf16_t*)take((size_t)MOE_ROWS * D * 2); p.he = (bf16_t*)take((size_t)MOE_ROWS * EH * 2); p.slots = (bf16_t*)take((size_t)MOE_ROWS * D * 2);
    const size_t moe_end = off;
    off = big + (((size_t)R * D * 2 + 255) & ~(size_t)255);
    p.Z1 = (bf16_t*)take((size_t)R * GINP * 2); p.BG = (float*)take((size_t)2 * R * 512 * 4); p.GST = (bf16_t*)take((size_t)2 * NB * 4 * NCH * 32768 * 2);
    const size_t l1_end = off;
    if (total > ws_size || moe_end > total || l1_end > total || n_in != 34 || out_size != RL * D) {
        fprintf(stderr, "kernel_launch: bad sizes (need %zu ws bytes, have %zu; moe_end %zu l1_end %zu)\n", total, ws_size, moe_end, l1_end); return; }
    static int grid = 0;
    if (!grid) {
        int dev = 0, cus = 0, per = 0; hipGetDevice(&dev); hipDeviceGetAttribute(&cus, hipDeviceAttributeMultiprocessorCount, dev);
        hipFuncSetAttribute((const void*)k_all, hipFuncAttributeMaxDynamicSharedMemorySize, LDS_BYTES);
        hipOccupancyMaxActiveBlocksPerMultiprocessor(&per, k_all, NT, LDS_BYTES);
        if (per < 1) { fprintf(stderr, "kernel_launch: occupancy query says %d blocks per CU\n", per); per = 1; }
        grid = cus;
    }
    hipMemsetAsync(d_ws, 0, ctl_bytes, stream);
    void* args[] = {&p};
    hipError_t e = hipLaunchCooperativeKernel((void*)k_all, dim3(grid), dim3(NT), args, LDS_BYTES, stream);
    if (e != hipSuccess) fprintf(stderr, "coop launch failed: %s (grid %d)\n", hipGetErrorString(e), grid);
}
```

```cpp
#include <hip/hip_runtime.h>
#include <hip/hip_cooperative_groups.h>
#include <cstdio>
#include <cstdint>
namespace cg = cooperative_groups;


namespace pg8 {
#define PG8_LAS __attribute__((address_space(3)))
typedef unsigned short bf16_t;
typedef short bf16x8 __attribute__((ext_vector_type(8)));
typedef float f32x4 __attribute__((ext_vector_type(4)));
typedef unsigned u32x4 __attribute__((ext_vector_type(4)));
constexpr int BM = 256, BK = 64, HALF = 128, HTB = HALF * BK * 2  , STAGE_BYTES = 8 * HTB, NXCD = 8, WGM = 8;

__host__ __device__ __forceinline__ int lds_byte(int r, int c) { const int st = (r >> 4) * 2 + (c >> 5), rr = r & 15, cc = c & 31, ob = rr * 64 + cc * 2; return st * 1024 + (ob ^ (((ob >> 9) & 1) << 5)); }
__host__ __device__ __forceinline__ void stage_rc(int b, int& R, int& C) { const int st = b / 1024, sb = b % 1024, swz = sb ^ (((sb >> 9) & 1) << 5); R = (st >> 1) * 16 + swz / 64; C = (st & 1) * 32 + (swz % 64) / 2; }
__host__ __device__ __forceinline__ int perm32(int rho) { const int n = rho >> 4, i = rho & 15; return 8 * (i >> 2) + 4 * n + (i & 3); }

struct Unit { int pm, pn; };
struct Gemm { const bf16_t* A; const bf16_t* Bt; int M, N, K; };

struct StaticOrder {
    int nM, nN, nwg, G, c;
    __host__ __device__ void init(int M, int N, int G_, int c_) { nM = M / BM; nN = N / BM; nwg = nM * nN; G = G_; c = c_; }
    __host__ __device__ bool next(int i, Unit& u) const {
        const long L = (long)i * G + c; if (L >= nwg) return false;
        int wgid = (int)L; { const int q = nwg / NXCD, r = nwg % NXCD, xcd = wgid % NXCD, off = wgid / NXCD; wgid = (xcd < r ? xcd * (q + 1) : r * (q + 1) + (xcd - r) * q) + off; }
        const int nig = WGM * nN, gid = wgid / nig, fm = gid * WGM, gsz = (nM - fm) < WGM ? (nM - fm) : WGM;
        u.pm = fm + ((wgid % nig) % gsz); u.pn = (wgid % nig) / gsz; return true;
    }
    __device__ __forceinline__ void a_ready(const Unit&) const {}
    __device__ __forceinline__ void done(const Unit&) const {}
};


__device__ __forceinline__ unsigned cvt_pk_bf16(float lo, float hi) { unsigned r; asm volatile("v_cvt_pk_bf16_f32 %0, %1, %2" : "=v"(r) : "v"(lo), "v"(hi)); return r; }

template <class Epi, class Sched, bool ALIGN_EPI = false, bool SP2 = false>
__device__ __forceinline__ void gemm_phase(PG8_LAS unsigned char* lds, const Gemm g, const Sched& S, const Epi& E) {
    int tid_l = threadIdx.x; asm volatile("" : "+v"(tid_l)); const int tid = tid_l, wid = __builtin_amdgcn_readfirstlane(tid >> 6), lane = tid & 63, wr = wid >> 2, wc = wid & 3, fr = lane & 15, fq = lane >> 4;
    const int K = g.K, nt = K / BK;
    unsigned voffA[2], voffB[2];
#pragma unroll
    for (int i = 0; i < 2; ++i) { int R, C; stage_rc(tid * 16 + i * 8192, R, C); const int Rb = Epi::PERM ? ((R & ~31) + perm32(R & 31)) : R;
        voffA[i] = (unsigned)(R * K + C) * 2u; voffB[i] = (unsigned)(Rb * K + C) * 2u; }
    const size_t kstep = (size_t)(BK * 2);
    const size_t hstep = (size_t)HALF * K * 2;
    const size_t tstep = 2 * hstep;
    const unsigned ldsw = (unsigned)wid * 1024u;
    const int aoff = lds_byte(wr * 64 + fr, fq * 8), boff = lds_byte(wc * 32 + fr, fq * 8);
#define PG8_SA(b, h) (((b) * 2 + (h)) * HTB)
#define PG8_SB(b, h) ((4 + (b) * 2 + (h)) * HTB)
#define PG8_STAGE(bufoff, gbase, voff) do { _Pragma("unroll") for (int _i = 0; _i < 2; ++_i) \
        __builtin_amdgcn_global_load_lds((const unsigned*)((const char*)(gbase) + (voff)[_i]), (PG8_LAS unsigned*)(lds + (bufoff) + ldsw + _i * 8192), 16, 0, 0); } while (0)
#define PG8_LDA(dst, b, h) do { _Pragma("unroll") for (int m = 0; m < 4; ++m) _Pragma("unroll") for (int k = 0; k < 2; ++k) dst[m][k] = *(const PG8_LAS bf16x8*)(lds + PG8_SA(b, h) + aoff + m * 2048 + k * 1024); } while (0)
#define PG8_LDB(dst, b, h) do { _Pragma("unroll") for (int n = 0; n < 2; ++n) _Pragma("unroll") for (int k = 0; k < 2; ++k) dst[n][k] = *(const PG8_LAS bf16x8*)(lds + PG8_SB(b, h) + boff + n * 2048 + k * 1024); } while (0)
#define PG8_MMA(ai, bj, At, Bt) do { __builtin_amdgcn_s_setprio(1); _Pragma("unroll") for (int m = 0; m < 4; ++m) _Pragma("unroll") for (int n = 0; n < 2; ++n) _Pragma("unroll") for (int k = 0; k < 2; ++k) \
        acc[ai][bj][m][n] = __builtin_amdgcn_mfma_f32_16x16x32_bf16(Bt[n][k], At[m][k], acc[ai][bj][m][n], 0, 0, 0); __builtin_amdgcn_s_setprio(0); } while (0)
#define PG8_WAIT_V(n) asm volatile("s_waitcnt vmcnt(" #n ")" ::: "memory")
#define PG8_WAIT_L(n) asm volatile("s_waitcnt lgkmcnt(" #n ")" ::: "memory")
#define PG8_BAR __builtin_amdgcn_s_barrier()
#define PG8_SCHED __builtin_amdgcn_sched_barrier(0)
    Unit cur, nxt; int ui = 0;
    if (!S.next(0, cur)) return;
    f32x4 acc[2][2][4][2];
#pragma unroll
    for (int a = 0; a < 2; ++a)
#pragma unroll
        for (int b = 0; b < 2; ++b)
#pragma unroll
            for (int m = 0; m < 4; ++m)
#pragma unroll
                for (int n = 0; n < 2; ++n) acc[a][b][m][n] = (f32x4){0.f, 0.f, 0.f, 0.f};
    bf16x8 At[4][2], B0[2][2], B1[2][2];
    const char* cA = (const char*)g.A + (size_t)cur.pm * tstep; const char* cB = (const char*)g.Bt + (size_t)cur.pn * tstep;
    S.a_ready(cur);
    if constexpr (SP2) {
        PG8_STAGE(PG8_SB(0, 0), cB, voffB); PG8_STAGE(PG8_SB(0, 1), cB + hstep, voffB); PG8_STAGE(PG8_SA(0, 0), cA, voffA); PG8_STAGE(PG8_SA(0, 1), cA + hstep, voffA);
        if (wr == 1) PG8_BAR;
        PG8_WAIT_V(2); PG8_BAR;
        PG8_STAGE(PG8_SB(1, 0), cB + kstep, voffB); PG8_STAGE(PG8_SA(1, 0), cA + kstep, voffA); PG8_STAGE(PG8_SB(1, 1), cB + hstep + kstep, voffB);
        PG8_WAIT_V(6); PG8_BAR;
    } else {
        PG8_STAGE(PG8_SB(0, 0), cB, voffB); PG8_STAGE(PG8_SA(0, 0), cA, voffA); PG8_STAGE(PG8_SB(0, 1), cB + hstep, voffB); PG8_STAGE(PG8_SA(0, 1), cA + hstep, voffA);
        if (wr == 1) PG8_BAR;
        PG8_WAIT_V(4); PG8_BAR;
        PG8_STAGE(PG8_SB(1, 0), cB + kstep, voffB); PG8_STAGE(PG8_SA(1, 0), cA + kstep, voffA); PG8_STAGE(PG8_SB(1, 1), cB + hstep + kstep, voffB);
        PG8_WAIT_V(6); PG8_BAR;
    }
    for (;;) {
        const bool has_next = S.next(ui + 1, nxt);
        const char* nA = has_next ? (const char*)g.A + (size_t)nxt.pm * tstep : cA; const char* nB = has_next ? (const char*)g.Bt + (size_t)nxt.pn * tstep : cB;
        for (int t = 0; t < nt; t += 2) {
            const bool last = (t == nt - 2);
            const char* a1 = cA + (size_t)(t + 1) * kstep;
            const char* a2 = last ? nA : cA + (size_t)(t + 2) * kstep; const char* b2 = last ? nB : cB + (size_t)(t + 2) * kstep;
            const char* a3 = a2 + kstep; const char* b3 = b2 + kstep;
            if (last && has_next) S.a_ready(nxt);
            if constexpr (SP2) {
            PG8_LDB(B0, 0, 0); PG8_LDB(B1, 0, 1); PG8_SCHED; PG8_LDA(At, 0, 0); PG8_STAGE(PG8_SA(1, 1), a1 + hstep, voffA);
            PG8_WAIT_V(8); PG8_WAIT_L(0); PG8_BAR; PG8_MMA(0, 0, At, B0); PG8_MMA(0, 1, At, B1); PG8_BAR; PG8_SCHED;
            PG8_LDA(At, 0, 1); PG8_STAGE(PG8_SB(0, 0), b2, voffB); PG8_STAGE(PG8_SB(0, 1), b2 + hstep, voffB); PG8_STAGE(PG8_SA(0, 0), a2, voffA);
            PG8_WAIT_V(8); PG8_WAIT_L(0); PG8_BAR; PG8_MMA(1, 0, At, B0); PG8_MMA(1, 1, At, B1); PG8_BAR; PG8_SCHED;
            PG8_LDB(B0, 1, 0); PG8_LDB(B1, 1, 1); PG8_SCHED; PG8_LDA(At, 1, 0); PG8_STAGE(PG8_SA(0, 1), a2 + hstep, voffA);
            PG8_WAIT_V(8); PG8_WAIT_L(0); PG8_BAR; PG8_MMA(0, 0, At, B0); PG8_MMA(0, 1, At, B1); PG8_BAR; PG8_SCHED;
            PG8_LDA(At, 1, 1); PG8_STAGE(PG8_SB(1, 0), b3, voffB); PG8_STAGE(PG8_SB(1, 1), b3 + hstep, voffB); PG8_STAGE(PG8_SA(1, 0), a3, voffA);
            PG8_WAIT_V(8); PG8_WAIT_L(0); PG8_BAR; PG8_MMA(1, 0, At, B0); PG8_MMA(1, 1, At, B1); PG8_BAR; PG8_SCHED;
            } else {
            PG8_LDB(B0, 0, 0); PG8_SCHED; PG8_LDA(At, 0, 0); PG8_STAGE(PG8_SA(1, 1), a1 + hstep, voffA);
            PG8_WAIT_L(8); PG8_BAR; PG8_WAIT_L(0); PG8_MMA(0, 0, At, B0); PG8_BAR; PG8_SCHED;
            PG8_LDB(B1, 0, 1); PG8_STAGE(PG8_SB(0, 0), b2, voffB);
            PG8_BAR; PG8_WAIT_L(0); PG8_MMA(0, 1, At, B1); PG8_BAR;
            PG8_LDA(At, 0, 1); PG8_STAGE(PG8_SA(0, 0), a2, voffA);
            PG8_BAR; PG8_WAIT_L(0); PG8_MMA(1, 0, At, B0); PG8_BAR; PG8_SCHED;
            PG8_STAGE(PG8_SB(0, 1), b2 + hstep, voffB);
            PG8_WAIT_V(6); PG8_BAR; PG8_MMA(1, 1, At, B1); PG8_BAR;
            PG8_LDB(B0, 1, 0); PG8_SCHED; PG8_LDA(At, 1, 0); PG8_STAGE(PG8_SA(0, 1), a2 + hstep, voffA);
            PG8_WAIT_L(8); PG8_BAR; PG8_WAIT_L(0); PG8_MMA(0, 0, At, B0); PG8_BAR; PG8_SCHED;
            PG8_LDB(B1, 1, 1); PG8_STAGE(PG8_SB(1, 0), b3, voffB);
            PG8_BAR; PG8_WAIT_L(0); PG8_MMA(0, 1, At, B1); PG8_BAR;
            PG8_LDA(At, 1, 1); PG8_STAGE(PG8_SA(1, 0), a3, voffA);
            PG8_BAR; PG8_WAIT_L(0); PG8_MMA(1, 0, At, B0); PG8_BAR; PG8_SCHED;
            PG8_STAGE(PG8_SB(1, 1), b3 + hstep, voffB);
            PG8_WAIT_V(6); PG8_BAR; PG8_MMA(1, 1, At, B1); PG8_BAR;
            }
        }
        if constexpr (ALIGN_EPI) { if (wr == 0) PG8_BAR; }
        if constexpr (!Epi::AFTER_DRAIN) { E(acc, cur, wr, wc, fr, fq); S.done(cur); }
        if (!has_next) break;
#pragma unroll
        for (int a = 0; a < 2; ++a)
#pragma unroll
            for (int b = 0; b < 2; ++b)
#pragma unroll
                for (int m = 0; m < 4; ++m)
#pragma unroll
                    for (int n = 0; n < 2; ++n) acc[a][b][m][n] = (f32x4){0.f, 0.f, 0.f, 0.f};
        cur = nxt; cA = nA; cB = nB; ++ui;
        if constexpr (ALIGN_EPI) { if (wr == 1) PG8_BAR; }
    }
    PG8_WAIT_V(0);
    if constexpr (!ALIGN_EPI) { if (wr == 0) PG8_BAR; }
    PG8_BAR;
    if constexpr (Epi::AFTER_DRAIN) { E.fused(acc, cur, wr, wc, fr, fq, lds, wid, lane); S.done(cur); }
#undef PG8_SA
#undef PG8_SB
#undef PG8_STAGE
#undef PG8_LDA
#undef PG8_LDB
#undef PG8_MMA
#undef PG8_WAIT_V
#undef PG8_WAIT_L
#undef PG8_BAR
#undef PG8_SCHED
}
}

typedef float f2v_t __attribute__((ext_vector_type(2)));
typedef __bf16 b2v_t __attribute__((ext_vector_type(2)));
__device__ __forceinline__ unsigned pk_bf16(float lo, float hi) { const f2v_t f = {lo, hi}; const b2v_t b = __builtin_convertvector(f, b2v_t); return __builtin_bit_cast(unsigned, b); }
namespace pg8 {
typedef unsigned u32x2 __attribute__((ext_vector_type(2)));
struct EpiSplit {
    static constexpr bool PERM = true, AFTER_DRAIN = false;
    bf16_t* O0; int ld0; bf16_t* O1; int ld1; int split_col;
    __device__ __forceinline__ void operator()(const f32x4 (&acc)[2][2][4][2], const Unit& u, int wr, int wc, int fr, int fq) const {
        const int row0 = u.pm * BM + wr * 64 + fr; int colt = u.pn * BM; bf16_t* base = O0; int ldc = ld0;
        if (colt >= split_col) { base = O1; ldc = ld1; colt -= split_col; }
        const int col0 = colt + wc * 32 + 8 * fq;
#pragma unroll
        for (int ai = 0; ai < 2; ++ai)
#pragma unroll
            for (int m = 0; m < 4; ++m) { bf16_t* rowp = base + (size_t)(row0 + ai * HALF + m * 16) * ldc + col0;
#pragma unroll
                for (int bj = 0; bj < 2; ++bj) { const f32x4 v0 = acc[ai][bj][m][0], v1 = acc[ai][bj][m][1];
                    u32x4 w; w.x = ::pk_bf16(v0[0], v0[1]); w.y = ::pk_bf16(v0[2], v0[3]); w.z = ::pk_bf16(v1[0], v1[1]); w.w = ::pk_bf16(v1[2], v1[3]);
                    *(u32x4*)(rowp + bj * HALF) = w; } }
    }
};
struct EpiSwiGLU {
    static constexpr bool PERM = true, AFTER_DRAIN = false;
    bf16_t* O;
    __device__ __forceinline__ void operator()(const f32x4 (&acc)[2][2][4][2], const Unit& u, int wr, int wc, int fr, int fq) const {
        const int row0 = u.pm * BM + wr * 64 + fr; const int j0 = (u.pn & 3) * 128 + wc * 16 + 4 * fq;
#pragma unroll
        for (int ai = 0; ai < 2; ++ai)
#pragma unroll
            for (int m = 0; m < 4; ++m) { bf16_t* rowp = O + (size_t)(row0 + ai * HALF + m * 16) * 512 + j0;
#pragma unroll
                for (int bj = 0; bj < 2; ++bj) { const f32x4 g = acc[ai][bj][m][0], up = acc[ai][bj][m][1]; float h[4];
#pragma unroll
                    for (int q = 0; q < 4; ++q) h[q] = g[q] / (1.f + __expf(-g[q])) * up[q];
                    u32x2 w; w.x = ::pk_bf16(h[0], h[1]); w.y = ::pk_bf16(h[2], h[3]);
                    *(u32x2*)(rowp + bj * 64) = w; } }
    }
};
struct EpiRowScale {
    static constexpr bool PERM = true, AFTER_DRAIN = false;
    bf16_t* O; const float* ws;
    __device__ __forceinline__ void operator()(const f32x4 (&acc)[2][2][4][2], const Unit& u, int wr, int wc, int fr, int fq) const {
        const int row0 = u.pm * BM + wr * 64 + fr; const int col0 = (u.pn & 3) * BM + wc * 32 + 8 * fq;
#pragma unroll
        for (int ai = 0; ai < 2; ++ai)
#pragma unroll
            for (int m = 0; m < 4; ++m) { const int row = row0 + ai * HALF + m * 16; const float s = ws[row]; bf16_t* rowp = O + (size_t)row * 1024 + col0;
#pragma unroll
                for (int bj = 0; bj < 2; ++bj) { const f32x4 v0 = acc[ai][bj][m][0] * s, v1 = acc[ai][bj][m][1] * s;
                    u32x4 w; w.x = ::pk_bf16(v0[0], v0[1]); w.y = ::pk_bf16(v0[2], v0[3]); w.z = ::pk_bf16(v1[0], v1[1]); w.w = ::pk_bf16(v1[2], v1[3]);
                    *(u32x4*)(rowp + bj * HALF) = w; } }
    }
};
struct MoeOrder {
    int G, c, nt; int toff[16];
    __device__ __forceinline__ void init(const int* cnt, int G_, int c_) { G = G_; c = c_; int s = 0;
#pragma unroll
        for (int e = 0; e < 16; ++e) { toff[e] = s; s += (cnt[e] + 255) >> 8; } nt = s; }
    __device__ __forceinline__ bool next(int i, Unit& u) const {
        const int Lq = i * G + c; if (Lq >= nt * 4) return false;
        const int pm = Lq % nt, pn4 = Lq / nt; int e = 0;
#pragma unroll
        for (int q = 1; q < 16; ++q) e += (pm >= toff[q]) ? 1 : 0;
        u.pm = pm; u.pn = e * 4 + pn4; return true; }
    __device__ __forceinline__ void a_ready(const Unit&) const {}
    __device__ __forceinline__ void done(const Unit&) const {}
};
}

constexpr int NB = 2, L = 8192, D = 1024, CTX = 256, RB = L + CTX;
constexpr int RL = NB * L, RCX = NB * CTX, R = RL + RCX;
constexpr int GW = 64;
constexpr int NCH = 66;
constexpr int ABIN = 3584, GIN = 3104, GINP = 3328;
constexpr int NE = 16, NG = 4, EPG = 4, EH = 512;
constexpr int MOE_ROWS = 37888;
constexpr float ALPHA = 1.4142135623730951f, LN_EPS = 1e-5f, KSCALE = 0.08838834764831845f;
constexpr int NT = 512;
constexpr int LDS_BYTES = 147456;

typedef unsigned short bf16_t;
#define LAS __attribute__((address_space(3)))
__device__ __forceinline__ float bf2f(bf16_t v) { return __uint_as_float((unsigned)v << 16); }
__device__ __forceinline__ bf16_t f2bf(float f) { unsigned u = __float_as_uint(f); return (bf16_t)((u + 0x7fffu + ((u >> 16) & 1u)) >> 16); }
__device__ __forceinline__ float siluf(float x) { return x / (1.f + expf(-x)); }
__device__ __forceinline__ float sigmf(float x) { return 1.f / (1.f + expf(-x)); }
__device__ __forceinline__ float logsigf(float x) { return fminf(x, 0.f) - log1pf(expf(-fabsf(x))); }

struct P {
    const float* in[34];
    float* out;
    float* Xc;
    float* MOD;
    float* NORM;
    int* CNT;
    unsigned* BAR;
    float* A1; float* A2;
    float* RS; int* RE; int* RPOS; float* RWt; float* WS;
    bf16_t *Win0, *Wout0, *Win1, *Wout1, *Wgu, *Wd;
    bf16_t* H;
    bf16_t* Zr;
    bf16_t* Zh;
    bf16_t* hyT;
    float* FILT;
    bf16_t *Hs, *he, *slots;
    bf16_t* Z1;
    float* BG;
    bf16_t* GST;
};

__device__ __forceinline__ int launder_i(int x) { asm volatile("" : "+v"(x)); return x; }
#define TIDX launder_i((int)threadIdx.x)
#define GSTRIDE(i, n) for (long i = (long)blockIdx.x * blockDim.x + TIDX; i < (long)(n); i += (long)gridDim.x * blockDim.x)

__device__ __forceinline__ float* xrow(const P& p, int r) { return r < RL ? p.out + (size_t)r * D : p.Xc + (size_t)(r - RL) * D; }
__device__ __forceinline__ int seg_of(int r) { return r < RL ? r / L : 2; }
__device__ __forceinline__ const float* modv(const P& p, int l, int r, int chunk) { return p.MOD + ((size_t)(l * 3 + seg_of(r)) * 6 + chunk) * D; }
__device__ __forceinline__ int chunk_row0(int b, int c) { return c < 2 ? RL + b * CTX + c * 128 : b * L + (c - 2) * 128; }
__device__ __forceinline__ void row_bt(int r, int& b, int& tl) { if (r < RL) { b = r / L; tl = r % L; } else { b = (r - RL) / CTX; tl = L + (r - RL) % CTX; } }
__device__ __forceinline__ int bt_row(int b, int tl) { return tl < L ? b * L + tl : RL + b * CTX + (tl - L); }

#define XB_TMO      128
#define XB_XCNT(j)  (256  + 64 * (j))
#define XB_XSUB(j)  (1280 + 64 * (j))
#define XB_XGEN(j)  (2304 + 64 * (j))
#define XB_TOP      3328
#define XB_TOPGEN   3392
#define XCD_BAR_WORDS 3456
#define XB_SPIN_CAP (1u << 18)

__device__ __forceinline__ unsigned xb_ld(unsigned* p)              { return __hip_atomic_load(p, __ATOMIC_RELAXED, __HIP_MEMORY_SCOPE_AGENT); }
__device__ __forceinline__ unsigned xb_add(unsigned* p, unsigned v) { return __hip_atomic_fetch_add(p, v, __ATOMIC_RELAXED, __HIP_MEMORY_SCOPE_AGENT); }
__device__ __forceinline__ unsigned xb_xcc_id() { return (unsigned)__builtin_amdgcn_s_getreg((3 << 11) | 20) & 0xFu; }
#define XB_SPIN(cond, bar) do { unsigned _sp = 0; while (cond) { __builtin_amdgcn_s_sleep(1); \
    if ((++_sp & 255u) == 0u) { if (xb_ld(&(bar)[XB_TMO])) break; if (_sp > XB_SPIN_CAP) { atomicAdd(&(bar)[XB_TMO], 1u); break; } } } } while (0)

struct XcdBarrier {
    unsigned* bar; unsigned x;
    volatile LAS unsigned* st;
};

__device__ __forceinline__ XcdBarrier xcd_barrier_post(unsigned* bar, volatile LAS unsigned* st) {
    XcdBarrier b; b.bar = bar; b.x = xb_xcc_id(); b.st = st;
    if (threadIdx.x == 0) (void)xb_add(&bar[XB_XCNT(b.x)], 1u);
    return b;
}
__device__ __forceinline__ void xcd_barrier_complete(unsigned* bar, unsigned x, unsigned& nloc, unsigned& nx) {
    const unsigned G = gridDim.x * gridDim.y * gridDim.z;
    unsigned sum, cnt, mine, sp = 0u;
    for (;;) {
        sum = 0u; cnt = 0u; mine = 0u;
#pragma unroll
        for (unsigned j = 0; j < 16; ++j) { const unsigned c = xb_ld(&bar[XB_XCNT(j)]); sum += c; cnt += (c > 0u) ? 1u : 0u; mine = (j == x) ? c : mine; }
        if (sum == G) break;
        __builtin_amdgcn_s_sleep(1);
        if ((++sp & 255u) == 0u) { if (xb_ld(&bar[XB_TMO])) break; if (sp > XB_SPIN_CAP) { atomicAdd(&bar[XB_TMO], 1u); break; } }
    }
    nloc = mine > 0u ? mine : 1u; nx = cnt > 0u ? cnt : 1u;
}

__device__ __forceinline__ void xcd_barrier(const XcdBarrier& b) {
    asm volatile("s_waitcnt vmcnt(0)" ::: "memory");
    __syncthreads();
    if (threadIdx.x == 0) {
        unsigned* bar = b.bar;
        __builtin_amdgcn_s_waitcnt(0);
        unsigned nloc = b.st[0], nx = b.st[1];
        if (nloc == 0u) { xcd_barrier_complete(bar, b.x, nloc, nx); b.st[0] = nloc; b.st[1] = nx; }
        const unsigned old = xb_add(&bar[XB_XSUB(b.x)], 1u);
        const unsigned gen = old / nloc;
        if (old + 1u == (gen + 1u) * nloc) {
            __builtin_amdgcn_fence(__ATOMIC_RELEASE, "agent");
            asm volatile("s_waitcnt vmcnt(0)" ::: "memory");
            const unsigned og = xb_add(&bar[XB_TOP], 1u);
            const unsigned tg = og / nx;
            if (og + 1u == (tg + 1u) * nx) xb_add(&bar[XB_TOPGEN], 1u);
            else XB_SPIN(xb_ld(&bar[XB_TOPGEN]) == tg, bar);
            __builtin_amdgcn_fence(__ATOMIC_ACQUIRE, "agent");
            xb_add(&bar[XB_XGEN(b.x)], 1u);
            asm volatile("s_waitcnt vmcnt(0)" ::: "memory");
        } else {
            XB_SPIN(xb_ld(&bar[XB_XGEN(b.x)]) == gen, bar);
            __builtin_amdgcn_fence(__ATOMIC_ACQUIRE, "agent");
            asm volatile("s_waitcnt vmcnt(0)" ::: "memory");
        }
    }
    __syncthreads();
}

__device__ __forceinline__ void ph_wconv(bf16_t* dst, const float* src, int N, int K, int ldsrc, int nvalid) {
    GSTRIDE(idx, (long)N * K) { const int k = idx % K, n = idx / K; dst[idx] = n < nvalid ? f2bf(src[(size_t)k * ldsrc + n]) : (bf16_t)0; }
}
__device__ __forceinline__ void ph_wconv_moe(const P& p, int l) {
    GSTRIDE(idx, (long)NE * 1024 * 1024) {
        const int k = idx % 1024, n = (idx / 1024) % 1024, e = idx / (1024 * 1024);
        const int q = n >> 3, r = n & 7, j = 4 * q + (r & 3);
        const float* src = (r < 4 ? p.in[31] : p.in[32]) + ((size_t)(l * NE + e) * D + k) * EH + j;
        p.Wgu[idx] = f2bf(*src);
    }
    GSTRIDE(idx, (long)NE * 1024 * 512) {
        const int k = idx % 512, n = (idx / 512) % 1024, e = idx / (512 * 1024);
        p.Wd[idx] = f2bf(p.in[33][((size_t)(l * NE + e) * EH + k) * D + n]);
    }
}
__device__ __forceinline__ void ph_ada(const P& p) {
    GSTRIDE(idx, 2 * 3 * 6144) {
        const int n = idx % 6144, j = (idx / 6144) % 3, l = idx / (3 * 6144);
        const float* cv = j < 2 ? p.in[1] + j * D : p.in[3];
        const float* w = p.in[4] + (size_t)l * D * 6144;
        float acc = p.in[5][l * 6144 + n];
        for (int k = 0; k < D; ++k) acc += siluf(cv[k]) * w[(size_t)k * 6144 + n];
        p.MOD[idx] = acc;
    }
}
__device__ __forceinline__ void ph_init(const P& p) {
    GSTRIDE(i, (long)RL * D) p.out[i] = p.in[0][i];
    GSTRIDE(i, (long)RCX * D) p.Xc[i] = p.in[2][i];
}
__device__ __forceinline__ void hy_pos(int pidx, int& len, int& i) { if (pidx < L) { len = L; i = pidx; } else { len = CTX; i = pidx - L; } }
__device__ __forceinline__ void ph_hyA1(const P& p) {
    GSTRIDE(idx, (long)RB * 64) {
        const int j = idx % 64, pidx = idx / 64; int len, i; hy_pos(pidx, len, i);
        const float t = (float)i / (float)(len - 1);
        const float w = 2.0f * 3.14159265358979323846f * (float)i / (float)len;
        const float* w1 = p.in[13];
        float acc = p.in[14][j] + t * w1[j];
        for (int m = 0; m < 16; ++m) {
            const float f = 1e-4f + (float)m * ((15.f - 1e-4f) / 15.f);
            acc += cosf(f * w) * w1[(1 + m) * 64 + j] - sinf(f * w) * w1[(17 + m) * 64 + j];
        }
        p.A1[idx] = sinf(p.in[20][j] * acc);
    }
}
__device__ __forceinline__ void ph_hyA(const float* src, float* dst, const float* w, const float* bias, const float* freq) {
    GSTRIDE(idx, (long)RB * 64) {
        const int j = idx % 64, pidx = idx / 64;
        float acc = bias[j];
        for (int i = 0; i < 64; ++i) acc += src[(size_t)pidx * 64 + i] * w[i * 64 + j];
        dst[idx] = sinf(freq[j] * acc);
    }
}
__device__ __forceinline__ void ph_hyF(const P& p, const float* a3) {
    const float mind = logf(1e-2f) / 1.5f, maxd = logf(1e-2f) / 0.3f;
    GSTRIDE(idx, (long)2048 * RB) {
        const int pidx = idx % RB, col = idx / RB, ch = col % 512; int len, i; hy_pos(pidx, len, i);
        const float t = (float)i / (float)(len - 1);
        float acc = 0.f;
        for (int m = 0; m < 64; ++m) acc += a3[(size_t)pidx * 64 + m] * p.in[19][m * 2048 + col];
        const float delta = fabsf(mind + (float)ch * ((maxd - mind) / 511.f));
        p.FILT[idx] = acc * expf(-t * delta);
    }
}
__device__ __forceinline__ float block_sum(float v, float* red);
__device__ __forceinline__ void ph_hyNorm(const P& p, float* red) {
    for (int u = blockIdx.x; u < 2 * 2048; u += gridDim.x) {
        const int col = u % 2048, which = u / 2048; const int p0 = which ? L : 0, n = which ? CTX : L;
        float s = 0.f;
        for (int i = TIDX; i < n; i += NT) { const float v = p.FILT[(size_t)col * RB + p0 + i]; s += v * v; }
        const float t = block_sum(s, red);
        if (TIDX == 0) p.NORM[which * 2048 + col] = t;
    }
}
__device__ __forceinline__ void ph_mod(const P& p, int l, int which) {
    GSTRIDE(i, (long)R * D) {
        const int r = i / D, k = i % D;
        p.H[i] = f2bf(xrow(p, r)[k] * (1.f + modv(p, l, r, which * 3 + 1)[k]) + modv(p, l, r, which * 3 + 0)[k]);
    }
}
__device__ __forceinline__ void ph_prep_rope(const P& p) {
    GSTRIDE(i, (long)R * 2 * 4 * 64) {
        const int pr = i % 64, h = (i / 64) % 4, w = (i / 256) % 2, r = i / 512;
        bf16_t* base = p.Zr + (size_t)r * 2048 + w * 512 + h * 128;
        float t1 = bf2f(base[pr]), t2 = bf2f(base[64 + pr]);
        if (w == 1) { t1 *= KSCALE; t2 *= KSCALE; }
        if (r < RL) {
            const int t = r % L, row = t / GW, col = t % GW;
            const float inv = powf(10000.f, -(float)(pr & 31) / 32.f);
            const float ang = (pr < 32 ? (float)row : (float)col) * inv;
            float sn, cs; sincosf(ang, &sn, &cs);
            const float a = t1 * cs - t2 * sn, bb = t1 * sn + t2 * cs; t1 = a; t2 = bb;
        }
        base[pr] = f2bf(t1); base[64 + pr] = f2bf(t2);
    }
}
__device__ __forceinline__ void ph_prep_hy(const P& p) {
    GSTRIDE(idx, (long)NB * 1536 * RB) {
        const int tl = idx % RB, col = (idx / RB) % 1536, b = idx / (RB * 1536);
        const int s0 = tl < L ? 0 : L, s1 = tl < L ? L : RB;
        const float* w = p.in[11];
        float acc = p.in[12][col] + w[1536 + col] * bf2f(p.Zh[(size_t)bt_row(b, tl) * 1536 + col]);
        if (tl - 1 >= s0) acc += w[col] * bf2f(p.Zh[(size_t)bt_row(b, tl - 1) * 1536 + col]);
        if (tl + 1 < s1) acc += w[2 * 1536 + col] * bf2f(p.Zh[(size_t)bt_row(b, tl + 1) * 1536 + col]);
        p.hyT[idx] = f2bf(acc);
    }
}
__device__ __forceinline__ float hy_tapT(const float* Ff, const float* Fb, float nf, float nb, int d) {
    if (d > 0) return Ff[d] * nf; if (d < 0) return Fb[-d] * nb; return Ff[0] * nf + Fb[0] * nb;
}
__device__ __forceinline__ void ph_hyconv_naive(const P& p, int n, float* conv) {
    GSTRIDE(idx, (long)NB * 512 * (RB / 4)) {
        const int tb = idx % (RB / 4), ch = (idx / (RB / 4)) % 512, b = idx / ((RB / 4) * 512);
        const int tl0 = tb * 4, s0 = tl0 < L ? 0 : L, len = tl0 < L ? L : CTX, nrm = tl0 < L ? 0 : 1, t0 = tl0 - s0;
        const int cf = (n * 2 + 0) * 512 + ch, cb = (n * 2 + 1) * 512 + ch;
        const float nf = 1.f / sqrtf(p.NORM[nrm * 2048 + cf]), nb = 1.f / sqrtf(p.NORM[nrm * 2048 + cb]);
        const float* Ff = p.FILT + (size_t)cf * RB + s0; const float* Fb = p.FILT + (size_t)cb * RB + s0;
        const bf16_t* z = p.hyT + ((size_t)(b * 3 + 2) * 512 + ch) * RB + s0;
        float w0 = hy_tapT(Ff, Fb, nf, nb, t0), w1 = hy_tapT(Ff, Fb, nf, nb, t0 + 1), w2 = hy_tapT(Ff, Fb, nf, nb, t0 + 2), w3 = hy_tapT(Ff, Fb, nf, nb, t0 + 3);
        float a0 = 0.f, a1 = 0.f, a2 = 0.f, a3 = 0.f;
        for (int s = 0; s < len; ++s) {
            const float zz = bf2f(z[s]);
            a0 += w0 * zz; a1 += w1 * zz; a2 += w2 * zz; a3 += w3 * zz;
            w3 = w2; w2 = w1; w1 = w0;
            if (s + 1 < len) w0 = hy_tapT(Ff, Fb, nf, nb, t0 - (s + 1));
        }
        float* o = conv + ((size_t)b * 512 + ch) * RB + tl0; o[0] = a0; o[1] = a1; o[2] = a2; o[3] = a3;
    }
}
__device__ __forceinline__ void ph_hygate_naive(const P& p, int n, const float* conv) {
    bf16_t* yhT = p.Zh + (size_t)2 * NB * 4 * NCH * 16384;
    GSTRIDE(idx, (long)NB * 512 * RB) {
        const int tl = idx % RB, ch = (idx / RB) % 512, b = idx / (RB * 512);
        bf16_t* z = p.hyT + ((size_t)(b * 3 + 2) * 512 + ch) * RB + tl; const float gate = bf2f(p.hyT[((size_t)(b * 3 + n) * 512 + ch) * RB + tl]);
        const float r = gate * (conv[idx] + p.in[21][n * 512 + ch] * bf2f(*z));
        if (n == 0) *z = f2bf(r); else yhT[idx] = f2bf(r);
    }
}
__device__ __forceinline__ void ph_hy_untranspose(const P& p) {
    const bf16_t* yhT = p.Zh + (size_t)2 * NB * 4 * NCH * 16384;
    GSTRIDE(idx, (long)R * 512) { const int ch = idx % 512, r = idx / 512; int b, tl; row_bt(r, b, tl); p.H[(size_t)r * D + 512 + ch] = yhT[((size_t)b * 512 + ch) * RB + tl]; }
}
__device__ __forceinline__ size_t st_idx(int dir, int b, int h, int c) { return ((((size_t)dir * NB + b) * 4 + h) * NCH + c) * 16384; }
__device__ __forceinline__ void ph_retU_naive(const P& p) {
    bf16_t* ST = p.Zh;
    GSTRIDE(idx, (long)NB * 4 * NCH * 16384) {
        const int d = idx % 128, e = (idx / 128) % 128, c = (idx / 16384) % NCH, h = (idx / (16384 * NCH)) % 4, b = idx / (16384 * NCH * 4);
        const float lgf = p.in[9][h], lgb = p.in[10][h]; const int r0 = chunk_row0(b, c);
        float uf = 0.f, ub = 0.f;
        for (int j = 0; j < 128; ++j) {
            const float kk = bf2f(p.Zr[(size_t)(r0 + j) * 2048 + 512 + h * 128 + d]), vv = bf2f(p.Zr[(size_t)(r0 + j) * 2048 + 1024 + h * 128 + e]);
            uf += kk * expf(lgf * (float)(127 - j)) * vv; ub += kk * expf(lgb * (float)j) * vv;
        }
        ST[st_idx(0, b, h, c) + e * 128 + d] = f2bf(uf); ST[st_idx(1, b, h, c) + e * 128 + d] = f2bf(ub);
    }
}
__device__ __forceinline__ void ph_retScan(const P& p) {
    bf16_t* ST = p.Zh;
    GSTRIDE(idx, (long)2 * NB * 4 * 16384) {
        const int ed = idx % 16384, h = (idx / 16384) % 4, b = (idx / 65536) % NB, dir = idx / (65536 * NB);
        const float dc = expf((dir ? p.in[10] : p.in[9])[h] * 128.f);
        float s = 0.f;
        for (int cc = 0; cc < NCH; ++cc) {
            const int c = dir == 0 ? cc : (cc < 2 ? 1 - cc : NCH + 1 - cc);
            bf16_t* q = ST + st_idx(dir, b, h, c) + ed; const float u = bf2f(*q); *q = f2bf(s); s = dc * s + u;
        }
    }
}
__device__ __forceinline__ void ph_retO_naive(const P& p, float* lds) {
    const bf16_t* ST = p.Zh;
    for (int u = blockIdx.x; u < NB * 4 * NCH; u += gridDim.x) {
        const int c = u % NCH, h = (u / NCH) % 4, b = u / (NCH * 4); const int r0 = chunk_row0(b, c);
        const float lgf = p.in[9][h], lgb = p.in[10][h];
        __syncthreads();
        for (int e = TIDX; e < 128 * 128; e += NT) {
            const int j = e % 128, i = e / 128;
            const bf16_t* q = p.Zr + (size_t)(r0 + i) * 2048 + h * 128; const bf16_t* k = p.Zr + (size_t)(r0 + j) * 2048 + 512 + h * 128;
            float s = 0.f; for (int d = 0; d < 128; ++d) s += bf2f(q[d]) * bf2f(k[d]);
            const float m = i > j ? expf(lgf * (float)(i - j)) : (j > i ? expf(lgb * (float)(j - i)) : 2.f);
            lds[e] = s * m;
        }
        __syncthreads();
        const bf16_t* sf = ST + st_idx(0, b, h, c); const bf16_t* sb = ST + st_idx(1, b, h, c);
        for (int e2 = TIDX; e2 < 128 * 128; e2 += NT) {
            const int e = e2 % 128, i = e2 / 128;
            float o = 0.f; for (int j = 0; j < 128; ++j) o += lds[i * 128 + j] * bf2f(p.Zr[(size_t)(r0 + j) * 2048 + 1024 + h * 128 + e]);
            const bf16_t* q = p.Zr + (size_t)(r0 + i) * 2048 + h * 128;
            float of = 0.f, ob = 0.f; for (int d = 0; d < 128; ++d) { const float qq = bf2f(q[d]); of += qq * bf2f(sf[e * 128 + d]); ob += qq * bf2f(sb[e * 128 + d]); }
            p.H[(size_t)(r0 + i) * D + h * 128 + e] = f2bf(o + expf(lgf * (float)(i + 1)) * of + expf(lgb * (float)(128 - i)) * ob);
        }
    }
}
__device__ __forceinline__ void ph_retNorm_naive(const P& p) {
    GSTRIDE(idx, (long)R * 4) {
        const int h = idx % 4, r = idx / 4; bf16_t* o = p.H + (size_t)r * D + h * 128;
        float mu = 0.f; for (int e = 0; e < 128; ++e) mu += bf2f(o[e]); mu *= (1.f / 128.f);
        float var = 0.f; for (int e = 0; e < 128; ++e) { const float d = bf2f(o[e]) - mu; var += d * d; } var *= (1.f / 128.f);
        const float rs = 1.f / sqrtf(var + LN_EPS);
        for (int e = 0; e < 128; ++e) o[e] = f2bf((bf2f(o[e]) - mu) * rs * siluf(bf2f(p.Zr[(size_t)r * 2048 + 1536 + h * 128 + e])));
    }
}
__device__ __forceinline__ float block_sum(float v, float* red) {
    __syncthreads();
#pragma unroll
    for (int o = 32; o > 0; o >>= 1) v += __shfl_xor(v, o);
    if ((TIDX & 63) == 0) red[TIDX >> 6] = v;
    __syncthreads();
    float t = 0.f;
#pragma unroll
    for (int w = 0; w < NT / 64; ++w) t += red[w];
    return t;
}
template <int MODE> __device__ __forceinline__ void ph_post(const P& p, int l, int which, const bf16_t* Y, int ln, int wn, int nrows, float* red) {
    const float* lg = p.in[6] + (size_t)(l * 2 + which) * D; const float* lb = p.in[7] + (size_t)(l * 2 + which) * D;
    int toff[16];
    if (MODE == 1) { int s = 0;
#pragma unroll
        for (int e = 0; e < 16; ++e) { toff[e] = s; s += (p.CNT[l * 16 + e] + 255) >> 8; } }
    for (int r = blockIdx.x; r < nrows; r += gridDim.x) {
        float* x = xrow(p, r); const float* gate = modv(p, l, r, which * 3 + 2);
        const bf16_t *y0, *y1 = nullptr;
        if (MODE == 0) y0 = Y + (size_t)r * D;
        else {
            int sr[2];
#pragma unroll
            for (int k = 0; k < 2; ++k) { const int e = p.RE[r * 2 + k]; int to = 0;
#pragma unroll
                for (int q = 0; q < 16; ++q) to = (q == e) ? toff[q] : to;
                sr[k] = to * 256 + p.RPOS[r * 2 + k]; }
            y0 = p.slots + (size_t)sr[0] * D; y1 = p.slots + (size_t)sr[1] * D;
        }
        float v[2]; float s = 0.f;
#pragma unroll
        for (int i = 0; i < 2; ++i) { const int k = TIDX + i * NT; float yy = bf2f(y0[k]); if (MODE == 1) yy += bf2f(y1[k]); v[i] = ALPHA * x[k] + gate[k] * yy; s += v[i]; }
        const float mu = block_sum(s, red) * (1.f / D);
        float q = 0.f;
#pragma unroll
        for (int i = 0; i < 2; ++i) { const float d = v[i] - mu; q += d * d; }
        const float rs = 1.f / sqrtf(block_sum(q, red) * (1.f / D) + LN_EPS);
#pragma unroll
        for (int i = 0; i < 2; ++i) { const int k = TIDX + i * NT; const float xn = (v[i] - mu) * rs * lg[k] + lb[k]; x[k] = xn;
            if (ln >= 0) p.H[(size_t)r * D + k] = f2bf(xn * (1.f + modv(p, ln, r, wn * 3 + 1)[k]) + modv(p, ln, r, wn * 3 + 0)[k]); }
    }
}
__device__ __forceinline__ void ph_route1(const P& p, int l, int nrows) {
    GSTRIDE(idx, (long)nrows * NE) {
        const int e = idx % NE, r = idx / NE; const float* x = xrow(p, r); const float* sc = modv(p, l, r, 4); const float* sh = modv(p, l, r, 3);
        float acc = 0.f;
        for (int k = 0; k < D; ++k) acc += (x[k] * (1.f + sc[k]) + sh[k]) * p.in[29][k * NE + e];
        p.RS[idx] = sigmf(acc);
    }
}
__device__ __forceinline__ void ph_route2(const P& p, int l, int nrows) {
    GSTRIDE(r, nrows) {
        const float* s = p.RS + (size_t)r * NE; const float* rb = p.in[30];
        int best = 0; float bs = -1e30f;
        for (int g = 0; g < NG; ++g) {
            float m1 = -1e30f, m2 = -1e30f;
            for (int q = 0; q < EPG; ++q) { const float v = s[g * EPG + q] + rb[g * EPG + q]; if (v > m1) { m2 = m1; m1 = v; } else if (v > m2) m2 = v; }
            if (m1 + m2 > bs) { bs = m1 + m2; best = g; }
        }
        int i1 = 0; float v1 = -1e30f;
        for (int q = 0; q < EPG; ++q) { const float v = s[best * EPG + q] + rb[best * EPG + q]; if (v > v1) { v1 = v; i1 = q; } }
        int i2 = 0; float v2 = -1e30f;
        for (int q = 0; q < EPG; ++q) { if (q == i1) continue; const float v = s[best * EPG + q] + rb[best * EPG + q]; if (v > v2) { v2 = v; i2 = q; } }
        const int e1 = best * EPG + i1, e2 = best * EPG + i2; const float a = s[e1], c = s[e2];
        p.RE[r * 2] = e1; p.RE[r * 2 + 1] = e2; p.RWt[r * 2] = a / (a + c); p.RWt[r * 2 + 1] = c / (a + c);
        p.RPOS[r * 2] = atomicAdd(&p.CNT[l * 16 + e1], 1); p.RPOS[r * 2 + 1] = atomicAdd(&p.CNT[l * 16 + e2], 1);
    }
}
__device__ __forceinline__ void ph_permute(const P& p, int l, int nrows) {
    int toff[16]; { int s = 0;
#pragma unroll
        for (int e = 0; e < 16; ++e) { toff[e] = s; s += (p.CNT[l * 16 + e] + 255) >> 8; } }
    GSTRIDE(idx, (long)nrows * 2 * 128) {
        const int ck = idx % 128, k = (idx / 128) % 2, r = idx / 256; const int e = p.RE[r * 2 + k]; int to = 0;
#pragma unroll
        for (int q = 0; q < 16; ++q) to = (q == e) ? toff[q] : to;
        const int sr = to * 256 + p.RPOS[r * 2 + k];
        ((uint4*)(p.Hs + (size_t)sr * D))[ck] = ((const uint4*)(p.H + (size_t)r * D))[ck];
        if (ck == 0) p.WS[sr] = p.RWt[r * 2 + k];
    }
}
__device__ __forceinline__ void ph_glagate(const P& p) {
    GSTRIDE(idx, (long)2 * R * 512) {
        const int ch = idx % 512, r = (idx / 512) % R, dir = idx / (512 * R);
        const float* gw = (dir ? p.in[26] : p.in[24]); const float* gb = (dir ? p.in[27] : p.in[25]);
        float acc = gb[ch];
        for (int q = 0; q < 16; ++q) acc += bf2f(p.Z1[(size_t)r * GINP + 3072 + dir * 16 + q]) * gw[q * 512 + ch];
        p.BG[idx] = logsigf(acc) * (1.f / 16.f);
    }
}
__device__ __forceinline__ void ph_glacum(const P& p) {
    GSTRIDE(idx, (long)2 * NB * NCH * 512) {
        const int ch = idx % 512, c = (idx / 512) % NCH, b = (idx / (512 * NCH)) % NB, dir = idx / (512 * NCH * NB);
        float* a = p.BG + ((size_t)dir * R + chunk_row0(b, c)) * 512 + ch;
        float s = 0.f;
        if (dir == 0) for (int i = 0; i < 128; ++i) { s += a[(size_t)i * 512]; a[(size_t)i * 512] = s; }
        else for (int i = 127; i >= 0; --i) { s += a[(size_t)i * 512]; a[(size_t)i * 512] = s; }
    }
}
__device__ __forceinline__ size_t gst_idx(int dir, int b, int h, int c) { return ((((size_t)dir * NB + b) * 4 + h) * NCH + c) * 32768; }
__device__ __forceinline__ void ph_glaU_naive(const P& p) {
    const float* BF = p.BG; const float* BB = p.BG + (size_t)R * 512;
    GSTRIDE(idx, (long)NB * 4 * NCH * 32768) {
        const int d = idx % 128, e = (idx / 128) % 256, c = (idx / 32768) % NCH, h = (idx / (32768 * NCH)) % 4, b = idx / (32768 * NCH * 4);
        const int r0 = chunk_row0(b, c);
        const float bfe = BF[(size_t)(r0 + 127) * 512 + h * 128 + d], bbe = BB[(size_t)r0 * 512 + h * 128 + d];
        float uf = 0.f, ub = 0.f;
        for (int j = 0; j < 128; ++j) {
            const float kk = bf2f(p.Z1[(size_t)(r0 + j) * GINP + 512 + h * 128 + d]), vv = bf2f(p.Z1[(size_t)(r0 + j) * GINP + 1024 + h * 256 + e]);
            uf += kk * expf(bfe - BF[(size_t)(r0 + j) * 512 + h * 128 + d]) * vv; ub += kk * expf(bbe - BB[(size_t)(r0 + j) * 512 + h * 128 + d]) * vv;
        }
        p.GST[gst_idx(0, b, h, c) + e * 128 + d] = f2bf(uf); p.GST[gst_idx(1, b, h, c) + e * 128 + d] = f2bf(ub);
    }
}
__device__ __forceinline__ void ph_glaScan(const P& p) {
    const float* BF = p.BG; const float* BB = p.BG + (size_t)R * 512;
    GSTRIDE(idx, (long)2 * NB * 4 * 32768) {
        const int d = idx % 128, ed = idx % 32768, h = (idx / 32768) % 4, b = (idx / 131072) % NB, dir = idx / (131072 * NB);
        float s = 0.f;
        for (int cc = 0; cc < NCH; ++cc) {
            const int c = dir == 0 ? cc : (cc < 2 ? 1 - cc : NCH + 1 - cc); const int r0 = chunk_row0(b, c);
            const float dc = dir == 0 ? expf(BF[(size_t)(r0 + 127) * 512 + h * 128 + d]) : expf(BB[(size_t)r0 * 512 + h * 128 + d]);
            bf16_t* q = p.GST + gst_idx(dir, b, h, c) + ed; const float u = bf2f(*q); *q = f2bf(s); s = dc * s + u;
        }
    }
}
__device__ __forceinline__ void ph_glaO_naive(const P& p, float* lds) {
    const float* BF = p.BG; const float* BB = p.BG + (size_t)R * 512;
    for (int u = blockIdx.x; u < NB * 4 * 64; u += gridDim.x) {
        const int c = 2 + u % 64, h = (u / 64) % 4, b = u / 256; const int r0 = chunk_row0(b, c);
        __syncthreads();
        for (int e = TIDX; e < 128 * 128; e += NT) {
            const int j = e % 128, i = e / 128;
            const bf16_t* q = p.Z1 + (size_t)(r0 + i) * GINP + h * 128; const bf16_t* k = p.Z1 + (size_t)(r0 + j) * GINP + 512 + h * 128;
            float s = 0.f;
            if (i >= j) { const float* bi = BF + (size_t)(r0 + i) * 512 + h * 128; const float* bj = BF + (size_t)(r0 + j) * 512 + h * 128;
                for (int d = 0; d < 128; ++d) s += bf2f(q[d]) * bf2f(k[d]) * expf(bi[d] - bj[d]); }
            if (i <= j) { const float* bi = BB + (size_t)(r0 + i) * 512 + h * 128; const float* bj = BB + (size_t)(r0 + j) * 512 + h * 128;
                for (int d = 0; d < 128; ++d) s += bf2f(q[d]) * bf2f(k[d]) * expf(bi[d] - bj[d]); }
            lds[e] = s * KSCALE;
        }
        __syncthreads();
        const bf16_t* sf = p.GST + gst_idx(0, b, h, c); const bf16_t* sb = p.GST + gst_idx(1, b, h, c);
        for (int e2 = TIDX; e2 < 128 * 256; e2 += NT) {
            const int e = e2 % 256, i = e2 / 256;
            float o = 0.f; for (int j = 0; j < 128; ++j) o += lds[i * 128 + j] * bf2f(p.Z1[(size_t)(r0 + j) * GINP + 1024 + h * 256 + e]);
            const bf16_t* q = p.Z1 + (size_t)(r0 + i) * GINP + h * 128; const float* bi = BF + (size_t)(r0 + i) * 512 + h * 128; const float* bbi = BB + (size_t)(r0 + i) * 512 + h * 128;
            float a = 0.f; for (int d = 0; d < 128; ++d) a += bf2f(q[d]) * (expf(bi[d]) * bf2f(sf[e * 128 + d]) + expf(bbi[d]) * bf2f(sb[e * 128 + d]));
            p.H[(size_t)(r0 + i) * D + h * 256 + e] = f2bf(o + a * KSCALE);
        }
    }
}
__device__ __forceinline__ void ph_glaNorm_naive(const P& p) {
    GSTRIDE(idx, (long)RL * 4) {
        const int h = idx % 4, r = idx / 4; bf16_t* o = p.H + (size_t)r * D + h * 256;
        float ss = 0.f; for (int e = 0; e < 256; ++e) { const float v = bf2f(o[e]); ss += v * v; }
        const float rs = 1.f / sqrtf(ss * (1.f / 256.f) + LN_EPS);
        for (int e = 0; e < 256; ++e) o[e] = f2bf(bf2f(o[e]) * rs * siluf(bf2f(p.Z1[(size_t)r * GINP + 2048 + h * 256 + e])));
    }
}

#define FD __device__ __forceinline__
#define TIE(a, b) asm volatile("" : "+v"(a) : "v"(b))
#define HWCOS(x) __builtin_amdgcn_cosf(x)
#define HWSIN(x) __builtin_amdgcn_sinf(x)
struct cf { float x, y; };
FD cf cadd(cf a, cf b) { return {a.x + b.x, a.y + b.y}; }
FD cf csub(cf a, cf b) { return {a.x - b.x, a.y - b.y}; }
FD cf cmul(cf a, cf b) { return {a.x * b.x - a.y * b.y, a.x * b.y + a.y * b.x}; }
#define C32(k) ((k)==0?1.0f:(k)==1?0.98078528040323043f:(k)==2?0.92387953251128674f:(k)==3?0.83146961230254524f:(k)==4?0.70710678118654752f:(k)==5?0.55557023301960222f:(k)==6?0.38268343236508977f:(k)==7?0.19509032201612825f:(k)==8?0.0f:(k)==9?-0.19509032201612825f:(k)==10?-0.38268343236508977f:(k)==11?-0.55557023301960222f:(k)==12?-0.70710678118654752f:(k)==13?-0.83146961230254524f:(k)==14?-0.92387953251128674f:-0.98078528040323043f)
#define S32(k) ((k)==0?0.0f:(k)==1?0.19509032201612825f:(k)==2?0.38268343236508977f:(k)==3?0.55557023301960222f:(k)==4?0.70710678118654752f:(k)==5?0.83146961230254524f:(k)==6?0.92387953251128674f:(k)==7?0.98078528040323043f:(k)==8?1.0f:(k)==9?0.98078528040323043f:(k)==10?0.92387953251128674f:(k)==11?0.83146961230254524f:(k)==12?0.70710678118654752f:(k)==13?0.55557023301960222f:(k)==14?0.38268343236508977f:0.19509032201612825f)
template <int N, int LEN, bool INV> FD void dit_level(cf (&x)[N]) {
#pragma unroll
    for (int blk = 0; blk < N; blk += LEN)
#pragma unroll
        for (int j = 0; j < LEN / 2; ++j) {
            const int k = j * (32 / LEN);
            const cf a = x[blk + j], b0 = x[blk + j + LEN / 2];
            const cf b = k == 0 ? b0 : (k == 8 ? (INV ? cf{-b0.y, b0.x} : cf{b0.y, -b0.x}) : cmul(b0, cf{C32(k), INV ? S32(k) : -S32(k)}));
            x[blk + j] = cadd(a, b); x[blk + j + LEN / 2] = csub(a, b);
        }
}
template <int N, bool INV> FD void dit_reg(cf (&x)[N]) {
    dit_level<N, 2, INV>(x); dit_level<N, 4, INV>(x);
    if constexpr (N >= 8) dit_level<N, 8, INV>(x);
    if constexpr (N >= 16) dit_level<N, 16, INV>(x);
}
template <int N, int LEN, bool INV> FD void dif_level(cf (&x)[N]) {
#pragma unroll
    for (int blk = 0; blk < N; blk += LEN)
#pragma unroll
        for (int j = 0; j < LEN / 2; ++j) {
            const int k = j * (32 / LEN);
            const cf a = x[blk + j], b = x[blk + j + LEN / 2];
            x[blk + j] = cadd(a, b); const cf d = csub(a, b);
            x[blk + j + LEN / 2] = k == 0 ? d : (k == 8 ? (INV ? cf{-d.y, d.x} : cf{d.y, -d.x}) : cmul(d, cf{C32(k), INV ? S32(k) : -S32(k)}));
        }
}
template <int N, bool INV> FD void dif_reg(cf (&x)[N]) {
    if constexpr (N >= 16) dif_level<N, 16, INV>(x);
    if constexpr (N >= 8) dif_level<N, 8, INV>(x);
    dif_level<N, 4, INV>(x); dif_level<N, 2, INV>(x);
}
constexpr int FFT_N = 16384, FFT_LDS_CF = 17920;
FD int brev4(int i) { return ((i & 1) << 3) | ((i & 2) << 1) | ((i & 4) >> 1) | ((i & 8) >> 3); }
FD int physA(int m, int a) { return 4480 * a + m + (m >> 4) + 16 * (m >> 9); }
FD int physB(int b, int a, int m) { return 4480 * b + 272 * a + 16 * (a >> 1) + m + (m >> 4); }
FD int physC(int b, int a, int m) { return 272 * b + 16 * (b >> 1) + 17 * a + m; }
FD int physD(int g, int j) { return 17 * g + 16 * (g >> 5) + j; }
template <int RR, int RM> FD void twiddle(cf (&x)[RR], int m, float sgn) {
#pragma unroll
    for (int s = 1; s < RR; ++s) { const float fr = (float)((m * s) & (RM - 1)) * (1.0f / (float)RM); x[s] = cmul(x[s], cf{HWCOS(fr), sgn * HWSIN(fr)}); }
}
FD void stA_fwd(int m, cf v0, cf v1, cf v2, cf v3, cf* buf) {
    cf x[4] = {v0, v2, v1, v3};
    dit_reg<4, false>(x); twiddle<4, 16384>(x, m, -1.f);
#pragma unroll
    for (int s = 0; s < 4; ++s) buf[physA(m, s)] = x[s];
}
FD void stB_fwd(int idx, cf* buf) {
    const int b = idx >> 8, m = idx & 255; cf x[16];
#pragma unroll
    for (int i = 0; i < 16; ++i) x[i] = buf[physB(b, brev4(i), m)];
    dit_reg<16, false>(x); twiddle<16, 4096>(x, m, -1.f);
#pragma unroll
    for (int s = 0; s < 16; ++s) buf[physB(b, s, m)] = x[s];
}
FD void stC_fwd(int idx, cf* buf) {
    const int b = idx >> 4, m = idx & 15; cf x[16];
#pragma unroll
    for (int i = 0; i < 16; ++i) x[i] = buf[physC(b, brev4(i), m)];
    dit_reg<16, false>(x); twiddle<16, 256>(x, m, -1.f);
#pragma unroll
    for (int s = 0; s < 16; ++s) buf[physC(b, s, m)] = x[s];
}
FD void stD_fwd_regs(int g, const cf* buf, cf (&x)[16]) {
#pragma unroll
    for (int i = 0; i < 16; ++i) x[i] = buf[physD(g, brev4(i))];
    dit_reg<16, false>(x);
}
FD void stD_mul(int g, cf* buf, const cf (&h)[16]) {
    cf x[16];
#pragma unroll
    for (int i = 0; i < 16; ++i) x[i] = buf[physD(g, brev4(i))];
    dit_reg<16, false>(x);
#pragma unroll
    for (int s = 0; s < 16; ++s) x[s] = cmul(x[s], h[s]);
    dif_reg<16, true>(x);
#pragma unroll
    for (int i = 0; i < 16; ++i) buf[physD(g, brev4(i))] = x[i];
}
FD void stC_inv(int idx, cf* buf) {
    const int b = idx >> 4, m = idx & 15; cf x[16];
#pragma unroll
    for (int s = 0; s < 16; ++s) x[s] = buf[physC(b, s, m)];
    twiddle<16, 256>(x, m, 1.f); dif_reg<16, true>(x);
#pragma unroll
    for (int i = 0; i < 16; ++i) buf[physC(b, brev4(i), m)] = x[i];
}
FD void stB_inv(int idx, cf* buf) {
    const int b = idx >> 8, m = idx & 255; cf x[16];
#pragma unroll
    for (int s = 0; s < 16; ++s) x[s] = buf[physB(b, s, m)];
    twiddle<16, 4096>(x, m, 1.f); dif_reg<16, true>(x);
#pragma unroll
    for (int i = 0; i < 16; ++i) buf[physB(b, brev4(i), m)] = x[i];
}
FD void stA_inv(int m, const cf* buf, cf& r0, cf& r1) {
    cf x[4];
#pragma unroll
    for (int s = 0; s < 4; ++s) x[s] = buf[physA(m, s)];
    twiddle<4, 16384>(x, m, 1.f); dif_reg<4, true>(x);
    r0 = x[0]; r1 = x[2];
}

#undef FD
__device__ __forceinline__ void ph_hyena_fft(const P& p, unsigned char* smem) {
    cf* buf = (cf*)smem; float* fb = (float*)smem;
    const int t = TIDX;
    bf16_t* yhT = p.Zh + (size_t)2 * NB * 4 * NCH * 16384;
    for (int ch = blockIdx.x; ch < 512; ch += gridDim.x) {
        const bf16_t* hy0 = p.hyT + ((size_t)0 * 512 + ch) * RB;
        const size_t bstr = (size_t)3 * 512 * RB, jstr = (size_t)512 * RB;
        cf* Hg = (cf*)p.H + (size_t)blockIdx.x * 16384;
        bf16_t* zs0 = p.hyT + ((size_t)2 * 512 + ch) * RB;
#pragma unroll 1
        for (int n = 0; n < 2; ++n) {
            const int cfi = (n * 2) * 512 + ch, cbi = (n * 2 + 1) * 512 + ch;
            const float nf = 1.f / sqrtf(p.NORM[cfi]), nb = 1.f / sqrtf(p.NORM[cbi]);
            const float* Ff = p.FILT + (size_t)cfi * RB; const float* Fb = p.FILT + (size_t)cbi * RB;
#pragma unroll 2
            for (int j = 0; j < 8; ++j) { const int m = launder_i(t) + 512 * j;
                float v0 = Ff[m] * nf; if (m == 0) v0 += Fb[0] * nb;
                const float v1 = Ff[4096 + m] * nf, v2 = (m == 0) ? 0.f : Fb[8192 - (m == 0 ? 1 : m)] * nb, v3 = Fb[4096 - m] * nb;
                stA_fwd(m, cf{v0, 0.f}, cf{v1, 0.f}, cf{v2, 0.f}, cf{v3, 0.f}, buf); }
            __syncthreads();
#pragma unroll 1
            for (int q = 0; q < 2; ++q) stB_fwd(launder_i(t) + 512 * q, buf);
            __syncthreads();
#pragma unroll 1
            for (int q = 0; q < 2; ++q) stC_fwd(launder_i(t) + 512 * q, buf);
            __syncthreads();
#pragma unroll 1
            for (int q = 0; q < 2; ++q) { const int g = launder_i(t) + 512 * q; cf hh[16]; stD_fwd_regs(g, buf, hh);
#pragma unroll
                for (int s = 0; s < 16; ++s) Hg[s * 1024 + g] = hh[s]; }
            __syncthreads();
#pragma unroll 2
            for (int j = 0; j < 8; ++j) { const int m = launder_i(t) + 512 * j;
                stA_fwd(m, cf{bf2f(zs0[m]), bf2f(zs0[bstr + m])}, cf{bf2f(zs0[4096 + m]), bf2f(zs0[bstr + 4096 + m])}, cf{0.f, 0.f}, cf{0.f, 0.f}, buf); }
            __syncthreads();
#pragma unroll 1
            for (int q = 0; q < 2; ++q) stB_fwd(launder_i(t) + 512 * q, buf);
            __syncthreads();
#pragma unroll 1
            for (int q = 0; q < 2; ++q) stC_fwd(launder_i(t) + 512 * q, buf);
            __syncthreads();
#pragma unroll 1
            for (int q = 0; q < 2; ++q) { const int g = launder_i(t) + 512 * q; cf hh[16];
#pragma unroll
                for (int s = 0; s < 16; ++s) hh[s] = Hg[s * 1024 + g];
                stD_mul(g, buf, hh); }
            __syncthreads();
#pragma unroll 1
            for (int q = 0; q < 2; ++q) stC_inv(launder_i(t) + 512 * q, buf);
            __syncthreads();
#pragma unroll 1
            for (int q = 0; q < 2; ++q) stB_inv(launder_i(t) + 512 * q, buf);
            __syncthreads();
            const float sk = p.in[21][n * 512 + ch];
#pragma unroll 2
            for (int j = 0; j < 8; ++j) { const int m = launder_i(t) + 512 * j; cf r0, r1; stA_inv(m, buf, r0, r1);
#pragma unroll
                for (int hlf = 0; hlf < 2; ++hlf) { const int d = m + 4096 * hlf; const cf r = hlf ? r1 : r0;
                    const float g0 = bf2f(hy0[n * jstr + d]), g1 = bf2f(hy0[bstr + n * jstr + d]);
                    const float o0 = g0 * (r.x * (1.f / 16384.f) + sk * bf2f(zs0[d])), o1 = g1 * (r.y * (1.f / 16384.f) + sk * bf2f(zs0[bstr + d]));
                    if (n == 0) { zs0[d] = f2bf(o0); zs0[bstr + d] = f2bf(o1); }
                    else { yhT[((size_t)0 * 512 + ch) * RB + d] = f2bf(o0); yhT[((size_t)1 * 512 + ch) * RB + d] = f2bf(o1); } } }
            __syncthreads();
        }
        {
            float* tap = fb;
            float* zc = fb + 1024;
            const int b = t >> 8, tt = t & 255;
#pragma unroll
            for (int n = 0; n < 2; ++n) {
                const int cfi = (n * 2) * 512 + ch, cbi = (n * 2 + 1) * 512 + ch;
                const float nf = 1.f / sqrtf(p.NORM[2048 + cfi]), nb = 1.f / sqrtf(p.NORM[2048 + cbi]);
                const float* Ff = p.FILT + (size_t)cfi * RB + L; const float* Fb = p.FILT + (size_t)cbi * RB + L;
                if (t < 511) { const int d = t - 255; tap[n * 512 + t] = d > 0 ? Ff[d] * nf : (d < 0 ? Fb[-d] * nb : Ff[0] * nf + Fb[0] * nb); }
            }
            const bf16_t* hb_ = hy0 + (size_t)b * bstr + L + tt;
            const float z1 = bf2f(hb_[2 * jstr]);
            zc[b * 256 + tt] = z1;
            __syncthreads();
            float c1 = 0.f;
            for (int s = 0; s < 256; ++s) c1 += tap[tt - s + 255] * zc[b * 256 + s];
            const float z2 = bf2f(hb_[0]) * (c1 + p.in[21][ch] * z1);
            __syncthreads();
            zc[b * 256 + tt] = z2;
            __syncthreads();
            float c2 = 0.f;
            for (int s = 0; s < 256; ++s) c2 += tap[512 + tt - s + 255] * zc[b * 256 + s];
            yhT[((size_t)b * 512 + ch) * RB + L + tt] = f2bf(bf2f(hb_[jstr]) * (c2 + p.in[21][512 + ch] * z2));
            __syncthreads();
        }
    }
}

typedef short bf16x8 __attribute__((ext_vector_type(8)));
typedef short s16x4 __attribute__((ext_vector_type(4)));
typedef float f32x4 __attribute__((ext_vector_type(4)));
typedef unsigned u4v __attribute__((ext_vector_type(4)));
typedef unsigned u2v __attribute__((ext_vector_type(2)));
constexpr int LDT = 136;
constexpr int TILE_E = 128 * LDT;
__device__ __forceinline__ bf16x8 frag_row(const LAS bf16_t* T, int ld, int r0, int k0, int lane) {
    return *(const LAS bf16x8*)(T + (r0 + (lane & 15)) * ld + k0 + 8 * (lane >> 4));
}
__device__ __forceinline__ bf16x8 frag_tr(const LAS bf16_t* T, int ld, int k0, int n0, int lane) {
    const int g = lane >> 4, q = (lane & 15) >> 2, pp = lane & 3;
    const LAS bf16_t* a0 = T + (k0 + 8 * g + q) * ld + n0 + 4 * pp;
    const s16x4 lo = __builtin_amdgcn_ds_read_tr16_b64_v4i16((LAS s16x4*)a0);
    const s16x4 hi = __builtin_amdgcn_ds_read_tr16_b64_v4i16((LAS s16x4*)(a0 + 4 * ld));
    return (bf16x8){lo[0], lo[1], lo[2], lo[3], hi[0], hi[1], hi[2], hi[3]};
}
#define MFMA16(xn, xm, acc) __builtin_amdgcn_mfma_f32_16x16x32_bf16(xn, xm, acc, 0, 0, 0)
__device__ __forceinline__ void unpack8(const u4v u, float (&f)[8]) {
    f[0] = __uint_as_float(u.x << 16); f[1] = __uint_as_float(u.x & 0xffff0000u); f[2] = __uint_as_float(u.y << 16); f[3] = __uint_as_float(u.y & 0xffff0000u);
    f[4] = __uint_as_float(u.z << 16); f[5] = __uint_as_float(u.z & 0xffff0000u); f[6] = __uint_as_float(u.w << 16); f[7] = __uint_as_float(u.w & 0xffff0000u);
}
__device__ __forceinline__ u4v pack8(const float (&f)[8]) {
    u4v u; u.x = pk_bf16(f[0], f[1]); u.y = pk_bf16(f[2], f[3]); u.z = pk_bf16(f[4], f[5]); u.w = pk_bf16(f[6], f[7]); return u;
}
__device__ __forceinline__ void stage_tile(LAS bf16_t* dst, const bf16_t* src, int gld, int tid) {
#pragma unroll
    for (int i = 0; i < 4; ++i) { const int c = tid + 512 * i, row = c >> 4, ch = c & 15;
        *(LAS u4v*)(dst + row * LDT + ch * 8) = *(const u4v*)(src + (size_t)row * gld + ch * 8); }
}
__device__ __forceinline__ void ph_retU_mfma(const P& p, unsigned char* smem) {
    LAS bf16_t* Kt = (LAS bf16_t*)smem; LAS bf16_t* VF = Kt + TILE_E; LAS bf16_t* VB = VF + TILE_E;
    bf16_t* ST = p.Zh;
    for (int u = blockIdx.x; u < NB * 4 * NCH; u += gridDim.x) {
        const int tid = TIDX, lane = tid & 63, w = tid >> 6;
        const int c = u % NCH, h = (u / NCH) % 4, b = u / (NCH * 4); const int r0 = chunk_row0(b, c);
        const float lgf = p.in[9][h], lgb = p.in[10][h];
        const bf16_t* kb = p.Zr + (size_t)r0 * 2048 + 512 + h * 128; const bf16_t* vb = p.Zr + (size_t)r0 * 2048 + 1024 + h * 128;
        __syncthreads();
        stage_tile(Kt, kb, 2048, tid);
#pragma unroll
        for (int i = 0; i < 4; ++i) { const int cc = tid + 512 * i, j = cc >> 4, ch = cc & 15;
            float f[8], g[8]; unpack8(*(const u4v*)(vb + (size_t)j * 2048 + ch * 8), f);
            const float wf = __expf(lgf * (float)(127 - j)), wb = __expf(lgb * (float)j);
#pragma unroll
            for (int q = 0; q < 8; ++q) { g[q] = f[q] * wb; f[q] *= wf; }
            *(LAS u4v*)(VF + j * LDT + ch * 8) = pack8(f); *(LAS u4v*)(VB + j * LDT + ch * 8) = pack8(g); }
        __syncthreads();
        f32x4 af[8], ab[8];
#pragma unroll
        for (int nt = 0; nt < 8; ++nt) { af[nt] = (f32x4){0.f, 0.f, 0.f, 0.f}; ab[nt] = (f32x4){0.f, 0.f, 0.f, 0.f}; }
#pragma unroll
        for (int ks = 0; ks < 4; ++ks) {
            const bf16x8 xf = frag_tr(VF, LDT, 32 * ks, 16 * w, lane), xb = frag_tr(VB, LDT, 32 * ks, 16 * w, lane);
#pragma unroll
            for (int nt = 0; nt < 8; ++nt) { const bf16x8 xn = frag_tr(Kt, LDT, 32 * ks, 16 * nt, lane); af[nt] = MFMA16(xn, xf, af[nt]); ab[nt] = MFMA16(xn, xb, ab[nt]); }
        }
        const int e = 16 * w + (lane & 15), d0 = 4 * (lane >> 4);
        bf16_t* of = ST + st_idx(0, b, h, c) + e * 128 + d0; bf16_t* ob = ST + st_idx(1, b, h, c) + e * 128 + d0;
#pragma unroll
        for (int nt = 0; nt < 8; ++nt) {
            u2v o; o.x = pk_bf16(af[nt][0], af[nt][1]); o.y = pk_bf16(af[nt][2], af[nt][3]); *(u2v*)(of + 16 * nt) = o;
            o.x = pk_bf16(ab[nt][0], ab[nt][1]); o.y = pk_bf16(ab[nt][2], ab[nt][3]); *(u2v*)(ob + 16 * nt) = o; }
    }
}
__device__ __forceinline__ void ph_retO_mfma(const P& p, unsigned char* smem) {
    LAS bf16_t* Qs = (LAS bf16_t*)smem; LAS bf16_t* Ks = Qs + TILE_E; LAS bf16_t* Vs = Ks + TILE_E; LAS bf16_t* Ss = Vs + TILE_E;
    const bf16_t* ST = p.Zh;
    for (int u = blockIdx.x; u < NB * 4 * NCH; u += gridDim.x) {
        const int tid = TIDX, lane = tid & 63, w = tid >> 6, fr = lane & 15, fq = lane >> 4;
        const int c = u % NCH, h = (u / NCH) % 4, b = u / (NCH * 4); const int r0 = chunk_row0(b, c);
        const float lgf = p.in[9][h], lgb = p.in[10][h];
        const bf16_t* zb = p.Zr + (size_t)r0 * 2048 + h * 128;
        __syncthreads();
        stage_tile(Qs, zb, 2048, tid); stage_tile(Ks, zb + 512, 2048, tid); stage_tile(Vs, zb + 1024, 2048, tid); stage_tile(Ss, ST + st_idx(0, b, h, c), 128, tid);
        __syncthreads();
        f32x4 as[8], af[8];
#pragma unroll
        for (int nt = 0; nt < 8; ++nt) { as[nt] = (f32x4){0.f, 0.f, 0.f, 0.f}; af[nt] = (f32x4){0.f, 0.f, 0.f, 0.f}; }
#pragma unroll
        for (int ks = 0; ks < 4; ++ks) { const bf16x8 xm = frag_row(Qs, LDT, 16 * w, 32 * ks, lane);
#pragma unroll
            for (int nt = 0; nt < 8; ++nt) { as[nt] = MFMA16(frag_row(Ks, LDT, 16 * nt, 32 * ks, lane), xm, as[nt]); af[nt] = MFMA16(frag_row(Ss, LDT, 16 * nt, 32 * ks, lane), xm, af[nt]); } }
        const int i = 16 * w + fr;
        __syncthreads();
#pragma unroll
        for (int nt = 0; nt < 8; ++nt) { float pv[4];
#pragma unroll
            for (int q = 0; q < 4; ++q) { const int j = 16 * nt + 4 * fq + q; const float m = i > j ? __expf(lgf * (float)(i - j)) : (j > i ? __expf(lgb * (float)(j - i)) : 2.f); pv[q] = as[nt][q] * m; }
            u2v o; o.x = pk_bf16(pv[0], pv[1]); o.y = pk_bf16(pv[2], pv[3]); *(LAS u2v*)(Ks + i * LDT + 16 * nt + 4 * fq) = o; }
        stage_tile(Ss, ST + st_idx(1, b, h, c), 128, tid);
        __syncthreads();
        f32x4 ao[8], ab[8];
#pragma unroll
        for (int nt = 0; nt < 8; ++nt) { ao[nt] = (f32x4){0.f, 0.f, 0.f, 0.f}; ab[nt] = (f32x4){0.f, 0.f, 0.f, 0.f}; }
#pragma unroll
        for (int ks = 0; ks < 4; ++ks) { const bf16x8 xp = frag_row(Ks, LDT, 16 * w, 32 * ks, lane), xq = frag_row(Qs, LDT, 16 * w, 32 * ks, lane);
#pragma unroll
            for (int nt = 0; nt < 8; ++nt) { ao[nt] = MFMA16(frag_tr(Vs, LDT, 32 * ks, 16 * nt, lane), xp, ao[nt]); ab[nt] = MFMA16(frag_row(Ss, LDT, 16 * nt, 32 * ks, lane), xq, ab[nt]); } }
        const float rf = __expf(lgf * (float)(i + 1)), rb = __expf(lgb * (float)(128 - i));
        float s = 0.f;
#pragma unroll
        for (int nt = 0; nt < 8; ++nt) { ao[nt] = ao[nt] + af[nt] * rf + ab[nt] * rb; s += (ao[nt][0] + ao[nt][1]) + (ao[nt][2] + ao[nt][3]); }
        s += __shfl_xor(s, 16); s += __shfl_xor(s, 32);
        const float mu = s * (1.f / 128.f); float qv = 0.f;
#pragma unroll
        for (int nt = 0; nt < 8; ++nt) { const f32x4 dd = ao[nt] - mu; qv += (dd[0] * dd[0] + dd[1] * dd[1]) + (dd[2] * dd[2] + dd[3] * dd[3]); }
        qv += __shfl_xor(qv, 16); qv += __shfl_xor(qv, 32);
        const float rs = 1.f / sqrtf(qv * (1.f / 128.f) + LN_EPS);
        const bf16_t* gp = p.Zr + (size_t)(r0 + i) * 2048 + 1536 + h * 128 + 4 * fq; bf16_t* yp = p.H + (size_t)(r0 + i) * D + h * 128 + 4 * fq;
#pragma unroll
        for (int nt = 0; nt < 8; ++nt) { const u2v gu = *(const u2v*)(gp + 16 * nt);
            const float g0 = __uint_as_float(gu.x << 16), g1 = __uint_as_float(gu.x & 0xffff0000u), g2 = __uint_as_float(gu.y << 16), g3 = __uint_as_float(gu.y & 0xffff0000u);
            u2v o; o.x = pk_bf16((ao[nt][0] - mu) * rs * siluf(g0), (ao[nt][1] - mu) * rs * siluf(g1)); o.y = pk_bf16((ao[nt][2] - mu) * rs * siluf(g2), (ao[nt][3] - mu) * rs * siluf(g3));
            *(u2v*)(yp + 16 * nt) = o; }
    }
}
__device__ __forceinline__ void ph_glaU_mfma(const P& p, unsigned char* smem) {
    LAS bf16_t* KF = (LAS bf16_t*)smem; LAS bf16_t* KB = KF + TILE_E; LAS bf16_t* Vs = KB + TILE_E;
    for (int u = blockIdx.x; u < NB * 4 * NCH; u += gridDim.x) {
        const int tid = TIDX, lane = tid & 63, w = tid >> 6;
        const int c = u % NCH, h = (u / NCH) % 4, b = u / (NCH * 4); const int r0 = chunk_row0(b, c);
        const bf16_t* kb = p.Z1 + (size_t)r0 * GINP + 512 + h * 128; const bf16_t* vb = p.Z1 + (size_t)r0 * GINP + 1024 + h * 256;
        const float* BF = p.BG + (size_t)r0 * 512 + h * 128; const float* BB = p.BG + (size_t)R * 512 + (size_t)r0 * 512 + h * 128;
        __syncthreads();
#pragma unroll
        for (int i = 0; i < 4; ++i) { const int cc = tid + 512 * i, j = cc >> 4, ch = cc & 15;
            float k8[8], g8[8]; unpack8(*(const u4v*)(kb + (size_t)j * GINP + ch * 8), k8);
            const f32x4 f0 = *(const f32x4*)(BF + (size_t)j * 512 + ch * 8), f1 = *(const f32x4*)(BF + (size_t)j * 512 + ch * 8 + 4), e0 = *(const f32x4*)(BF + (size_t)127 * 512 + ch * 8), e1 = *(const f32x4*)(BF + (size_t)127 * 512 + ch * 8 + 4);
            const f32x4 b0 = *(const f32x4*)(BB + (size_t)j * 512 + ch * 8), b1 = *(const f32x4*)(BB + (size_t)j * 512 + ch * 8 + 4), t0 = *(const f32x4*)(BB + ch * 8), t1 = *(const f32x4*)(BB + ch * 8 + 4);
#pragma unroll
            for (int q = 0; q < 4; ++q) { g8[q] = k8[q] * __expf(t0[q] - b0[q]); g8[q + 4] = k8[q + 4] * __expf(t1[q] - b1[q]); k8[q] *= __expf(e0[q] - f0[q]); k8[q + 4] *= __expf(e1[q] - f1[q]); }
            *(LAS u4v*)(KF + j * LDT + ch * 8) = pack8(k8); *(LAS u4v*)(KB + j * LDT + ch * 8) = pack8(g8); }
        const int fr = lane & 15, fq = lane >> 4;
#pragma unroll 1
        for (int hf = 0; hf < 2; ++hf) {
            if (hf) __syncthreads();
            stage_tile(Vs, vb + hf * 128, GINP, tid);
            __syncthreads();
            {
                f32x4 af[8], ab[8];
#pragma unroll
                for (int nt = 0; nt < 8; ++nt) { af[nt] = (f32x4){0.f, 0.f, 0.f, 0.f}; ab[nt] = (f32x4){0.f, 0.f, 0.f, 0.f}; }
#pragma unroll
                for (int ks = 0; ks < 4; ++ks) { const bf16x8 x0 = frag_tr(Vs, LDT, 32 * ks, 16 * w, lane);
#pragma unroll
                    for (int nt = 0; nt < 8; ++nt) { af[nt] = MFMA16(frag_tr(KF, LDT, 32 * ks, 16 * nt, lane), x0, af[nt]); ab[nt] = MFMA16(frag_tr(KB, LDT, 32 * ks, 16 * nt, lane), x0, ab[nt]); } }
                bf16_t* of = p.GST + gst_idx(0, b, h, c) + (size_t)(hf * 128 + 16 * w + fr) * 128 + 4 * fq; bf16_t* ob = p.GST + gst_idx(1, b, h, c) + (size_t)(hf * 128 + 16 * w + fr) * 128 + 4 * fq;
#pragma unroll
                for (int nt = 0; nt < 8; ++nt) { u2v v; v.x = pk_bf16(af[nt][0], af[nt][1]); v.y = pk_bf16(af[nt][2], af[nt][3]); *(u2v*)(of + 16 * nt) = v;
                    v.x = pk_bf16(ab[nt][0], ab[nt][1]); v.y = pk_bf16(ab[nt][2], ab[nt][3]); *(u2v*)(ob + 16 * nt) = v; }
            }
        }
    }
}
__device__ __forceinline__ void stage_scaled(LAS bf16_t* dst, const bf16_t* src, const float* G, float sgn, float mul, int tid) {
#pragma unroll
    for (int i = 0; i < 4; ++i) { const int cc = tid + 512 * i, j = cc >> 4, ch = cc & 15;
        float k8[8]; unpack8(*(const u4v*)(src + (size_t)j * GINP + ch * 8), k8);
        const f32x4 f0 = *(const f32x4*)(G + (size_t)j * 512 + ch * 8), f1 = *(const f32x4*)(G + (size_t)j * 512 + ch * 8 + 4);
#pragma unroll
        for (int q = 0; q < 4; ++q) { k8[q] *= __expf(sgn * f0[q]) * mul; k8[q + 4] *= __expf(sgn * f1[q]) * mul; }
        *(LAS u4v*)(dst + j * LDT + ch * 8) = pack8(k8); }
}
__device__ __forceinline__ void ph_glaO_mfma(const P& p, unsigned char* smem) {
    LAS bf16_t* QF = (LAS bf16_t*)smem; LAS bf16_t* QB = QF + TILE_E; LAS bf16_t* KX = QB + TILE_E; LAS bf16_t* R4 = KX + TILE_E;
    for (int u = blockIdx.x; u < NB * 4 * 64; u += gridDim.x) {
        const int tid = TIDX, lane = tid & 63, w = tid >> 6, fr = lane & 15, fq = lane >> 4;
        const int c = 2 + u % 64, h = (u / 64) % 4, b = u / 256; const int r0 = chunk_row0(b, c);
        const bf16_t* qb = p.Z1 + (size_t)r0 * GINP + h * 128; const bf16_t* kb = qb + 512; const bf16_t* vb = p.Z1 + (size_t)r0 * GINP + 1024 + h * 256;
        const float* BF = p.BG + (size_t)r0 * 512 + h * 128; const float* BB = p.BG + (size_t)R * 512 + (size_t)r0 * 512 + h * 128;
        const int i = 16 * w + fr;
        __syncthreads();
        stage_scaled(QF, qb, BF, 1.f, KSCALE, tid); stage_scaled(QB, qb, BB, 1.f, KSCALE, tid); stage_scaled(KX, kb, BF, -1.f, 1.f, tid);
        __syncthreads();
        f32x4 s1[8];
#pragma unroll
        for (int nt = 0; nt < 8; ++nt) s1[nt] = (f32x4){0.f, 0.f, 0.f, 0.f};
#pragma unroll
        for (int ks = 0; ks < 4; ++ks) { const bf16x8 xm = frag_row(QF, LDT, 16 * w, 32 * ks, lane);
#pragma unroll
            for (int nt = 0; nt < 8; ++nt) s1[nt] = MFMA16(frag_row(KX, LDT, 16 * nt, 32 * ks, lane), xm, s1[nt]); }
#pragma unroll
        for (int nt = 0; nt < 8; ++nt)
#pragma unroll
            for (int q = 0; q < 4; ++q) { const int j = 16 * nt + 4 * fq + q; s1[nt][q] = (i >= j) ? s1[nt][q] : 0.f; }
        __syncthreads();
        stage_scaled(KX, kb, BB, -1.f, 1.f, tid);
        __syncthreads();
        {
            f32x4 s2[8];
#pragma unroll
            for (int nt = 0; nt < 8; ++nt) s2[nt] = (f32x4){0.f, 0.f, 0.f, 0.f};
#pragma unroll
            for (int ks = 0; ks < 4; ++ks) { const bf16x8 xm = frag_row(QB, LDT, 16 * w, 32 * ks, lane);
#pragma unroll
                for (int nt = 0; nt < 8; ++nt) s2[nt] = MFMA16(frag_row(KX, LDT, 16 * nt, 32 * ks, lane), xm, s2[nt]); }
#pragma unroll
            for (int nt = 0; nt < 8; ++nt)
#pragma unroll
                for (int q = 0; q < 4; ++q) { const int j = 16 * nt + 4 * fq + q; s1[nt][q] += (i <= j) ? s2[nt][q] : 0.f; }
        }
        __syncthreads();
#pragma unroll
        for (int nt = 0; nt < 8; ++nt) { u2v o; o.x = pk_bf16(s1[nt][0], s1[nt][1]); o.y = pk_bf16(s1[nt][2], s1[nt][3]); *(LAS u2v*)(KX + i * LDT + 16 * nt + 4 * fq) = o; }
        f32x4 ao[2][8];
#pragma unroll
        for (int hf = 0; hf < 2; ++hf) {
#pragma unroll
            for (int nt = 0; nt < 8; ++nt) ao[hf][nt] = (f32x4){0.f, 0.f, 0.f, 0.f};
            stage_tile(R4, vb + hf * 128, GINP, tid);
            __syncthreads();
#pragma unroll
            for (int ks = 0; ks < 4; ++ks) { const bf16x8 xp = frag_row(KX, LDT, 16 * w, 32 * ks, lane);
#pragma unroll
                for (int nt = 0; nt < 8; ++nt) ao[hf][nt] = MFMA16(frag_tr(R4, LDT, 32 * ks, 16 * nt, lane), xp, ao[hf][nt]); }
            __syncthreads();
            stage_tile(R4, p.GST + gst_idx(0, b, h, c) + (size_t)hf * 128 * 128, 128, tid);
            __syncthreads();
#pragma unroll
            for (int ks = 0; ks < 4; ++ks) { const bf16x8 xq = frag_row(QF, LDT, 16 * w, 32 * ks, lane);
#pragma unroll
                for (int nt = 0; nt < 8; ++nt) ao[hf][nt] = MFMA16(frag_row(R4, LDT, 16 * nt, 32 * ks, lane), xq, ao[hf][nt]); }
            __syncthreads();
            stage_tile(R4, p.GST + gst_idx(1, b, h, c) + (size_t)hf * 128 * 128, 128, tid);
            __syncthreads();
#pragma unroll
            for (int ks = 0; ks < 4; ++ks) { const bf16x8 xq = frag_row(QB, LDT, 16 * w, 32 * ks, lane);
#pragma unroll
                for (int nt = 0; nt < 8; ++nt) ao[hf][nt] = MFMA16(frag_row(R4, LDT, 16 * nt, 32 * ks, lane), xq, ao[hf][nt]); }
            __syncthreads();
        }
        float ss = 0.f;
#pragma unroll
        for (int hf = 0; hf < 2; ++hf)
#pragma unroll
            for (int nt = 0; nt < 8; ++nt) { const f32x4 v = ao[hf][nt]; ss += (v[0] * v[0] + v[1] * v[1]) + (v[2] * v[2] + v[3] * v[3]); }
        ss += __shfl_xor(ss, 16); ss += __shfl_xor(ss, 32);
        const float rs = 1.f / sqrtf(ss * (1.f / 256.f) + LN_EPS);
        const bf16_t* gp = p.Z1 + (size_t)(r0 + i) * GINP + 2048 + h * 256 + 4 * fq; bf16_t* yp = p.H + (size_t)(r0 + i) * D + h * 256 + 4 * fq;
#pragma unroll
        for (int hf = 0; hf < 2; ++hf)
#pragma unroll
            for (int nt = 0; nt < 8; ++nt) { const u2v gu = *(const u2v*)(gp + hf * 128 + 16 * nt);
                const float g0 = __uint_as_float(gu.x << 16), g1 = __uint_as_float(gu.x & 0xffff0000u), g2 = __uint_as_float(gu.y << 16), g3 = __uint_as_float(gu.y & 0xffff0000u);
                u2v o; o.x = pk_bf16(ao[hf][nt][0] * rs * siluf(g0), ao[hf][nt][1] * rs * siluf(g1)); o.y = pk_bf16(ao[hf][nt][2] * rs * siluf(g2), ao[hf][nt][3] * rs * siluf(g3));
                *(u2v*)(yp + hf * 128 + 16 * nt) = o; }
    }
}

template <int MODE> __device__ __forceinline__ void tr_w(bf16_t* dst, const float* src, int N, int K, int ldsrc, float* t  , int& tile0, int tile_stride) {
    const int nt_n = N / 64, ntiles = nt_n * (K / 64);
    for (int tile = tile0; tile < ntiles; tile += tile_stride) {
        const int tid = TIDX; const int n0 = (tile % nt_n) * 64, k0 = (tile / nt_n) * 64;
        __syncthreads();
#pragma unroll
        for (int i = 0; i < 8; ++i) { const int e = tid + 512 * i, kk = e >> 6, nn = e & 63; t[kk * 65 + nn] = src[(size_t)(k0 + kk) * ldsrc + n0 + nn]; }
        __syncthreads();
#pragma unroll
        for (int i = 0; i < 4; ++i) { const int e = tid + 512 * i, nn = e >> 5, kp = e & 31; const int n = n0 + nn;
            const int row = MODE == 0 ? n : (8 * (n >> 2) + (n & 3) + (MODE == 2 ? 4 : 0));
            *(unsigned*)(dst + (size_t)row * K + k0 + 2 * kp) = pk_bf16(t[(2 * kp) * 65 + nn], t[(2 * kp + 1) * 65 + nn]); }
    }
    tile0 = tile0 - (ntiles % tile_stride);
    if (tile0 < 0) tile0 += tile_stride;
}
__device__ __forceinline__ void ph_wconv_fast(const P& p, float* t) {
    int t0 = blockIdx.x; const int G = gridDim.x;
    tr_w<0>(p.Win0, p.in[8], ABIN, D, ABIN, t, t0, G);
    tr_w<0>(p.Wout0, p.in[22], D, D, D, t, t0, G);
    tr_w<0>(p.Win1, p.in[23], 3072, D, GIN, t, t0, G);
    tr_w<0>(p.Wout1, p.in[28], D, D, D, t, t0, G);
    GSTRIDE(idx, (long)(GINP - 3072) * D) { const int k = idx % D, n = 3072 + idx / D; p.Win1[(size_t)n * D + k] = n < GIN ? f2bf(p.in[23][(size_t)k * GIN + n]) : (bf16_t)0; }
}
__device__ __forceinline__ void ph_wconv_moe_fast(const P& p, int l, float* t) {
    int t0 = blockIdx.x; const int G = gridDim.x;
    for (int e = 0; e < NE; ++e) {
        tr_w<1>(p.Wgu + (size_t)e * 1024 * 1024, p.in[31] + (size_t)(l * NE + e) * D * EH, EH, D, EH, t, t0, G);
        tr_w<2>(p.Wgu + (size_t)e * 1024 * 1024, p.in[32] + (size_t)(l * NE + e) * D * EH, EH, D, EH, t, t0, G);
        tr_w<0>(p.Wd + (size_t)e * 1024 * 512, p.in[33] + (size_t)(l * NE + e) * EH * D, D, EH, D, t, t0, G);
    }
}
__device__ __forceinline__ void ph_prep_hy_fast(const P& p, float* t  ) {
    const int ntt = RB / 64, ntc = 1536 / 64;
    for (int tile = blockIdx.x; tile < NB * ntt * ntc; tile += gridDim.x) {
        const int tid = TIDX; const int ct = tile % ntc, tt = (tile / ntc) % ntt, b = tile / (ntc * ntt); const int c0 = ct * 64, tl0 = tt * 64;
        const int s0 = tl0 < L ? 0 : L, s1 = tl0 < L ? L : RB;
        __syncthreads();
        for (int e = tid; e < 66 * 64; e += NT) { const int rr = e >> 6, cc = e & 63, tl = tl0 - 1 + rr;
            t[rr * 65 + cc] = (tl >= s0 && tl < s1) ? bf2f(p.Zh[(size_t)bt_row(b, tl) * 1536 + c0 + cc]) : 0.f; }
        __syncthreads();
#pragma unroll
        for (int i = 0; i < 4; ++i) { const int e = tid + 512 * i, cc = e >> 5, tp = e & 31; const int col = c0 + cc;
            const float w0 = p.in[11][col], w1 = p.in[11][1536 + col], w2 = p.in[11][3072 + col], bs = p.in[12][col];
            const float a = bs + w0 * t[(2 * tp) * 65 + cc] + w1 * t[(2 * tp + 1) * 65 + cc] + w2 * t[(2 * tp + 2) * 65 + cc];
            const float c2 = bs + w0 * t[(2 * tp + 1) * 65 + cc] + w1 * t[(2 * tp + 2) * 65 + cc] + w2 * t[(2 * tp + 3) * 65 + cc];
            *(unsigned*)(p.hyT + ((size_t)b * 1536 + col) * RB + tl0 + 2 * tp) = pk_bf16(a, c2); }
    }
}
__device__ __forceinline__ void ph_hy_untranspose_fast(const P& p, float* t) {
    const bf16_t* yhT = p.Zh + (size_t)2 * NB * 4 * NCH * 16384;
    const int ntt = RB / 64, ntc = 512 / 64;
    for (int tile = blockIdx.x; tile < NB * ntt * ntc; tile += gridDim.x) {
        const int tid = TIDX; const int ct = tile % ntc, tt = (tile / ntc) % ntt, b = tile / (ntc * ntt); const int c0 = ct * 64, tl0 = tt * 64;
        __syncthreads();
#pragma unroll
        for (int i = 0; i < 8; ++i) { const int e = tid + 512 * i, cc = e >> 6, ti = e & 63; t[cc * 65 + ti] = bf2f(yhT[((size_t)b * 512 + c0 + cc) * RB + tl0 + ti]); }
        __syncthreads();
#pragma unroll
        for (int i = 0; i < 4; ++i) { const int e = tid + 512 * i, ti = e >> 5, cp = e & 31;
            *(unsigned*)(p.H + (size_t)bt_row(b, tl0 + ti) * D + 512 + c0 + 2 * cp) = pk_bf16(t[(2 * cp) * 65 + ti], t[(2 * cp + 1) * 65 + ti]); }
    }
}
__device__ __forceinline__ void ph_prep_rope_fast(const P& p) {
    GSTRIDE(idx, (long)R * 2 * 4 * 8) {
        const int pc = idx % 8, h = (idx / 8) % 4, w = (idx / 32) % 2, r = idx / 64;
        bf16_t* base = p.Zr + (size_t)r * 2048 + w * 512 + h * 128 + pc * 8;
        float a[8], c[8]; unpack8(*(const u4v*)base, a); unpack8(*(const u4v*)(base + 64), c);
        const float sc = w ? KSCALE : 1.f;
        if (r < RL) {
            const int t = r % L; const float pos = (pc < 4) ? (float)(t / GW) : (float)(t % GW);
#pragma unroll
            for (int q = 0; q < 8; ++q) { const int pr = pc * 8 + q; const float inv = exp2f(-(float)(pr & 31) * (13.287712379549449f / 32.f));
                float sn, cs; sincosf(pos * inv, &sn, &cs); const float x1 = a[q] * sc, x2 = c[q] * sc; a[q] = x1 * cs - x2 * sn; c[q] = x1 * sn + x2 * cs; }
        } else {
#pragma unroll
            for (int q = 0; q < 8; ++q) { a[q] *= sc; c[q] *= sc; }
        }
        *(u4v*)base = pack8(a); *(u4v*)(base + 64) = pack8(c);
    }
}
__device__ __forceinline__ void ph_mod_fast(const P& p, int l, int which, const float* xl  , const float* xc  ) {
    const int lane = TIDX & 63, gw = blockIdx.x * (NT / 64) + (TIDX >> 6), ngw = gridDim.x * (NT / 64);
    for (int r = gw; r < R; r += ngw) {
        const float* x = r < RL ? xl + (size_t)r * D : xc + (size_t)(r - RL) * D; const float* sh = modv(p, l, r, which * 3 + 0); const float* sc = modv(p, l, r, which * 3 + 1);
#pragma unroll
        for (int i = 0; i < 4; ++i) { const int k = 4 * lane + 256 * i; const f32x4 xv = *(const f32x4*)(x + k), s = *(const f32x4*)(sc + k), hh = *(const f32x4*)(sh + k);
            u2v o; o.x = pk_bf16(xv[0] * (1.f + s[0]) + hh[0], xv[1] * (1.f + s[1]) + hh[1]); o.y = pk_bf16(xv[2] * (1.f + s[2]) + hh[2], xv[3] * (1.f + s[3]) + hh[3]);
            *(u2v*)(p.H + (size_t)r * D + k) = o; }
    }
}

__device__ __forceinline__ float wave_sum(float v) {
#pragma unroll
    for (int o = 1; o < 64; o <<= 1) v += __shfl_xor(v, o);
    return v;
}
__device__ __forceinline__ void ph_ada_fast(const P& p, float* lds) {
    float* sv = lds;
    float* red = lds + 3072;
    const int tid = TIDX;
    __syncthreads();
    for (int i = tid; i < 3 * D; i += NT) { const int j = i / D, k = i % D; sv[i] = siluf(j < 2 ? p.in[1][j * D + k] : p.in[3][k]); }
    __syncthreads();
    for (int u = blockIdx.x; u < 2 * 96; u += gridDim.x) {
        const int l = u / 96, n = (u % 96) * 64 + (tid & 63), ks = tid >> 6;
        const float* w = p.in[4] + (size_t)l * D * 6144 + n;
        float a0 = 0.f, a1 = 0.f, a2 = 0.f;
#pragma unroll 8
        for (int k = ks * 128; k < ks * 128 + 128; ++k) { const float wv = w[(size_t)k * 6144]; a0 += sv[k] * wv; a1 += sv[D + k] * wv; a2 += sv[2 * D + k] * wv; }
        red[(ks * 3 + 0) * 64 + (tid & 63)] = a0; red[(ks * 3 + 1) * 64 + (tid & 63)] = a1; red[(ks * 3 + 2) * 64 + (tid & 63)] = a2;
        __syncthreads();
        if (tid < 192) { const int j = tid >> 6, nl = tid & 63; float s = p.in[5][l * 6144 + (u % 96) * 64 + nl];
#pragma unroll
            for (int q = 0; q < 8; ++q) s += red[(q * 3 + j) * 64 + nl];
            p.MOD[(size_t)(l * 3 + j) * 6144 + (u % 96) * 64 + nl] = s; }
        __syncthreads();
    }
}
__device__ __forceinline__ void ph_hyF_fast(const P& p, const float* a3, float* lds) {
    float* at = lds;
    float* wt = lds + 64 * 65;
    const float mind = logf(1e-2f) / 1.5f, maxd = logf(1e-2f) / 0.3f;
    for (int u = blockIdx.x; u < (RB / 64) * 16; u += gridDim.x) {
        const int tid = TIDX; const int ct = u % 16, pt = u / 16, p0 = pt * 64, c0 = ct * 128;
        __syncthreads();
#pragma unroll
        for (int i = 0; i < 8; ++i) { const int e = tid + 512 * i; at[(e >> 6) * 65 + (e & 63)] = a3[(size_t)(p0 + (e >> 6)) * 64 + (e & 63)]; }
#pragma unroll
        for (int i = 0; i < 16; ++i) { const int e = tid + 512 * i; wt[e] = p.in[19][(size_t)(e >> 7) * 2048 + c0 + (e & 127)]; }
        __syncthreads();
        const int pos = tid & 63, cg = tid >> 6;
        float acc[16];
#pragma unroll
        for (int q = 0; q < 16; ++q) acc[q] = 0.f;
#pragma unroll 4
        for (int m = 0; m < 64; ++m) { const float a = at[pos * 65 + m];
#pragma unroll
            for (int q = 0; q < 16; ++q) acc[q] += a * wt[m * 128 + cg * 16 + q]; }
        int len, i0; hy_pos(p0 + pos, len, i0); const float tt = (float)i0 / (float)(len - 1);
#pragma unroll
        for (int q = 0; q < 16; ++q) { const int col = c0 + cg * 16 + q; const float delta = fabsf(mind + (float)(col % 512) * ((maxd - mind) / 511.f));
            p.FILT[(size_t)col * RB + p0 + pos] = acc[q] * expf(-tt * delta); }
    }
}
__device__ __forceinline__ void ph_retScan_fast(const P& p) {
    bf16_t* ST = p.Zh;
    GSTRIDE(idx, (long)2 * NB * 4 * 16384) {
        const int ed = idx % 16384, h = (idx / 16384) % 4, b = (idx / 65536) % NB, dir = idx / (65536 * NB);
        const float dc = expf((dir ? p.in[10] : p.in[9])[h] * 128.f);
        bf16_t* base = ST + st_idx(dir, b, h, 0) + ed;
        float s = 0.f;
#pragma unroll 1
        for (int c0 = 0; c0 < NCH; c0 += 11) {
            float u[11]; int cc[11];
#pragma unroll
            for (int j = 0; j < 11; ++j) { const int q = c0 + j; cc[j] = dir == 0 ? q : (q < 2 ? 1 - q : NCH + 1 - q); u[j] = bf2f(base[(size_t)cc[j] * 16384]); }
#pragma unroll
            for (int j = 0; j < 11; ++j) { base[(size_t)cc[j] * 16384] = f2bf(s); s = dc * s + u[j]; }
        }
    }
}
__device__ __forceinline__ void ph_glaScan_fast(const P& p) {
    const float* BF = p.BG; const float* BB = p.BG + (size_t)R * 512;
    GSTRIDE(idx, (long)2 * NB * 4 * 32768) {
        const int d = idx % 128, ed = idx % 32768, h = (idx / 32768) % 4, b = (idx / 131072) % NB, dir = idx / (131072 * NB);
        bf16_t* base = p.GST + gst_idx(dir, b, h, 0) + ed;
        float s = 0.f;
#pragma unroll 1
        for (int c0 = 0; c0 < NCH; c0 += 11) {
            float u[11], dcv[11]; int cc[11];
#pragma unroll
            for (int j = 0; j < 11; ++j) { const int q = c0 + j; cc[j] = dir == 0 ? q : (q < 2 ? 1 - q : NCH + 1 - q); const int r0 = chunk_row0(b, cc[j]);
                u[j] = bf2f(base[(size_t)cc[j] * 32768]); dcv[j] = dir == 0 ? BF[(size_t)(r0 + 127) * 512 + h * 128 + d] : BB[(size_t)r0 * 512 + h * 128 + d]; }
#pragma unroll
            for (int j = 0; j < 11; ++j) { base[(size_t)cc[j] * 32768] = f2bf(s); s = __expf(dcv[j]) * s + u[j]; }
        }
    }
}
__device__ __forceinline__ void ph_glagates_fast(const P& p, float* lds) {
    float* lr = lds;
    for (int u = blockIdx.x; u < NB * NCH * 2; u += gridDim.x) {
        const int tid = TIDX; const int dir = u % 2, c = (u / 2) % NCH, b = u / (2 * NCH); const int r0 = chunk_row0(b, c);
        __syncthreads();
        for (int e = tid; e < 128 * 16; e += NT) lr[e] = bf2f(p.Z1[(size_t)(r0 + (e >> 4)) * GINP + 3072 + dir * 16 + (e & 15)]);
        __syncthreads();
        const float* gw = (dir ? p.in[26] : p.in[24]); float g[16];
#pragma unroll
        for (int q = 0; q < 16; ++q) g[q] = gw[q * 512 + tid];
        const float gb = (dir ? p.in[27] : p.in[25])[tid];
        float* out = p.BG + ((size_t)dir * R + r0) * 512 + tid;
        float s = 0.f;
#pragma unroll 4
        for (int ii = 0; ii < 128; ++ii) { const int i = dir ? 127 - ii : ii; float acc = gb;
#pragma unroll
            for (int q = 0; q < 16; ++q) acc += lr[i * 16 + q] * g[q];
            s += logsigf(acc) * (1.f / 16.f); out[(size_t)i * 512] = s; }
    }
}
template <int MODE, bool ROUTE> __device__ __forceinline__ void ph_post_fast(const P& p, int l, int which, const bf16_t* Y, int ln, int wn, int nrows, const float* xl, const float* xc, float* lds) {
    const float* lg = p.in[6] + (size_t)(l * 2 + which) * D; const float* lb = p.in[7] + (size_t)(l * 2 + which) * D;
    const int tid = TIDX, lane = tid & 63, gw = blockIdx.x * (NT / 64) + (tid >> 6), ngw = gridDim.x * (NT / 64);
    if (ROUTE) { __syncthreads(); for (int e = tid; e < D * NE; e += NT) lds[(e & 15) * D + (e >> 4)] = p.in[29][e]; __syncthreads(); }
    int toff[16];
    if (MODE == 1) { int s = 0;
#pragma unroll
        for (int e = 0; e < 16; ++e) { toff[e] = s; s += (p.CNT[l * 16 + e] + 255) >> 8; } }
    for (int r = gw; r < nrows; r += ngw) {
        const float* x = r < RL ? xl + (size_t)r * D : xc + (size_t)(r - RL) * D; float* xo = xrow(p, r);
        const float* gate = modv(p, l, r, which * 3 + 2);
        const bf16_t *y0, *y1 = nullptr;
        if (MODE == 0) y0 = Y + (size_t)r * D;
        else { int sr[2];
#pragma unroll
            for (int k = 0; k < 2; ++k) { const int e = p.RE[r * 2 + k]; int to = 0;
#pragma unroll
                for (int q = 0; q < 16; ++q) to = (q == e) ? toff[q] : to;
                sr[k] = to * 256 + p.RPOS[r * 2 + k]; }
            y0 = p.slots + (size_t)sr[0] * D; y1 = p.slots + (size_t)sr[1] * D; }
        f32x4 v[4]; float s = 0.f;
#pragma unroll
        for (int i = 0; i < 4; ++i) { const int k = 4 * lane + 256 * i; const f32x4 xv = *(const f32x4*)(x + k), gv = *(const f32x4*)(gate + k);
            const u2v yu = *(const u2v*)(y0 + k); f32x4 yy = {__uint_as_float(yu.x << 16), __uint_as_float(yu.x & 0xffff0000u), __uint_as_float(yu.y << 16), __uint_as_float(yu.y & 0xffff0000u)};
            if (MODE == 1) { const u2v y2 = *(const u2v*)(y1 + k); yy += (f32x4){__uint_as_float(y2.x << 16), __uint_as_float(y2.x & 0xffff0000u), __uint_as_float(y2.y << 16), __uint_as_float(y2.y & 0xffff0000u)}; }
            v[i] = xv * ALPHA + gv * yy; s += (v[i][0] + v[i][1]) + (v[i][2] + v[i][3]); }
        const float mu = wave_sum(s) * (1.f / D); float q2 = 0.f;
#pragma unroll
        for (int i = 0; i < 4; ++i) { v[i] = v[i] - mu; q2 += (v[i][0] * v[i][0] + v[i][1] * v[i][1]) + (v[i][2] * v[i][2] + v[i][3] * v[i][3]); }
        const float rs = 1.f / sqrtf(wave_sum(q2) * (1.f / D) + LN_EPS);
        f32x4 hk[4];
#pragma unroll
        for (int i = 0; i < 4; ++i) { const int k = 4 * lane + 256 * i; const f32x4 xn = v[i] * rs * *(const f32x4*)(lg + k) + *(const f32x4*)(lb + k);
            *(f32x4*)(xo + k) = xn;
            if (ln >= 0) { const f32x4 h2 = xn * (*(const f32x4*)(modv(p, ln, r, wn * 3 + 1) + k) + 1.f) + *(const f32x4*)(modv(p, ln, r, wn * 3 + 0) + k);
                u2v o; o.x = pk_bf16(h2[0], h2[1]); o.y = pk_bf16(h2[2], h2[3]); *(u2v*)(p.H + (size_t)r * D + k) = o;
                if (ROUTE) hk[i] = h2; } }
        if (ROUTE) {
            int best = 0, i1 = 0, i2 = 0; float bs = -1e30f, a1 = 0.f, a2 = 0.f;
#pragma unroll 1
            for (int g = 0; g < NG; ++g) {
                float sg[4], sel[4];
#pragma unroll
                for (int q = 0; q < 4; ++q) { const float* wr = lds + (g * EPG + q) * D + 4 * lane; float a = 0.f;
#pragma unroll
                    for (int i = 0; i < 4; ++i) { const f32x4 wv = *(const f32x4*)(wr + 256 * i); a += (hk[i][0] * wv[0] + hk[i][1] * wv[1]) + (hk[i][2] * wv[2] + hk[i][3] * wv[3]); }
                    sg[q] = sigmf(wave_sum(a)); sel[q] = sg[q] + p.in[30][g * EPG + q]; }
                int j1 = 0; float v1 = sel[0];
#pragma unroll
                for (int q = 1; q < 4; ++q) if (sel[q] > v1) { v1 = sel[q]; j1 = q; }
                int j2 = -1; float v2 = -1e30f;
#pragma unroll
                for (int q = 0; q < 4; ++q) if (q != j1 && sel[q] > v2) { v2 = sel[q]; j2 = q; }
                if (v1 + v2 > bs) { bs = v1 + v2; best = g; i1 = j1; i2 = j2; a1 = 0.f; a2 = 0.f;
#pragma unroll
                    for (int q = 0; q < 4; ++q) { a1 = (q == j1) ? sg[q] : a1; a2 = (q == j2) ? sg[q] : a2; } }
            }
            if (lane == 0) { const int e1 = best * EPG + i1, e2 = best * EPG + i2;
                p.RE[r * 2] = e1; p.RE[r * 2 + 1] = e2; p.RWt[r * 2] = a1 / (a1 + a2); p.RWt[r * 2 + 1] = a2 / (a1 + a2);
                p.RPOS[r * 2] = atomicAdd(&p.CNT[l * 16 + e1], 1); p.RPOS[r * 2 + 1] = atomicAdd(&p.CNT[l * 16 + e2], 1); }
        }
    }
}

constexpr int N_STEPS = 34;
#define PG8_ALIGN true
#define PG8_SP2 true
template <class Epi> __device__ __forceinline__ void dense_gemm(LAS unsigned char* lds, const bf16_t* A, const bf16_t* Bt, int M, int N, int K, const Epi& E) {
    pg8::Gemm g{A, Bt, M, N, K}; pg8::StaticOrder S; S.init(M, N, (int)gridDim.x, (int)blockIdx.x);
    pg8::gemm_phase<Epi, pg8::StaticOrder, PG8_ALIGN, PG8_SP2>(lds, g, S, E);
}
__device__ __forceinline__ void moe_gemms(const P& p, LAS unsigned char* lds, int l, int which) {
    pg8::MoeOrder S; S.init(p.CNT + l * 16, (int)gridDim.x, (int)blockIdx.x);
    if (which == 0) { pg8::Gemm g{p.Hs, p.Wgu, 0, 0, 1024}; pg8::EpiSwiGLU E{p.he}; pg8::gemm_phase<pg8::EpiSwiGLU, pg8::MoeOrder, PG8_ALIGN, PG8_SP2>(lds, g, S, E); }
    else { pg8::Gemm g{p.he, p.Wd, 0, 0, 512}; pg8::EpiRowScale E{p.slots, p.WS}; pg8::gemm_phase<pg8::EpiRowScale, pg8::MoeOrder, PG8_ALIGN, PG8_SP2>(lds, g, S, E); }
}
__device__ __forceinline__ void run_step(const P& p, int step, unsigned char* smem) {
    LAS unsigned char* lds = (LAS unsigned char*)smem; float* fl = (float*)smem;
    float* conv = (float*)p.H;
    switch (step) {
        case 0: ph_ada_fast(p, fl); ph_wconv_fast(p, fl); ph_wconv_moe_fast(p, 0, fl); ph_hyA1(p); break;
        case 1: ph_mod_fast(p, 0, 0, p.in[0], p.in[2]); ph_hyA(p.A1, p.A2, p.in[15], p.in[16], p.in[20] + 64); break;
        case 2: { pg8::EpiSplit E{p.Zr, 2048, p.Zh, 1536, 2048}; dense_gemm(lds, p.H, p.Win0, R, ABIN, D, E); }
                ph_hyA(p.A2, p.A1, p.in[17], p.in[18], p.in[20] + 128); break;
        case 3: ph_prep_rope_fast(p); ph_prep_hy_fast(p, fl); ph_hyF_fast(p, p.A1, fl); break;
        case 4: ph_hyNorm(p, fl); ph_retU_mfma(p, smem); break;
        case 5: ph_retScan_fast(p); ph_hyena_fft(p, smem); break;
        case 6: break;
        case 7: break;
        case 8: break;
        case 9: ph_retO_mfma(p, smem); break;
        case 10: ph_hy_untranspose_fast(p, fl); break;
        case 11: { pg8::EpiSplit E{p.Zr, 1024, p.Zr, 1024, 1 << 30}; dense_gemm(lds, p.H, p.Wout0, R, D, D, E); } break;
        case 12: ph_post_fast<0, true>(p, 0, 0, p.Zr, 0, 1, R, p.in[0], p.in[2], fl); break;
        case 13: break;
        case 14: break;
        case 15: ph_permute(p, 0, R); break;
        case 16: moe_gemms(p, lds, 0, 0); break;
        case 17: moe_gemms(p, lds, 0, 1); break;
        case 18: ph_post_fast<1, false>(p, 0, 1, nullptr, 1, 0, R, p.out, p.Xc, fl); break;
        case 19: { pg8::EpiSplit E{p.Z1, GINP, p.Z1, GINP, 1 << 30}; dense_gemm(lds, p.H, p.Win1, R, GINP, D, E); } ph_wconv_moe_fast(p, 1, fl); break;
        case 20: ph_glagates_fast(p, fl); break;
        case 21: break;
        case 22: ph_glaU_mfma(p, smem); break;
        case 23: ph_glaScan_fast(p); break;
        case 24: ph_glaO_mfma(p, smem); break;
        case 25: break;
        case 26: { pg8::EpiSplit E{p.Zr, 1024, p.Zr, 1024, 1 << 30}; dense_gemm(lds, p.H, p.Wout1, RL, D, D, E); } break;
        case 27: ph_post_fast<0, true>(p, 1, 0, p.Zr, 1, 1, RL, p.out, p.Xc, fl); break;
        case 28: break;
        case 29: break;
        case 30: ph_permute(p, 1, RL); break;
        case 31: moe_gemms(p, lds, 1, 0); break;
        case 32: moe_gemms(p, lds, 1, 1); break;
        case 33: ph_post_fast<1, false>(p, 1, 1, nullptr, -1, 0, RL, p.out, p.Xc, fl); break;
    }
}
__global__ void __launch_bounds__(NT, 2) k_all(P p) {
    extern __shared__ __attribute__((aligned(16))) unsigned char smem[];
    cg::grid_group grid = cg::this_grid();
    volatile LAS unsigned* bst = (volatile LAS unsigned*)((LAS unsigned char*)smem + LDS_BYTES - 64);
    if (threadIdx.x < 2) bst[threadIdx.x] = 0u;
    __syncthreads();
    const XcdBarrier bar = xcd_barrier_post(p.BAR, bst);
#define STEP(n) run_step(p, n, smem); xcd_barrier(bar);
#define STEP_CG(n) run_step(p, n, smem); asm volatile("s_waitcnt vmcnt(0)" ::: "memory"); grid.sync();
    STEP_CG(0) STEP(1) STEP(2) STEP(3) STEP(4) STEP(5) STEP(9) STEP(10) STEP(11) STEP(12) STEP(15) STEP(16)
    STEP(17) STEP(18) STEP(19) STEP(20) STEP(22) STEP(23) STEP(24) STEP(26) STEP(27) STEP(30) STEP(31) STEP(32) run_step(p, 33, smem);
#undef STEP
#undef STEP_CG
}

extern "C" void kernel_launch(void* const* d_in, const int* in_sizes, int n_in, void* d_out, int out_size, void* d_ws, size_t ws_size, hipStream_t stream) {
    P p{};
    for (int i = 0; i < 34; ++i) p.in[i] = (const float*)d_in[i];
    p.out = (float*)d_out;
    unsigned char* w = (unsigned char*)d_ws; size_t off = 0;
    auto take = [&](size_t bytes) { unsigned char* r = w + off; off += (bytes + 255) & ~(size_t)255; return r; };
    p.NORM = (float*)take(2 * 2048 * 4); p.CNT = (int*)take(2 * 16 * 4); p.BAR = (unsigned*)take(XCD_BAR_WORDS * 4);
    const size_t ctl_bytes = off;
    p.Win1 = (bf16_t*)take((size_t)GINP * D * 2); p.Wout1 = (bf16_t*)take((size_t)D * D * 2);
    p.Wgu = (bf16_t*)take((size_t)NE * 1024 * 1024 * 2); p.Wd = (bf16_t*)take((size_t)NE * 1024 * 512 * 2);
    p.Xc = (float*)take((size_t)RCX * D * 4); p.MOD = (float*)take(2 * 3 * 6144 * 4);
    p.RS = (float*)take((size_t)R * NE * 4); p.RE = (int*)take((size_t)R * 2 * 4); p.RPOS = (int*)take((size_t)R * 2 * 4); p.RWt = (float*)take((size_t)R * 2 * 4);
    p.WS = (float*)take((size_t)MOE_ROWS * 4);
    const size_t big = off;
    p.H = (bf16_t*)take((size_t)R * D * 2);
    p.Zr = (bf16_t*)take((size_t)R * 2048 * 2);
    p.Zh = (bf16_t*)take((size_t)R * 1536 * 2);
    p.hyT = (bf16_t*)take((size_t)NB * 3 * 512 * RB * 2);
    p.FILT = (float*)take((size_t)2048 * RB * 4);
    p.Win0 = (bf16_t*)take((size_t)ABIN * D * 2); p.Wout0 = (bf16_t*)take((size_t)D * D * 2);
    p.A1 = (float*)take((size_t)RB * 64 * 4); p.A2 = (float*)take((size_t)RB * 64 * 4);
    const size_t total = off;
    off = big + (((size_t)R * D * 2 + 255) & ~(size_t)255);
    p.Hs = (bf16_t*)take((size_t)MOE_ROWS * D * 2); p.he = (bf16_t*)take((size_t)MOE_ROWS * EH * 2); p.slots = (bf16_t*)take((size_t)MOE_ROWS * D * 2);
    const size_t moe_end = off;
    off = big + (((size_t)R * D * 2 + 255) & ~(size_t)255);
    p.Z1 = (bf16_t*)take((size_t)R * GINP * 2); p.BG = (float*)take((size_t)2 * R * 512 * 4); p.GST = (bf16_t*)take((size_t)2 * NB * 4 * NCH * 32768 * 2);
    const size_t l1_end = off;
    if (total > ws_size || moe_end > total || l1_end > total || n_in != 34 || out_size != RL * D) {
        fprintf(stderr, "kernel_launch: bad sizes (need %zu ws bytes, have %zu; moe_end %zu l1_end %zu)\n", total, ws_size, moe_end, l1_end); return; }
    static int grid = 0;
    if (!grid) {
        int dev = 0, cus = 0, per = 0; hipGetDevice(&dev); hipDeviceGetAttribute(&cus, hipDeviceAttributeMultiprocessorCount, dev);
        hipFuncSetAttribute((const void*)k_all, hipFuncAttributeMaxDynamicSharedMemorySize, LDS_BYTES);
        hipOccupancyMaxActiveBlocksPerMultiprocessor(&per, k_all, NT, LDS_BYTES);
        if (per < 1) { fprintf(stderr, "kernel_launch: occupancy query says %d blocks per CU\n", per); per = 1; }
        grid = cus;
    }
    hipMemsetAsync(d_ws, 0, ctl_bytes, stream);
    void* args[] = {&p};
    hipError_t e = hipLaunchCooperativeKernel((void*)k_all, dim3(grid), dim3(NT), args, LDS_BYTES, stream);
    if (e != hipSuccess) fprintf(stderr, "coop launch failed: %s (grid %d)\n", hipGetErrorString(e), grid);
}
```

```cpp
#include <hip/hip_runtime.h>
#include <hip/hip_cooperative_groups.h>
#include <cstdio>
#include <cstdint>
namespace cg = cooperative_groups;


namespace pg8 {
#define PG8_LAS __attribute__((address_space(3)))
typedef unsigned short bf16_t;
typedef short bf16x8 __attribute__((ext_vector_type(8)));
typedef float f32x4 __attribute__((ext_vector_type(4)));
typedef unsigned u32x4 __attribute__((ext_vector_type(4)));
constexpr int BM = 256, BK = 64, HALF = 128, HTB = HALF * BK * 2  , STAGE_BYTES = 8 * HTB, NXCD = 8, WGM = 8;

__host__ __device__ __forceinline__ int lds_byte(int r, int c) { const int st = (r >> 4) * 2 + (c >> 5), rr = r & 15, cc = c & 31, ob = rr * 64 + cc * 2; return st * 1024 + (ob ^ (((ob >> 9) & 1) << 5)); }
__host__ __device__ __forceinline__ void stage_rc(int b, int& R, int& C) { const int st = b / 1024, sb = b % 1024, swz = sb ^ (((sb >> 9) & 1) << 5); R = (st >> 1) * 16 + swz / 64; C = (st & 1) * 32 + (swz % 64) / 2; }
__host__ __device__ __forceinline__ int perm32(int rho) { const int n = rho >> 4, i = rho & 15; return 8 * (i >> 2) + 4 * n + (i & 3); }

struct Unit { int pm, pn; };
struct Gemm { const bf16_t* A; const bf16_t* Bt; int M, N, K; };

struct StaticOrder {
    int nM, nN, nwg, G, c;
    __host__ __device__ void init(int M, int N, int G_, int c_) { nM = M / BM; nN = N / BM; nwg = nM * nN; G = G_; c = c_; }
    __host__ __device__ bool next(int i, Unit& u) const {
        const long L = (long)i * G + c; if (L >= nwg) return false;
        int wgid = (int)L; { const int q = nwg / NXCD, r = nwg % NXCD, xcd = wgid % NXCD, off = wgid / NXCD; wgid = (xcd < r ? xcd * (q + 1) : r * (q + 1) + (xcd - r) * q) + off; }
        const int nig = WGM * nN, gid = wgid / nig, fm = gid * WGM, gsz = (nM - fm) < WGM ? (nM - fm) : WGM;
        u.pm = fm + ((wgid % nig) % gsz); u.pn = (wgid % nig) / gsz; return true;
    }
    __device__ __forceinline__ void a_ready(const Unit&) const {}
    __device__ __forceinline__ void done(const Unit&) const {}
};


__device__ __forceinline__ unsigned cvt_pk_bf16(float lo, float hi) { unsigned r; asm volatile("v_cvt_pk_bf16_f32 %0, %1, %2" : "=v"(r) : "v"(lo), "v"(hi)); return r; }

template <class Epi, class Sched, bool ALIGN_EPI = false, bool SP2 = false>
__device__ __forceinline__ void gemm_phase(PG8_LAS unsigned char* lds, const Gemm g, const Sched& S, const Epi& E) {
    int tid_l = threadIdx.x; asm volatile("" : "+v"(tid_l)); const int tid = tid_l, wid = __builtin_amdgcn_readfirstlane(tid >> 6), lane = tid & 63, wr = wid >> 2, wc = wid & 3, fr = lane & 15, fq = lane >> 4;
    const int K = g.K, nt = K / BK;
    unsigned voffA[2], voffB[2];
#pragma unroll
    for (int i = 0; i < 2; ++i) { int R, C; stage_rc(tid * 16 + i * 8192, R, C); const int Rb = Epi::PERM ? ((R & ~31) + perm32(R & 31)) : R;
        voffA[i] = (unsigned)(R * K + C) * 2u; voffB[i] = (unsigned)(Rb * K + C) * 2u; }
    const size_t kstep = (size_t)(BK * 2);
    const size_t hstep = (size_t)HALF * K * 2;
    const size_t tstep = 2 * hstep;
    const unsigned ldsw = (unsigned)wid * 1024u;
    const int aoff = lds_byte(wr * 64 + fr, fq * 8), boff = lds_byte(wc * 32 + fr, fq * 8);
#define PG8_SA(b, h) (((b) * 2 + (h)) * HTB)
#define PG8_SB(b, h) ((4 + (b) * 2 + (h)) * HTB)
#define PG8_STAGE(bufoff, gbase, voff) do { _Pragma("unroll") for (int _i = 0; _i < 2; ++_i) \
        __builtin_amdgcn_global_load_lds((const unsigned*)((const char*)(gbase) + (voff)[_i]), (PG8_LAS unsigned*)(lds + (bufoff) + ldsw + _i * 8192), 16, 0, 0); } while (0)
#define PG8_LDA(dst, b, h) do { _Pragma("unroll") for (int m = 0; m < 4; ++m) _Pragma("unroll") for (int k = 0; k < 2; ++k) dst[m][k] = *(const PG8_LAS bf16x8*)(lds + PG8_SA(b, h) + aoff + m * 2048 + k * 1024); } while (0)
#define PG8_LDB(dst, b, h) do { _Pragma("unroll") for (int n = 0; n < 2; ++n) _Pragma("unroll") for (int k = 0; k < 2; ++k) dst[n][k] = *(const PG8_LAS bf16x8*)(lds + PG8_SB(b, h) + boff + n * 2048 + k * 1024); } while (0)
#define PG8_MMA(ai, bj, At, Bt) do { __builtin_amdgcn_s_setprio(1); _Pragma("unroll") for (int m = 0; m < 4; ++m) _Pragma("unroll") for (int n = 0; n < 2; ++n) _Pragma("unroll") for (int k = 0; k < 2; ++k) \
        acc[ai][bj][m][n] = __builtin_amdgcn_mfma_f32_16x16x32_bf16(Bt[n][k], At[m][k], acc[ai][bj][m][n], 0, 0, 0); __builtin_amdgcn_s_setprio(0); } while (0)
#define PG8_WAIT_V(n) asm volatile("s_waitcnt vmcnt(" #n ")" ::: "memory")
#define PG8_WAIT_L(n) asm volatile("s_waitcnt lgkmcnt(" #n ")" ::: "memory")
#define PG8_BAR __builtin_amdgcn_s_barrier()
#define PG8_SCHED __builtin_amdgcn_sched_barrier(0)
    Unit cur, nxt; int ui = 0;
    if (!S.next(0, cur)) return;
    f32x4 acc[2][2][4][2];
#pragma unroll
    for (int a = 0; a < 2; ++a)
#pragma unroll
        for (int b = 0; b < 2; ++b)
#pragma unroll
            for (int m = 0; m < 4; ++m)
#pragma unroll
                for (int n = 0; n < 2; ++n) acc[a][b][m][n] = (f32x4){0.f, 0.f, 0.f, 0.f};
    bf16x8 At[4][2], B0[2][2], B1[2][2];
    const char* cA = (const char*)g.A + (size_t)cur.pm * tstep; const char* cB = (const char*)g.Bt + (size_t)cur.pn * tstep;
    S.a_ready(cur);
    if constexpr (SP2) {
        PG8_STAGE(PG8_SB(0, 0), cB, voffB); PG8_STAGE(PG8_SB(0, 1), cB + hstep, voffB); PG8_STAGE(PG8_SA(0, 0), cA, voffA); PG8_STAGE(PG8_SA(0, 1), cA + hstep, voffA);
        if (wr == 1) PG8_BAR;
        PG8_WAIT_V(2); PG8_BAR;
        PG8_STAGE(PG8_SB(1, 0), cB + kstep, voffB); PG8_STAGE(PG8_SA(1, 0), cA + kstep, voffA); PG8_STAGE(PG8_SB(1, 1), cB + hstep + kstep, voffB);
        PG8_WAIT_V(6); PG8_BAR;
    } else {
        PG8_STAGE(PG8_SB(0, 0), cB, voffB); PG8_STAGE(PG8_SA(0, 0), cA, voffA); PG8_STAGE(PG8_SB(0, 1), cB + hstep, voffB); PG8_STAGE(PG8_SA(0, 1), cA + hstep, voffA);
        if (wr == 1) PG8_BAR;
        PG8_WAIT_V(4); PG8_BAR;
        PG8_STAGE(PG8_SB(1, 0), cB + kstep, voffB); PG8_STAGE(PG8_SA(1, 0), cA + kstep, voffA); PG8_STAGE(PG8_SB(1, 1), cB + hstep + kstep, voffB);
        PG8_WAIT_V(6); PG8_BAR;
    }
    for (;;) {
        const bool has_next = S.next(ui + 1, nxt);
        const char* nA = has_next ? (const char*)g.A + (size_t)nxt.pm * tstep : cA; const char* nB = has_next ? (const char*)g.Bt + (size_t)nxt.pn * tstep : cB;
        for (int t = 0; t < nt; t += 2) {
            const bool last = (t == nt - 2);
            const char* a1 = cA + (size_t)(t + 1) * kstep;
            const char* a2 = last ? nA : cA + (size_t)(t + 2) * kstep; const char* b2 = last ? nB : cB + (size_t)(t + 2) * kstep;
            const char* a3 = a2 + kstep; const char* b3 = b2 + kstep;
            if (last && has_next) S.a_ready(nxt);
            if constexpr (SP2) {
            PG8_LDB(B0, 0, 0); PG8_LDB(B1, 0, 1); PG8_SCHED; PG8_LDA(At, 0, 0); PG8_STAGE(PG8_SA(1, 1), a1 + hstep, voffA);
            PG8_WAIT_V(8); PG8_WAIT_L(0); PG8_BAR; PG8_MMA(0, 0, At, B0); PG8_MMA(0, 1, At, B1); PG8_BAR; PG8_SCHED;
            PG8_LDA(At, 0, 1); PG8_STAGE(PG8_SB(0, 0), b2, voffB); PG8_STAGE(PG8_SB(0, 1), b2 + hstep, voffB); PG8_STAGE(PG8_SA(0, 0), a2, voffA);
            PG8_WAIT_V(8); PG8_WAIT_L(0); PG8_BAR; PG8_MMA(1, 0, At, B0); PG8_MMA(1, 1, At, B1); PG8_BAR; PG8_SCHED;
            PG8_LDB(B0, 1, 0); PG8_LDB(B1, 1, 1); PG8_SCHED; PG8_LDA(At, 1, 0); PG8_STAGE(PG8_SA(0, 1), a2 + hstep, voffA);
            PG8_WAIT_V(8); PG8_WAIT_L(0); PG8_BAR; PG8_MMA(0, 0, At, B0); PG8_MMA(0, 1, At, B1); PG8_BAR; PG8_SCHED;
            PG8_LDA(At, 1, 1); PG8_STAGE(PG8_SB(1, 0), b3, voffB); PG8_STAGE(PG8_SB(1, 1), b3 + hstep, voffB); PG8_STAGE(PG8_SA(1, 0), a3, voffA);
            PG8_WAIT_V(8); PG8_WAIT_L(0); PG8_BAR; PG8_MMA(1, 0, At, B0); PG8_MMA(1, 1, At, B1); PG8_BAR; PG8_SCHED;
            } else {
            PG8_LDB(B0, 0, 0); PG8_SCHED; PG8_LDA(At, 0, 0); PG8_STAGE(PG8_SA(1, 1), a1 + hstep, voffA);
            PG8_WAIT_L(8); PG8_BAR; PG8_WAIT_L(0); PG8_MMA(0, 0, At, B0); PG8_BAR; PG8_SCHED;
            PG8_LDB(B1, 0, 1); PG8_STAGE(PG8_SB(0, 0), b2, voffB);
            PG8_BAR; PG8_WAIT_L(0); PG8_MMA(0, 1, At, B1); PG8_BAR;
            PG8_LDA(At, 0, 1); PG8_STAGE(PG8_SA(0, 0), a2, voffA);
            PG8_BAR; PG8_WAIT_L(0); PG8_MMA(1, 0, At, B0); PG8_BAR; PG8_SCHED;
            PG8_STAGE(PG8_SB(0, 1), b2 + hstep, voffB);
            PG8_WAIT_V(6); PG8_BAR; PG8_MMA(1, 1, At, B1); PG8_BAR;
            PG8_LDB(B0, 1, 0); PG8_SCHED; PG8_LDA(At, 1, 0); PG8_STAGE(PG8_SA(0, 1), a2 + hstep, voffA);
            PG8_WAIT_L(8); PG8_BAR; PG8_WAIT_L(0); PG8_MMA(0, 0, At, B0); PG8_BAR; PG8_SCHED;
            PG8_LDB(B1, 1, 1); PG8_STAGE(PG8_SB(1, 0), b3, voffB);
            PG8_BAR; PG8_WAIT_L(0); PG8_MMA(0, 1, At, B1); PG8_BAR;
            PG8_LDA(At, 1, 1); PG8_STAGE(PG8_SA(1, 0), a3, voffA);
            PG8_BAR; PG8_WAIT_L(0); PG8_MMA(1, 0, At, B0); PG8_BAR; PG8_SCHED;
            PG8_STAGE(PG8_SB(1, 1), b3 + hstep, voffB);
            PG8_WAIT_V(6); PG8_BAR; PG8_MMA(1, 1, At, B1); PG8_BAR;
            }
        }
        if constexpr (ALIGN_EPI) { if (wr == 0) PG8_BAR; }
        if constexpr (!Epi::AFTER_DRAIN) { E(acc, cur, wr, wc, fr, fq); S.done(cur); }
        if (!has_next) break;
#pragma unroll
        for (int a = 0; a < 2; ++a)
#pragma unroll
            for (int b = 0; b < 2; ++b)
#pragma unroll
                for (int m = 0; m < 4; ++m)
#pragma unroll
                    for (int n = 0; n < 2; ++n) acc[a][b][m][n] = (f32x4){0.f, 0.f, 0.f, 0.f};
        cur = nxt; cA = nA; cB = nB; ++ui;
        if constexpr (ALIGN_EPI) { if (wr == 1) PG8_BAR; }
    }
    PG8_WAIT_V(0);
    if constexpr (!ALIGN_EPI) { if (wr == 0) PG8_BAR; }
    PG8_BAR;
    if constexpr (Epi::AFTER_DRAIN) { E.fused(acc, cur, wr, wc, fr, fq, lds, wid, lane); S.done(cur); }
#undef PG8_SA
#undef PG8_SB
#undef PG8_STAGE
#undef PG8_LDA
#undef PG8_LDB
#undef PG8_MMA
#undef PG8_WAIT_V
#undef PG8_WAIT_L
#undef PG8_BAR
#undef PG8_SCHED
}
}

typedef float f2v_t __attribute__((ext_vector_type(2)));
typedef __bf16 b2v_t __attribute__((ext_vector_type(2)));
__device__ __forceinline__ unsigned pk_bf16(float lo, float hi) { const f2v_t f = {lo, hi}; const b2v_t b = __builtin_convertvector(f, b2v_t); return __builtin_bit_cast(unsigned, b); }
namespace pg8 {
typedef unsigned u32x2 __attribute__((ext_vector_type(2)));
struct EpiSplit {
    static constexpr bool PERM = true, AFTER_DRAIN = false;
    bf16_t* O0; int ld0; bf16_t* O1; int ld1; int split_col;
    __device__ __forceinline__ void operator()(const f32x4 (&acc)[2][2][4][2], const Unit& u, int wr, int wc, int fr, int fq) const {
        const int row0 = u.pm * BM + wr * 64 + fr; int colt = u.pn * BM; bf16_t* base = O0; int ldc = ld0;
        if (colt >= split_col) { base = O1; ldc = ld1; colt -= split_col; }
        const int col0 = colt + wc * 32 + 8 * fq;
#pragma unroll
        for (int ai = 0; ai < 2; ++ai)
#pragma unroll
            for (int m = 0; m < 4; ++m) { bf16_t* rowp = base + (size_t)(row0 + ai * HALF + m * 16) * ldc + col0;
#pragma unroll
                for (int bj = 0; bj < 2; ++bj) { const f32x4 v0 = acc[ai][bj][m][0], v1 = acc[ai][bj][m][1];
                    u32x4 w; w.x = ::pk_bf16(v0[0], v0[1]); w.y = ::pk_bf16(v0[2], v0[3]); w.z = ::pk_bf16(v1[0], v1[1]); w.w = ::pk_bf16(v1[2], v1[3]);
                    *(u32x4*)(rowp + bj * HALF) = w; } }
    }
};
struct EpiSwiGLU {
    static constexpr bool PERM = true, AFTER_DRAIN = false;
    bf16_t* O;
    __device__ __forceinline__ void operator()(const f32x4 (&acc)[2][2][4][2], const Unit& u, int wr, int wc, int fr, int fq) const {
        const int row0 = u.pm * BM + wr * 64 + fr; const int j0 = (u.pn & 3) * 128 + wc * 16 + 4 * fq;
#pragma unroll
        for (int ai = 0; ai < 2; ++ai)
#pragma unroll
            for (int m = 0; m < 4; ++m) { bf16_t* rowp = O + (size_t)(row0 + ai * HALF + m * 16) * 512 + j0;
#pragma unroll
                for (int bj = 0; bj < 2; ++bj) { const f32x4 g = acc[ai][bj][m][0], up = acc[ai][bj][m][1]; float h[4];
#pragma unroll
                    for (int q = 0; q < 4; ++q) h[q] = g[q] / (1.f + __expf(-g[q])) * up[q];
                    u32x2 w; w.x = ::pk_bf16(h[0], h[1]); w.y = ::pk_bf16(h[2], h[3]);
                    *(u32x2*)(rowp + bj * 64) = w; } }
    }
};
struct EpiRowScale {
    static constexpr bool PERM = true, AFTER_DRAIN = false;
    bf16_t* O; const float* ws;
    __device__ __forceinline__ void operator()(const f32x4 (&acc)[2][2][4][2], const Unit& u, int wr, int wc, int fr, int fq) const {
        const int row0 = u.pm * BM + wr * 64 + fr; const int col0 = (u.pn & 3) * BM + wc * 32 + 8 * fq;
#pragma unroll
        for (int ai = 0; ai < 2; ++ai)
#pragma unroll
            for (int m = 0; m < 4; ++m) { const int row = row0 + ai * HALF + m * 16; const float s = ws[row]; bf16_t* rowp = O + (size_t)row * 1024 + col0;
#pragma unroll
                for (int bj = 0; bj < 2; ++bj) { const f32x4 v0 = acc[ai][bj][m][0] * s, v1 = acc[ai][bj][m][1] * s;
                    u32x4 w; w.x = ::pk_bf16(v0[0], v0[1]); w.y = ::pk_bf16(v0[2], v0[3]); w.z = ::pk_bf16(v1[0], v1[1]); w.w = ::pk_bf16(v1[2], v1[3]);
                    *(u32x4*)(rowp + bj * HALF) = w; } }
    }
};
struct MoeOrder {
    int G, c, nt; int toff[16];
    __device__ __forceinline__ void init(const int* cnt, int G_, int c_) { G = G_; c = c_; int s = 0;
#pragma unroll
        for (int e = 0; e < 16; ++e) { toff[e] = s; s += (cnt[e] + 255) >> 8; } nt = s; }
    __device__ __forceinline__ bool next(int i, Unit& u) const {
        const int Lq = i * G + c; if (Lq >= nt * 4) return false;
        const int pm = Lq % nt, pn4 = Lq / nt; int e = 0;
#pragma unroll
        for (int q = 1; q < 16; ++q) e += (pm >= toff[q]) ? 1 : 0;
        u.pm = pm; u.pn = e * 4 + pn4; return true; }
    __device__ __forceinline__ void a_ready(const Unit&) const {}
    __device__ __forceinline__ void done(const Unit&) const {}
};
}

constexpr int NB = 2, L = 8192, D = 1024, CTX = 256, RB = L + CTX;
constexpr int RL = NB * L, RCX = NB * CTX, R = RL + RCX;
constexpr int GW = 64;
constexpr int NCH = 66;
constexpr int ABIN = 3584, GIN = 3104, GINP = 3328;
constexpr int NE = 16, NG = 4, EPG = 4, EH = 512;
constexpr int MOE_ROWS = 37888;
constexpr float ALPHA = 1.4142135623730951f, LN_EPS = 1e-5f, KSCALE = 0.08838834764831845f;
constexpr int NT = 512;
constexpr int LDS_BYTES = 147456;

typedef unsigned short bf16_t;
#define LAS __attribute__((address_space(3)))
__device__ __forceinline__ float bf2f(bf16_t v) { return __uint_as_float((unsigned)v << 16); }
__device__ __forceinline__ bf16_t f2bf(float f) { unsigned u = __float_as_uint(f); return (bf16_t)((u + 0x7fffu + ((u >> 16) & 1u)) >> 16); }
__device__ __forceinline__ float siluf(float x) { return x / (1.f + expf(-x)); }
__device__ __forceinline__ float sigmf(float x) { return 1.f / (1.f + expf(-x)); }
__device__ __forceinline__ float logsigf(float x) { return fminf(x, 0.f) - log1pf(expf(-fabsf(x))); }

struct P {
    const float* in[34];
    float* out;
    float* Xc;
    float* MOD;
    float* NORM;
    int* CNT;
    unsigned* BAR;
    float* A1; float* A2;
    float* RS; int* RE; int* RPOS; float* RWt; float* WS;
    bf16_t *Win0, *Wout0, *Win1, *Wout1, *Wgu, *Wd;
    bf16_t* H;
    bf16_t* Zr;
    bf16_t* Zh;
    bf16_t* hyT;
    float* FILT;
    bf16_t *Hs, *he, *slots;
    bf16_t* Z1;
    float* BG;
    bf16_t* GST;
};

__device__ __forceinline__ int launder_i(int x) { asm volatile("" : "+v"(x)); return x; }
#define TIDX launder_i((int)threadIdx.x)
#define GSTRIDE(i, n) for (long i = (long)blockIdx.x * blockDim.x + TIDX; i < (long)(n); i += (long)gridDim.x * blockDim.x)

__device__ __forceinline__ float* xrow(const P& p, int r) { return r < RL ? p.out + (size_t)r * D : p.Xc + (size_t)(r - RL) * D; }
__device__ __forceinline__ int seg_of(int r) { return r < RL ? r / L : 2; }
__device__ __forceinline__ const float* modv(const P& p, int l, int r, int chunk) { return p.MOD + ((size_t)(l * 3 + seg_of(r)) * 6 + chunk) * D; }
__device__ __forceinline__ int chunk_row0(int b, int c) { return c < 2 ? RL + b * CTX + c * 128 : b * L + (c - 2) * 128; }
__device__ __forceinline__ void row_bt(int r, int& b, int& tl) { if (r < RL) { b = r / L; tl = r % L; } else { b = (r - RL) / CTX; tl = L + (r - RL) % CTX; } }
__device__ __forceinline__ int bt_row(int b, int tl) { return tl < L ? b * L + tl : RL + b * CTX + (tl - L); }

#define XB_TMO      128
#define XB_XCNT(j)  (256  + 64 * (j))
#define XB_XSUB(j)  (1280 + 64 * (j))
#define XB_XGEN(j)  (2304 + 64 * (j))
#define XB_TOP      3328
#define XB_TOPGEN   3392
#define XCD_BAR_WORDS 3456
#define XB_SPIN_CAP (1u << 18)

__device__ __forceinline__ unsigned xb_ld(unsigned* p)              { return __hip_atomic_load(p, __ATOMIC_RELAXED, __HIP_MEMORY_SCOPE_AGENT); }
__device__ __forceinline__ unsigned xb_add(unsigned* p, unsigned v) { return __hip_atomic_fetch_add(p, v, __ATOMIC_RELAXED, __HIP_MEMORY_SCOPE_AGENT); }
__device__ __forceinline__ unsigned xb_xcc_id() { return (unsigned)__builtin_amdgcn_s_getreg((3 << 11) | 20) & 0xFu; }
#define XB_SPIN(cond, bar) do { unsigned _sp = 0; while (cond) { __builtin_amdgcn_s_sleep(1); \
    if ((++_sp & 255u) == 0u) { if (xb_ld(&(bar)[XB_TMO])) break; if (_sp > XB_SPIN_CAP) { atomicAdd(&(bar)[XB_TMO], 1u); break; } } } } while (0)

struct XcdBarrier {
    unsigned* bar; unsigned x;
    volatile LAS unsigned* st;
};

__device__ __forceinline__ XcdBarrier xcd_barrier_post(unsigned* bar, volatile LAS unsigned* st) {
    XcdBarrier b; b.bar = bar; b.x = xb_xcc_id(); b.st = st;
    if (threadIdx.x == 0) (void)xb_add(&bar[XB_XCNT(b.x)], 1u);
    return b;
}
__device__ __forceinline__ void xcd_barrier_complete(unsigned* bar, unsigned x, unsigned& nloc, unsigned& nx) {
    const unsigned G = gridDim.x * gridDim.y * gridDim.z;
    unsigned sum, cnt, mine, sp = 0u;
    for (;;) {
        sum = 0u; cnt = 0u; mine = 0u;
#pragma unroll
        for (unsigned j = 0; j < 16; ++j) { const unsigned c = xb_ld(&bar[XB_XCNT(j)]); sum += c; cnt += (c > 0u) ? 1u : 0u; mine = (j == x) ? c : mine; }
        if (sum == G) break;
        __builtin_amdgcn_s_sleep(1);
        if ((++sp & 255u) == 0u) { if (xb_ld(&bar[XB_TMO])) break; if (sp > XB_SPIN_CAP) { atomicAdd(&bar[XB_TMO], 1u); break; } }
    }
    nloc = mine > 0u ? mine : 1u; nx = cnt > 0u ? cnt : 1u;
}

__device__ __forceinline__ void xcd_barrier(const XcdBarrier& b) {
    asm volatile("s_waitcnt vmcnt(0)" ::: "memory");
    __syncthreads();
    if (threadIdx.x == 0) {
        unsigned* bar = b.bar;
        __builtin_amdgcn_s_waitcnt(0);
        unsigned nloc = b.st[0], nx = b.st[1];
        if (nloc == 0u) { xcd_barrier_complete(bar, b.x, nloc, nx); b.st[0] = nloc; b.st[1] = nx; }
        const unsigned old = xb_add(&bar[XB_XSUB(b.x)], 1u);
        const unsigned gen = old / nloc;
        if (old + 1u == (gen + 1u) * nloc) {
            __builtin_amdgcn_fence(__ATOMIC_RELEASE, "agent");
            asm volatile("s_waitcnt vmcnt(0)" ::: "memory");
            const unsigned og = xb_add(&bar[XB_TOP], 1u);
            const unsigned tg = og / nx;
            if (og + 1u == (tg + 1u) * nx) xb_add(&bar[XB_TOPGEN], 1u);
            else XB_SPIN(xb_ld(&bar[XB_TOPGEN]) == tg, bar);
            __builtin_amdgcn_fence(__ATOMIC_ACQUIRE, "agent");
            xb_add(&bar[XB_XGEN(b.x)], 1u);
            asm volatile("s_waitcnt vmcnt(0)" ::: "memory");
        } else {
            XB_SPIN(xb_ld(&bar[XB_XGEN(b.x)]) == gen, bar);
            __builtin_amdgcn_fence(__ATOMIC_ACQUIRE, "agent");
            asm volatile("s_waitcnt vmcnt(0)" ::: "memory");
        }
    }
    __syncthreads();
}

__device__ __forceinline__ void ph_wconv(bf16_t* dst, const float* src, int N, int K, int ldsrc, int nvalid) {
    GSTRIDE(idx, (long)N * K) { const int k = idx % K, n = idx / K; dst[idx] = n < nvalid ? f2bf(src[(size_t)k * ldsrc + n]) : (bf16_t)0; }
}
__device__ __forceinline__ void ph_wconv_moe(const P& p, int l) {
    GSTRIDE(idx, (long)NE * 1024 * 1024) {
        const int k = idx % 1024, n = (idx / 1024) % 1024, e = idx / (1024 * 1024);
        const int q = n >> 3, r = n & 7, j = 4 * q + (r & 3);
        const float* src = (r < 4 ? p.in[31] : p.in[32]) + ((size_t)(l * NE + e) * D + k) * EH + j;
        p.Wgu[idx] = f2bf(*src);
    }
    GSTRIDE(idx, (long)NE * 1024 * 512) {
        const int k = idx % 512, n = (idx / 512) % 1024, e = idx / (512 * 1024);
        p.Wd[idx] = f2bf(p.in[33][((size_t)(l * NE + e) * EH + k) * D + n]);
    }
}
__device__ __forceinline__ void ph_ada(const P& p) {
    GSTRIDE(idx, 2 * 3 * 6144) {
        const int n = idx % 6144, j = (idx / 6144) % 3, l = idx / (3 * 6144);
        const float* cv = j < 2 ? p.in[1] + j * D : p.in[3];
        const float* w = p.in[4] + (size_t)l * D * 6144;
        float acc = p.in[5][l * 6144 + n];
        for (int k = 0; k < D; ++k) acc += siluf(cv[k]) * w[(size_t)k * 6144 + n];
        p.MOD[idx] = acc;
    }
}
__device__ __forceinline__ void ph_init(const P& p) {
    GSTRIDE(i, (long)RL * D) p.out[i] = p.in[0][i];
    GSTRIDE(i, (long)RCX * D) p.Xc[i] = p.in[2][i];
}
__device__ __forceinline__ void hy_pos(int pidx, int& len, int& i) { if (pidx < L) { len = L; i = pidx; } else { len = CTX; i = pidx - L; } }
__device__ __forceinline__ void ph_hyA1(const P& p) {
    GSTRIDE(idx, (long)RB * 64) {
        const int j = idx % 64, pidx = idx / 64; int len, i; hy_pos(pidx, len, i);
        const float t = (float)i / (float)(len - 1);
        const float w = 2.0f * 3.14159265358979323846f * (float)i / (float)len;
        const float* w1 = p.in[13];
        float acc = p.in[14][j] + t * w1[j];
        for (int m = 0; m < 16; ++m) {
            const float f = 1e-4f + (float)m * ((15.f - 1e-4f) / 15.f);
            acc += cosf(f * w) * w1[(1 + m) * 64 + j] - sinf(f * w) * w1[(17 + m) * 64 + j];
        }
        p.A1[idx] = sinf(p.in[20][j] * acc);
    }
}
__device__ __forceinline__ void ph_hyA(const float* src, float* dst, const float* w, const float* bias, const float* freq) {
    GSTRIDE(idx, (long)RB * 64) {
        const int j = idx % 64, pidx = idx / 64;
        float acc = bias[j];
        for (int i = 0; i < 64; ++i) acc += src[(size_t)pidx * 64 + i] * w[i * 64 + j];
        dst[idx] = sinf(freq[j] * acc);
    }
}
__device__ __forceinline__ void ph_hyF(const P& p, const float* a3) {
    const float mind = logf(1e-2f) / 1.5f, maxd = logf(1e-2f) / 0.3f;
    GSTRIDE(idx, (long)2048 * RB) {
        const int pidx = idx % RB, col = idx / RB, ch = col % 512; int len, i; hy_pos(pidx, len, i);
        const float t = (float)i / (float)(len - 1);
        float acc = 0.f;
        for (int m = 0; m < 64; ++m) acc += a3[(size_t)pidx * 64 + m] * p.in[19][m * 2048 + col];
        const float delta = fabsf(mind + (float)ch * ((maxd - mind) / 511.f));
        p.FILT[idx] = acc * expf(-t * delta);
    }
}
__device__ __forceinline__ float block_sum(float v, float* red);
__device__ __forceinline__ void ph_hyNorm(const P& p, float* red) {
    for (int u = blockIdx.x; u < 2 * 2048; u += gridDim.x) {
        const int col = u % 2048, which = u / 2048; const int p0 = which ? L : 0, n = which ? CTX : L;
        float s = 0.f;
        for (int i = TIDX; i < n; i += NT) { const float v = p.FILT[(size_t)col * RB + p0 + i]; s += v * v; }
        const float t = block_sum(s, red);
        if (TIDX == 0) p.NORM[which * 2048 + col] = t;
    }
}
__device__ __forceinline__ void ph_mod(const P& p, int l, int which) {
    GSTRIDE(i, (long)R * D) {
        const int r = i / D, k = i % D;
        p.H[i] = f2bf(xrow(p, r)[k] * (1.f + modv(p, l, r, which * 3 + 1)[k]) + modv(p, l, r, which * 3 + 0)[k]);
    }
}
__device__ __forceinline__ void ph_prep_rope(const P& p) {
    GSTRIDE(i, (long)R * 2 * 4 * 64) {
        const int pr = i % 64, h = (i / 64) % 4, w = (i / 256) % 2, r = i / 512;
        bf16_t* base = p.Zr + (size_t)r * 2048 + w * 512 + h * 128;
        float t1 = bf2f(base[pr]), t2 = bf2f(base[64 + pr]);
        if (w == 1) { t1 *= KSCALE; t2 *= KSCALE; }
        if (r < RL) {
            const int t = r % L, row = t / GW, col = t % GW;
            const float inv = powf(10000.f, -(float)(pr & 31) / 32.f);
            const float ang = (pr < 32 ? (float)row : (float)col) * inv;
            float sn, cs; sincosf(ang, &sn, &cs);
            const float a = t1 * cs - t2 * sn, bb = t1 * sn + t2 * cs; t1 = a; t2 = bb;
        }
        base[pr] = f2bf(t1); base[64 + pr] = f2bf(t2);
    }
}
__device__ __forceinline__ void ph_prep_hy(const P& p) {
    GSTRIDE(idx, (long)NB * 1536 * RB) {
        const int tl = idx % RB, col = (idx / RB) % 1536, b = idx / (RB * 1536);
        const int s0 = tl < L ? 0 : L, s1 = tl < L ? L : RB;
        const float* w = p.in[11];
        float acc = p.in[12][col] + w[1536 + col] * bf2f(p.Zh[(size_t)bt_row(b, tl) * 1536 + col]);
        if (tl - 1 >= s0) acc += w[col] * bf2f(p.Zh[(size_t)bt_row(b, tl - 1) * 1536 + col]);
        if (tl + 1 < s1) acc += w[2 * 1536 + col] * bf2f(p.Zh[(size_t)bt_row(b, tl + 1) * 1536 + col]);
        p.hyT[idx] = f2bf(acc);
    }
}
__device__ __forceinline__ float hy_tapT(const float* Ff, const float* Fb, float nf, float nb, int d) {
    if (d > 0) return Ff[d] * nf; if (d < 0) return Fb[-d] * nb; return Ff[0] * nf + Fb[0] * nb;
}
__device__ __forceinline__ void ph_hyconv_naive(const P& p, int n, float* conv) {
    GSTRIDE(idx, (long)NB * 512 * (RB / 4)) {
        const int tb = idx % (RB / 4), ch = (idx / (RB / 4)) % 512, b = idx / ((RB / 4) * 512);
        const int tl0 = tb * 4, s0 = tl0 < L ? 0 : L, len = tl0 < L ? L : CTX, nrm = tl0 < L ? 0 : 1, t0 = tl0 - s0;
        const int cf = (n * 2 + 0) * 512 + ch, cb = (n * 2 + 1) * 512 + ch;
        const float nf = 1.f / sqrtf(p.NORM[nrm * 2048 + cf]), nb = 1.f / sqrtf(p.NORM[nrm * 2048 + cb]);
        const float* Ff = p.FILT + (size_t)cf * RB + s0; const float* Fb = p.FILT + (size_t)cb * RB + s0;
        const bf16_t* z = p.hyT + ((size_t)(b * 3 + 2) * 512 + ch) * RB + s0;
        float w0 = hy_tapT(Ff, Fb, nf, nb, t0), w1 = hy_tapT(Ff, Fb, nf, nb, t0 + 1), w2 = hy_tapT(Ff, Fb, nf, nb, t0 + 2), w3 = hy_tapT(Ff, Fb, nf, nb, t0 + 3);
        float a0 = 0.f, a1 = 0.f, a2 = 0.f, a3 = 0.f;
        for (int s = 0; s < len; ++s) {
            const float zz = bf2f(z[s]);
            a0 += w0 * zz; a1 += w1 * zz; a2 += w2 * zz; a3 += w3 * zz;
            w3 = w2; w2 = w1; w1 = w0;
            if (s + 1 < len) w0 = hy_tapT(Ff, Fb, nf, nb, t0 - (s + 1));
        }
        float* o = conv + ((size_t)b * 512 + ch) * RB + tl0; o[0] = a0; o[1] = a1; o[2] = a2; o[3] = a3;
    }
}
__device__ __forceinline__ void ph_hygate_naive(const P& p, int n, const float* conv) {
    bf16_t* yhT = p.Zh + (size_t)2 * NB * 4 * NCH * 16384;
    GSTRIDE(idx, (long)NB * 512 * RB) {
        const int tl = idx % RB, ch = (idx / RB) % 512, b = idx / (RB * 512);
        bf16_t* z = p.hyT + ((size_t)(b * 3 + 2) * 512 + ch) * RB + tl; const float gate = bf2f(p.hyT[((size_t)(b * 3 + n) * 512 + ch) * RB + tl]);
        const float r = gate * (conv[idx] + p.in[21][n * 512 + ch] * bf2f(*z));
        if (n == 0) *z = f2bf(r); else yhT[idx] = f2bf(r);
    }
}
__device__ __forceinline__ void ph_hy_untranspose(const P& p) {
    const bf16_t* yhT = p.Zh + (size_t)2 * NB * 4 * NCH * 16384;
    GSTRIDE(idx, (long)R * 512) { const int ch = idx % 512, r = idx / 512; int b, tl; row_bt(r, b, tl); p.H[(size_t)r * D + 512 + ch] = yhT[((size_t)b * 512 + ch) * RB + tl]; }
}
__device__ __forceinline__ size_t st_idx(int dir, int b, int h, int c) { return ((((size_t)dir * NB + b) * 4 + h) * NCH + c) * 16384; }
__device__ __forceinline__ void ph_retU_naive(const P& p) {
    bf16_t* ST = p.Zh;
    GSTRIDE(idx, (long)NB * 4 * NCH * 16384) {
        const int d = idx % 128, e = (idx / 128) % 128, c = (idx / 16384) % NCH, h = (idx / (16384 * NCH)) % 4, b = idx / (16384 * NCH * 4);
        const float lgf = p.in[9][h], lgb = p.in[10][h]; const int r0 = chunk_row0(b, c);
        float uf = 0.f, ub = 0.f;
        for (int j = 0; j < 128; ++j) {
            const float kk = bf2f(p.Zr[(size_t)(r0 + j) * 2048 + 512 + h * 128 + d]), vv = bf2f(p.Zr[(size_t)(r0 + j) * 2048 + 1024 + h * 128 + e]);
            uf += kk * expf(lgf * (float)(127 - j)) * vv; ub += kk * expf(lgb * (float)j) * vv;
        }
        ST[st_idx(0, b, h, c) + e * 128 + d] = f2bf(uf); ST[st_idx(1, b, h, c) + e * 128 + d] = f2bf(ub);
    }
}
__device__ __forceinline__ void ph_retScan(const P& p) {
    bf16_t* ST = p.Zh;
    GSTRIDE(idx, (long)2 * NB * 4 * 16384) {
        const int ed = idx % 16384, h = (idx / 16384) % 4, b = (idx / 65536) % NB, dir = idx / (65536 * NB);
        const float dc = expf((dir ? p.in[10] : p.in[9])[h] * 128.f);
        float s = 0.f;
        for (int cc = 0; cc < NCH; ++cc) {
            const int c = dir == 0 ? cc : (cc < 2 ? 1 - cc : NCH + 1 - cc);
            bf16_t* q = ST + st_idx(dir, b, h, c) + ed; const float u = bf2f(*q); *q = f2bf(s); s = dc * s + u;
        }
    }
}
__device__ __forceinline__ void ph_retO_naive(const P& p, float* lds) {
    const bf16_t* ST = p.Zh;
    for (int u = blockIdx.x; u < NB * 4 * NCH; u += gridDim.x) {
        const int c = u % NCH, h = (u / NCH) % 4, b = u / (NCH * 4); const int r0 = chunk_row0(b, c);
        const float lgf = p.in[9][h], lgb = p.in[10][h];
        __syncthreads();
        for (int e = TIDX; e < 128 * 128; e += NT) {
            const int j = e % 128, i = e / 128;
            const bf16_t* q = p.Zr + (size_t)(r0 + i) * 2048 + h * 128; const bf16_t* k = p.Zr + (size_t)(r0 + j) * 2048 + 512 + h * 128;
            float s = 0.f; for (int d = 0; d < 128; ++d) s += bf2f(q[d]) * bf2f(k[d]);
            const float m = i > j ? expf(lgf * (float)(i - j)) : (j > i ? expf(lgb * (float)(j - i)) : 2.f);
            lds[e] = s * m;
        }
        __syncthreads();
        const bf16_t* sf = ST + st_idx(0, b, h, c); const bf16_t* sb = ST + st_idx(1, b, h, c);
        for (int e2 = TIDX; e2 < 128 * 128; e2 += NT) {
            const int e = e2 % 128, i = e2 / 128;
            float o = 0.f; for (int j = 0; j < 128; ++j) o += lds[i * 128 + j] * bf2f(p.Zr[(size_t)(r0 + j) * 2048 + 1024 + h * 128 + e]);
            const bf16_t* q = p.Zr + (size_t)(r0 + i) * 2048 + h * 128;
            float of = 0.f, ob = 0.f; for (int d = 0; d < 128; ++d) { const float qq = bf2f(q[d]); of += qq * bf2f(sf[e * 128 + d]); ob += qq * bf2f(sb[e * 128 + d]); }
            p.H[(size_t)(r0 + i) * D + h * 128 + e] = f2bf(o + expf(lgf * (float)(i + 1)) * of + expf(lgb * (float)(128 - i)) * ob);
        }
    }
}
__device__ __forceinline__ void ph_retNorm_naive(const P& p) {
    GSTRIDE(idx, (long)R * 4) {
        const int h = idx % 4, r = idx / 4; bf16_t* o = p.H + (size_t)r * D + h * 128;
        float mu = 0.f; for (int e = 0; e < 128; ++e) mu += bf2f(o[e]); mu *= (1.f / 128.f);
        float var = 0.f; for (int e = 0; e < 128; ++e) { const float d = bf2f(o[e]) - mu; var += d * d; } var *= (1.f / 128.f);
        const float rs = 1.f / sqrtf(var + LN_EPS);
        for (int e = 0; e < 128; ++e) o[e] = f2bf((bf2f(o[e]) - mu) * rs * siluf(bf2f(p.Zr[(size_t)r * 2048 + 1536 + h * 128 + e])));
    }
}
__device__ __forceinline__ float block_sum(float v, float* red) {
    __syncthreads();
#pragma unroll
    for (int o = 32; o > 0; o >>= 1) v += __shfl_xor(v, o);
    if ((TIDX & 63) == 0) red[TIDX >> 6] = v;
    __syncthreads();
    float t = 0.f;
#pragma unroll
    for (int w = 0; w < NT / 64; ++w) t += red[w];
    return t;
}
template <int MODE> __device__ __forceinline__ void ph_post(const P& p, int l, int which, const bf16_t* Y, int ln, int wn, int nrows, float* red) {
    const float* lg = p.in[6] + (size_t)(l * 2 + which) * D; const float* lb = p.in[7] + (size_t)(l * 2 + which) * D;
    int toff[16];
    if (MODE == 1) { int s = 0;
#pragma unroll
        for (int e = 0; e < 16; ++e) { toff[e] = s; s += (p.CNT[l * 16 + e] + 255) >> 8; } }
    for (int r = blockIdx.x; r < nrows; r += gridDim.x) {
        float* x = xrow(p, r); const float* gate = modv(p, l, r, which * 3 + 2);
        const bf16_t *y0, *y1 = nullptr;
        if (MODE == 0) y0 = Y + (size_t)r * D;
        else {
            int sr[2];
#pragma unroll
            for (int k = 0; k < 2; ++k) { const int e = p.RE[r * 2 + k]; int to = 0;
#pragma unroll
                for (int q = 0; q < 16; ++q) to = (q == e) ? toff[q] : to;
                sr[k] = to * 256 + p.RPOS[r * 2 + k]; }
            y0 = p.slots + (size_t)sr[0] * D; y1 = p.slots + (size_t)sr[1] * D;
        }
        float v[2]; float s = 0.f;
#pragma unroll
        for (int i = 0; i < 2; ++i) { const int k = TIDX + i * NT; float yy = bf2f(y0[k]); if (MODE == 1) yy += bf2f(y1[k]); v[i] = ALPHA * x[k] + gate[k] * yy; s += v[i]; }
        const float mu = block_sum(s, red) * (1.f / D);
        float q = 0.f;
#pragma unroll
        for (int i = 0; i < 2; ++i) { const float d = v[i] - mu; q += d * d; }
        const float rs = 1.f / sqrtf(block_sum(q, red) * (1.f / D) + LN_EPS);
#pragma unroll
        for (int i = 0; i < 2; ++i) { const int k = TIDX + i * NT; const float xn = (v[i] - mu) * rs * lg[k] + lb[k]; x[k] = xn;
            if (ln >= 0) p.H[(size_t)r * D + k] = f2bf(xn * (1.f + modv(p, ln, r, wn * 3 + 1)[k]) + modv(p, ln, r, wn * 3 + 0)[k]); }
    }
}
__device__ __forceinline__ void ph_route1(const P& p, int l, int nrows) {
    GSTRIDE(idx, (long)nrows * NE) {
        const int e = idx % NE, r = idx / NE; const float* x = xrow(p, r); const float* sc = modv(p, l, r, 4); const float* sh = modv(p, l, r, 3);
        float acc = 0.f;
        for (int k = 0; k < D; ++k) acc += (x[k] * (1.f + sc[k]) + sh[k]) * p.in[29][k * NE + e];
        p.RS[idx] = sigmf(acc);
    }
}
__device__ __forceinline__ void ph_route2(const P& p, int l, int nrows) {
    GSTRIDE(r, nrows) {
        const float* s = p.RS + (size_t)r * NE; const float* rb = p.in[30];
        int best = 0; float bs = -1e30f;
        for (int g = 0; g < NG; ++g) {
            float m1 = -1e30f, m2 = -1e30f;
            for (int q = 0; q < EPG; ++q) { const float v = s[g * EPG + q] + rb[g * EPG + q]; if (v > m1) { m2 = m1; m1 = v; } else if (v > m2) m2 = v; }
            if (m1 + m2 > bs) { bs = m1 + m2; best = g; }
        }
        int i1 = 0; float v1 = -1e30f;
        for (int q = 0; q < EPG; ++q) { const float v = s[best * EPG + q] + rb[best * EPG + q]; if (v > v1) { v1 = v; i1 = q; } }
        int i2 = 0; float v2 = -1e30f;
        for (int q = 0; q < EPG; ++q) { if (q == i1) continue; const float v = s[best * EPG + q] + rb[best * EPG + q]; if (v > v2) { v2 = v; i2 = q; } }
        const int e1 = best * EPG + i1, e2 = best * EPG + i2; const float a = s[e1], c = s[e2];
        p.RE[r * 2] = e1; p.RE[r * 2 + 1] = e2; p.RWt[r * 2] = a / (a + c); p.RWt[r * 2 + 1] = c / (a + c);
        p.RPOS[r * 2] = atomicAdd(&p.CNT[l * 16 + e1], 1); p.RPOS[r * 2 + 1] = atomicAdd(&p.CNT[l * 16 + e2], 1);
    }
}
__device__ __forceinline__ void ph_permute(const P& p, int l, int nrows) {
    int toff[16]; { int s = 0;
#pragma unroll
        for (int e = 0; e < 16; ++e) { toff[e] = s; s += (p.CNT[l * 16 + e] + 255) >> 8; } }
    GSTRIDE(idx, (long)nrows * 2 * 128) {
        const int ck = idx % 128, k = (idx / 128) % 2, r = idx / 256; const int e = p.RE[r * 2 + k]; int to = 0;
#pragma unroll
        for (int q = 0; q < 16; ++q) to = (q == e) ? toff[q] : to;
        const int sr = to * 256 + p.RPOS[r * 2 + k];
        ((uint4*)(p.Hs + (size_t)sr * D))[ck] = ((const uint4*)(p.H + (size_t)r * D))[ck];
        if (ck == 0) p.WS[sr] = p.RWt[r * 2 + k];
    }
}
__device__ __forceinline__ void ph_glagate(const P& p) {
    GSTRIDE(idx, (long)2 * R * 512) {
        const int ch = idx % 512, r = (idx / 512) % R, dir = idx / (512 * R);
        const float* gw = (dir ? p.in[26] : p.in[24]); const float* gb = (dir ? p.in[27] : p.in[25]);
        float acc = gb[ch];
        for (int q = 0; q < 16; ++q) acc += bf2f(p.Z1[(size_t)r * GINP + 3072 + dir * 16 + q]) * gw[q * 512 + ch];
        p.BG[idx] = logsigf(acc) * (1.f / 16.f);
    }
}
__device__ __forceinline__ void ph_glacum(const P& p) {
    GSTRIDE(idx, (long)2 * NB * NCH * 512) {
        const int ch = idx % 512, c = (idx / 512) % NCH, b = (idx / (512 * NCH)) % NB, dir = idx / (512 * NCH * NB);
        float* a = p.BG + ((size_t)dir * R + chunk_row0(b, c)) * 512 + ch;
        float s = 0.f;
        if (dir == 0) for (int i = 0; i < 128; ++i) { s += a[(size_t)i * 512]; a[(size_t)i * 512] = s; }
        else for (int i = 127; i >= 0; --i) { s += a[(size_t)i * 512]; a[(size_t)i * 512] = s; }
    }
}
__device__ __forceinline__ size_t gst_idx(int dir, int b, int h, int c) { return ((((size_t)dir * NB + b) * 4 + h) * NCH + c) * 32768; }
__device__ __forceinline__ void ph_glaU_naive(const P& p) {
    const float* BF = p.BG; const float* BB = p.BG + (size_t)R * 512;
    GSTRIDE(idx, (long)NB * 4 * NCH * 32768) {
        const int d = idx % 128, e = (idx / 128) % 256, c = (idx / 32768) % NCH, h = (idx / (32768 * NCH)) % 4, b = idx / (32768 * NCH * 4);
        const int r0 = chunk_row0(b, c);
        const float bfe = BF[(size_t)(r0 + 127) * 512 + h * 128 + d], bbe = BB[(size_t)r0 * 512 + h * 128 + d];
        float uf = 0.f, ub = 0.f;
        for (int j = 0; j < 128; ++j) {
            const float kk = bf2f(p.Z1[(size_t)(r0 + j) * GINP + 512 + h * 128 + d]), vv = bf2f(p.Z1[(size_t)(r0 + j) * GINP + 1024 + h * 256 + e]);
            uf += kk * expf(bfe - BF[(size_t)(r0 + j) * 512 + h * 128 + d]) * vv; ub += kk * expf(bbe - BB[(size_t)(r0 + j) * 512 + h * 128 + d]) * vv;
        }
        p.GST[gst_idx(0, b, h, c) + e * 128 + d] = f2bf(uf); p.GST[gst_idx(1, b, h, c) + e * 128 + d] = f2bf(ub);
    }
}
__device__ __forceinline__ void ph_glaScan(const P& p) {
    const float* BF = p.BG; const float* BB = p.BG + (size_t)R * 512;
    GSTRIDE(idx, (long)2 * NB * 4 * 32768) {
        const int d = idx % 128, ed = idx % 32768, h = (idx / 32768) % 4, b = (idx / 131072) % NB, dir = idx / (131072 * NB);
        float s = 0.f;
        for (int cc = 0; cc < NCH; ++cc) {
            const int c = dir == 0 ? cc : (cc < 2 ? 1 - cc : NCH + 1 - cc); const int r0 = chunk_row0(b, c);
            const float dc = dir == 0 ? expf(BF[(size_t)(r0 + 127) * 512 + h * 128 + d]) : expf(BB[(size_t)r0 * 512 + h * 128 + d]);
            bf16_t* q = p.GST + gst_idx(dir, b, h, c) + ed; const float u = bf2f(*q); *q = f2bf(s); s = dc * s + u;
        }
    }
}
__device__ __forceinline__ void ph_glaO_naive(const P& p, float* lds) {
    const float* BF = p.BG; const float* BB = p.BG + (size_t)R * 512;
    for (int u = blockIdx.x; u < NB * 4 * 64; u += gridDim.x) {
        const int c = 2 + u % 64, h = (u / 64) % 4, b = u / 256; const int r0 = chunk_row0(b, c);
        __syncthreads();
        for (int e = TIDX; e < 128 * 128; e += NT) {
            const int j = e % 128, i = e / 128;
            const bf16_t* q = p.Z1 + (size_t)(r0 + i) * GINP + h * 128; const bf16_t* k = p.Z1 + (size_t)(r0 + j) * GINP + 512 + h * 128;
            float s = 0.f;
            if (i >= j) { const float* bi = BF + (size_t)(r0 + i) * 512 + h * 128; const float* bj = BF + (size_t)(r0 + j) * 512 + h * 128;
                for (int d = 0; d < 128; ++d) s += bf2f(q[d]) * bf2f(k[d]) * expf(bi[d] - bj[d]); }
            if (i <= j) { const float* bi = BB + (size_t)(r0 + i) * 512 + h * 128; const float* bj = BB + (size_t)(r0 + j) * 512 + h * 128;
                for (int d = 0; d < 128; ++d) s += bf2f(q[d]) * bf2f(k[d]) * expf(bi[d] - bj[d]); }
            lds[e] = s * KSCALE;
        }
        __syncthreads();
        const bf16_t* sf = p.GST + gst_idx(0, b, h, c); const bf16_t* sb = p.GST + gst_idx(1, b, h, c);
        for (int e2 = TIDX; e2 < 128 * 256; e2 += NT) {
            const int e = e2 % 256, i = e2 / 256;
            float o = 0.f; for (int j = 0; j < 128; ++j) o += lds[i * 128 + j] * bf2f(p.Z1[(size_t)(r0 + j) * GINP + 1024 + h * 256 + e]);
            const bf16_t* q = p.Z1 + (size_t)(r0 + i) * GINP + h * 128; const float* bi = BF + (size_t)(r0 + i) * 512 + h * 128; const float* bbi = BB + (size_t)(r0 + i) * 512 + h * 128;
            float a = 0.f; for (int d = 0; d < 128; ++d) a += bf2f(q[d]) * (expf(bi[d]) * bf2f(sf[e * 128 + d]) + expf(bbi[d]) * bf2f(sb[e * 128 + d]));
            p.H[(size_t)(r0 + i) * D + h * 256 + e] = f2bf(o + a * KSCALE);
        }
    }
}
__device__ __forceinline__ void ph_glaNorm_naive(const P& p) {
    GSTRIDE(idx, (long)RL * 4) {
        const int h = idx % 4, r = idx / 4; bf16_t* o = p.H + (size_t)r * D + h * 256;
        float ss = 0.f; for (int e = 0; e < 256; ++e) { const float v = bf2f(o[e]); ss += v * v; }
        const float rs = 1.f / sqrtf(ss * (1.f / 256.f) + LN_EPS);
        for (int e = 0; e < 256; ++e) o[e] = f2bf(bf2f(o[e]) * rs * siluf(bf2f(p.Z1[(size_t)r * GINP + 2048 + h * 256 + e])));
    }
}

#define FD __device__ __forceinline__
#define TIE(a, b) asm volatile("" : "+v"(a) : "v"(b))
#define HWCOS(x) __builtin_amdgcn_cosf(x)
#define HWSIN(x) __builtin_amdgcn_sinf(x)
struct cf { float x, y; };
FD cf cadd(cf a, cf b) { return {a.x + b.x, a.y + b.y}; }
FD cf csub(cf a, cf b) { return {a.x - b.x, a.y - b.y}; }
FD cf cmul(cf a, cf b) { return {a.x * b.x - a.y * b.y, a.x * b.y + a.y * b.x}; }
#define C32(k) ((k)==0?1.0f:(k)==1?0.98078528040323043f:(k)==2?0.92387953251128674f:(k)==3?0.83146961230254524f:(k)==4?0.70710678118654752f:(k)==5?0.55557023301960222f:(k)==6?0.38268343236508977f:(k)==7?0.19509032201612825f:(k)==8?0.0f:(k)==9?-0.19509032201612825f:(k)==10?-0.38268343236508977f:(k)==11?-0.55557023301960222f:(k)==12?-0.70710678118654752f:(k)==13?-0.83146961230254524f:(k)==14?-0.92387953251128674f:-0.98078528040323043f)
#define S32(k) ((k)==0?0.0f:(k)==1?0.19509032201612825f:(k)==2?0.38268343236508977f:(k)==3?0.55557023301960222f:(k)==4?0.70710678118654752f:(k)==5?0.83146961230254524f:(k)==6?0.92387953251128674f:(k)==7?0.98078528040323043f:(k)==8?1.0f:(k)==9?0.98078528040323043f:(k)==10?0.92387953251128674f:(k)==11?0.83146961230254524f:(k)==12?0.70710678118654752f:(k)==13?0.55557023301960222f:(k)==14?0.38268343236508977f:0.19509032201612825f)
template <int N, int LEN, bool INV> FD void dit_level(cf (&x)[N]) {
#pragma unroll
    for (int blk = 0; blk < N; blk += LEN)
#pragma unroll
        for (int j = 0; j < LEN / 2; ++j) {
            const int k = j * (32 / LEN);
            const cf a = x[blk + j], b0 = x[blk + j + LEN / 2];
            const cf b = k == 0 ? b0 : (k == 8 ? (INV ? cf{-b0.y, b0.x} : cf{b0.y, -b0.x}) : cmul(b0, cf{C32(k), INV ? S32(k) : -S32(k)}));
            x[blk + j] = cadd(a, b); x[blk + j + LEN / 2] = csub(a, b);
        }
}
template <int N, bool INV> FD void dit_reg(cf (&x)[N]) {
    dit_level<N, 2, INV>(x); dit_level<N, 4, INV>(x);
    if constexpr (N >= 8) dit_level<N, 8, INV>(x);
    if constexpr (N >= 16) dit_level<N, 16, INV>(x);
}
template <int N, int LEN, bool INV> FD void dif_level(cf (&x)[N]) {
#pragma unroll
    for (int blk = 0; blk < N; blk += LEN)
#pragma unroll
        for (int j = 0; j < LEN / 2; ++j) {
            const int k = j * (32 / LEN);
            const cf a = x[blk + j], b = x[blk + j + LEN / 2];
            x[blk + j] = cadd(a, b); const cf d = csub(a, b);
            x[blk + j + LEN / 2] = k == 0 ? d : (k == 8 ? (INV ? cf{-d.y, d.x} : cf{d.y, -d.x}) : cmul(d, cf{C32(k), INV ? S32(k) : -S32(k)}));
        }
}
template <int N, bool INV> FD void dif_reg(cf (&x)[N]) {
    if constexpr (N >= 16) dif_level<N, 16, INV>(x);
    if constexpr (N >= 8) dif_level<N, 8, INV>(x);
    dif_level<N, 4, INV>(x); dif_level<N, 2, INV>(x);
}
constexpr int FFT_N = 16384, FFT_LDS_CF = 17920;
FD int brev4(int i) { return ((i & 1) << 3) | ((i & 2) << 1) | ((i & 4) >> 1) | ((i & 8) >> 3); }
FD int physA(int m, int a) { return 4480 * a + m + (m >> 4) + 16 * (m >> 9); }
FD int physB(int b, int a, int m) { return 4480 * b + 272 * a + 16 * (a >> 1) + m + (m >> 4); }
FD int physC(int b, int a, int m) { return 272 * b + 16 * (b >> 1) + 17 * a + m; }
FD int physD(int g, int j) { return 17 * g + 16 * (g >> 5) + j; }
template <int RR, int RM> FD void twiddle(cf (&x)[RR], int m, float sgn) {
#pragma unroll
    for (int s = 1; s < RR; ++s) { const float fr = (float)((m * s) & (RM - 1)) * (1.0f / (float)RM); x[s] = cmul(x[s], cf{HWCOS(fr), sgn * HWSIN(fr)}); }
}
FD void stA_fwd(int m, cf v0, cf v1, cf v2, cf v3, cf* buf) {
    cf x[4] = {v0, v2, v1, v3};
    dit_reg<4, false>(x); twiddle<4, 16384>(x, m, -1.f);
#pragma unroll
    for (int s = 0; s < 4; ++s) buf[physA(m, s)] = x[s];
}
FD void stB_fwd(int idx, cf* buf) {
    const int b = idx >> 8, m = idx & 255; cf x[16];
#pragma unroll
    for (int i = 0; i < 16; ++i) x[i] = buf[physB(b, brev4(i), m)];
    dit_reg<16, false>(x); twiddle<16, 4096>(x, m, -1.f);
#pragma unroll
    for (int s = 0; s < 16; ++s) buf[physB(b, s, m)] = x[s];
}
FD void stC_fwd(int idx, cf* buf) {
    const int b = idx >> 4, m = idx & 15; cf x[16];
#pragma unroll
    for (int i = 0; i < 16; ++i) x[i] = buf[physC(b, brev4(i), m)];
    dit_reg<16, false>(x); twiddle<16, 256>(x, m, -1.f);
#pragma unroll
    for (int s = 0; s < 16; ++s) buf[physC(b, s, m)] = x[s];
}
FD void stD_fwd_regs(int g, const cf* buf, cf (&x)[16]) {
#pragma unroll
    for (int i = 0; i < 16; ++i) x[i] = buf[physD(g, brev4(i))];
    dit_reg<16, false>(x);
}
FD void stD_mul(int g, cf* buf, const cf (&h)[16]) {
    cf x[16];
#pragma unroll
    for (int i = 0; i < 16; ++i) x[i] = buf[physD(g, brev4(i))];
    dit_reg<16, false>(x);
#pragma unroll
    for (int s = 0; s < 16; ++s) x[s] = cmul(x[s], h[s]);
    dif_reg<16, true>(x);
#pragma unroll
    for (int i = 0; i < 16; ++i) buf[physD(g, brev4(i))] = x[i];
}
FD void stC_inv(int idx, cf* buf) {
    const int b = idx >> 4, m = idx & 15; cf x[16];
#pragma unroll
    for (int s = 0; s < 16; ++s) x[s] = buf[physC(b, s, m)];
    twiddle<16, 256>(x, m, 1.f); dif_reg<16, true>(x);
#pragma unroll
    for (int i = 0; i < 16; ++i) buf[physC(b, brev4(i), m)] = x[i];
}
FD void stB_inv(int idx, cf* buf) {
    const int b = idx >> 8, m = idx & 255; cf x[16];
#pragma unroll
    for (int s = 0; s < 16; ++s) x[s] = buf[physB(b, s, m)];
    twiddle<16, 4096>(x, m, 1.f); dif_reg<16, true>(x);
#pragma unroll
    for (int i = 0; i < 16; ++i) buf[physB(b, brev4(i), m)] = x[i];
}
FD void stA_inv(int m, const cf* buf, cf& r0, cf& r1) {
    cf x[4];
#pragma unroll
    for (int s = 0; s < 4; ++s) x[s] = buf[physA(m, s)];
    twiddle<4, 16384>(x, m, 1.f); dif_reg<4, true>(x);
    r0 = x[0]; r1 = x[2];
}

#undef FD
__device__ __forceinline__ void ph_hyena_fft(const P& p, unsigned char* smem) {
    cf* buf = (cf*)smem; float* fb = (float*)smem; float* red = (float*)(smem + FFT_LDS_CF * 8);
    const int t = TIDX;
    bf16_t* yhT = p.Zh + (size_t)2 * NB * 4 * NCH * 16384;
    for (int ch = blockIdx.x; ch < 512; ch += gridDim.x) {
        const bf16_t* hy0 = p.hyT + ((size_t)0 * 512 + ch) * RB;
        const size_t bstr = (size_t)3 * 512 * RB, jstr = (size_t)512 * RB;
        cf* Hg = (cf*)p.H + (size_t)blockIdx.x * 16384;
        bf16_t* zs0 = p.hyT + ((size_t)2 * 512 + ch) * RB;
#pragma unroll 1
        for (int n = 0; n < 2; ++n) {
            const int cfi = (n * 2) * 512 + ch, cbi = (n * 2 + 1) * 512 + ch;
            const float* Ff = p.FILT + (size_t)cfi * RB; const float* Fb = p.FILT + (size_t)cbi * RB;
            float tf0[8], tf1[8], tb2[8], tb3[8]; float sf = 0.f, sb = 0.f;
#pragma unroll
            for (int j = 0; j < 8; ++j) { const int m = t + 512 * j;
                tf0[j] = Ff[m]; tf1[j] = Ff[4096 + m]; tb2[j] = (m == 0) ? Fb[0] : Fb[8192 - (m == 0 ? 1 : m)]; tb3[j] = Fb[4096 - m];
                sf += tf0[j] * tf0[j] + tf1[j] * tf1[j]; sb += tb2[j] * tb2[j] + tb3[j] * tb3[j]; }
            const float nf = 1.f / sqrtf(block_sum(sf, red)), nb = 1.f / sqrtf(block_sum(sb, red));
#pragma unroll
            for (int j = 0; j < 8; ++j) { const int m = launder_i(t) + 512 * j;
                const float v0 = tf0[j] * nf + ((m == 0) ? tb2[j] * nb : 0.f), v2 = (m == 0) ? 0.f : tb2[j] * nb;
                stA_fwd(m, cf{v0, 0.f}, cf{tf1[j] * nf, 0.f}, cf{v2, 0.f}, cf{tb3[j] * nb, 0.f}, buf); }
            __syncthreads();
#pragma unroll 1
            for (int q = 0; q < 2; ++q) stB_fwd(launder_i(t) + 512 * q, buf);
            __syncthreads();
#pragma unroll 1
            for (int q = 0; q < 2; ++q) stC_fwd(launder_i(t) + 512 * q, buf);
            __syncthreads();
#pragma unroll 1
            for (int q = 0; q < 2; ++q) { const int g = launder_i(t) + 512 * q; cf hh[16]; stD_fwd_regs(g, buf, hh);
#pragma unroll
                for (int s = 0; s < 16; ++s) Hg[s * 1024 + g] = hh[s]; }
            __syncthreads();
#pragma unroll 2
            for (int j = 0; j < 8; ++j) { const int m = launder_i(t) + 512 * j;
                stA_fwd(m, cf{bf2f(zs0[m]), bf2f(zs0[bstr + m])}, cf{bf2f(zs0[4096 + m]), bf2f(zs0[bstr + 4096 + m])}, cf{0.f, 0.f}, cf{0.f, 0.f}, buf); }
            __syncthreads();
#pragma unroll 1
            for (int q = 0; q < 2; ++q) stB_fwd(launder_i(t) + 512 * q, buf);
            __syncthreads();
#pragma unroll 1
            for (int q = 0; q < 2; ++q) stC_fwd(launder_i(t) + 512 * q, buf);
            __syncthreads();
#pragma unroll 1
            for (int q = 0; q < 2; ++q) { const int g = launder_i(t) + 512 * q; cf hh[16];
#pragma unroll
                for (int s = 0; s < 16; ++s) hh[s] = Hg[s * 1024 + g];
                stD_mul(g, buf, hh); }
            __syncthreads();
#pragma unroll 1
            for (int q = 0; q < 2; ++q) stC_inv(launder_i(t) + 512 * q, buf);
            __syncthreads();
#pragma unroll 1
            for (int q = 0; q < 2; ++q) stB_inv(launder_i(t) + 512 * q, buf);
            __syncthreads();
            const float sk = p.in[21][n * 512 + ch];
#pragma unroll 2
            for (int j = 0; j < 8; ++j) { const int m = launder_i(t) + 512 * j; cf r0, r1; stA_inv(m, buf, r0, r1);
#pragma unroll
                for (int hlf = 0; hlf < 2; ++hlf) { const int d = m + 4096 * hlf; const cf r = hlf ? r1 : r0;
                    const float g0 = bf2f(hy0[n * jstr + d]), g1 = bf2f(hy0[bstr + n * jstr + d]);
                    const float o0 = g0 * (r.x * (1.f / 16384.f) + sk * bf2f(zs0[d])), o1 = g1 * (r.y * (1.f / 16384.f) + sk * bf2f(zs0[bstr + d]));
                    if (n == 0) { zs0[d] = f2bf(o0); zs0[bstr + d] = f2bf(o1); }
                    else { yhT[((size_t)0 * 512 + ch) * RB + d] = f2bf(o0); yhT[((size_t)1 * 512 + ch) * RB + d] = f2bf(o1); } } }
            __syncthreads();
        }
        {
            float* tap = fb;
            float* zc = fb + 1024;
            const int b = t >> 8, tt = t & 255;
#pragma unroll
            for (int n = 0; n < 2; ++n) {
                const int cfi = (n * 2) * 512 + ch, cbi = (n * 2 + 1) * 512 + ch;
                const float* Ff = p.FILT + (size_t)cfi * RB + L; const float* Fb = p.FILT + (size_t)cbi * RB + L;
                const float vf = t < 256 ? Ff[t] : 0.f, vb = t < 256 ? Fb[t] : 0.f;
                const float nf = 1.f / sqrtf(block_sum(vf * vf, red)), nb = 1.f / sqrtf(block_sum(vb * vb, red));
                if (t < 511) { const int d = t - 255; tap[n * 512 + t] = d > 0 ? Ff[d] * nf : (d < 0 ? Fb[-d] * nb : Ff[0] * nf + Fb[0] * nb); }
            }
            const bf16_t* hb_ = hy0 + (size_t)b * bstr + L + tt;
            const float z1 = bf2f(hb_[2 * jstr]);
            zc[b * 256 + tt] = z1;
            __syncthreads();
            float c1 = 0.f;
            for (int s = 0; s < 256; ++s) c1 += tap[tt - s + 255] * zc[b * 256 + s];
            const float z2 = bf2f(hb_[0]) * (c1 + p.in[21][ch] * z1);
            __syncthreads();
            zc[b * 256 + tt] = z2;
            __syncthreads();
            float c2 = 0.f;
            for (int s = 0; s < 256; ++s) c2 += tap[512 + tt - s + 255] * zc[b * 256 + s];
            yhT[((size_t)b * 512 + ch) * RB + L + tt] = f2bf(bf2f(hb_[jstr]) * (c2 + p.in[21][512 + ch] * z2));
            __syncthreads();
        }
    }
}

typedef short bf16x8 __attribute__((ext_vector_type(8)));
typedef short s16x4 __attribute__((ext_vector_type(4)));
typedef float f32x4 __attribute__((ext_vector_type(4)));
typedef unsigned u4v __attribute__((ext_vector_type(4)));
typedef unsigned u2v __attribute__((ext_vector_type(2)));
constexpr int LDT = 136;
constexpr int TILE_E = 128 * LDT;
__device__ __forceinline__ bf16x8 frag_row(const LAS bf16_t* T, int ld, int r0, int k0, int lane) {
    return *(const LAS bf16x8*)(T + (r0 + (lane & 15)) * ld + k0 + 8 * (lane >> 4));
}
__device__ __forceinline__ bf16x8 frag_tr(const LAS bf16_t* T, int ld, int k0, int n0, int lane) {
    const int g = lane >> 4, q = (lane & 15) >> 2, pp = lane & 3;
    const LAS bf16_t* a0 = T + (k0 + 8 * g + q) * ld + n0 + 4 * pp;
    const s16x4 lo = __builtin_amdgcn_ds_read_tr16_b64_v4i16((LAS s16x4*)a0);
    const s16x4 hi = __builtin_amdgcn_ds_read_tr16_b64_v4i16((LAS s16x4*)(a0 + 4 * ld));
    return (bf16x8){lo[0], lo[1], lo[2], lo[3], hi[0], hi[1], hi[2], hi[3]};
}
#define MFMA16(xn, xm, acc) __builtin_amdgcn_mfma_f32_16x16x32_bf16(xn, xm, acc, 0, 0, 0)
__device__ __forceinline__ void unpack8(const u4v u, float (&f)[8]) {
    f[0] = __uint_as_float(u.x << 16); f[1] = __uint_as_float(u.x & 0xffff0000u); f[2] = __uint_as_float(u.y << 16); f[3] = __uint_as_float(u.y & 0xffff0000u);
    f[4] = __uint_as_float(u.z << 16); f[5] = __uint_as_float(u.z & 0xffff0000u); f[6] = __uint_as_float(u.w << 16); f[7] = __uint_as_float(u.w & 0xffff0000u);
}
__device__ __forceinline__ u4v pack8(const float (&f)[8]) {
    u4v u; u.x = pk_bf16(f[0], f[1]); u.y = pk_bf16(f[2], f[3]); u.z = pk_bf16(f[4], f[5]); u.w = pk_bf16(f[6], f[7]); return u;
}
__device__ __forceinline__ void stage_tile(LAS bf16_t* dst, const bf16_t* src, int gld, int tid) {
#pragma unroll
    for (int i = 0; i < 4; ++i) { const int c = tid + 512 * i, row = c >> 4, ch = c & 15;
        *(LAS u4v*)(dst + row * LDT + ch * 8) = *(const u4v*)(src + (size_t)row * gld + ch * 8); }
}
__device__ __forceinline__ void ph_retU_mfma(const P& p, unsigned char* smem) {
    LAS bf16_t* Kt = (LAS bf16_t*)smem; LAS bf16_t* VF = Kt + TILE_E; LAS bf16_t* VB = VF + TILE_E;
    bf16_t* ST = p.Zh;
    for (int u = blockIdx.x; u < NB * 4 * NCH; u += gridDim.x) {
        const int tid = TIDX, lane = tid & 63, w = tid >> 6;
        const int c = u % NCH, h = (u / NCH) % 4, b = u / (NCH * 4); const int r0 = chunk_row0(b, c);
        const float lgf = p.in[9][h], lgb = p.in[10][h];
        const bf16_t* kb = p.Zr + (size_t)r0 * 2048 + 512 + h * 128; const bf16_t* vb = p.Zr + (size_t)r0 * 2048 + 1024 + h * 128;
        __syncthreads();
        stage_tile(Kt, kb, 2048, tid);
#pragma unroll
        for (int i = 0; i < 4; ++i) { const int cc = tid + 512 * i, j = cc >> 4, ch = cc & 15;
            float f[8], g[8]; unpack8(*(const u4v*)(vb + (size_t)j * 2048 + ch * 8), f);
            const float wf = __expf(lgf * (float)(127 - j)), wb = __expf(lgb * (float)j);
#pragma unroll
            for (int q = 0; q < 8; ++q) { g[q] = f[q] * wb; f[q] *= wf; }
            *(LAS u4v*)(VF + j * LDT + ch * 8) = pack8(f); *(LAS u4v*)(VB + j * LDT + ch * 8) = pack8(g); }
        __syncthreads();
        f32x4 af[8], ab[8];
#pragma unroll
        for (int nt = 0; nt < 8; ++nt) { af[nt] = (f32x4){0.f, 0.f, 0.f, 0.f}; ab[nt] = (f32x4){0.f, 0.f, 0.f, 0.f}; }
#pragma unroll
        for (int ks = 0; ks < 4; ++ks) {
            const bf16x8 xf = frag_tr(VF, LDT, 32 * ks, 16 * w, lane), xb = frag_tr(VB, LDT, 32 * ks, 16 * w, lane);
#pragma unroll
            for (int nt = 0; nt < 8; ++nt) { const bf16x8 xn = frag_tr(Kt, LDT, 32 * ks, 16 * nt, lane); af[nt] = MFMA16(xn, xf, af[nt]); ab[nt] = MFMA16(xn, xb, ab[nt]); }
        }
        const int e = 16 * w + (lane & 15), d0 = 4 * (lane >> 4);
        bf16_t* of = ST + st_idx(0, b, h, c) + e * 128 + d0; bf16_t* ob = ST + st_idx(1, b, h, c) + e * 128 + d0;
#pragma unroll
        for (int nt = 0; nt < 8; ++nt) {
            u2v o; o.x = pk_bf16(af[nt][0], af[nt][1]); o.y = pk_bf16(af[nt][2], af[nt][3]); *(u2v*)(of + 16 * nt) = o;
            o.x = pk_bf16(ab[nt][0], ab[nt][1]); o.y = pk_bf16(ab[nt][2], ab[nt][3]); *(u2v*)(ob + 16 * nt) = o; }
    }
}
__device__ __forceinline__ void ph_retO_mfma(const P& p, unsigned char* smem) {
    LAS bf16_t* Qs = (LAS bf16_t*)smem; LAS bf16_t* Ks = Qs + TILE_E; LAS bf16_t* Vs = Ks + TILE_E; LAS bf16_t* Ss = Vs + TILE_E;
    const bf16_t* ST = p.Zh;
    for (int u = blockIdx.x; u < NB * 4 * NCH; u += gridDim.x) {
        const int tid = TIDX, lane = tid & 63, w = tid >> 6, fr = lane & 15, fq = lane >> 4;
        const int c = u % NCH, h = (u / NCH) % 4, b = u / (NCH * 4); const int r0 = chunk_row0(b, c);
        const float lgf = p.in[9][h], lgb = p.in[10][h];
        const bf16_t* zb = p.Zr + (size_t)r0 * 2048 + h * 128;
        __syncthreads();
        stage_tile(Qs, zb, 2048, tid); stage_tile(Ks, zb + 512, 2048, tid); stage_tile(Vs, zb + 1024, 2048, tid); stage_tile(Ss, ST + st_idx(0, b, h, c), 128, tid);
        __syncthreads();
        f32x4 as[8], af[8];
#pragma unroll
        for (int nt = 0; nt < 8; ++nt) { as[nt] = (f32x4){0.f, 0.f, 0.f, 0.f}; af[nt] = (f32x4){0.f, 0.f, 0.f, 0.f}; }
#pragma unroll
        for (int ks = 0; ks < 4; ++ks) { const bf16x8 xm = frag_row(Qs, LDT, 16 * w, 32 * ks, lane);
#pragma unroll
            for (int nt = 0; nt < 8; ++nt) { as[nt] = MFMA16(frag_row(Ks, LDT, 16 * nt, 32 * ks, lane), xm, as[nt]); af[nt] = MFMA16(frag_row(Ss, LDT, 16 * nt, 32 * ks, lane), xm, af[nt]); } }
        const int i = 16 * w + fr;
        __syncthreads();
#pragma unroll
        for (int nt = 0; nt < 8; ++nt) { float pv[4];
#pragma unroll
            for (int q = 0; q < 4; ++q) { const int j = 16 * nt + 4 * fq + q; const float m = i > j ? __expf(lgf * (float)(i - j)) : (j > i ? __expf(lgb * (float)(j - i)) : 2.f); pv[q] = as[nt][q] * m; }
            u2v o; o.x = pk_bf16(pv[0], pv[1]); o.y = pk_bf16(pv[2], pv[3]); *(LAS u2v*)(Ks + i * LDT + 16 * nt + 4 * fq) = o; }
        stage_tile(Ss, ST + st_idx(1, b, h, c), 128, tid);
        __syncthreads();
        f32x4 ao[8], ab[8];
#pragma unroll
        for (int nt = 0; nt < 8; ++nt) { ao[nt] = (f32x4){0.f, 0.f, 0.f, 0.f}; ab[nt] = (f32x4){0.f, 0.f, 0.f, 0.f}; }
#pragma unroll
        for (int ks = 0; ks < 4; ++ks) { const bf16x8 xp = frag_row(Ks, LDT, 16 * w, 32 * ks, lane), xq = frag_row(Qs, LDT, 16 * w, 32 * ks, lane);
#pragma unroll
            for (int nt = 0; nt < 8; ++nt) { ao[nt] = MFMA16(frag_tr(Vs, LDT, 32 * ks, 16 * nt, lane), xp, ao[nt]); ab[nt] = MFMA16(frag_row(Ss, LDT, 16 * nt, 32 * ks, lane), xq, ab[nt]); } }
        const float rf = __expf(lgf * (float)(i + 1)), rb = __expf(lgb * (float)(128 - i));
        float s = 0.f;
#pragma unroll
        for (int nt = 0; nt < 8; ++nt) { ao[nt] = ao[nt] + af[nt] * rf + ab[nt] * rb; s += (ao[nt][0] + ao[nt][1]) + (ao[nt][2] + ao[nt][3]); }
        s += __shfl_xor(s, 16); s += __shfl_xor(s, 32);
        const float mu = s * (1.f / 128.f); float qv = 0.f;
#pragma unroll
        for (int nt = 0; nt < 8; ++nt) { const f32x4 dd = ao[nt] - mu; qv += (dd[0] * dd[0] + dd[1] * dd[1]) + (dd[2] * dd[2] + dd[3] * dd[3]); }
        qv += __shfl_xor(qv, 16); qv += __shfl_xor(qv, 32);
        const float rs = 1.f / sqrtf(qv * (1.f / 128.f) + LN_EPS);
        const bf16_t* gp = p.Zr + (size_t)(r0 + i) * 2048 + 1536 + h * 128 + 4 * fq; bf16_t* yp = p.H + (size_t)(r0 + i) * D + h * 128 + 4 * fq;
#pragma unroll
        for (int nt = 0; nt < 8; ++nt) { const u2v gu = *(const u2v*)(gp + 16 * nt);
            const float g0 = __uint_as_float(gu.x << 16), g1 = __uint_as_float(gu.x & 0xffff0000u), g2 = __uint_as_float(gu.y << 16), g3 = __uint_as_float(gu.y & 0xffff0000u);
            u2v o; o.x = pk_bf16((ao[nt][0] - mu) * rs * siluf(g0), (ao[nt][1] - mu) * rs * siluf(g1)); o.y = pk_bf16((ao[nt][2] - mu) * rs * siluf(g2), (ao[nt][3] - mu) * rs * siluf(g3));
            *(u2v*)(yp + 16 * nt) = o; }
    }
}
__device__ __forceinline__ void ph_glaU_mfma(const P& p, unsigned char* smem) {
    LAS bf16_t* KF = (LAS bf16_t*)smem; LAS bf16_t* KB = KF + TILE_E; LAS bf16_t* Vs = KB + TILE_E;
    for (int u = blockIdx.x; u < NB * 4 * NCH; u += gridDim.x) {
        const int tid = TIDX, lane = tid & 63, w = tid >> 6;
        const int c = u % NCH, h = (u / NCH) % 4, b = u / (NCH * 4); const int r0 = chunk_row0(b, c);
        const bf16_t* kb = p.Z1 + (size_t)r0 * GINP + 512 + h * 128; const bf16_t* vb = p.Z1 + (size_t)r0 * GINP + 1024 + h * 256;
        float* BFw = p.BG + (size_t)r0 * 512 + h * 128; float* BBw = p.BG + (size_t)R * 512 + (size_t)r0 * 512 + h * 128;
        const float* BF = BFw; const float* BB = BBw;
        __syncthreads();
        {
            float* lr = (float*)(Vs);
            float* tot = lr + 128 * 32;
            for (int e = tid; e < 128 * 32; e += NT) lr[e] = bf2f(p.Z1[(size_t)(r0 + (e >> 5)) * GINP + 3072 + (e & 31)]);
            const int chn = tid & 127, dir = (tid >> 7) & 1, half = tid >> 8;
            const float* gw = (dir ? p.in[26] : p.in[24]) + h * 128 + chn; float g[16];
#pragma unroll
            for (int q = 0; q < 16; ++q) g[q] = gw[q * 512];
            const float gb = (dir ? p.in[27] : p.in[25])[h * 128 + chn];
            __syncthreads();
            float s = 0.f;
#pragma unroll 4
            for (int ii = 0; ii < 64; ++ii) { const int i = half * 64 + ii; float a = gb;
#pragma unroll
                for (int q = 0; q < 16; ++q) a += lr[i * 32 + dir * 16 + q] * g[q];
                s += (fminf(a, 0.f) - __logf(1.f + __expf(-fabsf(a)))) * (1.f / 16.f); }
            tot[(dir * 2 + half) * 128 + chn] = s;
            __syncthreads();
            const float total = tot[(dir * 2 + 0) * 128 + chn] + tot[(dir * 2 + 1) * 128 + chn];
            s = dir == 0 ? (half ? tot[(0 * 2 + 0) * 128 + chn] : 0.f) : (half ? 0.f : tot[(1 * 2 + 1) * 128 + chn]);
            float* out = (dir ? BBw : BFw) + chn; LAS bf16_t* Kd = dir ? KB : KF;
#pragma unroll 4
            for (int ii = 0; ii < 64; ++ii) { const int i = half * 64 + (dir ? 63 - ii : ii); float a = gb;
#pragma unroll
                for (int q = 0; q < 16; ++q) a += lr[i * 32 + dir * 16 + q] * g[q];
                s += (fminf(a, 0.f) - __logf(1.f + __expf(-fabsf(a)))) * (1.f / 16.f); out[(size_t)i * 512] = s;
                Kd[i * LDT + chn] = f2bf(bf2f(kb[(size_t)i * GINP + chn]) * __expf(total - s)); }
            __syncthreads();
        }
        const int fr = lane & 15, fq = lane >> 4;
#pragma unroll 1
        for (int hf = 0; hf < 2; ++hf) {
            if (hf) __syncthreads();
            stage_tile(Vs, vb + hf * 128, GINP, tid);
            __syncthreads();
            {
                f32x4 af[8], ab[8];
#pragma unroll
                for (int nt = 0; nt < 8; ++nt) { af[nt] = (f32x4){0.f, 0.f, 0.f, 0.f}; ab[nt] = (f32x4){0.f, 0.f, 0.f, 0.f}; }
#pragma unroll
                for (int ks = 0; ks < 4; ++ks) { const bf16x8 x0 = frag_tr(Vs, LDT, 32 * ks, 16 * w, lane);
#pragma unroll
                    for (int nt = 0; nt < 8; ++nt) { af[nt] = MFMA16(frag_tr(KF, LDT, 32 * ks, 16 * nt, lane), x0, af[nt]); ab[nt] = MFMA16(frag_tr(KB, LDT, 32 * ks, 16 * nt, lane), x0, ab[nt]); } }
                bf16_t* of = p.GST + gst_idx(0, b, h, c) + (size_t)(hf * 128 + 16 * w + fr) * 128 + 4 * fq; bf16_t* ob = p.GST + gst_idx(1, b, h, c) + (size_t)(hf * 128 + 16 * w + fr) * 128 + 4 * fq;
#pragma unroll
                for (int nt = 0; nt < 8; ++nt) { u2v v; v.x = pk_bf16(af[nt][0], af[nt][1]); v.y = pk_bf16(af[nt][2], af[nt][3]); *(u2v*)(of + 16 * nt) = v;
                    v.x = pk_bf16(ab[nt][0], ab[nt][1]); v.y = pk_bf16(ab[nt][2], ab[nt][3]); *(u2v*)(ob + 16 * nt) = v; }
            }
        }
    }
}
__device__ __forceinline__ void stage_scaled(LAS bf16_t* dst, const bf16_t* src, const float* G, float sgn, float mul, int tid) {
#pragma unroll
    for (int i = 0; i < 4; ++i) { const int cc = tid + 512 * i, j = cc >> 4, ch = cc & 15;
        float k8[8]; unpack8(*(const u4v*)(src + (size_t)j * GINP + ch * 8), k8);
        const f32x4 f0 = *(const f32x4*)(G + (size_t)j * 512 + ch * 8), f1 = *(const f32x4*)(G + (size_t)j * 512 + ch * 8 + 4);
#pragma unroll
        for (int q = 0; q < 4; ++q) { k8[q] *= __expf(sgn * f0[q]) * mul; k8[q + 4] *= __expf(sgn * f1[q]) * mul; }
        *(LAS u4v*)(dst + j * LDT + ch * 8) = pack8(k8); }
}
__device__ __forceinline__ void ph_glaO_mfma(const P& p, unsigned char* smem) {
    LAS bf16_t* QF = (LAS bf16_t*)smem; LAS bf16_t* QB = QF + TILE_E; LAS bf16_t* KX = QB + TILE_E; LAS bf16_t* R4 = KX + TILE_E;
    for (int u = blockIdx.x; u < NB * 4 * 64; u += gridDim.x) {
        const int tid = TIDX, lane = tid & 63, w = tid >> 6, fr = lane & 15, fq = lane >> 4;
        const int c = 2 + u % 64, h = (u / 64) % 4, b = u / 256; const int r0 = chunk_row0(b, c);
        const bf16_t* qb = p.Z1 + (size_t)r0 * GINP + h * 128; const bf16_t* kb = qb + 512; const bf16_t* vb = p.Z1 + (size_t)r0 * GINP + 1024 + h * 256;
        const float* BF = p.BG + (size_t)r0 * 512 + h * 128; const float* BB = p.BG + (size_t)R * 512 + (size_t)r0 * 512 + h * 128;
        const int i = 16 * w + fr;
        __syncthreads();
        stage_scaled(QF, qb, BF, 1.f, KSCALE, tid); stage_scaled(QB, qb, BB, 1.f, KSCALE, tid); stage_scaled(KX, kb, BF, -1.f, 1.f, tid);
        __syncthreads();
        f32x4 s1[8];
#pragma unroll
        for (int nt = 0; nt < 8; ++nt) s1[nt] = (f32x4){0.f, 0.f, 0.f, 0.f};
#pragma unroll
        for (int ks = 0; ks < 4; ++ks) { const bf16x8 xm = frag_row(QF, LDT, 16 * w, 32 * ks, lane);
#pragma unroll
            for (int nt = 0; nt < 8; ++nt) s1[nt] = MFMA16(frag_row(KX, LDT, 16 * nt, 32 * ks, lane), xm, s1[nt]); }
#pragma unroll
        for (int nt = 0; nt < 8; ++nt)
#pragma unroll
            for (int q = 0; q < 4; ++q) { const int j = 16 * nt + 4 * fq + q; s1[nt][q] = (i >= j) ? s1[nt][q] : 0.f; }
        __syncthreads();
        stage_scaled(KX, kb, BB, -1.f, 1.f, tid);
        __syncthreads();
        {
            f32x4 s2[8];
#pragma unroll
            for (int nt = 0; nt < 8; ++nt) s2[nt] = (f32x4){0.f, 0.f, 0.f, 0.f};
#pragma unroll
            for (int ks = 0; ks < 4; ++ks) { const bf16x8 xm = frag_row(QB, LDT, 16 * w, 32 * ks, lane);
#pragma unroll
                for (int nt = 0; nt < 8; ++nt) s2[nt] = MFMA16(frag_row(KX, LDT, 16 * nt, 32 * ks, lane), xm, s2[nt]); }
#pragma unroll
            for (int nt = 0; nt < 8; ++nt)
#pragma unroll
                for (int q = 0; q < 4; ++q) { const int j = 16 * nt + 4 * fq + q; s1[nt][q] += (i <= j) ? s2[nt][q] : 0.f; }
        }
        __syncthreads();
#pragma unroll
        for (int nt = 0; nt < 8; ++nt) { u2v o; o.x = pk_bf16(s1[nt][0], s1[nt][1]); o.y = pk_bf16(s1[nt][2], s1[nt][3]); *(LAS u2v*)(KX + i * LDT + 16 * nt + 4 * fq) = o; }
        f32x4 ao[2][8];
#pragma unroll
        for (int hf = 0; hf < 2; ++hf) {
#pragma unroll
            for (int nt = 0; nt < 8; ++nt) ao[hf][nt] = (f32x4){0.f, 0.f, 0.f, 0.f};
            stage_tile(R4, vb + hf * 128, GINP, tid);
            __syncthreads();
#pragma unroll
            for (int ks = 0; ks < 4; ++ks) { const bf16x8 xp = frag_row(KX, LDT, 16 * w, 32 * ks, lane);
#pragma unroll
                for (int nt = 0; nt < 8; ++nt) ao[hf][nt] = MFMA16(frag_tr(R4, LDT, 32 * ks, 16 * nt, lane), xp, ao[hf][nt]); }
            __syncthreads();
            stage_tile(R4, p.GST + gst_idx(0, b, h, c) + (size_t)hf * 128 * 128, 128, tid);
            __syncthreads();
#pragma unroll
            for (int ks = 0; ks < 4; ++ks) { const bf16x8 xq = frag_row(QF, LDT, 16 * w, 32 * ks, lane);
#pragma unroll
                for (int nt = 0; nt < 8; ++nt) ao[hf][nt] = MFMA16(frag_row(R4, LDT, 16 * nt, 32 * ks, lane), xq, ao[hf][nt]); }
            __syncthreads();
            stage_tile(R4, p.GST + gst_idx(1, b, h, c) + (size_t)hf * 128 * 128, 128, tid);
            __syncthreads();
#pragma unroll
            for (int ks = 0; ks < 4; ++ks) { const bf16x8 xq = frag_row(QB, LDT, 16 * w, 32 * ks, lane);
#pragma unroll
                for (int nt = 0; nt < 8; ++nt) ao[hf][nt] = MFMA16(frag_row(R4, LDT, 16 * nt, 32 * ks, lane), xq, ao[hf][nt]); }
            __syncthreads();
        }
        float ss = 0.f;
#pragma unroll
        for (int hf = 0; hf < 2; ++hf)
#pragma unroll
            for (int nt = 0; nt < 8; ++nt) { const f32x4 v = ao[hf][nt]; ss += (v[0] * v[0] + v[1] * v[1]) + (v[2] * v[2] + v[3] * v[3]); }
        ss += __shfl_xor(ss, 16); ss += __shfl_xor(ss, 32);
        const float rs = 1.f / sqrtf(ss * (1.f / 256.f) + LN_EPS);
        const bf16_t* gp = p.Z1 + (size_t)(r0 + i) * GINP + 2048 + h * 256 + 4 * fq; bf16_t* yp = p.H + (size_t)(r0 + i) * D + h * 256 + 4 * fq;
#pragma unroll
        for (int hf = 0; hf < 2; ++hf)
#pragma unroll
            for (int nt = 0; nt < 8; ++nt) { const u2v gu = *(const u2v*)(gp + hf * 128 + 16 * nt);
                const float g0 = __uint_as_float(gu.x << 16), g1 = __uint_as_float(gu.x & 0xffff0000u), g2 = __uint_as_float(gu.y << 16), g3 = __uint_as_float(gu.y & 0xffff0000u);
                u2v o; o.x = pk_bf16(ao[hf][nt][0] * rs * siluf(g0), ao[hf][nt][1] * rs * siluf(g1)); o.y = pk_bf16(ao[hf][nt][2] * rs * siluf(g2), ao[hf][nt][3] * rs * siluf(g3));
                *(u2v*)(yp + hf * 128 + 16 * nt) = o; }
    }
}

template <int MODE> __device__ __forceinline__ void tr_w(bf16_t* dst, const float* src, int N, int K, int ldsrc, float* t  , int& tile0, int tile_stride) {
    const int nt_n = N / 64, ntiles = nt_n * (K / 64);
    for (int tile = tile0; tile < ntiles; tile += tile_stride) {
        const int tid = TIDX; const int n0 = (tile % nt_n) * 64, k0 = (tile / nt_n) * 64;
        __syncthreads();
#pragma unroll
        for (int i = 0; i < 8; ++i) { const int e = tid + 512 * i, kk = e >> 6, nn = e & 63; t[kk * 65 + nn] = src[(size_t)(k0 + kk) * ldsrc + n0 + nn]; }
        __syncthreads();
#pragma unroll
        for (int i = 0; i < 4; ++i) { const int e = tid + 512 * i, nn = e >> 5, kp = e & 31; const int n = n0 + nn;
            const int row = MODE == 0 ? n : (8 * (n >> 2) + (n & 3) + (MODE == 2 ? 4 : 0));
            *(unsigned*)(dst + (size_t)row * K + k0 + 2 * kp) = pk_bf16(t[(2 * kp) * 65 + nn], t[(2 * kp + 1) * 65 + nn]); }
    }
    tile0 = tile0 - (ntiles % tile_stride);
    if (tile0 < 0) tile0 += tile_stride;
}
__device__ __forceinline__ void ph_wconv_fast(const P& p, float* t) {
    int t0 = blockIdx.x; const int G = gridDim.x;
    tr_w<0>(p.Win0, p.in[8], ABIN, D, ABIN, t, t0, G);
    tr_w<0>(p.Wout0, p.in[22], D, D, D, t, t0, G);
    tr_w<0>(p.Win1, p.in[23], 3072, D, GIN, t, t0, G);
    tr_w<0>(p.Wout1, p.in[28], D, D, D, t, t0, G);
    GSTRIDE(idx, (long)(GINP - 3072) * D) { const int k = idx % D, n = 3072 + idx / D; p.Win1[(size_t)n * D + k] = n < GIN ? f2bf(p.in[23][(size_t)k * GIN + n]) : (bf16_t)0; }
}
__device__ __forceinline__ void ph_wconv_moe_fast(const P& p, int l, float* t) {
    int t0 = blockIdx.x; const int G = gridDim.x;
    for (int e = 0; e < NE; ++e) {
        tr_w<1>(p.Wgu + (size_t)e * 1024 * 1024, p.in[31] + (size_t)(l * NE + e) * D * EH, EH, D, EH, t, t0, G);
        tr_w<2>(p.Wgu + (size_t)e * 1024 * 1024, p.in[32] + (size_t)(l * NE + e) * D * EH, EH, D, EH, t, t0, G);
        tr_w<0>(p.Wd + (size_t)e * 1024 * 512, p.in[33] + (size_t)(l * NE + e) * EH * D, D, EH, D, t, t0, G);
    }
}
__device__ __forceinline__ void ph_prep_hy_fast(const P& p, float* t  ) {
    const int ntt = RB / 64, ntc = 1536 / 64;
    for (int tile = blockIdx.x; tile < NB * ntt * ntc; tile += gridDim.x) {
        const int tid = TIDX; const int ct = tile % ntc, tt = (tile / ntc) % ntt, b = tile / (ntc * ntt); const int c0 = ct * 64, tl0 = tt * 64;
        const int s0 = tl0 < L ? 0 : L, s1 = tl0 < L ? L : RB;
        __syncthreads();
        for (int e = tid; e < 66 * 64; e += NT) { const int rr = e >> 6, cc = e & 63, tl = tl0 - 1 + rr;
            t[rr * 65 + cc] = (tl >= s0 && tl < s1) ? bf2f(p.Zh[(size_t)bt_row(b, tl) * 1536 + c0 + cc]) : 0.f; }
        __syncthreads();
#pragma unroll
        for (int i = 0; i < 4; ++i) { const int e = tid + 512 * i, cc = e >> 5, tp = e & 31; const int col = c0 + cc;
            const float w0 = p.in[11][col], w1 = p.in[11][1536 + col], w2 = p.in[11][3072 + col], bs = p.in[12][col];
            const float a = bs + w0 * t[(2 * tp) * 65 + cc] + w1 * t[(2 * tp + 1) * 65 + cc] + w2 * t[(2 * tp + 2) * 65 + cc];
            const float c2 = bs + w0 * t[(2 * tp + 1) * 65 + cc] + w1 * t[(2 * tp + 2) * 65 + cc] + w2 * t[(2 * tp + 3) * 65 + cc];
            *(unsigned*)(p.hyT + ((size_t)b * 1536 + col) * RB + tl0 + 2 * tp) = pk_bf16(a, c2); }
    }
}
__device__ __forceinline__ void ph_hy_untranspose_fast(const P& p, float* t) {
    const bf16_t* yhT = p.Zh + (size_t)2 * NB * 4 * NCH * 16384;
    const int ntt = RB / 64, ntc = 512 / 64;
    for (int tile = blockIdx.x; tile < NB * ntt * ntc; tile += gridDim.x) {
        const int tid = TIDX; const int ct = tile % ntc, tt = (tile / ntc) % ntt, b = tile / (ntc * ntt); const int c0 = ct * 64, tl0 = tt * 64;
        __syncthreads();
#pragma unroll
        for (int i = 0; i < 8; ++i) { const int e = tid + 512 * i, cc = e >> 6, ti = e & 63; t[cc * 65 + ti] = bf2f(yhT[((size_t)b * 512 + c0 + cc) * RB + tl0 + ti]); }
        __syncthreads();
#pragma unroll
        for (int i = 0; i < 4; ++i) { const int e = tid + 512 * i, ti = e >> 5, cp = e & 31;
            *(unsigned*)(p.H + (size_t)bt_row(b, tl0 + ti) * D + 512 + c0 + 2 * cp) = pk_bf16(t[(2 * cp) * 65 + ti], t[(2 * cp + 1) * 65 + ti]); }
    }
}
__device__ __forceinline__ void ph_prep_rope_fast(const P& p) {
    GSTRIDE(idx, (long)R * 2 * 4 * 8) {
        const int pc = idx % 8, h = (idx / 8) % 4, w = (idx / 32) % 2, r = idx / 64;
        bf16_t* base = p.Zr + (size_t)r * 2048 + w * 512 + h * 128 + pc * 8;
        float a[8], c[8]; unpack8(*(const u4v*)base, a); unpack8(*(const u4v*)(base + 64), c);
        const float sc = w ? KSCALE : 1.f;
        if (r < RL) {
            const int t = r % L; const float pos = (pc < 4) ? (float)(t / GW) : (float)(t % GW);
#pragma unroll
            for (int q = 0; q < 8; ++q) { const int pr = pc * 8 + q; const float inv = exp2f(-(float)(pr & 31) * (13.287712379549449f / 32.f));
                float sn, cs; sincosf(pos * inv, &sn, &cs); const float x1 = a[q] * sc, x2 = c[q] * sc; a[q] = x1 * cs - x2 * sn; c[q] = x1 * sn + x2 * cs; }
        } else {
#pragma unroll
            for (int q = 0; q < 8; ++q) { a[q] *= sc; c[q] *= sc; }
        }
        *(u4v*)base = pack8(a); *(u4v*)(base + 64) = pack8(c);
    }
}
__device__ __forceinline__ void ph_mod_fast(const P& p, int l, int which, const float* xl  , const float* xc  ) {
    const int lane = TIDX & 63, gw = blockIdx.x * (NT / 64) + (TIDX >> 6), ngw = gridDim.x * (NT / 64);
    for (int r = gw; r < R; r += ngw) {
        const float* x = r < RL ? xl + (size_t)r * D : xc + (size_t)(r - RL) * D; const float* sh = modv(p, l, r, which * 3 + 0); const float* sc = modv(p, l, r, which * 3 + 1);
#pragma unroll
        for (int i = 0; i < 4; ++i) { const int k = 4 * lane + 256 * i; const f32x4 xv = *(const f32x4*)(x + k), s = *(const f32x4*)(sc + k), hh = *(const f32x4*)(sh + k);
            u2v o; o.x = pk_bf16(xv[0] * (1.f + s[0]) + hh[0], xv[1] * (1.f + s[1]) + hh[1]); o.y = pk_bf16(xv[2] * (1.f + s[2]) + hh[2], xv[3] * (1.f + s[3]) + hh[3]);
            *(u2v*)(p.H + (size_t)r * D + k) = o; }
    }
}

__device__ __forceinline__ float wave_sum(float v) {
#pragma unroll
    for (int o = 1; o < 64; o <<= 1) v += __shfl_xor(v, o);
    return v;
}
__device__ __forceinline__ void ph_ada_fast(const P& p, float* lds) {
    float* sv = lds;
    float* red = lds + 3072;
    const int tid = TIDX;
    __syncthreads();
    for (int i = tid; i < 3 * D; i += NT) { const int j = i / D, k = i % D; sv[i] = siluf(j < 2 ? p.in[1][j * D + k] : p.in[3][k]); }
    __syncthreads();
    for (int u = blockIdx.x; u < 2 * 96; u += gridDim.x) {
        const int l = u / 96, n = (u % 96) * 64 + (tid & 63), ks = tid >> 6;
        const float* w = p.in[4] + (size_t)l * D * 6144 + n;
        float a0 = 0.f, a1 = 0.f, a2 = 0.f;
#pragma unroll 8
        for (int k = ks * 128; k < ks * 128 + 128; ++k) { const float wv = w[(size_t)k * 6144]; a0 += sv[k] * wv; a1 += sv[D + k] * wv; a2 += sv[2 * D + k] * wv; }
        red[(ks * 3 + 0) * 64 + (tid & 63)] = a0; red[(ks * 3 + 1) * 64 + (tid & 63)] = a1; red[(ks * 3 + 2) * 64 + (tid & 63)] = a2;
        __syncthreads();
        if (tid < 192) { const int j = tid >> 6, nl = tid & 63; float s = p.in[5][l * 6144 + (u % 96) * 64 + nl];
#pragma unroll
            for (int q = 0; q < 8; ++q) s += red[(q * 3 + j) * 64 + nl];
            p.MOD[(size_t)(l * 3 + j) * 6144 + (u % 96) * 64 + nl] = s; }
        __syncthreads();
    }
}
__device__ __forceinline__ void ph_hyF_fast(const P& p, const float* a3, float* lds) {
    float* at = lds;
    float* wt = lds + 64 * 65;
    const float mind = logf(1e-2f) / 1.5f, maxd = logf(1e-2f) / 0.3f;
    for (int u = blockIdx.x; u < (RB / 64) * 16; u += gridDim.x) {
        const int tid = TIDX; const int ct = u % 16, pt = u / 16, p0 = pt * 64, c0 = ct * 128;
        __syncthreads();
#pragma unroll
        for (int i = 0; i < 8; ++i) { const int e = tid + 512 * i; at[(e >> 6) * 65 + (e & 63)] = a3[(size_t)(p0 + (e >> 6)) * 64 + (e & 63)]; }
#pragma unroll
        for (int i = 0; i < 16; ++i) { const int e = tid + 512 * i; wt[e] = p.in[19][(size_t)(e >> 7) * 2048 + c0 + (e & 127)]; }
        __syncthreads();
        const int pos = tid & 63, cg = tid >> 6;
        float acc[16];
#pragma unroll
        for (int q = 0; q < 16; ++q) acc[q] = 0.f;
#pragma unroll 4
        for (int m = 0; m < 64; ++m) { const float a = at[pos * 65 + m];
#pragma unroll
            for (int q = 0; q < 16; ++q) acc[q] += a * wt[m * 128 + cg * 16 + q]; }
        int len, i0; hy_pos(p0 + pos, len, i0); const float tt = (float)i0 / (float)(len - 1);
#pragma unroll
        for (int q = 0; q < 16; ++q) { const int col = c0 + cg * 16 + q; const float delta = fabsf(mind + (float)(col % 512) * ((maxd - mind) / 511.f));
            p.FILT[(size_t)col * RB + p0 + pos] = acc[q] * expf(-tt * delta); }
    }
}
__device__ __forceinline__ void ph_retScan_fast(const P& p) {
    bf16_t* ST = p.Zh;
    GSTRIDE(idx, (long)2 * NB * 4 * 16384) {
        const int ed = idx % 16384, h = (idx / 16384) % 4, b = (idx / 65536) % NB, dir = idx / (65536 * NB);
        const float dc = expf((dir ? p.in[10] : p.in[9])[h] * 128.f);
        bf16_t* base = ST + st_idx(dir, b, h, 0) + ed;
        float s = 0.f;
#pragma unroll 1
        for (int c0 = 0; c0 < NCH; c0 += 11) {
            float u[11]; int cc[11];
#pragma unroll
            for (int j = 0; j < 11; ++j) { const int q = c0 + j; cc[j] = dir == 0 ? q : (q < 2 ? 1 - q : NCH + 1 - q); u[j] = bf2f(base[(size_t)cc[j] * 16384]); }
#pragma unroll
            for (int j = 0; j < 11; ++j) { base[(size_t)cc[j] * 16384] = f2bf(s); s = dc * s + u[j]; }
        }
    }
}
__device__ __forceinline__ void ph_glaScan_fast(const P& p) {
    const float* BF = p.BG; const float* BB = p.BG + (size_t)R * 512;
    GSTRIDE(idx, (long)2 * NB * 4 * 32768) {
        const int d = idx % 128, ed = idx % 32768, h = (idx / 32768) % 4, b = (idx / 131072) % NB, dir = idx / (131072 * NB);
        bf16_t* base = p.GST + gst_idx(dir, b, h, 0) + ed;
        float s = 0.f;
#pragma unroll 1
        for (int c0 = 0; c0 < NCH; c0 += 11) {
            float u[11], dcv[11]; int cc[11];
#pragma unroll
            for (int j = 0; j < 11; ++j) { const int q = c0 + j; cc[j] = dir == 0 ? q : (q < 2 ? 1 - q : NCH + 1 - q); const int r0 = chunk_row0(b, cc[j]);
                u[j] = bf2f(base[(size_t)cc[j] * 32768]); dcv[j] = dir == 0 ? BF[(size_t)(r0 + 127) * 512 + h * 128 + d] : BB[(size_t)r0 * 512 + h * 128 + d]; }
#pragma unroll
            for (int j = 0; j < 11; ++j) { base[(size_t)cc[j] * 32768] = f2bf(s); s = __expf(dcv[j]) * s + u[j]; }
        }
    }
}
__device__ __forceinline__ void ph_glagates_fast(const P& p, float* lds) {
    float* lr = lds;
    for (int u = blockIdx.x; u < NB * NCH * 2; u += gridDim.x) {
        const int tid = TIDX; const int dir = u % 2, c = (u / 2) % NCH, b = u / (2 * NCH); const int r0 = chunk_row0(b, c);
        __syncthreads();
        for (int e = tid; e < 128 * 16; e += NT) lr[e] = bf2f(p.Z1[(size_t)(r0 + (e >> 4)) * GINP + 3072 + dir * 16 + (e & 15)]);
        __syncthreads();
        const float* gw = (dir ? p.in[26] : p.in[24]); float g[16];
#pragma unroll
        for (int q = 0; q < 16; ++q) g[q] = gw[q * 512 + tid];
        const float gb = (dir ? p.in[27] : p.in[25])[tid];
        float* out = p.BG + ((size_t)dir * R + r0) * 512 + tid;
        float s = 0.f;
#pragma unroll 4
        for (int ii = 0; ii < 128; ++ii) { const int i = dir ? 127 - ii : ii; float acc = gb;
#pragma unroll
            for (int q = 0; q < 16; ++q) acc += lr[i * 16 + q] * g[q];
            s += logsigf(acc) * (1.f / 16.f); out[(size_t)i * 512] = s; }
    }
}
template <int MODE, bool ROUTE> __device__ __forceinline__ void ph_post_fast(const P& p, int l, int which, const bf16_t* Y, int ln, int wn, int nrows, const float* xl, const float* xc, float* lds) {
    const float* lg = p.in[6] + (size_t)(l * 2 + which) * D; const float* lb = p.in[7] + (size_t)(l * 2 + which) * D;
    const int tid = TIDX, lane = tid & 63, gw = blockIdx.x * (NT / 64) + (tid >> 6), ngw = gridDim.x * (NT / 64);
    int* lcnt = (int*)(lds + D * NE);
    if (ROUTE) { __syncthreads(); for (int e = tid; e < D * NE; e += NT) lds[(e & 15) * D + (e >> 4)] = p.in[29][e]; if (tid < 32) lcnt[tid] = 0; __syncthreads(); }
    int toff[16];
    if (MODE == 1) { int s = 0;
#pragma unroll
        for (int e = 0; e < 16; ++e) { toff[e] = s; s += (p.CNT[l * 16 + e] + 255) >> 8; } }
    for (int r = gw; r < nrows; r += ngw) {
        const float* x = r < RL ? xl + (size_t)r * D : xc + (size_t)(r - RL) * D; float* xo = xrow(p, r);
        const float* gate = modv(p, l, r, which * 3 + 2);
        const bf16_t *y0, *y1 = nullptr;
        if (MODE == 0) y0 = Y + (size_t)r * D;
        else { int sr[2];
#pragma unroll
            for (int k = 0; k < 2; ++k) { const int e = p.RE[r * 2 + k]; int to = 0;
#pragma unroll
                for (int q = 0; q < 16; ++q) to = (q == e) ? toff[q] : to;
                sr[k] = to * 256 + p.RPOS[r * 2 + k]; }
            y0 = p.slots + (size_t)sr[0] * D; y1 = p.slots + (size_t)sr[1] * D; }
        f32x4 v[4]; float s = 0.f;
#pragma unroll
        for (int i = 0; i < 4; ++i) { const int k = 4 * lane + 256 * i; const f32x4 xv = *(const f32x4*)(x + k), gv = *(const f32x4*)(gate + k);
            const u2v yu = *(const u2v*)(y0 + k); f32x4 yy = {__uint_as_float(yu.x << 16), __uint_as_float(yu.x & 0xffff0000u), __uint_as_float(yu.y << 16), __uint_as_float(yu.y & 0xffff0000u)};
            if (MODE == 1) { const u2v y2 = *(const u2v*)(y1 + k); yy += (f32x4){__uint_as_float(y2.x << 16), __uint_as_float(y2.x & 0xffff0000u), __uint_as_float(y2.y << 16), __uint_as_float(y2.y & 0xffff0000u)}; }
            v[i] = xv * ALPHA + gv * yy; s += (v[i][0] + v[i][1]) + (v[i][2] + v[i][3]); }
        const float mu = wave_sum(s) * (1.f / D); float q2 = 0.f;
#pragma unroll
        for (int i = 0; i < 4; ++i) { v[i] = v[i] - mu; q2 += (v[i][0] * v[i][0] + v[i][1] * v[i][1]) + (v[i][2] * v[i][2] + v[i][3] * v[i][3]); }
        const float rs = 1.f / sqrtf(wave_sum(q2) * (1.f / D) + LN_EPS);
        f32x4 hk[4];
#pragma unroll
        for (int i = 0; i < 4; ++i) { const int k = 4 * lane + 256 * i; const f32x4 xn = v[i] * rs * *(const f32x4*)(lg + k) + *(const f32x4*)(lb + k);
            *(f32x4*)(xo + k) = xn;
            if (ln >= 0) { const f32x4 h2 = xn * (*(const f32x4*)(modv(p, ln, r, wn * 3 + 1) + k) + 1.f) + *(const f32x4*)(modv(p, ln, r, wn * 3 + 0) + k);
                u2v o; o.x = pk_bf16(h2[0], h2[1]); o.y = pk_bf16(h2[2], h2[3]); *(u2v*)(p.H + (size_t)r * D + k) = o;
                if (ROUTE) hk[i] = h2; } }
        if (ROUTE) {
            int best = 0, i1 = 0, i2 = 0; float bs = -1e30f, a1 = 0.f, a2 = 0.f;
#pragma unroll 1
            for (int g = 0; g < NG; ++g) {
                float sg[4], sel[4];
#pragma unroll
                for (int q = 0; q < 4; ++q) { const float* wr = lds + (g * EPG + q) * D + 4 * lane; float a = 0.f;
#pragma unroll
                    for (int i = 0; i < 4; ++i) { const f32x4 wv = *(const f32x4*)(wr + 256 * i); a += (hk[i][0] * wv[0] + hk[i][1] * wv[1]) + (hk[i][2] * wv[2] + hk[i][3] * wv[3]); }
                    sg[q] = sigmf(wave_sum(a)); sel[q] = sg[q] + p.in[30][g * EPG + q]; }
                int j1 = 0; float v1 = sel[0];
#pragma unroll
                for (int q = 1; q < 4; ++q) if (sel[q] > v1) { v1 = sel[q]; j1 = q; }
                int j2 = -1; float v2 = -1e30f;
#pragma unroll
                for (int q = 0; q < 4; ++q) if (q != j1 && sel[q] > v2) { v2 = sel[q]; j2 = q; }
                if (v1 + v2 > bs) { bs = v1 + v2; best = g; i1 = j1; i2 = j2; a1 = 0.f; a2 = 0.f;
#pragma unroll
                    for (int q = 0; q < 4; ++q) { a1 = (q == j1) ? sg[q] : a1; a2 = (q == j2) ? sg[q] : a2; } }
            }
            if (lane == 0) { const int e1 = best * EPG + i1, e2 = best * EPG + i2;
                p.RE[r * 2] = e1; p.RE[r * 2 + 1] = e2; p.RWt[r * 2] = a1 / (a1 + a2); p.RWt[r * 2 + 1] = a2 / (a1 + a2);
                p.RPOS[r * 2] = atomicAdd(&lcnt[e1], 1); p.RPOS[r * 2 + 1] = atomicAdd(&lcnt[e2], 1); }
        }
    }
    if (ROUTE) {
        __syncthreads();
        if (tid < 16) lcnt[16 + tid] = atomicAdd(&p.CNT[l * 16 + tid], lcnt[tid]);
        __syncthreads();
        for (int r = gw + lane * ngw; r < nrows; r += 64 * ngw) {
#pragma unroll
            for (int k = 0; k < 2; ++k) p.RPOS[r * 2 + k] += lcnt[16 + p.RE[r * 2 + k]];
        }
    }
}

constexpr int N_STEPS = 34;
#define PG8_ALIGN true
#define PG8_SP2 true
template <class Epi> __device__ __forceinline__ void dense_gemm(LAS unsigned char* lds, const bf16_t* A, const bf16_t* Bt, int M, int N, int K, const Epi& E) {
    pg8::Gemm g{A, Bt, M, N, K}; pg8::StaticOrder S; S.init(M, N, (int)gridDim.x, (int)blockIdx.x);
    pg8::gemm_phase<Epi, pg8::StaticOrder, PG8_ALIGN, PG8_SP2>(lds, g, S, E);
}
__device__ __forceinline__ void moe_gemms(const P& p, LAS unsigned char* lds, int l, int which) {
    pg8::MoeOrder S; S.init(p.CNT + l * 16, (int)gridDim.x, (int)blockIdx.x);
    if (which == 0) { pg8::Gemm g{p.Hs, p.Wgu, 0, 0, 1024}; pg8::EpiSwiGLU E{p.he}; pg8::gemm_phase<pg8::EpiSwiGLU, pg8::MoeOrder, PG8_ALIGN, PG8_SP2>(lds, g, S, E); }
    else { pg8::Gemm g{p.he, p.Wd, 0, 0, 512}; pg8::EpiRowScale E{p.slots, p.WS}; pg8::gemm_phase<pg8::EpiRowScale, pg8::MoeOrder, PG8_ALIGN, PG8_SP2>(lds, g, S, E); }
}
__device__ __forceinline__ void run_step(const P& p, int step, unsigned char* smem) {
    LAS unsigned char* lds = (LAS unsigned char*)smem; float* fl = (float*)smem;
    float* conv = (float*)p.H;
    switch (step) {
        case 0: ph_ada_fast(p, fl); ph_wconv_fast(p, fl); ph_wconv_moe_fast(p, 0, fl); ph_hyA1(p); break;
        case 1: ph_mod_fast(p, 0, 0, p.in[0], p.in[2]); ph_hyA(p.A1, p.A2, p.in[15], p.in[16], p.in[20] + 64); break;
        case 2: { pg8::EpiSplit E{p.Zr, 2048, p.Zh, 1536, 2048}; dense_gemm(lds, p.H, p.Win0, R, ABIN, D, E); }
                ph_hyA(p.A2, p.A1, p.in[17], p.in[18], p.in[20] + 128); break;
        case 3: ph_prep_rope_fast(p); ph_prep_hy_fast(p, fl); ph_hyF_fast(p, p.A1, fl); break;
        case 4: ph_retU_mfma(p, smem); ph_hyena_fft(p, smem); break;
        case 5: ph_retScan_fast(p); break;
        case 6: break;
        case 7: break;
        case 8: break;
        case 9: ph_retO_mfma(p, smem); ph_hy_untranspose_fast(p, fl); break;
        case 10: ph_hy_untranspose_fast(p, fl); break;
        case 11: { pg8::EpiSplit E{p.Zr, 1024, p.Zr, 1024, 1 << 30}; dense_gemm(lds, p.H, p.Wout0, R, D, D, E); } break;
        case 12: ph_post_fast<0, true>(p, 0, 0, p.Zr, 0, 1, R, p.in[0], p.in[2], fl); break;
        case 13: break;
        case 14: break;
        case 15: ph_permute(p, 0, R); break;
        case 16: moe_gemms(p, lds, 0, 0); break;
        case 17: moe_gemms(p, lds, 0, 1); break;
        case 18: ph_post_fast<1, false>(p, 0, 1, nullptr, 1, 0, R, p.out, p.Xc, fl); break;
        case 19: { pg8::EpiSplit E{p.Z1, GINP, p.Z1, GINP, 1 << 30}; dense_gemm(lds, p.H, p.Win1, R, GINP, D, E); } ph_wconv_moe_fast(p, 1, fl); break;
        case 20: break;
        case 21: break;
        case 22: ph_glaU_mfma(p, smem); break;
        case 23: ph_glaScan_fast(p); break;
        case 24: ph_glaO_mfma(p, smem); break;
        case 25: break;
        case 26: { pg8::EpiSplit E{p.Zr, 1024, p.Zr, 1024, 1 << 30}; dense_gemm(lds, p.H, p.Wout1, RL, D, D, E); } break;
        case 27: ph_post_fast<0, true>(p, 1, 0, p.Zr, 1, 1, RL, p.out, p.Xc, fl); break;
        case 28: break;
        case 29: break;
        case 30: ph_permute(p, 1, RL); break;
        case 31: moe_gemms(p, lds, 1, 0); break;
        case 32: moe_gemms(p, lds, 1, 1); break;
        case 33: ph_post_fast<1, false>(p, 1, 1, nullptr, -1, 0, RL, p.out, p.Xc, fl); break;
    }
}
__global__ void __launch_bounds__(NT, 2) k_all(P p) {
    extern __shared__ __attribute__((aligned(16))) unsigned char smem[];
    cg::grid_group grid = cg::this_grid();
    volatile LAS unsigned* bst = (volatile LAS unsigned*)((LAS unsigned char*)smem + LDS_BYTES - 64);
    if (threadIdx.x < 2) bst[threadIdx.x] = 0u;
    __syncthreads();
    const XcdBarrier bar = xcd_barrier_post(p.BAR, bst);
#define STEP(n) run_step(p, n, smem); xcd_barrier(bar);
#define STEP_CG(n) run_step(p, n, smem); asm volatile("s_waitcnt vmcnt(0)" ::: "memory"); grid.sync();
    STEP_CG(0) STEP(1) STEP(2) STEP(3) STEP(4) STEP(5) STEP(9) STEP(11) STEP(12) STEP(15) STEP(16)
    STEP(17) STEP(18) STEP(19) STEP(22) STEP(23) STEP(24) STEP(26) STEP(27) STEP(30) STEP(31) STEP(32) run_step(p, 33, smem);
#undef STEP
#undef STEP_CG
}

extern "C" void kernel_launch(void* const* d_in, const int* in_sizes, int n_in, void* d_out, int out_size, void* d_ws, size_t ws_size, hipStream_t stream) {
    P p{};
    for (int i = 0; i < 34; ++i) p.in[i] = (const float*)d_in[i];
    p.out = (float*)d_out;
    unsigned char* w = (unsigned char*)d_ws; size_t off = 0;
    auto take = [&](size_t bytes) { unsigned char* r = w + off; off += (bytes + 255) & ~(size_t)255; return r; };
    p.NORM = (float*)take(2 * 2048 * 4); p.CNT = (int*)take(2 * 16 * 4); p.BAR = (unsigned*)take(XCD_BAR_WORDS * 4);
    const size_t ctl_bytes = off;
    p.Win1 = (bf16_t*)take((size_t)GINP * D * 2); p.Wout1 = (bf16_t*)take((size_t)D * D * 2);
    p.Wgu = (bf16_t*)take((size_t)NE * 1024 * 1024 * 2); p.Wd = (bf16_t*)take((size_t)NE * 1024 * 512 * 2);
    p.Xc = (float*)take((size_t)RCX * D * 4); p.MOD = (float*)take(2 * 3 * 6144 * 4);
    p.RS = (float*)take((size_t)R * NE * 4); p.RE = (int*)take((size_t)R * 2 * 4); p.RPOS = (int*)take((size_t)R * 2 * 4); p.RWt = (float*)take((size_t)R * 2 * 4);
    p.WS = (float*)take((size_t)MOE_ROWS * 4);
    const size_t big = off;
    p.H = (bf16_t*)take((size_t)R * D * 2);
    p.Zr = (bf16_t*)take((size_t)R * 2048 * 2);
    p.Zh = (bf16_t*)take((size_t)R * 1536 * 2);
    p.hyT = (bf16_t*)take((size_t)NB * 3 * 512 * RB * 2);
    p.FILT = (float*)take((size_t)2048 * RB * 4);
    p.Win0 = (bf16_t*)take((size_t)ABIN * D * 2); p.Wout0 = (bf16_t*)take((size_t)D * D * 2);
    p.A1 = (float*)take((size_t)RB * 64 * 4); p.A2 = (float*)take((size_t)RB * 64 * 4);
    const size_t total = off;
    off = big + (((size_t)R * D * 2 + 255) & ~(size_t)255);
    p.Hs = (bf16_t*)take((size_t)MOE_ROWS * D * 2); p.he = (bf16_t*)take((size_t)MOE_ROWS * EH * 2); p.slots = (bf16_t*)take((size_t)MOE_ROWS * D * 2);
    const size_t moe_end = off;
    off = big + (((size_t)R * D * 2 + 255) & ~(size_t)255);
    p.Z1 = (bf16_t*)take((size_t)R * GINP * 2); p.BG = (float*)take((size_t)2 * R * 512 * 4); p.GST = (bf16_t*)take((size_t)2 * NB * 4 * NCH * 32768 * 2);
    const size_t l1_end = off;
    if (total > ws_size || moe_end > total || l1_end > total || n_in != 34 || out_size != RL * D) {
        fprintf(stderr, "kernel_launch: bad sizes (need %zu ws bytes, have %zu; moe_end %zu l1_end %zu)\n", total, ws_size, moe_end, l1_end); return; }
    static int grid = 0;
    if (!grid) {
        int dev = 0, cus = 0, per = 0; hipGetDevice(&dev); hipDeviceGetAttribute(&cus, hipDeviceAttributeMultiprocessorCount, dev);
        hipFuncSetAttribute((const void*)k_all, hipFuncAttributeMaxDynamicSharedMemorySize, LDS_BYTES);
        hipOccupancyMaxActiveBlocksPerMultiprocessor(&per, k_all, NT, LDS_BYTES);
        if (per < 1) { fprintf(stderr, "kernel_launch: occupancy query says %d blocks per CU\n", per); per = 1; }
        grid = cus;
    }
    hipMemsetAsync(d_ws, 0, ctl_bytes, stream);
    void* args[] = {&p};
    hipError_t e = hipLaunchCooperativeKernel((void*)k_all, dim3(grid), dim3(NT), args, LDS_BYTES, stream);
    if (e != hipSuccess) fprintf(stderr, "coop launch failed: %s (grid %d)\n", hipGetErrorString(e), grid);
}
```

```cpp
#include <hip/hip_runtime.h>
#include <hip/hip_cooperative_groups.h>
#include <cstdio>
#include <cstdint>
namespace cg = cooperative_groups;


namespace pg8 {
#define PG8_LAS __attribute__((address_space(3)))
typedef unsigned short bf16_t;
typedef short bf16x8 __attribute__((ext_vector_type(8)));
typedef float f32x4 __attribute__((ext_vector_type(4)));
typedef unsigned u32x4 __attribute__((ext_vector_type(4)));
constexpr int BM = 256, BK = 64, HALF = 128, HTB = HALF * BK * 2  , STAGE_BYTES = 8 * HTB, NXCD = 8, WGM = 8;

__host__ __device__ __forceinline__ int lds_byte(int r, int c) { const int st = (r >> 4) * 2 + (c >> 5), rr = r & 15, cc = c & 31, ob = rr * 64 + cc * 2; return st * 1024 + (ob ^ (((ob >> 9) & 1) << 5)); }
__host__ __device__ __forceinline__ void stage_rc(int b, int& R, int& C) { const int st = b / 1024, sb = b % 1024, swz = sb ^ (((sb >> 9) & 1) << 5); R = (st >> 1) * 16 + swz / 64; C = (st & 1) * 32 + (swz % 64) / 2; }
__host__ __device__ __forceinline__ int perm32(int rho) { const int n = rho >> 4, i = rho & 15; return 8 * (i >> 2) + 4 * n + (i & 3); }

struct Unit { int pm, pn; };
struct Gemm { const bf16_t* A; const bf16_t* Bt; int M, N, K; };

struct StaticOrder {
    int nM, nN, nwg, G, c;
    __host__ __device__ void init(int M, int N, int G_, int c_) { nM = M / BM; nN = N / BM; nwg = nM * nN; G = G_; c = c_; }
    __host__ __device__ bool next(int i, Unit& u) const {
        const long L = (long)i * G + c; if (L >= nwg) return false;
        int wgid = (int)L; { const int q = nwg / NXCD, r = nwg % NXCD, xcd = wgid % NXCD, off = wgid / NXCD; wgid = (xcd < r ? xcd * (q + 1) : r * (q + 1) + (xcd - r) * q) + off; }
        const int nig = WGM * nN, gid = wgid / nig, fm = gid * WGM, gsz = (nM - fm) < WGM ? (nM - fm) : WGM;
        u.pm = fm + ((wgid % nig) % gsz); u.pn = (wgid % nig) / gsz; return true;
    }
    __device__ __forceinline__ void a_ready(const Unit&) const {}
    __device__ __forceinline__ void done(const Unit&) const {}
};


__device__ __forceinline__ unsigned cvt_pk_bf16(float lo, float hi) { unsigned r; asm volatile("v_cvt_pk_bf16_f32 %0, %1, %2" : "=v"(r) : "v"(lo), "v"(hi)); return r; }

template <class Epi, class Sched, bool ALIGN_EPI = false, bool SP2 = false>
__device__ __forceinline__ void gemm_phase(PG8_LAS unsigned char* lds, const Gemm g, const Sched& S, const Epi& E) {
    int tid_l = threadIdx.x; asm volatile("" : "+v"(tid_l)); const int tid = tid_l, wid = __builtin_amdgcn_readfirstlane(tid >> 6), lane = tid & 63, wr = wid >> 2, wc = wid & 3, fr = lane & 15, fq = lane >> 4;
    const int K = g.K, nt = K / BK;
    unsigned voffA[2], voffB[2];
#pragma unroll
    for (int i = 0; i < 2; ++i) { int R, C; stage_rc(tid * 16 + i * 8192, R, C); const int Rb = Epi::PERM ? ((R & ~31) + perm32(R & 31)) : R;
        voffA[i] = (unsigned)(R * K + C) * 2u; voffB[i] = (unsigned)(Rb * K + C) * 2u; }
    const size_t kstep = (size_t)(BK * 2);
    const size_t hstep = (size_t)HALF * K * 2;
    const size_t tstep = 2 * hstep;
    const unsigned ldsw = (unsigned)wid * 1024u;
    const int aoff = lds_byte(wr * 64 + fr, fq * 8), boff = lds_byte(wc * 32 + fr, fq * 8);
#define PG8_SA(b, h) (((b) * 2 + (h)) * HTB)
#define PG8_SB(b, h) ((4 + (b) * 2 + (h)) * HTB)
#define PG8_STAGE(bufoff, gbase, voff) do { _Pragma("unroll") for (int _i = 0; _i < 2; ++_i) \
        __builtin_amdgcn_global_load_lds((const unsigned*)((const char*)(gbase) + (voff)[_i]), (PG8_LAS unsigned*)(lds + (bufoff) + ldsw + _i * 8192), 16, 0, 0); } while (0)
#define PG8_LDA(dst, b, h) do { _Pragma("unroll") for (int m = 0; m < 4; ++m) _Pragma("unroll") for (int k = 0; k < 2; ++k) dst[m][k] = *(const PG8_LAS bf16x8*)(lds + PG8_SA(b, h) + aoff + m * 2048 + k * 1024); } while (0)
#define PG8_LDB(dst, b, h) do { _Pragma("unroll") for (int n = 0; n < 2; ++n) _Pragma("unroll") for (int k = 0; k < 2; ++k) dst[n][k] = *(const PG8_LAS bf16x8*)(lds + PG8_SB(b, h) + boff + n * 2048 + k * 1024); } while (0)
#define PG8_MMA(ai, bj, At, Bt) do { __builtin_amdgcn_s_setprio(1); _Pragma("unroll") for (int m = 0; m < 4; ++m) _Pragma("unroll") for (int n = 0; n < 2; ++n) _Pragma("unroll") for (int k = 0; k < 2; ++k) \
        acc[ai][bj][m][n] = __builtin_amdgcn_mfma_f32_16x16x32_bf16(Bt[n][k], At[m][k], acc[ai][bj][m][n], 0, 0, 0); __builtin_amdgcn_s_setprio(0); } while (0)
#define PG8_WAIT_V(n) asm volatile("s_waitcnt vmcnt(" #n ")" ::: "memory")
#define PG8_WAIT_L(n) asm volatile("s_waitcnt lgkmcnt(" #n ")" ::: "memory")
#define PG8_BAR __builtin_amdgcn_s_barrier()
#define PG8_SCHED __builtin_amdgcn_sched_barrier(0)
    Unit cur, nxt; int ui = 0;
    if (!S.next(0, cur)) return;
    f32x4 acc[2][2][4][2];
#pragma unroll
    for (int a = 0; a < 2; ++a)
#pragma unroll
        for (int b = 0; b < 2; ++b)
#pragma unroll
            for (int m = 0; m < 4; ++m)
#pragma unroll
                for (int n = 0; n < 2; ++n) acc[a][b][m][n] = (f32x4){0.f, 0.f, 0.f, 0.f};
    bf16x8 At[4][2], B0[2][2], B1[2][2];
    const char* cA = (const char*)g.A + (size_t)cur.pm * tstep; const char* cB = (const char*)g.Bt + (size_t)cur.pn * tstep;
    S.a_ready(cur);
    if constexpr (SP2) {
        PG8_STAGE(PG8_SB(0, 0), cB, voffB); PG8_STAGE(PG8_SB(0, 1), cB + hstep, voffB); PG8_STAGE(PG8_SA(0, 0), cA, voffA); PG8_STAGE(PG8_SA(0, 1), cA + hstep, voffA);
        if (wr == 1) PG8_BAR;
        PG8_WAIT_V(2); PG8_BAR;
        PG8_STAGE(PG8_SB(1, 0), cB + kstep, voffB); PG8_STAGE(PG8_SA(1, 0), cA + kstep, voffA); PG8_STAGE(PG8_SB(1, 1), cB + hstep + kstep, voffB);
        PG8_WAIT_V(6); PG8_BAR;
    } else {
        PG8_STAGE(PG8_SB(0, 0), cB, voffB); PG8_STAGE(PG8_SA(0, 0), cA, voffA); PG8_STAGE(PG8_SB(0, 1), cB + hstep, voffB); PG8_STAGE(PG8_SA(0, 1), cA + hstep, voffA);
        if (wr == 1) PG8_BAR;
        PG8_WAIT_V(4); PG8_BAR;
        PG8_STAGE(PG8_SB(1, 0), cB + kstep, voffB); PG8_STAGE(PG8_SA(1, 0), cA + kstep, voffA); PG8_STAGE(PG8_SB(1, 1), cB + hstep + kstep, voffB);
        PG8_WAIT_V(6); PG8_BAR;
    }
    for (;;) {
        const bool has_next = S.next(ui + 1, nxt);
        const char* nA = has_next ? (const char*)g.A + (size_t)nxt.pm * tstep : cA; const char* nB = has_next ? (const char*)g.Bt + (size_t)nxt.pn * tstep : cB;
        for (int t = 0; t < nt; t += 2) {
            const bool last = (t == nt - 2);
            const char* a1 = cA + (size_t)(t + 1) * kstep;
            const char* a2 = last ? nA : cA + (size_t)(t + 2) * kstep; const char* b2 = last ? nB : cB + (size_t)(t + 2) * kstep;
            const char* a3 = a2 + kstep; const char* b3 = b2 + kstep;
            if (last && has_next) S.a_ready(nxt);
            if constexpr (SP2) {
            PG8_LDB(B0, 0, 0); PG8_LDB(B1, 0, 1); PG8_SCHED; PG8_LDA(At, 0, 0); PG8_STAGE(PG8_SA(1, 1), a1 + hstep, voffA);
            PG8_WAIT_V(8); PG8_WAIT_L(0); PG8_BAR; PG8_MMA(0, 0, At, B0); PG8_MMA(0, 1, At, B1); PG8_BAR; PG8_SCHED;
            PG8_LDA(At, 0, 1); PG8_STAGE(PG8_SB(0, 0), b2, voffB); PG8_STAGE(PG8_SB(0, 1), b2 + hstep, voffB); PG8_STAGE(PG8_SA(0, 0), a2, voffA);
            PG8_WAIT_V(8); PG8_WAIT_L(0); PG8_BAR; PG8_MMA(1, 0, At, B0); PG8_MMA(1, 1, At, B1); PG8_BAR; PG8_SCHED;
            PG8_LDB(B0, 1, 0); PG8_LDB(B1, 1, 1); PG8_SCHED; PG8_LDA(At, 1, 0); PG8_STAGE(PG8_SA(0, 1), a2 + hstep, voffA);
            PG8_WAIT_V(8); PG8_WAIT_L(0); PG8_BAR; PG8_MMA(0, 0, At, B0); PG8_MMA(0, 1, At, B1); PG8_BAR; PG8_SCHED;
            PG8_LDA(At, 1, 1); PG8_STAGE(PG8_SB(1, 0), b3, voffB); PG8_STAGE(PG8_SB(1, 1), b3 + hstep, voffB); PG8_STAGE(PG8_SA(1, 0), a3, voffA);
            PG8_WAIT_V(8); PG8_WAIT_L(0); PG8_BAR; PG8_MMA(1, 0, At, B0); PG8_MMA(1, 1, At, B1); PG8_BAR; PG8_SCHED;
            } else {
            PG8_LDB(B0, 0, 0); PG8_SCHED; PG8_LDA(At, 0, 0); PG8_STAGE(PG8_SA(1, 1), a1 + hstep, voffA);
            PG8_WAIT_L(8); PG8_BAR; PG8_WAIT_L(0); PG8_MMA(0, 0, At, B0); PG8_BAR; PG8_SCHED;
            PG8_LDB(B1, 0, 1); PG8_STAGE(PG8_SB(0, 0), b2, voffB);
            PG8_BAR; PG8_WAIT_L(0); PG8_MMA(0, 1, At, B1); PG8_BAR;
            PG8_LDA(At, 0, 1); PG8_STAGE(PG8_SA(0, 0), a2, voffA);
            PG8_BAR; PG8_WAIT_L(0); PG8_MMA(1, 0, At, B0); PG8_BAR; PG8_SCHED;
            PG8_STAGE(PG8_SB(0, 1), b2 + hstep, voffB);
            PG8_WAIT_V(6); PG8_BAR; PG8_MMA(1, 1, At, B1); PG8_BAR;
            PG8_LDB(B0, 1, 0); PG8_SCHED; PG8_LDA(At, 1, 0); PG8_STAGE(PG8_SA(0, 1), a2 + hstep, voffA);
            PG8_WAIT_L(8); PG8_BAR; PG8_WAIT_L(0); PG8_MMA(0, 0, At, B0); PG8_BAR; PG8_SCHED;
            PG8_LDB(B1, 1, 1); PG8_STAGE(PG8_SB(1, 0), b3, voffB);
            PG8_BAR; PG8_WAIT_L(0); PG8_MMA(0, 1, At, B1); PG8_BAR;
            PG8_LDA(At, 1, 1); PG8_STAGE(PG8_SA(1, 0), a3, voffA);
            PG8_BAR; PG8_WAIT_L(0); PG8_MMA(1, 0, At, B0); PG8_BAR; PG8_SCHED;
            PG8_STAGE(PG8_SB(1, 1), b3 + hstep, voffB);
            PG8_WAIT_V(6); PG8_BAR; PG8_MMA(1, 1, At, B1); PG8_BAR;
            }
        }
        if constexpr (ALIGN_EPI) { if (wr == 0) PG8_BAR; }
        if constexpr (!Epi::AFTER_DRAIN) { E(acc, cur, wr, wc, fr, fq); S.done(cur); }
        if (!has_next) break;
#pragma unroll
        for (int a = 0; a < 2; ++a)
#pragma unroll
            for (int b = 0; b < 2; ++b)
#pragma unroll
                for (int m = 0; m < 4; ++m)
#pragma unroll
                    for (int n = 0; n < 2; ++n) acc[a][b][m][n] = (f32x4){0.f, 0.f, 0.f, 0.f};
        cur = nxt; cA = nA; cB = nB; ++ui;
        if constexpr (ALIGN_EPI) { if (wr == 1) PG8_BAR; }
    }
    PG8_WAIT_V(0);
    if constexpr (!ALIGN_EPI) { if (wr == 0) PG8_BAR; }
    PG8_BAR;
    if constexpr (Epi::AFTER_DRAIN) { E.fused(acc, cur, wr, wc, fr, fq, lds, wid, lane); S.done(cur); }
#undef PG8_SA
#undef PG8_SB
#undef PG8_STAGE
#undef PG8_LDA
#undef PG8_LDB
#undef PG8_MMA
#undef PG8_WAIT_V
#undef PG8_WAIT_L
#undef PG8_BAR
#undef PG8_SCHED
}
}

typedef float f2v_t __attribute__((ext_vector_type(2)));
typedef __bf16 b2v_t __attribute__((ext_vector_type(2)));
__device__ __forceinline__ unsigned pk_bf16(float lo, float hi) { const f2v_t f = {lo, hi}; const b2v_t b = __builtin_convertvector(f, b2v_t); return __builtin_bit_cast(unsigned, b); }
namespace pg8 {
typedef unsigned u32x2 __attribute__((ext_vector_type(2)));
struct EpiSplit {
    static constexpr bool PERM = true, AFTER_DRAIN = false;
    bf16_t* O0; int ld0; bf16_t* O1; int ld1; int split_col;
    __device__ __forceinline__ void operator()(const f32x4 (&acc)[2][2][4][2], const Unit& u, int wr, int wc, int fr, int fq) const {
        const int row0 = u.pm * BM + wr * 64 + fr; int colt = u.pn * BM; bf16_t* base = O0; int ldc = ld0;
        if (colt >= split_col) { base = O1; ldc = ld1; colt -= split_col; }
        const int col0 = colt + wc * 32 + 8 * fq;
#pragma unroll
        for (int ai = 0; ai < 2; ++ai)
#pragma unroll
            for (int m = 0; m < 4; ++m) { bf16_t* rowp = base + (size_t)(row0 + ai * HALF + m * 16) * ldc + col0;
#pragma unroll
                for (int bj = 0; bj < 2; ++bj) { const f32x4 v0 = acc[ai][bj][m][0], v1 = acc[ai][bj][m][1];
                    u32x4 w; w.x = ::pk_bf16(v0[0], v0[1]); w.y = ::pk_bf16(v0[2], v0[3]); w.z = ::pk_bf16(v1[0], v1[1]); w.w = ::pk_bf16(v1[2], v1[3]);
                    *(u32x4*)(rowp + bj * HALF) = w; } }
    }
};
struct EpiInL0 {
    static constexpr bool PERM = true, AFTER_DRAIN = false;
    bf16_t* Zr; bf16_t* hyT; const float* tab; int RLv, Lv, CTXv, RBv;
    __device__ __forceinline__ void operator()(const f32x4 (&acc)[2][2][4][2], const Unit& u, int wr, int wc, int fr, int fq) const {
        const int rowbase = u.pm * BM, colt = u.pn * BM;
        if (colt < 2048) {
            const int col0 = colt + wc * 32 + 8 * fq; const bool rot = colt < 1024; const int pp0 = wc * 16 + 4 * fq;
#pragma unroll
            for (int ai = 0; ai < 2; ++ai)
#pragma unroll
                for (int m = 0; m < 4; ++m) { const int row = rowbase + wr * 64 + fr + ai * HALF + m * 16; bf16_t* rowp = Zr + (size_t)row * 2048 + col0;
                    const int t = row % Lv; const int prow = t >> 6, pcol = t & 63; const bool dorot = rot && row < RLv;
#pragma unroll
                    for (int bj = 0; bj < 2; ++bj) { f32x4 v0 = acc[ai][bj][m][0], v1 = acc[ai][bj][m][1];
                        if (dorot) {
#pragma unroll
                            for (int pr = 0; pr < 4; ++pr) { const int pp = pp0 + pr; const int pos = pp < 32 ? prow : pcol; const float cs = tab[(pos * 32 + (pp & 31)) * 2], sn = tab[(pos * 32 + (pp & 31)) * 2 + 1];
                                if (pr < 2) { const float x1 = v0[2 * pr], x2 = v0[2 * pr + 1]; v0[2 * pr] = x1 * cs - x2 * sn; v0[2 * pr + 1] = x1 * sn + x2 * cs; }
                                else { const float x1 = v1[2 * pr - 4], x2 = v1[2 * pr - 3]; v1[2 * pr - 4] = x1 * cs - x2 * sn; v1[2 * pr - 3] = x1 * sn + x2 * cs; } } }
                        u32x4 w; w.x = ::pk_bf16(v0[0], v0[1]); w.y = ::pk_bf16(v0[2], v0[3]); w.z = ::pk_bf16(v1[0], v1[1]); w.w = ::pk_bf16(v1[2], v1[3]);
                        *(u32x4*)(rowp + bj * HALF) = w; } }
        } else {
            const int hc0 = colt - 2048 + wc * 32 + 8 * fq;
            int b, tlb; if (rowbase < RLv) { b = rowbase / Lv; tlb = rowbase % Lv; } else { b = (rowbase - RLv) / CTXv; tlb = Lv + (rowbase - RLv) % CTXv; }
#pragma unroll
            for (int ai = 0; ai < 2; ++ai)
#pragma unroll
                for (int m = 0; m < 4; ++m) { const int tl = tlb + wr * 64 + fr + ai * HALF + m * 16;
#pragma unroll
                    for (int bj = 0; bj < 2; ++bj) { const f32x4 v0 = acc[ai][bj][m][0], v1 = acc[ai][bj][m][1];
                        bf16_t* o = hyT + ((size_t)b * 1536 + hc0 + bj * HALF) * RBv + tl;
#pragma unroll
                        for (int q = 0; q < 4; ++q) { o[(size_t)q * RBv] = (bf16_t)(::pk_bf16(v0[q], 0.f) & 0xffffu); o[(size_t)(q + 4) * RBv] = (bf16_t)(::pk_bf16(v1[q], 0.f) & 0xffffu); } } }
        }
    }
};
struct EpiSwiGLU {
    static constexpr bool PERM = true, AFTER_DRAIN = false;
    bf16_t* O;
    __device__ __forceinline__ void operator()(const f32x4 (&acc)[2][2][4][2], const Unit& u, int wr, int wc, int fr, int fq) const {
        const int row0 = u.pm * BM + wr * 64 + fr; const int j0 = (u.pn & 3) * 128 + wc * 16 + 4 * fq;
#pragma unroll
        for (int ai = 0; ai < 2; ++ai)
#pragma unroll
            for (int m = 0; m < 4; ++m) { bf16_t* rowp = O + (size_t)(row0 + ai * HALF + m * 16) * 512 + j0;
#pragma unroll
                for (int bj = 0; bj < 2; ++bj) { const f32x4 g = acc[ai][bj][m][0], up = acc[ai][bj][m][1]; float h[4];
#pragma unroll
                    for (int q = 0; q < 4; ++q) h[q] = g[q] / (1.f + __expf(-g[q])) * up[q];
                    u32x2 w; w.x = ::pk_bf16(h[0], h[1]); w.y = ::pk_bf16(h[2], h[3]);
                    *(u32x2*)(rowp + bj * 64) = w; } }
    }
};
struct EpiRowScale {
    static constexpr bool PERM = true, AFTER_DRAIN = false;
    bf16_t* O; const float* ws;
    __device__ __forceinline__ void operator()(const f32x4 (&acc)[2][2][4][2], const Unit& u, int wr, int wc, int fr, int fq) const {
        const int row0 = u.pm * BM + wr * 64 + fr; const int col0 = (u.pn & 3) * BM + wc * 32 + 8 * fq;
#pragma unroll
        for (int ai = 0; ai < 2; ++ai)
#pragma unroll
            for (int m = 0; m < 4; ++m) { const int row = row0 + ai * HALF + m * 16; const float s = ws[row]; bf16_t* rowp = O + (size_t)row * 1024 + col0;
#pragma unroll
                for (int bj = 0; bj < 2; ++bj) { const f32x4 v0 = acc[ai][bj][m][0] * s, v1 = acc[ai][bj][m][1] * s;
                    u32x4 w; w.x = ::pk_bf16(v0[0], v0[1]); w.y = ::pk_bf16(v0[2], v0[3]); w.z = ::pk_bf16(v1[0], v1[1]); w.w = ::pk_bf16(v1[2], v1[3]);
                    *(u32x4*)(rowp + bj * HALF) = w; } }
    }
};
struct MoeOrder {
    int G, c, nt; int toff[16];
    __device__ __forceinline__ void init(const int* cnt, int G_, int c_) { G = G_; c = c_; int s = 0;
#pragma unroll
        for (int e = 0; e < 16; ++e) { toff[e] = s; s += (cnt[e] + 255) >> 8; } nt = s; }
    __device__ __forceinline__ bool next(int i, Unit& u) const {
        const int Lq = i * G + c; if (Lq >= nt * 4) return false;
        const int pm = Lq % nt, pn4 = Lq / nt; int e = 0;
#pragma unroll
        for (int q = 1; q < 16; ++q) e += (pm >= toff[q]) ? 1 : 0;
        u.pm = pm; u.pn = e * 4 + pn4; return true; }
    __device__ __forceinline__ void a_ready(const Unit&) const {}
    __device__ __forceinline__ void done(const Unit&) const {}
};
}

constexpr int NB = 2, L = 8192, D = 1024, CTX = 256, RB = L + CTX;
constexpr int RL = NB * L, RCX = NB * CTX, R = RL + RCX;
constexpr int GW = 64;
constexpr int NCH = 66;
constexpr int ABIN = 3584, GIN = 3104, GINP = 3328;
constexpr int NE = 16, NG = 4, EPG = 4, EH = 512;
constexpr int MOE_ROWS = 37888;
constexpr float ALPHA = 1.4142135623730951f, LN_EPS = 1e-5f, KSCALE = 0.08838834764831845f;
constexpr int NT = 512;
constexpr int LDS_BYTES = 147456;

typedef unsigned short bf16_t;
#define LAS __attribute__((address_space(3)))
__device__ __forceinline__ float bf2f(bf16_t v) { return __uint_as_float((unsigned)v << 16); }
__device__ __forceinline__ bf16_t f2bf(float f) { unsigned u = __float_as_uint(f); return (bf16_t)((u + 0x7fffu + ((u >> 16) & 1u)) >> 16); }
__device__ __forceinline__ float siluf(float x) { return x / (1.f + expf(-x)); }
__device__ __forceinline__ float sigmf(float x) { return 1.f / (1.f + expf(-x)); }
__device__ __forceinline__ float logsigf(float x) { return fminf(x, 0.f) - log1pf(expf(-fabsf(x))); }

struct P {
    const float* in[34];
    float* out;
    float* Xc;
    float* MOD;
    float* NORM;
    int* CNT;
    unsigned* BAR;
    float* A1; float* A2;
    float* RS; int* RE; int* RPOS; float* RWt; float* WS;
    bf16_t *Win0, *Wout0, *Win1, *Wout1, *Wgu, *Wd;
    bf16_t* H;
    bf16_t* Zr;
    bf16_t* Zh;
    bf16_t* hyT;
    float* FILT;
    bf16_t *Hs, *he, *slots;
    bf16_t* Z1;
    float* BG;
    bf16_t* GST;
};

__device__ __forceinline__ int launder_i(int x) { asm volatile("" : "+v"(x)); return x; }
#define TIDX launder_i((int)threadIdx.x)
#define GSTRIDE(i, n) for (long i = (long)blockIdx.x * blockDim.x + TIDX; i < (long)(n); i += (long)gridDim.x * blockDim.x)

__device__ __forceinline__ float* xrow(const P& p, int r) { return r < RL ? p.out + (size_t)r * D : p.Xc + (size_t)(r - RL) * D; }
__device__ __forceinline__ int seg_of(int r) { return r < RL ? r / L : 2; }
__device__ __forceinline__ const float* modv(const P& p, int l, int r, int chunk) { return p.MOD + ((size_t)(l * 3 + seg_of(r)) * 6 + chunk) * D; }
__device__ __forceinline__ int chunk_row0(int b, int c) { return c < 2 ? RL + b * CTX + c * 128 : b * L + (c - 2) * 128; }
__device__ __forceinline__ void row_bt(int r, int& b, int& tl) { if (r < RL) { b = r / L; tl = r % L; } else { b = (r - RL) / CTX; tl = L + (r - RL) % CTX; } }
__device__ __forceinline__ int bt_row(int b, int tl) { return tl < L ? b * L + tl : RL + b * CTX + (tl - L); }

#define XB_TMO      128
#define XB_XCNT(j)  (256  + 64 * (j))
#define XB_XSUB(j)  (1280 + 64 * (j))
#define XB_XGEN(j)  (2304 + 64 * (j))
#define XB_TOP      3328
#define XB_TOPGEN   3392
#define XCD_BAR_WORDS 3456
#define XB_SPIN_CAP (1u << 18)

__device__ __forceinline__ unsigned xb_ld(unsigned* p)              { return __hip_atomic_load(p, __ATOMIC_RELAXED, __HIP_MEMORY_SCOPE_AGENT); }
__device__ __forceinline__ unsigned xb_add(unsigned* p, unsigned v) { return __hip_atomic_fetch_add(p, v, __ATOMIC_RELAXED, __HIP_MEMORY_SCOPE_AGENT); }
__device__ __forceinline__ unsigned xb_xcc_id() { return (unsigned)__builtin_amdgcn_s_getreg((3 << 11) | 20) & 0xFu; }
#define XB_SPIN(cond, bar) do { unsigned _sp = 0; while (cond) { __builtin_amdgcn_s_sleep(1); \
    if ((++_sp & 255u) == 0u) { if (xb_ld(&(bar)[XB_TMO])) break; if (_sp > XB_SPIN_CAP) { atomicAdd(&(bar)[XB_TMO], 1u); break; } } } } while (0)

struct XcdBarrier {
    unsigned* bar; unsigned x;
    volatile LAS unsigned* st;
};

__device__ __forceinline__ XcdBarrier xcd_barrier_post(unsigned* bar, volatile LAS unsigned* st) {
    XcdBarrier b; b.bar = bar; b.x = xb_xcc_id(); b.st = st;
    if (threadIdx.x == 0) (void)xb_add(&bar[XB_XCNT(b.x)], 1u);
    return b;
}
__device__ __forceinline__ void xcd_barrier_complete(unsigned* bar, unsigned x, unsigned& nloc, unsigned& nx) {
    const unsigned G = gridDim.x * gridDim.y * gridDim.z;
    unsigned sum, cnt, mine, sp = 0u;
    for (;;) {
        sum = 0u; cnt = 0u; mine = 0u;
#pragma unroll
        for (unsigned j = 0; j < 16; ++j) { const unsigned c = xb_ld(&bar[XB_XCNT(j)]); sum += c; cnt += (c > 0u) ? 1u : 0u; mine = (j == x) ? c : mine; }
        if (sum == G) break;
        __builtin_amdgcn_s_sleep(1);
        if ((++sp & 255u) == 0u) { if (xb_ld(&bar[XB_TMO])) break; if (sp > XB_SPIN_CAP) { atomicAdd(&bar[XB_TMO], 1u); break; } }
    }
    nloc = mine > 0u ? mine : 1u; nx = cnt > 0u ? cnt : 1u;
}

__device__ __forceinline__ void xcd_barrier(const XcdBarrier& b) {
    asm volatile("s_waitcnt vmcnt(0)" ::: "memory");
    __syncthreads();
    if (threadIdx.x == 0) {
        unsigned* bar = b.bar;
        __builtin_amdgcn_s_waitcnt(0);
        unsigned nloc = b.st[0], nx = b.st[1];
        if (nloc == 0u) { xcd_barrier_complete(bar, b.x, nloc, nx); b.st[0] = nloc; b.st[1] = nx; }
        const unsigned old = xb_add(&bar[XB_XSUB(b.x)], 1u);
        const unsigned gen = old / nloc;
        if (old + 1u == (gen + 1u) * nloc) {
            __builtin_amdgcn_fence(__ATOMIC_RELEASE, "agent");
            asm volatile("s_waitcnt vmcnt(0)" ::: "memory");
            const unsigned og = xb_add(&bar[XB_TOP], 1u);
            const unsigned tg = og / nx;
            if (og + 1u == (tg + 1u) * nx) xb_add(&bar[XB_TOPGEN], 1u);
            else XB_SPIN(xb_ld(&bar[XB_TOPGEN]) == tg, bar);
            __builtin_amdgcn_fence(__ATOMIC_ACQUIRE, "agent");
            xb_add(&bar[XB_XGEN(b.x)], 1u);
            asm volatile("s_waitcnt vmcnt(0)" ::: "memory");
        } else {
            XB_SPIN(xb_ld(&bar[XB_XGEN(b.x)]) == gen, bar);
            __builtin_amdgcn_fence(__ATOMIC_ACQUIRE, "agent");
            asm volatile("s_waitcnt vmcnt(0)" ::: "memory");
        }
    }
    __syncthreads();
}

__device__ __forceinline__ void ph_wconv(bf16_t* dst, const float* src, int N, int K, int ldsrc, int nvalid) {
    GSTRIDE(idx, (long)N * K) { const int k = idx % K, n = idx / K; dst[idx] = n < nvalid ? f2bf(src[(size_t)k * ldsrc + n]) : (bf16_t)0; }
}
__device__ __forceinline__ void ph_wconv_moe(const P& p, int l) {
    GSTRIDE(idx, (long)NE * 1024 * 1024) {
        const int k = idx % 1024, n = (idx / 1024) % 1024, e = idx / (1024 * 1024);
        const int q = n >> 3, r = n & 7, j = 4 * q + (r & 3);
        const float* src = (r < 4 ? p.in[31] : p.in[32]) + ((size_t)(l * NE + e) * D + k) * EH + j;
        p.Wgu[idx] = f2bf(*src);
    }
    GSTRIDE(idx, (long)NE * 1024 * 512) {
        const int k = idx % 512, n = (idx / 512) % 1024, e = idx / (512 * 1024);
        p.Wd[idx] = f2bf(p.in[33][((size_t)(l * NE + e) * EH + k) * D + n]);
    }
}
__device__ __forceinline__ void ph_ada(const P& p) {
    GSTRIDE(idx, 2 * 3 * 6144) {
        const int n = idx % 6144, j = (idx / 6144) % 3, l = idx / (3 * 6144);
        const float* cv = j < 2 ? p.in[1] + j * D : p.in[3];
        const float* w = p.in[4] + (size_t)l * D * 6144;
        float acc = p.in[5][l * 6144 + n];
        for (int k = 0; k < D; ++k) acc += siluf(cv[k]) * w[(size_t)k * 6144 + n];
        p.MOD[idx] = acc;
    }
}
__device__ __forceinline__ void ph_init(const P& p) {
    GSTRIDE(i, (long)RL * D) p.out[i] = p.in[0][i];
    GSTRIDE(i, (long)RCX * D) p.Xc[i] = p.in[2][i];
}
__device__ __forceinline__ void hy_pos(int pidx, int& len, int& i) { if (pidx < L) { len = L; i = pidx; } else { len = CTX; i = pidx - L; } }
__device__ __forceinline__ void ph_hyA1(const P& p) {
    GSTRIDE(idx, (long)RB * 64) {
        const int j = idx % 64, pidx = idx / 64; int len, i; hy_pos(pidx, len, i);
        const float t = (float)i / (float)(len - 1);
        const float w = 2.0f * 3.14159265358979323846f * (float)i / (float)len;
        const float* w1 = p.in[13];
        float acc = p.in[14][j] + t * w1[j];
        for (int m = 0; m < 16; ++m) {
            const float f = 1e-4f + (float)m * ((15.f - 1e-4f) / 15.f);
            acc += cosf(f * w) * w1[(1 + m) * 64 + j] - sinf(f * w) * w1[(17 + m) * 64 + j];
        }
        p.A1[idx] = sinf(p.in[20][j] * acc);
    }
}
__device__ __forceinline__ void ph_hyA(const float* src, float* dst, const float* w, const float* bias, const float* freq) {
    GSTRIDE(idx, (long)RB * 64) {
        const int j = idx % 64, pidx = idx / 64;
        float acc = bias[j];
        for (int i = 0; i < 64; ++i) acc += src[(size_t)pidx * 64 + i] * w[i * 64 + j];
        dst[idx] = sinf(freq[j] * acc);
    }
}
__device__ __forceinline__ void ph_hyF(const P& p, const float* a3) {
    const float mind = logf(1e-2f) / 1.5f, maxd = logf(1e-2f) / 0.3f;
    GSTRIDE(idx, (long)2048 * RB) {
        const int pidx = idx % RB, col = idx / RB, ch = col % 512; int len, i; hy_pos(pidx, len, i);
        const float t = (float)i / (float)(len - 1);
        float acc = 0.f;
        for (int m = 0; m < 64; ++m) acc += a3[(size_t)pidx * 64 + m] * p.in[19][m * 2048 + col];
        const float delta = fabsf(mind + (float)ch * ((maxd - mind) / 511.f));
        p.FILT[idx] = acc * expf(-t * delta);
    }
}
__device__ __forceinline__ float block_sum(float v, float* red);
__device__ __forceinline__ void ph_hyNorm(const P& p, float* red) {
    for (int u = blockIdx.x; u < 2 * 2048; u += gridDim.x) {
        const int col = u % 2048, which = u / 2048; const int p0 = which ? L : 0, n = which ? CTX : L;
        float s = 0.f;
        for (int i = TIDX; i < n; i += NT) { const float v = p.FILT[(size_t)col * RB + p0 + i]; s += v * v; }
        const float t = block_sum(s, red);
        if (TIDX == 0) p.NORM[which * 2048 + col] = t;
    }
}
__device__ __forceinline__ void ph_mod(const P& p, int l, int which) {
    GSTRIDE(i, (long)R * D) {
        const int r = i / D, k = i % D;
        p.H[i] = f2bf(xrow(p, r)[k] * (1.f + modv(p, l, r, which * 3 + 1)[k]) + modv(p, l, r, which * 3 + 0)[k]);
    }
}
__device__ __forceinline__ void ph_prep_rope(const P& p) {
    GSTRIDE(i, (long)R * 2 * 4 * 64) {
        const int pr = i % 64, h = (i / 64) % 4, w = (i / 256) % 2, r = i / 512;
        bf16_t* base = p.Zr + (size_t)r * 2048 + w * 512 + h * 128;
        float t1 = bf2f(base[pr]), t2 = bf2f(base[64 + pr]);
        if (w == 1) { t1 *= KSCALE; t2 *= KSCALE; }
        if (r < RL) {
            const int t = r % L, row = t / GW, col = t % GW;
            const float inv = powf(10000.f, -(float)(pr & 31) / 32.f);
            const float ang = (pr < 32 ? (float)row : (float)col) * inv;
            float sn, cs; sincosf(ang, &sn, &cs);
            const float a = t1 * cs - t2 * sn, bb = t1 * sn + t2 * cs; t1 = a; t2 = bb;
        }
        base[pr] = f2bf(t1); base[64 + pr] = f2bf(t2);
    }
}
__device__ __forceinline__ void ph_prep_hy(const P& p) {
    GSTRIDE(idx, (long)NB * 1536 * RB) {
        const int tl = idx % RB, col = (idx / RB) % 1536, b = idx / (RB * 1536);
        const int s0 = tl < L ? 0 : L, s1 = tl < L ? L : RB;
        const float* w = p.in[11];
        float acc = p.in[12][col] + w[1536 + col] * bf2f(p.Zh[(size_t)bt_row(b, tl) * 1536 + col]);
        if (tl - 1 >= s0) acc += w[col] * bf2f(p.Zh[(size_t)bt_row(b, tl - 1) * 1536 + col]);
        if (tl + 1 < s1) acc += w[2 * 1536 + col] * bf2f(p.Zh[(size_t)bt_row(b, tl + 1) * 1536 + col]);
        p.hyT[idx] = f2bf(acc);
    }
}
__device__ __forceinline__ float hy_tapT(const float* Ff, const float* Fb, float nf, float nb, int d) {
    if (d > 0) return Ff[d] * nf; if (d < 0) return Fb[-d] * nb; return Ff[0] * nf + Fb[0] * nb;
}
__device__ __forceinline__ void ph_hyconv_naive(const P& p, int n, float* conv) {
    GSTRIDE(idx, (long)NB * 512 * (RB / 4)) {
        const int tb = idx % (RB / 4), ch = (idx / (RB / 4)) % 512, b = idx / ((RB / 4) * 512);
        const int tl0 = tb * 4, s0 = tl0 < L ? 0 : L, len = tl0 < L ? L : CTX, nrm = tl0 < L ? 0 : 1, t0 = tl0 - s0;
        const int cf = (n * 2 + 0) * 512 + ch, cb = (n * 2 + 1) * 512 + ch;
        const float nf = 1.f / sqrtf(p.NORM[nrm * 2048 + cf]), nb = 1.f / sqrtf(p.NORM[nrm * 2048 + cb]);
        const float* Ff = p.FILT + (size_t)cf * RB + s0; const float* Fb = p.FILT + (size_t)cb * RB + s0;
        const bf16_t* z = p.hyT + ((size_t)(b * 3 + 2) * 512 + ch) * RB + s0;
        float w0 = hy_tapT(Ff, Fb, nf, nb, t0), w1 = hy_tapT(Ff, Fb, nf, nb, t0 + 1), w2 = hy_tapT(Ff, Fb, nf, nb, t0 + 2), w3 = hy_tapT(Ff, Fb, nf, nb, t0 + 3);
        float a0 = 0.f, a1 = 0.f, a2 = 0.f, a3 = 0.f;
        for (int s = 0; s < len; ++s) {
            const float zz = bf2f(z[s]);
            a0 += w0 * zz; a1 += w1 * zz; a2 += w2 * zz; a3 += w3 * zz;
            w3 = w2; w2 = w1; w1 = w0;
            if (s + 1 < len) w0 = hy_tapT(Ff, Fb, nf, nb, t0 - (s + 1));
        }
        float* o = conv + ((size_t)b * 512 + ch) * RB + tl0; o[0] = a0; o[1] = a1; o[2] = a2; o[3] = a3;
    }
}
__device__ __forceinline__ void ph_hygate_naive(const P& p, int n, const float* conv) {
    bf16_t* yhT = p.Zh + (size_t)2 * NB * 4 * NCH * 16384;
    GSTRIDE(idx, (long)NB * 512 * RB) {
        const int tl = idx % RB, ch = (idx / RB) % 512, b = idx / (RB * 512);
        bf16_t* z = p.hyT + ((size_t)(b * 3 + 2) * 512 + ch) * RB + tl; const float gate = bf2f(p.hyT[((size_t)(b * 3 + n) * 512 + ch) * RB + tl]);
        const float r = gate * (conv[idx] + p.in[21][n * 512 + ch] * bf2f(*z));
        if (n == 0) *z = f2bf(r); else yhT[idx] = f2bf(r);
    }
}
__device__ __forceinline__ void ph_hy_untranspose(const P& p) {
    const bf16_t* yhT = p.Zh + (size_t)2 * NB * 4 * NCH * 16384;
    GSTRIDE(idx, (long)R * 512) { const int ch = idx % 512, r = idx / 512; int b, tl; row_bt(r, b, tl); p.H[(size_t)r * D + 512 + ch] = yhT[((size_t)b * 512 + ch) * RB + tl]; }
}
__device__ __forceinline__ size_t st_idx(int dir, int b, int h, int c) { return ((((size_t)dir * NB + b) * 4 + h) * NCH + c) * 16384; }
__device__ __forceinline__ void ph_retU_naive(const P& p) {
    bf16_t* ST = p.Zh;
    GSTRIDE(idx, (long)NB * 4 * NCH * 16384) {
        const int d = idx % 128, e = (idx / 128) % 128, c = (idx / 16384) % NCH, h = (idx / (16384 * NCH)) % 4, b = idx / (16384 * NCH * 4);
        const float lgf = p.in[9][h], lgb = p.in[10][h]; const int r0 = chunk_row0(b, c);
        float uf = 0.f, ub = 0.f;
        for (int j = 0; j < 128; ++j) {
            const float kk = bf2f(p.Zr[(size_t)(r0 + j) * 2048 + 512 + h * 128 + d]), vv = bf2f(p.Zr[(size_t)(r0 + j) * 2048 + 1024 + h * 128 + e]);
            uf += kk * expf(lgf * (float)(127 - j)) * vv; ub += kk * expf(lgb * (float)j) * vv;
        }
        ST[st_idx(0, b, h, c) + e * 128 + d] = f2bf(uf); ST[st_idx(1, b, h, c) + e * 128 + d] = f2bf(ub);
    }
}
__device__ __forceinline__ void ph_retScan(const P& p) {
    bf16_t* ST = p.Zh;
    GSTRIDE(idx, (long)2 * NB * 4 * 16384) {
        const int ed = idx % 16384, h = (idx / 16384) % 4, b = (idx / 65536) % NB, dir = idx / (65536 * NB);
        const float dc = expf((dir ? p.in[10] : p.in[9])[h] * 128.f);
        float s = 0.f;
        for (int cc = 0; cc < NCH; ++cc) {
            const int c = dir == 0 ? cc : (cc < 2 ? 1 - cc : NCH + 1 - cc);
            bf16_t* q = ST + st_idx(dir, b, h, c) + ed; const float u = bf2f(*q); *q = f2bf(s); s = dc * s + u;
        }
    }
}
__device__ __forceinline__ void ph_retO_naive(const P& p, float* lds) {
    const bf16_t* ST = p.Zh;
    for (int u = blockIdx.x; u < NB * 4 * NCH; u += gridDim.x) {
        const int c = u % NCH, h = (u / NCH) % 4, b = u / (NCH * 4); const int r0 = chunk_row0(b, c);
        const float lgf = p.in[9][h], lgb = p.in[10][h];
        __syncthreads();
        for (int e = TIDX; e < 128 * 128; e += NT) {
            const int j = e % 128, i = e / 128;
            const bf16_t* q = p.Zr + (size_t)(r0 + i) * 2048 + h * 128; const bf16_t* k = p.Zr + (size_t)(r0 + j) * 2048 + 512 + h * 128;
            float s = 0.f; for (int d = 0; d < 128; ++d) s += bf2f(q[d]) * bf2f(k[d]);
            const float m = i > j ? expf(lgf * (float)(i - j)) : (j > i ? expf(lgb * (float)(j - i)) : 2.f);
            lds[e] = s * m;
        }
        __syncthreads();
        const bf16_t* sf = ST + st_idx(0, b, h, c); const bf16_t* sb = ST + st_idx(1, b, h, c);
        for (int e2 = TIDX; e2 < 128 * 128; e2 += NT) {
            const int e = e2 % 128, i = e2 / 128;
            float o = 0.f; for (int j = 0; j < 128; ++j) o += lds[i * 128 + j] * bf2f(p.Zr[(size_t)(r0 + j) * 2048 + 1024 + h * 128 + e]);
            const bf16_t* q = p.Zr + (size_t)(r0 + i) * 2048 + h * 128;
            float of = 0.f, ob = 0.f; for (int d = 0; d < 128; ++d) { const float qq = bf2f(q[d]); of += qq * bf2f(sf[e * 128 + d]); ob += qq * bf2f(sb[e * 128 + d]); }
            p.H[(size_t)(r0 + i) * D + h * 128 + e] = f2bf(o + expf(lgf * (float)(i + 1)) * of + expf(lgb * (float)(128 - i)) * ob);
        }
    }
}
__device__ __forceinline__ void ph_retNorm_naive(const P& p) {
    GSTRIDE(idx, (long)R * 4) {
        const int h = idx % 4, r = idx / 4; bf16_t* o = p.H + (size_t)r * D + h * 128;
        float mu = 0.f; for (int e = 0; e < 128; ++e) mu += bf2f(o[e]); mu *= (1.f / 128.f);
        float var = 0.f; for (int e = 0; e < 128; ++e) { const float d = bf2f(o[e]) - mu; var += d * d; } var *= (1.f / 128.f);
        const float rs = 1.f / sqrtf(var + LN_EPS);
        for (int e = 0; e < 128; ++e) o[e] = f2bf((bf2f(o[e]) - mu) * rs * siluf(bf2f(p.Zr[(size_t)r * 2048 + 1536 + h * 128 + e])));
    }
}
__device__ __forceinline__ float block_sum(float v, float* red) {
    __syncthreads();
#pragma unroll
    for (int o = 32; o > 0; o >>= 1) v += __shfl_xor(v, o);
    if ((TIDX & 63) == 0) red[TIDX >> 6] = v;
    __syncthreads();
    float t = 0.f;
#pragma unroll
    for (int w = 0; w < NT / 64; ++w) t += red[w];
    return t;
}
template <int MODE> __device__ __forceinline__ void ph_post(const P& p, int l, int which, const bf16_t* Y, int ln, int wn, int nrows, float* red) {
    const float* lg = p.in[6] + (size_t)(l * 2 + which) * D; const float* lb = p.in[7] + (size_t)(l * 2 + which) * D;
    int toff[16];
    if (MODE == 1) { int s = 0;
#pragma unroll
        for (int e = 0; e < 16; ++e) { toff[e] = s; s += (p.CNT[l * 16 + e] + 255) >> 8; } }
    for (int r = blockIdx.x; r < nrows; r += gridDim.x) {
        float* x = xrow(p, r); const float* gate = modv(p, l, r, which * 3 + 2);
        const bf16_t *y0, *y1 = nullptr;
        if (MODE == 0) y0 = Y + (size_t)r * D;
        else {
            int sr[2];
#pragma unroll
            for (int k = 0; k < 2; ++k) { const int e = p.RE[r * 2 + k]; int to = 0;
#pragma unroll
                for (int q = 0; q < 16; ++q) to = (q == e) ? toff[q] : to;
                sr[k] = to * 256 + p.RPOS[r * 2 + k]; }
            y0 = p.slots + (size_t)sr[0] * D; y1 = p.slots + (size_t)sr[1] * D;
        }
        float v[2]; float s = 0.f;
#pragma unroll
        for (int i = 0; i < 2; ++i) { const int k = TIDX + i * NT; float yy = bf2f(y0[k]); if (MODE == 1) yy += bf2f(y1[k]); v[i] = ALPHA * x[k] + gate[k] * yy; s += v[i]; }
        const float mu = block_sum(s, red) * (1.f / D);
        float q = 0.f;
#pragma unroll
        for (int i = 0; i < 2; ++i) { const float d = v[i] - mu; q += d * d; }
        const float rs = 1.f / sqrtf(block_sum(q, red) * (1.f / D) + LN_EPS);
#pragma unroll
        for (int i = 0; i < 2; ++i) { const int k = TIDX + i * NT; const float xn = (v[i] - mu) * rs * lg[k] + lb[k]; x[k] = xn;
            if (ln >= 0) p.H[(size_t)r * D + k] = f2bf(xn * (1.f + modv(p, ln, r, wn * 3 + 1)[k]) + modv(p, ln, r, wn * 3 + 0)[k]); }
    }
}
__device__ __forceinline__ void ph_route1(const P& p, int l, int nrows) {
    GSTRIDE(idx, (long)nrows * NE) {
        const int e = idx % NE, r = idx / NE; const float* x = xrow(p, r); const float* sc = modv(p, l, r, 4); const float* sh = modv(p, l, r, 3);
        float acc = 0.f;
        for (int k = 0; k < D; ++k) acc += (x[k] * (1.f + sc[k]) + sh[k]) * p.in[29][k * NE + e];
        p.RS[idx] = sigmf(acc);
    }
}
__device__ __forceinline__ void ph_route2(const P& p, int l, int nrows) {
    GSTRIDE(r, nrows) {
        const float* s = p.RS + (size_t)r * NE; const float* rb = p.in[30];
        int best = 0; float bs = -1e30f;
        for (int g = 0; g < NG; ++g) {
            float m1 = -1e30f, m2 = -1e30f;
            for (int q = 0; q < EPG; ++q) { const float v = s[g * EPG + q] + rb[g * EPG + q]; if (v > m1) { m2 = m1; m1 = v; } else if (v > m2) m2 = v; }
            if (m1 + m2 > bs) { bs = m1 + m2; best = g; }
        }
        int i1 = 0; float v1 = -1e30f;
        for (int q = 0; q < EPG; ++q) { const float v = s[best * EPG + q] + rb[best * EPG + q]; if (v > v1) { v1 = v; i1 = q; } }
        int i2 = 0; float v2 = -1e30f;
        for (int q = 0; q < EPG; ++q) { if (q == i1) continue; const float v = s[best * EPG + q] + rb[best * EPG + q]; if (v > v2) { v2 = v; i2 = q; } }
        const int e1 = best * EPG + i1, e2 = best * EPG + i2; const float a = s[e1], c = s[e2];
        p.RE[r * 2] = e1; p.RE[r * 2 + 1] = e2; p.RWt[r * 2] = a / (a + c); p.RWt[r * 2 + 1] = c / (a + c);
        p.RPOS[r * 2] = atomicAdd(&p.CNT[l * 16 + e1], 1); p.RPOS[r * 2 + 1] = atomicAdd(&p.CNT[l * 16 + e2], 1);
    }
}
__device__ __forceinline__ void ph_permute(const P& p, int l, int nrows) {
    int toff[16]; { int s = 0;
#pragma unroll
        for (int e = 0; e < 16; ++e) { toff[e] = s; s += (p.CNT[l * 16 + e] + 255) >> 8; } }
    GSTRIDE(idx, (long)nrows * 2 * 128) {
        const int ck = idx % 128, k = (idx / 128) % 2, r = idx / 256; const int e = p.RE[r * 2 + k]; int to = 0;
#pragma unroll
        for (int q = 0; q < 16; ++q) to = (q == e) ? toff[q] : to;
        const int sr = to * 256 + p.RPOS[r * 2 + k];
        ((uint4*)(p.Hs + (size_t)sr * D))[ck] = ((const uint4*)(p.H + (size_t)r * D))[ck];
        if (ck == 0) p.WS[sr] = p.RWt[r * 2 + k];
    }
}
__device__ __forceinline__ void ph_glagate(const P& p) {
    GSTRIDE(idx, (long)2 * R * 512) {
        const int ch = idx % 512, r = (idx / 512) % R, dir = idx / (512 * R);
        const float* gw = (dir ? p.in[26] : p.in[24]); const float* gb = (dir ? p.in[27] : p.in[25]);
        float acc = gb[ch];
        for (int q = 0; q < 16; ++q) acc += bf2f(p.Z1[(size_t)r * GINP + 3072 + dir * 16 + q]) * gw[q * 512 + ch];
        p.BG[idx] = logsigf(acc) * (1.f / 16.f);
    }
}
__device__ __forceinline__ void ph_glacum(const P& p) {
    GSTRIDE(idx, (long)2 * NB * NCH * 512) {
        const int ch = idx % 512, c = (idx / 512) % NCH, b = (idx / (512 * NCH)) % NB, dir = idx / (512 * NCH * NB);
        float* a = p.BG + ((size_t)dir * R + chunk_row0(b, c)) * 512 + ch;
        float s = 0.f;
        if (dir == 0) for (int i = 0; i < 128; ++i) { s += a[(size_t)i * 512]; a[(size_t)i * 512] = s; }
        else for (int i = 127; i >= 0; --i) { s += a[(size_t)i * 512]; a[(size_t)i * 512] = s; }
    }
}
__device__ __forceinline__ size_t gst_idx(int dir, int b, int h, int c) { return ((((size_t)dir * NB + b) * 4 + h) * NCH + c) * 32768; }
__device__ __forceinline__ void ph_glaU_naive(const P& p) {
    const float* BF = p.BG; const float* BB = p.BG + (size_t)R * 512;
    GSTRIDE(idx, (long)NB * 4 * NCH * 32768) {
        const int d = idx % 128, e = (idx / 128) % 256, c = (idx / 32768) % NCH, h = (idx / (32768 * NCH)) % 4, b = idx / (32768 * NCH * 4);
        const int r0 = chunk_row0(b, c);
        const float bfe = BF[(size_t)(r0 + 127) * 512 + h * 128 + d], bbe = BB[(size_t)r0 * 512 + h * 128 + d];
        float uf = 0.f, ub = 0.f;
        for (int j = 0; j < 128; ++j) {
            const float kk = bf2f(p.Z1[(size_t)(r0 + j) * GINP + 512 + h * 128 + d]), vv = bf2f(p.Z1[(size_t)(r0 + j) * GINP + 1024 + h * 256 + e]);
            uf += kk * expf(bfe - BF[(size_t)(r0 + j) * 512 + h * 128 + d]) * vv; ub += kk * expf(bbe - BB[(size_t)(r0 + j) * 512 + h * 128 + d]) * vv;
        }
        p.GST[gst_idx(0, b, h, c) + e * 128 + d] = f2bf(uf); p.GST[gst_idx(1, b, h, c) + e * 128 + d] = f2bf(ub);
    }
}
__device__ __forceinline__ void ph_glaScan(const P& p) {
    const float* BF = p.BG; const float* BB = p.BG + (size_t)R * 512;
    GSTRIDE(idx, (long)2 * NB * 4 * 32768) {
        const int d = idx % 128, ed = idx % 32768, h = (idx / 32768) % 4, b = (idx / 131072) % NB, dir = idx / (131072 * NB);
        float s = 0.f;
        for (int cc = 0; cc < NCH; ++cc) {
            const int c = dir == 0 ? cc : (cc < 2 ? 1 - cc : NCH + 1 - cc); const int r0 = chunk_row0(b, c);
            const float dc = dir == 0 ? expf(BF[(size_t)(r0 + 127) * 512 + h * 128 + d]) : expf(BB[(size_t)r0 * 512 + h * 128 + d]);
            bf16_t* q = p.GST + gst_idx(dir, b, h, c) + ed; const float u = bf2f(*q); *q = f2bf(s); s = dc * s + u;
        }
    }
}
__device__ __forceinline__ void ph_glaO_naive(const P& p, float* lds) {
    const float* BF = p.BG; const float* BB = p.BG + (size_t)R * 512;
    for (int u = blockIdx.x; u < NB * 4 * 64; u += gridDim.x) {
        const int c = 2 + u % 64, h = (u / 64) % 4, b = u / 256; const int r0 = chunk_row0(b, c);
        __syncthreads();
        for (int e = TIDX; e < 128 * 128; e += NT) {
            const int j = e % 128, i = e / 128;
            const bf16_t* q = p.Z1 + (size_t)(r0 + i) * GINP + h * 128; const bf16_t* k = p.Z1 + (size_t)(r0 + j) * GINP + 512 + h * 128;
            float s = 0.f;
            if (i >= j) { const float* bi = BF + (size_t)(r0 + i) * 512 + h * 128; const float* bj = BF + (size_t)(r0 + j) * 512 + h * 128;
                for (int d = 0; d < 128; ++d) s += bf2f(q[d]) * bf2f(k[d]) * expf(bi[d] - bj[d]); }
            if (i <= j) { const float* bi = BB + (size_t)(r0 + i) * 512 + h * 128; const float* bj = BB + (size_t)(r0 + j) * 512 + h * 128;
                for (int d = 0; d < 128; ++d) s += bf2f(q[d]) * bf2f(k[d]) * expf(bi[d] - bj[d]); }
            lds[e] = s * KSCALE;
        }
        __syncthreads();
        const bf16_t* sf = p.GST + gst_idx(0, b, h, c); const bf16_t* sb = p.GST + gst_idx(1, b, h, c);
        for (int e2 = TIDX; e2 < 128 * 256; e2 += NT) {
            const int e = e2 % 256, i = e2 / 256;
            float o = 0.f; for (int j = 0; j < 128; ++j) o += lds[i * 128 + j] * bf2f(p.Z1[(size_t)(r0 + j) * GINP + 1024 + h * 256 + e]);
            const bf16_t* q = p.Z1 + (size_t)(r0 + i) * GINP + h * 128; const float* bi = BF + (size_t)(r0 + i) * 512 + h * 128; const float* bbi = BB + (size_t)(r0 + i) * 512 + h * 128;
            float a = 0.f; for (int d = 0; d < 128; ++d) a += bf2f(q[d]) * (expf(bi[d]) * bf2f(sf[e * 128 + d]) + expf(bbi[d]) * bf2f(sb[e * 128 + d]));
            p.H[(size_t)(r0 + i) * D + h * 256 + e] = f2bf(o + a * KSCALE);
        }
    }
}
__device__ __forceinline__ void ph_glaNorm_naive(const P& p) {
    GSTRIDE(idx, (long)RL * 4) {
        const int h = idx % 4, r = idx / 4; bf16_t* o = p.H + (size_t)r * D + h * 256;
        float ss = 0.f; for (int e = 0; e < 256; ++e) { const float v = bf2f(o[e]); ss += v * v; }
        const float rs = 1.f / sqrtf(ss * (1.f / 256.f) + LN_EPS);
        for (int e = 0; e < 256; ++e) o[e] = f2bf(bf2f(o[e]) * rs * siluf(bf2f(p.Z1[(size_t)r * GINP + 2048 + h * 256 + e])));
    }
}

#define FD __device__ __forceinline__
#define TIE(a, b) asm volatile("" : "+v"(a) : "v"(b))
#define HWCOS(x) __builtin_amdgcn_cosf(x)
#define HWSIN(x) __builtin_amdgcn_sinf(x)
struct cf { float x, y; };
FD cf cadd(cf a, cf b) { return {a.x + b.x, a.y + b.y}; }
FD cf csub(cf a, cf b) { return {a.x - b.x, a.y - b.y}; }
FD cf cmul(cf a, cf b) { return {a.x * b.x - a.y * b.y, a.x * b.y + a.y * b.x}; }
#define C32(k) ((k)==0?1.0f:(k)==1?0.98078528040323043f:(k)==2?0.92387953251128674f:(k)==3?0.83146961230254524f:(k)==4?0.70710678118654752f:(k)==5?0.55557023301960222f:(k)==6?0.38268343236508977f:(k)==7?0.19509032201612825f:(k)==8?0.0f:(k)==9?-0.19509032201612825f:(k)==10?-0.38268343236508977f:(k)==11?-0.55557023301960222f:(k)==12?-0.70710678118654752f:(k)==13?-0.83146961230254524f:(k)==14?-0.92387953251128674f:-0.98078528040323043f)
#define S32(k) ((k)==0?0.0f:(k)==1?0.19509032201612825f:(k)==2?0.38268343236508977f:(k)==3?0.55557023301960222f:(k)==4?0.70710678118654752f:(k)==5?0.83146961230254524f:(k)==6?0.92387953251128674f:(k)==7?0.98078528040323043f:(k)==8?1.0f:(k)==9?0.98078528040323043f:(k)==10?0.92387953251128674f:(k)==11?0.83146961230254524f:(k)==12?0.70710678118654752f:(k)==13?0.55557023301960222f:(k)==14?0.38268343236508977f:0.19509032201612825f)
template <int N, int LEN, bool INV> FD void dit_level(cf (&x)[N]) {
#pragma unroll
    for (int blk = 0; blk < N; blk += LEN)
#pragma unroll
        for (int j = 0; j < LEN / 2; ++j) {
            const int k = j * (32 / LEN);
            const cf a = x[blk + j], b0 = x[blk + j + LEN / 2];
            const cf b = k == 0 ? b0 : (k == 8 ? (INV ? cf{-b0.y, b0.x} : cf{b0.y, -b0.x}) : cmul(b0, cf{C32(k), INV ? S32(k) : -S32(k)}));
            x[blk + j] = cadd(a, b); x[blk + j + LEN / 2] = csub(a, b);
        }
}
template <int N, bool INV> FD void dit_reg(cf (&x)[N]) {
    dit_level<N, 2, INV>(x); dit_level<N, 4, INV>(x);
    if constexpr (N >= 8) dit_level<N, 8, INV>(x);
    if constexpr (N >= 16) dit_level<N, 16, INV>(x);
}
template <int N, int LEN, bool INV> FD void dif_level(cf (&x)[N]) {
#pragma unroll
    for (int blk = 0; blk < N; blk += LEN)
#pragma unroll
        for (int j = 0; j < LEN / 2; ++j) {
            const int k = j * (32 / LEN);
            const cf a = x[blk + j], b = x[blk + j + LEN / 2];
            x[blk + j] = cadd(a, b); const cf d = csub(a, b);
            x[blk + j + LEN / 2] = k == 0 ? d : (k == 8 ? (INV ? cf{-d.y, d.x} : cf{d.y, -d.x}) : cmul(d, cf{C32(k), INV ? S32(k) : -S32(k)}));
        }
}
template <int N, bool INV> FD void dif_reg(cf (&x)[N]) {
    if constexpr (N >= 16) dif_level<N, 16, INV>(x);
    if constexpr (N >= 8) dif_level<N, 8, INV>(x);
    dif_level<N, 4, INV>(x); dif_level<N, 2, INV>(x);
}
constexpr int FFT_N = 16384, FFT_LDS_CF = 17920;
FD int brev4(int i) { return ((i & 1) << 3) | ((i & 2) << 1) | ((i & 4) >> 1) | ((i & 8) >> 3); }
FD int physA(int m, int a) { return 4480 * a + m + (m >> 4) + 16 * (m >> 9); }
FD int physB(int b, int a, int m) { return 4480 * b + 272 * a + 16 * (a >> 1) + m + (m >> 4); }
FD int physC(int b, int a, int m) { return 272 * b + 16 * (b >> 1) + 17 * a + m; }
FD int physD(int g, int j) { return 17 * g + 16 * (g >> 5) + j; }
template <int RR, int RM> FD void twiddle(cf (&x)[RR], int m, float sgn) {
    const float fr = (float)m * (1.0f / (float)RM); const cf w{HWCOS(fr), sgn * HWSIN(fr)}; cf cur = w;
#pragma unroll
    for (int s = 1; s < RR; ++s) { x[s] = cmul(x[s], cur); if (s + 1 < RR) cur = cmul(cur, w); }
}
FD void stA_fwd(int m, cf v0, cf v1, cf v2, cf v3, cf* buf) {
    cf x[4] = {v0, v2, v1, v3};
    dit_reg<4, false>(x); twiddle<4, 16384>(x, m, -1.f);
#pragma unroll
    for (int s = 0; s < 4; ++s) buf[physA(m, s)] = x[s];
}
FD void stB_fwd(int idx, cf* buf) {
    const int b = idx >> 8, m = idx & 255; cf x[16];
#pragma unroll
    for (int i = 0; i < 16; ++i) x[i] = buf[physB(b, brev4(i), m)];
    dit_reg<16, false>(x); twiddle<16, 4096>(x, m, -1.f);
#pragma unroll
    for (int s = 0; s < 16; ++s) buf[physB(b, s, m)] = x[s];
}
FD void stC_fwd(int idx, cf* buf) {
    const int b = idx >> 4, m = idx & 15; cf x[16];
#pragma unroll
    for (int i = 0; i < 16; ++i) x[i] = buf[physC(b, brev4(i), m)];
    dit_reg<16, false>(x); twiddle<16, 256>(x, m, -1.f);
#pragma unroll
    for (int s = 0; s < 16; ++s) buf[physC(b, s, m)] = x[s];
}
FD void stD_fwd_regs(int g, const cf* buf, cf (&x)[16]) {
#pragma unroll
    for (int i = 0; i < 16; ++i) x[i] = buf[physD(g, brev4(i))];
    dit_reg<16, false>(x);
}
FD void stD_mul(int g, cf* buf, const cf (&h)[16]) {
    cf x[16];
#pragma unroll
    for (int i = 0; i < 16; ++i) x[i] = buf[physD(g, brev4(i))];
    dit_reg<16, false>(x);
#pragma unroll
    for (int s = 0; s < 16; ++s) x[s] = cmul(x[s], h[s]);
    dif_reg<16, true>(x);
#pragma unroll
    for (int i = 0; i < 16; ++i) buf[physD(g, brev4(i))] = x[i];
}
FD void stC_inv(int idx, cf* buf) {
    const int b = idx >> 4, m = idx & 15; cf x[16];
#pragma unroll
    for (int s = 0; s < 16; ++s) x[s] = buf[physC(b, s, m)];
    twiddle<16, 256>(x, m, 1.f); dif_reg<16, true>(x);
#pragma unroll
    for (int i = 0; i < 16; ++i) buf[physC(b, brev4(i), m)] = x[i];
}
FD void stB_inv(int idx, cf* buf) {
    const int b = idx >> 8, m = idx & 255; cf x[16];
#pragma unroll
    for (int s = 0; s < 16; ++s) x[s] = buf[physB(b, s, m)];
    twiddle<16, 4096>(x, m, 1.f); dif_reg<16, true>(x);
#pragma unroll
    for (int i = 0; i < 16; ++i) buf[physB(b, brev4(i), m)] = x[i];
}
FD void stA_inv(int m, const cf* buf, cf& r0, cf& r1) {
    cf x[4];
#pragma unroll
    for (int s = 0; s < 4; ++s) x[s] = buf[physA(m, s)];
    twiddle<4, 16384>(x, m, 1.f); dif_reg<4, true>(x);
    r0 = x[0]; r1 = x[2];
}

#undef FD
__device__ __forceinline__ float dw3(const bf16_t* u, int d, int lo, int hi, float w0, float w1, float w2, float bs) {
    float a = bs + w1 * bf2f(u[d]);
    if (d > lo) a += w0 * bf2f(u[d - 1]);
    if (d < hi) a += w2 * bf2f(u[d + 1]);
    return a;
}
__device__ __forceinline__ void ph_hyena_fft(const P& p, unsigned char* smem) {
    cf* buf = (cf*)smem; float* fb = (float*)smem; float* red = (float*)(smem + FFT_LDS_CF * 8);
    const int t = TIDX;
    bf16_t* yhT = p.Zh + (size_t)2 * NB * 4 * NCH * 16384;
    for (int ch = blockIdx.x; ch < 512; ch += gridDim.x) {
        const bf16_t* hy0 = p.hyT + ((size_t)0 * 512 + ch) * RB;
        const size_t bstr = (size_t)3 * 512 * RB, jstr = (size_t)512 * RB;
        cf* Hg = (cf*)p.H + (size_t)blockIdx.x * 16384;
        cf zreg[16];
        float cw[3][3], cbv[3];
#pragma unroll
        for (int j = 0; j < 3; ++j) { cbv[j] = p.in[12][j * 512 + ch];
#pragma unroll
            for (int q = 0; q < 3; ++q) cw[j][q] = p.in[11][q * 1536 + j * 512 + ch]; }
#pragma unroll 1
        for (int n = 0; n < 2; ++n) {
            const int cfi = (n * 2) * 512 + ch, cbi = (n * 2 + 1) * 512 + ch;
            const float* Ff = p.FILT + (size_t)cfi * RB; const float* Fb = p.FILT + (size_t)cbi * RB;
            float tf0[8], tf1[8], tb2[8], tb3[8]; float sf = 0.f, sb = 0.f;
#pragma unroll
            for (int j = 0; j < 8; ++j) { const int m = t + 512 * j;
                tf0[j] = Ff[m]; tf1[j] = Ff[4096 + m]; tb2[j] = (m == 0) ? Fb[0] : Fb[8192 - (m == 0 ? 1 : m)]; tb3[j] = Fb[4096 - m];
                sf += tf0[j] * tf0[j] + tf1[j] * tf1[j]; sb += tb2[j] * tb2[j] + tb3[j] * tb3[j]; }
            const float nf = 1.f / sqrtf(block_sum(sf, red)), nb = 1.f / sqrtf(block_sum(sb, red));
#pragma unroll
            for (int j = 0; j < 8; ++j) { const int m = launder_i(t) + 512 * j;
                const float v0 = tf0[j] * nf + ((m == 0) ? tb2[j] * nb : 0.f), v2 = (m == 0) ? 0.f : tb2[j] * nb;
                stA_fwd(m, cf{v0, 0.f}, cf{tf1[j] * nf, 0.f}, cf{v2, 0.f}, cf{tb3[j] * nb, 0.f}, buf); }
            __syncthreads();
#pragma unroll 1
            for (int q = 0; q < 2; ++q) stB_fwd(launder_i(t) + 512 * q, buf);
            __syncthreads();
#pragma unroll 1
            for (int q = 0; q < 2; ++q) stC_fwd(launder_i(t) + 512 * q, buf);
            __syncthreads();
#pragma unroll 1
            for (int q = 0; q < 2; ++q) { const int g = launder_i(t) + 512 * q; cf hh[16]; stD_fwd_regs(g, buf, hh);
#pragma unroll
                for (int s = 0; s < 16; ++s) Hg[s * 1024 + g] = hh[s]; }
            __syncthreads();
#pragma unroll
            for (int j = 0; j < 8; ++j) { const int m = launder_i(t) + 512 * j;
                if (n == 0) { zreg[2 * j] = cf{dw3(hy0 + 2 * jstr, m, 0, L - 1, cw[2][0], cw[2][1], cw[2][2], cbv[2]), dw3(hy0 + bstr + 2 * jstr, m, 0, L - 1, cw[2][0], cw[2][1], cw[2][2], cbv[2])};
                              zreg[2 * j + 1] = cf{dw3(hy0 + 2 * jstr, 4096 + m, 0, L - 1, cw[2][0], cw[2][1], cw[2][2], cbv[2]), dw3(hy0 + bstr + 2 * jstr, 4096 + m, 0, L - 1, cw[2][0], cw[2][1], cw[2][2], cbv[2])}; }
                stA_fwd(m, zreg[2 * j], zreg[2 * j + 1], cf{0.f, 0.f}, cf{0.f, 0.f}, buf); }
            __syncthreads();
#pragma unroll 1
            for (int q = 0; q < 2; ++q) stB_fwd(launder_i(t) + 512 * q, buf);
            __syncthreads();
#pragma unroll 1
            for (int q = 0; q < 2; ++q) stC_fwd(launder_i(t) + 512 * q, buf);
            __syncthreads();
#pragma unroll 1
            for (int q = 0; q < 2; ++q) { const int g = launder_i(t) + 512 * q; cf hh[16];
#pragma unroll
                for (int s = 0; s < 16; ++s) hh[s] = Hg[s * 1024 + g];
                stD_mul(g, buf, hh); }
            __syncthreads();
#pragma unroll 1
            for (int q = 0; q < 2; ++q) stC_inv(launder_i(t) + 512 * q, buf);
            __syncthreads();
#pragma unroll 1
            for (int q = 0; q < 2; ++q) stB_inv(launder_i(t) + 512 * q, buf);
            __syncthreads();
            const float sk = p.in[21][n * 512 + ch];
#pragma unroll
            for (int j = 0; j < 8; ++j) { const int m = launder_i(t) + 512 * j; cf r0, r1; stA_inv(m, buf, r0, r1);
#pragma unroll
                for (int hlf = 0; hlf < 2; ++hlf) { const int d = m + 4096 * hlf; const cf r = hlf ? r1 : r0; const cf z = zreg[2 * j + hlf];
                    const bf16_t* gs = hy0 + n * jstr;
                    const float g0 = dw3(gs, d, 0, L - 1, cw[n][0], cw[n][1], cw[n][2], cbv[n]), g1 = dw3(gs + bstr, d, 0, L - 1, cw[n][0], cw[n][1], cw[n][2], cbv[n]);
                    const float o0 = g0 * (r.x * (1.f / 16384.f) + sk * z.x), o1 = g1 * (r.y * (1.f / 16384.f) + sk * z.y);
                    if (n == 0) zreg[2 * j + hlf] = cf{o0, o1};
                    else { yhT[((size_t)0 * 512 + ch) * RB + d] = f2bf(o0); yhT[((size_t)1 * 512 + ch) * RB + d] = f2bf(o1); } } }
            __syncthreads();
        }
        {
            float* tap = fb;
            float* zc = fb + 1024;
            const int b = t >> 8, tt = t & 255;
#pragma unroll
            for (int n = 0; n < 2; ++n) {
                const int cfi = (n * 2) * 512 + ch, cbi = (n * 2 + 1) * 512 + ch;
                const float* Ff = p.FILT + (size_t)cfi * RB + L; const float* Fb = p.FILT + (size_t)cbi * RB + L;
                const float vf = t < 256 ? Ff[t] : 0.f, vb = t < 256 ? Fb[t] : 0.f;
                const float nf = 1.f / sqrtf(block_sum(vf * vf, red)), nb = 1.f / sqrtf(block_sum(vb * vb, red));
                if (t < 511) { const int d = t - 255; tap[n * 512 + t] = d > 0 ? Ff[d] * nf : (d < 0 ? Fb[-d] * nb : Ff[0] * nf + Fb[0] * nb); }
            }
            const bf16_t* hb_ = hy0 + (size_t)b * bstr;
            const float z1 = dw3(hb_ + 2 * jstr, L + tt, L, RB - 1, cw[2][0], cw[2][1], cw[2][2], cbv[2]);
            zc[b * 256 + tt] = z1;
            __syncthreads();
            float c1 = 0.f;
            for (int s = 0; s < 256; ++s) c1 += tap[tt - s + 255] * zc[b * 256 + s];
            const float z2 = dw3(hb_, L + tt, L, RB - 1, cw[0][0], cw[0][1], cw[0][2], cbv[0]) * (c1 + p.in[21][ch] * z1);
            __syncthreads();
            zc[b * 256 + tt] = z2;
            __syncthreads();
            float c2 = 0.f;
            for (int s = 0; s < 256; ++s) c2 += tap[512 + tt - s + 255] * zc[b * 256 + s];
            yhT[((size_t)b * 512 + ch) * RB + L + tt] = f2bf(dw3(hb_ + jstr, L + tt, L, RB - 1, cw[1][0], cw[1][1], cw[1][2], cbv[1]) * (c2 + p.in[21][512 + ch] * z2));
            __syncthreads();
        }
    }
}

typedef short bf16x8 __attribute__((ext_vector_type(8)));
typedef short s16x4 __attribute__((ext_vector_type(4)));
typedef float f32x4 __attribute__((ext_vector_type(4)));
typedef unsigned u4v __attribute__((ext_vector_type(4)));
typedef unsigned u2v __attribute__((ext_vector_type(2)));
constexpr int LDT = 136;
constexpr int TILE_E = 128 * LDT;
__device__ __forceinline__ bf16x8 frag_row(const LAS bf16_t* T, int ld, int r0, int k0, int lane) {
    return *(const LAS bf16x8*)(T + (r0 + (lane & 15)) * ld + k0 + 8 * (lane >> 4));
}
__device__ __forceinline__ bf16x8 frag_tr(const LAS bf16_t* T, int ld, int k0, int n0, int lane) {
    const int g = lane >> 4, q = (lane & 15) >> 2, pp = lane & 3;
    const LAS bf16_t* a0 = T + (k0 + 8 * g + q) * ld + n0 + 4 * pp;
    const s16x4 lo = __builtin_amdgcn_ds_read_tr16_b64_v4i16((LAS s16x4*)a0);
    const s16x4 hi = __builtin_amdgcn_ds_read_tr16_b64_v4i16((LAS s16x4*)(a0 + 4 * ld));
    return (bf16x8){lo[0], lo[1], lo[2], lo[3], hi[0], hi[1], hi[2], hi[3]};
}
#define MFMA16(xn, xm, acc) __builtin_amdgcn_mfma_f32_16x16x32_bf16(xn, xm, acc, 0, 0, 0)
__device__ __forceinline__ void unpack8(const u4v u, float (&f)[8]) {
    f[0] = __uint_as_float(u.x << 16); f[1] = __uint_as_float(u.x & 0xffff0000u); f[2] = __uint_as_float(u.y << 16); f[3] = __uint_as_float(u.y & 0xffff0000u);
    f[4] = __uint_as_float(u.z << 16); f[5] = __uint_as_float(u.z & 0xffff0000u); f[6] = __uint_as_float(u.w << 16); f[7] = __uint_as_float(u.w & 0xffff0000u);
}
__device__ __forceinline__ u4v pack8(const float (&f)[8]) {
    u4v u; u.x = pk_bf16(f[0], f[1]); u.y = pk_bf16(f[2], f[3]); u.z = pk_bf16(f[4], f[5]); u.w = pk_bf16(f[6], f[7]); return u;
}
__device__ __forceinline__ void stage_tile(LAS bf16_t* dst, const bf16_t* src, int gld, int tid) {
#pragma unroll
    for (int i = 0; i < 4; ++i) { const int c = tid + 512 * i, row = c >> 4, ch = c & 15;
        *(LAS u4v*)(dst + row * LDT + ch * 8) = *(const u4v*)(src + (size_t)row * gld + ch * 8); }
}
__device__ __forceinline__ void ph_retU_mfma(const P& p, unsigned char* smem) {
    LAS bf16_t* Kt = (LAS bf16_t*)smem; LAS bf16_t* VF = Kt + TILE_E; LAS bf16_t* VB = VF + TILE_E;
    bf16_t* ST = p.Zh;
    for (int u = blockIdx.x; u < NB * 4 * NCH; u += gridDim.x) {
        const int tid = TIDX, lane = tid & 63, w = tid >> 6;
        const int c = u % NCH, h = (u / NCH) % 4, b = u / (NCH * 4); const int r0 = chunk_row0(b, c);
        const float lgf = p.in[9][h], lgb = p.in[10][h];
        const bf16_t* kb = p.Zr + (size_t)r0 * 2048 + 512 + h * 128; const bf16_t* vb = p.Zr + (size_t)r0 * 2048 + 1024 + h * 128;
        __syncthreads();
        stage_tile(Kt, kb, 2048, tid);
#pragma unroll
        for (int i = 0; i < 4; ++i) { const int cc = tid + 512 * i, j = cc >> 4, ch = cc & 15;
            float f[8], g[8]; unpack8(*(const u4v*)(vb + (size_t)j * 2048 + ch * 8), f);
            const float wf = __expf(lgf * (float)(127 - j)), wb = __expf(lgb * (float)j);
#pragma unroll
            for (int q = 0; q < 8; ++q) { g[q] = f[q] * wb; f[q] *= wf; }
            *(LAS u4v*)(VF + j * LDT + ch * 8) = pack8(f); *(LAS u4v*)(VB + j * LDT + ch * 8) = pack8(g); }
        __syncthreads();
        f32x4 af[8], ab[8];
#pragma unroll
        for (int nt = 0; nt < 8; ++nt) { af[nt] = (f32x4){0.f, 0.f, 0.f, 0.f}; ab[nt] = (f32x4){0.f, 0.f, 0.f, 0.f}; }
#pragma unroll
        for (int ks = 0; ks < 4; ++ks) {
            const bf16x8 xf = frag_tr(VF, LDT, 32 * ks, 16 * w, lane), xb = frag_tr(VB, LDT, 32 * ks, 16 * w, lane);
#pragma unroll
            for (int nt = 0; nt < 8; ++nt) { const bf16x8 xn = frag_tr(Kt, LDT, 32 * ks, 16 * nt, lane); af[nt] = MFMA16(xn, xf, af[nt]); ab[nt] = MFMA16(xn, xb, ab[nt]); }
        }
        const int e = 16 * w + (lane & 15), d0 = 4 * (lane >> 4);
        bf16_t* of = ST + st_idx(0, b, h, c) + e * 128 + d0; bf16_t* ob = ST + st_idx(1, b, h, c) + e * 128 + d0;
#pragma unroll
        for (int nt = 0; nt < 8; ++nt) {
            u2v o; o.x = pk_bf16(af[nt][0], af[nt][1]); o.y = pk_bf16(af[nt][2], af[nt][3]); *(u2v*)(of + 16 * nt) = o;
            o.x = pk_bf16(ab[nt][0], ab[nt][1]); o.y = pk_bf16(ab[nt][2], ab[nt][3]); *(u2v*)(ob + 16 * nt) = o; }
    }
}
__device__ __forceinline__ void ph_retO_mfma(const P& p, unsigned char* smem) {
    LAS bf16_t* Qs = (LAS bf16_t*)smem; LAS bf16_t* Ks = Qs + TILE_E; LAS bf16_t* Vs = Ks + TILE_E; LAS bf16_t* Ss = Vs + TILE_E;
    const bf16_t* ST = p.Zh;
    for (int u = blockIdx.x; u < NB * 4 * NCH; u += gridDim.x) {
        const int tid = TIDX, lane = tid & 63, w = tid >> 6, fr = lane & 15, fq = lane >> 4;
        const int c = u % NCH, h = (u / NCH) % 4, b = u / (NCH * 4); const int r0 = chunk_row0(b, c);
        const float lgf = p.in[9][h], lgb = p.in[10][h];
        const bf16_t* zb = p.Zr + (size_t)r0 * 2048 + h * 128;
        __syncthreads();
        stage_tile(Qs, zb, 2048, tid); stage_tile(Ks, zb + 512, 2048, tid); stage_tile(Vs, zb + 1024, 2048, tid); stage_tile(Ss, ST + st_idx(0, b, h, c), 128, tid);
        __syncthreads();
        f32x4 as[8], af[8];
#pragma unroll
        for (int nt = 0; nt < 8; ++nt) { as[nt] = (f32x4){0.f, 0.f, 0.f, 0.f}; af[nt] = (f32x4){0.f, 0.f, 0.f, 0.f}; }
#pragma unroll
        for (int ks = 0; ks < 4; ++ks) { const bf16x8 xm = frag_row(Qs, LDT, 16 * w, 32 * ks, lane);
#pragma unroll
            for (int nt = 0; nt < 8; ++nt) { as[nt] = MFMA16(frag_row(Ks, LDT, 16 * nt, 32 * ks, lane), xm, as[nt]); af[nt] = MFMA16(frag_row(Ss, LDT, 16 * nt, 32 * ks, lane), xm, af[nt]); } }
        const int i = 16 * w + fr;
        __syncthreads();
#pragma unroll
        for (int nt = 0; nt < 8; ++nt) { float pv[4];
#pragma unroll
            for (int q = 0; q < 4; ++q) { const int j = 16 * nt + 4 * fq + q; const float m = i > j ? __expf(lgf * (float)(i - j)) : (j > i ? __expf(lgb * (float)(j - i)) : 2.f); pv[q] = as[nt][q] * m; }
            u2v o; o.x = pk_bf16(pv[0], pv[1]); o.y = pk_bf16(pv[2], pv[3]); *(LAS u2v*)(Ks + i * LDT + 16 * nt + 4 * fq) = o; }
        stage_tile(Ss, ST + st_idx(1, b, h, c), 128, tid);
        __syncthreads();
        f32x4 ao[8], ab[8];
#pragma unroll
        for (int nt = 0; nt < 8; ++nt) { ao[nt] = (f32x4){0.f, 0.f, 0.f, 0.f}; ab[nt] = (f32x4){0.f, 0.f, 0.f, 0.f}; }
#pragma unroll
        for (int ks = 0; ks < 4; ++ks) { const bf16x8 xp = frag_row(Ks, LDT, 16 * w, 32 * ks, lane), xq = frag_row(Qs, LDT, 16 * w, 32 * ks, lane);
#pragma unroll
            for (int nt = 0; nt < 8; ++nt) { ao[nt] = MFMA16(frag_tr(Vs, LDT, 32 * ks, 16 * nt, lane), xp, ao[nt]); ab[nt] = MFMA16(frag_row(Ss, LDT, 16 * nt, 32 * ks, lane), xq, ab[nt]); } }
        const float rf = __expf(lgf * (float)(i + 1)), rb = __expf(lgb * (float)(128 - i));
        float s = 0.f;
#pragma unroll
        for (int nt = 0; nt < 8; ++nt) { ao[nt] = ao[nt] + af[nt] * rf + ab[nt] * rb; s += (ao[nt][0] + ao[nt][1]) + (ao[nt][2] + ao[nt][3]); }
        s += __shfl_xor(s, 16); s += __shfl_xor(s, 32);
        const float mu = s * (1.f / 128.f); float qv = 0.f;
#pragma unroll
        for (int nt = 0; nt < 8; ++nt) { const f32x4 dd = ao[nt] - mu; qv += (dd[0] * dd[0] + dd[1] * dd[1]) + (dd[2] * dd[2] + dd[3] * dd[3]); }
        qv += __shfl_xor(qv, 16); qv += __shfl_xor(qv, 32);
        const float rs = 1.f / sqrtf(qv * (1.f / 128.f) + LN_EPS);
        const bf16_t* gp = p.Zr + (size_t)(r0 + i) * 2048 + 1536 + h * 128 + 4 * fq; bf16_t* yp = p.H + (size_t)(r0 + i) * D + h * 128 + 4 * fq;
#pragma unroll
        for (int nt = 0; nt < 8; ++nt) { const u2v gu = *(const u2v*)(gp + 16 * nt);
            const float g0 = __uint_as_float(gu.x << 16), g1 = __uint_as_float(gu.x & 0xffff0000u), g2 = __uint_as_float(gu.y << 16), g3 = __uint_as_float(gu.y & 0xffff0000u);
            u2v o; o.x = pk_bf16((ao[nt][0] - mu) * rs * siluf(g0), (ao[nt][1] - mu) * rs * siluf(g1)); o.y = pk_bf16((ao[nt][2] - mu) * rs * siluf(g2), (ao[nt][3] - mu) * rs * siluf(g3));
            *(u2v*)(yp + 16 * nt) = o; }
    }
}
__device__ __forceinline__ void ph_glaU_mfma(const P& p, unsigned char* smem) {
    LAS bf16_t* KF = (LAS bf16_t*)smem; LAS bf16_t* KB = KF + TILE_E; LAS bf16_t* Vs = KB + TILE_E;
    for (int u = blockIdx.x; u < NB * 4 * NCH; u += gridDim.x) {
        const int tid = TIDX, lane = tid & 63, w = tid >> 6;
        const int c = u % NCH, h = (u / NCH) % 4, b = u / (NCH * 4); const int r0 = chunk_row0(b, c);
        const bf16_t* kb = p.Z1 + (size_t)r0 * GINP + 512 + h * 128; const bf16_t* vb = p.Z1 + (size_t)r0 * GINP + 1024 + h * 256;
        float* BFw = p.BG + (size_t)r0 * 512 + h * 128; float* BBw = p.BG + (size_t)R * 512 + (size_t)r0 * 512 + h * 128;
        const float* BF = BFw; const float* BB = BBw;
        __syncthreads();
        {
            float* lr = (float*)(Vs);
            float* tot = lr + 128 * 32;
            for (int e = tid; e < 128 * 32; e += NT) lr[e] = bf2f(p.Z1[(size_t)(r0 + (e >> 5)) * GINP + 3072 + (e & 31)]);
            const int chn = tid & 127, dir = (tid >> 7) & 1, half = tid >> 8;
            const float* gw = (dir ? p.in[26] : p.in[24]) + h * 128 + chn; float g[16];
#pragma unroll
            for (int q = 0; q < 16; ++q) g[q] = gw[q * 512];
            const float gb = (dir ? p.in[27] : p.in[25])[h * 128 + chn];
            __syncthreads();
            float la[64]; float s = 0.f;
#pragma unroll
            for (int ii = 0; ii < 64; ++ii) { const int i = half * 64 + ii; float a = gb;
#pragma unroll
                for (int q = 0; q < 16; ++q) a += lr[i * 32 + dir * 16 + q] * g[q];
                la[ii] = (fminf(a, 0.f) - __logf(1.f + __expf(-fabsf(a)))) * (1.f / 16.f); s += la[ii]; }
            tot[(dir * 2 + half) * 128 + chn] = s;
            __syncthreads();
            const float total = tot[(dir * 2 + 0) * 128 + chn] + tot[(dir * 2 + 1) * 128 + chn];
            s = dir == 0 ? (half ? tot[(0 * 2 + 0) * 128 + chn] : 0.f) : (half ? 0.f : tot[(1 * 2 + 1) * 128 + chn]);
            float* out = (dir ? BBw : BFw) + chn; LAS bf16_t* Kd = dir ? KB : KF;
            if (dir == 0) {
#pragma unroll
                for (int ii = 0; ii < 64; ++ii) { const int i = half * 64 + ii; s += la[ii]; out[(size_t)i * 512] = s; Kd[i * LDT + chn] = f2bf(bf2f(kb[(size_t)i * GINP + chn]) * __expf(total - s)); }
            } else {
#pragma unroll
                for (int ii = 63; ii >= 0; --ii) { const int i = half * 64 + ii; s += la[ii]; out[(size_t)i * 512] = s; Kd[i * LDT + chn] = f2bf(bf2f(kb[(size_t)i * GINP + chn]) * __expf(total - s)); }
            }
            __syncthreads();
        }
        const int fr = lane & 15, fq = lane >> 4;
#pragma unroll 1
        for (int hf = 0; hf < 2; ++hf) {
            if (hf) __syncthreads();
            stage_tile(Vs, vb + hf * 128, GINP, tid);
            __syncthreads();
            {
                f32x4 af[8], ab[8];
#pragma unroll
                for (int nt = 0; nt < 8; ++nt) { af[nt] = (f32x4){0.f, 0.f, 0.f, 0.f}; ab[nt] = (f32x4){0.f, 0.f, 0.f, 0.f}; }
#pragma unroll
                for (int ks = 0; ks < 4; ++ks) { const bf16x8 x0 = frag_tr(Vs, LDT, 32 * ks, 16 * w, lane);
#pragma unroll
                    for (int nt = 0; nt < 8; ++nt) { af[nt] = MFMA16(frag_tr(KF, LDT, 32 * ks, 16 * nt, lane), x0, af[nt]); ab[nt] = MFMA16(frag_tr(KB, LDT, 32 * ks, 16 * nt, lane), x0, ab[nt]); } }
                bf16_t* of = p.GST + gst_idx(0, b, h, c) + (size_t)(hf * 128 + 16 * w + fr) * 128 + 4 * fq; bf16_t* ob = p.GST + gst_idx(1, b, h, c) + (size_t)(hf * 128 + 16 * w + fr) * 128 + 4 * fq;
#pragma unroll
                for (int nt = 0; nt < 8; ++nt) { u2v v; v.x = pk_bf16(af[nt][0], af[nt][1]); v.y = pk_bf16(af[nt][2], af[nt][3]); *(u2v*)(of + 16 * nt) = v;
                    v.x = pk_bf16(ab[nt][0], ab[nt][1]); v.y = pk_bf16(ab[nt][2], ab[nt][3]); *(u2v*)(ob + 16 * nt) = v; }
            }
        }
    }
}
__device__ __forceinline__ void stage_scaled(LAS bf16_t* dst, const bf16_t* src, const float* G, float sgn, float mul, int tid) {
#pragma unroll
    for (int i = 0; i < 4; ++i) { const int cc = tid + 512 * i, j = cc >> 4, ch = cc & 15;
        float k8[8]; unpack8(*(const u4v*)(src + (size_t)j * GINP + ch * 8), k8);
        const f32x4 f0 = *(const f32x4*)(G + (size_t)j * 512 + ch * 8), f1 = *(const f32x4*)(G + (size_t)j * 512 + ch * 8 + 4);
#pragma unroll
        for (int q = 0; q < 4; ++q) { k8[q] *= __expf(sgn * f0[q]) * mul; k8[q + 4] *= __expf(sgn * f1[q]) * mul; }
        *(LAS u4v*)(dst + j * LDT + ch * 8) = pack8(k8); }
}
__device__ __forceinline__ void ph_glaO_mfma(const P& p, unsigned char* smem) {
    LAS bf16_t* QF = (LAS bf16_t*)smem; LAS bf16_t* QB = QF + TILE_E; LAS bf16_t* KX = QB + TILE_E; LAS bf16_t* R4 = KX + TILE_E;
    for (int u = blockIdx.x; u < NB * 4 * 64; u += gridDim.x) {
        const int tid = TIDX, lane = tid & 63, w = tid >> 6, fr = lane & 15, fq = lane >> 4;
        const int c = 2 + u % 64, h = (u / 64) % 4, b = u / 256; const int r0 = chunk_row0(b, c);
        const bf16_t* qb = p.Z1 + (size_t)r0 * GINP + h * 128; const bf16_t* kb = qb + 512; const bf16_t* vb = p.Z1 + (size_t)r0 * GINP + 1024 + h * 256;
        const float* BF = p.BG + (size_t)r0 * 512 + h * 128; const float* BB = p.BG + (size_t)R * 512 + (size_t)r0 * 512 + h * 128;
        const int i = 16 * w + fr;
        __syncthreads();
        stage_scaled(QF, qb, BF, 1.f, KSCALE, tid); stage_scaled(QB, qb, BB, 1.f, KSCALE, tid); stage_scaled(KX, kb, BF, -1.f, 1.f, tid);
        __syncthreads();
        f32x4 s1[8];
#pragma unroll
        for (int nt = 0; nt < 8; ++nt) s1[nt] = (f32x4){0.f, 0.f, 0.f, 0.f};
#pragma unroll
        for (int ks = 0; ks < 4; ++ks) { const bf16x8 xm = frag_row(QF, LDT, 16 * w, 32 * ks, lane);
#pragma unroll
            for (int nt = 0; nt < 8; ++nt) s1[nt] = MFMA16(frag_row(KX, LDT, 16 * nt, 32 * ks, lane), xm, s1[nt]); }
#pragma unroll
        for (int nt = 0; nt < 8; ++nt)
#pragma unroll
            for (int q = 0; q < 4; ++q) { const int j = 16 * nt + 4 * fq + q; s1[nt][q] = (i >= j) ? s1[nt][q] : 0.f; }
        __syncthreads();
        stage_scaled(KX, kb, BB, -1.f, 1.f, tid);
        __syncthreads();
        {
            f32x4 s2[8];
#pragma unroll
            for (int nt = 0; nt < 8; ++nt) s2[nt] = (f32x4){0.f, 0.f, 0.f, 0.f};
#pragma unroll
            for (int ks = 0; ks < 4; ++ks) { const bf16x8 xm = frag_row(QB, LDT, 16 * w, 32 * ks, lane);
#pragma unroll
                for (int nt = 0; nt < 8; ++nt) s2[nt] = MFMA16(frag_row(KX, LDT, 16 * nt, 32 * ks, lane), xm, s2[nt]); }
#pragma unroll
            for (int nt = 0; nt < 8; ++nt)
#pragma unroll
                for (int q = 0; q < 4; ++q) { const int j = 16 * nt + 4 * fq + q; s1[nt][q] += (i <= j) ? s2[nt][q] : 0.f; }
        }
        __syncthreads();
#pragma unroll
        for (int nt = 0; nt < 8; ++nt) { u2v o; o.x = pk_bf16(s1[nt][0], s1[nt][1]); o.y = pk_bf16(s1[nt][2], s1[nt][3]); *(LAS u2v*)(KX + i * LDT + 16 * nt + 4 * fq) = o; }
        f32x4 ao[2][8];
#pragma unroll
        for (int hf = 0; hf < 2; ++hf) {
#pragma unroll
            for (int nt = 0; nt < 8; ++nt) ao[hf][nt] = (f32x4){0.f, 0.f, 0.f, 0.f};
            stage_tile(R4, vb + hf * 128, GINP, tid);
            __syncthreads();
#pragma unroll
            for (int ks = 0; ks < 4; ++ks) { const bf16x8 xp = frag_row(KX, LDT, 16 * w, 32 * ks, lane);
#pragma unroll
                for (int nt = 0; nt < 8; ++nt) ao[hf][nt] = MFMA16(frag_tr(R4, LDT, 32 * ks, 16 * nt, lane), xp, ao[hf][nt]); }
            __syncthreads();
            stage_tile(R4, p.GST + gst_idx(0, b, h, c) + (size_t)hf * 128 * 128, 128, tid);
            __syncthreads();
#pragma unroll
            for (int ks = 0; ks < 4; ++ks) { const bf16x8 xq = frag_row(QF, LDT, 16 * w, 32 * ks, lane);
#pragma unroll
                for (int nt = 0; nt < 8; ++nt) ao[hf][nt] = MFMA16(frag_row(R4, LDT, 16 * nt, 32 * ks, lane), xq, ao[hf][nt]); }
            __syncthreads();
            stage_tile(R4, p.GST + gst_idx(1, b, h, c) + (size_t)hf * 128 * 128, 128, tid);
            __syncthreads();
#pragma unroll
            for (int ks = 0; ks < 4; ++ks) { const bf16x8 xq = frag_row(QB, LDT, 16 * w, 32 * ks, lane);
#pragma unroll
                for (int nt = 0; nt < 8; ++nt) ao[hf][nt] = MFMA16(frag_row(R4, LDT, 16 * nt, 32 * ks, lane), xq, ao[hf][nt]); }
            __syncthreads();
        }
        float ss = 0.f;
#pragma unroll
        for (int hf = 0; hf < 2; ++hf)
#pragma unroll
            for (int nt = 0; nt < 8; ++nt) { const f32x4 v = ao[hf][nt]; ss += (v[0] * v[0] + v[1] * v[1]) + (v[2] * v[2] + v[3] * v[3]); }
        ss += __shfl_xor(ss, 16); ss += __shfl_xor(ss, 32);
        const float rs = 1.f / sqrtf(ss * (1.f / 256.f) + LN_EPS);
        const bf16_t* gp = p.Z1 + (size_t)(r0 + i) * GINP + 2048 + h * 256 + 4 * fq; bf16_t* yp = p.H + (size_t)(r0 + i) * D + h * 256 + 4 * fq;
#pragma unroll
        for (int hf = 0; hf < 2; ++hf)
#pragma unroll
            for (int nt = 0; nt < 8; ++nt) { const u2v gu = *(const u2v*)(gp + hf * 128 + 16 * nt);
                const float g0 = __uint_as_float(gu.x << 16), g1 = __uint_as_float(gu.x & 0xffff0000u), g2 = __uint_as_float(gu.y << 16), g3 = __uint_as_float(gu.y & 0xffff0000u);
                u2v o; o.x = pk_bf16(ao[hf][nt][0] * rs * siluf(g0), ao[hf][nt][1] * rs * siluf(g1)); o.y = pk_bf16(ao[hf][nt][2] * rs * siluf(g2), ao[hf][nt][3] * rs * siluf(g3));
                *(u2v*)(yp + hf * 128 + 16 * nt) = o; }
    }
}

template <int MODE> __device__ __forceinline__ void tr_w(bf16_t* dst, const float* src, int N, int K, int ldsrc, float* t  , int& tile0, int tile_stride) {
    const int nt_n = N / 64, ntiles = nt_n * (K / 64);
    for (int tile = tile0; tile < ntiles; tile += tile_stride) {
        const int tid = TIDX; const int n0 = (tile % nt_n) * 64, k0 = (tile / nt_n) * 64;
        __syncthreads();
#pragma unroll
        for (int i = 0; i < 8; ++i) { const int e = tid + 512 * i, kk = e >> 6, nn = e & 63; t[kk * 65 + nn] = src[(size_t)(k0 + kk) * ldsrc + n0 + nn]; }
        __syncthreads();
#pragma unroll
        for (int i = 0; i < 4; ++i) { const int e = tid + 512 * i, nn = e >> 5, kp = e & 31; const int n = n0 + nn;
            int row; float sc = 1.f;
            if (MODE == 0) row = n; else if (MODE == 3) { const int d = n & 127; row = n < 1024 ? (n - d) + 2 * (d & 63) + (d >> 6) : n; sc = (n >= 512 && n < 1024) ? KSCALE : 1.f; }
            else row = 8 * (n >> 2) + (n & 3) + (MODE == 2 ? 4 : 0);
            *(unsigned*)(dst + (size_t)row * K + k0 + 2 * kp) = pk_bf16(t[(2 * kp) * 65 + nn] * sc, t[(2 * kp + 1) * 65 + nn] * sc); }
    }
    tile0 = tile0 - (ntiles % tile_stride);
    if (tile0 < 0) tile0 += tile_stride;
}
__device__ __forceinline__ void ph_wconv_fast(const P& p, float* t) {
    int t0 = blockIdx.x; const int G = gridDim.x;
    tr_w<3>(p.Win0, p.in[8], ABIN, D, ABIN, t, t0, G);
    tr_w<0>(p.Wout0, p.in[22], D, D, D, t, t0, G);
    tr_w<0>(p.Win1, p.in[23], 3072, D, GIN, t, t0, G);
    tr_w<0>(p.Wout1, p.in[28], D, D, D, t, t0, G);
    GSTRIDE(idx, (long)(GINP - 3072) * D) { const int k = idx % D, n = 3072 + idx / D; p.Win1[(size_t)n * D + k] = n < GIN ? f2bf(p.in[23][(size_t)k * GIN + n]) : (bf16_t)0; }
}
__device__ __forceinline__ void ph_wconv_moe_fast(const P& p, int l, float* t) {
    int t0 = blockIdx.x; const int G = gridDim.x;
    for (int e = 0; e < NE; ++e) {
        tr_w<1>(p.Wgu + (size_t)e * 1024 * 1024, p.in[31] + (size_t)(l * NE + e) * D * EH, EH, D, EH, t, t0, G);
        tr_w<2>(p.Wgu + (size_t)e * 1024 * 1024, p.in[32] + (size_t)(l * NE + e) * D * EH, EH, D, EH, t, t0, G);
        tr_w<0>(p.Wd + (size_t)e * 1024 * 512, p.in[33] + (size_t)(l * NE + e) * EH * D, D, EH, D, t, t0, G);
    }
}
__device__ __forceinline__ void ph_prep_hy_fast(const P& p, float* t  ) {
    const int ntt = RB / 64, ntc = 1536 / 64;
    for (int tile = blockIdx.x; tile < NB * ntt * ntc; tile += gridDim.x) {
        const int tid = TIDX; const int ct = tile % ntc, tt = (tile / ntc) % ntt, b = tile / (ntc * ntt); const int c0 = ct * 64, tl0 = tt * 64;
        const int s0 = tl0 < L ? 0 : L, s1 = tl0 < L ? L : RB;
        __syncthreads();
        for (int e = tid; e < 66 * 64; e += NT) { const int rr = e >> 6, cc = e & 63, tl = tl0 - 1 + rr;
            t[rr * 65 + cc] = (tl >= s0 && tl < s1) ? bf2f(p.Zh[(size_t)bt_row(b, tl) * 1536 + c0 + cc]) : 0.f; }
        __syncthreads();
#pragma unroll
        for (int i = 0; i < 4; ++i) { const int e = tid + 512 * i, cc = e >> 5, tp = e & 31; const int col = c0 + cc;
            const float w0 = p.in[11][col], w1 = p.in[11][1536 + col], w2 = p.in[11][3072 + col], bs = p.in[12][col];
            const float a = bs + w0 * t[(2 * tp) * 65 + cc] + w1 * t[(2 * tp + 1) * 65 + cc] + w2 * t[(2 * tp + 2) * 65 + cc];
            const float c2 = bs + w0 * t[(2 * tp + 1) * 65 + cc] + w1 * t[(2 * tp + 2) * 65 + cc] + w2 * t[(2 * tp + 3) * 65 + cc];
            *(unsigned*)(p.hyT + ((size_t)b * 1536 + col) * RB + tl0 + 2 * tp) = pk_bf16(a, c2); }
    }
}
__device__ __forceinline__ void ph_hy_untranspose_fast(const P& p, float* t) {
    const bf16_t* yhT = p.Zh + (size_t)2 * NB * 4 * NCH * 16384;
    const int ntt = RB / 64, ntc = 512 / 64;
    for (int tile = blockIdx.x; tile < NB * ntt * ntc; tile += gridDim.x) {
        const int tid = TIDX; const int ct = tile % ntc, tt = (tile / ntc) % ntt, b = tile / (ntc * ntt); const int c0 = ct * 64, tl0 = tt * 64;
        __syncthreads();
#pragma unroll
        for (int i = 0; i < 8; ++i) { const int e = tid + 512 * i, cc = e >> 6, ti = e & 63; t[cc * 65 + ti] = bf2f(yhT[((size_t)b * 512 + c0 + cc) * RB + tl0 + ti]); }
        __syncthreads();
#pragma unroll
        for (int i = 0; i < 4; ++i) { const int e = tid + 512 * i, ti = e >> 5, cp = e & 31;
            *(unsigned*)(p.H + (size_t)bt_row(b, tl0 + ti) * D + 512 + c0 + 2 * cp) = pk_bf16(t[(2 * cp) * 65 + ti], t[(2 * cp + 1) * 65 + ti]); }
    }
}
__device__ __forceinline__ void ph_prep_rope_fast(const P& p) {
    GSTRIDE(idx, (long)R * 2 * 4 * 8) {
        const int pc = idx % 8, h = (idx / 8) % 4, w = (idx / 32) % 2, r = idx / 64;
        bf16_t* base = p.Zr + (size_t)r * 2048 + w * 512 + h * 128 + pc * 8;
        float a[8], c[8]; unpack8(*(const u4v*)base, a); unpack8(*(const u4v*)(base + 64), c);
        const float sc = w ? KSCALE : 1.f;
        if (r < RL) {
            const int t = r % L; const float pos = (pc < 4) ? (float)(t / GW) : (float)(t % GW);
#pragma unroll
            for (int q = 0; q < 8; ++q) { const int pr = pc * 8 + q; const float inv = exp2f(-(float)(pr & 31) * (13.287712379549449f / 32.f));
                float sn, cs; sincosf(pos * inv, &sn, &cs); const float x1 = a[q] * sc, x2 = c[q] * sc; a[q] = x1 * cs - x2 * sn; c[q] = x1 * sn + x2 * cs; }
        } else {
#pragma unroll
            for (int q = 0; q < 8; ++q) { a[q] *= sc; c[q] *= sc; }
        }
        *(u4v*)base = pack8(a); *(u4v*)(base + 64) = pack8(c);
    }
}
__device__ __forceinline__ void ph_mod_fast(const P& p, int l, int which, const float* xl  , const float* xc  ) {
    const int lane = TIDX & 63, gw = blockIdx.x * (NT / 64) + (TIDX >> 6), ngw = gridDim.x * (NT / 64);
    for (int r = gw; r < R; r += ngw) {
        const float* x = r < RL ? xl + (size_t)r * D : xc + (size_t)(r - RL) * D; const float* sh = modv(p, l, r, which * 3 + 0); const float* sc = modv(p, l, r, which * 3 + 1);
#pragma unroll
        for (int i = 0; i < 4; ++i) { const int k = 4 * lane + 256 * i; const f32x4 xv = *(const f32x4*)(x + k), s = *(const f32x4*)(sc + k), hh = *(const f32x4*)(sh + k);
            u2v o; o.x = pk_bf16(xv[0] * (1.f + s[0]) + hh[0], xv[1] * (1.f + s[1]) + hh[1]); o.y = pk_bf16(xv[2] * (1.f + s[2]) + hh[2], xv[3] * (1.f + s[3]) + hh[3]);
            *(u2v*)(p.H + (size_t)r * D + k) = o; }
    }
}

__device__ __forceinline__ void ph_rope_table(const P& p) {
    GSTRIDE(idx, 128 * 32) { const int f = idx & 31, pos = idx >> 5; float sn, cs; sincosf((float)pos * exp2f(-(float)f * (13.287712379549449f / 32.f)), &sn, &cs); p.A2[2 * idx] = cs; p.A2[2 * idx + 1] = sn; }
}
__device__ __forceinline__ void ph_filters(const P& p, unsigned char* smem) {
    float* lds = (float*)smem;
    float* aA = lds;
    float* aB = lds + 64 * 65;
    LAS bf16_t* A3 = (LAS bf16_t*)(smem + 2 * 64 * 65 * 4);
    LAS bf16_t* Ws = A3 + 64 * 72;
    const float mind = logf(1e-2f) / 1.5f, maxd = logf(1e-2f) / 0.3f;
    for (int u = blockIdx.x; u < RB / 64; u += gridDim.x) {
        const int tid = TIDX; const int p0 = u * 64; const int pos = tid & 63, jg = tid >> 6, lane = tid & 63, w = tid >> 6;
        __syncthreads();
        for (int e = tid; e < 64 * 33; e += NT) { const int ps = e & 63, m = e >> 6; int ln2, i2; hy_pos(p0 + ps, ln2, i2);
            const float w2 = 2.0f * 3.14159265358979323846f * (float)i2 / (float)ln2; float v;
            if (m == 0) v = (float)i2 / (float)(ln2 - 1); else { const int q = (m - 1) & 15; const float f = 1e-4f + (float)q * ((15.f - 1e-4f) / 15.f); v = m <= 16 ? cosf(f * w2) : -sinf(f * w2); }
            aB[ps * 65 + m] = v; }
        __syncthreads();
        {
            float acc[8];
#pragma unroll
            for (int q = 0; q < 8; ++q) acc[q] = p.in[14][jg * 8 + q];
#pragma unroll 3
            for (int m = 0; m < 33; ++m) { const float a = aB[pos * 65 + m];
#pragma unroll
                for (int q = 0; q < 8; ++q) acc[q] += a * p.in[13][m * 64 + jg * 8 + q]; }
#pragma unroll
            for (int q = 0; q < 8; ++q) aA[pos * 65 + jg * 8 + q] = sinf(p.in[20][jg * 8 + q] * acc[q]);
        }
        __syncthreads();
#pragma unroll 1
        for (int layer = 0; layer < 2; ++layer) {
            const float* W = layer ? p.in[17] : p.in[15]; const float* Bv = layer ? p.in[18] : p.in[16]; const float* Fq = p.in[20] + 64 * (layer + 1);
            float* src = layer ? aB : aA; float* dst = layer ? aA : aB;
            float acc[8];
#pragma unroll
            for (int q = 0; q < 8; ++q) acc[q] = Bv[jg * 8 + q];
#pragma unroll 4
            for (int m = 0; m < 64; ++m) { const float a = src[pos * 65 + m];
#pragma unroll
                for (int q = 0; q < 8; ++q) acc[q] += a * W[m * 64 + jg * 8 + q]; }
#pragma unroll
            for (int q = 0; q < 8; ++q) { const float v = sinf(Fq[jg * 8 + q] * acc[q]); dst[pos * 65 + jg * 8 + q] = v; if (layer == 1) A3[pos * 72 + jg * 8 + q] = f2bf(v); }
            __syncthreads();
        }
        float tpos[4];
#pragma unroll
        for (int mt = 0; mt < 4; ++mt) { int len, i0; hy_pos(p0 + 16 * mt + (lane & 15), len, i0); tpos[mt] = (float)i0 / (float)(len - 1); }
#pragma unroll 1
        for (int cq = 0; cq < 4; ++cq) {
            for (int e = tid; e < 64 * 128; e += NT) { const int k = e >> 7, c4 = e & 127; const f32x4 wv = *(const f32x4*)(p.in[19] + (size_t)k * 2048 + cq * 512 + 4 * c4);
                u2v o; o.x = pk_bf16(wv[0], wv[1]); o.y = pk_bf16(wv[2], wv[3]); *(LAS u2v*)(Ws + k * 520 + 4 * c4) = o; }
            __syncthreads();
            f32x4 acc[4][4];
#pragma unroll
            for (int mt = 0; mt < 4; ++mt)
#pragma unroll
                for (int nt = 0; nt < 4; ++nt) acc[mt][nt] = (f32x4){0.f, 0.f, 0.f, 0.f};
#pragma unroll
            for (int ks = 0; ks < 2; ++ks) { bf16x8 xm[4];
#pragma unroll
                for (int mt = 0; mt < 4; ++mt) xm[mt] = frag_row(A3, 72, 16 * mt, 32 * ks, lane);
#pragma unroll
                for (int nt = 0; nt < 4; ++nt) { const bf16x8 xn = frag_tr(Ws, 520, 32 * ks, 64 * w + 16 * nt, lane);
#pragma unroll
                    for (int mt = 0; mt < 4; ++mt) acc[mt][nt] = MFMA16(xn, xm[mt], acc[mt][nt]); } }
#pragma unroll
            for (int nt = 0; nt < 4; ++nt)
#pragma unroll
                for (int q = 0; q < 4; ++q) { const int col = cq * 512 + 64 * w + 16 * nt + 4 * (lane >> 4) + q; const float delta = fabsf(mind + (float)(col % 512) * ((maxd - mind) / 511.f));
#pragma unroll
                    for (int mt = 0; mt < 4; ++mt) p.FILT[(size_t)col * RB + p0 + 16 * mt + (lane & 15)] = acc[mt][nt][q] * __expf(-tpos[mt] * delta); }
            __syncthreads();
        }
    }
}

__device__ __forceinline__ float wave_sum(float v) {
#pragma unroll
    for (int o = 1; o < 64; o <<= 1) v += __shfl_xor(v, o);
    return v;
}
__device__ __forceinline__ void ph_ada_fast(const P& p, float* lds) {
    float* sv = lds;
    float* red = lds + 3072;
    const int tid = TIDX;
    __syncthreads();
    for (int i = tid; i < 3 * D; i += NT) { const int j = i / D, k = i % D; sv[i] = siluf(j < 2 ? p.in[1][j * D + k] : p.in[3][k]); }
    __syncthreads();
    for (int u = blockIdx.x; u < 2 * 96; u += gridDim.x) {
        const int l = u / 96, n = (u % 96) * 64 + (tid & 63), ks = tid >> 6;
        const float* w = p.in[4] + (size_t)l * D * 6144 + n;
        float a0 = 0.f, a1 = 0.f, a2 = 0.f;
#pragma unroll 8
        for (int k = ks * 128; k < ks * 128 + 128; ++k) { const float wv = w[(size_t)k * 6144]; a0 += sv[k] * wv; a1 += sv[D + k] * wv; a2 += sv[2 * D + k] * wv; }
        red[(ks * 3 + 0) * 64 + (tid & 63)] = a0; red[(ks * 3 + 1) * 64 + (tid & 63)] = a1; red[(ks * 3 + 2) * 64 + (tid & 63)] = a2;
        __syncthreads();
        if (tid < 192) { const int j = tid >> 6, nl = tid & 63; float s = p.in[5][l * 6144 + (u % 96) * 64 + nl];
#pragma unroll
            for (int q = 0; q < 8; ++q) s += red[(q * 3 + j) * 64 + nl];
            p.MOD[(size_t)(l * 3 + j) * 6144 + (u % 96) * 64 + nl] = s; }
        __syncthreads();
    }
}
__device__ __forceinline__ void ph_hyF_fast(const P& p, const float* a3, float* lds) {
    float* at = lds;
    float* wt = lds + 64 * 65;
    const float mind = logf(1e-2f) / 1.5f, maxd = logf(1e-2f) / 0.3f;
    for (int u = blockIdx.x; u < (RB / 64) * 16; u += gridDim.x) {
        const int tid = TIDX; const int ct = u % 16, pt = u / 16, p0 = pt * 64, c0 = ct * 128;
        __syncthreads();
#pragma unroll
        for (int i = 0; i < 8; ++i) { const int e = tid + 512 * i; at[(e >> 6) * 65 + (e & 63)] = a3[(size_t)(p0 + (e >> 6)) * 64 + (e & 63)]; }
#pragma unroll
        for (int i = 0; i < 16; ++i) { const int e = tid + 512 * i; wt[e] = p.in[19][(size_t)(e >> 7) * 2048 + c0 + (e & 127)]; }
        __syncthreads();
        const int pos = tid & 63, cg = tid >> 6;
        float acc[16];
#pragma unroll
        for (int q = 0; q < 16; ++q) acc[q] = 0.f;
#pragma unroll 4
        for (int m = 0; m < 64; ++m) { const float a = at[pos * 65 + m];
#pragma unroll
            for (int q = 0; q < 16; ++q) acc[q] += a * wt[m * 128 + cg * 16 + q]; }
        int len, i0; hy_pos(p0 + pos, len, i0); const float tt = (float)i0 / (float)(len - 1);
#pragma unroll
        for (int q = 0; q < 16; ++q) { const int col = c0 + cg * 16 + q; const float delta = fabsf(mind + (float)(col % 512) * ((maxd - mind) / 511.f));
            p.FILT[(size_t)col * RB + p0 + pos] = acc[q] * expf(-tt * delta); }
    }
}
__device__ __forceinline__ void ph_retScan_fast(const P& p) {
    bf16_t* ST = p.Zh;
    GSTRIDE(idx, (long)2 * NB * 4 * 16384) {
        const int ed = idx % 16384, h = (idx / 16384) % 4, b = (idx / 65536) % NB, dir = idx / (65536 * NB);
        const float dc = expf((dir ? p.in[10] : p.in[9])[h] * 128.f);
        bf16_t* base = ST + st_idx(dir, b, h, 0) + ed;
        float s = 0.f;
#pragma unroll 1
        for (int c0 = 0; c0 < NCH; c0 += 11) {
            float u[11]; int cc[11];
#pragma unroll
            for (int j = 0; j < 11; ++j) { const int q = c0 + j; cc[j] = dir == 0 ? q : (q < 2 ? 1 - q : NCH + 1 - q); u[j] = bf2f(base[(size_t)cc[j] * 16384]); }
#pragma unroll
            for (int j = 0; j < 11; ++j) { base[(size_t)cc[j] * 16384] = f2bf(s); s = dc * s + u[j]; }
        }
    }
}
__device__ __forceinline__ void ph_glaScan_fast(const P& p) {
    const float* BF = p.BG; const float* BB = p.BG + (size_t)R * 512;
    GSTRIDE(idx, (long)2 * NB * 4 * 32768) {
        const int d = idx % 128, ed = idx % 32768, h = (idx / 32768) % 4, b = (idx / 131072) % NB, dir = idx / (131072 * NB);
        bf16_t* base = p.GST + gst_idx(dir, b, h, 0) + ed;
        float s = 0.f;
#pragma unroll 1
        for (int c0 = 0; c0 < NCH; c0 += 11) {
            float u[11], dcv[11]; int cc[11];
#pragma unroll
            for (int j = 0; j < 11; ++j) { const int q = c0 + j; cc[j] = dir == 0 ? q : (q < 2 ? 1 - q : NCH + 1 - q); const int r0 = chunk_row0(b, cc[j]);
                u[j] = bf2f(base[(size_t)cc[j] * 32768]); dcv[j] = dir == 0 ? BF[(size_t)(r0 + 127) * 512 + h * 128 + d] : BB[(size_t)r0 * 512 + h * 128 + d]; }
#pragma unroll
            for (int j = 0; j < 11; ++j) { base[(size_t)cc[j] * 32768] = f2bf(s); s = __expf(dcv[j]) * s + u[j]; }
        }
    }
}
__device__ __forceinline__ void ph_glagates_fast(const P& p, float* lds) {
    float* lr = lds;
    for (int u = blockIdx.x; u < NB * NCH * 2; u += gridDim.x) {
        const int tid = TIDX; const int dir = u % 2, c = (u / 2) % NCH, b = u / (2 * NCH); const int r0 = chunk_row0(b, c);
        __syncthreads();
        for (int e = tid; e < 128 * 16; e += NT) lr[e] = bf2f(p.Z1[(size_t)(r0 + (e >> 4)) * GINP + 3072 + dir * 16 + (e & 15)]);
        __syncthreads();
        const float* gw = (dir ? p.in[26] : p.in[24]); float g[16];
#pragma unroll
        for (int q = 0; q < 16; ++q) g[q] = gw[q * 512 + tid];
        const float gb = (dir ? p.in[27] : p.in[25])[tid];
        float* out = p.BG + ((size_t)dir * R + r0) * 512 + tid;
        float s = 0.f;
#pragma unroll 4
        for (int ii = 0; ii < 128; ++ii) { const int i = dir ? 127 - ii : ii; float acc = gb;
#pragma unroll
            for (int q = 0; q < 16; ++q) acc += lr[i * 16 + q] * g[q];
            s += logsigf(acc) * (1.f / 16.f); out[(size_t)i * 512] = s; }
    }
}
template <int MODE, bool ROUTE> __device__ __forceinline__ void ph_post_fast(const P& p, int l, int which, const bf16_t* Y, int ln, int wn, int nrows, const float* xl, const float* xc, float* lds) {
    const float* lg = p.in[6] + (size_t)(l * 2 + which) * D; const float* lb = p.in[7] + (size_t)(l * 2 + which) * D;
    const int tid = TIDX, lane = tid & 63, gw = blockIdx.x * (NT / 64) + (tid >> 6), ngw = gridDim.x * (NT / 64);
    int* lcnt = (int*)(lds + D * NE);
    if (ROUTE) { __syncthreads(); for (int e = tid; e < D * NE; e += NT) lds[(e & 15) * D + (e >> 4)] = p.in[29][e]; if (tid < 32) lcnt[tid] = 0; __syncthreads(); }
    int toff[16];
    if (MODE == 1) { int s = 0;
#pragma unroll
        for (int e = 0; e < 16; ++e) { toff[e] = s; s += (p.CNT[l * 16 + e] + 255) >> 8; } }
    for (int r = gw; r < nrows; r += ngw) {
        const float* x = r < RL ? xl + (size_t)r * D : xc + (size_t)(r - RL) * D; float* xo = xrow(p, r);
        const float* gate = modv(p, l, r, which * 3 + 2);
        const bf16_t *y0, *y1 = nullptr;
        if (MODE == 0) y0 = Y + (size_t)r * D;
        else { int sr[2];
#pragma unroll
            for (int k = 0; k < 2; ++k) { const int e = p.RE[r * 2 + k]; int to = 0;
#pragma unroll
                for (int q = 0; q < 16; ++q) to = (q == e) ? toff[q] : to;
                sr[k] = to * 256 + p.RPOS[r * 2 + k]; }
            y0 = p.slots + (size_t)sr[0] * D; y1 = p.slots + (size_t)sr[1] * D; }
        f32x4 v[4]; float s = 0.f;
#pragma unroll
        for (int i = 0; i < 4; ++i) { const int k = 4 * lane + 256 * i; const f32x4 xv = *(const f32x4*)(x + k), gv = *(const f32x4*)(gate + k);
            const u2v yu = *(const u2v*)(y0 + k); f32x4 yy = {__uint_as_float(yu.x << 16), __uint_as_float(yu.x & 0xffff0000u), __uint_as_float(yu.y << 16), __uint_as_float(yu.y & 0xffff0000u)};
            if (MODE == 1) { const u2v y2 = *(const u2v*)(y1 + k); yy += (f32x4){__uint_as_float(y2.x << 16), __uint_as_float(y2.x & 0xffff0000u), __uint_as_float(y2.y << 16), __uint_as_float(y2.y & 0xffff0000u)}; }
            v[i] = xv * ALPHA + gv * yy; s += (v[i][0] + v[i][1]) + (v[i][2] + v[i][3]); }
        const float mu = wave_sum(s) * (1.f / D); float q2 = 0.f;
#pragma unroll
        for (int i = 0; i < 4; ++i) { v[i] = v[i] - mu; q2 += (v[i][0] * v[i][0] + v[i][1] * v[i][1]) + (v[i][2] * v[i][2] + v[i][3] * v[i][3]); }
        const float rs = 1.f / sqrtf(wave_sum(q2) * (1.f / D) + LN_EPS);
        f32x4 hk[4];
#pragma unroll
        for (int i = 0; i < 4; ++i) { const int k = 4 * lane + 256 * i; const f32x4 xn = v[i] * rs * *(const f32x4*)(lg + k) + *(const f32x4*)(lb + k);
            *(f32x4*)(xo + k) = xn;
            if (ln >= 0) { const f32x4 h2 = xn * (*(const f32x4*)(modv(p, ln, r, wn * 3 + 1) + k) + 1.f) + *(const f32x4*)(modv(p, ln, r, wn * 3 + 0) + k);
                u2v o; o.x = pk_bf16(h2[0], h2[1]); o.y = pk_bf16(h2[2], h2[3]); *(u2v*)(p.H + (size_t)r * D + k) = o;
                if (ROUTE) hk[i] = h2; } }
        if (ROUTE) {
            int best = 0, i1 = 0, i2 = 0; float bs = -1e30f, a1 = 0.f, a2 = 0.f;
#pragma unroll 1
            for (int g = 0; g < NG; ++g) {
                float sg[4], sel[4];
#pragma unroll
                for (int q = 0; q < 4; ++q) { const float* wr = lds + (g * EPG + q) * D + 4 * lane; float a = 0.f;
#pragma unroll
                    for (int i = 0; i < 4; ++i) { const f32x4 wv = *(const f32x4*)(wr + 256 * i); a += (hk[i][0] * wv[0] + hk[i][1] * wv[1]) + (hk[i][2] * wv[2] + hk[i][3] * wv[3]); }
                    sg[q] = sigmf(wave_sum(a)); sel[q] = sg[q] + p.in[30][g * EPG + q]; }
                int j1 = 0; float v1 = sel[0];
#pragma unroll
                for (int q = 1; q < 4; ++q) if (sel[q] > v1) { v1 = sel[q]; j1 = q; }
                int j2 = -1; float v2 = -1e30f;
#pragma unroll
                for (int q = 0; q < 4; ++q) if (q != j1 && sel[q] > v2) { v2 = sel[q]; j2 = q; }
                if (v1 + v2 > bs) { bs = v1 + v2; best = g; i1 = j1; i2 = j2; a1 = 0.f; a2 = 0.f;
#pragma unroll
                    for (int q = 0; q < 4; ++q) { a1 = (q == j1) ? sg[q] : a1; a2 = (q == j2) ? sg[q] : a2; } }
            }
            if (lane == 0) { const int e1 = best * EPG + i1, e2 = best * EPG + i2;
                p.RE[r * 2] = e1; p.RE[r * 2 + 1] = e2; p.RWt[r * 2] = a1 / (a1 + a2); p.RWt[r * 2 + 1] = a2 / (a1 + a2);
                p.RPOS[r * 2] = atomicAdd(&lcnt[e1], 1); p.RPOS[r * 2 + 1] = atomicAdd(&lcnt[e2], 1); }
        }
    }
    if (ROUTE) {
        __syncthreads();
        if (tid < 16) lcnt[16 + tid] = atomicAdd(&p.CNT[l * 16 + tid], lcnt[tid]);
        __syncthreads();
        for (int r = gw + lane * ngw; r < nrows; r += 64 * ngw) {
#pragma unroll
            for (int k = 0; k < 2; ++k) p.RPOS[r * 2 + k] += lcnt[16 + p.RE[r * 2 + k]];
        }
    }
}

constexpr int N_STEPS = 34;
#define PG8_ALIGN true
#define PG8_SP2 true
template <class Epi> __device__ __forceinline__ void dense_gemm(LAS unsigned char* lds, const bf16_t* A, const bf16_t* Bt, int M, int N, int K, const Epi& E) {
    pg8::Gemm g{A, Bt, M, N, K}; pg8::StaticOrder S; S.init(M, N, (int)gridDim.x, (int)blockIdx.x);
    pg8::gemm_phase<Epi, pg8::StaticOrder, PG8_ALIGN, PG8_SP2>(lds, g, S, E);
}
__device__ __forceinline__ void moe_gemms(const P& p, LAS unsigned char* lds, int l, int which) {
    pg8::MoeOrder S; S.init(p.CNT + l * 16, (int)gridDim.x, (int)blockIdx.x);
    if (which == 0) { pg8::Gemm g{p.Hs, p.Wgu, 0, 0, 1024}; pg8::EpiSwiGLU E{p.he}; pg8::gemm_phase<pg8::EpiSwiGLU, pg8::MoeOrder, PG8_ALIGN, PG8_SP2>(lds, g, S, E); }
    else { pg8::Gemm g{p.he, p.Wd, 0, 0, 512}; pg8::EpiRowScale E{p.slots, p.WS}; pg8::gemm_phase<pg8::EpiRowScale, pg8::MoeOrder, PG8_ALIGN, PG8_SP2>(lds, g, S, E); }
}
__device__ __forceinline__ void run_step(const P& p, int step, unsigned char* smem) {
    LAS unsigned char* lds = (LAS unsigned char*)smem; float* fl = (float*)smem;
    float* conv = (float*)p.H;
    switch (step) {
        case 0: ph_ada_fast(p, fl); ph_rope_table(p); ph_wconv_fast(p, fl); ph_wconv_moe_fast(p, 0, fl); break;
        case 1: ph_mod_fast(p, 0, 0, p.in[0], p.in[2]); ph_filters(p, smem); break;
        case 2: { pg8::EpiInL0 E{p.Zr, p.hyT, p.A2, RL, L, CTX, RB}; dense_gemm(lds, p.H, p.Win0, R, ABIN, D, E); } break;
        case 3: break;
        case 4: ph_retU_mfma(p, smem); ph_hyena_fft(p, smem); break;
        case 5: ph_retScan_fast(p); break;
        case 6: break;
        case 7: break;
        case 8: break;
        case 9: ph_retO_mfma(p, smem); ph_hy_untranspose_fast(p, fl); break;
        case 10: ph_hy_untranspose_fast(p, fl); break;
        case 11: { pg8::EpiSplit E{p.Zr, 1024, p.Zr, 1024, 1 << 30}; dense_gemm(lds, p.H, p.Wout0, R, D, D, E); } break;
        case 12: ph_post_fast<0, true>(p, 0, 0, p.Zr, 0, 1, R, p.in[0], p.in[2], fl); break;
        case 13: break;
        case 14: break;
        case 15: ph_permute(p, 0, R); break;
        case 16: moe_gemms(p, lds, 0, 0); break;
        case 17: moe_gemms(p, lds, 0, 1); break;
        case 18: ph_post_fast<1, false>(p, 0, 1, nullptr, 1, 0, R, p.out, p.Xc, fl); break;
        case 19: { pg8::EpiSplit E{p.Z1, GINP, p.Z1, GINP, 1 << 30}; dense_gemm(lds, p.H, p.Win1, R, GINP, D, E); } ph_wconv_moe_fast(p, 1, fl); break;
        case 20: break;
        case 21: break;
        case 22: ph_glaU_mfma(p, smem); break;
        case 23: ph_glaScan_fast(p); break;
        case 24: ph_glaO_mfma(p, smem); break;
        case 25: break;
        case 26: { pg8::EpiSplit E{p.Zr, 1024, p.Zr, 1024, 1 << 30}; dense_gemm(lds, p.H, p.Wout1, RL, D, D, E); } break;
        case 27: ph_post_fast<0, true>(p, 1, 0, p.Zr, 1, 1, RL, p.out, p.Xc, fl); break;
        case 28: break;
        case 29: break;
        case 30: ph_permute(p, 1, RL); break;
        case 31: moe_gemms(p, lds, 1, 0); break;
        case 32: moe_gemms(p, lds, 1, 1); break;
        case 33: ph_post_fast<1, false>(p, 1, 1, nullptr, -1, 0, RL, p.out, p.Xc, fl); break;
    }
}
__global__ void __launch_bounds__(NT, 2) k_all(P p) {
    extern __shared__ __attribute__((aligned(16))) unsigned char smem[];
    cg::grid_group grid = cg::this_grid();
    volatile LAS unsigned* bst = (volatile LAS unsigned*)((LAS unsigned char*)smem + LDS_BYTES - 64);
    if (threadIdx.x < 2) bst[threadIdx.x] = 0u;
    __syncthreads();
    const XcdBarrier bar = xcd_barrier_post(p.BAR, bst);
#define STEP(n) run_step(p, n, smem); xcd_barrier(bar);
#define STEP_CG(n) run_step(p, n, smem); asm volatile("s_waitcnt vmcnt(0)" ::: "memory"); grid.sync();
    STEP_CG(0) STEP(1) STEP(2) STEP(4) STEP(5) STEP(9) STEP(11) STEP(12) STEP(15) STEP(16)
    STEP(17) STEP(18) STEP(19) STEP(22) STEP(23) STEP(24) STEP(26) STEP(27) STEP(30) STEP(31) STEP(32) run_step(p, 33, smem);
#undef STEP
#undef STEP_CG
}

extern "C" void kernel_launch(void* const* d_in, const int* in_sizes, int n_in, void* d_out, int out_size, void* d_ws, size_t ws_size, hipStream_t stream) {
    P p{};
    for (int i = 0; i < 34; ++i) p.in[i] = (const float*)d_in[i];
    p.out = (float*)d_out;
    unsigned char* w = (unsigned char*)d_ws; size_t off = 0;
    auto take = [&](size_t bytes) { unsigned char* r = w + off; off += (bytes + 255) & ~(size_t)255; return r; };
    p.NORM = (float*)take(2 * 2048 * 4); p.CNT = (int*)take(2 * 16 * 4); p.BAR = (unsigned*)take(XCD_BAR_WORDS * 4);
    const size_t ctl_bytes = off;
    p.Win1 = (bf16_t*)take((size_t)GINP * D * 2); p.Wout1 = (bf16_t*)take((size_t)D * D * 2);
    p.Wgu = (bf16_t*)take((size_t)NE * 1024 * 1024 * 2); p.Wd = (bf16_t*)take((size_t)NE * 1024 * 512 * 2);
    p.Xc = (float*)take((size_t)RCX * D * 4); p.MOD = (float*)take(2 * 3 * 6144 * 4);
    p.RS = (float*)take((size_t)R * NE * 4); p.RE = (int*)take((size_t)R * 2 * 4); p.RPOS = (int*)take((size_t)R * 2 * 4); p.RWt = (float*)take((size_t)R * 2 * 4);
    p.WS = (float*)take((size_t)MOE_ROWS * 4);
    const size_t big = off;
    p.H = (bf16_t*)take((size_t)R * D * 2);
    p.Zr = (bf16_t*)take((size_t)R * 2048 * 2);
    p.Zh = (bf16_t*)take((size_t)R * 1536 * 2);
    p.hyT = (bf16_t*)take((size_t)NB * 3 * 512 * RB * 2);
    p.FILT = (float*)take((size_t)2048 * RB * 4);
    p.Win0 = (bf16_t*)take((size_t)ABIN * D * 2); p.Wout0 = (bf16_t*)take((size_t)D * D * 2);
    p.A1 = (float*)take((size_t)RB * 64 * 4); p.A2 = (float*)take((size_t)RB * 64 * 4);
    const size_t total = off;
    off = big + (((size_t)R * D * 2 + 255) & ~(size_t)255);
    p.Hs = (bf16_t*)take((size_t)MOE_ROWS * D * 2); p.he = (bf16_t*)take((size_t)MOE_ROWS * EH * 2); p.slots = (bf16_t*)take((size_t)MOE_ROWS * D * 2);
    const size_t moe_end = off;
    off = big + (((size_t)R * D * 2 + 255) & ~(size_t)255);
    p.Z1 = (bf16_t*)take((size_t)R * GINP * 2); p.BG = (float*)take((size_t)2 * R * 512 * 4); p.GST = (bf16_t*)take((size_t)2 * NB * 4 * NCH * 32768 * 2);
    const size_t l1_end = off;
    if (total > ws_size || moe_end > total || l1_end > total || n_in != 34 || out_size != RL * D) {
        fprintf(stderr, "kernel_launch: bad sizes (need %zu ws bytes, have %zu; moe_end %zu l1_end %zu)\n", total, ws_size, moe_end, l1_end); return; }
    static int grid = 0;
    if (!grid) {
        int dev = 0, cus = 0, per = 0; hipGetDevice(&dev); hipDeviceGetAttribute(&cus, hipDeviceAttributeMultiprocessorCount, dev);
        hipFuncSetAttribute((const void*)k_all, hipFuncAttributeMaxDynamicSharedMemorySize, LDS_BYTES);
        hipOccupancyMaxActiveBlocksPerMultiprocessor(&per, k_all, NT, LDS_BYTES);
        if (per < 1) { fprintf(stderr, "kernel_launch: occupancy query says %d blocks per CU\n", per); per = 1; }
        grid = cus;
    }
    hipMemsetAsync(d_ws, 0, ctl_bytes, stream);
    void* args[] = {&p};
    hipError_t e = hipLaunchCooperativeKernel((void*)k_all, dim3(grid), dim3(NT), args, LDS_BYTES, stream);
    if (e != hipSuccess) fprintf(stderr, "coop launch failed: %s (grid %d)\n", hipGetErrorString(e), grid);
}
```

```cpp
#include <hip/hip_runtime.h>
#include <hip/hip_cooperative_groups.h>
#include <cstdio>
#include <cstdint>
namespace cg = cooperative_groups;


namespace pg8 {
#define PG8_LAS __attribute__((address_space(3)))
typedef unsigned short bf16_t;
typedef short bf16x8 __attribute__((ext_vector_type(8)));
typedef float f32x4 __attribute__((ext_vector_type(4)));
typedef unsigned u32x4 __attribute__((ext_vector_type(4)));
constexpr int BM = 256, BK = 64, HALF = 128, HTB = HALF * BK * 2  , STAGE_BYTES = 8 * HTB, NXCD = 8, WGM = 8;

__host__ __device__ __forceinline__ int lds_byte(int r, int c) { const int st = (r >> 4) * 2 + (c >> 5), rr = r & 15, cc = c & 31, ob = rr * 64 + cc * 2; return st * 1024 + (ob ^ (((ob >> 9) & 1) << 5)); }
__host__ __device__ __forceinline__ void stage_rc(int b, int& R, int& C) { const int st = b / 1024, sb = b % 1024, swz = sb ^ (((sb >> 9) & 1) << 5); R = (st >> 1) * 16 + swz / 64; C = (st & 1) * 32 + (swz % 64) / 2; }
__host__ __device__ __forceinline__ int perm32(int rho) { const int n = rho >> 4, i = rho & 15; return 8 * (i >> 2) + 4 * n + (i & 3); }

struct Unit { int pm, pn; };
struct Gemm { const bf16_t* A; const bf16_t* Bt; int M, N, K; };

struct StaticOrder {
    int nM, nN, nwg, G, c;
    __host__ __device__ void init(int M, int N, int G_, int c_) { nM = M / BM; nN = N / BM; nwg = nM * nN; G = G_; c = c_; }
    __host__ __device__ bool next(int i, Unit& u) const {
        const long L = (long)i * G + c; if (L >= nwg) return false;
        int wgid = (int)L; { const int q = nwg / NXCD, r = nwg % NXCD, xcd = wgid % NXCD, off = wgid / NXCD; wgid = (xcd < r ? xcd * (q + 1) : r * (q + 1) + (xcd - r) * q) + off; }
        const int nig = WGM * nN, gid = wgid / nig, fm = gid * WGM, gsz = (nM - fm) < WGM ? (nM - fm) : WGM;
        u.pm = fm + ((wgid % nig) % gsz); u.pn = (wgid % nig) / gsz; return true;
    }
    __device__ __forceinline__ void a_ready(const Unit&) const {}
    __device__ __forceinline__ void done(const Unit&) const {}
};


__device__ __forceinline__ unsigned cvt_pk_bf16(float lo, float hi) { unsigned r; asm volatile("v_cvt_pk_bf16_f32 %0, %1, %2" : "=v"(r) : "v"(lo), "v"(hi)); return r; }

template <class Epi, class Sched, bool ALIGN_EPI = false, bool SP2 = false>
__device__ __forceinline__ void gemm_phase(PG8_LAS unsigned char* lds, const Gemm g, const Sched& S, const Epi& E) {
    int tid_l = threadIdx.x; asm volatile("" : "+v"(tid_l)); const int tid = tid_l, wid = __builtin_amdgcn_readfirstlane(tid >> 6), lane = tid & 63, wr = wid >> 2, wc = wid & 3, fr = lane & 15, fq = lane >> 4;
    const int K = g.K, nt = K / BK;
    unsigned voffA[2], voffB[2];
#pragma unroll
    for (int i = 0; i < 2; ++i) { int R, C; stage_rc(tid * 16 + i * 8192, R, C); const int Rb = Epi::PERM ? ((R & ~31) + perm32(R & 31)) : R;
        voffA[i] = (unsigned)(R * K + C) * 2u; voffB[i] = (unsigned)(Rb * K + C) * 2u; }
    const size_t kstep = (size_t)(BK * 2);
    const size_t hstep = (size_t)HALF * K * 2;
    const size_t tstep = 2 * hstep;
    const unsigned ldsw = (unsigned)wid * 1024u;
    const int aoff = lds_byte(wr * 64 + fr, fq * 8), boff = lds_byte(wc * 32 + fr, fq * 8);
#define PG8_SA(b, h) (((b) * 2 + (h)) * HTB)
#define PG8_SB(b, h) ((4 + (b) * 2 + (h)) * HTB)
#define PG8_STAGE(bufoff, gbase, voff) do { _Pragma("unroll") for (int _i = 0; _i < 2; ++_i) \
        __builtin_amdgcn_global_load_lds((const unsigned*)((const char*)(gbase) + (voff)[_i]), (PG8_LAS unsigned*)(lds + (bufoff) + ldsw + _i * 8192), 16, 0, 0); } while (0)
#define PG8_LDA(dst, b, h) do { _Pragma("unroll") for (int m = 0; m < 4; ++m) _Pragma("unroll") for (int k = 0; k < 2; ++k) dst[m][k] = *(const PG8_LAS bf16x8*)(lds + PG8_SA(b, h) + aoff + m * 2048 + k * 1024); } while (0)
#define PG8_LDB(dst, b, h) do { _Pragma("unroll") for (int n = 0; n < 2; ++n) _Pragma("unroll") for (int k = 0; k < 2; ++k) dst[n][k] = *(const PG8_LAS bf16x8*)(lds + PG8_SB(b, h) + boff + n * 2048 + k * 1024); } while (0)
#define PG8_MMA(ai, bj, At, Bt) do { __builtin_amdgcn_s_setprio(1); _Pragma("unroll") for (int m = 0; m < 4; ++m) _Pragma("unroll") for (int n = 0; n < 2; ++n) _Pragma("unroll") for (int k = 0; k < 2; ++k) \
        acc[ai][bj][m][n] = __builtin_amdgcn_mfma_f32_16x16x32_bf16(Bt[n][k], At[m][k], acc[ai][bj][m][n], 0, 0, 0); __builtin_amdgcn_s_setprio(0); } while (0)
#define PG8_WAIT_V(n) asm volatile("s_waitcnt vmcnt(" #n ")" ::: "memory")
#define PG8_WAIT_L(n) asm volatile("s_waitcnt lgkmcnt(" #n ")" ::: "memory")
#define PG8_BAR __builtin_amdgcn_s_barrier()
#define PG8_SCHED __builtin_amdgcn_sched_barrier(0)
    Unit cur, nxt; int ui = 0;
    if (!S.next(0, cur)) return;
    f32x4 acc[2][2][4][2];
#pragma unroll
    for (int a = 0; a < 2; ++a)
#pragma unroll
        for (int b = 0; b < 2; ++b)
#pragma unroll
            for (int m = 0; m < 4; ++m)
#pragma unroll
                for (int n = 0; n < 2; ++n) acc[a][b][m][n] = (f32x4){0.f, 0.f, 0.f, 0.f};
    bf16x8 At[4][2], B0[2][2], B1[2][2];
    const char* cA = (const char*)g.A + (size_t)cur.pm * tstep; const char* cB = (const char*)g.Bt + (size_t)cur.pn * tstep;
    S.a_ready(cur);
    if constexpr (SP2) {
        PG8_STAGE(PG8_SB(0, 0), cB, voffB); PG8_STAGE(PG8_SB(0, 1), cB + hstep, voffB); PG8_STAGE(PG8_SA(0, 0), cA, voffA); PG8_STAGE(PG8_SA(0, 1), cA + hstep, voffA);
        if (wr == 1) PG8_BAR;
        PG8_WAIT_V(2); PG8_BAR;
        PG8_STAGE(PG8_SB(1, 0), cB + kstep, voffB); PG8_STAGE(PG8_SA(1, 0), cA + kstep, voffA); PG8_STAGE(PG8_SB(1, 1), cB + hstep + kstep, voffB);
        PG8_WAIT_V(6); PG8_BAR;
    } else {
        PG8_STAGE(PG8_SB(0, 0), cB, voffB); PG8_STAGE(PG8_SA(0, 0), cA, voffA); PG8_STAGE(PG8_SB(0, 1), cB + hstep, voffB); PG8_STAGE(PG8_SA(0, 1), cA + hstep, voffA);
        if (wr == 1) PG8_BAR;
        PG8_WAIT_V(4); PG8_BAR;
        PG8_STAGE(PG8_SB(1, 0), cB + kstep, voffB); PG8_STAGE(PG8_SA(1, 0), cA + kstep, voffA); PG8_STAGE(PG8_SB(1, 1), cB + hstep + kstep, voffB);
        PG8_WAIT_V(6); PG8_BAR;
    }
    for (;;) {
        const bool has_next = S.next(ui + 1, nxt);
        const char* nA = has_next ? (const char*)g.A + (size_t)nxt.pm * tstep : cA; const char* nB = has_next ? (const char*)g.Bt + (size_t)nxt.pn * tstep : cB;
        for (int t = 0; t < nt; t += 2) {
            const bool last = (t == nt - 2);
            const char* a1 = cA + (size_t)(t + 1) * kstep;
            const char* a2 = last ? nA : cA + (size_t)(t + 2) * kstep; const char* b2 = last ? nB : cB + (size_t)(t + 2) * kstep;
            const char* a3 = a2 + kstep; const char* b3 = b2 + kstep;
            if (last && has_next) S.a_ready(nxt);
            if constexpr (SP2) {
            PG8_LDB(B0, 0, 0); PG8_LDB(B1, 0, 1); PG8_SCHED; PG8_LDA(At, 0, 0); PG8_STAGE(PG8_SA(1, 1), a1 + hstep, voffA);
            PG8_WAIT_V(8); PG8_WAIT_L(0); PG8_BAR; PG8_MMA(0, 0, At, B0); PG8_MMA(0, 1, At, B1); PG8_BAR; PG8_SCHED;
            PG8_LDA(At, 0, 1); PG8_STAGE(PG8_SB(0, 0), b2, voffB); PG8_STAGE(PG8_SB(0, 1), b2 + hstep, voffB); PG8_STAGE(PG8_SA(0, 0), a2, voffA);
            PG8_WAIT_V(8); PG8_WAIT_L(0); PG8_BAR; PG8_MMA(1, 0, At, B0); PG8_MMA(1, 1, At, B1); PG8_BAR; PG8_SCHED;
            PG8_LDB(B0, 1, 0); PG8_LDB(B1, 1, 1); PG8_SCHED; PG8_LDA(At, 1, 0); PG8_STAGE(PG8_SA(0, 1), a2 + hstep, voffA);
            PG8_WAIT_V(8); PG8_WAIT_L(0); PG8_BAR; PG8_MMA(0, 0, At, B0); PG8_MMA(0, 1, At, B1); PG8_BAR; PG8_SCHED;
            PG8_LDA(At, 1, 1); PG8_STAGE(PG8_SB(1, 0), b3, voffB); PG8_STAGE(PG8_SB(1, 1), b3 + hstep, voffB); PG8_STAGE(PG8_SA(1, 0), a3, voffA);
            PG8_WAIT_V(8); PG8_WAIT_L(0); PG8_BAR; PG8_MMA(1, 0, At, B0); PG8_MMA(1, 1, At, B1); PG8_BAR; PG8_SCHED;
            } else {
            PG8_LDB(B0, 0, 0); PG8_SCHED; PG8_LDA(At, 0, 0); PG8_STAGE(PG8_SA(1, 1), a1 + hstep, voffA);
            PG8_WAIT_L(8); PG8_BAR; PG8_WAIT_L(0); PG8_MMA(0, 0, At, B0); PG8_BAR; PG8_SCHED;
            PG8_LDB(B1, 0, 1); PG8_STAGE(PG8_SB(0, 0), b2, voffB);
            PG8_BAR; PG8_WAIT_L(0); PG8_MMA(0, 1, At, B1); PG8_BAR;
            PG8_LDA(At, 0, 1); PG8_STAGE(PG8_SA(0, 0), a2, voffA);
            PG8_BAR; PG8_WAIT_L(0); PG8_MMA(1, 0, At, B0); PG8_BAR; PG8_SCHED;
            PG8_STAGE(PG8_SB(0, 1), b2 + hstep, voffB);
            PG8_WAIT_V(6); PG8_BAR; PG8_MMA(1, 1, At, B1); PG8_BAR;
            PG8_LDB(B0, 1, 0); PG8_SCHED; PG8_LDA(At, 1, 0); PG8_STAGE(PG8_SA(0, 1), a2 + hstep, voffA);
            PG8_WAIT_L(8); PG8_BAR; PG8_WAIT_L(0); PG8_MMA(0, 0, At, B0); PG8_BAR; PG8_SCHED;
            PG8_LDB(B1, 1, 1); PG8_STAGE(PG8_SB(1, 0), b3, voffB);
            PG8_BAR; PG8_WAIT_L(0); PG8_MMA(0, 1, At, B1); PG8_BAR;
            PG8_LDA(At, 1, 1); PG8_STAGE(PG8_SA(1, 0), a3, voffA);
            PG8_BAR; PG8_WAIT_L(0); PG8_MMA(1, 0, At, B0); PG8_BAR; PG8_SCHED;
            PG8_STAGE(PG8_SB(1, 1), b3 + hstep, voffB);
            PG8_WAIT_V(6); PG8_BAR; PG8_MMA(1, 1, At, B1); PG8_BAR;
            }
        }
        if constexpr (ALIGN_EPI) { if (wr == 0) PG8_BAR; }
        if constexpr (!Epi::AFTER_DRAIN) { E(acc, cur, wr, wc, fr, fq); S.done(cur); }
        if (!has_next) break;
#pragma unroll
        for (int a = 0; a < 2; ++a)
#pragma unroll
            for (int b = 0; b < 2; ++b)
#pragma unroll
                for (int m = 0; m < 4; ++m)
#pragma unroll
                    for (int n = 0; n < 2; ++n) acc[a][b][m][n] = (f32x4){0.f, 0.f, 0.f, 0.f};
        cur = nxt; cA = nA; cB = nB; ++ui;
        if constexpr (ALIGN_EPI) { if (wr == 1) PG8_BAR; }
    }
    PG8_WAIT_V(0);
    if constexpr (!ALIGN_EPI) { if (wr == 0) PG8_BAR; }
    PG8_BAR;
    if constexpr (Epi::AFTER_DRAIN) { E.fused(acc, cur, wr, wc, fr, fq, lds, wid, lane); S.done(cur); }
#undef PG8_SA
#undef PG8_SB
#undef PG8_STAGE
#undef PG8_LDA
#undef PG8_LDB
#undef PG8_MMA
#undef PG8_WAIT_V
#undef PG8_WAIT_L
#undef PG8_BAR
#undef PG8_SCHED
}
}

typedef float f2v_t __attribute__((ext_vector_type(2)));
typedef __bf16 b2v_t __attribute__((ext_vector_type(2)));
__device__ __forceinline__ unsigned pk_bf16(float lo, float hi) { const f2v_t f = {lo, hi}; const b2v_t b = __builtin_convertvector(f, b2v_t); return __builtin_bit_cast(unsigned, b); }
namespace pg8 {
typedef unsigned u32x2 __attribute__((ext_vector_type(2)));
struct EpiSplit {
    static constexpr bool PERM = true, AFTER_DRAIN = false;
    bf16_t* O0; int ld0; bf16_t* O1; int ld1; int split_col;
    __device__ __forceinline__ void operator()(const f32x4 (&acc)[2][2][4][2], const Unit& u, int wr, int wc, int fr, int fq) const {
        const int row0 = u.pm * BM + wr * 64 + fr; int colt = u.pn * BM; bf16_t* base = O0; int ldc = ld0;
        if (colt >= split_col) { base = O1; ldc = ld1; colt -= split_col; }
        const int col0 = colt + wc * 32 + 8 * fq;
#pragma unroll
        for (int ai = 0; ai < 2; ++ai)
#pragma unroll
            for (int m = 0; m < 4; ++m) { bf16_t* rowp = base + (size_t)(row0 + ai * HALF + m * 16) * ldc + col0;
#pragma unroll
                for (int bj = 0; bj < 2; ++bj) { const f32x4 v0 = acc[ai][bj][m][0], v1 = acc[ai][bj][m][1];
                    u32x4 w; w.x = ::pk_bf16(v0[0], v0[1]); w.y = ::pk_bf16(v0[2], v0[3]); w.z = ::pk_bf16(v1[0], v1[1]); w.w = ::pk_bf16(v1[2], v1[3]);
                    *(u32x4*)(rowp + bj * HALF) = w; } }
    }
};
struct EpiInL0 {
    static constexpr bool PERM = true, AFTER_DRAIN = false;
    bf16_t* Zr; bf16_t* hyT; const float* tab; int RLv, Lv, CTXv, RBv;
    __device__ __forceinline__ void operator()(const f32x4 (&acc)[2][2][4][2], const Unit& u, int wr, int wc, int fr, int fq) const {
        const int rowbase = u.pm * BM, colt = u.pn * BM;
        if (colt < 2048) {
            const int col0 = colt + wc * 32 + 8 * fq; const bool rot = colt < 1024; const int pp0 = wc * 16 + 4 * fq;
#pragma unroll
            for (int ai = 0; ai < 2; ++ai)
#pragma unroll
                for (int m = 0; m < 4; ++m) { const int row = rowbase + wr * 64 + fr + ai * HALF + m * 16; bf16_t* rowp = Zr + (size_t)row * 2048 + col0;
                    const int t = row % Lv; const int prow = t >> 6, pcol = t & 63; const bool dorot = rot && row < RLv;
#pragma unroll
                    for (int bj = 0; bj < 2; ++bj) { f32x4 v0 = acc[ai][bj][m][0], v1 = acc[ai][bj][m][1];
                        if (dorot) {
#pragma unroll
                            for (int pr = 0; pr < 4; ++pr) { const int pp = pp0 + pr; const int pos = pp < 32 ? prow : pcol; const float cs = tab[(pos * 32 + (pp & 31)) * 2], sn = tab[(pos * 32 + (pp & 31)) * 2 + 1];
                                if (pr < 2) { const float x1 = v0[2 * pr], x2 = v0[2 * pr + 1]; v0[2 * pr] = x1 * cs - x2 * sn; v0[2 * pr + 1] = x1 * sn + x2 * cs; }
                                else { const float x1 = v1[2 * pr - 4], x2 = v1[2 * pr - 3]; v1[2 * pr - 4] = x1 * cs - x2 * sn; v1[2 * pr - 3] = x1 * sn + x2 * cs; } } }
                        u32x4 w; w.x = ::pk_bf16(v0[0], v0[1]); w.y = ::pk_bf16(v0[2], v0[3]); w.z = ::pk_bf16(v1[0], v1[1]); w.w = ::pk_bf16(v1[2], v1[3]);
                        *(u32x4*)(rowp + bj * HALF) = w; } }
        } else {
            const int hc0 = colt - 2048 + wc * 32 + 8 * fq;
            int b, tlb; if (rowbase < RLv) { b = rowbase / Lv; tlb = rowbase % Lv; } else { b = (rowbase - RLv) / CTXv; tlb = Lv + (rowbase - RLv) % CTXv; }
#pragma unroll
            for (int ai = 0; ai < 2; ++ai)
#pragma unroll
                for (int m = 0; m < 4; ++m) { const int tl = tlb + wr * 64 + fr + ai * HALF + m * 16;
#pragma unroll
                    for (int bj = 0; bj < 2; ++bj) { const f32x4 v0 = acc[ai][bj][m][0], v1 = acc[ai][bj][m][1];
                        bf16_t* o = hyT + ((size_t)b * 1536 + hc0 + bj * HALF) * RBv + tl;
#pragma unroll
                        for (int q = 0; q < 4; ++q) { o[(size_t)q * RBv] = (bf16_t)(::pk_bf16(v0[q], 0.f) & 0xffffu); o[(size_t)(q + 4) * RBv] = (bf16_t)(::pk_bf16(v1[q], 0.f) & 0xffffu); } } }
        }
    }
};
struct EpiSwiGLU {
    static constexpr bool PERM = true, AFTER_DRAIN = false;
    bf16_t* O;
    __device__ __forceinline__ void operator()(const f32x4 (&acc)[2][2][4][2], const Unit& u, int wr, int wc, int fr, int fq) const {
        const int row0 = u.pm * BM + wr * 64 + fr; const int j0 = (u.pn & 3) * 128 + wc * 16 + 4 * fq;
#pragma unroll
        for (int ai = 0; ai < 2; ++ai)
#pragma unroll
            for (int m = 0; m < 4; ++m) { bf16_t* rowp = O + (size_t)(row0 + ai * HALF + m * 16) * 512 + j0;
#pragma unroll
                for (int bj = 0; bj < 2; ++bj) { const f32x4 g = acc[ai][bj][m][0], up = acc[ai][bj][m][1]; float h[4];
#pragma unroll
                    for (int q = 0; q < 4; ++q) h[q] = g[q] / (1.f + __expf(-g[q])) * up[q];
                    u32x2 w; w.x = ::pk_bf16(h[0], h[1]); w.y = ::pk_bf16(h[2], h[3]);
                    *(u32x2*)(rowp + bj * 64) = w; } }
    }
};
struct EpiRowScale {
    static constexpr bool PERM = true, AFTER_DRAIN = false;
    bf16_t* O; const float* ws;
    __device__ __forceinline__ void operator()(const f32x4 (&acc)[2][2][4][2], const Unit& u, int wr, int wc, int fr, int fq) const {
        const int row0 = u.pm * BM + wr * 64 + fr; const int col0 = (u.pn & 3) * BM + wc * 32 + 8 * fq;
#pragma unroll
        for (int ai = 0; ai < 2; ++ai)
#pragma unroll
            for (int m = 0; m < 4; ++m) { const int row = row0 + ai * HALF + m * 16; const float s = ws[row]; bf16_t* rowp = O + (size_t)row * 1024 + col0;
#pragma unroll
                for (int bj = 0; bj < 2; ++bj) { const f32x4 v0 = acc[ai][bj][m][0] * s, v1 = acc[ai][bj][m][1] * s;
                    u32x4 w; w.x = ::pk_bf16(v0[0], v0[1]); w.y = ::pk_bf16(v0[2], v0[3]); w.z = ::pk_bf16(v1[0], v1[1]); w.w = ::pk_bf16(v1[2], v1[3]);
                    *(u32x4*)(rowp + bj * HALF) = w; } }
    }
};
struct MoeOrder {
    int G, c, nt; int toff[16];
    __device__ __forceinline__ void init(const int* cnt, int G_, int c_) { G = G_; c = c_; int s = 0;
#pragma unroll
        for (int e = 0; e < 16; ++e) { toff[e] = s; s += (cnt[e] + 255) >> 8; } nt = s; }
    __device__ __forceinline__ bool next(int i, Unit& u) const {
        const int Lq = i * G + c; if (Lq >= nt * 4) return false;
        const int pm = Lq % nt, pn4 = Lq / nt; int e = 0;
#pragma unroll
        for (int q = 1; q < 16; ++q) e += (pm >= toff[q]) ? 1 : 0;
        u.pm = pm; u.pn = e * 4 + pn4; return true; }
    __device__ __forceinline__ void a_ready(const Unit&) const {}
    __device__ __forceinline__ void done(const Unit&) const {}
};
}

constexpr int NB = 2, L = 8192, D = 1024, CTX = 256, RB = L + CTX;
constexpr int RL = NB * L, RCX = NB * CTX, R = RL + RCX;
constexpr int GW = 64;
constexpr int NCH = 66;
constexpr int ABIN = 3584, GIN = 3104, GINP = 3328;
constexpr int NE = 16, NG = 4, EPG = 4, EH = 512;
constexpr int MOE_ROWS = 37888;
constexpr float ALPHA = 1.4142135623730951f, LN_EPS = 1e-5f, KSCALE = 0.08838834764831845f;
constexpr int NT = 512;
constexpr int LDS_BYTES = 147456;

typedef unsigned short bf16_t;
#define LAS __attribute__((address_space(3)))
__device__ __forceinline__ float bf2f(bf16_t v) { return __uint_as_float((unsigned)v << 16); }
__device__ __forceinline__ bf16_t f2bf(float f) { unsigned u = __float_as_uint(f); return (bf16_t)((u + 0x7fffu + ((u >> 16) & 1u)) >> 16); }
__device__ __forceinline__ float siluf(float x) { return x / (1.f + expf(-x)); }
__device__ __forceinline__ float sigmf(float x) { return 1.f / (1.f + expf(-x)); }
__device__ __forceinline__ float logsigf(float x) { return fminf(x, 0.f) - log1pf(expf(-fabsf(x))); }

struct P {
    const float* in[34];
    float* out;
    float* Xc;
    float* MOD;
    float* NORM;
    int* CNT;
    unsigned* BAR;
    float* A1; float* A2;
    float* RS; int* RE; int* RPOS; float* RWt; float* WS;
    bf16_t *Win0, *Wout0, *Win1, *Wout1, *Wgu, *Wd;
    bf16_t* H;
    bf16_t* Zr;
    bf16_t* Zh;
    bf16_t* hyT;
    float* FILT;
    bf16_t *Hs, *he, *slots;
    bf16_t* Z1;
    float* BG;
    bf16_t* GST;
};

__device__ __forceinline__ int launder_i(int x) { asm volatile("" : "+v"(x)); return x; }
#define TIDX launder_i((int)threadIdx.x)
#define GSTRIDE(i, n) for (long i = (long)blockIdx.x * blockDim.x + TIDX; i < (long)(n); i += (long)gridDim.x * blockDim.x)

__device__ __forceinline__ float* xrow(const P& p, int r) { return r < RL ? p.out + (size_t)r * D : p.Xc + (size_t)(r - RL) * D; }
__device__ __forceinline__ int seg_of(int r) { return r < RL ? r / L : 2; }
__device__ __forceinline__ const float* modv(const P& p, int l, int r, int chunk) { return p.MOD + ((size_t)(l * 3 + seg_of(r)) * 6 + chunk) * D; }
__device__ __forceinline__ int chunk_row0(int b, int c) { return c < 2 ? RL + b * CTX + c * 128 : b * L + (c - 2) * 128; }
__device__ __forceinline__ void row_bt(int r, int& b, int& tl) { if (r < RL) { b = r / L; tl = r % L; } else { b = (r - RL) / CTX; tl = L + (r - RL) % CTX; } }
__device__ __forceinline__ int bt_row(int b, int tl) { return tl < L ? b * L + tl : RL + b * CTX + (tl - L); }

#define XB_TMO      128
#define XB_XCNT(j)  (256  + 64 * (j))
#define XB_XSUB(j)  (1280 + 64 * (j))
#define XB_XGEN(j)  (2304 + 64 * (j))
#define XB_TOP      3328
#define XB_TOPGEN   3392
#define XCD_BAR_WORDS 3456
#define XB_SPIN_CAP (1u << 18)

__device__ __forceinline__ unsigned xb_ld(unsigned* p)              { return __hip_atomic_load(p, __ATOMIC_RELAXED, __HIP_MEMORY_SCOPE_AGENT); }
__device__ __forceinline__ unsigned xb_add(unsigned* p, unsigned v) { return __hip_atomic_fetch_add(p, v, __ATOMIC_RELAXED, __HIP_MEMORY_SCOPE_AGENT); }
__device__ __forceinline__ unsigned xb_xcc_id() { return (unsigned)__builtin_amdgcn_s_getreg((3 << 11) | 20) & 0xFu; }
#define XB_SPIN(cond, bar) do { unsigned _sp = 0; while (cond) { __builtin_amdgcn_s_sleep(1); \
    if ((++_sp & 255u) == 0u) { if (xb_ld(&(bar)[XB_TMO])) break; if (_sp > XB_SPIN_CAP) { atomicAdd(&(bar)[XB_TMO], 1u); break; } } } } while (0)

struct XcdBarrier {
    unsigned* bar; unsigned x;
    volatile LAS unsigned* st;
};

__device__ __forceinline__ XcdBarrier xcd_barrier_post(unsigned* bar, volatile LAS unsigned* st) {
    XcdBarrier b; b.bar = bar; b.x = xb_xcc_id(); b.st = st;
    if (threadIdx.x == 0) (void)xb_add(&bar[XB_XCNT(b.x)], 1u);
    return b;
}
__device__ __forceinline__ void xcd_barrier_complete(unsigned* bar, unsigned x, unsigned& nloc, unsigned& nx) {
    const unsigned G = gridDim.x * gridDim.y * gridDim.z;
    unsigned sum, cnt, mine, sp = 0u;
    for (;;) {
        sum = 0u; cnt = 0u; mine = 0u;
#pragma unroll
        for (unsigned j = 0; j < 16; ++j) { const unsigned c = xb_ld(&bar[XB_XCNT(j)]); sum += c; cnt += (c > 0u) ? 1u : 0u; mine = (j == x) ? c : mine; }
        if (sum == G) break;
        __builtin_amdgcn_s_sleep(1);
        if ((++sp & 255u) == 0u) { if (xb_ld(&bar[XB_TMO])) break; if (sp > XB_SPIN_CAP) { atomicAdd(&bar[XB_TMO], 1u); break; } }
    }
    nloc = mine > 0u ? mine : 1u; nx = cnt > 0u ? cnt : 1u;
}

__device__ __forceinline__ void xcd_barrier(const XcdBarrier& b) {
    asm volatile("s_waitcnt vmcnt(0)" ::: "memory");
    __syncthreads();
    if (threadIdx.x == 0) {
        unsigned* bar = b.bar;
        __builtin_amdgcn_s_waitcnt(0);
        unsigned nloc = b.st[0], nx = b.st[1];
        if (nloc == 0u) { xcd_barrier_complete(bar, b.x, nloc, nx); b.st[0] = nloc; b.st[1] = nx; }
        const unsigned old = xb_add(&bar[XB_XSUB(b.x)], 1u);
        const unsigned gen = old / nloc;
        if (old + 1u == (gen + 1u) * nloc) {
            __builtin_amdgcn_fence(__ATOMIC_RELEASE, "agent");
            asm volatile("s_waitcnt vmcnt(0)" ::: "memory");
            const unsigned og = xb_add(&bar[XB_TOP], 1u);
            const unsigned tg = og / nx;
            if (og + 1u == (tg + 1u) * nx) xb_add(&bar[XB_TOPGEN], 1u);
            else XB_SPIN(xb_ld(&bar[XB_TOPGEN]) == tg, bar);
            __builtin_amdgcn_fence(__ATOMIC_ACQUIRE, "agent");
            xb_add(&bar[XB_XGEN(b.x)], 1u);
            asm volatile("s_waitcnt vmcnt(0)" ::: "memory");
        } else {
            XB_SPIN(xb_ld(&bar[XB_XGEN(b.x)]) == gen, bar);
            __builtin_amdgcn_fence(__ATOMIC_ACQUIRE, "agent");
            asm volatile("s_waitcnt vmcnt(0)" ::: "memory");
        }
    }
    __syncthreads();
}

__device__ __forceinline__ void ph_wconv(bf16_t* dst, const float* src, int N, int K, int ldsrc, int nvalid) {
    GSTRIDE(idx, (long)N * K) { const int k = idx % K, n = idx / K; dst[idx] = n < nvalid ? f2bf(src[(size_t)k * ldsrc + n]) : (bf16_t)0; }
}
__device__ __forceinline__ void ph_wconv_moe(const P& p, int l) {
    GSTRIDE(idx, (long)NE * 1024 * 1024) {
        const int k = idx % 1024, n = (idx / 1024) % 1024, e = idx / (1024 * 1024);
        const int q = n >> 3, r = n & 7, j = 4 * q + (r & 3);
        const float* src = (r < 4 ? p.in[31] : p.in[32]) + ((size_t)(l * NE + e) * D + k) * EH + j;
        p.Wgu[idx] = f2bf(*src);
    }
    GSTRIDE(idx, (long)NE * 1024 * 512) {
        const int k = idx % 512, n = (idx / 512) % 1024, e = idx / (512 * 1024);
        p.Wd[idx] = f2bf(p.in[33][((size_t)(l * NE + e) * EH + k) * D + n]);
    }
}
__device__ __forceinline__ void ph_ada(const P& p) {
    GSTRIDE(idx, 2 * 3 * 6144) {
        const int n = idx % 6144, j = (idx / 6144) % 3, l = idx / (3 * 6144);
        const float* cv = j < 2 ? p.in[1] + j * D : p.in[3];
        const float* w = p.in[4] + (size_t)l * D * 6144;
        float acc = p.in[5][l * 6144 + n];
        for (int k = 0; k < D; ++k) acc += siluf(cv[k]) * w[(size_t)k * 6144 + n];
        p.MOD[idx] = acc;
    }
}
__device__ __forceinline__ void ph_init(const P& p) {
    GSTRIDE(i, (long)RL * D) p.out[i] = p.in[0][i];
    GSTRIDE(i, (long)RCX * D) p.Xc[i] = p.in[2][i];
}
__device__ __forceinline__ void hy_pos(int pidx, int& len, int& i) { if (pidx < L) { len = L; i = pidx; } else { len = CTX; i = pidx - L; } }
__device__ __forceinline__ void ph_hyA1(const P& p) {
    GSTRIDE(idx, (long)RB * 64) {
        const int j = idx % 64, pidx = idx / 64; int len, i; hy_pos(pidx, len, i);
        const float t = (float)i / (float)(len - 1);
        const float w = 2.0f * 3.14159265358979323846f * (float)i / (float)len;
        const float* w1 = p.in[13];
        float acc = p.in[14][j] + t * w1[j];
        for (int m = 0; m < 16; ++m) {
            const float f = 1e-4f + (float)m * ((15.f - 1e-4f) / 15.f);
            acc += cosf(f * w) * w1[(1 + m) * 64 + j] - sinf(f * w) * w1[(17 + m) * 64 + j];
        }
        p.A1[idx] = sinf(p.in[20][j] * acc);
    }
}
__device__ __forceinline__ void ph_hyA(const float* src, float* dst, const float* w, const float* bias, const float* freq) {
    GSTRIDE(idx, (long)RB * 64) {
        const int j = idx % 64, pidx = idx / 64;
        float acc = bias[j];
        for (int i = 0; i < 64; ++i) acc += src[(size_t)pidx * 64 + i] * w[i * 64 + j];
        dst[idx] = sinf(freq[j] * acc);
    }
}
__device__ __forceinline__ void ph_hyF(const P& p, const float* a3) {
    const float mind = logf(1e-2f) / 1.5f, maxd = logf(1e-2f) / 0.3f;
    GSTRIDE(idx, (long)2048 * RB) {
        const int pidx = idx % RB, col = idx / RB, ch = col % 512; int len, i; hy_pos(pidx, len, i);
        const float t = (float)i / (float)(len - 1);
        float acc = 0.f;
        for (int m = 0; m < 64; ++m) acc += a3[(size_t)pidx * 64 + m] * p.in[19][m * 2048 + col];
        const float delta = fabsf(mind + (float)ch * ((maxd - mind) / 511.f));
        p.FILT[idx] = acc * expf(-t * delta);
    }
}
__device__ __forceinline__ float block_sum(float v, float* red);
__device__ __forceinline__ void ph_hyNorm(const P& p, float* red) {
    for (int u = blockIdx.x; u < 2 * 2048; u += gridDim.x) {
        const int col = u % 2048, which = u / 2048; const int p0 = which ? L : 0, n = which ? CTX : L;
        float s = 0.f;
        for (int i = TIDX; i < n; i += NT) { const float v = p.FILT[(size_t)col * RB + p0 + i]; s += v * v; }
        const float t = block_sum(s, red);
        if (TIDX == 0) p.NORM[which * 2048 + col] = t;
    }
}
__device__ __forceinline__ void ph_mod(const P& p, int l, int which) {
    GSTRIDE(i, (long)R * D) {
        const int r = i / D, k = i % D;
        p.H[i] = f2bf(xrow(p, r)[k] * (1.f + modv(p, l, r, which * 3 + 1)[k]) + modv(p, l, r, which * 3 + 0)[k]);
    }
}
__device__ __forceinline__ void ph_prep_rope(const P& p) {
    GSTRIDE(i, (long)R * 2 * 4 * 64) {
        const int pr = i % 64, h = (i / 64) % 4, w = (i / 256) % 2, r = i / 512;
        bf16_t* base = p.Zr + (size_t)r * 2048 + w * 512 + h * 128;
        float t1 = bf2f(base[pr]), t2 = bf2f(base[64 + pr]);
        if (w == 1) { t1 *= KSCALE; t2 *= KSCALE; }
        if (r < RL) {
            const int t = r % L, row = t / GW, col = t % GW;
            const float inv = powf(10000.f, -(float)(pr & 31) / 32.f);
            const float ang = (pr < 32 ? (float)row : (float)col) * inv;
            float sn, cs; sincosf(ang, &sn, &cs);
            const float a = t1 * cs - t2 * sn, bb = t1 * sn + t2 * cs; t1 = a; t2 = bb;
        }
        base[pr] = f2bf(t1); base[64 + pr] = f2bf(t2);
    }
}
__device__ __forceinline__ void ph_prep_hy(const P& p) {
    GSTRIDE(idx, (long)NB * 1536 * RB) {
        const int tl = idx % RB, col = (idx / RB) % 1536, b = idx / (RB * 1536);
        const int s0 = tl < L ? 0 : L, s1 = tl < L ? L : RB;
        const float* w = p.in[11];
        float acc = p.in[12][col] + w[1536 + col] * bf2f(p.Zh[(size_t)bt_row(b, tl) * 1536 + col]);
        if (tl - 1 >= s0) acc += w[col] * bf2f(p.Zh[(size_t)bt_row(b, tl - 1) * 1536 + col]);
        if (tl + 1 < s1) acc += w[2 * 1536 + col] * bf2f(p.Zh[(size_t)bt_row(b, tl + 1) * 1536 + col]);
        p.hyT[idx] = f2bf(acc);
    }
}
__device__ __forceinline__ float hy_tapT(const float* Ff, const float* Fb, float nf, float nb, int d) {
    if (d > 0) return Ff[d] * nf; if (d < 0) return Fb[-d] * nb; return Ff[0] * nf + Fb[0] * nb;
}
__device__ __forceinline__ void ph_hyconv_naive(const P& p, int n, float* conv) {
    GSTRIDE(idx, (long)NB * 512 * (RB / 4)) {
        const int tb = idx % (RB / 4), ch = (idx / (RB / 4)) % 512, b = idx / ((RB / 4) * 512);
        const int tl0 = tb * 4, s0 = tl0 < L ? 0 : L, len = tl0 < L ? L : CTX, nrm = tl0 < L ? 0 : 1, t0 = tl0 - s0;
        const int cf = (n * 2 + 0) * 512 + ch, cb = (n * 2 + 1) * 512 + ch;
        const float nf = 1.f / sqrtf(p.NORM[nrm * 2048 + cf]), nb = 1.f / sqrtf(p.NORM[nrm * 2048 + cb]);
        const float* Ff = p.FILT + (size_t)cf * RB + s0; const float* Fb = p.FILT + (size_t)cb * RB + s0;
        const bf16_t* z = p.hyT + ((size_t)(b * 3 + 2) * 512 + ch) * RB + s0;
        float w0 = hy_tapT(Ff, Fb, nf, nb, t0), w1 = hy_tapT(Ff, Fb, nf, nb, t0 + 1), w2 = hy_tapT(Ff, Fb, nf, nb, t0 + 2), w3 = hy_tapT(Ff, Fb, nf, nb, t0 + 3);
        float a0 = 0.f, a1 = 0.f, a2 = 0.f, a3 = 0.f;
        for (int s = 0; s < len; ++s) {
            const float zz = bf2f(z[s]);
            a0 += w0 * zz; a1 += w1 * zz; a2 += w2 * zz; a3 += w3 * zz;
            w3 = w2; w2 = w1; w1 = w0;
            if (s + 1 < len) w0 = hy_tapT(Ff, Fb, nf, nb, t0 - (s + 1));
        }
        float* o = conv + ((size_t)b * 512 + ch) * RB + tl0; o[0] = a0; o[1] = a1; o[2] = a2; o[3] = a3;
    }
}
__device__ __forceinline__ void ph_hygate_naive(const P& p, int n, const float* conv) {
    bf16_t* yhT = p.Zh + (size_t)2 * NB * 4 * NCH * 16384;
    GSTRIDE(idx, (long)NB * 512 * RB) {
        const int tl = idx % RB, ch = (idx / RB) % 512, b = idx / (RB * 512);
        bf16_t* z = p.hyT + ((size_t)(b * 3 + 2) * 512 + ch) * RB + tl; const float gate = bf2f(p.hyT[((size_t)(b * 3 + n) * 512 + ch) * RB + tl]);
        const float r = gate * (conv[idx] + p.in[21][n * 512 + ch] * bf2f(*z));
        if (n == 0) *z = f2bf(r); else yhT[idx] = f2bf(r);
    }
}
__device__ __forceinline__ void ph_hy_untranspose(const P& p) {
    const bf16_t* yhT = p.Zh + (size_t)2 * NB * 4 * NCH * 16384;
    GSTRIDE(idx, (long)R * 512) { const int ch = idx % 512, r = idx / 512; int b, tl; row_bt(r, b, tl); p.H[(size_t)r * D + 512 + ch] = yhT[((size_t)b * 512 + ch) * RB + tl]; }
}
__device__ __forceinline__ size_t st_idx(int dir, int b, int h, int c) { return ((((size_t)dir * NB + b) * 4 + h) * NCH + c) * 16384; }
__device__ __forceinline__ void ph_retU_naive(const P& p) {
    bf16_t* ST = p.Zh;
    GSTRIDE(idx, (long)NB * 4 * NCH * 16384) {
        const int d = idx % 128, e = (idx / 128) % 128, c = (idx / 16384) % NCH, h = (idx / (16384 * NCH)) % 4, b = idx / (16384 * NCH * 4);
        const float lgf = p.in[9][h], lgb = p.in[10][h]; const int r0 = chunk_row0(b, c);
        float uf = 0.f, ub = 0.f;
        for (int j = 0; j < 128; ++j) {
            const float kk = bf2f(p.Zr[(size_t)(r0 + j) * 2048 + 512 + h * 128 + d]), vv = bf2f(p.Zr[(size_t)(r0 + j) * 2048 + 1024 + h * 128 + e]);
            uf += kk * expf(lgf * (float)(127 - j)) * vv; ub += kk * expf(lgb * (float)j) * vv;
        }
        ST[st_idx(0, b, h, c) + e * 128 + d] = f2bf(uf); ST[st_idx(1, b, h, c) + e * 128 + d] = f2bf(ub);
    }
}
__device__ __forceinline__ void ph_retScan(const P& p) {
    bf16_t* ST = p.Zh;
    GSTRIDE(idx, (long)2 * NB * 4 * 16384) {
        const int ed = idx % 16384, h = (idx / 16384) % 4, b = (idx / 65536) % NB, dir = idx / (65536 * NB);
        const float dc = expf((dir ? p.in[10] : p.in[9])[h] * 128.f);
        float s = 0.f;
        for (int cc = 0; cc < NCH; ++cc) {
            const int c = dir == 0 ? cc : (cc < 2 ? 1 - cc : NCH + 1 - cc);
            bf16_t* q = ST + st_idx(dir, b, h, c) + ed; const float u = bf2f(*q); *q = f2bf(s); s = dc * s + u;
        }
    }
}
__device__ __forceinline__ void ph_retO_naive(const P& p, float* lds) {
    const bf16_t* ST = p.Zh;
    for (int u = blockIdx.x; u < NB * 4 * NCH; u += gridDim.x) {
        const int c = u % NCH, h = (u / NCH) % 4, b = u / (NCH * 4); const int r0 = chunk_row0(b, c);
        const float lgf = p.in[9][h], lgb = p.in[10][h];
        __syncthreads();
        for (int e = TIDX; e < 128 * 128; e += NT) {
            const int j = e % 128, i = e / 128;
            const bf16_t* q = p.Zr + (size_t)(r0 + i) * 2048 + h * 128; const bf16_t* k = p.Zr + (size_t)(r0 + j) * 2048 + 512 + h * 128;
            float s = 0.f; for (int d = 0; d < 128; ++d) s += bf2f(q[d]) * bf2f(k[d]);
            const float m = i > j ? expf(lgf * (float)(i - j)) : (j > i ? expf(lgb * (float)(j - i)) : 2.f);
            lds[e] = s * m;
        }
        __syncthreads();
        const bf16_t* sf = ST + st_idx(0, b, h, c); const bf16_t* sb = ST + st_idx(1, b, h, c);
        for (int e2 = TIDX; e2 < 128 * 128; e2 += NT) {
            const int e = e2 % 128, i = e2 / 128;
            float o = 0.f; for (int j = 0; j < 128; ++j) o += lds[i * 128 + j] * bf2f(p.Zr[(size_t)(r0 + j) * 2048 + 1024 + h * 128 + e]);
            const bf16_t* q = p.Zr + (size_t)(r0 + i) * 2048 + h * 128;
            float of = 0.f, ob = 0.f; for (int d = 0; d < 128; ++d) { const float qq = bf2f(q[d]); of += qq * bf2f(sf[e * 128 + d]); ob += qq * bf2f(sb[e * 128 + d]); }
            p.H[(size_t)(r0 + i) * D + h * 128 + e] = f2bf(o + expf(lgf * (float)(i + 1)) * of + expf(lgb * (float)(128 - i)) * ob);
        }
    }
}
__device__ __forceinline__ void ph_retNorm_naive(const P& p) {
    GSTRIDE(idx, (long)R * 4) {
        const int h = idx % 4, r = idx / 4; bf16_t* o = p.H + (size_t)r * D + h * 128;
        float mu = 0.f; for (int e = 0; e < 128; ++e) mu += bf2f(o[e]); mu *= (1.f / 128.f);
        float var = 0.f; for (int e = 0; e < 128; ++e) { const float d = bf2f(o[e]) - mu; var += d * d; } var *= (1.f / 128.f);
        const float rs = 1.f / sqrtf(var + LN_EPS);
        for (int e = 0; e < 128; ++e) o[e] = f2bf((bf2f(o[e]) - mu) * rs * siluf(bf2f(p.Zr[(size_t)r * 2048 + 1536 + h * 128 + e])));
    }
}
__device__ __forceinline__ float block_sum(float v, float* red) {
    __syncthreads();
#pragma unroll
    for (int o = 32; o > 0; o >>= 1) v += __shfl_xor(v, o);
    if ((TIDX & 63) == 0) red[TIDX >> 6] = v;
    __syncthreads();
    float t = 0.f;
#pragma unroll
    for (int w = 0; w < NT / 64; ++w) t += red[w];
    return t;
}
template <int MODE> __device__ __forceinline__ void ph_post(const P& p, int l, int which, const bf16_t* Y, int ln, int wn, int nrows, float* red) {
    const float* lg = p.in[6] + (size_t)(l * 2 + which) * D; const float* lb = p.in[7] + (size_t)(l * 2 + which) * D;
    int toff[16];
    if (MODE == 1) { int s = 0;
#pragma unroll
        for (int e = 0; e < 16; ++e) { toff[e] = s; s += (p.CNT[l * 16 + e] + 255) >> 8; } }
    for (int r = blockIdx.x; r < nrows; r += gridDim.x) {
        float* x = xrow(p, r); const float* gate = modv(p, l, r, which * 3 + 2);
        const bf16_t *y0, *y1 = nullptr;
        if (MODE == 0) y0 = Y + (size_t)r * D;
        else {
            int sr[2];
#pragma unroll
            for (int k = 0; k < 2; ++k) { const int e = p.RE[r * 2 + k]; int to = 0;
#pragma unroll
                for (int q = 0; q < 16; ++q) to = (q == e) ? toff[q] : to;
                sr[k] = to * 256 + p.RPOS[r * 2 + k]; }
            y0 = p.slots + (size_t)sr[0] * D; y1 = p.slots + (size_t)sr[1] * D;
        }
        float v[2]; float s = 0.f;
#pragma unroll
        for (int i = 0; i < 2; ++i) { const int k = TIDX + i * NT; float yy = bf2f(y0[k]); if (MODE == 1) yy += bf2f(y1[k]); v[i] = ALPHA * x[k] + gate[k] * yy; s += v[i]; }
        const float mu = block_sum(s, red) * (1.f / D);
        float q = 0.f;
#pragma unroll
        for (int i = 0; i < 2; ++i) { const float d = v[i] - mu; q += d * d; }
        const float rs = 1.f / sqrtf(block_sum(q, red) * (1.f / D) + LN_EPS);
#pragma unroll
        for (int i = 0; i < 2; ++i) { const int k = TIDX + i * NT; const float xn = (v[i] - mu) * rs * lg[k] + lb[k]; x[k] = xn;
            if (ln >= 0) p.H[(size_t)r * D + k] = f2bf(xn * (1.f + modv(p, ln, r, wn * 3 + 1)[k]) + modv(p, ln, r, wn * 3 + 0)[k]); }
    }
}
__device__ __forceinline__ void ph_route1(const P& p, int l, int nrows) {
    GSTRIDE(idx, (long)nrows * NE) {
        const int e = idx % NE, r = idx / NE; const float* x = xrow(p, r); const float* sc = modv(p, l, r, 4); const float* sh = modv(p, l, r, 3);
        float acc = 0.f;
        for (int k = 0; k < D; ++k) acc += (x[k] * (1.f + sc[k]) + sh[k]) * p.in[29][k * NE + e];
        p.RS[idx] = sigmf(acc);
    }
}
__device__ __forceinline__ void ph_route2(const P& p, int l, int nrows) {
    GSTRIDE(r, nrows) {
        const float* s = p.RS + (size_t)r * NE; const float* rb = p.in[30];
        int best = 0; float bs = -1e30f;
        for (int g = 0; g < NG; ++g) {
            float m1 = -1e30f, m2 = -1e30f;
            for (int q = 0; q < EPG; ++q) { const float v = s[g * EPG + q] + rb[g * EPG + q]; if (v > m1) { m2 = m1; m1 = v; } else if (v > m2) m2 = v; }
            if (m1 + m2 > bs) { bs = m1 + m2; best = g; }
        }
        int i1 = 0; float v1 = -1e30f;
        for (int q = 0; q < EPG; ++q) { const float v = s[best * EPG + q] + rb[best * EPG + q]; if (v > v1) { v1 = v; i1 = q; } }
        int i2 = 0; float v2 = -1e30f;
        for (int q = 0; q < EPG; ++q) { if (q == i1) continue; const float v = s[best * EPG + q] + rb[best * EPG + q]; if (v > v2) { v2 = v; i2 = q; } }
        const int e1 = best * EPG + i1, e2 = best * EPG + i2; const float a = s[e1], c = s[e2];
        p.RE[r * 2] = e1; p.RE[r * 2 + 1] = e2; p.RWt[r * 2] = a / (a + c); p.RWt[r * 2 + 1] = c / (a + c);
        p.RPOS[r * 2] = atomicAdd(&p.CNT[l * 16 + e1], 1); p.RPOS[r * 2 + 1] = atomicAdd(&p.CNT[l * 16 + e2], 1);
    }
}
__device__ __forceinline__ void ph_permute(const P& p, int l, int nrows) {
    int toff[16]; { int s = 0;
#pragma unroll
        for (int e = 0; e < 16; ++e) { toff[e] = s; s += (p.CNT[l * 16 + e] + 255) >> 8; } }
    GSTRIDE(idx, (long)nrows * 2 * 128) {
        const int ck = idx % 128, k = (idx / 128) % 2, r = idx / 256; const int e = p.RE[r * 2 + k]; int to = 0;
#pragma unroll
        for (int q = 0; q < 16; ++q) to = (q == e) ? toff[q] : to;
        const int sr = to * 256 + p.RPOS[r * 2 + k];
        ((uint4*)(p.Hs + (size_t)sr * D))[ck] = ((const uint4*)(p.H + (size_t)r * D))[ck];
        if (ck == 0) p.WS[sr] = p.RWt[r * 2 + k];
    }
}
__device__ __forceinline__ void ph_glagate(const P& p) {
    GSTRIDE(idx, (long)2 * R * 512) {
        const int ch = idx % 512, r = (idx / 512) % R, dir = idx / (512 * R);
        const float* gw = (dir ? p.in[26] : p.in[24]); const float* gb = (dir ? p.in[27] : p.in[25]);
        float acc = gb[ch];
        for (int q = 0; q < 16; ++q) acc += bf2f(p.Z1[(size_t)r * GINP + 3072 + dir * 16 + q]) * gw[q * 512 + ch];
        p.BG[idx] = logsigf(acc) * (1.f / 16.f);
    }
}
__device__ __forceinline__ void ph_glacum(const P& p) {
    GSTRIDE(idx, (long)2 * NB * NCH * 512) {
        const int ch = idx % 512, c = (idx / 512) % NCH, b = (idx / (512 * NCH)) % NB, dir = idx / (512 * NCH * NB);
        float* a = p.BG + ((size_t)dir * R + chunk_row0(b, c)) * 512 + ch;
        float s = 0.f;
        if (dir == 0) for (int i = 0; i < 128; ++i) { s += a[(size_t)i * 512]; a[(size_t)i * 512] = s; }
        else for (int i = 127; i >= 0; --i) { s += a[(size_t)i * 512]; a[(size_t)i * 512] = s; }
    }
}
__device__ __forceinline__ size_t gst_idx(int dir, int b, int h, int c) { return ((((size_t)dir * NB + b) * 4 + h) * NCH + c) * 32768; }
__device__ __forceinline__ void ph_glaU_naive(const P& p) {
    const float* BF = p.BG; const float* BB = p.BG + (size_t)R * 512;
    GSTRIDE(idx, (long)NB * 4 * NCH * 32768) {
        const int d = idx % 128, e = (idx / 128) % 256, c = (idx / 32768) % NCH, h = (idx / (32768 * NCH)) % 4, b = idx / (32768 * NCH * 4);
        const int r0 = chunk_row0(b, c);
        const float bfe = BF[(size_t)(r0 + 127) * 512 + h * 128 + d], bbe = BB[(size_t)r0 * 512 + h * 128 + d];
        float uf = 0.f, ub = 0.f;
        for (int j = 0; j < 128; ++j) {
            const float kk = bf2f(p.Z1[(size_t)(r0 + j) * GINP + 512 + h * 128 + d]), vv = bf2f(p.Z1[(size_t)(r0 + j) * GINP + 1024 + h * 256 + e]);
            uf += kk * expf(bfe - BF[(size_t)(r0 + j) * 512 + h * 128 + d]) * vv; ub += kk * expf(bbe - BB[(size_t)(r0 + j) * 512 + h * 128 + d]) * vv;
        }
        p.GST[gst_idx(0, b, h, c) + e * 128 + d] = f2bf(uf); p.GST[gst_idx(1, b, h, c) + e * 128 + d] = f2bf(ub);
    }
}
__device__ __forceinline__ void ph_glaScan(const P& p) {
    const float* BF = p.BG; const float* BB = p.BG + (size_t)R * 512;
    GSTRIDE(idx, (long)2 * NB * 4 * 32768) {
        const int d = idx % 128, ed = idx % 32768, h = (idx / 32768) % 4, b = (idx / 131072) % NB, dir = idx / (131072 * NB);
        float s = 0.f;
        for (int cc = 0; cc < NCH; ++cc) {
            const int c = dir == 0 ? cc : (cc < 2 ? 1 - cc : NCH + 1 - cc); const int r0 = chunk_row0(b, c);
            const float dc = dir == 0 ? expf(BF[(size_t)(r0 + 127) * 512 + h * 128 + d]) : expf(BB[(size_t)r0 * 512 + h * 128 + d]);
            bf16_t* q = p.GST + gst_idx(dir, b, h, c) + ed; const float u = bf2f(*q); *q = f2bf(s); s = dc * s + u;
        }
    }
}
__device__ __forceinline__ void ph_glaO_naive(const P& p, float* lds) {
    const float* BF = p.BG; const float* BB = p.BG + (size_t)R * 512;
    for (int u = blockIdx.x; u < NB * 4 * 64; u += gridDim.x) {
        const int c = 2 + u % 64, h = (u / 64) % 4, b = u / 256; const int r0 = chunk_row0(b, c);
        __syncthreads();
        for (int e = TIDX; e < 128 * 128; e += NT) {
            const int j = e % 128, i = e / 128;
            const bf16_t* q = p.Z1 + (size_t)(r0 + i) * GINP + h * 128; const bf16_t* k = p.Z1 + (size_t)(r0 + j) * GINP + 512 + h * 128;
            float s = 0.f;
            if (i >= j) { const float* bi = BF + (size_t)(r0 + i) * 512 + h * 128; const float* bj = BF + (size_t)(r0 + j) * 512 + h * 128;
                for (int d = 0; d < 128; ++d) s += bf2f(q[d]) * bf2f(k[d]) * expf(bi[d] - bj[d]); }
            if (i <= j) { const float* bi = BB + (size_t)(r0 + i) * 512 + h * 128; const float* bj = BB + (size_t)(r0 + j) * 512 + h * 128;
                for (int d = 0; d < 128; ++d) s += bf2f(q[d]) * bf2f(k[d]) * expf(bi[d] - bj[d]); }
            lds[e] = s * KSCALE;
        }
        __syncthreads();
        const bf16_t* sf = p.GST + gst_idx(0, b, h, c); const bf16_t* sb = p.GST + gst_idx(1, b, h, c);
        for (int e2 = TIDX; e2 < 128 * 256; e2 += NT) {
            const int e = e2 % 256, i = e2 / 256;
            float o = 0.f; for (int j = 0; j < 128; ++j) o += lds[i * 128 + j] * bf2f(p.Z1[(size_t)(r0 + j) * GINP + 1024 + h * 256 + e]);
            const bf16_t* q = p.Z1 + (size_t)(r0 + i) * GINP + h * 128; const float* bi = BF + (size_t)(r0 + i) * 512 + h * 128; const float* bbi = BB + (size_t)(r0 + i) * 512 + h * 128;
            float a = 0.f; for (int d = 0; d < 128; ++d) a += bf2f(q[d]) * (expf(bi[d]) * bf2f(sf[e * 128 + d]) + expf(bbi[d]) * bf2f(sb[e * 128 + d]));
            p.H[(size_t)(r0 + i) * D + h * 256 + e] = f2bf(o + a * KSCALE);
        }
    }
}
__device__ __forceinline__ void ph_glaNorm_naive(const P& p) {
    GSTRIDE(idx, (long)RL * 4) {
        const int h = idx % 4, r = idx / 4; bf16_t* o = p.H + (size_t)r * D + h * 256;
        float ss = 0.f; for (int e = 0; e < 256; ++e) { const float v = bf2f(o[e]); ss += v * v; }
        const float rs = 1.f / sqrtf(ss * (1.f / 256.f) + LN_EPS);
        for (int e = 0; e < 256; ++e) o[e] = f2bf(bf2f(o[e]) * rs * siluf(bf2f(p.Z1[(size_t)r * GINP + 2048 + h * 256 + e])));
    }
}

#define FD __device__ __forceinline__
#define TIE(a, b) asm volatile("" : "+v"(a) : "v"(b))
#define HWCOS(x) __builtin_amdgcn_cosf(x)
#define HWSIN(x) __builtin_amdgcn_sinf(x)
struct cf { float x, y; };
FD cf cadd(cf a, cf b) { return {a.x + b.x, a.y + b.y}; }
FD cf csub(cf a, cf b) { return {a.x - b.x, a.y - b.y}; }
FD cf cmul(cf a, cf b) { return {a.x * b.x - a.y * b.y, a.x * b.y + a.y * b.x}; }
#define C32(k) ((k)==0?1.0f:(k)==1?0.98078528040323043f:(k)==2?0.92387953251128674f:(k)==3?0.83146961230254524f:(k)==4?0.70710678118654752f:(k)==5?0.55557023301960222f:(k)==6?0.38268343236508977f:(k)==7?0.19509032201612825f:(k)==8?0.0f:(k)==9?-0.19509032201612825f:(k)==10?-0.38268343236508977f:(k)==11?-0.55557023301960222f:(k)==12?-0.70710678118654752f:(k)==13?-0.83146961230254524f:(k)==14?-0.92387953251128674f:-0.98078528040323043f)
#define S32(k) ((k)==0?0.0f:(k)==1?0.19509032201612825f:(k)==2?0.38268343236508977f:(k)==3?0.55557023301960222f:(k)==4?0.70710678118654752f:(k)==5?0.83146961230254524f:(k)==6?0.92387953251128674f:(k)==7?0.98078528040323043f:(k)==8?1.0f:(k)==9?0.98078528040323043f:(k)==10?0.92387953251128674f:(k)==11?0.83146961230254524f:(k)==12?0.70710678118654752f:(k)==13?0.55557023301960222f:(k)==14?0.38268343236508977f:0.19509032201612825f)
template <int N, int LEN, bool INV> FD void dit_level(cf (&x)[N]) {
#pragma unroll
    for (int blk = 0; blk < N; blk += LEN)
#pragma unroll
        for (int j = 0; j < LEN / 2; ++j) {
            const int k = j * (32 / LEN);
            const cf a = x[blk + j], b0 = x[blk + j + LEN / 2];
            const cf b = k == 0 ? b0 : (k == 8 ? (INV ? cf{-b0.y, b0.x} : cf{b0.y, -b0.x}) : cmul(b0, cf{C32(k), INV ? S32(k) : -S32(k)}));
            x[blk + j] = cadd(a, b); x[blk + j + LEN / 2] = csub(a, b);
        }
}
template <int N, bool INV> FD void dit_reg(cf (&x)[N]) {
    dit_level<N, 2, INV>(x); dit_level<N, 4, INV>(x);
    if constexpr (N >= 8) dit_level<N, 8, INV>(x);
    if constexpr (N >= 16) dit_level<N, 16, INV>(x);
}
template <int N, int LEN, bool INV> FD void dif_level(cf (&x)[N]) {
#pragma unroll
    for (int blk = 0; blk < N; blk += LEN)
#pragma unroll
        for (int j = 0; j < LEN / 2; ++j) {
            const int k = j * (32 / LEN);
            const cf a = x[blk + j], b = x[blk + j + LEN / 2];
            x[blk + j] = cadd(a, b); const cf d = csub(a, b);
            x[blk + j + LEN / 2] = k == 0 ? d : (k == 8 ? (INV ? cf{-d.y, d.x} : cf{d.y, -d.x}) : cmul(d, cf{C32(k), INV ? S32(k) : -S32(k)}));
        }
}
template <int N, bool INV> FD void dif_reg(cf (&x)[N]) {
    if constexpr (N >= 16) dif_level<N, 16, INV>(x);
    if constexpr (N >= 8) dif_level<N, 8, INV>(x);
    dif_level<N, 4, INV>(x); dif_level<N, 2, INV>(x);
}
constexpr int FFT_N = 16384, FFT_LDS_CF = 17920;
FD int brev4(int i) { return ((i & 1) << 3) | ((i & 2) << 1) | ((i & 4) >> 1) | ((i & 8) >> 3); }
FD int physA(int m, int a) { return 4480 * a + m + (m >> 4) + 16 * (m >> 9); }
FD int physB(int b, int a, int m) { return 4480 * b + 272 * a + 16 * (a >> 1) + m + (m >> 4); }
FD int physC(int b, int a, int m) { return 272 * b + 16 * (b >> 1) + 17 * a + m; }
FD int physD(int g, int j) { return 17 * g + 16 * (g >> 5) + j; }
template <int RR, int RM> FD void twiddle(cf (&x)[RR], int m, float sgn) {
    const float fr = (float)m * (1.0f / (float)RM); const cf w{HWCOS(fr), sgn * HWSIN(fr)}; cf cur = w;
#pragma unroll
    for (int s = 1; s < RR; ++s) { x[s] = cmul(x[s], cur); if (s + 1 < RR) cur = cmul(cur, w); }
}
FD void stA_fwd(int m, cf v0, cf v1, cf v2, cf v3, cf* buf) {
    cf x[4] = {v0, v2, v1, v3};
    dit_reg<4, false>(x); twiddle<4, 16384>(x, m, -1.f);
#pragma unroll
    for (int s = 0; s < 4; ++s) buf[physA(m, s)] = x[s];
}
FD void stB_fwd(int idx, cf* buf) {
    const int b = idx >> 8, m = idx & 255; cf x[16];
#pragma unroll
    for (int i = 0; i < 16; ++i) x[i] = buf[physB(b, brev4(i), m)];
    dit_reg<16, false>(x); twiddle<16, 4096>(x, m, -1.f);
#pragma unroll
    for (int s = 0; s < 16; ++s) buf[physB(b, s, m)] = x[s];
}
FD void stC_fwd(int idx, cf* buf) {
    const int b = idx >> 4, m = idx & 15; cf x[16];
#pragma unroll
    for (int i = 0; i < 16; ++i) x[i] = buf[physC(b, brev4(i), m)];
    dit_reg<16, false>(x); twiddle<16, 256>(x, m, -1.f);
#pragma unroll
    for (int s = 0; s < 16; ++s) buf[physC(b, s, m)] = x[s];
}
FD void stD_fwd_regs(int g, const cf* buf, cf (&x)[16]) {
#pragma unroll
    for (int i = 0; i < 16; ++i) x[i] = buf[physD(g, brev4(i))];
    dit_reg<16, false>(x);
}
FD void stD_mul(int g, cf* buf, const cf (&h)[16]) {
    cf x[16];
#pragma unroll
    for (int i = 0; i < 16; ++i) x[i] = buf[physD(g, brev4(i))];
    dit_reg<16, false>(x);
#pragma unroll
    for (int s = 0; s < 16; ++s) x[s] = cmul(x[s], h[s]);
    dif_reg<16, true>(x);
#pragma unroll
    for (int i = 0; i < 16; ++i) buf[physD(g, brev4(i))] = x[i];
}
FD void stC_inv(int idx, cf* buf) {
    const int b = idx >> 4, m = idx & 15; cf x[16];
#pragma unroll
    for (int s = 0; s < 16; ++s) x[s] = buf[physC(b, s, m)];
    twiddle<16, 256>(x, m, 1.f); dif_reg<16, true>(x);
#pragma unroll
    for (int i = 0; i < 16; ++i) buf[physC(b, brev4(i), m)] = x[i];
}
FD void stB_inv(int idx, cf* buf) {
    const int b = idx >> 8, m = idx & 255; cf x[16];
#pragma unroll
    for (int s = 0; s < 16; ++s) x[s] = buf[physB(b, s, m)];
    twiddle<16, 4096>(x, m, 1.f); dif_reg<16, true>(x);
#pragma unroll
    for (int i = 0; i < 16; ++i) buf[physB(b, brev4(i), m)] = x[i];
}
FD void stA_inv(int m, const cf* buf, cf& r0, cf& r1) {
    cf x[4];
#pragma unroll
    for (int s = 0; s < 4; ++s) x[s] = buf[physA(m, s)];
    twiddle<4, 16384>(x, m, 1.f); dif_reg<4, true>(x);
    r0 = x[0]; r1 = x[2];
}

#undef FD
__device__ __forceinline__ float dw3(const bf16_t* u, int d, int lo, int hi, float w0, float w1, float w2, float bs) {
    float a = bs + w1 * bf2f(u[d]);
    if (d > lo) a += w0 * bf2f(u[d - 1]);
    if (d < hi) a += w2 * bf2f(u[d + 1]);
    return a;
}
__device__ __forceinline__ void ph_hyena_fft(const P& p, unsigned char* smem) {
    cf* buf = (cf*)smem; float* fb = (float*)smem; float* red = (float*)(smem + FFT_LDS_CF * 8);
    const int t = TIDX;
    bf16_t* yhT = p.Zh + (size_t)2 * NB * 4 * NCH * 16384;
    for (int ch = blockIdx.x; ch < 512; ch += gridDim.x) {
        const bf16_t* hy0 = p.hyT + ((size_t)0 * 512 + ch) * RB;
        const size_t bstr = (size_t)3 * 512 * RB, jstr = (size_t)512 * RB;
        cf* Hg = (cf*)p.H + (size_t)blockIdx.x * 16384;
        cf zreg[16];
        float cw[3][3], cbv[3];
#pragma unroll
        for (int j = 0; j < 3; ++j) { cbv[j] = p.in[12][j * 512 + ch];
#pragma unroll
            for (int q = 0; q < 3; ++q) cw[j][q] = p.in[11][q * 1536 + j * 512 + ch]; }
#pragma unroll 1
        for (int n = 0; n < 2; ++n) {
            const int cfi = (n * 2) * 512 + ch, cbi = (n * 2 + 1) * 512 + ch;
            const float* Ff = p.FILT + (size_t)cfi * RB; const float* Fb = p.FILT + (size_t)cbi * RB;
            float tf0[8], tf1[8], tb2[8], tb3[8]; float sf = 0.f, sb = 0.f;
#pragma unroll
            for (int j = 0; j < 8; ++j) { const int m = t + 512 * j;
                tf0[j] = Ff[m]; tf1[j] = Ff[4096 + m]; tb2[j] = (m == 0) ? Fb[0] : Fb[8192 - (m == 0 ? 1 : m)]; tb3[j] = Fb[4096 - m];
                sf += tf0[j] * tf0[j] + tf1[j] * tf1[j]; sb += tb2[j] * tb2[j] + tb3[j] * tb3[j]; }
            const float nf = 1.f / sqrtf(block_sum(sf, red)), nb = 1.f / sqrtf(block_sum(sb, red));
#pragma unroll
            for (int j = 0; j < 8; ++j) { const int m = launder_i(t) + 512 * j;
                const float v0 = tf0[j] * nf + ((m == 0) ? tb2[j] * nb : 0.f), v2 = (m == 0) ? 0.f : tb2[j] * nb;
                stA_fwd(m, cf{v0, 0.f}, cf{tf1[j] * nf, 0.f}, cf{v2, 0.f}, cf{tb3[j] * nb, 0.f}, buf); }
            __syncthreads();
#pragma unroll 1
            for (int q = 0; q < 2; ++q) stB_fwd(launder_i(t) + 512 * q, buf);
            __syncthreads();
#pragma unroll 1
            for (int q = 0; q < 2; ++q) stC_fwd(launder_i(t) + 512 * q, buf);
            __syncthreads();
#pragma unroll 1
            for (int q = 0; q < 2; ++q) { const int g = launder_i(t) + 512 * q; cf hh[16]; stD_fwd_regs(g, buf, hh);
#pragma unroll
                for (int s = 0; s < 16; ++s) Hg[s * 1024 + g] = hh[s]; }
            __syncthreads();
#pragma unroll
            for (int j = 0; j < 8; ++j) { const int m = launder_i(t) + 512 * j;
                if (n == 0) { zreg[2 * j] = cf{dw3(hy0 + 2 * jstr, m, 0, L - 1, cw[2][0], cw[2][1], cw[2][2], cbv[2]), dw3(hy0 + bstr + 2 * jstr, m, 0, L - 1, cw[2][0], cw[2][1], cw[2][2], cbv[2])};
                              zreg[2 * j + 1] = cf{dw3(hy0 + 2 * jstr, 4096 + m, 0, L - 1, cw[2][0], cw[2][1], cw[2][2], cbv[2]), dw3(hy0 + bstr + 2 * jstr, 4096 + m, 0, L - 1, cw[2][0], cw[2][1], cw[2][2], cbv[2])}; }
                stA_fwd(m, zreg[2 * j], zreg[2 * j + 1], cf{0.f, 0.f}, cf{0.f, 0.f}, buf); }
            __syncthreads();
#pragma unroll 1
            for (int q = 0; q < 2; ++q) stB_fwd(launder_i(t) + 512 * q, buf);
            __syncthreads();
#pragma unroll 1
            for (int q = 0; q < 2; ++q) stC_fwd(launder_i(t) + 512 * q, buf);
            __syncthreads();
#pragma unroll 1
            for (int q = 0; q < 2; ++q) { const int g = launder_i(t) + 512 * q; cf hh[16];
#pragma unroll
                for (int s = 0; s < 16; ++s) hh[s] = Hg[s * 1024 + g];
                stD_mul(g, buf, hh); }
            __syncthreads();
#pragma unroll 1
            for (int q = 0; q < 2; ++q) stC_inv(launder_i(t) + 512 * q, buf);
            __syncthreads();
#pragma unroll 1
            for (int q = 0; q < 2; ++q) stB_inv(launder_i(t) + 512 * q, buf);
            __syncthreads();
            const float sk = p.in[21][n * 512 + ch];
#pragma unroll
            for (int j = 0; j < 8; ++j) { const int m = launder_i(t) + 512 * j; cf r0, r1; stA_inv(m, buf, r0, r1);
#pragma unroll
                for (int hlf = 0; hlf < 2; ++hlf) { const int d = m + 4096 * hlf; const cf r = hlf ? r1 : r0; const cf z = zreg[2 * j + hlf];
                    const bf16_t* gs = hy0 + n * jstr;
                    const float g0 = dw3(gs, d, 0, L - 1, cw[n][0], cw[n][1], cw[n][2], cbv[n]), g1 = dw3(gs + bstr, d, 0, L - 1, cw[n][0], cw[n][1], cw[n][2], cbv[n]);
                    const float o0 = g0 * (r.x * (1.f / 16384.f) + sk * z.x), o1 = g1 * (r.y * (1.f / 16384.f) + sk * z.y);
                    if (n == 0) zreg[2 * j + hlf] = cf{o0, o1};
                    else { yhT[((size_t)0 * 512 + ch) * RB + d] = f2bf(o0); yhT[((size_t)1 * 512 + ch) * RB + d] = f2bf(o1); } } }
            __syncthreads();
        }
        {
            float* tap = fb;
            float* zc = fb + 1024;
            const int b = t >> 8, tt = t & 255;
#pragma unroll
            for (int n = 0; n < 2; ++n) {
                const int cfi = (n * 2) * 512 + ch, cbi = (n * 2 + 1) * 512 + ch;
                const float* Ff = p.FILT + (size_t)cfi * RB + L; const float* Fb = p.FILT + (size_t)cbi * RB + L;
                const float vf = t < 256 ? Ff[t] : 0.f, vb = t < 256 ? Fb[t] : 0.f;
                const float nf = 1.f / sqrtf(block_sum(vf * vf, red)), nb = 1.f / sqrtf(block_sum(vb * vb, red));
                if (t < 511) { const int d = t - 255; tap[n * 512 + t] = d > 0 ? Ff[d] * nf : (d < 0 ? Fb[-d] * nb : Ff[0] * nf + Fb[0] * nb); }
            }
            const bf16_t* hb_ = hy0 + (size_t)b * bstr;
            const float z1 = dw3(hb_ + 2 * jstr, L + tt, L, RB - 1, cw[2][0], cw[2][1], cw[2][2], cbv[2]);
            zc[b * 256 + tt] = z1;
            __syncthreads();
            float c1 = 0.f;
            for (int s = 0; s < 256; ++s) c1 += tap[tt - s + 255] * zc[b * 256 + s];
            const float z2 = dw3(hb_, L + tt, L, RB - 1, cw[0][0], cw[0][1], cw[0][2], cbv[0]) * (c1 + p.in[21][ch] * z1);
            __syncthreads();
            zc[b * 256 + tt] = z2;
            __syncthreads();
            float c2 = 0.f;
            for (int s = 0; s < 256; ++s) c2 += tap[512 + tt - s + 255] * zc[b * 256 + s];
            yhT[((size_t)b * 512 + ch) * RB + L + tt] = f2bf(dw3(hb_ + jstr, L + tt, L, RB - 1, cw[1][0], cw[1][1], cw[1][2], cbv[1]) * (c2 + p.in[21][512 + ch] * z2));
            __syncthreads();
        }
    }
}

typedef short bf16x8 __attribute__((ext_vector_type(8)));
typedef short s16x4 __attribute__((ext_vector_type(4)));
typedef float f32x4 __attribute__((ext_vector_type(4)));
typedef unsigned u4v __attribute__((ext_vector_type(4)));
typedef unsigned u2v __attribute__((ext_vector_type(2)));
constexpr int LDT = 136;
constexpr int TILE_E = 128 * LDT;
__device__ __forceinline__ bf16x8 frag_row(const LAS bf16_t* T, int ld, int r0, int k0, int lane) {
    return *(const LAS bf16x8*)(T + (r0 + (lane & 15)) * ld + k0 + 8 * (lane >> 4));
}
__device__ __forceinline__ bf16x8 frag_tr(const LAS bf16_t* T, int ld, int k0, int n0, int lane) {
    const int g = lane >> 4, q = (lane & 15) >> 2, pp = lane & 3;
    const LAS bf16_t* a0 = T + (k0 + 8 * g + q) * ld + n0 + 4 * pp;
    const s16x4 lo = __builtin_amdgcn_ds_read_tr16_b64_v4i16((LAS s16x4*)a0);
    const s16x4 hi = __builtin_amdgcn_ds_read_tr16_b64_v4i16((LAS s16x4*)(a0 + 4 * ld));
    return (bf16x8){lo[0], lo[1], lo[2], lo[3], hi[0], hi[1], hi[2], hi[3]};
}
#define MFMA16(xn, xm, acc) __builtin_amdgcn_mfma_f32_16x16x32_bf16(xn, xm, acc, 0, 0, 0)
__device__ __forceinline__ void unpack8(const u4v u, float (&f)[8]) {
    f[0] = __uint_as_float(u.x << 16); f[1] = __uint_as_float(u.x & 0xffff0000u); f[2] = __uint_as_float(u.y << 16); f[3] = __uint_as_float(u.y & 0xffff0000u);
    f[4] = __uint_as_float(u.z << 16); f[5] = __uint_as_float(u.z & 0xffff0000u); f[6] = __uint_as_float(u.w << 16); f[7] = __uint_as_float(u.w & 0xffff0000u);
}
__device__ __forceinline__ u4v pack8(const float (&f)[8]) {
    u4v u; u.x = pk_bf16(f[0], f[1]); u.y = pk_bf16(f[2], f[3]); u.z = pk_bf16(f[4], f[5]); u.w = pk_bf16(f[6], f[7]); return u;
}
__device__ __forceinline__ void stage_tile(LAS bf16_t* dst, const bf16_t* src, int gld, int tid) {
#pragma unroll
    for (int i = 0; i < 4; ++i) { const int c = tid + 512 * i, row = c >> 4, ch = c & 15;
        *(LAS u4v*)(dst + row * LDT + ch * 8) = *(const u4v*)(src + (size_t)row * gld + ch * 8); }
}
__device__ __forceinline__ void ph_retU_mfma(const P& p, unsigned char* smem) {
    LAS bf16_t* Kt = (LAS bf16_t*)smem; LAS bf16_t* VF = Kt + TILE_E; LAS bf16_t* VB = VF + TILE_E;
    bf16_t* ST = p.Zh;
    for (int u = blockIdx.x; u < NB * 4 * NCH; u += gridDim.x) {
        const int tid = TIDX, lane = tid & 63, w = tid >> 6;
        const int c = u % NCH, h = (u / NCH) % 4, b = u / (NCH * 4); const int r0 = chunk_row0(b, c);
        const float lgf = p.in[9][h], lgb = p.in[10][h];
        const bf16_t* kb = p.Zr + (size_t)r0 * 2048 + 512 + h * 128; const bf16_t* vb = p.Zr + (size_t)r0 * 2048 + 1024 + h * 128;
        __syncthreads();
        stage_tile(Kt, kb, 2048, tid);
#pragma unroll
        for (int i = 0; i < 4; ++i) { const int cc = tid + 512 * i, j = cc >> 4, ch = cc & 15;
            float f[8], g[8]; unpack8(*(const u4v*)(vb + (size_t)j * 2048 + ch * 8), f);
            const float wf = __expf(lgf * (float)(127 - j)), wb = __expf(lgb * (float)j);
#pragma unroll
            for (int q = 0; q < 8; ++q) { g[q] = f[q] * wb; f[q] *= wf; }
            *(LAS u4v*)(VF + j * LDT + ch * 8) = pack8(f); *(LAS u4v*)(VB + j * LDT + ch * 8) = pack8(g); }
        __syncthreads();
        f32x4 af[8], ab[8];
#pragma unroll
        for (int nt = 0; nt < 8; ++nt) { af[nt] = (f32x4){0.f, 0.f, 0.f, 0.f}; ab[nt] = (f32x4){0.f, 0.f, 0.f, 0.f}; }
#pragma unroll
        for (int ks = 0; ks < 4; ++ks) {
            const bf16x8 xf = frag_tr(VF, LDT, 32 * ks, 16 * w, lane), xb = frag_tr(VB, LDT, 32 * ks, 16 * w, lane);
#pragma unroll
            for (int nt = 0; nt < 8; ++nt) { const bf16x8 xn = frag_tr(Kt, LDT, 32 * ks, 16 * nt, lane); af[nt] = MFMA16(xn, xf, af[nt]); ab[nt] = MFMA16(xn, xb, ab[nt]); }
        }
        const int e = 16 * w + (lane & 15), d0 = 4 * (lane >> 4);
        bf16_t* of = ST + st_idx(0, b, h, c) + e * 128 + d0; bf16_t* ob = ST + st_idx(1, b, h, c) + e * 128 + d0;
#pragma unroll
        for (int nt = 0; nt < 8; ++nt) {
            u2v o; o.x = pk_bf16(af[nt][0], af[nt][1]); o.y = pk_bf16(af[nt][2], af[nt][3]); *(u2v*)(of + 16 * nt) = o;
            o.x = pk_bf16(ab[nt][0], ab[nt][1]); o.y = pk_bf16(ab[nt][2], ab[nt][3]); *(u2v*)(ob + 16 * nt) = o; }
    }
}
__device__ __forceinline__ void ph_retO_mfma(const P& p, unsigned char* smem) {
    LAS bf16_t* Qs = (LAS bf16_t*)smem; LAS bf16_t* Ks = Qs + TILE_E; LAS bf16_t* Vs = Ks + TILE_E; LAS bf16_t* Ss = Vs + TILE_E;
    const bf16_t* ST = p.Zh;
    for (int u = blockIdx.x; u < NB * 4 * NCH; u += gridDim.x) {
        const int tid = TIDX, lane = tid & 63, w = tid >> 6, fr = lane & 15, fq = lane >> 4;
        const int c = u % NCH, h = (u / NCH) % 4, b = u / (NCH * 4); const int r0 = chunk_row0(b, c);
        const float lgf = p.in[9][h], lgb = p.in[10][h];
        const bf16_t* zb = p.Zr + (size_t)r0 * 2048 + h * 128;
        __syncthreads();
        stage_tile(Qs, zb, 2048, tid); stage_tile(Ks, zb + 512, 2048, tid); stage_tile(Vs, zb + 1024, 2048, tid); stage_tile(Ss, ST + st_idx(0, b, h, c), 128, tid);
        __syncthreads();
        f32x4 as[8], af[8];
#pragma unroll
        for (int nt = 0; nt < 8; ++nt) { as[nt] = (f32x4){0.f, 0.f, 0.f, 0.f}; af[nt] = (f32x4){0.f, 0.f, 0.f, 0.f}; }
#pragma unroll
        for (int ks = 0; ks < 4; ++ks) { const bf16x8 xm = frag_row(Qs, LDT, 16 * w, 32 * ks, lane);
#pragma unroll
            for (int nt = 0; nt < 8; ++nt) { as[nt] = MFMA16(frag_row(Ks, LDT, 16 * nt, 32 * ks, lane), xm, as[nt]); af[nt] = MFMA16(frag_row(Ss, LDT, 16 * nt, 32 * ks, lane), xm, af[nt]); } }
        const int i = 16 * w + fr;
        __syncthreads();
#pragma unroll
        for (int nt = 0; nt < 8; ++nt) { float pv[4];
#pragma unroll
            for (int q = 0; q < 4; ++q) { const int j = 16 * nt + 4 * fq + q; const float m = i > j ? __expf(lgf * (float)(i - j)) : (j > i ? __expf(lgb * (float)(j - i)) : 2.f); pv[q] = as[nt][q] * m; }
            u2v o; o.x = pk_bf16(pv[0], pv[1]); o.y = pk_bf16(pv[2], pv[3]); *(LAS u2v*)(Ks + i * LDT + 16 * nt + 4 * fq) = o; }
        stage_tile(Ss, ST + st_idx(1, b, h, c), 128, tid);
        __syncthreads();
        f32x4 ao[8], ab[8];
#pragma unroll
        for (int nt = 0; nt < 8; ++nt) { ao[nt] = (f32x4){0.f, 0.f, 0.f, 0.f}; ab[nt] = (f32x4){0.f, 0.f, 0.f, 0.f}; }
#pragma unroll
        for (int ks = 0; ks < 4; ++ks) { const bf16x8 xp = frag_row(Ks, LDT, 16 * w, 32 * ks, lane), xq = frag_row(Qs, LDT, 16 * w, 32 * ks, lane);
#pragma unroll
            for (int nt = 0; nt < 8; ++nt) { ao[nt] = MFMA16(frag_tr(Vs, LDT, 32 * ks, 16 * nt, lane), xp, ao[nt]); ab[nt] = MFMA16(frag_row(Ss, LDT, 16 * nt, 32 * ks, lane), xq, ab[nt]); } }
        const float rf = __expf(lgf * (float)(i + 1)), rb = __expf(lgb * (float)(128 - i));
        float s = 0.f;
#pragma unroll
        for (int nt = 0; nt < 8; ++nt) { ao[nt] = ao[nt] + af[nt] * rf + ab[nt] * rb; s += (ao[nt][0] + ao[nt][1]) + (ao[nt][2] + ao[nt][3]); }
        s += __shfl_xor(s, 16); s += __shfl_xor(s, 32);
        const float mu = s * (1.f / 128.f); float qv = 0.f;
#pragma unroll
        for (int nt = 0; nt < 8; ++nt) { const f32x4 dd = ao[nt] - mu; qv += (dd[0] * dd[0] + dd[1] * dd[1]) + (dd[2] * dd[2] + dd[3] * dd[3]); }
        qv += __shfl_xor(qv, 16); qv += __shfl_xor(qv, 32);
        const float rs = 1.f / sqrtf(qv * (1.f / 128.f) + LN_EPS);
        const bf16_t* gp = p.Zr + (size_t)(r0 + i) * 2048 + 1536 + h * 128 + 4 * fq; bf16_t* yp = p.H + (size_t)(r0 + i) * D + h * 128 + 4 * fq;
#pragma unroll
        for (int nt = 0; nt < 8; ++nt) { const u2v gu = *(const u2v*)(gp + 16 * nt);
            const float g0 = __uint_as_float(gu.x << 16), g1 = __uint_as_float(gu.x & 0xffff0000u), g2 = __uint_as_float(gu.y << 16), g3 = __uint_as_float(gu.y & 0xffff0000u);
            u2v o; o.x = pk_bf16((ao[nt][0] - mu) * rs * siluf(g0), (ao[nt][1] - mu) * rs * siluf(g1)); o.y = pk_bf16((ao[nt][2] - mu) * rs * siluf(g2), (ao[nt][3] - mu) * rs * siluf(g3));
            *(u2v*)(yp + 16 * nt) = o; }
    }
}
__device__ __forceinline__ void ph_glaU_mfma(const P& p, unsigned char* smem) {
    LAS bf16_t* KF = (LAS bf16_t*)smem; LAS bf16_t* KB = KF + TILE_E; LAS bf16_t* Vs = KB + TILE_E;
    for (int u = blockIdx.x; u < NB * 4 * NCH; u += gridDim.x) {
        const int tid = TIDX, lane = tid & 63, w = tid >> 6;
        const int c = u % NCH, h = (u / NCH) % 4, b = u / (NCH * 4); const int r0 = chunk_row0(b, c);
        const bf16_t* kb = p.Z1 + (size_t)r0 * GINP + 512 + h * 128; const bf16_t* vb = p.Z1 + (size_t)r0 * GINP + 1024 + h * 256;
        float* BFw = p.BG + (size_t)r0 * 512 + h * 128; float* BBw = p.BG + (size_t)R * 512 + (size_t)r0 * 512 + h * 128;
        const float* BF = BFw; const float* BB = BBw;
        __syncthreads();
        {
            float* lr = (float*)(Vs);
            float* tot = lr + 128 * 32;
            for (int e = tid; e < 128 * 32; e += NT) lr[e] = bf2f(p.Z1[(size_t)(r0 + (e >> 5)) * GINP + 3072 + (e & 31)]);
            const int chn = tid & 127, dir = (tid >> 7) & 1, half = tid >> 8;
            const float* gw = (dir ? p.in[26] : p.in[24]) + h * 128 + chn; float g[16];
#pragma unroll
            for (int q = 0; q < 16; ++q) g[q] = gw[q * 512];
            const float gb = (dir ? p.in[27] : p.in[25])[h * 128 + chn];
            __syncthreads();
            float la[64]; float s = 0.f;
#pragma unroll
            for (int ii = 0; ii < 64; ++ii) { const int i = half * 64 + ii; float a = gb;
#pragma unroll
                for (int q = 0; q < 16; ++q) a += lr[i * 32 + dir * 16 + q] * g[q];
                la[ii] = (fminf(a, 0.f) - __logf(1.f + __expf(-fabsf(a)))) * (1.f / 16.f); s += la[ii]; }
            tot[(dir * 2 + half) * 128 + chn] = s;
            __syncthreads();
            const float total = tot[(dir * 2 + 0) * 128 + chn] + tot[(dir * 2 + 1) * 128 + chn];
            s = dir == 0 ? (half ? tot[(0 * 2 + 0) * 128 + chn] : 0.f) : (half ? 0.f : tot[(1 * 2 + 1) * 128 + chn]);
            float* out = (dir ? BBw : BFw) + chn; LAS bf16_t* Kd = dir ? KB : KF;
            if (dir == 0) {
#pragma unroll
                for (int ii = 0; ii < 64; ++ii) { const int i = half * 64 + ii; s += la[ii]; out[(size_t)i * 512] = s; Kd[i * LDT + chn] = f2bf(bf2f(kb[(size_t)i * GINP + chn]) * __expf(total - s)); }
            } else {
#pragma unroll
                for (int ii = 63; ii >= 0; --ii) { const int i = half * 64 + ii; s += la[ii]; out[(size_t)i * 512] = s; Kd[i * LDT + chn] = f2bf(bf2f(kb[(size_t)i * GINP + chn]) * __expf(total - s)); }
            }
            __syncthreads();
        }
        const int fr = lane & 15, fq = lane >> 4;
#pragma unroll 1
        for (int hf = 0; hf < 2; ++hf) {
            if (hf) __syncthreads();
            stage_tile(Vs, vb + hf * 128, GINP, tid);
            __syncthreads();
            {
                f32x4 af[8], ab[8];
#pragma unroll
                for (int nt = 0; nt < 8; ++nt) { af[nt] = (f32x4){0.f, 0.f, 0.f, 0.f}; ab[nt] = (f32x4){0.f, 0.f, 0.f, 0.f}; }
#pragma unroll
                for (int ks = 0; ks < 4; ++ks) { const bf16x8 x0 = frag_tr(Vs, LDT, 32 * ks, 16 * w, lane);
#pragma unroll
                    for (int nt = 0; nt < 8; ++nt) { af[nt] = MFMA16(frag_tr(KF, LDT, 32 * ks, 16 * nt, lane), x0, af[nt]); ab[nt] = MFMA16(frag_tr(KB, LDT, 32 * ks, 16 * nt, lane), x0, ab[nt]); } }
                bf16_t* of = p.GST + gst_idx(0, b, h, c) + (size_t)(hf * 128 + 16 * w + fr) * 128 + 4 * fq; bf16_t* ob = p.GST + gst_idx(1, b, h, c) + (size_t)(hf * 128 + 16 * w + fr) * 128 + 4 * fq;
#pragma unroll
                for (int nt = 0; nt < 8; ++nt) { u2v v; v.x = pk_bf16(af[nt][0], af[nt][1]); v.y = pk_bf16(af[nt][2], af[nt][3]); *(u2v*)(of + 16 * nt) = v;
                    v.x = pk_bf16(ab[nt][0], ab[nt][1]); v.y = pk_bf16(ab[nt][2], ab[nt][3]); *(u2v*)(ob + 16 * nt) = v; }
            }
        }
    }
}
__device__ __forceinline__ void stage_scaled(LAS bf16_t* dst, const bf16_t* src, const float* G, float sgn, float mul, int tid) {
#pragma unroll
    for (int i = 0; i < 4; ++i) { const int cc = tid + 512 * i, j = cc >> 4, ch = cc & 15;
        float k8[8]; unpack8(*(const u4v*)(src + (size_t)j * GINP + ch * 8), k8);
        const f32x4 f0 = *(const f32x4*)(G + (size_t)j * 512 + ch * 8), f1 = *(const f32x4*)(G + (size_t)j * 512 + ch * 8 + 4);
#pragma unroll
        for (int q = 0; q < 4; ++q) { k8[q] *= __expf(sgn * f0[q]) * mul; k8[q + 4] *= __expf(sgn * f1[q]) * mul; }
        *(LAS u4v*)(dst + j * LDT + ch * 8) = pack8(k8); }
}
__device__ __forceinline__ void ph_glaO_mfma(const P& p, unsigned char* smem) {
    LAS bf16_t* QF = (LAS bf16_t*)smem; LAS bf16_t* QB = QF + TILE_E; LAS bf16_t* KX = QB + TILE_E; LAS bf16_t* R4 = KX + TILE_E;
    for (int u = blockIdx.x; u < NB * 4 * 64; u += gridDim.x) {
        const int tid = TIDX, lane = tid & 63, w = tid >> 6, fr = lane & 15, fq = lane >> 4;
        const int c = 2 + u % 64, h = (u / 64) % 4, b = u / 256; const int r0 = chunk_row0(b, c);
        const bf16_t* qb = p.Z1 + (size_t)r0 * GINP + h * 128; const bf16_t* kb = qb + 512; const bf16_t* vb = p.Z1 + (size_t)r0 * GINP + 1024 + h * 256;
        const float* BF = p.BG + (size_t)r0 * 512 + h * 128; const float* BB = p.BG + (size_t)R * 512 + (size_t)r0 * 512 + h * 128;
        const int i = 16 * w + fr;
        __syncthreads();
        stage_scaled(QF, qb, BF, 1.f, KSCALE, tid); stage_scaled(QB, qb, BB, 1.f, KSCALE, tid); stage_scaled(KX, kb, BF, -1.f, 1.f, tid);
        __syncthreads();
        f32x4 s1[8];
#pragma unroll
        for (int nt = 0; nt < 8; ++nt) s1[nt] = (f32x4){0.f, 0.f, 0.f, 0.f};
#pragma unroll
        for (int ks = 0; ks < 4; ++ks) { const bf16x8 xm = frag_row(QF, LDT, 16 * w, 32 * ks, lane);
#pragma unroll
            for (int nt = 0; nt < 8; ++nt) s1[nt] = MFMA16(frag_row(KX, LDT, 16 * nt, 32 * ks, lane), xm, s1[nt]); }
#pragma unroll
        for (int nt = 0; nt < 8; ++nt)
#pragma unroll
            for (int q = 0; q < 4; ++q) { const int j = 16 * nt + 4 * fq + q; s1[nt][q] = (i >= j) ? s1[nt][q] : 0.f; }
        __syncthreads();
        stage_scaled(KX, kb, BB, -1.f, 1.f, tid);
        __syncthreads();
        {
            f32x4 s2[8];
#pragma unroll
            for (int nt = 0; nt < 8; ++nt) s2[nt] = (f32x4){0.f, 0.f, 0.f, 0.f};
#pragma unroll
            for (int ks = 0; ks < 4; ++ks) { const bf16x8 xm = frag_row(QB, LDT, 16 * w, 32 * ks, lane);
#pragma unroll
                for (int nt = 0; nt < 8; ++nt) s2[nt] = MFMA16(frag_row(KX, LDT, 16 * nt, 32 * ks, lane), xm, s2[nt]); }
#pragma unroll
            for (int nt = 0; nt < 8; ++nt)
#pragma unroll
                for (int q = 0; q < 4; ++q) { const int j = 16 * nt + 4 * fq + q; s1[nt][q] += (i <= j) ? s2[nt][q] : 0.f; }
        }
        __syncthreads();
#pragma unroll
        for (int nt = 0; nt < 8; ++nt) { u2v o; o.x = pk_bf16(s1[nt][0], s1[nt][1]); o.y = pk_bf16(s1[nt][2], s1[nt][3]); *(LAS u2v*)(KX + i * LDT + 16 * nt + 4 * fq) = o; }
        f32x4 ao[2][8];
#pragma unroll
        for (int hf = 0; hf < 2; ++hf) {
#pragma unroll
            for (int nt = 0; nt < 8; ++nt) ao[hf][nt] = (f32x4){0.f, 0.f, 0.f, 0.f};
            stage_tile(R4, vb + hf * 128, GINP, tid);
            __syncthreads();
#pragma unroll
            for (int ks = 0; ks < 4; ++ks) { const bf16x8 xp = frag_row(KX, LDT, 16 * w, 32 * ks, lane);
#pragma unroll
                for (int nt = 0; nt < 8; ++nt) ao[hf][nt] = MFMA16(frag_tr(R4, LDT, 32 * ks, 16 * nt, lane), xp, ao[hf][nt]); }
            __syncthreads();
            stage_tile(R4, p.GST + gst_idx(0, b, h, c) + (size_t)hf * 128 * 128, 128, tid);
            __syncthreads();
#pragma unroll
            for (int ks = 0; ks < 4; ++ks) { const bf16x8 xq = frag_row(QF, LDT, 16 * w, 32 * ks, lane);
#pragma unroll
                for (int nt = 0; nt < 8; ++nt) ao[hf][nt] = MFMA16(frag_row(R4, LDT, 16 * nt, 32 * ks, lane), xq, ao[hf][nt]); }
            __syncthreads();
            stage_tile(R4, p.GST + gst_idx(1, b, h, c) + (size_t)hf * 128 * 128, 128, tid);
            __syncthreads();
#pragma unroll
            for (int ks = 0; ks < 4; ++ks) { const bf16x8 xq = frag_row(QB, LDT, 16 * w, 32 * ks, lane);
#pragma unroll
                for (int nt = 0; nt < 8; ++nt) ao[hf][nt] = MFMA16(frag_row(R4, LDT, 16 * nt, 32 * ks, lane), xq, ao[hf][nt]); }
            __syncthreads();
        }
        float ss = 0.f;
#pragma unroll
        for (int hf = 0; hf < 2; ++hf)
#pragma unroll
            for (int nt = 0; nt < 8; ++nt) { const f32x4 v = ao[hf][nt]; ss += (v[0] * v[0] + v[1] * v[1]) + (v[2] * v[2] + v[3] * v[3]); }
        ss += __shfl_xor(ss, 16); ss += __shfl_xor(ss, 32);
        const float rs = 1.f / sqrtf(ss * (1.f / 256.f) + LN_EPS);
        const bf16_t* gp = p.Z1 + (size_t)(r0 + i) * GINP + 2048 + h * 256 + 4 * fq; bf16_t* yp = p.H + (size_t)(r0 + i) * D + h * 256 + 4 * fq;
#pragma unroll
        for (int hf = 0; hf < 2; ++hf)
#pragma unroll
            for (int nt = 0; nt < 8; ++nt) { const u2v gu = *(const u2v*)(gp + hf * 128 + 16 * nt);
                const float g0 = __uint_as_float(gu.x << 16), g1 = __uint_as_float(gu.x & 0xffff0000u), g2 = __uint_as_float(gu.y << 16), g3 = __uint_as_float(gu.y & 0xffff0000u);
                u2v o; o.x = pk_bf16(ao[hf][nt][0] * rs * siluf(g0), ao[hf][nt][1] * rs * siluf(g1)); o.y = pk_bf16(ao[hf][nt][2] * rs * siluf(g2), ao[hf][nt][3] * rs * siluf(g3));
                *(u2v*)(yp + hf * 128 + 16 * nt) = o; }
    }
}

template <int MODE> __device__ __forceinline__ void tr_w(bf16_t* dst, const float* src, int N, int K, int ldsrc, float* t  , int& tile0, int tile_stride) {
    const int nt_n = N / 64, ntiles = nt_n * (K / 64);
    for (int tile = tile0; tile < ntiles; tile += tile_stride) {
        const int tid = TIDX; const int n0 = (tile % nt_n) * 64, k0 = (tile / nt_n) * 64;
        __syncthreads();
#pragma unroll
        for (int i = 0; i < 8; ++i) { const int e = tid + 512 * i, kk = e >> 6, nn = e & 63; t[kk * 65 + nn] = src[(size_t)(k0 + kk) * ldsrc + n0 + nn]; }
        __syncthreads();
#pragma unroll
        for (int i = 0; i < 4; ++i) { const int e = tid + 512 * i, nn = e >> 5, kp = e & 31; const int n = n0 + nn;
            int row; float sc = 1.f;
            if (MODE == 0) row = n; else if (MODE == 3) { const int d = n & 127; row = n < 1024 ? (n - d) + 2 * (d & 63) + (d >> 6) : n; sc = (n >= 512 && n < 1024) ? KSCALE : 1.f; }
            else row = 8 * (n >> 2) + (n & 3) + (MODE == 2 ? 4 : 0);
            *(unsigned*)(dst + (size_t)row * K + k0 + 2 * kp) = pk_bf16(t[(2 * kp) * 65 + nn] * sc, t[(2 * kp + 1) * 65 + nn] * sc); }
    }
    tile0 = tile0 - (ntiles % tile_stride);
    if (tile0 < 0) tile0 += tile_stride;
}
__device__ __forceinline__ void ph_wconv_fast(const P& p, float* t) {
    int t0 = blockIdx.x; const int G = gridDim.x;
    tr_w<3>(p.Win0, p.in[8], ABIN, D, ABIN, t, t0, G);
    tr_w<0>(p.Wout0, p.in[22], D, D, D, t, t0, G);
    tr_w<0>(p.Win1, p.in[23], 3072, D, GIN, t, t0, G);
    tr_w<0>(p.Wout1, p.in[28], D, D, D, t, t0, G);
    GSTRIDE(idx, (long)(GINP - 3072) * D) { const int k = idx % D, n = 3072 + idx / D; p.Win1[(size_t)n * D + k] = n < GIN ? f2bf(p.in[23][(size_t)k * GIN + n]) : (bf16_t)0; }
}
__device__ __forceinline__ void ph_wconv_moe_fast(const P& p, int l, float* t) {
    int t0 = blockIdx.x; const int G = gridDim.x;
    for (int e = 0; e < NE; ++e) {
        tr_w<1>(p.Wgu + (size_t)e * 1024 * 1024, p.in[31] + (size_t)(l * NE + e) * D * EH, EH, D, EH, t, t0, G);
        tr_w<2>(p.Wgu + (size_t)e * 1024 * 1024, p.in[32] + (size_t)(l * NE + e) * D * EH, EH, D, EH, t, t0, G);
        tr_w<0>(p.Wd + (size_t)e * 1024 * 512, p.in[33] + (size_t)(l * NE + e) * EH * D, D, EH, D, t, t0, G);
    }
}
__device__ __forceinline__ void ph_prep_hy_fast(const P& p, float* t  ) {
    const int ntt = RB / 64, ntc = 1536 / 64;
    for (int tile = blockIdx.x; tile < NB * ntt * ntc; tile += gridDim.x) {
        const int tid = TIDX; const int ct = tile % ntc, tt = (tile / ntc) % ntt, b = tile / (ntc * ntt); const int c0 = ct * 64, tl0 = tt * 64;
        const int s0 = tl0 < L ? 0 : L, s1 = tl0 < L ? L : RB;
        __syncthreads();
        for (int e = tid; e < 66 * 64; e += NT) { const int rr = e >> 6, cc = e & 63, tl = tl0 - 1 + rr;
            t[rr * 65 + cc] = (tl >= s0 && tl < s1) ? bf2f(p.Zh[(size_t)bt_row(b, tl) * 1536 + c0 + cc]) : 0.f; }
        __syncthreads();
#pragma unroll
        for (int i = 0; i < 4; ++i) { const int e = tid + 512 * i, cc = e >> 5, tp = e & 31; const int col = c0 + cc;
            const float w0 = p.in[11][col], w1 = p.in[11][1536 + col], w2 = p.in[11][3072 + col], bs = p.in[12][col];
            const float a = bs + w0 * t[(2 * tp) * 65 + cc] + w1 * t[(2 * tp + 1) * 65 + cc] + w2 * t[(2 * tp + 2) * 65 + cc];
            const float c2 = bs + w0 * t[(2 * tp + 1) * 65 + cc] + w1 * t[(2 * tp + 2) * 65 + cc] + w2 * t[(2 * tp + 3) * 65 + cc];
            *(unsigned*)(p.hyT + ((size_t)b * 1536 + col) * RB + tl0 + 2 * tp) = pk_bf16(a, c2); }
    }
}
__device__ __forceinline__ void ph_hy_untranspose_fast(const P& p, float* t) {
    const bf16_t* yhT = p.Zh + (size_t)2 * NB * 4 * NCH * 16384;
    const int ntt = RB / 64, ntc = 512 / 64;
    for (int tile = blockIdx.x; tile < NB * ntt * ntc; tile += gridDim.x) {
        const int tid = TIDX; const int ct = tile % ntc, tt = (tile / ntc) % ntt, b = tile / (ntc * ntt); const int c0 = ct * 64, tl0 = tt * 64;
        __syncthreads();
#pragma unroll
        for (int i = 0; i < 8; ++i) { const int e = tid + 512 * i, cc = e >> 6, ti = e & 63; t[cc * 65 + ti] = bf2f(yhT[((size_t)b * 512 + c0 + cc) * RB + tl0 + ti]); }
        __syncthreads();
#pragma unroll
        for (int i = 0; i < 4; ++i) { const int e = tid + 512 * i, ti = e >> 5, cp = e & 31;
            *(unsigned*)(p.H + (size_t)bt_row(b, tl0 + ti) * D + 512 + c0 + 2 * cp) = pk_bf16(t[(2 * cp) * 65 + ti], t[(2 * cp + 1) * 65 + ti]); }
    }
}
__device__ __forceinline__ void ph_prep_rope_fast(const P& p) {
    GSTRIDE(idx, (long)R * 2 * 4 * 8) {
        const int pc = idx % 8, h = (idx / 8) % 4, w = (idx / 32) % 2, r = idx / 64;
        bf16_t* base = p.Zr + (size_t)r * 2048 + w * 512 + h * 128 + pc * 8;
        float a[8], c[8]; unpack8(*(const u4v*)base, a); unpack8(*(const u4v*)(base + 64), c);
        const float sc = w ? KSCALE : 1.f;
        if (r < RL) {
            const int t = r % L; const float pos = (pc < 4) ? (float)(t / GW) : (float)(t % GW);
#pragma unroll
            for (int q = 0; q < 8; ++q) { const int pr = pc * 8 + q; const float inv = exp2f(-(float)(pr & 31) * (13.287712379549449f / 32.f));
                float sn, cs; sincosf(pos * inv, &sn, &cs); const float x1 = a[q] * sc, x2 = c[q] * sc; a[q] = x1 * cs - x2 * sn; c[q] = x1 * sn + x2 * cs; }
        } else {
#pragma unroll
            for (int q = 0; q < 8; ++q) { a[q] *= sc; c[q] *= sc; }
        }
        *(u4v*)base = pack8(a); *(u4v*)(base + 64) = pack8(c);
    }
}
__device__ __forceinline__ void ph_mod_fast(const P& p, int l, int which, const float* xl  , const float* xc  ) {
    const int lane = TIDX & 63, gw = blockIdx.x * (NT / 64) + (TIDX >> 6), ngw = gridDim.x * (NT / 64);
    for (int r = gw; r < R; r += ngw) {
        const float* x = r < RL ? xl + (size_t)r * D : xc + (size_t)(r - RL) * D; const float* sh = modv(p, l, r, which * 3 + 0); const float* sc = modv(p, l, r, which * 3 + 1);
#pragma unroll
        for (int i = 0; i < 4; ++i) { const int k = 4 * lane + 256 * i; const f32x4 xv = *(const f32x4*)(x + k), s = *(const f32x4*)(sc + k), hh = *(const f32x4*)(sh + k);
            u2v o; o.x = pk_bf16(xv[0] * (1.f + s[0]) + hh[0], xv[1] * (1.f + s[1]) + hh[1]); o.y = pk_bf16(xv[2] * (1.f + s[2]) + hh[2], xv[3] * (1.f + s[3]) + hh[3]);
            *(u2v*)(p.H + (size_t)r * D + k) = o; }
    }
}

__device__ __forceinline__ void ph_rope_table(const P& p) {
    GSTRIDE(idx, 128 * 32) { const int f = idx & 31, pos = idx >> 5; float sn, cs; sincosf((float)pos * exp2f(-(float)f * (13.287712379549449f / 32.f)), &sn, &cs); p.A2[2 * idx] = cs; p.A2[2 * idx + 1] = sn; }
}
__device__ __forceinline__ void ph_filters(const P& p, unsigned char* smem, int u0, int ustride) {
    float* lds = (float*)smem;
    float* aA = lds;
    float* aB = lds + 64 * 65;
    LAS bf16_t* A3 = (LAS bf16_t*)(smem + 2 * 64 * 65 * 4);
    LAS bf16_t* Ws = A3 + 64 * 72;
    float* mw = (float*)(smem + 2 * 64 * 65 * 4 + 64 * 72 * 2 + 64 * 264 * 2);
    const float mind = logf(1e-2f) / 1.5f, maxd = logf(1e-2f) / 0.3f;
    if (u0 < 0) return;
    __syncthreads();
    for (int e = TIDX; e < 33 * 64; e += NT) mw[e] = p.in[13][e];
    for (int e = TIDX; e < 64 * 64; e += NT) { mw[2112 + e] = p.in[15][e]; mw[2112 + 4096 + e] = p.in[17][e]; }
    if (TIDX < 64) { mw[10304 + TIDX] = p.in[14][TIDX]; mw[10368 + TIDX] = p.in[16][TIDX]; mw[10432 + TIDX] = p.in[18][TIDX]; }
    if (TIDX < 192) mw[10496 + TIDX] = p.in[20][TIDX];
    for (int u = u0; u < RB / 64; u += ustride) {
        const int tid = TIDX; const int p0 = u * 64; const int pos = tid & 63, jg = tid >> 6, lane = tid & 63, w = tid >> 6;
        __syncthreads();
        for (int e = tid; e < 64 * 33; e += NT) { const int ps = e & 63, m = e >> 6; int ln2, i2; hy_pos(p0 + ps, ln2, i2);
            const float w2 = 2.0f * 3.14159265358979323846f * (float)i2 / (float)ln2; float v;
            if (m == 0) v = (float)i2 / (float)(ln2 - 1); else { const int q = (m - 1) & 15; const float f = 1e-4f + (float)q * ((15.f - 1e-4f) / 15.f); v = m <= 16 ? cosf(f * w2) : -sinf(f * w2); }
            aB[ps * 65 + m] = v; }
        __syncthreads();
        {
            float acc[8];
#pragma unroll
            for (int q = 0; q < 8; ++q) acc[q] = mw[10304 + jg * 8 + q];
#pragma unroll 3
            for (int m = 0; m < 33; ++m) { const float a = aB[pos * 65 + m];
#pragma unroll
                for (int q = 0; q < 8; ++q) acc[q] += a * mw[m * 64 + jg * 8 + q]; }
#pragma unroll
            for (int q = 0; q < 8; ++q) aA[pos * 65 + jg * 8 + q] = sinf(mw[10496 + jg * 8 + q] * acc[q]);
        }
        __syncthreads();
#pragma unroll 1
        for (int layer = 0; layer < 2; ++layer) {
            const float* W = mw + 2112 + 4096 * layer; const float* Bv = mw + 10368 + 64 * layer; const float* Fq = mw + 10496 + 64 * (layer + 1);
            float* src = layer ? aB : aA; float* dst = layer ? aA : aB;
            float acc[8];
#pragma unroll
            for (int q = 0; q < 8; ++q) acc[q] = Bv[jg * 8 + q];
#pragma unroll 4
            for (int m = 0; m < 64; ++m) { const float a = src[pos * 65 + m];
#pragma unroll
                for (int q = 0; q < 8; ++q) acc[q] += a * W[m * 64 + jg * 8 + q]; }
#pragma unroll
            for (int q = 0; q < 8; ++q) { const float v = sinf(Fq[jg * 8 + q] * acc[q]); dst[pos * 65 + jg * 8 + q] = v; if (layer == 1) A3[pos * 72 + jg * 8 + q] = f2bf(v); }
            __syncthreads();
        }
        float tpos[4];
#pragma unroll
        for (int mt = 0; mt < 4; ++mt) { int len, i0; hy_pos(p0 + 16 * mt + (lane & 15), len, i0); tpos[mt] = (float)i0 / (float)(len - 1); }
#pragma unroll 1
        for (int cq = 0; cq < 8; ++cq) {
            for (int e = tid; e < 64 * 64; e += NT) { const int k = e >> 6, c4 = e & 63; const f32x4 wv = *(const f32x4*)(p.in[19] + (size_t)k * 2048 + cq * 256 + 4 * c4);
                u2v o; o.x = pk_bf16(wv[0], wv[1]); o.y = pk_bf16(wv[2], wv[3]); *(LAS u2v*)(Ws + k * 264 + 4 * c4) = o; }
            __syncthreads();
            f32x4 acc[4][2];
#pragma unroll
            for (int mt = 0; mt < 4; ++mt)
#pragma unroll
                for (int nt = 0; nt < 2; ++nt) acc[mt][nt] = (f32x4){0.f, 0.f, 0.f, 0.f};
#pragma unroll
            for (int ks = 0; ks < 2; ++ks) { bf16x8 xm[4];
#pragma unroll
                for (int mt = 0; mt < 4; ++mt) xm[mt] = frag_row(A3, 72, 16 * mt, 32 * ks, lane);
#pragma unroll
                for (int nt = 0; nt < 2; ++nt) { const bf16x8 xn = frag_tr(Ws, 264, 32 * ks, 32 * w + 16 * nt, lane);
#pragma unroll
                    for (int mt = 0; mt < 4; ++mt) acc[mt][nt] = MFMA16(xn, xm[mt], acc[mt][nt]); } }
#pragma unroll
            for (int nt = 0; nt < 2; ++nt)
#pragma unroll
                for (int q = 0; q < 4; ++q) { const int col = cq * 256 + 32 * w + 16 * nt + 4 * (lane >> 4) + q; const float delta = fabsf(mind + (float)(col % 512) * ((maxd - mind) / 511.f));
#pragma unroll
                    for (int mt = 0; mt < 4; ++mt) p.FILT[(size_t)col * RB + p0 + 16 * mt + (lane & 15)] = acc[mt][nt][q] * __expf(-tpos[mt] * delta); }
            __syncthreads();
        }
    }
}

__device__ __forceinline__ float wave_sum(float v) {
#pragma unroll
    for (int o = 1; o < 64; o <<= 1) v += __shfl_xor(v, o);
    return v;
}
__device__ __forceinline__ void ph_ada_fast(const P& p, float* lds) {
    float* sv = lds;
    float* red = lds + 3072;
    const int tid = TIDX;
    __syncthreads();
    for (int i = tid; i < 3 * D; i += NT) { const int j = i / D, k = i % D; sv[i] = siluf(j < 2 ? p.in[1][j * D + k] : p.in[3][k]); }
    __syncthreads();
    for (int u = blockIdx.x; u < 2 * 96; u += gridDim.x) {
        const int l = u / 96, n = (u % 96) * 64 + (tid & 63), ks = tid >> 6;
        const float* w = p.in[4] + (size_t)l * D * 6144 + n;
        float a0 = 0.f, a1 = 0.f, a2 = 0.f;
#pragma unroll 8
        for (int k = ks * 128; k < ks * 128 + 128; ++k) { const float wv = w[(size_t)k * 6144]; a0 += sv[k] * wv; a1 += sv[D + k] * wv; a2 += sv[2 * D + k] * wv; }
        red[(ks * 3 + 0) * 64 + (tid & 63)] = a0; red[(ks * 3 + 1) * 64 + (tid & 63)] = a1; red[(ks * 3 + 2) * 64 + (tid & 63)] = a2;
        __syncthreads();
        if (tid < 192) { const int j = tid >> 6, nl = tid & 63; float s = p.in[5][l * 6144 + (u % 96) * 64 + nl];
#pragma unroll
            for (int q = 0; q < 8; ++q) s += red[(q * 3 + j) * 64 + nl];
            p.MOD[(size_t)(l * 3 + j) * 6144 + (u % 96) * 64 + nl] = s; }
        __syncthreads();
    }
}
__device__ __forceinline__ void ph_hyF_fast(const P& p, const float* a3, float* lds) {
    float* at = lds;
    float* wt = lds + 64 * 65;
    const float mind = logf(1e-2f) / 1.5f, maxd = logf(1e-2f) / 0.3f;
    for (int u = blockIdx.x; u < (RB / 64) * 16; u += gridDim.x) {
        const int tid = TIDX; const int ct = u % 16, pt = u / 16, p0 = pt * 64, c0 = ct * 128;
        __syncthreads();
#pragma unroll
        for (int i = 0; i < 8; ++i) { const int e = tid + 512 * i; at[(e >> 6) * 65 + (e & 63)] = a3[(size_t)(p0 + (e >> 6)) * 64 + (e & 63)]; }
#pragma unroll
        for (int i = 0; i < 16; ++i) { const int e = tid + 512 * i; wt[e] = p.in[19][(size_t)(e >> 7) * 2048 + c0 + (e & 127)]; }
        __syncthreads();
        const int pos = tid & 63, cg = tid >> 6;
        float acc[16];
#pragma unroll
        for (int q = 0; q < 16; ++q) acc[q] = 0.f;
#pragma unroll 4
        for (int m = 0; m < 64; ++m) { const float a = at[pos * 65 + m];
#pragma unroll
            for (int q = 0; q < 16; ++q) acc[q] += a * wt[m * 128 + cg * 16 + q]; }
        int len, i0; hy_pos(p0 + pos, len, i0); const float tt = (float)i0 / (float)(len - 1);
#pragma unroll
        for (int q = 0; q < 16; ++q) { const int col = c0 + cg * 16 + q; const float delta = fabsf(mind + (float)(col % 512) * ((maxd - mind) / 511.f));
            p.FILT[(size_t)col * RB + p0 + pos] = acc[q] * expf(-tt * delta); }
    }
}
__device__ __forceinline__ void ph_retScan_fast(const P& p) {
    bf16_t* ST = p.Zh;
    GSTRIDE(idx, (long)2 * NB * 4 * 16384) {
        const int ed = idx % 16384, h = (idx / 16384) % 4, b = (idx / 65536) % NB, dir = idx / (65536 * NB);
        const float dc = expf((dir ? p.in[10] : p.in[9])[h] * 128.f);
        bf16_t* base = ST + st_idx(dir, b, h, 0) + ed;
        float s = 0.f;
#pragma unroll 1
        for (int c0 = 0; c0 < NCH; c0 += 11) {
            float u[11]; int cc[11];
#pragma unroll
            for (int j = 0; j < 11; ++j) { const int q = c0 + j; cc[j] = dir == 0 ? q : (q < 2 ? 1 - q : NCH + 1 - q); u[j] = bf2f(base[(size_t)cc[j] * 16384]); }
#pragma unroll
            for (int j = 0; j < 11; ++j) { base[(size_t)cc[j] * 16384] = f2bf(s); s = dc * s + u[j]; }
        }
    }
}
__device__ __forceinline__ void ph_glaScan_fast(const P& p) {
    const float* BF = p.BG; const float* BB = p.BG + (size_t)R * 512;
    GSTRIDE(idx, (long)2 * NB * 4 * 32768) {
        const int d = idx % 128, ed = idx % 32768, h = (idx / 32768) % 4, b = (idx / 131072) % NB, dir = idx / (131072 * NB);
        bf16_t* base = p.GST + gst_idx(dir, b, h, 0) + ed;
        float s = 0.f;
#pragma unroll 1
        for (int c0 = 0; c0 < NCH; c0 += 11) {
            float u[11], dcv[11]; int cc[11];
#pragma unroll
            for (int j = 0; j < 11; ++j) { const int q = c0 + j; cc[j] = dir == 0 ? q : (q < 2 ? 1 - q : NCH + 1 - q); const int r0 = chunk_row0(b, cc[j]);
                u[j] = bf2f(base[(size_t)cc[j] * 32768]); dcv[j] = dir == 0 ? BF[(size_t)(r0 + 127) * 512 + h * 128 + d] : BB[(size_t)r0 * 512 + h * 128 + d]; }
#pragma unroll
            for (int j = 0; j < 11; ++j) { base[(size_t)cc[j] * 32768] = f2bf(s); s = __expf(dcv[j]) * s + u[j]; }
        }
    }
}
__device__ __forceinline__ void ph_glagates_fast(const P& p, float* lds) {
    float* lr = lds;
    for (int u = blockIdx.x; u < NB * NCH * 2; u += gridDim.x) {
        const int tid = TIDX; const int dir = u % 2, c = (u / 2) % NCH, b = u / (2 * NCH); const int r0 = chunk_row0(b, c);
        __syncthreads();
        for (int e = tid; e < 128 * 16; e += NT) lr[e] = bf2f(p.Z1[(size_t)(r0 + (e >> 4)) * GINP + 3072 + dir * 16 + (e & 15)]);
        __syncthreads();
        const float* gw = (dir ? p.in[26] : p.in[24]); float g[16];
#pragma unroll
        for (int q = 0; q < 16; ++q) g[q] = gw[q * 512 + tid];
        const float gb = (dir ? p.in[27] : p.in[25])[tid];
        float* out = p.BG + ((size_t)dir * R + r0) * 512 + tid;
        float s = 0.f;
#pragma unroll 4
        for (int ii = 0; ii < 128; ++ii) { const int i = dir ? 127 - ii : ii; float acc = gb;
#pragma unroll
            for (int q = 0; q < 16; ++q) acc += lr[i * 16 + q] * g[q];
            s += logsigf(acc) * (1.f / 16.f); out[(size_t)i * 512] = s; }
    }
}
template <int MODE, bool ROUTE> __device__ __forceinline__ void ph_post_fast(const P& p, int l, int which, const bf16_t* Y, int ln, int wn, int nrows, const float* xl, const float* xc, float* lds) {
    const float* lg = p.in[6] + (size_t)(l * 2 + which) * D; const float* lb = p.in[7] + (size_t)(l * 2 + which) * D;
    const int tid = TIDX, lane = tid & 63, gw = blockIdx.x * (NT / 64) + (tid >> 6), ngw = gridDim.x * (NT / 64);
    int* lcnt = (int*)(lds + D * NE);
    if (ROUTE) { __syncthreads(); for (int e = tid; e < D * NE; e += NT) lds[(e & 15) * D + (e >> 4)] = p.in[29][e]; if (tid < 32) lcnt[tid] = 0; __syncthreads(); }
    int toff[16];
    if (MODE == 1) { int s = 0;
#pragma unroll
        for (int e = 0; e < 16; ++e) { toff[e] = s; s += (p.CNT[l * 16 + e] + 255) >> 8; } }
    f32x4 cg_[4], clg[4], clb[4], csc[4], csh[4]; int cseg = -1;
#pragma unroll
    for (int i = 0; i < 4; ++i) { clg[i] = *(const f32x4*)(lg + 4 * lane + 256 * i); clb[i] = *(const f32x4*)(lb + 4 * lane + 256 * i); }
    for (int r = gw; r < nrows; r += ngw) {
        const float* x = r < RL ? xl + (size_t)r * D : xc + (size_t)(r - RL) * D; float* xo = xrow(p, r);
        if (seg_of(r) != cseg) { cseg = seg_of(r);
#pragma unroll
            for (int i = 0; i < 4; ++i) { const int k = 4 * lane + 256 * i; cg_[i] = *(const f32x4*)(modv(p, l, r, which * 3 + 2) + k);
                if (ln >= 0) { csc[i] = *(const f32x4*)(modv(p, ln, r, wn * 3 + 1) + k); csh[i] = *(const f32x4*)(modv(p, ln, r, wn * 3 + 0) + k); } } }
        const bf16_t *y0, *y1 = nullptr;
        if (MODE == 0) y0 = Y + (size_t)r * D;
        else { int sr[2];
#pragma unroll
            for (int k = 0; k < 2; ++k) { const int e = p.RE[r * 2 + k]; int to = 0;
#pragma unroll
                for (int q = 0; q < 16; ++q) to = (q == e) ? toff[q] : to;
                sr[k] = to * 256 + p.RPOS[r * 2 + k]; }
            y0 = p.slots + (size_t)sr[0] * D; y1 = p.slots + (size_t)sr[1] * D; }
        f32x4 v[4]; float s = 0.f;
#pragma unroll
        for (int i = 0; i < 4; ++i) { const int k = 4 * lane + 256 * i; const f32x4 xv = *(const f32x4*)(x + k), gv = cg_[i];
            const u2v yu = *(const u2v*)(y0 + k); f32x4 yy = {__uint_as_float(yu.x << 16), __uint_as_float(yu.x & 0xffff0000u), __uint_as_float(yu.y << 16), __uint_as_float(yu.y & 0xffff0000u)};
            if (MODE == 1) { const u2v y2 = *(const u2v*)(y1 + k); yy += (f32x4){__uint_as_float(y2.x << 16), __uint_as_float(y2.x & 0xffff0000u), __uint_as_float(y2.y << 16), __uint_as_float(y2.y & 0xffff0000u)}; }
            v[i] = xv * ALPHA + gv * yy; s += (v[i][0] + v[i][1]) + (v[i][2] + v[i][3]); }
        const float mu = wave_sum(s) * (1.f / D); float q2 = 0.f;
#pragma unroll
        for (int i = 0; i < 4; ++i) { v[i] = v[i] - mu; q2 += (v[i][0] * v[i][0] + v[i][1] * v[i][1]) + (v[i][2] * v[i][2] + v[i][3] * v[i][3]); }
        const float rs = 1.f / sqrtf(wave_sum(q2) * (1.f / D) + LN_EPS);
        f32x4 hk[4];
#pragma unroll
        for (int i = 0; i < 4; ++i) { const int k = 4 * lane + 256 * i; const f32x4 xn = v[i] * rs * clg[i] + clb[i];
            *(f32x4*)(xo + k) = xn;
            if (ln >= 0) { const f32x4 h2 = xn * (csc[i] + 1.f) + csh[i];
                u2v o; o.x = pk_bf16(h2[0], h2[1]); o.y = pk_bf16(h2[2], h2[3]); *(u2v*)(p.H + (size_t)r * D + k) = o;
                if (ROUTE) hk[i] = h2; } }
        if (ROUTE) {
            float pl[16];
#pragma unroll
            for (int e = 0; e < 16; ++e) { const float* wr = lds + e * D + 4 * lane; float a = 0.f;
#pragma unroll
                for (int i = 0; i < 4; ++i) { const f32x4 wv = *(const f32x4*)(wr + 256 * i); a += (hk[i][0] * wv[0] + hk[i][1] * wv[1]) + (hk[i][2] * wv[2] + hk[i][3] * wv[3]); }
                pl[e] = a; }
            float r8[8], r4[4], r2[2];
            { const bool up = (lane & 32) != 0;
#pragma unroll
              for (int q = 0; q < 8; ++q) { const float keep = up ? pl[8 + q] : pl[q], send = up ? pl[q] : pl[8 + q]; r8[q] = keep + __shfl_xor(send, 32); } }
            { const bool up = (lane & 16) != 0;
#pragma unroll
              for (int q = 0; q < 4; ++q) { const float keep = up ? r8[4 + q] : r8[q], send = up ? r8[q] : r8[4 + q]; r4[q] = keep + __shfl_xor(send, 16); } }
            { const bool up = (lane & 8) != 0;
#pragma unroll
              for (int q = 0; q < 2; ++q) { const float keep = up ? r4[2 + q] : r4[q], send = up ? r4[q] : r4[2 + q]; r2[q] = keep + __shfl_xor(send, 8); } }
            float r1;
            { const bool up = (lane & 4) != 0; const float keep = up ? r2[1] : r2[0], send = up ? r2[0] : r2[1]; r1 = keep + __shfl_xor(send, 4); }
            r1 += __shfl_xor(r1, 2); r1 += __shfl_xor(r1, 1);
            const float sgm = sigmf(r1);
            int best = 0, i1 = 0, i2 = 0; float bs = -1e30f, a1 = 0.f, a2 = 0.f;
#pragma unroll
            for (int g = 0; g < NG; ++g) {
                float sg[4], sel[4];
#pragma unroll
                for (int q = 0; q < 4; ++q) { const int e = g * EPG + q; const int src = ((e >> 3) & 1) * 32 + ((e >> 2) & 1) * 16 + ((e >> 1) & 1) * 8 + (e & 1) * 4;
                    sg[q] = __int_as_float(__builtin_amdgcn_readlane(__float_as_int(sgm), src)); sel[q] = sg[q] + p.in[30][e]; }
                int j1 = 0; float v1 = sel[0];
#pragma unroll
                for (int q = 1; q < 4; ++q) if (sel[q] > v1) { v1 = sel[q]; j1 = q; }
                int j2 = -1; float v2 = -1e30f;
#pragma unroll
                for (int q = 0; q < 4; ++q) if (q != j1 && sel[q] > v2) { v2 = sel[q]; j2 = q; }
                if (v1 + v2 > bs) { bs = v1 + v2; best = g; i1 = j1; i2 = j2; a1 = 0.f; a2 = 0.f;
#pragma unroll
                    for (int q = 0; q < 4; ++q) { a1 = (q == j1) ? sg[q] : a1; a2 = (q == j2) ? sg[q] : a2; } }
            }
            if (lane == 0) { const int e1 = best * EPG + i1, e2 = best * EPG + i2;
                p.RE[r * 2] = e1; p.RE[r * 2 + 1] = e2; p.RWt[r * 2] = a1 / (a1 + a2); p.RWt[r * 2 + 1] = a2 / (a1 + a2);
                p.RPOS[r * 2] = atomicAdd(&lcnt[e1], 1); p.RPOS[r * 2 + 1] = atomicAdd(&lcnt[e2], 1); }
        }
    }
    if (ROUTE) {
        __syncthreads();
        if (tid < 16) lcnt[16 + tid] = atomicAdd(&p.CNT[l * 16 + tid], lcnt[tid]);
        __syncthreads();
        for (int r = gw + lane * ngw; r < nrows; r += 64 * ngw) {
#pragma unroll
            for (int k = 0; k < 2; ++k) p.RPOS[r * 2 + k] += lcnt[16 + p.RE[r * 2 + k]];
        }
    }
}

constexpr int N_STEPS = 34;
#define PG8_ALIGN true
#define PG8_SP2 true
template <class Epi> __device__ __forceinline__ void dense_gemm(LAS unsigned char* lds, const bf16_t* A, const bf16_t* Bt, int M, int N, int K, const Epi& E) {
    pg8::Gemm g{A, Bt, M, N, K}; pg8::StaticOrder S; S.init(M, N, (int)gridDim.x, (int)blockIdx.x);
    pg8::gemm_phase<Epi, pg8::StaticOrder, PG8_ALIGN, PG8_SP2>(lds, g, S, E);
}
__device__ __forceinline__ void moe_gemms(const P& p, LAS unsigned char* lds, int l, int which) {
    pg8::MoeOrder S; S.init(p.CNT + l * 16, (int)gridDim.x, (int)blockIdx.x);
    if (which == 0) { pg8::Gemm g{p.Hs, p.Wgu, 0, 0, 1024}; pg8::EpiSwiGLU E{p.he}; pg8::gemm_phase<pg8::EpiSwiGLU, pg8::MoeOrder, PG8_ALIGN, PG8_SP2>(lds, g, S, E); }
    else { pg8::Gemm g{p.he, p.Wd, 0, 0, 512}; pg8::EpiRowScale E{p.slots, p.WS}; pg8::gemm_phase<pg8::EpiRowScale, pg8::MoeOrder, PG8_ALIGN, PG8_SP2>(lds, g, S, E); }
}
__device__ __forceinline__ void run_step(const P& p, int step, unsigned char* smem) {
    LAS unsigned char* lds = (LAS unsigned char*)smem; float* fl = (float*)smem;
    float* conv = (float*)p.H;
    switch (step) {
        case 0: ph_ada_fast(p, fl); ph_rope_table(p); ph_wconv_fast(p, fl); ph_wconv_moe_fast(p, 0, fl); break;
        case 1: ph_mod_fast(p, 0, 0, p.in[0], p.in[2]); break;
        case 2: { pg8::EpiInL0 E{p.Zr, p.hyT, p.A2, RL, L, CTX, RB}; dense_gemm(lds, p.H, p.Win0, R, ABIN, D, E); }
                 if (gridDim.x == 256) ph_filters(p, smem, (int)blockIdx.x - 156, 100); else ph_filters(p, smem, (int)blockIdx.x, (int)gridDim.x); break;
        case 3: break;
        case 4: ph_retU_mfma(p, smem); ph_hyena_fft(p, smem); break;
        case 5: ph_retScan_fast(p); break;
        case 6: break;
        case 7: break;
        case 8: break;
        case 9: ph_retO_mfma(p, smem); ph_hy_untranspose_fast(p, fl); break;
        case 10: ph_hy_untranspose_fast(p, fl); break;
        case 11: { pg8::EpiSplit E{p.Zr, 1024, p.Zr, 1024, 1 << 30}; dense_gemm(lds, p.H, p.Wout0, R, D, D, E); } break;
        case 12: ph_post_fast<0, true>(p, 0, 0, p.Zr, 0, 1, R, p.in[0], p.in[2], fl); break;
        case 13: break;
        case 14: break;
        case 15: ph_permute(p, 0, R); break;
        case 16: moe_gemms(p, lds, 0, 0); break;
        case 17: moe_gemms(p, lds, 0, 1); break;
        case 18: ph_post_fast<1, false>(p, 0, 1, nullptr, 1, 0, R, p.out, p.Xc, fl); break;
        case 19: { pg8::EpiSplit E{p.Z1, GINP, p.Z1, GINP, 1 << 30}; dense_gemm(lds, p.H, p.Win1, R, GINP, D, E); } ph_wconv_moe_fast(p, 1, fl); break;
        case 20: break;
        case 21: break;
        case 22: ph_glaU_mfma(p, smem); break;
        case 23: ph_glaScan_fast(p); break;
        case 24: ph_glaO_mfma(p, smem); break;
        case 25: break;
        case 26: { pg8::EpiSplit E{p.Zr, 1024, p.Zr, 1024, 1 << 30}; dense_gemm(lds, p.H, p.Wout1, RL, D, D, E); } break;
        case 27: ph_post_fast<0, true>(p, 1, 0, p.Zr, 1, 1, RL, p.out, p.Xc, fl); break;
        case 28: break;
        case 29: break;
        case 30: ph_permute(p, 1, RL); break;
        case 31: moe_gemms(p, lds, 1, 0); break;
        case 32: moe_gemms(p, lds, 1, 1); break;
        case 33: ph_post_fast<1, false>(p, 1, 1, nullptr, -1, 0, RL, p.out, p.Xc, fl); break;
    }
}
__global__ void __launch_bounds__(NT, 2) k_all(P p) {
    extern __shared__ __attribute__((aligned(16))) unsigned char smem[];
    cg::grid_group grid = cg::this_grid();
    volatile LAS unsigned* bst = (volatile LAS unsigned*)((LAS unsigned char*)smem + LDS_BYTES - 64);
    if (threadIdx.x < 2) bst[threadIdx.x] = 0u;
    __syncthreads();
    const XcdBarrier bar = xcd_barrier_post(p.BAR, bst);
#define STEP(n) run_step(p, n, smem); xcd_barrier(bar);
#define STEP_CG(n) run_step(p, n, smem); asm volatile("s_waitcnt vmcnt(0)" ::: "memory"); grid.sync();
    STEP_CG(0) STEP(1) STEP(2) STEP(4) STEP(5) STEP(9) STEP(11) STEP(12) STEP(15) STEP(16)
    STEP(17) STEP(18) STEP(19) STEP(22) STEP(23) STEP(24) STEP(26) STEP(27) STEP(30) STEP(31) STEP(32) run_step(p, 33, smem);
#undef STEP
#undef STEP_CG
}

extern "C" void kernel_launch(void* const* d_in, const int* in_sizes, int n_in, void* d_out, int out_size, void* d_ws, size_t ws_size, hipStream_t stream) {
    P p{};
    for (int i = 0; i < 34; ++i) p.in[i] = (const float*)d_in[i];
    p.out = (float*)d_out;
    unsigned char* w = (unsigned char*)d_ws; size_t off = 0;
    auto take = [&](size_t bytes) { unsigned char* r = w + off; off += (bytes + 255) & ~(size_t)255; return r; };
    p.NORM = (float*)take(2 * 2048 * 4); p.CNT = (int*)take(2 * 16 * 4); p.BAR = (unsigned*)take(XCD_BAR_WORDS * 4);
    const size_t ctl_bytes = off;
    p.Win1 = (bf16_t*)take((size_t)GINP * D * 2); p.Wout1 = (bf16_t*)take((size_t)D * D * 2);
    p.Wgu = (bf16_t*)take((size_t)NE * 1024 * 1024 * 2); p.Wd = (bf16_t*)take((size_t)NE * 1024 * 512 * 2);
    p.Xc = (float*)take((size_t)RCX * D * 4); p.MOD = (float*)take(2 * 3 * 6144 * 4);
    p.RS = (float*)take((size_t)R * NE * 4); p.RE = (int*)take((size_t)R * 2 * 4); p.RPOS = (int*)take((size_t)R * 2 * 4); p.RWt = (float*)take((size_t)R * 2 * 4);
    p.WS = (float*)take((size_t)MOE_ROWS * 4);
    const size_t big = off;
    p.H = (bf16_t*)take((size_t)R * D * 2);
    p.Zr = (bf16_t*)take((size_t)R * 2048 * 2);
    p.Zh = (bf16_t*)take((size_t)R * 1536 * 2);
    p.hyT = (bf16_t*)take((size_t)NB * 3 * 512 * RB * 2);
    p.FILT = (float*)take((size_t)2048 * RB * 4);
    p.Win0 = (bf16_t*)take((size_t)ABIN * D * 2); p.Wout0 = (bf16_t*)take((size_t)D * D * 2);
    p.A1 = (float*)take((size_t)RB * 64 * 4); p.A2 = (float*)take((size_t)RB * 64 * 4);
    const size_t total = off;
    off = big + (((size_t)R * D * 2 + 255) & ~(size_t)255);
    p.Hs = (bf16_t*)take((size_t)MOE_ROWS * D * 2); p.he = (bf16_t*)take((size_t)MOE_ROWS * EH * 2); p.slots = (bf16_t*)take((size_t)MOE_ROWS * D * 2);
    const size_t moe_end = off;
    off = big + (((size_t)R * D * 2 + 255) & ~(size_t)255);
    p.Z1 = (bf16_t*)take((size_t)R * GINP * 2); p.BG = (float*)take((size_t)2 * R * 512 * 4); p.GST = (bf16_t*)take((size_t)2 * NB * 4 * NCH * 32768 * 2);
    const size_t l1_end = off;
    if (total > ws_size || moe_end > total || l1_end > total || n_in != 34 || out_size != RL * D) {
        fprintf(stderr, "kernel_launch: bad sizes (need %zu ws bytes, have %zu; moe_end %zu l1_end %zu)\n", total, ws_size, moe_end, l1_end); return; }
    static int grid = 0;
    if (!grid) {
        int dev = 0, cus = 0, per = 0; hipGetDevice(&dev); hipDeviceGetAttribute(&cus, hipDeviceAttributeMultiprocessorCount, dev);
        hipFuncSetAttribute((const void*)k_all, hipFuncAttributeMaxDynamicSharedMemorySize, LDS_BYTES);
        hipOccupancyMaxActiveBlocksPerMultiprocessor(&per, k_all, NT, LDS_BYTES);
        if (per < 1) { fprintf(stderr, "kernel_launch: occupancy query says %d blocks per CU\n", per); per = 1; }
        grid = cus < 256 ? cus : 256;
    }
    hipMemsetAsync(d_ws, 0, ctl_bytes, stream);
    void* args[] = {&p};
    hipError_t e = hipLaunchCooperativeKernel((void*)k_all, dim3(grid), dim3(NT), args, LDS_BYTES, stream);
    if (e != hipSuccess) fprintf(stderr, "coop launch failed: %s (grid %d)\n", hipGetErrorString(e), grid);
}
```

```cpp
#include <hip/hip_runtime.h>
#include <hip/hip_cooperative_groups.h>
#include <cstdio>
#include <cstdint>
namespace cg = cooperative_groups;


namespace pg8 {
#define PG8_LAS __attribute__((address_space(3)))
typedef unsigned short bf16_t;
typedef short bf16x8 __attribute__((ext_vector_type(8)));
typedef float f32x4 __attribute__((ext_vector_type(4)));
typedef unsigned u32x4 __attribute__((ext_vector_type(4)));
constexpr int BM = 256, BK = 64, HALF = 128, HTB = HALF * BK * 2  , STAGE_BYTES = 8 * HTB, NXCD = 8, WGM = 8;

__host__ __device__ __forceinline__ int lds_byte(int r, int c) { const int st = (r >> 4) * 2 + (c >> 5), rr = r & 15, cc = c & 31, ob = rr * 64 + cc * 2; return st * 1024 + (ob ^ (((ob >> 9) & 1) << 5)); }
__host__ __device__ __forceinline__ void stage_rc(int b, int& R, int& C) { const int st = b / 1024, sb = b % 1024, swz = sb ^ (((sb >> 9) & 1) << 5); R = (st >> 1) * 16 + swz / 64; C = (st & 1) * 32 + (swz % 64) / 2; }
__host__ __device__ __forceinline__ int perm32(int rho) { const int n = rho >> 4, i = rho & 15; return 8 * (i >> 2) + 4 * n + (i & 3); }

struct Unit { int pm, pn; };
struct Gemm { const bf16_t* A; const bf16_t* Bt; int M, N, K; };

struct StaticOrder {
    int nM, nN, nwg, G, c;
    __host__ __device__ void init(int M, int N, int G_, int c_) { nM = M / BM; nN = N / BM; nwg = nM * nN; G = G_; c = c_; }
    __host__ __device__ bool next(int i, Unit& u) const {
        const long L = (long)i * G + c; if (L >= nwg) return false;
        int wgid = (int)L; { const int q = nwg / NXCD, r = nwg % NXCD, xcd = wgid % NXCD, off = wgid / NXCD; wgid = (xcd < r ? xcd * (q + 1) : r * (q + 1) + (xcd - r) * q) + off; }
        const int nig = WGM * nN, gid = wgid / nig, fm = gid * WGM, gsz = (nM - fm) < WGM ? (nM - fm) : WGM;
        u.pm = fm + ((wgid % nig) % gsz); u.pn = (wgid % nig) / gsz; return true;
    }
    __device__ __forceinline__ void a_ready(const Unit&) const {}
    __device__ __forceinline__ void done(const Unit&) const {}
};


__device__ __forceinline__ unsigned cvt_pk_bf16(float lo, float hi) { unsigned r; asm volatile("v_cvt_pk_bf16_f32 %0, %1, %2" : "=v"(r) : "v"(lo), "v"(hi)); return r; }

template <class Epi, class Sched, bool ALIGN_EPI = false, bool SP2 = false>
__device__ __forceinline__ void gemm_phase(PG8_LAS unsigned char* lds, const Gemm g, const Sched& S, const Epi& E) {
    int tid_l = threadIdx.x; asm volatile("" : "+v"(tid_l)); const int tid = tid_l, wid = __builtin_amdgcn_readfirstlane(tid >> 6), lane = tid & 63, wr = wid >> 2, wc = wid & 3, fr = lane & 15, fq = lane >> 4;
    const int K = g.K, nt = K / BK;
    unsigned voffA[2], voffB[2];
#pragma unroll
    for (int i = 0; i < 2; ++i) { int R, C; stage_rc(tid * 16 + i * 8192, R, C); const int Rb = Epi::PERM ? ((R & ~31) + perm32(R & 31)) : R;
        voffA[i] = (unsigned)(R * K + C) * 2u; voffB[i] = (unsigned)(Rb * K + C) * 2u; }
    const size_t kstep = (size_t)(BK * 2);
    const size_t hstep = (size_t)HALF * K * 2;
    const size_t tstep = 2 * hstep;
    const unsigned ldsw = (unsigned)wid * 1024u;
    const int aoff = lds_byte(wr * 64 + fr, fq * 8), boff = lds_byte(wc * 32 + fr, fq * 8);
#define PG8_SA(b, h) (((b) * 2 + (h)) * HTB)
#define PG8_SB(b, h) ((4 + (b) * 2 + (h)) * HTB)
#define PG8_STAGE(bufoff, gbase, voff) do { _Pragma("unroll") for (int _i = 0; _i < 2; ++_i) \
        __builtin_amdgcn_global_load_lds((const unsigned*)((const char*)(gbase) + (voff)[_i]), (PG8_LAS unsigned*)(lds + (bufoff) + ldsw + _i * 8192), 16, 0, 0); } while (0)
#define PG8_LDA(dst, b, h) do { _Pragma("unroll") for (int m = 0; m < 4; ++m) _Pragma("unroll") for (int k = 0; k < 2; ++k) dst[m][k] = *(const PG8_LAS bf16x8*)(lds + PG8_SA(b, h) + aoff + m * 2048 + k * 1024); } while (0)
#define PG8_LDB(dst, b, h) do { _Pragma("unroll") for (int n = 0; n < 2; ++n) _Pragma("unroll") for (int k = 0; k < 2; ++k) dst[n][k] = *(const PG8_LAS bf16x8*)(lds + PG8_SB(b, h) + boff + n * 2048 + k * 1024); } while (0)
#define PG8_MMA(ai, bj, At, Bt) do { __builtin_amdgcn_s_setprio(1); _Pragma("unroll") for (int m = 0; m < 4; ++m) _Pragma("unroll") for (int n = 0; n < 2; ++n) _Pragma("unroll") for (int k = 0; k < 2; ++k) \
        acc[ai][bj][m][n] = __builtin_amdgcn_mfma_f32_16x16x32_bf16(Bt[n][k], At[m][k], acc[ai][bj][m][n], 0, 0, 0); __builtin_amdgcn_s_setprio(0); } while (0)
#define PG8_WAIT_V(n) asm volatile("s_waitcnt vmcnt(" #n ")" ::: "memory")
#define PG8_WAIT_L(n) asm volatile("s_waitcnt lgkmcnt(" #n ")" ::: "memory")
#define PG8_BAR __builtin_amdgcn_s_barrier()
#define PG8_SCHED __builtin_amdgcn_sched_barrier(0)
    Unit cur, nxt; int ui = 0;
    if (!S.next(0, cur)) return;
    f32x4 acc[2][2][4][2];
#pragma unroll
    for (int a = 0; a < 2; ++a)
#pragma unroll
        for (int b = 0; b < 2; ++b)
#pragma unroll
            for (int m = 0; m < 4; ++m)
#pragma unroll
                for (int n = 0; n < 2; ++n) acc[a][b][m][n] = (f32x4){0.f, 0.f, 0.f, 0.f};
    bf16x8 At[4][2], B0[2][2], B1[2][2];
    const char* cA = (const char*)g.A + (size_t)cur.pm * tstep; const char* cB = (const char*)g.Bt + (size_t)cur.pn * tstep;
    S.a_ready(cur);
    if constexpr (SP2) {
        PG8_STAGE(PG8_SB(0, 0), cB, voffB); PG8_STAGE(PG8_SB(0, 1), cB + hstep, voffB); PG8_STAGE(PG8_SA(0, 0), cA, voffA); PG8_STAGE(PG8_SA(0, 1), cA + hstep, voffA);
        if (wr == 1) PG8_BAR;
        PG8_WAIT_V(2); PG8_BAR;
        PG8_STAGE(PG8_SB(1, 0), cB + kstep, voffB); PG8_STAGE(PG8_SA(1, 0), cA + kstep, voffA); PG8_STAGE(PG8_SB(1, 1), cB + hstep + kstep, voffB);
        PG8_WAIT_V(6); PG8_BAR;
    } else {
        PG8_STAGE(PG8_SB(0, 0), cB, voffB); PG8_STAGE(PG8_SA(0, 0), cA, voffA); PG8_STAGE(PG8_SB(0, 1), cB + hstep, voffB); PG8_STAGE(PG8_SA(0, 1), cA + hstep, voffA);
        if (wr == 1) PG8_BAR;
        PG8_WAIT_V(4); PG8_BAR;
        PG8_STAGE(PG8_SB(1, 0), cB + kstep, voffB); PG8_STAGE(PG8_SA(1, 0), cA + kstep, voffA); PG8_STAGE(PG8_SB(1, 1), cB + hstep + kstep, voffB);
        PG8_WAIT_V(6); PG8_BAR;
    }
    for (;;) {
        const bool has_next = S.next(ui + 1, nxt);
        const char* nA = has_next ? (const char*)g.A + (size_t)nxt.pm * tstep : cA; const char* nB = has_next ? (const char*)g.Bt + (size_t)nxt.pn * tstep : cB;
        for (int t = 0; t < nt; t += 2) {
            const bool last = (t == nt - 2);
            const char* a1 = cA + (size_t)(t + 1) * kstep;
            const char* a2 = last ? nA : cA + (size_t)(t + 2) * kstep; const char* b2 = last ? nB : cB + (size_t)(t + 2) * kstep;
            const char* a3 = a2 + kstep; const char* b3 = b2 + kstep;
            if (last && has_next) S.a_ready(nxt);
            if constexpr (SP2) {
            PG8_LDB(B0, 0, 0); PG8_LDB(B1, 0, 1); PG8_SCHED; PG8_LDA(At, 0, 0); PG8_STAGE(PG8_SA(1, 1), a1 + hstep, voffA);
            PG8_WAIT_V(8); PG8_WAIT_L(0); PG8_BAR; PG8_MMA(0, 0, At, B0); PG8_MMA(0, 1, At, B1); PG8_BAR; PG8_SCHED;
            PG8_LDA(At, 0, 1); PG8_STAGE(PG8_SB(0, 0), b2, voffB); PG8_STAGE(PG8_SB(0, 1), b2 + hstep, voffB); PG8_STAGE(PG8_SA(0, 0), a2, voffA);
            PG8_WAIT_V(8); PG8_WAIT_L(0); PG8_BAR; PG8_MMA(1, 0, At, B0); PG8_MMA(1, 1, At, B1); PG8_BAR; PG8_SCHED;
            PG8_LDB(B0, 1, 0); PG8_LDB(B1, 1, 1); PG8_SCHED; PG8_LDA(At, 1, 0); PG8_STAGE(PG8_SA(0, 1), a2 + hstep, voffA);
            PG8_WAIT_V(8); PG8_WAIT_L(0); PG8_BAR; PG8_MMA(0, 0, At, B0); PG8_MMA(0, 1, At, B1); PG8_BAR; PG8_SCHED;
            PG8_LDA(At, 1, 1); PG8_STAGE(PG8_SB(1, 0), b3, voffB); PG8_STAGE(PG8_SB(1, 1), b3 + hstep, voffB); PG8_STAGE(PG8_SA(1, 0), a3, voffA);
            PG8_WAIT_V(8); PG8_WAIT_L(0); PG8_BAR; PG8_MMA(1, 0, At, B0); PG8_MMA(1, 1, At, B1); PG8_BAR; PG8_SCHED;
            } else {
            PG8_LDB(B0, 0, 0); PG8_SCHED; PG8_LDA(At, 0, 0); PG8_STAGE(PG8_SA(1, 1), a1 + hstep, voffA);
            PG8_WAIT_L(8); PG8_BAR; PG8_WAIT_L(0); PG8_MMA(0, 0, At, B0); PG8_BAR; PG8_SCHED;
            PG8_LDB(B1, 0, 1); PG8_STAGE(PG8_SB(0, 0), b2, voffB);
            PG8_BAR; PG8_WAIT_L(0); PG8_MMA(0, 1, At, B1); PG8_BAR;
            PG8_LDA(At, 0, 1); PG8_STAGE(PG8_SA(0, 0), a2, voffA);
            PG8_BAR; PG8_WAIT_L(0); PG8_MMA(1, 0, At, B0); PG8_BAR; PG8_SCHED;
            PG8_STAGE(PG8_SB(0, 1), b2 + hstep, voffB);
            PG8_WAIT_V(6); PG8_BAR; PG8_MMA(1, 1, At, B1); PG8_BAR;
            PG8_LDB(B0, 1, 0); PG8_SCHED; PG8_LDA(At, 1, 0); PG8_STAGE(PG8_SA(0, 1), a2 + hstep, voffA);
            PG8_WAIT_L(8); PG8_BAR; PG8_WAIT_L(0); PG8_MMA(0, 0, At, B0); PG8_BAR; PG8_SCHED;
            PG8_LDB(B1, 1, 1); PG8_STAGE(PG8_SB(1, 0), b3, voffB);
            PG8_BAR; PG8_WAIT_L(0); PG8_MMA(0, 1, At, B1); PG8_BAR;
            PG8_LDA(At, 1, 1); PG8_STAGE(PG8_SA(1, 0), a3, voffA);
            PG8_BAR; PG8_WAIT_L(0); PG8_MMA(1, 0, At, B0); PG8_BAR; PG8_SCHED;
            PG8_STAGE(PG8_SB(1, 1), b3 + hstep, voffB);
            PG8_WAIT_V(6); PG8_BAR; PG8_MMA(1, 1, At, B1); PG8_BAR;
            }
        }
        if constexpr (ALIGN_EPI) { if (wr == 0) PG8_BAR; }
        if constexpr (!Epi::AFTER_DRAIN) { E(acc, cur, wr, wc, fr, fq); S.done(cur); }
        if (!has_next) break;
#pragma unroll
        for (int a = 0; a < 2; ++a)
#pragma unroll
            for (int b = 0; b < 2; ++b)
#pragma unroll
                for (int m = 0; m < 4; ++m)
#pragma unroll
                    for (int n = 0; n < 2; ++n) acc[a][b][m][n] = (f32x4){0.f, 0.f, 0.f, 0.f};
        cur = nxt; cA = nA; cB = nB; ++ui;
        if constexpr (ALIGN_EPI) { if (wr == 1) PG8_BAR; }
    }
    PG8_WAIT_V(0);
    if constexpr (!ALIGN_EPI) { if (wr == 0) PG8_BAR; }
    PG8_BAR;
    if constexpr (Epi::AFTER_DRAIN) { E.fused(acc, cur, wr, wc, fr, fq, lds, wid, lane); S.done(cur); }
#undef PG8_SA
#undef PG8_SB
#undef PG8_STAGE
#undef PG8_LDA
#undef PG8_LDB
#undef PG8_MMA
#undef PG8_WAIT_V
#undef PG8_WAIT_L
#undef PG8_BAR
#undef PG8_SCHED
}
}

typedef float f2v_t __attribute__((ext_vector_type(2)));
typedef __bf16 b2v_t __attribute__((ext_vector_type(2)));
__device__ __forceinline__ unsigned pk_bf16(float lo, float hi) { const f2v_t f = {lo, hi}; const b2v_t b = __builtin_convertvector(f, b2v_t); return __builtin_bit_cast(unsigned, b); }
namespace pg8 {
typedef unsigned u32x2 __attribute__((ext_vector_type(2)));
struct EpiSplit {
    static constexpr bool PERM = true, AFTER_DRAIN = false;
    bf16_t* O0; int ld0; bf16_t* O1; int ld1; int split_col;
    __device__ __forceinline__ void operator()(const f32x4 (&acc)[2][2][4][2], const Unit& u, int wr, int wc, int fr, int fq) const {
        const int row0 = u.pm * BM + wr * 64 + fr; int colt = u.pn * BM; bf16_t* base = O0; int ldc = ld0;
        if (colt >= split_col) { base = O1; ldc = ld1; colt -= split_col; }
        const int col0 = colt + wc * 32 + 8 * fq;
#pragma unroll
        for (int ai = 0; ai < 2; ++ai)
#pragma unroll
            for (int m = 0; m < 4; ++m) { bf16_t* rowp = base + (size_t)(row0 + ai * HALF + m * 16) * ldc + col0;
#pragma unroll
                for (int bj = 0; bj < 2; ++bj) { const f32x4 v0 = acc[ai][bj][m][0], v1 = acc[ai][bj][m][1];
                    u32x4 w; w.x = ::pk_bf16(v0[0], v0[1]); w.y = ::pk_bf16(v0[2], v0[3]); w.z = ::pk_bf16(v1[0], v1[1]); w.w = ::pk_bf16(v1[2], v1[3]);
                    *(u32x4*)(rowp + bj * HALF) = w; } }
    }
};
struct EpiInL0 {
    static constexpr bool PERM = true, AFTER_DRAIN = false;
    bf16_t* Zr; bf16_t* hyT; const float* tab; int RLv, Lv, CTXv, RBv;
    __device__ __forceinline__ void operator()(const f32x4 (&acc)[2][2][4][2], const Unit& u, int wr, int wc, int fr, int fq) const {
        const int rowbase = u.pm * BM, colt = u.pn * BM;
        if (colt < 2048) {
            const int col0 = colt + wc * 32 + 8 * fq; const bool rot = colt < 1024; const int pp0 = wc * 16 + 4 * fq;
#pragma unroll
            for (int ai = 0; ai < 2; ++ai)
#pragma unroll
                for (int m = 0; m < 4; ++m) { const int row = rowbase + wr * 64 + fr + ai * HALF + m * 16; bf16_t* rowp = Zr + (size_t)row * 2048 + col0;
                    const int t = row % Lv; const int prow = t >> 6, pcol = t & 63; const bool dorot = rot && row < RLv;
#pragma unroll
                    for (int bj = 0; bj < 2; ++bj) { f32x4 v0 = acc[ai][bj][m][0], v1 = acc[ai][bj][m][1];
                        if (dorot) {
#pragma unroll
                            for (int pr = 0; pr < 4; ++pr) { const int pp = pp0 + pr; const int pos = pp < 32 ? prow : pcol; const float cs = tab[(pos * 32 + (pp & 31)) * 2], sn = tab[(pos * 32 + (pp & 31)) * 2 + 1];
                                if (pr < 2) { const float x1 = v0[2 * pr], x2 = v0[2 * pr + 1]; v0[2 * pr] = x1 * cs - x2 * sn; v0[2 * pr + 1] = x1 * sn + x2 * cs; }
                                else { const float x1 = v1[2 * pr - 4], x2 = v1[2 * pr - 3]; v1[2 * pr - 4] = x1 * cs - x2 * sn; v1[2 * pr - 3] = x1 * sn + x2 * cs; } } }
                        u32x4 w; w.x = ::pk_bf16(v0[0], v0[1]); w.y = ::pk_bf16(v0[2], v0[3]); w.z = ::pk_bf16(v1[0], v1[1]); w.w = ::pk_bf16(v1[2], v1[3]);
                        *(u32x4*)(rowp + bj * HALF) = w; } }
        } else {
            const int hc0 = colt - 2048 + wc * 32 + 8 * fq;
            int b, tlb; if (rowbase < RLv) { b = rowbase / Lv; tlb = rowbase % Lv; } else { b = (rowbase - RLv) / CTXv; tlb = Lv + (rowbase - RLv) % CTXv; }
#pragma unroll
            for (int ai = 0; ai < 2; ++ai)
#pragma unroll
                for (int m = 0; m < 4; ++m) { const int tl = tlb + wr * 64 + fr + ai * HALF + m * 16;
#pragma unroll
                    for (int bj = 0; bj < 2; ++bj) { const f32x4 v0 = acc[ai][bj][m][0], v1 = acc[ai][bj][m][1];
                        bf16_t* o = hyT + ((size_t)b * 1536 + hc0 + bj * HALF) * RBv + tl;
#pragma unroll
                        for (int q = 0; q < 4; ++q) { o[(size_t)q * RBv] = (bf16_t)(::pk_bf16(v0[q], 0.f) & 0xffffu); o[(size_t)(q + 4) * RBv] = (bf16_t)(::pk_bf16(v1[q], 0.f) & 0xffffu); } } }
        }
    }
};
struct EpiSwiGLU {
    static constexpr bool PERM = true, AFTER_DRAIN = false;
    bf16_t* O;
    __device__ __forceinline__ void operator()(const f32x4 (&acc)[2][2][4][2], const Unit& u, int wr, int wc, int fr, int fq) const {
        const int row0 = u.pm * BM + wr * 64 + fr; const int j0 = (u.pn & 3) * 128 + wc * 16 + 4 * fq;
#pragma unroll
        for (int ai = 0; ai < 2; ++ai)
#pragma unroll
            for (int m = 0; m < 4; ++m) { bf16_t* rowp = O + (size_t)(row0 + ai * HALF + m * 16) * 512 + j0;
#pragma unroll
                for (int bj = 0; bj < 2; ++bj) { const f32x4 g = acc[ai][bj][m][0], up = acc[ai][bj][m][1]; float h[4];
#pragma unroll
                    for (int q = 0; q < 4; ++q) h[q] = g[q] / (1.f + __expf(-g[q])) * up[q];
                    u32x2 w; w.x = ::pk_bf16(h[0], h[1]); w.y = ::pk_bf16(h[2], h[3]);
                    *(u32x2*)(rowp + bj * 64) = w; } }
    }
};
struct EpiRowScale {
    static constexpr bool PERM = true, AFTER_DRAIN = false;
    bf16_t* O; const float* ws;
    __device__ __forceinline__ void operator()(const f32x4 (&acc)[2][2][4][2], const Unit& u, int wr, int wc, int fr, int fq) const {
        const int row0 = u.pm * BM + wr * 64 + fr; const int col0 = (u.pn & 3) * BM + wc * 32 + 8 * fq;
#pragma unroll
        for (int ai = 0; ai < 2; ++ai)
#pragma unroll
            for (int m = 0; m < 4; ++m) { const int row = row0 + ai * HALF + m * 16; const float s = ws[row]; bf16_t* rowp = O + (size_t)row * 1024 + col0;
#pragma unroll
                for (int bj = 0; bj < 2; ++bj) { const f32x4 v0 = acc[ai][bj][m][0] * s, v1 = acc[ai][bj][m][1] * s;
                    u32x4 w; w.x = ::pk_bf16(v0[0], v0[1]); w.y = ::pk_bf16(v0[2], v0[3]); w.z = ::pk_bf16(v1[0], v1[1]); w.w = ::pk_bf16(v1[2], v1[3]);
                    *(u32x4*)(rowp + bj * HALF) = w; } }
    }
};
struct MoeOrder {
    int G, c, nt; int toff[16];
    __device__ __forceinline__ void init(const int* cnt, int G_, int c_) { G = G_; c = c_; int s = 0;
#pragma unroll
        for (int e = 0; e < 16; ++e) { toff[e] = s; s += (cnt[e] + 255) >> 8; } nt = s; }
    __device__ __forceinline__ bool next(int i, Unit& u) const {
        const int Lq = i * G + c; if (Lq >= nt * 4) return false;
        const int pm = Lq % nt, pn4 = Lq / nt; int e = 0;
#pragma unroll
        for (int q = 1; q < 16; ++q) e += (pm >= toff[q]) ? 1 : 0;
        u.pm = pm; u.pn = e * 4 + pn4; return true; }
    __device__ __forceinline__ void a_ready(const Unit&) const {}
    __device__ __forceinline__ void done(const Unit&) const {}
};
}

constexpr int NB = 2, L = 8192, D = 1024, CTX = 256, RB = L + CTX;
constexpr int RL = NB * L, RCX = NB * CTX, R = RL + RCX;
constexpr int GW = 64;
constexpr int NCH = 66;
constexpr int ABIN = 3584, GIN = 3104, GINP = 3328;
constexpr int NE = 16, NG = 4, EPG = 4, EH = 512;
constexpr int MOE_ROWS = 37888;
constexpr float ALPHA = 1.4142135623730951f, LN_EPS = 1e-5f, KSCALE = 0.08838834764831845f;
constexpr int NT = 512;
constexpr int LDS_BYTES = 147456;

typedef unsigned short bf16_t;
#define LAS __attribute__((address_space(3)))
__device__ __forceinline__ float bf2f(bf16_t v) { return __uint_as_float((unsigned)v << 16); }
__device__ __forceinline__ bf16_t f2bf(float f) { unsigned u = __float_as_uint(f); return (bf16_t)((u + 0x7fffu + ((u >> 16) & 1u)) >> 16); }
__device__ __forceinline__ float siluf(float x) { return x / (1.f + expf(-x)); }
__device__ __forceinline__ float sigmf(float x) { return 1.f / (1.f + expf(-x)); }
__device__ __forceinline__ float logsigf(float x) { return fminf(x, 0.f) - log1pf(expf(-fabsf(x))); }

struct P {
    const float* in[34];
    float* out;
    float* Xc;
    float* MOD;
    float* NORM;
    int* CNT;
    unsigned* BAR;
    float* A1; float* A2;
    float* RS; int* RE; int* RPOS; float* RWt; float* WS;
    bf16_t *Win0, *Wout0, *Win1, *Wout1, *Wgu, *Wd;
    bf16_t* H;
    bf16_t* Zr;
    bf16_t* Zh;
    bf16_t* hyT;
    float* FILT;
    bf16_t *Hs, *he, *slots;
    bf16_t* Z1;
    float* BG;
    bf16_t* GST;
};

__device__ __forceinline__ int launder_i(int x) { asm volatile("" : "+v"(x)); return x; }
#define TIDX launder_i((int)threadIdx.x)
#define GSTRIDE(i, n) for (long i = (long)blockIdx.x * blockDim.x + TIDX; i < (long)(n); i += (long)gridDim.x * blockDim.x)

__device__ __forceinline__ float* xrow(const P& p, int r) { return r < RL ? p.out + (size_t)r * D : p.Xc + (size_t)(r - RL) * D; }
__device__ __forceinline__ int seg_of(int r) { return r < RL ? r / L : 2; }
__device__ __forceinline__ const float* modv(const P& p, int l, int r, int chunk) { return p.MOD + ((size_t)(l * 3 + seg_of(r)) * 6 + chunk) * D; }
__device__ __forceinline__ int chunk_row0(int b, int c) { return c < 2 ? RL + b * CTX + c * 128 : b * L + (c - 2) * 128; }
__device__ __forceinline__ void row_bt(int r, int& b, int& tl) { if (r < RL) { b = r / L; tl = r % L; } else { b = (r - RL) / CTX; tl = L + (r - RL) % CTX; } }
__device__ __forceinline__ int bt_row(int b, int tl) { return tl < L ? b * L + tl : RL + b * CTX + (tl - L); }

#define XB_TMO      128
#define XB_XCNT(j)  (256  + 64 * (j))
#define XB_XSUB(j)  (1280 + 64 * (j))
#define XB_XGEN(j)  (2304 + 64 * (j))
#define XB_TOP      3328
#define XB_TOPGEN   3392
#define XCD_BAR_WORDS 3456
#define XB_SPIN_CAP (1u << 18)

__device__ __forceinline__ unsigned xb_ld(unsigned* p)              { return __hip_atomic_load(p, __ATOMIC_RELAXED, __HIP_MEMORY_SCOPE_AGENT); }
__device__ __forceinline__ unsigned xb_add(unsigned* p, unsigned v) { return __hip_atomic_fetch_add(p, v, __ATOMIC_RELAXED, __HIP_MEMORY_SCOPE_AGENT); }
__device__ __forceinline__ unsigned xb_xcc_id() { return (unsigned)__builtin_amdgcn_s_getreg((3 << 11) | 20) & 0xFu; }
#define XB_SPIN(cond, bar) do { unsigned _sp = 0; while (cond) { __builtin_amdgcn_s_sleep(1); \
    if ((++_sp & 255u) == 0u) { if (xb_ld(&(bar)[XB_TMO])) break; if (_sp > XB_SPIN_CAP) { atomicAdd(&(bar)[XB_TMO], 1u); break; } } } } while (0)

struct XcdBarrier {
    unsigned* bar; unsigned x;
    volatile LAS unsigned* st;
};

__device__ __forceinline__ XcdBarrier xcd_barrier_post(unsigned* bar, volatile LAS unsigned* st) {
    XcdBarrier b; b.bar = bar; b.x = xb_xcc_id(); b.st = st;
    if (threadIdx.x == 0) (void)xb_add(&bar[XB_XCNT(b.x)], 1u);
    return b;
}
__device__ __forceinline__ void xcd_barrier_complete(unsigned* bar, unsigned x, unsigned& nloc, unsigned& nx) {
    const unsigned G = gridDim.x * gridDim.y * gridDim.z;
    unsigned sum, cnt, mine, sp = 0u;
    for (;;) {
        sum = 0u; cnt = 0u; mine = 0u;
#pragma unroll
        for (unsigned j = 0; j < 16; ++j) { const unsigned c = xb_ld(&bar[XB_XCNT(j)]); sum += c; cnt += (c > 0u) ? 1u : 0u; mine = (j == x) ? c : mine; }
        if (sum == G) break;
        __builtin_amdgcn_s_sleep(1);
        if ((++sp & 255u) == 0u) { if (xb_ld(&bar[XB_TMO])) break; if (sp > XB_SPIN_CAP) { atomicAdd(&bar[XB_TMO], 1u); break; } }
    }
    nloc = mine > 0u ? mine : 1u; nx = cnt > 0u ? cnt : 1u;
}

__device__ __forceinline__ void xcd_barrier(const XcdBarrier& b) {
    asm volatile("s_waitcnt vmcnt(0)" ::: "memory");
    __syncthreads();
    if (threadIdx.x == 0) {
        unsigned* bar = b.bar;
        __builtin_amdgcn_s_waitcnt(0);
        unsigned nloc = b.st[0], nx = b.st[1];
        if (nloc == 0u) { xcd_barrier_complete(bar, b.x, nloc, nx); b.st[0] = nloc; b.st[1] = nx; }
        const unsigned old = xb_add(&bar[XB_XSUB(b.x)], 1u);
        const unsigned gen = old / nloc;
        if (old + 1u == (gen + 1u) * nloc) {
            __builtin_amdgcn_fence(__ATOMIC_RELEASE, "agent");
            asm volatile("s_waitcnt vmcnt(0)" ::: "memory");
            const unsigned og = xb_add(&bar[XB_TOP], 1u);
            const unsigned tg = og / nx;
            if (og + 1u == (tg + 1u) * nx) xb_add(&bar[XB_TOPGEN], 1u);
            else XB_SPIN(xb_ld(&bar[XB_TOPGEN]) == tg, bar);
            __builtin_amdgcn_fence(__ATOMIC_ACQUIRE, "agent");
            xb_add(&bar[XB_XGEN(b.x)], 1u);
            asm volatile("s_waitcnt vmcnt(0)" ::: "memory");
        } else {
            XB_SPIN(xb_ld(&bar[XB_XGEN(b.x)]) == gen, bar);
            __builtin_amdgcn_fence(__ATOMIC_ACQUIRE, "agent");
            asm volatile("s_waitcnt vmcnt(0)" ::: "memory");
        }
    }
    __syncthreads();
}

__device__ __forceinline__ void ph_wconv(bf16_t* dst, const float* src, int N, int K, int ldsrc, int nvalid) {
    GSTRIDE(idx, (long)N * K) { const int k = idx % K, n = idx / K; dst[idx] = n < nvalid ? f2bf(src[(size_t)k * ldsrc + n]) : (bf16_t)0; }
}
__device__ __forceinline__ void ph_wconv_moe(const P& p, int l) {
    GSTRIDE(idx, (long)NE * 1024 * 1024) {
        const int k = idx % 1024, n = (idx / 1024) % 1024, e = idx / (1024 * 1024);
        const int q = n >> 3, r = n & 7, j = 4 * q + (r & 3);
        const float* src = (r < 4 ? p.in[31] : p.in[32]) + ((size_t)(l * NE + e) * D + k) * EH + j;
        p.Wgu[idx] = f2bf(*src);
    }
    GSTRIDE(idx, (long)NE * 1024 * 512) {
        const int k = idx % 512, n = (idx / 512) % 1024, e = idx / (512 * 1024);
        p.Wd[idx] = f2bf(p.in[33][((size_t)(l * NE + e) * EH + k) * D + n]);
    }
}
__device__ __forceinline__ void ph_ada(const P& p) {
    GSTRIDE(idx, 2 * 3 * 6144) {
        const int n = idx % 6144, j = (idx / 6144) % 3, l = idx / (3 * 6144);
        const float* cv = j < 2 ? p.in[1] + j * D : p.in[3];
        const float* w = p.in[4] + (size_t)l * D * 6144;
        float acc = p.in[5][l * 6144 + n];
        for (int k = 0; k < D; ++k) acc += siluf(cv[k]) * w[(size_t)k * 6144 + n];
        p.MOD[idx] = acc;
    }
}
__device__ __forceinline__ void ph_init(const P& p) {
    GSTRIDE(i, (long)RL * D) p.out[i] = p.in[0][i];
    GSTRIDE(i, (long)RCX * D) p.Xc[i] = p.in[2][i];
}
__device__ __forceinline__ void hy_pos(int pidx, int& len, int& i) { if (pidx < L) { len = L; i = pidx; } else { len = CTX; i = pidx - L; } }
__device__ __forceinline__ void ph_hyA1(const P& p) {
    GSTRIDE(idx, (long)RB * 64) {
        const int j = idx % 64, pidx = idx / 64; int len, i; hy_pos(pidx, len, i);
        const float t = (float)i / (float)(len - 1);
        const float w = 2.0f * 3.14159265358979323846f * (float)i / (float)len;
        const float* w1 = p.in[13];
        float acc = p.in[14][j] + t * w1[j];
        for (int m = 0; m < 16; ++m) {
            const float f = 1e-4f + (float)m * ((15.f - 1e-4f) / 15.f);
            acc += cosf(f * w) * w1[(1 + m) * 64 + j] - sinf(f * w) * w1[(17 + m) * 64 + j];
        }
        p.A1[idx] = sinf(p.in[20][j] * acc);
    }
}
__device__ __forceinline__ void ph_hyA(const float* src, float* dst, const float* w, const float* bias, const float* freq) {
    GSTRIDE(idx, (long)RB * 64) {
        const int j = idx % 64, pidx = idx / 64;
        float acc = bias[j];
        for (int i = 0; i < 64; ++i) acc += src[(size_t)pidx * 64 + i] * w[i * 64 + j];
        dst[idx] = sinf(freq[j] * acc);
    }
}
__device__ __forceinline__ void ph_hyF(const P& p, const float* a3) {
    const float mind = logf(1e-2f) / 1.5f, maxd = logf(1e-2f) / 0.3f;
    GSTRIDE(idx, (long)2048 * RB) {
        const int pidx = idx % RB, col = idx / RB, ch = col % 512; int len, i; hy_pos(pidx, len, i);
        const float t = (float)i / (float)(len - 1);
        float acc = 0.f;
        for (int m = 0; m < 64; ++m) acc += a3[(size_t)pidx * 64 + m] * p.in[19][m * 2048 + col];
        const float delta = fabsf(mind + (float)ch * ((maxd - mind) / 511.f));
        p.FILT[idx] = acc * expf(-t * delta);
    }
}
__device__ __forceinline__ float block_sum(float v, float* red);
__device__ __forceinline__ void ph_hyNorm(const P& p, float* red) {
    for (int u = blockIdx.x; u < 2 * 2048; u += gridDim.x) {
        const int col = u % 2048, which = u / 2048; const int p0 = which ? L : 0, n = which ? CTX : L;
        float s = 0.f;
        for (int i = TIDX; i < n; i += NT) { const float v = p.FILT[(size_t)col * RB + p0 + i]; s += v * v; }
        const float t = block_sum(s, red);
        if (TIDX == 0) p.NORM[which * 2048 + col] = t;
    }
}
__device__ __forceinline__ void ph_mod(const P& p, int l, int which) {
    GSTRIDE(i, (long)R * D) {
        const int r = i / D, k = i % D;
        p.H[i] = f2bf(xrow(p, r)[k] * (1.f + modv(p, l, r, which * 3 + 1)[k]) + modv(p, l, r, which * 3 + 0)[k]);
    }
}
__device__ __forceinline__ void ph_prep_rope(const P& p) {
    GSTRIDE(i, (long)R * 2 * 4 * 64) {
        const int pr = i % 64, h = (i / 64) % 4, w = (i / 256) % 2, r = i / 512;
        bf16_t* base = p.Zr + (size_t)r * 2048 + w * 512 + h * 128;
        float t1 = bf2f(base[pr]), t2 = bf2f(base[64 + pr]);
        if (w == 1) { t1 *= KSCALE; t2 *= KSCALE; }
        if (r < RL) {
            const int t = r % L, row = t / GW, col = t % GW;
            const float inv = powf(10000.f, -(float)(pr & 31) / 32.f);
            const float ang = (pr < 32 ? (float)row : (float)col) * inv;
            float sn, cs; sincosf(ang, &sn, &cs);
            const float a = t1 * cs - t2 * sn, bb = t1 * sn + t2 * cs; t1 = a; t2 = bb;
        }
        base[pr] = f2bf(t1); base[64 + pr] = f2bf(t2);
    }
}
__device__ __forceinline__ void ph_prep_hy(const P& p) {
    GSTRIDE(idx, (long)NB * 1536 * RB) {
        const int tl = idx % RB, col = (idx / RB) % 1536, b = idx / (RB * 1536);
        const int s0 = tl < L ? 0 : L, s1 = tl < L ? L : RB;
        const float* w = p.in[11];
        float acc = p.in[12][col] + w[1536 + col] * bf2f(p.Zh[(size_t)bt_row(b, tl) * 1536 + col]);
        if (tl - 1 >= s0) acc += w[col] * bf2f(p.Zh[(size_t)bt_row(b, tl - 1) * 1536 + col]);
        if (tl + 1 < s1) acc += w[2 * 1536 + col] * bf2f(p.Zh[(size_t)bt_row(b, tl + 1) * 1536 + col]);
        p.hyT[idx] = f2bf(acc);
    }
}
__device__ __forceinline__ float hy_tapT(const float* Ff, const float* Fb, float nf, float nb, int d) {
    if (d > 0) return Ff[d] * nf; if (d < 0) return Fb[-d] * nb; return Ff[0] * nf + Fb[0] * nb;
}
__device__ __forceinline__ void ph_hyconv_naive(const P& p, int n, float* conv) {
    GSTRIDE(idx, (long)NB * 512 * (RB / 4)) {
        const int tb = idx % (RB / 4), ch = (idx / (RB / 4)) % 512, b = idx / ((RB / 4) * 512);
        const int tl0 = tb * 4, s0 = tl0 < L ? 0 : L, len = tl0 < L ? L : CTX, nrm = tl0 < L ? 0 : 1, t0 = tl0 - s0;
        const int cf = (n * 2 + 0) * 512 + ch, cb = (n * 2 + 1) * 512 + ch;
        const float nf = 1.f / sqrtf(p.NORM[nrm * 2048 + cf]), nb = 1.f / sqrtf(p.NORM[nrm * 2048 + cb]);
        const float* Ff = p.FILT + (size_t)cf * RB + s0; const float* Fb = p.FILT + (size_t)cb * RB + s0;
        const bf16_t* z = p.hyT + ((size_t)(b * 3 + 2) * 512 + ch) * RB + s0;
        float w0 = hy_tapT(Ff, Fb, nf, nb, t0), w1 = hy_tapT(Ff, Fb, nf, nb, t0 + 1), w2 = hy_tapT(Ff, Fb, nf, nb, t0 + 2), w3 = hy_tapT(Ff, Fb, nf, nb, t0 + 3);
        float a0 = 0.f, a1 = 0.f, a2 = 0.f, a3 = 0.f;
        for (int s = 0; s < len; ++s) {
            const float zz = bf2f(z[s]);
            a0 += w0 * zz; a1 += w1 * zz; a2 += w2 * zz; a3 += w3 * zz;
            w3 = w2; w2 = w1; w1 = w0;
            if (s + 1 < len) w0 = hy_tapT(Ff, Fb, nf, nb, t0 - (s + 1));
        }
        float* o = conv + ((size_t)b * 512 + ch) * RB + tl0; o[0] = a0; o[1] = a1; o[2] = a2; o[3] = a3;
    }
}
__device__ __forceinline__ void ph_hygate_naive(const P& p, int n, const float* conv) {
    bf16_t* yhT = p.Zh + (size_t)2 * NB * 4 * NCH * 16384;
    GSTRIDE(idx, (long)NB * 512 * RB) {
        const int tl = idx % RB, ch = (idx / RB) % 512, b = idx / (RB * 512);
        bf16_t* z = p.hyT + ((size_t)(b * 3 + 2) * 512 + ch) * RB + tl; const float gate = bf2f(p.hyT[((size_t)(b * 3 + n) * 512 + ch) * RB + tl]);
        const float r = gate * (conv[idx] + p.in[21][n * 512 + ch] * bf2f(*z));
        if (n == 0) *z = f2bf(r); else yhT[idx] = f2bf(r);
    }
}
__device__ __forceinline__ void ph_hy_untranspose(const P& p) {
    const bf16_t* yhT = p.Zh + (size_t)2 * NB * 4 * NCH * 16384;
    GSTRIDE(idx, (long)R * 512) { const int ch = idx % 512, r = idx / 512; int b, tl; row_bt(r, b, tl); p.H[(size_t)r * D + 512 + ch] = yhT[((size_t)b * 512 + ch) * RB + tl]; }
}
__device__ __forceinline__ size_t st_idx(int dir, int b, int h, int c) { return ((((size_t)dir * NB + b) * 4 + h) * NCH + c) * 16384; }
__device__ __forceinline__ void ph_retU_naive(const P& p) {
    bf16_t* ST = p.Zh;
    GSTRIDE(idx, (long)NB * 4 * NCH * 16384) {
        const int d = idx % 128, e = (idx / 128) % 128, c = (idx / 16384) % NCH, h = (idx / (16384 * NCH)) % 4, b = idx / (16384 * NCH * 4);
        const float lgf = p.in[9][h], lgb = p.in[10][h]; const int r0 = chunk_row0(b, c);
        float uf = 0.f, ub = 0.f;
        for (int j = 0; j < 128; ++j) {
            const float kk = bf2f(p.Zr[(size_t)(r0 + j) * 2048 + 512 + h * 128 + d]), vv = bf2f(p.Zr[(size_t)(r0 + j) * 2048 + 1024 + h * 128 + e]);
            uf += kk * expf(lgf * (float)(127 - j)) * vv; ub += kk * expf(lgb * (float)j) * vv;
        }
        ST[st_idx(0, b, h, c) + e * 128 + d] = f2bf(uf); ST[st_idx(1, b, h, c) + e * 128 + d] = f2bf(ub);
    }
}
__device__ __forceinline__ void ph_retScan(const P& p) {
    bf16_t* ST = p.Zh;
    GSTRIDE(idx, (long)2 * NB * 4 * 16384) {
        const int ed = idx % 16384, h = (idx / 16384) % 4, b = (idx / 65536) % NB, dir = idx / (65536 * NB);
        const float dc = expf((dir ? p.in[10] : p.in[9])[h] * 128.f);
        float s = 0.f;
        for (int cc = 0; cc < NCH; ++cc) {
            const int c = dir == 0 ? cc : (cc < 2 ? 1 - cc : NCH + 1 - cc);
            bf16_t* q = ST + st_idx(dir, b, h, c) + ed; const float u = bf2f(*q); *q = f2bf(s); s = dc * s + u;
        }
    }
}
__device__ __forceinline__ void ph_retO_naive(const P& p, float* lds) {
    const bf16_t* ST = p.Zh;
    for (int u = blockIdx.x; u < NB * 4 * NCH; u += gridDim.x) {
        const int c = u % NCH, h = (u / NCH) % 4, b = u / (NCH * 4); const int r0 = chunk_row0(b, c);
        const float lgf = p.in[9][h], lgb = p.in[10][h];
        __syncthreads();
        for (int e = TIDX; e < 128 * 128; e += NT) {
            const int j = e % 128, i = e / 128;
            const bf16_t* q = p.Zr + (size_t)(r0 + i) * 2048 + h * 128; const bf16_t* k = p.Zr + (size_t)(r0 + j) * 2048 + 512 + h * 128;
            float s = 0.f; for (int d = 0; d < 128; ++d) s += bf2f(q[d]) * bf2f(k[d]);
            const float m = i > j ? expf(lgf * (float)(i - j)) : (j > i ? expf(lgb * (float)(j - i)) : 2.f);
            lds[e] = s * m;
        }
        __syncthreads();
        const bf16_t* sf = ST + st_idx(0, b, h, c); const bf16_t* sb = ST + st_idx(1, b, h, c);
        for (int e2 = TIDX; e2 < 128 * 128; e2 += NT) {
            const int e = e2 % 128, i = e2 / 128;
            float o = 0.f; for (int j = 0; j < 128; ++j) o += lds[i * 128 + j] * bf2f(p.Zr[(size_t)(r0 + j) * 2048 + 1024 + h * 128 + e]);
            const bf16_t* q = p.Zr + (size_t)(r0 + i) * 2048 + h * 128;
            float of = 0.f, ob = 0.f; for (int d = 0; d < 128; ++d) { const float qq = bf2f(q[d]); of += qq * bf2f(sf[e * 128 + d]); ob += qq * bf2f(sb[e * 128 + d]); }
            p.H[(size_t)(r0 + i) * D + h * 128 + e] = f2bf(o + expf(lgf * (float)(i + 1)) * of + expf(lgb * (float)(128 - i)) * ob);
        }
    }
}
__device__ __forceinline__ void ph_retNorm_naive(const P& p) {
    GSTRIDE(idx, (long)R * 4) {
        const int h = idx % 4, r = idx / 4; bf16_t* o = p.H + (size_t)r * D + h * 128;
        float mu = 0.f; for (int e = 0; e < 128; ++e) mu += bf2f(o[e]); mu *= (1.f / 128.f);
        float var = 0.f; for (int e = 0; e < 128; ++e) { const float d = bf2f(o[e]) - mu; var += d * d; } var *= (1.f / 128.f);
        const float rs = 1.f / sqrtf(var + LN_EPS);
        for (int e = 0; e < 128; ++e) o[e] = f2bf((bf2f(o[e]) - mu) * rs * siluf(bf2f(p.Zr[(size_t)r * 2048 + 1536 + h * 128 + e])));
    }
}
__device__ __forceinline__ float block_sum(float v, float* red) {
    __syncthreads();
#pragma unroll
    for (int o = 32; o > 0; o >>= 1) v += __shfl_xor(v, o);
    if ((TIDX & 63) == 0) red[TIDX >> 6] = v;
    __syncthreads();
    float t = 0.f;
#pragma unroll
    for (int w = 0; w < NT / 64; ++w) t += red[w];
    return t;
}
template <int MODE> __device__ __forceinline__ void ph_post(const P& p, int l, int which, const bf16_t* Y, int ln, int wn, int nrows, float* red) {
    const float* lg = p.in[6] + (size_t)(l * 2 + which) * D; const float* lb = p.in[7] + (size_t)(l * 2 + which) * D;
    int toff[16];
    if (MODE == 1) { int s = 0;
#pragma unroll
        for (int e = 0; e < 16; ++e) { toff[e] = s; s += (p.CNT[l * 16 + e] + 255) >> 8; } }
    for (int r = blockIdx.x; r < nrows; r += gridDim.x) {
        float* x = xrow(p, r); const float* gate = modv(p, l, r, which * 3 + 2);
        const bf16_t *y0, *y1 = nullptr;
        if (MODE == 0) y0 = Y + (size_t)r * D;
        else {
            int sr[2];
#pragma unroll
            for (int k = 0; k < 2; ++k) { const int e = p.RE[r * 2 + k]; int to = 0;
#pragma unroll
                for (int q = 0; q < 16; ++q) to = (q == e) ? toff[q] : to;
                sr[k] = to * 256 + p.RPOS[r * 2 + k]; }
            y0 = p.slots + (size_t)sr[0] * D; y1 = p.slots + (size_t)sr[1] * D;
        }
        float v[2]; float s = 0.f;
#pragma unroll
        for (int i = 0; i < 2; ++i) { const int k = TIDX + i * NT; float yy = bf2f(y0[k]); if (MODE == 1) yy += bf2f(y1[k]); v[i] = ALPHA * x[k] + gate[k] * yy; s += v[i]; }
        const float mu = block_sum(s, red) * (1.f / D);
        float q = 0.f;
#pragma unroll
        for (int i = 0; i < 2; ++i) { const float d = v[i] - mu; q += d * d; }
        const float rs = 1.f / sqrtf(block_sum(q, red) * (1.f / D) + LN_EPS);
#pragma unroll
        for (int i = 0; i < 2; ++i) { const int k = TIDX + i * NT; const float xn = (v[i] - mu) * rs * lg[k] + lb[k]; x[k] = xn;
            if (ln >= 0) p.H[(size_t)r * D + k] = f2bf(xn * (1.f + modv(p, ln, r, wn * 3 + 1)[k]) + modv(p, ln, r, wn * 3 + 0)[k]); }
    }
}
__device__ __forceinline__ void ph_route1(const P& p, int l, int nrows) {
    GSTRIDE(idx, (long)nrows * NE) {
        const int e = idx % NE, r = idx / NE; const float* x = xrow(p, r); const float* sc = modv(p, l, r, 4); const float* sh = modv(p, l, r, 3);
        float acc = 0.f;
        for (int k = 0; k < D; ++k) acc += (x[k] * (1.f + sc[k]) + sh[k]) * p.in[29][k * NE + e];
        p.RS[idx] = sigmf(acc);
    }
}
__device__ __forceinline__ void ph_route2(const P& p, int l, int nrows) {
    GSTRIDE(r, nrows) {
        const float* s = p.RS + (size_t)r * NE; const float* rb = p.in[30];
        int best = 0; float bs = -1e30f;
        for (int g = 0; g < NG; ++g) {
            float m1 = -1e30f, m2 = -1e30f;
            for (int q = 0; q < EPG; ++q) { const float v = s[g * EPG + q] + rb[g * EPG + q]; if (v > m1) { m2 = m1; m1 = v; } else if (v > m2) m2 = v; }
            if (m1 + m2 > bs) { bs = m1 + m2; best = g; }
        }
        int i1 = 0; float v1 = -1e30f;
        for (int q = 0; q < EPG; ++q) { const float v = s[best * EPG + q] + rb[best * EPG + q]; if (v > v1) { v1 = v; i1 = q; } }
        int i2 = 0; float v2 = -1e30f;
        for (int q = 0; q < EPG; ++q) { if (q == i1) continue; const float v = s[best * EPG + q] + rb[best * EPG + q]; if (v > v2) { v2 = v; i2 = q; } }
        const int e1 = best * EPG + i1, e2 = best * EPG + i2; const float a = s[e1], c = s[e2];
        p.RE[r * 2] = e1; p.RE[r * 2 + 1] = e2; p.RWt[r * 2] = a / (a + c); p.RWt[r * 2 + 1] = c / (a + c);
        p.RPOS[r * 2] = atomicAdd(&p.CNT[l * 16 + e1], 1); p.RPOS[r * 2 + 1] = atomicAdd(&p.CNT[l * 16 + e2], 1);
    }
}
__device__ __forceinline__ void ph_permute(const P& p, int l, int nrows) {
    int toff[16]; { int s = 0;
#pragma unroll
        for (int e = 0; e < 16; ++e) { toff[e] = s; s += (p.CNT[l * 16 + e] + 255) >> 8; } }
    GSTRIDE(idx, (long)nrows * 2 * 128) {
        const int ck = idx % 128, k = (idx / 128) % 2, r = idx / 256; const int e = p.RE[r * 2 + k]; int to = 0;
#pragma unroll
        for (int q = 0; q < 16; ++q) to = (q == e) ? toff[q] : to;
        const int sr = to * 256 + p.RPOS[r * 2 + k];
        ((uint4*)(p.Hs + (size_t)sr * D))[ck] = ((const uint4*)(p.H + (size_t)r * D))[ck];
        if (ck == 0) p.WS[sr] = p.RWt[r * 2 + k];
    }
}
__device__ __forceinline__ void ph_glagate(const P& p) {
    GSTRIDE(idx, (long)2 * R * 512) {
        const int ch = idx % 512, r = (idx / 512) % R, dir = idx / (512 * R);
        const float* gw = (dir ? p.in[26] : p.in[24]); const float* gb = (dir ? p.in[27] : p.in[25]);
        float acc = gb[ch];
        for (int q = 0; q < 16; ++q) acc += bf2f(p.Z1[(size_t)r * GINP + 3072 + dir * 16 + q]) * gw[q * 512 + ch];
        p.BG[idx] = logsigf(acc) * (1.f / 16.f);
    }
}
__device__ __forceinline__ void ph_glacum(const P& p) {
    GSTRIDE(idx, (long)2 * NB * NCH * 512) {
        const int ch = idx % 512, c = (idx / 512) % NCH, b = (idx / (512 * NCH)) % NB, dir = idx / (512 * NCH * NB);
        float* a = p.BG + ((size_t)dir * R + chunk_row0(b, c)) * 512 + ch;
        float s = 0.f;
        if (dir == 0) for (int i = 0; i < 128; ++i) { s += a[(size_t)i * 512]; a[(size_t)i * 512] = s; }
        else for (int i = 127; i >= 0; --i) { s += a[(size_t)i * 512]; a[(size_t)i * 512] = s; }
    }
}
__device__ __forceinline__ size_t gst_idx(int dir, int b, int h, int c) { return ((((size_t)dir * NB + b) * 4 + h) * NCH + c) * 32768; }
__device__ __forceinline__ void ph_glaU_naive(const P& p) {
    const float* BF = p.BG; const float* BB = p.BG + (size_t)R * 512;
    GSTRIDE(idx, (long)NB * 4 * NCH * 32768) {
        const int d = idx % 128, e = (idx / 128) % 256, c = (idx / 32768) % NCH, h = (idx / (32768 * NCH)) % 4, b = idx / (32768 * NCH * 4);
        const int r0 = chunk_row0(b, c);
        const float bfe = BF[(size_t)(r0 + 127) * 512 + h * 128 + d], bbe = BB[(size_t)r0 * 512 + h * 128 + d];
        float uf = 0.f, ub = 0.f;
        for (int j = 0; j < 128; ++j) {
            const float kk = bf2f(p.Z1[(size_t)(r0 + j) * GINP + 512 + h * 128 + d]), vv = bf2f(p.Z1[(size_t)(r0 + j) * GINP + 1024 + h * 256 + e]);
            uf += kk * expf(bfe - BF[(size_t)(r0 + j) * 512 + h * 128 + d]) * vv; ub += kk * expf(bbe - BB[(size_t)(r0 + j) * 512 + h * 128 + d]) * vv;
        }
        p.GST[gst_idx(0, b, h, c) + e * 128 + d] = f2bf(uf); p.GST[gst_idx(1, b, h, c) + e * 128 + d] = f2bf(ub);
    }
}
__device__ __forceinline__ void ph_glaScan(const P& p) {
    const float* BF = p.BG; const float* BB = p.BG + (size_t)R * 512;
    GSTRIDE(idx, (long)2 * NB * 4 * 32768) {
        const int d = idx % 128, ed = idx % 32768, h = (idx / 32768) % 4, b = (idx / 131072) % NB, dir = idx / (131072 * NB);
        float s = 0.f;
        for (int cc = 0; cc < NCH; ++cc) {
            const int c = dir == 0 ? cc : (cc < 2 ? 1 - cc : NCH + 1 - cc); const int r0 = chunk_row0(b, c);
            const float dc = dir == 0 ? expf(BF[(size_t)(r0 + 127) * 512 + h * 128 + d]) : expf(BB[(size_t)r0 * 512 + h * 128 + d]);
            bf16_t* q = p.GST + gst_idx(dir, b, h, c) + ed; const float u = bf2f(*q); *q = f2bf(s); s = dc * s + u;
        }
    }
}
__device__ __forceinline__ void ph_glaO_naive(const P& p, float* lds) {
    const float* BF = p.BG; const float* BB = p.BG + (size_t)R * 512;
    for (int u = blockIdx.x; u < NB * 4 * 64; u += gridDim.x) {
        const int c = 2 + u % 64, h = (u / 64) % 4, b = u / 256; const int r0 = chunk_row0(b, c);
        __syncthreads();
        for (int e = TIDX; e < 128 * 128; e += NT) {
            const int j = e % 128, i = e / 128;
            const bf16_t* q = p.Z1 + (size_t)(r0 + i) * GINP + h * 128; const bf16_t* k = p.Z1 + (size_t)(r0 + j) * GINP + 512 + h * 128;
            float s = 0.f;
            if (i >= j) { const float* bi = BF + (size_t)(r0 + i) * 512 + h * 128; const float* bj = BF + (size_t)(r0 + j) * 512 + h * 128;
                for (int d = 0; d < 128; ++d) s += bf2f(q[d]) * bf2f(k[d]) * expf(bi[d] - bj[d]); }
            if (i <= j) { const float* bi = BB + (size_t)(r0 + i) * 512 + h * 128; const float* bj = BB + (size_t)(r0 + j) * 512 + h * 128;
                for (int d = 0; d < 128; ++d) s += bf2f(q[d]) * bf2f(k[d]) * expf(bi[d] - bj[d]); }
            lds[e] = s * KSCALE;
        }
        __syncthreads();
        const bf16_t* sf = p.GST + gst_idx(0, b, h, c); const bf16_t* sb = p.GST + gst_idx(1, b, h, c);
        for (int e2 = TIDX; e2 < 128 * 256; e2 += NT) {
            const int e = e2 % 256, i = e2 / 256;
            float o = 0.f; for (int j = 0; j < 128; ++j) o += lds[i * 128 + j] * bf2f(p.Z1[(size_t)(r0 + j) * GINP + 1024 + h * 256 + e]);
            const bf16_t* q = p.Z1 + (size_t)(r0 + i) * GINP + h * 128; const float* bi = BF + (size_t)(r0 + i) * 512 + h * 128; const float* bbi = BB + (size_t)(r0 + i) * 512 + h * 128;
            float a = 0.f; for (int d = 0; d < 128; ++d) a += bf2f(q[d]) * (expf(bi[d]) * bf2f(sf[e * 128 + d]) + expf(bbi[d]) * bf2f(sb[e * 128 + d]));
            p.H[(size_t)(r0 + i) * D + h * 256 + e] = f2bf(o + a * KSCALE);
        }
    }
}
__device__ __forceinline__ void ph_glaNorm_naive(const P& p) {
    GSTRIDE(idx, (long)RL * 4) {
        const int h = idx % 4, r = idx / 4; bf16_t* o = p.H + (size_t)r * D + h * 256;
        float ss = 0.f; for (int e = 0; e < 256; ++e) { const float v = bf2f(o[e]); ss += v * v; }
        const float rs = 1.f / sqrtf(ss * (1.f / 256.f) + LN_EPS);
        for (int e = 0; e < 256; ++e) o[e] = f2bf(bf2f(o[e]) * rs * siluf(bf2f(p.Z1[(size_t)r * GINP + 2048 + h * 256 + e])));
    }
}

#define FD __device__ __forceinline__
#define TIE(a, b) asm volatile("" : "+v"(a) : "v"(b))
#define HWCOS(x) __builtin_amdgcn_cosf(x)
#define HWSIN(x) __builtin_amdgcn_sinf(x)
struct cf { float x, y; };
FD cf cadd(cf a, cf b) { return {a.x + b.x, a.y + b.y}; }
FD cf csub(cf a, cf b) { return {a.x - b.x, a.y - b.y}; }
FD cf cmul(cf a, cf b) { return {a.x * b.x - a.y * b.y, a.x * b.y + a.y * b.x}; }
#define C32(k) ((k)==0?1.0f:(k)==1?0.98078528040323043f:(k)==2?0.92387953251128674f:(k)==3?0.83146961230254524f:(k)==4?0.70710678118654752f:(k)==5?0.55557023301960222f:(k)==6?0.38268343236508977f:(k)==7?0.19509032201612825f:(k)==8?0.0f:(k)==9?-0.19509032201612825f:(k)==10?-0.38268343236508977f:(k)==11?-0.55557023301960222f:(k)==12?-0.70710678118654752f:(k)==13?-0.83146961230254524f:(k)==14?-0.92387953251128674f:-0.98078528040323043f)
#define S32(k) ((k)==0?0.0f:(k)==1?0.19509032201612825f:(k)==2?0.38268343236508977f:(k)==3?0.55557023301960222f:(k)==4?0.70710678118654752f:(k)==5?0.83146961230254524f:(k)==6?0.92387953251128674f:(k)==7?0.98078528040323043f:(k)==8?1.0f:(k)==9?0.98078528040323043f:(k)==10?0.92387953251128674f:(k)==11?0.83146961230254524f:(k)==12?0.70710678118654752f:(k)==13?0.55557023301960222f:(k)==14?0.38268343236508977f:0.19509032201612825f)
template <int N, int LEN, bool INV> FD void dit_level(cf (&x)[N]) {
#pragma unroll
    for (int blk = 0; blk < N; blk += LEN)
#pragma unroll
        for (int j = 0; j < LEN / 2; ++j) {
            const int k = j * (32 / LEN);
            const cf a = x[blk + j], b0 = x[blk + j + LEN / 2];
            const cf b = k == 0 ? b0 : (k == 8 ? (INV ? cf{-b0.y, b0.x} : cf{b0.y, -b0.x}) : cmul(b0, cf{C32(k), INV ? S32(k) : -S32(k)}));
            x[blk + j] = cadd(a, b); x[blk + j + LEN / 2] = csub(a, b);
        }
}
template <int N, bool INV> FD void dit_reg(cf (&x)[N]) {
    dit_level<N, 2, INV>(x); dit_level<N, 4, INV>(x);
    if constexpr (N >= 8) dit_level<N, 8, INV>(x);
    if constexpr (N >= 16) dit_level<N, 16, INV>(x);
}
template <int N, int LEN, bool INV> FD void dif_level(cf (&x)[N]) {
#pragma unroll
    for (int blk = 0; blk < N; blk += LEN)
#pragma unroll
        for (int j = 0; j < LEN / 2; ++j) {
            const int k = j * (32 / LEN);
            const cf a = x[blk + j], b = x[blk + j + LEN / 2];
            x[blk + j] = cadd(a, b); const cf d = csub(a, b);
            x[blk + j + LEN / 2] = k == 0 ? d : (k == 8 ? (INV ? cf{-d.y, d.x} : cf{d.y, -d.x}) : cmul(d, cf{C32(k), INV ? S32(k) : -S32(k)}));
        }
}
template <int N, bool INV> FD void dif_reg(cf (&x)[N]) {
    if constexpr (N >= 16) dif_level<N, 16, INV>(x);
    if constexpr (N >= 8) dif_level<N, 8, INV>(x);
    dif_level<N, 4, INV>(x); dif_level<N, 2, INV>(x);
}
constexpr int FFT_N = 16384, FFT_LDS_CF = 17920;
FD int brev4(int i) { return ((i & 1) << 3) | ((i & 2) << 1) | ((i & 4) >> 1) | ((i & 8) >> 3); }
FD int physA(int m, int a) { return 4480 * a + m + (m >> 4) + 16 * (m >> 9); }
FD int physB(int b, int a, int m) { return 4480 * b + 272 * a + 16 * (a >> 1) + m + (m >> 4); }
FD int physC(int b, int a, int m) { return 272 * b + 16 * (b >> 1) + 17 * a + m; }
FD int physD(int g, int j) { return 17 * g + 16 * (g >> 5) + j; }
template <int RR, int RM> FD void twiddle(cf (&x)[RR], int m, float sgn) {
    const float fr = (float)m * (1.0f / (float)RM); const cf w{HWCOS(fr), sgn * HWSIN(fr)}; cf cur = w;
#pragma unroll
    for (int s = 1; s < RR; ++s) { x[s] = cmul(x[s], cur); if (s + 1 < RR) cur = cmul(cur, w); }
}
FD void stA_fwd(int m, cf v0, cf v1, cf v2, cf v3, cf* buf) {
    cf x[4] = {v0, v2, v1, v3};
    dit_reg<4, false>(x); twiddle<4, 16384>(x, m, -1.f);
#pragma unroll
    for (int s = 0; s < 4; ++s) buf[physA(m, s)] = x[s];
}
FD void stB_fwd(int idx, cf* buf) {
    const int b = idx >> 8, m = idx & 255; cf x[16];
#pragma unroll
    for (int i = 0; i < 16; ++i) x[i] = buf[physB(b, brev4(i), m)];
    dit_reg<16, false>(x); twiddle<16, 4096>(x, m, -1.f);
#pragma unroll
    for (int s = 0; s < 16; ++s) buf[physB(b, s, m)] = x[s];
}
FD void stC_fwd(int idx, cf* buf) {
    const int b = idx >> 4, m = idx & 15; cf x[16];
#pragma unroll
    for (int i = 0; i < 16; ++i) x[i] = buf[physC(b, brev4(i), m)];
    dit_reg<16, false>(x); twiddle<16, 256>(x, m, -1.f);
#pragma unroll
    for (int s = 0; s < 16; ++s) buf[physC(b, s, m)] = x[s];
}
FD void stD_fwd_regs(int g, const cf* buf, cf (&x)[16]) {
#pragma unroll
    for (int i = 0; i < 16; ++i) x[i] = buf[physD(g, brev4(i))];
    dit_reg<16, false>(x);
}
FD void stD_mul(int g, cf* buf, const cf (&h)[16]) {
    cf x[16];
#pragma unroll
    for (int i = 0; i < 16; ++i) x[i] = buf[physD(g, brev4(i))];
    dit_reg<16, false>(x);
#pragma unroll
    for (int s = 0; s < 16; ++s) x[s] = cmul(x[s], h[s]);
    dif_reg<16, true>(x);
#pragma unroll
    for (int i = 0; i < 16; ++i) buf[physD(g, brev4(i))] = x[i];
}
FD void stC_inv(int idx, cf* buf) {
    const int b = idx >> 4, m = idx & 15; cf x[16];
#pragma unroll
    for (int s = 0; s < 16; ++s) x[s] = buf[physC(b, s, m)];
    twiddle<16, 256>(x, m, 1.f); dif_reg<16, true>(x);
#pragma unroll
    for (int i = 0; i < 16; ++i) buf[physC(b, brev4(i), m)] = x[i];
}
FD void stB_inv(int idx, cf* buf) {
    const int b = idx >> 8, m = idx & 255; cf x[16];
#pragma unroll
    for (int s = 0; s < 16; ++s) x[s] = buf[physB(b, s, m)];
    twiddle<16, 4096>(x, m, 1.f); dif_reg<16, true>(x);
#pragma unroll
    for (int i = 0; i < 16; ++i) buf[physB(b, brev4(i), m)] = x[i];
}
FD void stA_inv(int m, const cf* buf, cf& r0, cf& r1) {
    cf x[4];
#pragma unroll
    for (int s = 0; s < 4; ++s) x[s] = buf[physA(m, s)];
    twiddle<4, 16384>(x, m, 1.f); dif_reg<4, true>(x);
    r0 = x[0]; r1 = x[2];
}

#undef FD
__device__ __forceinline__ float dw3(const bf16_t* u, int d, int lo, int hi, float w0, float w1, float w2, float bs) {
    float a = bs + w1 * bf2f(u[d]);
    if (d > lo) a += w0 * bf2f(u[d - 1]);
    if (d < hi) a += w2 * bf2f(u[d + 1]);
    return a;
}
__device__ __forceinline__ void ph_hyena_fft(const P& p, unsigned char* smem) {
    cf* buf = (cf*)smem; float* fb = (float*)smem; float* red = (float*)(smem + FFT_LDS_CF * 8);
    const int t = TIDX;
    bf16_t* yhT = p.Zh + (size_t)2 * NB * 4 * NCH * 16384;
    for (int ch = blockIdx.x; ch < 512; ch += gridDim.x) {
        const bf16_t* hy0 = p.hyT + ((size_t)0 * 512 + ch) * RB;
        const size_t bstr = (size_t)3 * 512 * RB, jstr = (size_t)512 * RB;
        cf* Hg = (cf*)p.H + (size_t)blockIdx.x * 16384;
        cf zreg[16];
        float cw[3][3], cbv[3];
#pragma unroll
        for (int j = 0; j < 3; ++j) { cbv[j] = p.in[12][j * 512 + ch];
#pragma unroll
            for (int q = 0; q < 3; ++q) cw[j][q] = p.in[11][q * 1536 + j * 512 + ch]; }
#pragma unroll 1
        for (int n = 0; n < 2; ++n) {
            const int cfi = (n * 2) * 512 + ch, cbi = (n * 2 + 1) * 512 + ch;
            const float* Ff = p.FILT + (size_t)cfi * RB; const float* Fb = p.FILT + (size_t)cbi * RB;
            float tf0[8], tf1[8], tb2[8], tb3[8]; float sf = 0.f, sb = 0.f;
#pragma unroll
            for (int j = 0; j < 8; ++j) { const int m = t + 512 * j;
                tf0[j] = Ff[m]; tf1[j] = Ff[4096 + m]; tb2[j] = (m == 0) ? Fb[0] : Fb[8192 - (m == 0 ? 1 : m)]; tb3[j] = Fb[4096 - m];
                sf += tf0[j] * tf0[j] + tf1[j] * tf1[j]; sb += tb2[j] * tb2[j] + tb3[j] * tb3[j]; }
            const float nf = 1.f / sqrtf(block_sum(sf, red)), nb = 1.f / sqrtf(block_sum(sb, red));
#pragma unroll
            for (int j = 0; j < 8; ++j) { const int m = launder_i(t) + 512 * j;
                const float v0 = tf0[j] * nf + ((m == 0) ? tb2[j] * nb : 0.f), v2 = (m == 0) ? 0.f : tb2[j] * nb;
                stA_fwd(m, cf{v0, 0.f}, cf{tf1[j] * nf, 0.f}, cf{v2, 0.f}, cf{tb3[j] * nb, 0.f}, buf); }
            __syncthreads();
#pragma unroll 1
            for (int q = 0; q < 2; ++q) stB_fwd(launder_i(t) + 512 * q, buf);
            __syncthreads();
#pragma unroll 1
            for (int q = 0; q < 2; ++q) stC_fwd(launder_i(t) + 512 * q, buf);
            __syncthreads();
#pragma unroll 1
            for (int q = 0; q < 2; ++q) { const int g = launder_i(t) + 512 * q; cf hh[16]; stD_fwd_regs(g, buf, hh);
#pragma unroll
                for (int s = 0; s < 16; ++s) Hg[s * 1024 + g] = hh[s]; }
            __syncthreads();
#pragma unroll
            for (int j = 0; j < 8; ++j) { const int m = launder_i(t) + 512 * j;
                if (n == 0) { zreg[2 * j] = cf{dw3(hy0 + 2 * jstr, m, 0, L - 1, cw[2][0], cw[2][1], cw[2][2], cbv[2]), dw3(hy0 + bstr + 2 * jstr, m, 0, L - 1, cw[2][0], cw[2][1], cw[2][2], cbv[2])};
                              zreg[2 * j + 1] = cf{dw3(hy0 + 2 * jstr, 4096 + m, 0, L - 1, cw[2][0], cw[2][1], cw[2][2], cbv[2]), dw3(hy0 + bstr + 2 * jstr, 4096 + m, 0, L - 1, cw[2][0], cw[2][1], cw[2][2], cbv[2])}; }
                stA_fwd(m, zreg[2 * j], zreg[2 * j + 1], cf{0.f, 0.f}, cf{0.f, 0.f}, buf); }
            __syncthreads();
#pragma unroll 1
            for (int q = 0; q < 2; ++q) stB_fwd(launder_i(t) + 512 * q, buf);
            __syncthreads();
#pragma unroll 1
            for (int q = 0; q < 2; ++q) stC_fwd(launder_i(t) + 512 * q, buf);
            __syncthreads();
#pragma unroll 1
            for (int q = 0; q < 2; ++q) { const int g = launder_i(t) + 512 * q; cf hh[16];
#pragma unroll
                for (int s = 0; s < 16; ++s) hh[s] = Hg[s * 1024 + g];
                stD_mul(g, buf, hh); }
            __syncthreads();
#pragma unroll 1
            for (int q = 0; q < 2; ++q) stC_inv(launder_i(t) + 512 * q, buf);
            __syncthreads();
#pragma unroll 1
            for (int q = 0; q < 2; ++q) stB_inv(launder_i(t) + 512 * q, buf);
            __syncthreads();
            const float sk = p.in[21][n * 512 + ch];
#pragma unroll
            for (int j = 0; j < 8; ++j) { const int m = launder_i(t) + 512 * j; cf r0, r1; stA_inv(m, buf, r0, r1);
#pragma unroll
                for (int hlf = 0; hlf < 2; ++hlf) { const int d = m + 4096 * hlf; const cf r = hlf ? r1 : r0; const cf z = zreg[2 * j + hlf];
                    const bf16_t* gs = hy0 + n * jstr;
                    const float g0 = dw3(gs, d, 0, L - 1, cw[n][0], cw[n][1], cw[n][2], cbv[n]), g1 = dw3(gs + bstr, d, 0, L - 1, cw[n][0], cw[n][1], cw[n][2], cbv[n]);
                    const float o0 = g0 * (r.x * (1.f / 16384.f) + sk * z.x), o1 = g1 * (r.y * (1.f / 16384.f) + sk * z.y);
                    if (n == 0) zreg[2 * j + hlf] = cf{o0, o1};
                    else { yhT[((size_t)0 * 512 + ch) * RB + d] = f2bf(o0); yhT[((size_t)1 * 512 + ch) * RB + d] = f2bf(o1); } } }
            __syncthreads();
        }
        {
            float* tap = fb;
            float* zc = fb + 1024;
            const int b = t >> 8, tt = t & 255;
#pragma unroll
            for (int n = 0; n < 2; ++n) {
                const int cfi = (n * 2) * 512 + ch, cbi = (n * 2 + 1) * 512 + ch;
                const float* Ff = p.FILT + (size_t)cfi * RB + L; const float* Fb = p.FILT + (size_t)cbi * RB + L;
                const float vf = t < 256 ? Ff[t] : 0.f, vb = t < 256 ? Fb[t] : 0.f;
                const float nf = 1.f / sqrtf(block_sum(vf * vf, red)), nb = 1.f / sqrtf(block_sum(vb * vb, red));
                if (t < 511) { const int d = t - 255; tap[n * 512 + t] = d > 0 ? Ff[d] * nf : (d < 0 ? Fb[-d] * nb : Ff[0] * nf + Fb[0] * nb); }
            }
            const bf16_t* hb_ = hy0 + (size_t)b * bstr;
            const float z1 = dw3(hb_ + 2 * jstr, L + tt, L, RB - 1, cw[2][0], cw[2][1], cw[2][2], cbv[2]);
            zc[b * 256 + tt] = z1;
            __syncthreads();
            float c1 = 0.f;
            for (int s = 0; s < 256; ++s) c1 += tap[tt - s + 255] * zc[b * 256 + s];
            const float z2 = dw3(hb_, L + tt, L, RB - 1, cw[0][0], cw[0][1], cw[0][2], cbv[0]) * (c1 + p.in[21][ch] * z1);
            __syncthreads();
            zc[b * 256 + tt] = z2;
            __syncthreads();
            float c2 = 0.f;
            for (int s = 0; s < 256; ++s) c2 += tap[512 + tt - s + 255] * zc[b * 256 + s];
            yhT[((size_t)b * 512 + ch) * RB + L + tt] = f2bf(dw3(hb_ + jstr, L + tt, L, RB - 1, cw[1][0], cw[1][1], cw[1][2], cbv[1]) * (c2 + p.in[21][512 + ch] * z2));
            __syncthreads();
        }
    }
}

typedef short bf16x8 __attribute__((ext_vector_type(8)));
typedef short s16x4 __attribute__((ext_vector_type(4)));
typedef float f32x4 __attribute__((ext_vector_type(4)));
typedef unsigned u4v __attribute__((ext_vector_type(4)));
typedef unsigned u2v __attribute__((ext_vector_type(2)));
constexpr int LDT = 136;
constexpr int TILE_E = 128 * LDT;
__device__ __forceinline__ bf16x8 frag_row(const LAS bf16_t* T, int ld, int r0, int k0, int lane) {
    return *(const LAS bf16x8*)(T + (r0 + (lane & 15)) * ld + k0 + 8 * (lane >> 4));
}
__device__ __forceinline__ bf16x8 frag_tr(const LAS bf16_t* T, int ld, int k0, int n0, int lane) {
    const int g = lane >> 4, q = (lane & 15) >> 2, pp = lane & 3;
    const LAS bf16_t* a0 = T + (k0 + 8 * g + q) * ld + n0 + 4 * pp;
    const s16x4 lo = __builtin_amdgcn_ds_read_tr16_b64_v4i16((LAS s16x4*)a0);
    const s16x4 hi = __builtin_amdgcn_ds_read_tr16_b64_v4i16((LAS s16x4*)(a0 + 4 * ld));
    return (bf16x8){lo[0], lo[1], lo[2], lo[3], hi[0], hi[1], hi[2], hi[3]};
}
#define MFMA16(xn, xm, acc) __builtin_amdgcn_mfma_f32_16x16x32_bf16(xn, xm, acc, 0, 0, 0)
__device__ __forceinline__ void unpack8(const u4v u, float (&f)[8]) {
    f[0] = __uint_as_float(u.x << 16); f[1] = __uint_as_float(u.x & 0xffff0000u); f[2] = __uint_as_float(u.y << 16); f[3] = __uint_as_float(u.y & 0xffff0000u);
    f[4] = __uint_as_float(u.z << 16); f[5] = __uint_as_float(u.z & 0xffff0000u); f[6] = __uint_as_float(u.w << 16); f[7] = __uint_as_float(u.w & 0xffff0000u);
}
__device__ __forceinline__ u4v pack8(const float (&f)[8]) {
    u4v u; u.x = pk_bf16(f[0], f[1]); u.y = pk_bf16(f[2], f[3]); u.z = pk_bf16(f[4], f[5]); u.w = pk_bf16(f[6], f[7]); return u;
}
__device__ __forceinline__ void stage_tile(LAS bf16_t* dst, const bf16_t* src, int gld, int tid) {
#pragma unroll
    for (int i = 0; i < 4; ++i) { const int c = tid + 512 * i, row = c >> 4, ch = c & 15;
        *(LAS u4v*)(dst + row * LDT + ch * 8) = *(const u4v*)(src + (size_t)row * gld + ch * 8); }
}
__device__ __forceinline__ void ph_retU_mfma(const P& p, unsigned char* smem) {
    LAS bf16_t* Kt = (LAS bf16_t*)smem; LAS bf16_t* VF = Kt + TILE_E; LAS bf16_t* VB = VF + TILE_E;
    bf16_t* ST = p.Zh;
    for (int u = blockIdx.x; u < NB * 4 * NCH; u += gridDim.x) {
        const int tid = TIDX, lane = tid & 63, w = tid >> 6;
        const int c = u % NCH, h = (u / NCH) % 4, b = u / (NCH * 4); const int r0 = chunk_row0(b, c);
        const float lgf = p.in[9][h], lgb = p.in[10][h];
        const bf16_t* kb = p.Zr + (size_t)r0 * 2048 + 512 + h * 128; const bf16_t* vb = p.Zr + (size_t)r0 * 2048 + 1024 + h * 128;
        __syncthreads();
        stage_tile(Kt, kb, 2048, tid);
#pragma unroll
        for (int i = 0; i < 4; ++i) { const int cc = tid + 512 * i, j = cc >> 4, ch = cc & 15;
            float f[8], g[8]; unpack8(*(const u4v*)(vb + (size_t)j * 2048 + ch * 8), f);
            const float wf = __expf(lgf * (float)(127 - j)), wb = __expf(lgb * (float)j);
#pragma unroll
            for (int q = 0; q < 8; ++q) { g[q] = f[q] * wb; f[q] *= wf; }
            *(LAS u4v*)(VF + j * LDT + ch * 8) = pack8(f); *(LAS u4v*)(VB + j * LDT + ch * 8) = pack8(g); }
        __syncthreads();
        f32x4 af[8], ab[8];
#pragma unroll
        for (int nt = 0; nt < 8; ++nt) { af[nt] = (f32x4){0.f, 0.f, 0.f, 0.f}; ab[nt] = (f32x4){0.f, 0.f, 0.f, 0.f}; }
#pragma unroll
        for (int ks = 0; ks < 4; ++ks) {
            const bf16x8 xf = frag_tr(VF, LDT, 32 * ks, 16 * w, lane), xb = frag_tr(VB, LDT, 32 * ks, 16 * w, lane);
#pragma unroll
            for (int nt = 0; nt < 8; ++nt) { const bf16x8 xn = frag_tr(Kt, LDT, 32 * ks, 16 * nt, lane); af[nt] = MFMA16(xn, xf, af[nt]); ab[nt] = MFMA16(xn, xb, ab[nt]); }
        }
        const int e = 16 * w + (lane & 15), d0 = 4 * (lane >> 4);
        bf16_t* of = ST + st_idx(0, b, h, c) + e * 128 + d0; bf16_t* ob = ST + st_idx(1, b, h, c) + e * 128 + d0;
#pragma unroll
        for (int nt = 0; nt < 8; ++nt) {
            u2v o; o.x = pk_bf16(af[nt][0], af[nt][1]); o.y = pk_bf16(af[nt][2], af[nt][3]); *(u2v*)(of + 16 * nt) = o;
            o.x = pk_bf16(ab[nt][0], ab[nt][1]); o.y = pk_bf16(ab[nt][2], ab[nt][3]); *(u2v*)(ob + 16 * nt) = o; }
    }
}
__device__ __forceinline__ void ph_retO_mfma(const P& p, unsigned char* smem) {
    LAS bf16_t* Qs = (LAS bf16_t*)smem; LAS bf16_t* Ks = Qs + TILE_E; LAS bf16_t* Vs = Ks + TILE_E; LAS bf16_t* Ss = Vs + TILE_E;
    const bf16_t* ST = p.Zh;
    for (int u = blockIdx.x; u < NB * 4 * NCH; u += gridDim.x) {
        const int tid = TIDX, lane = tid & 63, w = tid >> 6, fr = lane & 15, fq = lane >> 4;
        const int c = u % NCH, h = (u / NCH) % 4, b = u / (NCH * 4); const int r0 = chunk_row0(b, c);
        const float lgf = p.in[9][h], lgb = p.in[10][h];
        const bf16_t* zb = p.Zr + (size_t)r0 * 2048 + h * 128;
        __syncthreads();
        stage_tile(Qs, zb, 2048, tid); stage_tile(Ks, zb + 512, 2048, tid); stage_tile(Vs, zb + 1024, 2048, tid); stage_tile(Ss, ST + st_idx(0, b, h, c), 128, tid);
        __syncthreads();
        f32x4 as[8], af[8];
#pragma unroll
        for (int nt = 0; nt < 8; ++nt) { as[nt] = (f32x4){0.f, 0.f, 0.f, 0.f}; af[nt] = (f32x4){0.f, 0.f, 0.f, 0.f}; }
#pragma unroll
        for (int ks = 0; ks < 4; ++ks) { const bf16x8 xm = frag_row(Qs, LDT, 16 * w, 32 * ks, lane);
#pragma unroll
            for (int nt = 0; nt < 8; ++nt) { as[nt] = MFMA16(frag_row(Ks, LDT, 16 * nt, 32 * ks, lane), xm, as[nt]); af[nt] = MFMA16(frag_row(Ss, LDT, 16 * nt, 32 * ks, lane), xm, af[nt]); } }
        const int i = 16 * w + fr;
        __syncthreads();
#pragma unroll
        for (int nt = 0; nt < 8; ++nt) { float pv[4];
#pragma unroll
            for (int q = 0; q < 4; ++q) { const int j = 16 * nt + 4 * fq + q; const float m = i > j ? __expf(lgf * (float)(i - j)) : (j > i ? __expf(lgb * (float)(j - i)) : 2.f); pv[q] = as[nt][q] * m; }
            u2v o; o.x = pk_bf16(pv[0], pv[1]); o.y = pk_bf16(pv[2], pv[3]); *(LAS u2v*)(Ks + i * LDT + 16 * nt + 4 * fq) = o; }
        stage_tile(Ss, ST + st_idx(1, b, h, c), 128, tid);
        __syncthreads();
        f32x4 ao[8], ab[8];
#pragma unroll
        for (int nt = 0; nt < 8; ++nt) { ao[nt] = (f32x4){0.f, 0.f, 0.f, 0.f}; ab[nt] = (f32x4){0.f, 0.f, 0.f, 0.f}; }
#pragma unroll
        for (int ks = 0; ks < 4; ++ks) { const bf16x8 xp = frag_row(Ks, LDT, 16 * w, 32 * ks, lane), xq = frag_row(Qs, LDT, 16 * w, 32 * ks, lane);
#pragma unroll
            for (int nt = 0; nt < 8; ++nt) { ao[nt] = MFMA16(frag_tr(Vs, LDT, 32 * ks, 16 * nt, lane), xp, ao[nt]); ab[nt] = MFMA16(frag_row(Ss, LDT, 16 * nt, 32 * ks, lane), xq, ab[nt]); } }
        const float rf = __expf(lgf * (float)(i + 1)), rb = __expf(lgb * (float)(128 - i));
        float s = 0.f;
#pragma unroll
        for (int nt = 0; nt < 8; ++nt) { ao[nt] = ao[nt] + af[nt] * rf + ab[nt] * rb; s += (ao[nt][0] + ao[nt][1]) + (ao[nt][2] + ao[nt][3]); }
        s += __shfl_xor(s, 16); s += __shfl_xor(s, 32);
        const float mu = s * (1.f / 128.f); float qv = 0.f;
#pragma unroll
        for (int nt = 0; nt < 8; ++nt) { const f32x4 dd = ao[nt] - mu; qv += (dd[0] * dd[0] + dd[1] * dd[1]) + (dd[2] * dd[2] + dd[3] * dd[3]); }
        qv += __shfl_xor(qv, 16); qv += __shfl_xor(qv, 32);
        const float rs = 1.f / sqrtf(qv * (1.f / 128.f) + LN_EPS);
        const bf16_t* gp = p.Zr + (size_t)(r0 + i) * 2048 + 1536 + h * 128 + 4 * fq; bf16_t* yp = p.H + (size_t)(r0 + i) * D + h * 128 + 4 * fq;
#pragma unroll
        for (int nt = 0; nt < 8; ++nt) { const u2v gu = *(const u2v*)(gp + 16 * nt);
            const float g0 = __uint_as_float(gu.x << 16), g1 = __uint_as_float(gu.x & 0xffff0000u), g2 = __uint_as_float(gu.y << 16), g3 = __uint_as_float(gu.y & 0xffff0000u);
            u2v o; o.x = pk_bf16((ao[nt][0] - mu) * rs * siluf(g0), (ao[nt][1] - mu) * rs * siluf(g1)); o.y = pk_bf16((ao[nt][2] - mu) * rs * siluf(g2), (ao[nt][3] - mu) * rs * siluf(g3));
            *(u2v*)(yp + 16 * nt) = o; }
    }
}
__device__ __forceinline__ void ph_glaU_mfma(const P& p, unsigned char* smem) {
    LAS bf16_t* KF = (LAS bf16_t*)smem; LAS bf16_t* KB = KF + TILE_E; LAS bf16_t* Vs = KB + TILE_E;
    for (int u = blockIdx.x; u < NB * 4 * NCH; u += gridDim.x) {
        const int tid = TIDX, lane = tid & 63, w = tid >> 6;
        const int c = u % NCH, h = (u / NCH) % 4, b = u / (NCH * 4); const int r0 = chunk_row0(b, c);
        const bf16_t* kb = p.Z1 + (size_t)r0 * GINP + 512 + h * 128; const bf16_t* vb = p.Z1 + (size_t)r0 * GINP + 1024 + h * 256;
        float* BFw = p.BG + (size_t)r0 * 512 + h * 128; float* BBw = p.BG + (size_t)R * 512 + (size_t)r0 * 512 + h * 128;
        const float* BF = BFw; const float* BB = BBw;
        __syncthreads();
        {
            float* lr = (float*)(Vs);
            float* tot = lr + 128 * 32;
            for (int e = tid; e < 128 * 32; e += NT) lr[e] = bf2f(p.Z1[(size_t)(r0 + (e >> 5)) * GINP + 3072 + (e & 31)]);
            const int chn = tid & 127, dir = (tid >> 7) & 1, half = tid >> 8;
            const float* gw = (dir ? p.in[26] : p.in[24]) + h * 128 + chn; float g[16];
#pragma unroll
            for (int q = 0; q < 16; ++q) g[q] = gw[q * 512];
            const float gb = (dir ? p.in[27] : p.in[25])[h * 128 + chn];
            __syncthreads();
            float la[64]; float s = 0.f;
#pragma unroll
            for (int ii = 0; ii < 64; ++ii) { const int i = half * 64 + ii; float a = gb;
#pragma unroll
                for (int q = 0; q < 16; ++q) a += lr[i * 32 + dir * 16 + q] * g[q];
                la[ii] = (fminf(a, 0.f) - __logf(1.f + __expf(-fabsf(a)))) * (1.f / 16.f); s += la[ii]; }
            tot[(dir * 2 + half) * 128 + chn] = s;
            __syncthreads();
            const float total = tot[(dir * 2 + 0) * 128 + chn] + tot[(dir * 2 + 1) * 128 + chn];
            s = dir == 0 ? (half ? tot[(0 * 2 + 0) * 128 + chn] : 0.f) : (half ? 0.f : tot[(1 * 2 + 1) * 128 + chn]);
            float* out = (dir ? BBw : BFw) + chn; LAS bf16_t* Kd = dir ? KB : KF;
            if (dir == 0) {
#pragma unroll
                for (int ii = 0; ii < 64; ++ii) { const int i = half * 64 + ii; s += la[ii]; out[(size_t)i * 512] = s; Kd[i * LDT + chn] = f2bf(bf2f(kb[(size_t)i * GINP + chn]) * __expf(total - s)); }
            } else {
#pragma unroll
                for (int ii = 63; ii >= 0; --ii) { const int i = half * 64 + ii; s += la[ii]; out[(size_t)i * 512] = s; Kd[i * LDT + chn] = f2bf(bf2f(kb[(size_t)i * GINP + chn]) * __expf(total - s)); }
            }
            __syncthreads();
        }
        const int fr = lane & 15, fq = lane >> 4;
#pragma unroll 1
        for (int hf = 0; hf < 2; ++hf) {
            if (hf) __syncthreads();
            stage_tile(Vs, vb + hf * 128, GINP, tid);
            __syncthreads();
            {
                f32x4 af[8], ab[8];
#pragma unroll
                for (int nt = 0; nt < 8; ++nt) { af[nt] = (f32x4){0.f, 0.f, 0.f, 0.f}; ab[nt] = (f32x4){0.f, 0.f, 0.f, 0.f}; }
#pragma unroll
                for (int ks = 0; ks < 4; ++ks) { const bf16x8 x0 = frag_tr(Vs, LDT, 32 * ks, 16 * w, lane);
#pragma unroll
                    for (int nt = 0; nt < 8; ++nt) { af[nt] = MFMA16(frag_tr(KF, LDT, 32 * ks, 16 * nt, lane), x0, af[nt]); ab[nt] = MFMA16(frag_tr(KB, LDT, 32 * ks, 16 * nt, lane), x0, ab[nt]); } }
                bf16_t* of = p.GST + gst_idx(0, b, h, c) + (size_t)(hf * 128 + 16 * w + fr) * 128 + 4 * fq; bf16_t* ob = p.GST + gst_idx(1, b, h, c) + (size_t)(hf * 128 + 16 * w + fr) * 128 + 4 * fq;
#pragma unroll
                for (int nt = 0; nt < 8; ++nt) { u2v v; v.x = pk_bf16(af[nt][0], af[nt][1]); v.y = pk_bf16(af[nt][2], af[nt][3]); *(u2v*)(of + 16 * nt) = v;
                    v.x = pk_bf16(ab[nt][0], ab[nt][1]); v.y = pk_bf16(ab[nt][2], ab[nt][3]); *(u2v*)(ob + 16 * nt) = v; }
            }
        }
    }
}
__device__ __forceinline__ void stage_scaled(LAS bf16_t* dst, const bf16_t* src, const float* G, float sgn, float mul, int tid) {
#pragma unroll
    for (int i = 0; i < 4; ++i) { const int cc = tid + 512 * i, j = cc >> 4, ch = cc & 15;
        float k8[8]; unpack8(*(const u4v*)(src + (size_t)j * GINP + ch * 8), k8);
        const f32x4 f0 = *(const f32x4*)(G + (size_t)j * 512 + ch * 8), f1 = *(const f32x4*)(G + (size_t)j * 512 + ch * 8 + 4);
#pragma unroll
        for (int q = 0; q < 4; ++q) { k8[q] *= __expf(sgn * f0[q]) * mul; k8[q + 4] *= __expf(sgn * f1[q]) * mul; }
        *(LAS u4v*)(dst + j * LDT + ch * 8) = pack8(k8); }
}
__device__ __forceinline__ void ph_glaO_mfma(const P& p, unsigned char* smem) {
    LAS bf16_t* QF = (LAS bf16_t*)smem; LAS bf16_t* QB = QF + TILE_E; LAS bf16_t* KX = QB + TILE_E; LAS bf16_t* R4 = KX + TILE_E;
    for (int u = blockIdx.x; u < NB * 4 * 64; u += gridDim.x) {
        const int tid = TIDX, lane = tid & 63, w = tid >> 6, fr = lane & 15, fq = lane >> 4;
        const int c = 2 + u % 64, h = (u / 64) % 4, b = u / 256; const int r0 = chunk_row0(b, c);
        const bf16_t* qb = p.Z1 + (size_t)r0 * GINP + h * 128; const bf16_t* kb = qb + 512; const bf16_t* vb = p.Z1 + (size_t)r0 * GINP + 1024 + h * 256;
        const float* BF = p.BG + (size_t)r0 * 512 + h * 128; const float* BB = p.BG + (size_t)R * 512 + (size_t)r0 * 512 + h * 128;
        const int i = 16 * w + fr;
        __syncthreads();
        stage_scaled(QF, qb, BF, 1.f, KSCALE, tid); stage_scaled(QB, qb, BB, 1.f, KSCALE, tid); stage_scaled(KX, kb, BF, -1.f, 1.f, tid);
        __syncthreads();
        f32x4 s1[8];
#pragma unroll
        for (int nt = 0; nt < 8; ++nt) s1[nt] = (f32x4){0.f, 0.f, 0.f, 0.f};
#pragma unroll
        for (int ks = 0; ks < 4; ++ks) { const bf16x8 xm = frag_row(QF, LDT, 16 * w, 32 * ks, lane);
#pragma unroll
            for (int nt = 0; nt < 8; ++nt) s1[nt] = MFMA16(frag_row(KX, LDT, 16 * nt, 32 * ks, lane), xm, s1[nt]); }
#pragma unroll
        for (int nt = 0; nt < 8; ++nt)
#pragma unroll
            for (int q = 0; q < 4; ++q) { const int j = 16 * nt + 4 * fq + q; s1[nt][q] = (i >= j) ? s1[nt][q] : 0.f; }
        __syncthreads();
        stage_scaled(KX, kb, BB, -1.f, 1.f, tid);
        __syncthreads();
        {
            f32x4 s2[8];
#pragma unroll
            for (int nt = 0; nt < 8; ++nt) s2[nt] = (f32x4){0.f, 0.f, 0.f, 0.f};
#pragma unroll
            for (int ks = 0; ks < 4; ++ks) { const bf16x8 xm = frag_row(QB, LDT, 16 * w, 32 * ks, lane);
#pragma unroll
                for (int nt = 0; nt < 8; ++nt) s2[nt] = MFMA16(frag_row(KX, LDT, 16 * nt, 32 * ks, lane), xm, s2[nt]); }
#pragma unroll
            for (int nt = 0; nt < 8; ++nt)
#pragma unroll
                for (int q = 0; q < 4; ++q) { const int j = 16 * nt + 4 * fq + q; s1[nt][q] += (i <= j) ? s2[nt][q] : 0.f; }
        }
        __syncthreads();
#pragma unroll
        for (int nt = 0; nt < 8; ++nt) { u2v o; o.x = pk_bf16(s1[nt][0], s1[nt][1]); o.y = pk_bf16(s1[nt][2], s1[nt][3]); *(LAS u2v*)(KX + i * LDT + 16 * nt + 4 * fq) = o; }
        f32x4 ao[2][8];
#pragma unroll
        for (int hf = 0; hf < 2; ++hf) {
#pragma unroll
            for (int nt = 0; nt < 8; ++nt) ao[hf][nt] = (f32x4){0.f, 0.f, 0.f, 0.f};
            stage_tile(R4, vb + hf * 128, GINP, tid);
            __syncthreads();
#pragma unroll
            for (int ks = 0; ks < 4; ++ks) { const bf16x8 xp = frag_row(KX, LDT, 16 * w, 32 * ks, lane);
#pragma unroll
                for (int nt = 0; nt < 8; ++nt) ao[hf][nt] = MFMA16(frag_tr(R4, LDT, 32 * ks, 16 * nt, lane), xp, ao[hf][nt]); }
            __syncthreads();
            stage_tile(R4, p.GST + gst_idx(0, b, h, c) + (size_t)hf * 128 * 128, 128, tid);
            __syncthreads();
#pragma unroll
            for (int ks = 0; ks < 4; ++ks) { const bf16x8 xq = frag_row(QF, LDT, 16 * w, 32 * ks, lane);
#pragma unroll
                for (int nt = 0; nt < 8; ++nt) ao[hf][nt] = MFMA16(frag_row(R4, LDT, 16 * nt, 32 * ks, lane), xq, ao[hf][nt]); }
            __syncthreads();
            stage_tile(R4, p.GST + gst_idx(1, b, h, c) + (size_t)hf * 128 * 128, 128, tid);
            __syncthreads();
#pragma unroll
            for (int ks = 0; ks < 4; ++ks) { const bf16x8 xq = frag_row(QB, LDT, 16 * w, 32 * ks, lane);
#pragma unroll
                for (int nt = 0; nt < 8; ++nt) ao[hf][nt] = MFMA16(frag_row(R4, LDT, 16 * nt, 32 * ks, lane), xq, ao[hf][nt]); }
            __syncthreads();
        }
        float ss = 0.f;
#pragma unroll
        for (int hf = 0; hf < 2; ++hf)
#pragma unroll
            for (int nt = 0; nt < 8; ++nt) { const f32x4 v = ao[hf][nt]; ss += (v[0] * v[0] + v[1] * v[1]) + (v[2] * v[2] + v[3] * v[3]); }
        ss += __shfl_xor(ss, 16); ss += __shfl_xor(ss, 32);
        const float rs = 1.f / sqrtf(ss * (1.f / 256.f) + LN_EPS);
        const bf16_t* gp = p.Z1 + (size_t)(r0 + i) * GINP + 2048 + h * 256 + 4 * fq; bf16_t* yp = p.H + (size_t)(r0 + i) * D + h * 256 + 4 * fq;
#pragma unroll
        for (int hf = 0; hf < 2; ++hf)
#pragma unroll
            for (int nt = 0; nt < 8; ++nt) { const u2v gu = *(const u2v*)(gp + hf * 128 + 16 * nt);
                const float g0 = __uint_as_float(gu.x << 16), g1 = __uint_as_float(gu.x & 0xffff0000u), g2 = __uint_as_float(gu.y << 16), g3 = __uint_as_float(gu.y & 0xffff0000u);
                u2v o; o.x = pk_bf16(ao[hf][nt][0] * rs * siluf(g0), ao[hf][nt][1] * rs * siluf(g1)); o.y = pk_bf16(ao[hf][nt][2] * rs * siluf(g2), ao[hf][nt][3] * rs * siluf(g3));
                *(u2v*)(yp + hf * 128 + 16 * nt) = o; }
    }
}

template <int MODE> __device__ __forceinline__ void tr_w(bf16_t* dst, const float* src, int N, int K, int ldsrc, float* t  , int& tile0, int tile_stride) {
    const int nt_n = N / 64, ntiles = nt_n * (K / 64);
    float v[8];
    if (tile0 < ntiles) { const int tid = TIDX; const int n0 = (tile0 % nt_n) * 64, k0 = (tile0 / nt_n) * 64;
#pragma unroll
        for (int i = 0; i < 8; ++i) { const int e = tid + 512 * i; v[i] = src[(size_t)(k0 + (e >> 6)) * ldsrc + n0 + (e & 63)]; } }
    for (int tile = tile0; tile < ntiles; tile += tile_stride) {
        const int tid = TIDX; const int n0 = (tile % nt_n) * 64, k0 = (tile / nt_n) * 64;
        __syncthreads();
#pragma unroll
        for (int i = 0; i < 8; ++i) { const int e = tid + 512 * i; t[(e >> 6) * 65 + (e & 63)] = v[i]; }
        __syncthreads();
        if (tile + tile_stride < ntiles) { const int tn = tile + tile_stride; const int n1 = (tn % nt_n) * 64, k1 = (tn / nt_n) * 64;
#pragma unroll
            for (int i = 0; i < 8; ++i) { const int e = tid + 512 * i; v[i] = src[(size_t)(k1 + (e >> 6)) * ldsrc + n1 + (e & 63)]; } }
#pragma unroll
        for (int i = 0; i < 4; ++i) { const int e = tid + 512 * i, nn = e >> 5, kp = e & 31; const int n = n0 + nn;
            int row; float sc = 1.f;
            if (MODE == 0) row = n; else if (MODE == 3) { const int d = n & 127; row = n < 1024 ? (n - d) + 2 * (d & 63) + (d >> 6) : n; sc = (n >= 512 && n < 1024) ? KSCALE : 1.f; }
            else row = 8 * (n >> 2) + (n & 3) + (MODE == 2 ? 4 : 0);
            *(unsigned*)(dst + (size_t)row * K + k0 + 2 * kp) = pk_bf16(t[(2 * kp) * 65 + nn] * sc, t[(2 * kp + 1) * 65 + nn] * sc); }
    }
    tile0 = tile0 - (ntiles % tile_stride);
    if (tile0 < 0) tile0 += tile_stride;
}
__device__ __forceinline__ void ph_wconv_fast(const P& p, float* t) {
    int t0 = blockIdx.x; const int G = gridDim.x;
    tr_w<3>(p.Win0, p.in[8], ABIN, D, ABIN, t, t0, G);
    tr_w<0>(p.Wout0, p.in[22], D, D, D, t, t0, G);
    tr_w<0>(p.Win1, p.in[23], 3072, D, GIN, t, t0, G);
    tr_w<0>(p.Wout1, p.in[28], D, D, D, t, t0, G);
    GSTRIDE(idx, (long)(GINP - 3072) * D) { const int k = idx % D, n = 3072 + idx / D; p.Win1[(size_t)n * D + k] = n < GIN ? f2bf(p.in[23][(size_t)k * GIN + n]) : (bf16_t)0; }
}
__device__ __forceinline__ void ph_wconv_moe_fast(const P& p, int l, float* t) {
    int t0 = blockIdx.x; const int G = gridDim.x;
    for (int e = 0; e < NE; ++e) {
        tr_w<1>(p.Wgu + (size_t)e * 1024 * 1024, p.in[31] + (size_t)(l * NE + e) * D * EH, EH, D, EH, t, t0, G);
        tr_w<2>(p.Wgu + (size_t)e * 1024 * 1024, p.in[32] + (size_t)(l * NE + e) * D * EH, EH, D, EH, t, t0, G);
        tr_w<0>(p.Wd + (size_t)e * 1024 * 512, p.in[33] + (size_t)(l * NE + e) * EH * D, D, EH, D, t, t0, G);
    }
}
__device__ __forceinline__ void ph_prep_hy_fast(const P& p, float* t  ) {
    const int ntt = RB / 64, ntc = 1536 / 64;
    for (int tile = blockIdx.x; tile < NB * ntt * ntc; tile += gridDim.x) {
        const int tid = TIDX; const int ct = tile % ntc, tt = (tile / ntc) % ntt, b = tile / (ntc * ntt); const int c0 = ct * 64, tl0 = tt * 64;
        const int s0 = tl0 < L ? 0 : L, s1 = tl0 < L ? L : RB;
        __syncthreads();
        for (int e = tid; e < 66 * 64; e += NT) { const int rr = e >> 6, cc = e & 63, tl = tl0 - 1 + rr;
            t[rr * 65 + cc] = (tl >= s0 && tl < s1) ? bf2f(p.Zh[(size_t)bt_row(b, tl) * 1536 + c0 + cc]) : 0.f; }
        __syncthreads();
#pragma unroll
        for (int i = 0; i < 4; ++i) { const int e = tid + 512 * i, cc = e >> 5, tp = e & 31; const int col = c0 + cc;
            const float w0 = p.in[11][col], w1 = p.in[11][1536 + col], w2 = p.in[11][3072 + col], bs = p.in[12][col];
            const float a = bs + w0 * t[(2 * tp) * 65 + cc] + w1 * t[(2 * tp + 1) * 65 + cc] + w2 * t[(2 * tp + 2) * 65 + cc];
            const float c2 = bs + w0 * t[(2 * tp + 1) * 65 + cc] + w1 * t[(2 * tp + 2) * 65 + cc] + w2 * t[(2 * tp + 3) * 65 + cc];
            *(unsigned*)(p.hyT + ((size_t)b * 1536 + col) * RB + tl0 + 2 * tp) = pk_bf16(a, c2); }
    }
}
__device__ __forceinline__ void ph_hy_untranspose_fast(const P& p, float* t) {
    const bf16_t* yhT = p.Zh + (size_t)2 * NB * 4 * NCH * 16384;
    const int ntt = RB / 64, ntc = 512 / 64;
    for (int tile = blockIdx.x; tile < NB * ntt * ntc; tile += gridDim.x) {
        const int tid = TIDX; const int ct = tile % ntc, tt = (tile / ntc) % ntt, b = tile / (ntc * ntt); const int c0 = ct * 64, tl0 = tt * 64;
        __syncthreads();
#pragma unroll
        for (int i = 0; i < 8; ++i) { const int e = tid + 512 * i, cc = e >> 6, ti = e & 63; t[cc * 65 + ti] = bf2f(yhT[((size_t)b * 512 + c0 + cc) * RB + tl0 + ti]); }
        __syncthreads();
#pragma unroll
        for (int i = 0; i < 4; ++i) { const int e = tid + 512 * i, ti = e >> 5, cp = e & 31;
            *(unsigned*)(p.H + (size_t)bt_row(b, tl0 + ti) * D + 512 + c0 + 2 * cp) = pk_bf16(t[(2 * cp) * 65 + ti], t[(2 * cp + 1) * 65 + ti]); }
    }
}
__device__ __forceinline__ void ph_prep_rope_fast(const P& p) {
    GSTRIDE(idx, (long)R * 2 * 4 * 8) {
        const int pc = idx % 8, h = (idx / 8) % 4, w = (idx / 32) % 2, r = idx / 64;
        bf16_t* base = p.Zr + (size_t)r * 2048 + w * 512 + h * 128 + pc * 8;
        float a[8], c[8]; unpack8(*(const u4v*)base, a); unpack8(*(const u4v*)(base + 64), c);
        const float sc = w ? KSCALE : 1.f;
        if (r < RL) {
            const int t = r % L; const float pos = (pc < 4) ? (float)(t / GW) : (float)(t % GW);
#pragma unroll
            for (int q = 0; q < 8; ++q) { const int pr = pc * 8 + q; const float inv = exp2f(-(float)(pr & 31) * (13.287712379549449f / 32.f));
                float sn, cs; sincosf(pos * inv, &sn, &cs); const float x1 = a[q] * sc, x2 = c[q] * sc; a[q] = x1 * cs - x2 * sn; c[q] = x1 * sn + x2 * cs; }
        } else {
#pragma unroll
            for (int q = 0; q < 8; ++q) { a[q] *= sc; c[q] *= sc; }
        }
        *(u4v*)base = pack8(a); *(u4v*)(base + 64) = pack8(c);
    }
}
__device__ __forceinline__ void ph_mod_fast(const P& p, int l, int which, const float* xl  , const float* xc  ) {
    const int lane = TIDX & 63, gw = blockIdx.x * (NT / 64) + (TIDX >> 6), ngw = gridDim.x * (NT / 64);
    for (int r = gw; r < R; r += ngw) {
        const float* x = r < RL ? xl + (size_t)r * D : xc + (size_t)(r - RL) * D; const float* sh = modv(p, l, r, which * 3 + 0); const float* sc = modv(p, l, r, which * 3 + 1);
#pragma unroll
        for (int i = 0; i < 4; ++i) { const int k = 4 * lane + 256 * i; const f32x4 xv = *(const f32x4*)(x + k), s = *(const f32x4*)(sc + k), hh = *(const f32x4*)(sh + k);
            u2v o; o.x = pk_bf16(xv[0] * (1.f + s[0]) + hh[0], xv[1] * (1.f + s[1]) + hh[1]); o.y = pk_bf16(xv[2] * (1.f + s[2]) + hh[2], xv[3] * (1.f + s[3]) + hh[3]);
            *(u2v*)(p.H + (size_t)r * D + k) = o; }
    }
}

__device__ __forceinline__ void ph_rope_table(const P& p) {
    GSTRIDE(idx, 128 * 32) { const int f = idx & 31, pos = idx >> 5; float sn, cs; sincosf((float)pos * exp2f(-(float)f * (13.287712379549449f / 32.f)), &sn, &cs); p.A2[2 * idx] = cs; p.A2[2 * idx + 1] = sn; }
}
__device__ __forceinline__ void ph_filters(const P& p, unsigned char* smem, int u0, int ustride) {
    float* lds = (float*)smem;
    float* aA = lds;
    float* aB = lds + 64 * 65;
    LAS bf16_t* A3 = (LAS bf16_t*)(smem + 2 * 64 * 65 * 4);
    LAS bf16_t* Ws = A3 + 64 * 72;
    float* mw = (float*)(smem + 2 * 64 * 65 * 4 + 64 * 72 * 2 + 64 * 264 * 2);
    const float mind = logf(1e-2f) / 1.5f, maxd = logf(1e-2f) / 0.3f;
    if (u0 < 0) return;
    __syncthreads();
    for (int e = TIDX; e < 33 * 64; e += NT) mw[e] = p.in[13][e];
    for (int e = TIDX; e < 64 * 64; e += NT) { mw[2112 + e] = p.in[15][e]; mw[2112 + 4096 + e] = p.in[17][e]; }
    if (TIDX < 64) { mw[10304 + TIDX] = p.in[14][TIDX]; mw[10368 + TIDX] = p.in[16][TIDX]; mw[10432 + TIDX] = p.in[18][TIDX]; }
    if (TIDX < 192) mw[10496 + TIDX] = p.in[20][TIDX];
    for (int u = u0; u < RB / 64; u += ustride) {
        const int tid = TIDX; const int p0 = u * 64; const int pos = tid & 63, jg = tid >> 6, lane = tid & 63, w = tid >> 6;
        __syncthreads();
        for (int e = tid; e < 64 * 33; e += NT) { const int ps = e & 63, m = e >> 6; int ln2, i2; hy_pos(p0 + ps, ln2, i2);
            const float w2 = 2.0f * 3.14159265358979323846f * (float)i2 / (float)ln2; float v;
            if (m == 0) v = (float)i2 / (float)(ln2 - 1); else { const int q = (m - 1) & 15; const float f = 1e-4f + (float)q * ((15.f - 1e-4f) / 15.f); v = m <= 16 ? cosf(f * w2) : -sinf(f * w2); }
            aB[ps * 65 + m] = v; }
        __syncthreads();
        {
            float acc[8];
#pragma unroll
            for (int q = 0; q < 8; ++q) acc[q] = mw[10304 + jg * 8 + q];
#pragma unroll 3
            for (int m = 0; m < 33; ++m) { const float a = aB[pos * 65 + m];
#pragma unroll
                for (int q = 0; q < 8; ++q) acc[q] += a * mw[m * 64 + jg * 8 + q]; }
#pragma unroll
            for (int q = 0; q < 8; ++q) aA[pos * 65 + jg * 8 + q] = sinf(mw[10496 + jg * 8 + q] * acc[q]);
        }
        __syncthreads();
#pragma unroll 1
        for (int layer = 0; layer < 2; ++layer) {
            const float* W = mw + 2112 + 4096 * layer; const float* Bv = mw + 10368 + 64 * layer; const float* Fq = mw + 10496 + 64 * (layer + 1);
            float* src = layer ? aB : aA; float* dst = layer ? aA : aB;
            float acc[8];
#pragma unroll
            for (int q = 0; q < 8; ++q) acc[q] = Bv[jg * 8 + q];
#pragma unroll 4
            for (int m = 0; m < 64; ++m) { const float a = src[pos * 65 + m];
#pragma unroll
                for (int q = 0; q < 8; ++q) acc[q] += a * W[m * 64 + jg * 8 + q]; }
#pragma unroll
            for (int q = 0; q < 8; ++q) { const float v = sinf(Fq[jg * 8 + q] * acc[q]); dst[pos * 65 + jg * 8 + q] = v; if (layer == 1) A3[pos * 72 + jg * 8 + q] = f2bf(v); }
            __syncthreads();
        }
        float tpos[4];
#pragma unroll
        for (int mt = 0; mt < 4; ++mt) { int len, i0; hy_pos(p0 + 16 * mt + (lane & 15), len, i0); tpos[mt] = (float)i0 / (float)(len - 1); }
#pragma unroll 1
        for (int cq = 0; cq < 8; ++cq) {
            for (int e = tid; e < 64 * 64; e += NT) { const int k = e >> 6, c4 = e & 63; const f32x4 wv = *(const f32x4*)(p.in[19] + (size_t)k * 2048 + cq * 256 + 4 * c4);
                u2v o; o.x = pk_bf16(wv[0], wv[1]); o.y = pk_bf16(wv[2], wv[3]); *(LAS u2v*)(Ws + k * 264 + 4 * c4) = o; }
            __syncthreads();
            f32x4 acc[4][2];
#pragma unroll
            for (int mt = 0; mt < 4; ++mt)
#pragma unroll
                for (int nt = 0; nt < 2; ++nt) acc[mt][nt] = (f32x4){0.f, 0.f, 0.f, 0.f};
#pragma unroll
            for (int ks = 0; ks < 2; ++ks) { bf16x8 xm[4];
#pragma unroll
                for (int mt = 0; mt < 4; ++mt) xm[mt] = frag_row(A3, 72, 16 * mt, 32 * ks, lane);
#pragma unroll
                for (int nt = 0; nt < 2; ++nt) { const bf16x8 xn = frag_tr(Ws, 264, 32 * ks, 32 * w + 16 * nt, lane);
#pragma unroll
                    for (int mt = 0; mt < 4; ++mt) acc[mt][nt] = MFMA16(xn, xm[mt], acc[mt][nt]); } }
#pragma unroll
            for (int nt = 0; nt < 2; ++nt)
#pragma unroll
                for (int q = 0; q < 4; ++q) { const int col = cq * 256 + 32 * w + 16 * nt + 4 * (lane >> 4) + q; const float delta = fabsf(mind + (float)(col % 512) * ((maxd - mind) / 511.f));
#pragma unroll
                    for (int mt = 0; mt < 4; ++mt) p.FILT[(size_t)col * RB + p0 + 16 * mt + (lane & 15)] = acc[mt][nt][q] * __expf(-tpos[mt] * delta); }
            __syncthreads();
        }
    }
}

__device__ __forceinline__ float wave_sum(float v) {
#pragma unroll
    for (int o = 1; o < 64; o <<= 1) v += __shfl_xor(v, o);
    return v;
}
__device__ __forceinline__ void ph_ada_fast(const P& p, float* lds) {
    float* sv = lds;
    float* red = lds + 3072;
    const int tid = TIDX;
    __syncthreads();
    for (int i = tid; i < 3 * D; i += NT) { const int j = i / D, k = i % D; sv[i] = siluf(j < 2 ? p.in[1][j * D + k] : p.in[3][k]); }
    __syncthreads();
    for (int u = blockIdx.x; u < 2 * 96; u += gridDim.x) {
        const int l = u / 96, n = (u % 96) * 64 + (tid & 63), ks = tid >> 6;
        const float* w = p.in[4] + (size_t)l * D * 6144 + n;
        float a0 = 0.f, a1 = 0.f, a2 = 0.f;
#pragma unroll 8
        for (int k = ks * 128; k < ks * 128 + 128; ++k) { const float wv = w[(size_t)k * 6144]; a0 += sv[k] * wv; a1 += sv[D + k] * wv; a2 += sv[2 * D + k] * wv; }
        red[(ks * 3 + 0) * 64 + (tid & 63)] = a0; red[(ks * 3 + 1) * 64 + (tid & 63)] = a1; red[(ks * 3 + 2) * 64 + (tid & 63)] = a2;
        __syncthreads();
        if (tid < 192) { const int j = tid >> 6, nl = tid & 63; float s = p.in[5][l * 6144 + (u % 96) * 64 + nl];
#pragma unroll
            for (int q = 0; q < 8; ++q) s += red[(q * 3 + j) * 64 + nl];
            p.MOD[(size_t)(l * 3 + j) * 6144 + (u % 96) * 64 + nl] = s; }
        __syncthreads();
    }
}
__device__ __forceinline__ void ph_hyF_fast(const P& p, const float* a3, float* lds) {
    float* at = lds;
    float* wt = lds + 64 * 65;
    const float mind = logf(1e-2f) / 1.5f, maxd = logf(1e-2f) / 0.3f;
    for (int u = blockIdx.x; u < (RB / 64) * 16; u += gridDim.x) {
        const int tid = TIDX; const int ct = u % 16, pt = u / 16, p0 = pt * 64, c0 = ct * 128;
        __syncthreads();
#pragma unroll
        for (int i = 0; i < 8; ++i) { const int e = tid + 512 * i; at[(e >> 6) * 65 + (e & 63)] = a3[(size_t)(p0 + (e >> 6)) * 64 + (e & 63)]; }
#pragma unroll
        for (int i = 0; i < 16; ++i) { const int e = tid + 512 * i; wt[e] = p.in[19][(size_t)(e >> 7) * 2048 + c0 + (e & 127)]; }
        __syncthreads();
        const int pos = tid & 63, cg = tid >> 6;
        float acc[16];
#pragma unroll
        for (int q = 0; q < 16; ++q) acc[q] = 0.f;
#pragma unroll 4
        for (int m = 0; m < 64; ++m) { const float a = at[pos * 65 + m];
#pragma unroll
            for (int q = 0; q < 16; ++q) acc[q] += a * wt[m * 128 + cg * 16 + q]; }
        int len, i0; hy_pos(p0 + pos, len, i0); const float tt = (float)i0 / (float)(len - 1);
#pragma unroll
        for (int q = 0; q < 16; ++q) { const int col = c0 + cg * 16 + q; const float delta = fabsf(mind + (float)(col % 512) * ((maxd - mind) / 511.f));
            p.FILT[(size_t)col * RB + p0 + pos] = acc[q] * expf(-tt * delta); }
    }
}
__device__ __forceinline__ void ph_retScan_fast(const P& p) {
    bf16_t* ST = p.Zh;
    GSTRIDE(idx, (long)2 * NB * 4 * 16384) {
        const int ed = idx % 16384, h = (idx / 16384) % 4, b = (idx / 65536) % NB, dir = idx / (65536 * NB);
        const float dc = expf((dir ? p.in[10] : p.in[9])[h] * 128.f);
        bf16_t* base = ST + st_idx(dir, b, h, 0) + ed;
        float s = 0.f;
#pragma unroll 1
        for (int c0 = 0; c0 < NCH; c0 += 11) {
            float u[11]; int cc[11];
#pragma unroll
            for (int j = 0; j < 11; ++j) { const int q = c0 + j; cc[j] = dir == 0 ? q : (q < 2 ? 1 - q : NCH + 1 - q); u[j] = bf2f(base[(size_t)cc[j] * 16384]); }
#pragma unroll
            for (int j = 0; j < 11; ++j) { base[(size_t)cc[j] * 16384] = f2bf(s); s = dc * s + u[j]; }
        }
    }
}
__device__ __forceinline__ void ph_glaScan_fast(const P& p) {
    const float* BF = p.BG; const float* BB = p.BG + (size_t)R * 512;
    GSTRIDE(idx, (long)2 * NB * 4 * 32768) {
        const int d = idx % 128, ed = idx % 32768, h = (idx / 32768) % 4, b = (idx / 131072) % NB, dir = idx / (131072 * NB);
        bf16_t* base = p.GST + gst_idx(dir, b, h, 0) + ed;
        float s = 0.f;
#pragma unroll 1
        for (int c0 = 0; c0 < NCH; c0 += 11) {
            float u[11], dcv[11]; int cc[11];
#pragma unroll
            for (int j = 0; j < 11; ++j) { const int q = c0 + j; cc[j] = dir == 0 ? q : (q < 2 ? 1 - q : NCH + 1 - q); const int r0 = chunk_row0(b, cc[j]);
                u[j] = bf2f(base[(size_t)cc[j] * 32768]); dcv[j] = dir == 0 ? BF[(size_t)(r0 + 127) * 512 + h * 128 + d] : BB[(size_t)r0 * 512 + h * 128 + d]; }
#pragma unroll
            for (int j = 0; j < 11; ++j) { base[(size_t)cc[j] * 32768] = f2bf(s); s = __expf(dcv[j]) * s + u[j]; }
        }
    }
}
__device__ __forceinline__ void ph_glagates_fast(const P& p, float* lds) {
    float* lr = lds;
    for (int u = blockIdx.x; u < NB * NCH * 2; u += gridDim.x) {
        const int tid = TIDX; const int dir = u % 2, c = (u / 2) % NCH, b = u / (2 * NCH); const int r0 = chunk_row0(b, c);
        __syncthreads();
        for (int e = tid; e < 128 * 16; e += NT) lr[e] = bf2f(p.Z1[(size_t)(r0 + (e >> 4)) * GINP + 3072 + dir * 16 + (e & 15)]);
        __syncthreads();
        const float* gw = (dir ? p.in[26] : p.in[24]); float g[16];
#pragma unroll
        for (int q = 0; q < 16; ++q) g[q] = gw[q * 512 + tid];
        const float gb = (dir ? p.in[27] : p.in[25])[tid];
        float* out = p.BG + ((size_t)dir * R + r0) * 512 + tid;
        float s = 0.f;
#pragma unroll 4
        for (int ii = 0; ii < 128; ++ii) { const int i = dir ? 127 - ii : ii; float acc = gb;
#pragma unroll
            for (int q = 0; q < 16; ++q) acc += lr[i * 16 + q] * g[q];
            s += logsigf(acc) * (1.f / 16.f); out[(size_t)i * 512] = s; }
    }
}
template <int MODE, bool ROUTE> __device__ __forceinline__ void ph_post_fast(const P& p, int l, int which, const bf16_t* Y, int ln, int wn, int nrows, const float* xl, const float* xc, float* lds) {
    const float* lg = p.in[6] + (size_t)(l * 2 + which) * D; const float* lb = p.in[7] + (size_t)(l * 2 + which) * D;
    const int tid = TIDX, lane = tid & 63, gw = blockIdx.x * (NT / 64) + (tid >> 6), ngw = gridDim.x * (NT / 64);
    int* lcnt = (int*)(lds + D * NE);
    if (ROUTE) { __syncthreads(); for (int e = tid; e < D * NE; e += NT) lds[(e & 15) * D + (e >> 4)] = p.in[29][e]; if (tid < 32) lcnt[tid] = 0; __syncthreads(); }
    int toff[16];
    if (MODE == 1) { int s = 0;
#pragma unroll
        for (int e = 0; e < 16; ++e) { toff[e] = s; s += (p.CNT[l * 16 + e] + 255) >> 8; } }
    f32x4 cg_[4], clg[4], clb[4], csc[4], csh[4]; int cseg = -1;
#pragma unroll
    for (int i = 0; i < 4; ++i) { clg[i] = *(const f32x4*)(lg + 4 * lane + 256 * i); clb[i] = *(const f32x4*)(lb + 4 * lane + 256 * i); }
    f32x4 xr[4]; u2v ya[4], yb[4];
#define POST_LOAD(rr) do { const int r_ = (rr); const float* x_ = r_ < RL ? xl + (size_t)r_ * D : xc + (size_t)(r_ - RL) * D; const bf16_t *y0_, *y1_ = nullptr; \
        if (MODE == 0) y0_ = Y + (size_t)r_ * D; \
        else { int sr_[2]; _Pragma("unroll") for (int k_ = 0; k_ < 2; ++k_) { const int e_ = p.RE[r_ * 2 + k_]; int to_ = 0; _Pragma("unroll") for (int q_ = 0; q_ < 16; ++q_) to_ = (q_ == e_) ? toff[q_] : to_; sr_[k_] = to_ * 256 + p.RPOS[r_ * 2 + k_]; } \
               y0_ = p.slots + (size_t)sr_[0] * D; y1_ = p.slots + (size_t)sr_[1] * D; } \
        _Pragma("unroll") for (int i_ = 0; i_ < 4; ++i_) { const int k_ = 4 * lane + 256 * i_; xr[i_] = *(const f32x4*)(x_ + k_); ya[i_] = *(const u2v*)(y0_ + k_); if (MODE == 1) yb[i_] = *(const u2v*)(y1_ + k_); } } while (0)
    if (gw < nrows) POST_LOAD(gw);
    for (int r = gw; r < nrows; r += ngw) {
        float* xo = xrow(p, r);
        if (seg_of(r) != cseg) { cseg = seg_of(r);
#pragma unroll
            for (int i = 0; i < 4; ++i) { const int k = 4 * lane + 256 * i; cg_[i] = *(const f32x4*)(modv(p, l, r, which * 3 + 2) + k);
                if (ln >= 0) { csc[i] = *(const f32x4*)(modv(p, ln, r, wn * 3 + 1) + k); csh[i] = *(const f32x4*)(modv(p, ln, r, wn * 3 + 0) + k); } } }
        f32x4 v[4]; float s = 0.f;
#pragma unroll
        for (int i = 0; i < 4; ++i) { const u2v yu = ya[i]; f32x4 yy = {__uint_as_float(yu.x << 16), __uint_as_float(yu.x & 0xffff0000u), __uint_as_float(yu.y << 16), __uint_as_float(yu.y & 0xffff0000u)};
            if (MODE == 1) { const u2v y2 = yb[i]; yy += (f32x4){__uint_as_float(y2.x << 16), __uint_as_float(y2.x & 0xffff0000u), __uint_as_float(y2.y << 16), __uint_as_float(y2.y & 0xffff0000u)}; }
            v[i] = xr[i] * ALPHA + cg_[i] * yy; s += (v[i][0] + v[i][1]) + (v[i][2] + v[i][3]); }
        if (r + ngw < nrows) POST_LOAD(r + ngw);
        const float mu = wave_sum(s) * (1.f / D); float q2 = 0.f;
#pragma unroll
        for (int i = 0; i < 4; ++i) { v[i] = v[i] - mu; q2 += (v[i][0] * v[i][0] + v[i][1] * v[i][1]) + (v[i][2] * v[i][2] + v[i][3] * v[i][3]); }
        const float rs = 1.f / sqrtf(wave_sum(q2) * (1.f / D) + LN_EPS);
        f32x4 hk[4];
#pragma unroll
        for (int i = 0; i < 4; ++i) { const int k = 4 * lane + 256 * i; const f32x4 xn = v[i] * rs * clg[i] + clb[i];
            *(f32x4*)(xo + k) = xn;
            if (ln >= 0) { const f32x4 h2 = xn * (csc[i] + 1.f) + csh[i];
                u2v o; o.x = pk_bf16(h2[0], h2[1]); o.y = pk_bf16(h2[2], h2[3]); *(u2v*)(p.H + (size_t)r * D + k) = o;
                if (ROUTE) hk[i] = h2; } }
        if (ROUTE) {
            float pl[16];
#pragma unroll
            for (int e = 0; e < 16; ++e) { const float* wr = lds + e * D + 4 * lane; float a = 0.f;
#pragma unroll
                for (int i = 0; i < 4; ++i) { const f32x4 wv = *(const f32x4*)(wr + 256 * i); a += (hk[i][0] * wv[0] + hk[i][1] * wv[1]) + (hk[i][2] * wv[2] + hk[i][3] * wv[3]); }
                pl[e] = a; }
            float r8[8], r4[4], r2[2];
            { const bool up = (lane & 32) != 0;
#pragma unroll
              for (int q = 0; q < 8; ++q) { const float keep = up ? pl[8 + q] : pl[q], send = up ? pl[q] : pl[8 + q]; r8[q] = keep + __shfl_xor(send, 32); } }
            { const bool up = (lane & 16) != 0;
#pragma unroll
              for (int q = 0; q < 4; ++q) { const float keep = up ? r8[4 + q] : r8[q], send = up ? r8[q] : r8[4 + q]; r4[q] = keep + __shfl_xor(send, 16); } }
            { const bool up = (lane & 8) != 0;
#pragma unroll
              for (int q = 0; q < 2; ++q) { const float keep = up ? r4[2 + q] : r4[q], send = up ? r4[q] : r4[2 + q]; r2[q] = keep + __shfl_xor(send, 8); } }
            float r1;
            { const bool up = (lane & 4) != 0; const float keep = up ? r2[1] : r2[0], send = up ? r2[0] : r2[1]; r1 = keep + __shfl_xor(send, 4); }
            r1 += __shfl_xor(r1, 2); r1 += __shfl_xor(r1, 1);
            const float sgm = sigmf(r1);
            int best = 0, i1 = 0, i2 = 0; float bs = -1e30f, a1 = 0.f, a2 = 0.f;
#pragma unroll
            for (int g = 0; g < NG; ++g) {
                float sg[4], sel[4];
#pragma unroll
                for (int q = 0; q < 4; ++q) { const int e = g * EPG + q; const int src = ((e >> 3) & 1) * 32 + ((e >> 2) & 1) * 16 + ((e >> 1) & 1) * 8 + (e & 1) * 4;
                    sg[q] = __int_as_float(__builtin_amdgcn_readlane(__float_as_int(sgm), src)); sel[q] = sg[q] + p.in[30][e]; }
                int j1 = 0; float v1 = sel[0];
#pragma unroll
                for (int q = 1; q < 4; ++q) if (sel[q] > v1) { v1 = sel[q]; j1 = q; }
                int j2 = -1; float v2 = -1e30f;
#pragma unroll
                for (int q = 0; q < 4; ++q) if (q != j1 && sel[q] > v2) { v2 = sel[q]; j2 = q; }
                if (v1 + v2 > bs) { bs = v1 + v2; best = g; i1 = j1; i2 = j2; a1 = 0.f; a2 = 0.f;
#pragma unroll
                    for (int q = 0; q < 4; ++q) { a1 = (q == j1) ? sg[q] : a1; a2 = (q == j2) ? sg[q] : a2; } }
            }
            if (lane == 0) { const int e1 = best * EPG + i1, e2 = best * EPG + i2;
                p.RE[r * 2] = e1; p.RE[r * 2 + 1] = e2; p.RWt[r * 2] = a1 / (a1 + a2); p.RWt[r * 2 + 1] = a2 / (a1 + a2);
                p.RPOS[r * 2] = atomicAdd(&lcnt[e1], 1); p.RPOS[r * 2 + 1] = atomicAdd(&lcnt[e2], 1); }
        }
    }
    if (ROUTE) {
        __syncthreads();
        if (tid < 16) lcnt[16 + tid] = atomicAdd(&p.CNT[l * 16 + tid], lcnt[tid]);
        __syncthreads();
        for (int r = gw + lane * ngw; r < nrows; r += 64 * ngw) {
#pragma unroll
            for (int k = 0; k < 2; ++k) p.RPOS[r * 2 + k] += lcnt[16 + p.RE[r * 2 + k]];
        }
    }
}
#undef POST_LOAD

constexpr int N_STEPS = 34;
#define PG8_ALIGN true
#define PG8_SP2 true
template <class Epi> __device__ __forceinline__ void dense_gemm(LAS unsigned char* lds, const bf16_t* A, const bf16_t* Bt, int M, int N, int K, const Epi& E) {
    pg8::Gemm g{A, Bt, M, N, K}; pg8::StaticOrder S; S.init(M, N, (int)gridDim.x, (int)blockIdx.x);
    pg8::gemm_phase<Epi, pg8::StaticOrder, PG8_ALIGN, PG8_SP2>(lds, g, S, E);
}
__device__ __forceinline__ void moe_gemms(const P& p, LAS unsigned char* lds, int l, int which) {
    pg8::MoeOrder S; S.init(p.CNT + l * 16, (int)gridDim.x, (int)blockIdx.x);
    if (which == 0) { pg8::Gemm g{p.Hs, p.Wgu, 0, 0, 1024}; pg8::EpiSwiGLU E{p.he}; pg8::gemm_phase<pg8::EpiSwiGLU, pg8::MoeOrder, PG8_ALIGN, PG8_SP2>(lds, g, S, E); }
    else { pg8::Gemm g{p.he, p.Wd, 0, 0, 512}; pg8::EpiRowScale E{p.slots, p.WS}; pg8::gemm_phase<pg8::EpiRowScale, pg8::MoeOrder, PG8_ALIGN, PG8_SP2>(lds, g, S, E); }
}
__device__ __forceinline__ void run_step(const P& p, int step, unsigned char* smem) {
    LAS unsigned char* lds = (LAS unsigned char*)smem; float* fl = (float*)smem;
    float* conv = (float*)p.H;
    switch (step) {
        case 0: ph_ada_fast(p, fl); ph_rope_table(p); ph_wconv_fast(p, fl); ph_wconv_moe_fast(p, 0, fl); break;
        case 1: ph_mod_fast(p, 0, 0, p.in[0], p.in[2]); break;
        case 2: { pg8::EpiInL0 E{p.Zr, p.hyT, p.A2, RL, L, CTX, RB}; dense_gemm(lds, p.H, p.Win0, R, ABIN, D, E); }
                 if (gridDim.x == 256) ph_filters(p, smem, (int)blockIdx.x - 156, 100); else ph_filters(p, smem, (int)blockIdx.x, (int)gridDim.x); break;
        case 3: break;
        case 4: ph_retU_mfma(p, smem); ph_hyena_fft(p, smem); break;
        case 5: ph_retScan_fast(p); break;
        case 6: break;
        case 7: break;
        case 8: break;
        case 9: ph_retO_mfma(p, smem); ph_hy_untranspose_fast(p, fl); break;
        case 10: ph_hy_untranspose_fast(p, fl); break;
        case 11: { pg8::EpiSplit E{p.Zr, 1024, p.Zr, 1024, 1 << 30}; dense_gemm(lds, p.H, p.Wout0, R, D, D, E); } break;
        case 12: ph_post_fast<0, true>(p, 0, 0, p.Zr, 0, 1, R, p.in[0], p.in[2], fl); break;
        case 13: break;
        case 14: break;
        case 15: ph_permute(p, 0, R); break;
        case 16: moe_gemms(p, lds, 0, 0); break;
        case 17: moe_gemms(p, lds, 0, 1); break;
        case 18: ph_post_fast<1, false>(p, 0, 1, nullptr, 1, 0, R, p.out, p.Xc, fl); break;
        case 19: { pg8::EpiSplit E{p.Z1, GINP, p.Z1, GINP, 1 << 30}; dense_gemm(lds, p.H, p.Win1, R, GINP, D, E); } ph_wconv_moe_fast(p, 1, fl); break;
        case 20: break;
        case 21: break;
        case 22: ph_glaU_mfma(p, smem); break;
        case 23: ph_glaScan_fast(p); break;
        case 24: ph_glaO_mfma(p, smem); break;
        case 25: break;
        case 26: { pg8::EpiSplit E{p.Zr, 1024, p.Zr, 1024, 1 << 30}; dense_gemm(lds, p.H, p.Wout1, RL, D, D, E); } break;
        case 27: ph_post_fast<0, true>(p, 1, 0, p.Zr, 1, 1, RL, p.out, p.Xc, fl); break;
        case 28: break;
        case 29: break;
        case 30: ph_permute(p, 1, RL); break;
        case 31: moe_gemms(p, lds, 1, 0); break;
        case 32: moe_gemms(p, lds, 1, 1); break;
        case 33: ph_post_fast<1, false>(p, 1, 1, nullptr, -1, 0, RL, p.out, p.Xc, fl); break;
    }
}
__global__ void __launch_bounds__(NT, 2) k_all(P p) {
    extern __shared__ __attribute__((aligned(16))) unsigned char smem[];
    cg::grid_group grid = cg::this_grid();
    volatile LAS unsigned* bst = (volatile LAS unsigned*)((LAS unsigned char*)smem + LDS_BYTES - 64);
    if (threadIdx.x < 2) bst[threadIdx.x] = 0u;
    __syncthreads();
    const XcdBarrier bar = xcd_barrier_post(p.BAR, bst);
#define STEP(n) run_step(p, n, smem); xcd_barrier(bar);
#define STEP_CG(n) run_step(p, n, smem); asm volatile("s_waitcnt vmcnt(0)" ::: "memory"); grid.sync();
    STEP_CG(0) STEP(1) STEP(2) STEP(4) STEP(5) STEP(9) STEP(11) STEP(12) STEP(15) STEP(16)
    STEP(17) STEP(18) STEP(19) STEP(22) STEP(23) STEP(24) STEP(26) STEP(27) STEP(30) STEP(31) STEP(32) run_step(p, 33, smem);
#undef STEP
#undef STEP_CG
}

extern "C" void kernel_launch(void* const* d_in, const int* in_sizes, int n_in, void* d_out, int out_size, void* d_ws, size_t ws_size, hipStream_t stream) {
    P p{};
    for (int i = 0; i < 34; ++i) p.in[i] = (const float*)d_in[i];
    p.out = (float*)d_out;
    unsigned char* w = (unsigned char*)d_ws; size_t off = 0;
    auto take = [&](size_t bytes) { unsigned char* r = w + off; off += (bytes + 255) & ~(size_t)255; return r; };
    p.NORM = (float*)take(2 * 2048 * 4); p.CNT = (int*)take(2 * 16 * 4); p.BAR = (unsigned*)take(XCD_BAR_WORDS * 4);
    const size_t ctl_bytes = off;
    p.Win1 = (bf16_t*)take((size_t)GINP * D * 2); p.Wout1 = (bf16_t*)take((size_t)D * D * 2);
    p.Wgu = (bf16_t*)take((size_t)NE * 1024 * 1024 * 2); p.Wd = (bf16_t*)take((size_t)NE * 1024 * 512 * 2);
    p.Xc = (float*)take((size_t)RCX * D * 4); p.MOD = (float*)take(2 * 3 * 6144 * 4);
    p.RS = (float*)take((size_t)R * NE * 4); p.RE = (int*)take((size_t)R * 2 * 4); p.RPOS = (int*)take((size_t)R * 2 * 4); p.RWt = (float*)take((size_t)R * 2 * 4);
    p.WS = (float*)take((size_t)MOE_ROWS * 4);
    const size_t big = off;
    p.H = (bf16_t*)take((size_t)R * D * 2);
    p.Zr = (bf16_t*)take((size_t)R * 2048 * 2);
    p.Zh = (bf16_t*)take((size_t)R * 1536 * 2);
    p.hyT = (bf16_t*)take((size_t)NB * 3 * 512 * RB * 2);
    p.FILT = (float*)take((size_t)2048 * RB * 4);
    p.Win0 = (bf16_t*)take((size_t)ABIN * D * 2); p.Wout0 = (bf16_t*)take((size_t)D * D * 2);
    p.A1 = (float*)take((size_t)RB * 64 * 4); p.A2 = (float*)take((size_t)RB * 64 * 4);
    const size_t total = off;
    off = big + (((size_t)R * D * 2 + 255) & ~(size_t)255);
    p.Hs = (bf16_t*)take((size_t)MOE_ROWS * D * 2); p.he = (bf16_t*)take((size_t)MOE_ROWS * EH * 2); p.slots = (bf16_t*)take((size_t)MOE_ROWS * D * 2);
    const size_t moe_end = off;
    off = big + (((size_t)R * D * 2 + 255) & ~(size_t)255);
    p.Z1 = (bf16_t*)take((size_t)R * GINP * 2); p.BG = (float*)take((size_t)2 * R * 512 * 4); p.GST = (bf16_t*)take((size_t)2 * NB * 4 * NCH * 32768 * 2);
    const size_t l1_end = off;
    if (total > ws_size || moe_end > total || l1_end > total || n_in != 34 || out_size != RL * D) {
        fprintf(stderr, "kernel_launch: bad sizes (need %zu ws bytes, have %zu; moe_end %zu l1_end %zu)\n", total, ws_size, moe_end, l1_end); return; }
    static int grid = 0;
    if (!grid) {
        int dev = 0, cus = 0, per = 0; hipGetDevice(&dev); hipDeviceGetAttribute(&cus, hipDeviceAttributeMultiprocessorCount, dev);
        hipFuncSetAttribute((const void*)k_all, hipFuncAttributeMaxDynamicSharedMemorySize, LDS_BYTES);
        hipOccupancyMaxActiveBlocksPerMultiprocessor(&per, k_all, NT, LDS_BYTES);
        if (per < 1) { fprintf(stderr, "kernel_launch: occupancy query says %d blocks per CU\n", per); per = 1; }
        grid = cus < 256 ? cus : 256;
    }
    hipMemsetAsync(d_ws, 0, ctl_bytes, stream);
    void* args[] = {&p};
    hipError_t e = hipLaunchCooperativeKernel((void*)k_all, dim3(grid), dim3(NT), args, LDS_BYTES, stream);
    if (e != hipSuccess) fprintf(stderr, "coop launch failed: %s (grid %d)\n", hipGetErrorString(e), grid);
}
```

```cpp
#include <hip/hip_runtime.h>
#include <hip/hip_cooperative_groups.h>
#include <cstdio>
#include <cstdint>
namespace cg = cooperative_groups;


namespace pg8 {
#define PG8_LAS __attribute__((address_space(3)))
typedef unsigned short bf16_t;
typedef short bf16x8 __attribute__((ext_vector_type(8)));
typedef float f32x4 __attribute__((ext_vector_type(4)));
typedef unsigned u32x4 __attribute__((ext_vector_type(4)));
constexpr int BM = 256, BK = 64, HALF = 128, HTB = HALF * BK * 2  , STAGE_BYTES = 8 * HTB, NXCD = 8, WGM = 8;

__host__ __device__ __forceinline__ int lds_byte(int r, int c) { const int st = (r >> 4) * 2 + (c >> 5), rr = r & 15, cc = c & 31, ob = rr * 64 + cc * 2; return st * 1024 + (ob ^ (((ob >> 9) & 1) << 5)); }
__host__ __device__ __forceinline__ void stage_rc(int b, int& R, int& C) { const int st = b / 1024, sb = b % 1024, swz = sb ^ (((sb >> 9) & 1) << 5); R = (st >> 1) * 16 + swz / 64; C = (st & 1) * 32 + (swz % 64) / 2; }
__host__ __device__ __forceinline__ int perm32(int rho) { const int n = rho >> 4, i = rho & 15; return 8 * (i >> 2) + 4 * n + (i & 3); }

struct Unit { int pm, pn; };
struct Gemm { const bf16_t* A; const bf16_t* Bt; int M, N, K; };

struct StaticOrder {
    int nM, nN, nwg, G, c;
    __host__ __device__ void init(int M, int N, int G_, int c_) { nM = M / BM; nN = N / BM; nwg = nM * nN; G = G_; c = c_; }
    __host__ __device__ bool next(int i, Unit& u) const {
        const long L = (long)i * G + c; if (L >= nwg) return false;
        int wgid = (int)L; { const int q = nwg / NXCD, r = nwg % NXCD, xcd = wgid % NXCD, off = wgid / NXCD; wgid = (xcd < r ? xcd * (q + 1) : r * (q + 1) + (xcd - r) * q) + off; }
        const int nig = WGM * nN, gid = wgid / nig, fm = gid * WGM, gsz = (nM - fm) < WGM ? (nM - fm) : WGM;
        u.pm = fm + ((wgid % nig) % gsz); u.pn = (wgid % nig) / gsz; return true;
    }
    __device__ __forceinline__ void a_ready(const Unit&) const {}
    __device__ __forceinline__ void done(const Unit&) const {}
};


__device__ __forceinline__ unsigned cvt_pk_bf16(float lo, float hi) { unsigned r; asm volatile("v_cvt_pk_bf16_f32 %0, %1, %2" : "=v"(r) : "v"(lo), "v"(hi)); return r; }

template <class Epi, class Sched, bool ALIGN_EPI = false, bool SP2 = false>
__device__ __forceinline__ void gemm_phase(PG8_LAS unsigned char* lds, const Gemm g, const Sched& S, const Epi& E) {
    int tid_l = threadIdx.x; asm volatile("" : "+v"(tid_l)); const int tid = tid_l, wid = __builtin_amdgcn_readfirstlane(tid >> 6), lane = tid & 63, wr = wid >> 2, wc = wid & 3, fr = lane & 15, fq = lane >> 4;
    const int K = g.K, nt = K / BK;
    unsigned voffA[2], voffB[2];
#pragma unroll
    for (int i = 0; i < 2; ++i) { int R, C; stage_rc(tid * 16 + i * 8192, R, C); const int Rb = Epi::PERM ? ((R & ~31) + perm32(R & 31)) : R;
        voffA[i] = (unsigned)(R * K + C) * 2u; voffB[i] = (unsigned)(Rb * K + C) * 2u; }
    const size_t kstep = (size_t)(BK * 2);
    const size_t hstep = (size_t)HALF * K * 2;
    const size_t tstep = 2 * hstep;
    const unsigned ldsw = (unsigned)wid * 1024u;
    const int aoff = lds_byte(wr * 64 + fr, fq * 8), boff = lds_byte(wc * 32 + fr, fq * 8);
#define PG8_SA(b, h) (((b) * 2 + (h)) * HTB)
#define PG8_SB(b, h) ((4 + (b) * 2 + (h)) * HTB)
#define PG8_STAGE(bufoff, gbase, voff) do { _Pragma("unroll") for (int _i = 0; _i < 2; ++_i) \
        __builtin_amdgcn_global_load_lds((const unsigned*)((const char*)(gbase) + (voff)[_i]), (PG8_LAS unsigned*)(lds + (bufoff) + ldsw + _i * 8192), 16, 0, 0); } while (0)
#define PG8_LDA(dst, b, h) do { _Pragma("unroll") for (int m = 0; m < 4; ++m) _Pragma("unroll") for (int k = 0; k < 2; ++k) dst[m][k] = *(const PG8_LAS bf16x8*)(lds + PG8_SA(b, h) + aoff + m * 2048 + k * 1024); } while (0)
#define PG8_LDB(dst, b, h) do { _Pragma("unroll") for (int n = 0; n < 2; ++n) _Pragma("unroll") for (int k = 0; k < 2; ++k) dst[n][k] = *(const PG8_LAS bf16x8*)(lds + PG8_SB(b, h) + boff + n * 2048 + k * 1024); } while (0)
#define PG8_MMA(ai, bj, At, Bt) do { __builtin_amdgcn_s_setprio(1); _Pragma("unroll") for (int m = 0; m < 4; ++m) _Pragma("unroll") for (int n = 0; n < 2; ++n) _Pragma("unroll") for (int k = 0; k < 2; ++k) \
        acc[ai][bj][m][n] = __builtin_amdgcn_mfma_f32_16x16x32_bf16(Bt[n][k], At[m][k], acc[ai][bj][m][n], 0, 0, 0); __builtin_amdgcn_s_setprio(0); } while (0)
#define PG8_WAIT_V(n) asm volatile("s_waitcnt vmcnt(" #n ")" ::: "memory")
#define PG8_WAIT_L(n) asm volatile("s_waitcnt lgkmcnt(" #n ")" ::: "memory")
#define PG8_BAR __builtin_amdgcn_s_barrier()
#define PG8_SCHED __builtin_amdgcn_sched_barrier(0)
    Unit cur, nxt; int ui = 0;
    if (!S.next(0, cur)) return;
    f32x4 acc[2][2][4][2];
#pragma unroll
    for (int a = 0; a < 2; ++a)
#pragma unroll
        for (int b = 0; b < 2; ++b)
#pragma unroll
            for (int m = 0; m < 4; ++m)
#pragma unroll
                for (int n = 0; n < 2; ++n) acc[a][b][m][n] = (f32x4){0.f, 0.f, 0.f, 0.f};
    bf16x8 At[4][2], B0[2][2], B1[2][2];
    const char* cA = (const char*)g.A + (size_t)cur.pm * tstep; const char* cB = (const char*)g.Bt + (size_t)cur.pn * tstep;
    S.a_ready(cur);
    if constexpr (SP2) {
        PG8_STAGE(PG8_SB(0, 0), cB, voffB); PG8_STAGE(PG8_SB(0, 1), cB + hstep, voffB); PG8_STAGE(PG8_SA(0, 0), cA, voffA); PG8_STAGE(PG8_SA(0, 1), cA + hstep, voffA);
        if (wr == 1) PG8_BAR;
        PG8_WAIT_V(2); PG8_BAR;
        PG8_STAGE(PG8_SB(1, 0), cB + kstep, voffB); PG8_STAGE(PG8_SA(1, 0), cA + kstep, voffA); PG8_STAGE(PG8_SB(1, 1), cB + hstep + kstep, voffB);
        PG8_WAIT_V(6); PG8_BAR;
    } else {
        PG8_STAGE(PG8_SB(0, 0), cB, voffB); PG8_STAGE(PG8_SA(0, 0), cA, voffA); PG8_STAGE(PG8_SB(0, 1), cB + hstep, voffB); PG8_STAGE(PG8_SA(0, 1), cA + hstep, voffA);
        if (wr == 1) PG8_BAR;
        PG8_WAIT_V(4); PG8_BAR;
        PG8_STAGE(PG8_SB(1, 0), cB + kstep, voffB); PG8_STAGE(PG8_SA(1, 0), cA + kstep, voffA); PG8_STAGE(PG8_SB(1, 1), cB + hstep + kstep, voffB);
        PG8_WAIT_V(6); PG8_BAR;
    }
    for (;;) {
        const bool has_next = S.next(ui + 1, nxt);
        const char* nA = has_next ? (const char*)g.A + (size_t)nxt.pm * tstep : cA; const char* nB = has_next ? (const char*)g.Bt + (size_t)nxt.pn * tstep : cB;
        for (int t = 0; t < nt; t += 2) {
            const bool last = (t == nt - 2);
            const char* a1 = cA + (size_t)(t + 1) * kstep;
            const char* a2 = last ? nA : cA + (size_t)(t + 2) * kstep; const char* b2 = last ? nB : cB + (size_t)(t + 2) * kstep;
            const char* a3 = a2 + kstep; const char* b3 = b2 + kstep;
            if (last && has_next) S.a_ready(nxt);
            if constexpr (SP2) {
            PG8_LDB(B0, 0, 0); PG8_LDB(B1, 0, 1); PG8_SCHED; PG8_LDA(At, 0, 0); PG8_STAGE(PG8_SA(1, 1), a1 + hstep, voffA);
            PG8_WAIT_V(8); PG8_WAIT_L(0); PG8_BAR; PG8_MMA(0, 0, At, B0); PG8_MMA(0, 1, At, B1); PG8_BAR; PG8_SCHED;
            PG8_LDA(At, 0, 1); PG8_STAGE(PG8_SB(0, 0), b2, voffB); PG8_STAGE(PG8_SB(0, 1), b2 + hstep, voffB); PG8_STAGE(PG8_SA(0, 0), a2, voffA);
            PG8_WAIT_V(8); PG8_WAIT_L(0); PG8_BAR; PG8_MMA(1, 0, At, B0); PG8_MMA(1, 1, At, B1); PG8_BAR; PG8_SCHED;
            PG8_LDB(B0, 1, 0); PG8_LDB(B1, 1, 1); PG8_SCHED; PG8_LDA(At, 1, 0); PG8_STAGE(PG8_SA(0, 1), a2 + hstep, voffA);
            PG8_WAIT_V(8); PG8_WAIT_L(0); PG8_BAR; PG8_MMA(0, 0, At, B0); PG8_MMA(0, 1, At, B1); PG8_BAR; PG8_SCHED;
            PG8_LDA(At, 1, 1); PG8_STAGE(PG8_SB(1, 0), b3, voffB); PG8_STAGE(PG8_SB(1, 1), b3 + hstep, voffB); PG8_STAGE(PG8_SA(1, 0), a3, voffA);
            PG8_WAIT_V(8); PG8_WAIT_L(0); PG8_BAR; PG8_MMA(1, 0, At, B0); PG8_MMA(1, 1, At, B1); PG8_BAR; PG8_SCHED;
            } else {
            PG8_LDB(B0, 0, 0); PG8_SCHED; PG8_LDA(At, 0, 0); PG8_STAGE(PG8_SA(1, 1), a1 + hstep, voffA);
            PG8_WAIT_L(8); PG8_BAR; PG8_WAIT_L(0); PG8_MMA(0, 0, At, B0); PG8_BAR; PG8_SCHED;
            PG8_LDB(B1, 0, 1); PG8_STAGE(PG8_SB(0, 0), b2, voffB);
            PG8_BAR; PG8_WAIT_L(0); PG8_MMA(0, 1, At, B1); PG8_BAR;
            PG8_LDA(At, 0, 1); PG8_STAGE(PG8_SA(0, 0), a2, voffA);
            PG8_BAR; PG8_WAIT_L(0); PG8_MMA(1, 0, At, B0); PG8_BAR; PG8_SCHED;
            PG8_STAGE(PG8_SB(0, 1), b2 + hstep, voffB);
            PG8_WAIT_V(6); PG8_BAR; PG8_MMA(1, 1, At, B1); PG8_BAR;
            PG8_LDB(B0, 1, 0); PG8_SCHED; PG8_LDA(At, 1, 0); PG8_STAGE(PG8_SA(0, 1), a2 + hstep, voffA);
            PG8_WAIT_L(8); PG8_BAR; PG8_WAIT_L(0); PG8_MMA(0, 0, At, B0); PG8_BAR; PG8_SCHED;
            PG8_LDB(B1, 1, 1); PG8_STAGE(PG8_SB(1, 0), b3, voffB);
            PG8_BAR; PG8_WAIT_L(0); PG8_MMA(0, 1, At, B1); PG8_BAR;
            PG8_LDA(At, 1, 1); PG8_STAGE(PG8_SA(1, 0), a3, voffA);
            PG8_BAR; PG8_WAIT_L(0); PG8_MMA(1, 0, At, B0); PG8_BAR; PG8_SCHED;
            PG8_STAGE(PG8_SB(1, 1), b3 + hstep, voffB);
            PG8_WAIT_V(6); PG8_BAR; PG8_MMA(1, 1, At, B1); PG8_BAR;
            }
        }
        if constexpr (ALIGN_EPI) { if (wr == 0) PG8_BAR; }
        if constexpr (!Epi::AFTER_DRAIN) { E(acc, cur, wr, wc, fr, fq); S.done(cur); }
        if (!has_next) break;
#pragma unroll
        for (int a = 0; a < 2; ++a)
#pragma unroll
            for (int b = 0; b < 2; ++b)
#pragma unroll
                for (int m = 0; m < 4; ++m)
#pragma unroll
                    for (int n = 0; n < 2; ++n) acc[a][b][m][n] = (f32x4){0.f, 0.f, 0.f, 0.f};
        cur = nxt; cA = nA; cB = nB; ++ui;
        if constexpr (ALIGN_EPI) { if (wr == 1) PG8_BAR; }
    }
    PG8_WAIT_V(0);
    if constexpr (!ALIGN_EPI) { if (wr == 0) PG8_BAR; }
    PG8_BAR;
    if constexpr (Epi::AFTER_DRAIN) { E.fused(acc, cur, wr, wc, fr, fq, lds, wid, lane); S.done(cur); }
#undef PG8_SA
#undef PG8_SB
#undef PG8_STAGE
#undef PG8_LDA
#undef PG8_LDB
#undef PG8_MMA
#undef PG8_WAIT_V
#undef PG8_WAIT_L
#undef PG8_BAR
#undef PG8_SCHED
}
}

typedef float f2v_t __attribute__((ext_vector_type(2)));
typedef __bf16 b2v_t __attribute__((ext_vector_type(2)));
__device__ __forceinline__ unsigned pk_bf16(float lo, float hi) { const f2v_t f = {lo, hi}; const b2v_t b = __builtin_convertvector(f, b2v_t); return __builtin_bit_cast(unsigned, b); }
namespace pg8 {
typedef unsigned u32x2 __attribute__((ext_vector_type(2)));
struct EpiSplit {
    static constexpr bool PERM = true, AFTER_DRAIN = false;
    bf16_t* O0; int ld0; bf16_t* O1; int ld1; int split_col;
    __device__ __forceinline__ void operator()(const f32x4 (&acc)[2][2][4][2], const Unit& u, int wr, int wc, int fr, int fq) const {
        const int row0 = u.pm * BM + wr * 64 + fr; int colt = u.pn * BM; bf16_t* base = O0; int ldc = ld0;
        if (colt >= split_col) { base = O1; ldc = ld1; colt -= split_col; }
        const int col0 = colt + wc * 32 + 8 * fq;
#pragma unroll
        for (int ai = 0; ai < 2; ++ai)
#pragma unroll
            for (int m = 0; m < 4; ++m) { bf16_t* rowp = base + (size_t)(row0 + ai * HALF + m * 16) * ldc + col0;
#pragma unroll
                for (int bj = 0; bj < 2; ++bj) { const f32x4 v0 = acc[ai][bj][m][0], v1 = acc[ai][bj][m][1];
                    u32x4 w; w.x = ::pk_bf16(v0[0], v0[1]); w.y = ::pk_bf16(v0[2], v0[3]); w.z = ::pk_bf16(v1[0], v1[1]); w.w = ::pk_bf16(v1[2], v1[3]);
                    *(u32x4*)(rowp + bj * HALF) = w; } }
    }
};
struct EpiInL0 {
    static constexpr bool PERM = true, AFTER_DRAIN = false;
    bf16_t* Zr; bf16_t* hyT; const float* tab; int RLv, Lv, CTXv, RBv;
    __device__ __forceinline__ void operator()(const f32x4 (&acc)[2][2][4][2], const Unit& u, int wr, int wc, int fr, int fq) const {
        const int rowbase = u.pm * BM, colt = u.pn * BM;
        if (colt < 2048) {
            const int col0 = colt + wc * 32 + 8 * fq; const bool rot = colt < 1024; const int pp0 = wc * 16 + 4 * fq;
#pragma unroll
            for (int ai = 0; ai < 2; ++ai)
#pragma unroll
                for (int m = 0; m < 4; ++m) { const int row = rowbase + wr * 64 + fr + ai * HALF + m * 16; bf16_t* rowp = Zr + (size_t)row * 2048 + col0;
                    const int t = row % Lv; const int prow = t >> 6, pcol = t & 63; const bool dorot = rot && row < RLv;
#pragma unroll
                    for (int bj = 0; bj < 2; ++bj) { f32x4 v0 = acc[ai][bj][m][0], v1 = acc[ai][bj][m][1];
                        if (dorot) {
#pragma unroll
                            for (int pr = 0; pr < 4; ++pr) { const int pp = pp0 + pr; const int pos = pp < 32 ? prow : pcol; const float cs = tab[(pos * 32 + (pp & 31)) * 2], sn = tab[(pos * 32 + (pp & 31)) * 2 + 1];
                                if (pr < 2) { const float x1 = v0[2 * pr], x2 = v0[2 * pr + 1]; v0[2 * pr] = x1 * cs - x2 * sn; v0[2 * pr + 1] = x1 * sn + x2 * cs; }
                                else { const float x1 = v1[2 * pr - 4], x2 = v1[2 * pr - 3]; v1[2 * pr - 4] = x1 * cs - x2 * sn; v1[2 * pr - 3] = x1 * sn + x2 * cs; } } }
                        u32x4 w; w.x = ::pk_bf16(v0[0], v0[1]); w.y = ::pk_bf16(v0[2], v0[3]); w.z = ::pk_bf16(v1[0], v1[1]); w.w = ::pk_bf16(v1[2], v1[3]);
                        *(u32x4*)(rowp + bj * HALF) = w; } }
        } else {
            const int hc0 = colt - 2048 + wc * 32 + 8 * fq;
            int b, tlb; if (rowbase < RLv) { b = rowbase / Lv; tlb = rowbase % Lv; } else { b = (rowbase - RLv) / CTXv; tlb = Lv + (rowbase - RLv) % CTXv; }
#pragma unroll
            for (int ai = 0; ai < 2; ++ai)
#pragma unroll
                for (int m = 0; m < 4; ++m) { const int tl = tlb + wr * 64 + fr + ai * HALF + m * 16;
#pragma unroll
                    for (int bj = 0; bj < 2; ++bj) { const f32x4 v0 = acc[ai][bj][m][0], v1 = acc[ai][bj][m][1];
                        bf16_t* o = hyT + ((size_t)b * 1536 + hc0 + bj * HALF) * RBv + tl;
#pragma unroll
                        for (int q = 0; q < 4; ++q) { o[(size_t)q * RBv] = (bf16_t)(::pk_bf16(v0[q], 0.f) & 0xffffu); o[(size_t)(q + 4) * RBv] = (bf16_t)(::pk_bf16(v1[q], 0.f) & 0xffffu); } } }
        }
    }
};
struct EpiSwiGLU {
    static constexpr bool PERM = true, AFTER_DRAIN = false;
    bf16_t* O;
    __device__ __forceinline__ void operator()(const f32x4 (&acc)[2][2][4][2], const Unit& u, int wr, int wc, int fr, int fq) const {
        const int row0 = u.pm * BM + wr * 64 + fr; const int j0 = (u.pn & 3) * 128 + wc * 16 + 4 * fq;
#pragma unroll
        for (int ai = 0; ai < 2; ++ai)
#pragma unroll
            for (int m = 0; m < 4; ++m) { bf16_t* rowp = O + (size_t)(row0 + ai * HALF + m * 16) * 512 + j0;
#pragma unroll
                for (int bj = 0; bj < 2; ++bj) { const f32x4 g = acc[ai][bj][m][0], up = acc[ai][bj][m][1]; float h[4];
#pragma unroll
                    for (int q = 0; q < 4; ++q) h[q] = g[q] / (1.f + __expf(-g[q])) * up[q];
                    u32x2 w; w.x = ::pk_bf16(h[0], h[1]); w.y = ::pk_bf16(h[2], h[3]);
                    *(u32x2*)(rowp + bj * 64) = w; } }
    }
};
struct EpiRowScale {
    static constexpr bool PERM = true, AFTER_DRAIN = false;
    bf16_t* O; const float* ws;
    __device__ __forceinline__ void operator()(const f32x4 (&acc)[2][2][4][2], const Unit& u, int wr, int wc, int fr, int fq) const {
        const int row0 = u.pm * BM + wr * 64 + fr; const int col0 = (u.pn & 3) * BM + wc * 32 + 8 * fq;
#pragma unroll
        for (int ai = 0; ai < 2; ++ai)
#pragma unroll
            for (int m = 0; m < 4; ++m) { const int row = row0 + ai * HALF + m * 16; const float s = ws[row]; bf16_t* rowp = O + (size_t)row * 1024 + col0;
#pragma unroll
                for (int bj = 0; bj < 2; ++bj) { const f32x4 v0 = acc[ai][bj][m][0] * s, v1 = acc[ai][bj][m][1] * s;
                    u32x4 w; w.x = ::pk_bf16(v0[0], v0[1]); w.y = ::pk_bf16(v0[2], v0[3]); w.z = ::pk_bf16(v1[0], v1[1]); w.w = ::pk_bf16(v1[2], v1[3]);
                    *(u32x4*)(rowp + bj * HALF) = w; } }
    }
};
struct MoeOrder {
    int G, c, nt; int toff[16];
    __device__ __forceinline__ void init(const int* cnt, int G_, int c_) { G = G_; c = c_; int s = 0;
#pragma unroll
        for (int e = 0; e < 16; ++e) { toff[e] = s; s += (cnt[e] + 255) >> 8; } nt = s; }
    __device__ __forceinline__ bool next(int i, Unit& u) const {
        const int Lq = i * G + c; if (Lq >= nt * 4) return false;
        const int pm = Lq % nt, pn4 = Lq / nt; int e = 0;
#pragma unroll
        for (int q = 1; q < 16; ++q) e += (pm >= toff[q]) ? 1 : 0;
        u.pm = pm; u.pn = e * 4 + pn4; return true; }
    __device__ __forceinline__ void a_ready(const Unit&) const {}
    __device__ __forceinline__ void done(const Unit&) const {}
};
}

constexpr int NB = 2, L = 8192, D = 1024, CTX = 256, RB = L + CTX;
constexpr int RL = NB * L, RCX = NB * CTX, R = RL + RCX;
constexpr int GW = 64;
constexpr int NCH = 66;
constexpr int ABIN = 3584, GIN = 3104, GINP = 3328;
constexpr int NE = 16, NG = 4, EPG = 4, EH = 512;
constexpr int MOE_ROWS = 37888;
constexpr float ALPHA = 1.4142135623730951f, LN_EPS = 1e-5f, KSCALE = 0.08838834764831845f;
constexpr int NT = 512;
constexpr int LDS_BYTES = 147456;

typedef unsigned short bf16_t;
#define LAS __attribute__((address_space(3)))
__device__ __forceinline__ float bf2f(bf16_t v) { return __uint_as_float((unsigned)v << 16); }
__device__ __forceinline__ bf16_t f2bf(float f) { unsigned u = __float_as_uint(f); return (bf16_t)((u + 0x7fffu + ((u >> 16) & 1u)) >> 16); }
__device__ __forceinline__ float siluf(float x) { return x / (1.f + expf(-x)); }
__device__ __forceinline__ float sigmf(float x) { return 1.f / (1.f + expf(-x)); }
__device__ __forceinline__ float logsigf(float x) { return fminf(x, 0.f) - log1pf(expf(-fabsf(x))); }

struct P {
    const float* in[34];
    float* out;
    float* Xc;
    float* MOD;
    float* NORM;
    int* CNT;
    unsigned* BAR;
    float* A1; float* A2;
    float* RS; int* RE; int* RPOS; float* RWt; float* WS;
    bf16_t *Win0, *Wout0, *Win1, *Wout1, *Wgu, *Wd;
    bf16_t* H;
    bf16_t* Zr;
    bf16_t* Zh;
    bf16_t* hyT;
    float* FILT;
    bf16_t *Hs, *he, *slots;
    bf16_t* Z1;
    float* BG;
    bf16_t* GST;
};

__device__ __forceinline__ int launder_i(int x) { asm volatile("" : "+v"(x)); return x; }
#define TIDX launder_i((int)threadIdx.x)
#define GSTRIDE(i, n) for (long i = (long)blockIdx.x * blockDim.x + TIDX; i < (long)(n); i += (long)gridDim.x * blockDim.x)

__device__ __forceinline__ float* xrow(const P& p, int r) { return r < RL ? p.out + (size_t)r * D : p.Xc + (size_t)(r - RL) * D; }
__device__ __forceinline__ int seg_of(int r) { return r < RL ? r / L : 2; }
__device__ __forceinline__ const float* modv(const P& p, int l, int r, int chunk) { return p.MOD + ((size_t)(l * 3 + seg_of(r)) * 6 + chunk) * D; }
__device__ __forceinline__ int chunk_row0(int b, int c) { return c < 2 ? RL + b * CTX + c * 128 : b * L + (c - 2) * 128; }
__device__ __forceinline__ void row_bt(int r, int& b, int& tl) { if (r < RL) { b = r / L; tl = r % L; } else { b = (r - RL) / CTX; tl = L + (r - RL) % CTX; } }
__device__ __forceinline__ int bt_row(int b, int tl) { return tl < L ? b * L + tl : RL + b * CTX + (tl - L); }

#define XB_TMO      128
#define XB_XCNT(j)  (256  + 64 * (j))
#define XB_XSUB(j)  (1280 + 64 * (j))
#define XB_XGEN(j)  (2304 + 64 * (j))
#define XB_TOP      3328
#define XB_TOPGEN   3392
#define XCD_BAR_WORDS 3456
#define XB_SPIN_CAP (1u << 18)

__device__ __forceinline__ unsigned xb_ld(unsigned* p)              { return __hip_atomic_load(p, __ATOMIC_RELAXED, __HIP_MEMORY_SCOPE_AGENT); }
__device__ __forceinline__ unsigned xb_add(unsigned* p, unsigned v) { return __hip_atomic_fetch_add(p, v, __ATOMIC_RELAXED, __HIP_MEMORY_SCOPE_AGENT); }
__device__ __forceinline__ unsigned xb_xcc_id() { return (unsigned)__builtin_amdgcn_s_getreg((3 << 11) | 20) & 0xFu; }
#define XB_SPIN(cond, bar) do { unsigned _sp = 0; while (cond) { __builtin_amdgcn_s_sleep(1); \
    if ((++_sp & 255u) == 0u) { if (xb_ld(&(bar)[XB_TMO])) break; if (_sp > XB_SPIN_CAP) { atomicAdd(&(bar)[XB_TMO], 1u); break; } } } } while (0)

struct XcdBarrier {
    unsigned* bar; unsigned x;
    volatile LAS unsigned* st;
};

__device__ __forceinline__ XcdBarrier xcd_barrier_post(unsigned* bar, volatile LAS unsigned* st) {
    XcdBarrier b; b.bar = bar; b.x = xb_xcc_id(); b.st = st;
    if (threadIdx.x == 0) (void)xb_add(&bar[XB_XCNT(b.x)], 1u);
    return b;
}
__device__ __forceinline__ void xcd_barrier_complete(unsigned* bar, unsigned x, unsigned& nloc, unsigned& nx) {
    const unsigned G = gridDim.x * gridDim.y * gridDim.z;
    unsigned sum, cnt, mine, sp = 0u;
    for (;;) {
        sum = 0u; cnt = 0u; mine = 0u;
#pragma unroll
        for (unsigned j = 0; j < 16; ++j) { const unsigned c = xb_ld(&bar[XB_XCNT(j)]); sum += c; cnt += (c > 0u) ? 1u : 0u; mine = (j == x) ? c : mine; }
        if (sum == G) break;
        __builtin_amdgcn_s_sleep(1);
        if ((++sp & 255u) == 0u) { if (xb_ld(&bar[XB_TMO])) break; if (sp > XB_SPIN_CAP) { atomicAdd(&bar[XB_TMO], 1u); break; } }
    }
    nloc = mine > 0u ? mine : 1u; nx = cnt > 0u ? cnt : 1u;
}

__device__ __forceinline__ void xcd_barrier(const XcdBarrier& b) {
    asm volatile("s_waitcnt vmcnt(0)" ::: "memory");
    __syncthreads();
    if (threadIdx.x == 0) {
        unsigned* bar = b.bar;
        __builtin_amdgcn_s_waitcnt(0);
        unsigned nloc = b.st[0], nx = b.st[1];
        if (nloc == 0u) { xcd_barrier_complete(bar, b.x, nloc, nx); b.st[0] = nloc; b.st[1] = nx; }
        const unsigned old = xb_add(&bar[XB_XSUB(b.x)], 1u);
        const unsigned gen = old / nloc;
        if (old + 1u == (gen + 1u) * nloc) {
            __builtin_amdgcn_fence(__ATOMIC_RELEASE, "agent");
            asm volatile("s_waitcnt vmcnt(0)" ::: "memory");
            const unsigned og = xb_add(&bar[XB_TOP], 1u);
            const unsigned tg = og / nx;
            if (og + 1u == (tg + 1u) * nx) xb_add(&bar[XB_TOPGEN], 1u);
            else XB_SPIN(xb_ld(&bar[XB_TOPGEN]) == tg, bar);
            __builtin_amdgcn_fence(__ATOMIC_ACQUIRE, "agent");
            xb_add(&bar[XB_XGEN(b.x)], 1u);
            asm volatile("s_waitcnt vmcnt(0)" ::: "memory");
        } else {
            XB_SPIN(xb_ld(&bar[XB_XGEN(b.x)]) == gen, bar);
            __builtin_amdgcn_fence(__ATOMIC_ACQUIRE, "agent");
            asm volatile("s_waitcnt vmcnt(0)" ::: "memory");
        }
    }
    __syncthreads();
}

__device__ __forceinline__ void ph_wconv(bf16_t* dst, const float* src, int N, int K, int ldsrc, int nvalid) {
    GSTRIDE(idx, (long)N * K) { const int k = idx % K, n = idx / K; dst[idx] = n < nvalid ? f2bf(src[(size_t)k * ldsrc + n]) : (bf16_t)0; }
}
__device__ __forceinline__ void ph_wconv_moe(const P& p, int l) {
    GSTRIDE(idx, (long)NE * 1024 * 1024) {
        const int k = idx % 1024, n = (idx / 1024) % 1024, e = idx / (1024 * 1024);
        const int q = n >> 3, r = n & 7, j = 4 * q + (r & 3);
        const float* src = (r < 4 ? p.in[31] : p.in[32]) + ((size_t)(l * NE + e) * D + k) * EH + j;
        p.Wgu[idx] = f2bf(*src);
    }
    GSTRIDE(idx, (long)NE * 1024 * 512) {
        const int k = idx % 512, n = (idx / 512) % 1024, e = idx / (512 * 1024);
        p.Wd[idx] = f2bf(p.in[33][((size_t)(l * NE + e) * EH + k) * D + n]);
    }
}
__device__ __forceinline__ void ph_ada(const P& p) {
    GSTRIDE(idx, 2 * 3 * 6144) {
        const int n = idx % 6144, j = (idx / 6144) % 3, l = idx / (3 * 6144);
        const float* cv = j < 2 ? p.in[1] + j * D : p.in[3];
        const float* w = p.in[4] + (size_t)l * D * 6144;
        float acc = p.in[5][l * 6144 + n];
        for (int k = 0; k < D; ++k) acc += siluf(cv[k]) * w[(size_t)k * 6144 + n];
        p.MOD[idx] = acc;
    }
}
__device__ __forceinline__ void ph_init(const P& p) {
    GSTRIDE(i, (long)RL * D) p.out[i] = p.in[0][i];
    GSTRIDE(i, (long)RCX * D) p.Xc[i] = p.in[2][i];
}
__device__ __forceinline__ void hy_pos(int pidx, int& len, int& i) { if (pidx < L) { len = L; i = pidx; } else { len = CTX; i = pidx - L; } }
__device__ __forceinline__ void ph_hyA1(const P& p) {
    GSTRIDE(idx, (long)RB * 64) {
        const int j = idx % 64, pidx = idx / 64; int len, i; hy_pos(pidx, len, i);
        const float t = (float)i / (float)(len - 1);
        const float w = 2.0f * 3.14159265358979323846f * (float)i / (float)len;
        const float* w1 = p.in[13];
        float acc = p.in[14][j] + t * w1[j];
        for (int m = 0; m < 16; ++m) {
            const float f = 1e-4f + (float)m * ((15.f - 1e-4f) / 15.f);
            acc += cosf(f * w) * w1[(1 + m) * 64 + j] - sinf(f * w) * w1[(17 + m) * 64 + j];
        }
        p.A1[idx] = sinf(p.in[20][j] * acc);
    }
}
__device__ __forceinline__ void ph_hyA(const float* src, float* dst, const float* w, const float* bias, const float* freq) {
    GSTRIDE(idx, (long)RB * 64) {
        const int j = idx % 64, pidx = idx / 64;
        float acc = bias[j];
        for (int i = 0; i < 64; ++i) acc += src[(size_t)pidx * 64 + i] * w[i * 64 + j];
        dst[idx] = sinf(freq[j] * acc);
    }
}
__device__ __forceinline__ void ph_hyF(const P& p, const float* a3) {
    const float mind = logf(1e-2f) / 1.5f, maxd = logf(1e-2f) / 0.3f;
    GSTRIDE(idx, (long)2048 * RB) {
        const int pidx = idx % RB, col = idx / RB, ch = col % 512; int len, i; hy_pos(pidx, len, i);
        const float t = (float)i / (float)(len - 1);
        float acc = 0.f;
        for (int m = 0; m < 64; ++m) acc += a3[(size_t)pidx * 64 + m] * p.in[19][m * 2048 + col];
        const float delta = fabsf(mind + (float)ch * ((maxd - mind) / 511.f));
        p.FILT[idx] = acc * expf(-t * delta);
    }
}
__device__ __forceinline__ float block_sum(float v, float* red);
__device__ __forceinline__ void ph_hyNorm(const P& p, float* red) {
    for (int u = blockIdx.x; u < 2 * 2048; u += gridDim.x) {
        const int col = u % 2048, which = u / 2048; const int p0 = which ? L : 0, n = which ? CTX : L;
        float s = 0.f;
        for (int i = TIDX; i < n; i += NT) { const float v = p.FILT[(size_t)col * RB + p0 + i]; s += v * v; }
        const float t = block_sum(s, red);
        if (TIDX == 0) p.NORM[which * 2048 + col] = t;
    }
}
__device__ __forceinline__ void ph_mod(const P& p, int l, int which) {
    GSTRIDE(i, (long)R * D) {
        const int r = i / D, k = i % D;
        p.H[i] = f2bf(xrow(p, r)[k] * (1.f + modv(p, l, r, which * 3 + 1)[k]) + modv(p, l, r, which * 3 + 0)[k]);
    }
}
__device__ __forceinline__ void ph_prep_rope(const P& p) {
    GSTRIDE(i, (long)R * 2 * 4 * 64) {
        const int pr = i % 64, h = (i / 64) % 4, w = (i / 256) % 2, r = i / 512;
        bf16_t* base = p.Zr + (size_t)r * 2048 + w * 512 + h * 128;
        float t1 = bf2f(base[pr]), t2 = bf2f(base[64 + pr]);
        if (w == 1) { t1 *= KSCALE; t2 *= KSCALE; }
        if (r < RL) {
            const int t = r % L, row = t / GW, col = t % GW;
            const float inv = powf(10000.f, -(float)(pr & 31) / 32.f);
            const float ang = (pr < 32 ? (float)row : (float)col) * inv;
            float sn, cs; sincosf(ang, &sn, &cs);
            const float a = t1 * cs - t2 * sn, bb = t1 * sn + t2 * cs; t1 = a; t2 = bb;
        }
        base[pr] = f2bf(t1); base[64 + pr] = f2bf(t2);
    }
}
__device__ __forceinline__ void ph_prep_hy(const P& p) {
    GSTRIDE(idx, (long)NB * 1536 * RB) {
        const int tl = idx % RB, col = (idx / RB) % 1536, b = idx / (RB * 1536);
        const int s0 = tl < L ? 0 : L, s1 = tl < L ? L : RB;
        const float* w = p.in[11];
        float acc = p.in[12][col] + w[1536 + col] * bf2f(p.Zh[(size_t)bt_row(b, tl) * 1536 + col]);
        if (tl - 1 >= s0) acc += w[col] * bf2f(p.Zh[(size_t)bt_row(b, tl - 1) * 1536 + col]);
        if (tl + 1 < s1) acc += w[2 * 1536 + col] * bf2f(p.Zh[(size_t)bt_row(b, tl + 1) * 1536 + col]);
        p.hyT[idx] = f2bf(acc);
    }
}
__device__ __forceinline__ float hy_tapT(const float* Ff, const float* Fb, float nf, float nb, int d) {
    if (d > 0) return Ff[d] * nf; if (d < 0) return Fb[-d] * nb; return Ff[0] * nf + Fb[0] * nb;
}
__device__ __forceinline__ void ph_hyconv_naive(const P& p, int n, float* conv) {
    GSTRIDE(idx, (long)NB * 512 * (RB / 4)) {
        const int tb = idx % (RB / 4), ch = (idx / (RB / 4)) % 512, b = idx / ((RB / 4) * 512);
        const int tl0 = tb * 4, s0 = tl0 < L ? 0 : L, len = tl0 < L ? L : CTX, nrm = tl0 < L ? 0 : 1, t0 = tl0 - s0;
        const int cf = (n * 2 + 0) * 512 + ch, cb = (n * 2 + 1) * 512 + ch;
        const float nf = 1.f / sqrtf(p.NORM[nrm * 2048 + cf]), nb = 1.f / sqrtf(p.NORM[nrm * 2048 + cb]);
        const float* Ff = p.FILT + (size_t)cf * RB + s0; const float* Fb = p.FILT + (size_t)cb * RB + s0;
        const bf16_t* z = p.hyT + ((size_t)(b * 3 + 2) * 512 + ch) * RB + s0;
        float w0 = hy_tapT(Ff, Fb, nf, nb, t0), w1 = hy_tapT(Ff, Fb, nf, nb, t0 + 1), w2 = hy_tapT(Ff, Fb, nf, nb, t0 + 2), w3 = hy_tapT(Ff, Fb, nf, nb, t0 + 3);
        float a0 = 0.f, a1 = 0.f, a2 = 0.f, a3 = 0.f;
        for (int s = 0; s < len; ++s) {
            const float zz = bf2f(z[s]);
            a0 += w0 * zz; a1 += w1 * zz; a2 += w2 * zz; a3 += w3 * zz;
            w3 = w2; w2 = w1; w1 = w0;
            if (s + 1 < len) w0 = hy_tapT(Ff, Fb, nf, nb, t0 - (s + 1));
        }
        float* o = conv + ((size_t)b * 512 + ch) * RB + tl0; o[0] = a0; o[1] = a1; o[2] = a2; o[3] = a3;
    }
}
__device__ __forceinline__ void ph_hygate_naive(const P& p, int n, const float* conv) {
    bf16_t* yhT = p.Zh + (size_t)2 * NB * 4 * NCH * 16384;
    GSTRIDE(idx, (long)NB * 512 * RB) {
        const int tl = idx % RB, ch = (idx / RB) % 512, b = idx / (RB * 512);
        bf16_t* z = p.hyT + ((size_t)(b * 3 + 2) * 512 + ch) * RB + tl; const float gate = bf2f(p.hyT[((size_t)(b * 3 + n) * 512 + ch) * RB + tl]);
        const float r = gate * (conv[idx] + p.in[21][n * 512 + ch] * bf2f(*z));
        if (n == 0) *z = f2bf(r); else yhT[idx] = f2bf(r);
    }
}
__device__ __forceinline__ void ph_hy_untranspose(const P& p) {
    const bf16_t* yhT = p.Zh + (size_t)2 * NB * 4 * NCH * 16384;
    GSTRIDE(idx, (long)R * 512) { const int ch = idx % 512, r = idx / 512; int b, tl; row_bt(r, b, tl); p.H[(size_t)r * D + 512 + ch] = yhT[((size_t)b * 512 + ch) * RB + tl]; }
}
__device__ __forceinline__ size_t st_idx(int dir, int b, int h, int c) { return ((((size_t)dir * NB + b) * 4 + h) * NCH + c) * 16384; }
__device__ __forceinline__ void ph_retU_naive(const P& p) {
    bf16_t* ST = p.Zh;
    GSTRIDE(idx, (long)NB * 4 * NCH * 16384) {
        const int d = idx % 128, e = (idx / 128) % 128, c = (idx / 16384) % NCH, h = (idx / (16384 * NCH)) % 4, b = idx / (16384 * NCH * 4);
        const float lgf = p.in[9][h], lgb = p.in[10][h]; const int r0 = chunk_row0(b, c);
        float uf = 0.f, ub = 0.f;
        for (int j = 0; j < 128; ++j) {
            const float kk = bf2f(p.Zr[(size_t)(r0 + j) * 2048 + 512 + h * 128 + d]), vv = bf2f(p.Zr[(size_t)(r0 + j) * 2048 + 1024 + h * 128 + e]);
            uf += kk * expf(lgf * (float)(127 - j)) * vv; ub += kk * expf(lgb * (float)j) * vv;
        }
        ST[st_idx(0, b, h, c) + e * 128 + d] = f2bf(uf); ST[st_idx(1, b, h, c) + e * 128 + d] = f2bf(ub);
    }
}
__device__ __forceinline__ void ph_retScan(const P& p) {
    bf16_t* ST = p.Zh;
    GSTRIDE(idx, (long)2 * NB * 4 * 16384) {
        const int ed = idx % 16384, h = (idx / 16384) % 4, b = (idx / 65536) % NB, dir = idx / (65536 * NB);
        const float dc = expf((dir ? p.in[10] : p.in[9])[h] * 128.f);
        float s = 0.f;
        for (int cc = 0; cc < NCH; ++cc) {
            const int c = dir == 0 ? cc : (cc < 2 ? 1 - cc : NCH + 1 - cc);
            bf16_t* q = ST + st_idx(dir, b, h, c) + ed; const float u = bf2f(*q); *q = f2bf(s); s = dc * s + u;
        }
    }
}
__device__ __forceinline__ void ph_retO_naive(const P& p, float* lds) {
    const bf16_t* ST = p.Zh;
    for (int u = blockIdx.x; u < NB * 4 * NCH; u += gridDim.x) {
        const int c = u % NCH, h = (u / NCH) % 4, b = u / (NCH * 4); const int r0 = chunk_row0(b, c);
        const float lgf = p.in[9][h], lgb = p.in[10][h];
        __syncthreads();
        for (int e = TIDX; e < 128 * 128; e += NT) {
            const int j = e % 128, i = e / 128;
            const bf16_t* q = p.Zr + (size_t)(r0 + i) * 2048 + h * 128; const bf16_t* k = p.Zr + (size_t)(r0 + j) * 2048 + 512 + h * 128;
            float s = 0.f; for (int d = 0; d < 128; ++d) s += bf2f(q[d]) * bf2f(k[d]);
            const float m = i > j ? expf(lgf * (float)(i - j)) : (j > i ? expf(lgb * (float)(j - i)) : 2.f);
            lds[e] = s * m;
        }
        __syncthreads();
        const bf16_t* sf = ST + st_idx(0, b, h, c); const bf16_t* sb = ST + st_idx(1, b, h, c);
        for (int e2 = TIDX; e2 < 128 * 128; e2 += NT) {
            const int e = e2 % 128, i = e2 / 128;
            float o = 0.f; for (int j = 0; j < 128; ++j) o += lds[i * 128 + j] * bf2f(p.Zr[(size_t)(r0 + j) * 2048 + 1024 + h * 128 + e]);
            const bf16_t* q = p.Zr + (size_t)(r0 + i) * 2048 + h * 128;
            float of = 0.f, ob = 0.f; for (int d = 0; d < 128; ++d) { const float qq = bf2f(q[d]); of += qq * bf2f(sf[e * 128 + d]); ob += qq * bf2f(sb[e * 128 + d]); }
            p.H[(size_t)(r0 + i) * D + h * 128 + e] = f2bf(o + expf(lgf * (float)(i + 1)) * of + expf(lgb * (float)(128 - i)) * ob);
        }
    }
}
__device__ __forceinline__ void ph_retNorm_naive(const P& p) {
    GSTRIDE(idx, (long)R * 4) {
        const int h = idx % 4, r = idx / 4; bf16_t* o = p.H + (size_t)r * D + h * 128;
        float mu = 0.f; for (int e = 0; e < 128; ++e) mu += bf2f(o[e]); mu *= (1.f / 128.f);
        float var = 0.f; for (int e = 0; e < 128; ++e) { const float d = bf2f(o[e]) - mu; var += d * d; } var *= (1.f / 128.f);
        const float rs = 1.f / sqrtf(var + LN_EPS);
        for (int e = 0; e < 128; ++e) o[e] = f2bf((bf2f(o[e]) - mu) * rs * siluf(bf2f(p.Zr[(size_t)r * 2048 + 1536 + h * 128 + e])));
    }
}
__device__ __forceinline__ float block_sum(float v, float* red) {
    __syncthreads();
#pragma unroll
    for (int o = 32; o > 0; o >>= 1) v += __shfl_xor(v, o);
    if ((TIDX & 63) == 0) red[TIDX >> 6] = v;
    __syncthreads();
    float t = 0.f;
#pragma unroll
    for (int w = 0; w < NT / 64; ++w) t += red[w];
    return t;
}
template <int MODE> __device__ __forceinline__ void ph_post(const P& p, int l, int which, const bf16_t* Y, int ln, int wn, int nrows, float* red) {
    const float* lg = p.in[6] + (size_t)(l * 2 + which) * D; const float* lb = p.in[7] + (size_t)(l * 2 + which) * D;
    int toff[16];
    if (MODE == 1) { int s = 0;
#pragma unroll
        for (int e = 0; e < 16; ++e) { toff[e] = s; s += (p.CNT[l * 16 + e] + 255) >> 8; } }
    for (int r = blockIdx.x; r < nrows; r += gridDim.x) {
        float* x = xrow(p, r); const float* gate = modv(p, l, r, which * 3 + 2);
        const bf16_t *y0, *y1 = nullptr;
        if (MODE == 0) y0 = Y + (size_t)r * D;
        else {
            int sr[2];
#pragma unroll
            for (int k = 0; k < 2; ++k) { const int e = p.RE[r * 2 + k]; int to = 0;
#pragma unroll
                for (int q = 0; q < 16; ++q) to = (q == e) ? toff[q] : to;
                sr[k] = to * 256 + p.RPOS[r * 2 + k]; }
            y0 = p.slots + (size_t)sr[0] * D; y1 = p.slots + (size_t)sr[1] * D;
        }
        float v[2]; float s = 0.f;
#pragma unroll
        for (int i = 0; i < 2; ++i) { const int k = TIDX + i * NT; float yy = bf2f(y0[k]); if (MODE == 1) yy += bf2f(y1[k]); v[i] = ALPHA * x[k] + gate[k] * yy; s += v[i]; }
        const float mu = block_sum(s, red) * (1.f / D);
        float q = 0.f;
#pragma unroll
        for (int i = 0; i < 2; ++i) { const float d = v[i] - mu; q += d * d; }
        const float rs = 1.f / sqrtf(block_sum(q, red) * (1.f / D) + LN_EPS);
#pragma unroll
        for (int i = 0; i < 2; ++i) { const int k = TIDX + i * NT; const float xn = (v[i] - mu) * rs * lg[k] + lb[k]; x[k] = xn;
            if (ln >= 0) p.H[(size_t)r * D + k] = f2bf(xn * (1.f + modv(p, ln, r, wn * 3 + 1)[k]) + modv(p, ln, r, wn * 3 + 0)[k]); }
    }
}
__device__ __forceinline__ void ph_route1(const P& p, int l, int nrows) {
    GSTRIDE(idx, (long)nrows * NE) {
        const int e = idx % NE, r = idx / NE; const float* x = xrow(p, r); const float* sc = modv(p, l, r, 4); const float* sh = modv(p, l, r, 3);
        float acc = 0.f;
        for (int k = 0; k < D; ++k) acc += (x[k] * (1.f + sc[k]) + sh[k]) * p.in[29][k * NE + e];
        p.RS[idx] = sigmf(acc);
    }
}
__device__ __forceinline__ void ph_route2(const P& p, int l, int nrows) {
    GSTRIDE(r, nrows) {
        const float* s = p.RS + (size_t)r * NE; const float* rb = p.in[30];
        int best = 0; float bs = -1e30f;
        for (int g = 0; g < NG; ++g) {
            float m1 = -1e30f, m2 = -1e30f;
            for (int q = 0; q < EPG; ++q) { const float v = s[g * EPG + q] + rb[g * EPG + q]; if (v > m1) { m2 = m1; m1 = v; } else if (v > m2) m2 = v; }
            if (m1 + m2 > bs) { bs = m1 + m2; best = g; }
        }
        int i1 = 0; float v1 = -1e30f;
        for (int q = 0; q < EPG; ++q) { const float v = s[best * EPG + q] + rb[best * EPG + q]; if (v > v1) { v1 = v; i1 = q; } }
        int i2 = 0; float v2 = -1e30f;
        for (int q = 0; q < EPG; ++q) { if (q == i1) continue; const float v = s[best * EPG + q] + rb[best * EPG + q]; if (v > v2) { v2 = v; i2 = q; } }
        const int e1 = best * EPG + i1, e2 = best * EPG + i2; const float a = s[e1], c = s[e2];
        p.RE[r * 2] = e1; p.RE[r * 2 + 1] = e2; p.RWt[r * 2] = a / (a + c); p.RWt[r * 2 + 1] = c / (a + c);
        p.RPOS[r * 2] = atomicAdd(&p.CNT[l * 16 + e1], 1); p.RPOS[r * 2 + 1] = atomicAdd(&p.CNT[l * 16 + e2], 1);
    }
}
__device__ __forceinline__ void ph_permute(const P& p, int l, int nrows) {
    int toff[16]; { int s = 0;
#pragma unroll
        for (int e = 0; e < 16; ++e) { toff[e] = s; s += (p.CNT[l * 16 + e] + 255) >> 8; } }
    GSTRIDE(idx, (long)nrows * 2 * 128) {
        const int ck = idx % 128, k = (idx / 128) % 2, r = idx / 256; const int e = p.RE[r * 2 + k]; int to = 0;
#pragma unroll
        for (int q = 0; q < 16; ++q) to = (q == e) ? toff[q] : to;
        const int sr = to * 256 + p.RPOS[r * 2 + k];
        ((uint4*)(p.Hs + (size_t)sr * D))[ck] = ((const uint4*)(p.H + (size_t)r * D))[ck];
        if (ck == 0) p.WS[sr] = p.RWt[r * 2 + k];
    }
}
__device__ __forceinline__ void ph_glagate(const P& p) {
    GSTRIDE(idx, (long)2 * R * 512) {
        const int ch = idx % 512, r = (idx / 512) % R, dir = idx / (512 * R);
        const float* gw = (dir ? p.in[26] : p.in[24]); const float* gb = (dir ? p.in[27] : p.in[25]);
        float acc = gb[ch];
        for (int q = 0; q < 16; ++q) acc += bf2f(p.Z1[(size_t)r * GINP + 3072 + dir * 16 + q]) * gw[q * 512 + ch];
        p.BG[idx] = logsigf(acc) * (1.f / 16.f);
    }
}
__device__ __forceinline__ void ph_glacum(const P& p) {
    GSTRIDE(idx, (long)2 * NB * NCH * 512) {
        const int ch = idx % 512, c = (idx / 512) % NCH, b = (idx / (512 * NCH)) % NB, dir = idx / (512 * NCH * NB);
        float* a = p.BG + ((size_t)dir * R + chunk_row0(b, c)) * 512 + ch;
        float s = 0.f;
        if (dir == 0) for (int i = 0; i < 128; ++i) { s += a[(size_t)i * 512]; a[(size_t)i * 512] = s; }
        else for (int i = 127; i >= 0; --i) { s += a[(size_t)i * 512]; a[(size_t)i * 512] = s; }
    }
}
__device__ __forceinline__ size_t gst_idx(int dir, int b, int h, int c) { return ((((size_t)dir * NB + b) * 4 + h) * NCH + c) * 32768; }
__device__ __forceinline__ void ph_glaU_naive(const P& p) {
    const float* BF = p.BG; const float* BB = p.BG + (size_t)R * 512;
    GSTRIDE(idx, (long)NB * 4 * NCH * 32768) {
        const int d = idx % 128, e = (idx / 128) % 256, c = (idx / 32768) % NCH, h = (idx / (32768 * NCH)) % 4, b = idx / (32768 * NCH * 4);
        const int r0 = chunk_row0(b, c);
        const float bfe = BF[(size_t)(r0 + 127) * 512 + h * 128 + d], bbe = BB[(size_t)r0 * 512 + h * 128 + d];
        float uf = 0.f, ub = 0.f;
        for (int j = 0; j < 128; ++j) {
            const float kk = bf2f(p.Z1[(size_t)(r0 + j) * GINP + 512 + h * 128 + d]), vv = bf2f(p.Z1[(size_t)(r0 + j) * GINP + 1024 + h * 256 + e]);
            uf += kk * expf(bfe - BF[(size_t)(r0 + j) * 512 + h * 128 + d]) * vv; ub += kk * expf(bbe - BB[(size_t)(r0 + j) * 512 + h * 128 + d]) * vv;
        }
        p.GST[gst_idx(0, b, h, c) + e * 128 + d] = f2bf(uf); p.GST[gst_idx(1, b, h, c) + e * 128 + d] = f2bf(ub);
    }
}
__device__ __forceinline__ void ph_glaScan(const P& p) {
    const float* BF = p.BG; const float* BB = p.BG + (size_t)R * 512;
    GSTRIDE(idx, (long)2 * NB * 4 * 32768) {
        const int d = idx % 128, ed = idx % 32768, h = (idx / 32768) % 4, b = (idx / 131072) % NB, dir = idx / (131072 * NB);
        float s = 0.f;
        for (int cc = 0; cc < NCH; ++cc) {
            const int c = dir == 0 ? cc : (cc < 2 ? 1 - cc : NCH + 1 - cc); const int r0 = chunk_row0(b, c);
            const float dc = dir == 0 ? expf(BF[(size_t)(r0 + 127) * 512 + h * 128 + d]) : expf(BB[(size_t)r0 * 512 + h * 128 + d]);
            bf16_t* q = p.GST + gst_idx(dir, b, h, c) + ed; const float u = bf2f(*q); *q = f2bf(s); s = dc * s + u;
        }
    }
}
__device__ __forceinline__ void ph_glaO_naive(const P& p, float* lds) {
    const float* BF = p.BG; const float* BB = p.BG + (size_t)R * 512;
    for (int u = blockIdx.x; u < NB * 4 * 64; u += gridDim.x) {
        const int c = 2 + u % 64, h = (u / 64) % 4, b = u / 256; const int r0 = chunk_row0(b, c);
        __syncthreads();
        for (int e = TIDX; e < 128 * 128; e += NT) {
            const int j = e % 128, i = e / 128;
            const bf16_t* q = p.Z1 + (size_t)(r0 + i) * GINP + h * 128; const bf16_t* k = p.Z1 + (size_t)(r0 + j) * GINP + 512 + h * 128;
            float s = 0.f;
            if (i >= j) { const float* bi = BF + (size_t)(r0 + i) * 512 + h * 128; const float* bj = BF + (size_t)(r0 + j) * 512 + h * 128;
                for (int d = 0; d < 128; ++d) s += bf2f(q[d]) * bf2f(k[d]) * expf(bi[d] - bj[d]); }
            if (i <= j) { const float* bi = BB + (size_t)(r0 + i) * 512 + h * 128; const float* bj = BB + (size_t)(r0 + j) * 512 + h * 128;
                for (int d = 0; d < 128; ++d) s += bf2f(q[d]) * bf2f(k[d]) * expf(bi[d] - bj[d]); }
            lds[e] = s * KSCALE;
        }
        __syncthreads();
        const bf16_t* sf = p.GST + gst_idx(0, b, h, c); const bf16_t* sb = p.GST + gst_idx(1, b, h, c);
        for (int e2 = TIDX; e2 < 128 * 256; e2 += NT) {
            const int e = e2 % 256, i = e2 / 256;
            float o = 0.f; for (int j = 0; j < 128; ++j) o += lds[i * 128 + j] * bf2f(p.Z1[(size_t)(r0 + j) * GINP + 1024 + h * 256 + e]);
            const bf16_t* q = p.Z1 + (size_t)(r0 + i) * GINP + h * 128; const float* bi = BF + (size_t)(r0 + i) * 512 + h * 128; const float* bbi = BB + (size_t)(r0 + i) * 512 + h * 128;
            float a = 0.f; for (int d = 0; d < 128; ++d) a += bf2f(q[d]) * (expf(bi[d]) * bf2f(sf[e * 128 + d]) + expf(bbi[d]) * bf2f(sb[e * 128 + d]));
            p.H[(size_t)(r0 + i) * D + h * 256 + e] = f2bf(o + a * KSCALE);
        }
    }
}
__device__ __forceinline__ void ph_glaNorm_naive(const P& p) {
    GSTRIDE(idx, (long)RL * 4) {
        const int h = idx % 4, r = idx / 4; bf16_t* o = p.H + (size_t)r * D + h * 256;
        float ss = 0.f; for (int e = 0; e < 256; ++e) { const float v = bf2f(o[e]); ss += v * v; }
        const float rs = 1.f / sqrtf(ss * (1.f / 256.f) + LN_EPS);
        for (int e = 0; e < 256; ++e) o[e] = f2bf(bf2f(o[e]) * rs * siluf(bf2f(p.Z1[(size_t)r * GINP + 2048 + h * 256 + e])));
    }
}

#define FD __device__ __forceinline__
#define TIE(a, b) asm volatile("" : "+v"(a) : "v"(b))
#define HWCOS(x) __builtin_amdgcn_cosf(x)
#define HWSIN(x) __builtin_amdgcn_sinf(x)
struct cf { float x, y; };
FD cf cadd(cf a, cf b) { return {a.x + b.x, a.y + b.y}; }
FD cf csub(cf a, cf b) { return {a.x - b.x, a.y - b.y}; }
FD cf cmul(cf a, cf b) { return {a.x * b.x - a.y * b.y, a.x * b.y + a.y * b.x}; }
#define C32(k) ((k)==0?1.0f:(k)==1?0.98078528040323043f:(k)==2?0.92387953251128674f:(k)==3?0.83146961230254524f:(k)==4?0.70710678118654752f:(k)==5?0.55557023301960222f:(k)==6?0.38268343236508977f:(k)==7?0.19509032201612825f:(k)==8?0.0f:(k)==9?-0.19509032201612825f:(k)==10?-0.38268343236508977f:(k)==11?-0.55557023301960222f:(k)==12?-0.70710678118654752f:(k)==13?-0.83146961230254524f:(k)==14?-0.92387953251128674f:-0.98078528040323043f)
#define S32(k) ((k)==0?0.0f:(k)==1?0.19509032201612825f:(k)==2?0.38268343236508977f:(k)==3?0.55557023301960222f:(k)==4?0.70710678118654752f:(k)==5?0.83146961230254524f:(k)==6?0.92387953251128674f:(k)==7?0.98078528040323043f:(k)==8?1.0f:(k)==9?0.98078528040323043f:(k)==10?0.92387953251128674f:(k)==11?0.83146961230254524f:(k)==12?0.70710678118654752f:(k)==13?0.55557023301960222f:(k)==14?0.38268343236508977f:0.19509032201612825f)
template <int N, int LEN, bool INV> FD void dit_level(cf (&x)[N]) {
#pragma unroll
    for (int blk = 0; blk < N; blk += LEN)
#pragma unroll
        for (int j = 0; j < LEN / 2; ++j) {
            const int k = j * (32 / LEN);
            const cf a = x[blk + j], b0 = x[blk + j + LEN / 2];
            const cf b = k == 0 ? b0 : (k == 8 ? (INV ? cf{-b0.y, b0.x} : cf{b0.y, -b0.x}) : cmul(b0, cf{C32(k), INV ? S32(k) : -S32(k)}));
            x[blk + j] = cadd(a, b); x[blk + j + LEN / 2] = csub(a, b);
        }
}
template <int N, bool INV> FD void dit_reg(cf (&x)[N]) {
    dit_level<N, 2, INV>(x); dit_level<N, 4, INV>(x);
    if constexpr (N >= 8) dit_level<N, 8, INV>(x);
    if constexpr (N >= 16) dit_level<N, 16, INV>(x);
}
template <int N, int LEN, bool INV> FD void dif_level(cf (&x)[N]) {
#pragma unroll
    for (int blk = 0; blk < N; blk += LEN)
#pragma unroll
        for (int j = 0; j < LEN / 2; ++j) {
            const int k = j * (32 / LEN);
            const cf a = x[blk + j], b = x[blk + j + LEN / 2];
            x[blk + j] = cadd(a, b); const cf d = csub(a, b);
            x[blk + j + LEN / 2] = k == 0 ? d : (k == 8 ? (INV ? cf{-d.y, d.x} : cf{d.y, -d.x}) : cmul(d, cf{C32(k), INV ? S32(k) : -S32(k)}));
        }
}
template <int N, bool INV> FD void dif_reg(cf (&x)[N]) {
    if constexpr (N >= 16) dif_level<N, 16, INV>(x);
    if constexpr (N >= 8) dif_level<N, 8, INV>(x);
    dif_level<N, 4, INV>(x); dif_level<N, 2, INV>(x);
}
constexpr int FFT_N = 16384, FFT_LDS_CF = 17920;
FD int brev4(int i) { return ((i & 1) << 3) | ((i & 2) << 1) | ((i & 4) >> 1) | ((i & 8) >> 3); }
FD int physA(int m, int a) { return 4480 * a + m + (m >> 4) + 16 * (m >> 9); }
FD int physB(int b, int a, int m) { return 4480 * b + 272 * a + 16 * (a >> 1) + m + (m >> 4); }
FD int physC(int b, int a, int m) { return 272 * b + 16 * (b >> 1) + 17 * a + m; }
FD int physD(int g, int j) { return 17 * g + 16 * (g >> 5) + j; }
template <int RR, int RM> FD void twiddle(cf (&x)[RR], int m, float sgn) {
    const float fr = (float)m * (1.0f / (float)RM); const cf w{HWCOS(fr), sgn * HWSIN(fr)}; cf cur = w;
#pragma unroll
    for (int s = 1; s < RR; ++s) { x[s] = cmul(x[s], cur); if (s + 1 < RR) cur = cmul(cur, w); }
}
FD void stA_fwd(int m, cf v0, cf v1, cf v2, cf v3, cf* buf) {
    cf x[4] = {v0, v2, v1, v3};
    dit_reg<4, false>(x); twiddle<4, 16384>(x, m, -1.f);
#pragma unroll
    for (int s = 0; s < 4; ++s) buf[physA(m, s)] = x[s];
}
FD void stB_fwd(int idx, cf* buf) {
    const int b = idx >> 8, m = idx & 255; cf x[16];
#pragma unroll
    for (int i = 0; i < 16; ++i) x[i] = buf[physB(b, brev4(i), m)];
    dit_reg<16, false>(x); twiddle<16, 4096>(x, m, -1.f);
#pragma unroll
    for (int s = 0; s < 16; ++s) buf[physB(b, s, m)] = x[s];
}
FD void stC_fwd(int idx, cf* buf) {
    const int b = idx >> 4, m = idx & 15; cf x[16];
#pragma unroll
    for (int i = 0; i < 16; ++i) x[i] = buf[physC(b, brev4(i), m)];
    dit_reg<16, false>(x); twiddle<16, 256>(x, m, -1.f);
#pragma unroll
    for (int s = 0; s < 16; ++s) buf[physC(b, s, m)] = x[s];
}
FD void stD_fwd_regs(int g, const cf* buf, cf (&x)[16]) {
#pragma unroll
    for (int i = 0; i < 16; ++i) x[i] = buf[physD(g, brev4(i))];
    dit_reg<16, false>(x);
}
FD void stD_mul(int g, cf* buf, const cf (&h)[16]) {
    cf x[16];
#pragma unroll
    for (int i = 0; i < 16; ++i) x[i] = buf[physD(g, brev4(i))];
    dit_reg<16, false>(x);
#pragma unroll
    for (int s = 0; s < 16; ++s) x[s] = cmul(x[s], h[s]);
    dif_reg<16, true>(x);
#pragma unroll
    for (int i = 0; i < 16; ++i) buf[physD(g, brev4(i))] = x[i];
}
FD void stC_inv(int idx, cf* buf) {
    const int b = idx >> 4, m = idx & 15; cf x[16];
#pragma unroll
    for (int s = 0; s < 16; ++s) x[s] = buf[physC(b, s, m)];
    twiddle<16, 256>(x, m, 1.f); dif_reg<16, true>(x);
#pragma unroll
    for (int i = 0; i < 16; ++i) buf[physC(b, brev4(i), m)] = x[i];
}
FD void stB_inv(int idx, cf* buf) {
    const int b = idx >> 8, m = idx & 255; cf x[16];
#pragma unroll
    for (int s = 0; s < 16; ++s) x[s] = buf[physB(b, s, m)];
    twiddle<16, 4096>(x, m, 1.f); dif_reg<16, true>(x);
#pragma unroll
    for (int i = 0; i < 16; ++i) buf[physB(b, brev4(i), m)] = x[i];
}
FD void stA_inv(int m, const cf* buf, cf& r0, cf& r1) {
    cf x[4];
#pragma unroll
    for (int s = 0; s < 4; ++s) x[s] = buf[physA(m, s)];
    twiddle<4, 16384>(x, m, 1.f); dif_reg<4, true>(x);
    r0 = x[0]; r1 = x[2];
}

#undef FD
__device__ __forceinline__ float dw3(const bf16_t* u, int d, int lo, int hi, float w0, float w1, float w2, float bs) {
    float a = bs + w1 * bf2f(u[d]);
    if (d > lo) a += w0 * bf2f(u[d - 1]);
    if (d < hi) a += w2 * bf2f(u[d + 1]);
    return a;
}
__device__ __forceinline__ void ph_hyena_fft(const P& p, unsigned char* smem) {
    cf* buf = (cf*)smem; float* fb = (float*)smem; float* red = (float*)(smem + FFT_LDS_CF * 8);
    const int t = TIDX;
    bf16_t* yhT = p.Zh + (size_t)2 * NB * 4 * NCH * 16384;
    for (int ch = blockIdx.x; ch < 512; ch += gridDim.x) {
        const bf16_t* hy0 = p.hyT + ((size_t)0 * 512 + ch) * RB;
        const size_t bstr = (size_t)3 * 512 * RB, jstr = (size_t)512 * RB;
        cf* Hg = (cf*)p.H + (size_t)blockIdx.x * 16384;
        cf zreg[16];
        float cw[3][3], cbv[3];
#pragma unroll
        for (int j = 0; j < 3; ++j) { cbv[j] = p.in[12][j * 512 + ch];
#pragma unroll
            for (int q = 0; q < 3; ++q) cw[j][q] = p.in[11][q * 1536 + j * 512 + ch]; }
#pragma unroll 1
        for (int n = 0; n < 2; ++n) {
            const int cfi = (n * 2) * 512 + ch, cbi = (n * 2 + 1) * 512 + ch;
            const float* Ff = p.FILT + (size_t)cfi * RB; const float* Fb = p.FILT + (size_t)cbi * RB;
            float tf0[8], tf1[8], tb2[8], tb3[8]; float sf = 0.f, sb = 0.f;
#pragma unroll
            for (int j = 0; j < 8; ++j) { const int m = t + 512 * j;
                tf0[j] = Ff[m]; tf1[j] = Ff[4096 + m]; tb2[j] = (m == 0) ? Fb[0] : Fb[8192 - (m == 0 ? 1 : m)]; tb3[j] = Fb[4096 - m];
                sf += tf0[j] * tf0[j] + tf1[j] * tf1[j]; sb += tb2[j] * tb2[j] + tb3[j] * tb3[j]; }
            const float nf = 1.f / sqrtf(block_sum(sf, red)), nb = 1.f / sqrtf(block_sum(sb, red));
#pragma unroll
            for (int j = 0; j < 8; ++j) { const int m = launder_i(t) + 512 * j;
                const float v0 = tf0[j] * nf + ((m == 0) ? tb2[j] * nb : 0.f), v2 = (m == 0) ? 0.f : tb2[j] * nb;
                stA_fwd(m, cf{v0, 0.f}, cf{tf1[j] * nf, 0.f}, cf{v2, 0.f}, cf{tb3[j] * nb, 0.f}, buf); }
            __syncthreads();
#pragma unroll 1
            for (int q = 0; q < 2; ++q) stB_fwd(launder_i(t) + 512 * q, buf);
            __syncthreads();
#pragma unroll 1
            for (int q = 0; q < 2; ++q) stC_fwd(launder_i(t) + 512 * q, buf);
            __syncthreads();
            cf H0[16];
            stD_fwd_regs(launder_i(t), buf, H0);
            { const int g = launder_i(t) + 512; cf hh[16]; stD_fwd_regs(g, buf, hh);
#pragma unroll
                for (int s = 0; s < 16; ++s) Hg[s * 512 + t] = hh[s]; }
            __syncthreads();
#pragma unroll
            for (int j = 0; j < 8; ++j) { const int m = launder_i(t) + 512 * j;
                if (n == 0) { zreg[2 * j] = cf{dw3(hy0 + 2 * jstr, m, 0, L - 1, cw[2][0], cw[2][1], cw[2][2], cbv[2]), dw3(hy0 + bstr + 2 * jstr, m, 0, L - 1, cw[2][0], cw[2][1], cw[2][2], cbv[2])};
                              zreg[2 * j + 1] = cf{dw3(hy0 + 2 * jstr, 4096 + m, 0, L - 1, cw[2][0], cw[2][1], cw[2][2], cbv[2]), dw3(hy0 + bstr + 2 * jstr, 4096 + m, 0, L - 1, cw[2][0], cw[2][1], cw[2][2], cbv[2])}; }
                stA_fwd(m, zreg[2 * j], zreg[2 * j + 1], cf{0.f, 0.f}, cf{0.f, 0.f}, buf); }
            __syncthreads();
#pragma unroll 1
            for (int q = 0; q < 2; ++q) stB_fwd(launder_i(t) + 512 * q, buf);
            __syncthreads();
#pragma unroll 1
            for (int q = 0; q < 2; ++q) stC_fwd(launder_i(t) + 512 * q, buf);
            __syncthreads();
            stD_mul(launder_i(t), buf, H0);
            { const int g = launder_i(t) + 512; cf hh[16];
#pragma unroll
                for (int s = 0; s < 16; ++s) hh[s] = Hg[s * 512 + t];
                stD_mul(g, buf, hh); }
            __syncthreads();
#pragma unroll 1
            for (int q = 0; q < 2; ++q) stC_inv(launder_i(t) + 512 * q, buf);
            __syncthreads();
#pragma unroll 1
            for (int q = 0; q < 2; ++q) stB_inv(launder_i(t) + 512 * q, buf);
            __syncthreads();
            const float sk = p.in[21][n * 512 + ch];
#pragma unroll
            for (int j = 0; j < 8; ++j) { const int m = launder_i(t) + 512 * j; cf r0, r1; stA_inv(m, buf, r0, r1);
#pragma unroll
                for (int hlf = 0; hlf < 2; ++hlf) { const int d = m + 4096 * hlf; const cf r = hlf ? r1 : r0; const cf z = zreg[2 * j + hlf];
                    const bf16_t* gs = hy0 + n * jstr;
                    const float g0 = dw3(gs, d, 0, L - 1, cw[n][0], cw[n][1], cw[n][2], cbv[n]), g1 = dw3(gs + bstr, d, 0, L - 1, cw[n][0], cw[n][1], cw[n][2], cbv[n]);
                    const float o0 = g0 * (r.x * (1.f / 16384.f) + sk * z.x), o1 = g1 * (r.y * (1.f / 16384.f) + sk * z.y);
                    if (n == 0) zreg[2 * j + hlf] = cf{o0, o1};
                    else { yhT[((size_t)0 * 512 + ch) * RB + d] = f2bf(o0); yhT[((size_t)1 * 512 + ch) * RB + d] = f2bf(o1); } } }
            __syncthreads();
        }
        {
            float* tap = fb;
            float* zc = fb + 1024;
            const int b = t >> 8, tt = t & 255;
#pragma unroll
            for (int n = 0; n < 2; ++n) {
                const int cfi = (n * 2) * 512 + ch, cbi = (n * 2 + 1) * 512 + ch;
                const float* Ff = p.FILT + (size_t)cfi * RB + L; const float* Fb = p.FILT + (size_t)cbi * RB + L;
                const float vf = t < 256 ? Ff[t] : 0.f, vb = t < 256 ? Fb[t] : 0.f;
                const float nf = 1.f / sqrtf(block_sum(vf * vf, red)), nb = 1.f / sqrtf(block_sum(vb * vb, red));
                if (t < 511) { const int d = t - 255; tap[n * 512 + t] = d > 0 ? Ff[d] * nf : (d < 0 ? Fb[-d] * nb : Ff[0] * nf + Fb[0] * nb); }
            }
            const bf16_t* hb_ = hy0 + (size_t)b * bstr;
            const float z1 = dw3(hb_ + 2 * jstr, L + tt, L, RB - 1, cw[2][0], cw[2][1], cw[2][2], cbv[2]);
            zc[b * 256 + tt] = z1;
            __syncthreads();
            float c1 = 0.f;
            for (int s = 0; s < 256; ++s) c1 += tap[tt - s + 255] * zc[b * 256 + s];
            const float z2 = dw3(hb_, L + tt, L, RB - 1, cw[0][0], cw[0][1], cw[0][2], cbv[0]) * (c1 + p.in[21][ch] * z1);
            __syncthreads();
            zc[b * 256 + tt] = z2;
            __syncthreads();
            float c2 = 0.f;
            for (int s = 0; s < 256; ++s) c2 += tap[512 + tt - s + 255] * zc[b * 256 + s];
            yhT[((size_t)b * 512 + ch) * RB + L + tt] = f2bf(dw3(hb_ + jstr, L + tt, L, RB - 1, cw[1][0], cw[1][1], cw[1][2], cbv[1]) * (c2 + p.in[21][512 + ch] * z2));
            __syncthreads();
        }
    }
}

typedef short bf16x8 __attribute__((ext_vector_type(8)));
typedef short s16x4 __attribute__((ext_vector_type(4)));
typedef float f32x4 __attribute__((ext_vector_type(4)));
typedef unsigned u4v __attribute__((ext_vector_type(4)));
typedef unsigned u2v __attribute__((ext_vector_type(2)));
constexpr int LDT = 136;
constexpr int TILE_E = 128 * LDT;
__device__ __forceinline__ bf16x8 frag_row(const LAS bf16_t* T, int ld, int r0, int k0, int lane) {
    return *(const LAS bf16x8*)(T + (r0 + (lane & 15)) * ld + k0 + 8 * (lane >> 4));
}
__device__ __forceinline__ bf16x8 frag_tr(const LAS bf16_t* T, int ld, int k0, int n0, int lane) {
    const int g = lane >> 4, q = (lane & 15) >> 2, pp = lane & 3;
    const LAS bf16_t* a0 = T + (k0 + 8 * g + q) * ld + n0 + 4 * pp;
    const s16x4 lo = __builtin_amdgcn_ds_read_tr16_b64_v4i16((LAS s16x4*)a0);
    const s16x4 hi = __builtin_amdgcn_ds_read_tr16_b64_v4i16((LAS s16x4*)(a0 + 4 * ld));
    return (bf16x8){lo[0], lo[1], lo[2], lo[3], hi[0], hi[1], hi[2], hi[3]};
}
#define MFMA16(xn, xm, acc) __builtin_amdgcn_mfma_f32_16x16x32_bf16(xn, xm, acc, 0, 0, 0)
__device__ __forceinline__ void unpack8(const u4v u, float (&f)[8]) {
    f[0] = __uint_as_float(u.x << 16); f[1] = __uint_as_float(u.x & 0xffff0000u); f[2] = __uint_as_float(u.y << 16); f[3] = __uint_as_float(u.y & 0xffff0000u);
    f[4] = __uint_as_float(u.z << 16); f[5] = __uint_as_float(u.z & 0xffff0000u); f[6] = __uint_as_float(u.w << 16); f[7] = __uint_as_float(u.w & 0xffff0000u);
}
__device__ __forceinline__ u4v pack8(const float (&f)[8]) {
    u4v u; u.x = pk_bf16(f[0], f[1]); u.y = pk_bf16(f[2], f[3]); u.z = pk_bf16(f[4], f[5]); u.w = pk_bf16(f[6], f[7]); return u;
}
__device__ __forceinline__ void stage_tile(LAS bf16_t* dst, const bf16_t* src, int gld, int tid) {
#pragma unroll
    for (int i = 0; i < 4; ++i) { const int c = tid + 512 * i, row = c >> 4, ch = c & 15;
        *(LAS u4v*)(dst + row * LDT + ch * 8) = *(const u4v*)(src + (size_t)row * gld + ch * 8); }
}
__device__ __forceinline__ void ph_retU_mfma(const P& p, unsigned char* smem) {
    LAS bf16_t* Kt = (LAS bf16_t*)smem; LAS bf16_t* VF = Kt + TILE_E; LAS bf16_t* VB = VF + TILE_E;
    bf16_t* ST = p.Zh;
    for (int u = blockIdx.x; u < NB * 4 * NCH; u += gridDim.x) {
        const int tid = TIDX, lane = tid & 63, w = tid >> 6;
        const int c = u % NCH, h = (u / NCH) % 4, b = u / (NCH * 4); const int r0 = chunk_row0(b, c);
        const float lgf = p.in[9][h], lgb = p.in[10][h];
        const bf16_t* kb = p.Zr + (size_t)r0 * 2048 + 512 + h * 128; const bf16_t* vb = p.Zr + (size_t)r0 * 2048 + 1024 + h * 128;
        __syncthreads();
        stage_tile(Kt, kb, 2048, tid);
#pragma unroll
        for (int i = 0; i < 4; ++i) { const int cc = tid + 512 * i, j = cc >> 4, ch = cc & 15;
            float f[8], g[8]; unpack8(*(const u4v*)(vb + (size_t)j * 2048 + ch * 8), f);
            const float wf = __expf(lgf * (float)(127 - j)), wb = __expf(lgb * (float)j);
#pragma unroll
            for (int q = 0; q < 8; ++q) { g[q] = f[q] * wb; f[q] *= wf; }
            *(LAS u4v*)(VF + j * LDT + ch * 8) = pack8(f); *(LAS u4v*)(VB + j * LDT + ch * 8) = pack8(g); }
        __syncthreads();
        f32x4 af[8], ab[8];
#pragma unroll
        for (int nt = 0; nt < 8; ++nt) { af[nt] = (f32x4){0.f, 0.f, 0.f, 0.f}; ab[nt] = (f32x4){0.f, 0.f, 0.f, 0.f}; }
#pragma unroll
        for (int ks = 0; ks < 4; ++ks) {
            const bf16x8 xf = frag_tr(VF, LDT, 32 * ks, 16 * w, lane), xb = frag_tr(VB, LDT, 32 * ks, 16 * w, lane);
#pragma unroll
            for (int nt = 0; nt < 8; ++nt) { const bf16x8 xn = frag_tr(Kt, LDT, 32 * ks, 16 * nt, lane); af[nt] = MFMA16(xn, xf, af[nt]); ab[nt] = MFMA16(xn, xb, ab[nt]); }
        }
        const int e = 16 * w + (lane & 15), d0 = 4 * (lane >> 4);
        bf16_t* of = ST + st_idx(0, b, h, c) + e * 128 + d0; bf16_t* ob = ST + st_idx(1, b, h, c) + e * 128 + d0;
#pragma unroll
        for (int nt = 0; nt < 8; ++nt) {
            u2v o; o.x = pk_bf16(af[nt][0], af[nt][1]); o.y = pk_bf16(af[nt][2], af[nt][3]); *(u2v*)(of + 16 * nt) = o;
            o.x = pk_bf16(ab[nt][0], ab[nt][1]); o.y = pk_bf16(ab[nt][2], ab[nt][3]); *(u2v*)(ob + 16 * nt) = o; }
    }
}
__device__ __forceinline__ void ph_retO_mfma(const P& p, unsigned char* smem) {
    LAS bf16_t* Qs = (LAS bf16_t*)smem; LAS bf16_t* Ks = Qs + TILE_E; LAS bf16_t* Vs = Ks + TILE_E; LAS bf16_t* Ss = Vs + TILE_E;
    const bf16_t* ST = p.Zh;
    for (int u = blockIdx.x; u < NB * 4 * NCH; u += gridDim.x) {
        const int tid = TIDX, lane = tid & 63, w = tid >> 6, fr = lane & 15, fq = lane >> 4;
        const int c = u % NCH, h = (u / NCH) % 4, b = u / (NCH * 4); const int r0 = chunk_row0(b, c);
        const float lgf = p.in[9][h], lgb = p.in[10][h];
        const bf16_t* zb = p.Zr + (size_t)r0 * 2048 + h * 128;
        __syncthreads();
        stage_tile(Qs, zb, 2048, tid); stage_tile(Ks, zb + 512, 2048, tid); stage_tile(Vs, zb + 1024, 2048, tid); stage_tile(Ss, ST + st_idx(0, b, h, c), 128, tid);
        __syncthreads();
        f32x4 as[8], af[8];
#pragma unroll
        for (int nt = 0; nt < 8; ++nt) { as[nt] = (f32x4){0.f, 0.f, 0.f, 0.f}; af[nt] = (f32x4){0.f, 0.f, 0.f, 0.f}; }
#pragma unroll
        for (int ks = 0; ks < 4; ++ks) { const bf16x8 xm = frag_row(Qs, LDT, 16 * w, 32 * ks, lane);
#pragma unroll
            for (int nt = 0; nt < 8; ++nt) { as[nt] = MFMA16(frag_row(Ks, LDT, 16 * nt, 32 * ks, lane), xm, as[nt]); af[nt] = MFMA16(frag_row(Ss, LDT, 16 * nt, 32 * ks, lane), xm, af[nt]); } }
        const int i = 16 * w + fr;
        __syncthreads();
#pragma unroll
        for (int nt = 0; nt < 8; ++nt) { float pv[4];
#pragma unroll
            for (int q = 0; q < 4; ++q) { const int j = 16 * nt + 4 * fq + q; const float m = i > j ? __expf(lgf * (float)(i - j)) : (j > i ? __expf(lgb * (float)(j - i)) : 2.f); pv[q] = as[nt][q] * m; }
            u2v o; o.x = pk_bf16(pv[0], pv[1]); o.y = pk_bf16(pv[2], pv[3]); *(LAS u2v*)(Ks + i * LDT + 16 * nt + 4 * fq) = o; }
        stage_tile(Ss, ST + st_idx(1, b, h, c), 128, tid);
        __syncthreads();
        f32x4 ao[8], ab[8];
#pragma unroll
        for (int nt = 0; nt < 8; ++nt) { ao[nt] = (f32x4){0.f, 0.f, 0.f, 0.f}; ab[nt] = (f32x4){0.f, 0.f, 0.f, 0.f}; }
#pragma unroll
        for (int ks = 0; ks < 4; ++ks) { const bf16x8 xp = frag_row(Ks, LDT, 16 * w, 32 * ks, lane), xq = frag_row(Qs, LDT, 16 * w, 32 * ks, lane);
#pragma unroll
            for (int nt = 0; nt < 8; ++nt) { ao[nt] = MFMA16(frag_tr(Vs, LDT, 32 * ks, 16 * nt, lane), xp, ao[nt]); ab[nt] = MFMA16(frag_row(Ss, LDT, 16 * nt, 32 * ks, lane), xq, ab[nt]); } }
        const float rf = __expf(lgf * (float)(i + 1)), rb = __expf(lgb * (float)(128 - i));
        float s = 0.f;
#pragma unroll
        for (int nt = 0; nt < 8; ++nt) { ao[nt] = ao[nt] + af[nt] * rf + ab[nt] * rb; s += (ao[nt][0] + ao[nt][1]) + (ao[nt][2] + ao[nt][3]); }
        s += __shfl_xor(s, 16); s += __shfl_xor(s, 32);
        const float mu = s * (1.f / 128.f); float qv = 0.f;
#pragma unroll
        for (int nt = 0; nt < 8; ++nt) { const f32x4 dd = ao[nt] - mu; qv += (dd[0] * dd[0] + dd[1] * dd[1]) + (dd[2] * dd[2] + dd[3] * dd[3]); }
        qv += __shfl_xor(qv, 16); qv += __shfl_xor(qv, 32);
        const float rs = 1.f / sqrtf(qv * (1.f / 128.f) + LN_EPS);
        const bf16_t* gp = p.Zr + (size_t)(r0 + i) * 2048 + 1536 + h * 128 + 4 * fq; bf16_t* yp = p.H + (size_t)(r0 + i) * D + h * 128 + 4 * fq;
#pragma unroll
        for (int nt = 0; nt < 8; ++nt) { const u2v gu = *(const u2v*)(gp + 16 * nt);
            const float g0 = __uint_as_float(gu.x << 16), g1 = __uint_as_float(gu.x & 0xffff0000u), g2 = __uint_as_float(gu.y << 16), g3 = __uint_as_float(gu.y & 0xffff0000u);
            u2v o; o.x = pk_bf16((ao[nt][0] - mu) * rs * siluf(g0), (ao[nt][1] - mu) * rs * siluf(g1)); o.y = pk_bf16((ao[nt][2] - mu) * rs * siluf(g2), (ao[nt][3] - mu) * rs * siluf(g3));
            *(u2v*)(yp + 16 * nt) = o; }
    }
}
__device__ __forceinline__ void ph_glaU_mfma(const P& p, unsigned char* smem) {
    LAS bf16_t* KF = (LAS bf16_t*)smem; LAS bf16_t* KB = KF + TILE_E; LAS bf16_t* Vs = KB + TILE_E;
    for (int u = blockIdx.x; u < NB * 4 * NCH; u += gridDim.x) {
        const int tid = TIDX, lane = tid & 63, w = tid >> 6;
        const int c = u % NCH, h = (u / NCH) % 4, b = u / (NCH * 4); const int r0 = chunk_row0(b, c);
        const bf16_t* kb = p.Z1 + (size_t)r0 * GINP + 512 + h * 128; const bf16_t* vb = p.Z1 + (size_t)r0 * GINP + 1024 + h * 256;
        float* BFw = p.BG + (size_t)r0 * 512 + h * 128; float* BBw = p.BG + (size_t)R * 512 + (size_t)r0 * 512 + h * 128;
        const float* BF = BFw; const float* BB = BBw;
        __syncthreads();
        {
            float* lr = (float*)(Vs);
            float* tot = lr + 128 * 32;
            for (int e = tid; e < 128 * 32; e += NT) lr[e] = bf2f(p.Z1[(size_t)(r0 + (e >> 5)) * GINP + 3072 + (e & 31)]);
            const int chn = tid & 127, dir = (tid >> 7) & 1, half = tid >> 8;
            const float* gw = (dir ? p.in[26] : p.in[24]) + h * 128 + chn; float g[16];
#pragma unroll
            for (int q = 0; q < 16; ++q) g[q] = gw[q * 512];
            const float gb = (dir ? p.in[27] : p.in[25])[h * 128 + chn];
            __syncthreads();
            float la[64]; float s = 0.f;
#pragma unroll
            for (int ii = 0; ii < 64; ++ii) { const int i = half * 64 + ii; float a = gb;
#pragma unroll
                for (int q = 0; q < 16; ++q) a += lr[i * 32 + dir * 16 + q] * g[q];
                la[ii] = (fminf(a, 0.f) - __logf(1.f + __expf(-fabsf(a)))) * (1.f / 16.f); s += la[ii]; }
            tot[(dir * 2 + half) * 128 + chn] = s;
            __syncthreads();
            const float total = tot[(dir * 2 + 0) * 128 + chn] + tot[(dir * 2 + 1) * 128 + chn];
            s = dir == 0 ? (half ? tot[(0 * 2 + 0) * 128 + chn] : 0.f) : (half ? 0.f : tot[(1 * 2 + 1) * 128 + chn]);
            float* out = (dir ? BBw : BFw) + chn; LAS bf16_t* Kd = dir ? KB : KF;
            if (dir == 0) {
#pragma unroll
                for (int ii = 0; ii < 64; ++ii) { const int i = half * 64 + ii; s += la[ii]; out[(size_t)i * 512] = s; Kd[i * LDT + chn] = f2bf(bf2f(kb[(size_t)i * GINP + chn]) * __expf(total - s)); }
            } else {
#pragma unroll
                for (int ii = 63; ii >= 0; --ii) { const int i = half * 64 + ii; s += la[ii]; out[(size_t)i * 512] = s; Kd[i * LDT + chn] = f2bf(bf2f(kb[(size_t)i * GINP + chn]) * __expf(total - s)); }
            }
            __syncthreads();
        }
        const int fr = lane & 15, fq = lane >> 4;
#pragma unroll 1
        for (int hf = 0; hf < 2; ++hf) {
            if (hf) __syncthreads();
            stage_tile(Vs, vb + hf * 128, GINP, tid);
            __syncthreads();
            {
                f32x4 af[8], ab[8];
#pragma unroll
                for (int nt = 0; nt < 8; ++nt) { af[nt] = (f32x4){0.f, 0.f, 0.f, 0.f}; ab[nt] = (f32x4){0.f, 0.f, 0.f, 0.f}; }
#pragma unroll
                for (int ks = 0; ks < 4; ++ks) { const bf16x8 x0 = frag_tr(Vs, LDT, 32 * ks, 16 * w, lane);
#pragma unroll
                    for (int nt = 0; nt < 8; ++nt) { af[nt] = MFMA16(frag_tr(KF, LDT, 32 * ks, 16 * nt, lane), x0, af[nt]); ab[nt] = MFMA16(frag_tr(KB, LDT, 32 * ks, 16 * nt, lane), x0, ab[nt]); } }
                bf16_t* of = p.GST + gst_idx(0, b, h, c) + (size_t)(hf * 128 + 16 * w + fr) * 128 + 4 * fq; bf16_t* ob = p.GST + gst_idx(1, b, h, c) + (size_t)(hf * 128 + 16 * w + fr) * 128 + 4 * fq;
#pragma unroll
                for (int nt = 0; nt < 8; ++nt) { u2v v; v.x = pk_bf16(af[nt][0], af[nt][1]); v.y = pk_bf16(af[nt][2], af[nt][3]); *(u2v*)(of + 16 * nt) = v;
                    v.x = pk_bf16(ab[nt][0], ab[nt][1]); v.y = pk_bf16(ab[nt][2], ab[nt][3]); *(u2v*)(ob + 16 * nt) = v; }
            }
        }
    }
}
__device__ __forceinline__ void stage_scaled(LAS bf16_t* dst, const bf16_t* src, const float* G, float sgn, float mul, int tid) {
#pragma unroll
    for (int i = 0; i < 4; ++i) { const int cc = tid + 512 * i, j = cc >> 4, ch = cc & 15;
        float k8[8]; unpack8(*(const u4v*)(src + (size_t)j * GINP + ch * 8), k8);
        const f32x4 f0 = *(const f32x4*)(G + (size_t)j * 512 + ch * 8), f1 = *(const f32x4*)(G + (size_t)j * 512 + ch * 8 + 4);
#pragma unroll
        for (int q = 0; q < 4; ++q) { k8[q] *= __expf(sgn * f0[q]) * mul; k8[q + 4] *= __expf(sgn * f1[q]) * mul; }
        *(LAS u4v*)(dst + j * LDT + ch * 8) = pack8(k8); }
}
__device__ __forceinline__ void ph_glaO_mfma(const P& p, unsigned char* smem) {
    LAS bf16_t* QF = (LAS bf16_t*)smem; LAS bf16_t* QB = QF + TILE_E; LAS bf16_t* KX = QB + TILE_E; LAS bf16_t* R4 = KX + TILE_E;
    for (int u = blockIdx.x; u < NB * 4 * 64; u += gridDim.x) {
        const int tid = TIDX, lane = tid & 63, w = tid >> 6, fr = lane & 15, fq = lane >> 4;
        const int c = 2 + u % 64, h = (u / 64) % 4, b = u / 256; const int r0 = chunk_row0(b, c);
        const bf16_t* qb = p.Z1 + (size_t)r0 * GINP + h * 128; const bf16_t* kb = qb + 512; const bf16_t* vb = p.Z1 + (size_t)r0 * GINP + 1024 + h * 256;
        const float* BF = p.BG + (size_t)r0 * 512 + h * 128; const float* BB = p.BG + (size_t)R * 512 + (size_t)r0 * 512 + h * 128;
        const int i = 16 * w + fr;
        __syncthreads();
        stage_scaled(QF, qb, BF, 1.f, KSCALE, tid); stage_scaled(QB, qb, BB, 1.f, KSCALE, tid); stage_scaled(KX, kb, BF, -1.f, 1.f, tid);
        __syncthreads();
        f32x4 s1[8];
#pragma unroll
        for (int nt = 0; nt < 8; ++nt) s1[nt] = (f32x4){0.f, 0.f, 0.f, 0.f};
#pragma unroll
        for (int ks = 0; ks < 4; ++ks) { const bf16x8 xm = frag_row(QF, LDT, 16 * w, 32 * ks, lane);
#pragma unroll
            for (int nt = 0; nt < 8; ++nt) s1[nt] = MFMA16(frag_row(KX, LDT, 16 * nt, 32 * ks, lane), xm, s1[nt]); }
#pragma unroll
        for (int nt = 0; nt < 8; ++nt)
#pragma unroll
            for (int q = 0; q < 4; ++q) { const int j = 16 * nt + 4 * fq + q; s1[nt][q] = (i >= j) ? s1[nt][q] : 0.f; }
        __syncthreads();
        stage_scaled(KX, kb, BB, -1.f, 1.f, tid);
        __syncthreads();
        {
            f32x4 s2[8];
#pragma unroll
            for (int nt = 0; nt < 8; ++nt) s2[nt] = (f32x4){0.f, 0.f, 0.f, 0.f};
#pragma unroll
            for (int ks = 0; ks < 4; ++ks) { const bf16x8 xm = frag_row(QB, LDT, 16 * w, 32 * ks, lane);
#pragma unroll
                for (int nt = 0; nt < 8; ++nt) s2[nt] = MFMA16(frag_row(KX, LDT, 16 * nt, 32 * ks, lane), xm, s2[nt]); }
#pragma unroll
            for (int nt = 0; nt < 8; ++nt)
#pragma unroll
                for (int q = 0; q < 4; ++q) { const int j = 16 * nt + 4 * fq + q; s1[nt][q] += (i <= j) ? s2[nt][q] : 0.f; }
        }
        __syncthreads();
#pragma unroll
        for (int nt = 0; nt < 8; ++nt) { u2v o; o.x = pk_bf16(s1[nt][0], s1[nt][1]); o.y = pk_bf16(s1[nt][2], s1[nt][3]); *(LAS u2v*)(KX + i * LDT + 16 * nt + 4 * fq) = o; }
        f32x4 ao[2][8];
#pragma unroll
        for (int hf = 0; hf < 2; ++hf) {
#pragma unroll
            for (int nt = 0; nt < 8; ++nt) ao[hf][nt] = (f32x4){0.f, 0.f, 0.f, 0.f};
            stage_tile(R4, vb + hf * 128, GINP, tid);
            __syncthreads();
#pragma unroll
            for (int ks = 0; ks < 4; ++ks) { const bf16x8 xp = frag_row(KX, LDT, 16 * w, 32 * ks, lane);
#pragma unroll
                for (int nt = 0; nt < 8; ++nt) ao[hf][nt] = MFMA16(frag_tr(R4, LDT, 32 * ks, 16 * nt, lane), xp, ao[hf][nt]); }
            __syncthreads();
            stage_tile(R4, p.GST + gst_idx(0, b, h, c) + (size_t)hf * 128 * 128, 128, tid);
            __syncthreads();
#pragma unroll
            for (int ks = 0; ks < 4; ++ks) { const bf16x8 xq = frag_row(QF, LDT, 16 * w, 32 * ks, lane);
#pragma unroll
                for (int nt = 0; nt < 8; ++nt) ao[hf][nt] = MFMA16(frag_row(R4, LDT, 16 * nt, 32 * ks, lane), xq, ao[hf][nt]); }
            __syncthreads();
            stage_tile(R4, p.GST + gst_idx(1, b, h, c) + (size_t)hf * 128 * 128, 128, tid);
            __syncthreads();
#pragma unroll
            for (int ks = 0; ks < 4; ++ks) { const bf16x8 xq = frag_row(QB, LDT, 16 * w, 32 * ks, lane);
#pragma unroll
                for (int nt = 0; nt < 8; ++nt) ao[hf][nt] = MFMA16(frag_row(R4, LDT, 16 * nt, 32 * ks, lane), xq, ao[hf][nt]); }
            __syncthreads();
        }
        float ss = 0.f;
#pragma unroll
        for (int hf = 0; hf < 2; ++hf)
#pragma unroll
            for (int nt = 0; nt < 8; ++nt) { const f32x4 v = ao[hf][nt]; ss += (v[0] * v[0] + v[1] * v[1]) + (v[2] * v[2] + v[3] * v[3]); }
        ss += __shfl_xor(ss, 16); ss += __shfl_xor(ss, 32);
        const float rs = 1.f / sqrtf(ss * (1.f / 256.f) + LN_EPS);
        const bf16_t* gp = p.Z1 + (size_t)(r0 + i) * GINP + 2048 + h * 256 + 4 * fq; bf16_t* yp = p.H + (size_t)(r0 + i) * D + h * 256 + 4 * fq;
#pragma unroll
        for (int hf = 0; hf < 2; ++hf)
#pragma unroll
            for (int nt = 0; nt < 8; ++nt) { const u2v gu = *(const u2v*)(gp + hf * 128 + 16 * nt);
                const float g0 = __uint_as_float(gu.x << 16), g1 = __uint_as_float(gu.x & 0xffff0000u), g2 = __uint_as_float(gu.y << 16), g3 = __uint_as_float(gu.y & 0xffff0000u);
                u2v o; o.x = pk_bf16(ao[hf][nt][0] * rs * siluf(g0), ao[hf][nt][1] * rs * siluf(g1)); o.y = pk_bf16(ao[hf][nt][2] * rs * siluf(g2), ao[hf][nt][3] * rs * siluf(g3));
                *(u2v*)(yp + hf * 128 + 16 * nt) = o; }
    }
}

template <int MODE> __device__ __forceinline__ void tr_w(bf16_t* dst, const float* src, int N, int K, int ldsrc, float* t  , int& tile0, int tile_stride) {
    const int nt_n = N / 64, ntiles = nt_n * (K / 64);
    float v[8];
    if (tile0 < ntiles) { const int tid = TIDX; const int n0 = (tile0 % nt_n) * 64, k0 = (tile0 / nt_n) * 64;
#pragma unroll
        for (int i = 0; i < 8; ++i) { const int e = tid + 512 * i; v[i] = src[(size_t)(k0 + (e >> 6)) * ldsrc + n0 + (e & 63)]; } }
    for (int tile = tile0; tile < ntiles; tile += tile_stride) {
        const int tid = TIDX; const int n0 = (tile % nt_n) * 64, k0 = (tile / nt_n) * 64;
        __syncthreads();
#pragma unroll
        for (int i = 0; i < 8; ++i) { const int e = tid + 512 * i; t[(e >> 6) * 65 + (e & 63)] = v[i]; }
        __syncthreads();
        if (tile + tile_stride < ntiles) { const int tn = tile + tile_stride; const int n1 = (tn % nt_n) * 64, k1 = (tn / nt_n) * 64;
#pragma unroll
            for (int i = 0; i < 8; ++i) { const int e = tid + 512 * i; v[i] = src[(size_t)(k1 + (e >> 6)) * ldsrc + n1 + (e & 63)]; } }
#pragma unroll
        for (int i = 0; i < 4; ++i) { const int e = tid + 512 * i, nn = e >> 5, kp = e & 31; const int n = n0 + nn;
            int row; float sc = 1.f;
            if (MODE == 0) row = n; else if (MODE == 3) { const int d = n & 127; row = n < 1024 ? (n - d) + 2 * (d & 63) + (d >> 6) : n; sc = (n >= 512 && n < 1024) ? KSCALE : 1.f; }
            else row = 8 * (n >> 2) + (n & 3) + (MODE == 2 ? 4 : 0);
            *(unsigned*)(dst + (size_t)row * K + k0 + 2 * kp) = pk_bf16(t[(2 * kp) * 65 + nn] * sc, t[(2 * kp + 1) * 65 + nn] * sc); }
    }
    tile0 = tile0 - (ntiles % tile_stride);
    if (tile0 < 0) tile0 += tile_stride;
}
__device__ __forceinline__ void ph_wconv_fast(const P& p, float* t) {
    int t0 = blockIdx.x; const int G = gridDim.x;
    tr_w<3>(p.Win0, p.in[8], ABIN, D, ABIN, t, t0, G);
    tr_w<0>(p.Wout0, p.in[22], D, D, D, t, t0, G);
    tr_w<0>(p.Win1, p.in[23], 3072, D, GIN, t, t0, G);
    tr_w<0>(p.Wout1, p.in[28], D, D, D, t, t0, G);
    GSTRIDE(idx, (long)(GINP - 3072) * D) { const int k = idx % D, n = 3072 + idx / D; p.Win1[(size_t)n * D + k] = n < GIN ? f2bf(p.in[23][(size_t)k * GIN + n]) : (bf16_t)0; }
}
__device__ __forceinline__ void ph_wconv_moe_fast(const P& p, int l, float* t) {
    int t0 = blockIdx.x; const int G = gridDim.x;
    for (int e = 0; e < NE; ++e) {
        tr_w<1>(p.Wgu + (size_t)e * 1024 * 1024, p.in[31] + (size_t)(l * NE + e) * D * EH, EH, D, EH, t, t0, G);
        tr_w<2>(p.Wgu + (size_t)e * 1024 * 1024, p.in[32] + (size_t)(l * NE + e) * D * EH, EH, D, EH, t, t0, G);
        tr_w<0>(p.Wd + (size_t)e * 1024 * 512, p.in[33] + (size_t)(l * NE + e) * EH * D, D, EH, D, t, t0, G);
    }
}
__device__ __forceinline__ void ph_prep_hy_fast(const P& p, float* t  ) {
    const int ntt = RB / 64, ntc = 1536 / 64;
    for (int tile = blockIdx.x; tile < NB * ntt * ntc; tile += gridDim.x) {
        const int tid = TIDX; const int ct = tile % ntc, tt = (tile / ntc) % ntt, b = tile / (ntc * ntt); const int c0 = ct * 64, tl0 = tt * 64;
        const int s0 = tl0 < L ? 0 : L, s1 = tl0 < L ? L : RB;
        __syncthreads();
        for (int e = tid; e < 66 * 64; e += NT) { const int rr = e >> 6, cc = e & 63, tl = tl0 - 1 + rr;
            t[rr * 65 + cc] = (tl >= s0 && tl < s1) ? bf2f(p.Zh[(size_t)bt_row(b, tl) * 1536 + c0 + cc]) : 0.f; }
        __syncthreads();
#pragma unroll
        for (int i = 0; i < 4; ++i) { const int e = tid + 512 * i, cc = e >> 5, tp = e & 31; const int col = c0 + cc;
            const float w0 = p.in[11][col], w1 = p.in[11][1536 + col], w2 = p.in[11][3072 + col], bs = p.in[12][col];
            const float a = bs + w0 * t[(2 * tp) * 65 + cc] + w1 * t[(2 * tp + 1) * 65 + cc] + w2 * t[(2 * tp + 2) * 65 + cc];
            const float c2 = bs + w0 * t[(2 * tp + 1) * 65 + cc] + w1 * t[(2 * tp + 2) * 65 + cc] + w2 * t[(2 * tp + 3) * 65 + cc];
            *(unsigned*)(p.hyT + ((size_t)b * 1536 + col) * RB + tl0 + 2 * tp) = pk_bf16(a, c2); }
    }
}
__device__ __forceinline__ void ph_hy_untranspose_fast(const P& p, float* t) {
    const bf16_t* yhT = p.Zh + (size_t)2 * NB * 4 * NCH * 16384;
    const int ntt = RB / 64, ntc = 512 / 64;
    for (int tile = blockIdx.x; tile < NB * ntt * ntc; tile += gridDim.x) {
        const int tid = TIDX; const int ct = tile % ntc, tt = (tile / ntc) % ntt, b = tile / (ntc * ntt); const int c0 = ct * 64, tl0 = tt * 64;
        __syncthreads();
#pragma unroll
        for (int i = 0; i < 8; ++i) { const int e = tid + 512 * i, cc = e >> 6, ti = e & 63; t[cc * 65 + ti] = bf2f(yhT[((size_t)b * 512 + c0 + cc) * RB + tl0 + ti]); }
        __syncthreads();
#pragma unroll
        for (int i = 0; i < 4; ++i) { const int e = tid + 512 * i, ti = e >> 5, cp = e & 31;
            *(unsigned*)(p.H + (size_t)bt_row(b, tl0 + ti) * D + 512 + c0 + 2 * cp) = pk_bf16(t[(2 * cp) * 65 + ti], t[(2 * cp + 1) * 65 + ti]); }
    }
}
__device__ __forceinline__ void ph_prep_rope_fast(const P& p) {
    GSTRIDE(idx, (long)R * 2 * 4 * 8) {
        const int pc = idx % 8, h = (idx / 8) % 4, w = (idx / 32) % 2, r = idx / 64;
        bf16_t* base = p.Zr + (size_t)r * 2048 + w * 512 + h * 128 + pc * 8;
        float a[8], c[8]; unpack8(*(const u4v*)base, a); unpack8(*(const u4v*)(base + 64), c);
        const float sc = w ? KSCALE : 1.f;
        if (r < RL) {
            const int t = r % L; const float pos = (pc < 4) ? (float)(t / GW) : (float)(t % GW);
#pragma unroll
            for (int q = 0; q < 8; ++q) { const int pr = pc * 8 + q; const float inv = exp2f(-(float)(pr & 31) * (13.287712379549449f / 32.f));
                float sn, cs; sincosf(pos * inv, &sn, &cs); const float x1 = a[q] * sc, x2 = c[q] * sc; a[q] = x1 * cs - x2 * sn; c[q] = x1 * sn + x2 * cs; }
        } else {
#pragma unroll
            for (int q = 0; q < 8; ++q) { a[q] *= sc; c[q] *= sc; }
        }
        *(u4v*)base = pack8(a); *(u4v*)(base + 64) = pack8(c);
    }
}
__device__ __forceinline__ void ph_mod_fast(const P& p, int l, int which, const float* xl  , const float* xc  ) {
    const int lane = TIDX & 63, gw = blockIdx.x * (NT / 64) + (TIDX >> 6), ngw = gridDim.x * (NT / 64);
    for (int r = gw; r < R; r += ngw) {
        const float* x = r < RL ? xl + (size_t)r * D : xc + (size_t)(r - RL) * D; const float* sh = modv(p, l, r, which * 3 + 0); const float* sc = modv(p, l, r, which * 3 + 1);
#pragma unroll
        for (int i = 0; i < 4; ++i) { const int k = 4 * lane + 256 * i; const f32x4 xv = *(const f32x4*)(x + k), s = *(const f32x4*)(sc + k), hh = *(const f32x4*)(sh + k);
            u2v o; o.x = pk_bf16(xv[0] * (1.f + s[0]) + hh[0], xv[1] * (1.f + s[1]) + hh[1]); o.y = pk_bf16(xv[2] * (1.f + s[2]) + hh[2], xv[3] * (1.f + s[3]) + hh[3]);
            *(u2v*)(p.H + (size_t)r * D + k) = o; }
    }
}

__device__ __forceinline__ void ph_rope_table(const P& p) {
    GSTRIDE(idx, 128 * 32) { const int f = idx & 31, pos = idx >> 5; float sn, cs; sincosf((float)pos * exp2f(-(float)f * (13.287712379549449f / 32.f)), &sn, &cs); p.A2[2 * idx] = cs; p.A2[2 * idx + 1] = sn; }
}
__device__ __forceinline__ void ph_filters(const P& p, unsigned char* smem) {
    float* lds = (float*)smem;
    float* aA = lds;
    float* aB = lds + 64 * 65;
    LAS bf16_t* A3 = (LAS bf16_t*)(smem + 2 * 64 * 65 * 4);
    LAS bf16_t* Ws = A3 + 64 * 72;
    float* mw = (float*)(smem + 2 * 64 * 65 * 4 + 64 * 72 * 2 + 64 * 264 * 2);
    const float mind = logf(1e-2f) / 1.5f, maxd = logf(1e-2f) / 0.3f;
    __syncthreads();
    for (int e = TIDX; e < 33 * 64; e += NT) mw[e] = p.in[13][e];
    for (int e = TIDX; e < 64 * 64; e += NT) { mw[2112 + e] = p.in[15][e]; mw[2112 + 4096 + e] = p.in[17][e]; }
    if (TIDX < 64) { mw[10304 + TIDX] = p.in[14][TIDX]; mw[10368 + TIDX] = p.in[16][TIDX]; mw[10432 + TIDX] = p.in[18][TIDX]; }
    if (TIDX < 192) mw[10496 + TIDX] = p.in[20][TIDX];
    for (int u = blockIdx.x; u < RB / 33; u += gridDim.x) {
        const int tid = TIDX; const int p0 = u * 33; const int pos = tid & 63, jg = tid >> 6, lane = tid & 63, w = tid >> 6;
        f32x4 wv[8];
#pragma unroll
        for (int i = 0; i < 8; ++i) { const int e = tid + 512 * i; wv[i] = *(const f32x4*)(p.in[19] + (size_t)(e >> 6) * 2048 + 4 * (e & 63)); }
        __syncthreads();
        for (int e = tid; e < 64 * 33; e += NT) { const int ps = e & 63, m = e >> 6; int ln2, i2; hy_pos(p0 + ps, ln2, i2);
            const float w2 = 2.0f * 3.14159265358979323846f * (float)i2 / (float)ln2; float v;
            if (m == 0) v = (float)i2 / (float)(ln2 - 1); else { const int q = (m - 1) & 15; const float f = 1e-4f + (float)q * ((15.f - 1e-4f) / 15.f); v = m <= 16 ? cosf(f * w2) : -sinf(f * w2); }
            aB[ps * 65 + m] = v; }
        __syncthreads();
        {
            float acc[8];
#pragma unroll
            for (int q = 0; q < 8; ++q) acc[q] = mw[10304 + jg * 8 + q];
#pragma unroll 3
            for (int m = 0; m < 33; ++m) { const float a = aB[pos * 65 + m];
#pragma unroll
                for (int q = 0; q < 8; ++q) acc[q] += a * mw[m * 64 + jg * 8 + q]; }
#pragma unroll
            for (int q = 0; q < 8; ++q) aA[pos * 65 + jg * 8 + q] = sinf(mw[10496 + jg * 8 + q] * acc[q]);
        }
        __syncthreads();
#pragma unroll 1
        for (int layer = 0; layer < 2; ++layer) {
            const float* W = mw + 2112 + 4096 * layer; const float* Bv = mw + 10368 + 64 * layer; const float* Fq = mw + 10496 + 64 * (layer + 1);
            float* src = layer ? aB : aA; float* dst = layer ? aA : aB;
            float acc[8];
#pragma unroll
            for (int q = 0; q < 8; ++q) acc[q] = Bv[jg * 8 + q];
#pragma unroll 4
            for (int m = 0; m < 64; ++m) { const float a = src[pos * 65 + m];
#pragma unroll
                for (int q = 0; q < 8; ++q) acc[q] += a * W[m * 64 + jg * 8 + q]; }
#pragma unroll
            for (int q = 0; q < 8; ++q) { const float v = sinf(Fq[jg * 8 + q] * acc[q]); dst[pos * 65 + jg * 8 + q] = v; if (layer == 1 && pos < 48) A3[pos * 72 + jg * 8 + q] = f2bf(v); }
            __syncthreads();
        }
        float tpos[3];
#pragma unroll
        for (int mt = 0; mt < 3; ++mt) { int len, i0; hy_pos(p0 + 16 * mt + (lane & 15), len, i0); tpos[mt] = (float)i0 / (float)(len - 1); }
#pragma unroll 1
        for (int cq = 0; cq < 8; ++cq) {
#pragma unroll
            for (int i = 0; i < 8; ++i) { const int e = tid + 512 * i; u2v o; o.x = pk_bf16(wv[i][0], wv[i][1]); o.y = pk_bf16(wv[i][2], wv[i][3]); *(LAS u2v*)(Ws + (e >> 6) * 264 + 4 * (e & 63)) = o; }
            __syncthreads();
            if (cq < 7) {
#pragma unroll
                for (int i = 0; i < 8; ++i) { const int e = tid + 512 * i; wv[i] = *(const f32x4*)(p.in[19] + (size_t)(e >> 6) * 2048 + (cq + 1) * 256 + 4 * (e & 63)); } }
            f32x4 acc[3][2];
#pragma unroll
            for (int mt = 0; mt < 3; ++mt)
#pragma unroll
                for (int nt = 0; nt < 2; ++nt) acc[mt][nt] = (f32x4){0.f, 0.f, 0.f, 0.f};
#pragma unroll
            for (int ks = 0; ks < 2; ++ks) { bf16x8 xm[3];
#pragma unroll
                for (int mt = 0; mt < 3; ++mt) xm[mt] = frag_row(A3, 72, 16 * mt, 32 * ks, lane);
#pragma unroll
                for (int nt = 0; nt < 2; ++nt) { const bf16x8 xn = frag_tr(Ws, 264, 32 * ks, 32 * w + 16 * nt, lane);
#pragma unroll
                    for (int mt = 0; mt < 3; ++mt) acc[mt][nt] = MFMA16(xn, xm[mt], acc[mt][nt]); } }
#pragma unroll
            for (int nt = 0; nt < 2; ++nt)
#pragma unroll
                for (int q = 0; q < 4; ++q) { const int col = cq * 256 + 32 * w + 16 * nt + 4 * (lane >> 4) + q; const float delta = fabsf(mind + (float)(col % 512) * ((maxd - mind) / 511.f));
#pragma unroll
                    for (int mt = 0; mt < 3; ++mt) { const int pl = 16 * mt + (lane & 15); if (pl < 33) p.FILT[(size_t)col * RB + p0 + pl] = acc[mt][nt][q] * __expf(-tpos[mt] * delta); } }
            __syncthreads();
        }
    }
}

__device__ __forceinline__ float wave_sum(float v) {
#pragma unroll
    for (int o = 1; o < 64; o <<= 1) v += __shfl_xor(v, o);
    return v;
}
__device__ __forceinline__ void ph_ada_fast(const P& p, float* lds) {
    float* sv = lds;
    float* red = lds + 3072;
    const int tid = TIDX;
    __syncthreads();
    for (int i = tid; i < 3 * D; i += NT) { const int j = i / D, k = i % D; sv[i] = siluf(j < 2 ? p.in[1][j * D + k] : p.in[3][k]); }
    __syncthreads();
    for (int u = blockIdx.x; u < 2 * 96; u += gridDim.x) {
        const int l = u / 96, n = (u % 96) * 64 + (tid & 63), ks = tid >> 6;
        const float* w = p.in[4] + (size_t)l * D * 6144 + n;
        float a0 = 0.f, a1 = 0.f, a2 = 0.f;
#pragma unroll 8
        for (int k = ks * 128; k < ks * 128 + 128; ++k) { const float wv = w[(size_t)k * 6144]; a0 += sv[k] * wv; a1 += sv[D + k] * wv; a2 += sv[2 * D + k] * wv; }
        red[(ks * 3 + 0) * 64 + (tid & 63)] = a0; red[(ks * 3 + 1) * 64 + (tid & 63)] = a1; red[(ks * 3 + 2) * 64 + (tid & 63)] = a2;
        __syncthreads();
        if (tid < 192) { const int j = tid >> 6, nl = tid & 63; float s = p.in[5][l * 6144 + (u % 96) * 64 + nl];
#pragma unroll
            for (int q = 0; q < 8; ++q) s += red[(q * 3 + j) * 64 + nl];
            p.MOD[(size_t)(l * 3 + j) * 6144 + (u % 96) * 64 + nl] = s; }
        __syncthreads();
    }
}
__device__ __forceinline__ void ph_hyF_fast(const P& p, const float* a3, float* lds) {
    float* at = lds;
    float* wt = lds + 64 * 65;
    const float mind = logf(1e-2f) / 1.5f, maxd = logf(1e-2f) / 0.3f;
    for (int u = blockIdx.x; u < (RB / 64) * 16; u += gridDim.x) {
        const int tid = TIDX; const int ct = u % 16, pt = u / 16, p0 = pt * 64, c0 = ct * 128;
        __syncthreads();
#pragma unroll
        for (int i = 0; i < 8; ++i) { const int e = tid + 512 * i; at[(e >> 6) * 65 + (e & 63)] = a3[(size_t)(p0 + (e >> 6)) * 64 + (e & 63)]; }
#pragma unroll
        for (int i = 0; i < 16; ++i) { const int e = tid + 512 * i; wt[e] = p.in[19][(size_t)(e >> 7) * 2048 + c0 + (e & 127)]; }
        __syncthreads();
        const int pos = tid & 63, cg = tid >> 6;
        float acc[16];
#pragma unroll
        for (int q = 0; q < 16; ++q) acc[q] = 0.f;
#pragma unroll 4
        for (int m = 0; m < 64; ++m) { const float a = at[pos * 65 + m];
#pragma unroll
            for (int q = 0; q < 16; ++q) acc[q] += a * wt[m * 128 + cg * 16 + q]; }
        int len, i0; hy_pos(p0 + pos, len, i0); const float tt = (float)i0 / (float)(len - 1);
#pragma unroll
        for (int q = 0; q < 16; ++q) { const int col = c0 + cg * 16 + q; const float delta = fabsf(mind + (float)(col % 512) * ((maxd - mind) / 511.f));
            p.FILT[(size_t)col * RB + p0 + pos] = acc[q] * expf(-tt * delta); }
    }
}
__device__ __forceinline__ void ph_retScan_fast(const P& p) {
    bf16_t* ST = p.Zh;
    GSTRIDE(idx, (long)2 * NB * 4 * 16384) {
        const int ed = idx % 16384, h = (idx / 16384) % 4, b = (idx / 65536) % NB, dir = idx / (65536 * NB);
        const float dc = expf((dir ? p.in[10] : p.in[9])[h] * 128.f);
        bf16_t* base = ST + st_idx(dir, b, h, 0) + ed;
        float s = 0.f;
#pragma unroll 1
        for (int c0 = 0; c0 < NCH; c0 += 11) {
            float u[11]; int cc[11];
#pragma unroll
            for (int j = 0; j < 11; ++j) { const int q = c0 + j; cc[j] = dir == 0 ? q : (q < 2 ? 1 - q : NCH + 1 - q); u[j] = bf2f(base[(size_t)cc[j] * 16384]); }
#pragma unroll
            for (int j = 0; j < 11; ++j) { base[(size_t)cc[j] * 16384] = f2bf(s); s = dc * s + u[j]; }
        }
    }
}
__device__ __forceinline__ void ph_glaScan_fast(const P& p) {
    const float* BF = p.BG; const float* BB = p.BG + (size_t)R * 512;
    GSTRIDE(idx, (long)2 * NB * 4 * 32768) {
        const int d = idx % 128, ed = idx % 32768, h = (idx / 32768) % 4, b = (idx / 131072) % NB, dir = idx / (131072 * NB);
        bf16_t* base = p.GST + gst_idx(dir, b, h, 0) + ed;
        float s = 0.f;
#pragma unroll 1
        for (int c0 = 0; c0 < NCH; c0 += 11) {
            float u[11], dcv[11]; int cc[11];
#pragma unroll
            for (int j = 0; j < 11; ++j) { const int q = c0 + j; cc[j] = dir == 0 ? q : (q < 2 ? 1 - q : NCH + 1 - q); const int r0 = chunk_row0(b, cc[j]);
                u[j] = bf2f(base[(size_t)cc[j] * 32768]); dcv[j] = dir == 0 ? BF[(size_t)(r0 + 127) * 512 + h * 128 + d] : BB[(size_t)r0 * 512 + h * 128 + d]; }
#pragma unroll
            for (int j = 0; j < 11; ++j) { base[(size_t)cc[j] * 32768] = f2bf(s); s = __expf(dcv[j]) * s + u[j]; }
        }
    }
}
__device__ __forceinline__ void ph_glagates_fast(const P& p, float* lds) {
    float* lr = lds;
    for (int u = blockIdx.x; u < NB * NCH * 2; u += gridDim.x) {
        const int tid = TIDX; const int dir = u % 2, c = (u / 2) % NCH, b = u / (2 * NCH); const int r0 = chunk_row0(b, c);
        __syncthreads();
        for (int e = tid; e < 128 * 16; e += NT) lr[e] = bf2f(p.Z1[(size_t)(r0 + (e >> 4)) * GINP + 3072 + dir * 16 + (e & 15)]);
        __syncthreads();
        const float* gw = (dir ? p.in[26] : p.in[24]); float g[16];
#pragma unroll
        for (int q = 0; q < 16; ++q) g[q] = gw[q * 512 + tid];
        const float gb = (dir ? p.in[27] : p.in[25])[tid];
        float* out = p.BG + ((size_t)dir * R + r0) * 512 + tid;
        float s = 0.f;
#pragma unroll 4
        for (int ii = 0; ii < 128; ++ii) { const int i = dir ? 127 - ii : ii; float acc = gb;
#pragma unroll
            for (int q = 0; q < 16; ++q) acc += lr[i * 16 + q] * g[q];
            s += logsigf(acc) * (1.f / 16.f); out[(size_t)i * 512] = s; }
    }
}
template <int MODE, bool ROUTE> __device__ __forceinline__ void ph_post_fast(const P& p, int l, int which, const bf16_t* Y, int ln, int wn, int nrows, const float* xl, const float* xc, float* lds) {
    const float* lg = p.in[6] + (size_t)(l * 2 + which) * D; const float* lb = p.in[7] + (size_t)(l * 2 + which) * D;
    const int tid = TIDX, lane = tid & 63, gw = blockIdx.x * (NT / 64) + (tid >> 6), ngw = gridDim.x * (NT / 64);
    int* lcnt = (int*)(lds + D * NE);
    if (ROUTE) { __syncthreads(); for (int e = tid; e < D * NE; e += NT) lds[(e & 15) * D + (e >> 4)] = p.in[29][e]; if (tid < 32) lcnt[tid] = 0; __syncthreads(); }
    int toff[16];
    if (MODE == 1) { int s = 0;
#pragma unroll
        for (int e = 0; e < 16; ++e) { toff[e] = s; s += (p.CNT[l * 16 + e] + 255) >> 8; } }
    f32x4 cg_[4], clg[4], clb[4], csc[4], csh[4]; int cseg = -1;
#pragma unroll
    for (int i = 0; i < 4; ++i) { clg[i] = *(const f32x4*)(lg + 4 * lane + 256 * i); clb[i] = *(const f32x4*)(lb + 4 * lane + 256 * i); }
    f32x4 xr[4]; u2v ya[4], yb[4];
#define POST_LOAD(rr) do { const int r_ = (rr); const float* x_ = r_ < RL ? xl + (size_t)r_ * D : xc + (size_t)(r_ - RL) * D; const bf16_t *y0_, *y1_ = nullptr; \
        if (MODE == 0) y0_ = Y + (size_t)r_ * D; \
        else { int sr_[2]; _Pragma("unroll") for (int k_ = 0; k_ < 2; ++k_) { const int e_ = p.RE[r_ * 2 + k_]; int to_ = 0; _Pragma("unroll") for (int q_ = 0; q_ < 16; ++q_) to_ = (q_ == e_) ? toff[q_] : to_; sr_[k_] = to_ * 256 + p.RPOS[r_ * 2 + k_]; } \
               y0_ = p.slots + (size_t)sr_[0] * D; y1_ = p.slots + (size_t)sr_[1] * D; } \
        _Pragma("unroll") for (int i_ = 0; i_ < 4; ++i_) { const int k_ = 4 * lane + 256 * i_; xr[i_] = *(const f32x4*)(x_ + k_); ya[i_] = *(const u2v*)(y0_ + k_); if (MODE == 1) yb[i_] = *(const u2v*)(y1_ + k_); } } while (0)
    if (gw < nrows) POST_LOAD(gw);
    for (int r = gw; r < nrows; r += ngw) {
        float* xo = xrow(p, r);
        if (seg_of(r) != cseg) { cseg = seg_of(r);
#pragma unroll
            for (int i = 0; i < 4; ++i) { const int k = 4 * lane + 256 * i; cg_[i] = *(const f32x4*)(modv(p, l, r, which * 3 + 2) + k);
                if (ln >= 0) { csc[i] = *(const f32x4*)(modv(p, ln, r, wn * 3 + 1) + k); csh[i] = *(const f32x4*)(modv(p, ln, r, wn * 3 + 0) + k); } } }
        f32x4 v[4]; float s = 0.f;
#pragma unroll
        for (int i = 0; i < 4; ++i) { const u2v yu = ya[i]; f32x4 yy = {__uint_as_float(yu.x << 16), __uint_as_float(yu.x & 0xffff0000u), __uint_as_float(yu.y << 16), __uint_as_float(yu.y & 0xffff0000u)};
            if (MODE == 1) { const u2v y2 = yb[i]; yy += (f32x4){__uint_as_float(y2.x << 16), __uint_as_float(y2.x & 0xffff0000u), __uint_as_float(y2.y << 16), __uint_as_float(y2.y & 0xffff0000u)}; }
            v[i] = xr[i] * ALPHA + cg_[i] * yy; s += (v[i][0] + v[i][1]) + (v[i][2] + v[i][3]); }
        if (r + ngw < nrows) POST_LOAD(r + ngw);
        const float mu = wave_sum(s) * (1.f / D); float q2 = 0.f;
#pragma unroll
        for (int i = 0; i < 4; ++i) { v[i] = v[i] - mu; q2 += (v[i][0] * v[i][0] + v[i][1] * v[i][1]) + (v[i][2] * v[i][2] + v[i][3] * v[i][3]); }
        const float rs = 1.f / sqrtf(wave_sum(q2) * (1.f / D) + LN_EPS);
        f32x4 hk[4];
#pragma unroll
        for (int i = 0; i < 4; ++i) { const int k = 4 * lane + 256 * i; const f32x4 xn = v[i] * rs * clg[i] + clb[i];
            *(f32x4*)(xo + k) = xn;
            if (ln >= 0) { const f32x4 h2 = xn * (csc[i] + 1.f) + csh[i];
                u2v o; o.x = pk_bf16(h2[0], h2[1]); o.y = pk_bf16(h2[2], h2[3]); *(u2v*)(p.H + (size_t)r * D + k) = o;
                if (ROUTE) hk[i] = h2; } }
        if (ROUTE) {
            float pl[16];
#pragma unroll
            for (int e = 0; e < 16; ++e) { const float* wr = lds + e * D + 4 * lane; float a = 0.f;
#pragma unroll
                for (int i = 0; i < 4; ++i) { const f32x4 wv = *(const f32x4*)(wr + 256 * i); a += (hk[i][0] * wv[0] + hk[i][1] * wv[1]) + (hk[i][2] * wv[2] + hk[i][3] * wv[3]); }
                pl[e] = a; }
            float r8[8], r4[4], r2[2];
            { const bool up = (lane & 32) != 0;
#pragma unroll
              for (int q = 0; q < 8; ++q) { const float keep = up ? pl[8 + q] : pl[q], send = up ? pl[q] : pl[8 + q]; r8[q] = keep + __shfl_xor(send, 32); } }
            { const bool up = (lane & 16) != 0;
#pragma unroll
              for (int q = 0; q < 4; ++q) { const float keep = up ? r8[4 + q] : r8[q], send = up ? r8[q] : r8[4 + q]; r4[q] = keep + __shfl_xor(send, 16); } }
            { const bool up = (lane & 8) != 0;
#pragma unroll
              for (int q = 0; q < 2; ++q) { const float keep = up ? r4[2 + q] : r4[q], send = up ? r4[q] : r4[2 + q]; r2[q] = keep + __shfl_xor(send, 8); } }
            float r1;
            { const bool up = (lane & 4) != 0; const float keep = up ? r2[1] : r2[0], send = up ? r2[0] : r2[1]; r1 = keep + __shfl_xor(send, 4); }
            r1 += __shfl_xor(r1, 2); r1 += __shfl_xor(r1, 1);
            const float sgm = sigmf(r1);
            int best = 0, i1 = 0, i2 = 0; float bs = -1e30f, a1 = 0.f, a2 = 0.f;
#pragma unroll
            for (int g = 0; g < NG; ++g) {
                float sg[4], sel[4];
#pragma unroll
                for (int q = 0; q < 4; ++q) { const int e = g * EPG + q; const int src = ((e >> 3) & 1) * 32 + ((e >> 2) & 1) * 16 + ((e >> 1) & 1) * 8 + (e & 1) * 4;
                    sg[q] = __int_as_float(__builtin_amdgcn_readlane(__float_as_int(sgm), src)); sel[q] = sg[q] + p.in[30][e]; }
                int j1 = 0; float v1 = sel[0];
#pragma unroll
                for (int q = 1; q < 4; ++q) if (sel[q] > v1) { v1 = sel[q]; j1 = q; }
                int j2 = -1; float v2 = -1e30f;
#pragma unroll
                for (int q = 0; q < 4; ++q) if (q != j1 && sel[q] > v2) { v2 = sel[q]; j2 = q; }
                if (v1 + v2 > bs) { bs = v1 + v2; best = g; i1 = j1; i2 = j2; a1 = 0.f; a2 = 0.f;
#pragma unroll
                    for (int q = 0; q < 4; ++q) { a1 = (q == j1) ? sg[q] : a1; a2 = (q == j2) ? sg[q] : a2; } }
            }
            if (lane == 0) { const int e1 = best * EPG + i1, e2 = best * EPG + i2;
                p.RE[r * 2] = e1; p.RE[r * 2 + 1] = e2; p.RWt[r * 2] = a1 / (a1 + a2); p.RWt[r * 2 + 1] = a2 / (a1 + a2);
                p.RPOS[r * 2] = atomicAdd(&lcnt[e1], 1); p.RPOS[r * 2 + 1] = atomicAdd(&lcnt[e2], 1); }
        }
    }
    if (ROUTE) {
        __syncthreads();
        if (tid < 16) lcnt[16 + tid] = atomicAdd(&p.CNT[l * 16 + tid], lcnt[tid]);
        __syncthreads();
        for (int r = gw + lane * ngw; r < nrows; r += 64 * ngw) {
#pragma unroll
            for (int k = 0; k < 2; ++k) p.RPOS[r * 2 + k] += lcnt[16 + p.RE[r * 2 + k]];
        }
    }
}
#undef POST_LOAD

constexpr int N_STEPS = 34;
#define PG8_ALIGN true
#define PG8_SP2 true
template <class Epi> __device__ __forceinline__ void dense_gemm(LAS unsigned char* lds, const bf16_t* A, const bf16_t* Bt, int M, int N, int K, const Epi& E) {
    pg8::Gemm g{A, Bt, M, N, K}; pg8::StaticOrder S; S.init(M, N, (int)gridDim.x, (int)blockIdx.x);
    pg8::gemm_phase<Epi, pg8::StaticOrder, PG8_ALIGN, PG8_SP2>(lds, g, S, E);
}
__device__ __forceinline__ void moe_gemms(const P& p, LAS unsigned char* lds, int l, int which) {
    pg8::MoeOrder S; S.init(p.CNT + l * 16, (int)gridDim.x, (int)blockIdx.x);
    if (which == 0) { pg8::Gemm g{p.Hs, p.Wgu, 0, 0, 1024}; pg8::EpiSwiGLU E{p.he}; pg8::gemm_phase<pg8::EpiSwiGLU, pg8::MoeOrder, PG8_ALIGN, PG8_SP2>(lds, g, S, E); }
    else { pg8::Gemm g{p.he, p.Wd, 0, 0, 512}; pg8::EpiRowScale E{p.slots, p.WS}; pg8::gemm_phase<pg8::EpiRowScale, pg8::MoeOrder, PG8_ALIGN, PG8_SP2>(lds, g, S, E); }
}
__device__ __forceinline__ void run_step(const P& p, int step, unsigned char* smem) {
    LAS unsigned char* lds = (LAS unsigned char*)smem; float* fl = (float*)smem;
    float* conv = (float*)p.H;
    switch (step) {
        case 0: ph_ada_fast(p, fl); ph_rope_table(p); ph_wconv_fast(p, fl); ph_wconv_moe_fast(p, 0, fl); break;
        case 1: ph_mod_fast(p, 0, 0, p.in[0], p.in[2]); ph_filters(p, smem); break;
        case 2: { pg8::EpiInL0 E{p.Zr, p.hyT, p.A2, RL, L, CTX, RB}; dense_gemm(lds, p.H, p.Win0, R, ABIN, D, E); }
                 break;
        case 3: break;
        case 4: ph_retU_mfma(p, smem); ph_hyena_fft(p, smem); break;
        case 5: ph_retScan_fast(p); break;
        case 6: break;
        case 7: break;
        case 8: break;
        case 9: ph_retO_mfma(p, smem); ph_hy_untranspose_fast(p, fl); break;
        case 10: ph_hy_untranspose_fast(p, fl); break;
        case 11: { pg8::EpiSplit E{p.Zr, 1024, p.Zr, 1024, 1 << 30}; dense_gemm(lds, p.H, p.Wout0, R, D, D, E); } break;
        case 12: ph_post_fast<0, true>(p, 0, 0, p.Zr, 0, 1, R, p.in[0], p.in[2], fl); break;
        case 13: break;
        case 14: break;
        case 15: ph_permute(p, 0, R); break;
        case 16: moe_gemms(p, lds, 0, 0); break;
        case 17: moe_gemms(p, lds, 0, 1); break;
        case 18: ph_post_fast<1, false>(p, 0, 1, nullptr, 1, 0, R, p.out, p.Xc, fl); break;
        case 19: { pg8::EpiSplit E{p.Z1, GINP, p.Z1, GINP, 1 << 30}; dense_gemm(lds, p.H, p.Win1, R, GINP, D, E); } ph_wconv_moe_fast(p, 1, fl); break;
        case 20: break;
        case 21: break;
        case 22: ph_glaU_mfma(p, smem); break;
        case 23: ph_glaScan_fast(p); break;
        case 24: ph_glaO_mfma(p, smem); break;
        case 25: break;
        case 26: { pg8::EpiSplit E{p.Zr, 1024, p.Zr, 1024, 1 << 30}; dense_gemm(lds, p.H, p.Wout1, RL, D, D, E); } break;
        case 27: ph_post_fast<0, true>(p, 1, 0, p.Zr, 1, 1, RL, p.out, p.Xc, fl); break;
        case 28: break;
        case 29: break;
        case 30: ph_permute(p, 1, RL); break;
        case 31: moe_gemms(p, lds, 1, 0); break;
        case 32: moe_gemms(p, lds, 1, 1); break;
        case 33: ph_post_fast<1, false>(p, 1, 1, nullptr, -1, 0, RL, p.out, p.Xc, fl); break;
    }
}
__global__ void __launch_bounds__(NT, 2) k_all(P p) {
    extern __shared__ __attribute__((aligned(16))) unsigned char smem[];
    cg::grid_group grid = cg::this_grid();
    volatile LAS unsigned* bst = (volatile LAS unsigned*)((LAS unsigned char*)smem + LDS_BYTES - 64);
    if (threadIdx.x < 2) bst[threadIdx.x] = 0u;
    __syncthreads();
    const XcdBarrier bar = xcd_barrier_post(p.BAR, bst);
#define STEP(n) run_step(p, n, smem); xcd_barrier(bar);
#define STEP_CG(n) run_step(p, n, smem); asm volatile("s_waitcnt vmcnt(0)" ::: "memory"); grid.sync();
    STEP_CG(0) STEP(1) STEP(2) STEP(4) STEP(5) STEP(9) STEP(11) STEP(12) STEP(15) STEP(16)
    STEP(17) STEP(18) STEP(19) STEP(22) STEP(23) STEP(24) STEP(26) STEP(27) STEP(30) STEP(31) STEP(32) run_step(p, 33, smem);
#undef STEP
#undef STEP_CG
}

extern "C" void kernel_launch(void* const* d_in, const int* in_sizes, int n_in, void* d_out, int out_size, void* d_ws, size_t ws_size, hipStream_t stream) {
    P p{};
    for (int i = 0; i < 34; ++i) p.in[i] = (const float*)d_in[i];
    p.out = (float*)d_out;
    unsigned char* w = (unsigned char*)d_ws; size_t off = 0;
    auto take = [&](size_t bytes) { unsigned char* r = w + off; off += (bytes + 255) & ~(size_t)255; return r; };
    p.NORM = (float*)take(2 * 2048 * 4); p.CNT = (int*)take(2 * 16 * 4); p.BAR = (unsigned*)take(XCD_BAR_WORDS * 4);
    const size_t ctl_bytes = off;
    p.Win1 = (bf16_t*)take((size_t)GINP * D * 2); p.Wout1 = (bf16_t*)take((size_t)D * D * 2);
    p.Wgu = (bf16_t*)take((size_t)NE * 1024 * 1024 * 2); p.Wd = (bf16_t*)take((size_t)NE * 1024 * 512 * 2);
    p.Xc = (float*)take((size_t)RCX * D * 4); p.MOD = (float*)take(2 * 3 * 6144 * 4);
    p.RS = (float*)take((size_t)R * NE * 4); p.RE = (int*)take((size_t)R * 2 * 4); p.RPOS = (int*)take((size_t)R * 2 * 4); p.RWt = (float*)take((size_t)R * 2 * 4);
    p.WS = (float*)take((size_t)MOE_ROWS * 4);
    const size_t big = off;
    p.H = (bf16_t*)take((size_t)R * D * 2);
    p.Zr = (bf16_t*)take((size_t)R * 2048 * 2);
    p.Zh = (bf16_t*)take((size_t)R * 1536 * 2);
    p.hyT = (bf16_t*)take((size_t)NB * 3 * 512 * RB * 2);
    p.FILT = (float*)take((size_t)2048 * RB * 4);
    p.Win0 = (bf16_t*)take((size_t)ABIN * D * 2); p.Wout0 = (bf16_t*)take((size_t)D * D * 2);
    p.A1 = (float*)take((size_t)RB * 64 * 4); p.A2 = (float*)take((size_t)RB * 64 * 4);
    const size_t total = off;
    off = big + (((size_t)R * D * 2 + 255) & ~(size_t)255);
    p.Hs = (bf16_t*)take((size_t)MOE_ROWS * D * 2); p.he = (bf16_t*)take((size_t)MOE_ROWS * EH * 2); p.slots = (bf16_t*)take((size_t)MOE_ROWS * D * 2);
    const size_t moe_end = off;
    off = big + (((size_t)R * D * 2 + 255) & ~(size_t)255);
    p.Z1 = (bf16_t*)take((size_t)R * GINP * 2); p.BG = (float*)take((size_t)2 * R * 512 * 4); p.GST = (bf16_t*)take((size_t)2 * NB * 4 * NCH * 32768 * 2);
    const size_t l1_end = off;
    if (total > ws_size || moe_end > total || l1_end > total || n_in != 34 || out_size != RL * D) {
        fprintf(stderr, "kernel_launch: bad sizes (need %zu ws bytes, have %zu; moe_end %zu l1_end %zu)\n", total, ws_size, moe_end, l1_end); return; }
    static int grid = 0;
    if (!grid) {
        int dev = 0, cus = 0, per = 0; hipGetDevice(&dev); hipDeviceGetAttribute(&cus, hipDeviceAttributeMultiprocessorCount, dev);
        hipFuncSetAttribute((const void*)k_all, hipFuncAttributeMaxDynamicSharedMemorySize, LDS_BYTES);
        hipOccupancyMaxActiveBlocksPerMultiprocessor(&per, k_all, NT, LDS_BYTES);
        if (per < 1) { fprintf(stderr, "kernel_launch: occupancy query says %d blocks per CU\n", per); per = 1; }
        grid = cus < 256 ? cus : 256;
    }
    hipMemsetAsync(d_ws, 0, ctl_bytes, stream);
    void* args[] = {&p};
    hipError_t e = hipLaunchCooperativeKernel((void*)k_all, dim3(grid), dim3(NT), args, LDS_BYTES, stream);
    if (e != hipSuccess) fprintf(stderr, "coop launch failed: %s (grid %d)\n", hipGetErrorString(e), grid);
}
```

```cpp
#include <hip/hip_runtime.h>
#include <hip/hip_cooperative_groups.h>
#include <cstdio>
#include <cstdint>
namespace cg = cooperative_groups;


namespace pg8 {
#define PG8_LAS __attribute__((address_space(3)))
typedef unsigned short bf16_t;
typedef short bf16x8 __attribute__((ext_vector_type(8)));
typedef float f32x4 __attribute__((ext_vector_type(4)));
typedef unsigned u32x4 __attribute__((ext_vector_type(4)));
constexpr int BM = 256, BK = 64, HALF = 128, HTB = HALF * BK * 2  , STAGE_BYTES = 8 * HTB, NXCD = 8, WGM = 8;

__host__ __device__ __forceinline__ int lds_byte(int r, int c) { const int st = (r >> 4) * 2 + (c >> 5), rr = r & 15, cc = c & 31, ob = rr * 64 + cc * 2; return st * 1024 + (ob ^ (((ob >> 9) & 1) << 5)); }
__host__ __device__ __forceinline__ void stage_rc(int b, int& R, int& C) { const int st = b / 1024, sb = b % 1024, swz = sb ^ (((sb >> 9) & 1) << 5); R = (st >> 1) * 16 + swz / 64; C = (st & 1) * 32 + (swz % 64) / 2; }
__host__ __device__ __forceinline__ int perm32(int rho) { const int n = rho >> 4, i = rho & 15; return 8 * (i >> 2) + 4 * n + (i & 3); }

struct Unit { int pm, pn; };
struct Gemm { const bf16_t* A; const bf16_t* Bt; int M, N, K; };

struct StaticOrder {
    int nM, nN, nwg, G, c;
    __host__ __device__ void init(int M, int N, int G_, int c_) { nM = M / BM; nN = N / BM; nwg = nM * nN; G = G_; c = c_; }
    __host__ __device__ bool next(int i, Unit& u) const {
        const long L = (long)i * G + c; if (L >= nwg) return false;
        int wgid = (int)L; { const int q = nwg / NXCD, r = nwg % NXCD, xcd = wgid % NXCD, off = wgid / NXCD; wgid = (xcd < r ? xcd * (q + 1) : r * (q + 1) + (xcd - r) * q) + off; }
        const int nig = WGM * nN, gid = wgid / nig, fm = gid * WGM, gsz = (nM - fm) < WGM ? (nM - fm) : WGM;
        u.pm = fm + ((wgid % nig) % gsz); u.pn = (wgid % nig) / gsz; return true;
    }
    __device__ __forceinline__ void a_ready(const Unit&) const {}
    __device__ __forceinline__ void done(const Unit&) const {}
};


__device__ __forceinline__ unsigned cvt_pk_bf16(float lo, float hi) { unsigned r; asm volatile("v_cvt_pk_bf16_f32 %0, %1, %2" : "=v"(r) : "v"(lo), "v"(hi)); return r; }

template <class Epi, class Sched, bool ALIGN_EPI = false, bool SP2 = false>
__device__ __forceinline__ void gemm_phase(PG8_LAS unsigned char* lds, const Gemm g, const Sched& S, const Epi& E) {
    int tid_l = threadIdx.x; asm volatile("" : "+v"(tid_l)); const int tid = tid_l, wid = __builtin_amdgcn_readfirstlane(tid >> 6), lane = tid & 63, wr = wid >> 2, wc = wid & 3, fr = lane & 15, fq = lane >> 4;
    const int K = g.K, nt = K / BK;
    unsigned voffA[2], voffB[2];
#pragma unroll
    for (int i = 0; i < 2; ++i) { int R, C; stage_rc(tid * 16 + i * 8192, R, C); const int Rb = Epi::PERM ? ((R & ~31) + perm32(R & 31)) : R;
        voffA[i] = (unsigned)(R * K + C) * 2u; voffB[i] = (unsigned)(Rb * K + C) * 2u; }
    const size_t kstep = (size_t)(BK * 2);
    const size_t hstep = (size_t)HALF * K * 2;
    const size_t tstep = 2 * hstep;
    const unsigned ldsw = (unsigned)wid * 1024u;
    const int aoff = lds_byte(wr * 64 + fr, fq * 8), boff = lds_byte(wc * 32 + fr, fq * 8);
#define PG8_SA(b, h) (((b) * 2 + (h)) * HTB)
#define PG8_SB(b, h) ((4 + (b) * 2 + (h)) * HTB)
#define PG8_STAGE(bufoff, gbase, voff) do { _Pragma("unroll") for (int _i = 0; _i < 2; ++_i) \
        __builtin_amdgcn_global_load_lds((const unsigned*)((const char*)(gbase) + (voff)[_i]), (PG8_LAS unsigned*)(lds + (bufoff) + ldsw + _i * 8192), 16, 0, 0); } while (0)
#define PG8_LDA(dst, b, h) do { _Pragma("unroll") for (int m = 0; m < 4; ++m) _Pragma("unroll") for (int k = 0; k < 2; ++k) dst[m][k] = *(const PG8_LAS bf16x8*)(lds + PG8_SA(b, h) + aoff + m * 2048 + k * 1024); } while (0)
#define PG8_LDB(dst, b, h) do { _Pragma("unroll") for (int n = 0; n < 2; ++n) _Pragma("unroll") for (int k = 0; k < 2; ++k) dst[n][k] = *(const PG8_LAS bf16x8*)(lds + PG8_SB(b, h) + boff + n * 2048 + k * 1024); } while (0)
#define PG8_MMA(ai, bj, At, Bt) do { __builtin_amdgcn_s_setprio(1); _Pragma("unroll") for (int m = 0; m < 4; ++m) _Pragma("unroll") for (int n = 0; n < 2; ++n) _Pragma("unroll") for (int k = 0; k < 2; ++k) \
        acc[ai][bj][m][n] = __builtin_amdgcn_mfma_f32_16x16x32_bf16(Bt[n][k], At[m][k], acc[ai][bj][m][n], 0, 0, 0); __builtin_amdgcn_s_setprio(0); } while (0)
#define PG8_WAIT_V(n) asm volatile("s_waitcnt vmcnt(" #n ")" ::: "memory")
#define PG8_WAIT_L(n) asm volatile("s_waitcnt lgkmcnt(" #n ")" ::: "memory")
#define PG8_BAR __builtin_amdgcn_s_barrier()
#define PG8_SCHED __builtin_amdgcn_sched_barrier(0)
    Unit cur, nxt; int ui = 0;
    if (!S.next(0, cur)) return;
    f32x4 acc[2][2][4][2];
#pragma unroll
    for (int a = 0; a < 2; ++a)
#pragma unroll
        for (int b = 0; b < 2; ++b)
#pragma unroll
            for (int m = 0; m < 4; ++m)
#pragma unroll
                for (int n = 0; n < 2; ++n) acc[a][b][m][n] = (f32x4){0.f, 0.f, 0.f, 0.f};
    bf16x8 At[4][2], B0[2][2], B1[2][2];
    const char* cA = (const char*)g.A + (size_t)cur.pm * tstep; const char* cB = (const char*)g.Bt + (size_t)cur.pn * tstep;
    S.a_ready(cur);
    if constexpr (SP2) {
        PG8_STAGE(PG8_SB(0, 0), cB, voffB); PG8_STAGE(PG8_SB(0, 1), cB + hstep, voffB); PG8_STAGE(PG8_SA(0, 0), cA, voffA); PG8_STAGE(PG8_SA(0, 1), cA + hstep, voffA);
        if (wr == 1) PG8_BAR;
        PG8_WAIT_V(2); PG8_BAR;
        PG8_STAGE(PG8_SB(1, 0), cB + kstep, voffB); PG8_STAGE(PG8_SA(1, 0), cA + kstep, voffA); PG8_STAGE(PG8_SB(1, 1), cB + hstep + kstep, voffB);
        PG8_WAIT_V(6); PG8_BAR;
    } else {
        PG8_STAGE(PG8_SB(0, 0), cB, voffB); PG8_STAGE(PG8_SA(0, 0), cA, voffA); PG8_STAGE(PG8_SB(0, 1), cB + hstep, voffB); PG8_STAGE(PG8_SA(0, 1), cA + hstep, voffA);
        if (wr == 1) PG8_BAR;
        PG8_WAIT_V(4); PG8_BAR;
        PG8_STAGE(PG8_SB(1, 0), cB + kstep, voffB); PG8_STAGE(PG8_SA(1, 0), cA + kstep, voffA); PG8_STAGE(PG8_SB(1, 1), cB + hstep + kstep, voffB);
        PG8_WAIT_V(6); PG8_BAR;
    }
    for (;;) {
        const bool has_next = S.next(ui + 1, nxt);
        const char* nA = has_next ? (const char*)g.A + (size_t)nxt.pm * tstep : cA; const char* nB = has_next ? (const char*)g.Bt + (size_t)nxt.pn * tstep : cB;
        for (int t = 0; t < nt; t += 2) {
            const bool last = (t == nt - 2);
            const char* a1 = cA + (size_t)(t + 1) * kstep;
            const char* a2 = last ? nA : cA + (size_t)(t + 2) * kstep; const char* b2 = last ? nB : cB + (size_t)(t + 2) * kstep;
            const char* a3 = a2 + kstep; const char* b3 = b2 + kstep;
            if (last && has_next) S.a_ready(nxt);
            if constexpr (SP2) {
            PG8_LDB(B0, 0, 0); PG8_LDB(B1, 0, 1); PG8_SCHED; PG8_LDA(At, 0, 0); PG8_STAGE(PG8_SA(1, 1), a1 + hstep, voffA);
            PG8_WAIT_V(8); PG8_WAIT_L(0); PG8_BAR; PG8_MMA(0, 0, At, B0); PG8_MMA(0, 1, At, B1); PG8_BAR; PG8_SCHED;
            PG8_LDA(At, 0, 1); PG8_STAGE(PG8_SB(0, 0), b2, voffB); PG8_STAGE(PG8_SB(0, 1), b2 + hstep, voffB); PG8_STAGE(PG8_SA(0, 0), a2, voffA);
            PG8_WAIT_V(8); PG8_WAIT_L(0); PG8_BAR; PG8_MMA(1, 0, At, B0); PG8_MMA(1, 1, At, B1); PG8_BAR; PG8_SCHED;
            PG8_LDB(B0, 1, 0); PG8_LDB(B1, 1, 1); PG8_SCHED; PG8_LDA(At, 1, 0); PG8_STAGE(PG8_SA(0, 1), a2 + hstep, voffA);
            PG8_WAIT_V(8); PG8_WAIT_L(0); PG8_BAR; PG8_MMA(0, 0, At, B0); PG8_MMA(0, 1, At, B1); PG8_BAR; PG8_SCHED;
            PG8_LDA(At, 1, 1); PG8_STAGE(PG8_SB(1, 0), b3, voffB); PG8_STAGE(PG8_SB(1, 1), b3 + hstep, voffB); PG8_STAGE(PG8_SA(1, 0), a3, voffA);
            PG8_WAIT_V(8); PG8_WAIT_L(0); PG8_BAR; PG8_MMA(1, 0, At, B0); PG8_MMA(1, 1, At, B1); PG8_BAR; PG8_SCHED;
            } else {
            PG8_LDB(B0, 0, 0); PG8_SCHED; PG8_LDA(At, 0, 0); PG8_STAGE(PG8_SA(1, 1), a1 + hstep, voffA);
            PG8_WAIT_L(8); PG8_BAR; PG8_WAIT_L(0); PG8_MMA(0, 0, At, B0); PG8_BAR; PG8_SCHED;
            PG8_LDB(B1, 0, 1); PG8_STAGE(PG8_SB(0, 0), b2, voffB);
            PG8_BAR; PG8_WAIT_L(0); PG8_MMA(0, 1, At, B1); PG8_BAR;
            PG8_LDA(At, 0, 1); PG8_STAGE(PG8_SA(0, 0), a2, voffA);
            PG8_BAR; PG8_WAIT_L(0); PG8_MMA(1, 0, At, B0); PG8_BAR; PG8_SCHED;
            PG8_STAGE(PG8_SB(0, 1), b2 + hstep, voffB);
            PG8_WAIT_V(6); PG8_BAR; PG8_MMA(1, 1, At, B1); PG8_BAR;
            PG8_LDB(B0, 1, 0); PG8_SCHED; PG8_LDA(At, 1, 0); PG8_STAGE(PG8_SA(0, 1), a2 + hstep, voffA);
            PG8_WAIT_L(8); PG8_BAR; PG8_WAIT_L(0); PG8_MMA(0, 0, At, B0); PG8_BAR; PG8_SCHED;
            PG8_LDB(B1, 1, 1); PG8_STAGE(PG8_SB(1, 0), b3, voffB);
            PG8_BAR; PG8_WAIT_L(0); PG8_MMA(0, 1, At, B1); PG8_BAR;
            PG8_LDA(At, 1, 1); PG8_STAGE(PG8_SA(1, 0), a3, voffA);
            PG8_BAR; PG8_WAIT_L(0); PG8_MMA(1, 0, At, B0); PG8_BAR; PG8_SCHED;
            PG8_STAGE(PG8_SB(1, 1), b3 + hstep, voffB);
            PG8_WAIT_V(6); PG8_BAR; PG8_MMA(1, 1, At, B1); PG8_BAR;
            }
        }
        if constexpr (ALIGN_EPI) { if (wr == 0) PG8_BAR; }
        if constexpr (!Epi::AFTER_DRAIN) { E(acc, cur, wr, wc, fr, fq); S.done(cur); }
        if (!has_next) break;
#pragma unroll
        for (int a = 0; a < 2; ++a)
#pragma unroll
            for (int b = 0; b < 2; ++b)
#pragma unroll
                for (int m = 0; m < 4; ++m)
#pragma unroll
                    for (int n = 0; n < 2; ++n) acc[a][b][m][n] = (f32x4){0.f, 0.f, 0.f, 0.f};
        cur = nxt; cA = nA; cB = nB; ++ui;
        if constexpr (ALIGN_EPI) { if (wr == 1) PG8_BAR; }
    }
    PG8_WAIT_V(0);
    if constexpr (!ALIGN_EPI) { if (wr == 0) PG8_BAR; }
    PG8_BAR;
    if constexpr (Epi::AFTER_DRAIN) { E.fused(acc, cur, wr, wc, fr, fq, lds, wid, lane); S.done(cur); }
#undef PG8_SA
#undef PG8_SB
#undef PG8_STAGE
#undef PG8_LDA
#undef PG8_LDB
#undef PG8_MMA
#undef PG8_WAIT_V
#undef PG8_WAIT_L
#undef PG8_BAR
#undef PG8_SCHED
}
}

typedef float f2v_t __attribute__((ext_vector_type(2)));
typedef __bf16 b2v_t __attribute__((ext_vector_type(2)));
__device__ __forceinline__ unsigned pk_bf16(float lo, float hi) { const f2v_t f = {lo, hi}; const b2v_t b = __builtin_convertvector(f, b2v_t); return __builtin_bit_cast(unsigned, b); }
namespace pg8 {
typedef unsigned u32x2 __attribute__((ext_vector_type(2)));
struct EpiSplit {
    static constexpr bool PERM = true, AFTER_DRAIN = false;
    bf16_t* O0; int ld0; bf16_t* O1; int ld1; int split_col;
    __device__ __forceinline__ void operator()(const f32x4 (&acc)[2][2][4][2], const Unit& u, int wr, int wc, int fr, int fq) const {
        const int row0 = u.pm * BM + wr * 64 + fr; int colt = u.pn * BM; bf16_t* base = O0; int ldc = ld0;
        if (colt >= split_col) { base = O1; ldc = ld1; colt -= split_col; }
        const int col0 = colt + wc * 32 + 8 * fq;
#pragma unroll
        for (int ai = 0; ai < 2; ++ai)
#pragma unroll
            for (int m = 0; m < 4; ++m) { bf16_t* rowp = base + (size_t)(row0 + ai * HALF + m * 16) * ldc + col0;
#pragma unroll
                for (int bj = 0; bj < 2; ++bj) { const f32x4 v0 = acc[ai][bj][m][0], v1 = acc[ai][bj][m][1];
                    u32x4 w; w.x = ::pk_bf16(v0[0], v0[1]); w.y = ::pk_bf16(v0[2], v0[3]); w.z = ::pk_bf16(v1[0], v1[1]); w.w = ::pk_bf16(v1[2], v1[3]);
                    *(u32x4*)(rowp + bj * HALF) = w; } }
    }
};
struct EpiInL0 {
    static constexpr bool PERM = true, AFTER_DRAIN = false;
    bf16_t* Zr; bf16_t* hyT; const float* tab; int RLv, Lv, CTXv, RBv;
    __device__ __forceinline__ void operator()(const f32x4 (&acc)[2][2][4][2], const Unit& u, int wr, int wc, int fr, int fq) const {
        const int rowbase = u.pm * BM, colt = u.pn * BM;
        if (colt < 2048) {
            const int col0 = colt + wc * 32 + 8 * fq; const bool rot = colt < 1024; const int pp0 = wc * 16 + 4 * fq;
#pragma unroll
            for (int ai = 0; ai < 2; ++ai)
#pragma unroll
                for (int m = 0; m < 4; ++m) { const int row = rowbase + wr * 64 + fr + ai * HALF + m * 16; bf16_t* rowp = Zr + (size_t)row * 2048 + col0;
                    const int t = row % Lv; const int prow = t >> 6, pcol = t & 63; const bool dorot = rot && row < RLv;
#pragma unroll
                    for (int bj = 0; bj < 2; ++bj) { f32x4 v0 = acc[ai][bj][m][0], v1 = acc[ai][bj][m][1];
                        if (dorot) {
#pragma unroll
                            for (int pr = 0; pr < 4; ++pr) { const int pp = pp0 + pr; const int pos = pp < 32 ? prow : pcol; const float cs = tab[(pos * 32 + (pp & 31)) * 2], sn = tab[(pos * 32 + (pp & 31)) * 2 + 1];
                                if (pr < 2) { const float x1 = v0[2 * pr], x2 = v0[2 * pr + 1]; v0[2 * pr] = x1 * cs - x2 * sn; v0[2 * pr + 1] = x1 * sn + x2 * cs; }
                                else { const float x1 = v1[2 * pr - 4], x2 = v1[2 * pr - 3]; v1[2 * pr - 4] = x1 * cs - x2 * sn; v1[2 * pr - 3] = x1 * sn + x2 * cs; } } }
                        u32x4 w; w.x = ::pk_bf16(v0[0], v0[1]); w.y = ::pk_bf16(v0[2], v0[3]); w.z = ::pk_bf16(v1[0], v1[1]); w.w = ::pk_bf16(v1[2], v1[3]);
                        *(u32x4*)(rowp + bj * HALF) = w; } }
        } else {
            const int hc0 = colt - 2048 + wc * 32 + 8 * fq;
            int b, tlb; if (rowbase < RLv) { b = rowbase / Lv; tlb = rowbase % Lv; } else { b = (rowbase - RLv) / CTXv; tlb = Lv + (rowbase - RLv) % CTXv; }
#pragma unroll
            for (int ai = 0; ai < 2; ++ai)
#pragma unroll
                for (int m = 0; m < 4; ++m) { const int tl = tlb + wr * 64 + fr + ai * HALF + m * 16;
#pragma unroll
                    for (int bj = 0; bj < 2; ++bj) { const f32x4 v0 = acc[ai][bj][m][0], v1 = acc[ai][bj][m][1];
                        bf16_t* o = hyT + ((size_t)b * 1536 + hc0 + bj * HALF) * RBv + tl;
#pragma unroll
                        for (int q = 0; q < 4; ++q) { o[(size_t)q * RBv] = (bf16_t)(::pk_bf16(v0[q], 0.f) & 0xffffu); o[(size_t)(q + 4) * RBv] = (bf16_t)(::pk_bf16(v1[q], 0.f) & 0xffffu); } } }
        }
    }
};
struct EpiSwiGLU {
    static constexpr bool PERM = true, AFTER_DRAIN = false;
    bf16_t* O;
    __device__ __forceinline__ void operator()(const f32x4 (&acc)[2][2][4][2], const Unit& u, int wr, int wc, int fr, int fq) const {
        const int row0 = u.pm * BM + wr * 64 + fr; const int j0 = (u.pn & 3) * 128 + wc * 16 + 4 * fq;
#pragma unroll
        for (int ai = 0; ai < 2; ++ai)
#pragma unroll
            for (int m = 0; m < 4; ++m) { bf16_t* rowp = O + (size_t)(row0 + ai * HALF + m * 16) * 512 + j0;
#pragma unroll
                for (int bj = 0; bj < 2; ++bj) { const f32x4 g = acc[ai][bj][m][0], up = acc[ai][bj][m][1]; float h[4];
#pragma unroll
                    for (int q = 0; q < 4; ++q) h[q] = g[q] / (1.f + __expf(-g[q])) * up[q];
                    u32x2 w; w.x = ::pk_bf16(h[0], h[1]); w.y = ::pk_bf16(h[2], h[3]);
                    *(u32x2*)(rowp + bj * 64) = w; } }
    }
};
struct EpiRowScale {
    static constexpr bool PERM = true, AFTER_DRAIN = false;
    bf16_t* O; const float* ws;
    __device__ __forceinline__ void operator()(const f32x4 (&acc)[2][2][4][2], const Unit& u, int wr, int wc, int fr, int fq) const {
        const int row0 = u.pm * BM + wr * 64 + fr; const int col0 = (u.pn & 3) * BM + wc * 32 + 8 * fq;
#pragma unroll
        for (int ai = 0; ai < 2; ++ai)
#pragma unroll
            for (int m = 0; m < 4; ++m) { const int row = row0 + ai * HALF + m * 16; const float s = ws[row]; bf16_t* rowp = O + (size_t)row * 1024 + col0;
#pragma unroll
                for (int bj = 0; bj < 2; ++bj) { const f32x4 v0 = acc[ai][bj][m][0] * s, v1 = acc[ai][bj][m][1] * s;
                    u32x4 w; w.x = ::pk_bf16(v0[0], v0[1]); w.y = ::pk_bf16(v0[2], v0[3]); w.z = ::pk_bf16(v1[0], v1[1]); w.w = ::pk_bf16(v1[2], v1[3]);
                    *(u32x4*)(rowp + bj * HALF) = w; } }
    }
};
struct MoeOrder {
    int G, c, nt; int toff[16];
    __device__ __forceinline__ void init(const int* cnt, int G_, int c_) { G = G_; c = c_; int s = 0;
#pragma unroll
        for (int e = 0; e < 16; ++e) { toff[e] = s; s += (cnt[e] + 255) >> 8; } nt = s; }
    __device__ __forceinline__ bool next(int i, Unit& u) const {
        const int Lq = i * G + c; if (Lq >= nt * 4) return false;
        const int pm = Lq % nt, pn4 = Lq / nt; int e = 0;
#pragma unroll
        for (int q = 1; q < 16; ++q) e += (pm >= toff[q]) ? 1 : 0;
        u.pm = pm; u.pn = e * 4 + pn4; return true; }
    __device__ __forceinline__ void a_ready(const Unit&) const {}
    __device__ __forceinline__ void done(const Unit&) const {}
};
}

constexpr int NB = 2, L = 8192, D = 1024, CTX = 256, RB = L + CTX;
constexpr int RL = NB * L, RCX = NB * CTX, R = RL + RCX;
constexpr int GW = 64;
constexpr int NCH = 66;
constexpr int ABIN = 3584, GIN = 3104, GINP = 3328;
constexpr int NE = 16, NG = 4, EPG = 4, EH = 512;
constexpr int MOE_ROWS = 37888;
constexpr float ALPHA = 1.4142135623730951f, LN_EPS = 1e-5f, KSCALE = 0.08838834764831845f;
constexpr int NT = 512;
constexpr int LDS_BYTES = 147456;

typedef unsigned short bf16_t;
#define LAS __attribute__((address_space(3)))
__device__ __forceinline__ float bf2f(bf16_t v) { return __uint_as_float((unsigned)v << 16); }
__device__ __forceinline__ bf16_t f2bf(float f) { unsigned u = __float_as_uint(f); return (bf16_t)((u + 0x7fffu + ((u >> 16) & 1u)) >> 16); }
__device__ __forceinline__ float siluf(float x) { return x / (1.f + expf(-x)); }
__device__ __forceinline__ float sigmf(float x) { return 1.f / (1.f + expf(-x)); }
__device__ __forceinline__ float logsigf(float x) { return fminf(x, 0.f) - log1pf(expf(-fabsf(x))); }

struct P {
    const float* in[34];
    float* out;
    float* Xc;
    float* MOD;
    float* NORM;
    int* CNT;
    unsigned* BAR;
    float* A1; float* A2;
    float* RS; int* RE; int* RPOS; float* RWt; float* WS;
    bf16_t *Win0, *Wout0, *Win1, *Wout1, *Wgu, *Wd;
    bf16_t* H;
    bf16_t* Zr;
    bf16_t* Zh;
    bf16_t* hyT;
    float* FILT;
    bf16_t *Hs, *he, *slots;
    bf16_t* Z1;
    float* BG;
    bf16_t* GST;
};

__device__ __forceinline__ int launder_i(int x) { asm volatile("" : "+v"(x)); return x; }
#define TIDX launder_i((int)threadIdx.x)
#define GSTRIDE(i, n) for (long i = (long)blockIdx.x * blockDim.x + TIDX; i < (long)(n); i += (long)gridDim.x * blockDim.x)

__device__ __forceinline__ float* xrow(const P& p, int r) { return r < RL ? p.out + (size_t)r * D : p.Xc + (size_t)(r - RL) * D; }
__device__ __forceinline__ int seg_of(int r) { return r < RL ? r / L : 2; }
__device__ __forceinline__ const float* modv(const P& p, int l, int r, int chunk) { return p.MOD + ((size_t)(l * 3 + seg_of(r)) * 6 + chunk) * D; }
__device__ __forceinline__ int chunk_row0(int b, int c) { return c < 2 ? RL + b * CTX + c * 128 : b * L + (c - 2) * 128; }
__device__ __forceinline__ void row_bt(int r, int& b, int& tl) { if (r < RL) { b = r / L; tl = r % L; } else { b = (r - RL) / CTX; tl = L + (r - RL) % CTX; } }
__device__ __forceinline__ int bt_row(int b, int tl) { return tl < L ? b * L + tl : RL + b * CTX + (tl - L); }

#define XB_TMO      128
#define XB_XCNT(j)  (256  + 64 * (j))
#define XB_XSUB(j)  (1280 + 64 * (j))
#define XB_XGEN(j)  (2304 + 64 * (j))
#define XB_TOP      3328
#define XB_TOPGEN   3392
#define XCD_BAR_WORDS 3456
#define XB_SPIN_CAP (1u << 18)

__device__ __forceinline__ unsigned xb_ld(unsigned* p)              { return __hip_atomic_load(p, __ATOMIC_RELAXED, __HIP_MEMORY_SCOPE_AGENT); }
__device__ __forceinline__ unsigned xb_add(unsigned* p, unsigned v) { return __hip_atomic_fetch_add(p, v, __ATOMIC_RELAXED, __HIP_MEMORY_SCOPE_AGENT); }
__device__ __forceinline__ unsigned xb_xcc_id() { return (unsigned)__builtin_amdgcn_s_getreg((3 << 11) | 20) & 0xFu; }
#define XB_SPIN(cond, bar) do { unsigned _sp = 0; while (cond) { __builtin_amdgcn_s_sleep(1); \
    if ((++_sp & 255u) == 0u) { if (xb_ld(&(bar)[XB_TMO])) break; if (_sp > XB_SPIN_CAP) { atomicAdd(&(bar)[XB_TMO], 1u); break; } } } } while (0)

struct XcdBarrier {
    unsigned* bar; unsigned x;
    volatile LAS unsigned* st;
};

__device__ __forceinline__ XcdBarrier xcd_barrier_post(unsigned* bar, volatile LAS unsigned* st) {
    XcdBarrier b; b.bar = bar; b.x = xb_xcc_id(); b.st = st;
    if (threadIdx.x == 0) (void)xb_add(&bar[XB_XCNT(b.x)], 1u);
    return b;
}
__device__ __forceinline__ void xcd_barrier_complete(unsigned* bar, unsigned x, unsigned& nloc, unsigned& nx) {
    const unsigned G = gridDim.x * gridDim.y * gridDim.z;
    unsigned sum, cnt, mine, sp = 0u;
    for (;;) {
        sum = 0u; cnt = 0u; mine = 0u;
#pragma unroll
        for (unsigned j = 0; j < 16; ++j) { const unsigned c = xb_ld(&bar[XB_XCNT(j)]); sum += c; cnt += (c > 0u) ? 1u : 0u; mine = (j == x) ? c : mine; }
        if (sum == G) break;
        __builtin_amdgcn_s_sleep(1);
        if ((++sp & 255u) == 0u) { if (xb_ld(&bar[XB_TMO])) break; if (sp > XB_SPIN_CAP) { atomicAdd(&bar[XB_TMO], 1u); break; } }
    }
    nloc = mine > 0u ? mine : 1u; nx = cnt > 0u ? cnt : 1u;
}

__device__ __forceinline__ void xcd_barrier(const XcdBarrier& b) {
    asm volatile("s_waitcnt vmcnt(0)" ::: "memory");
    __syncthreads();
    if (threadIdx.x == 0) {
        unsigned* bar = b.bar;
        __builtin_amdgcn_s_waitcnt(0);
        unsigned nloc = b.st[0], nx = b.st[1];
        if (nloc == 0u) { xcd_barrier_complete(bar, b.x, nloc, nx); b.st[0] = nloc; b.st[1] = nx; }
        const unsigned old = xb_add(&bar[XB_XSUB(b.x)], 1u);
        const unsigned gen = old / nloc;
        if (old + 1u == (gen + 1u) * nloc) {
            __builtin_amdgcn_fence(__ATOMIC_RELEASE, "agent");
            asm volatile("s_waitcnt vmcnt(0)" ::: "memory");
            const unsigned og = xb_add(&bar[XB_TOP], 1u);
            const unsigned tg = og / nx;
            if (og + 1u == (tg + 1u) * nx) xb_add(&bar[XB_TOPGEN], 1u);
            else XB_SPIN(xb_ld(&bar[XB_TOPGEN]) == tg, bar);
            __builtin_amdgcn_fence(__ATOMIC_ACQUIRE, "agent");
            xb_add(&bar[XB_XGEN(b.x)], 1u);
            asm volatile("s_waitcnt vmcnt(0)" ::: "memory");
        } else {
            XB_SPIN(xb_ld(&bar[XB_XGEN(b.x)]) == gen, bar);
            __builtin_amdgcn_fence(__ATOMIC_ACQUIRE, "agent");
            asm volatile("s_waitcnt vmcnt(0)" ::: "memory");
        }
    }
    __syncthreads();
}

__device__ __forceinline__ void ph_wconv(bf16_t* dst, const float* src, int N, int K, int ldsrc, int nvalid) {
    GSTRIDE(idx, (long)N * K) { const int k = idx % K, n = idx / K; dst[idx] = n < nvalid ? f2bf(src[(size_t)k * ldsrc + n]) : (bf16_t)0; }
}
__device__ __forceinline__ void ph_wconv_moe(const P& p, int l) {
    GSTRIDE(idx, (long)NE * 1024 * 1024) {
        const int k = idx % 1024, n = (idx / 1024) % 1024, e = idx / (1024 * 1024);
        const int q = n >> 3, r = n & 7, j = 4 * q + (r & 3);
        const float* src = (r < 4 ? p.in[31] : p.in[32]) + ((size_t)(l * NE + e) * D + k) * EH + j;
        p.Wgu[idx] = f2bf(*src);
    }
    GSTRIDE(idx, (long)NE * 1024 * 512) {
        const int k = idx % 512, n = (idx / 512) % 1024, e = idx / (512 * 1024);
        p.Wd[idx] = f2bf(p.in[33][((size_t)(l * NE + e) * EH + k) * D + n]);
    }
}
__device__ __forceinline__ void ph_ada(const P& p) {
    GSTRIDE(idx, 2 * 3 * 6144) {
        const int n = idx % 6144, j = (idx / 6144) % 3, l = idx / (3 * 6144);
        const float* cv = j < 2 ? p.in[1] + j * D : p.in[3];
        const float* w = p.in[4] + (size_t)l * D * 6144;
        float acc = p.in[5][l * 6144 + n];
        for (int k = 0; k < D; ++k) acc += siluf(cv[k]) * w[(size_t)k * 6144 + n];
        p.MOD[idx] = acc;
    }
}
__device__ __forceinline__ void ph_init(const P& p) {
    GSTRIDE(i, (long)RL * D) p.out[i] = p.in[0][i];
    GSTRIDE(i, (long)RCX * D) p.Xc[i] = p.in[2][i];
}
__device__ __forceinline__ void hy_pos(int pidx, int& len, int& i) { if (pidx < L) { len = L; i = pidx; } else { len = CTX; i = pidx - L; } }
__device__ __forceinline__ void ph_hyA1(const P& p) {
    GSTRIDE(idx, (long)RB * 64) {
        const int j = idx % 64, pidx = idx / 64; int len, i; hy_pos(pidx, len, i);
        const float t = (float)i / (float)(len - 1);
        const float w = 2.0f * 3.14159265358979323846f * (float)i / (float)len;
        const float* w1 = p.in[13];
        float acc = p.in[14][j] + t * w1[j];
        for (int m = 0; m < 16; ++m) {
            const float f = 1e-4f + (float)m * ((15.f - 1e-4f) / 15.f);
            acc += cosf(f * w) * w1[(1 + m) * 64 + j] - sinf(f * w) * w1[(17 + m) * 64 + j];
        }
        p.A1[idx] = sinf(p.in[20][j] * acc);
    }
}
__device__ __forceinline__ void ph_hyA(const float* src, float* dst, const float* w, const float* bias, const float* freq) {
    GSTRIDE(idx, (long)RB * 64) {
        const int j = idx % 64, pidx = idx / 64;
        float acc = bias[j];
        for (int i = 0; i < 64; ++i) acc += src[(size_t)pidx * 64 + i] * w[i * 64 + j];
        dst[idx] = sinf(freq[j] * acc);
    }
}
__device__ __forceinline__ void ph_hyF(const P& p, const float* a3) {
    const float mind = logf(1e-2f) / 1.5f, maxd = logf(1e-2f) / 0.3f;
    GSTRIDE(idx, (long)2048 * RB) {
        const int pidx = idx % RB, col = idx / RB, ch = col % 512; int len, i; hy_pos(pidx, len, i);
        const float t = (float)i / (float)(len - 1);
        float acc = 0.f;
        for (int m = 0; m < 64; ++m) acc += a3[(size_t)pidx * 64 + m] * p.in[19][m * 2048 + col];
        const float delta = fabsf(mind + (float)ch * ((maxd - mind) / 511.f));
        p.FILT[idx] = acc * expf(-t * delta);
    }
}
__device__ __forceinline__ float block_sum(float v, float* red);
__device__ __forceinline__ void ph_hyNorm(const P& p, float* red) {
    for (int u = blockIdx.x; u < 2 * 2048; u += gridDim.x) {
        const int col = u % 2048, which = u / 2048; const int p0 = which ? L : 0, n = which ? CTX : L;
        float s = 0.f;
        for (int i = TIDX; i < n; i += NT) { const float v = p.FILT[(size_t)col * RB + p0 + i]; s += v * v; }
        const float t = block_sum(s, red);
        if (TIDX == 0) p.NORM[which * 2048 + col] = t;
    }
}
__device__ __forceinline__ void ph_mod(const P& p, int l, int which) {
    GSTRIDE(i, (long)R * D) {
        const int r = i / D, k = i % D;
        p.H[i] = f2bf(xrow(p, r)[k] * (1.f + modv(p, l, r, which * 3 + 1)[k]) + modv(p, l, r, which * 3 + 0)[k]);
    }
}
__device__ __forceinline__ void ph_prep_rope(const P& p) {
    GSTRIDE(i, (long)R * 2 * 4 * 64) {
        const int pr = i % 64, h = (i / 64) % 4, w = (i / 256) % 2, r = i / 512;
        bf16_t* base = p.Zr + (size_t)r * 2048 + w * 512 + h * 128;
        float t1 = bf2f(base[pr]), t2 = bf2f(base[64 + pr]);
        if (w == 1) { t1 *= KSCALE; t2 *= KSCALE; }
        if (r < RL) {
            const int t = r % L, row = t / GW, col = t % GW;
            const float inv = powf(10000.f, -(float)(pr & 31) / 32.f);
            const float ang = (pr < 32 ? (float)row : (float)col) * inv;
            float sn, cs; sincosf(ang, &sn, &cs);
            const float a = t1 * cs - t2 * sn, bb = t1 * sn + t2 * cs; t1 = a; t2 = bb;
        }
        base[pr] = f2bf(t1); base[64 + pr] = f2bf(t2);
    }
}
__device__ __forceinline__ void ph_prep_hy(const P& p) {
    GSTRIDE(idx, (long)NB * 1536 * RB) {
        const int tl = idx % RB, col = (idx / RB) % 1536, b = idx / (RB * 1536);
        const int s0 = tl < L ? 0 : L, s1 = tl < L ? L : RB;
        const float* w = p.in[11];
        float acc = p.in[12][col] + w[1536 + col] * bf2f(p.Zh[(size_t)bt_row(b, tl) * 1536 + col]);
        if (tl - 1 >= s0) acc += w[col] * bf2f(p.Zh[(size_t)bt_row(b, tl - 1) * 1536 + col]);
        if (tl + 1 < s1) acc += w[2 * 1536 + col] * bf2f(p.Zh[(size_t)bt_row(b, tl + 1) * 1536 + col]);
        p.hyT[idx] = f2bf(acc);
    }
}
__device__ __forceinline__ float hy_tapT(const float* Ff, const float* Fb, float nf, float nb, int d) {
    if (d > 0) return Ff[d] * nf; if (d < 0) return Fb[-d] * nb; return Ff[0] * nf + Fb[0] * nb;
}
__device__ __forceinline__ void ph_hyconv_naive(const P& p, int n, float* conv) {
    GSTRIDE(idx, (long)NB * 512 * (RB / 4)) {
        const int tb = idx % (RB / 4), ch = (idx / (RB / 4)) % 512, b = idx / ((RB / 4) * 512);
        const int tl0 = tb * 4, s0 = tl0 < L ? 0 : L, len = tl0 < L ? L : CTX, nrm = tl0 < L ? 0 : 1, t0 = tl0 - s0;
        const int cf = (n * 2 + 0) * 512 + ch, cb = (n * 2 + 1) * 512 + ch;
        const float nf = 1.f / sqrtf(p.NORM[nrm * 2048 + cf]), nb = 1.f / sqrtf(p.NORM[nrm * 2048 + cb]);
        const float* Ff = p.FILT + (size_t)cf * RB + s0; const float* Fb = p.FILT + (size_t)cb * RB + s0;
        const bf16_t* z = p.hyT + ((size_t)(b * 3 + 2) * 512 + ch) * RB + s0;
        float w0 = hy_tapT(Ff, Fb, nf, nb, t0), w1 = hy_tapT(Ff, Fb, nf, nb, t0 + 1), w2 = hy_tapT(Ff, Fb, nf, nb, t0 + 2), w3 = hy_tapT(Ff, Fb, nf, nb, t0 + 3);
        float a0 = 0.f, a1 = 0.f, a2 = 0.f, a3 = 0.f;
        for (int s = 0; s < len; ++s) {
            const float zz = bf2f(z[s]);
            a0 += w0 * zz; a1 += w1 * zz; a2 += w2 * zz; a3 += w3 * zz;
            w3 = w2; w2 = w1; w1 = w0;
            if (s + 1 < len) w0 = hy_tapT(Ff, Fb, nf, nb, t0 - (s + 1));
        }
        float* o = conv + ((size_t)b * 512 + ch) * RB + tl0; o[0] = a0; o[1] = a1; o[2] = a2; o[3] = a3;
    }
}
__device__ __forceinline__ void ph_hygate_naive(const P& p, int n, const float* conv) {
    bf16_t* yhT = p.Zh + (size_t)2 * NB * 4 * NCH * 16384;
    GSTRIDE(idx, (long)NB * 512 * RB) {
        const int tl = idx % RB, ch = (idx / RB) % 512, b = idx / (RB * 512);
        bf16_t* z = p.hyT + ((size_t)(b * 3 + 2) * 512 + ch) * RB + tl; const float gate = bf2f(p.hyT[((size_t)(b * 3 + n) * 512 + ch) * RB + tl]);
        const float r = gate * (conv[idx] + p.in[21][n * 512 + ch] * bf2f(*z));
        if (n == 0) *z = f2bf(r); else yhT[idx] = f2bf(r);
    }
}
__device__ __forceinline__ void ph_hy_untranspose(const P& p) {
    const bf16_t* yhT = p.Zh + (size_t)2 * NB * 4 * NCH * 16384;
    GSTRIDE(idx, (long)R * 512) { const int ch = idx % 512, r = idx / 512; int b, tl; row_bt(r, b, tl); p.H[(size_t)r * D + 512 + ch] = yhT[((size_t)b * 512 + ch) * RB + tl]; }
}
__device__ __forceinline__ size_t st_idx(int dir, int b, int h, int c) { return ((((size_t)dir * NB + b) * 4 + h) * NCH + c) * 16384; }
__device__ __forceinline__ void ph_retU_naive(const P& p) {
    bf16_t* ST = p.Zh;
    GSTRIDE(idx, (long)NB * 4 * NCH * 16384) {
        const int d = idx % 128, e = (idx / 128) % 128, c = (idx / 16384) % NCH, h = (idx / (16384 * NCH)) % 4, b = idx / (16384 * NCH * 4);
        const float lgf = p.in[9][h], lgb = p.in[10][h]; const int r0 = chunk_row0(b, c);
        float uf = 0.f, ub = 0.f;
        for (int j = 0; j < 128; ++j) {
            const float kk = bf2f(p.Zr[(size_t)(r0 + j) * 2048 + 512 + h * 128 + d]), vv = bf2f(p.Zr[(size_t)(r0 + j) * 2048 + 1024 + h * 128 + e]);
            uf += kk * expf(lgf * (float)(127 - j)) * vv; ub += kk * expf(lgb * (float)j) * vv;
        }
        ST[st_idx(0, b, h, c) + e * 128 + d] = f2bf(uf); ST[st_idx(1, b, h, c) + e * 128 + d] = f2bf(ub);
    }
}
__device__ __forceinline__ void ph_retScan(const P& p) {
    bf16_t* ST = p.Zh;
    GSTRIDE(idx, (long)2 * NB * 4 * 16384) {
        const int ed = idx % 16384, h = (idx / 16384) % 4, b = (idx / 65536) % NB, dir = idx / (65536 * NB);
        const float dc = expf((dir ? p.in[10] : p.in[9])[h] * 128.f);
        float s = 0.f;
        for (int cc = 0; cc < NCH; ++cc) {
            const int c = dir == 0 ? cc : (cc < 2 ? 1 - cc : NCH + 1 - cc);
            bf16_t* q = ST + st_idx(dir, b, h, c) + ed; const float u = bf2f(*q); *q = f2bf(s); s = dc * s + u;
        }
    }
}
__device__ __forceinline__ void ph_retO_naive(const P& p, float* lds) {
    const bf16_t* ST = p.Zh;
    for (int u = blockIdx.x; u < NB * 4 * NCH; u += gridDim.x) {
        const int c = u % NCH, h = (u / NCH) % 4, b = u / (NCH * 4); const int r0 = chunk_row0(b, c);
        const float lgf = p.in[9][h], lgb = p.in[10][h];
        __syncthreads();
        for (int e = TIDX; e < 128 * 128; e += NT) {
            const int j = e % 128, i = e / 128;
            const bf16_t* q = p.Zr + (size_t)(r0 + i) * 2048 + h * 128; const bf16_t* k = p.Zr + (size_t)(r0 + j) * 2048 + 512 + h * 128;
            float s = 0.f; for (int d = 0; d < 128; ++d) s += bf2f(q[d]) * bf2f(k[d]);
            const float m = i > j ? expf(lgf * (float)(i - j)) : (j > i ? expf(lgb * (float)(j - i)) : 2.f);
            lds[e] = s * m;
        }
        __syncthreads();
        const bf16_t* sf = ST + st_idx(0, b, h, c); const bf16_t* sb = ST + st_idx(1, b, h, c);
        for (int e2 = TIDX; e2 < 128 * 128; e2 += NT) {
            const int e = e2 % 128, i = e2 / 128;
            float o = 0.f; for (int j = 0; j < 128; ++j) o += lds[i * 128 + j] * bf2f(p.Zr[(size_t)(r0 + j) * 2048 + 1024 + h * 128 + e]);
            const bf16_t* q = p.Zr + (size_t)(r0 + i) * 2048 + h * 128;
            float of = 0.f, ob = 0.f; for (int d = 0; d < 128; ++d) { const float qq = bf2f(q[d]); of += qq * bf2f(sf[e * 128 + d]); ob += qq * bf2f(sb[e * 128 + d]); }
            p.H[(size_t)(r0 + i) * D + h * 128 + e] = f2bf(o + expf(lgf * (float)(i + 1)) * of + expf(lgb * (float)(128 - i)) * ob);
        }
    }
}
__device__ __forceinline__ void ph_retNorm_naive(const P& p) {
    GSTRIDE(idx, (long)R * 4) {
        const int h = idx % 4, r = idx / 4; bf16_t* o = p.H + (size_t)r * D + h * 128;
        float mu = 0.f; for (int e = 0; e < 128; ++e) mu += bf2f(o[e]); mu *= (1.f / 128.f);
        float var = 0.f; for (int e = 0; e < 128; ++e) { const float d = bf2f(o[e]) - mu; var += d * d; } var *= (1.f / 128.f);
        const float rs = 1.f / sqrtf(var + LN_EPS);
        for (int e = 0; e < 128; ++e) o[e] = f2bf((bf2f(o[e]) - mu) * rs * siluf(bf2f(p.Zr[(size_t)r * 2048 + 1536 + h * 128 + e])));
    }
}
__device__ __forceinline__ float block_sum(float v, float* red) {
    __syncthreads();
#pragma unroll
    for (int o = 32; o > 0; o >>= 1) v += __shfl_xor(v, o);
    if ((TIDX & 63) == 0) red[TIDX >> 6] = v;
    __syncthreads();
    float t = 0.f;
#pragma unroll
    for (int w = 0; w < NT / 64; ++w) t += red[w];
    return t;
}
template <int MODE> __device__ __forceinline__ void ph_post(const P& p, int l, int which, const bf16_t* Y, int ln, int wn, int nrows, float* red) {
    const float* lg = p.in[6] + (size_t)(l * 2 + which) * D; const float* lb = p.in[7] + (size_t)(l * 2 + which) * D;
    int toff[16];
    if (MODE == 1) { int s = 0;
#pragma unroll
        for (int e = 0; e < 16; ++e) { toff[e] = s; s += (p.CNT[l * 16 + e] + 255) >> 8; } }
    for (int r = blockIdx.x; r < nrows; r += gridDim.x) {
        float* x = xrow(p, r); const float* gate = modv(p, l, r, which * 3 + 2);
        const bf16_t *y0, *y1 = nullptr;
        if (MODE == 0) y0 = Y + (size_t)r * D;
        else {
            int sr[2];
#pragma unroll
            for (int k = 0; k < 2; ++k) { const int e = p.RE[r * 2 + k]; int to = 0;
#pragma unroll
                for (int q = 0; q < 16; ++q) to = (q == e) ? toff[q] : to;
                sr[k] = to * 256 + p.RPOS[r * 2 + k]; }
            y0 = p.slots + (size_t)sr[0] * D; y1 = p.slots + (size_t)sr[1] * D;
        }
        float v[2]; float s = 0.f;
#pragma unroll
        for (int i = 0; i < 2; ++i) { const int k = TIDX + i * NT; float yy = bf2f(y0[k]); if (MODE == 1) yy += bf2f(y1[k]); v[i] = ALPHA * x[k] + gate[k] * yy; s += v[i]; }
        const float mu = block_sum(s, red) * (1.f / D);
        float q = 0.f;
#pragma unroll
        for (int i = 0; i < 2; ++i) { const float d = v[i] - mu; q += d * d; }
        const float rs = 1.f / sqrtf(block_sum(q, red) * (1.f / D) + LN_EPS);
#pragma unroll
        for (int i = 0; i < 2; ++i) { const int k = TIDX + i * NT; const float xn = (v[i] - mu) * rs * lg[k] + lb[k]; x[k] = xn;
            if (ln >= 0) p.H[(size_t)r * D + k] = f2bf(xn * (1.f + modv(p, ln, r, wn * 3 + 1)[k]) + modv(p, ln, r, wn * 3 + 0)[k]); }
    }
}
__device__ __forceinline__ void ph_route1(const P& p, int l, int nrows) {
    GSTRIDE(idx, (long)nrows * NE) {
        const int e = idx % NE, r = idx / NE; const float* x = xrow(p, r); const float* sc = modv(p, l, r, 4); const float* sh = modv(p, l, r, 3);
        float acc = 0.f;
        for (int k = 0; k < D; ++k) acc += (x[k] * (1.f + sc[k]) + sh[k]) * p.in[29][k * NE + e];
        p.RS[idx] = sigmf(acc);
    }
}
__device__ __forceinline__ void ph_route2(const P& p, int l, int nrows) {
    GSTRIDE(r, nrows) {
        const float* s = p.RS + (size_t)r * NE; const float* rb = p.in[30];
        int best = 0; float bs = -1e30f;
        for (int g = 0; g < NG; ++g) {
            float m1 = -1e30f, m2 = -1e30f;
            for (int q = 0; q < EPG; ++q) { const float v = s[g * EPG + q] + rb[g * EPG + q]; if (v > m1) { m2 = m1; m1 = v; } else if (v > m2) m2 = v; }
            if (m1 + m2 > bs) { bs = m1 + m2; best = g; }
        }
        int i1 = 0; float v1 = -1e30f;
        for (int q = 0; q < EPG; ++q) { const float v = s[best * EPG + q] + rb[best * EPG + q]; if (v > v1) { v1 = v; i1 = q; } }
        int i2 = 0; float v2 = -1e30f;
        for (int q = 0; q < EPG; ++q) { if (q == i1) continue; const float v = s[best * EPG + q] + rb[best * EPG + q]; if (v > v2) { v2 = v; i2 = q; } }
        const int e1 = best * EPG + i1, e2 = best * EPG + i2; const float a = s[e1], c = s[e2];
        p.RE[r * 2] = e1; p.RE[r * 2 + 1] = e2; p.RWt[r * 2] = a / (a + c); p.RWt[r * 2 + 1] = c / (a + c);
        p.RPOS[r * 2] = atomicAdd(&p.CNT[l * 16 + e1], 1); p.RPOS[r * 2 + 1] = atomicAdd(&p.CNT[l * 16 + e2], 1);
    }
}
__device__ __forceinline__ void ph_permute(const P& p, int l, int nrows) {
    int toff[16]; { int s = 0;
#pragma unroll
        for (int e = 0; e < 16; ++e) { toff[e] = s; s += (p.CNT[l * 16 + e] + 255) >> 8; } }
    GSTRIDE(idx, (long)nrows * 2 * 128) {
        const int ck = idx % 128, k = (idx / 128) % 2, r = idx / 256; const int e = p.RE[r * 2 + k]; int to = 0;
#pragma unroll
        for (int q = 0; q < 16; ++q) to = (q == e) ? toff[q] : to;
        const int sr = to * 256 + p.RPOS[r * 2 + k];
        ((uint4*)(p.Hs + (size_t)sr * D))[ck] = ((const uint4*)(p.H + (size_t)r * D))[ck];
        if (ck == 0) p.WS[sr] = p.RWt[r * 2 + k];
    }
}
__device__ __forceinline__ void ph_glagate(const P& p) {
    GSTRIDE(idx, (long)2 * R * 512) {
        const int ch = idx % 512, r = (idx / 512) % R, dir = idx / (512 * R);
        const float* gw = (dir ? p.in[26] : p.in[24]); const float* gb = (dir ? p.in[27] : p.in[25]);
        float acc = gb[ch];
        for (int q = 0; q < 16; ++q) acc += bf2f(p.Z1[(size_t)r * GINP + 3072 + dir * 16 + q]) * gw[q * 512 + ch];
        p.BG[idx] = logsigf(acc) * (1.f / 16.f);
    }
}
__device__ __forceinline__ void ph_glacum(const P& p) {
    GSTRIDE(idx, (long)2 * NB * NCH * 512) {
        const int ch = idx % 512, c = (idx / 512) % NCH, b = (idx / (512 * NCH)) % NB, dir = idx / (512 * NCH * NB);
        float* a = p.BG + ((size_t)dir * R + chunk_row0(b, c)) * 512 + ch;
        float s = 0.f;
        if (dir == 0) for (int i = 0; i < 128; ++i) { s += a[(size_t)i * 512]; a[(size_t)i * 512] = s; }
        else for (int i = 127; i >= 0; --i) { s += a[(size_t)i * 512]; a[(size_t)i * 512] = s; }
    }
}
__device__ __forceinline__ size_t gst_idx(int dir, int b, int h, int c) { return ((((size_t)dir * NB + b) * 4 + h) * NCH + c) * 32768; }
__device__ __forceinline__ void ph_glaU_naive(const P& p) {
    const float* BF = p.BG; const float* BB = p.BG + (size_t)R * 512;
    GSTRIDE(idx, (long)NB * 4 * NCH * 32768) {
        const int d = idx % 128, e = (idx / 128) % 256, c = (idx / 32768) % NCH, h = (idx / (32768 * NCH)) % 4, b = idx / (32768 * NCH * 4);
        const int r0 = chunk_row0(b, c);
        const float bfe = BF[(size_t)(r0 + 127) * 512 + h * 128 + d], bbe = BB[(size_t)r0 * 512 + h * 128 + d];
        float uf = 0.f, ub = 0.f;
        for (int j = 0; j < 128; ++j) {
            const float kk = bf2f(p.Z1[(size_t)(r0 + j) * GINP + 512 + h * 128 + d]), vv = bf2f(p.Z1[(size_t)(r0 + j) * GINP + 1024 + h * 256 + e]);
            uf += kk * expf(bfe - BF[(size_t)(r0 + j) * 512 + h * 128 + d]) * vv; ub += kk * expf(bbe - BB[(size_t)(r0 + j) * 512 + h * 128 + d]) * vv;
        }
        p.GST[gst_idx(0, b, h, c) + e * 128 + d] = f2bf(uf); p.GST[gst_idx(1, b, h, c) + e * 128 + d] = f2bf(ub);
    }
}
__device__ __forceinline__ void ph_glaScan(const P& p) {
    const float* BF = p.BG; const float* BB = p.BG + (size_t)R * 512;
    GSTRIDE(idx, (long)2 * NB * 4 * 32768) {
        const int d = idx % 128, ed = idx % 32768, h = (idx / 32768) % 4, b = (idx / 131072) % NB, dir = idx / (131072 * NB);
        float s = 0.f;
        for (int cc = 0; cc < NCH; ++cc) {
            const int c = dir == 0 ? cc : (cc < 2 ? 1 - cc : NCH + 1 - cc); const int r0 = chunk_row0(b, c);
            const float dc = dir == 0 ? expf(BF[(size_t)(r0 + 127) * 512 + h * 128 + d]) : expf(BB[(size_t)r0 * 512 + h * 128 + d]);
            bf16_t* q = p.GST + gst_idx(dir, b, h, c) + ed; const float u = bf2f(*q); *q = f2bf(s); s = dc * s + u;
        }
    }
}
__device__ __forceinline__ void ph_glaO_naive(const P& p, float* lds) {
    const float* BF = p.BG; const float* BB = p.BG + (size_t)R * 512;
    for (int u = blockIdx.x; u < NB * 4 * 64; u += gridDim.x) {
        const int c = 2 + u % 64, h = (u / 64) % 4, b = u / 256; const int r0 = chunk_row0(b, c);
        __syncthreads();
        for (int e = TIDX; e < 128 * 128; e += NT) {
            const int j = e % 128, i = e / 128;
            const bf16_t* q = p.Z1 + (size_t)(r0 + i) * GINP + h * 128; const bf16_t* k = p.Z1 + (size_t)(r0 + j) * GINP + 512 + h * 128;
            float s = 0.f;
            if (i >= j) { const float* bi = BF + (size_t)(r0 + i) * 512 + h * 128; const float* bj = BF + (size_t)(r0 + j) * 512 + h * 128;
                for (int d = 0; d < 128; ++d) s += bf2f(q[d]) * bf2f(k[d]) * expf(bi[d] - bj[d]); }
            if (i <= j) { const float* bi = BB + (size_t)(r0 + i) * 512 + h * 128; const float* bj = BB + (size_t)(r0 + j) * 512 + h * 128;
                for (int d = 0; d < 128; ++d) s += bf2f(q[d]) * bf2f(k[d]) * expf(bi[d] - bj[d]); }
            lds[e] = s * KSCALE;
        }
        __syncthreads();
        const bf16_t* sf = p.GST + gst_idx(0, b, h, c); const bf16_t* sb = p.GST + gst_idx(1, b, h, c);
        for (int e2 = TIDX; e2 < 128 * 256; e2 += NT) {
            const int e = e2 % 256, i = e2 / 256;
            float o = 0.f; for (int j = 0; j < 128; ++j) o += lds[i * 128 + j] * bf2f(p.Z1[(size_t)(r0 + j) * GINP + 1024 + h * 256 + e]);
            const bf16_t* q = p.Z1 + (size_t)(r0 + i) * GINP + h * 128; const float* bi = BF + (size_t)(r0 + i) * 512 + h * 128; const float* bbi = BB + (size_t)(r0 + i) * 512 + h * 128;
            float a = 0.f; for (int d = 0; d < 128; ++d) a += bf2f(q[d]) * (expf(bi[d]) * bf2f(sf[e * 128 + d]) + expf(bbi[d]) * bf2f(sb[e * 128 + d]));
            p.H[(size_t)(r0 + i) * D + h * 256 + e] = f2bf(o + a * KSCALE);
        }
    }
}
__device__ __forceinline__ void ph_glaNorm_naive(const P& p) {
    GSTRIDE(idx, (long)RL * 4) {
        const int h = idx % 4, r = idx / 4; bf16_t* o = p.H + (size_t)r * D + h * 256;
        float ss = 0.f; for (int e = 0; e < 256; ++e) { const float v = bf2f(o[e]); ss += v * v; }
        const float rs = 1.f / sqrtf(ss * (1.f / 256.f) + LN_EPS);
        for (int e = 0; e < 256; ++e) o[e] = f2bf(bf2f(o[e]) * rs * siluf(bf2f(p.Z1[(size_t)r * GINP + 2048 + h * 256 + e])));
    }
}

#define FD __device__ __forceinline__
#define TIE(a, b) asm volatile("" : "+v"(a) : "v"(b))
#define HWCOS(x) __builtin_amdgcn_cosf(x)
#define HWSIN(x) __builtin_amdgcn_sinf(x)
struct cf { float x, y; };
FD cf cadd(cf a, cf b) { return {a.x + b.x, a.y + b.y}; }
FD cf csub(cf a, cf b) { return {a.x - b.x, a.y - b.y}; }
FD cf cmul(cf a, cf b) { return {a.x * b.x - a.y * b.y, a.x * b.y + a.y * b.x}; }
#define C32(k) ((k)==0?1.0f:(k)==1?0.98078528040323043f:(k)==2?0.92387953251128674f:(k)==3?0.83146961230254524f:(k)==4?0.70710678118654752f:(k)==5?0.55557023301960222f:(k)==6?0.38268343236508977f:(k)==7?0.19509032201612825f:(k)==8?0.0f:(k)==9?-0.19509032201612825f:(k)==10?-0.38268343236508977f:(k)==11?-0.55557023301960222f:(k)==12?-0.70710678118654752f:(k)==13?-0.83146961230254524f:(k)==14?-0.92387953251128674f:-0.98078528040323043f)
#define S32(k) ((k)==0?0.0f:(k)==1?0.19509032201612825f:(k)==2?0.38268343236508977f:(k)==3?0.55557023301960222f:(k)==4?0.70710678118654752f:(k)==5?0.83146961230254524f:(k)==6?0.92387953251128674f:(k)==7?0.98078528040323043f:(k)==8?1.0f:(k)==9?0.98078528040323043f:(k)==10?0.92387953251128674f:(k)==11?0.83146961230254524f:(k)==12?0.70710678118654752f:(k)==13?0.55557023301960222f:(k)==14?0.38268343236508977f:0.19509032201612825f)
template <int N, int LEN, bool INV> FD void dit_level(cf (&x)[N]) {
#pragma unroll
    for (int blk = 0; blk < N; blk += LEN)
#pragma unroll
        for (int j = 0; j < LEN / 2; ++j) {
            const int k = j * (32 / LEN);
            const cf a = x[blk + j], b0 = x[blk + j + LEN / 2];
            const cf b = k == 0 ? b0 : (k == 8 ? (INV ? cf{-b0.y, b0.x} : cf{b0.y, -b0.x}) : cmul(b0, cf{C32(k), INV ? S32(k) : -S32(k)}));
            x[blk + j] = cadd(a, b); x[blk + j + LEN / 2] = csub(a, b);
        }
}
template <int N, bool INV> FD void dit_reg(cf (&x)[N]) {
    dit_level<N, 2, INV>(x); dit_level<N, 4, INV>(x);
    if constexpr (N >= 8) dit_level<N, 8, INV>(x);
    if constexpr (N >= 16) dit_level<N, 16, INV>(x);
}
template <int N, int LEN, bool INV> FD void dif_level(cf (&x)[N]) {
#pragma unroll
    for (int blk = 0; blk < N; blk += LEN)
#pragma unroll
        for (int j = 0; j < LEN / 2; ++j) {
            const int k = j * (32 / LEN);
            const cf a = x[blk + j], b = x[blk + j + LEN / 2];
            x[blk + j] = cadd(a, b); const cf d = csub(a, b);
            x[blk + j + LEN / 2] = k == 0 ? d : (k == 8 ? (INV ? cf{-d.y, d.x} : cf{d.y, -d.x}) : cmul(d, cf{C32(k), INV ? S32(k) : -S32(k)}));
        }
}
template <int N, bool INV> FD void dif_reg(cf (&x)[N]) {
    if constexpr (N >= 16) dif_level<N, 16, INV>(x);
    if constexpr (N >= 8) dif_level<N, 8, INV>(x);
    dif_level<N, 4, INV>(x); dif_level<N, 2, INV>(x);
}
constexpr int FFT_N = 16384, FFT_LDS_CF = 17920;
FD int brev4(int i) { return ((i & 1) << 3) | ((i & 2) << 1) | ((i & 4) >> 1) | ((i & 8) >> 3); }
FD int physA(int m, int a) { return 4480 * a + m + (m >> 4) + 16 * (m >> 9); }
FD int physB(int b, int a, int m) { return 4480 * b + 272 * a + 16 * (a >> 1) + m + (m >> 4); }
FD int physC(int b, int a, int m) { return 272 * b + 16 * (b >> 1) + 17 * a + m; }
FD int physD(int g, int j) { return 17 * g + 16 * (g >> 5) + j; }
template <int RR, int RM> FD void twiddle(cf (&x)[RR], int m, float sgn) {
    const float fr = (float)m * (1.0f / (float)RM); const cf w{HWCOS(fr), sgn * HWSIN(fr)}; cf cur = w;
#pragma unroll
    for (int s = 1; s < RR; ++s) { x[s] = cmul(x[s], cur); if (s + 1 < RR) cur = cmul(cur, w); }
}
FD void stA_fwd(int m, cf v0, cf v1, cf v2, cf v3, cf* buf) {
    cf x[4] = {v0, v2, v1, v3};
    dit_reg<4, false>(x); twiddle<4, 16384>(x, m, -1.f);
#pragma unroll
    for (int s = 0; s < 4; ++s) buf[physA(m, s)] = x[s];
}
FD void stB_fwd(int idx, cf* buf) {
    const int b = idx >> 8, m = idx & 255; cf x[16];
#pragma unroll
    for (int i = 0; i < 16; ++i) x[i] = buf[physB(b, brev4(i), m)];
    dit_reg<16, false>(x); twiddle<16, 4096>(x, m, -1.f);
#pragma unroll
    for (int s = 0; s < 16; ++s) buf[physB(b, s, m)] = x[s];
}
FD void stC_fwd(int idx, cf* buf) {
    const int b = idx >> 4, m = idx & 15; cf x[16];
#pragma unroll
    for (int i = 0; i < 16; ++i) x[i] = buf[physC(b, brev4(i), m)];
    dit_reg<16, false>(x); twiddle<16, 256>(x, m, -1.f);
#pragma unroll
    for (int s = 0; s < 16; ++s) buf[physC(b, s, m)] = x[s];
}
FD void stD_fwd_regs(int g, const cf* buf, cf (&x)[16]) {
#pragma unroll
    for (int i = 0; i < 16; ++i) x[i] = buf[physD(g, brev4(i))];
    dit_reg<16, false>(x);
}
FD void stD_mul(int g, cf* buf, const cf (&h)[16]) {
    cf x[16];
#pragma unroll
    for (int i = 0; i < 16; ++i) x[i] = buf[physD(g, brev4(i))];
    dit_reg<16, false>(x);
#pragma unroll
    for (int s = 0; s < 16; ++s) x[s] = cmul(x[s], h[s]);
    dif_reg<16, true>(x);
#pragma unroll
    for (int i = 0; i < 16; ++i) buf[physD(g, brev4(i))] = x[i];
}
FD void stC_inv(int idx, cf* buf) {
    const int b = idx >> 4, m = idx & 15; cf x[16];
#pragma unroll
    for (int s = 0; s < 16; ++s) x[s] = buf[physC(b, s, m)];
    twiddle<16, 256>(x, m, 1.f); dif_reg<16, true>(x);
#pragma unroll
    for (int i = 0; i < 16; ++i) buf[physC(b, brev4(i), m)] = x[i];
}
FD void stB_inv(int idx, cf* buf) {
    const int b = idx >> 8, m = idx & 255; cf x[16];
#pragma unroll
    for (int s = 0; s < 16; ++s) x[s] = buf[physB(b, s, m)];
    twiddle<16, 4096>(x, m, 1.f); dif_reg<16, true>(x);
#pragma unroll
    for (int i = 0; i < 16; ++i) buf[physB(b, brev4(i), m)] = x[i];
}
FD void stA_inv(int m, const cf* buf, cf& r0, cf& r1) {
    cf x[4];
#pragma unroll
    for (int s = 0; s < 4; ++s) x[s] = buf[physA(m, s)];
    twiddle<4, 16384>(x, m, 1.f); dif_reg<4, true>(x);
    r0 = x[0]; r1 = x[2];
}

#undef FD
__device__ __forceinline__ float dw3(const bf16_t* u, int d, int lo, int hi, float w0, float w1, float w2, float bs) {
    float a = bs + w1 * bf2f(u[d]);
    if (d > lo) a += w0 * bf2f(u[d - 1]);
    if (d < hi) a += w2 * bf2f(u[d + 1]);
    return a;
}
__device__ __forceinline__ void ph_hyena_fft(const P& p, unsigned char* smem) {
    cf* buf = (cf*)smem; float* fb = (float*)smem; float* red = (float*)(smem + FFT_LDS_CF * 8);
    const int t = TIDX;
    bf16_t* yhT = p.Zh + (size_t)2 * NB * 4 * NCH * 16384;
    for (int ch = blockIdx.x; ch < 512; ch += gridDim.x) {
        const bf16_t* hy0 = p.hyT + ((size_t)0 * 512 + ch) * RB;
        const size_t bstr = (size_t)3 * 512 * RB, jstr = (size_t)512 * RB;
        cf* Hg = (cf*)p.H + (size_t)blockIdx.x * 16384;
        cf zreg[16];
        float cw[3][3], cbv[3];
#pragma unroll
        for (int j = 0; j < 3; ++j) { cbv[j] = p.in[12][j * 512 + ch];
#pragma unroll
            for (int q = 0; q < 3; ++q) cw[j][q] = p.in[11][q * 1536 + j * 512 + ch]; }
#pragma unroll 1
        for (int n = 0; n < 2; ++n) {
            const int cfi = (n * 2) * 512 + ch, cbi = (n * 2 + 1) * 512 + ch;
            const float* Ff = p.FILT + (size_t)cfi * RB; const float* Fb = p.FILT + (size_t)cbi * RB;
            float tf0[8], tf1[8], tb2[8], tb3[8]; float sf = 0.f, sb = 0.f;
#pragma unroll
            for (int j = 0; j < 8; ++j) { const int m = t + 512 * j;
                tf0[j] = Ff[m]; tf1[j] = Ff[4096 + m]; tb2[j] = (m == 0) ? Fb[0] : Fb[8192 - (m == 0 ? 1 : m)]; tb3[j] = Fb[4096 - m];
                sf += tf0[j] * tf0[j] + tf1[j] * tf1[j]; sb += tb2[j] * tb2[j] + tb3[j] * tb3[j]; }
            const float nf = 1.f / sqrtf(block_sum(sf, red)), nb = 1.f / sqrtf(block_sum(sb, red));
#pragma unroll
            for (int j = 0; j < 8; ++j) { const int m = launder_i(t) + 512 * j;
                const float v0 = tf0[j] * nf + ((m == 0) ? tb2[j] * nb : 0.f), v2 = (m == 0) ? 0.f : tb2[j] * nb;
                stA_fwd(m, cf{v0, 0.f}, cf{tf1[j] * nf, 0.f}, cf{v2, 0.f}, cf{tb3[j] * nb, 0.f}, buf); }
            __syncthreads();
#pragma unroll 1
            for (int q = 0; q < 2; ++q) stB_fwd(launder_i(t) + 512 * q, buf);
            __syncthreads();
#pragma unroll 1
            for (int q = 0; q < 2; ++q) stC_fwd(launder_i(t) + 512 * q, buf);
            __syncthreads();
            cf H0[16];
            stD_fwd_regs(launder_i(t), buf, H0);
            { const int g = launder_i(t) + 512; cf hh[16]; stD_fwd_regs(g, buf, hh);
#pragma unroll
                for (int s = 0; s < 16; ++s) Hg[s * 512 + t] = hh[s]; }
            __syncthreads();
#pragma unroll
            for (int j = 0; j < 8; ++j) { const int m = launder_i(t) + 512 * j;
                if (n == 0) { zreg[2 * j] = cf{dw3(hy0 + 2 * jstr, m, 0, L - 1, cw[2][0], cw[2][1], cw[2][2], cbv[2]), dw3(hy0 + bstr + 2 * jstr, m, 0, L - 1, cw[2][0], cw[2][1], cw[2][2], cbv[2])};
                              zreg[2 * j + 1] = cf{dw3(hy0 + 2 * jstr, 4096 + m, 0, L - 1, cw[2][0], cw[2][1], cw[2][2], cbv[2]), dw3(hy0 + bstr + 2 * jstr, 4096 + m, 0, L - 1, cw[2][0], cw[2][1], cw[2][2], cbv[2])}; }
                stA_fwd(m, zreg[2 * j], zreg[2 * j + 1], cf{0.f, 0.f}, cf{0.f, 0.f}, buf); }
            __syncthreads();
#pragma unroll 1
            for (int q = 0; q < 2; ++q) stB_fwd(launder_i(t) + 512 * q, buf);
            __syncthreads();
#pragma unroll 1
            for (int q = 0; q < 2; ++q) stC_fwd(launder_i(t) + 512 * q, buf);
            __syncthreads();
            stD_mul(launder_i(t), buf, H0);
            { const int g = launder_i(t) + 512; cf hh[16];
#pragma unroll
                for (int s = 0; s < 16; ++s) hh[s] = Hg[s * 512 + t];
                stD_mul(g, buf, hh); }
            __syncthreads();
#pragma unroll 1
            for (int q = 0; q < 2; ++q) stC_inv(launder_i(t) + 512 * q, buf);
            __syncthreads();
#pragma unroll 1
            for (int q = 0; q < 2; ++q) stB_inv(launder_i(t) + 512 * q, buf);
            __syncthreads();
            const float sk = p.in[21][n * 512 + ch];
#pragma unroll
            for (int j = 0; j < 8; ++j) { const int m = launder_i(t) + 512 * j; cf r0, r1; stA_inv(m, buf, r0, r1);
#pragma unroll
                for (int hlf = 0; hlf < 2; ++hlf) { const int d = m + 4096 * hlf; const cf r = hlf ? r1 : r0; const cf z = zreg[2 * j + hlf];
                    const bf16_t* gs = hy0 + n * jstr;
                    const float g0 = dw3(gs, d, 0, L - 1, cw[n][0], cw[n][1], cw[n][2], cbv[n]), g1 = dw3(gs + bstr, d, 0, L - 1, cw[n][0], cw[n][1], cw[n][2], cbv[n]);
                    const float o0 = g0 * (r.x * (1.f / 16384.f) + sk * z.x), o1 = g1 * (r.y * (1.f / 16384.f) + sk * z.y);
                    if (n == 0) zreg[2 * j + hlf] = cf{o0, o1};
                    else { yhT[((size_t)0 * 512 + ch) * RB + d] = f2bf(o0); yhT[((size_t)1 * 512 + ch) * RB + d] = f2bf(o1); } } }
            __syncthreads();
        }
        {
            float* tap = fb;
            float* zc = fb + 1024;
            const int b = t >> 8, tt = t & 255;
#pragma unroll
            for (int n = 0; n < 2; ++n) {
                const int cfi = (n * 2) * 512 + ch, cbi = (n * 2 + 1) * 512 + ch;
                const float* Ff = p.FILT + (size_t)cfi * RB + L; const float* Fb = p.FILT + (size_t)cbi * RB + L;
                const float vf = t < 256 ? Ff[t] : 0.f, vb = t < 256 ? Fb[t] : 0.f;
                const float nf = 1.f / sqrtf(block_sum(vf * vf, red)), nb = 1.f / sqrtf(block_sum(vb * vb, red));
                if (t < 511) { const int d = t - 255; tap[n * 512 + t] = d > 0 ? Ff[d] * nf : (d < 0 ? Fb[-d] * nb : Ff[0] * nf + Fb[0] * nb); }
            }
            const bf16_t* hb_ = hy0 + (size_t)b * bstr;
            const float z1 = dw3(hb_ + 2 * jstr, L + tt, L, RB - 1, cw[2][0], cw[2][1], cw[2][2], cbv[2]);
            zc[b * 256 + tt] = z1;
            __syncthreads();
            float c1 = 0.f;
            for (int s = 0; s < 256; ++s) c1 += tap[tt - s + 255] * zc[b * 256 + s];
            const float z2 = dw3(hb_, L + tt, L, RB - 1, cw[0][0], cw[0][1], cw[0][2], cbv[0]) * (c1 + p.in[21][ch] * z1);
            __syncthreads();
            zc[b * 256 + tt] = z2;
            __syncthreads();
            float c2 = 0.f;
            for (int s = 0; s < 256; ++s) c2 += tap[512 + tt - s + 255] * zc[b * 256 + s];
            yhT[((size_t)b * 512 + ch) * RB + L + tt] = f2bf(dw3(hb_ + jstr, L + tt, L, RB - 1, cw[1][0], cw[1][1], cw[1][2], cbv[1]) * (c2 + p.in[21][512 + ch] * z2));
            __syncthreads();
        }
    }
}

typedef short bf16x8 __attribute__((ext_vector_type(8)));
typedef short s16x4 __attribute__((ext_vector_type(4)));
typedef float f32x4 __attribute__((ext_vector_type(4)));
typedef unsigned u4v __attribute__((ext_vector_type(4)));
typedef unsigned u2v __attribute__((ext_vector_type(2)));
constexpr int LDT = 136;
constexpr int TILE_E = 128 * LDT;
__device__ __forceinline__ bf16x8 frag_row(const LAS bf16_t* T, int ld, int r0, int k0, int lane) {
    return *(const LAS bf16x8*)(T + (r0 + (lane & 15)) * ld + k0 + 8 * (lane >> 4));
}
__device__ __forceinline__ bf16x8 frag_tr(const LAS bf16_t* T, int ld, int k0, int n0, int lane) {
    const int g = lane >> 4, q = (lane & 15) >> 2, pp = lane & 3;
    const LAS bf16_t* a0 = T + (k0 + 8 * g + q) * ld + n0 + 4 * pp;
    const s16x4 lo = __builtin_amdgcn_ds_read_tr16_b64_v4i16((LAS s16x4*)a0);
    const s16x4 hi = __builtin_amdgcn_ds_read_tr16_b64_v4i16((LAS s16x4*)(a0 + 4 * ld));
    return (bf16x8){lo[0], lo[1], lo[2], lo[3], hi[0], hi[1], hi[2], hi[3]};
}
#define MFMA16(xn, xm, acc) __builtin_amdgcn_mfma_f32_16x16x32_bf16(xn, xm, acc, 0, 0, 0)
__device__ __forceinline__ void unpack8(const u4v u, float (&f)[8]) {
    f[0] = __uint_as_float(u.x << 16); f[1] = __uint_as_float(u.x & 0xffff0000u); f[2] = __uint_as_float(u.y << 16); f[3] = __uint_as_float(u.y & 0xffff0000u);
    f[4] = __uint_as_float(u.z << 16); f[5] = __uint_as_float(u.z & 0xffff0000u); f[6] = __uint_as_float(u.w << 16); f[7] = __uint_as_float(u.w & 0xffff0000u);
}
__device__ __forceinline__ u4v pack8(const float (&f)[8]) {
    u4v u; u.x = pk_bf16(f[0], f[1]); u.y = pk_bf16(f[2], f[3]); u.z = pk_bf16(f[4], f[5]); u.w = pk_bf16(f[6], f[7]); return u;
}
__device__ __forceinline__ void stage_tile(LAS bf16_t* dst, const bf16_t* src, int gld, int tid) {
#pragma unroll
    for (int i = 0; i < 4; ++i) { const int c = tid + 512 * i, row = c >> 4, ch = c & 15;
        *(LAS u4v*)(dst + row * LDT + ch * 8) = *(const u4v*)(src + (size_t)row * gld + ch * 8); }
}
__device__ __forceinline__ void ph_retU_mfma(const P& p, unsigned char* smem) {
    LAS bf16_t* Kt = (LAS bf16_t*)smem; LAS bf16_t* VF = Kt + TILE_E; LAS bf16_t* VB = VF + TILE_E;
    bf16_t* ST = p.Zh;
    for (int u = blockIdx.x; u < NB * 4 * NCH; u += gridDim.x) {
        const int tid = TIDX, lane = tid & 63, w = tid >> 6;
        const int c = u % NCH, h = (u / NCH) % 4, b = u / (NCH * 4); const int r0 = chunk_row0(b, c);
        const float lgf = p.in[9][h], lgb = p.in[10][h];
        const bf16_t* kb = p.Zr + (size_t)r0 * 2048 + 512 + h * 128; const bf16_t* vb = p.Zr + (size_t)r0 * 2048 + 1024 + h * 128;
        __syncthreads();
        stage_tile(Kt, kb, 2048, tid);
#pragma unroll
        for (int i = 0; i < 4; ++i) { const int cc = tid + 512 * i, j = cc >> 4, ch = cc & 15;
            float f[8], g[8]; unpack8(*(const u4v*)(vb + (size_t)j * 2048 + ch * 8), f);
            const float wf = __expf(lgf * (float)(127 - j)), wb = __expf(lgb * (float)j);
#pragma unroll
            for (int q = 0; q < 8; ++q) { g[q] = f[q] * wb; f[q] *= wf; }
            *(LAS u4v*)(VF + j * LDT + ch * 8) = pack8(f); *(LAS u4v*)(VB + j * LDT + ch * 8) = pack8(g); }
        __syncthreads();
        f32x4 af[8], ab[8];
#pragma unroll
        for (int nt = 0; nt < 8; ++nt) { af[nt] = (f32x4){0.f, 0.f, 0.f, 0.f}; ab[nt] = (f32x4){0.f, 0.f, 0.f, 0.f}; }
#pragma unroll
        for (int ks = 0; ks < 4; ++ks) {
            const bf16x8 xf = frag_tr(VF, LDT, 32 * ks, 16 * w, lane), xb = frag_tr(VB, LDT, 32 * ks, 16 * w, lane);
#pragma unroll
            for (int nt = 0; nt < 8; ++nt) { const bf16x8 xn = frag_tr(Kt, LDT, 32 * ks, 16 * nt, lane); af[nt] = MFMA16(xn, xf, af[nt]); ab[nt] = MFMA16(xn, xb, ab[nt]); }
        }
        const int e = 16 * w + (lane & 15), d0 = 4 * (lane >> 4);
        bf16_t* of = ST + st_idx(0, b, h, c) + e * 128 + d0; bf16_t* ob = ST + st_idx(1, b, h, c) + e * 128 + d0;
#pragma unroll
        for (int nt = 0; nt < 8; ++nt) {
            u2v o; o.x = pk_bf16(af[nt][0], af[nt][1]); o.y = pk_bf16(af[nt][2], af[nt][3]); *(u2v*)(of + 16 * nt) = o;
            o.x = pk_bf16(ab[nt][0], ab[nt][1]); o.y = pk_bf16(ab[nt][2], ab[nt][3]); *(u2v*)(ob + 16 * nt) = o; }
    }
}
__device__ __forceinline__ void ph_retO_mfma(const P& p, unsigned char* smem) {
    LAS bf16_t* Qs = (LAS bf16_t*)smem; LAS bf16_t* Ks = Qs + TILE_E; LAS bf16_t* Vs = Ks + TILE_E; LAS bf16_t* Ss = Vs + TILE_E;
    const bf16_t* ST = p.Zh;
    for (int u = blockIdx.x; u < NB * 4 * NCH; u += gridDim.x) {
        const int tid = TIDX, lane = tid & 63, w = tid >> 6, fr = lane & 15, fq = lane >> 4;
        const int c = u % NCH, h = (u / NCH) % 4, b = u / (NCH * 4); const int r0 = chunk_row0(b, c);
        const float lgf = p.in[9][h], lgb = p.in[10][h];
        const bf16_t* zb = p.Zr + (size_t)r0 * 2048 + h * 128;
        __syncthreads();
        stage_tile(Qs, zb, 2048, tid); stage_tile(Ks, zb + 512, 2048, tid); stage_tile(Vs, zb + 1024, 2048, tid); stage_tile(Ss, ST + st_idx(0, b, h, c), 128, tid);
        __syncthreads();
        f32x4 as[8], af[8];
#pragma unroll
        for (int nt = 0; nt < 8; ++nt) { as[nt] = (f32x4){0.f, 0.f, 0.f, 0.f}; af[nt] = (f32x4){0.f, 0.f, 0.f, 0.f}; }
#pragma unroll
        for (int ks = 0; ks < 4; ++ks) { const bf16x8 xm = frag_row(Qs, LDT, 16 * w, 32 * ks, lane);
#pragma unroll
            for (int nt = 0; nt < 8; ++nt) { as[nt] = MFMA16(frag_row(Ks, LDT, 16 * nt, 32 * ks, lane), xm, as[nt]); af[nt] = MFMA16(frag_row(Ss, LDT, 16 * nt, 32 * ks, lane), xm, af[nt]); } }
        const int i = 16 * w + fr;
        __syncthreads();
#pragma unroll
        for (int nt = 0; nt < 8; ++nt) { float pv[4];
#pragma unroll
            for (int q = 0; q < 4; ++q) { const int j = 16 * nt + 4 * fq + q; const float m = i > j ? __expf(lgf * (float)(i - j)) : (j > i ? __expf(lgb * (float)(j - i)) : 2.f); pv[q] = as[nt][q] * m; }
            u2v o; o.x = pk_bf16(pv[0], pv[1]); o.y = pk_bf16(pv[2], pv[3]); *(LAS u2v*)(Ks + i * LDT + 16 * nt + 4 * fq) = o; }
        stage_tile(Ss, ST + st_idx(1, b, h, c), 128, tid);
        __syncthreads();
        f32x4 ao[8], ab[8];
#pragma unroll
        for (int nt = 0; nt < 8; ++nt) { ao[nt] = (f32x4){0.f, 0.f, 0.f, 0.f}; ab[nt] = (f32x4){0.f, 0.f, 0.f, 0.f}; }
#pragma unroll
        for (int ks = 0; ks < 4; ++ks) { const bf16x8 xp = frag_row(Ks, LDT, 16 * w, 32 * ks, lane), xq = frag_row(Qs, LDT, 16 * w, 32 * ks, lane);
#pragma unroll
            for (int nt = 0; nt < 8; ++nt) { ao[nt] = MFMA16(frag_tr(Vs, LDT, 32 * ks, 16 * nt, lane), xp, ao[nt]); ab[nt] = MFMA16(frag_row(Ss, LDT, 16 * nt, 32 * ks, lane), xq, ab[nt]); } }
        const float rf = __expf(lgf * (float)(i + 1)), rb = __expf(lgb * (float)(128 - i));
        float s = 0.f;
#pragma unroll
        for (int nt = 0; nt < 8; ++nt) { ao[nt] = ao[nt] + af[nt] * rf + ab[nt] * rb; s += (ao[nt][0] + ao[nt][1]) + (ao[nt][2] + ao[nt][3]); }
        s += __shfl_xor(s, 16); s += __shfl_xor(s, 32);
        const float mu = s * (1.f / 128.f); float qv = 0.f;
#pragma unroll
        for (int nt = 0; nt < 8; ++nt) { const f32x4 dd = ao[nt] - mu; qv += (dd[0] * dd[0] + dd[1] * dd[1]) + (dd[2] * dd[2] + dd[3] * dd[3]); }
        qv += __shfl_xor(qv, 16); qv += __shfl_xor(qv, 32);
        const float rs = 1.f / sqrtf(qv * (1.f / 128.f) + LN_EPS);
        const bf16_t* gp = p.Zr + (size_t)(r0 + i) * 2048 + 1536 + h * 128 + 4 * fq; bf16_t* yp = p.H + (size_t)(r0 + i) * D + h * 128 + 4 * fq;
#pragma unroll
        for (int nt = 0; nt < 8; ++nt) { const u2v gu = *(const u2v*)(gp + 16 * nt);
            const float g0 = __uint_as_float(gu.x << 16), g1 = __uint_as_float(gu.x & 0xffff0000u), g2 = __uint_as_float(gu.y << 16), g3 = __uint_as_float(gu.y & 0xffff0000u);
            u2v o; o.x = pk_bf16((ao[nt][0] - mu) * rs * siluf(g0), (ao[nt][1] - mu) * rs * siluf(g1)); o.y = pk_bf16((ao[nt][2] - mu) * rs * siluf(g2), (ao[nt][3] - mu) * rs * siluf(g3));
            *(u2v*)(yp + 16 * nt) = o; }
    }
}
__device__ __forceinline__ void ph_glaU_mfma(const P& p, unsigned char* smem) {
    LAS bf16_t* KF = (LAS bf16_t*)smem; LAS bf16_t* KB = KF + TILE_E; LAS bf16_t* Vs = KB + TILE_E;
    for (int u = blockIdx.x; u < NB * 4 * NCH; u += gridDim.x) {
        const int tid = TIDX, lane = tid & 63, w = tid >> 6;
        const int c = u % NCH, h = (u / NCH) % 4, b = u / (NCH * 4); const int r0 = chunk_row0(b, c);
        const bf16_t* kb = p.Z1 + (size_t)r0 * GINP + 512 + h * 128; const bf16_t* vb = p.Z1 + (size_t)r0 * GINP + 1024 + h * 256;
        float* BFw = p.BG + (size_t)r0 * 512 + h * 128; float* BBw = p.BG + (size_t)R * 512 + (size_t)r0 * 512 + h * 128;
        const float* BF = BFw; const float* BB = BBw;
        __syncthreads();
        {
            float* lr = (float*)(Vs);
            float* tot = lr + 128 * 32;
            for (int e = tid; e < 128 * 32; e += NT) lr[e] = bf2f(p.Z1[(size_t)(r0 + (e >> 5)) * GINP + 3072 + (e & 31)]);
            const int chn = tid & 127, dir = (tid >> 7) & 1, half = tid >> 8;
            const float* gw = (dir ? p.in[26] : p.in[24]) + h * 128 + chn; float g[16];
#pragma unroll
            for (int q = 0; q < 16; ++q) g[q] = gw[q * 512];
            const float gb = (dir ? p.in[27] : p.in[25])[h * 128 + chn];
            __syncthreads();
            float la[64]; float s = 0.f;
#pragma unroll
            for (int ii = 0; ii < 64; ++ii) { const int i = half * 64 + ii; float a = gb;
#pragma unroll
                for (int q = 0; q < 16; ++q) a += lr[i * 32 + dir * 16 + q] * g[q];
                la[ii] = (fminf(a, 0.f) - __logf(1.f + __expf(-fabsf(a)))) * (1.f / 16.f); s += la[ii]; }
            tot[(dir * 2 + half) * 128 + chn] = s;
            __syncthreads();
            const float total = tot[(dir * 2 + 0) * 128 + chn] + tot[(dir * 2 + 1) * 128 + chn];
            s = dir == 0 ? (half ? tot[(0 * 2 + 0) * 128 + chn] : 0.f) : (half ? 0.f : tot[(1 * 2 + 1) * 128 + chn]);
            float* out = (dir ? BBw : BFw) + chn; LAS bf16_t* Kd = dir ? KB : KF;
            if (dir == 0) {
#pragma unroll
                for (int ii = 0; ii < 64; ++ii) { const int i = half * 64 + ii; s += la[ii]; out[(size_t)i * 512] = s; Kd[i * LDT + chn] = f2bf(bf2f(kb[(size_t)i * GINP + chn]) * __expf(total - s)); }
            } else {
#pragma unroll
                for (int ii = 63; ii >= 0; --ii) { const int i = half * 64 + ii; s += la[ii]; out[(size_t)i * 512] = s; Kd[i * LDT + chn] = f2bf(bf2f(kb[(size_t)i * GINP + chn]) * __expf(total - s)); }
            }
            __syncthreads();
        }
        const int fr = lane & 15, fq = lane >> 4;
#pragma unroll 1
        for (int hf = 0; hf < 2; ++hf) {
            if (hf) __syncthreads();
            stage_tile(Vs, vb + hf * 128, GINP, tid);
            __syncthreads();
            {
                f32x4 af[8], ab[8];
#pragma unroll
                for (int nt = 0; nt < 8; ++nt) { af[nt] = (f32x4){0.f, 0.f, 0.f, 0.f}; ab[nt] = (f32x4){0.f, 0.f, 0.f, 0.f}; }
#pragma unroll
                for (int ks = 0; ks < 4; ++ks) { const bf16x8 x0 = frag_tr(Vs, LDT, 32 * ks, 16 * w, lane);
#pragma unroll
                    for (int nt = 0; nt < 8; ++nt) { af[nt] = MFMA16(frag_tr(KF, LDT, 32 * ks, 16 * nt, lane), x0, af[nt]); ab[nt] = MFMA16(frag_tr(KB, LDT, 32 * ks, 16 * nt, lane), x0, ab[nt]); } }
                bf16_t* of = p.GST + gst_idx(0, b, h, c) + (size_t)(hf * 128 + 16 * w + fr) * 128 + 4 * fq; bf16_t* ob = p.GST + gst_idx(1, b, h, c) + (size_t)(hf * 128 + 16 * w + fr) * 128 + 4 * fq;
#pragma unroll
                for (int nt = 0; nt < 8; ++nt) { u2v v; v.x = pk_bf16(af[nt][0], af[nt][1]); v.y = pk_bf16(af[nt][2], af[nt][3]); *(u2v*)(of + 16 * nt) = v;
                    v.x = pk_bf16(ab[nt][0], ab[nt][1]); v.y = pk_bf16(ab[nt][2], ab[nt][3]); *(u2v*)(ob + 16 * nt) = v; }
            }
        }
    }
}
__device__ __forceinline__ void stage_scaled(LAS bf16_t* dst, const bf16_t* src, const float* G, float sgn, float mul, int tid) {
#pragma unroll
    for (int i = 0; i < 4; ++i) { const int cc = tid + 512 * i, j = cc >> 4, ch = cc & 15;
        float k8[8]; unpack8(*(const u4v*)(src + (size_t)j * GINP + ch * 8), k8);
        const f32x4 f0 = *(const f32x4*)(G + (size_t)j * 512 + ch * 8), f1 = *(const f32x4*)(G + (size_t)j * 512 + ch * 8 + 4);
#pragma unroll
        for (int q = 0; q < 4; ++q) { k8[q] *= __expf(sgn * f0[q]) * mul; k8[q + 4] *= __expf(sgn * f1[q]) * mul; }
        *(LAS u4v*)(dst + j * LDT + ch * 8) = pack8(k8); }
}
__device__ __forceinline__ void ph_glaO_mfma(const P& p, unsigned char* smem) {
    LAS bf16_t* QF = (LAS bf16_t*)smem; LAS bf16_t* QB = QF + TILE_E; LAS bf16_t* KX = QB + TILE_E; LAS bf16_t* R4 = KX + TILE_E;
    for (int u = blockIdx.x; u < NB * 4 * 64; u += gridDim.x) {
        const int tid = TIDX, lane = tid & 63, w = tid >> 6, fr = lane & 15, fq = lane >> 4;
        const int c = 2 + u % 64, h = (u / 64) % 4, b = u / 256; const int r0 = chunk_row0(b, c);
        const bf16_t* qb = p.Z1 + (size_t)r0 * GINP + h * 128; const bf16_t* kb = qb + 512; const bf16_t* vb = p.Z1 + (size_t)r0 * GINP + 1024 + h * 256;
        const float* BF = p.BG + (size_t)r0 * 512 + h * 128; const float* BB = p.BG + (size_t)R * 512 + (size_t)r0 * 512 + h * 128;
        const int i = 16 * w + fr;
        __syncthreads();
        stage_scaled(QF, qb, BF, 1.f, KSCALE, tid); stage_scaled(QB, qb, BB, 1.f, KSCALE, tid); stage_scaled(KX, kb, BF, -1.f, 1.f, tid);
        __syncthreads();
        f32x4 s1[8];
#pragma unroll
        for (int nt = 0; nt < 8; ++nt) s1[nt] = (f32x4){0.f, 0.f, 0.f, 0.f};
#pragma unroll
        for (int ks = 0; ks < 4; ++ks) { const bf16x8 xm = frag_row(QF, LDT, 16 * w, 32 * ks, lane);
#pragma unroll
            for (int nt = 0; nt < 8; ++nt) s1[nt] = MFMA16(frag_row(KX, LDT, 16 * nt, 32 * ks, lane), xm, s1[nt]); }
#pragma unroll
        for (int nt = 0; nt < 8; ++nt)
#pragma unroll
            for (int q = 0; q < 4; ++q) { const int j = 16 * nt + 4 * fq + q; s1[nt][q] = (i >= j) ? s1[nt][q] : 0.f; }
        __syncthreads();
        stage_scaled(KX, kb, BB, -1.f, 1.f, tid);
        __syncthreads();
        {
            f32x4 s2[8];
#pragma unroll
            for (int nt = 0; nt < 8; ++nt) s2[nt] = (f32x4){0.f, 0.f, 0.f, 0.f};
#pragma unroll
            for (int ks = 0; ks < 4; ++ks) { const bf16x8 xm = frag_row(QB, LDT, 16 * w, 32 * ks, lane);
#pragma unroll
                for (int nt = 0; nt < 8; ++nt) s2[nt] = MFMA16(frag_row(KX, LDT, 16 * nt, 32 * ks, lane), xm, s2[nt]); }
#pragma unroll
            for (int nt = 0; nt < 8; ++nt)
#pragma unroll
                for (int q = 0; q < 4; ++q) { const int j = 16 * nt + 4 * fq + q; s1[nt][q] += (i <= j) ? s2[nt][q] : 0.f; }
        }
        __syncthreads();
#pragma unroll
        for (int nt = 0; nt < 8; ++nt) { u2v o; o.x = pk_bf16(s1[nt][0], s1[nt][1]); o.y = pk_bf16(s1[nt][2], s1[nt][3]); *(LAS u2v*)(KX + i * LDT + 16 * nt + 4 * fq) = o; }
        f32x4 ao[2][8];
#pragma unroll
        for (int hf = 0; hf < 2; ++hf) {
#pragma unroll
            for (int nt = 0; nt < 8; ++nt) ao[hf][nt] = (f32x4){0.f, 0.f, 0.f, 0.f};
            stage_tile(R4, vb + hf * 128, GINP, tid);
            __syncthreads();
#pragma unroll
            for (int ks = 0; ks < 4; ++ks) { const bf16x8 xp = frag_row(KX, LDT, 16 * w, 32 * ks, lane);
#pragma unroll
                for (int nt = 0; nt < 8; ++nt) ao[hf][nt] = MFMA16(frag_tr(R4, LDT, 32 * ks, 16 * nt, lane), xp, ao[hf][nt]); }
            __syncthreads();
            stage_tile(R4, p.GST + gst_idx(0, b, h, c) + (size_t)hf * 128 * 128, 128, tid);
            __syncthreads();
#pragma unroll
            for (int ks = 0; ks < 4; ++ks) { const bf16x8 xq = frag_row(QF, LDT, 16 * w, 32 * ks, lane);
#pragma unroll
                for (int nt = 0; nt < 8; ++nt) ao[hf][nt] = MFMA16(frag_row(R4, LDT, 16 * nt, 32 * ks, lane), xq, ao[hf][nt]); }
            __syncthreads();
            stage_tile(R4, p.GST + gst_idx(1, b, h, c) + (size_t)hf * 128 * 128, 128, tid);
            __syncthreads();
#pragma unroll
            for (int ks = 0; ks < 4; ++ks) { const bf16x8 xq = frag_row(QB, LDT, 16 * w, 32 * ks, lane);
#pragma unroll
                for (int nt = 0; nt < 8; ++nt) ao[hf][nt] = MFMA16(frag_row(R4, LDT, 16 * nt, 32 * ks, lane), xq, ao[hf][nt]); }
            __syncthreads();
        }
        float ss = 0.f;
#pragma unroll
        for (int hf = 0; hf < 2; ++hf)
#pragma unroll
            for (int nt = 0; nt < 8; ++nt) { const f32x4 v = ao[hf][nt]; ss += (v[0] * v[0] + v[1] * v[1]) + (v[2] * v[2] + v[3] * v[3]); }
        ss += __shfl_xor(ss, 16); ss += __shfl_xor(ss, 32);
        const float rs = 1.f / sqrtf(ss * (1.f / 256.f) + LN_EPS);
        const bf16_t* gp = p.Z1 + (size_t)(r0 + i) * GINP + 2048 + h * 256 + 4 * fq; bf16_t* yp = p.H + (size_t)(r0 + i) * D + h * 256 + 4 * fq;
#pragma unroll
        for (int hf = 0; hf < 2; ++hf)
#pragma unroll
            for (int nt = 0; nt < 8; ++nt) { const u2v gu = *(const u2v*)(gp + hf * 128 + 16 * nt);
                const float g0 = __uint_as_float(gu.x << 16), g1 = __uint_as_float(gu.x & 0xffff0000u), g2 = __uint_as_float(gu.y << 16), g3 = __uint_as_float(gu.y & 0xffff0000u);
                u2v o; o.x = pk_bf16(ao[hf][nt][0] * rs * siluf(g0), ao[hf][nt][1] * rs * siluf(g1)); o.y = pk_bf16(ao[hf][nt][2] * rs * siluf(g2), ao[hf][nt][3] * rs * siluf(g3));
                *(u2v*)(yp + hf * 128 + 16 * nt) = o; }
    }
}

template <int MODE> __device__ __forceinline__ void tr_w(bf16_t* dst, const float* src, int N, int K, int ldsrc, float* t  , int& tile0, int tile_stride) {
    const int nt_n = N / 64, ntiles = nt_n * (K / 64);
    float v[8];
    if (tile0 < ntiles) { const int tid = TIDX; const int n0 = (tile0 % nt_n) * 64, k0 = (tile0 / nt_n) * 64;
#pragma unroll
        for (int i = 0; i < 8; ++i) { const int e = tid + 512 * i; v[i] = src[(size_t)(k0 + (e >> 6)) * ldsrc + n0 + (e & 63)]; } }
    for (int tile = tile0; tile < ntiles; tile += tile_stride) {
        const int tid = TIDX; const int n0 = (tile % nt_n) * 64, k0 = (tile / nt_n) * 64;
        __syncthreads();
#pragma unroll
        for (int i = 0; i < 8; ++i) { const int e = tid + 512 * i; t[(e >> 6) * 65 + (e & 63)] = v[i]; }
        __syncthreads();
        if (tile + tile_stride < ntiles) { const int tn = tile + tile_stride; const int n1 = (tn % nt_n) * 64, k1 = (tn / nt_n) * 64;
#pragma unroll
            for (int i = 0; i < 8; ++i) { const int e = tid + 512 * i; v[i] = src[(size_t)(k1 + (e >> 6)) * ldsrc + n1 + (e & 63)]; } }
#pragma unroll
        for (int i = 0; i < 4; ++i) { const int e = tid + 512 * i, nn = e >> 5, kp = e & 31; const int n = n0 + nn;
            int row; float sc = 1.f;
            if (MODE == 0) row = n; else if (MODE == 3) { const int d = n & 127; row = n < 1024 ? (n - d) + 2 * (d & 63) + (d >> 6) : n; sc = (n >= 512 && n < 1024) ? KSCALE : 1.f; }
            else row = 8 * (n >> 2) + (n & 3) + (MODE == 2 ? 4 : 0);
            *(unsigned*)(dst + (size_t)row * K + k0 + 2 * kp) = pk_bf16(t[(2 * kp) * 65 + nn] * sc, t[(2 * kp + 1) * 65 + nn] * sc); }
    }
    tile0 = tile0 - (ntiles % tile_stride);
    if (tile0 < 0) tile0 += tile_stride;
}
__device__ __forceinline__ void ph_wconv_l0(const P& p, float* t) {
    int t0 = blockIdx.x; const int G = gridDim.x;
    tr_w<3>(p.Win0, p.in[8], ABIN, D, ABIN, t, t0, G);
    tr_w<0>(p.Wout0, p.in[22], D, D, D, t, t0, G);
}
__device__ __forceinline__ void ph_wconv_l1(const P& p, float* t) {
    int t0 = blockIdx.x; const int G = gridDim.x;
    tr_w<0>(p.Win1, p.in[23], 3072, D, GIN, t, t0, G);
    tr_w<0>(p.Wout1, p.in[28], D, D, D, t, t0, G);
    GSTRIDE(idx, (long)(GINP - 3072) * D) { const int k = idx % D, n = 3072 + idx / D; p.Win1[(size_t)n * D + k] = n < GIN ? f2bf(p.in[23][(size_t)k * GIN + n]) : (bf16_t)0; }
}
__device__ __forceinline__ void ph_wconv_moe_part(const P& p, int l, int part, float* t, int t0, int stride) {
    if (t0 < 0) return;
    for (int e = 0; e < NE; ++e) {
        if (part == 0) { tr_w<1>(p.Wgu + (size_t)e * 1024 * 1024, p.in[31] + (size_t)(l * NE + e) * D * EH, EH, D, EH, t, t0, stride);
                         tr_w<2>(p.Wgu + (size_t)e * 1024 * 1024, p.in[32] + (size_t)(l * NE + e) * D * EH, EH, D, EH, t, t0, stride); }
        else tr_w<0>(p.Wd + (size_t)e * 1024 * 512, p.in[33] + (size_t)(l * NE + e) * EH * D, D, EH, D, t, t0, stride);
    }
}
__device__ __forceinline__ void ph_wconv_moe_fast(const P& p, int l, float* t) { ph_wconv_moe_part(p, l, 0, t, blockIdx.x, gridDim.x); ph_wconv_moe_part(p, l, 1, t, blockIdx.x, gridDim.x); }
__device__ __forceinline__ void ph_prep_hy_fast(const P& p, float* t  ) {
    const int ntt = RB / 64, ntc = 1536 / 64;
    for (int tile = blockIdx.x; tile < NB * ntt * ntc; tile += gridDim.x) {
        const int tid = TIDX; const int ct = tile % ntc, tt = (tile / ntc) % ntt, b = tile / (ntc * ntt); const int c0 = ct * 64, tl0 = tt * 64;
        const int s0 = tl0 < L ? 0 : L, s1 = tl0 < L ? L : RB;
        __syncthreads();
        for (int e = tid; e < 66 * 64; e += NT) { const int rr = e >> 6, cc = e & 63, tl = tl0 - 1 + rr;
            t[rr * 65 + cc] = (tl >= s0 && tl < s1) ? bf2f(p.Zh[(size_t)bt_row(b, tl) * 1536 + c0 + cc]) : 0.f; }
        __syncthreads();
#pragma unroll
        for (int i = 0; i < 4; ++i) { const int e = tid + 512 * i, cc = e >> 5, tp = e & 31; const int col = c0 + cc;
            const float w0 = p.in[11][col], w1 = p.in[11][1536 + col], w2 = p.in[11][3072 + col], bs = p.in[12][col];
            const float a = bs + w0 * t[(2 * tp) * 65 + cc] + w1 * t[(2 * tp + 1) * 65 + cc] + w2 * t[(2 * tp + 2) * 65 + cc];
            const float c2 = bs + w0 * t[(2 * tp + 1) * 65 + cc] + w1 * t[(2 * tp + 2) * 65 + cc] + w2 * t[(2 * tp + 3) * 65 + cc];
            *(unsigned*)(p.hyT + ((size_t)b * 1536 + col) * RB + tl0 + 2 * tp) = pk_bf16(a, c2); }
    }
}
__device__ __forceinline__ void ph_hy_untranspose_fast(const P& p, float* t) {
    const bf16_t* yhT = p.Zh + (size_t)2 * NB * 4 * NCH * 16384;
    const int ntt = RB / 64, ntc = 512 / 64;
    for (int tile = blockIdx.x; tile < NB * ntt * ntc; tile += gridDim.x) {
        const int tid = TIDX; const int ct = tile % ntc, tt = (tile / ntc) % ntt, b = tile / (ntc * ntt); const int c0 = ct * 64, tl0 = tt * 64;
        __syncthreads();
#pragma unroll
        for (int i = 0; i < 8; ++i) { const int e = tid + 512 * i, cc = e >> 6, ti = e & 63; t[cc * 65 + ti] = bf2f(yhT[((size_t)b * 512 + c0 + cc) * RB + tl0 + ti]); }
        __syncthreads();
#pragma unroll
        for (int i = 0; i < 4; ++i) { const int e = tid + 512 * i, ti = e >> 5, cp = e & 31;
            *(unsigned*)(p.H + (size_t)bt_row(b, tl0 + ti) * D + 512 + c0 + 2 * cp) = pk_bf16(t[(2 * cp) * 65 + ti], t[(2 * cp + 1) * 65 + ti]); }
    }
}
__device__ __forceinline__ void ph_prep_rope_fast(const P& p) {
    GSTRIDE(idx, (long)R * 2 * 4 * 8) {
        const int pc = idx % 8, h = (idx / 8) % 4, w = (idx / 32) % 2, r = idx / 64;
        bf16_t* base = p.Zr + (size_t)r * 2048 + w * 512 + h * 128 + pc * 8;
        float a[8], c[8]; unpack8(*(const u4v*)base, a); unpack8(*(const u4v*)(base + 64), c);
        const float sc = w ? KSCALE : 1.f;
        if (r < RL) {
            const int t = r % L; const float pos = (pc < 4) ? (float)(t / GW) : (float)(t % GW);
#pragma unroll
            for (int q = 0; q < 8; ++q) { const int pr = pc * 8 + q; const float inv = exp2f(-(float)(pr & 31) * (13.287712379549449f / 32.f));
                float sn, cs; sincosf(pos * inv, &sn, &cs); const float x1 = a[q] * sc, x2 = c[q] * sc; a[q] = x1 * cs - x2 * sn; c[q] = x1 * sn + x2 * cs; }
        } else {
#pragma unroll
            for (int q = 0; q < 8; ++q) { a[q] *= sc; c[q] *= sc; }
        }
        *(u4v*)base = pack8(a); *(u4v*)(base + 64) = pack8(c);
    }
}
__device__ __forceinline__ void ph_mod_fast(const P& p, int l, int which, const float* xl  , const float* xc  ) {
    const int lane = TIDX & 63, gw = blockIdx.x * (NT / 64) + (TIDX >> 6), ngw = gridDim.x * (NT / 64);
    for (int r = gw; r < R; r += ngw) {
        const float* x = r < RL ? xl + (size_t)r * D : xc + (size_t)(r - RL) * D; const float* sh = modv(p, l, r, which * 3 + 0); const float* sc = modv(p, l, r, which * 3 + 1);
#pragma unroll
        for (int i = 0; i < 4; ++i) { const int k = 4 * lane + 256 * i; const f32x4 xv = *(const f32x4*)(x + k), s = *(const f32x4*)(sc + k), hh = *(const f32x4*)(sh + k);
            u2v o; o.x = pk_bf16(xv[0] * (1.f + s[0]) + hh[0], xv[1] * (1.f + s[1]) + hh[1]); o.y = pk_bf16(xv[2] * (1.f + s[2]) + hh[2], xv[3] * (1.f + s[3]) + hh[3]);
            *(u2v*)(p.H + (size_t)r * D + k) = o; }
    }
}

__device__ __forceinline__ void ph_rope_table(const P& p) {
    GSTRIDE(idx, 128 * 32) { const int f = idx & 31, pos = idx >> 5; float sn, cs; sincosf((float)pos * exp2f(-(float)f * (13.287712379549449f / 32.f)), &sn, &cs); p.A2[2 * idx] = cs; p.A2[2 * idx + 1] = sn; }
}
__device__ __forceinline__ void ph_filters(const P& p, unsigned char* smem) {
    float* lds = (float*)smem;
    float* aA = lds;
    float* aB = lds + 64 * 65;
    LAS bf16_t* A3 = (LAS bf16_t*)(smem + 2 * 64 * 65 * 4);
    LAS bf16_t* Ws = A3 + 64 * 72;
    float* mw = (float*)(smem + 2 * 64 * 65 * 4 + 64 * 72 * 2 + 64 * 264 * 2);
    const float mind = logf(1e-2f) / 1.5f, maxd = logf(1e-2f) / 0.3f;
    __syncthreads();
    for (int e = TIDX; e < 33 * 64; e += NT) mw[e] = p.in[13][e];
    for (int e = TIDX; e < 64 * 64; e += NT) { mw[2112 + e] = p.in[15][e]; mw[2112 + 4096 + e] = p.in[17][e]; }
    if (TIDX < 64) { mw[10304 + TIDX] = p.in[14][TIDX]; mw[10368 + TIDX] = p.in[16][TIDX]; mw[10432 + TIDX] = p.in[18][TIDX]; }
    if (TIDX < 192) mw[10496 + TIDX] = p.in[20][TIDX];
    for (int u = blockIdx.x; u < RB / 33; u += gridDim.x) {
        const int tid = TIDX; const int p0 = u * 33; const int pos = tid & 63, jg = tid >> 6, lane = tid & 63, w = tid >> 6;
        f32x4 wv[8];
#pragma unroll
        for (int i = 0; i < 8; ++i) { const int e = tid + 512 * i; wv[i] = *(const f32x4*)(p.in[19] + (size_t)(e >> 6) * 2048 + 4 * (e & 63)); }
        __syncthreads();
        for (int e = tid; e < 64 * 33; e += NT) { const int ps = e & 63, m = e >> 6; int ln2, i2; hy_pos(p0 + ps, ln2, i2);
            const float w2 = 2.0f * 3.14159265358979323846f * (float)i2 / (float)ln2; float v;
            if (m == 0) v = (float)i2 / (float)(ln2 - 1); else { const int q = (m - 1) & 15; const float f = 1e-4f + (float)q * ((15.f - 1e-4f) / 15.f); v = m <= 16 ? cosf(f * w2) : -sinf(f * w2); }
            aB[ps * 65 + m] = v; }
        __syncthreads();
        {
            float acc[8];
#pragma unroll
            for (int q = 0; q < 8; ++q) acc[q] = mw[10304 + jg * 8 + q];
#pragma unroll 3
            for (int m = 0; m < 33; ++m) { const float a = aB[pos * 65 + m];
#pragma unroll
                for (int q = 0; q < 8; ++q) acc[q] += a * mw[m * 64 + jg * 8 + q]; }
#pragma unroll
            for (int q = 0; q < 8; ++q) aA[pos * 65 + jg * 8 + q] = sinf(mw[10496 + jg * 8 + q] * acc[q]);
        }
        __syncthreads();
#pragma unroll 1
        for (int layer = 0; layer < 2; ++layer) {
            const float* W = mw + 2112 + 4096 * layer; const float* Bv = mw + 10368 + 64 * layer; const float* Fq = mw + 10496 + 64 * (layer + 1);
            float* src = layer ? aB : aA; float* dst = layer ? aA : aB;
            float acc[8];
#pragma unroll
            for (int q = 0; q < 8; ++q) acc[q] = Bv[jg * 8 + q];
#pragma unroll 4
            for (int m = 0; m < 64; ++m) { const float a = src[pos * 65 + m];
#pragma unroll
                for (int q = 0; q < 8; ++q) acc[q] += a * W[m * 64 + jg * 8 + q]; }
#pragma unroll
            for (int q = 0; q < 8; ++q) { const float v = sinf(Fq[jg * 8 + q] * acc[q]); dst[pos * 65 + jg * 8 + q] = v; if (layer == 1 && pos < 48) A3[pos * 72 + jg * 8 + q] = f2bf(v); }
            __syncthreads();
        }
        float tpos[3];
#pragma unroll
        for (int mt = 0; mt < 3; ++mt) { int len, i0; hy_pos(p0 + 16 * mt + (lane & 15), len, i0); tpos[mt] = (float)i0 / (float)(len - 1); }
#pragma unroll 1
        for (int cq = 0; cq < 8; ++cq) {
#pragma unroll
            for (int i = 0; i < 8; ++i) { const int e = tid + 512 * i; u2v o; o.x = pk_bf16(wv[i][0], wv[i][1]); o.y = pk_bf16(wv[i][2], wv[i][3]); *(LAS u2v*)(Ws + (e >> 6) * 264 + 4 * (e & 63)) = o; }
            __syncthreads();
            if (cq < 7) {
#pragma unroll
                for (int i = 0; i < 8; ++i) { const int e = tid + 512 * i; wv[i] = *(const f32x4*)(p.in[19] + (size_t)(e >> 6) * 2048 + (cq + 1) * 256 + 4 * (e & 63)); } }
            f32x4 acc[3][2];
#pragma unroll
            for (int mt = 0; mt < 3; ++mt)
#pragma unroll
                for (int nt = 0; nt < 2; ++nt) acc[mt][nt] = (f32x4){0.f, 0.f, 0.f, 0.f};
#pragma unroll
            for (int ks = 0; ks < 2; ++ks) { bf16x8 xm[3];
#pragma unroll
                for (int mt = 0; mt < 3; ++mt) xm[mt] = frag_row(A3, 72, 16 * mt, 32 * ks, lane);
#pragma unroll
                for (int nt = 0; nt < 2; ++nt) { const bf16x8 xn = frag_tr(Ws, 264, 32 * ks, 32 * w + 16 * nt, lane);
#pragma unroll
                    for (int mt = 0; mt < 3; ++mt) acc[mt][nt] = MFMA16(xn, xm[mt], acc[mt][nt]); } }
#pragma unroll
            for (int nt = 0; nt < 2; ++nt)
#pragma unroll
                for (int q = 0; q < 4; ++q) { const int col = cq * 256 + 32 * w + 16 * nt + 4 * (lane >> 4) + q; const float delta = fabsf(mind + (float)(col % 512) * ((maxd - mind) / 511.f));
#pragma unroll
                    for (int mt = 0; mt < 3; ++mt) { const int pl = 16 * mt + (lane & 15); if (pl < 33) p.FILT[(size_t)col * RB + p0 + pl] = acc[mt][nt][q] * __expf(-tpos[mt] * delta); } }
            __syncthreads();
        }
    }
}

__device__ __forceinline__ float wave_sum(float v) {
#pragma unroll
    for (int o = 1; o < 64; o <<= 1) v += __shfl_xor(v, o);
    return v;
}
__device__ __forceinline__ void ph_ada_fast(const P& p, float* lds) {
    float* sv = lds;
    float* red = lds + 3072;
    const int tid = TIDX;
    __syncthreads();
    for (int i = tid; i < 3 * D; i += NT) { const int j = i / D, k = i % D; sv[i] = siluf(j < 2 ? p.in[1][j * D + k] : p.in[3][k]); }
    __syncthreads();
    for (int u = blockIdx.x; u < 2 * 96; u += gridDim.x) {
        const int l = u / 96, n = (u % 96) * 64 + (tid & 63), ks = tid >> 6;
        const float* w = p.in[4] + (size_t)l * D * 6144 + n;
        float a0 = 0.f, a1 = 0.f, a2 = 0.f;
#pragma unroll 8
        for (int k = ks * 128; k < ks * 128 + 128; ++k) { const float wv = w[(size_t)k * 6144]; a0 += sv[k] * wv; a1 += sv[D + k] * wv; a2 += sv[2 * D + k] * wv; }
        red[(ks * 3 + 0) * 64 + (tid & 63)] = a0; red[(ks * 3 + 1) * 64 + (tid & 63)] = a1; red[(ks * 3 + 2) * 64 + (tid & 63)] = a2;
        __syncthreads();
        if (tid < 192) { const int j = tid >> 6, nl = tid & 63; float s = p.in[5][l * 6144 + (u % 96) * 64 + nl];
#pragma unroll
            for (int q = 0; q < 8; ++q) s += red[(q * 3 + j) * 64 + nl];
            p.MOD[(size_t)(l * 3 + j) * 6144 + (u % 96) * 64 + nl] = s; }
        __syncthreads();
    }
}
__device__ __forceinline__ void ph_hyF_fast(const P& p, const float* a3, float* lds) {
    float* at = lds;
    float* wt = lds + 64 * 65;
    const float mind = logf(1e-2f) / 1.5f, maxd = logf(1e-2f) / 0.3f;
    for (int u = blockIdx.x; u < (RB / 64) * 16; u += gridDim.x) {
        const int tid = TIDX; const int ct = u % 16, pt = u / 16, p0 = pt * 64, c0 = ct * 128;
        __syncthreads();
#pragma unroll
        for (int i = 0; i < 8; ++i) { const int e = tid + 512 * i; at[(e >> 6) * 65 + (e & 63)] = a3[(size_t)(p0 + (e >> 6)) * 64 + (e & 63)]; }
#pragma unroll
        for (int i = 0; i < 16; ++i) { const int e = tid + 512 * i; wt[e] = p.in[19][(size_t)(e >> 7) * 2048 + c0 + (e & 127)]; }
        __syncthreads();
        const int pos = tid & 63, cg = tid >> 6;
        float acc[16];
#pragma unroll
        for (int q = 0; q < 16; ++q) acc[q] = 0.f;
#pragma unroll 4
        for (int m = 0; m < 64; ++m) { const float a = at[pos * 65 + m];
#pragma unroll
            for (int q = 0; q < 16; ++q) acc[q] += a * wt[m * 128 + cg * 16 + q]; }
        int len, i0; hy_pos(p0 + pos, len, i0); const float tt = (float)i0 / (float)(len - 1);
#pragma unroll
        for (int q = 0; q < 16; ++q) { const int col = c0 + cg * 16 + q; const float delta = fabsf(mind + (float)(col % 512) * ((maxd - mind) / 511.f));
            p.FILT[(size_t)col * RB + p0 + pos] = acc[q] * expf(-tt * delta); }
    }
}
__device__ __forceinline__ void ph_retScan_fast(const P& p) {
    bf16_t* ST = p.Zh;
    GSTRIDE(idx, (long)2 * NB * 4 * 16384) {
        const int ed = idx % 16384, h = (idx / 16384) % 4, b = (idx / 65536) % NB, dir = idx / (65536 * NB);
        const float dc = expf((dir ? p.in[10] : p.in[9])[h] * 128.f);
        bf16_t* base = ST + st_idx(dir, b, h, 0) + ed;
        float s = 0.f;
#pragma unroll 1
        for (int c0 = 0; c0 < NCH; c0 += 11) {
            float u[11]; int cc[11];
#pragma unroll
            for (int j = 0; j < 11; ++j) { const int q = c0 + j; cc[j] = dir == 0 ? q : (q < 2 ? 1 - q : NCH + 1 - q); u[j] = bf2f(base[(size_t)cc[j] * 16384]); }
#pragma unroll
            for (int j = 0; j < 11; ++j) { base[(size_t)cc[j] * 16384] = f2bf(s); s = dc * s + u[j]; }
        }
    }
}
__device__ __forceinline__ void ph_glaScan_fast(const P& p) {
    const float* BF = p.BG; const float* BB = p.BG + (size_t)R * 512;
    GSTRIDE(idx, (long)2 * NB * 4 * 32768) {
        const int d = idx % 128, ed = idx % 32768, h = (idx / 32768) % 4, b = (idx / 131072) % NB, dir = idx / (131072 * NB);
        bf16_t* base = p.GST + gst_idx(dir, b, h, 0) + ed;
        float s = 0.f;
#pragma unroll 1
        for (int c0 = 0; c0 < NCH; c0 += 11) {
            float u[11], dcv[11]; int cc[11];
#pragma unroll
            for (int j = 0; j < 11; ++j) { const int q = c0 + j; cc[j] = dir == 0 ? q : (q < 2 ? 1 - q : NCH + 1 - q); const int r0 = chunk_row0(b, cc[j]);
                u[j] = bf2f(base[(size_t)cc[j] * 32768]); dcv[j] = dir == 0 ? BF[(size_t)(r0 + 127) * 512 + h * 128 + d] : BB[(size_t)r0 * 512 + h * 128 + d]; }
#pragma unroll
            for (int j = 0; j < 11; ++j) { base[(size_t)cc[j] * 32768] = f2bf(s); s = __expf(dcv[j]) * s + u[j]; }
        }
    }
}
__device__ __forceinline__ void ph_glagates_fast(const P& p, float* lds) {
    float* lr = lds;
    for (int u = blockIdx.x; u < NB * NCH * 2; u += gridDim.x) {
        const int tid = TIDX; const int dir = u % 2, c = (u / 2) % NCH, b = u / (2 * NCH); const int r0 = chunk_row0(b, c);
        __syncthreads();
        for (int e = tid; e < 128 * 16; e += NT) lr[e] = bf2f(p.Z1[(size_t)(r0 + (e >> 4)) * GINP + 3072 + dir * 16 + (e & 15)]);
        __syncthreads();
        const float* gw = (dir ? p.in[26] : p.in[24]); float g[16];
#pragma unroll
        for (int q = 0; q < 16; ++q) g[q] = gw[q * 512 + tid];
        const float gb = (dir ? p.in[27] : p.in[25])[tid];
        float* out = p.BG + ((size_t)dir * R + r0) * 512 + tid;
        float s = 0.f;
#pragma unroll 4
        for (int ii = 0; ii < 128; ++ii) { const int i = dir ? 127 - ii : ii; float acc = gb;
#pragma unroll
            for (int q = 0; q < 16; ++q) acc += lr[i * 16 + q] * g[q];
            s += logsigf(acc) * (1.f / 16.f); out[(size_t)i * 512] = s; }
    }
}
template <int MODE, bool ROUTE> __device__ __forceinline__ void ph_post_fast(const P& p, int l, int which, const bf16_t* Y, int ln, int wn, int nrows, const float* xl, const float* xc, float* lds) {
    const float* lg = p.in[6] + (size_t)(l * 2 + which) * D; const float* lb = p.in[7] + (size_t)(l * 2 + which) * D;
    const int tid = TIDX, lane = tid & 63, gw = blockIdx.x * (NT / 64) + (tid >> 6), ngw = gridDim.x * (NT / 64);
    int* lcnt = (int*)(lds + D * NE);
    if (ROUTE) { __syncthreads(); for (int e = tid; e < D * NE; e += NT) lds[(e & 15) * D + (e >> 4)] = p.in[29][e]; if (tid < 32) lcnt[tid] = 0; __syncthreads(); }
    int toff[16];
    if (MODE == 1) { int s = 0;
#pragma unroll
        for (int e = 0; e < 16; ++e) { toff[e] = s; s += (p.CNT[l * 16 + e] + 255) >> 8; } }
    f32x4 cg_[4], clg[4], clb[4], csc[4], csh[4]; int cseg = -1;
#pragma unroll
    for (int i = 0; i < 4; ++i) { clg[i] = *(const f32x4*)(lg + 4 * lane + 256 * i); clb[i] = *(const f32x4*)(lb + 4 * lane + 256 * i); }
    f32x4 xr[4]; u2v ya[4], yb[4];
#define POST_LOAD(rr) do { const int r_ = (rr); const float* x_ = r_ < RL ? xl + (size_t)r_ * D : xc + (size_t)(r_ - RL) * D; const bf16_t *y0_, *y1_ = nullptr; \
        if (MODE == 0) y0_ = Y + (size_t)r_ * D; \
        else { int sr_[2]; _Pragma("unroll") for (int k_ = 0; k_ < 2; ++k_) { const int e_ = p.RE[r_ * 2 + k_]; int to_ = 0; _Pragma("unroll") for (int q_ = 0; q_ < 16; ++q_) to_ = (q_ == e_) ? toff[q_] : to_; sr_[k_] = to_ * 256 + p.RPOS[r_ * 2 + k_]; } \
               y0_ = p.slots + (size_t)sr_[0] * D; y1_ = p.slots + (size_t)sr_[1] * D; } \
        _Pragma("unroll") for (int i_ = 0; i_ < 4; ++i_) { const int k_ = 4 * lane + 256 * i_; xr[i_] = *(const f32x4*)(x_ + k_); ya[i_] = *(const u2v*)(y0_ + k_); if (MODE == 1) yb[i_] = *(const u2v*)(y1_ + k_); } } while (0)
    if (gw < nrows) POST_LOAD(gw);
    for (int r = gw; r < nrows; r += ngw) {
        float* xo = xrow(p, r);
        if (seg_of(r) != cseg) { cseg = seg_of(r);
#pragma unroll
            for (int i = 0; i < 4; ++i) { const int k = 4 * lane + 256 * i; cg_[i] = *(const f32x4*)(modv(p, l, r, which * 3 + 2) + k);
                if (ln >= 0) { csc[i] = *(const f32x4*)(modv(p, ln, r, wn * 3 + 1) + k); csh[i] = *(const f32x4*)(modv(p, ln, r, wn * 3 + 0) + k); } } }
        f32x4 v[4]; float s = 0.f;
#pragma unroll
        for (int i = 0; i < 4; ++i) { const u2v yu = ya[i]; f32x4 yy = {__uint_as_float(yu.x << 16), __uint_as_float(yu.x & 0xffff0000u), __uint_as_float(yu.y << 16), __uint_as_float(yu.y & 0xffff0000u)};
            if (MODE == 1) { const u2v y2 = yb[i]; yy += (f32x4){__uint_as_float(y2.x << 16), __uint_as_float(y2.x & 0xffff0000u), __uint_as_float(y2.y << 16), __uint_as_float(y2.y & 0xffff0000u)}; }
            v[i] = xr[i] * ALPHA + cg_[i] * yy; s += (v[i][0] + v[i][1]) + (v[i][2] + v[i][3]); }
        if (r + ngw < nrows) POST_LOAD(r + ngw);
        const float mu = wave_sum(s) * (1.f / D); float q2 = 0.f;
#pragma unroll
        for (int i = 0; i < 4; ++i) { v[i] = v[i] - mu; q2 += (v[i][0] * v[i][0] + v[i][1] * v[i][1]) + (v[i][2] * v[i][2] + v[i][3] * v[i][3]); }
        const float rs = 1.f / sqrtf(wave_sum(q2) * (1.f / D) + LN_EPS);
        f32x4 hk[4];
#pragma unroll
        for (int i = 0; i < 4; ++i) { const int k = 4 * lane + 256 * i; const f32x4 xn = v[i] * rs * clg[i] + clb[i];
            *(f32x4*)(xo + k) = xn;
            if (ln >= 0) { const f32x4 h2 = xn * (csc[i] + 1.f) + csh[i];
                u2v o; o.x = pk_bf16(h2[0], h2[1]); o.y = pk_bf16(h2[2], h2[3]); *(u2v*)(p.H + (size_t)r * D + k) = o;
                if (ROUTE) hk[i] = h2; } }
        if (ROUTE) {
            float pl[16];
#pragma unroll
            for (int e = 0; e < 16; ++e) { const float* wr = lds + e * D + 4 * lane; float a = 0.f;
#pragma unroll
                for (int i = 0; i < 4; ++i) { const f32x4 wv = *(const f32x4*)(wr + 256 * i); a += (hk[i][0] * wv[0] + hk[i][1] * wv[1]) + (hk[i][2] * wv[2] + hk[i][3] * wv[3]); }
                pl[e] = a; }
            float r8[8], r4[4], r2[2];
            { const bool up = (lane & 32) != 0;
#pragma unroll
              for (int q = 0; q < 8; ++q) { const float keep = up ? pl[8 + q] : pl[q], send = up ? pl[q] : pl[8 + q]; r8[q] = keep + __shfl_xor(send, 32); } }
            { const bool up = (lane & 16) != 0;
#pragma unroll
              for (int q = 0; q < 4; ++q) { const float keep = up ? r8[4 + q] : r8[q], send = up ? r8[q] : r8[4 + q]; r4[q] = keep + __shfl_xor(send, 16); } }
            { const bool up = (lane & 8) != 0;
#pragma unroll
              for (int q = 0; q < 2; ++q) { const float keep = up ? r4[2 + q] : r4[q], send = up ? r4[q] : r4[2 + q]; r2[q] = keep + __shfl_xor(send, 8); } }
            float r1;
            { const bool up = (lane & 4) != 0; const float keep = up ? r2[1] : r2[0], send = up ? r2[0] : r2[1]; r1 = keep + __shfl_xor(send, 4); }
            r1 += __shfl_xor(r1, 2); r1 += __shfl_xor(r1, 1);
            const float sgm = sigmf(r1);
            int best = 0, i1 = 0, i2 = 0; float bs = -1e30f, a1 = 0.f, a2 = 0.f;
#pragma unroll
            for (int g = 0; g < NG; ++g) {
                float sg[4], sel[4];
#pragma unroll
                for (int q = 0; q < 4; ++q) { const int e = g * EPG + q; const int src = ((e >> 3) & 1) * 32 + ((e >> 2) & 1) * 16 + ((e >> 1) & 1) * 8 + (e & 1) * 4;
                    sg[q] = __int_as_float(__builtin_amdgcn_readlane(__float_as_int(sgm), src)); sel[q] = sg[q] + p.in[30][e]; }
                int j1 = 0; float v1 = sel[0];
#pragma unroll
                for (int q = 1; q < 4; ++q) if (sel[q] > v1) { v1 = sel[q]; j1 = q; }
                int j2 = -1; float v2 = -1e30f;
#pragma unroll
                for (int q = 0; q < 4; ++q) if (q != j1 && sel[q] > v2) { v2 = sel[q]; j2 = q; }
                if (v1 + v2 > bs) { bs = v1 + v2; best = g; i1 = j1; i2 = j2; a1 = 0.f; a2 = 0.f;
#pragma unroll
                    for (int q = 0; q < 4; ++q) { a1 = (q == j1) ? sg[q] : a1; a2 = (q == j2) ? sg[q] : a2; } }
            }
            if (lane == 0) { const int e1 = best * EPG + i1, e2 = best * EPG + i2;
                p.RE[r * 2] = e1; p.RE[r * 2 + 1] = e2; p.RWt[r * 2] = a1 / (a1 + a2); p.RWt[r * 2 + 1] = a2 / (a1 + a2);
                p.RPOS[r * 2] = atomicAdd(&lcnt[e1], 1); p.RPOS[r * 2 + 1] = atomicAdd(&lcnt[e2], 1); }
        }
    }
    if (ROUTE) {
        __syncthreads();
        if (tid < 16) lcnt[16 + tid] = atomicAdd(&p.CNT[l * 16 + tid], lcnt[tid]);
        __syncthreads();
        for (int r = gw + lane * ngw; r < nrows; r += 64 * ngw) {
#pragma unroll
            for (int k = 0; k < 2; ++k) p.RPOS[r * 2 + k] += lcnt[16 + p.RE[r * 2 + k]];
        }
    }
}
#undef POST_LOAD

constexpr int N_STEPS = 34;
#define PG8_ALIGN true
#define PG8_SP2 true
template <class Epi> __device__ __forceinline__ void dense_gemm(LAS unsigned char* lds, const bf16_t* A, const bf16_t* Bt, int M, int N, int K, const Epi& E) {
    pg8::Gemm g{A, Bt, M, N, K}; pg8::StaticOrder S; S.init(M, N, (int)gridDim.x, (int)blockIdx.x);
    pg8::gemm_phase<Epi, pg8::StaticOrder, PG8_ALIGN, PG8_SP2>(lds, g, S, E);
}
__device__ __forceinline__ void moe_gemms(const P& p, LAS unsigned char* lds, int l, int which) {
    pg8::MoeOrder S; S.init(p.CNT + l * 16, (int)gridDim.x, (int)blockIdx.x);
    if (which == 0) { pg8::Gemm g{p.Hs, p.Wgu, 0, 0, 1024}; pg8::EpiSwiGLU E{p.he}; pg8::gemm_phase<pg8::EpiSwiGLU, pg8::MoeOrder, PG8_ALIGN, PG8_SP2>(lds, g, S, E); }
    else { pg8::Gemm g{p.he, p.Wd, 0, 0, 512}; pg8::EpiRowScale E{p.slots, p.WS}; pg8::gemm_phase<pg8::EpiRowScale, pg8::MoeOrder, PG8_ALIGN, PG8_SP2>(lds, g, S, E); }
}
__device__ __forceinline__ void run_step(const P& p, int step, unsigned char* smem) {
    LAS unsigned char* lds = (LAS unsigned char*)smem; float* fl = (float*)smem;
    float* conv = (float*)p.H;
    switch (step) {
        case 0: ph_ada_fast(p, fl); ph_rope_table(p); ph_wconv_l0(p, fl); if (gridDim.x != 256) ph_wconv_moe_fast(p, 0, fl); break;
        case 1: ph_mod_fast(p, 0, 0, p.in[0], p.in[2]); ph_filters(p, smem); break;
        case 2: { pg8::EpiInL0 E{p.Zr, p.hyT, p.A2, RL, L, CTX, RB}; dense_gemm(lds, p.H, p.Win0, R, ABIN, D, E); }
                 if (gridDim.x == 256) ph_wconv_moe_part(p, 0, 1, fl, (int)blockIdx.x - 156, 100); break;
        case 3: break;
        case 4: ph_retU_mfma(p, smem); ph_hyena_fft(p, smem); break;
        case 5: ph_retScan_fast(p); break;
        case 6: break;
        case 7: break;
        case 8: break;
        case 9: ph_retO_mfma(p, smem); ph_hy_untranspose_fast(p, fl); break;
        case 10: ph_hy_untranspose_fast(p, fl); break;
        case 11: { pg8::EpiSplit E{p.Zr, 1024, p.Zr, 1024, 1 << 30}; dense_gemm(lds, p.H, p.Wout0, R, D, D, E); }
                 if (gridDim.x == 256) ph_wconv_moe_part(p, 0, 0, fl, (int)blockIdx.x - 8, 248); break;
        case 12: ph_post_fast<0, true>(p, 0, 0, p.Zr, 0, 1, R, p.in[0], p.in[2], fl); break;
        case 13: break;
        case 14: break;
        case 15: ph_permute(p, 0, R); break;
        case 16: moe_gemms(p, lds, 0, 0); break;
        case 17: moe_gemms(p, lds, 0, 1); ph_wconv_l1(p, fl); break;
        case 18: ph_post_fast<1, false>(p, 0, 1, nullptr, 1, 0, R, p.out, p.Xc, fl); break;
        case 19: { pg8::EpiSplit E{p.Z1, GINP, p.Z1, GINP, 1 << 30}; dense_gemm(lds, p.H, p.Win1, R, GINP, D, E); } ph_wconv_moe_fast(p, 1, fl); break;
        case 20: break;
        case 21: break;
        case 22: ph_glaU_mfma(p, smem); break;
        case 23: ph_glaScan_fast(p); break;
        case 24: ph_glaO_mfma(p, smem); break;
        case 25: break;
        case 26: { pg8::EpiSplit E{p.Zr, 1024, p.Zr, 1024, 1 << 30}; dense_gemm(lds, p.H, p.Wout1, RL, D, D, E); } break;
        case 27: ph_post_fast<0, true>(p, 1, 0, p.Zr, 1, 1, RL, p.out, p.Xc, fl); break;
        case 28: break;
        case 29: break;
        case 30: ph_permute(p, 1, RL); break;
        case 31: moe_gemms(p, lds, 1, 0); break;
        case 32: moe_gemms(p, lds, 1, 1); break;
        case 33: ph_post_fast<1, false>(p, 1, 1, nullptr, -1, 0, RL, p.out, p.Xc, fl); break;
    }
}
__global__ void __launch_bounds__(NT, 2) k_all(P p) {
    extern __shared__ __attribute__((aligned(16))) unsigned char smem[];
    cg::grid_group grid = cg::this_grid();
    volatile LAS unsigned* bst = (volatile LAS unsigned*)((LAS unsigned char*)smem + LDS_BYTES - 64);
    if (threadIdx.x < 2) bst[threadIdx.x] = 0u;
    __syncthreads();
    const XcdBarrier bar = xcd_barrier_post(p.BAR, bst);
#define STEP(n) run_step(p, n, smem); xcd_barrier(bar);
#define STEP_CG(n) run_step(p, n, smem); asm volatile("s_waitcnt vmcnt(0)" ::: "memory"); grid.sync();
    STEP_CG(0) STEP(1) STEP(2) STEP(4) STEP(5) STEP(9) STEP(11) STEP(12) STEP(15) STEP(16)
    STEP(17) STEP(18) STEP(19) STEP(22) STEP(23) STEP(24) STEP(26) STEP(27) STEP(30) STEP(31) STEP(32) run_step(p, 33, smem);
#undef STEP
#undef STEP_CG
}

extern "C" void kernel_launch(void* const* d_in, const int* in_sizes, int n_in, void* d_out, int out_size, void* d_ws, size_t ws_size, hipStream_t stream) {
    P p{};
    for (int i = 0; i < 34; ++i) p.in[i] = (const float*)d_in[i];
    p.out = (float*)d_out;
    unsigned char* w = (unsigned char*)d_ws; size_t off = 0;
    auto take = [&](size_t bytes) { unsigned char* r = w + off; off += (bytes + 255) & ~(size_t)255; return r; };
    p.NORM = (float*)take(2 * 2048 * 4); p.CNT = (int*)take(2 * 16 * 4); p.BAR = (unsigned*)take(XCD_BAR_WORDS * 4);
    const size_t ctl_bytes = off;
    p.Win1 = (bf16_t*)take((size_t)GINP * D * 2); p.Wout1 = (bf16_t*)take((size_t)D * D * 2);
    p.Wgu = (bf16_t*)take((size_t)NE * 1024 * 1024 * 2); p.Wd = (bf16_t*)take((size_t)NE * 1024 * 512 * 2);
    p.Xc = (float*)take((size_t)RCX * D * 4); p.MOD = (float*)take(2 * 3 * 6144 * 4);
    p.RS = (float*)take((size_t)R * NE * 4); p.RE = (int*)take((size_t)R * 2 * 4); p.RPOS = (int*)take((size_t)R * 2 * 4); p.RWt = (float*)take((size_t)R * 2 * 4);
    p.WS = (float*)take((size_t)MOE_ROWS * 4);
    const size_t big = off;
    p.H = (bf16_t*)take((size_t)R * D * 2);
    p.Zr = (bf16_t*)take((size_t)R * 2048 * 2);
    p.Zh = (bf16_t*)take((size_t)R * 1536 * 2);
    p.hyT = (bf16_t*)take((size_t)NB * 3 * 512 * RB * 2);
    p.FILT = (float*)take((size_t)2048 * RB * 4);
    p.Win0 = (bf16_t*)take((size_t)ABIN * D * 2); p.Wout0 = (bf16_t*)take((size_t)D * D * 2);
    p.A1 = (float*)take((size_t)RB * 64 * 4); p.A2 = (float*)take((size_t)RB * 64 * 4);
    const size_t total = off;
    off = big + (((size_t)R * D * 2 + 255) & ~(size_t)255);
    p.Hs = (bf16_t*)take((size_t)MOE_ROWS * D * 2); p.he = (bf16_t*)take((size_t)MOE_ROWS * EH * 2); p.slots = (bf16_t*)take((size_t)MOE_ROWS * D * 2);
    const size_t moe_end = off;
    off = big + (((size_t)R * D * 2 + 255) & ~(size_t)255);
    p.Z1 = (bf16_t*)take((size_t)R * GINP * 2); p.BG = (float*)take((size_t)2 * R * 512 * 4); p.GST = (bf16_t*)take((size_t)2 * NB * 4 * NCH * 32768 * 2);
    const size_t l1_end = off;
    if (total > ws_size || moe_end > total || l1_end > total || n_in != 34 || out_size != RL * D) {
        fprintf(stderr, "kernel_launch: bad sizes (need %zu ws bytes, have %zu; moe_end %zu l1_end %zu)\n", total, ws_size, moe_end, l1_end); return; }
    static int grid = 0;
    if (!grid) {
        int dev = 0, cus = 0, per = 0; hipGetDevice(&dev); hipDeviceGetAttribute(&cus, hipDeviceAttributeMultiprocessorCount, dev);
        hipFuncSetAttribute((const void*)k_all, hipFuncAttributeMaxDynamicSharedMemorySize, LDS_BYTES);
        hipOccupancyMaxActiveBlocksPerMultiprocessor(&per, k_all, NT, LDS_BYTES);
        if (per < 1) { fprintf(stderr, "kernel_launch: occupancy query says %d blocks per CU\n", per); per = 1; }
        grid = cus < 256 ? cus : 256;
    }
    hipMemsetAsync(d_ws, 0, ctl_bytes, stream);
    void* args[] = {&p};
    hipError_t e = hipLaunchCooperativeKernel((void*)k_all, dim3(grid), dim3(NT), args, LDS_BYTES, stream);
    if (e != hipSuccess) fprintf(stderr, "coop launch failed: %s (grid %d)\n", hipGetErrorString(e), grid);
}
```

```cpp
#include <hip/hip_runtime.h>
#include <hip/hip_cooperative_groups.h>
#include <cstdio>
#include <cstdint>
namespace cg = cooperative_groups;


namespace pg8 {
#define PG8_LAS __attribute__((address_space(3)))
typedef unsigned short bf16_t;
typedef short bf16x8 __attribute__((ext_vector_type(8)));
typedef float f32x4 __attribute__((ext_vector_type(4)));
typedef unsigned u32x4 __attribute__((ext_vector_type(4)));
constexpr int BM = 256, BK = 64, HALF = 128, HTB = HALF * BK * 2  , STAGE_BYTES = 8 * HTB, NXCD = 8, WGM = 8;

__host__ __device__ __forceinline__ int lds_byte(int r, int c) { const int st = (r >> 4) * 2 + (c >> 5), rr = r & 15, cc = c & 31, ob = rr * 64 + cc * 2; return st * 1024 + (ob ^ (((ob >> 9) & 1) << 5)); }
__host__ __device__ __forceinline__ void stage_rc(int b, int& R, int& C) { const int st = b / 1024, sb = b % 1024, swz = sb ^ (((sb >> 9) & 1) << 5); R = (st >> 1) * 16 + swz / 64; C = (st & 1) * 32 + (swz % 64) / 2; }
__host__ __device__ __forceinline__ int perm32(int rho) { const int n = rho >> 4, i = rho & 15; return 8 * (i >> 2) + 4 * n + (i & 3); }

struct Unit { int pm, pn; };
struct Gemm { const bf16_t* A; const bf16_t* Bt; int M, N, K; };

struct StaticOrder {
    int nM, nN, nwg, G, c;
    __host__ __device__ void init(int M, int N, int G_, int c_) { nM = M / BM; nN = N / BM; nwg = nM * nN; G = G_; c = c_; }
    __host__ __device__ bool next(int i, Unit& u) const {
        const long L = (long)i * G + c; if (L >= nwg) return false;
        int wgid = (int)L; { const int q = nwg / NXCD, r = nwg % NXCD, xcd = wgid % NXCD, off = wgid / NXCD; wgid = (xcd < r ? xcd * (q + 1) : r * (q + 1) + (xcd - r) * q) + off; }
        const int nig = WGM * nN, gid = wgid / nig, fm = gid * WGM, gsz = (nM - fm) < WGM ? (nM - fm) : WGM;
        u.pm = fm + ((wgid % nig) % gsz); u.pn = (wgid % nig) / gsz; return true;
    }
    __device__ __forceinline__ void a_ready(const Unit&) const {}
    __device__ __forceinline__ void done(const Unit&) const {}
};


__device__ __forceinline__ unsigned cvt_pk_bf16(float lo, float hi) { unsigned r; asm volatile("v_cvt_pk_bf16_f32 %0, %1, %2" : "=v"(r) : "v"(lo), "v"(hi)); return r; }

template <class Epi, class Sched, bool ALIGN_EPI = false, bool SP2 = false>
__device__ __forceinline__ void gemm_phase(PG8_LAS unsigned char* lds, const Gemm g, const Sched& S, const Epi& E) {
    int tid_l = threadIdx.x; asm volatile("" : "+v"(tid_l)); const int tid = tid_l, wid = __builtin_amdgcn_readfirstlane(tid >> 6), lane = tid & 63, wr = wid >> 2, wc = wid & 3, fr = lane & 15, fq = lane >> 4;
    const int K = g.K, nt = K / BK;
    unsigned voffA[2], voffB[2];
#pragma unroll
    for (int i = 0; i < 2; ++i) { int R, C; stage_rc(tid * 16 + i * 8192, R, C); const int Rb = Epi::PERM ? ((R & ~31) + perm32(R & 31)) : R;
        voffA[i] = (unsigned)(R * K + C) * 2u; voffB[i] = (unsigned)(Rb * K + C) * 2u; }
    const size_t kstep = (size_t)(BK * 2);
    const size_t hstep = (size_t)HALF * K * 2;
    const size_t tstep = 2 * hstep;
    const unsigned ldsw = (unsigned)wid * 1024u;
    const int aoff = lds_byte(wr * 64 + fr, fq * 8), boff = lds_byte(wc * 32 + fr, fq * 8);
#define PG8_SA(b, h) (((b) * 2 + (h)) * HTB)
#define PG8_SB(b, h) ((4 + (b) * 2 + (h)) * HTB)
#define PG8_STAGE(bufoff, gbase, voff) do { _Pragma("unroll") for (int _i = 0; _i < 2; ++_i) \
        __builtin_amdgcn_global_load_lds((const unsigned*)((const char*)(gbase) + (voff)[_i]), (PG8_LAS unsigned*)(lds + (bufoff) + ldsw + _i * 8192), 16, 0, 0); } while (0)
#define PG8_LDA(dst, b, h) do { _Pragma("unroll") for (int m = 0; m < 4; ++m) _Pragma("unroll") for (int k = 0; k < 2; ++k) dst[m][k] = *(const PG8_LAS bf16x8*)(lds + PG8_SA(b, h) + aoff + m * 2048 + k * 1024); } while (0)
#define PG8_LDB(dst, b, h) do { _Pragma("unroll") for (int n = 0; n < 2; ++n) _Pragma("unroll") for (int k = 0; k < 2; ++k) dst[n][k] = *(const PG8_LAS bf16x8*)(lds + PG8_SB(b, h) + boff + n * 2048 + k * 1024); } while (0)
#define PG8_MMA(ai, bj, At, Bt) do { __builtin_amdgcn_s_setprio(1); _Pragma("unroll") for (int m = 0; m < 4; ++m) _Pragma("unroll") for (int n = 0; n < 2; ++n) _Pragma("unroll") for (int k = 0; k < 2; ++k) \
        acc[ai][bj][m][n] = __builtin_amdgcn_mfma_f32_16x16x32_bf16(Bt[n][k], At[m][k], acc[ai][bj][m][n], 0, 0, 0); __builtin_amdgcn_s_setprio(0); } while (0)
#define PG8_WAIT_V(n) asm volatile("s_waitcnt vmcnt(" #n ")" ::: "memory")
#define PG8_WAIT_L(n) asm volatile("s_waitcnt lgkmcnt(" #n ")" ::: "memory")
#define PG8_BAR __builtin_amdgcn_s_barrier()
#define PG8_SCHED __builtin_amdgcn_sched_barrier(0)
    Unit cur, nxt; int ui = 0;
    if (!S.next(0, cur)) return;
    f32x4 acc[2][2][4][2];
#pragma unroll
    for (int a = 0; a < 2; ++a)
#pragma unroll
        for (int b = 0; b < 2; ++b)
#pragma unroll
            for (int m = 0; m < 4; ++m)
#pragma unroll
                for (int n = 0; n < 2; ++n) acc[a][b][m][n] = (f32x4){0.f, 0.f, 0.f, 0.f};
    bf16x8 At[4][2], B0[2][2], B1[2][2];
    const char* cA = (const char*)g.A + (size_t)cur.pm * tstep; const char* cB = (const char*)g.Bt + (size_t)cur.pn * tstep;
    S.a_ready(cur);
    if constexpr (SP2) {
        PG8_STAGE(PG8_SB(0, 0), cB, voffB); PG8_STAGE(PG8_SB(0, 1), cB + hstep, voffB); PG8_STAGE(PG8_SA(0, 0), cA, voffA); PG8_STAGE(PG8_SA(0, 1), cA + hstep, voffA);
        if (wr == 1) PG8_BAR;
        PG8_WAIT_V(2); PG8_BAR;
        PG8_STAGE(PG8_SB(1, 0), cB + kstep, voffB); PG8_STAGE(PG8_SA(1, 0), cA + kstep, voffA); PG8_STAGE(PG8_SB(1, 1), cB + hstep + kstep, voffB);
        PG8_WAIT_V(6); PG8_BAR;
    } else {
        PG8_STAGE(PG8_SB(0, 0), cB, voffB); PG8_STAGE(PG8_SA(0, 0), cA, voffA); PG8_STAGE(PG8_SB(0, 1), cB + hstep, voffB); PG8_STAGE(PG8_SA(0, 1), cA + hstep, voffA);
        if (wr == 1) PG8_BAR;
        PG8_WAIT_V(4); PG8_BAR;
        PG8_STAGE(PG8_SB(1, 0), cB + kstep, voffB); PG8_STAGE(PG8_SA(1, 0), cA + kstep, voffA); PG8_STAGE(PG8_SB(1, 1), cB + hstep + kstep, voffB);
        PG8_WAIT_V(6); PG8_BAR;
    }
    for (;;) {
        const bool has_next = S.next(ui + 1, nxt);
        const char* nA = has_next ? (const char*)g.A + (size_t)nxt.pm * tstep : cA; const char* nB = has_next ? (const char*)g.Bt + (size_t)nxt.pn * tstep : cB;
        for (int t = 0; t < nt; t += 2) {
            const bool last = (t == nt - 2);
            const char* a1 = cA + (size_t)(t + 1) * kstep;
            const char* a2 = last ? nA : cA + (size_t)(t + 2) * kstep; const char* b2 = last ? nB : cB + (size_t)(t + 2) * kstep;
            const char* a3 = a2 + kstep; const char* b3 = b2 + kstep;
            if (last && has_next) S.a_ready(nxt);
            if constexpr (SP2) {
            PG8_LDB(B0, 0, 0); PG8_LDB(B1, 0, 1); PG8_SCHED; PG8_LDA(At, 0, 0); PG8_STAGE(PG8_SA(1, 1), a1 + hstep, voffA);
            PG8_WAIT_V(8); PG8_WAIT_L(0); PG8_BAR; PG8_MMA(0, 0, At, B0); PG8_MMA(0, 1, At, B1); PG8_BAR; PG8_SCHED;
            PG8_LDA(At, 0, 1); PG8_STAGE(PG8_SB(0, 0), b2, voffB); PG8_STAGE(PG8_SB(0, 1), b2 + hstep, voffB); PG8_STAGE(PG8_SA(0, 0), a2, voffA);
            PG8_WAIT_V(8); PG8_WAIT_L(0); PG8_BAR; PG8_MMA(1, 0, At, B0); PG8_MMA(1, 1, At, B1); PG8_BAR; PG8_SCHED;
            PG8_LDB(B0, 1, 0); PG8_LDB(B1, 1, 1); PG8_SCHED; PG8_LDA(At, 1, 0); PG8_STAGE(PG8_SA(0, 1), a2 + hstep, voffA);
            PG8_WAIT_V(8); PG8_WAIT_L(0); PG8_BAR; PG8_MMA(0, 0, At, B0); PG8_MMA(0, 1, At, B1); PG8_BAR; PG8_SCHED;
            PG8_LDA(At, 1, 1); PG8_STAGE(PG8_SB(1, 0), b3, voffB); PG8_STAGE(PG8_SB(1, 1), b3 + hstep, voffB); PG8_STAGE(PG8_SA(1, 0), a3, voffA);
            PG8_WAIT_V(8); PG8_WAIT_L(0); PG8_BAR; PG8_MMA(1, 0, At, B0); PG8_MMA(1, 1, At, B1); PG8_BAR; PG8_SCHED;
            } else {
            PG8_LDB(B0, 0, 0); PG8_SCHED; PG8_LDA(At, 0, 0); PG8_STAGE(PG8_SA(1, 1), a1 + hstep, voffA);
            PG8_WAIT_L(8); PG8_BAR; PG8_WAIT_L(0); PG8_MMA(0, 0, At, B0); PG8_BAR; PG8_SCHED;
            PG8_LDB(B1, 0, 1); PG8_STAGE(PG8_SB(0, 0), b2, voffB);
            PG8_BAR; PG8_WAIT_L(0); PG8_MMA(0, 1, At, B1); PG8_BAR;
            PG8_LDA(At, 0, 1); PG8_STAGE(PG8_SA(0, 0), a2, voffA);
            PG8_BAR; PG8_WAIT_L(0); PG8_MMA(1, 0, At, B0); PG8_BAR; PG8_SCHED;
            PG8_STAGE(PG8_SB(0, 1), b2 + hstep, voffB);
            PG8_WAIT_V(6); PG8_BAR; PG8_MMA(1, 1, At, B1); PG8_BAR;
            PG8_LDB(B0, 1, 0); PG8_SCHED; PG8_LDA(At, 1, 0); PG8_STAGE(PG8_SA(0, 1), a2 + hstep, voffA);
            PG8_WAIT_L(8); PG8_BAR; PG8_WAIT_L(0); PG8_MMA(0, 0, At, B0); PG8_BAR; PG8_SCHED;
            PG8_LDB(B1, 1, 1); PG8_STAGE(PG8_SB(1, 0), b3, voffB);
            PG8_BAR; PG8_WAIT_L(0); PG8_MMA(0, 1, At, B1); PG8_BAR;
            PG8_LDA(At, 1, 1); PG8_STAGE(PG8_SA(1, 0), a3, voffA);
            PG8_BAR; PG8_WAIT_L(0); PG8_MMA(1, 0, At, B0); PG8_BAR; PG8_SCHED;
            PG8_STAGE(PG8_SB(1, 1), b3 + hstep, voffB);
            PG8_WAIT_V(6); PG8_BAR; PG8_MMA(1, 1, At, B1); PG8_BAR;
            }
        }
        if constexpr (ALIGN_EPI) { if (wr == 0) PG8_BAR; }
        if constexpr (!Epi::AFTER_DRAIN) { E(acc, cur, wr, wc, fr, fq); S.done(cur); }
        if (!has_next) break;
#pragma unroll
        for (int a = 0; a < 2; ++a)
#pragma unroll
            for (int b = 0; b < 2; ++b)
#pragma unroll
                for (int m = 0; m < 4; ++m)
#pragma unroll
                    for (int n = 0; n < 2; ++n) acc[a][b][m][n] = (f32x4){0.f, 0.f, 0.f, 0.f};
        cur = nxt; cA = nA; cB = nB; ++ui;
        if constexpr (ALIGN_EPI) { if (wr == 1) PG8_BAR; }
    }
    PG8_WAIT_V(0);
    if constexpr (!ALIGN_EPI) { if (wr == 0) PG8_BAR; }
    PG8_BAR;
    if constexpr (Epi::AFTER_DRAIN) { E.fused(acc, cur, wr, wc, fr, fq, lds, wid, lane); S.done(cur); }
#undef PG8_SA
#undef PG8_SB
#undef PG8_STAGE
#undef PG8_LDA
#undef PG8_LDB
#undef PG8_MMA
#undef PG8_WAIT_V
#undef PG8_WAIT_L
#undef PG8_BAR
#undef PG8_SCHED
}
}

typedef float f2v_t __attribute__((ext_vector_type(2)));
typedef __bf16 b2v_t __attribute__((ext_vector_type(2)));
__device__ __forceinline__ unsigned pk_bf16(float lo, float hi) { const f2v_t f = {lo, hi}; const b2v_t b = __builtin_convertvector(f, b2v_t); return __builtin_bit_cast(unsigned, b); }
namespace pg8 {
typedef unsigned u32x2 __attribute__((ext_vector_type(2)));
struct EpiSplit {
    static constexpr bool PERM = true, AFTER_DRAIN = false;
    bf16_t* O0; int ld0; bf16_t* O1; int ld1; int split_col;
    __device__ __forceinline__ void operator()(const f32x4 (&acc)[2][2][4][2], const Unit& u, int wr, int wc, int fr, int fq) const {
        const int row0 = u.pm * BM + wr * 64 + fr; int colt = u.pn * BM; bf16_t* base = O0; int ldc = ld0;
        if (colt >= split_col) { base = O1; ldc = ld1; colt -= split_col; }
        const int col0 = colt + wc * 32 + 8 * fq;
#pragma unroll
        for (int ai = 0; ai < 2; ++ai)
#pragma unroll
            for (int m = 0; m < 4; ++m) { bf16_t* rowp = base + (size_t)(row0 + ai * HALF + m * 16) * ldc + col0;
#pragma unroll
                for (int bj = 0; bj < 2; ++bj) { const f32x4 v0 = acc[ai][bj][m][0], v1 = acc[ai][bj][m][1];
                    u32x4 w; w.x = ::pk_bf16(v0[0], v0[1]); w.y = ::pk_bf16(v0[2], v0[3]); w.z = ::pk_bf16(v1[0], v1[1]); w.w = ::pk_bf16(v1[2], v1[3]);
                    *(u32x4*)(rowp + bj * HALF) = w; } }
    }
};
struct EpiInL0 {
    static constexpr bool PERM = true, AFTER_DRAIN = false;
    bf16_t* Zr; bf16_t* hyT; const float* tab; int RLv, Lv, CTXv, RBv;
    __device__ __forceinline__ void operator()(const f32x4 (&acc)[2][2][4][2], const Unit& u, int wr, int wc, int fr, int fq) const {
        const int rowbase = u.pm * BM, colt = u.pn * BM;
        if (colt < 2048) {
            const int col0 = colt + wc * 32 + 8 * fq; const bool rot = colt < 1024; const int pp0 = wc * 16 + 4 * fq;
#pragma unroll
            for (int ai = 0; ai < 2; ++ai)
#pragma unroll
                for (int m = 0; m < 4; ++m) { const int row = rowbase + wr * 64 + fr + ai * HALF + m * 16; bf16_t* rowp = Zr + (size_t)row * 2048 + col0;
                    const int t = row % Lv; const int prow = t >> 6, pcol = t & 63; const bool lat = row < RLv;
#pragma unroll
                    for (int bj = 0; bj < 2; ++bj) { f32x4 v0 = acc[ai][bj][m][0], v1 = acc[ai][bj][m][1];
                        if (rot) {
#pragma unroll
                            for (int pr = 0; pr < 4; ++pr) { const int pp = pp0 + pr; const int pos = pp < 32 ? prow : pcol; const float cs_ = tab[(pos * 32 + (pp & 31)) * 2], sn_ = tab[(pos * 32 + (pp & 31)) * 2 + 1];
                                const float cs = lat ? cs_ : 1.f, sn = lat ? sn_ : 0.f;
                                if (pr < 2) { const float x1 = v0[2 * pr], x2 = v0[2 * pr + 1]; v0[2 * pr] = x1 * cs - x2 * sn; v0[2 * pr + 1] = x1 * sn + x2 * cs; }
                                else { const float x1 = v1[2 * pr - 4], x2 = v1[2 * pr - 3]; v1[2 * pr - 4] = x1 * cs - x2 * sn; v1[2 * pr - 3] = x1 * sn + x2 * cs; } } }
                        u32x4 w; w.x = ::pk_bf16(v0[0], v0[1]); w.y = ::pk_bf16(v0[2], v0[3]); w.z = ::pk_bf16(v1[0], v1[1]); w.w = ::pk_bf16(v1[2], v1[3]);
                        *(u32x4*)(rowp + bj * HALF) = w; } }
        } else {
            const int hc0 = colt - 2048 + wc * 32 + 8 * fq;
            int b, tlb; if (rowbase < RLv) { b = rowbase / Lv; tlb = rowbase % Lv; } else { b = (rowbase - RLv) / CTXv; tlb = Lv + (rowbase - RLv) % CTXv; }
#pragma unroll
            for (int ai = 0; ai < 2; ++ai)
#pragma unroll
                for (int m = 0; m < 4; ++m) { const int tl = tlb + wr * 64 + fr + ai * HALF + m * 16;
#pragma unroll
                    for (int bj = 0; bj < 2; ++bj) { const f32x4 v0 = acc[ai][bj][m][0], v1 = acc[ai][bj][m][1];
                        bf16_t* o = hyT + ((size_t)b * 1536 + hc0 + bj * HALF) * RBv + tl;
#pragma unroll
                        for (int q = 0; q < 4; ++q) { o[(size_t)q * RBv] = (bf16_t)(::pk_bf16(v0[q], 0.f) & 0xffffu); o[(size_t)(q + 4) * RBv] = (bf16_t)(::pk_bf16(v1[q], 0.f) & 0xffffu); } } }
        }
    }
};
struct EpiSwiGLU {
    static constexpr bool PERM = true, AFTER_DRAIN = false;
    bf16_t* O;
    __device__ __forceinline__ void operator()(const f32x4 (&acc)[2][2][4][2], const Unit& u, int wr, int wc, int fr, int fq) const {
        const int row0 = u.pm * BM + wr * 64 + fr; const int j0 = (u.pn & 3) * 128 + wc * 16 + 4 * fq;
#pragma unroll
        for (int ai = 0; ai < 2; ++ai)
#pragma unroll
            for (int m = 0; m < 4; ++m) { bf16_t* rowp = O + (size_t)(row0 + ai * HALF + m * 16) * 512 + j0;
#pragma unroll
                for (int bj = 0; bj < 2; ++bj) { const f32x4 g = acc[ai][bj][m][0], up = acc[ai][bj][m][1]; float h[4];
#pragma unroll
                    for (int q = 0; q < 4; ++q) h[q] = g[q] / (1.f + __expf(-g[q])) * up[q];
                    u32x2 w; w.x = ::pk_bf16(h[0], h[1]); w.y = ::pk_bf16(h[2], h[3]);
                    *(u32x2*)(rowp + bj * 64) = w; } }
    }
};
struct EpiRowScale {
    static constexpr bool PERM = true, AFTER_DRAIN = false;
    bf16_t* O; const float* ws;
    __device__ __forceinline__ void operator()(const f32x4 (&acc)[2][2][4][2], const Unit& u, int wr, int wc, int fr, int fq) const {
        const int row0 = u.pm * BM + wr * 64 + fr; const int col0 = (u.pn & 3) * BM + wc * 32 + 8 * fq;
#pragma unroll
        for (int ai = 0; ai < 2; ++ai)
#pragma unroll
            for (int m = 0; m < 4; ++m) { const int row = row0 + ai * HALF + m * 16; const float s = ws[row]; bf16_t* rowp = O + (size_t)row * 1024 + col0;
#pragma unroll
                for (int bj = 0; bj < 2; ++bj) { const f32x4 v0 = acc[ai][bj][m][0] * s, v1 = acc[ai][bj][m][1] * s;
                    u32x4 w; w.x = ::pk_bf16(v0[0], v0[1]); w.y = ::pk_bf16(v0[2], v0[3]); w.z = ::pk_bf16(v1[0], v1[1]); w.w = ::pk_bf16(v1[2], v1[3]);
                    *(u32x4*)(rowp + bj * HALF) = w; } }
    }
};
struct MoeOrder {
    int G, c, nt; int toff[16];
    __device__ __forceinline__ void init(const int* cnt, int G_, int c_) { G = G_; c = c_; int s = 0;
#pragma unroll
        for (int e = 0; e < 16; ++e) { toff[e] = s; s += (cnt[e] + 255) >> 8; } nt = s; }
    __device__ __forceinline__ bool next(int i, Unit& u) const {
        const int Lq = i * G + c; if (Lq >= nt * 4) return false;
        const int pm = Lq % nt, pn4 = Lq / nt; int e = 0;
#pragma unroll
        for (int q = 1; q < 16; ++q) e += (pm >= toff[q]) ? 1 : 0;
        u.pm = pm; u.pn = e * 4 + pn4; return true; }
    __device__ __forceinline__ void a_ready(const Unit&) const {}
    __device__ __forceinline__ void done(const Unit&) const {}
};
}

constexpr int NB = 2, L = 8192, D = 1024, CTX = 256, RB = L + CTX;
constexpr int RL = NB * L, RCX = NB * CTX, R = RL + RCX;
constexpr int GW = 64;
constexpr int NCH = 66;
constexpr int ABIN = 3584, GIN = 3104, GINP = 3328;
constexpr int NE = 16, NG = 4, EPG = 4, EH = 512;
constexpr int MOE_ROWS = 37888;
constexpr float ALPHA = 1.4142135623730951f, LN_EPS = 1e-5f, KSCALE = 0.08838834764831845f;
constexpr int NT = 512;
constexpr int LDS_BYTES = 147456;

typedef unsigned short bf16_t;
#define LAS __attribute__((address_space(3)))
__device__ __forceinline__ float bf2f(bf16_t v) { return __uint_as_float((unsigned)v << 16); }
__device__ __forceinline__ bf16_t f2bf(float f) { unsigned u = __float_as_uint(f); return (bf16_t)((u + 0x7fffu + ((u >> 16) & 1u)) >> 16); }
__device__ __forceinline__ float siluf(float x) { return x / (1.f + expf(-x)); }
__device__ __forceinline__ float sigmf(float x) { return 1.f / (1.f + expf(-x)); }
__device__ __forceinline__ float logsigf(float x) { return fminf(x, 0.f) - log1pf(expf(-fabsf(x))); }

struct P {
    const float* in[34];
    float* out;
    float* Xc;
    float* MOD;
    float* NORM;
    int* CNT;
    unsigned* BAR;
    float* A1; float* A2;
    float* RS; int* RE; int* RPOS; float* RWt; float* WS;
    bf16_t *Win0, *Wout0, *Win1, *Wout1, *Wgu, *Wd;
    bf16_t* H;
    bf16_t* Zr;
    bf16_t* Zh;
    bf16_t* hyT;
    float* FILT;
    bf16_t *Hs, *he, *slots;
    bf16_t* Z1;
    float* BG;
    bf16_t* GST;
};

__device__ __forceinline__ int launder_i(int x) { asm volatile("" : "+v"(x)); return x; }
#define TIDX launder_i((int)threadIdx.x)
#define GSTRIDE(i, n) for (long i = (long)blockIdx.x * blockDim.x + TIDX; i < (long)(n); i += (long)gridDim.x * blockDim.x)

__device__ __forceinline__ float* xrow(const P& p, int r) { return r < RL ? p.out + (size_t)r * D : p.Xc + (size_t)(r - RL) * D; }
__device__ __forceinline__ int seg_of(int r) { return r < RL ? r / L : 2; }
__device__ __forceinline__ const float* modv(const P& p, int l, int r, int chunk) { return p.MOD + ((size_t)(l * 3 + seg_of(r)) * 6 + chunk) * D; }
__device__ __forceinline__ int chunk_row0(int b, int c) { return c < 2 ? RL + b * CTX + c * 128 : b * L + (c - 2) * 128; }
__device__ __forceinline__ void row_bt(int r, int& b, int& tl) { if (r < RL) { b = r / L; tl = r % L; } else { b = (r - RL) / CTX; tl = L + (r - RL) % CTX; } }
__device__ __forceinline__ int bt_row(int b, int tl) { return tl < L ? b * L + tl : RL + b * CTX + (tl - L); }

#define XB_TMO      128
#define XB_XCNT(j)  (256  + 64 * (j))
#define XB_XSUB(j)  (1280 + 64 * (j))
#define XB_XGEN(j)  (2304 + 64 * (j))
#define XB_TOP      3328
#define XB_TOPGEN   3392
#define XCD_BAR_WORDS 3456
#define XB_SPIN_CAP (1u << 18)

__device__ __forceinline__ unsigned xb_ld(unsigned* p)              { return __hip_atomic_load(p, __ATOMIC_RELAXED, __HIP_MEMORY_SCOPE_AGENT); }
__device__ __forceinline__ unsigned xb_add(unsigned* p, unsigned v) { return __hip_atomic_fetch_add(p, v, __ATOMIC_RELAXED, __HIP_MEMORY_SCOPE_AGENT); }
__device__ __forceinline__ unsigned xb_xcc_id() { return (unsigned)__builtin_amdgcn_s_getreg((3 << 11) | 20) & 0xFu; }
#define XB_SPIN(cond, bar) do { unsigned _sp = 0; while (cond) { __builtin_amdgcn_s_sleep(1); \
    if ((++_sp & 255u) == 0u) { if (xb_ld(&(bar)[XB_TMO])) break; if (_sp > XB_SPIN_CAP) { atomicAdd(&(bar)[XB_TMO], 1u); break; } } } } while (0)

struct XcdBarrier {
    unsigned* bar; unsigned x;
    volatile LAS unsigned* st;
};

__device__ __forceinline__ XcdBarrier xcd_barrier_post(unsigned* bar, volatile LAS unsigned* st) {
    XcdBarrier b; b.bar = bar; b.x = xb_xcc_id(); b.st = st;
    if (threadIdx.x == 0) (void)xb_add(&bar[XB_XCNT(b.x)], 1u);
    return b;
}
__device__ __forceinline__ void xcd_barrier_complete(unsigned* bar, unsigned x, unsigned& nloc, unsigned& nx) {
    const unsigned G = gridDim.x * gridDim.y * gridDim.z;
    unsigned sum, cnt, mine, sp = 0u;
    for (;;) {
        sum = 0u; cnt = 0u; mine = 0u;
#pragma unroll
        for (unsigned j = 0; j < 16; ++j) { const unsigned c = xb_ld(&bar[XB_XCNT(j)]); sum += c; cnt += (c > 0u) ? 1u : 0u; mine = (j == x) ? c : mine; }
        if (sum == G) break;
        __builtin_amdgcn_s_sleep(1);
        if ((++sp & 255u) == 0u) { if (xb_ld(&bar[XB_TMO])) break; if (sp > XB_SPIN_CAP) { atomicAdd(&bar[XB_TMO], 1u); break; } }
    }
    nloc = mine > 0u ? mine : 1u; nx = cnt > 0u ? cnt : 1u;
}

__device__ __forceinline__ void xcd_barrier(const XcdBarrier& b) {
    asm volatile("s_waitcnt vmcnt(0)" ::: "memory");
    __syncthreads();
    if (threadIdx.x == 0) {
        unsigned* bar = b.bar;
        __builtin_amdgcn_s_waitcnt(0);
        unsigned nloc = b.st[0], nx = b.st[1];
        if (nloc == 0u) { xcd_barrier_complete(bar, b.x, nloc, nx); b.st[0] = nloc; b.st[1] = nx; }
        const unsigned old = xb_add(&bar[XB_XSUB(b.x)], 1u);
        const unsigned gen = old / nloc;
        if (old + 1u == (gen + 1u) * nloc) {
            __builtin_amdgcn_fence(__ATOMIC_RELEASE, "agent");
            asm volatile("s_waitcnt vmcnt(0)" ::: "memory");
            const unsigned og = xb_add(&bar[XB_TOP], 1u);
            const unsigned tg = og / nx;
            if (og + 1u == (tg + 1u) * nx) xb_add(&bar[XB_TOPGEN], 1u);
            else XB_SPIN(xb_ld(&bar[XB_TOPGEN]) == tg, bar);
            __builtin_amdgcn_fence(__ATOMIC_ACQUIRE, "agent");
            xb_add(&bar[XB_XGEN(b.x)], 1u);
            asm volatile("s_waitcnt vmcnt(0)" ::: "memory");
        } else {
            XB_SPIN(xb_ld(&bar[XB_XGEN(b.x)]) == gen, bar);
            __builtin_amdgcn_fence(__ATOMIC_ACQUIRE, "agent");
            asm volatile("s_waitcnt vmcnt(0)" ::: "memory");
        }
    }
    __syncthreads();
}

__device__ __forceinline__ void ph_wconv(bf16_t* dst, const float* src, int N, int K, int ldsrc, int nvalid) {
    GSTRIDE(idx, (long)N * K) { const int k = idx % K, n = idx / K; dst[idx] = n < nvalid ? f2bf(src[(size_t)k * ldsrc + n]) : (bf16_t)0; }
}
__device__ __forceinline__ void ph_wconv_moe(const P& p, int l) {
    GSTRIDE(idx, (long)NE * 1024 * 1024) {
        const int k = idx % 1024, n = (idx / 1024) % 1024, e = idx / (1024 * 1024);
        const int q = n >> 3, r = n & 7, j = 4 * q + (r & 3);
        const float* src = (r < 4 ? p.in[31] : p.in[32]) + ((size_t)(l * NE + e) * D + k) * EH + j;
        p.Wgu[idx] = f2bf(*src);
    }
    GSTRIDE(idx, (long)NE * 1024 * 512) {
        const int k = idx % 512, n = (idx / 512) % 1024, e = idx / (512 * 1024);
        p.Wd[idx] = f2bf(p.in[33][((size_t)(l * NE + e) * EH + k) * D + n]);
    }
}
__device__ __forceinline__ void ph_ada(const P& p) {
    GSTRIDE(idx, 2 * 3 * 6144) {
        const int n = idx % 6144, j = (idx / 6144) % 3, l = idx / (3 * 6144);
        const float* cv = j < 2 ? p.in[1] + j * D : p.in[3];
        const float* w = p.in[4] + (size_t)l * D * 6144;
        float acc = p.in[5][l * 6144 + n];
        for (int k = 0; k < D; ++k) acc += siluf(cv[k]) * w[(size_t)k * 6144 + n];
        p.MOD[idx] = acc;
    }
}
__device__ __forceinline__ void ph_init(const P& p) {
    GSTRIDE(i, (long)RL * D) p.out[i] = p.in[0][i];
    GSTRIDE(i, (long)RCX * D) p.Xc[i] = p.in[2][i];
}
__device__ __forceinline__ void hy_pos(int pidx, int& len, int& i) { if (pidx < L) { len = L; i = pidx; } else { len = CTX; i = pidx - L; } }
__device__ __forceinline__ void ph_hyA1(const P& p) {
    GSTRIDE(idx, (long)RB * 64) {
        const int j = idx % 64, pidx = idx / 64; int len, i; hy_pos(pidx, len, i);
        const float t = (float)i / (float)(len - 1);
        const float w = 2.0f * 3.14159265358979323846f * (float)i / (float)len;
        const float* w1 = p.in[13];
        float acc = p.in[14][j] + t * w1[j];
        for (int m = 0; m < 16; ++m) {
            const float f = 1e-4f + (float)m * ((15.f - 1e-4f) / 15.f);
            acc += cosf(f * w) * w1[(1 + m) * 64 + j] - sinf(f * w) * w1[(17 + m) * 64 + j];
        }
        p.A1[idx] = sinf(p.in[20][j] * acc);
    }
}
__device__ __forceinline__ void ph_hyA(const float* src, float* dst, const float* w, const float* bias, const float* freq) {
    GSTRIDE(idx, (long)RB * 64) {
        const int j = idx % 64, pidx = idx / 64;
        float acc = bias[j];
        for (int i = 0; i < 64; ++i) acc += src[(size_t)pidx * 64 + i] * w[i * 64 + j];
        dst[idx] = sinf(freq[j] * acc);
    }
}
__device__ __forceinline__ void ph_hyF(const P& p, const float* a3) {
    const float mind = logf(1e-2f) / 1.5f, maxd = logf(1e-2f) / 0.3f;
    GSTRIDE(idx, (long)2048 * RB) {
        const int pidx = idx % RB, col = idx / RB, ch = col % 512; int len, i; hy_pos(pidx, len, i);
        const float t = (float)i / (float)(len - 1);
        float acc = 0.f;
        for (int m = 0; m < 64; ++m) acc += a3[(size_t)pidx * 64 + m] * p.in[19][m * 2048 + col];
        const float delta = fabsf(mind + (float)ch * ((maxd - mind) / 511.f));
        p.FILT[idx] = acc * expf(-t * delta);
    }
}
__device__ __forceinline__ float block_sum(float v, float* red);
__device__ __forceinline__ void ph_hyNorm(const P& p, float* red) {
    for (int u = blockIdx.x; u < 2 * 2048; u += gridDim.x) {
        const int col = u % 2048, which = u / 2048; const int p0 = which ? L : 0, n = which ? CTX : L;
        float s = 0.f;
        for (int i = TIDX; i < n; i += NT) { const float v = p.FILT[(size_t)col * RB + p0 + i]; s += v * v; }
        const float t = block_sum(s, red);
        if (TIDX == 0) p.NORM[which * 2048 + col] = t;
    }
}
__device__ __forceinline__ void ph_mod(const P& p, int l, int which) {
    GSTRIDE(i, (long)R * D) {
        const int r = i / D, k = i % D;
        p.H[i] = f2bf(xrow(p, r)[k] * (1.f + modv(p, l, r, which * 3 + 1)[k]) + modv(p, l, r, which * 3 + 0)[k]);
    }
}
__device__ __forceinline__ void ph_prep_rope(const P& p) {
    GSTRIDE(i, (long)R * 2 * 4 * 64) {
        const int pr = i % 64, h = (i / 64) % 4, w = (i / 256) % 2, r = i / 512;
        bf16_t* base = p.Zr + (size_t)r * 2048 + w * 512 + h * 128;
        float t1 = bf2f(base[pr]), t2 = bf2f(base[64 + pr]);
        if (w == 1) { t1 *= KSCALE; t2 *= KSCALE; }
        if (r < RL) {
            const int t = r % L, row = t / GW, col = t % GW;
            const float inv = powf(10000.f, -(float)(pr & 31) / 32.f);
            const float ang = (pr < 32 ? (float)row : (float)col) * inv;
            float sn, cs; sincosf(ang, &sn, &cs);
            const float a = t1 * cs - t2 * sn, bb = t1 * sn + t2 * cs; t1 = a; t2 = bb;
        }
        base[pr] = f2bf(t1); base[64 + pr] = f2bf(t2);
    }
}
__device__ __forceinline__ void ph_prep_hy(const P& p) {
    GSTRIDE(idx, (long)NB * 1536 * RB) {
        const int tl = idx % RB, col = (idx / RB) % 1536, b = idx / (RB * 1536);
        const int s0 = tl < L ? 0 : L, s1 = tl < L ? L : RB;
        const float* w = p.in[11];
        float acc = p.in[12][col] + w[1536 + col] * bf2f(p.Zh[(size_t)bt_row(b, tl) * 1536 + col]);
        if (tl - 1 >= s0) acc += w[col] * bf2f(p.Zh[(size_t)bt_row(b, tl - 1) * 1536 + col]);
        if (tl + 1 < s1) acc += w[2 * 1536 + col] * bf2f(p.Zh[(size_t)bt_row(b, tl + 1) * 1536 + col]);
        p.hyT[idx] = f2bf(acc);
    }
}
__device__ __forceinline__ float hy_tapT(const float* Ff, const float* Fb, float nf, float nb, int d) {
    if (d > 0) return Ff[d] * nf; if (d < 0) return Fb[-d] * nb; return Ff[0] * nf + Fb[0] * nb;
}
__device__ __forceinline__ void ph_hyconv_naive(const P& p, int n, float* conv) {
    GSTRIDE(idx, (long)NB * 512 * (RB / 4)) {
        const int tb = idx % (RB / 4), ch = (idx / (RB / 4)) % 512, b = idx / ((RB / 4) * 512);
        const int tl0 = tb * 4, s0 = tl0 < L ? 0 : L, len = tl0 < L ? L : CTX, nrm = tl0 < L ? 0 : 1, t0 = tl0 - s0;
        const int cf = (n * 2 + 0) * 512 + ch, cb = (n * 2 + 1) * 512 + ch;
        const float nf = 1.f / sqrtf(p.NORM[nrm * 2048 + cf]), nb = 1.f / sqrtf(p.NORM[nrm * 2048 + cb]);
        const float* Ff = p.FILT + (size_t)cf * RB + s0; const float* Fb = p.FILT + (size_t)cb * RB + s0;
        const bf16_t* z = p.hyT + ((size_t)(b * 3 + 2) * 512 + ch) * RB + s0;
        float w0 = hy_tapT(Ff, Fb, nf, nb, t0), w1 = hy_tapT(Ff, Fb, nf, nb, t0 + 1), w2 = hy_tapT(Ff, Fb, nf, nb, t0 + 2), w3 = hy_tapT(Ff, Fb, nf, nb, t0 + 3);
        float a0 = 0.f, a1 = 0.f, a2 = 0.f, a3 = 0.f;
        for (int s = 0; s < len; ++s) {
            const float zz = bf2f(z[s]);
            a0 += w0 * zz; a1 += w1 * zz; a2 += w2 * zz; a3 += w3 * zz;
            w3 = w2; w2 = w1; w1 = w0;
            if (s + 1 < len) w0 = hy_tapT(Ff, Fb, nf, nb, t0 - (s + 1));
        }
        float* o = conv + ((size_t)b * 512 + ch) * RB + tl0; o[0] = a0; o[1] = a1; o[2] = a2; o[3] = a3;
    }
}
__device__ __forceinline__ void ph_hygate_naive(const P& p, int n, const float* conv) {
    bf16_t* yhT = p.Zh + (size_t)2 * NB * 4 * NCH * 16384;
    GSTRIDE(idx, (long)NB * 512 * RB) {
        const int tl = idx % RB, ch = (idx / RB) % 512, b = idx / (RB * 512);
        bf16_t* z = p.hyT + ((size_t)(b * 3 + 2) * 512 + ch) * RB + tl; const float gate = bf2f(p.hyT[((size_t)(b * 3 + n) * 512 + ch) * RB + tl]);
        const float r = gate * (conv[idx] + p.in[21][n * 512 + ch] * bf2f(*z));
        if (n == 0) *z = f2bf(r); else yhT[idx] = f2bf(r);
    }
}
__device__ __forceinline__ void ph_hy_untranspose(const P& p) {
    const bf16_t* yhT = p.Zh + (size_t)2 * NB * 4 * NCH * 16384;
    GSTRIDE(idx, (long)R * 512) { const int ch = idx % 512, r = idx / 512; int b, tl; row_bt(r, b, tl); p.H[(size_t)r * D + 512 + ch] = yhT[((size_t)b * 512 + ch) * RB + tl]; }
}
__device__ __forceinline__ size_t st_idx(int dir, int b, int h, int c) { return ((((size_t)dir * NB + b) * 4 + h) * NCH + c) * 16384; }
__device__ __forceinline__ void ph_retU_naive(const P& p) {
    bf16_t* ST = p.Zh;
    GSTRIDE(idx, (long)NB * 4 * NCH * 16384) {
        const int d = idx % 128, e = (idx / 128) % 128, c = (idx / 16384) % NCH, h = (idx / (16384 * NCH)) % 4, b = idx / (16384 * NCH * 4);
        const float lgf = p.in[9][h], lgb = p.in[10][h]; const int r0 = chunk_row0(b, c);
        float uf = 0.f, ub = 0.f;
        for (int j = 0; j < 128; ++j) {
            const float kk = bf2f(p.Zr[(size_t)(r0 + j) * 2048 + 512 + h * 128 + d]), vv = bf2f(p.Zr[(size_t)(r0 + j) * 2048 + 1024 + h * 128 + e]);
            uf += kk * expf(lgf * (float)(127 - j)) * vv; ub += kk * expf(lgb * (float)j) * vv;
        }
        ST[st_idx(0, b, h, c) + e * 128 + d] = f2bf(uf); ST[st_idx(1, b, h, c) + e * 128 + d] = f2bf(ub);
    }
}
__device__ __forceinline__ void ph_retScan(const P& p) {
    bf16_t* ST = p.Zh;
    GSTRIDE(idx, (long)2 * NB * 4 * 16384) {
        const int ed = idx % 16384, h = (idx / 16384) % 4, b = (idx / 65536) % NB, dir = idx / (65536 * NB);
        const float dc = expf((dir ? p.in[10] : p.in[9])[h] * 128.f);
        float s = 0.f;
        for (int cc = 0; cc < NCH; ++cc) {
            const int c = dir == 0 ? cc : (cc < 2 ? 1 - cc : NCH + 1 - cc);
            bf16_t* q = ST + st_idx(dir, b, h, c) + ed; const float u = bf2f(*q); *q = f2bf(s); s = dc * s + u;
        }
    }
}
__device__ __forceinline__ void ph_retO_naive(const P& p, float* lds) {
    const bf16_t* ST = p.Zh;
    for (int u = blockIdx.x; u < NB * 4 * NCH; u += gridDim.x) {
        const int c = u % NCH, h = (u / NCH) % 4, b = u / (NCH * 4); const int r0 = chunk_row0(b, c);
        const float lgf = p.in[9][h], lgb = p.in[10][h];
        __syncthreads();
        for (int e = TIDX; e < 128 * 128; e += NT) {
            const int j = e % 128, i = e / 128;
            const bf16_t* q = p.Zr + (size_t)(r0 + i) * 2048 + h * 128; const bf16_t* k = p.Zr + (size_t)(r0 + j) * 2048 + 512 + h * 128;
            float s = 0.f; for (int d = 0; d < 128; ++d) s += bf2f(q[d]) * bf2f(k[d]);
            const float m = i > j ? expf(lgf * (float)(i - j)) : (j > i ? expf(lgb * (float)(j - i)) : 2.f);
            lds[e] = s * m;
        }
        __syncthreads();
        const bf16_t* sf = ST + st_idx(0, b, h, c); const bf16_t* sb = ST + st_idx(1, b, h, c);
        for (int e2 = TIDX; e2 < 128 * 128; e2 += NT) {
            const int e = e2 % 128, i = e2 / 128;
            float o = 0.f; for (int j = 0; j < 128; ++j) o += lds[i * 128 + j] * bf2f(p.Zr[(size_t)(r0 + j) * 2048 + 1024 + h * 128 + e]);
            const bf16_t* q = p.Zr + (size_t)(r0 + i) * 2048 + h * 128;
            float of = 0.f, ob = 0.f; for (int d = 0; d < 128; ++d) { const float qq = bf2f(q[d]); of += qq * bf2f(sf[e * 128 + d]); ob += qq * bf2f(sb[e * 128 + d]); }
            p.H[(size_t)(r0 + i) * D + h * 128 + e] = f2bf(o + expf(lgf * (float)(i + 1)) * of + expf(lgb * (float)(128 - i)) * ob);
        }
    }
}
__device__ __forceinline__ void ph_retNorm_naive(const P& p) {
    GSTRIDE(idx, (long)R * 4) {
        const int h = idx % 4, r = idx / 4; bf16_t* o = p.H + (size_t)r * D + h * 128;
        float mu = 0.f; for (int e = 0; e < 128; ++e) mu += bf2f(o[e]); mu *= (1.f / 128.f);
        float var = 0.f; for (int e = 0; e < 128; ++e) { const float d = bf2f(o[e]) - mu; var += d * d; } var *= (1.f / 128.f);
        const float rs = 1.f / sqrtf(var + LN_EPS);
        for (int e = 0; e < 128; ++e) o[e] = f2bf((bf2f(o[e]) - mu) * rs * siluf(bf2f(p.Zr[(size_t)r * 2048 + 1536 + h * 128 + e])));
    }
}
__device__ __forceinline__ float block_sum(float v, float* red) {
    __syncthreads();
#pragma unroll
    for (int o = 32; o > 0; o >>= 1) v += __shfl_xor(v, o);
    if ((TIDX & 63) == 0) red[TIDX >> 6] = v;
    __syncthreads();
    float t = 0.f;
#pragma unroll
    for (int w = 0; w < NT / 64; ++w) t += red[w];
    return t;
}
template <int MODE> __device__ __forceinline__ void ph_post(const P& p, int l, int which, const bf16_t* Y, int ln, int wn, int nrows, float* red) {
    const float* lg = p.in[6] + (size_t)(l * 2 + which) * D; const float* lb = p.in[7] + (size_t)(l * 2 + which) * D;
    int toff[16];
    if (MODE == 1) { int s = 0;
#pragma unroll
        for (int e = 0; e < 16; ++e) { toff[e] = s; s += (p.CNT[l * 16 + e] + 255) >> 8; } }
    for (int r = blockIdx.x; r < nrows; r += gridDim.x) {
        float* x = xrow(p, r); const float* gate = modv(p, l, r, which * 3 + 2);
        const bf16_t *y0, *y1 = nullptr;
        if (MODE == 0) y0 = Y + (size_t)r * D;
        else {
            int sr[2];
#pragma unroll
            for (int k = 0; k < 2; ++k) { const int e = p.RE[r * 2 + k]; int to = 0;
#pragma unroll
                for (int q = 0; q < 16; ++q) to = (q == e) ? toff[q] : to;
                sr[k] = to * 256 + p.RPOS[r * 2 + k]; }
            y0 = p.slots + (size_t)sr[0] * D; y1 = p.slots + (size_t)sr[1] * D;
        }
        float v[2]; float s = 0.f;
#pragma unroll
        for (int i = 0; i < 2; ++i) { const int k = TIDX + i * NT; float yy = bf2f(y0[k]); if (MODE == 1) yy += bf2f(y1[k]); v[i] = ALPHA * x[k] + gate[k] * yy; s += v[i]; }
        const float mu = block_sum(s, red) * (1.f / D);
        float q = 0.f;
#pragma unroll
        for (int i = 0; i < 2; ++i) { const float d = v[i] - mu; q += d * d; }
        const float rs = 1.f / sqrtf(block_sum(q, red) * (1.f / D) + LN_EPS);
#pragma unroll
        for (int i = 0; i < 2; ++i) { const int k = TIDX + i * NT; const float xn = (v[i] - mu) * rs * lg[k] + lb[k]; x[k] = xn;
            if (ln >= 0) p.H[(size_t)r * D + k] = f2bf(xn * (1.f + modv(p, ln, r, wn * 3 + 1)[k]) + modv(p, ln, r, wn * 3 + 0)[k]); }
    }
}
__device__ __forceinline__ void ph_route1(const P& p, int l, int nrows) {
    GSTRIDE(idx, (long)nrows * NE) {
        const int e = idx % NE, r = idx / NE; const float* x = xrow(p, r); const float* sc = modv(p, l, r, 4); const float* sh = modv(p, l, r, 3);
        float acc = 0.f;
        for (int k = 0; k < D; ++k) acc += (x[k] * (1.f + sc[k]) + sh[k]) * p.in[29][k * NE + e];
        p.RS[idx] = sigmf(acc);
    }
}
__device__ __forceinline__ void ph_route2(const P& p, int l, int nrows) {
    GSTRIDE(r, nrows) {
        const float* s = p.RS + (size_t)r * NE; const float* rb = p.in[30];
        int best = 0; float bs = -1e30f;
        for (int g = 0; g < NG; ++g) {
            float m1 = -1e30f, m2 = -1e30f;
            for (int q = 0; q < EPG; ++q) { const float v = s[g * EPG + q] + rb[g * EPG + q]; if (v > m1) { m2 = m1; m1 = v; } else if (v > m2) m2 = v; }
            if (m1 + m2 > bs) { bs = m1 + m2; best = g; }
        }
        int i1 = 0; float v1 = -1e30f;
        for (int q = 0; q < EPG; ++q) { const float v = s[best * EPG + q] + rb[best * EPG + q]; if (v > v1) { v1 = v; i1 = q; } }
        int i2 = 0; float v2 = -1e30f;
        for (int q = 0; q < EPG; ++q) { if (q == i1) continue; const float v = s[best * EPG + q] + rb[best * EPG + q]; if (v > v2) { v2 = v; i2 = q; } }
        const int e1 = best * EPG + i1, e2 = best * EPG + i2; const float a = s[e1], c = s[e2];
        p.RE[r * 2] = e1; p.RE[r * 2 + 1] = e2; p.RWt[r * 2] = a / (a + c); p.RWt[r * 2 + 1] = c / (a + c);
        p.RPOS[r * 2] = atomicAdd(&p.CNT[l * 16 + e1], 1); p.RPOS[r * 2 + 1] = atomicAdd(&p.CNT[l * 16 + e2], 1);
    }
}
__device__ __forceinline__ void ph_permute(const P& p, int l, int nrows) {
    int toff[16]; { int s = 0;
#pragma unroll
        for (int e = 0; e < 16; ++e) { toff[e] = s; s += (p.CNT[l * 16 + e] + 255) >> 8; } }
    GSTRIDE(idx, (long)nrows * 2 * 128) {
        const int ck = idx % 128, k = (idx / 128) % 2, r = idx / 256; const int e = p.RE[r * 2 + k]; int to = 0;
#pragma unroll
        for (int q = 0; q < 16; ++q) to = (q == e) ? toff[q] : to;
        const int sr = to * 256 + p.RPOS[r * 2 + k];
        ((uint4*)(p.Hs + (size_t)sr * D))[ck] = ((const uint4*)(p.H + (size_t)r * D))[ck];
        if (ck == 0) p.WS[sr] = p.RWt[r * 2 + k];
    }
}
__device__ __forceinline__ void ph_glagate(const P& p) {
    GSTRIDE(idx, (long)2 * R * 512) {
        const int ch = idx % 512, r = (idx / 512) % R, dir = idx / (512 * R);
        const float* gw = (dir ? p.in[26] : p.in[24]); const float* gb = (dir ? p.in[27] : p.in[25]);
        float acc = gb[ch];
        for (int q = 0; q < 16; ++q) acc += bf2f(p.Z1[(size_t)r * GINP + 3072 + dir * 16 + q]) * gw[q * 512 + ch];
        p.BG[idx] = logsigf(acc) * (1.f / 16.f);
    }
}
__device__ __forceinline__ void ph_glacum(const P& p) {
    GSTRIDE(idx, (long)2 * NB * NCH * 512) {
        const int ch = idx % 512, c = (idx / 512) % NCH, b = (idx / (512 * NCH)) % NB, dir = idx / (512 * NCH * NB);
        float* a = p.BG + ((size_t)dir * R + chunk_row0(b, c)) * 512 + ch;
        float s = 0.f;
        if (dir == 0) for (int i = 0; i < 128; ++i) { s += a[(size_t)i * 512]; a[(size_t)i * 512] = s; }
        else for (int i = 127; i >= 0; --i) { s += a[(size_t)i * 512]; a[(size_t)i * 512] = s; }
    }
}
__device__ __forceinline__ size_t gst_idx(int dir, int b, int h, int c) { return ((((size_t)dir * NB + b) * 4 + h) * NCH + c) * 32768; }
__device__ __forceinline__ void ph_glaU_naive(const P& p) {
    const float* BF = p.BG; const float* BB = p.BG + (size_t)R * 512;
    GSTRIDE(idx, (long)NB * 4 * NCH * 32768) {
        const int d = idx % 128, e = (idx / 128) % 256, c = (idx / 32768) % NCH, h = (idx / (32768 * NCH)) % 4, b = idx / (32768 * NCH * 4);
        const int r0 = chunk_row0(b, c);
        const float bfe = BF[(size_t)(r0 + 127) * 512 + h * 128 + d], bbe = BB[(size_t)r0 * 512 + h * 128 + d];
        float uf = 0.f, ub = 0.f;
        for (int j = 0; j < 128; ++j) {
            const float kk = bf2f(p.Z1[(size_t)(r0 + j) * GINP + 512 + h * 128 + d]), vv = bf2f(p.Z1[(size_t)(r0 + j) * GINP + 1024 + h * 256 + e]);
            uf += kk * expf(bfe - BF[(size_t)(r0 + j) * 512 + h * 128 + d]) * vv; ub += kk * expf(bbe - BB[(size_t)(r0 + j) * 512 + h * 128 + d]) * vv;
        }
        p.GST[gst_idx(0, b, h, c) + e * 128 + d] = f2bf(uf); p.GST[gst_idx(1, b, h, c) + e * 128 + d] = f2bf(ub);
    }
}
__device__ __forceinline__ void ph_glaScan(const P& p) {
    const float* BF = p.BG; const float* BB = p.BG + (size_t)R * 512;
    GSTRIDE(idx, (long)2 * NB * 4 * 32768) {
        const int d = idx % 128, ed = idx % 32768, h = (idx / 32768) % 4, b = (idx / 131072) % NB, dir = idx / (131072 * NB);
        float s = 0.f;
        for (int cc = 0; cc < NCH; ++cc) {
            const int c = dir == 0 ? cc : (cc < 2 ? 1 - cc : NCH + 1 - cc); const int r0 = chunk_row0(b, c);
            const float dc = dir == 0 ? expf(BF[(size_t)(r0 + 127) * 512 + h * 128 + d]) : expf(BB[(size_t)r0 * 512 + h * 128 + d]);
            bf16_t* q = p.GST + gst_idx(dir, b, h, c) + ed; const float u = bf2f(*q); *q = f2bf(s); s = dc * s + u;
        }
    }
}
__device__ __forceinline__ void ph_glaO_naive(const P& p, float* lds) {
    const float* BF = p.BG; const float* BB = p.BG + (size_t)R * 512;
    for (int u = blockIdx.x; u < NB * 4 * 64; u += gridDim.x) {
        const int c = 2 + u % 64, h = (u / 64) % 4, b = u / 256; const int r0 = chunk_row0(b, c);
        __syncthreads();
        for (int e = TIDX; e < 128 * 128; e += NT) {
            const int j = e % 128, i = e / 128;
            const bf16_t* q = p.Z1 + (size_t)(r0 + i) * GINP + h * 128; const bf16_t* k = p.Z1 + (size_t)(r0 + j) * GINP + 512 + h * 128;
            float s = 0.f;
            if (i >= j) { const float* bi = BF + (size_t)(r0 + i) * 512 + h * 128; const float* bj = BF + (size_t)(r0 + j) * 512 + h * 128;
                for (int d = 0; d < 128; ++d) s += bf2f(q[d]) * bf2f(k[d]) * expf(bi[d] - bj[d]); }
            if (i <= j) { const float* bi = BB + (size_t)(r0 + i) * 512 + h * 128; const float* bj = BB + (size_t)(r0 + j) * 512 + h * 128;
                for (int d = 0; d < 128; ++d) s += bf2f(q[d]) * bf2f(k[d]) * expf(bi[d] - bj[d]); }
            lds[e] = s * KSCALE;
        }
        __syncthreads();
        const bf16_t* sf = p.GST + gst_idx(0, b, h, c); const bf16_t* sb = p.GST + gst_idx(1, b, h, c);
        for (int e2 = TIDX; e2 < 128 * 256; e2 += NT) {
            const int e = e2 % 256, i = e2 / 256;
            float o = 0.f; for (int j = 0; j < 128; ++j) o += lds[i * 128 + j] * bf2f(p.Z1[(size_t)(r0 + j) * GINP + 1024 + h * 256 + e]);
            const bf16_t* q = p.Z1 + (size_t)(r0 + i) * GINP + h * 128; const float* bi = BF + (size_t)(r0 + i) * 512 + h * 128; const float* bbi = BB + (size_t)(r0 + i) * 512 + h * 128;
            float a = 0.f; for (int d = 0; d < 128; ++d) a += bf2f(q[d]) * (expf(bi[d]) * bf2f(sf[e * 128 + d]) + expf(bbi[d]) * bf2f(sb[e * 128 + d]));
            p.H[(size_t)(r0 + i) * D + h * 256 + e] = f2bf(o + a * KSCALE);
        }
    }
}
__device__ __forceinline__ void ph_glaNorm_naive(const P& p) {
    GSTRIDE(idx, (long)RL * 4) {
        const int h = idx % 4, r = idx / 4; bf16_t* o = p.H + (size_t)r * D + h * 256;
        float ss = 0.f; for (int e = 0; e < 256; ++e) { const float v = bf2f(o[e]); ss += v * v; }
        const float rs = 1.f / sqrtf(ss * (1.f / 256.f) + LN_EPS);
        for (int e = 0; e < 256; ++e) o[e] = f2bf(bf2f(o[e]) * rs * siluf(bf2f(p.Z1[(size_t)r * GINP + 2048 + h * 256 + e])));
    }
}

#define FD __device__ __forceinline__
#define TIE(a, b) asm volatile("" : "+v"(a) : "v"(b))
#define HWCOS(x) __builtin_amdgcn_cosf(x)
#define HWSIN(x) __builtin_amdgcn_sinf(x)
struct cf { float x, y; };
FD cf cadd(cf a, cf b) { return {a.x + b.x, a.y + b.y}; }
FD cf csub(cf a, cf b) { return {a.x - b.x, a.y - b.y}; }
FD cf cmul(cf a, cf b) { return {a.x * b.x - a.y * b.y, a.x * b.y + a.y * b.x}; }
#define C32(k) ((k)==0?1.0f:(k)==1?0.98078528040323043f:(k)==2?0.92387953251128674f:(k)==3?0.83146961230254524f:(k)==4?0.70710678118654752f:(k)==5?0.55557023301960222f:(k)==6?0.38268343236508977f:(k)==7?0.19509032201612825f:(k)==8?0.0f:(k)==9?-0.19509032201612825f:(k)==10?-0.38268343236508977f:(k)==11?-0.55557023301960222f:(k)==12?-0.70710678118654752f:(k)==13?-0.83146961230254524f:(k)==14?-0.92387953251128674f:-0.98078528040323043f)
#define S32(k) ((k)==0?0.0f:(k)==1?0.19509032201612825f:(k)==2?0.38268343236508977f:(k)==3?0.55557023301960222f:(k)==4?0.70710678118654752f:(k)==5?0.83146961230254524f:(k)==6?0.92387953251128674f:(k)==7?0.98078528040323043f:(k)==8?1.0f:(k)==9?0.98078528040323043f:(k)==10?0.92387953251128674f:(k)==11?0.83146961230254524f:(k)==12?0.70710678118654752f:(k)==13?0.55557023301960222f:(k)==14?0.38268343236508977f:0.19509032201612825f)
template <int N, int LEN, bool INV> FD void dit_level(cf (&x)[N]) {
#pragma unroll
    for (int blk = 0; blk < N; blk += LEN)
#pragma unroll
        for (int j = 0; j < LEN / 2; ++j) {
            const int k = j * (32 / LEN);
            const cf a = x[blk + j], b0 = x[blk + j + LEN / 2];
            const cf b = k == 0 ? b0 : (k == 8 ? (INV ? cf{-b0.y, b0.x} : cf{b0.y, -b0.x}) : cmul(b0, cf{C32(k), INV ? S32(k) : -S32(k)}));
            x[blk + j] = cadd(a, b); x[blk + j + LEN / 2] = csub(a, b);
        }
}
template <int N, bool INV> FD void dit_reg(cf (&x)[N]) {
    dit_level<N, 2, INV>(x); dit_level<N, 4, INV>(x);
    if constexpr (N >= 8) dit_level<N, 8, INV>(x);
    if constexpr (N >= 16) dit_level<N, 16, INV>(x);
}
template <int N, int LEN, bool INV> FD void dif_level(cf (&x)[N]) {
#pragma unroll
    for (int blk = 0; blk < N; blk += LEN)
#pragma unroll
        for (int j = 0; j < LEN / 2; ++j) {
            const int k = j * (32 / LEN);
            const cf a = x[blk + j], b = x[blk + j + LEN / 2];
            x[blk + j] = cadd(a, b); const cf d = csub(a, b);
            x[blk + j + LEN / 2] = k == 0 ? d : (k == 8 ? (INV ? cf{-d.y, d.x} : cf{d.y, -d.x}) : cmul(d, cf{C32(k), INV ? S32(k) : -S32(k)}));
        }
}
template <int N, bool INV> FD void dif_reg(cf (&x)[N]) {
    if constexpr (N >= 16) dif_level<N, 16, INV>(x);
    if constexpr (N >= 8) dif_level<N, 8, INV>(x);
    dif_level<N, 4, INV>(x); dif_level<N, 2, INV>(x);
}
constexpr int FFT_N = 16384, FFT_LDS_CF = 17920;
FD int brev4(int i) { return ((i & 1) << 3) | ((i & 2) << 1) | ((i & 4) >> 1) | ((i & 8) >> 3); }
FD int physA(int m, int a) { return 4480 * a + m + (m >> 4) + 16 * (m >> 9); }
FD int physB(int b, int a, int m) { return 4480 * b + 272 * a + 16 * (a >> 1) + m + (m >> 4); }
FD int physC(int b, int a, int m) { return 272 * b + 16 * (b >> 1) + 17 * a + m; }
FD int physD(int g, int j) { return 17 * g + 16 * (g >> 5) + j; }
template <int RR, int RM> FD void twiddle(cf (&x)[RR], int m, float sgn) {
    const float fr = (float)m * (1.0f / (float)RM); const cf w{HWCOS(fr), sgn * HWSIN(fr)}; cf cur = w;
#pragma unroll
    for (int s = 1; s < RR; ++s) { x[s] = cmul(x[s], cur); if (s + 1 < RR) cur = cmul(cur, w); }
}
FD void stA_fwd(int m, cf v0, cf v1, cf v2, cf v3, cf* buf) {
    cf x[4] = {v0, v2, v1, v3};
    dit_reg<4, false>(x); twiddle<4, 16384>(x, m, -1.f);
#pragma unroll
    for (int s = 0; s < 4; ++s) buf[physA(m, s)] = x[s];
}
FD void stB_fwd(int idx, cf* buf) {
    const int b = idx >> 8, m = idx & 255; cf x[16];
#pragma unroll
    for (int i = 0; i < 16; ++i) x[i] = buf[physB(b, brev4(i), m)];
    dit_reg<16, false>(x); twiddle<16, 4096>(x, m, -1.f);
#pragma unroll
    for (int s = 0; s < 16; ++s) buf[physB(b, s, m)] = x[s];
}
FD void stC_fwd(int idx, cf* buf) {
    const int b = idx >> 4, m = idx & 15; cf x[16];
#pragma unroll
    for (int i = 0; i < 16; ++i) x[i] = buf[physC(b, brev4(i), m)];
    dit_reg<16, false>(x); twiddle<16, 256>(x, m, -1.f);
#pragma unroll
    for (int s = 0; s < 16; ++s) buf[physC(b, s, m)] = x[s];
}
FD void stD_fwd_regs(int g, const cf* buf, cf (&x)[16]) {
#pragma unroll
    for (int i = 0; i < 16; ++i) x[i] = buf[physD(g, brev4(i))];
    dit_reg<16, false>(x);
}
FD void stD_mul(int g, cf* buf, const cf (&h)[16]) {
    cf x[16];
#pragma unroll
    for (int i = 0; i < 16; ++i) x[i] = buf[physD(g, brev4(i))];
    dit_reg<16, false>(x);
#pragma unroll
    for (int s = 0; s < 16; ++s) x[s] = cmul(x[s], h[s]);
    dif_reg<16, true>(x);
#pragma unroll
    for (int i = 0; i < 16; ++i) buf[physD(g, brev4(i))] = x[i];
}
FD void stC_inv(int idx, cf* buf) {
    const int b = idx >> 4, m = idx & 15; cf x[16];
#pragma unroll
    for (int s = 0; s < 16; ++s) x[s] = buf[physC(b, s, m)];
    twiddle<16, 256>(x, m, 1.f); dif_reg<16, true>(x);
#pragma unroll
    for (int i = 0; i < 16; ++i) buf[physC(b, brev4(i), m)] = x[i];
}
FD void stB_inv(int idx, cf* buf) {
    const int b = idx >> 8, m = idx & 255; cf x[16];
#pragma unroll
    for (int s = 0; s < 16; ++s) x[s] = buf[physB(b, s, m)];
    twiddle<16, 4096>(x, m, 1.f); dif_reg<16, true>(x);
#pragma unroll
    for (int i = 0; i < 16; ++i) buf[physB(b, brev4(i), m)] = x[i];
}
FD void stA_inv(int m, const cf* buf, cf& r0, cf& r1) {
    cf x[4];
#pragma unroll
    for (int s = 0; s < 4; ++s) x[s] = buf[physA(m, s)];
    twiddle<4, 16384>(x, m, 1.f); dif_reg<4, true>(x);
    r0 = x[0]; r1 = x[2];
}

#undef FD
__device__ __forceinline__ float dw3(const bf16_t* u, int d, int lo, int hi, float w0, float w1, float w2, float bs) {
    const float um = bf2f(u[d > lo ? d - 1 : d]), uc = bf2f(u[d]), up = bf2f(u[d < hi ? d + 1 : d]);
    return bs + w1 * uc + (d > lo ? w0 : 0.f) * um + (d < hi ? w2 : 0.f) * up;
}
__device__ __forceinline__ void ph_hyena_fft(const P& p, unsigned char* smem) {
    cf* buf = (cf*)smem; float* fb = (float*)smem; float* red = (float*)(smem + FFT_LDS_CF * 8);
    const int t = TIDX;
    bf16_t* yhT = p.Zh + (size_t)2 * NB * 4 * NCH * 16384;
    for (int ch = blockIdx.x; ch < 512; ch += gridDim.x) {
        const bf16_t* hy0 = p.hyT + ((size_t)0 * 512 + ch) * RB;
        const size_t bstr = (size_t)3 * 512 * RB, jstr = (size_t)512 * RB;
        cf* Hg = (cf*)p.H + (size_t)blockIdx.x * 16384;
        cf zreg[16];
        float cw[3][3], cbv[3];
#pragma unroll
        for (int j = 0; j < 3; ++j) { cbv[j] = p.in[12][j * 512 + ch];
#pragma unroll
            for (int q = 0; q < 3; ++q) cw[j][q] = p.in[11][q * 1536 + j * 512 + ch]; }
#pragma unroll 1
        for (int n = 0; n < 2; ++n) {
            const int cfi = (n * 2) * 512 + ch, cbi = (n * 2 + 1) * 512 + ch;
            const float* Ff = p.FILT + (size_t)cfi * RB; const float* Fb = p.FILT + (size_t)cbi * RB;
            float tf0[8], tf1[8], tb2[8], tb3[8]; float sf = 0.f, sb = 0.f;
#pragma unroll
            for (int j = 0; j < 8; ++j) { const int m = t + 512 * j;
                tf0[j] = Ff[m]; tf1[j] = Ff[4096 + m]; tb2[j] = Fb[m == 0 ? 0 : 8192 - m]; tb3[j] = Fb[4096 - m];
                sf += tf0[j] * tf0[j] + tf1[j] * tf1[j]; sb += tb2[j] * tb2[j] + tb3[j] * tb3[j]; }
            const float nf = 1.f / sqrtf(block_sum(sf, red)), nb = 1.f / sqrtf(block_sum(sb, red));
#pragma unroll
            for (int j = 0; j < 8; ++j) { const int m = launder_i(t) + 512 * j;
                const float v0 = tf0[j] * nf + ((m == 0) ? tb2[j] * nb : 0.f), v2 = (m == 0) ? 0.f : tb2[j] * nb;
                stA_fwd(m, cf{v0, 0.f}, cf{tf1[j] * nf, 0.f}, cf{v2, 0.f}, cf{tb3[j] * nb, 0.f}, buf); }
            __syncthreads();
#pragma unroll 1
            for (int q = 0; q < 2; ++q) stB_fwd(launder_i(t) + 512 * q, buf);
            __syncthreads();
#pragma unroll 1
            for (int q = 0; q < 2; ++q) stC_fwd(launder_i(t) + 512 * q, buf);
            __syncthreads();
#pragma unroll 1
            for (int q = 0; q < 2; ++q) { const int g = launder_i(t) + 512 * q; cf hh[16]; stD_fwd_regs(g, buf, hh);
#pragma unroll
                for (int s = 0; s < 16; ++s) Hg[s * 1024 + g] = hh[s]; }
            __syncthreads();
#pragma unroll
            for (int j = 0; j < 8; ++j) { const int m = launder_i(t) + 512 * j;
                if (n == 0) { zreg[2 * j] = cf{dw3(hy0 + 2 * jstr, m, 0, L - 1, cw[2][0], cw[2][1], cw[2][2], cbv[2]), dw3(hy0 + bstr + 2 * jstr, m, 0, L - 1, cw[2][0], cw[2][1], cw[2][2], cbv[2])};
                              zreg[2 * j + 1] = cf{dw3(hy0 + 2 * jstr, 4096 + m, 0, L - 1, cw[2][0], cw[2][1], cw[2][2], cbv[2]), dw3(hy0 + bstr + 2 * jstr, 4096 + m, 0, L - 1, cw[2][0], cw[2][1], cw[2][2], cbv[2])}; }
                stA_fwd(m, zreg[2 * j], zreg[2 * j + 1], cf{0.f, 0.f}, cf{0.f, 0.f}, buf); }
            __syncthreads();
#pragma unroll 1
            for (int q = 0; q < 2; ++q) stB_fwd(launder_i(t) + 512 * q, buf);
            __syncthreads();
#pragma unroll 1
            for (int q = 0; q < 2; ++q) stC_fwd(launder_i(t) + 512 * q, buf);
            __syncthreads();
#pragma unroll 1
            for (int q = 0; q < 2; ++q) { const int g = launder_i(t) + 512 * q; cf hh[16];
#pragma unroll
                for (int s = 0; s < 16; ++s) hh[s] = Hg[s * 1024 + g];
                stD_mul(g, buf, hh); }
            __syncthreads();
#pragma unroll 1
            for (int q = 0; q < 2; ++q) stC_inv(launder_i(t) + 512 * q, buf);
            __syncthreads();
#pragma unroll 1
            for (int q = 0; q < 2; ++q) stB_inv(launder_i(t) + 512 * q, buf);
            __syncthreads();
            const float sk = p.in[21][n * 512 + ch];
#pragma unroll
            for (int j = 0; j < 8; ++j) { const int m = launder_i(t) + 512 * j; cf r0, r1; stA_inv(m, buf, r0, r1);
#pragma unroll
                for (int hlf = 0; hlf < 2; ++hlf) { const int d = m + 4096 * hlf; const cf r = hlf ? r1 : r0; const cf z = zreg[2 * j + hlf];
                    const bf16_t* gs = hy0 + n * jstr;
                    const float g0 = dw3(gs, d, 0, L - 1, cw[n][0], cw[n][1], cw[n][2], cbv[n]), g1 = dw3(gs + bstr, d, 0, L - 1, cw[n][0], cw[n][1], cw[n][2], cbv[n]);
                    const float o0 = g0 * (r.x * (1.f / 16384.f) + sk * z.x), o1 = g1 * (r.y * (1.f / 16384.f) + sk * z.y);
                    if (n == 0) zreg[2 * j + hlf] = cf{o0, o1};
                    else { yhT[((size_t)0 * 512 + ch) * RB + d] = f2bf(o0); yhT[((size_t)1 * 512 + ch) * RB + d] = f2bf(o1); } } }
            __syncthreads();
        }
        {
            float* tap = fb;
            float* zc = fb + 1024;
            const int b = t >> 8, tt = t & 255;
#pragma unroll
            for (int n = 0; n < 2; ++n) {
                const int cfi = (n * 2) * 512 + ch, cbi = (n * 2 + 1) * 512 + ch;
                const float* Ff = p.FILT + (size_t)cfi * RB + L; const float* Fb = p.FILT + (size_t)cbi * RB + L;
                const float vf = t < 256 ? Ff[t] : 0.f, vb = t < 256 ? Fb[t] : 0.f;
                const float nf = 1.f / sqrtf(block_sum(vf * vf, red)), nb = 1.f / sqrtf(block_sum(vb * vb, red));
                if (t < 511) { const int d = t - 255; tap[n * 512 + t] = d > 0 ? Ff[d] * nf : (d < 0 ? Fb[-d] * nb : Ff[0] * nf + Fb[0] * nb); }
            }
            const bf16_t* hb_ = hy0 + (size_t)b * bstr;
            const float z1 = dw3(hb_ + 2 * jstr, L + tt, L, RB - 1, cw[2][0], cw[2][1], cw[2][2], cbv[2]);
            zc[b * 256 + tt] = z1;
            __syncthreads();
            float c1 = 0.f;
            for (int s = 0; s < 256; ++s) c1 += tap[tt - s + 255] * zc[b * 256 + s];
            const float z2 = dw3(hb_, L + tt, L, RB - 1, cw[0][0], cw[0][1], cw[0][2], cbv[0]) * (c1 + p.in[21][ch] * z1);
            __syncthreads();
            zc[b * 256 + tt] = z2;
            __syncthreads();
            float c2 = 0.f;
            for (int s = 0; s < 256; ++s) c2 += tap[512 + tt - s + 255] * zc[b * 256 + s];
            yhT[((size_t)b * 512 + ch) * RB + L + tt] = f2bf(dw3(hb_ + jstr, L + tt, L, RB - 1, cw[1][0], cw[1][1], cw[1][2], cbv[1]) * (c2 + p.in[21][512 + ch] * z2));
            __syncthreads();
        }
    }
}

typedef short bf16x8 __attribute__((ext_vector_type(8)));
typedef short s16x4 __attribute__((ext_vector_type(4)));
typedef float f32x4 __attribute__((ext_vector_type(4)));
typedef unsigned u4v __attribute__((ext_vector_type(4)));
typedef unsigned u2v __attribute__((ext_vector_type(2)));
constexpr int LDT = 136;
constexpr int TILE_E = 128 * LDT;
__device__ __forceinline__ bf16x8 frag_row(const LAS bf16_t* T, int ld, int r0, int k0, int lane) {
    return *(const LAS bf16x8*)(T + (r0 + (lane & 15)) * ld + k0 + 8 * (lane >> 4));
}
__device__ __forceinline__ bf16x8 frag_tr(const LAS bf16_t* T, int ld, int k0, int n0, int lane) {
    const int g = lane >> 4, q = (lane & 15) >> 2, pp = lane & 3;
    const LAS bf16_t* a0 = T + (k0 + 8 * g + q) * ld + n0 + 4 * pp;
    const s16x4 lo = __builtin_amdgcn_ds_read_tr16_b64_v4i16((LAS s16x4*)a0);
    const s16x4 hi = __builtin_amdgcn_ds_read_tr16_b64_v4i16((LAS s16x4*)(a0 + 4 * ld));
    return (bf16x8){lo[0], lo[1], lo[2], lo[3], hi[0], hi[1], hi[2], hi[3]};
}
#define MFMA16(xn, xm, acc) __builtin_amdgcn_mfma_f32_16x16x32_bf16(xn, xm, acc, 0, 0, 0)
__device__ __forceinline__ void unpack8(const u4v u, float (&f)[8]) {
    f[0] = __uint_as_float(u.x << 16); f[1] = __uint_as_float(u.x & 0xffff0000u); f[2] = __uint_as_float(u.y << 16); f[3] = __uint_as_float(u.y & 0xffff0000u);
    f[4] = __uint_as_float(u.z << 16); f[5] = __uint_as_float(u.z & 0xffff0000u); f[6] = __uint_as_float(u.w << 16); f[7] = __uint_as_float(u.w & 0xffff0000u);
}
__device__ __forceinline__ u4v pack8(const float (&f)[8]) {
    u4v u; u.x = pk_bf16(f[0], f[1]); u.y = pk_bf16(f[2], f[3]); u.z = pk_bf16(f[4], f[5]); u.w = pk_bf16(f[6], f[7]); return u;
}
__device__ __forceinline__ void stage_tile(LAS bf16_t* dst, const bf16_t* src, int gld, int tid) {
#pragma unroll
    for (int i = 0; i < 4; ++i) { const int c = tid + 512 * i, row = c >> 4, ch = c & 15;
        *(LAS u4v*)(dst + row * LDT + ch * 8) = *(const u4v*)(src + (size_t)row * gld + ch * 8); }
}
__device__ __forceinline__ void ph_retU_mfma(const P& p, unsigned char* smem) {
    LAS bf16_t* Kt = (LAS bf16_t*)smem; LAS bf16_t* VF = Kt + TILE_E; LAS bf16_t* VB = VF + TILE_E;
    bf16_t* ST = p.Zh;
    for (int u = blockIdx.x; u < NB * 4 * NCH; u += gridDim.x) {
        const int tid = TIDX, lane = tid & 63, w = tid >> 6;
        const int c = u % NCH, h = (u / NCH) % 4, b = u / (NCH * 4); const int r0 = chunk_row0(b, c);
        const float lgf = p.in[9][h], lgb = p.in[10][h];
        const bf16_t* kb = p.Zr + (size_t)r0 * 2048 + 512 + h * 128; const bf16_t* vb = p.Zr + (size_t)r0 * 2048 + 1024 + h * 128;
        __syncthreads();
        stage_tile(Kt, kb, 2048, tid);
#pragma unroll
        for (int i = 0; i < 4; ++i) { const int cc = tid + 512 * i, j = cc >> 4, ch = cc & 15;
            float f[8], g[8]; unpack8(*(const u4v*)(vb + (size_t)j * 2048 + ch * 8), f);
            const float wf = __expf(lgf * (float)(127 - j)), wb = __expf(lgb * (float)j);
#pragma unroll
            for (int q = 0; q < 8; ++q) { g[q] = f[q] * wb; f[q] *= wf; }
            *(LAS u4v*)(VF + j * LDT + ch * 8) = pack8(f); *(LAS u4v*)(VB + j * LDT + ch * 8) = pack8(g); }
        __syncthreads();
        f32x4 af[8], ab[8];
#pragma unroll
        for (int nt = 0; nt < 8; ++nt) { af[nt] = (f32x4){0.f, 0.f, 0.f, 0.f}; ab[nt] = (f32x4){0.f, 0.f, 0.f, 0.f}; }
#pragma unroll
        for (int ks = 0; ks < 4; ++ks) {
            const bf16x8 xf = frag_tr(VF, LDT, 32 * ks, 16 * w, lane), xb = frag_tr(VB, LDT, 32 * ks, 16 * w, lane);
#pragma unroll
            for (int nt = 0; nt < 8; ++nt) { const bf16x8 xn = frag_tr(Kt, LDT, 32 * ks, 16 * nt, lane); af[nt] = MFMA16(xn, xf, af[nt]); ab[nt] = MFMA16(xn, xb, ab[nt]); }
        }
        const int e = 16 * w + (lane & 15), d0 = 4 * (lane >> 4);
        bf16_t* of = ST + st_idx(0, b, h, c) + e * 128 + d0; bf16_t* ob = ST + st_idx(1, b, h, c) + e * 128 + d0;
#pragma unroll
        for (int nt = 0; nt < 8; ++nt) {
            u2v o; o.x = pk_bf16(af[nt][0], af[nt][1]); o.y = pk_bf16(af[nt][2], af[nt][3]); *(u2v*)(of + 16 * nt) = o;
            o.x = pk_bf16(ab[nt][0], ab[nt][1]); o.y = pk_bf16(ab[nt][2], ab[nt][3]); *(u2v*)(ob + 16 * nt) = o; }
    }
}
__device__ __forceinline__ void ph_retO_mfma(const P& p, unsigned char* smem) {
    LAS bf16_t* Qs = (LAS bf16_t*)smem; LAS bf16_t* Ks = Qs + TILE_E; LAS bf16_t* Vs = Ks + TILE_E; LAS bf16_t* Ss = Vs + TILE_E;
    const bf16_t* ST = p.Zh;
    for (int u = blockIdx.x; u < NB * 4 * NCH; u += gridDim.x) {
        const int tid = TIDX, lane = tid & 63, w = tid >> 6, fr = lane & 15, fq = lane >> 4;
        const int c = u % NCH, h = (u / NCH) % 4, b = u / (NCH * 4); const int r0 = chunk_row0(b, c);
        const float lgf = p.in[9][h], lgb = p.in[10][h];
        const bf16_t* zb = p.Zr + (size_t)r0 * 2048 + h * 128;
        __syncthreads();
        stage_tile(Qs, zb, 2048, tid); stage_tile(Ks, zb + 512, 2048, tid); stage_tile(Vs, zb + 1024, 2048, tid); stage_tile(Ss, ST + st_idx(0, b, h, c), 128, tid);
        __syncthreads();
        f32x4 as[8], af[8];
#pragma unroll
        for (int nt = 0; nt < 8; ++nt) { as[nt] = (f32x4){0.f, 0.f, 0.f, 0.f}; af[nt] = (f32x4){0.f, 0.f, 0.f, 0.f}; }
#pragma unroll
        for (int ks = 0; ks < 4; ++ks) { const bf16x8 xm = frag_row(Qs, LDT, 16 * w, 32 * ks, lane);
#pragma unroll
            for (int nt = 0; nt < 8; ++nt) { as[nt] = MFMA16(frag_row(Ks, LDT, 16 * nt, 32 * ks, lane), xm, as[nt]); af[nt] = MFMA16(frag_row(Ss, LDT, 16 * nt, 32 * ks, lane), xm, af[nt]); } }
        const int i = 16 * w + fr;
        __syncthreads();
#pragma unroll
        for (int nt = 0; nt < 8; ++nt) { float pv[4];
#pragma unroll
            for (int q = 0; q < 4; ++q) { const int j = 16 * nt + 4 * fq + q; const float ea = i > j ? lgf * (float)(i - j) : lgb * (float)(j - i); const float m = (i == j) ? 2.f : __expf(ea); pv[q] = as[nt][q] * m; }
            u2v o; o.x = pk_bf16(pv[0], pv[1]); o.y = pk_bf16(pv[2], pv[3]); *(LAS u2v*)(Ks + i * LDT + 16 * nt + 4 * fq) = o; }
        stage_tile(Ss, ST + st_idx(1, b, h, c), 128, tid);
        __syncthreads();
        f32x4 ao[8], ab[8];
#pragma unroll
        for (int nt = 0; nt < 8; ++nt) { ao[nt] = (f32x4){0.f, 0.f, 0.f, 0.f}; ab[nt] = (f32x4){0.f, 0.f, 0.f, 0.f}; }
#pragma unroll
        for (int ks = 0; ks < 4; ++ks) { const bf16x8 xp = frag_row(Ks, LDT, 16 * w, 32 * ks, lane), xq = frag_row(Qs, LDT, 16 * w, 32 * ks, lane);
#pragma unroll
            for (int nt = 0; nt < 8; ++nt) { ao[nt] = MFMA16(frag_tr(Vs, LDT, 32 * ks, 16 * nt, lane), xp, ao[nt]); ab[nt] = MFMA16(frag_row(Ss, LDT, 16 * nt, 32 * ks, lane), xq, ab[nt]); } }
        const float rf = __expf(lgf * (float)(i + 1)), rb = __expf(lgb * (float)(128 - i));
        float s = 0.f;
#pragma unroll
        for (int nt = 0; nt < 8; ++nt) { ao[nt] = ao[nt] + af[nt] * rf + ab[nt] * rb; s += (ao[nt][0] + ao[nt][1]) + (ao[nt][2] + ao[nt][3]); }
        s += __shfl_xor(s, 16); s += __shfl_xor(s, 32);
        const float mu = s * (1.f / 128.f); float qv = 0.f;
#pragma unroll
        for (int nt = 0; nt < 8; ++nt) { const f32x4 dd = ao[nt] - mu; qv += (dd[0] * dd[0] + dd[1] * dd[1]) + (dd[2] * dd[2] + dd[3] * dd[3]); }
        qv += __shfl_xor(qv, 16); qv += __shfl_xor(qv, 32);
        const float rs = 1.f / sqrtf(qv * (1.f / 128.f) + LN_EPS);
        const bf16_t* gp = p.Zr + (size_t)(r0 + i) * 2048 + 1536 + h * 128 + 4 * fq; bf16_t* yp = p.H + (size_t)(r0 + i) * D + h * 128 + 4 * fq;
#pragma unroll
        for (int nt = 0; nt < 8; ++nt) { const u2v gu = *(const u2v*)(gp + 16 * nt);
            const float g0 = __uint_as_float(gu.x << 16), g1 = __uint_as_float(gu.x & 0xffff0000u), g2 = __uint_as_float(gu.y << 16), g3 = __uint_as_float(gu.y & 0xffff0000u);
            u2v o; o.x = pk_bf16((ao[nt][0] - mu) * rs * siluf(g0), (ao[nt][1] - mu) * rs * siluf(g1)); o.y = pk_bf16((ao[nt][2] - mu) * rs * siluf(g2), (ao[nt][3] - mu) * rs * siluf(g3));
            *(u2v*)(yp + 16 * nt) = o; }
    }
}
__device__ __forceinline__ void ph_glaU_mfma(const P& p, unsigned char* smem) {
    LAS bf16_t* KF = (LAS bf16_t*)smem; LAS bf16_t* KB = KF + TILE_E; LAS bf16_t* Vs = KB + TILE_E;
    for (int u = blockIdx.x; u < NB * 4 * NCH; u += gridDim.x) {
        const int tid = TIDX, lane = tid & 63, w = tid >> 6;
        const int c = u % NCH, h = (u / NCH) % 4, b = u / (NCH * 4); const int r0 = chunk_row0(b, c);
        const bf16_t* kb = p.Z1 + (size_t)r0 * GINP + 512 + h * 128; const bf16_t* vb = p.Z1 + (size_t)r0 * GINP + 1024 + h * 256;
        float* BFw = p.BG + (size_t)r0 * 512 + h * 128; float* BBw = p.BG + (size_t)R * 512 + (size_t)r0 * 512 + h * 128;
        const float* BF = BFw; const float* BB = BBw;
        __syncthreads();
        {
            float* lr = (float*)(Vs);
            float* tot = lr + 128 * 32;
            for (int e = tid; e < 128 * 32; e += NT) lr[e] = bf2f(p.Z1[(size_t)(r0 + (e >> 5)) * GINP + 3072 + (e & 31)]);
            const int chn = tid & 127, dir = (tid >> 7) & 1, half = tid >> 8;
            const float* gw = (dir ? p.in[26] : p.in[24]) + h * 128 + chn; float g[16];
#pragma unroll
            for (int q = 0; q < 16; ++q) g[q] = gw[q * 512];
            const float gb = (dir ? p.in[27] : p.in[25])[h * 128 + chn];
            __syncthreads();
            float la[64]; float s = 0.f;
#pragma unroll
            for (int ii = 0; ii < 64; ++ii) { const int i = half * 64 + ii; float a = gb;
#pragma unroll
                for (int q = 0; q < 16; ++q) a += lr[i * 32 + dir * 16 + q] * g[q];
                la[ii] = (fminf(a, 0.f) - __logf(1.f + __expf(-fabsf(a)))) * (1.f / 16.f); s += la[ii]; }
            tot[(dir * 2 + half) * 128 + chn] = s;
            __syncthreads();
            const float total = tot[(dir * 2 + 0) * 128 + chn] + tot[(dir * 2 + 1) * 128 + chn];
            s = dir == 0 ? (half ? tot[(0 * 2 + 0) * 128 + chn] : 0.f) : (half ? 0.f : tot[(1 * 2 + 1) * 128 + chn]);
            float* out = (dir ? BBw : BFw) + chn; LAS bf16_t* Kd = dir ? KB : KF;
            if (dir == 0) {
#pragma unroll
                for (int ii = 0; ii < 64; ++ii) { const int i = half * 64 + ii; s += la[ii]; out[(size_t)i * 512] = s; Kd[i * LDT + chn] = f2bf(bf2f(kb[(size_t)i * GINP + chn]) * __expf(total - s)); }
            } else {
#pragma unroll
                for (int ii = 63; ii >= 0; --ii) { const int i = half * 64 + ii; s += la[ii]; out[(size_t)i * 512] = s; Kd[i * LDT + chn] = f2bf(bf2f(kb[(size_t)i * GINP + chn]) * __expf(total - s)); }
            }
            __syncthreads();
        }
        const int fr = lane & 15, fq = lane >> 4;
#pragma unroll 1
        for (int hf = 0; hf < 2; ++hf) {
            if (hf) __syncthreads();
            stage_tile(Vs, vb + hf * 128, GINP, tid);
            __syncthreads();
            {
                f32x4 af[8], ab[8];
#pragma unroll
                for (int nt = 0; nt < 8; ++nt) { af[nt] = (f32x4){0.f, 0.f, 0.f, 0.f}; ab[nt] = (f32x4){0.f, 0.f, 0.f, 0.f}; }
#pragma unroll
                for (int ks = 0; ks < 4; ++ks) { const bf16x8 x0 = frag_tr(Vs, LDT, 32 * ks, 16 * w, lane);
#pragma unroll
                    for (int nt = 0; nt < 8; ++nt) { af[nt] = MFMA16(frag_tr(KF, LDT, 32 * ks, 16 * nt, lane), x0, af[nt]); ab[nt] = MFMA16(frag_tr(KB, LDT, 32 * ks, 16 * nt, lane), x0, ab[nt]); } }
                bf16_t* of = p.GST + gst_idx(0, b, h, c) + (size_t)(hf * 128 + 16 * w + fr) * 128 + 4 * fq; bf16_t* ob = p.GST + gst_idx(1, b, h, c) + (size_t)(hf * 128 + 16 * w + fr) * 128 + 4 * fq;
#pragma unroll
                for (int nt = 0; nt < 8; ++nt) { u2v v; v.x = pk_bf16(af[nt][0], af[nt][1]); v.y = pk_bf16(af[nt][2], af[nt][3]); *(u2v*)(of + 16 * nt) = v;
                    v.x = pk_bf16(ab[nt][0], ab[nt][1]); v.y = pk_bf16(ab[nt][2], ab[nt][3]); *(u2v*)(ob + 16 * nt) = v; }
            }
        }
    }
}
__device__ __forceinline__ void stage_scaled(LAS bf16_t* dst, const bf16_t* src, const float* G, float sgn, float mul, int tid) {
#pragma unroll
    for (int i = 0; i < 4; ++i) { const int cc = tid + 512 * i, j = cc >> 4, ch = cc & 15;
        float k8[8]; unpack8(*(const u4v*)(src + (size_t)j * GINP + ch * 8), k8);
        const f32x4 f0 = *(const f32x4*)(G + (size_t)j * 512 + ch * 8), f1 = *(const f32x4*)(G + (size_t)j * 512 + ch * 8 + 4);
#pragma unroll
        for (int q = 0; q < 4; ++q) { k8[q] *= __expf(sgn * f0[q]) * mul; k8[q + 4] *= __expf(sgn * f1[q]) * mul; }
        *(LAS u4v*)(dst + j * LDT + ch * 8) = pack8(k8); }
}
__device__ __forceinline__ void ph_glaO_mfma(const P& p, unsigned char* smem) {
    LAS bf16_t* QF = (LAS bf16_t*)smem; LAS bf16_t* QB = QF + TILE_E; LAS bf16_t* KX = QB + TILE_E; LAS bf16_t* R4 = KX + TILE_E;
    for (int u = blockIdx.x; u < NB * 4 * 64; u += gridDim.x) {
        const int tid = TIDX, lane = tid & 63, w = tid >> 6, fr = lane & 15, fq = lane >> 4;
        const int c = 2 + u % 64, h = (u / 64) % 4, b = u / 256; const int r0 = chunk_row0(b, c);
        const bf16_t* qb = p.Z1 + (size_t)r0 * GINP + h * 128; const bf16_t* kb = qb + 512; const bf16_t* vb = p.Z1 + (size_t)r0 * GINP + 1024 + h * 256;
        const float* BF = p.BG + (size_t)r0 * 512 + h * 128; const float* BB = p.BG + (size_t)R * 512 + (size_t)r0 * 512 + h * 128;
        const int i = 16 * w + fr;
        __syncthreads();
        stage_scaled(QF, qb, BF, 1.f, KSCALE, tid); stage_scaled(QB, qb, BB, 1.f, KSCALE, tid); stage_scaled(KX, kb, BF, -1.f, 1.f, tid);
        __syncthreads();
        f32x4 s1[8];
#pragma unroll
        for (int nt = 0; nt < 8; ++nt) s1[nt] = (f32x4){0.f, 0.f, 0.f, 0.f};
#pragma unroll
        for (int ks = 0; ks < 4; ++ks) { const bf16x8 xm = frag_row(QF, LDT, 16 * w, 32 * ks, lane);
#pragma unroll
            for (int nt = 0; nt < 8; ++nt) s1[nt] = MFMA16(frag_row(KX, LDT, 16 * nt, 32 * ks, lane), xm, s1[nt]); }
#pragma unroll
        for (int nt = 0; nt < 8; ++nt)
#pragma unroll
            for (int q = 0; q < 4; ++q) { const int j = 16 * nt + 4 * fq + q; s1[nt][q] = (i >= j) ? s1[nt][q] : 0.f; }
        __syncthreads();
        stage_scaled(KX, kb, BB, -1.f, 1.f, tid);
        __syncthreads();
        {
            f32x4 s2[8];
#pragma unroll
            for (int nt = 0; nt < 8; ++nt) s2[nt] = (f32x4){0.f, 0.f, 0.f, 0.f};
#pragma unroll
            for (int ks = 0; ks < 4; ++ks) { const bf16x8 xm = frag_row(QB, LDT, 16 * w, 32 * ks, lane);
#pragma unroll
                for (int nt = 0; nt < 8; ++nt) s2[nt] = MFMA16(frag_row(KX, LDT, 16 * nt, 32 * ks, lane), xm, s2[nt]); }
#pragma unroll
            for (int nt = 0; nt < 8; ++nt)
#pragma unroll
                for (int q = 0; q < 4; ++q) { const int j = 16 * nt + 4 * fq + q; s1[nt][q] += (i <= j) ? s2[nt][q] : 0.f; }
        }
        __syncthreads();
#pragma unroll
        for (int nt = 0; nt < 8; ++nt) { u2v o; o.x = pk_bf16(s1[nt][0], s1[nt][1]); o.y = pk_bf16(s1[nt][2], s1[nt][3]); *(LAS u2v*)(KX + i * LDT + 16 * nt + 4 * fq) = o; }
        f32x4 ao[2][8];
#pragma unroll
        for (int hf = 0; hf < 2; ++hf) {
#pragma unroll
            for (int nt = 0; nt < 8; ++nt) ao[hf][nt] = (f32x4){0.f, 0.f, 0.f, 0.f};
            stage_tile(R4, vb + hf * 128, GINP, tid);
            __syncthreads();
#pragma unroll
            for (int ks = 0; ks < 4; ++ks) { const bf16x8 xp = frag_row(KX, LDT, 16 * w, 32 * ks, lane);
#pragma unroll
                for (int nt = 0; nt < 8; ++nt) ao[hf][nt] = MFMA16(frag_tr(R4, LDT, 32 * ks, 16 * nt, lane), xp, ao[hf][nt]); }
            __syncthreads();
            stage_tile(R4, p.GST + gst_idx(0, b, h, c) + (size_t)hf * 128 * 128, 128, tid);
            __syncthreads();
#pragma unroll
            for (int ks = 0; ks < 4; ++ks) { const bf16x8 xq = frag_row(QF, LDT, 16 * w, 32 * ks, lane);
#pragma unroll
                for (int nt = 0; nt < 8; ++nt) ao[hf][nt] = MFMA16(frag_row(R4, LDT, 16 * nt, 32 * ks, lane), xq, ao[hf][nt]); }
            __syncthreads();
            stage_tile(R4, p.GST + gst_idx(1, b, h, c) + (size_t)hf * 128 * 128, 128, tid);
            __syncthreads();
#pragma unroll
            for (int ks = 0; ks < 4; ++ks) { const bf16x8 xq = frag_row(QB, LDT, 16 * w, 32 * ks, lane);
#pragma unroll
                for (int nt = 0; nt < 8; ++nt) ao[hf][nt] = MFMA16(frag_row(R4, LDT, 16 * nt, 32 * ks, lane), xq, ao[hf][nt]); }
            __syncthreads();
        }
        float ss = 0.f;
#pragma unroll
        for (int hf = 0; hf < 2; ++hf)
#pragma unroll
            for (int nt = 0; nt < 8; ++nt) { const f32x4 v = ao[hf][nt]; ss += (v[0] * v[0] + v[1] * v[1]) + (v[2] * v[2] + v[3] * v[3]); }
        ss += __shfl_xor(ss, 16); ss += __shfl_xor(ss, 32);
        const float rs = 1.f / sqrtf(ss * (1.f / 256.f) + LN_EPS);
        const bf16_t* gp = p.Z1 + (size_t)(r0 + i) * GINP + 2048 + h * 256 + 4 * fq; bf16_t* yp = p.H + (size_t)(r0 + i) * D + h * 256 + 4 * fq;
#pragma unroll
        for (int hf = 0; hf < 2; ++hf)
#pragma unroll
            for (int nt = 0; nt < 8; ++nt) { const u2v gu = *(const u2v*)(gp + hf * 128 + 16 * nt);
                const float g0 = __uint_as_float(gu.x << 16), g1 = __uint_as_float(gu.x & 0xffff0000u), g2 = __uint_as_float(gu.y << 16), g3 = __uint_as_float(gu.y & 0xffff0000u);
                u2v o; o.x = pk_bf16(ao[hf][nt][0] * rs * siluf(g0), ao[hf][nt][1] * rs * siluf(g1)); o.y = pk_bf16(ao[hf][nt][2] * rs * siluf(g2), ao[hf][nt][3] * rs * siluf(g3));
                *(u2v*)(yp + hf * 128 + 16 * nt) = o; }
    }
}

template <int MODE> __device__ __forceinline__ void tr_w(bf16_t* dst, const float* src, int N, int K, int ldsrc, float* t  , int& tile0, int tile_stride) {
    const int nt_n = N / 64, ntiles = nt_n * (K / 64);
    float v[8];
    if (tile0 < ntiles) { const int tid = TIDX; const int n0 = (tile0 % nt_n) * 64, k0 = (tile0 / nt_n) * 64;
#pragma unroll
        for (int i = 0; i < 8; ++i) { const int e = tid + 512 * i; v[i] = src[(size_t)(k0 + (e >> 6)) * ldsrc + n0 + (e & 63)]; } }
    for (int tile = tile0; tile < ntiles; tile += tile_stride) {
        const int tid = TIDX; const int n0 = (tile % nt_n) * 64, k0 = (tile / nt_n) * 64;
        __syncthreads();
#pragma unroll
        for (int i = 0; i < 8; ++i) { const int e = tid + 512 * i; t[(e >> 6) * 65 + (e & 63)] = v[i]; }
        __syncthreads();
        if (tile + tile_stride < ntiles) { const int tn = tile + tile_stride; const int n1 = (tn % nt_n) * 64, k1 = (tn / nt_n) * 64;
#pragma unroll
            for (int i = 0; i < 8; ++i) { const int e = tid + 512 * i; v[i] = src[(size_t)(k1 + (e >> 6)) * ldsrc + n1 + (e & 63)]; } }
#pragma unroll
        for (int i = 0; i < 4; ++i) { const int e = tid + 512 * i, nn = e >> 5, kp = e & 31; const int n = n0 + nn;
            int row; float sc = 1.f;
            if (MODE == 0) row = n; else if (MODE == 3) { const int d = n & 127; row = n < 1024 ? (n - d) + 2 * (d & 63) + (d >> 6) : n; sc = (n >= 512 && n < 1024) ? KSCALE : 1.f; }
            else row = 8 * (n >> 2) + (n & 3) + (MODE == 2 ? 4 : 0);
            *(unsigned*)(dst + (size_t)row * K + k0 + 2 * kp) = pk_bf16(t[(2 * kp) * 65 + nn] * sc, t[(2 * kp + 1) * 65 + nn] * sc); }
    }
    tile0 = tile0 - (ntiles % tile_stride);
    if (tile0 < 0) tile0 += tile_stride;
}
__device__ __forceinline__ void ph_wconv_l0(const P& p, float* t) {
    int t0 = blockIdx.x; const int G = gridDim.x;
    tr_w<3>(p.Win0, p.in[8], ABIN, D, ABIN, t, t0, G);
    tr_w<0>(p.Wout0, p.in[22], D, D, D, t, t0, G);
}
__device__ __forceinline__ void ph_wconv_l1(const P& p, float* t) {
    int t0 = blockIdx.x; const int G = gridDim.x;
    tr_w<0>(p.Win1, p.in[23], 3072, D, GIN, t, t0, G);
    tr_w<0>(p.Wout1, p.in[28], D, D, D, t, t0, G);
    GSTRIDE(idx, (long)(GINP - 3072) * D) { const int k = idx % D, n = 3072 + idx / D; p.Win1[(size_t)n * D + k] = n < GIN ? f2bf(p.in[23][(size_t)k * GIN + n]) : (bf16_t)0; }
}
__device__ __forceinline__ void ph_wconv_moe_part(const P& p, int l, int part, float* t, int t0, int stride) {
    if (t0 < 0) return;
    for (int e = 0; e < NE; ++e) {
        if (part == 0) { tr_w<1>(p.Wgu + (size_t)e * 1024 * 1024, p.in[31] + (size_t)(l * NE + e) * D * EH, EH, D, EH, t, t0, stride);
                         tr_w<2>(p.Wgu + (size_t)e * 1024 * 1024, p.in[32] + (size_t)(l * NE + e) * D * EH, EH, D, EH, t, t0, stride); }
        else tr_w<0>(p.Wd + (size_t)e * 1024 * 512, p.in[33] + (size_t)(l * NE + e) * EH * D, D, EH, D, t, t0, stride);
    }
}
__device__ __forceinline__ void ph_wconv_moe_fast(const P& p, int l, float* t) { ph_wconv_moe_part(p, l, 0, t, blockIdx.x, gridDim.x); ph_wconv_moe_part(p, l, 1, t, blockIdx.x, gridDim.x); }
__device__ __forceinline__ void ph_prep_hy_fast(const P& p, float* t  ) {
    const int ntt = RB / 64, ntc = 1536 / 64;
    for (int tile = blockIdx.x; tile < NB * ntt * ntc; tile += gridDim.x) {
        const int tid = TIDX; const int ct = tile % ntc, tt = (tile / ntc) % ntt, b = tile / (ntc * ntt); const int c0 = ct * 64, tl0 = tt * 64;
        const int s0 = tl0 < L ? 0 : L, s1 = tl0 < L ? L : RB;
        __syncthreads();
        for (int e = tid; e < 66 * 64; e += NT) { const int rr = e >> 6, cc = e & 63, tl = tl0 - 1 + rr;
            t[rr * 65 + cc] = (tl >= s0 && tl < s1) ? bf2f(p.Zh[(size_t)bt_row(b, tl) * 1536 + c0 + cc]) : 0.f; }
        __syncthreads();
#pragma unroll
        for (int i = 0; i < 4; ++i) { const int e = tid + 512 * i, cc = e >> 5, tp = e & 31; const int col = c0 + cc;
            const float w0 = p.in[11][col], w1 = p.in[11][1536 + col], w2 = p.in[11][3072 + col], bs = p.in[12][col];
            const float a = bs + w0 * t[(2 * tp) * 65 + cc] + w1 * t[(2 * tp + 1) * 65 + cc] + w2 * t[(2 * tp + 2) * 65 + cc];
            const float c2 = bs + w0 * t[(2 * tp + 1) * 65 + cc] + w1 * t[(2 * tp + 2) * 65 + cc] + w2 * t[(2 * tp + 3) * 65 + cc];
            *(unsigned*)(p.hyT + ((size_t)b * 1536 + col) * RB + tl0 + 2 * tp) = pk_bf16(a, c2); }
    }
}
__device__ __forceinline__ void ph_hy_untranspose_fast(const P& p, float* t) {
    const bf16_t* yhT = p.Zh + (size_t)2 * NB * 4 * NCH * 16384;
    const int ntt = RB / 64, ntc = 512 / 64;
    for (int tile = blockIdx.x; tile < NB * ntt * ntc; tile += gridDim.x) {
        const int tid = TIDX; const int ct = tile % ntc, tt = (tile / ntc) % ntt, b = tile / (ntc * ntt); const int c0 = ct * 64, tl0 = tt * 64;
        __syncthreads();
#pragma unroll
        for (int i = 0; i < 8; ++i) { const int e = tid + 512 * i, cc = e >> 6, ti = e & 63; t[cc * 65 + ti] = bf2f(yhT[((size_t)b * 512 + c0 + cc) * RB + tl0 + ti]); }
        __syncthreads();
#pragma unroll
        for (int i = 0; i < 4; ++i) { const int e = tid + 512 * i, ti = e >> 5, cp = e & 31;
            *(unsigned*)(p.H + (size_t)bt_row(b, tl0 + ti) * D + 512 + c0 + 2 * cp) = pk_bf16(t[(2 * cp) * 65 + ti], t[(2 * cp + 1) * 65 + ti]); }
    }
}
__device__ __forceinline__ void ph_prep_rope_fast(const P& p) {
    GSTRIDE(idx, (long)R * 2 * 4 * 8) {
        const int pc = idx % 8, h = (idx / 8) % 4, w = (idx / 32) % 2, r = idx / 64;
        bf16_t* base = p.Zr + (size_t)r * 2048 + w * 512 + h * 128 + pc * 8;
        float a[8], c[8]; unpack8(*(const u4v*)base, a); unpack8(*(const u4v*)(base + 64), c);
        const float sc = w ? KSCALE : 1.f;
        if (r < RL) {
            const int t = r % L; const float pos = (pc < 4) ? (float)(t / GW) : (float)(t % GW);
#pragma unroll
            for (int q = 0; q < 8; ++q) { const int pr = pc * 8 + q; const float inv = exp2f(-(float)(pr & 31) * (13.287712379549449f / 32.f));
                float sn, cs; sincosf(pos * inv, &sn, &cs); const float x1 = a[q] * sc, x2 = c[q] * sc; a[q] = x1 * cs - x2 * sn; c[q] = x1 * sn + x2 * cs; }
        } else {
#pragma unroll
            for (int q = 0; q < 8; ++q) { a[q] *= sc; c[q] *= sc; }
        }
        *(u4v*)base = pack8(a); *(u4v*)(base + 64) = pack8(c);
    }
}
__device__ __forceinline__ void ph_mod_fast(const P& p, int l, int which, const float* xl  , const float* xc  ) {
    const int lane = TIDX & 63, gw = blockIdx.x * (NT / 64) + (TIDX >> 6), ngw = gridDim.x * (NT / 64);
    for (int r = gw; r < R; r += ngw) {
        const float* x = r < RL ? xl + (size_t)r * D : xc + (size_t)(r - RL) * D; const float* sh = modv(p, l, r, which * 3 + 0); const float* sc = modv(p, l, r, which * 3 + 1);
#pragma unroll
        for (int i = 0; i < 4; ++i) { const int k = 4 * lane + 256 * i; const f32x4 xv = *(const f32x4*)(x + k), s = *(const f32x4*)(sc + k), hh = *(const f32x4*)(sh + k);
            u2v o; o.x = pk_bf16(xv[0] * (1.f + s[0]) + hh[0], xv[1] * (1.f + s[1]) + hh[1]); o.y = pk_bf16(xv[2] * (1.f + s[2]) + hh[2], xv[3] * (1.f + s[3]) + hh[3]);
            *(u2v*)(p.H + (size_t)r * D + k) = o; }
    }
}

__device__ __forceinline__ void ph_rope_table(const P& p) {
    GSTRIDE(idx, 128 * 32) { const int f = idx & 31, pos = idx >> 5; float sn, cs; sincosf((float)pos * exp2f(-(float)f * (13.287712379549449f / 32.f)), &sn, &cs); p.A2[2 * idx] = cs; p.A2[2 * idx + 1] = sn; }
}
__device__ __forceinline__ void ph_filters(const P& p, unsigned char* smem) {
    float* lds = (float*)smem;
    float* aA = lds;
    float* aB = lds + 64 * 65;
    LAS bf16_t* A3 = (LAS bf16_t*)(smem + 2 * 64 * 65 * 4);
    LAS bf16_t* Ws = A3 + 64 * 72;
    float* mw = (float*)(smem + 2 * 64 * 65 * 4 + 64 * 72 * 2 + 64 * 264 * 2);
    const float mind = logf(1e-2f) / 1.5f, maxd = logf(1e-2f) / 0.3f;
    __syncthreads();
    for (int e = TIDX; e < 33 * 64; e += NT) mw[e] = p.in[13][e];
    for (int e = TIDX; e < 64 * 64; e += NT) { mw[2112 + e] = p.in[15][e]; mw[2112 + 4096 + e] = p.in[17][e]; }
    if (TIDX < 64) { mw[10304 + TIDX] = p.in[14][TIDX]; mw[10368 + TIDX] = p.in[16][TIDX]; mw[10432 + TIDX] = p.in[18][TIDX]; }
    if (TIDX < 192) mw[10496 + TIDX] = p.in[20][TIDX];
    for (int u = blockIdx.x; u < RB / 33; u += gridDim.x) {
        const int tid = TIDX; const int p0 = u * 33; const int pos = tid & 63, jg = tid >> 6, lane = tid & 63, w = tid >> 6;
        f32x4 wv[8];
#pragma unroll
        for (int i = 0; i < 8; ++i) { const int e = tid + 512 * i; wv[i] = *(const f32x4*)(p.in[19] + (size_t)(e >> 6) * 2048 + 4 * (e & 63)); }
        __syncthreads();
        for (int e = tid; e < 64 * 33; e += NT) { const int ps = e & 63, m = e >> 6; int ln2, i2; hy_pos(p0 + ps, ln2, i2);
            const float rv = (float)i2 / (float)ln2; float v;
            const int q = (m - 1) & 15; const float fr_ = (1e-4f + (float)q * ((15.f - 1e-4f) / 15.f)) * rv; const float fr2 = fr_ - floorf(fr_);
            v = m == 0 ? (float)i2 / (float)(ln2 - 1) : (m <= 16 ? __builtin_amdgcn_cosf(fr2) : -__builtin_amdgcn_sinf(fr2));
            aB[ps * 65 + m] = v; }
        __syncthreads();
        {
            float acc[8];
#pragma unroll
            for (int q = 0; q < 8; ++q) acc[q] = mw[10304 + jg * 8 + q];
#pragma unroll 3
            for (int m = 0; m < 33; ++m) { const float a = aB[pos * 65 + m];
#pragma unroll
                for (int q = 0; q < 8; ++q) acc[q] += a * mw[m * 64 + jg * 8 + q]; }
#pragma unroll
            for (int q = 0; q < 8; ++q) aA[pos * 65 + jg * 8 + q] = __sinf(mw[10496 + jg * 8 + q] * acc[q]);
        }
        __syncthreads();
#pragma unroll 1
        for (int layer = 0; layer < 2; ++layer) {
            const float* W = mw + 2112 + 4096 * layer; const float* Bv = mw + 10368 + 64 * layer; const float* Fq = mw + 10496 + 64 * (layer + 1);
            float* src = layer ? aB : aA; float* dst = layer ? aA : aB;
            float acc[8];
#pragma unroll
            for (int q = 0; q < 8; ++q) acc[q] = Bv[jg * 8 + q];
#pragma unroll 4
            for (int m = 0; m < 64; ++m) { const float a = src[pos * 65 + m];
#pragma unroll
                for (int q = 0; q < 8; ++q) acc[q] += a * W[m * 64 + jg * 8 + q]; }
#pragma unroll
            for (int q = 0; q < 8; ++q) { const float v = __sinf(Fq[jg * 8 + q] * acc[q]); dst[pos * 65 + jg * 8 + q] = v; if (layer == 1 && pos < 48) A3[pos * 72 + jg * 8 + q] = f2bf(v); }
            __syncthreads();
        }
        float tpos[3];
#pragma unroll
        for (int mt = 0; mt < 3; ++mt) { int len, i0; hy_pos(p0 + 16 * mt + (lane & 15), len, i0); tpos[mt] = (float)i0 / (float)(len - 1); }
#pragma unroll 1
        for (int cq = 0; cq < 8; ++cq) {
#pragma unroll
            for (int i = 0; i < 8; ++i) { const int e = tid + 512 * i; u2v o; o.x = pk_bf16(wv[i][0], wv[i][1]); o.y = pk_bf16(wv[i][2], wv[i][3]); *(LAS u2v*)(Ws + (e >> 6) * 264 + 4 * (e & 63)) = o; }
            __syncthreads();
            if (cq < 7) {
#pragma unroll
                for (int i = 0; i < 8; ++i) { const int e = tid + 512 * i; wv[i] = *(const f32x4*)(p.in[19] + (size_t)(e >> 6) * 2048 + (cq + 1) * 256 + 4 * (e & 63)); } }
            f32x4 acc[3][2];
#pragma unroll
            for (int mt = 0; mt < 3; ++mt)
#pragma unroll
                for (int nt = 0; nt < 2; ++nt) acc[mt][nt] = (f32x4){0.f, 0.f, 0.f, 0.f};
#pragma unroll
            for (int ks = 0; ks < 2; ++ks) { bf16x8 xm[3];
#pragma unroll
                for (int mt = 0; mt < 3; ++mt) xm[mt] = frag_row(A3, 72, 16 * mt, 32 * ks, lane);
#pragma unroll
                for (int nt = 0; nt < 2; ++nt) { const bf16x8 xn = frag_tr(Ws, 264, 32 * ks, 32 * w + 16 * nt, lane);
#pragma unroll
                    for (int mt = 0; mt < 3; ++mt) acc[mt][nt] = MFMA16(xn, xm[mt], acc[mt][nt]); } }
#pragma unroll
            for (int nt = 0; nt < 2; ++nt)
#pragma unroll
                for (int q = 0; q < 4; ++q) { const int col = cq * 256 + 32 * w + 16 * nt + 4 * (lane >> 4) + q; const float delta = fabsf(mind + (float)(col % 512) * ((maxd - mind) / 511.f));
#pragma unroll
                    for (int mt = 0; mt < 3; ++mt) { const int pl = 16 * mt + (lane & 15); if (pl < 33) p.FILT[(size_t)col * RB + p0 + pl] = acc[mt][nt][q] * __expf(-tpos[mt] * delta); } }
            __syncthreads();
        }
    }
}

__device__ __forceinline__ float wave_sum(float v) {
#pragma unroll
    for (int o = 1; o < 64; o <<= 1) v += __shfl_xor(v, o);
    return v;
}
__device__ __forceinline__ void ph_ada_fast(const P& p, float* lds) {
    float* sv = lds;
    float* red = lds + 3072;
    const int tid = TIDX;
    __syncthreads();
    for (int i = tid; i < 3 * D; i += NT) { const int j = i / D, k = i % D; sv[i] = siluf(j < 2 ? p.in[1][j * D + k] : p.in[3][k]); }
    __syncthreads();
    for (int u = blockIdx.x; u < 2 * 96; u += gridDim.x) {
        const int l = u / 96, n = (u % 96) * 64 + (tid & 63), ks = tid >> 6;
        const float* w = p.in[4] + (size_t)l * D * 6144 + n;
        float a0 = 0.f, a1 = 0.f, a2 = 0.f;
#pragma unroll 8
        for (int k = ks * 128; k < ks * 128 + 128; ++k) { const float wv = w[(size_t)k * 6144]; a0 += sv[k] * wv; a1 += sv[D + k] * wv; a2 += sv[2 * D + k] * wv; }
        red[(ks * 3 + 0) * 64 + (tid & 63)] = a0; red[(ks * 3 + 1) * 64 + (tid & 63)] = a1; red[(ks * 3 + 2) * 64 + (tid & 63)] = a2;
        __syncthreads();
        if (tid < 192) { const int j = tid >> 6, nl = tid & 63; float s = p.in[5][l * 6144 + (u % 96) * 64 + nl];
#pragma unroll
            for (int q = 0; q < 8; ++q) s += red[(q * 3 + j) * 64 + nl];
            p.MOD[(size_t)(l * 3 + j) * 6144 + (u % 96) * 64 + nl] = s; }
        __syncthreads();
    }
}
__device__ __forceinline__ void ph_hyF_fast(const P& p, const float* a3, float* lds) {
    float* at = lds;
    float* wt = lds + 64 * 65;
    const float mind = logf(1e-2f) / 1.5f, maxd = logf(1e-2f) / 0.3f;
    for (int u = blockIdx.x; u < (RB / 64) * 16; u += gridDim.x) {
        const int tid = TIDX; const int ct = u % 16, pt = u / 16, p0 = pt * 64, c0 = ct * 128;
        __syncthreads();
#pragma unroll
        for (int i = 0; i < 8; ++i) { const int e = tid + 512 * i; at[(e >> 6) * 65 + (e & 63)] = a3[(size_t)(p0 + (e >> 6)) * 64 + (e & 63)]; }
#pragma unroll
        for (int i = 0; i < 16; ++i) { const int e = tid + 512 * i; wt[e] = p.in[19][(size_t)(e >> 7) * 2048 + c0 + (e & 127)]; }
        __syncthreads();
        const int pos = tid & 63, cg = tid >> 6;
        float acc[16];
#pragma unroll
        for (int q = 0; q < 16; ++q) acc[q] = 0.f;
#pragma unroll 4
        for (int m = 0; m < 64; ++m) { const float a = at[pos * 65 + m];
#pragma unroll
            for (int q = 0; q < 16; ++q) acc[q] += a * wt[m * 128 + cg * 16 + q]; }
        int len, i0; hy_pos(p0 + pos, len, i0); const float tt = (float)i0 / (float)(len - 1);
#pragma unroll
        for (int q = 0; q < 16; ++q) { const int col = c0 + cg * 16 + q; const float delta = fabsf(mind + (float)(col % 512) * ((maxd - mind) / 511.f));
            p.FILT[(size_t)col * RB + p0 + pos] = acc[q] * expf(-tt * delta); }
    }
}
__device__ __forceinline__ void ph_retScan_fast(const P& p) {
    bf16_t* ST = p.Zh;
    GSTRIDE(idx, (long)2 * NB * 4 * 16384) {
        const int ed = idx % 16384, h = (idx / 16384) % 4, b = (idx / 65536) % NB, dir = idx / (65536 * NB);
        const float dc = expf((dir ? p.in[10] : p.in[9])[h] * 128.f);
        bf16_t* base = ST + st_idx(dir, b, h, 0) + ed;
        float s = 0.f;
#pragma unroll 1
        for (int c0 = 0; c0 < NCH; c0 += 11) {
            float u[11]; int cc[11];
#pragma unroll
            for (int j = 0; j < 11; ++j) { const int q = c0 + j; cc[j] = dir == 0 ? q : (q < 2 ? 1 - q : NCH + 1 - q); u[j] = bf2f(base[(size_t)cc[j] * 16384]); }
#pragma unroll
            for (int j = 0; j < 11; ++j) { base[(size_t)cc[j] * 16384] = f2bf(s); s = dc * s + u[j]; }
        }
    }
}
__device__ __forceinline__ void ph_glaScan_fast(const P& p) {
    const float* BF = p.BG; const float* BB = p.BG + (size_t)R * 512;
    GSTRIDE(idx, (long)2 * NB * 4 * 32768) {
        const int d = idx % 128, ed = idx % 32768, h = (idx / 32768) % 4, b = (idx / 131072) % NB, dir = idx / (131072 * NB);
        bf16_t* base = p.GST + gst_idx(dir, b, h, 0) + ed;
        float s = 0.f;
#pragma unroll 1
        for (int c0 = 0; c0 < NCH; c0 += 11) {
            float u[11], dcv[11]; int cc[11];
#pragma unroll
            for (int j = 0; j < 11; ++j) { const int q = c0 + j; cc[j] = dir == 0 ? q : (q < 2 ? 1 - q : NCH + 1 - q); const int r0 = chunk_row0(b, cc[j]);
                u[j] = bf2f(base[(size_t)cc[j] * 32768]); dcv[j] = dir == 0 ? BF[(size_t)(r0 + 127) * 512 + h * 128 + d] : BB[(size_t)r0 * 512 + h * 128 + d]; }
#pragma unroll
            for (int j = 0; j < 11; ++j) { base[(size_t)cc[j] * 32768] = f2bf(s); s = __expf(dcv[j]) * s + u[j]; }
        }
    }
}
__device__ __forceinline__ void ph_glagates_fast(const P& p, float* lds) {
    float* lr = lds;
    for (int u = blockIdx.x; u < NB * NCH * 2; u += gridDim.x) {
        const int tid = TIDX; const int dir = u % 2, c = (u / 2) % NCH, b = u / (2 * NCH); const int r0 = chunk_row0(b, c);
        __syncthreads();
        for (int e = tid; e < 128 * 16; e += NT) lr[e] = bf2f(p.Z1[(size_t)(r0 + (e >> 4)) * GINP + 3072 + dir * 16 + (e & 15)]);
        __syncthreads();
        const float* gw = (dir ? p.in[26] : p.in[24]); float g[16];
#pragma unroll
        for (int q = 0; q < 16; ++q) g[q] = gw[q * 512 + tid];
        const float gb = (dir ? p.in[27] : p.in[25])[tid];
        float* out = p.BG + ((size_t)dir * R + r0) * 512 + tid;
        float s = 0.f;
#pragma unroll 4
        for (int ii = 0; ii < 128; ++ii) { const int i = dir ? 127 - ii : ii; float acc = gb;
#pragma unroll
            for (int q = 0; q < 16; ++q) acc += lr[i * 16 + q] * g[q];
            s += logsigf(acc) * (1.f / 16.f); out[(size_t)i * 512] = s; }
    }
}
template <int MODE, bool ROUTE> __device__ __forceinline__ void ph_post_fast(const P& p, int l, int which, const bf16_t* Y, int ln, int wn, int nrows, const float* xl, const float* xc, float* lds) {
    const float* lg = p.in[6] + (size_t)(l * 2 + which) * D; const float* lb = p.in[7] + (size_t)(l * 2 + which) * D;
    const int tid = TIDX, lane = tid & 63, gw = blockIdx.x * (NT / 64) + (tid >> 6), ngw = gridDim.x * (NT / 64);
    int* lcnt = (int*)(lds + D * NE);
    if (ROUTE) { __syncthreads(); for (int e = tid; e < D * NE; e += NT) lds[(e & 15) * D + (e >> 4)] = p.in[29][e]; if (tid < 32) lcnt[tid] = 0; __syncthreads(); }
    int toff[16];
    if (MODE == 1) { int s = 0;
#pragma unroll
        for (int e = 0; e < 16; ++e) { toff[e] = s; s += (p.CNT[l * 16 + e] + 255) >> 8; } }
    f32x4 cg_[4], clg[4], clb[4], csc[4], csh[4]; int cseg = -1;
#pragma unroll
    for (int i = 0; i < 4; ++i) { clg[i] = *(const f32x4*)(lg + 4 * lane + 256 * i); clb[i] = *(const f32x4*)(lb + 4 * lane + 256 * i); }
    f32x4 xr[4]; u2v ya[4], yb[4];
#define POST_LOAD(rr) do { const int r_ = (rr); const float* x_ = r_ < RL ? xl + (size_t)r_ * D : xc + (size_t)(r_ - RL) * D; const bf16_t *y0_, *y1_ = nullptr; \
        if (MODE == 0) y0_ = Y + (size_t)r_ * D; \
        else { int sr_[2]; _Pragma("unroll") for (int k_ = 0; k_ < 2; ++k_) { const int e_ = p.RE[r_ * 2 + k_]; int to_ = 0; _Pragma("unroll") for (int q_ = 0; q_ < 16; ++q_) to_ = (q_ == e_) ? toff[q_] : to_; sr_[k_] = to_ * 256 + p.RPOS[r_ * 2 + k_]; } \
               y0_ = p.slots + (size_t)sr_[0] * D; y1_ = p.slots + (size_t)sr_[1] * D; } \
        _Pragma("unroll") for (int i_ = 0; i_ < 4; ++i_) { const int k_ = 4 * lane + 256 * i_; xr[i_] = *(const f32x4*)(x_ + k_); ya[i_] = *(const u2v*)(y0_ + k_); if (MODE == 1) yb[i_] = *(const u2v*)(y1_ + k_); } } while (0)
    if (gw < nrows) POST_LOAD(gw);
    for (int r = gw; r < nrows; r += ngw) {
        float* xo = xrow(p, r);
        if (seg_of(r) != cseg) { cseg = seg_of(r);
#pragma unroll
            for (int i = 0; i < 4; ++i) { const int k = 4 * lane + 256 * i; cg_[i] = *(const f32x4*)(modv(p, l, r, which * 3 + 2) + k);
                if (ln >= 0) { csc[i] = *(const f32x4*)(modv(p, ln, r, wn * 3 + 1) + k); csh[i] = *(const f32x4*)(modv(p, ln, r, wn * 3 + 0) + k); } } }
        f32x4 v[4]; float s = 0.f;
#pragma unroll
        for (int i = 0; i < 4; ++i) { const u2v yu = ya[i]; f32x4 yy = {__uint_as_float(yu.x << 16), __uint_as_float(yu.x & 0xffff0000u), __uint_as_float(yu.y << 16), __uint_as_float(yu.y & 0xffff0000u)};
            if (MODE == 1) { const u2v y2 = yb[i]; yy += (f32x4){__uint_as_float(y2.x << 16), __uint_as_float(y2.x & 0xffff0000u), __uint_as_float(y2.y << 16), __uint_as_float(y2.y & 0xffff0000u)}; }
            v[i] = xr[i] * ALPHA + cg_[i] * yy; s += (v[i][0] + v[i][1]) + (v[i][2] + v[i][3]); }
        if (r + ngw < nrows) POST_LOAD(r + ngw);
        const float mu = wave_sum(s) * (1.f / D); float q2 = 0.f;
#pragma unroll
        for (int i = 0; i < 4; ++i) { v[i] = v[i] - mu; q2 += (v[i][0] * v[i][0] + v[i][1] * v[i][1]) + (v[i][2] * v[i][2] + v[i][3] * v[i][3]); }
        const float rs = 1.f / sqrtf(wave_sum(q2) * (1.f / D) + LN_EPS);
        f32x4 hk[4];
#pragma unroll
        for (int i = 0; i < 4; ++i) { const int k = 4 * lane + 256 * i; const f32x4 xn = v[i] * rs * clg[i] + clb[i];
            *(f32x4*)(xo + k) = xn;
            if (ln >= 0) { const f32x4 h2 = xn * (csc[i] + 1.f) + csh[i];
                u2v o; o.x = pk_bf16(h2[0], h2[1]); o.y = pk_bf16(h2[2], h2[3]); *(u2v*)(p.H + (size_t)r * D + k) = o;
                if (ROUTE) hk[i] = h2; } }
        if (ROUTE) {
            float pl[16];
#pragma unroll
            for (int e = 0; e < 16; ++e) { const float* wr = lds + e * D + 4 * lane; float a = 0.f;
#pragma unroll
                for (int i = 0; i < 4; ++i) { const f32x4 wv = *(const f32x4*)(wr + 256 * i); a += (hk[i][0] * wv[0] + hk[i][1] * wv[1]) + (hk[i][2] * wv[2] + hk[i][3] * wv[3]); }
                pl[e] = a; }
            float r8[8], r4[4], r2[2];
            { const bool up = (lane & 32) != 0;
#pragma unroll
              for (int q = 0; q < 8; ++q) { const float keep = up ? pl[8 + q] : pl[q], send = up ? pl[q] : pl[8 + q]; r8[q] = keep + __shfl_xor(send, 32); } }
            { const bool up = (lane & 16) != 0;
#pragma unroll
              for (int q = 0; q < 4; ++q) { const float keep = up ? r8[4 + q] : r8[q], send = up ? r8[q] : r8[4 + q]; r4[q] = keep + __shfl_xor(send, 16); } }
            { const bool up = (lane & 8) != 0;
#pragma unroll
              for (int q = 0; q < 2; ++q) { const float keep = up ? r4[2 + q] : r4[q], send = up ? r4[q] : r4[2 + q]; r2[q] = keep + __shfl_xor(send, 8); } }
            float r1;
            { const bool up = (lane & 4) != 0; const float keep = up ? r2[1] : r2[0], send = up ? r2[0] : r2[1]; r1 = keep + __shfl_xor(send, 4); }
            r1 += __shfl_xor(r1, 2); r1 += __shfl_xor(r1, 1);
            const float sgm = sigmf(r1);
            int best = 0, i1 = 0, i2 = 0; float bs = -1e30f, a1 = 0.f, a2 = 0.f;
#pragma unroll
            for (int g = 0; g < NG; ++g) {
                float sg[4], sel[4];
#pragma unroll
                for (int q = 0; q < 4; ++q) { const int e = g * EPG + q; const int src = ((e >> 3) & 1) * 32 + ((e >> 2) & 1) * 16 + ((e >> 1) & 1) * 8 + (e & 1) * 4;
                    sg[q] = __int_as_float(__builtin_amdgcn_readlane(__float_as_int(sgm), src)); sel[q] = sg[q] + p.in[30][e]; }
                int j1 = 0; float v1 = sel[0];
#pragma unroll
                for (int q = 1; q < 4; ++q) if (sel[q] > v1) { v1 = sel[q]; j1 = q; }
                int j2 = -1; float v2 = -1e30f;
#pragma unroll
                for (int q = 0; q < 4; ++q) if (q != j1 && sel[q] > v2) { v2 = sel[q]; j2 = q; }
                if (v1 + v2 > bs) { bs = v1 + v2; best = g; i1 = j1; i2 = j2; a1 = 0.f; a2 = 0.f;
#pragma unroll
                    for (int q = 0; q < 4; ++q) { a1 = (q == j1) ? sg[q] : a1; a2 = (q == j2) ? sg[q] : a2; } }
            }
            if (lane == 0) { const int e1 = best * EPG + i1, e2 = best * EPG + i2;
                p.RE[r * 2] = e1; p.RE[r * 2 + 1] = e2; p.RWt[r * 2] = a1 / (a1 + a2); p.RWt[r * 2 + 1] = a2 / (a1 + a2);
                p.RPOS[r * 2] = atomicAdd(&lcnt[e1], 1); p.RPOS[r * 2 + 1] = atomicAdd(&lcnt[e2], 1); }
        }
    }
    if (ROUTE) {
        __syncthreads();
        if (tid < 16) lcnt[16 + tid] = atomicAdd(&p.CNT[l * 16 + tid], lcnt[tid]);
        __syncthreads();
        for (int r = gw + lane * ngw; r < nrows; r += 64 * ngw) {
#pragma unroll
            for (int k = 0; k < 2; ++k) p.RPOS[r * 2 + k] += lcnt[16 + p.RE[r * 2 + k]];
        }
    }
}
#undef POST_LOAD

constexpr int N_STEPS = 34;
#define PG8_ALIGN true
#define PG8_SP2 true
template <class Epi> __device__ __forceinline__ void dense_gemm(LAS unsigned char* lds, const bf16_t* A, const bf16_t* Bt, int M, int N, int K, const Epi& E) {
    pg8::Gemm g{A, Bt, M, N, K}; pg8::StaticOrder S; S.init(M, N, (int)gridDim.x, (int)blockIdx.x);
    pg8::gemm_phase<Epi, pg8::StaticOrder, PG8_ALIGN, PG8_SP2>(lds, g, S, E);
}
__device__ __forceinline__ void moe_gemms(const P& p, LAS unsigned char* lds, int l, int which) {
    pg8::MoeOrder S; S.init(p.CNT + l * 16, (int)gridDim.x, (int)blockIdx.x);
    if (which == 0) { pg8::Gemm g{p.Hs, p.Wgu, 0, 0, 1024}; pg8::EpiSwiGLU E{p.he}; pg8::gemm_phase<pg8::EpiSwiGLU, pg8::MoeOrder, PG8_ALIGN, PG8_SP2>(lds, g, S, E); }
    else { pg8::Gemm g{p.he, p.Wd, 0, 0, 512}; pg8::EpiRowScale E{p.slots, p.WS}; pg8::gemm_phase<pg8::EpiRowScale, pg8::MoeOrder, PG8_ALIGN, PG8_SP2>(lds, g, S, E); }
}
__device__ __forceinline__ void run_step(const P& p, int step, unsigned char* smem) {
    LAS unsigned char* lds = (LAS unsigned char*)smem; float* fl = (float*)smem;
    float* conv = (float*)p.H;
    switch (step) {
        case 0: ph_ada_fast(p, fl); ph_rope_table(p); ph_wconv_l0(p, fl); if (gridDim.x != 256) ph_wconv_moe_fast(p, 0, fl); break;
        case 1: ph_mod_fast(p, 0, 0, p.in[0], p.in[2]); ph_filters(p, smem); break;
        case 2: { pg8::EpiInL0 E{p.Zr, p.hyT, p.A2, RL, L, CTX, RB}; dense_gemm(lds, p.H, p.Win0, R, ABIN, D, E); }
                 if (gridDim.x == 256) ph_wconv_moe_part(p, 0, 1, fl, (int)blockIdx.x - 156, 100); break;
        case 3: break;
        case 4: ph_retU_mfma(p, smem); ph_hyena_fft(p, smem); break;
        case 5: ph_retScan_fast(p); break;
        case 6: break;
        case 7: break;
        case 8: break;
        case 9: ph_retO_mfma(p, smem); ph_hy_untranspose_fast(p, fl); break;
        case 10: ph_hy_untranspose_fast(p, fl); break;
        case 11: { pg8::EpiSplit E{p.Zr, 1024, p.Zr, 1024, 1 << 30}; dense_gemm(lds, p.H, p.Wout0, R, D, D, E); }
                 if (gridDim.x == 256) ph_wconv_moe_part(p, 0, 0, fl, (int)blockIdx.x - 8, 248); break;
        case 12: ph_post_fast<0, true>(p, 0, 0, p.Zr, 0, 1, R, p.in[0], p.in[2], fl); break;
        case 13: break;
        case 14: break;
        case 15: ph_permute(p, 0, R); break;
        case 16: moe_gemms(p, lds, 0, 0); break;
        case 17: moe_gemms(p, lds, 0, 1); ph_wconv_l1(p, fl); break;
        case 18: ph_post_fast<1, false>(p, 0, 1, nullptr, 1, 0, R, p.out, p.Xc, fl); break;
        case 19: { pg8::EpiSplit E{p.Z1, GINP, p.Z1, GINP, 1 << 30}; dense_gemm(lds, p.H, p.Win1, R, GINP, D, E); } ph_wconv_moe_fast(p, 1, fl); break;
        case 20: break;
        case 21: break;
        case 22: ph_glaU_mfma(p, smem); break;
        case 23: ph_glaScan_fast(p); break;
        case 24: ph_glaO_mfma(p, smem); break;
        case 25: break;
        case 26: { pg8::EpiSplit E{p.Zr, 1024, p.Zr, 1024, 1 << 30}; dense_gemm(lds, p.H, p.Wout1, RL, D, D, E); } break;
        case 27: ph_post_fast<0, true>(p, 1, 0, p.Zr, 1, 1, RL, p.out, p.Xc, fl); break;
        case 28: break;
        case 29: break;
        case 30: ph_permute(p, 1, RL); break;
        case 31: moe_gemms(p, lds, 1, 0); break;
        case 32: moe_gemms(p, lds, 1, 1); break;
        case 33: ph_post_fast<1, false>(p, 1, 1, nullptr, -1, 0, RL, p.out, p.Xc, fl); break;
    }
}
__global__ void __launch_bounds__(NT, 2) k_all(P p) {
    extern __shared__ __attribute__((aligned(16))) unsigned char smem[];
    cg::grid_group grid = cg::this_grid();
    volatile LAS unsigned* bst = (volatile LAS unsigned*)((LAS unsigned char*)smem + LDS_BYTES - 64);
    if (threadIdx.x < 2) bst[threadIdx.x] = 0u;
    __syncthreads();
    const XcdBarrier bar = xcd_barrier_post(p.BAR, bst);
#define STEP(n) run_step(p, n, smem); xcd_barrier(bar);
#define STEP_CG(n) run_step(p, n, smem); asm volatile("s_waitcnt vmcnt(0)" ::: "memory"); grid.sync();
    STEP_CG(0) STEP(1) STEP(2) STEP(4) STEP(5) STEP(9) STEP(11) STEP(12) STEP(15) STEP(16)
    STEP(17) STEP(18) STEP(19) STEP(22) STEP(23) STEP(24) STEP(26) STEP(27) STEP(30) STEP(31) STEP(32) run_step(p, 33, smem);
#undef STEP
#undef STEP_CG
}

extern "C" void kernel_launch(void* const* d_in, const int* in_sizes, int n_in, void* d_out, int out_size, void* d_ws, size_t ws_size, hipStream_t stream) {
    P p{};
    for (int i = 0; i < 34; ++i) p.in[i] = (const float*)d_in[i];
    p.out = (float*)d_out;
    unsigned char* w = (unsigned char*)d_ws; size_t off = 0;
    auto take = [&](size_t bytes) { unsigned char* r = w + off; off += (bytes + 255) & ~(size_t)255; return r; };
    p.NORM = (float*)take(2 * 2048 * 4); p.CNT = (int*)take(2 * 16 * 4); p.BAR = (unsigned*)take(XCD_BAR_WORDS * 4);
    const size_t ctl_bytes = off;
    p.Win1 = (bf16_t*)take((size_t)GINP * D * 2); p.Wout1 = (bf16_t*)take((size_t)D * D * 2);
    p.Wgu = (bf16_t*)take((size_t)NE * 1024 * 1024 * 2); p.Wd = (bf16_t*)take((size_t)NE * 1024 * 512 * 2);
    p.Xc = (float*)take((size_t)RCX * D * 4); p.MOD = (float*)take(2 * 3 * 6144 * 4);
    p.RS = (float*)take((size_t)R * NE * 4); p.RE = (int*)take((size_t)R * 2 * 4); p.RPOS = (int*)take((size_t)R * 2 * 4); p.RWt = (float*)take((size_t)R * 2 * 4);
    p.WS = (float*)take((size_t)MOE_ROWS * 4);
    const size_t big = off;
    p.H = (bf16_t*)take((size_t)R * D * 2);
    p.Zr = (bf16_t*)take((size_t)R * 2048 * 2);
    p.Zh = (bf16_t*)take((size_t)R * 1536 * 2);
    p.hyT = (bf16_t*)take((size_t)NB * 3 * 512 * RB * 2);
    p.FILT = (float*)take((size_t)2048 * RB * 4);
    p.Win0 = (bf16_t*)take((size_t)ABIN * D * 2); p.Wout0 = (bf16_t*)take((size_t)D * D * 2);
    p.A1 = (float*)take((size_t)RB * 64 * 4); p.A2 = (float*)take((size_t)RB * 64 * 4);
    const size_t total = off;
    off = big + (((size_t)R * D * 2 + 255) & ~(size_t)255);
    p.Hs = (bf16_t*)take((size_t)MOE_ROWS * D * 2); p.he = (bf16_t*)take((size_t)MOE_ROWS * EH * 2); p.slots = (bf16_t*)take((size_t)MOE_ROWS * D * 2);
    const size_t moe_end = off;
    off = big + (((size_t)R * D * 2 + 255) & ~(size_t)255);
    p.Z1 = (bf16_t*)take((size_t)R * GINP * 2); p.BG = (float*)take((size_t)2 * R * 512 * 4); p.GST = (bf16_t*)take((size_t)2 * NB * 4 * NCH * 32768 * 2);
    const size_t l1_end = off;
    if (total > ws_size || moe_end > total || l1_end > total || n_in != 34 || out_size != RL * D) {
        fprintf(stderr, "kernel_launch: bad sizes (need %zu ws bytes, have %zu; moe_end %zu l1_end %zu)\n", total, ws_size, moe_end, l1_end); return; }
    static int grid = 0;
    if (!grid) {
        int dev = 0, cus = 0, per = 0; hipGetDevice(&dev); hipDeviceGetAttribute(&cus, hipDeviceAttributeMultiprocessorCount, dev);
        hipFuncSetAttribute((const void*)k_all, hipFuncAttributeMaxDynamicSharedMemorySize, LDS_BYTES);
        hipOccupancyMaxActiveBlocksPerMultiprocessor(&per, k_all, NT, LDS_BYTES);
        if (per < 1) { fprintf(stderr, "kernel_launch: occupancy query says %d blocks per CU\n", per); per = 1; }
        grid = cus < 256 ? cus : 256;
    }
    hipMemsetAsync(d_ws, 0, ctl_bytes, stream);
    void* args[] = {&p};
    hipError_t e = hipLaunchCooperativeKernel((void*)k_all, dim3(grid), dim3(NT), args, LDS_BYTES, stream);
    if (e != hipSuccess) fprintf(stderr, "coop launch failed: %s (grid %d)\n", hipGetErrorString(e), grid);
}
```

```cpp
#include <hip/hip_runtime.h>
#include <hip/hip_cooperative_groups.h>
#include <cstdio>
#include <cstdint>
namespace cg = cooperative_groups;


namespace pg8 {
#define PG8_LAS __attribute__((address_space(3)))
typedef unsigned short bf16_t;
typedef short bf16x8 __attribute__((ext_vector_type(8)));
typedef float f32x4 __attribute__((ext_vector_type(4)));
typedef unsigned u32x4 __attribute__((ext_vector_type(4)));
constexpr int BM = 256, BK = 64, HALF = 128, HTB = HALF * BK * 2  , STAGE_BYTES = 8 * HTB, NXCD = 8, WGM = 8;

__host__ __device__ __forceinline__ int lds_byte(int r, int c) { const int st = (r >> 4) * 2 + (c >> 5), rr = r & 15, cc = c & 31, ob = rr * 64 + cc * 2; return st * 1024 + (ob ^ (((ob >> 9) & 1) << 5)); }
__host__ __device__ __forceinline__ void stage_rc(int b, int& R, int& C) { const int st = b / 1024, sb = b % 1024, swz = sb ^ (((sb >> 9) & 1) << 5); R = (st >> 1) * 16 + swz / 64; C = (st & 1) * 32 + (swz % 64) / 2; }
__host__ __device__ __forceinline__ int perm32(int rho) { const int n = rho >> 4, i = rho & 15; return 8 * (i >> 2) + 4 * n + (i & 3); }

struct Unit { int pm, pn, aux; };
struct Gemm { const bf16_t* A; const bf16_t* Bt; int M, N, K; };

struct StaticOrder {
    int nM, nN, nwg, G, c;
    __host__ __device__ void init(int M, int N, int G_, int c_) { nM = M / BM; nN = N / BM; nwg = nM * nN; G = G_; c = c_; }
    __host__ __device__ bool next(int i, Unit& u) const {
        const long L = (long)i * G + c; if (L >= nwg) return false;
        int wgid = (int)L; { const int q = nwg / NXCD, r = nwg % NXCD, xcd = wgid % NXCD, off = wgid / NXCD; wgid = (xcd < r ? xcd * (q + 1) : r * (q + 1) + (xcd - r) * q) + off; }
        const int nig = WGM * nN, gid = wgid / nig, fm = gid * WGM, gsz = (nM - fm) < WGM ? (nM - fm) : WGM;
        u.pm = fm + ((wgid % nig) % gsz); u.pn = (wgid % nig) / gsz; u.aux = 0; return true;
    }
    __device__ __forceinline__ void a_ready(const Unit&) const {}
    __device__ __forceinline__ void done(const Unit&) const {}
    __device__ __forceinline__ int gather_row(const Unit&, int) const { return 0; }
};


__device__ __forceinline__ unsigned cvt_pk_bf16(float lo, float hi) { unsigned r; asm volatile("v_cvt_pk_bf16_f32 %0, %1, %2" : "=v"(r) : "v"(lo), "v"(hi)); return r; }

template <class Epi, class Sched, bool ALIGN_EPI = false, bool SP2 = false, bool GATHER = false>
__device__ __forceinline__ void gemm_phase(PG8_LAS unsigned char* lds, const Gemm g, const Sched& S, const Epi& E) {
    int tid_l = threadIdx.x; asm volatile("" : "+v"(tid_l)); const int tid = tid_l, wid = __builtin_amdgcn_readfirstlane(tid >> 6), lane = tid & 63, wr = wid >> 2, wc = wid & 3, fr = lane & 15, fq = lane >> 4;
    const int K = g.K, nt = K / BK;
    unsigned voffA[2], voffB[2]; int Rg_[2], Cg_[2]; unsigned vgC[2][2], vgN[2][2];
#pragma unroll
    for (int i = 0; i < 2; ++i) { int R, C; stage_rc(tid * 16 + i * 8192, R, C); const int Rb = Epi::PERM ? ((R & ~31) + perm32(R & 31)) : R;
        voffA[i] = (unsigned)(R * K + C) * 2u; voffB[i] = (unsigned)(Rb * K + C) * 2u; Rg_[i] = R; Cg_[i] = C; }
    const size_t kstep = (size_t)(BK * 2);
    const size_t hstep = (size_t)HALF * K * 2;
    const size_t tstep = 2 * hstep;
    const unsigned ldsw = (unsigned)wid * 1024u;
    const int aoff = lds_byte(wr * 64 + fr, fq * 8), boff = lds_byte(wc * 32 + fr, fq * 8);
#define PG8_SA(b, h) (((b) * 2 + (h)) * HTB)
#define PG8_SB(b, h) ((4 + (b) * 2 + (h)) * HTB)
#define PG8_STAGE(bufoff, gbase, voff) do { _Pragma("unroll") for (int _i = 0; _i < 2; ++_i) \
        __builtin_amdgcn_global_load_lds((const unsigned*)((const char*)(gbase) + (voff)[_i]), (PG8_LAS unsigned*)(lds + (bufoff) + ldsw + _i * 8192), 16, 0, 0); } while (0)
#define PG8_GFILL(dst, unit) do { if constexpr (GATHER) { _Pragma("unroll") for (int h_ = 0; h_ < 2; ++h_) _Pragma("unroll") for (int i_ = 0; i_ < 2; ++i_) dst[h_][i_] = (unsigned)(S.gather_row(unit, h_ * HALF + Rg_[i_]) * K + Cg_[i_]) * 2u; } } while (0)
#define PG8_STAGE_A(bufoff, ptr_plain, kb, h, usenext) do { if constexpr (GATHER) { unsigned vv_[2]; vv_[0] = (usenext) ? vgN[h][0] : vgC[h][0]; vv_[1] = (usenext) ? vgN[h][1] : vgC[h][1]; PG8_STAGE(bufoff, (const char*)g.A + (kb), vv_); } else { PG8_STAGE(bufoff, ptr_plain, voffA); } } while (0)
#define PG8_LDA(dst, b, h) do { _Pragma("unroll") for (int m = 0; m < 4; ++m) _Pragma("unroll") for (int k = 0; k < 2; ++k) dst[m][k] = *(const PG8_LAS bf16x8*)(lds + PG8_SA(b, h) + aoff + m * 2048 + k * 1024); } while (0)
#define PG8_LDB(dst, b, h) do { _Pragma("unroll") for (int n = 0; n < 2; ++n) _Pragma("unroll") for (int k = 0; k < 2; ++k) dst[n][k] = *(const PG8_LAS bf16x8*)(lds + PG8_SB(b, h) + boff + n * 2048 + k * 1024); } while (0)
#define PG8_MMA(ai, bj, At, Bt) do { __builtin_amdgcn_s_setprio(1); _Pragma("unroll") for (int m = 0; m < 4; ++m) _Pragma("unroll") for (int n = 0; n < 2; ++n) _Pragma("unroll") for (int k = 0; k < 2; ++k) \
        acc[ai][bj][m][n] = __builtin_amdgcn_mfma_f32_16x16x32_bf16(Bt[n][k], At[m][k], acc[ai][bj][m][n], 0, 0, 0); __builtin_amdgcn_s_setprio(0); } while (0)
#define PG8_WAIT_V(n) asm volatile("s_waitcnt vmcnt(" #n ")" ::: "memory")
#define PG8_WAIT_L(n) asm volatile("s_waitcnt lgkmcnt(" #n ")" ::: "memory")
#define PG8_BAR __builtin_amdgcn_s_barrier()
#define PG8_SCHED __builtin_amdgcn_sched_barrier(0)
    Unit cur, nxt; int ui = 0;
    if (!S.next(0, cur)) return;
    PG8_GFILL(vgC, cur);
    f32x4 acc[2][2][4][2];
#pragma unroll
    for (int a = 0; a < 2; ++a)
#pragma unroll
        for (int b = 0; b < 2; ++b)
#pragma unroll
            for (int m = 0; m < 4; ++m)
#pragma unroll
                for (int n = 0; n < 2; ++n) acc[a][b][m][n] = (f32x4){0.f, 0.f, 0.f, 0.f};
    bf16x8 At[4][2], B0[2][2], B1[2][2];
    const char* cA = (const char*)g.A + (size_t)cur.pm * tstep; const char* cB = (const char*)g.Bt + (size_t)cur.pn * tstep;
    S.a_ready(cur);
    if constexpr (SP2) {
        PG8_STAGE(PG8_SB(0, 0), cB, voffB); PG8_STAGE(PG8_SB(0, 1), cB + hstep, voffB); PG8_STAGE_A(PG8_SA(0, 0), cA, 0, 0, false); PG8_STAGE_A(PG8_SA(0, 1), cA + hstep, 0, 1, false);
        if (wr == 1) PG8_BAR;
        PG8_WAIT_V(2); PG8_BAR;
        PG8_STAGE(PG8_SB(1, 0), cB + kstep, voffB); PG8_STAGE_A(PG8_SA(1, 0), cA + kstep, kstep, 0, false); PG8_STAGE(PG8_SB(1, 1), cB + hstep + kstep, voffB);
        PG8_WAIT_V(6); PG8_BAR;
    } else {
        PG8_STAGE(PG8_SB(0, 0), cB, voffB); PG8_STAGE_A(PG8_SA(0, 0), cA, 0, 0, false); PG8_STAGE(PG8_SB(0, 1), cB + hstep, voffB); PG8_STAGE_A(PG8_SA(0, 1), cA + hstep, 0, 1, false);
        if (wr == 1) PG8_BAR;
        PG8_WAIT_V(4); PG8_BAR;
        PG8_STAGE(PG8_SB(1, 0), cB + kstep, voffB); PG8_STAGE_A(PG8_SA(1, 0), cA + kstep, kstep, 0, false); PG8_STAGE(PG8_SB(1, 1), cB + hstep + kstep, voffB);
        PG8_WAIT_V(6); PG8_BAR;
    }
    for (;;) {
        const bool has_next = S.next(ui + 1, nxt);
        if constexpr (GATHER) { if (has_next) PG8_GFILL(vgN, nxt); else { _Pragma("unroll") for (int h_ = 0; h_ < 2; ++h_) { vgN[h_][0] = vgC[h_][0]; vgN[h_][1] = vgC[h_][1]; } } }
        const char* nA = has_next ? (const char*)g.A + (size_t)nxt.pm * tstep : cA; const char* nB = has_next ? (const char*)g.Bt + (size_t)nxt.pn * tstep : cB;
        for (int t = 0; t < nt; t += 2) {
            const bool last = (t == nt - 2);
            const char* a1 = cA + (size_t)(t + 1) * kstep;
            const char* a2 = last ? nA : cA + (size_t)(t + 2) * kstep; const char* b2 = last ? nB : cB + (size_t)(t + 2) * kstep;
            const char* a3 = a2 + kstep; const char* b3 = b2 + kstep;
            if (last && has_next) S.a_ready(nxt);
            if constexpr (SP2) {
            PG8_LDB(B0, 0, 0); PG8_LDB(B1, 0, 1); PG8_SCHED; PG8_LDA(At, 0, 0); PG8_STAGE_A(PG8_SA(1, 1), a1 + hstep, (size_t)(t + 1) * kstep, 1, false);
            PG8_WAIT_V(8); PG8_WAIT_L(0); PG8_BAR; PG8_MMA(0, 0, At, B0); PG8_MMA(0, 1, At, B1); PG8_BAR; PG8_SCHED;
            PG8_LDA(At, 0, 1); PG8_STAGE(PG8_SB(0, 0), b2, voffB); PG8_STAGE(PG8_SB(0, 1), b2 + hstep, voffB); PG8_STAGE_A(PG8_SA(0, 0), a2, (last ? (size_t)0 : (size_t)(t + 2) * kstep), 0, last);
            PG8_WAIT_V(8); PG8_WAIT_L(0); PG8_BAR; PG8_MMA(1, 0, At, B0); PG8_MMA(1, 1, At, B1); PG8_BAR; PG8_SCHED;
            PG8_LDB(B0, 1, 0); PG8_LDB(B1, 1, 1); PG8_SCHED; PG8_LDA(At, 1, 0); PG8_STAGE_A(PG8_SA(0, 1), a2 + hstep, (last ? (size_t)0 : (size_t)(t + 2) * kstep), 1, last);
            PG8_WAIT_V(8); PG8_WAIT_L(0); PG8_BAR; PG8_MMA(0, 0, At, B0); PG8_MMA(0, 1, At, B1); PG8_BAR; PG8_SCHED;
            PG8_LDA(At, 1, 1); PG8_STAGE(PG8_SB(1, 0), b3, voffB); PG8_STAGE(PG8_SB(1, 1), b3 + hstep, voffB); PG8_STAGE_A(PG8_SA(1, 0), a3, (last ? (size_t)0 : (size_t)(t + 2) * kstep) + kstep, 0, last);
            PG8_WAIT_V(8); PG8_WAIT_L(0); PG8_BAR; PG8_MMA(1, 0, At, B0); PG8_MMA(1, 1, At, B1); PG8_BAR; PG8_SCHED;
            } else {
            PG8_LDB(B0, 0, 0); PG8_SCHED; PG8_LDA(At, 0, 0); PG8_STAGE_A(PG8_SA(1, 1), a1 + hstep, (size_t)(t + 1) * kstep, 1, false);
            PG8_WAIT_L(8); PG8_BAR; PG8_WAIT_L(0); PG8_MMA(0, 0, At, B0); PG8_BAR; PG8_SCHED;
            PG8_LDB(B1, 0, 1); PG8_STAGE(PG8_SB(0, 0), b2, voffB);
            PG8_BAR; PG8_WAIT_L(0); PG8_MMA(0, 1, At, B1); PG8_BAR;
            PG8_LDA(At, 0, 1); PG8_STAGE_A(PG8_SA(0, 0), a2, (last ? (size_t)0 : (size_t)(t + 2) * kstep), 0, last);
            PG8_BAR; PG8_WAIT_L(0); PG8_MMA(1, 0, At, B0); PG8_BAR; PG8_SCHED;
            PG8_STAGE(PG8_SB(0, 1), b2 + hstep, voffB);
            PG8_WAIT_V(6); PG8_BAR; PG8_MMA(1, 1, At, B1); PG8_BAR;
            PG8_LDB(B0, 1, 0); PG8_SCHED; PG8_LDA(At, 1, 0); PG8_STAGE_A(PG8_SA(0, 1), a2 + hstep, (last ? (size_t)0 : (size_t)(t + 2) * kstep), 1, last);
            PG8_WAIT_L(8); PG8_BAR; PG8_WAIT_L(0); PG8_MMA(0, 0, At, B0); PG8_BAR; PG8_SCHED;
            PG8_LDB(B1, 1, 1); PG8_STAGE(PG8_SB(1, 0), b3, voffB);
            PG8_BAR; PG8_WAIT_L(0); PG8_MMA(0, 1, At, B1); PG8_BAR;
            PG8_LDA(At, 1, 1); PG8_STAGE_A(PG8_SA(1, 0), a3, (last ? (size_t)0 : (size_t)(t + 2) * kstep) + kstep, 0, last);
            PG8_BAR; PG8_WAIT_L(0); PG8_MMA(1, 0, At, B0); PG8_BAR; PG8_SCHED;
            PG8_STAGE(PG8_SB(1, 1), b3 + hstep, voffB);
            PG8_WAIT_V(6); PG8_BAR; PG8_MMA(1, 1, At, B1); PG8_BAR;
            }
        }
        if constexpr (ALIGN_EPI) { if (wr == 0) PG8_BAR; }
        if constexpr (!Epi::AFTER_DRAIN) { E(acc, cur, wr, wc, fr, fq); S.done(cur); }
        if (!has_next) break;
#pragma unroll
        for (int a = 0; a < 2; ++a)
#pragma unroll
            for (int b = 0; b < 2; ++b)
#pragma unroll
                for (int m = 0; m < 4; ++m)
#pragma unroll
                    for (int n = 0; n < 2; ++n) acc[a][b][m][n] = (f32x4){0.f, 0.f, 0.f, 0.f};
        cur = nxt; cA = nA; cB = nB; ++ui;
        if constexpr (GATHER) { _Pragma("unroll") for (int h_ = 0; h_ < 2; ++h_) { vgC[h_][0] = vgN[h_][0]; vgC[h_][1] = vgN[h_][1]; } }
        if constexpr (ALIGN_EPI) { if (wr == 1) PG8_BAR; }
    }
    PG8_WAIT_V(0);
    if constexpr (!ALIGN_EPI) { if (wr == 0) PG8_BAR; }
    PG8_BAR;
    if constexpr (Epi::AFTER_DRAIN) { E.fused(acc, cur, wr, wc, fr, fq, lds, wid, lane); S.done(cur); }
#undef PG8_SA
#undef PG8_SB
#undef PG8_STAGE
#undef PG8_LDA
#undef PG8_GFILL
#undef PG8_STAGE_A
#undef PG8_LDB
#undef PG8_MMA
#undef PG8_WAIT_V
#undef PG8_WAIT_L
#undef PG8_BAR
#undef PG8_SCHED
}
}

typedef float f2v_t __attribute__((ext_vector_type(2)));
typedef __bf16 b2v_t __attribute__((ext_vector_type(2)));
__device__ __forceinline__ unsigned pk_bf16(float lo, float hi) { const f2v_t f = {lo, hi}; const b2v_t b = __builtin_convertvector(f, b2v_t); return __builtin_bit_cast(unsigned, b); }
namespace pg8 {
typedef unsigned u32x2 __attribute__((ext_vector_type(2)));
struct EpiSplit {
    static constexpr bool PERM = true, AFTER_DRAIN = false;
    bf16_t* O0; int ld0; bf16_t* O1; int ld1; int split_col;
    __device__ __forceinline__ void operator()(const f32x4 (&acc)[2][2][4][2], const Unit& u, int wr, int wc, int fr, int fq) const {
        const int row0 = u.pm * BM + wr * 64 + fr; int colt = u.pn * BM; bf16_t* base = O0; int ldc = ld0;
        if (colt >= split_col) { base = O1; ldc = ld1; colt -= split_col; }
        const int col0 = colt + wc * 32 + 8 * fq;
#pragma unroll
        for (int ai = 0; ai < 2; ++ai)
#pragma unroll
            for (int m = 0; m < 4; ++m) { bf16_t* rowp = base + (size_t)(row0 + ai * HALF + m * 16) * ldc + col0;
#pragma unroll
                for (int bj = 0; bj < 2; ++bj) { const f32x4 v0 = acc[ai][bj][m][0], v1 = acc[ai][bj][m][1];
                    u32x4 w; w.x = ::pk_bf16(v0[0], v0[1]); w.y = ::pk_bf16(v0[2], v0[3]); w.z = ::pk_bf16(v1[0], v1[1]); w.w = ::pk_bf16(v1[2], v1[3]);
                    *(u32x4*)(rowp + bj * HALF) = w; } }
    }
};
struct EpiInL0 {
    static constexpr bool PERM = true, AFTER_DRAIN = false;
    bf16_t* Zr; bf16_t* hyT; const float* tab; int RLv, Lv, CTXv, RBv;
    __device__ __forceinline__ void operator()(const f32x4 (&acc)[2][2][4][2], const Unit& u, int wr, int wc, int fr, int fq) const {
        const int rowbase = u.pm * BM, colt = u.pn * BM;
        if (colt < 2048) {
            const int col0 = colt + wc * 32 + 8 * fq; const bool rot = colt < 1024; const int pp0 = wc * 16 + 4 * fq;
#pragma unroll
            for (int ai = 0; ai < 2; ++ai)
#pragma unroll
                for (int m = 0; m < 4; ++m) { const int row = rowbase + wr * 64 + fr + ai * HALF + m * 16; bf16_t* rowp = Zr + (size_t)row * 2048 + col0;
                    const int t = row % Lv; const int prow = t >> 6, pcol = t & 63; const bool lat = row < RLv;
#pragma unroll
                    for (int bj = 0; bj < 2; ++bj) { f32x4 v0 = acc[ai][bj][m][0], v1 = acc[ai][bj][m][1];
                        if (rot) {
#pragma unroll
                            for (int pr = 0; pr < 4; ++pr) { const int pp = pp0 + pr; const int pos = pp < 32 ? prow : pcol; const float cs_ = tab[(pos * 32 + (pp & 31)) * 2], sn_ = tab[(pos * 32 + (pp & 31)) * 2 + 1];
                                const float cs = lat ? cs_ : 1.f, sn = lat ? sn_ : 0.f;
                                if (pr < 2) { const float x1 = v0[2 * pr], x2 = v0[2 * pr + 1]; v0[2 * pr] = x1 * cs - x2 * sn; v0[2 * pr + 1] = x1 * sn + x2 * cs; }
                                else { const float x1 = v1[2 * pr - 4], x2 = v1[2 * pr - 3]; v1[2 * pr - 4] = x1 * cs - x2 * sn; v1[2 * pr - 3] = x1 * sn + x2 * cs; } } }
                        u32x4 w; w.x = ::pk_bf16(v0[0], v0[1]); w.y = ::pk_bf16(v0[2], v0[3]); w.z = ::pk_bf16(v1[0], v1[1]); w.w = ::pk_bf16(v1[2], v1[3]);
                        *(u32x4*)(rowp + bj * HALF) = w; } }
        } else {
            const int hc0 = colt - 2048 + wc * 32 + 8 * fq;
            int b, tlb; if (rowbase < RLv) { b = rowbase / Lv; tlb = rowbase % Lv; } else { b = (rowbase - RLv) / CTXv; tlb = Lv + (rowbase - RLv) % CTXv; }
#pragma unroll
            for (int ai = 0; ai < 2; ++ai)
#pragma unroll
                for (int m = 0; m < 4; ++m) { const int tl = tlb + wr * 64 + fr + ai * HALF + m * 16;
#pragma unroll
                    for (int bj = 0; bj < 2; ++bj) { const f32x4 v0 = acc[ai][bj][m][0], v1 = acc[ai][bj][m][1];
                        bf16_t* o = hyT + ((size_t)b * 1536 + hc0 + bj * HALF) * RBv + tl;
#pragma unroll
                        for (int q = 0; q < 4; ++q) { o[(size_t)q * RBv] = (bf16_t)(::pk_bf16(v0[q], 0.f) & 0xffffu); o[(size_t)(q + 4) * RBv] = (bf16_t)(::pk_bf16(v1[q], 0.f) & 0xffffu); } } }
        }
    }
};
struct EpiSwiGLU {
    static constexpr bool PERM = true, AFTER_DRAIN = false;
    bf16_t* O;
    __device__ __forceinline__ void operator()(const f32x4 (&acc)[2][2][4][2], const Unit& u, int wr, int wc, int fr, int fq) const {
        const int row0 = u.pm * BM + wr * 64 + fr; const int j0 = (u.pn & 3) * 128 + wc * 16 + 4 * fq;
#pragma unroll
        for (int ai = 0; ai < 2; ++ai)
#pragma unroll
            for (int m = 0; m < 4; ++m) { bf16_t* rowp = O + (size_t)(row0 + ai * HALF + m * 16) * 512 + j0;
#pragma unroll
                for (int bj = 0; bj < 2; ++bj) { const f32x4 g = acc[ai][bj][m][0], up = acc[ai][bj][m][1]; float h[4];
#pragma unroll
                    for (int q = 0; q < 4; ++q) h[q] = g[q] / (1.f + __expf(-g[q])) * up[q];
                    u32x2 w; w.x = ::pk_bf16(h[0], h[1]); w.y = ::pk_bf16(h[2], h[3]);
                    *(u32x2*)(rowp + bj * 64) = w; } }
    }
};
struct EpiRowScale {
    static constexpr bool PERM = true, AFTER_DRAIN = false;
    bf16_t* O; const float* wlist; int lcap;
    __device__ __forceinline__ void operator()(const f32x4 (&acc)[2][2][4][2], const Unit& u, int wr, int wc, int fr, int fq) const {
        const int row0 = u.pm * BM + wr * 64 + fr; const int col0 = (u.pn & 3) * BM + wc * 32 + 8 * fq; const float* wl = wlist + (size_t)(u.pn >> 2) * lcap - u.aux * 256;
#pragma unroll
        for (int ai = 0; ai < 2; ++ai)
#pragma unroll
            for (int m = 0; m < 4; ++m) { const int row = row0 + ai * HALF + m * 16; const float s = wl[row]; bf16_t* rowp = O + (size_t)row * 1024 + col0;
#pragma unroll
                for (int bj = 0; bj < 2; ++bj) { const f32x4 v0 = acc[ai][bj][m][0] * s, v1 = acc[ai][bj][m][1] * s;
                    u32x4 w; w.x = ::pk_bf16(v0[0], v0[1]); w.y = ::pk_bf16(v0[2], v0[3]); w.z = ::pk_bf16(v1[0], v1[1]); w.w = ::pk_bf16(v1[2], v1[3]);
                    *(u32x4*)(rowp + bj * HALF) = w; } }
    }
};
struct MoeOrder {
    int G, c, nt; int toff[16], cnt[16]; const int* list; int lcap;
    __device__ __forceinline__ void init(const int* cnt_, const int* list_, int lcap_, int G_, int c_) { G = G_; c = c_; list = list_; lcap = lcap_; int s = 0;
#pragma unroll
        for (int e = 0; e < 16; ++e) { cnt[e] = cnt_[e]; toff[e] = s; s += (cnt[e] + 255) >> 8; } nt = s; }
    __device__ __forceinline__ bool next(int i, Unit& u) const {
        const int Lq = i * G + c; if (Lq >= nt * 4) return false;
        const int pm = Lq % nt, pn4 = Lq / nt; int e = 0, to = 0;
#pragma unroll
        for (int q = 1; q < 16; ++q) { const bool ge = pm >= toff[q]; e += ge ? 1 : 0; to = ge ? toff[q] : to; }
        u.pm = pm; u.pn = e * 4 + pn4; u.aux = to; return true; }
    __device__ __forceinline__ void a_ready(const Unit&) const {}
    __device__ __forceinline__ void done(const Unit&) const {}
    __device__ __forceinline__ int gather_row(const Unit& u, int r) const {
        const int e = u.pn >> 2, slot = (u.pm - u.aux) * 256 + r; int n = 0;
#pragma unroll
        for (int q = 0; q < 16; ++q) n = (q == e) ? cnt[q] : n;
        return slot < n ? list[e * lcap + slot] : 0; }
};
}

constexpr int NB = 2, L = 8192, D = 1024, CTX = 256, RB = L + CTX;
constexpr int RL = NB * L, RCX = NB * CTX, R = RL + RCX;
constexpr int GW = 64;
constexpr int NCH = 66;
constexpr int ABIN = 3584, GIN = 3104, GINP = 3328;
constexpr int NE = 16, NG = 4, EPG = 4, EH = 512;
constexpr int MOE_ROWS = 37888;
constexpr float ALPHA = 1.4142135623730951f, LN_EPS = 1e-5f, KSCALE = 0.08838834764831845f;
constexpr int NT = 512;
constexpr int LDS_BYTES = 147456;

typedef unsigned short bf16_t;
#define LAS __attribute__((address_space(3)))
__device__ __forceinline__ float bf2f(bf16_t v) { return __uint_as_float((unsigned)v << 16); }
__device__ __forceinline__ bf16_t f2bf(float f) { unsigned u = __float_as_uint(f); return (bf16_t)((u + 0x7fffu + ((u >> 16) & 1u)) >> 16); }
__device__ __forceinline__ float siluf(float x) { return x / (1.f + expf(-x)); }
__device__ __forceinline__ float sigmf(float x) { return 1.f / (1.f + expf(-x)); }
__device__ __forceinline__ float logsigf(float x) { return fminf(x, 0.f) - log1pf(expf(-fabsf(x))); }

struct P {
    const float* in[34];
    float* out;
    float* Xc;
    float* MOD;
    float* NORM;
    int* CNT;
    unsigned* BAR;
    float* A1; float* A2;
    float* RS; int* RE; int* RPOS; float* RWt; float* WS;
    int* LIST; float* LISTW;
    bf16_t *Win0, *Wout0, *Win1, *Wout1, *Wgu, *Wd;
    bf16_t* H;
    bf16_t* Zr;
    bf16_t* Zh;
    bf16_t* hyT;
    float* FILT;
    bf16_t *Hs, *he, *slots;
    bf16_t* Z1;
    float* BG;
    bf16_t* GST;
};

__device__ __forceinline__ int launder_i(int x) { asm volatile("" : "+v"(x)); return x; }
#define TIDX launder_i((int)threadIdx.x)
#define GSTRIDE(i, n) for (long i = (long)blockIdx.x * blockDim.x + TIDX; i < (long)(n); i += (long)gridDim.x * blockDim.x)

__device__ __forceinline__ float* xrow(const P& p, int r) { return r < RL ? p.out + (size_t)r * D : p.Xc + (size_t)(r - RL) * D; }
__device__ __forceinline__ int seg_of(int r) { return r < RL ? r / L : 2; }
__device__ __forceinline__ const float* modv(const P& p, int l, int r, int chunk) { return p.MOD + ((size_t)(l * 3 + seg_of(r)) * 6 + chunk) * D; }
__device__ __forceinline__ int chunk_row0(int b, int c) { return c < 2 ? RL + b * CTX + c * 128 : b * L + (c - 2) * 128; }
__device__ __forceinline__ void row_bt(int r, int& b, int& tl) { if (r < RL) { b = r / L; tl = r % L; } else { b = (r - RL) / CTX; tl = L + (r - RL) % CTX; } }
__device__ __forceinline__ int bt_row(int b, int tl) { return tl < L ? b * L + tl : RL + b * CTX + (tl - L); }

#define XB_TMO      128
#define XB_XCNT(j)  (256  + 64 * (j))
#define XB_XSUB(j)  (1280 + 64 * (j))
#define XB_XGEN(j)  (2304 + 64 * (j))
#define XB_TOP      3328
#define XB_TOPGEN   3392
#define XCD_BAR_WORDS 3456
#define XB_SPIN_CAP (1u << 18)

__device__ __forceinline__ unsigned xb_ld(unsigned* p)              { return __hip_atomic_load(p, __ATOMIC_RELAXED, __HIP_MEMORY_SCOPE_AGENT); }
__device__ __forceinline__ unsigned xb_add(unsigned* p, unsigned v) { return __hip_atomic_fetch_add(p, v, __ATOMIC_RELAXED, __HIP_MEMORY_SCOPE_AGENT); }
__device__ __forceinline__ unsigned xb_xcc_id() { return (unsigned)__builtin_amdgcn_s_getreg((3 << 11) | 20) & 0xFu; }
#define XB_SPIN(cond, bar) do { unsigned _sp = 0; while (cond) { __builtin_amdgcn_s_sleep(1); \
    if ((++_sp & 255u) == 0u) { if (xb_ld(&(bar)[XB_TMO])) break; if (_sp > XB_SPIN_CAP) { atomicAdd(&(bar)[XB_TMO], 1u); break; } } } } while (0)

struct XcdBarrier {
    unsigned* bar; unsigned x;
    volatile LAS unsigned* st;
};

__device__ __forceinline__ XcdBarrier xcd_barrier_post(unsigned* bar, volatile LAS unsigned* st) {
    XcdBarrier b; b.bar = bar; b.x = xb_xcc_id(); b.st = st;
    if (threadIdx.x == 0) (void)xb_add(&bar[XB_XCNT(b.x)], 1u);
    return b;
}
__device__ __forceinline__ void xcd_barrier_complete(unsigned* bar, unsigned x, unsigned& nloc, unsigned& nx) {
    const unsigned G = gridDim.x * gridDim.y * gridDim.z;
    unsigned sum, cnt, mine, sp = 0u;
    for (;;) {
        sum = 0u; cnt = 0u; mine = 0u;
#pragma unroll
        for (unsigned j = 0; j < 16; ++j) { const unsigned c = xb_ld(&bar[XB_XCNT(j)]); sum += c; cnt += (c > 0u) ? 1u : 0u; mine = (j == x) ? c : mine; }
        if (sum == G) break;
        __builtin_amdgcn_s_sleep(1);
        if ((++sp & 255u) == 0u) { if (xb_ld(&bar[XB_TMO])) break; if (sp > XB_SPIN_CAP) { atomicAdd(&bar[XB_TMO], 1u); break; } }
    }
    nloc = mine > 0u ? mine : 1u; nx = cnt > 0u ? cnt : 1u;
}

__device__ __forceinline__ void xcd_barrier(const XcdBarrier& b) {
    asm volatile("s_waitcnt vmcnt(0)" ::: "memory");
    __syncthreads();
    if (threadIdx.x == 0) {
        unsigned* bar = b.bar;
        __builtin_amdgcn_s_waitcnt(0);
        unsigned nloc = b.st[0], nx = b.st[1];
        if (nloc == 0u) { xcd_barrier_complete(bar, b.x, nloc, nx); b.st[0] = nloc; b.st[1] = nx; }
        const unsigned old = xb_add(&bar[XB_XSUB(b.x)], 1u);
        const unsigned gen = old / nloc;
        if (old + 1u == (gen + 1u) * nloc) {
            __builtin_amdgcn_fence(__ATOMIC_RELEASE, "agent");
            asm volatile("s_waitcnt vmcnt(0)" ::: "memory");
            const unsigned og = xb_add(&bar[XB_TOP], 1u);
            const unsigned tg = og / nx;
            if (og + 1u == (tg + 1u) * nx) xb_add(&bar[XB_TOPGEN], 1u);
            else XB_SPIN(xb_ld(&bar[XB_TOPGEN]) == tg, bar);
            __builtin_amdgcn_fence(__ATOMIC_ACQUIRE, "agent");
            xb_add(&bar[XB_XGEN(b.x)], 1u);
            asm volatile("s_waitcnt vmcnt(0)" ::: "memory");
        } else {
            XB_SPIN(xb_ld(&bar[XB_XGEN(b.x)]) == gen, bar);
            __builtin_amdgcn_fence(__ATOMIC_ACQUIRE, "agent");
            asm volatile("s_waitcnt vmcnt(0)" ::: "memory");
        }
    }
    __syncthreads();
}

__device__ __forceinline__ void ph_wconv(bf16_t* dst, const float* src, int N, int K, int ldsrc, int nvalid) {
    GSTRIDE(idx, (long)N * K) { const int k = idx % K, n = idx / K; dst[idx] = n < nvalid ? f2bf(src[(size_t)k * ldsrc + n]) : (bf16_t)0; }
}
__device__ __forceinline__ void ph_wconv_moe(const P& p, int l) {
    GSTRIDE(idx, (long)NE * 1024 * 1024) {
        const int k = idx % 1024, n = (idx / 1024) % 1024, e = idx / (1024 * 1024);
        const int q = n >> 3, r = n & 7, j = 4 * q + (r & 3);
        const float* src = (r < 4 ? p.in[31] : p.in[32]) + ((size_t)(l * NE + e) * D + k) * EH + j;
        p.Wgu[idx] = f2bf(*src);
    }
    GSTRIDE(idx, (long)NE * 1024 * 512) {
        const int k = idx % 512, n = (idx / 512) % 1024, e = idx / (512 * 1024);
        p.Wd[idx] = f2bf(p.in[33][((size_t)(l * NE + e) * EH + k) * D + n]);
    }
}
__device__ __forceinline__ void ph_ada(const P& p) {
    GSTRIDE(idx, 2 * 3 * 6144) {
        const int n = idx % 6144, j = (idx / 6144) % 3, l = idx / (3 * 6144);
        const float* cv = j < 2 ? p.in[1] + j * D : p.in[3];
        const float* w = p.in[4] + (size_t)l * D * 6144;
        float acc = p.in[5][l * 6144 + n];
        for (int k = 0; k < D; ++k) acc += siluf(cv[k]) * w[(size_t)k * 6144 + n];
        p.MOD[idx] = acc;
    }
}
__device__ __forceinline__ void ph_init(const P& p) {
    GSTRIDE(i, (long)RL * D) p.out[i] = p.in[0][i];
    GSTRIDE(i, (long)RCX * D) p.Xc[i] = p.in[2][i];
}
__device__ __forceinline__ void hy_pos(int pidx, int& len, int& i) { if (pidx < L) { len = L; i = pidx; } else { len = CTX; i = pidx - L; } }
__device__ __forceinline__ void ph_hyA1(const P& p) {
    GSTRIDE(idx, (long)RB * 64) {
        const int j = idx % 64, pidx = idx / 64; int len, i; hy_pos(pidx, len, i);
        const float t = (float)i / (float)(len - 1);
        const float w = 2.0f * 3.14159265358979323846f * (float)i / (float)len;
        const float* w1 = p.in[13];
        float acc = p.in[14][j] + t * w1[j];
        for (int m = 0; m < 16; ++m) {
            const float f = 1e-4f + (float)m * ((15.f - 1e-4f) / 15.f);
            acc += cosf(f * w) * w1[(1 + m) * 64 + j] - sinf(f * w) * w1[(17 + m) * 64 + j];
        }
        p.A1[idx] = sinf(p.in[20][j] * acc);
    }
}
__device__ __forceinline__ void ph_hyA(const float* src, float* dst, const float* w, const float* bias, const float* freq) {
    GSTRIDE(idx, (long)RB * 64) {
        const int j = idx % 64, pidx = idx / 64;
        float acc = bias[j];
        for (int i = 0; i < 64; ++i) acc += src[(size_t)pidx * 64 + i] * w[i * 64 + j];
        dst[idx] = sinf(freq[j] * acc);
    }
}
__device__ __forceinline__ void ph_hyF(const P& p, const float* a3) {
    const float mind = logf(1e-2f) / 1.5f, maxd = logf(1e-2f) / 0.3f;
    GSTRIDE(idx, (long)2048 * RB) {
        const int pidx = idx % RB, col = idx / RB, ch = col % 512; int len, i; hy_pos(pidx, len, i);
        const float t = (float)i / (float)(len - 1);
        float acc = 0.f;
        for (int m = 0; m < 64; ++m) acc += a3[(size_t)pidx * 64 + m] * p.in[19][m * 2048 + col];
        const float delta = fabsf(mind + (float)ch * ((maxd - mind) / 511.f));
        p.FILT[idx] = acc * expf(-t * delta);
    }
}
__device__ __forceinline__ float block_sum(float v, float* red);
__device__ __forceinline__ void ph_hyNorm(const P& p, float* red) {
    for (int u = blockIdx.x; u < 2 * 2048; u += gridDim.x) {
        const int col = u % 2048, which = u / 2048; const int p0 = which ? L : 0, n = which ? CTX : L;
        float s = 0.f;
        for (int i = TIDX; i < n; i += NT) { const float v = p.FILT[(size_t)col * RB + p0 + i]; s += v * v; }
        const float t = block_sum(s, red);
        if (TIDX == 0) p.NORM[which * 2048 + col] = t;
    }
}
__device__ __forceinline__ void ph_mod(const P& p, int l, int which) {
    GSTRIDE(i, (long)R * D) {
        const int r = i / D, k = i % D;
        p.H[i] = f2bf(xrow(p, r)[k] * (1.f + modv(p, l, r, which * 3 + 1)[k]) + modv(p, l, r, which * 3 + 0)[k]);
    }
}
__device__ __forceinline__ void ph_prep_rope(const P& p) {
    GSTRIDE(i, (long)R * 2 * 4 * 64) {
        const int pr = i % 64, h = (i / 64) % 4, w = (i / 256) % 2, r = i / 512;
        bf16_t* base = p.Zr + (size_t)r * 2048 + w * 512 + h * 128;
        float t1 = bf2f(base[pr]), t2 = bf2f(base[64 + pr]);
        if (w == 1) { t1 *= KSCALE; t2 *= KSCALE; }
        if (r < RL) {
            const int t = r % L, row = t / GW, col = t % GW;
            const float inv = powf(10000.f, -(float)(pr & 31) / 32.f);
            const float ang = (pr < 32 ? (float)row : (float)col) * inv;
            float sn, cs; sincosf(ang, &sn, &cs);
            const float a = t1 * cs - t2 * sn, bb = t1 * sn + t2 * cs; t1 = a; t2 = bb;
        }
        base[pr] = f2bf(t1); base[64 + pr] = f2bf(t2);
    }
}
__device__ __forceinline__ void ph_prep_hy(const P& p) {
    GSTRIDE(idx, (long)NB * 1536 * RB) {
        const int tl = idx % RB, col = (idx / RB) % 1536, b = idx / (RB * 1536);
        const int s0 = tl < L ? 0 : L, s1 = tl < L ? L : RB;
        const float* w = p.in[11];
        float acc = p.in[12][col] + w[1536 + col] * bf2f(p.Zh[(size_t)bt_row(b, tl) * 1536 + col]);
        if (tl - 1 >= s0) acc += w[col] * bf2f(p.Zh[(size_t)bt_row(b, tl - 1) * 1536 + col]);
        if (tl + 1 < s1) acc += w[2 * 1536 + col] * bf2f(p.Zh[(size_t)bt_row(b, tl + 1) * 1536 + col]);
        p.hyT[idx] = f2bf(acc);
    }
}
__device__ __forceinline__ float hy_tapT(const float* Ff, const float* Fb, float nf, float nb, int d) {
    if (d > 0) return Ff[d] * nf; if (d < 0) return Fb[-d] * nb; return Ff[0] * nf + Fb[0] * nb;
}
__device__ __forceinline__ void ph_hyconv_naive(const P& p, int n, float* conv) {
    GSTRIDE(idx, (long)NB * 512 * (RB / 4)) {
        const int tb = idx % (RB / 4), ch = (idx / (RB / 4)) % 512, b = idx / ((RB / 4) * 512);
        const int tl0 = tb * 4, s0 = tl0 < L ? 0 : L, len = tl0 < L ? L : CTX, nrm = tl0 < L ? 0 : 1, t0 = tl0 - s0;
        const int cf = (n * 2 + 0) * 512 + ch, cb = (n * 2 + 1) * 512 + ch;
        const float nf = 1.f / sqrtf(p.NORM[nrm * 2048 + cf]), nb = 1.f / sqrtf(p.NORM[nrm * 2048 + cb]);
        const float* Ff = p.FILT + (size_t)cf * RB + s0; const float* Fb = p.FILT + (size_t)cb * RB + s0;
        const bf16_t* z = p.hyT + ((size_t)(b * 3 + 2) * 512 + ch) * RB + s0;
        float w0 = hy_tapT(Ff, Fb, nf, nb, t0), w1 = hy_tapT(Ff, Fb, nf, nb, t0 + 1), w2 = hy_tapT(Ff, Fb, nf, nb, t0 + 2), w3 = hy_tapT(Ff, Fb, nf, nb, t0 + 3);
        float a0 = 0.f, a1 = 0.f, a2 = 0.f, a3 = 0.f;
        for (int s = 0; s < len; ++s) {
            const float zz = bf2f(z[s]);
            a0 += w0 * zz; a1 += w1 * zz; a2 += w2 * zz; a3 += w3 * zz;
            w3 = w2; w2 = w1; w1 = w0;
            if (s + 1 < len) w0 = hy_tapT(Ff, Fb, nf, nb, t0 - (s + 1));
        }
        float* o = conv + ((size_t)b * 512 + ch) * RB + tl0; o[0] = a0; o[1] = a1; o[2] = a2; o[3] = a3;
    }
}
__device__ __forceinline__ void ph_hygate_naive(const P& p, int n, const float* conv) {
    bf16_t* yhT = p.Zh + (size_t)2 * NB * 4 * NCH * 16384;
    GSTRIDE(idx, (long)NB * 512 * RB) {
        const int tl = idx % RB, ch = (idx / RB) % 512, b = idx / (RB * 512);
        bf16_t* z = p.hyT + ((size_t)(b * 3 + 2) * 512 + ch) * RB + tl; const float gate = bf2f(p.hyT[((size_t)(b * 3 + n) * 512 + ch) * RB + tl]);
        const float r = gate * (conv[idx] + p.in[21][n * 512 + ch] * bf2f(*z));
        if (n == 0) *z = f2bf(r); else yhT[idx] = f2bf(r);
    }
}
__device__ __forceinline__ void ph_hy_untranspose(const P& p) {
    const bf16_t* yhT = p.Zh + (size_t)2 * NB * 4 * NCH * 16384;
    GSTRIDE(idx, (long)R * 512) { const int ch = idx % 512, r = idx / 512; int b, tl; row_bt(r, b, tl); p.H[(size_t)r * D + 512 + ch] = yhT[((size_t)b * 512 + ch) * RB + tl]; }
}
__device__ __forceinline__ size_t st_idx(int dir, int b, int h, int c) { return ((((size_t)dir * NB + b) * 4 + h) * NCH + c) * 16384; }
__device__ __forceinline__ void ph_retU_naive(const P& p) {
    bf16_t* ST = p.Zh;
    GSTRIDE(idx, (long)NB * 4 * NCH * 16384) {
        const int d = idx % 128, e = (idx / 128) % 128, c = (idx / 16384) % NCH, h = (idx / (16384 * NCH)) % 4, b = idx / (16384 * NCH * 4);
        const float lgf = p.in[9][h], lgb = p.in[10][h]; const int r0 = chunk_row0(b, c);
        float uf = 0.f, ub = 0.f;
        for (int j = 0; j < 128; ++j) {
            const float kk = bf2f(p.Zr[(size_t)(r0 + j) * 2048 + 512 + h * 128 + d]), vv = bf2f(p.Zr[(size_t)(r0 + j) * 2048 + 1024 + h * 128 + e]);
            uf += kk * expf(lgf * (float)(127 - j)) * vv; ub += kk * expf(lgb * (float)j) * vv;
        }
        ST[st_idx(0, b, h, c) + e * 128 + d] = f2bf(uf); ST[st_idx(1, b, h, c) + e * 128 + d] = f2bf(ub);
    }
}
__device__ __forceinline__ void ph_retScan(const P& p) {
    bf16_t* ST = p.Zh;
    GSTRIDE(idx, (long)2 * NB * 4 * 16384) {
        const int ed = idx % 16384, h = (idx / 16384) % 4, b = (idx / 65536) % NB, dir = idx / (65536 * NB);
        const float dc = expf((dir ? p.in[10] : p.in[9])[h] * 128.f);
        float s = 0.f;
        for (int cc = 0; cc < NCH; ++cc) {
            const int c = dir == 0 ? cc : (cc < 2 ? 1 - cc : NCH + 1 - cc);
            bf16_t* q = ST + st_idx(dir, b, h, c) + ed; const float u = bf2f(*q); *q = f2bf(s); s = dc * s + u;
        }
    }
}
__device__ __forceinline__ void ph_retO_naive(const P& p, float* lds) {
    const bf16_t* ST = p.Zh;
    for (int u = blockIdx.x; u < NB * 4 * NCH; u += gridDim.x) {
        const int c = u % NCH, h = (u / NCH) % 4, b = u / (NCH * 4); const int r0 = chunk_row0(b, c);
        const float lgf = p.in[9][h], lgb = p.in[10][h];
        __syncthreads();
        for (int e = TIDX; e < 128 * 128; e += NT) {
            const int j = e % 128, i = e / 128;
            const bf16_t* q = p.Zr + (size_t)(r0 + i) * 2048 + h * 128; const bf16_t* k = p.Zr + (size_t)(r0 + j) * 2048 + 512 + h * 128;
            float s = 0.f; for (int d = 0; d < 128; ++d) s += bf2f(q[d]) * bf2f(k[d]);
            const float m = i > j ? expf(lgf * (float)(i - j)) : (j > i ? expf(lgb * (float)(j - i)) : 2.f);
            lds[e] = s * m;
        }
        __syncthreads();
        const bf16_t* sf = ST + st_idx(0, b, h, c); const bf16_t* sb = ST + st_idx(1, b, h, c);
        for (int e2 = TIDX; e2 < 128 * 128; e2 += NT) {
            const int e = e2 % 128, i = e2 / 128;
            float o = 0.f; for (int j = 0; j < 128; ++j) o += lds[i * 128 + j] * bf2f(p.Zr[(size_t)(r0 + j) * 2048 + 1024 + h * 128 + e]);
            const bf16_t* q = p.Zr + (size_t)(r0 + i) * 2048 + h * 128;
            float of = 0.f, ob = 0.f; for (int d = 0; d < 128; ++d) { const float qq = bf2f(q[d]); of += qq * bf2f(sf[e * 128 + d]); ob += qq * bf2f(sb[e * 128 + d]); }
            p.H[(size_t)(r0 + i) * D + h * 128 + e] = f2bf(o + expf(lgf * (float)(i + 1)) * of + expf(lgb * (float)(128 - i)) * ob);
        }
    }
}
__device__ __forceinline__ void ph_retNorm_naive(const P& p) {
    GSTRIDE(idx, (long)R * 4) {
        const int h = idx % 4, r = idx / 4; bf16_t* o = p.H + (size_t)r * D + h * 128;
        float mu = 0.f; for (int e = 0; e < 128; ++e) mu += bf2f(o[e]); mu *= (1.f / 128.f);
        float var = 0.f; for (int e = 0; e < 128; ++e) { const float d = bf2f(o[e]) - mu; var += d * d; } var *= (1.f / 128.f);
        const float rs = 1.f / sqrtf(var + LN_EPS);
        for (int e = 0; e < 128; ++e) o[e] = f2bf((bf2f(o[e]) - mu) * rs * siluf(bf2f(p.Zr[(size_t)r * 2048 + 1536 + h * 128 + e])));
    }
}
__device__ __forceinline__ float block_sum(float v, float* red) {
    __syncthreads();
#pragma unroll
    for (int o = 32; o > 0; o >>= 1) v += __shfl_xor(v, o);
    if ((TIDX & 63) == 0) red[TIDX >> 6] = v;
    __syncthreads();
    float t = 0.f;
#pragma unroll
    for (int w = 0; w < NT / 64; ++w) t += red[w];
    return t;
}
template <int MODE> __device__ __forceinline__ void ph_post(const P& p, int l, int which, const bf16_t* Y, int ln, int wn, int nrows, float* red) {
    const float* lg = p.in[6] + (size_t)(l * 2 + which) * D; const float* lb = p.in[7] + (size_t)(l * 2 + which) * D;
    int toff[16];
    if (MODE == 1) { int s = 0;
#pragma unroll
        for (int e = 0; e < 16; ++e) { toff[e] = s; s += (p.CNT[l * 16 + e] + 255) >> 8; } }
    for (int r = blockIdx.x; r < nrows; r += gridDim.x) {
        float* x = xrow(p, r); const float* gate = modv(p, l, r, which * 3 + 2);
        const bf16_t *y0, *y1 = nullptr;
        if (MODE == 0) y0 = Y + (size_t)r * D;
        else {
            int sr[2];
#pragma unroll
            for (int k = 0; k < 2; ++k) { const int e = p.RE[r * 2 + k]; int to = 0;
#pragma unroll
                for (int q = 0; q < 16; ++q) to = (q == e) ? toff[q] : to;
                sr[k] = to * 256 + p.RPOS[r * 2 + k]; }
            y0 = p.slots + (size_t)sr[0] * D; y1 = p.slots + (size_t)sr[1] * D;
        }
        float v[2]; float s = 0.f;
#pragma unroll
        for (int i = 0; i < 2; ++i) { const int k = TIDX + i * NT; float yy = bf2f(y0[k]); if (MODE == 1) yy += bf2f(y1[k]); v[i] = ALPHA * x[k] + gate[k] * yy; s += v[i]; }
        const float mu = block_sum(s, red) * (1.f / D);
        float q = 0.f;
#pragma unroll
        for (int i = 0; i < 2; ++i) { const float d = v[i] - mu; q += d * d; }
        const float rs = 1.f / sqrtf(block_sum(q, red) * (1.f / D) + LN_EPS);
#pragma unroll
        for (int i = 0; i < 2; ++i) { const int k = TIDX + i * NT; const float xn = (v[i] - mu) * rs * lg[k] + lb[k]; x[k] = xn;
            if (ln >= 0) p.H[(size_t)r * D + k] = f2bf(xn * (1.f + modv(p, ln, r, wn * 3 + 1)[k]) + modv(p, ln, r, wn * 3 + 0)[k]); }
    }
}
__device__ __forceinline__ void ph_route1(const P& p, int l, int nrows) {
    GSTRIDE(idx, (long)nrows * NE) {
        const int e = idx % NE, r = idx / NE; const float* x = xrow(p, r); const float* sc = modv(p, l, r, 4); const float* sh = modv(p, l, r, 3);
        float acc = 0.f;
        for (int k = 0; k < D; ++k) acc += (x[k] * (1.f + sc[k]) + sh[k]) * p.in[29][k * NE + e];
        p.RS[idx] = sigmf(acc);
    }
}
__device__ __forceinline__ void ph_route2(const P& p, int l, int nrows) {
    GSTRIDE(r, nrows) {
        const float* s = p.RS + (size_t)r * NE; const float* rb = p.in[30];
        int best = 0; float bs = -1e30f;
        for (int g = 0; g < NG; ++g) {
            float m1 = -1e30f, m2 = -1e30f;
            for (int q = 0; q < EPG; ++q) { const float v = s[g * EPG + q] + rb[g * EPG + q]; if (v > m1) { m2 = m1; m1 = v; } else if (v > m2) m2 = v; }
            if (m1 + m2 > bs) { bs = m1 + m2; best = g; }
        }
        int i1 = 0; float v1 = -1e30f;
        for (int q = 0; q < EPG; ++q) { const float v = s[best * EPG + q] + rb[best * EPG + q]; if (v > v1) { v1 = v; i1 = q; } }
        int i2 = 0; float v2 = -1e30f;
        for (int q = 0; q < EPG; ++q) { if (q == i1) continue; const float v = s[best * EPG + q] + rb[best * EPG + q]; if (v > v2) { v2 = v; i2 = q; } }
        const int e1 = best * EPG + i1, e2 = best * EPG + i2; const float a = s[e1], c = s[e2];
        p.RE[r * 2] = e1; p.RE[r * 2 + 1] = e2; p.RWt[r * 2] = a / (a + c); p.RWt[r * 2 + 1] = c / (a + c);
        p.RPOS[r * 2] = atomicAdd(&p.CNT[l * 16 + e1], 1); p.RPOS[r * 2 + 1] = atomicAdd(&p.CNT[l * 16 + e2], 1);
    }
}
__device__ __forceinline__ void ph_permute(const P& p, int l, int nrows) {
    int toff[16]; { int s = 0;
#pragma unroll
        for (int e = 0; e < 16; ++e) { toff[e] = s; s += (p.CNT[l * 16 + e] + 255) >> 8; } }
    GSTRIDE(idx, (long)nrows * 2 * 128) {
        const int ck = idx % 128, k = (idx / 128) % 2, r = idx / 256; const int e = p.RE[r * 2 + k]; int to = 0;
#pragma unroll
        for (int q = 0; q < 16; ++q) to = (q == e) ? toff[q] : to;
        const int sr = to * 256 + p.RPOS[r * 2 + k];
        ((uint4*)(p.Hs + (size_t)sr * D))[ck] = ((const uint4*)(p.H + (size_t)r * D))[ck];
        if (ck == 0) p.WS[sr] = p.RWt[r * 2 + k];
    }
}
__device__ __forceinline__ void ph_glagate(const P& p) {
    GSTRIDE(idx, (long)2 * R * 512) {
        const int ch = idx % 512, r = (idx / 512) % R, dir = idx / (512 * R);
        const float* gw = (dir ? p.in[26] : p.in[24]); const float* gb = (dir ? p.in[27] : p.in[25]);
        float acc = gb[ch];
        for (int q = 0; q < 16; ++q) acc += bf2f(p.Z1[(size_t)r * GINP + 3072 + dir * 16 + q]) * gw[q * 512 + ch];
        p.BG[idx] = logsigf(acc) * (1.f / 16.f);
    }
}
__device__ __forceinline__ void ph_glacum(const P& p) {
    GSTRIDE(idx, (long)2 * NB * NCH * 512) {
        const int ch = idx % 512, c = (idx / 512) % NCH, b = (idx / (512 * NCH)) % NB, dir = idx / (512 * NCH * NB);
        float* a = p.BG + ((size_t)dir * R + chunk_row0(b, c)) * 512 + ch;
        float s = 0.f;
        if (dir == 0) for (int i = 0; i < 128; ++i) { s += a[(size_t)i * 512]; a[(size_t)i * 512] = s; }
        else for (int i = 127; i >= 0; --i) { s += a[(size_t)i * 512]; a[(size_t)i * 512] = s; }
    }
}
__device__ __forceinline__ size_t gst_idx(int dir, int b, int h, int c) { return ((((size_t)dir * NB + b) * 4 + h) * NCH + c) * 32768; }
__device__ __forceinline__ void ph_glaU_naive(const P& p) {
    const float* BF = p.BG; const float* BB = p.BG + (size_t)R * 512;
    GSTRIDE(idx, (long)NB * 4 * NCH * 32768) {
        const int d = idx % 128, e = (idx / 128) % 256, c = (idx / 32768) % NCH, h = (idx / (32768 * NCH)) % 4, b = idx / (32768 * NCH * 4);
        const int r0 = chunk_row0(b, c);
        const float bfe = BF[(size_t)(r0 + 127) * 512 + h * 128 + d], bbe = BB[(size_t)r0 * 512 + h * 128 + d];
        float uf = 0.f, ub = 0.f;
        for (int j = 0; j < 128; ++j) {
            const float kk = bf2f(p.Z1[(size_t)(r0 + j) * GINP + 512 + h * 128 + d]), vv = bf2f(p.Z1[(size_t)(r0 + j) * GINP + 1024 + h * 256 + e]);
            uf += kk * expf(bfe - BF[(size_t)(r0 + j) * 512 + h * 128 + d]) * vv; ub += kk * expf(bbe - BB[(size_t)(r0 + j) * 512 + h * 128 + d]) * vv;
        }
        p.GST[gst_idx(0, b, h, c) + e * 128 + d] = f2bf(uf); p.GST[gst_idx(1, b, h, c) + e * 128 + d] = f2bf(ub);
    }
}
__device__ __forceinline__ void ph_glaScan(const P& p) {
    const float* BF = p.BG; const float* BB = p.BG + (size_t)R * 512;
    GSTRIDE(idx, (long)2 * NB * 4 * 32768) {
        const int d = idx % 128, ed = idx % 32768, h = (idx / 32768) % 4, b = (idx / 131072) % NB, dir = idx / (131072 * NB);
        float s = 0.f;
        for (int cc = 0; cc < NCH; ++cc) {
            const int c = dir == 0 ? cc : (cc < 2 ? 1 - cc : NCH + 1 - cc); const int r0 = chunk_row0(b, c);
            const float dc = dir == 0 ? expf(BF[(size_t)(r0 + 127) * 512 + h * 128 + d]) : expf(BB[(size_t)r0 * 512 + h * 128 + d]);
            bf16_t* q = p.GST + gst_idx(dir, b, h, c) + ed; const float u = bf2f(*q); *q = f2bf(s); s = dc * s + u;
        }
    }
}
__device__ __forceinline__ void ph_glaO_naive(const P& p, float* lds) {
    const float* BF = p.BG; const float* BB = p.BG + (size_t)R * 512;
    for (int u = blockIdx.x; u < NB * 4 * 64; u += gridDim.x) {
        const int c = 2 + u % 64, h = (u / 64) % 4, b = u / 256; const int r0 = chunk_row0(b, c);
        __syncthreads();
        for (int e = TIDX; e < 128 * 128; e += NT) {
            const int j = e % 128, i = e / 128;
            const bf16_t* q = p.Z1 + (size_t)(r0 + i) * GINP + h * 128; const bf16_t* k = p.Z1 + (size_t)(r0 + j) * GINP + 512 + h * 128;
            float s = 0.f;
            if (i >= j) { const float* bi = BF + (size_t)(r0 + i) * 512 + h * 128; const float* bj = BF + (size_t)(r0 + j) * 512 + h * 128;
                for (int d = 0; d < 128; ++d) s += bf2f(q[d]) * bf2f(k[d]) * expf(bi[d] - bj[d]); }
            if (i <= j) { const float* bi = BB + (size_t)(r0 + i) * 512 + h * 128; const float* bj = BB + (size_t)(r0 + j) * 512 + h * 128;
                for (int d = 0; d < 128; ++d) s += bf2f(q[d]) * bf2f(k[d]) * expf(bi[d] - bj[d]); }
            lds[e] = s * KSCALE;
        }
        __syncthreads();
        const bf16_t* sf = p.GST + gst_idx(0, b, h, c); const bf16_t* sb = p.GST + gst_idx(1, b, h, c);
        for (int e2 = TIDX; e2 < 128 * 256; e2 += NT) {
            const int e = e2 % 256, i = e2 / 256;
            float o = 0.f; for (int j = 0; j < 128; ++j) o += lds[i * 128 + j] * bf2f(p.Z1[(size_t)(r0 + j) * GINP + 1024 + h * 256 + e]);
            const bf16_t* q = p.Z1 + (size_t)(r0 + i) * GINP + h * 128; const float* bi = BF + (size_t)(r0 + i) * 512 + h * 128; const float* bbi = BB + (size_t)(r0 + i) * 512 + h * 128;
            float a = 0.f; for (int d = 0; d < 128; ++d) a += bf2f(q[d]) * (expf(bi[d]) * bf2f(sf[e * 128 + d]) + expf(bbi[d]) * bf2f(sb[e * 128 + d]));
            p.H[(size_t)(r0 + i) * D + h * 256 + e] = f2bf(o + a * KSCALE);
        }
    }
}
__device__ __forceinline__ void ph_glaNorm_naive(const P& p) {
    GSTRIDE(idx, (long)RL * 4) {
        const int h = idx % 4, r = idx / 4; bf16_t* o = p.H + (size_t)r * D + h * 256;
        float ss = 0.f; for (int e = 0; e < 256; ++e) { const float v = bf2f(o[e]); ss += v * v; }
        const float rs = 1.f / sqrtf(ss * (1.f / 256.f) + LN_EPS);
        for (int e = 0; e < 256; ++e) o[e] = f2bf(bf2f(o[e]) * rs * siluf(bf2f(p.Z1[(size_t)r * GINP + 2048 + h * 256 + e])));
    }
}

#define FD __device__ __forceinline__
#define TIE(a, b) asm volatile("" : "+v"(a) : "v"(b))
#define HWCOS(x) __builtin_amdgcn_cosf(x)
#define HWSIN(x) __builtin_amdgcn_sinf(x)
struct cf { float x, y; };
FD cf cadd(cf a, cf b) { return {a.x + b.x, a.y + b.y}; }
FD cf csub(cf a, cf b) { return {a.x - b.x, a.y - b.y}; }
FD cf cmul(cf a, cf b) { return {a.x * b.x - a.y * b.y, a.x * b.y + a.y * b.x}; }
#define C32(k) ((k)==0?1.0f:(k)==1?0.98078528040323043f:(k)==2?0.92387953251128674f:(k)==3?0.83146961230254524f:(k)==4?0.70710678118654752f:(k)==5?0.55557023301960222f:(k)==6?0.38268343236508977f:(k)==7?0.19509032201612825f:(k)==8?0.0f:(k)==9?-0.19509032201612825f:(k)==10?-0.38268343236508977f:(k)==11?-0.55557023301960222f:(k)==12?-0.70710678118654752f:(k)==13?-0.83146961230254524f:(k)==14?-0.92387953251128674f:-0.98078528040323043f)
#define S32(k) ((k)==0?0.0f:(k)==1?0.19509032201612825f:(k)==2?0.38268343236508977f:(k)==3?0.55557023301960222f:(k)==4?0.70710678118654752f:(k)==5?0.83146961230254524f:(k)==6?0.92387953251128674f:(k)==7?0.98078528040323043f:(k)==8?1.0f:(k)==9?0.98078528040323043f:(k)==10?0.92387953251128674f:(k)==11?0.83146961230254524f:(k)==12?0.70710678118654752f:(k)==13?0.55557023301960222f:(k)==14?0.38268343236508977f:0.19509032201612825f)
template <int N, int LEN, bool INV> FD void dit_level(cf (&x)[N]) {
#pragma unroll
    for (int blk = 0; blk < N; blk += LEN)
#pragma unroll
        for (int j = 0; j < LEN / 2; ++j) {
            const int k = j * (32 / LEN);
            const cf a = x[blk + j], b0 = x[blk + j + LEN / 2];
            const cf b = k == 0 ? b0 : (k == 8 ? (INV ? cf{-b0.y, b0.x} : cf{b0.y, -b0.x}) : cmul(b0, cf{C32(k), INV ? S32(k) : -S32(k)}));
            x[blk + j] = cadd(a, b); x[blk + j + LEN / 2] = csub(a, b);
        }
}
template <int N, bool INV> FD void dit_reg(cf (&x)[N]) {
    dit_level<N, 2, INV>(x); dit_level<N, 4, INV>(x);
    if constexpr (N >= 8) dit_level<N, 8, INV>(x);
    if constexpr (N >= 16) dit_level<N, 16, INV>(x);
}
template <int N, int LEN, bool INV> FD void dif_level(cf (&x)[N]) {
#pragma unroll
    for (int blk = 0; blk < N; blk += LEN)
#pragma unroll
        for (int j = 0; j < LEN / 2; ++j) {
            const int k = j * (32 / LEN);
            const cf a = x[blk + j], b = x[blk + j + LEN / 2];
            x[blk + j] = cadd(a, b); const cf d = csub(a, b);
            x[blk + j + LEN / 2] = k == 0 ? d : (k == 8 ? (INV ? cf{-d.y, d.x} : cf{d.y, -d.x}) : cmul(d, cf{C32(k), INV ? S32(k) : -S32(k)}));
        }
}
template <int N, bool INV> FD void dif_reg(cf (&x)[N]) {
    if constexpr (N >= 16) dif_level<N, 16, INV>(x);
    if constexpr (N >= 8) dif_level<N, 8, INV>(x);
    dif_level<N, 4, INV>(x); dif_level<N, 2, INV>(x);
}
constexpr int FFT_N = 16384, FFT_LDS_CF = 17920;
FD int brev4(int i) { return ((i & 1) << 3) | ((i & 2) << 1) | ((i & 4) >> 1) | ((i & 8) >> 3); }
FD int physA(int m, int a) { return 4480 * a + m + (m >> 4) + 16 * (m >> 9); }
FD int physB(int b, int a, int m) { return 4480 * b + 272 * a + 16 * (a >> 1) + m + (m >> 4); }
FD int physC(int b, int a, int m) { return 272 * b + 16 * (b >> 1) + 17 * a + m; }
FD int physD(int g, int j) { return 17 * g + 16 * (g >> 5) + j; }
template <int RR, int RM> FD void twiddle(cf (&x)[RR], int m, float sgn) {
    const float fr = (float)m * (1.0f / (float)RM); const cf w{HWCOS(fr), sgn * HWSIN(fr)}; cf cur = w;
#pragma unroll
    for (int s = 1; s < RR; ++s) { x[s] = cmul(x[s], cur); if (s + 1 < RR) cur = cmul(cur, w); }
}
FD void stA_fwd(int m, cf v0, cf v1, cf v2, cf v3, cf* buf) {
    cf x[4] = {v0, v2, v1, v3};
    dit_reg<4, false>(x); twiddle<4, 16384>(x, m, -1.f);
#pragma unroll
    for (int s = 0; s < 4; ++s) buf[physA(m, s)] = x[s];
}
FD void stB_fwd(int idx, cf* buf) {
    const int b = idx >> 8, m = idx & 255; cf x[16];
#pragma unroll
    for (int i = 0; i < 16; ++i) x[i] = buf[physB(b, brev4(i), m)];
    dit_reg<16, false>(x); twiddle<16, 4096>(x, m, -1.f);
#pragma unroll
    for (int s = 0; s < 16; ++s) buf[physB(b, s, m)] = x[s];
}
FD void stC_fwd(int idx, cf* buf) {
    const int b = idx >> 4, m = idx & 15; cf x[16];
#pragma unroll
    for (int i = 0; i < 16; ++i) x[i] = buf[physC(b, brev4(i), m)];
    dit_reg<16, false>(x); twiddle<16, 256>(x, m, -1.f);
#pragma unroll
    for (int s = 0; s < 16; ++s) buf[physC(b, s, m)] = x[s];
}
FD void stD_fwd_regs(int g, const cf* buf, cf (&x)[16]) {
#pragma unroll
    for (int i = 0; i < 16; ++i) x[i] = buf[physD(g, brev4(i))];
    dit_reg<16, false>(x);
}
FD void stD_mul(int g, cf* buf, const cf (&h)[16]) {
    cf x[16];
#pragma unroll
    for (int i = 0; i < 16; ++i) x[i] = buf[physD(g, brev4(i))];
    dit_reg<16, false>(x);
#pragma unroll
    for (int s = 0; s < 16; ++s) x[s] = cmul(x[s], h[s]);
    dif_reg<16, true>(x);
#pragma unroll
    for (int i = 0; i < 16; ++i) buf[physD(g, brev4(i))] = x[i];
}
FD void stC_inv(int idx, cf* buf) {
    const int b = idx >> 4, m = idx & 15; cf x[16];
#pragma unroll
    for (int s = 0; s < 16; ++s) x[s] = buf[physC(b, s, m)];
    twiddle<16, 256>(x, m, 1.f); dif_reg<16, true>(x);
#pragma unroll
    for (int i = 0; i < 16; ++i) buf[physC(b, brev4(i), m)] = x[i];
}
FD void stB_inv(int idx, cf* buf) {
    const int b = idx >> 8, m = idx & 255; cf x[16];
#pragma unroll
    for (int s = 0; s < 16; ++s) x[s] = buf[physB(b, s, m)];
    twiddle<16, 4096>(x, m, 1.f); dif_reg<16, true>(x);
#pragma unroll
    for (int i = 0; i < 16; ++i) buf[physB(b, brev4(i), m)] = x[i];
}
FD void stA_inv(int m, const cf* buf, cf& r0, cf& r1) {
    cf x[4];
#pragma unroll
    for (int s = 0; s < 4; ++s) x[s] = buf[physA(m, s)];
    twiddle<4, 16384>(x, m, 1.f); dif_reg<4, true>(x);
    r0 = x[0]; r1 = x[2];
}

#undef FD
__device__ __forceinline__ float dw3(const bf16_t* u, int d, int lo, int hi, float w0, float w1, float w2, float bs) {
    const float um = bf2f(u[d > lo ? d - 1 : d]), uc = bf2f(u[d]), up = bf2f(u[d < hi ? d + 1 : d]);
    return bs + w1 * uc + (d > lo ? w0 : 0.f) * um + (d < hi ? w2 : 0.f) * up;
}
__device__ __forceinline__ void ph_hyena_fft(const P& p, unsigned char* smem) {
    cf* buf = (cf*)smem; float* fb = (float*)smem; float* red = (float*)(smem + FFT_LDS_CF * 8);
    const int t = TIDX;
    bf16_t* yhT = p.Zh + (size_t)2 * NB * 4 * NCH * 16384;
    for (int ch = blockIdx.x; ch < 512; ch += gridDim.x) {
        const bf16_t* hy0 = p.hyT + ((size_t)0 * 512 + ch) * RB;
        const size_t bstr = (size_t)3 * 512 * RB, jstr = (size_t)512 * RB;
        cf* Hg = (cf*)p.H + (size_t)blockIdx.x * 16384;
        cf zreg[16];
        float cw[3][3], cbv[3];
#pragma unroll
        for (int j = 0; j < 3; ++j) { cbv[j] = p.in[12][j * 512 + ch];
#pragma unroll
            for (int q = 0; q < 3; ++q) cw[j][q] = p.in[11][q * 1536 + j * 512 + ch]; }
#pragma unroll 1
        for (int n = 0; n < 2; ++n) {
            const int cfi = (n * 2) * 512 + ch, cbi = (n * 2 + 1) * 512 + ch;
            const float* Ff = p.FILT + (size_t)cfi * RB; const float* Fb = p.FILT + (size_t)cbi * RB;
            float tf0[8], tf1[8], tb2[8], tb3[8]; float sf = 0.f, sb = 0.f;
#pragma unroll
            for (int j = 0; j < 8; ++j) { const int m = t + 512 * j;
                tf0[j] = Ff[m]; tf1[j] = Ff[4096 + m]; tb2[j] = Fb[m == 0 ? 0 : 8192 - m]; tb3[j] = Fb[4096 - m];
                sf += tf0[j] * tf0[j] + tf1[j] * tf1[j]; sb += tb2[j] * tb2[j] + tb3[j] * tb3[j]; }
            const float nf = 1.f / sqrtf(block_sum(sf, red)), nb = 1.f / sqrtf(block_sum(sb, red));
#pragma unroll
            for (int j = 0; j < 8; ++j) { const int m = launder_i(t) + 512 * j;
                const float v0 = tf0[j] * nf + ((m == 0) ? tb2[j] * nb : 0.f), v2 = (m == 0) ? 0.f : tb2[j] * nb;
                stA_fwd(m, cf{v0, 0.f}, cf{tf1[j] * nf, 0.f}, cf{v2, 0.f}, cf{tb3[j] * nb, 0.f}, buf); }
            __syncthreads();
#pragma unroll 1
            for (int q = 0; q < 2; ++q) stB_fwd(launder_i(t) + 512 * q, buf);
            __syncthreads();
#pragma unroll 1
            for (int q = 0; q < 2; ++q) stC_fwd(launder_i(t) + 512 * q, buf);
            __syncthreads();
#pragma unroll 1
            for (int q = 0; q < 2; ++q) { const int g = launder_i(t) + 512 * q; cf hh[16]; stD_fwd_regs(g, buf, hh);
#pragma unroll
                for (int s = 0; s < 16; ++s) Hg[s * 1024 + g] = hh[s]; }
            __syncthreads();
#pragma unroll
            for (int j = 0; j < 8; ++j) { const int m = launder_i(t) + 512 * j;
                if (n == 0) { zreg[2 * j] = cf{dw3(hy0 + 2 * jstr, m, 0, L - 1, cw[2][0], cw[2][1], cw[2][2], cbv[2]), dw3(hy0 + bstr + 2 * jstr, m, 0, L - 1, cw[2][0], cw[2][1], cw[2][2], cbv[2])};
                              zreg[2 * j + 1] = cf{dw3(hy0 + 2 * jstr, 4096 + m, 0, L - 1, cw[2][0], cw[2][1], cw[2][2], cbv[2]), dw3(hy0 + bstr + 2 * jstr, 4096 + m, 0, L - 1, cw[2][0], cw[2][1], cw[2][2], cbv[2])}; }
                stA_fwd(m, zreg[2 * j], zreg[2 * j + 1], cf{0.f, 0.f}, cf{0.f, 0.f}, buf); }
            __syncthreads();
#pragma unroll 1
            for (int q = 0; q < 2; ++q) stB_fwd(launder_i(t) + 512 * q, buf);
            __syncthreads();
#pragma unroll 1
            for (int q = 0; q < 2; ++q) stC_fwd(launder_i(t) + 512 * q, buf);
            __syncthreads();
#pragma unroll 1
            for (int q = 0; q < 2; ++q) { const int g = launder_i(t) + 512 * q; cf hh[16];
#pragma unroll
                for (int s = 0; s < 16; ++s) hh[s] = Hg[s * 1024 + g];
                stD_mul(g, buf, hh); }
            __syncthreads();
#pragma unroll 1
            for (int q = 0; q < 2; ++q) stC_inv(launder_i(t) + 512 * q, buf);
            __syncthreads();
#pragma unroll 1
            for (int q = 0; q < 2; ++q) stB_inv(launder_i(t) + 512 * q, buf);
            __syncthreads();
            const float sk = p.in[21][n * 512 + ch];
#pragma unroll
            for (int j = 0; j < 8; ++j) { const int m = launder_i(t) + 512 * j; cf r0, r1; stA_inv(m, buf, r0, r1);
#pragma unroll
                for (int hlf = 0; hlf < 2; ++hlf) { const int d = m + 4096 * hlf; const cf r = hlf ? r1 : r0; const cf z = zreg[2 * j + hlf];
                    const bf16_t* gs = hy0 + n * jstr;
                    const float g0 = dw3(gs, d, 0, L - 1, cw[n][0], cw[n][1], cw[n][2], cbv[n]), g1 = dw3(gs + bstr, d, 0, L - 1, cw[n][0], cw[n][1], cw[n][2], cbv[n]);
                    const float o0 = g0 * (r.x * (1.f / 16384.f) + sk * z.x), o1 = g1 * (r.y * (1.f / 16384.f) + sk * z.y);
                    if (n == 0) zreg[2 * j + hlf] = cf{o0, o1};
                    else { yhT[((size_t)0 * 512 + ch) * RB + d] = f2bf(o0); yhT[((size_t)1 * 512 + ch) * RB + d] = f2bf(o1); } } }
            __syncthreads();
        }
        {
            float* tap = fb;
            float* zc = fb + 1024;
            const int b = t >> 8, tt = t & 255;
#pragma unroll
            for (int n = 0; n < 2; ++n) {
                const int cfi = (n * 2) * 512 + ch, cbi = (n * 2 + 1) * 512 + ch;
                const float* Ff = p.FILT + (size_t)cfi * RB + L; const float* Fb = p.FILT + (size_t)cbi * RB + L;
                const float vf = t < 256 ? Ff[t] : 0.f, vb = t < 256 ? Fb[t] : 0.f;
                const float nf = 1.f / sqrtf(block_sum(vf * vf, red)), nb = 1.f / sqrtf(block_sum(vb * vb, red));
                if (t < 511) { const int d = t - 255; tap[n * 512 + t] = d > 0 ? Ff[d] * nf : (d < 0 ? Fb[-d] * nb : Ff[0] * nf + Fb[0] * nb); }
            }
            const bf16_t* hb_ = hy0 + (size_t)b * bstr;
            const float z1 = dw3(hb_ + 2 * jstr, L + tt, L, RB - 1, cw[2][0], cw[2][1], cw[2][2], cbv[2]);
            zc[b * 256 + tt] = z1;
            __syncthreads();
            float c1 = 0.f;
            for (int s = 0; s < 256; ++s) c1 += tap[tt - s + 255] * zc[b * 256 + s];
            const float z2 = dw3(hb_, L + tt, L, RB - 1, cw[0][0], cw[0][1], cw[0][2], cbv[0]) * (c1 + p.in[21][ch] * z1);
            __syncthreads();
            zc[b * 256 + tt] = z2;
            __syncthreads();
            float c2 = 0.f;
            for (int s = 0; s < 256; ++s) c2 += tap[512 + tt - s + 255] * zc[b * 256 + s];
            yhT[((size_t)b * 512 + ch) * RB + L + tt] = f2bf(dw3(hb_ + jstr, L + tt, L, RB - 1, cw[1][0], cw[1][1], cw[1][2], cbv[1]) * (c2 + p.in[21][512 + ch] * z2));
            __syncthreads();
        }
    }
}

typedef short bf16x8 __attribute__((ext_vector_type(8)));
typedef short s16x4 __attribute__((ext_vector_type(4)));
typedef float f32x4 __attribute__((ext_vector_type(4)));
typedef unsigned u4v __attribute__((ext_vector_type(4)));
typedef unsigned u2v __attribute__((ext_vector_type(2)));
constexpr int LDT = 136;
constexpr int TILE_E = 128 * LDT;
__device__ __forceinline__ bf16x8 frag_row(const LAS bf16_t* T, int ld, int r0, int k0, int lane) {
    return *(const LAS bf16x8*)(T + (r0 + (lane & 15)) * ld + k0 + 8 * (lane >> 4));
}
__device__ __forceinline__ bf16x8 frag_tr(const LAS bf16_t* T, int ld, int k0, int n0, int lane) {
    const int g = lane >> 4, q = (lane & 15) >> 2, pp = lane & 3;
    const LAS bf16_t* a0 = T + (k0 + 8 * g + q) * ld + n0 + 4 * pp;
    const s16x4 lo = __builtin_amdgcn_ds_read_tr16_b64_v4i16((LAS s16x4*)a0);
    const s16x4 hi = __builtin_amdgcn_ds_read_tr16_b64_v4i16((LAS s16x4*)(a0 + 4 * ld));
    return (bf16x8){lo[0], lo[1], lo[2], lo[3], hi[0], hi[1], hi[2], hi[3]};
}
#define MFMA16(xn, xm, acc) __builtin_amdgcn_mfma_f32_16x16x32_bf16(xn, xm, acc, 0, 0, 0)
__device__ __forceinline__ void unpack8(const u4v u, float (&f)[8]) {
    f[0] = __uint_as_float(u.x << 16); f[1] = __uint_as_float(u.x & 0xffff0000u); f[2] = __uint_as_float(u.y << 16); f[3] = __uint_as_float(u.y & 0xffff0000u);
    f[4] = __uint_as_float(u.z << 16); f[5] = __uint_as_float(u.z & 0xffff0000u); f[6] = __uint_as_float(u.w << 16); f[7] = __uint_as_float(u.w & 0xffff0000u);
}
__device__ __forceinline__ u4v pack8(const float (&f)[8]) {
    u4v u; u.x = pk_bf16(f[0], f[1]); u.y = pk_bf16(f[2], f[3]); u.z = pk_bf16(f[4], f[5]); u.w = pk_bf16(f[6], f[7]); return u;
}
__device__ __forceinline__ void stage_tile(LAS bf16_t* dst, const bf16_t* src, int gld, int tid) {
#pragma unroll
    for (int i = 0; i < 4; ++i) { const int c = tid + 512 * i, row = c >> 4, ch = c & 15;
        *(LAS u4v*)(dst + row * LDT + ch * 8) = *(const u4v*)(src + (size_t)row * gld + ch * 8); }
}
__device__ __forceinline__ void ph_retU_mfma(const P& p, unsigned char* smem) {
    LAS bf16_t* Kt = (LAS bf16_t*)smem; LAS bf16_t* VF = Kt + TILE_E; LAS bf16_t* VB = VF + TILE_E;
    bf16_t* ST = p.Zh;
    for (int u = blockIdx.x; u < NB * 4 * NCH; u += gridDim.x) {
        const int tid = TIDX, lane = tid & 63, w = tid >> 6;
        const int c = u % NCH, h = (u / NCH) % 4, b = u / (NCH * 4); const int r0 = chunk_row0(b, c);
        const float lgf = p.in[9][h], lgb = p.in[10][h];
        const bf16_t* kb = p.Zr + (size_t)r0 * 2048 + 512 + h * 128; const bf16_t* vb = p.Zr + (size_t)r0 * 2048 + 1024 + h * 128;
        __syncthreads();
        stage_tile(Kt, kb, 2048, tid);
#pragma unroll
        for (int i = 0; i < 4; ++i) { const int cc = tid + 512 * i, j = cc >> 4, ch = cc & 15;
            float f[8], g[8]; unpack8(*(const u4v*)(vb + (size_t)j * 2048 + ch * 8), f);
            const float wf = __expf(lgf * (float)(127 - j)), wb = __expf(lgb * (float)j);
#pragma unroll
            for (int q = 0; q < 8; ++q) { g[q] = f[q] * wb; f[q] *= wf; }
            *(LAS u4v*)(VF + j * LDT + ch * 8) = pack8(f); *(LAS u4v*)(VB + j * LDT + ch * 8) = pack8(g); }
        __syncthreads();
        f32x4 af[8], ab[8];
#pragma unroll
        for (int nt = 0; nt < 8; ++nt) { af[nt] = (f32x4){0.f, 0.f, 0.f, 0.f}; ab[nt] = (f32x4){0.f, 0.f, 0.f, 0.f}; }
#pragma unroll
        for (int ks = 0; ks < 4; ++ks) {
            const bf16x8 xf = frag_tr(VF, LDT, 32 * ks, 16 * w, lane), xb = frag_tr(VB, LDT, 32 * ks, 16 * w, lane);
#pragma unroll
            for (int nt = 0; nt < 8; ++nt) { const bf16x8 xn = frag_tr(Kt, LDT, 32 * ks, 16 * nt, lane); af[nt] = MFMA16(xn, xf, af[nt]); ab[nt] = MFMA16(xn, xb, ab[nt]); }
        }
        const int e = 16 * w + (lane & 15), d0 = 4 * (lane >> 4);
        bf16_t* of = ST + st_idx(0, b, h, c) + e * 128 + d0; bf16_t* ob = ST + st_idx(1, b, h, c) + e * 128 + d0;
#pragma unroll
        for (int nt = 0; nt < 8; ++nt) {
            u2v o; o.x = pk_bf16(af[nt][0], af[nt][1]); o.y = pk_bf16(af[nt][2], af[nt][3]); *(u2v*)(of + 16 * nt) = o;
            o.x = pk_bf16(ab[nt][0], ab[nt][1]); o.y = pk_bf16(ab[nt][2], ab[nt][3]); *(u2v*)(ob + 16 * nt) = o; }
    }
}
__device__ __forceinline__ void ph_retO_mfma(const P& p, unsigned char* smem) {
    LAS bf16_t* Qs = (LAS bf16_t*)smem; LAS bf16_t* Ks = Qs + TILE_E; LAS bf16_t* Vs = Ks + TILE_E; LAS bf16_t* Ss = Vs + TILE_E;
    const bf16_t* ST = p.Zh;
    for (int u = blockIdx.x; u < NB * 4 * NCH; u += gridDim.x) {
        const int tid = TIDX, lane = tid & 63, w = tid >> 6, fr = lane & 15, fq = lane >> 4;
        const int c = u % NCH, h = (u / NCH) % 4, b = u / (NCH * 4); const int r0 = chunk_row0(b, c);
        const float lgf = p.in[9][h], lgb = p.in[10][h];
        const bf16_t* zb = p.Zr + (size_t)r0 * 2048 + h * 128;
        __syncthreads();
        stage_tile(Qs, zb, 2048, tid); stage_tile(Ks, zb + 512, 2048, tid); stage_tile(Vs, zb + 1024, 2048, tid); stage_tile(Ss, ST + st_idx(0, b, h, c), 128, tid);
        __syncthreads();
        f32x4 as[8], af[8];
#pragma unroll
        for (int nt = 0; nt < 8; ++nt) { as[nt] = (f32x4){0.f, 0.f, 0.f, 0.f}; af[nt] = (f32x4){0.f, 0.f, 0.f, 0.f}; }
#pragma unroll
        for (int ks = 0; ks < 4; ++ks) { const bf16x8 xm = frag_row(Qs, LDT, 16 * w, 32 * ks, lane);
#pragma unroll
            for (int nt = 0; nt < 8; ++nt) { as[nt] = MFMA16(frag_row(Ks, LDT, 16 * nt, 32 * ks, lane), xm, as[nt]); af[nt] = MFMA16(frag_row(Ss, LDT, 16 * nt, 32 * ks, lane), xm, af[nt]); } }
        const int i = 16 * w + fr;
        __syncthreads();
#pragma unroll
        for (int nt = 0; nt < 8; ++nt) { float pv[4];
#pragma unroll
            for (int q = 0; q < 4; ++q) { const int j = 16 * nt + 4 * fq + q; const float ea = i > j ? lgf * (float)(i - j) : lgb * (float)(j - i); const float m = (i == j) ? 2.f : __expf(ea); pv[q] = as[nt][q] * m; }
            u2v o; o.x = pk_bf16(pv[0], pv[1]); o.y = pk_bf16(pv[2], pv[3]); *(LAS u2v*)(Ks + i * LDT + 16 * nt + 4 * fq) = o; }
        stage_tile(Ss, ST + st_idx(1, b, h, c), 128, tid);
        __syncthreads();
        f32x4 ao[8], ab[8];
#pragma unroll
        for (int nt = 0; nt < 8; ++nt) { ao[nt] = (f32x4){0.f, 0.f, 0.f, 0.f}; ab[nt] = (f32x4){0.f, 0.f, 0.f, 0.f}; }
#pragma unroll
        for (int ks = 0; ks < 4; ++ks) { const bf16x8 xp = frag_row(Ks, LDT, 16 * w, 32 * ks, lane), xq = frag_row(Qs, LDT, 16 * w, 32 * ks, lane);
#pragma unroll
            for (int nt = 0; nt < 8; ++nt) { ao[nt] = MFMA16(frag_tr(Vs, LDT, 32 * ks, 16 * nt, lane), xp, ao[nt]); ab[nt] = MFMA16(frag_row(Ss, LDT, 16 * nt, 32 * ks, lane), xq, ab[nt]); } }
        const float rf = __expf(lgf * (float)(i + 1)), rb = __expf(lgb * (float)(128 - i));
        float s = 0.f;
#pragma unroll
        for (int nt = 0; nt < 8; ++nt) { ao[nt] = ao[nt] + af[nt] * rf + ab[nt] * rb; s += (ao[nt][0] + ao[nt][1]) + (ao[nt][2] + ao[nt][3]); }
        s += __shfl_xor(s, 16); s += __shfl_xor(s, 32);
        const float mu = s * (1.f / 128.f); float qv = 0.f;
#pragma unroll
        for (int nt = 0; nt < 8; ++nt) { const f32x4 dd = ao[nt] - mu; qv += (dd[0] * dd[0] + dd[1] * dd[1]) + (dd[2] * dd[2] + dd[3] * dd[3]); }
        qv += __shfl_xor(qv, 16); qv += __shfl_xor(qv, 32);
        const float rs = 1.f / sqrtf(qv * (1.f / 128.f) + LN_EPS);
        const bf16_t* gp = p.Zr + (size_t)(r0 + i) * 2048 + 1536 + h * 128 + 4 * fq; bf16_t* yp = p.H + (size_t)(r0 + i) * D + h * 128 + 4 * fq;
#pragma unroll
        for (int nt = 0; nt < 8; ++nt) { const u2v gu = *(const u2v*)(gp + 16 * nt);
            const float g0 = __uint_as_float(gu.x << 16), g1 = __uint_as_float(gu.x & 0xffff0000u), g2 = __uint_as_float(gu.y << 16), g3 = __uint_as_float(gu.y & 0xffff0000u);
            u2v o; o.x = pk_bf16((ao[nt][0] - mu) * rs * siluf(g0), (ao[nt][1] - mu) * rs * siluf(g1)); o.y = pk_bf16((ao[nt][2] - mu) * rs * siluf(g2), (ao[nt][3] - mu) * rs * siluf(g3));
            *(u2v*)(yp + 16 * nt) = o; }
    }
}
__device__ __forceinline__ void ph_glaU_mfma(const P& p, unsigned char* smem) {
    LAS bf16_t* KF = (LAS bf16_t*)smem; LAS bf16_t* KB = KF + TILE_E; LAS bf16_t* Vs = KB + TILE_E;
    for (int u = blockIdx.x; u < NB * 4 * NCH; u += gridDim.x) {
        const int tid = TIDX, lane = tid & 63, w = tid >> 6;
        const int c = u % NCH, h = (u / NCH) % 4, b = u / (NCH * 4); const int r0 = chunk_row0(b, c);
        const bf16_t* kb = p.Z1 + (size_t)r0 * GINP + 512 + h * 128; const bf16_t* vb = p.Z1 + (size_t)r0 * GINP + 1024 + h * 256;
        float* BFw = p.BG + (size_t)r0 * 512 + h * 128; float* BBw = p.BG + (size_t)R * 512 + (size_t)r0 * 512 + h * 128;
        const float* BF = BFw; const float* BB = BBw;
        __syncthreads();
        {
            float* lr = (float*)(Vs);
            float* tot = lr + 128 * 32;
            for (int e = tid; e < 128 * 32; e += NT) lr[e] = bf2f(p.Z1[(size_t)(r0 + (e >> 5)) * GINP + 3072 + (e & 31)]);
            stage_tile(KF, kb, GINP, tid); stage_tile(KB, kb, GINP, tid);
            const int chn = tid & 127, dir = (tid >> 7) & 1, half = tid >> 8;
            const float* gw = (dir ? p.in[26] : p.in[24]) + h * 128 + chn; float g[16];
#pragma unroll
            for (int q = 0; q < 16; ++q) g[q] = gw[q * 512];
            const float gb = (dir ? p.in[27] : p.in[25])[h * 128 + chn];
            __syncthreads();
            float la[64]; float s = 0.f;
#pragma unroll
            for (int ii = 0; ii < 64; ++ii) { const int i = half * 64 + ii; float a = gb; const f32x4* lv = (const f32x4*)(lr + i * 32 + dir * 16);
#pragma unroll
                for (int q4 = 0; q4 < 4; ++q4) { const f32x4 x4 = lv[q4]; a += (x4[0] * g[4 * q4] + x4[1] * g[4 * q4 + 1]) + (x4[2] * g[4 * q4 + 2] + x4[3] * g[4 * q4 + 3]); }
                la[ii] = (fminf(a, 0.f) - __logf(1.f + __expf(-fabsf(a)))) * (1.f / 16.f); s += la[ii]; }
            tot[(dir * 2 + half) * 128 + chn] = s;
            __syncthreads();
            const float total = tot[(dir * 2 + 0) * 128 + chn] + tot[(dir * 2 + 1) * 128 + chn];
            s = dir == 0 ? (half ? tot[(0 * 2 + 0) * 128 + chn] : 0.f) : (half ? 0.f : tot[(1 * 2 + 1) * 128 + chn]);
            float* out = (dir ? BBw : BFw) + chn; LAS bf16_t* Kd = dir ? KB : KF;
            if (dir == 0) {
#pragma unroll
                for (int ii = 0; ii < 64; ++ii) { const int i = half * 64 + ii; s += la[ii]; out[(size_t)i * 512] = s; Kd[i * LDT + chn] = f2bf(bf2f(Kd[i * LDT + chn]) * __expf(total - s)); }
            } else {
#pragma unroll
                for (int ii = 63; ii >= 0; --ii) { const int i = half * 64 + ii; s += la[ii]; out[(size_t)i * 512] = s; Kd[i * LDT + chn] = f2bf(bf2f(Kd[i * LDT + chn]) * __expf(total - s)); }
            }
            __syncthreads();
        }
        const int fr = lane & 15, fq = lane >> 4;
#pragma unroll 1
        for (int hf = 0; hf < 2; ++hf) {
            if (hf) __syncthreads();
            stage_tile(Vs, vb + hf * 128, GINP, tid);
            __syncthreads();
            {
                f32x4 af[8], ab[8];
#pragma unroll
                for (int nt = 0; nt < 8; ++nt) { af[nt] = (f32x4){0.f, 0.f, 0.f, 0.f}; ab[nt] = (f32x4){0.f, 0.f, 0.f, 0.f}; }
#pragma unroll
                for (int ks = 0; ks < 4; ++ks) { const bf16x8 x0 = frag_tr(Vs, LDT, 32 * ks, 16 * w, lane);
#pragma unroll
                    for (int nt = 0; nt < 8; ++nt) { af[nt] = MFMA16(frag_tr(KF, LDT, 32 * ks, 16 * nt, lane), x0, af[nt]); ab[nt] = MFMA16(frag_tr(KB, LDT, 32 * ks, 16 * nt, lane), x0, ab[nt]); } }
                bf16_t* of = p.GST + gst_idx(0, b, h, c) + (size_t)(hf * 128 + 16 * w + fr) * 128 + 4 * fq; bf16_t* ob = p.GST + gst_idx(1, b, h, c) + (size_t)(hf * 128 + 16 * w + fr) * 128 + 4 * fq;
#pragma unroll
                for (int nt = 0; nt < 8; ++nt) { u2v v; v.x = pk_bf16(af[nt][0], af[nt][1]); v.y = pk_bf16(af[nt][2], af[nt][3]); *(u2v*)(of + 16 * nt) = v;
                    v.x = pk_bf16(ab[nt][0], ab[nt][1]); v.y = pk_bf16(ab[nt][2], ab[nt][3]); *(u2v*)(ob + 16 * nt) = v; }
            }
        }
    }
}
__device__ __forceinline__ void stage_scaled(LAS bf16_t* dst, const bf16_t* src, const float* G, float sgn, float mul, int tid) {
#pragma unroll
    for (int i = 0; i < 4; ++i) { const int cc = tid + 512 * i, j = cc >> 4, ch = cc & 15;
        float k8[8]; unpack8(*(const u4v*)(src + (size_t)j * GINP + ch * 8), k8);
        const f32x4 f0 = *(const f32x4*)(G + (size_t)j * 512 + ch * 8), f1 = *(const f32x4*)(G + (size_t)j * 512 + ch * 8 + 4);
#pragma unroll
        for (int q = 0; q < 4; ++q) { k8[q] *= __expf(sgn * f0[q]) * mul; k8[q + 4] *= __expf(sgn * f1[q]) * mul; }
        *(LAS u4v*)(dst + j * LDT + ch * 8) = pack8(k8); }
}
__device__ __forceinline__ void ph_glaO_mfma(const P& p, unsigned char* smem) {
    LAS bf16_t* QF = (LAS bf16_t*)smem; LAS bf16_t* QB = QF + TILE_E; LAS bf16_t* KX = QB + TILE_E; LAS bf16_t* R4 = KX + TILE_E;
    for (int u = blockIdx.x; u < NB * 4 * 64; u += gridDim.x) {
        const int tid = TIDX, lane = tid & 63, w = tid >> 6, fr = lane & 15, fq = lane >> 4;
        const int c = 2 + u % 64, h = (u / 64) % 4, b = u / 256; const int r0 = chunk_row0(b, c);
        const bf16_t* qb = p.Z1 + (size_t)r0 * GINP + h * 128; const bf16_t* kb = qb + 512; const bf16_t* vb = p.Z1 + (size_t)r0 * GINP + 1024 + h * 256;
        const float* BF = p.BG + (size_t)r0 * 512 + h * 128; const float* BB = p.BG + (size_t)R * 512 + (size_t)r0 * 512 + h * 128;
        const int i = 16 * w + fr;
        __syncthreads();
        stage_scaled(QF, qb, BF, 1.f, KSCALE, tid); stage_scaled(QB, qb, BB, 1.f, KSCALE, tid); stage_scaled(KX, kb, BF, -1.f, 1.f, tid);
        __syncthreads();
        f32x4 s1[8];
#pragma unroll
        for (int nt = 0; nt < 8; ++nt) s1[nt] = (f32x4){0.f, 0.f, 0.f, 0.f};
#pragma unroll
        for (int ks = 0; ks < 4; ++ks) { const bf16x8 xm = frag_row(QF, LDT, 16 * w, 32 * ks, lane);
#pragma unroll
            for (int nt = 0; nt < 8; ++nt) s1[nt] = MFMA16(frag_row(KX, LDT, 16 * nt, 32 * ks, lane), xm, s1[nt]); }
#pragma unroll
        for (int nt = 0; nt < 8; ++nt)
#pragma unroll
            for (int q = 0; q < 4; ++q) { const int j = 16 * nt + 4 * fq + q; s1[nt][q] = (i >= j) ? s1[nt][q] : 0.f; }
        __syncthreads();
        stage_scaled(KX, kb, BB, -1.f, 1.f, tid);
        __syncthreads();
        {
            f32x4 s2[8];
#pragma unroll
            for (int nt = 0; nt < 8; ++nt) s2[nt] = (f32x4){0.f, 0.f, 0.f, 0.f};
#pragma unroll
            for (int ks = 0; ks < 4; ++ks) { const bf16x8 xm = frag_row(QB, LDT, 16 * w, 32 * ks, lane);
#pragma unroll
                for (int nt = 0; nt < 8; ++nt) s2[nt] = MFMA16(frag_row(KX, LDT, 16 * nt, 32 * ks, lane), xm, s2[nt]); }
#pragma unroll
            for (int nt = 0; nt < 8; ++nt)
#pragma unroll
                for (int q = 0; q < 4; ++q) { const int j = 16 * nt + 4 * fq + q; s1[nt][q] += (i <= j) ? s2[nt][q] : 0.f; }
        }
        __syncthreads();
#pragma unroll
        for (int nt = 0; nt < 8; ++nt) { u2v o; o.x = pk_bf16(s1[nt][0], s1[nt][1]); o.y = pk_bf16(s1[nt][2], s1[nt][3]); *(LAS u2v*)(KX + i * LDT + 16 * nt + 4 * fq) = o; }
        f32x4 ao[2][8];
#pragma unroll
        for (int hf = 0; hf < 2; ++hf) {
#pragma unroll
            for (int nt = 0; nt < 8; ++nt) ao[hf][nt] = (f32x4){0.f, 0.f, 0.f, 0.f};
            stage_tile(R4, vb + hf * 128, GINP, tid);
            __syncthreads();
#pragma unroll
            for (int ks = 0; ks < 4; ++ks) { const bf16x8 xp = frag_row(KX, LDT, 16 * w, 32 * ks, lane);
#pragma unroll
                for (int nt = 0; nt < 8; ++nt) ao[hf][nt] = MFMA16(frag_tr(R4, LDT, 32 * ks, 16 * nt, lane), xp, ao[hf][nt]); }
            __syncthreads();
            stage_tile(R4, p.GST + gst_idx(0, b, h, c) + (size_t)hf * 128 * 128, 128, tid);
            __syncthreads();
#pragma unroll
            for (int ks = 0; ks < 4; ++ks) { const bf16x8 xq = frag_row(QF, LDT, 16 * w, 32 * ks, lane);
#pragma unroll
                for (int nt = 0; nt < 8; ++nt) ao[hf][nt] = MFMA16(frag_row(R4, LDT, 16 * nt, 32 * ks, lane), xq, ao[hf][nt]); }
            __syncthreads();
            stage_tile(R4, p.GST + gst_idx(1, b, h, c) + (size_t)hf * 128 * 128, 128, tid);
            __syncthreads();
#pragma unroll
            for (int ks = 0; ks < 4; ++ks) { const bf16x8 xq = frag_row(QB, LDT, 16 * w, 32 * ks, lane);
#pragma unroll
                for (int nt = 0; nt < 8; ++nt) ao[hf][nt] = MFMA16(frag_row(R4, LDT, 16 * nt, 32 * ks, lane), xq, ao[hf][nt]); }
            __syncthreads();
        }
        float ss = 0.f;
#pragma unroll
        for (int hf = 0; hf < 2; ++hf)
#pragma unroll
            for (int nt = 0; nt < 8; ++nt) { const f32x4 v = ao[hf][nt]; ss += (v[0] * v[0] + v[1] * v[1]) + (v[2] * v[2] + v[3] * v[3]); }
        ss += __shfl_xor(ss, 16); ss += __shfl_xor(ss, 32);
        const float rs = 1.f / sqrtf(ss * (1.f / 256.f) + LN_EPS);
        const bf16_t* gp = p.Z1 + (size_t)(r0 + i) * GINP + 2048 + h * 256 + 4 * fq; bf16_t* yp = p.H + (size_t)(r0 + i) * D + h * 256 + 4 * fq;
#pragma unroll
        for (int hf = 0; hf < 2; ++hf)
#pragma unroll
            for (int nt = 0; nt < 8; ++nt) { const u2v gu = *(const u2v*)(gp + hf * 128 + 16 * nt);
                const float g0 = __uint_as_float(gu.x << 16), g1 = __uint_as_float(gu.x & 0xffff0000u), g2 = __uint_as_float(gu.y << 16), g3 = __uint_as_float(gu.y & 0xffff0000u);
                u2v o; o.x = pk_bf16(ao[hf][nt][0] * rs * siluf(g0), ao[hf][nt][1] * rs * siluf(g1)); o.y = pk_bf16(ao[hf][nt][2] * rs * siluf(g2), ao[hf][nt][3] * rs * siluf(g3));
                *(u2v*)(yp + hf * 128 + 16 * nt) = o; }
    }
}


template <int MODE> __device__ __forceinline__ void tr_w(bf16_t* dst, const float* src, int N, int K, int ldsrc, float* t  , int& tile0, int tile_stride) {
    const int nt_n = N / 64, ntiles = nt_n * (K / 64);
    float v[8];
    if (tile0 < ntiles) { const int tid = TIDX; const int n0 = (tile0 % nt_n) * 64, k0 = (tile0 / nt_n) * 64;
#pragma unroll
        for (int i = 0; i < 8; ++i) { const int e = tid + 512 * i; v[i] = src[(size_t)(k0 + (e >> 6)) * ldsrc + n0 + (e & 63)]; } }
    for (int tile = tile0; tile < ntiles; tile += tile_stride) {
        const int tid = TIDX; const int n0 = (tile % nt_n) * 64, k0 = (tile / nt_n) * 64;
        __syncthreads();
#pragma unroll
        for (int i = 0; i < 8; ++i) { const int e = tid + 512 * i; t[(e >> 6) * 65 + (e & 63)] = v[i]; }
        __syncthreads();
        if (tile + tile_stride < ntiles) { const int tn = tile + tile_stride; const int n1 = (tn % nt_n) * 64, k1 = (tn / nt_n) * 64;
#pragma unroll
            for (int i = 0; i < 8; ++i) { const int e = tid + 512 * i; v[i] = src[(size_t)(k1 + (e >> 6)) * ldsrc + n1 + (e & 63)]; } }
#pragma unroll
        for (int i = 0; i < 4; ++i) { const int e = tid + 512 * i, nn = e >> 5, kp = e & 31; const int n = n0 + nn;
            int row; float sc = 1.f;
            if (MODE == 0) row = n; else if (MODE == 3) { const int d = n & 127; row = n < 1024 ? (n - d) + 2 * (d & 63) + (d >> 6) : n; sc = (n >= 512 && n < 1024) ? KSCALE : 1.f; }
            else row = 8 * (n >> 2) + (n & 3) + (MODE == 2 ? 4 : 0);
            *(unsigned*)(dst + (size_t)row * K + k0 + 2 * kp) = pk_bf16(t[(2 * kp) * 65 + nn] * sc, t[(2 * kp + 1) * 65 + nn] * sc); }
    }
    tile0 = tile0 - (ntiles % tile_stride);
    if (tile0 < 0) tile0 += tile_stride;
}
__device__ __forceinline__ void ph_wconv_l0(const P& p, float* t) {
    int t0 = blockIdx.x; const int G = gridDim.x;
    tr_w<3>(p.Win0, p.in[8], ABIN, D, ABIN, t, t0, G);
    tr_w<0>(p.Wout0, p.in[22], D, D, D, t, t0, G);
}
__device__ __forceinline__ void ph_wconv_l1(const P& p, float* t) {
    int t0 = blockIdx.x; const int G = gridDim.x;
    tr_w<0>(p.Win1, p.in[23], 3072, D, GIN, t, t0, G);
    tr_w<0>(p.Wout1, p.in[28], D, D, D, t, t0, G);
    GSTRIDE(idx, (long)(GINP - 3072) * D) { const int k = idx % D, n = 3072 + idx / D; p.Win1[(size_t)n * D + k] = n < GIN ? f2bf(p.in[23][(size_t)k * GIN + n]) : (bf16_t)0; }
}
__device__ __forceinline__ void ph_wconv_moe_part(const P& p, int l, int part, float* t, int t0, int stride) {
    if (t0 < 0) return;
    for (int e = 0; e < NE; ++e) {
        if (part == 0) { tr_w<1>(p.Wgu + (size_t)e * 1024 * 1024, p.in[31] + (size_t)(l * NE + e) * D * EH, EH, D, EH, t, t0, stride);
                         tr_w<2>(p.Wgu + (size_t)e * 1024 * 1024, p.in[32] + (size_t)(l * NE + e) * D * EH, EH, D, EH, t, t0, stride); }
        else tr_w<0>(p.Wd + (size_t)e * 1024 * 512, p.in[33] + (size_t)(l * NE + e) * EH * D, D, EH, D, t, t0, stride);
    }
}
__device__ __forceinline__ void ph_wconv_moe_fast(const P& p, int l, float* t) { ph_wconv_moe_part(p, l, 0, t, blockIdx.x, gridDim.x); ph_wconv_moe_part(p, l, 1, t, blockIdx.x, gridDim.x); }
__device__ __forceinline__ void ph_prep_hy_fast(const P& p, float* t  ) {
    const int ntt = RB / 64, ntc = 1536 / 64;
    for (int tile = blockIdx.x; tile < NB * ntt * ntc; tile += gridDim.x) {
        const int tid = TIDX; const int ct = tile % ntc, tt = (tile / ntc) % ntt, b = tile / (ntc * ntt); const int c0 = ct * 64, tl0 = tt * 64;
        const int s0 = tl0 < L ? 0 : L, s1 = tl0 < L ? L : RB;
        __syncthreads();
        for (int e = tid; e < 66 * 64; e += NT) { const int rr = e >> 6, cc = e & 63, tl = tl0 - 1 + rr;
            t[rr * 65 + cc] = (tl >= s0 && tl < s1) ? bf2f(p.Zh[(size_t)bt_row(b, tl) * 1536 + c0 + cc]) : 0.f; }
        __syncthreads();
#pragma unroll
        for (int i = 0; i < 4; ++i) { const int e = tid + 512 * i, cc = e >> 5, tp = e & 31; const int col = c0 + cc;
            const float w0 = p.in[11][col], w1 = p.in[11][1536 + col], w2 = p.in[11][3072 + col], bs = p.in[12][col];
            const float a = bs + w0 * t[(2 * tp) * 65 + cc] + w1 * t[(2 * tp + 1) * 65 + cc] + w2 * t[(2 * tp + 2) * 65 + cc];
            const float c2 = bs + w0 * t[(2 * tp + 1) * 65 + cc] + w1 * t[(2 * tp + 2) * 65 + cc] + w2 * t[(2 * tp + 3) * 65 + cc];
            *(unsigned*)(p.hyT + ((size_t)b * 1536 + col) * RB + tl0 + 2 * tp) = pk_bf16(a, c2); }
    }
}
__device__ __forceinline__ void ph_hy_untranspose_fast(const P& p, float* t) {
    const bf16_t* yhT = p.Zh + (size_t)2 * NB * 4 * NCH * 16384;
    const int ntt = RB / 64, ntc = 512 / 64;
    for (int tile = blockIdx.x; tile < NB * ntt * ntc; tile += gridDim.x) {
        const int tid = TIDX; const int ct = tile % ntc, tt = (tile / ntc) % ntt, b = tile / (ntc * ntt); const int c0 = ct * 64, tl0 = tt * 64;
        __syncthreads();
#pragma unroll
        for (int i = 0; i < 8; ++i) { const int e = tid + 512 * i, cc = e >> 6, ti = e & 63; t[cc * 65 + ti] = bf2f(yhT[((size_t)b * 512 + c0 + cc) * RB + tl0 + ti]); }
        __syncthreads();
#pragma unroll
        for (int i = 0; i < 4; ++i) { const int e = tid + 512 * i, ti = e >> 5, cp = e & 31;
            *(unsigned*)(p.H + (size_t)bt_row(b, tl0 + ti) * D + 512 + c0 + 2 * cp) = pk_bf16(t[(2 * cp) * 65 + ti], t[(2 * cp + 1) * 65 + ti]); }
    }
}
__device__ __forceinline__ void ph_prep_rope_fast(const P& p) {
    GSTRIDE(idx, (long)R * 2 * 4 * 8) {
        const int pc = idx % 8, h = (idx / 8) % 4, w = (idx / 32) % 2, r = idx / 64;
        bf16_t* base = p.Zr + (size_t)r * 2048 + w * 512 + h * 128 + pc * 8;
        float a[8], c[8]; unpack8(*(const u4v*)base, a); unpack8(*(const u4v*)(base + 64), c);
        const float sc = w ? KSCALE : 1.f;
        if (r < RL) {
            const int t = r % L; const float pos = (pc < 4) ? (float)(t / GW) : (float)(t % GW);
#pragma unroll
            for (int q = 0; q < 8; ++q) { const int pr = pc * 8 + q; const float inv = exp2f(-(float)(pr & 31) * (13.287712379549449f / 32.f));
                float sn, cs; sincosf(pos * inv, &sn, &cs); const float x1 = a[q] * sc, x2 = c[q] * sc; a[q] = x1 * cs - x2 * sn; c[q] = x1 * sn + x2 * cs; }
        } else {
#pragma unroll
            for (int q = 0; q < 8; ++q) { a[q] *= sc; c[q] *= sc; }
        }
        *(u4v*)base = pack8(a); *(u4v*)(base + 64) = pack8(c);
    }
}
__device__ __forceinline__ void ph_mod_fast(const P& p, int l, int which, const float* xl  , const float* xc  ) {
    const int lane = TIDX & 63, gw = blockIdx.x * (NT / 64) + (TIDX >> 6), ngw = gridDim.x * (NT / 64);
    for (int r = gw; r < R; r += ngw) {
        const float* x = r < RL ? xl + (size_t)r * D : xc + (size_t)(r - RL) * D; const float* sh = modv(p, l, r, which * 3 + 0); const float* sc = modv(p, l, r, which * 3 + 1);
#pragma unroll
        for (int i = 0; i < 4; ++i) { const int k = 4 * lane + 256 * i; const f32x4 xv = *(const f32x4*)(x + k), s = *(const f32x4*)(sc + k), hh = *(const f32x4*)(sh + k);
            u2v o; o.x = pk_bf16(xv[0] * (1.f + s[0]) + hh[0], xv[1] * (1.f + s[1]) + hh[1]); o.y = pk_bf16(xv[2] * (1.f + s[2]) + hh[2], xv[3] * (1.f + s[3]) + hh[3]);
            *(u2v*)(p.H + (size_t)r * D + k) = o; }
    }
}

__device__ __forceinline__ void ph_rope_table(const P& p) {
    GSTRIDE(idx, 128 * 32) { const int f = idx & 31, pos = idx >> 5; float sn, cs; sincosf((float)pos * exp2f(-(float)f * (13.287712379549449f / 32.f)), &sn, &cs); p.A2[2 * idx] = cs; p.A2[2 * idx + 1] = sn; }
}
__device__ __forceinline__ void ph_filters(const P& p, unsigned char* smem) {
    float* lds = (float*)smem;
    float* aA = lds;
    float* aB = lds + 64 * 65;
    LAS bf16_t* A3 = (LAS bf16_t*)(smem + 2 * 64 * 65 * 4);
    LAS bf16_t* Ws = A3 + 64 * 72;
    float* mw = (float*)(smem + 2 * 64 * 65 * 4 + 64 * 72 * 2 + 64 * 264 * 2);
    const float mind = logf(1e-2f) / 1.5f, maxd = logf(1e-2f) / 0.3f;
    __syncthreads();
    for (int e = TIDX; e < 33 * 64; e += NT) mw[e] = p.in[13][e];
    for (int e = TIDX; e < 64 * 64; e += NT) { mw[2112 + e] = p.in[15][e]; mw[2112 + 4096 + e] = p.in[17][e]; }
    if (TIDX < 64) { mw[10304 + TIDX] = p.in[14][TIDX]; mw[10368 + TIDX] = p.in[16][TIDX]; mw[10432 + TIDX] = p.in[18][TIDX]; }
    if (TIDX < 192) mw[10496 + TIDX] = p.in[20][TIDX];
    for (int u = blockIdx.x; u < RB / 33; u += gridDim.x) {
        const int tid = TIDX; const int p0 = u * 33; const int pos = tid & 63, jg = tid >> 6, lane = tid & 63, w = tid >> 6;
        f32x4 wv[8];
#pragma unroll
        for (int i = 0; i < 8; ++i) { const int e = tid + 512 * i; wv[i] = *(const f32x4*)(p.in[19] + (size_t)(e >> 6) * 2048 + 4 * (e & 63)); }
        __syncthreads();
        for (int e = tid; e < 64 * 33; e += NT) { const int ps = e & 63, m = e >> 6; int ln2, i2; hy_pos(p0 + ps, ln2, i2);
            const float rv = (float)i2 / (float)ln2; float v;
            const int q = (m - 1) & 15; const float fr_ = (1e-4f + (float)q * ((15.f - 1e-4f) / 15.f)) * rv; const float fr2 = fr_ - floorf(fr_);
            v = m == 0 ? (float)i2 / (float)(ln2 - 1) : (m <= 16 ? __builtin_amdgcn_cosf(fr2) : -__builtin_amdgcn_sinf(fr2));
            aB[ps * 65 + m] = v; }
        __syncthreads();
        {
            float acc[8];
#pragma unroll
            for (int q = 0; q < 8; ++q) acc[q] = mw[10304 + jg * 8 + q];
#pragma unroll 3
            for (int m = 0; m < 33; ++m) { const float a = aB[pos * 65 + m];
#pragma unroll
                for (int q = 0; q < 8; ++q) acc[q] += a * mw[m * 64 + jg * 8 + q]; }
#pragma unroll
            for (int q = 0; q < 8; ++q) aA[pos * 65 + jg * 8 + q] = __sinf(mw[10496 + jg * 8 + q] * acc[q]);
        }
        __syncthreads();
#pragma unroll 1
        for (int layer = 0; layer < 2; ++layer) {
            const float* W = mw + 2112 + 4096 * layer; const float* Bv = mw + 10368 + 64 * layer; const float* Fq = mw + 10496 + 64 * (layer + 1);
            float* src = layer ? aB : aA; float* dst = layer ? aA : aB;
            float acc[8];
#pragma unroll
            for (int q = 0; q < 8; ++q) acc[q] = Bv[jg * 8 + q];
#pragma unroll 4
            for (int m = 0; m < 64; ++m) { const float a = src[pos * 65 + m];
#pragma unroll
                for (int q = 0; q < 8; ++q) acc[q] += a * W[m * 64 + jg * 8 + q]; }
#pragma unroll
            for (int q = 0; q < 8; ++q) { const float v = __sinf(Fq[jg * 8 + q] * acc[q]); dst[pos * 65 + jg * 8 + q] = v; if (layer == 1 && pos < 48) A3[pos * 72 + jg * 8 + q] = f2bf(v); }
            __syncthreads();
        }
        float tpos[3];
#pragma unroll
        for (int mt = 0; mt < 3; ++mt) { int len, i0; hy_pos(p0 + 16 * mt + (lane & 15), len, i0); tpos[mt] = (float)i0 / (float)(len - 1); }
#pragma unroll 1
        for (int cq = 0; cq < 8; ++cq) {
#pragma unroll
            for (int i = 0; i < 8; ++i) { const int e = tid + 512 * i; u2v o; o.x = pk_bf16(wv[i][0], wv[i][1]); o.y = pk_bf16(wv[i][2], wv[i][3]); *(LAS u2v*)(Ws + (e >> 6) * 264 + 4 * (e & 63)) = o; }
            __syncthreads();
            if (cq < 7) {
#pragma unroll
                for (int i = 0; i < 8; ++i) { const int e = tid + 512 * i; wv[i] = *(const f32x4*)(p.in[19] + (size_t)(e >> 6) * 2048 + (cq + 1) * 256 + 4 * (e & 63)); } }
            f32x4 acc[3][2];
#pragma unroll
            for (int mt = 0; mt < 3; ++mt)
#pragma unroll
                for (int nt = 0; nt < 2; ++nt) acc[mt][nt] = (f32x4){0.f, 0.f, 0.f, 0.f};
#pragma unroll
            for (int ks = 0; ks < 2; ++ks) { bf16x8 xm[3];
#pragma unroll
                for (int mt = 0; mt < 3; ++mt) xm[mt] = frag_row(A3, 72, 16 * mt, 32 * ks, lane);
#pragma unroll
                for (int nt = 0; nt < 2; ++nt) { const bf16x8 xn = frag_tr(Ws, 264, 32 * ks, 32 * w + 16 * nt, lane);
#pragma unroll
                    for (int mt = 0; mt < 3; ++mt) acc[mt][nt] = MFMA16(xn, xm[mt], acc[mt][nt]); } }
#pragma unroll
            for (int nt = 0; nt < 2; ++nt)
#pragma unroll
                for (int q = 0; q < 4; ++q) { const int col = cq * 256 + 32 * w + 16 * nt + 4 * (lane >> 4) + q; const float delta = fabsf(mind + (float)(col % 512) * ((maxd - mind) / 511.f));
#pragma unroll
                    for (int mt = 0; mt < 3; ++mt) { const int pl = 16 * mt + (lane & 15); if (pl < 33) p.FILT[(size_t)col * RB + p0 + pl] = acc[mt][nt][q] * __expf(-tpos[mt] * delta); } }
            __syncthreads();
        }
    }
}

__device__ __forceinline__ float wave_sum(float v) {
#pragma unroll
    for (int o = 1; o < 64; o <<= 1) v += __shfl_xor(v, o);
    return v;
}
__device__ __forceinline__ void ph_ada_fast(const P& p, float* lds) {
    float* sv = lds;
    float* red = lds + 3072;
    const int tid = TIDX;
    __syncthreads();
    for (int i = tid; i < 3 * D; i += NT) { const int j = i / D, k = i % D; sv[i] = siluf(j < 2 ? p.in[1][j * D + k] : p.in[3][k]); }
    __syncthreads();
    for (int u = blockIdx.x; u < 2 * 96; u += gridDim.x) {
        const int l = u / 96, n = (u % 96) * 64 + (tid & 63), ks = tid >> 6;
        const float* w = p.in[4] + (size_t)l * D * 6144 + n;
        float a0 = 0.f, a1 = 0.f, a2 = 0.f;
#pragma unroll 8
        for (int k = ks * 128; k < ks * 128 + 128; ++k) { const float wv = w[(size_t)k * 6144]; a0 += sv[k] * wv; a1 += sv[D + k] * wv; a2 += sv[2 * D + k] * wv; }
        red[(ks * 3 + 0) * 64 + (tid & 63)] = a0; red[(ks * 3 + 1) * 64 + (tid & 63)] = a1; red[(ks * 3 + 2) * 64 + (tid & 63)] = a2;
        __syncthreads();
        if (tid < 192) { const int j = tid >> 6, nl = tid & 63; float s = p.in[5][l * 6144 + (u % 96) * 64 + nl];
#pragma unroll
            for (int q = 0; q < 8; ++q) s += red[(q * 3 + j) * 64 + nl];
            p.MOD[(size_t)(l * 3 + j) * 6144 + (u % 96) * 64 + nl] = s; }
        __syncthreads();
    }
}
__device__ __forceinline__ void ph_hyF_fast(const P& p, const float* a3, float* lds) {
    float* at = lds;
    float* wt = lds + 64 * 65;
    const float mind = logf(1e-2f) / 1.5f, maxd = logf(1e-2f) / 0.3f;
    for (int u = blockIdx.x; u < (RB / 64) * 16; u += gridDim.x) {
        const int tid = TIDX; const int ct = u % 16, pt = u / 16, p0 = pt * 64, c0 = ct * 128;
        __syncthreads();
#pragma unroll
        for (int i = 0; i < 8; ++i) { const int e = tid + 512 * i; at[(e >> 6) * 65 + (e & 63)] = a3[(size_t)(p0 + (e >> 6)) * 64 + (e & 63)]; }
#pragma unroll
        for (int i = 0; i < 16; ++i) { const int e = tid + 512 * i; wt[e] = p.in[19][(size_t)(e >> 7) * 2048 + c0 + (e & 127)]; }
        __syncthreads();
        const int pos = tid & 63, cg = tid >> 6;
        float acc[16];
#pragma unroll
        for (int q = 0; q < 16; ++q) acc[q] = 0.f;
#pragma unroll 4
        for (int m = 0; m < 64; ++m) { const float a = at[pos * 65 + m];
#pragma unroll
            for (int q = 0; q < 16; ++q) acc[q] += a * wt[m * 128 + cg * 16 + q]; }
        int len, i0; hy_pos(p0 + pos, len, i0); const float tt = (float)i0 / (float)(len - 1);
#pragma unroll
        for (int q = 0; q < 16; ++q) { const int col = c0 + cg * 16 + q; const float delta = fabsf(mind + (float)(col % 512) * ((maxd - mind) / 511.f));
            p.FILT[(size_t)col * RB + p0 + pos] = acc[q] * expf(-tt * delta); }
    }
}
__device__ __forceinline__ void ph_retScan_fast(const P& p) {
    bf16_t* ST = p.Zh;
    GSTRIDE(idx, (long)2 * NB * 4 * 16384) {
        const int ed = idx % 16384, h = (idx / 16384) % 4, b = (idx / 65536) % NB, dir = idx / (65536 * NB);
        const float dc = expf((dir ? p.in[10] : p.in[9])[h] * 128.f);
        bf16_t* base = ST + st_idx(dir, b, h, 0) + ed;
        float s = 0.f;
#pragma unroll 1
        for (int c0 = 0; c0 < NCH; c0 += 11) {
            float u[11]; int cc[11];
#pragma unroll
            for (int j = 0; j < 11; ++j) { const int q = c0 + j; cc[j] = dir == 0 ? q : (q < 2 ? 1 - q : NCH + 1 - q); u[j] = bf2f(base[(size_t)cc[j] * 16384]); }
#pragma unroll
            for (int j = 0; j < 11; ++j) { base[(size_t)cc[j] * 16384] = f2bf(s); s = dc * s + u[j]; }
        }
    }
}
__device__ __forceinline__ void ph_glaScan_fast(const P& p) {
    const float* BF = p.BG; const float* BB = p.BG + (size_t)R * 512;
    GSTRIDE(idx, (long)2 * NB * 4 * 32768) {
        const int d = idx % 128, ed = idx % 32768, h = (idx / 32768) % 4, b = (idx / 131072) % NB, dir = idx / (131072 * NB);
        bf16_t* base = p.GST + gst_idx(dir, b, h, 0) + ed;
        float s = 0.f;
#pragma unroll 1
        for (int c0 = 0; c0 < NCH; c0 += 11) {
            float u[11], dcv[11]; int cc[11];
#pragma unroll
            for (int j = 0; j < 11; ++j) { const int q = c0 + j; cc[j] = dir == 0 ? q : (q < 2 ? 1 - q : NCH + 1 - q); const int r0 = chunk_row0(b, cc[j]);
                u[j] = bf2f(base[(size_t)cc[j] * 32768]); dcv[j] = dir == 0 ? BF[(size_t)(r0 + 127) * 512 + h * 128 + d] : BB[(size_t)r0 * 512 + h * 128 + d]; }
#pragma unroll
            for (int j = 0; j < 11; ++j) { base[(size_t)cc[j] * 32768] = f2bf(s); s = __expf(dcv[j]) * s + u[j]; }
        }
    }
}
__device__ __forceinline__ void ph_glagates_fast(const P& p, float* lds) {
    float* lr = lds;
    for (int u = blockIdx.x; u < NB * NCH * 2; u += gridDim.x) {
        const int tid = TIDX; const int dir = u % 2, c = (u / 2) % NCH, b = u / (2 * NCH); const int r0 = chunk_row0(b, c);
        __syncthreads();
        for (int e = tid; e < 128 * 16; e += NT) lr[e] = bf2f(p.Z1[(size_t)(r0 + (e >> 4)) * GINP + 3072 + dir * 16 + (e & 15)]);
        __syncthreads();
        const float* gw = (dir ? p.in[26] : p.in[24]); float g[16];
#pragma unroll
        for (int q = 0; q < 16; ++q) g[q] = gw[q * 512 + tid];
        const float gb = (dir ? p.in[27] : p.in[25])[tid];
        float* out = p.BG + ((size_t)dir * R + r0) * 512 + tid;
        float s = 0.f;
#pragma unroll 4
        for (int ii = 0; ii < 128; ++ii) { const int i = dir ? 127 - ii : ii; float acc = gb;
#pragma unroll
            for (int q = 0; q < 16; ++q) acc += lr[i * 16 + q] * g[q];
            s += logsigf(acc) * (1.f / 16.f); out[(size_t)i * 512] = s; }
    }
}
template <int MODE, bool ROUTE> __device__ __forceinline__ void ph_post_fast(const P& p, int l, int which, const bf16_t* Y, int ln, int wn, int nrows, const float* xl, const float* xc, float* lds) {
    const float* lg = p.in[6] + (size_t)(l * 2 + which) * D; const float* lb = p.in[7] + (size_t)(l * 2 + which) * D;
    const int tid = TIDX, lane = tid & 63, gw = blockIdx.x * (NT / 64) + (tid >> 6), ngw = gridDim.x * (NT / 64);
    int* lcnt = (int*)(lds + D * NE);
    if (ROUTE) { __syncthreads(); for (int e = tid; e < D * NE; e += NT) lds[(e & 15) * D + (e >> 4)] = p.in[29][e]; if (tid < 32) lcnt[tid] = 0; __syncthreads(); }
    int toff[16];
    if (MODE == 1) { int s = 0;
#pragma unroll
        for (int e = 0; e < 16; ++e) { toff[e] = s; s += (p.CNT[l * 16 + e] + 255) >> 8; } }
    f32x4 cg_[4], clg[4], clb[4], csc[4], csh[4]; int cseg = -1;
#pragma unroll
    for (int i = 0; i < 4; ++i) { clg[i] = *(const f32x4*)(lg + 4 * lane + 256 * i); clb[i] = *(const f32x4*)(lb + 4 * lane + 256 * i); }
    f32x4 xr[4]; u2v ya[4], yb[4];
#define POST_LOAD(rr) do { const int r_ = (rr); const float* x_ = r_ < RL ? xl + (size_t)r_ * D : xc + (size_t)(r_ - RL) * D; const bf16_t *y0_, *y1_ = nullptr; \
        if (MODE == 0) y0_ = Y + (size_t)r_ * D; \
        else { int sr_[2]; _Pragma("unroll") for (int k_ = 0; k_ < 2; ++k_) { const int e_ = p.RE[r_ * 2 + k_]; int to_ = 0; _Pragma("unroll") for (int q_ = 0; q_ < 16; ++q_) to_ = (q_ == e_) ? toff[q_] : to_; sr_[k_] = to_ * 256 + p.RPOS[r_ * 2 + k_]; } \
               y0_ = p.slots + (size_t)sr_[0] * D; y1_ = p.slots + (size_t)sr_[1] * D; } \
        _Pragma("unroll") for (int i_ = 0; i_ < 4; ++i_) { const int k_ = 4 * lane + 256 * i_; xr[i_] = *(const f32x4*)(x_ + k_); ya[i_] = *(const u2v*)(y0_ + k_); if (MODE == 1) yb[i_] = *(const u2v*)(y1_ + k_); } } while (0)
    if (gw < nrows) POST_LOAD(gw);
    for (int r = gw; r < nrows; r += ngw) {
        float* xo = xrow(p, r);
        if (seg_of(r) != cseg) { cseg = seg_of(r);
#pragma unroll
            for (int i = 0; i < 4; ++i) { const int k = 4 * lane + 256 * i; cg_[i] = *(const f32x4*)(modv(p, l, r, which * 3 + 2) + k);
                if (ln >= 0) { csc[i] = *(const f32x4*)(modv(p, ln, r, wn * 3 + 1) + k); csh[i] = *(const f32x4*)(modv(p, ln, r, wn * 3 + 0) + k); } } }
        f32x4 v[4]; float s = 0.f;
#pragma unroll
        for (int i = 0; i < 4; ++i) { const u2v yu = ya[i]; f32x4 yy = {__uint_as_float(yu.x << 16), __uint_as_float(yu.x & 0xffff0000u), __uint_as_float(yu.y << 16), __uint_as_float(yu.y & 0xffff0000u)};
            if (MODE == 1) { const u2v y2 = yb[i]; yy += (f32x4){__uint_as_float(y2.x << 16), __uint_as_float(y2.x & 0xffff0000u), __uint_as_float(y2.y << 16), __uint_as_float(y2.y & 0xffff0000u)}; }
            v[i] = xr[i] * ALPHA + cg_[i] * yy; s += (v[i][0] + v[i][1]) + (v[i][2] + v[i][3]); }
        if (r + ngw < nrows) POST_LOAD(r + ngw);
        const float mu = wave_sum(s) * (1.f / D); float q2 = 0.f;
#pragma unroll
        for (int i = 0; i < 4; ++i) { v[i] = v[i] - mu; q2 += (v[i][0] * v[i][0] + v[i][1] * v[i][1]) + (v[i][2] * v[i][2] + v[i][3] * v[i][3]); }
        const float rs = 1.f / sqrtf(wave_sum(q2) * (1.f / D) + LN_EPS);
        f32x4 hk[4];
#pragma unroll
        for (int i = 0; i < 4; ++i) { const int k = 4 * lane + 256 * i; const f32x4 xn = v[i] * rs * clg[i] + clb[i];
            *(f32x4*)(xo + k) = xn;
            if (ln >= 0) { const f32x4 h2 = xn * (csc[i] + 1.f) + csh[i];
                u2v o; o.x = pk_bf16(h2[0], h2[1]); o.y = pk_bf16(h2[2], h2[3]); *(u2v*)(p.H + (size_t)r * D + k) = o;
                if (ROUTE) hk[i] = h2; } }
        if (ROUTE) {
            float pl[16];
#pragma unroll
            for (int e = 0; e < 16; ++e) { const float* wr = lds + e * D + 4 * lane; float a = 0.f;
#pragma unroll
                for (int i = 0; i < 4; ++i) { const f32x4 wv = *(const f32x4*)(wr + 256 * i); a += (hk[i][0] * wv[0] + hk[i][1] * wv[1]) + (hk[i][2] * wv[2] + hk[i][3] * wv[3]); }
                pl[e] = a; }
            float r8[8], r4[4], r2[2];
            { const bool up = (lane & 32) != 0;
#pragma unroll
              for (int q = 0; q < 8; ++q) { const float keep = up ? pl[8 + q] : pl[q], send = up ? pl[q] : pl[8 + q]; r8[q] = keep + __shfl_xor(send, 32); } }
            { const bool up = (lane & 16) != 0;
#pragma unroll
              for (int q = 0; q < 4; ++q) { const float keep = up ? r8[4 + q] : r8[q], send = up ? r8[q] : r8[4 + q]; r4[q] = keep + __shfl_xor(send, 16); } }
            { const bool up = (lane & 8) != 0;
#pragma unroll
              for (int q = 0; q < 2; ++q) { const float keep = up ? r4[2 + q] : r4[q], send = up ? r4[q] : r4[2 + q]; r2[q] = keep + __shfl_xor(send, 8); } }
            float r1;
            { const bool up = (lane & 4) != 0; const float keep = up ? r2[1] : r2[0], send = up ? r2[0] : r2[1]; r1 = keep + __shfl_xor(send, 4); }
            r1 += __shfl_xor(r1, 2); r1 += __shfl_xor(r1, 1);
            const float sgm = sigmf(r1);
            int best = 0, i1 = 0, i2 = 0; float bs = -1e30f, a1 = 0.f, a2 = 0.f;
#pragma unroll
            for (int g = 0; g < NG; ++g) {
                float sg[4], sel[4];
#pragma unroll
                for (int q = 0; q < 4; ++q) { const int e = g * EPG + q; const int src = ((e >> 3) & 1) * 32 + ((e >> 2) & 1) * 16 + ((e >> 1) & 1) * 8 + (e & 1) * 4;
                    sg[q] = __int_as_float(__builtin_amdgcn_readlane(__float_as_int(sgm), src)); sel[q] = sg[q] + p.in[30][e]; }
                int j1 = 0; float v1 = sel[0];
#pragma unroll
                for (int q = 1; q < 4; ++q) if (sel[q] > v1) { v1 = sel[q]; j1 = q; }
                int j2 = -1; float v2 = -1e30f;
#pragma unroll
                for (int q = 0; q < 4; ++q) if (q != j1 && sel[q] > v2) { v2 = sel[q]; j2 = q; }
                if (v1 + v2 > bs) { bs = v1 + v2; best = g; i1 = j1; i2 = j2; a1 = 0.f; a2 = 0.f;
#pragma unroll
                    for (int q = 0; q < 4; ++q) { a1 = (q == j1) ? sg[q] : a1; a2 = (q == j2) ? sg[q] : a2; } }
            }
            if (lane == 0) { const int e1 = best * EPG + i1, e2 = best * EPG + i2;
                p.RE[r * 2] = e1; p.RE[r * 2 + 1] = e2; p.RWt[r * 2] = a1 / (a1 + a2); p.RWt[r * 2 + 1] = a2 / (a1 + a2);
                p.RPOS[r * 2] = atomicAdd(&lcnt[e1], 1); p.RPOS[r * 2 + 1] = atomicAdd(&lcnt[e2], 1); }
        }
    }
    if (ROUTE) {
        __syncthreads();
        if (tid < 16) lcnt[16 + tid] = atomicAdd(&p.CNT[l * 16 + tid], lcnt[tid]);
        __syncthreads();
        for (int r = gw + lane * ngw; r < nrows; r += 64 * ngw) {
#pragma unroll
            for (int k = 0; k < 2; ++k) { const int e = p.RE[r * 2 + k]; const int pos = p.RPOS[r * 2 + k] + lcnt[16 + e]; p.RPOS[r * 2 + k] = pos; p.LIST[e * R + pos] = r; p.LISTW[e * R + pos] = p.RWt[r * 2 + k]; }
        }
    }
}
#undef POST_LOAD

constexpr int N_STEPS = 34;
#define PG8_ALIGN true
#define PG8_SP2 true
template <class Epi> __device__ __forceinline__ void dense_gemm(LAS unsigned char* lds, const bf16_t* A, const bf16_t* Bt, int M, int N, int K, const Epi& E) {
    pg8::Gemm g{A, Bt, M, N, K}; pg8::StaticOrder S; S.init(M, N, (int)gridDim.x, (int)blockIdx.x);
    pg8::gemm_phase<Epi, pg8::StaticOrder, PG8_ALIGN, PG8_SP2>(lds, g, S, E);
}
__device__ __forceinline__ void moe_gemms(const P& p, LAS unsigned char* lds, int l, int which) {
    pg8::MoeOrder S; S.init(p.CNT + l * 16, p.LIST, R, (int)gridDim.x, (int)blockIdx.x);
    if (which == 0) { pg8::Gemm g{p.H, p.Wgu, 0, 0, 1024}; pg8::EpiSwiGLU E{p.he}; pg8::gemm_phase<pg8::EpiSwiGLU, pg8::MoeOrder, PG8_ALIGN, PG8_SP2, true>(lds, g, S, E); }
    else { pg8::Gemm g{p.he, p.Wd, 0, 0, 512}; pg8::EpiRowScale E{p.slots, p.LISTW, R}; pg8::gemm_phase<pg8::EpiRowScale, pg8::MoeOrder, PG8_ALIGN, PG8_SP2>(lds, g, S, E); }
}
__device__ __forceinline__ void run_step(const P& p, int step, unsigned char* smem) {
    LAS unsigned char* lds = (LAS unsigned char*)smem; float* fl = (float*)smem;
    float* conv = (float*)p.H;
    switch (step) {
        case 0: ph_ada_fast(p, fl); ph_rope_table(p); ph_wconv_l0(p, fl); if (gridDim.x != 256) ph_wconv_moe_fast(p, 0, fl); break;
        case 1: ph_mod_fast(p, 0, 0, p.in[0], p.in[2]); ph_filters(p, smem); break;
        case 2: { pg8::EpiInL0 E{p.Zr, p.hyT, p.A2, RL, L, CTX, RB}; dense_gemm(lds, p.H, p.Win0, R, ABIN, D, E); }
                 if (gridDim.x == 256) ph_wconv_moe_part(p, 0, 1, fl, (int)blockIdx.x - 156, 100); break;
        case 3: break;
        case 4: ph_retU_mfma(p, smem); ph_hyena_fft(p, smem); break;
        case 5: ph_retScan_fast(p); break;
        case 6: break;
        case 7: break;
        case 8: break;
        case 9: ph_retO_mfma(p, smem); ph_hy_untranspose_fast(p, fl); break;
        case 10: ph_hy_untranspose_fast(p, fl); break;
        case 11: { pg8::EpiSplit E{p.Zr, 1024, p.Zr, 1024, 1 << 30}; dense_gemm(lds, p.H, p.Wout0, R, D, D, E); }
                 if (gridDim.x == 256) ph_wconv_moe_part(p, 0, 0, fl, (int)blockIdx.x - 8, 248); break;
        case 12: ph_post_fast<0, true>(p, 0, 0, p.Zr, 0, 1, R, p.in[0], p.in[2], fl); break;
        case 13: break;
        case 14: break;
        case 15: break;
        case 16: moe_gemms(p, lds, 0, 0); break;
        case 17: moe_gemms(p, lds, 0, 1); ph_wconv_l1(p, fl); break;
        case 18: ph_post_fast<1, false>(p, 0, 1, nullptr, 1, 0, R, p.out, p.Xc, fl); break;
        case 19: { pg8::EpiSplit E{p.Z1, GINP, p.Z1, GINP, 1 << 30}; dense_gemm(lds, p.H, p.Win1, R, GINP, D, E); } ph_wconv_moe_fast(p, 1, fl); break;
        case 20: break;
        case 21: break;
        case 22: ph_glaU_mfma(p, smem); break;
        case 23: ph_glaScan_fast(p); break;
        case 24: ph_glaO_mfma(p, smem); break;
        case 25: break;
        case 26: { pg8::EpiSplit E{p.Zr, 1024, p.Zr, 1024, 1 << 30}; dense_gemm(lds, p.H, p.Wout1, RL, D, D, E); } break;
        case 27: ph_post_fast<0, true>(p, 1, 0, p.Zr, 1, 1, RL, p.out, p.Xc, fl); break;
        case 28: break;
        case 29: break;
        case 30: break;
        case 31: moe_gemms(p, lds, 1, 0); break;
        case 32: moe_gemms(p, lds, 1, 1); break;
        case 33: ph_post_fast<1, false>(p, 1, 1, nullptr, -1, 0, RL, p.out, p.Xc, fl); break;
    }
}
__global__ void __launch_bounds__(NT, 2) k_all(P p) {
    extern __shared__ __attribute__((aligned(16))) unsigned char smem[];
    cg::grid_group grid = cg::this_grid();
    volatile LAS unsigned* bst = (volatile LAS unsigned*)((LAS unsigned char*)smem + LDS_BYTES - 64);
    if (threadIdx.x < 2) bst[threadIdx.x] = 0u;
    __syncthreads();
    const XcdBarrier bar = xcd_barrier_post(p.BAR, bst);
#define STEP(n) run_step(p, n, smem); xcd_barrier(bar);
#define STEP_CG(n) run_step(p, n, smem); asm volatile("s_waitcnt vmcnt(0)" ::: "memory"); grid.sync();
    STEP_CG(0) STEP(1) STEP(2) STEP(4) STEP(5) STEP(9) STEP(11) STEP(12) STEP(16)
    STEP(17) STEP(18) STEP(19) STEP(22) STEP(23) STEP(24) STEP(26) STEP(27) STEP(31) STEP(32) run_step(p, 33, smem);
#undef STEP
#undef STEP_CG
}

extern "C" void kernel_launch(void* const* d_in, const int* in_sizes, int n_in, void* d_out, int out_size, void* d_ws, size_t ws_size, hipStream_t stream) {
    P p{};
    for (int i = 0; i < 34; ++i) p.in[i] = (const float*)d_in[i];
    p.out = (float*)d_out;
    unsigned char* w = (unsigned char*)d_ws; size_t off = 0;
    auto take = [&](size_t bytes) { unsigned char* r = w + off; off += (bytes + 255) & ~(size_t)255; return r; };
    p.NORM = (float*)take(2 * 2048 * 4); p.CNT = (int*)take(2 * 16 * 4); p.BAR = (unsigned*)take(XCD_BAR_WORDS * 4);
    const size_t ctl_bytes = off;
    p.Win1 = (bf16_t*)take((size_t)GINP * D * 2); p.Wout1 = (bf16_t*)take((size_t)D * D * 2);
    p.Wgu = (bf16_t*)take((size_t)NE * 1024 * 1024 * 2); p.Wd = (bf16_t*)take((size_t)NE * 1024 * 512 * 2);
    p.Xc = (float*)take((size_t)RCX * D * 4); p.MOD = (float*)take(2 * 3 * 6144 * 4);
    p.RS = (float*)take((size_t)R * NE * 4); p.RE = (int*)take((size_t)R * 2 * 4); p.RPOS = (int*)take((size_t)R * 2 * 4); p.RWt = (float*)take((size_t)R * 2 * 4);
    p.WS = (float*)take((size_t)MOE_ROWS * 4);
    p.LIST = (int*)take((size_t)NE * R * 4); p.LISTW = (float*)take((size_t)NE * R * 4);
    const size_t big = off;
    p.H = (bf16_t*)take((size_t)R * D * 2);
    p.Zr = (bf16_t*)take((size_t)R * 2048 * 2);
    p.Zh = (bf16_t*)take((size_t)R * 1536 * 2);
    p.hyT = (bf16_t*)take((size_t)NB * 3 * 512 * RB * 2);
    p.FILT = (float*)take((size_t)2048 * RB * 4);
    p.Win0 = (bf16_t*)take((size_t)ABIN * D * 2); p.Wout0 = (bf16_t*)take((size_t)D * D * 2);
    p.A1 = (float*)take((size_t)RB * 64 * 4); p.A2 = (float*)take((size_t)RB * 64 * 4);
    const size_t total = off;
    off = big + (((size_t)R * D * 2 + 255) & ~(size_t)255);
    p.Hs = (bf16_t*)take((size_t)MOE_ROWS * D * 2); p.he = (bf16_t*)take((size_t)MOE_ROWS * EH * 2); p.slots = (bf16_t*)take((size_t)MOE_ROWS * D * 2);
    const size_t moe_end = off;
    off = big + (((size_t)R * D * 2 + 255) & ~(size_t)255);
    p.Z1 = (bf16_t*)take((size_t)R * GINP * 2); p.BG = (float*)take((size_t)2 * R * 512 * 4); p.GST = (bf16_t*)take((size_t)2 * NB * 4 * NCH * 32768 * 2);
    const size_t l1_end = off;
    if (total > ws_size || moe_end > total || l1_end > total || n_in != 34 || out_size != RL * D) {
        fprintf(stderr, "kernel_launch: bad sizes (need %zu ws bytes, have %zu; moe_end %zu l1_end %zu)\n", total, ws_size, moe_end, l1_end); return; }
    static int grid = 0;
    if (!grid) {
        int dev = 0, cus = 0, per = 0; hipGetDevice(&dev); hipDeviceGetAttribute(&cus, hipDeviceAttributeMultiprocessorCount, dev);
        hipFuncSetAttribute((const void*)k_all, hipFuncAttributeMaxDynamicSharedMemorySize, LDS_BYTES);
        hipOccupancyMaxActiveBlocksPerMultiprocessor(&per, k_all, NT, LDS_BYTES);
        if (per < 1) { fprintf(stderr, "kernel_launch: occupancy query says %d blocks per CU\n", per); per = 1; }
        grid = cus < 256 ? cus : 256;
    }
    hipMemsetAsync(d_ws, 0, ctl_bytes, stream);
    void* args[] = {&p};
    hipError_t e = hipLaunchCooperativeKernel((void*)k_all, dim3(grid), dim3(NT), args, LDS_BYTES, stream);
    if (e != hipSuccess) fprintf(stderr, "coop launch failed: %s (grid %d)\n", hipGetErrorString(e), grid);
}
```
